# Optimizing an MI355X kernel written in HIP

```python
import numpy as np
import jax, jax.numpy as jnp
from jax import lax

D_MODEL = 1024
BATCH = 8
SEQ = 4096
DEPTH = 4

HEAD_DIM = 64
ROPE_THETA = 10000.0
NORM_EPS = 1e-6
BLOCK = 128
NEG = -1e30

A_HEADS = 4
A_PAIRS = ((128, 1), (512, 4), (2048, 16))

B_HEADS = 8
B_KV_GROUPS = 2
CMP_LEN = 32
CMP_STRIDE = 16
CMP_HIDDEN = 256
SLC_BLOCK = 64
N_SELECT = 16
WINDOW = 512
SLC_QCHUNK = 64
FORCE_BONUS = 1e4

C_HEADS = 4
Q_LORA = 256
KV_LORA = 128
QK_NOPE = 64
QK_ROPE = 32
V_DIM = 64

A_WIDTH = A_HEADS * HEAD_DIM
B_WIDTH = B_HEADS * HEAD_DIM
C_WIDTH = C_HEADS * V_DIM
MIX_WIDTH = A_WIDTH + B_WIDTH + C_WIDTH
B_KV_WIDTH = B_KV_GROUPS * HEAD_DIM
IN_SPLITS = (A_WIDTH, A_WIDTH, A_WIDTH, B_WIDTH, 6 * B_KV_WIDTH, 3 * B_HEADS, Q_LORA, KV_LORA, QK_ROPE)
IN_WIDTH = sum(IN_SPLITS)

N_EXPERTS = 32
TOP_K = 4
D_FF = 1024
SWIGLU_ALPHA = 1.702
SWIGLU_LIMIT = 7.0

kernel_name = "hybrid_dilated_nsa_mla_moe_adaln"

F32 = jnp.float32


def rms_norm(x, g):
    xf = x.astype(F32)
    y = xf * lax.rsqrt(jnp.mean(xf * xf, axis=-1, keepdims=True) + NORM_EPS)
    return (y * g.astype(F32)).astype(x.dtype)


def rope(t, pos):
    dim = t.shape[-1]
    half = dim // 2
    inv = jnp.power(ROPE_THETA, -jnp.arange(half, dtype=F32) * (2.0 / dim))
    ang = pos.astype(F32)[..., None] * inv
    cos = jnp.cos(ang)[:, :, None, :]
    sin = jnp.sin(ang)[:, :, None, :]
    t1 = t[..., :half].astype(F32)
    t2 = t[..., half:].astype(F32)
    return jnp.concatenate([t1 * cos - t2 * sin, t2 * cos + t1 * sin], axis=-1).astype(t.dtype)


def masked_softmax(s, mask):
    s = jnp.where(mask, s, NEG)
    m = jnp.max(s, axis=-1, keepdims=True)
    e = jnp.where(mask, jnp.exp(s - m), 0.0)
    den = jnp.sum(e, axis=-1, keepdims=True)
    return e / jnp.where(den > 0, den, 1.0), m, den


def banded_attention(q, k, v, max_dist, block):
    N, L, H, dh = q.shape
    G = k.shape[2]
    hpg = H // G
    nb = L // block
    n_prev = -(-max_dist // block)
    pad = n_prev * block
    kp = jnp.pad(k, ((0, 0), (pad, 0), (0, 0), (0, 0))).reshape(N, nb + n_prev, block, G, dh)
    vp = jnp.pad(v, ((0, 0), (pad, 0), (0, 0), (0, 0))).reshape(N, nb + n_prev, block, G, v.shape[-1])
    kb = jnp.concatenate([kp[:, j:j + nb] for j in range(n_prev + 1)], axis=2)
    vb = jnp.concatenate([vp[:, j:j + nb] for j in range(n_prev + 1)], axis=2)
    qb = q.reshape(N, nb, block, G, hpg, dh)
    s = jnp.einsum('nbqghd,nbkgd->nbghqk', qb, kb, preferred_element_type=F32) * (dh ** -0.5)
    n_keys = (n_prev + 1) * block
    qi = np.arange(block)[:, None] + pad
    ki = np.arange(n_keys)[None, :]
    dist = qi - ki
    band = (dist >= 0) & (dist <= max_dist)
    key_abs = np.arange(nb)[:, None] * block + np.arange(n_keys)[None, :] - pad
    mask = jnp.asarray(band[None] & (key_abs >= 0)[:, None, :])
    p, m, den = masked_softmax(s, mask[None, :, None, None])
    o = jnp.einsum('nbghqk,nbkgd->nbqghd', p.astype(v.dtype), vb).reshape(N, L, H, v.shape[-1])
    lse = (m + jnp.log(den))[..., 0].transpose(0, 1, 4, 2, 3).reshape(N, L, H)
    return o, lse


def dilated_attention(q, k, v):
    B, S, H, dh = q.shape
    outs, lses = [], []
    for window, d in A_PAIRS:
        L = S // d
        Lp = -(-L // BLOCK) * BLOCK

        def regroup(t):
            t = t.reshape(B, L, d, H, dh).transpose(0, 2, 1, 3, 4).reshape(B * d, L, H, dh)
            return jnp.pad(t, ((0, 0), (0, Lp - L), (0, 0), (0, 0)))

        o, lse = banded_attention(regroup(q), regroup(k), regroup(v), window // d, BLOCK)
        outs.append(o[:, :L].reshape(B, d, L, H, dh).transpose(0, 2, 1, 3, 4).reshape(B, S, H, dh))
        lses.append(lse[:, :L].reshape(B, d, L, H).transpose(0, 2, 1, 3).reshape(B, S, H))
    w = jax.nn.softmax(jnp.stack(lses, axis=0), axis=0)
    o = jnp.sum(w[..., None] * jnp.stack(outs, axis=0).astype(F32), axis=0)
    return o.astype(q.dtype)


def compress_blocks(t, cmp_idx, pos_emb, w1, b1, w2, b2):
    blk = t[:, cmp_idx] + pos_emb[None, :, None, :].astype(t.dtype)
    Bn, n, l, G, dh = blk.shape
    flat = blk.transpose(0, 1, 3, 2, 4).reshape(Bn, n, G, l * dh)
    return jax.nn.gelu(flat @ w1 + b1) @ w2 + b2


def native_sparse_attention(q, k_cmp, v_cmp, k_slc, v_slc, k_win, v_win, gate_logits, pos,
                            pos_k, pos_v, w1_k, b1_k, w2_k, b2_k, w1_v, b1_v, w2_v, b2_v):
    B, S, H, dh = q.shape
    G = B_KV_GROUPS
    hpg = H // G
    scale = dh ** -0.5
    q = rope(q, pos)
    qg = q.reshape(B, S, G, hpg, dh)
    t_idx = np.arange(S)

    n_cmp = (S - CMP_LEN) // CMP_STRIDE + 1
    cmp_idx = np.arange(n_cmp)[:, None] * CMP_STRIDE + np.arange(CMP_LEN)[None, :]
    cmp_end = cmp_idx[:, -1]
    kc = compress_blocks(k_cmp, cmp_idx, pos_k, w1_k, b1_k, w2_k, b2_k)
    kc = rope(kc, pos[:, cmp_end])
    vc = compress_blocks(v_cmp, cmp_idx, pos_v, w1_v, b1_v, w2_v, b2_v)
    s_cmp = jnp.einsum('bsghd,bcgd->bghsc', qg, kc, preferred_element_type=F32) * scale
    cmp_mask = jnp.asarray(cmp_end[None, :] <= t_idx[:, None])
    p_cmp, _, _ = masked_softmax(s_cmp, cmp_mask)
    o_cmp = jnp.einsum('bghsc,bcgd->bsghd', p_cmp.astype(vc.dtype), vc).reshape(B, S, H, dh)

    n_slc = S // SLC_BLOCK
    overlap = ((cmp_idx[:, :, None] // SLC_BLOCK) == np.arange(n_slc)[None, None, :]).mean(axis=1)
    imp = jnp.sum(p_cmp, axis=2) @ jnp.asarray(overlap.astype(np.float32))
    blk_j = np.arange(n_slc)[None, :]
    cur = (t_idx // SLC_BLOCK)[:, None]
    valid = jnp.asarray(blk_j * SLC_BLOCK <= t_idx[:, None])
    forced = jnp.asarray((blk_j == 0) | (blk_j == cur) | (blk_j == cur - 1))
    score = jnp.where(forced, imp + FORCE_BONUS, jnp.where(valid, imp, -1.0))
    n_sel = min(N_SELECT, n_slc)
    _, sel = lax.top_k(score, n_sel)

    k_slc = rope(k_slc, pos)
    kbt = k_slc.reshape(B, n_slc, SLC_BLOCK, G, dh).transpose(0, 3, 1, 2, 4)
    vbt = v_slc.reshape(B, n_slc, SLC_BLOCK, G, dh).transpose(0, 3, 1, 2, 4)
    nq = S // SLC_QCHUNK
    q_chunks = qg.reshape(B, nq, SLC_QCHUNK, G, hpg, dh).transpose(1, 0, 2, 3, 4, 5)
    sel_chunks = sel.reshape(B, G, nq, SLC_QCHUNK, n_sel).transpose(2, 0, 1, 3, 4)
    bi = jnp.arange(B)[:, None, None, None]
    gi = jnp.arange(G)[None, :, None, None]

    def select_step(args):
        qc, sc, i = args
        kg = kbt[bi, gi, sc].reshape(B, G, SLC_QCHUNK, n_sel * SLC_BLOCK, dh)
        vg = vbt[bi, gi, sc].reshape(B, G, SLC_QCHUNK, n_sel * SLC_BLOCK, dh)
        kpos = sc[..., None] * SLC_BLOCK + jnp.arange(SLC_BLOCK)
        qpos = i * SLC_QCHUNK + jnp.arange(SLC_QCHUNK)
        mask = (kpos <= qpos[None, None, :, None, None]).reshape(B, G, SLC_QCHUNK, n_sel * SLC_BLOCK)
        s = jnp.einsum('bqghd,bgqkd->bghqk', qc, kg, preferred_element_type=F32) * scale
        p, _, _ = masked_softmax(s, mask[:, :, None])
        return jnp.einsum('bghqk,bgqkd->bqghd', p.astype(vg.dtype), vg)

    o_slc = lax.map(select_step, (q_chunks, sel_chunks, jnp.arange(nq)))
    o_slc = o_slc.transpose(1, 0, 2, 3, 4, 5).reshape(B, S, H, dh)

    o_win, _ = banded_attention(q, rope(k_win, pos), v_win, WINDOW - 1, BLOCK)

    g = jax.nn.sigmoid(gate_logits.astype(F32)).reshape(B, S, H, 3, 1)
    o = g[..., 0, :] * o_cmp + g[..., 1, :] * o_slc + g[..., 2, :] * o_win
    return o.astype(q.dtype).reshape(B, S, H * dh)


def blocked_causal_attention(q, k, v):
    B, S, H, dq = q.shape
    nq = S // BLOCK
    q_chunks = q.reshape(B, nq, BLOCK, H, dq).transpose(1, 0, 2, 3, 4)
    kpos = jnp.arange(S)

    def step(args):
        qb, i = args
        s = jnp.einsum('bqhd,bkhd->bhqk', qb, k, preferred_element_type=F32) * (dq ** -0.5)
        qpos = i * BLOCK + jnp.arange(BLOCK)
        p, _, _ = masked_softmax(s, kpos[None, :] <= qpos[:, None])
        return jnp.einsum('bhqk,bkhd->bqhd', p.astype(v.dtype), v)

    o = lax.map(step, (q_chunks, jnp.arange(nq)))
    return o.transpose(1, 0, 2, 3, 4).reshape(B, S, H, v.shape[-1])


def latent_attention(c_q, c_kv, k_rope, pos, g_q, g_kv, w_q_up, w_kv_up):
    B, S, _ = c_q.shape
    q = (rms_norm(c_q, g_q) @ w_q_up).reshape(B, S, C_HEADS, QK_NOPE + QK_ROPE)
    q = jnp.concatenate([q[..., :QK_NOPE], rope(q[..., QK_NOPE:], pos)], axis=-1)
    kv = (rms_norm(c_kv, g_kv) @ w_kv_up).reshape(B, S, C_HEADS, QK_NOPE + V_DIM)
    k_nope, v = kv[..., :QK_NOPE], kv[..., QK_NOPE:]
    kr = rope(k_rope[:, :, None, :], pos)
    k = jnp.concatenate([k_nope, jnp.broadcast_to(kr, (B, S, C_HEADS, QK_ROPE))], axis=-1)
    return blocked_causal_attention(q, k, v).reshape(B, S, C_WIDTH)


def clamped_swiglu(u):
    x_glu = jnp.minimum(u[..., ::2], SWIGLU_LIMIT)
    x_lin = jnp.clip(u[..., 1::2], -SWIGLU_LIMIT, SWIGLU_LIMIT)
    return x_glu * jax.nn.sigmoid(SWIGLU_ALPHA * x_glu) * (x_lin + 1.0)


def moe(h, w_router, b_router, w1, b1, w2, b2):
    B, S, D = h.shape
    hf = h.reshape(B * S, D)
    logits = (hf @ w_router + b_router).astype(F32)
    top_vals, top_idx = lax.top_k(logits, TOP_K)
    gate = jax.nn.softmax(top_vals, axis=-1)
    cw = jnp.sum(jax.nn.one_hot(top_idx, N_EXPERTS, dtype=F32) * gate[..., None], axis=1)
    y = jnp.zeros((B * S, D), F32)
    for e in range(N_EXPERTS):
        out = clamped_swiglu(hf @ w1[e] + b1[e]) @ w2[e] + b2[e]
        y = y + cw[:, e:e + 1] * out.astype(F32)
    return y.astype(h.dtype).reshape(B, S, D)


def split_cols(t, sizes):
    parts, off = [], 0
    for n in sizes:
        parts.append(t[..., off:off + n])
        off += n
    return parts


def setup_inputs(seed: int = 0) -> dict:
    key = jax.random.key(seed)
    ks = iter(jax.random.split(key, 48))

    def nrm(shape, scale):
        return jax.random.normal(next(ks), shape, F32) * scale

    def gain(shape):
        return 1.0 + nrm(shape, 0.02)

    L, D = DEPTH, D_MODEL
    return {
        "x": nrm((BATCH, SEQ, D), 1.0),
        "c": nrm((BATCH, D), 1.0),
        "positions": jnp.arange(SEQ, dtype=jnp.int32)[None, :]
                     + jax.random.randint(next(ks), (BATCH, 1), 0, 1024, dtype=jnp.int32),
        "w_ada": nrm((L, D, 6 * D), 0.5 * D ** -0.5),
        "b_ada": nrm((L, 6 * D), 0.01),
        "g_norm1": gain((L, D)),
        "g_norm2": gain((L, D)),
        "w_in": nrm((L, D, IN_WIDTH), D ** -0.5),
        "nsa_pos_k": nrm((L, CMP_LEN, HEAD_DIM), 0.1),
        "nsa_pos_v": nrm((L, CMP_LEN, HEAD_DIM), 0.1),
        "nsa_w1_k": nrm((L, CMP_LEN * HEAD_DIM, CMP_HIDDEN), (CMP_LEN * HEAD_DIM) ** -0.5),
        "nsa_b1_k": nrm((L, CMP_HIDDEN), 0.01),
        "nsa_w2_k": nrm((L, CMP_HIDDEN, HEAD_DIM), CMP_HIDDEN ** -0.5),
        "nsa_b2_k": nrm((L, HEAD_DIM), 0.01),
        "nsa_w1_v": nrm((L, CMP_LEN * HEAD_DIM, CMP_HIDDEN), (CMP_LEN * HEAD_DIM) ** -0.5),
        "nsa_b1_v": nrm((L, CMP_HIDDEN), 0.01),
        "nsa_w2_v": nrm((L, CMP_HIDDEN, HEAD_DIM), CMP_HIDDEN ** -0.5),
        "nsa_b2_v": nrm((L, HEAD_DIM), 0.01),
        "mla_g_q": gain((L, Q_LORA)),
        "mla_g_kv": gain((L, KV_LORA)),
        "mla_w_q_up": nrm((L, Q_LORA, C_HEADS * (QK_NOPE + QK_ROPE)), Q_LORA ** -0.5),
        "mla_w_kv_up": nrm((L, KV_LORA, C_HEADS * (QK_NOPE + V_DIM)), KV_LORA ** -0.5),
        "g_out_a": gain((L, A_WIDTH)),
        "g_out_b": gain((L, B_WIDTH)),
        "g_out_c": gain((L, C_WIDTH)),
        "w_out": nrm((L, MIX_WIDTH, D), MIX_WIDTH ** -0.5),
        "w_router": nrm((L, D, N_EXPERTS), D ** -0.5),
        "b_router": nrm((L, N_EXPERTS), 0.01),
        "w_exp1": nrm((L, N_EXPERTS, D, 2 * D_FF), D ** -0.5),
        "b_exp1": nrm((L, N_EXPERTS, 2 * D_FF), 0.01),
        "w_exp2": nrm((L, N_EXPERTS, D_FF, D), D_FF ** -0.5),
        "b_exp2": nrm((L, N_EXPERTS, D), 0.01),
        "g_final": gain((D,)),
    }


def reference(x, c, positions, w_ada, b_ada, g_norm1, g_norm2, w_in,
              nsa_pos_k, nsa_pos_v, nsa_w1_k, nsa_b1_k, nsa_w2_k, nsa_b2_k,
              nsa_w1_v, nsa_b1_v, nsa_w2_v, nsa_b2_v,
              mla_g_q, mla_g_kv, mla_w_q_up, mla_w_kv_up,
              g_out_a, g_out_b, g_out_c, w_out,
              w_router, b_router, w_exp1, b_exp1, w_exp2, b_exp2, g_final):
    B, S, D = x.shape
    c_act = jax.nn.silu(c.astype(F32))
    for l in range(DEPTH):
        mods = (c_act @ w_ada[l].astype(F32) + b_ada[l].astype(F32)).reshape(B, 6, D)
        sh1, sc1, gt1, sh2, sc2, gt2 = [mods[:, i, None, :] for i in range(6)]

        h = (rms_norm(x, g_norm1[l]).astype(F32) * (1.0 + sc1) + sh1).astype(x.dtype)
        proj = h @ w_in[l]
        qa, ka, va, qb, kvb, gb, cq, ckv, kr = split_cols(proj, IN_SPLITS)

        qa = rope(qa.reshape(B, S, A_HEADS, HEAD_DIM), positions)
        ka = rope(ka.reshape(B, S, A_HEADS, HEAD_DIM), positions)
        oa = dilated_attention(qa, ka, va.reshape(B, S, A_HEADS, HEAD_DIM)).reshape(B, S, A_WIDTH)

        kvb = kvb.reshape(B, S, 6, B_KV_GROUPS, HEAD_DIM)
        ob = native_sparse_attention(
            qb.reshape(B, S, B_HEADS, HEAD_DIM),
            kvb[:, :, 0], kvb[:, :, 1], kvb[:, :, 2], kvb[:, :, 3], kvb[:, :, 4], kvb[:, :, 5],
            gb, positions,
            nsa_pos_k[l], nsa_pos_v[l], nsa_w1_k[l], nsa_b1_k[l], nsa_w2_k[l], nsa_b2_k[l],
            nsa_w1_v[l], nsa_b1_v[l], nsa_w2_v[l], nsa_b2_v[l])

        oc = latent_attention(cq, ckv, kr, positions, mla_g_q[l], mla_g_kv[l],
                              mla_w_q_up[l], mla_w_kv_up[l])

        mixed = jnp.concatenate([rms_norm(oa, g_out_a[l]), rms_norm(ob, g_out_b[l]),
                                 rms_norm(oc, g_out_c[l])], axis=-1) @ w_out[l]
        x = (x.astype(F32) + gt1 * mixed.astype(F32)).astype(x.dtype)

        h2 = (rms_norm(x, g_norm2[l]).astype(F32) * (1.0 + sc2) + sh2).astype(x.dtype)
        y = moe(h2, w_router[l], b_router[l], w_exp1[l], b_exp1[l], w_exp2[l], b_exp2[l])
        x = (x.astype(F32) + gt2 * y.astype(F32)).astype(x.dtype)
    return rms_norm(x, g_final)
```

```cpp
#include <hip/hip_runtime.h>
#include <cstdio>
#include <cstdint>

#ifndef MK_PER_PHASE
#define MK_PER_PHASE 0
#endif

#ifndef PH_MASK
#define PH_MASK 0xFFFFFFFFu
#endif
#define PHON(k) ((PH_MASK >> (k)) & 1u)
#ifndef DBL_MASK
#define DBL_MASK 0u
#endif
#define NREP(k) (((DBL_MASK >> (k)) & 1u) ? 2 : 1)
#ifndef DUM_MASK
#define DUM_MASK 0u
#endif
#define DUM(k) ((DUM_MASK >> (k)) & 1u)
#ifndef ATT_VAR
#define ATT_VAR 0
#endif
#ifndef CONV_IN_LAYER
#define CONV_IN_LAYER 1
#endif
#ifndef ATT_STAGGER
#define ATT_STAGGER 0
#endif
#define DI __device__ __forceinline__
#define LAS __attribute__((address_space(3)))
#define GAS __attribute__((address_space(1)))
typedef unsigned short bf16;
typedef short bf16x8 __attribute__((ext_vector_type(8)));
typedef short s16x4 __attribute__((ext_vector_type(4)));
typedef float f32x2 __attribute__((ext_vector_type(2)));
typedef float f32x4 __attribute__((ext_vector_type(4)));
typedef float f32x16 __attribute__((ext_vector_type(16)));
typedef unsigned u32x2 __attribute__((ext_vector_type(2)));
typedef unsigned u32x4 __attribute__((ext_vector_type(4)));
typedef __bf16 bf16x2_t __attribute__((ext_vector_type(2)));
typedef unsigned long long u64;

constexpr int NB = 8, S = 4096, T = NB * S, D = 1024, DEPTH = 4;
constexpr int NIN = 2560;
constexpr int NE = 32, DFF = 1024;
constexpr int SP = S + 64;
constexpr int ECAP = 32768;
constexpr int ACT_ROWS = 4 * T + NE * 256;
constexpr float LOG2E = 1.4426950408889634f;
constexpr float SCL64 = 0.125f * LOG2E;
constexpr float SCL96 = 0.10206207261596577f * LOG2E;
constexpr float EPS = 1e-6f;

constexpr size_t MiB = 1u << 20;
constexpr size_t WS_CTL = 0, CTL_ZERO_BYTES = 2 * MiB;
constexpr size_t WS_MODS = 2 * MiB, WS_B1P = 3 * MiB, WS_CS64 = 4 * MiB, WS_CS32 = 12 * MiB;
constexpr size_t WS_WIN = 16 * MiB, WS_WOUT = 36 * MiB, WS_NSAW1 = 44 * MiB, WS_MLAQ = 52 * MiB, WS_MLAKV = 53 * MiB;
constexpr size_t WS_W1E = 64 * MiB, WS_W2E = 576 * MiB;
constexpr size_t WS_X = 832 * MiB, WS_H = 960 * MiB;
constexpr size_t WS_QA = 1024 * MiB, WS_KA = 1040 * MiB, WS_VA = 1056 * MiB, WS_QB = 1072 * MiB;
constexpr size_t WS_KCMP = 1104 * MiB, WS_VCMP = 1113 * MiB;
constexpr size_t WS_KSLC = 1122 * MiB, WS_VSLC = 1130 * MiB, WS_KWIN = 1138 * MiB, WS_VWIN = 1146 * MiB;
constexpr size_t WS_CQ = 1154 * MiB, WS_MISC = 1170 * MiB;
constexpr size_t WS_RSTDQ = 1186 * MiB, WS_RSTDKV = 1186 * MiB + 512 * 1024, WS_KR = 1187 * MiB, WS_GATES = 1189 * MiB;
constexpr size_t WS_W2T = 1195 * MiB;
constexpr size_t WS_HID = 1192 * MiB, WS_KC = 1196 * MiB, WS_VC = 1196 * MiB + 512 * 1024;
constexpr size_t WS_QM = 1197 * MiB, WS_KN = 1221 * MiB, WS_VM = 1237 * MiB;
constexpr size_t WS_OA3 = 1253 * MiB, WS_LSEA = 1301 * MiB;
constexpr size_t WS_OCMP = 1303 * MiB, WS_OSLC = 1335 * MiB, WS_OWIN = 1367 * MiB, WS_OC = 1399 * MiB;
constexpr size_t WS_SEL = 1415 * MiB, WS_AMIX = 1416 * MiB;
constexpr size_t WS_IDX = 1480 * MiB, WS_GATEW = 1484 * MiB, WS_TOKSLOT = 1488 * MiB;
constexpr size_t WS_ACT = 1489 * MiB, WS_Y2 = 1761 * MiB, WS_END = 2033 * MiB;
static_assert((size_t)ACT_ROWS * 1024 * 2 <= 272 * MiB, "act rows");
static_assert((size_t)16 * SP * 64 * 2 + 65536 <= 9 * MiB, "kcmp");

constexpr int CW_TMO = 0, CW_FAIL = 2;
constexpr int CW_BAR = 4096;
constexpr int CW_QUEUE = 12288;
constexpr int CW_CNT = 16384;

constexpr int RING_BYTES = 131072;
constexpr int AUX_OFF = RING_BYTES;
constexpr int MISC_OFF = AUX_OFF + 8192;
constexpr int LDS_BYTES = 147456;

DI unsigned pk2(float lo, float hi) { f32x2 v = {lo, hi}; bf16x2_t b = __builtin_convertvector(v, bf16x2_t); return __builtin_bit_cast(unsigned, b); }
DI float bf2f(unsigned short h) { return __uint_as_float(((unsigned)h) << 16); }
DI float bflo(unsigned w) { return __uint_as_float(w << 16); }
DI float bfhi(unsigned w) { return __uint_as_float(w & 0xffff0000u); }
typedef float f32x2c __attribute__((ext_vector_type(2)));
constexpr float Y2_SCALE = 16.0f, Y2_ISCALE = 1.0f / 16.0f;
DI unsigned pk4_fp8(float a, float b, float c, float d) {
    a = fminf(fmaxf(a * Y2_SCALE, -440.f), 440.f); b = fminf(fmaxf(b * Y2_SCALE, -440.f), 440.f); c = fminf(fmaxf(c * Y2_SCALE, -440.f), 440.f); d = fminf(fmaxf(d * Y2_SCALE, -440.f), 440.f);
    int w = __builtin_amdgcn_cvt_pk_fp8_f32(a, b, 0, false); w = __builtin_amdgcn_cvt_pk_fp8_f32(c, d, w, true); return (unsigned)w; }
DI f32x4 unpk4_fp8(unsigned w) { const f32x2c lo = __builtin_amdgcn_cvt_pk_f32_fp8((int)w, false), hi = __builtin_amdgcn_cvt_pk_f32_fp8((int)w, true); return (f32x4){lo.x, lo.y, hi.x, hi.y}; }
constexpr float W8_SCALE = 64.0f, A8_SCALE = 4.0f;
constexpr int W8_E8M0 = 127 - 6, A8_E8M0 = 127 - 2;
constexpr float H8_SCALE = 8.0f; constexpr int H8_E8M0 = 127 - 3;
DI int lane_id() { return (int)__builtin_amdgcn_mbcnt_hi(~0u, __builtin_amdgcn_mbcnt_lo(~0u, 0u)); }
DI unsigned pk4_fp8s(float a, float b, float c, float d, float sc) {
    a = fminf(fmaxf(a * sc, -440.f), 440.f); b = fminf(fmaxf(b * sc, -440.f), 440.f); c = fminf(fmaxf(c * sc, -440.f), 440.f); d = fminf(fmaxf(d * sc, -440.f), 440.f);
    int w = __builtin_amdgcn_cvt_pk_fp8_f32(a, b, 0, false); w = __builtin_amdgcn_cvt_pk_fp8_f32(c, d, w, true); return (unsigned)w; }
DI float q8s(float x, float sc) {
    const float a = fminf(fmaxf(x * sc, -440.f), 440.f); const int w = __builtin_amdgcn_cvt_pk_fp8_f32(a, a, 0, false);
    const f32x2c r = __builtin_amdgcn_cvt_pk_f32_fp8(w, false); return r.x; }
DI float wave_sum(float v) {
#pragma unroll
    for (int o = 1; o < 64; o <<= 1) v += __shfl_xor(v, o);
    return v;
}
DI float fast_exp2(float x) { return __builtin_amdgcn_exp2f(x); }
DI float fast_rcp(float x) { return __builtin_amdgcn_rcpf(x); }
DI float sigmoidf_(float x) { return fast_rcp(1.0f + fast_exp2(-x * LOG2E)); }
#define RLX_AGENT __ATOMIC_RELAXED, __HIP_MEMORY_SCOPE_AGENT

#define XB_TMO      128
#define XB_XCNT(j)  (256  + 64 * (j))
#define XB_XSUB(j)  (1280 + 64 * (j))
#define XB_XGEN(j)  (2304 + 64 * (j))
#define XB_TOP      3328
#define XB_TOPGEN   3392
#define XCD_BAR_WORDS 3456
#define XB_SPIN_CAP (1u << 22)
DI unsigned xb_ld(unsigned* p)              { return __hip_atomic_load(p, __ATOMIC_RELAXED, __HIP_MEMORY_SCOPE_AGENT); }
DI unsigned xb_add(unsigned* p, unsigned v) { return __hip_atomic_fetch_add(p, v, __ATOMIC_RELAXED, __HIP_MEMORY_SCOPE_AGENT); }
DI unsigned xb_xcc_id() { return (unsigned)__builtin_amdgcn_s_getreg((3 << 11) | 20) & 0xFu; }
#define XB_SPIN(cond, bar) do { unsigned _sp = 0; while (cond) { __builtin_amdgcn_s_sleep(1); \
    if ((++_sp & 255u) == 0u) { if (xb_ld(&(bar)[XB_TMO])) break; if (_sp > XB_SPIN_CAP) { atomicAdd(&(bar)[XB_TMO], 1u); break; } } } } while (0)
struct XcdBarrier { unsigned* bar; unsigned x; volatile LAS unsigned* st; };
DI XcdBarrier xcd_barrier_post(unsigned* bar, volatile LAS unsigned* st) {
    XcdBarrier b; b.bar = bar; b.x = xb_xcc_id(); b.st = st;
    if (threadIdx.x == 0) (void)xb_add(&bar[XB_XCNT(b.x)], 1u);
    return b;
}
DI void xcd_barrier_complete(unsigned* bar, unsigned x, unsigned& nloc, unsigned& nx) {
    const unsigned G = gridDim.x * gridDim.y * gridDim.z;
    unsigned sum, cnt, mine, sp = 0u;
    for (;;) {
        sum = 0u; cnt = 0u; mine = 0u;
#pragma unroll
        for (unsigned j = 0; j < 16; ++j) { const unsigned c = xb_ld(&bar[XB_XCNT(j)]); sum += c; cnt += (c > 0u) ? 1u : 0u; mine = (j == x) ? c : mine; }
        if (sum == G) break;
        __builtin_amdgcn_s_sleep(1);
        if ((++sp & 255u) == 0u) { if (xb_ld(&bar[XB_TMO])) break; if (sp > XB_SPIN_CAP) { atomicAdd(&bar[XB_TMO], 1u); break; } }
    }
    nloc = mine > 0u ? mine : 1u; nx = cnt > 0u ? cnt : 1u;
}
DI void xcd_barrier(const XcdBarrier& b) {
    asm volatile("s_waitcnt vmcnt(0)" ::: "memory");
    __syncthreads();
    unsigned* bar = b.bar; asm volatile("" : "+s"(bar));
    if (threadIdx.x == 0) {
        __builtin_amdgcn_s_waitcnt(0);
        unsigned nloc = b.st[0], nx = b.st[1];
        if (nloc == 0u) { xcd_barrier_complete(bar, b.x, nloc, nx); b.st[0] = nloc; b.st[1] = nx; }
        const unsigned old = xb_add(&bar[XB_XSUB(b.x)], 1u);
        const unsigned gen = old / nloc;
        if (old + 1u == (gen + 1u) * nloc) {
            __builtin_amdgcn_fence(__ATOMIC_RELEASE, "agent");
            asm volatile("s_waitcnt vmcnt(0)" ::: "memory");
            const unsigned og = xb_add(&bar[XB_TOP], 1u);
            const unsigned tg = og / nx;
            if (og + 1u == (tg + 1u) * nx) xb_add(&bar[XB_TOPGEN], 1u);
            else XB_SPIN(xb_ld(&bar[XB_TOPGEN]) == tg, bar);
            __builtin_amdgcn_fence(__ATOMIC_ACQUIRE, "agent");
            xb_add(&bar[XB_XGEN(b.x)], 1u);
            asm volatile("s_waitcnt vmcnt(0)" ::: "memory");
        } else {
            XB_SPIN(xb_ld(&bar[XB_XGEN(b.x)]) == gen, bar);
            __builtin_amdgcn_fence(__ATOMIC_ACQUIRE, "agent");
            asm volatile("s_waitcnt vmcnt(0)" ::: "memory");
        }
    }
    __syncthreads();
}

struct Args {
    const float* in[33];
    float* out;
    unsigned char* ws;
    int ph_lo, ph_hi;
};
enum { I_X = 0, I_C, I_POS, I_WADA, I_BADA, I_G1, I_G2, I_WIN, I_POSK, I_POSV, I_W1K, I_B1K, I_W2K, I_B2K, I_W1V, I_B1V, I_W2V, I_B2V,
       I_GQ, I_GKV, I_WQUP, I_WKVUP, I_GOA, I_GOB, I_GOC, I_WOUT, I_WR, I_BR, I_WE1, I_BE1, I_WE2, I_BE2, I_GF };

struct Ctx {
    LAS unsigned char* lds;
    const Args* a;
    unsigned char* ws;
    int tid, lane, wave, blk, G, vcu;
    size_t dofs; int dcnt;
};
DI const float* ginp(const Ctx& F, int i) { return (const float*)(GAS const float*)(F.a->in[i]); }
DI float* gout(const Ctx& F) { return (float*)(GAS float*)(F.a->out); }

namespace pg8 {
constexpr int BM = 256, BK = 64, HALF = 128, HTB = HALF * BK * 2;
DI int lds_byte(int r, int c) { const int st = (r >> 4) * 2 + (c >> 5), rr = r & 15, cc = c & 31, ob = rr * 64 + cc * 2; return st * 1024 + (ob ^ (((ob >> 9) & 1) << 5)); }
DI void stage_rc(int b, int& R, int& C) { const int st = b / 1024, sb = b % 1024, swz = sb ^ (((sb >> 9) & 1) << 5); R = (st >> 1) * 16 + swz / 64; C = (st & 1) * 32 + (swz % 64) / 2; }
DI int perm32(int rho) { const int n = rho >> 4, i = rho & 15; return 8 * (i >> 2) + 4 * n + (i & 3); }
struct Unit { const char* a; const char* b; int pm, pn, e, ml; };

template <class Epi, class Sched, bool GATHER, bool FP8 = false>
DI void gemm_phase(LAS unsigned char* lds, const int lda, const int K, const Sched& S, const Epi& E) {
    typedef int i32x4_ __attribute__((ext_vector_type(4))); typedef int i32x8_ __attribute__((ext_vector_type(8)));
    int tid_ = threadIdx.x; asm volatile("" : "+v"(tid_));
    const int tid = tid_, wid = __builtin_amdgcn_readfirstlane(tid >> 6), lane = tid & 63, wr = wid >> 2, wc = wid & 3, fr = lane & 15, fq = lane >> 4;
    const int nt = K / BK;
    int Rr[2], Cc[2]; unsigned voffB[2];
#pragma unroll
    for (int i = 0; i < 2; ++i) { int R, C; stage_rc(tid * 16 + i * 8192, R, C); Rr[i] = R; Cc[i] = C; const int Rb = Epi::PERM ? ((R & ~31) + perm32(R & 31)) : R; voffB[i] = (unsigned)(Rb * K + C) * 2u; }
    const size_t kstep = (size_t)(BK * 2);
    const size_t hstepB = (size_t)HALF * K * 2;
    const unsigned ldsw = (unsigned)wid * 1024u;
    const int aoff = lds_byte(wr * 64 + fr, fq * 8), boff = lds_byte(wc * 32 + fr, fq * 8);
#define PG8_SA(b, h) (((b) * 2 + (h)) * HTB)
#define PG8_SB(b, h) ((4 + (b) * 2 + (h)) * HTB)
#define PG8_STAGE_B(bufoff, gbase) do { _Pragma("unroll") for (int _i = 0; _i < 2; ++_i) \
        __builtin_amdgcn_global_load_lds((const unsigned*)((const char*)(gbase) + (size_t)_i * 64 * K * 2 + voffB[0]), (LAS unsigned*)(lds + (bufoff) + ldsw + _i * 8192), 16, 0, 0); } while (0)
#define PG8_STAGE_A(bufoff, gbase, v, h) do { _Pragma("unroll") for (int _i = 0; _i < 2; ++_i) { \
        if constexpr (GATHER) __builtin_amdgcn_global_load_lds((const unsigned*)((const char*)(gbase) + (v)[h][_i]), (LAS unsigned*)(lds + (bufoff) + ldsw + _i * 8192), 16, 0, 0); \
        else __builtin_amdgcn_global_load_lds((const unsigned*)((const char*)(gbase) + (size_t)((h) * 128 + _i * 64) * lda * 2 + (v)[0][0]), (LAS unsigned*)(lds + (bufoff) + ldsw + _i * 8192), 16, 0, 0); } } while (0)
#define PG8_SETOFF(v, u) do { _Pragma("unroll") for (int _h = 0; _h < 2; ++_h) _Pragma("unroll") for (int _i = 0; _i < 2; ++_i) { \
        if constexpr (GATHER) (v)[_h][_i] = S.gather_off((u), _h * 128 + Rr[_i]) + (unsigned)Cc[_i] * 2u; \
        else (v)[_h][_i] = (unsigned)((_h * 128 + Rr[_i]) * lda + Cc[_i]) * 2u; } } while (0)
#define PG8_LDA(dst, b, h) do { _Pragma("unroll") for (int m = 0; m < 4; ++m) { const i32x4_ lo_ = *(const LAS i32x4_*)(lds + PG8_SA(b, h) + aoff + m * 2048), hi_ = *(const LAS i32x4_*)(lds + PG8_SA(b, h) + aoff + m * 2048 + 1024); dst[m] = __builtin_shufflevector(lo_, hi_, 0, 1, 2, 3, 4, 5, 6, 7); } } while (0)
#define PG8_LDB(dst, b, h) do { _Pragma("unroll") for (int n = 0; n < 2; ++n) { const i32x4_ lo_ = *(const LAS i32x4_*)(lds + PG8_SB(b, h) + boff + n * 2048), hi_ = *(const LAS i32x4_*)(lds + PG8_SB(b, h) + boff + n * 2048 + 1024); dst[n] = __builtin_shufflevector(lo_, hi_, 0, 1, 2, 3, 4, 5, 6, 7); } } while (0)
#define PG8_H0(x) __builtin_bit_cast(bf16x8, __builtin_shufflevector((x), (x), 0, 1, 2, 3))
#define PG8_H1(x) __builtin_bit_cast(bf16x8, __builtin_shufflevector((x), (x), 4, 5, 6, 7))
#define PG8_MMA(ai, bj, At, Bt) do { __builtin_amdgcn_s_setprio(1); \
        if constexpr (FP8) { _Pragma("unroll") for (int m = 0; m < 4; ++m) _Pragma("unroll") for (int n = 0; n < 2; ++n) \
            asm volatile("v_mfma_scale_f32_16x16x128_f8f6f4 %0, %1, %2, %0, %3, %4 op_sel_hi:[0,0,0]" : "+v"(acc[ai][bj][m][n]) : "v"(Bt[n]), "v"(At[m]), "v"(scw_), "v"(sca_)); } \
        else { _Pragma("unroll") for (int m = 0; m < 4; ++m) _Pragma("unroll") for (int n = 0; n < 2; ++n) { \
            acc[ai][bj][m][n] = __builtin_amdgcn_mfma_f32_16x16x32_bf16(PG8_H0(Bt[n]), PG8_H0(At[m]), acc[ai][bj][m][n], 0, 0, 0); \
            acc[ai][bj][m][n] = __builtin_amdgcn_mfma_f32_16x16x32_bf16(PG8_H1(Bt[n]), PG8_H1(At[m]), acc[ai][bj][m][n], 0, 0, 0); } } \
        __builtin_amdgcn_s_setprio(0); } while (0)
#define PG8_WAIT_V(n) asm volatile("s_waitcnt vmcnt(" #n ")" ::: "memory")
#define PG8_WAIT_L(n) asm volatile("s_waitcnt lgkmcnt(" #n ")" ::: "memory")
#define PG8_BAR __builtin_amdgcn_s_barrier()
#define PG8_SCHED __builtin_amdgcn_sched_barrier(0)
    Unit cur, nxt; int ui = 0;
    if (!S.next(0, cur)) return;
    f32x4 acc[2][2][4][2];
#pragma unroll
    for (int a = 0; a < 2; ++a)
#pragma unroll
        for (int b = 0; b < 2; ++b)
#pragma unroll
            for (int m = 0; m < 4; ++m)
#pragma unroll
                for (int n = 0; n < 2; ++n) acc[a][b][m][n] = (f32x4){0.f, 0.f, 0.f, 0.f};
    int scw_ = W8_E8M0, sca_ = A8_E8M0; if constexpr (FP8) sca_ = Epi::A_E8M0;
    i32x8_ At[4], B0[2], B1[2];
    unsigned vA[2][2], vAn[2][2];
    PG8_SETOFF(vA, cur);
    const char* cA = cur.a; const char* cB = cur.b;
    PG8_STAGE_B(PG8_SB(0, 0), cB); PG8_STAGE_B(PG8_SB(0, 1), cB + hstepB); PG8_STAGE_A(PG8_SA(0, 0), cA, vA, 0); PG8_STAGE_A(PG8_SA(0, 1), cA, vA, 1);
    if (wr == 1) PG8_BAR;
    PG8_WAIT_V(2); PG8_BAR;
    PG8_STAGE_B(PG8_SB(1, 0), cB + kstep); PG8_STAGE_A(PG8_SA(1, 0), cA + kstep, vA, 0); PG8_STAGE_B(PG8_SB(1, 1), cB + hstepB + kstep);
    PG8_WAIT_V(6); PG8_BAR;
    for (;;) {
        const bool has_next = S.next(ui + 1, nxt);
        if constexpr (GATHER) {
            if (has_next) {
#pragma unroll
                for (int h = 0; h < 2; ++h)
#pragma unroll
                    for (int i = 0; i < 2; ++i) vAn[h][i] = S.gather_raw(nxt, h * 128 + Rr[i]);
            }
        }
        const char* nA = has_next ? nxt.a : cA; const char* nB = has_next ? nxt.b : cB;
#pragma unroll 1
        for (int t = 0; t < nt; t += 2) {
            const bool last = (t == nt - 2);
            const char* a1 = cA + (size_t)(t + 1) * kstep;
            const char* a2 = last ? nA : cA + (size_t)(t + 2) * kstep; const char* b2 = last ? nB : cB + (size_t)(t + 2) * kstep;
            const char* a3 = a2 + kstep; const char* b3 = b2 + kstep;
            unsigned v2[2][2];
#pragma unroll
            for (int h = 0; h < 2; ++h)
#pragma unroll
                for (int i = 0; i < 2; ++i) v2[h][i] = vA[h][i];
            if constexpr (GATHER) {
                if (last && has_next) {
#pragma unroll
                    for (int h = 0; h < 2; ++h)
#pragma unroll
                        for (int i = 0; i < 2; ++i) { vAn[h][i] = vAn[h][i] * (unsigned)(lda * 2) + (unsigned)Cc[i] * 2u; v2[h][i] = vAn[h][i]; }
                }
            }
            PG8_LDB(B0, 0, 0); PG8_LDB(B1, 0, 1); PG8_SCHED; PG8_LDA(At, 0, 0); PG8_STAGE_A(PG8_SA(1, 1), a1, vA, 1);
            PG8_WAIT_V(8); PG8_WAIT_L(0); PG8_BAR; PG8_MMA(0, 0, At, B0); PG8_MMA(0, 1, At, B1); PG8_BAR; PG8_SCHED;
            PG8_LDA(At, 0, 1); PG8_STAGE_B(PG8_SB(0, 0), b2); PG8_STAGE_B(PG8_SB(0, 1), b2 + hstepB); PG8_STAGE_A(PG8_SA(0, 0), a2, v2, 0);
            PG8_WAIT_V(8); PG8_WAIT_L(0); PG8_BAR; PG8_MMA(1, 0, At, B0); PG8_MMA(1, 1, At, B1); PG8_BAR; PG8_SCHED;
            PG8_LDB(B0, 1, 0); PG8_LDB(B1, 1, 1); PG8_SCHED; PG8_LDA(At, 1, 0); PG8_STAGE_A(PG8_SA(0, 1), a2, v2, 1);
            PG8_WAIT_V(8); PG8_WAIT_L(0); PG8_BAR; PG8_MMA(0, 0, At, B0); PG8_MMA(0, 1, At, B1); PG8_BAR; PG8_SCHED;
            PG8_LDA(At, 1, 1); PG8_STAGE_B(PG8_SB(1, 0), b3); PG8_STAGE_B(PG8_SB(1, 1), b3 + hstepB); PG8_STAGE_A(PG8_SA(1, 0), a3, v2, 0);
            PG8_WAIT_V(8); PG8_WAIT_L(0); PG8_BAR; PG8_MMA(1, 0, At, B0); PG8_MMA(1, 1, At, B1); PG8_BAR; PG8_SCHED;
        }
        if (wr == 0) PG8_BAR;
        if constexpr (FP8) asm volatile("s_nop 15\n\ts_nop 15" ::: "memory");
        if constexpr (!Epi::AFTER_DRAIN) { int fr_ = fr, fq_ = fq; asm volatile("" : "+v"(fr_), "+v"(fq_)); E(acc, cur, wr, wc, fr_, fq_); }
        if (!has_next) break;
#pragma unroll
        for (int a = 0; a < 2; ++a)
#pragma unroll
            for (int b = 0; b < 2; ++b)
#pragma unroll
                for (int m = 0; m < 4; ++m)
#pragma unroll
                    for (int n = 0; n < 2; ++n) acc[a][b][m][n] = (f32x4){0.f, 0.f, 0.f, 0.f};
        cur = nxt; cA = nA; cB = nB; ++ui;
        if constexpr (GATHER) {
#pragma unroll
            for (int h = 0; h < 2; ++h)
#pragma unroll
                for (int i = 0; i < 2; ++i) vA[h][i] = vAn[h][i];
        }
        if (wr == 1) PG8_BAR;
    }
    PG8_WAIT_V(0);
    PG8_BAR;
    if constexpr (Epi::AFTER_DRAIN) { int fr_ = fr, fq_ = fq; asm volatile("" : "+v"(fr_), "+v"(fq_)); E.fused(acc, cur, wr, wc, fr_, fq_, lds, wid, lane); }
#undef PG8_SA
#undef PG8_SB
#undef PG8_STAGE_A
#undef PG8_STAGE_B
#undef PG8_SETOFF
#undef PG8_LDA
#undef PG8_LDB
#undef PG8_MMA
#undef PG8_H0
#undef PG8_H1
#undef PG8_WAIT_V
#undef PG8_WAIT_L
#undef PG8_BAR
#undef PG8_SCHED
}
}
using pg8::Unit;
typedef f32x4 AccT[2][2][4][2];

struct SchedGrid {
    const char* A; const char* B; int lda, K, nN, nwg, G, c;
    DI bool next(int i, Unit& u) const {
        const int L = i * G + c; if (L >= nwg) return false;
        u.pm = L / nN; u.pn = L % nN; u.e = 0; u.ml = 0;
        u.a = A + (size_t)u.pm * 256 * lda * 2; u.b = B + (size_t)u.pn * 256 * K * 2; return true;
    }
    DI unsigned gather_off(const Unit&, int) const { return 0u; }
    DI unsigned gather_raw(const Unit&, int) const { return 0u; }
};
struct SchedCmp {
    const char* KCMP; const char* VCMP; const char* W; int G, c;
    DI bool next(int i, Unit& u) const {
        const int L = i * G + c; if (L >= 32) return false;
        const int kv = L >> 4, bg = L & 15;
        u.pm = L; u.pn = 0; u.e = kv; u.ml = 0;
        u.a = (kv ? VCMP : KCMP) + (size_t)bg * SP * 64 * 2; u.b = W + (size_t)kv * 256 * 2048 * 2; return true;
    }
    DI unsigned gather_off(const Unit&, int) const { return 0u; }
    DI unsigned gather_raw(const Unit&, int) const { return 0u; }
};
struct SchedMla {
    const char* CQ; const char* MISC; const char* WQ; const char* WKV; int G, c;
    DI bool next(int i, Unit& u) const {
        const int L = i * G + c; if (L >= 512) return false;
        const int which = L >> 8, r = L & 255;
        u.pm = r >> 1; u.pn = r & 1; u.e = which; u.ml = 0;
        u.a = (which ? MISC : CQ) + (size_t)u.pm * 256 * 256 * 2; u.b = (which ? WKV : WQ) + (size_t)u.pn * 256 * 256 * 2; return true;
    }
    DI unsigned gather_off(const Unit&, int) const { return 0u; }
    DI unsigned gather_raw(const Unit&, int) const { return 0u; }
};
template <int NT, bool GATHERED>
struct SchedMoe {
    const LAS int* tb; const LAS int* cnt; const char* A; const char* W; const int* IDX; int total, G, c;
    DI bool next(int i, Unit& u) const {
        const int L = i * G + c; if (L >= total) return false;
        const int mtg = L / NT; u.pn = L % NT;
        const int ln_ = threadIdx.x & 63;
        const int e = __popcll(__ballot(ln_ < 32 && tb[ln_ & 31] <= mtg)) - 1;
        u.e = e; u.ml = mtg - tb[e]; u.pm = mtg;
        u.a = GATHERED ? A : A + (size_t)mtg * 256 * 1024 * 2;
        u.b = W + ((size_t)e * NT * 256 + (size_t)u.pn * 256) * 1024 * 2; return true;
    }
    DI unsigned gather_off(const Unit& u, int row) const {
        const int pos = u.ml * 256 + row; const int tok = (pos < cnt[u.e]) ? IDX[u.e * ECAP + pos] : 0;
        return (unsigned)tok * 2048u;
    }
    DI unsigned gather_raw(const Unit& u, int row) const {
        const int pos = u.ml * 256 + row;
        return (unsigned)IDX[u.e * ECAP + (pos < cnt[u.e] ? pos : 0)];
    }
};

struct SchedMoe1F8 {
    static constexpr bool HOOK = false;
    const LAS int* tb; const LAS int* cnt; const char* A; const char* W; const int* IDX; int total, G, c;
    DI bool next(int i, Unit& u) const {
        const int L = i * G + c; if (L >= total) return false;
        const int mtg = L >> 3; u.pn = L & 7;
        const int ln_ = lane_id();
        const int e = __popcll(__ballot(ln_ < 32 && tb[ln_ & 31] <= mtg)) - 1;
        u.e = e; u.ml = mtg - tb[e]; u.pm = mtg;
        u.a = A; u.b = W + ((size_t)e * 2048 + (size_t)u.pn * 256) * 1024; return true;
    }
    DI unsigned gather_raw(const Unit& u, int row) const { const int pos = u.ml * 256 + row; return (unsigned)IDX[u.e * ECAP + (pos < cnt[u.e] ? pos : 0)]; }
    DI unsigned gather_off(const Unit& u, int row) const { return gather_raw(u, row) * 1024u; }
};
struct SchedMoe2F8 {
    static constexpr bool HOOK = false;
    const LAS int* tb; const char* A; const char* W; int total, G, c;
    DI bool next(int i, Unit& u) const {
        const int L = i * G + c; if (L >= total) return false;
        const int mtg = L >> 2; u.pn = L & 3;
        const int ln_ = lane_id();
        const int e = __popcll(__ballot(ln_ < 32 && tb[ln_ & 31] <= mtg)) - 1;
        u.e = e; u.ml = mtg - tb[e]; u.pm = mtg;
        u.a = A + (size_t)mtg * 256 * 1024; u.b = W + ((size_t)e * 1024 + (size_t)u.pn * 256) * 1024; return true;
    }
    DI unsigned gather_off(const Unit&, int) const { return 0u; }
    DI unsigned gather_raw(const Unit&, int) const { return 0u; }
};

DI void rot4(f32x4& v0, f32x4& v1, const f32x4 c, const f32x4 s) {
    const float a0 = v0[0], b0 = v0[1], a1 = v0[2], b1 = v0[3], a2 = v1[0], b2 = v1[1], a3 = v1[2], b3 = v1[3];
    v0[0] = a0 * c[0] - b0 * s[0]; v0[1] = b0 * c[0] + a0 * s[0];
    v0[2] = a1 * c[1] - b1 * s[1]; v0[3] = b1 * c[1] + a1 * s[1];
    v1[0] = a2 * c[2] - b2 * s[2]; v1[1] = b2 * c[2] + a2 * s[2];
    v1[2] = a3 * c[3] - b3 * s[3]; v1[3] = b3 * c[3] + a3 * s[3];
}
DI u32x4 pack8(const f32x4 v0, const f32x4 v1) { u32x4 w; w.x = pk2(v0[0], v0[1]); w.y = pk2(v0[2], v0[3]); w.z = pk2(v1[0], v1[1]); w.w = pk2(v1[2], v1[3]); return w; }

struct EpiWin {
    static constexpr bool PERM = true, AFTER_DRAIN = false;
    unsigned char* ws; const float* CS64; const float* CS32;
    DI void operator()(const AccT& acc, const Unit& u, int wr, int wc, int fr, int fq) const {
#pragma unroll
        for (int bj = 0; bj < 2; ++bj) {
            const int w0 = bj * 128 + wc * 32;
            size_t off; int ld, dcol, mode = 0, gm = 0, g = 0; float sc = 1.f;
            switch (u.pn) {
                case 0: off = WS_QA; ld = 256; dcol = w0; mode = 1; sc = SCL64; break;
                case 1: off = WS_KA; ld = 256; dcol = w0; mode = 1; break;
                case 2: off = WS_VA; ld = 256; dcol = w0; break;
                case 3: off = WS_QB; ld = 512; dcol = w0; mode = 1; sc = SCL64; break;
                case 4: off = WS_QB; ld = 512; dcol = 256 + w0; mode = 1; sc = SCL64; break;
                case 5: off = (w0 < 128) ? WS_KCMP : WS_VCMP; ld = 64; gm = 1; g = (w0 & 127) >> 6; dcol = w0 & 63; break;
                case 6: off = (w0 < 128) ? WS_KSLC : WS_VSLC; ld = 128; dcol = w0 & 127; mode = (w0 < 128) ? 1 : 0; break;
                case 7: off = (w0 < 128) ? WS_KWIN : WS_VWIN; ld = 128; dcol = w0 & 127; mode = (w0 < 128) ? 1 : 0; break;
                case 8: off = WS_CQ; ld = 256; dcol = w0; break;
                default: if (w0 == 128) { off = WS_KR; ld = 32; dcol = 0; mode = 2; } else { off = WS_MISC; ld = 256; dcol = w0; } break;
            }
            bf16* base = (bf16*)(ws + off);
            const int i0 = 16 * (wc & 1) + 4 * fq;
#pragma unroll
            for (int ai = 0; ai < 2; ++ai) {
                f32x4 cc[4], sn[4];
                if (mode) {
#pragma unroll
                    for (int m = 0; m < 4; ++m) {
                        const int row = u.pm * 256 + ai * 128 + wr * 64 + m * 16 + fr;
                        const float* cs = (mode == 1) ? CS64 + (size_t)row * 64 + i0 : CS32 + (size_t)row * 32 + 4 * fq;
                        cc[m] = *(const f32x4*)cs; sn[m] = *(const f32x4*)(cs + (mode == 1 ? 32 : 16));
                    }
                }
#pragma unroll
                for (int m = 0; m < 4; ++m) {
                    const int row = u.pm * 256 + ai * 128 + wr * 64 + m * 16 + fr;
                    f32x4 v0 = acc[ai][bj][m][0], v1 = acc[ai][bj][m][1];
                    if (mode) rot4(v0, v1, cc[m], sn[m]);
                    v0 = v0 * sc; v1 = v1 * sc;
                    const size_t drow = gm ? (size_t)(((row >> 12) * 2 + g) * SP + (row & 4095)) : (size_t)row;
                    *(u32x4*)(base + drow * ld + dcol + 8 * fq) = pack8(v0, v1);
                }
            }
        }
    }
};
struct EpiCmp {
    static constexpr bool PERM = true, AFTER_DRAIN = true;
    const float* B1P; const bf16* W2T; const float *B2K, *B2V; bf16 *KC, *VC; const float* CS64;
    DI void fused(const AccT& acc, const Unit& u, int wr, int wc, int fr, int fq, LAS unsigned char* lds, int wid, int lane) const {
        constexpr int HST = 528;
        const int kv = u.e, bg = u.pm & 15;
#pragma unroll
        for (int bj = 0; bj < 2; ++bj) {
            const int col = bj * 128 + wc * 32 + 8 * fq;
            const f32x4 b0 = *(const f32x4*)(B1P + kv * 256 + col), b1 = *(const f32x4*)(B1P + kv * 256 + col + 4);
#pragma unroll
            for (int ai = 0; ai < 2; ++ai)
#pragma unroll
                for (int m = 0; m < 4; ++m) {
                    const int rl = ai * 128 + wr * 64 + m * 16 + fr;
                    f32x4 v0 = acc[ai][bj][m][0] + b0, v1 = acc[ai][bj][m][1] + b1;
#pragma unroll
                    for (int j = 0; j < 4; ++j) {
                        float x = v0[j]; float z = 0.7978845608028654f * (x + 0.044715f * x * x * x); v0[j] = x * sigmoidf_(2.f * z);
                        x = v1[j]; z = 0.7978845608028654f * (x + 0.044715f * x * x * x); v1[j] = x * sigmoidf_(2.f * z);
                    }
                    *(LAS u32x4*)(lds + rl * HST + col * 2) = pack8(v0, v1);
                }
        }
        asm volatile("s_waitcnt lgkmcnt(0)\n\ts_barrier" ::: "memory");
        const int r32 = lane & 31, hh = lane >> 5;
        f32x16 out0 = {0.f, 0.f, 0.f, 0.f, 0.f, 0.f, 0.f, 0.f, 0.f, 0.f, 0.f, 0.f, 0.f, 0.f, 0.f, 0.f}, out1 = out0;
        const bf16* w2 = W2T + (size_t)kv * 64 * 256;
#pragma unroll 4
        for (int ks = 0; ks < 16; ++ks) {
            const bf16x8 a = *(const LAS bf16x8*)(lds + (32 * wid + r32) * HST + (16 * ks + 8 * hh) * 2);
            const bf16x8 bq0 = *(const bf16x8*)(w2 + (size_t)r32 * 256 + 16 * ks + 8 * hh), bq1 = *(const bf16x8*)(w2 + (size_t)(32 + r32) * 256 + 16 * ks + 8 * hh);
            out0 = __builtin_amdgcn_mfma_f32_32x32x16_bf16(a, bq0, out0, 0, 0, 0); out1 = __builtin_amdgcn_mfma_f32_32x32x16_bf16(a, bq1, out1, 0, 0, 0);
        }
        const float* b2 = kv ? B2V : B2K;
        const float bb0 = b2[r32], bb1 = b2[32 + r32];
        const int b = bg >> 1;
#pragma unroll
        for (int i = 0; i < 16; ++i) {
            const int c = 32 * wid + 8 * (i >> 2) + 4 * hh + (i & 3);
            const size_t row = (size_t)bg * 256 + c;
            float x1 = out0[i] + bb0, x2 = out1[i] + bb1;
            if (c == 255) { x1 = 0.f; x2 = 0.f; }
            if (kv == 0) {
                const int tokr = (b * S + 16 * c + 31) & (T - 1);
                const float cs = CS64[(size_t)tokr * 64 + r32], sn = CS64[(size_t)tokr * 64 + 32 + r32];
                *(unsigned*)(KC + row * 64 + 2 * r32) = pk2(x1 * cs - x2 * sn, x2 * cs + x1 * sn);
            } else {
                VC[row * 64 + r32] = (bf16)(pk2(x1, 0.f) & 0xffffu); VC[row * 64 + 32 + r32] = (bf16)(pk2(x2, 0.f) & 0xffffu);
            }
        }
    }
};
struct EpiMla {
    static constexpr bool PERM = true, AFTER_DRAIN = false;
    bf16 *QM, *KN, *VM; const bf16 *CQ, *MISC; const float* CS32;
    DI void operator()(const AccT& acc, const Unit& u, int wr, int wc, int fr, int fq) const {
        float rstd[2][4];
#pragma unroll
        for (int ai = 0; ai < 2; ++ai)
#pragma unroll
            for (int m = 0; m < 4; ++m) {
                const int row = u.pm * 256 + ai * 128 + wr * 64 + m * 16 + fr;
                float ss = 0.f;
                if (u.e == 0) {
#pragma unroll
                    for (int c = 0; c < 8; ++c) { const u32x4 w = *(const u32x4*)(CQ + (size_t)row * 256 + fq * 64 + 8 * c);
                        ss += bflo(w.x) * bflo(w.x) + bfhi(w.x) * bfhi(w.x) + bflo(w.y) * bflo(w.y) + bfhi(w.y) * bfhi(w.y) + bflo(w.z) * bflo(w.z) + bfhi(w.z) * bfhi(w.z) + bflo(w.w) * bflo(w.w) + bfhi(w.w) * bfhi(w.w); }
                } else {
#pragma unroll
                    for (int c = 0; c < 4; ++c) { const u32x4 w = *(const u32x4*)(MISC + (size_t)row * 256 + fq * 32 + 8 * c);
                        ss += bflo(w.x) * bflo(w.x) + bfhi(w.x) * bfhi(w.x) + bflo(w.y) * bflo(w.y) + bfhi(w.y) * bfhi(w.y) + bflo(w.z) * bflo(w.z) + bfhi(w.z) * bfhi(w.z) + bflo(w.w) * bflo(w.w) + bfhi(w.w) * bfhi(w.w); }
                }
                ss += __shfl_xor(ss, 16); ss += __shfl_xor(ss, 32);
                rstd[ai][m] = rsqrtf(ss * (u.e == 0 ? (1.0f / 256.0f) : (1.0f / 128.0f)) + EPS);
            }
#pragma unroll
        for (int bj = 0; bj < 2; ++bj) {
            const int gc = u.pn * 256 + bj * 128 + wc * 32;
            bf16* base; int ld, dcol, rope = 0; float sc = 1.f;
            if (u.e == 0) { if (gc >= 384) continue; rope = ((gc >> 5) % 3) == 2; base = QM; ld = 384; dcol = gc; sc = SCL96; }
            else { const int head = gc >> 7, part = (gc & 127) >> 6, o = gc & 63; base = part ? VM : KN; ld = 256; dcol = head * 64 + o; }
#pragma unroll
            for (int ai = 0; ai < 2; ++ai) {
                f32x4 cc[4], sn[4];
                if (rope) {
#pragma unroll
                    for (int m = 0; m < 4; ++m) { const float* cs = CS32 + (size_t)(u.pm * 256 + ai * 128 + wr * 64 + m * 16 + fr) * 32 + 4 * fq; cc[m] = *(const f32x4*)cs; sn[m] = *(const f32x4*)(cs + 16); }
                }
#pragma unroll
                for (int m = 0; m < 4; ++m) {
                    const int row = u.pm * 256 + ai * 128 + wr * 64 + m * 16 + fr;
                    const float r = rstd[ai][m] * sc;
                    f32x4 v0 = acc[ai][bj][m][0] * r, v1 = acc[ai][bj][m][1] * r;
                    if (rope) rot4(v0, v1, cc[m], sn[m]);
                    *(u32x4*)(base + (size_t)row * ld + dcol + 8 * fq) = pack8(v0, v1);
                }
            }
        }
    }
};
struct EpiWout {
    static constexpr bool PERM = false, AFTER_DRAIN = false;
    bf16* X; const float* GT; size_t dofs;
    DI void operator()(const AccT& acc, const Unit& u, int wr, int wc, int fr, int fq) const {
        const int b = (u.pm * 256) >> 12;
        const int col0 = u.pn * 256 + wc * 32 + 4 * fq;
#pragma unroll
        for (int bj = 0; bj < 2; ++bj) {
#pragma unroll
            for (int n = 0; n < 2; ++n) {
                u32x2 xo[2][4];
                const f32x4 gt = *(const f32x4*)(GT + (size_t)b * 6144 + col0 + bj * 128 + n * 16);
#pragma unroll
                for (int ai = 0; ai < 2; ++ai)
#pragma unroll
                    for (int m = 0; m < 4; ++m) xo[ai][m] = *(const u32x2*)(X + (size_t)(u.pm * 256 + ai * 128 + wr * 64 + m * 16 + fr) * 1024 + col0 + bj * 128 + n * 16);
#pragma unroll
                for (int ai = 0; ai < 2; ++ai)
#pragma unroll
                    for (int m = 0; m < 4; ++m) {
                        bf16* p = X + (size_t)(u.pm * 256 + ai * 128 + wr * 64 + m * 16 + fr) * 1024 + col0 + bj * 128 + n * 16;
                        const f32x4 xv = (f32x4){bflo(xo[ai][m].x), bfhi(xo[ai][m].x), bflo(xo[ai][m].y), bfhi(xo[ai][m].y)} + gt * acc[ai][bj][m][n];
                        u32x2 w; w.x = pk2(xv[0], xv[1]); w.y = pk2(xv[2], xv[3]);
                        *(u32x2*)((char*)p + dofs) = w;
                    }
            }
        }
    }
};
struct EpiMoe1 {
    static constexpr bool PERM = true, AFTER_DRAIN = false; static constexpr int A_E8M0 = H8_E8M0;
    bf16* ACT; const float* B1;
    DI void operator()(const AccT& acc, const Unit& u, int wr, int wc, int fr, int fq) const {
#pragma unroll
        for (int bj = 0; bj < 2; ++bj) {
            const int col = u.pn * 256 + bj * 128 + wc * 32 + 8 * fq;
            const f32x4 b0 = *(const f32x4*)(B1 + (size_t)u.e * 2048 + col), b1 = *(const f32x4*)(B1 + (size_t)u.e * 2048 + col + 4);
#pragma unroll
            for (int ai = 0; ai < 2; ++ai)
#pragma unroll
                for (int m = 0; m < 4; ++m) {
                    const int row = u.pm * 256 + ai * 128 + wr * 64 + m * 16 + fr;
                    const f32x4 v0 = acc[ai][bj][m][0] + b0, v1 = acc[ai][bj][m][1] + b1;
                    float o[4];
#pragma unroll
                    for (int j = 0; j < 4; ++j) {
                        const float gl = fminf((j < 2) ? v0[2 * j] : v1[2 * j - 4], 7.0f);
                        const float li = fminf(fmaxf((j < 2) ? v0[2 * j + 1] : v1[2 * j - 3], -7.0f), 7.0f);
                        o[j] = gl * sigmoidf_(1.702f * gl) * (li + 1.0f);
                    }
                    *(unsigned*)((unsigned char*)ACT + (size_t)row * 1024 + (col >> 1)) = pk4_fp8s(o[0], o[1], o[2], o[3], A8_SCALE);
                }
        }
    }
};
struct EpiMoe2 {
    static constexpr bool PERM = true, AFTER_DRAIN = false; static constexpr int A_E8M0 = A8_E8M0;
    unsigned char* Y2; const float* B2; const float* GATEW;
    DI void operator()(const AccT& acc, const Unit& u, int wr, int wc, int fr, int fq) const {
        float gwv[2][4];
#pragma unroll
        for (int ai = 0; ai < 2; ++ai)
#pragma unroll
            for (int m = 0; m < 4; ++m) gwv[ai][m] = GATEW[(size_t)u.e * ECAP + u.ml * 256 + ai * 128 + wr * 64 + m * 16 + fr];
        f32x4 bb[2][2];
#pragma unroll
        for (int bj = 0; bj < 2; ++bj) { const int col = u.pn * 256 + bj * 128 + wc * 32 + 8 * fq; bb[bj][0] = *(const f32x4*)(B2 + (size_t)u.e * 1024 + col); bb[bj][1] = *(const f32x4*)(B2 + (size_t)u.e * 1024 + col + 4); }
#pragma unroll
        for (int ai = 0; ai < 2; ++ai)
#pragma unroll
            for (int m = 0; m < 4; ++m) {
                const int rl = ai * 128 + wr * 64 + m * 16 + fr;
                const float gw = gwv[ai][m];
                const size_t row = (size_t)u.pm * 256 + rl;
#pragma unroll
                for (int bj = 0; bj < 2; ++bj) {
                    const int col = u.pn * 256 + bj * 128 + wc * 32 + 8 * fq;
                    const f32x4 v0 = (acc[ai][bj][m][0] + bb[bj][0]) * gw, v1 = (acc[ai][bj][m][1] + bb[bj][1]) * gw;
                    { u32x2 w8; w8.x = pk4_fp8(v0[0], v0[1], v0[2], v0[3]); w8.y = pk4_fp8(v1[0], v1[1], v1[2], v1[3]); *(u32x2*)(Y2 + row * 1024 + col) = w8; }
                }
            }
    }
};

#define MFMA32(a, b, c) __builtin_amdgcn_mfma_f32_32x32x16_bf16((a), (b), (c), 0, 0, 0)
typedef short v4i16_t __attribute__((ext_vector_type(4)));
DI s16x4 tr_read(const LAS unsigned char* p) { return __builtin_bit_cast(s16x4, __builtin_amdgcn_ds_read_tr16_b64_v4i16((LAS v4i16_t*)p)); }
constexpr int VST = 144;
template <int DQ> struct AC { static constexpr int KST = DQ * 2 + 16, KS = DQ / 16, KBUF = 64 * KST, VBUF = 64 * VST, BUF = KBUF + VBUF; };

template <int DQ>
DI void qk_tile(const LAS unsigned char* kb, const bf16x8 (&qf)[DQ / 16], f32x16 (&s)[2], const f32x16& cinit, int lane) {
    const int r32 = lane & 31, hh = lane >> 5;
    bf16x8 kf[2][DQ / 16];
#pragma unroll
    for (int rt = 0; rt < 2; ++rt)
#pragma unroll
        for (int ks = 0; ks < DQ / 16; ++ks) kf[rt][ks] = *(const LAS bf16x8*)(kb + (32 * rt + r32) * AC<DQ>::KST + (16 * ks + 8 * hh) * 2);
    f32x16 a0 = MFMA32(kf[0][0], qf[0], cinit), a1 = MFMA32(kf[1][0], qf[0], cinit);
#pragma unroll
    for (int ks = 1; ks < DQ / 16; ++ks) { a0 = MFMA32(kf[0][ks], qf[ks], a0); a1 = MFMA32(kf[1][ks], qf[ks], a1); }
    s[0] = a0; s[1] = a1;
}
DI float max3f_(float a, float b, float c) { return __builtin_fmaxf(__builtin_fmaxf(a, b), c); }
constexpr float RESC_THR = 8.0f;
template <int DQ, int KMUL, int VAR = 0>
DI void attn_tile(const LAS unsigned char* kb, const LAS unsigned char* vb, const bf16x8 (&qf)[DQ / 16], f32x16 (&o)[2], f32x16& negm, float& m, float& l,
                  int dq, unsigned maxd, bool lf, int lane, const bool MASKED) {
    const int hh = lane >> 5;
    if (VAR == 1) return;
    f32x16 s[2];
    qk_tile<DQ>(kb, qf, s, negm, lane);
    if (VAR == 2) { o[0] += s[0]; o[1] += s[1]; return; }
    const int i16 = lane & 15, q = i16 >> 2, p_ = i16 & 3, mh = (lane >> 4) & 1;
    const LAS unsigned char* vbase = vb + (4 * hh + q) * VST + 32 * mh + 8 * p_;
    s16x4 vlo[4][2], vhi[4][2];
#pragma unroll
    for (int st = 0; st < 4; ++st)
#pragma unroll
        for (int mt = 0; mt < 2; ++mt) { vlo[st][mt] = tr_read(vbase + (16 * st) * VST + 64 * mt); vhi[st][mt] = tr_read(vbase + (16 * st + 8) * VST + 64 * mt); }
    __builtin_amdgcn_sched_barrier(0);
    if (MASKED) {
#pragma unroll
        for (int rt = 0; rt < 2; ++rt)
#pragma unroll
            for (int i = 0; i < 16; ++i) {
                const int d = dq - (32 * rt + 8 * (i >> 2) + (i & 3)) * KMUL;
                s[rt][i] = ((unsigned)d <= maxd) ? s[rt][i] : -1e30f;
            }
    }
    float mx = max3f_(s[0][0], s[0][1], s[0][2]);
#pragma unroll
    for (int i = 3; i < 15; i += 2) mx = max3f_(mx, s[0][i], s[0][i + 1]);
    mx = max3f_(mx, s[0][15], s[1][0]);
#pragma unroll
    for (int i = 1; i < 15; i += 2) mx = max3f_(mx, s[1][i], s[1][i + 1]);
    mx = fmaxf(mx, s[1][15]);
    if (__ballot(lf && mx > RESC_THR) != 0ull) {
        float mc = lf ? mx : -1e30f;
        mc = fmaxf(mc, __shfl_xor(mc, 32));
        const float delta = mc > RESC_THR ? mc : 0.f;
        const float alpha = fast_exp2(-delta);
        m += delta; l *= alpha;
#pragma unroll
        for (int i = 0; i < 16; ++i) { negm[i] = -m; o[0][i] *= alpha; o[1][i] *= alpha; s[0][i] -= delta; s[1][i] -= delta; }
    }
    float ps = 0.f;
#pragma unroll
    for (int rt = 0; rt < 2; ++rt)
#pragma unroll
        for (int i = 0; i < 16; ++i) { const float p = fast_exp2(s[rt][i]); s[rt][i] = p; ps += p; }
    const unsigned lmask = lf ? 0xffffffffu : 0u;
    l += lf ? ps : 0.f;
    if (VAR == 3) { o[0] += s[0]; o[1] += s[1]; return; }
#pragma unroll
    for (int rt = 0; rt < 2; ++rt)
#pragma unroll
        for (int s2 = 0; s2 < 2; ++s2) {
            u32x4 pw; pw.x = pk2(s[rt][8 * s2 + 0], s[rt][8 * s2 + 1]) & lmask; pw.y = pk2(s[rt][8 * s2 + 2], s[rt][8 * s2 + 3]) & lmask;
            pw.z = pk2(s[rt][8 * s2 + 4], s[rt][8 * s2 + 5]) & lmask; pw.w = pk2(s[rt][8 * s2 + 6], s[rt][8 * s2 + 7]) & lmask;
            const bf16x8 pb = __builtin_bit_cast(bf16x8, pw);
#pragma unroll
            for (int mt = 0; mt < 2; ++mt) {
                const bf16x8 va = __builtin_shufflevector(vlo[2 * rt + s2][mt], vhi[2 * rt + s2][mt], 0, 1, 2, 3, 4, 5, 6, 7);
                o[mt] = MFMA32(va, pb, o[mt]);
            }
        }
}
constexpr int OSTAGE_WAVE = 32 * 144;
static_assert(102400 + 8 * OSTAGE_WAVE <= MISC_OFF, "O stage below the LDS control words");
template <class P>
DI void store_o_rows(const P& p, LAS unsigned char* lds, int off, const f32x16 (&o)[2], float inv, int lane, int wave) {
    LAS unsigned char* st = lds + off + wave * OSTAGE_WAVE;
    const int n = lane & 31, hh = lane >> 5;
#pragma unroll
    for (int mt = 0; mt < 2; ++mt)
#pragma unroll
        for (int a = 0; a < 4; ++a) {
            u32x2 w; w.x = pk2(o[mt][4 * a] * inv, o[mt][4 * a + 1] * inv); w.y = pk2(o[mt][4 * a + 2] * inv, o[mt][4 * a + 3] * inv);
            *(LAS u32x2*)(st + n * 144 + (32 * mt + 8 * a + 4 * hh) * 2) = w;
        }
    asm volatile("s_waitcnt lgkmcnt(0)" ::: "memory");
#pragma unroll
    for (int it = 0; it < 4; ++it) {
        const int r = (lane >> 3) + 8 * it, c = lane & 7;
        const u32x4 v = *(const LAS u32x4*)(st + r * 144 + c * 16);
        *(u32x4*)(p.orow(wave, r) + 8 * c) = v;
    }
}
DI void store_o(bf16* orow, const f32x16 (&o)[2], float inv, int lane) {
    const int hh = lane >> 5;
#pragma unroll
    for (int mt = 0; mt < 2; ++mt)
#pragma unroll
        for (int a = 0; a < 4; ++a) {
            u32x2 w; w.x = pk2(o[mt][4 * a] * inv, o[mt][4 * a + 1] * inv); w.y = pk2(o[mt][4 * a + 2] * inv, o[mt][4 * a + 3] * inv);
            *(u32x2*)(orow + 32 * mt + 8 * a + 4 * hh) = w;
        }
}

struct PolA {
    static constexpr bool HASFLAG = false, LSE = true; static constexpr int KMUL = 1;
    const bf16 *Q, *K, *V; bf16* O; float* LSEP; int b, h, d, r, c; unsigned maxd; int j0, j1;
    DI int ql(int w, int lane) const { return 256 * c + 32 * w + (lane & 31); }
    DI size_t trow(int l_) const { return (size_t)b * S + (size_t)l_ * d + r; }
    DI const bf16* qrow(int w, int lane) const { return Q + trow(ql(w, lane)) * 256 + h * 64; }
    DI int qv(int w, int lane) const { return ql(w, lane); }
    DI int qmin(int w) const { return 256 * c + 32 * w; }
    DI int qmax(int w) const { return 256 * c + 32 * w + 31; }
    DI int kv0(int j) const { return 256 * c - 128 + 64 * j; }
    DI const bf16* krow(int j, int row) const { return K + trow(kv0(j) + row) * 256 + h * 64; }
    DI const bf16* vrow(int j, int row) const { return V + trow(kv0(j) + row) * 256 + h * 64; }
    DI const bf16* rrow(int, int) const { return nullptr; }
    DI bool flag(int, int, int) const { return true; }
    DI bf16* orow(int w, int lane) const { return O + trow(ql(w, lane)) * 256 + h * 64; }
    DI void lse(int w, int lane, float v) const { LSEP[trow(ql(w, lane)) * 4 + h] = v; }
};
struct PolB {
    static constexpr bool LSE = false; static constexpr int KMUL = 1;
    const bf16 *Q, *K, *V; bf16* O; int b, g, qc; unsigned maxd; int j0, j1; u64 sel; bool hasflag;
    DI int tok(int w, int lane) const { return 64 * qc + 8 * w + ((lane & 31) >> 2); }
    DI const bf16* qrow(int w, int lane) const { return Q + ((size_t)b * S + tok(w, lane)) * 512 + (4 * g + (lane & 3)) * 64; }
    DI int qv(int w, int lane) const { return tok(w, lane); }
    DI int qmin(int w) const { return 64 * qc + 8 * w; }
    DI int qmax(int w) const { return 64 * qc + 8 * w + 7; }
    DI int kv0(int j) const { return 64 * j; }
    DI const bf16* krow(int j, int row) const { return K + ((size_t)b * S + 64 * j + row) * 128 + g * 64; }
    DI const bf16* vrow(int j, int row) const { return V + ((size_t)b * S + 64 * j + row) * 128 + g * 64; }
    DI const bf16* rrow(int, int) const { return nullptr; }
    DI bf16* orow(int w, int lane) const { return O + ((size_t)b * S + tok(w, lane)) * 512 + (4 * g + (lane & 3)) * 64; }
    DI void lse(int, int, float) const {}
};
struct PolM {
    static constexpr bool HASFLAG = false, LSE = false; static constexpr int KMUL = 1;
    const bf16 *Q, *KN, *KR, *V; bf16* O; int b, h, c; unsigned maxd; int j0, j1;
    DI int tok(int w, int lane) const { return 256 * c + 32 * w + (lane & 31); }
    DI const bf16* qrow(int w, int lane) const { return Q + ((size_t)b * S + tok(w, lane)) * 384 + h * 96; }
    DI int qv(int w, int lane) const { return tok(w, lane); }
    DI int qmin(int w) const { return 256 * c + 32 * w; }
    DI int qmax(int w) const { return 256 * c + 32 * w + 31; }
    DI int kv0(int j) const { return 64 * j; }
    DI const bf16* krow(int j, int row) const { return KN + ((size_t)b * S + 64 * j + row) * 256 + h * 64; }
    DI const bf16* vrow(int j, int row) const { return V + ((size_t)b * S + 64 * j + row) * 256 + h * 64; }
    DI const bf16* rrow(int j, int row) const { return KR + ((size_t)b * S + 64 * j + row) * 32; }
    DI bf16* orow(int w, int lane) const { return O + ((size_t)b * S + tok(w, lane)) * 256 + h * 64; }
    DI void lse(int, int, float) const {}
};

template <int DQ, class P, bool FLAG, int VAR = 0>
DI void attn_unit(const P& p, LAS unsigned char* lds, int tid, int lane, int wave, u64 sel) {
    typedef AC<DQ> C;
    const int hh = lane >> 5;
    const bf16* qrow = p.qrow(wave, lane);
    bf16x8 qf[DQ / 16];
#pragma unroll
    for (int ks = 0; ks < DQ / 16; ++ks) qf[ks] = *(const bf16x8*)(qrow + 16 * ks + 8 * hh);
#pragma unroll
    for (int ks = 0; ks < DQ / 16; ++ks) asm volatile("s_waitcnt vmcnt(0)" : "+v"(qf[ks]) :: "memory");
    const int qv = p.qv(wave, lane), wq0 = p.qmin(wave), wq1 = p.qmax(wave);
    f32x16 o[2];
#pragma unroll
    for (int mt = 0; mt < 2; ++mt)
#pragma unroll
        for (int i = 0; i < 16; ++i) o[mt][i] = 0.f;
    float m = 0.f, l = 0.f;
    f32x16 negm;
#pragma unroll
    for (int i = 0; i < 16; ++i) negm[i] = 0.f;
    const int j0 = p.j0, j1 = p.j1;
    const int lrow = tid >> 3, lch = tid & 7;
    u32x4 k0A, v0A, r0A = {0u, 0u, 0u, 0u}, k1A, v1A, r1A = {0u, 0u, 0u, 0u}, k0B, v0B, r0B = {0u, 0u, 0u, 0u}, k1B, v1B, r1B = {0u, 0u, 0u, 0u};
    constexpr int NLD = (DQ == 96) ? 6 : 4;
    const int npair = (j1 - j0 + 1) >> 1;
#define ATT_LOAD1(RK, RV, RR, j) do { const bf16* pk_ = p.krow((j), lrow) + 8 * lch; const bf16* pv_ = p.vrow((j), lrow) + 8 * lch; \
        asm volatile("global_load_dwordx4 %0, %2, off\n\tglobal_load_dwordx4 %1, %3, off" : "=&v"(RK), "=&v"(RV) : "v"(pk_), "v"(pv_) : "memory"); \
        if (DQ == 96) { const bf16* pr_ = p.rrow((j), (tid & 255) >> 2) + 8 * (tid & 3); asm volatile("global_load_dwordx4 %0, %1, off" : "=&v"(RR) : "v"(pr_) : "memory"); } } while (0)
#define ATT_LOADP(K0, V0, R0, K1, V1, R1, t) do { const int ja_ = j0 + 2 * (t), jb_ = ja_ + 1; \
        { const int jc_ = ja_ < j1 ? ja_ : j1 - 1; ATT_LOAD1(K0, V0, R0, jc_); } { const int jd_ = jb_ < j1 ? jb_ : j1 - 1; ATT_LOAD1(K1, V1, R1, jd_); } } while (0)
#define ATT_TILE(kb_, jt_) do { const int j_ = (jt_); const int kv0 = p.kv0(j_); \
        bool need = (j_ < j1) && (wq1 - kv0 >= 0) && ((long long)wq0 - (long long)(kv0 + 63 * P::KMUL) <= (long long)p.maxd); \
        const bool interior = (wq0 - (kv0 + 63 * P::KMUL) >= 0) && ((long long)wq1 - (long long)kv0 <= (long long)p.maxd); \
        bool lf = true; \
        if (FLAG) { lf = ((sel >> j_) & 1ull) != 0ull; need = need && (__ballot(lf) != 0ull); } \
        if (need) attn_tile<DQ, P::KMUL, VAR>((kb_), (kb_) + C::KBUF, qf, o, negm, m, l, qv - kv0 - 4 * hh * P::KMUL, p.maxd, lf, lane, !interior); } while (0)
#define ATT_STEP(K0, V0, R0, K1, V1, R1, tt) do { const int t_ = (tt); \
        LAS unsigned char* pbuf = lds + (t_ & 1) * (2 * C::BUF); \
        asm volatile("s_waitcnt vmcnt(%6)" : "+v"(K0), "+v"(V0), "+v"(R0), "+v"(K1), "+v"(V1), "+v"(R1) : "n"(NLD) : "memory"); \
        *(LAS u32x4*)(pbuf + lrow * C::KST + lch * 16) = K0; *(LAS u32x4*)(pbuf + C::KBUF + lrow * VST + lch * 16) = V0; \
        *(LAS u32x4*)(pbuf + C::BUF + lrow * C::KST + lch * 16) = K1; *(LAS u32x4*)(pbuf + C::BUF + C::KBUF + lrow * VST + lch * 16) = V1; \
        if (DQ == 96) { *(LAS u32x4*)(pbuf + ((tid & 255) >> 2) * C::KST + 128 + (tid & 3) * 16) = R0; *(LAS u32x4*)(pbuf + C::BUF + ((tid & 255) >> 2) * C::KST + 128 + (tid & 3) * 16) = R1; } \
        asm volatile("s_waitcnt lgkmcnt(0)\n\ts_barrier" ::: "memory"); \
        ATT_LOADP(K0, V0, R0, K1, V1, R1, t_ + 2); \
        if (ATT_STAGGER > 0 && wave >= 4) __builtin_amdgcn_s_sleep(ATT_STAGGER); \
        ATT_TILE(pbuf, j0 + 2 * t_); ATT_TILE(pbuf + C::BUF, j0 + 2 * t_ + 1); } while (0)
    ATT_LOADP(k0A, v0A, r0A, k1A, v1A, r1A, 0);
    ATT_LOADP(k0B, v0B, r0B, k1B, v1B, r1B, 1);
    if (wave >= 4) __builtin_amdgcn_s_setprio(1);
#pragma unroll 1
    for (int t = 0; t < npair; t += 2) {
        ATT_STEP(k0A, v0A, r0A, k1A, v1A, r1A, t);
        ATT_STEP(k0B, v0B, r0B, k1B, v1B, r1B, t + 1);
    }
    __builtin_amdgcn_s_setprio(0);
    asm volatile("s_waitcnt vmcnt(0)" : "+v"(k0A), "+v"(v0A), "+v"(r0A), "+v"(k1A), "+v"(v1A), "+v"(r1A), "+v"(k0B), "+v"(v0B), "+v"(r0B), "+v"(k1B), "+v"(v1B), "+v"(r1B) :: "memory");
#undef ATT_LOAD1
#undef ATT_LOADP
#undef ATT_TILE
#undef ATT_STEP
    const float lt = l + __shfl_xor(l, 32);
    const float inv = lt > 0.f ? 1.0f / lt : 0.f;
    store_o_rows(p, lds, DQ == 96 ? 102400 : 90112, o, inv, lane, wave);
    if (P::LSE) { if (hh == 0) p.lse(wave, lane, m + __log2f(lt)); }
    __syncthreads();
}

DI u64 cmp_unit(const Ctx& F, int b, int g, int qc) {
    constexpr int KST = 144;
    LAS unsigned char* KL = F.lds; LAS unsigned char* VL = F.lds + 256 * KST; LAS float* IMP = (LAS float*)(F.lds + 2 * 256 * KST);
    const bf16* KC = (const bf16*)(F.ws + WS_KC) + (size_t)(b * 2 + g) * 256 * 64;
    const bf16* VC = (const bf16*)(F.ws + WS_VC) + (size_t)(b * 2 + g) * 256 * 64;
    const int tid = F.tid, lane = F.lane, w = F.wave, hh = lane >> 5, r32 = lane & 31;
#pragma unroll
    for (int it = 0; it < 4; ++it) { const int idx = tid + 512 * it, row = idx >> 3, ch = idx & 7;
        *(LAS u32x4*)(KL + row * KST + ch * 16) = *(const u32x4*)(KC + row * 64 + ch * 8);
        *(LAS u32x4*)(VL + row * VST + ch * 16) = *(const u32x4*)(VC + row * 64 + ch * 8); }
    __syncthreads();
    const int tokl = 8 * w + (r32 >> 2), tok = 64 * qc + tokl, head = 4 * g + (lane & 3);
    const bf16* qrow = (const bf16*)(F.ws + WS_QB) + ((size_t)b * S + tok) * 512 + head * 64;
    bf16x8 qf[4];
#pragma unroll
    for (int ks = 0; ks < 4; ++ks) qf[ks] = *(const bf16x8*)(qrow + 16 * ks + 8 * hh);
    const int qv = tok - 31, wq1 = 64 * qc + 8 * w + 7 - 31;
    f32x16 o[2];
#pragma unroll
    for (int mt = 0; mt < 2; ++mt)
#pragma unroll
        for (int i = 0; i < 16; ++i) o[mt][i] = 0.f;
    float m = 0.f, l = 0.f;
    f32x16 negm;
#pragma unroll
    for (int i = 0; i < 16; ++i) negm[i] = 0.f;
    const int wq0 = 64 * qc + 8 * w - 31;
#pragma unroll 1
    for (int jt = 0; jt < 4; ++jt) {
        if (wq1 - 1024 * jt >= 0) {
            const int dq = qv - 1024 * jt - 4 * hh * 16;
            attn_tile<64, 16>(KL + jt * 64 * KST, VL + jt * 64 * VST, qf, o, negm, m, l, dq, 0x7fffffffu, true, lane, !(wq0 - (1024 * jt + 63 * 16) >= 0));
        }
    }
    const float lt = l + __shfl_xor(l, 32);
    const float inv = lt > 0.f ? 1.0f / lt : 0.f;
    { struct { bf16* O; int b, g, qc; DI bf16* orow(int w_, int n_) const { return O + ((size_t)b * S + 64 * qc + 8 * w_ + (n_ >> 2)) * 512 + (4 * g + (n_ & 3)) * 64; } } pc{(bf16*)(F.ws + WS_OCMP), b, g, qc};
      store_o_rows(pc, F.lds, 90112, o, inv, lane, w); }
    float prev = 0.f;
#pragma unroll 1
    for (int jt = 0; jt < 4; ++jt) {
        const bool need = (wq1 - 1024 * jt >= 0);
        f32x16 s[2];
        if (need) qk_tile<64>(KL + jt * 64 * KST, qf, s, negm, lane);
#pragma unroll
        for (int rt = 0; rt < 2; ++rt)
#pragma unroll
            for (int a = 0; a < 4; ++a) {
                float mainp = 0.f, sp = 0.f;
                if (need) {
                    float pb[4];
#pragma unroll
                    for (int bb = 0; bb < 4; ++bb) { const int kidx = 64 * jt + 32 * rt + 8 * a + 4 * hh + bb; const bool ok = (qv - 16 * kidx) >= 0; pb[bb] = ok ? fast_exp2(s[rt][4 * a + bb]) * inv : 0.f; }
                    mainp = pb[0] + pb[1] + pb[2] + 0.5f * pb[3]; sp = 0.5f * pb[3];
                }
                const float rc = __shfl_xor(sp, 32);
                float v = mainp + (hh ? rc : prev);
                prev = rc;
                v += __shfl_xor(v, 1); v += __shfl_xor(v, 2);
                if ((lane & 3) == 0) IMP[tokl * 64 + 2 * (8 * jt + 4 * rt + a) + hh] = v;
            }
    }
    __syncthreads();
    u64 mysel = 0ull;
#pragma unroll 1
    for (int tk = 0; tk < 8; ++tk) {
        const int tl = 8 * w + tk, t = 64 * qc + tl, j = lane;
        const float v = IMP[tl * 64 + j];
        const bool forced = (j == 0) || (j == qc) || (j == qc - 1);
        const bool valid = j <= qc;
        const float score = forced ? v + 1e4f : (valid ? v : -1.0f);
        int rank = 0;
#pragma unroll
        for (int jp = 0; jp < 64; ++jp) { const float o_ = __builtin_bit_cast(float, __builtin_amdgcn_readlane(__builtin_bit_cast(int, score), jp)); rank += ((o_ > score) || (o_ == score && jp < j)) ? 1 : 0; }
        const u64 mask = __ballot(rank < 16);
        (void)t;
        if (tk == (r32 >> 2)) mysel = mask;
    }
    __syncthreads();
    return mysel;
}

DI void moe_tables(const Ctx& F, int l) {
    LAS int* tb = (LAS int*)(F.lds + AUX_OFF); LAS int* cn = tb + 64;
    if (F.tid == 0) {
        const unsigned* C = (const unsigned*)(F.ws + WS_CTL) + CW_CNT + l * 32 * 64;
        int acc = 0;
        for (int e = 0; e < 32; ++e) { const int c = (int)__hip_atomic_load(C + e * 64, RLX_AGENT); tb[e] = acc; cn[e] = c; acc += (c + 255) >> 8; }
        tb[32] = acc;
    }
    __syncthreads();
}
template <int MODE>
DI void phase_norm1(const Ctx& F, int l) {
    const float* mods = (const float*)(F.ws + WS_MODS);
    const bf16* X = (const bf16*)(F.ws + WS_X); bf16* H = (bf16*)(F.ws + F.dofs + WS_H); bf16* XW = (bf16*)(F.ws + F.dofs + WS_X);
    const LAS int* tb = (const LAS int*)(F.lds + AUX_OFF);
    if (l > 0) moe_tables(F, l - 1);
    const int gw = F.blk * 8 + F.wave, NGW = F.G * 8, lane = F.lane;
    for (int tok = gw; tok < T; tok += NGW) {
        const int b = tok >> 12;
        f32x4 v[4];
        if (l == 0) { const float* xr = ginp(F, I_X) + (size_t)tok * 1024;
#pragma unroll
            for (int k = 0; k < 4; ++k) v[k] = *(const f32x4*)(xr + 4 * lane + 256 * k);
        } else { const bf16* xr = X + (size_t)tok * 1024;
#pragma unroll
            for (int k = 0; k < 4; ++k) { const u32x2 w = *(const u32x2*)(xr + 4 * lane + 256 * k); v[k] = (f32x4){bflo(w.x), bfhi(w.x), bflo(w.y), bfhi(w.y)}; }
        }
        if (l > 0) {
            f32x4 y[4];
#pragma unroll
            for (int k = 0; k < 4; ++k) y[k] = (f32x4){0.f, 0.f, 0.f, 0.f};
            const int* ts = (const int*)(F.ws + WS_TOKSLOT) + (size_t)tok * 4;
#pragma unroll
            for (int s = 0; s < 4; ++s) {
                const int pk = ts[s]; const int e = pk >> 16, pos = pk & 0xffff;
                const unsigned char* yr = (const unsigned char*)(F.ws + WS_Y2) + ((size_t)tb[e] * 256 + pos) * 1024;
#pragma unroll
                for (int k = 0; k < 4; ++k) { const unsigned w = *(const unsigned*)(yr + 4 * lane + 256 * k); y[k] += unpk4_fp8(w); }
            }
            const float* gt2 = mods + ((size_t)((l - 1) * 8 + b) * 6 + 5) * 1024;
#pragma unroll
            for (int k = 0; k < 4; ++k) v[k] = v[k] + *(const f32x4*)(gt2 + 4 * lane + 256 * k) * (y[k] * Y2_ISCALE);
        }
        float ss = 0.f;
#pragma unroll
        for (int k = 0; k < 4; ++k) ss += v[k][0] * v[k][0] + v[k][1] * v[k][1] + v[k][2] * v[k][2] + v[k][3] * v[k][3];
        const float rstd = rsqrtf(wave_sum(ss) * (1.0f / 1024.0f) + EPS);
        if (MODE == 0) {
            const float* g1 = ginp(F, I_G1) + (size_t)l * 1024;
            const float* sh = mods + ((size_t)(l * 8 + b) * 6 + 0) * 1024; const float* sc = sh + 1024;
#pragma unroll
            for (int k = 0; k < 4; ++k) {
                const int c = 4 * lane + 256 * k;
                { u32x2 xw; xw.x = pk2(v[k][0], v[k][1]); xw.y = pk2(v[k][2], v[k][3]); *(u32x2*)(XW + (size_t)tok * 1024 + c) = xw; }
                const f32x4 hv = v[k] * rstd * *(const f32x4*)(g1 + c) * (*(const f32x4*)(sc + c) + 1.0f) + *(const f32x4*)(sh + c);
                u32x2 w; w.x = pk2(hv[0], hv[1]); w.y = pk2(hv[2], hv[3]);
                *(u32x2*)(H + (size_t)tok * 1024 + c) = w;
            }
        } else {
            const float* gf = ginp(F, I_GF);
#pragma unroll
            for (int k = 0; k < 4; ++k) { const int c = 4 * lane + 256 * k; *(f32x4*)(gout(F) + (size_t)tok * 1024 + c) = v[k] * rstd * *(const f32x4*)(gf + c); }
        }
    }
}
DI void phase_prep(const Ctx& F) {
    const bf16* CQ = (const bf16*)(F.ws + WS_CQ); const bf16* MISC = (const bf16*)(F.ws + WS_MISC);
    float* RQ = (float*)(F.ws + WS_RSTDQ); float* RKV = (float*)(F.ws + WS_RSTDKV);
    bf16* KR = (bf16*)(F.ws + WS_KR); float* GATES = (float*)(F.ws + WS_GATES); const float* CS32 = (const float*)(F.ws + WS_CS32);
    const int gw = F.blk * 8 + F.wave, NGW = F.G * 8, lane = F.lane;
    for (int tok = gw; tok < T; tok += NGW) {
        const u32x2 wq = *(const u32x2*)(CQ + (size_t)tok * 256 + 4 * lane);
        const u32x2 wm = *(const u32x2*)(MISC + (size_t)tok * 256 + 4 * lane);
        float a0 = bflo(wq.x), a1 = bfhi(wq.x), a2 = bflo(wq.y), a3 = bfhi(wq.y);
        const float sq = wave_sum(a0 * a0 + a1 * a1 + a2 * a2 + a3 * a3);
        float m0 = bflo(wm.x), m1 = bfhi(wm.x), m2 = bflo(wm.y), m3 = bfhi(wm.y);
        const float skv = wave_sum(lane < 32 ? (m0 * m0 + m1 * m1 + m2 * m2 + m3 * m3) : 0.f);
        if (lane == 0) { RQ[tok] = rsqrtf(sq * (1.0f / 256.0f) + EPS); RKV[tok] = rsqrtf(skv * (1.0f / 128.0f) + EPS); }
        const float p0 = __shfl_xor(m0, 4), p1 = __shfl_xor(m1, 4), p2 = __shfl_xor(m2, 4), p3 = __shfl_xor(m3, 4);
        if (lane >= 32 && lane < 36) {
            const int i0 = 4 * (lane - 32);
            const f32x4 c4 = *(const f32x4*)(CS32 + (size_t)tok * 32 + i0), s4 = *(const f32x4*)(CS32 + (size_t)tok * 32 + 16 + i0);
            u32x4 w;
            w.x = pk2(m0 * c4[0] - p0 * s4[0], p0 * c4[0] + m0 * s4[0]); w.y = pk2(m1 * c4[1] - p1 * s4[1], p1 * c4[1] + m1 * s4[1]);
            w.z = pk2(m2 * c4[2] - p2 * s4[2], p2 * c4[2] + m2 * s4[2]); w.w = pk2(m3 * c4[3] - p3 * s4[3], p3 * c4[3] + m3 * s4[3]);
            *(u32x4*)(KR + (size_t)tok * 32 + 2 * i0) = w;
        }
        if (lane >= 40 && lane < 46) {
            const int gi = 4 * (lane - 40);
            *(f32x4*)(GATES + (size_t)tok * 24 + gi) = (f32x4){sigmoidf_(m0), sigmoidf_(m1), sigmoidf_(m2), sigmoidf_(m3)};
        }
    }
}
DI void phase_cmp2(const Ctx& F, int l) {
    const bf16* HID = (const bf16*)(F.ws + WS_HID);
    const float* CS64 = (const float*)(F.ws + WS_CS64);
    const int gw = F.blk * 8 + F.wave, NGW = F.G * 8, lane = F.lane;
    for (int it = gw; it < 8192; it += NGW) {
        const int kv = it >> 12, row = it & 4095, c = row & 255, bg = row >> 8;
        const float* w2 = ginp(F, kv ? I_W2V : I_W2K) + (size_t)l * 256 * 64;
        const float* b2 = ginp(F, kv ? I_B2V : I_B2K) + (size_t)l * 64;
        const u32x2 hw = *(const u32x2*)(HID + ((size_t)kv * 4096 + row) * 256 + 4 * lane);
        const float h0 = bflo(hw.x), h1 = bfhi(hw.x), h2 = bflo(hw.y), h3 = bfhi(hw.y);
        float acc = b2[lane];
#pragma unroll 4
        for (int k4 = 0; k4 < 64; ++k4) {
            const float x0 = __builtin_bit_cast(float, __builtin_amdgcn_readlane(__builtin_bit_cast(int, h0), k4));
            const float x1 = __builtin_bit_cast(float, __builtin_amdgcn_readlane(__builtin_bit_cast(int, h1), k4));
            const float x2 = __builtin_bit_cast(float, __builtin_amdgcn_readlane(__builtin_bit_cast(int, h2), k4));
            const float x3 = __builtin_bit_cast(float, __builtin_amdgcn_readlane(__builtin_bit_cast(int, h3), k4));
            acc += x0 * w2[(4 * k4 + 0) * 64 + lane] + x1 * w2[(4 * k4 + 1) * 64 + lane] + x2 * w2[(4 * k4 + 2) * 64 + lane] + x3 * w2[(4 * k4 + 3) * 64 + lane];
        }
        if (c == 255) acc = 0.f;
        if (kv == 0) {
            const int b = bg >> 1, tokr = b * S + 16 * c + 31;
            const float other = __shfl_xor(acc, 32);
            const int i = lane & 31;
            const float cs = CS64[(size_t)(tokr & (T - 1)) * 64 + i], sn = CS64[(size_t)(tokr & (T - 1)) * 64 + 32 + i];
            const float y = (lane < 32) ? (acc * cs - other * sn) : (acc * cs + other * sn);
            ((bf16*)(F.ws + WS_KC))[(size_t)row * 64 + 2 * i + (lane >> 5)] = (bf16)(pk2(y, 0.f) & 0xffffu);
        } else {
            ((bf16*)(F.ws + WS_VC))[(size_t)row * 64 + lane] = (bf16)(pk2(acc, 0.f) & 0xffffu);
        }
    }
}
DI void phase_mix(const Ctx& F, int l) {
    const bf16* OA3 = (const bf16*)(F.ws + WS_OA3); const float* LSEA = (const float*)(F.ws + WS_LSEA);
    const bf16* OCMP = (const bf16*)(F.ws + WS_OCMP); const bf16* OSLC = (const bf16*)(F.ws + WS_OSLC); const bf16* OWIN = (const bf16*)(F.ws + WS_OWIN);
    const bf16* OC = (const bf16*)(F.ws + WS_OC); const bf16* MISC = (const bf16*)(F.ws + WS_MISC);
    bf16* AMIX = (bf16*)(F.ws + WS_AMIX);
    const float* ga = ginp(F, I_GOA) + (size_t)l * 256; const float* gb = ginp(F, I_GOB) + (size_t)l * 512; const float* gc = ginp(F, I_GOC) + (size_t)l * 256;
    const int gw = F.blk * 8 + F.wave, NGW = F.G * 8, lane = F.lane, ha = lane >> 4;
    for (int tok0 = gw; tok0 < T; tok0 += 2 * NGW) {
        int tok[2]; tok[0] = tok0; tok[1] = (tok0 + NGW < T) ? tok0 + NGW : tok0;
        float ls[2][3]; u32x2 wa[2][3], wb[2][2][3], wc_[2]; float gl[2][2][3];
#pragma unroll
        for (int q = 0; q < 2; ++q) {
#pragma unroll
            for (int p = 0; p < 3; ++p) { ls[q][p] = LSEA[((size_t)p * T + tok[q]) * 4 + ha]; wa[q][p] = *(const u32x2*)(OA3 + ((size_t)p * T + tok[q]) * 256 + 4 * lane); }
#pragma unroll
            for (int k = 0; k < 2; ++k) {
                const int col = 256 * k + 4 * lane, hb = col >> 6;
                const bf16* g_ = MISC + (size_t)tok[q] * 256 + 160 + hb * 3;
                gl[q][k][0] = bf2f(g_[0]); gl[q][k][1] = bf2f(g_[1]); gl[q][k][2] = bf2f(g_[2]);
                wb[q][k][0] = *(const u32x2*)(OCMP + (size_t)tok[q] * 512 + col); wb[q][k][1] = *(const u32x2*)(OSLC + (size_t)tok[q] * 512 + col); wb[q][k][2] = *(const u32x2*)(OWIN + (size_t)tok[q] * 512 + col);
            }
            wc_[q] = *(const u32x2*)(OC + (size_t)tok[q] * 256 + 4 * lane);
        }
        f32x4 va[2], vb[2][2], vc[2]; float red[2][3];
#pragma unroll
        for (int q = 0; q < 2; ++q) {
            const float mx = fmaxf(ls[q][0], fmaxf(ls[q][1], ls[q][2]));
            const float w0 = fast_exp2(ls[q][0] - mx), w1 = fast_exp2(ls[q][1] - mx), w2 = fast_exp2(ls[q][2] - mx), wi = 1.0f / (w0 + w1 + w2);
            va[q] = ((f32x4){bflo(wa[q][0].x), bfhi(wa[q][0].x), bflo(wa[q][0].y), bfhi(wa[q][0].y)} * w0 + (f32x4){bflo(wa[q][1].x), bfhi(wa[q][1].x), bflo(wa[q][1].y), bfhi(wa[q][1].y)} * w1
                   + (f32x4){bflo(wa[q][2].x), bfhi(wa[q][2].x), bflo(wa[q][2].y), bfhi(wa[q][2].y)} * w2) * wi;
            red[q][0] = va[q][0] * va[q][0] + va[q][1] * va[q][1] + va[q][2] * va[q][2] + va[q][3] * va[q][3];
            float sb = 0.f;
#pragma unroll
            for (int k = 0; k < 2; ++k) {
                const float g0 = sigmoidf_(gl[q][k][0]), g1 = sigmoidf_(gl[q][k][1]), g2 = sigmoidf_(gl[q][k][2]);
                const u32x2 a = wb[q][k][0], b_ = wb[q][k][1], c_ = wb[q][k][2];
                vb[q][k][0] = g0 * bflo(a.x) + g1 * bflo(b_.x) + g2 * bflo(c_.x); vb[q][k][1] = g0 * bfhi(a.x) + g1 * bfhi(b_.x) + g2 * bfhi(c_.x);
                vb[q][k][2] = g0 * bflo(a.y) + g1 * bflo(b_.y) + g2 * bflo(c_.y); vb[q][k][3] = g0 * bfhi(a.y) + g1 * bfhi(b_.y) + g2 * bfhi(c_.y);
                sb += vb[q][k][0] * vb[q][k][0] + vb[q][k][1] * vb[q][k][1] + vb[q][k][2] * vb[q][k][2] + vb[q][k][3] * vb[q][k][3];
            }
            red[q][1] = sb;
            vc[q] = (f32x4){bflo(wc_[q].x), bfhi(wc_[q].x), bflo(wc_[q].y), bfhi(wc_[q].y)};
            red[q][2] = vc[q][0] * vc[q][0] + vc[q][1] * vc[q][1] + vc[q][2] * vc[q][2] + vc[q][3] * vc[q][3];
        }
#pragma unroll
        for (int o = 1; o < 64; o <<= 1) {
#pragma unroll
            for (int q = 0; q < 2; ++q)
#pragma unroll
                for (int j = 0; j < 3; ++j) red[q][j] += __shfl_xor(red[q][j], o);
        }
#pragma unroll
        for (int q = 0; q < 2; ++q) {
            if (q == 1 && tok0 + NGW >= T) break;
            const float ra = rsqrtf(red[q][0] * (1.0f / 256.0f) + EPS), rb = rsqrtf(red[q][1] * (1.0f / 512.0f) + EPS), rc = rsqrtf(red[q][2] * (1.0f / 256.0f) + EPS);
            bf16* orow = AMIX + (size_t)tok[q] * 1024;
            { const f32x4 o = va[q] * ra * *(const f32x4*)(ga + 4 * lane); u32x2 w; w.x = pk2(o[0], o[1]); w.y = pk2(o[2], o[3]); *(u32x2*)(orow + 4 * lane) = w; }
#pragma unroll
            for (int k = 0; k < 2; ++k) { const f32x4 o = vb[q][k] * rb * *(const f32x4*)(gb + 256 * k + 4 * lane); u32x2 w; w.x = pk2(o[0], o[1]); w.y = pk2(o[2], o[3]); *(u32x2*)(orow + 256 + 256 * k + 4 * lane) = w; }
            { const f32x4 o = vc[q] * rc * *(const f32x4*)(gc + 4 * lane); u32x2 w; w.x = pk2(o[0], o[1]); w.y = pk2(o[2], o[3]); *(u32x2*)(orow + 768 + 4 * lane) = w; }
        }
    }
}
DI void phase_router(const Ctx& F, int l) {
    LAS float* WR = (LAS float*)F.lds;
    LAS int* lcnt = (LAS int*)(F.lds + AUX_OFF + 1024); LAS int* gbase = lcnt + 32;
    LAS int* tokE = gbase + 32; LAS float* tokG = (LAS float*)(tokE + 512); LAS int* tokP = (LAS int*)(tokG + 512);
    const float* wr = ginp(F, I_WR) + (size_t)l * 1024 * 32; const float* br = ginp(F, I_BR) + (size_t)l * 32;
    const float* mods = (const float*)(F.ws + WS_MODS); const bf16* X = (const bf16*)(F.ws + WS_X); bf16* H = (bf16*)(F.ws + F.dofs + WS_H);
    const float* g2 = ginp(F, I_G2) + (size_t)l * 1024;
    const int tid = F.tid, lane = F.lane, w = F.wave;
    for (int it = 0; it < 64; ++it) { const int idx = tid + 512 * it, d = idx >> 5, e = idx & 31; WR[e * 1024 + ((((d >> 2) ^ e) << 2) | (d & 3))] = wr[idx]; }
    if (tid < 32) lcnt[tid] = 0;
    __syncthreads();
    unsigned* CNT = (unsigned*)(F.ws + WS_CTL) + CW_CNT + (l + F.dcnt) * 32 * 64;
    for (int chunk = F.blk; chunk < T / 128; chunk += F.G) {
#pragma unroll 1
        for (int tt = 0; tt < 8; ++tt) {
            const int tl0 = w * 16 + 2 * tt, tok0 = chunk * 128 + tl0, b = tok0 >> 12;
            const float* sh = mods + ((size_t)(l * 8 + b) * 6 + 3) * 1024; const float* sc = sh + 1024;
            f32x4 v[2][4]; float ss0 = 0.f, ss1 = 0.f;
#pragma unroll
            for (int k = 0; k < 4; ++k) { const u32x2 wa = *(const u32x2*)(X + (size_t)tok0 * 1024 + 4 * lane + 256 * k), wb = *(const u32x2*)(X + (size_t)(tok0 + 1) * 1024 + 4 * lane + 256 * k);
                v[0][k] = (f32x4){bflo(wa.x), bfhi(wa.x), bflo(wa.y), bfhi(wa.y)}; v[1][k] = (f32x4){bflo(wb.x), bfhi(wb.x), bflo(wb.y), bfhi(wb.y)}; }
#pragma unroll
            for (int k = 0; k < 4; ++k) { ss0 += v[0][k][0] * v[0][k][0] + v[0][k][1] * v[0][k][1] + v[0][k][2] * v[0][k][2] + v[0][k][3] * v[0][k][3];
                                          ss1 += v[1][k][0] * v[1][k][0] + v[1][k][1] * v[1][k][1] + v[1][k][2] * v[1][k][2] + v[1][k][3] * v[1][k][3]; }
#pragma unroll
            for (int o = 1; o < 64; o <<= 1) { ss0 += __shfl_xor(ss0, o); ss1 += __shfl_xor(ss1, o); }
            const float rs0 = rsqrtf(ss0 * (1.0f / 1024.0f) + EPS), rs1 = rsqrtf(ss1 * (1.0f / 1024.0f) + EPS);
#pragma unroll
            for (int k = 0; k < 4; ++k) {
                const int c = 4 * lane + 256 * k;
                const f32x4 gg = *(const f32x4*)(g2 + c) * (*(const f32x4*)(sc + c) + 1.0f), hh_ = *(const f32x4*)(sh + c);
                v[0][k] = v[0][k] * rs0 * gg + hh_; v[1][k] = v[1][k] * rs1 * gg + hh_;
                *(unsigned*)((unsigned char*)H + (size_t)tok0 * 1024 + c) = pk4_fp8s(v[0][k][0], v[0][k][1], v[0][k][2], v[0][k][3], H8_SCALE);
                *(unsigned*)((unsigned char*)H + (size_t)(tok0 + 1) * 1024 + c) = pk4_fp8s(v[1][k][0], v[1][k][1], v[1][k][2], v[1][k][3], H8_SCALE);
            }
            float p0[32], p1[32];
#pragma unroll
            for (int e = 0; e < 32; ++e) {
                float s0 = 0.f, s1 = 0.f;
#pragma unroll
                for (int k = 0; k < 4; ++k) { const f32x4 wv = *(const LAS f32x4*)(WR + e * 1024 + (((lane + 64 * k) ^ e) << 2));
                    s0 += v[0][k][0] * wv[0] + v[0][k][1] * wv[1] + v[0][k][2] * wv[2] + v[0][k][3] * wv[3];
                    s1 += v[1][k][0] * wv[0] + v[1][k][1] * wv[1] + v[1][k][2] * wv[2] + v[1][k][3] * wv[3]; }
                p0[e] = s0; p1[e] = s1;
            }
#define RT_HALVE(N, BIT) _Pragma("unroll") for (int i = 0; i < N; ++i) { const bool hi = (lane & BIT) != 0; \
                { const float keep = hi ? p0[i + N] : p0[i], send = hi ? p0[i] : p0[i + N]; p0[i] = keep + __shfl_xor(send, BIT); } \
                { const float keep = hi ? p1[i + N] : p1[i], send = hi ? p1[i] : p1[i + N]; p1[i] = keep + __shfl_xor(send, BIT); } }
            RT_HALVE(16, 32) RT_HALVE(8, 16) RT_HALVE(4, 8) RT_HALVE(2, 4) RT_HALVE(1, 2)
#undef RT_HALVE
            const float bre = br[lane >> 1];
            const float lg0 = p0[0] + __shfl_xor(p0[0], 1) + bre, lg1 = p1[0] + __shfl_xor(p1[0], 1) + bre;
            int rk0 = 0, rk1 = 0; const int me = lane >> 1;
#pragma unroll
            for (int e = 0; e < 32; ++e) {
                const float o0 = __builtin_bit_cast(float, __builtin_amdgcn_readlane(__builtin_bit_cast(int, lg0), 2 * e));
                const float o1 = __builtin_bit_cast(float, __builtin_amdgcn_readlane(__builtin_bit_cast(int, lg1), 2 * e));
                rk0 += ((o0 > lg0) || (o0 == lg0 && e < me)) ? 1 : 0; rk1 += ((o1 > lg1) || (o1 == lg1 && e < me)) ? 1 : 0;
            }
#pragma unroll
            for (int tk = 0; tk < 2; ++tk) {
                const int rk = tk ? rk1 : rk0; const float lg = tk ? lg1 : lg0;
                int te[4]; float tv[4];
#pragma unroll
                for (int r = 0; r < 4; ++r) {
                    const u64 mk = __ballot(rk == r && (lane & 1) == 0);
                    const int sl = __builtin_amdgcn_readfirstlane((int)__builtin_ctzll(mk));
                    te[r] = sl >> 1; tv[r] = __builtin_bit_cast(float, __builtin_amdgcn_readlane(__builtin_bit_cast(int, lg), sl));
                }
                const float e1 = __expf(tv[1] - tv[0]), e2 = __expf(tv[2] - tv[0]), e3 = __expf(tv[3] - tv[0]);
                const float isum = 1.0f / (1.0f + e1 + e2 + e3);
                if (lane < 4) {
                    const int tl = tl0 + tk;
                    const int e = lane == 0 ? te[0] : lane == 1 ? te[1] : lane == 2 ? te[2] : te[3];
                    const float gte = (lane == 0 ? 1.0f : lane == 1 ? e1 : lane == 2 ? e2 : e3) * isum;
                    const int pos = atomicAdd((int*)(lcnt + e), 1);
                    tokE[tl * 4 + lane] = e; tokG[tl * 4 + lane] = gte; tokP[tl * 4 + lane] = pos;
                }
            }
        }
        __syncthreads();
        if (tid < 32) gbase[tid] = (int)__hip_atomic_fetch_add(CNT + tid * 64, (unsigned)lcnt[tid], RLX_AGENT);
        __syncthreads();
        {
            const int tl = tid >> 2, r = tid & 3, e = tokE[tid], pos = gbase[e] + tokP[tid], tok = chunk * 128 + tl;
            ((int*)(F.ws + F.dofs + WS_IDX))[(size_t)e * ECAP + pos] = tok;
            ((float*)(F.ws + F.dofs + WS_GATEW))[(size_t)e * ECAP + pos] = tokG[tid];
            ((int*)(F.ws + F.dofs + WS_TOKSLOT))[(size_t)tok * 4 + r] = (e << 16) | pos;
        }
        __syncthreads();
        if (tid < 32) lcnt[tid] = 0;
        __syncthreads();
    }
}

DI int ropeperm64(int p) { return (p >> 1) + 32 * (p & 1); }
DI int cmap_win(int n) {
    const int tile = n >> 8, w = n & 255, hb = w & ~63, pp = ropeperm64(w & 63);
    switch (tile) {
        case 0: return hb + pp;
        case 1: return 256 + hb + pp;
        case 2: return 512 + w;
        case 3: return 768 + hb + pp;
        case 4: return 1024 + hb + pp;
        case 5: return w < 128 ? 1280 + w : 1408 + (w - 128);
        case 6: return w < 128 ? 1536 + hb + pp : 1664 + (w - 128);
        case 7: return w < 128 ? 1792 + hb + pp : 1920 + (w - 128);
        case 8: return 2072 + w;
        default: return w < 128 ? 2328 + w : (w < 160 ? 2456 + ((w - 128) >> 1) + 16 * ((w - 128) & 1) : (w < 184 ? 2048 + (w - 160) : -1));
    }
}
DI int cmap_qup(int n) { if (n >= 384) return -1; const int h = n / 96, w = n % 96; if (w < 64) return h * 96 + w; const int j = w - 64; return h * 96 + 64 + (j >> 1) + 16 * (j & 1); }
DI void tr_tile(const float* src, int K, int Nsrc, bf16* dst, int Kdst, int maptype, const float* ksc, int ntile, int ktile, LAS float* scr, int tid) {
    const int n0 = ntile * 64, k0 = ktile * 128, nl = tid & 63, n = n0 + nl;
    const int c = maptype == 0 ? (n < Nsrc ? n : -1) : (maptype == 1 ? cmap_win(n) : cmap_qup(n));
    float v[16];
#pragma unroll
    for (int it = 0; it < 16; ++it) { const int k = k0 + (tid >> 6) + 8 * it; v[it] = (c >= 0 && k < K) ? src[(size_t)k * Nsrc + c] * (ksc ? ksc[k] : 1.0f) : 0.f; }
#pragma unroll
    for (int it = 0; it < 16; ++it) scr[((tid >> 6) + 8 * it) * 65 + nl] = v[it];
    __syncthreads();
#pragma unroll
    for (int it = 0; it < 2; ++it) {
        const int idx = tid + 512 * it, nn = idx >> 4, ch = idx & 15;
        const LAS float* s = scr + (8 * ch) * 65 + nn;
        u32x4 o; o.x = pk2(s[0], s[65]); o.y = pk2(s[2 * 65], s[3 * 65]); o.z = pk2(s[4 * 65], s[5 * 65]); o.w = pk2(s[6 * 65], s[7 * 65]);
        *(u32x4*)(dst + (size_t)(n0 + nn) * Kdst + k0 + 8 * ch) = o;
    }
    __syncthreads();
}
DI void trb_load(f32x4 (&v)[16], const float* src, int N, int n0, int k0, int tid) {
#pragma unroll
    for (int it = 0; it < 16; ++it) v[it] = *(const f32x4*)(src + (size_t)(k0 + (tid >> 6) + 8 * it) * N + n0 + 4 * (tid & 63));
}
DI void trb_store(const f32x4 (&v)[16], bf16* dst, int Kd, int n0, int k0, LAS unsigned char* L, int tid, int wave, int lane, int f8 = 0) {
#pragma unroll
    for (int it = 0; it < 16; ++it) { f32x4 x = v[it];
        if (f8) { x[0] = q8s(x[0], W8_SCALE); x[1] = q8s(x[1], W8_SCALE); x[2] = q8s(x[2], W8_SCALE); x[3] = q8s(x[3], W8_SCALE); }
        u32x2 w; w.x = pk2(x[0], x[1]); w.y = pk2(x[2], x[3]); *(LAS u32x2*)(L + ((tid >> 6) + 8 * it) * 576 + (tid & 63) * 8) = w; }
    asm volatile("s_waitcnt lgkmcnt(0)\n\ts_barrier" ::: "memory");
    const int i = lane & 15, gn = (lane >> 4) & 1, h = lane >> 5, q = i >> 2, p = i & 3;
    const LAS unsigned char* base = L + (8 * h + q) * 576 + (32 * wave + 16 * gn) * 2 + 8 * p;
    if (!f8) {
        bf16* drow = dst + (size_t)(n0 + 32 * wave + 16 * gn + i) * Kd + k0 + 8 * h;
#pragma unroll
        for (int kcp = 0; kcp < 8; ++kcp) {
            const s16x4 lo = tr_read(base + (16 * kcp) * 576), hi = tr_read(base + (16 * kcp + 4) * 576);
            *(bf16x8*)(drow + 16 * kcp) = __builtin_shufflevector(lo, hi, 0, 1, 2, 3, 4, 5, 6, 7);
        }
    } else {
        unsigned char* drow = (unsigned char*)dst + (size_t)(n0 + 32 * wave + 16 * gn + i) * Kd + k0 + 8 * h;
#pragma unroll
        for (int kcp = 0; kcp < 8; ++kcp) {
            const s16x4 lo = tr_read(base + (16 * kcp) * 576), hi = tr_read(base + (16 * kcp + 4) * 576);
            int w0 = __builtin_amdgcn_cvt_pk_fp8_f32(bf2f((unsigned short)lo[0]), bf2f((unsigned short)lo[1]), 0, false); w0 = __builtin_amdgcn_cvt_pk_fp8_f32(bf2f((unsigned short)lo[2]), bf2f((unsigned short)lo[3]), w0, true);
            int w1 = __builtin_amdgcn_cvt_pk_fp8_f32(bf2f((unsigned short)hi[0]), bf2f((unsigned short)hi[1]), 0, false); w1 = __builtin_amdgcn_cvt_pk_fp8_f32(bf2f((unsigned short)hi[2]), bf2f((unsigned short)hi[3]), w1, true);
            u32x2 o; o.x = (unsigned)w0; o.y = (unsigned)w1;
            *(u32x2*)(drow + 16 * kcp) = o;
        }
    }
    asm volatile("s_waitcnt lgkmcnt(0)\n\ts_barrier" ::: "memory");
}
struct TrbItem { const float* src; bf16* dst; int N, n0, k0, f8; };
DI TrbItem trb_item(const Ctx& F, int it) {
    const int le = it / 96, r = it % 96; TrbItem t;
    if (r < 64) { t.src = ginp(F, I_WE1) + (size_t)le * 1024 * 2048; t.dst = (bf16*)(F.ws + WS_W1E + (size_t)le * 2048 * 1024); t.N = 2048; t.n0 = (r & 7) * 256; t.k0 = (r >> 3) * 128; t.f8 = 1; }
    else { const int q = r - 64; t.src = ginp(F, I_WE2) + (size_t)le * 1024 * 1024; t.dst = (bf16*)(F.ws + WS_W2E + (size_t)le * 1024 * 1024); t.N = 1024; t.n0 = (q & 3) * 256; t.k0 = (q >> 2) * 128; t.f8 = 1; }
    return t;
}
DI void conv_layer_tiles(const Ctx& F, int l, int i0, int cnt) {
    const int NL = 32 * 96;
    int it = F.blk + F.G * i0; const int end = F.blk + F.G * (i0 + cnt);
    if (it >= NL) return;
    f32x4 va[16];
    TrbItem ta = trb_item(F, l * NL + it);
    trb_load(va, ta.src, ta.N, ta.n0, ta.k0, F.tid);
#pragma unroll 1
    while (it < NL && it < end) {
        f32x4 vb[16];
#pragma unroll
        for (int k = 0; k < 16; ++k) vb[k] = va[k];
        const TrbItem tc = ta;
        it += F.G;
        const bool more = (it < NL && it < end);
        ta = trb_item(F, l * NL + (more ? it : 0));
        if (more) trb_load(va, ta.src, ta.N, ta.n0, ta.k0, F.tid);
        trb_store(vb, tc.dst, 1024, tc.n0, tc.k0, F.lds, F.tid, F.wave, F.lane, tc.f8);
    }
}
DI void phase_prologue(const Ctx& F) {
    const Args& A = *F.a; const int tid = F.tid;
    LAS float* scr = (LAS float*)F.lds;
    if (!CONV_IN_LAYER) {
        const int NIT = DEPTH * 32 * 96;
        f32x4 va[16];
        int it = F.blk;
        TrbItem ta = trb_item(F, it < NIT ? it : 0);
        if (it < NIT) trb_load(va, ta.src, ta.N, ta.n0, ta.k0, tid);
#pragma unroll 1
        while (it < NIT) {
            f32x4 vb[16];
#pragma unroll
            for (int k = 0; k < 16; ++k) vb[k] = va[k];
            const TrbItem tc = ta;
            it += F.G;
            ta = trb_item(F, it < NIT ? it : 0);
            if (it < NIT) trb_load(va, ta.src, ta.N, ta.n0, ta.k0, tid);
            trb_store(vb, tc.dst, 1024, tc.n0, tc.k0, F.lds, tid, F.wave, F.lane, tc.f8);
        }
    }
    constexpr int PER_L = 8192 + 4096 + 320 + 128 + 128 + 16 + 16;
    for (int it = F.blk; it < DEPTH * PER_L; it += F.G) {
        const int l = it / PER_L; int r = it % PER_L;
        if (r < 8192 + 4096) continue;
        if (r < 8192) { const int e = r >> 8, t = r & 255;
            tr_tile(ginp(F, I_WE1) + ((size_t)(l * 32 + e)) * 1024 * 2048, 1024, 2048, (bf16*)(F.ws + WS_W1E) + ((size_t)(l * 32 + e)) * 2048 * 1024, 1024, 0, nullptr, t >> 3, t & 7, scr, tid); continue; }
        r -= 8192;
        if (r < 4096) { const int e = r >> 7, t = r & 127;
            tr_tile(ginp(F, I_WE2) + ((size_t)(l * 32 + e)) * 1024 * 1024, 1024, 1024, (bf16*)(F.ws + WS_W2E) + ((size_t)(l * 32 + e)) * 1024 * 1024, 1024, 0, nullptr, t >> 3, t & 7, scr, tid); continue; }
        r -= 4096;
        if (r < 320) { tr_tile(ginp(F, I_WIN) + (size_t)l * 1024 * 2488, 1024, 2488, (bf16*)(F.ws + WS_WIN) + (size_t)l * NIN * 1024, 1024, 1, nullptr, r >> 3, r & 7, scr, tid); continue; }
        r -= 320;
        if (r < 128) { tr_tile(ginp(F, I_WOUT) + (size_t)l * 1024 * 1024, 1024, 1024, (bf16*)(F.ws + WS_WOUT) + (size_t)l * 1024 * 1024, 1024, 0, nullptr, r >> 3, r & 7, scr, tid); continue; }
        r -= 128;
        if (r < 128) { const int kv = r >> 6, t = r & 63;
            tr_tile(ginp(F, kv ? I_W1V : I_W1K) + (size_t)l * 2048 * 256, 2048, 256, (bf16*)(F.ws + WS_NSAW1) + ((size_t)(l * 2 + kv)) * 256 * 2048, 2048, 0, nullptr, t >> 4, t & 15, scr, tid); continue; }
        r -= 128;
        if (r < 16) { tr_tile(ginp(F, I_WQUP) + (size_t)l * 256 * 384, 256, 384, (bf16*)(F.ws + WS_MLAQ) + (size_t)l * 512 * 256, 256, 2, ginp(F, I_GQ) + (size_t)l * 256, r >> 1, r & 1, scr, tid); continue; }
        r -= 16;
        tr_tile(ginp(F, I_WKVUP) + (size_t)l * 128 * 512, 128, 512, (bf16*)(F.ws + WS_MLAKV) + (size_t)l * 512 * 256, 256, 0, ginp(F, I_GKV) + (size_t)l * 128, r >> 1, r & 1, scr, tid);
    }
    for (int it = F.blk; it < DEPTH * 4; it += F.G) {
        const int l = it >> 2, kv = (it >> 1) & 1, kt = it & 1;
        tr_tile(ginp(F, kv ? I_W2V : I_W2K) + (size_t)l * 256 * 64, 256, 64, (bf16*)(F.ws + WS_W2T) + ((size_t)(l * 2 + kv)) * 64 * 256, 256, 0, nullptr, 0, kt, scr, tid);
    }
    {
        float* CS64 = (float*)(F.ws + WS_CS64); float* CS32 = (float*)(F.ws + WS_CS32);
        const int* pos = (const int*)ginp(F, I_POS);
        for (int idx = F.blk * 512 + tid; idx < T * 48; idx += F.G * 512) {
            const int tok = idx / 48, i = idx % 48;
            const double p = (double)pos[tok];
            const double inv = (i < 32) ? exp2(-(double)i * (13.287712379549449 / 32.0)) : exp2(-(double)(i - 32) * (13.287712379549449 / 16.0));
            double ang = p * inv;
            const double kk = __builtin_rint(ang * 0.15915494309189535);
            ang = ang - kk * 6.283185307179586;
            const float af = (float)ang;
            const float cs = __cosf(af), sn = __sinf(af);
            if (i < 32) { CS64[(size_t)tok * 64 + i] = cs; CS64[(size_t)tok * 64 + 32 + i] = sn; }
            else { CS32[(size_t)tok * 32 + (i - 32)] = cs; CS32[(size_t)tok * 32 + 16 + (i - 32)] = sn; }
        }
    }
    for (int item = F.blk; item < 32; item += F.G) {
        const int lk = item >> 2, l = lk >> 1, kv = lk & 1, col = (item & 3) * 64 + F.lane;
        const float* w1 = ginp(F, kv ? I_W1V : I_W1K) + (size_t)l * 2048 * 256 + col; const float* pe = ginp(F, kv ? I_POSV : I_POSK) + (size_t)l * 2048;
        float s = 0.f;
#pragma unroll 1
        for (int kb = 256 * F.wave; kb < 256 * F.wave + 256; kb += 16) {
            float wv[16];
#pragma unroll
            for (int j = 0; j < 16; ++j) wv[j] = w1[(size_t)(kb + j) * 256];
#pragma unroll
            for (int j = 0; j < 16; ++j) s += pe[kb + j] * wv[j];
        }
        scr[F.wave * 64 + F.lane] = s;
        __syncthreads();
        if (tid < 64) { float t = ginp(F, kv ? I_B1V : I_B1K)[(size_t)l * 256 + col];
#pragma unroll
            for (int ww = 0; ww < 8; ++ww) t += scr[ww * 64 + tid];
            ((float*)(F.ws + WS_B1P))[(size_t)lk * 256 + col] = t; }
        __syncthreads();
    }
    {
        LAS float* sc = scr; LAS float* red = scr + 8192;
        for (int i = tid; i < 8192; i += 512) { const float c = ginp(F, I_C)[i]; sc[i] = c * sigmoidf_(c); }
        __syncthreads();
        float* MODS = (float*)(F.ws + WS_MODS);
        const int lane = F.lane, w = F.wave;
        for (int item = F.blk; item < 384; item += F.G) {
            const int l = item / 96, col = (item % 96) * 64 + lane;
            float acc[8];
#pragma unroll
            for (int b = 0; b < 8; ++b) acc[b] = 0.f;
            const float* wa = ginp(F, I_WADA) + (size_t)l * 1024 * 6144 + col;
#pragma unroll 1
            for (int kb = 128 * w; kb < 128 * w + 128; kb += 16) {
                float wv[16];
#pragma unroll
                for (int j = 0; j < 16; ++j) wv[j] = wa[(size_t)(kb + j) * 6144];
#pragma unroll
                for (int j = 0; j < 16; ++j) {
#pragma unroll
                    for (int b = 0; b < 8; ++b) acc[b] += sc[b * 1024 + kb + j] * wv[j]; }
            }
#pragma unroll
            for (int b = 0; b < 8; ++b) red[(w * 8 + b) * 64 + lane] = acc[b];
            __syncthreads();
            { const int b = tid >> 6; float s = ginp(F, I_BADA)[(size_t)l * 6144 + col];
#pragma unroll
              for (int ww = 0; ww < 8; ++ww) s += red[(ww * 8 + b) * 64 + lane];
              MODS[((size_t)(l * 8 + b)) * 6144 + col] = s; }
            __syncthreads();
        }
    }
}

constexpr int PH_PER_LAYER = 11;
constexpr int N_PHASES = 1 + DEPTH * PH_PER_LAYER + 1;

__global__ void __launch_bounds__(512, 2) fwd_kernel(Args args) {
    extern __shared__ __attribute__((aligned(16))) unsigned char lds_raw[];
    Ctx F;
    F.lds = (LAS unsigned char*)lds_raw; F.a = &args; F.ws = args.ws;
    F.dofs = 0; F.dcnt = 0;
    F.tid = threadIdx.x; F.lane = F.tid & 63; F.wave = __builtin_amdgcn_readfirstlane(F.tid >> 6); F.blk = blockIdx.x; F.G = gridDim.x; F.vcu = F.blk;
    volatile LAS unsigned* MISC = (volatile LAS unsigned*)(F.lds + MISC_OFF);
    for (int u = F.tid; u < (LDS_BYTES - MISC_OFF) / 4; u += 512) MISC[u] = 0u;
    __syncthreads();
    unsigned* ctl = (unsigned*)(F.ws + WS_CTL);
    XcdBarrier bar; bar.bar = ctl + CW_BAR; bar.x = 0; bar.st = nullptr;
    if (!MK_PER_PHASE) bar = xcd_barrier_post(ctl + CW_BAR, MISC + 8);
    const int lo = args.ph_lo, hi = args.ph_hi;
#define IN(k) (lo <= (k) && (k) < hi)
#define SEAM(k) do { if (IN(k) && IN((k) + 1)) xcd_barrier(bar); } while (0)
    unsigned char* ws = F.ws;
#define PHASE_BEGIN() do { int t_ = threadIdx.x; asm volatile("" : "+v"(t_)); F.tid = t_; F.lane = t_ & 63; F.wave = __builtin_amdgcn_readfirstlane(t_ >> 6); \
        GAS unsigned char* w_ = (GAS unsigned char*)args.ws; asm volatile("" : "+s"(w_)); F.ws = (unsigned char*)w_; ws = (unsigned char*)w_; int b_ = blockIdx.x; asm volatile("" : "+s"(b_)); F.blk = b_; F.vcu = (F.G % 8 == 0) ? (b_ % 8) * (F.G / 8) + b_ / 8 : b_; } while (0)

    if (PHON(0) && IN(0)) _Pragma("unroll 1") for (int rep_ = 0; rep_ < NREP(0); ++rep_) { PHASE_BEGIN(); phase_prologue(F); }
    SEAM(0);
#pragma unroll 1
    for (int l = 0; l < DEPTH; ++l) {
        const int P = 1 + l * PH_PER_LAYER;
        if (PHON(1) && IN(P + 0)) _Pragma("unroll 1") for (int rep_ = 0; rep_ < (DUM(1) ? 2 : 1); ++rep_) { PHASE_BEGIN(); F.dofs = (DUM(1) && rep_ == 0) ? WS_END : 0; phase_norm1<0>(F, l); }
        SEAM(P + 0);
        if (PHON(2) && IN(P + 1)) _Pragma("unroll 1") for (int rep_ = 0; rep_ < NREP(2); ++rep_) { PHASE_BEGIN();
            SchedGrid Sg{(const char*)(ws + WS_H), (const char*)(ws + WS_WIN) + (size_t)l * NIN * 1024 * 2, 1024, 1024, NIN / 256, (T / 256) * (NIN / 256), F.G, F.vcu};
            EpiWin E{ws, (const float*)(ws + WS_CS64), (const float*)(ws + WS_CS32)};
            pg8::gemm_phase<EpiWin, SchedGrid, false>(F.lds, 1024, 1024, Sg, E);
        }
        SEAM(P + 1);
        if (PHON(3) && IN(P + 2)) _Pragma("unroll 1") for (int rep_ = 0; rep_ < NREP(3); ++rep_) { PHASE_BEGIN();
            if (PHON(13)) {
                SchedCmp Sc{(const char*)(ws + WS_KCMP), (const char*)(ws + WS_VCMP), (const char*)(ws + WS_NSAW1) + (size_t)l * 2 * 256 * 2048 * 2, F.G, F.blk};
                EpiCmp E{(const float*)(ws + WS_B1P) + (size_t)l * 512, (const bf16*)(ws + WS_W2T) + (size_t)l * 2 * 64 * 256, ginp(F, I_B2K) + (size_t)l * 64, ginp(F, I_B2V) + (size_t)l * 64,
                         (bf16*)(ws + WS_KC), (bf16*)(ws + WS_VC), (const float*)(ws + WS_CS64)};
                pg8::gemm_phase<EpiCmp, SchedCmp, false>(F.lds, 1024, 2048, Sc, E);
            }
            PHASE_BEGIN();
            if (PHON(18)) {
                SchedMla Sm{(const char*)(ws + WS_CQ), (const char*)(ws + WS_MISC), (const char*)(ws + WS_MLAQ) + (size_t)l * 512 * 256 * 2, (const char*)(ws + WS_MLAKV) + (size_t)l * 512 * 256 * 2, F.G, F.vcu};
                EpiMla E{(bf16*)(ws + WS_QM), (bf16*)(ws + WS_KN), (bf16*)(ws + WS_VM), (const bf16*)(ws + WS_CQ), (const bf16*)(ws + WS_MISC), (const float*)(ws + WS_CS32)};
                pg8::gemm_phase<EpiMla, SchedMla, false>(F.lds, 256, 256, Sm, E);
            }
            PHASE_BEGIN();
            if (PHON(15)) {
                unsigned* qw = (unsigned*)(ws + WS_CTL) + CW_QUEUE + (l * 2 + rep_) * 64;
                volatile LAS int* qslot = (volatile LAS int*)(F.lds + AUX_OFF + 512);
                int nxt_t = 0;
                if (F.tid == 0) nxt_t = (int)__hip_atomic_fetch_add(qw, 1u, RLX_AGENT);
                for (;;) {
                    if (F.tid == 0) { qslot[0] = nxt_t; nxt_t = (int)__hip_atomic_fetch_add(qw, 1u, RLX_AGENT); }
                    __syncthreads();
                    const int uq = qslot[0];
                    __syncthreads();
                    if (uq >= 2560) break;
                    if (uq < 1024) {
                        const int u = uq;
                        PolB pb; pb.Q = (const bf16*)(ws + WS_QB); pb.K = (const bf16*)(ws + WS_KWIN); pb.V = (const bf16*)(ws + WS_VWIN); pb.O = (bf16*)(ws + WS_OWIN);
                        pb.b = u >> 7; pb.g = (u >> 6) & 1; pb.qc = 63 - (u & 63); pb.maxd = 511u; pb.j0 = pb.qc > 8 ? pb.qc - 8 : 0; pb.j1 = pb.qc + 1;
                        attn_unit<64, PolB, false>(pb, F.lds, F.tid, F.lane, F.wave, 0ull);
                    } else {
                        const int uu = uq - 1024;
                        const int bh = uu / 48, w48 = uu % 48, p = w48 >> 4, s16 = w48 & 15;
                        PolA pa; pa.Q = (const bf16*)(ws + WS_QA); pa.K = (const bf16*)(ws + WS_KA); pa.V = (const bf16*)(ws + WS_VA);
                        pa.O = (bf16*)(ws + WS_OA3) + (size_t)p * T * 256; pa.LSEP = (float*)(ws + WS_LSEA) + (size_t)p * T * 4;
                        pa.b = bh >> 2; pa.h = bh & 3; pa.d = p == 0 ? 1 : (p == 1 ? 4 : 16);
                        const int cpr = p == 0 ? 16 : (p == 1 ? 4 : 1);
                        pa.r = s16 / cpr; pa.c = s16 % cpr; pa.maxd = 128u; pa.j0 = pa.c == 0 ? 2 : 0; pa.j1 = 6;
                        attn_unit<64, PolA, false>(pa, F.lds, F.tid, F.lane, F.wave, 0ull);
                    }
                }
            }
        }
        SEAM(P + 2);
        if (PHON(5) && IN(P + 4)) _Pragma("unroll 1") for (int rep_ = 0; rep_ < NREP(5); ++rep_) { PHASE_BEGIN();
            int cti = 0;
            if (PHON(19)) for (int u = F.vcu; u < 1024; u += F.G) {
                const int bg = (u % 256) >> 4, k = u & 15, rnd = u >> 8;
                const int qc = rnd == 0 ? 2 * k : (rnd == 1 ? 2 * k + 1 : (rnd == 2 ? 63 - 2 * k : 62 - 2 * k));
                const u64 sel = cmp_unit(F, bg >> 1, bg & 1, qc);
                PolB pb; pb.Q = (const bf16*)(ws + WS_QB); pb.K = (const bf16*)(ws + WS_KSLC); pb.V = (const bf16*)(ws + WS_VSLC); pb.O = (bf16*)(ws + WS_OSLC);
                pb.b = bg >> 1; pb.g = bg & 1; pb.qc = qc; pb.maxd = 0x7fffffffu; pb.j0 = 0; pb.j1 = qc + 1;
                attn_unit<64, PolB, true>(pb, F.lds, F.tid, F.lane, F.wave, sel);
                if (CONV_IN_LAYER && rep_ == 0) { PHASE_BEGIN(); conv_layer_tiles(F, l, cti, 2); cti += 2; }
            }
            PHASE_BEGIN();
            if (PHON(20)) for (int v = F.vcu; v < 512; v += F.G) {
                const int bh = (v & 255) >> 3, k = v & 7, c = (v < 256) ? k : 15 - k;
                PolM pm; pm.Q = (const bf16*)(ws + WS_QM); pm.KN = (const bf16*)(ws + WS_KN); pm.KR = (const bf16*)(ws + WS_KR); pm.V = (const bf16*)(ws + WS_VM); pm.O = (bf16*)(ws + WS_OC);
                pm.b = bh >> 2; pm.h = bh & 3; pm.c = c; pm.maxd = 0x7fffffffu; pm.j0 = 0; pm.j1 = 4 * c + 4;
                attn_unit<96, PolM, false>(pm, F.lds, F.tid, F.lane, F.wave, 0ull);
                if (CONV_IN_LAYER && rep_ == 0) { PHASE_BEGIN(); conv_layer_tiles(F, l, cti, 2); cti += 2; }
            }
            if (CONV_IN_LAYER && rep_ == 0) { PHASE_BEGIN(); conv_layer_tiles(F, l, cti, 1 << 20); }
        }
        SEAM(P + 4);
        if (PHON(7) && IN(P + 6)) _Pragma("unroll 1") for (int rep_ = 0; rep_ < NREP(7); ++rep_) { PHASE_BEGIN(); phase_mix(F, l); }
        SEAM(P + 6);
        if (PHON(8) && IN(P + 7)) _Pragma("unroll 1") for (int rep_ = 0; rep_ < (DUM(8) ? 2 : 1); ++rep_) { PHASE_BEGIN(); F.dofs = (DUM(8) && rep_ == 0) ? WS_END : 0;
            SchedGrid Sg{(const char*)(ws + WS_AMIX), (const char*)(ws + WS_WOUT) + (size_t)l * 1024 * 1024 * 2, 1024, 1024, 4, (T / 256) * 4, F.G, F.vcu};
            EpiWout E{(bf16*)(ws + WS_X), (const float*)(ws + WS_MODS) + ((size_t)(l * 8) * 6 + 2) * 1024, F.dofs};
            pg8::gemm_phase<EpiWout, SchedGrid, false>(F.lds, 1024, 1024, Sg, E);
        }
        SEAM(P + 7);
        if (PHON(9) && IN(P + 8)) _Pragma("unroll 1") for (int rep_ = 0; rep_ < (DUM(9) ? 2 : 1); ++rep_) { PHASE_BEGIN(); F.dofs = (DUM(9) && rep_ == 0) ? WS_END : 0; F.dcnt = (DUM(9) && rep_ == 0) ? 4 : 0; phase_router(F, l); }
        SEAM(P + 8);
        if (PHON(10) && IN(P + 9)) _Pragma("unroll 1") for (int rep_ = 0; rep_ < NREP(10); ++rep_) { PHASE_BEGIN();
            moe_tables(F, l);
            const LAS int* tb = (const LAS int*)(F.lds + AUX_OFF);
            SchedMoe1F8 Sm{tb, tb + 64, (const char*)(ws + WS_H), (const char*)(ws + WS_W1E) + (size_t)l * 32 * 2048 * 1024, (const int*)(ws + WS_IDX), tb[32] * 8, F.G, F.vcu};
            EpiMoe1 E{(bf16*)(ws + WS_ACT), ginp(F, I_BE1) + (size_t)l * 32 * 2048};
            pg8::gemm_phase<EpiMoe1, SchedMoe1F8, true, true>(F.lds, 512, 512, Sm, E);
        }
        SEAM(P + 9);
        if (PHON(11) && IN(P + 10)) _Pragma("unroll 1") for (int rep_ = 0; rep_ < NREP(11); ++rep_) { PHASE_BEGIN();
            moe_tables(F, l);
            const LAS int* tb = (const LAS int*)(F.lds + AUX_OFF);
            SchedMoe2F8 Sm{tb, (const char*)(ws + WS_ACT), (const char*)(ws + WS_W2E) + (size_t)l * 32 * 1024 * 1024, tb[32] * 4, F.G, F.vcu};
            EpiMoe2 E{(unsigned char*)(ws + WS_Y2), ginp(F, I_BE2) + (size_t)l * 32 * 1024, (const float*)(ws + WS_GATEW)};
            pg8::gemm_phase<EpiMoe2, SchedMoe2F8, false, true>(F.lds, 512, 512, Sm, E);
        }
        SEAM(P + 10);
    }
    if (PHON(12) && IN(N_PHASES - 1)) { PHASE_BEGIN(); phase_norm1<1>(F, DEPTH); }
#undef IN
#undef SEAM
}

extern "C" void kernel_launch(void* const* d_in, const int* in_sizes, int n_in, void* d_out, int out_size, void* d_ws, size_t ws_size, hipStream_t stream) {
    static int grid = 0;
    if (grid == 0) {
        if (n_in != 33 || out_size != T * D || ws_size < WS_END * (DUM_MASK ? 2 : 1)) { fprintf(stderr, "kernel_launch: unexpected problem (n_in %d out %d ws %zu)\n", n_in, out_size, ws_size); grid = -1; return; }
        int dev = 0, cus = 0, per_cu = 0;
        if (hipGetDevice(&dev) != hipSuccess || hipDeviceGetAttribute(&cus, hipDeviceAttributeMultiprocessorCount, dev) != hipSuccess) { grid = -1; return; }
        if (hipFuncSetAttribute((const void*)fwd_kernel, hipFuncAttributeMaxDynamicSharedMemorySize, LDS_BYTES) != hipSuccess) { fprintf(stderr, "kernel_launch: hipFuncSetAttribute failed\n"); grid = -1; return; }
        if (hipOccupancyMaxActiveBlocksPerMultiprocessor(&per_cu, (const void*)fwd_kernel, 512, LDS_BYTES) != hipSuccess || per_cu < 1) { fprintf(stderr, "kernel_launch: occupancy query says %d\n", per_cu); per_cu = 1; }
        (void)hipGetLastError();
        grid = cus;
    }
    if (grid < 0) return;
    if (hipMemsetAsync((char*)d_ws + WS_CTL, 0, CTL_ZERO_BYTES, stream) != hipSuccess) return;
    Args a{};
    for (int i = 0; i < 33; ++i) a.in[i] = (const float*)d_in[i];
    a.out = (float*)d_out; a.ws = (unsigned char*)d_ws;
#if MK_PER_PHASE
    for (int p = 0; p < N_PHASES; ++p) { a.ph_lo = p; a.ph_hi = p + 1; hipLaunchKernelGGL(fwd_kernel, dim3(grid), dim3(512), LDS_BYTES, stream, a); }
#else
    a.ph_lo = 0; a.ph_hi = N_PHASES;
    hipLaunchKernelGGL(fwd_kernel, dim3(grid), dim3(512), LDS_BYTES, stream, a);
#endif
}
```

```cpp
#include <hip/hip_runtime.h>
#include <cstdio>
#include <cstdint>

#ifndef MK_PER_PHASE
#define MK_PER_PHASE 0
#endif

#ifndef PH_MASK
#define PH_MASK 0xFFFFFFFFu
#endif
#define PHON(k) ((PH_MASK >> (k)) & 1u)
#ifndef DBL_MASK
#define DBL_MASK 0u
#endif
#define NREP(k) (((DBL_MASK >> (k)) & 1u) ? 2 : 1)
#ifndef DUM_MASK
#define DUM_MASK 0u
#endif
#define DUM(k) ((DUM_MASK >> (k)) & 1u)
#ifndef ATT_VAR
#define ATT_VAR 0
#endif
#ifndef CONV_IN_LAYER
#define CONV_IN_LAYER 1
#endif
#ifndef CONV_TAIL1
#define CONV_TAIL1 3
#endif
#ifndef CONV_TAIL2
#define CONV_TAIL2 4
#endif
#ifndef ATT_STAGGER
#define ATT_STAGGER 0
#endif
#define DI __device__ __forceinline__
#define LAS __attribute__((address_space(3)))
#define GAS __attribute__((address_space(1)))
typedef unsigned short bf16;
typedef short bf16x8 __attribute__((ext_vector_type(8)));
typedef short s16x4 __attribute__((ext_vector_type(4)));
typedef float f32x2 __attribute__((ext_vector_type(2)));
typedef float f32x4 __attribute__((ext_vector_type(4)));
typedef float f32x16 __attribute__((ext_vector_type(16)));
typedef unsigned u32x2 __attribute__((ext_vector_type(2)));
typedef unsigned u32x4 __attribute__((ext_vector_type(4)));
typedef __bf16 bf16x2_t __attribute__((ext_vector_type(2)));
typedef unsigned long long u64;

constexpr int NB = 8, S = 4096, T = NB * S, D = 1024, DEPTH = 4;
constexpr int NIN = 2560;
constexpr int NE = 32, DFF = 1024;
constexpr int SP = S + 64;
constexpr int ECAP = 32768;
constexpr int ACT_ROWS = 4 * T + NE * 256;
constexpr float LOG2E = 1.4426950408889634f;
constexpr float SCL64 = 0.125f * LOG2E;
constexpr float SCL96 = 0.10206207261596577f * LOG2E;
constexpr float EPS = 1e-6f;

constexpr size_t MiB = 1u << 20;
constexpr size_t WS_CTL = 0, CTL_ZERO_BYTES = 2 * MiB;
constexpr size_t WS_MODS = 2 * MiB, WS_B1P = 3 * MiB, WS_CS64 = 4 * MiB, WS_CS32 = 12 * MiB;
constexpr size_t WS_WIN = 16 * MiB, WS_WOUT = 36 * MiB, WS_NSAW1 = 44 * MiB, WS_MLAQ = 52 * MiB, WS_MLAKV = 53 * MiB;
constexpr size_t WS_W1E = 64 * MiB, WS_W2E = 576 * MiB;
constexpr size_t WS_X = 832 * MiB, WS_H = 960 * MiB;
constexpr size_t WS_QA = 1024 * MiB, WS_KA = 1040 * MiB, WS_VA = 1056 * MiB, WS_QB = 1072 * MiB;
constexpr size_t WS_KCMP = 1104 * MiB, WS_VCMP = 1113 * MiB;
constexpr size_t WS_KSLC = 1122 * MiB, WS_VSLC = 1130 * MiB, WS_KWIN = 1138 * MiB, WS_VWIN = 1146 * MiB;
constexpr size_t WS_CQ = 1154 * MiB, WS_MISC = 1170 * MiB;
constexpr size_t WS_RSTDQ = 1186 * MiB, WS_RSTDKV = 1186 * MiB + 512 * 1024, WS_KR = 1187 * MiB, WS_GATES = 1189 * MiB;
constexpr size_t WS_W2T = 1195 * MiB;
constexpr size_t WS_HID = 1192 * MiB, WS_KC = 1196 * MiB, WS_VC = 1196 * MiB + 512 * 1024;
constexpr size_t WS_QM = 1197 * MiB, WS_KN = 1221 * MiB, WS_VM = 1237 * MiB;
constexpr size_t WS_OA3 = 1253 * MiB, WS_LSEA = 1301 * MiB;
constexpr size_t WS_OCMP = 1303 * MiB, WS_OSLC = 1335 * MiB, WS_OWIN = 1367 * MiB, WS_OC = 1399 * MiB;
constexpr size_t WS_SEL = 1415 * MiB, WS_AMIX = 1416 * MiB;
constexpr size_t WS_IDX = 1480 * MiB, WS_GATEW = 1484 * MiB, WS_TOKSLOT = 1488 * MiB;
constexpr size_t WS_ACT = 1489 * MiB, WS_Y2 = 1761 * MiB, WS_END = 2033 * MiB;
static_assert((size_t)ACT_ROWS * 1024 * 2 <= 272 * MiB, "act rows");
static_assert((size_t)16 * SP * 64 * 2 + 65536 <= 9 * MiB, "kcmp");

constexpr int CW_TMO = 0, CW_FAIL = 2;
constexpr int CW_BAR = 4096;
constexpr int CW_QUEUE = 12288;
constexpr int CW_CONVQ = 13312;
constexpr int CW_CNT = 16384;

constexpr int RING_BYTES = 131072;
constexpr int AUX_OFF = RING_BYTES;
constexpr int MISC_OFF = AUX_OFF + 8192;
constexpr int LDS_BYTES = 147456;

DI unsigned pk2(float lo, float hi) { f32x2 v = {lo, hi}; bf16x2_t b = __builtin_convertvector(v, bf16x2_t); return __builtin_bit_cast(unsigned, b); }
DI float bf2f(unsigned short h) { return __uint_as_float(((unsigned)h) << 16); }
DI float bflo(unsigned w) { return __uint_as_float(w << 16); }
DI float bfhi(unsigned w) { return __uint_as_float(w & 0xffff0000u); }
typedef float f32x2c __attribute__((ext_vector_type(2)));
constexpr float Y2_SCALE = 16.0f, Y2_ISCALE = 1.0f / 16.0f;
DI unsigned pk4_fp8(float a, float b, float c, float d) {
    a = fminf(fmaxf(a * Y2_SCALE, -440.f), 440.f); b = fminf(fmaxf(b * Y2_SCALE, -440.f), 440.f); c = fminf(fmaxf(c * Y2_SCALE, -440.f), 440.f); d = fminf(fmaxf(d * Y2_SCALE, -440.f), 440.f);
    int w = __builtin_amdgcn_cvt_pk_fp8_f32(a, b, 0, false); w = __builtin_amdgcn_cvt_pk_fp8_f32(c, d, w, true); return (unsigned)w; }
DI f32x4 unpk4_fp8(unsigned w) { const f32x2c lo = __builtin_amdgcn_cvt_pk_f32_fp8((int)w, false), hi = __builtin_amdgcn_cvt_pk_f32_fp8((int)w, true); return (f32x4){lo.x, lo.y, hi.x, hi.y}; }
constexpr float W8_SCALE = 64.0f, A8_SCALE = 4.0f;
constexpr int W8_E8M0 = 127 - 6, A8_E8M0 = 127 - 2;
constexpr float H8_SCALE = 8.0f; constexpr int H8_E8M0 = 127 - 3;
DI int lane_id() { return (int)__builtin_amdgcn_mbcnt_hi(~0u, __builtin_amdgcn_mbcnt_lo(~0u, 0u)); }
DI unsigned pk4_fp8s(float a, float b, float c, float d, float sc) {
    a = fminf(fmaxf(a * sc, -440.f), 440.f); b = fminf(fmaxf(b * sc, -440.f), 440.f); c = fminf(fmaxf(c * sc, -440.f), 440.f); d = fminf(fmaxf(d * sc, -440.f), 440.f);
    int w = __builtin_amdgcn_cvt_pk_fp8_f32(a, b, 0, false); w = __builtin_amdgcn_cvt_pk_fp8_f32(c, d, w, true); return (unsigned)w; }
DI float q8s(float x, float sc) {
    const float a = fminf(fmaxf(x * sc, -440.f), 440.f); const int w = __builtin_amdgcn_cvt_pk_fp8_f32(a, a, 0, false);
    const f32x2c r = __builtin_amdgcn_cvt_pk_f32_fp8(w, false); return r.x; }
DI float wave_sum(float v) {
#pragma unroll
    for (int o = 1; o < 64; o <<= 1) v += __shfl_xor(v, o);
    return v;
}
DI float fast_exp2(float x) { return __builtin_amdgcn_exp2f(x); }
DI float fast_rcp(float x) { return __builtin_amdgcn_rcpf(x); }
DI float sigmoidf_(float x) { return fast_rcp(1.0f + fast_exp2(-x * LOG2E)); }
#define RLX_AGENT __ATOMIC_RELAXED, __HIP_MEMORY_SCOPE_AGENT

#define XB_TMO      128
#define XB_XCNT(j)  (256  + 64 * (j))
#define XB_XSUB(j)  (1280 + 64 * (j))
#define XB_XGEN(j)  (2304 + 64 * (j))
#define XB_TOP      3328
#define XB_TOPGEN   3392
#define XCD_BAR_WORDS 3456
#define XB_SPIN_CAP (1u << 22)
DI unsigned xb_ld(unsigned* p)              { return __hip_atomic_load(p, __ATOMIC_RELAXED, __HIP_MEMORY_SCOPE_AGENT); }
DI unsigned xb_add(unsigned* p, unsigned v) { return __hip_atomic_fetch_add(p, v, __ATOMIC_RELAXED, __HIP_MEMORY_SCOPE_AGENT); }
DI unsigned xb_xcc_id() { return (unsigned)__builtin_amdgcn_s_getreg((3 << 11) | 20) & 0xFu; }
#define XB_SPIN(cond, bar) do { unsigned _sp = 0; while (cond) { __builtin_amdgcn_s_sleep(1); \
    if ((++_sp & 255u) == 0u) { if (xb_ld(&(bar)[XB_TMO])) break; if (_sp > XB_SPIN_CAP) { atomicAdd(&(bar)[XB_TMO], 1u); break; } } } } while (0)
struct XcdBarrier { unsigned* bar; unsigned x; volatile LAS unsigned* st; };
DI XcdBarrier xcd_barrier_post(unsigned* bar, volatile LAS unsigned* st) {
    XcdBarrier b; b.bar = bar; b.x = xb_xcc_id(); b.st = st;
    if (threadIdx.x == 0) (void)xb_add(&bar[XB_XCNT(b.x)], 1u);
    return b;
}
DI void xcd_barrier_complete(unsigned* bar, unsigned x, unsigned& nloc, unsigned& nx) {
    const unsigned G = gridDim.x * gridDim.y * gridDim.z;
    unsigned sum, cnt, mine, sp = 0u;
    for (;;) {
        sum = 0u; cnt = 0u; mine = 0u;
#pragma unroll
        for (unsigned j = 0; j < 16; ++j) { const unsigned c = xb_ld(&bar[XB_XCNT(j)]); sum += c; cnt += (c > 0u) ? 1u : 0u; mine = (j == x) ? c : mine; }
        if (sum == G) break;
        __builtin_amdgcn_s_sleep(1);
        if ((++sp & 255u) == 0u) { if (xb_ld(&bar[XB_TMO])) break; if (sp > XB_SPIN_CAP) { atomicAdd(&bar[XB_TMO], 1u); break; } }
    }
    nloc = mine > 0u ? mine : 1u; nx = cnt > 0u ? cnt : 1u;
}
DI void xcd_barrier(const XcdBarrier& b) {
    asm volatile("s_waitcnt vmcnt(0)" ::: "memory");
    __syncthreads();
    unsigned* bar = b.bar; asm volatile("" : "+s"(bar));
    if (threadIdx.x == 0) {
        __builtin_amdgcn_s_waitcnt(0);
        unsigned nloc = b.st[0], nx = b.st[1];
        if (nloc == 0u) { xcd_barrier_complete(bar, b.x, nloc, nx); b.st[0] = nloc; b.st[1] = nx; }
        const unsigned old = xb_add(&bar[XB_XSUB(b.x)], 1u);
        const unsigned gen = old / nloc;
        if (old + 1u == (gen + 1u) * nloc) {
            __builtin_amdgcn_fence(__ATOMIC_RELEASE, "agent");
            asm volatile("s_waitcnt vmcnt(0)" ::: "memory");
            const unsigned og = xb_add(&bar[XB_TOP], 1u);
            const unsigned tg = og / nx;
            if (og + 1u == (tg + 1u) * nx) xb_add(&bar[XB_TOPGEN], 1u);
            else XB_SPIN(xb_ld(&bar[XB_TOPGEN]) == tg, bar);
            __builtin_amdgcn_fence(__ATOMIC_ACQUIRE, "agent");
            xb_add(&bar[XB_XGEN(b.x)], 1u);
            asm volatile("s_waitcnt vmcnt(0)" ::: "memory");
        } else {
            XB_SPIN(xb_ld(&bar[XB_XGEN(b.x)]) == gen, bar);
            __builtin_amdgcn_fence(__ATOMIC_ACQUIRE, "agent");
            asm volatile("s_waitcnt vmcnt(0)" ::: "memory");
        }
    }
    __syncthreads();
}

struct Args {
    const float* in[33];
    float* out;
    unsigned char* ws;
    int ph_lo, ph_hi;
};
enum { I_X = 0, I_C, I_POS, I_WADA, I_BADA, I_G1, I_G2, I_WIN, I_POSK, I_POSV, I_W1K, I_B1K, I_W2K, I_B2K, I_W1V, I_B1V, I_W2V, I_B2V,
       I_GQ, I_GKV, I_WQUP, I_WKVUP, I_GOA, I_GOB, I_GOC, I_WOUT, I_WR, I_BR, I_WE1, I_BE1, I_WE2, I_BE2, I_GF };

struct Ctx {
    LAS unsigned char* lds;
    const Args* a;
    unsigned char* ws;
    int tid, lane, wave, blk, G, vcu;
    size_t dofs; int dcnt;
};
DI const float* ginp(const Ctx& F, int i) { return (const float*)(GAS const float*)(F.a->in[i]); }
DI float* gout(const Ctx& F) { return (float*)(GAS float*)(F.a->out); }

namespace pg8 {
constexpr int BM = 256, BK = 64, HALF = 128, HTB = HALF * BK * 2;
DI int lds_byte(int r, int c) { const int st = (r >> 4) * 2 + (c >> 5), rr = r & 15, cc = c & 31, ob = rr * 64 + cc * 2; return st * 1024 + (ob ^ (((ob >> 9) & 1) << 5)); }
DI void stage_rc(int b, int& R, int& C) { const int st = b / 1024, sb = b % 1024, swz = sb ^ (((sb >> 9) & 1) << 5); R = (st >> 1) * 16 + swz / 64; C = (st & 1) * 32 + (swz % 64) / 2; }
DI int perm32(int rho) { const int n = rho >> 4, i = rho & 15; return 8 * (i >> 2) + 4 * n + (i & 3); }
struct Unit { const char* a; const char* b; int pm, pn, e, ml; };

template <class Epi, class Sched, bool GATHER, bool FP8 = false>
DI void gemm_phase(LAS unsigned char* lds, const int lda, const int K, const Sched& S, const Epi& E) {
    typedef int i32x4_ __attribute__((ext_vector_type(4))); typedef int i32x8_ __attribute__((ext_vector_type(8)));
    int tid_ = threadIdx.x; asm volatile("" : "+v"(tid_));
    const int tid = tid_, wid = __builtin_amdgcn_readfirstlane(tid >> 6), lane = tid & 63, wr = wid >> 2, wc = wid & 3, fr = lane & 15, fq = lane >> 4;
    const int nt = K / BK;
    int Rr[2], Cc[2]; unsigned voffB[2];
#pragma unroll
    for (int i = 0; i < 2; ++i) { int R, C; stage_rc(tid * 16 + i * 8192, R, C); Rr[i] = R; Cc[i] = C; const int Rb = Epi::PERM ? ((R & ~31) + perm32(R & 31)) : R; voffB[i] = (unsigned)(Rb * K + C) * 2u; }
    const size_t kstep = (size_t)(BK * 2);
    const size_t hstepB = (size_t)HALF * K * 2;
    const unsigned ldsw = (unsigned)wid * 1024u;
    const int aoff = lds_byte(wr * 64 + fr, fq * 8), boff = lds_byte(wc * 32 + fr, fq * 8);
#define PG8_SA(b, h) (((b) * 2 + (h)) * HTB)
#define PG8_SB(b, h) ((4 + (b) * 2 + (h)) * HTB)
#define PG8_STAGE_B(bufoff, gbase) do { _Pragma("unroll") for (int _i = 0; _i < 2; ++_i) \
        __builtin_amdgcn_global_load_lds((const unsigned*)((const char*)(gbase) + (size_t)_i * 64 * K * 2 + voffB[0]), (LAS unsigned*)(lds + (bufoff) + ldsw + _i * 8192), 16, 0, 0); } while (0)
#define PG8_STAGE_A(bufoff, gbase, v, h) do { _Pragma("unroll") for (int _i = 0; _i < 2; ++_i) { \
        if constexpr (GATHER) __builtin_amdgcn_global_load_lds((const unsigned*)((const char*)(gbase) + (v)[h][_i]), (LAS unsigned*)(lds + (bufoff) + ldsw + _i * 8192), 16, 0, 0); \
        else __builtin_amdgcn_global_load_lds((const unsigned*)((const char*)(gbase) + (size_t)((h) * 128 + _i * 64) * lda * 2 + (v)[0][0]), (LAS unsigned*)(lds + (bufoff) + ldsw + _i * 8192), 16, 0, 0); } } while (0)
#define PG8_SETOFF(v, u) do { _Pragma("unroll") for (int _h = 0; _h < 2; ++_h) _Pragma("unroll") for (int _i = 0; _i < 2; ++_i) { \
        if constexpr (GATHER) (v)[_h][_i] = S.gather_off((u), _h * 128 + Rr[_i]) + (unsigned)Cc[_i] * 2u; \
        else (v)[_h][_i] = (unsigned)((_h * 128 + Rr[_i]) * lda + Cc[_i]) * 2u; } } while (0)
#define PG8_LDA(dst, b, h) do { _Pragma("unroll") for (int m = 0; m < 4; ++m) { const i32x4_ lo_ = *(const LAS i32x4_*)(lds + PG8_SA(b, h) + aoff + m * 2048), hi_ = *(const LAS i32x4_*)(lds + PG8_SA(b, h) + aoff + m * 2048 + 1024); dst[m] = __builtin_shufflevector(lo_, hi_, 0, 1, 2, 3, 4, 5, 6, 7); } } while (0)
#define PG8_LDB(dst, b, h) do { _Pragma("unroll") for (int n = 0; n < 2; ++n) { const i32x4_ lo_ = *(const LAS i32x4_*)(lds + PG8_SB(b, h) + boff + n * 2048), hi_ = *(const LAS i32x4_*)(lds + PG8_SB(b, h) + boff + n * 2048 + 1024); dst[n] = __builtin_shufflevector(lo_, hi_, 0, 1, 2, 3, 4, 5, 6, 7); } } while (0)
#define PG8_H0(x) __builtin_bit_cast(bf16x8, __builtin_shufflevector((x), (x), 0, 1, 2, 3))
#define PG8_H1(x) __builtin_bit_cast(bf16x8, __builtin_shufflevector((x), (x), 4, 5, 6, 7))
#define PG8_MMA(ai, bj, At, Bt) do { __builtin_amdgcn_s_setprio(1); \
        if constexpr (FP8) { _Pragma("unroll") for (int m = 0; m < 4; ++m) _Pragma("unroll") for (int n = 0; n < 2; ++n) \
            asm volatile("v_mfma_scale_f32_16x16x128_f8f6f4 %0, %1, %2, %0, %3, %4 op_sel_hi:[0,0,0]" : "+v"(acc[ai][bj][m][n]) : "v"(Bt[n]), "v"(At[m]), "v"(scw_), "v"(sca_)); } \
        else { _Pragma("unroll") for (int m = 0; m < 4; ++m) _Pragma("unroll") for (int n = 0; n < 2; ++n) { \
            acc[ai][bj][m][n] = __builtin_amdgcn_mfma_f32_16x16x32_bf16(PG8_H0(Bt[n]), PG8_H0(At[m]), acc[ai][bj][m][n], 0, 0, 0); \
            acc[ai][bj][m][n] = __builtin_amdgcn_mfma_f32_16x16x32_bf16(PG8_H1(Bt[n]), PG8_H1(At[m]), acc[ai][bj][m][n], 0, 0, 0); } } \
        __builtin_amdgcn_s_setprio(0); } while (0)
#define PG8_WAIT_V(n) asm volatile("s_waitcnt vmcnt(" #n ")" ::: "memory")
#define PG8_WAIT_L(n) asm volatile("s_waitcnt lgkmcnt(" #n ")" ::: "memory")
#define PG8_BAR __builtin_amdgcn_s_barrier()
#define PG8_SCHED __builtin_amdgcn_sched_barrier(0)
    Unit cur, nxt; int ui = 0;
    if (!S.next(0, cur)) return;
    f32x4 acc[2][2][4][2];
#pragma unroll
    for (int a = 0; a < 2; ++a)
#pragma unroll
        for (int b = 0; b < 2; ++b)
#pragma unroll
            for (int m = 0; m < 4; ++m)
#pragma unroll
                for (int n = 0; n < 2; ++n) acc[a][b][m][n] = (f32x4){0.f, 0.f, 0.f, 0.f};
    int scw_ = W8_E8M0, sca_ = A8_E8M0; if constexpr (FP8) sca_ = Epi::A_E8M0;
    i32x8_ At[4], B0[2], B1[2];
    unsigned vA[2][2], vAn[2][2];
    PG8_SETOFF(vA, cur);
    const char* cA = cur.a; const char* cB = cur.b;
    PG8_STAGE_B(PG8_SB(0, 0), cB); PG8_STAGE_B(PG8_SB(0, 1), cB + hstepB); PG8_STAGE_A(PG8_SA(0, 0), cA, vA, 0); PG8_STAGE_A(PG8_SA(0, 1), cA, vA, 1);
    if (wr == 1) PG8_BAR;
    PG8_WAIT_V(2); PG8_BAR;
    PG8_STAGE_B(PG8_SB(1, 0), cB + kstep); PG8_STAGE_A(PG8_SA(1, 0), cA + kstep, vA, 0); PG8_STAGE_B(PG8_SB(1, 1), cB + hstepB + kstep);
    PG8_WAIT_V(6); PG8_BAR;
    for (;;) {
        const bool has_next = S.next(ui + 1, nxt);
        if constexpr (GATHER) {
            if (has_next) {
#pragma unroll
                for (int h = 0; h < 2; ++h)
#pragma unroll
                    for (int i = 0; i < 2; ++i) vAn[h][i] = S.gather_raw(nxt, h * 128 + Rr[i]);
            }
        }
        const char* nA = has_next ? nxt.a : cA; const char* nB = has_next ? nxt.b : cB;
#pragma unroll 1
        for (int t = 0; t < nt; t += 2) {
            const bool last = (t == nt - 2);
            const char* a1 = cA + (size_t)(t + 1) * kstep;
            const char* a2 = last ? nA : cA + (size_t)(t + 2) * kstep; const char* b2 = last ? nB : cB + (size_t)(t + 2) * kstep;
            const char* a3 = a2 + kstep; const char* b3 = b2 + kstep;
            unsigned v2[2][2];
#pragma unroll
            for (int h = 0; h < 2; ++h)
#pragma unroll
                for (int i = 0; i < 2; ++i) v2[h][i] = vA[h][i];
            if constexpr (GATHER) {
                if (last && has_next) {
#pragma unroll
                    for (int h = 0; h < 2; ++h)
#pragma unroll
                        for (int i = 0; i < 2; ++i) { vAn[h][i] = vAn[h][i] * (unsigned)(lda * 2) + (unsigned)Cc[i] * 2u; v2[h][i] = vAn[h][i]; }
                }
            }
            PG8_LDB(B0, 0, 0); PG8_LDB(B1, 0, 1); PG8_SCHED; PG8_LDA(At, 0, 0); PG8_STAGE_A(PG8_SA(1, 1), a1, vA, 1);
            PG8_WAIT_V(8); PG8_WAIT_L(0); PG8_BAR; PG8_MMA(0, 0, At, B0); PG8_MMA(0, 1, At, B1); PG8_BAR; PG8_SCHED;
            PG8_LDA(At, 0, 1); PG8_STAGE_B(PG8_SB(0, 0), b2); PG8_STAGE_B(PG8_SB(0, 1), b2 + hstepB); PG8_STAGE_A(PG8_SA(0, 0), a2, v2, 0);
            PG8_WAIT_V(8); PG8_WAIT_L(0); PG8_BAR; PG8_MMA(1, 0, At, B0); PG8_MMA(1, 1, At, B1); PG8_BAR; PG8_SCHED;
            PG8_LDB(B0, 1, 0); PG8_LDB(B1, 1, 1); PG8_SCHED; PG8_LDA(At, 1, 0); PG8_STAGE_A(PG8_SA(0, 1), a2, v2, 1);
            PG8_WAIT_V(8); PG8_WAIT_L(0); PG8_BAR; PG8_MMA(0, 0, At, B0); PG8_MMA(0, 1, At, B1); PG8_BAR; PG8_SCHED;
            PG8_LDA(At, 1, 1); PG8_STAGE_B(PG8_SB(1, 0), b3); PG8_STAGE_B(PG8_SB(1, 1), b3 + hstepB); PG8_STAGE_A(PG8_SA(1, 0), a3, v2, 0);
            PG8_WAIT_V(8); PG8_WAIT_L(0); PG8_BAR; PG8_MMA(1, 0, At, B0); PG8_MMA(1, 1, At, B1); PG8_BAR; PG8_SCHED;
        }
        if (wr == 0) PG8_BAR;
        if constexpr (FP8) asm volatile("s_nop 15\n\ts_nop 15" ::: "memory");
        if constexpr (!Epi::AFTER_DRAIN) { int fr_ = fr, fq_ = fq; asm volatile("" : "+v"(fr_), "+v"(fq_)); E(acc, cur, wr, wc, fr_, fq_); }
        if (!has_next) break;
#pragma unroll
        for (int a = 0; a < 2; ++a)
#pragma unroll
            for (int b = 0; b < 2; ++b)
#pragma unroll
                for (int m = 0; m < 4; ++m)
#pragma unroll
                    for (int n = 0; n < 2; ++n) acc[a][b][m][n] = (f32x4){0.f, 0.f, 0.f, 0.f};
        cur = nxt; cA = nA; cB = nB; ++ui;
        if constexpr (GATHER) {
#pragma unroll
            for (int h = 0; h < 2; ++h)
#pragma unroll
                for (int i = 0; i < 2; ++i) vA[h][i] = vAn[h][i];
        }
        if (wr == 1) PG8_BAR;
    }
    PG8_WAIT_V(0);
    PG8_BAR;
    if constexpr (Epi::AFTER_DRAIN) { int fr_ = fr, fq_ = fq; asm volatile("" : "+v"(fr_), "+v"(fq_)); E.fused(acc, cur, wr, wc, fr_, fq_, lds, wid, lane); }
#undef PG8_SA
#undef PG8_SB
#undef PG8_STAGE_A
#undef PG8_STAGE_B
#undef PG8_SETOFF
#undef PG8_LDA
#undef PG8_LDB
#undef PG8_MMA
#undef PG8_H0
#undef PG8_H1
#undef PG8_WAIT_V
#undef PG8_WAIT_L
#undef PG8_BAR
#undef PG8_SCHED
}
}
using pg8::Unit;
typedef f32x4 AccT[2][2][4][2];

struct SchedGrid {
    const char* A; const char* B; int lda, K, nN, nwg, G, c;
    DI bool next(int i, Unit& u) const {
        const int L = i * G + c; if (L >= nwg) return false;
        u.pm = L / nN; u.pn = L % nN; u.e = 0; u.ml = 0;
        u.a = A + (size_t)u.pm * 256 * lda * 2; u.b = B + (size_t)u.pn * 256 * K * 2; return true;
    }
    DI unsigned gather_off(const Unit&, int) const { return 0u; }
    DI unsigned gather_raw(const Unit&, int) const { return 0u; }
};
struct SchedCmp {
    const char* KCMP; const char* VCMP; const char* W; int G, c;
    DI bool next(int i, Unit& u) const {
        const int L = i * G + c; if (L >= 32) return false;
        const int kv = L >> 4, bg = L & 15;
        u.pm = L; u.pn = 0; u.e = kv; u.ml = 0;
        u.a = (kv ? VCMP : KCMP) + (size_t)bg * SP * 64 * 2; u.b = W + (size_t)kv * 256 * 2048 * 2; return true;
    }
    DI unsigned gather_off(const Unit&, int) const { return 0u; }
    DI unsigned gather_raw(const Unit&, int) const { return 0u; }
};
struct SchedMla {
    const char* CQ; const char* MISC; const char* WQ; const char* WKV; int G, c;
    DI bool next(int i, Unit& u) const {
        const int L = i * G + c; if (L >= 512) return false;
        const int which = L >> 8, r = L & 255;
        u.pm = r >> 1; u.pn = r & 1; u.e = which; u.ml = 0;
        u.a = (which ? MISC : CQ) + (size_t)u.pm * 256 * 256 * 2; u.b = (which ? WKV : WQ) + (size_t)u.pn * 256 * 256 * 2; return true;
    }
    DI unsigned gather_off(const Unit&, int) const { return 0u; }
    DI unsigned gather_raw(const Unit&, int) const { return 0u; }
};
template <int NT, bool GATHERED>
struct SchedMoe {
    const LAS int* tb; const LAS int* cnt; const char* A; const char* W; const int* IDX; int total, G, c;
    DI bool next(int i, Unit& u) const {
        const int L = i * G + c; if (L >= total) return false;
        const int mtg = L / NT; u.pn = L % NT;
        const int ln_ = threadIdx.x & 63;
        const int e = __popcll(__ballot(ln_ < 32 && tb[ln_ & 31] <= mtg)) - 1;
        u.e = e; u.ml = mtg - tb[e]; u.pm = mtg;
        u.a = GATHERED ? A : A + (size_t)mtg * 256 * 1024 * 2;
        u.b = W + ((size_t)e * NT * 256 + (size_t)u.pn * 256) * 1024 * 2; return true;
    }
    DI unsigned gather_off(const Unit& u, int row) const {
        const int pos = u.ml * 256 + row; const int tok = (pos < cnt[u.e]) ? IDX[u.e * ECAP + pos] : 0;
        return (unsigned)tok * 2048u;
    }
    DI unsigned gather_raw(const Unit& u, int row) const {
        const int pos = u.ml * 256 + row;
        return (unsigned)IDX[u.e * ECAP + (pos < cnt[u.e] ? pos : 0)];
    }
};

struct SchedMoe1F8 {
    static constexpr bool HOOK = false;
    const LAS int* tb; const LAS int* cnt; const char* A; const char* W; const int* IDX; int total, G, c;
    DI bool next(int i, Unit& u) const {
        const int L = i * G + c; if (L >= total) return false;
        const int mtg = L >> 3; u.pn = L & 7;
        const int ln_ = lane_id();
        const int e = __popcll(__ballot(ln_ < 32 && tb[ln_ & 31] <= mtg)) - 1;
        u.e = e; u.ml = mtg - tb[e]; u.pm = mtg;
        u.a = A; u.b = W + ((size_t)e * 2048 + (size_t)u.pn * 256) * 1024; return true;
    }
    DI unsigned gather_raw(const Unit& u, int row) const { const int pos = u.ml * 256 + row; return (unsigned)IDX[u.e * ECAP + (pos < cnt[u.e] ? pos : 0)]; }
    DI unsigned gather_off(const Unit& u, int row) const { return gather_raw(u, row) * 1024u; }
};
struct SchedMoe2F8 {
    static constexpr bool HOOK = false;
    const LAS int* tb; const char* A; const char* W; int total, G, c;
    DI bool next(int i, Unit& u) const {
        const int L = i * G + c; if (L >= total) return false;
        const int mtg = L >> 2; u.pn = L & 3;
        const int ln_ = lane_id();
        const int e = __popcll(__ballot(ln_ < 32 && tb[ln_ & 31] <= mtg)) - 1;
        u.e = e; u.ml = mtg - tb[e]; u.pm = mtg;
        u.a = A + (size_t)mtg * 256 * 1024; u.b = W + ((size_t)e * 1024 + (size_t)u.pn * 256) * 1024; return true;
    }
    DI unsigned gather_off(const Unit&, int) const { return 0u; }
    DI unsigned gather_raw(const Unit&, int) const { return 0u; }
};

DI void rot4(f32x4& v0, f32x4& v1, const f32x4 c, const f32x4 s) {
    const float a0 = v0[0], b0 = v0[1], a1 = v0[2], b1 = v0[3], a2 = v1[0], b2 = v1[1], a3 = v1[2], b3 = v1[3];
    v0[0] = a0 * c[0] - b0 * s[0]; v0[1] = b0 * c[0] + a0 * s[0];
    v0[2] = a1 * c[1] - b1 * s[1]; v0[3] = b1 * c[1] + a1 * s[1];
    v1[0] = a2 * c[2] - b2 * s[2]; v1[1] = b2 * c[2] + a2 * s[2];
    v1[2] = a3 * c[3] - b3 * s[3]; v1[3] = b3 * c[3] + a3 * s[3];
}
DI u32x4 pack8(const f32x4 v0, const f32x4 v1) { u32x4 w; w.x = pk2(v0[0], v0[1]); w.y = pk2(v0[2], v0[3]); w.z = pk2(v1[0], v1[1]); w.w = pk2(v1[2], v1[3]); return w; }

struct EpiWin {
    static constexpr bool PERM = true, AFTER_DRAIN = false;
    unsigned char* ws; const float* CS64; const float* CS32;
    DI void operator()(const AccT& acc, const Unit& u, int wr, int wc, int fr, int fq) const {
#pragma unroll
        for (int bj = 0; bj < 2; ++bj) {
            const int w0 = bj * 128 + wc * 32;
            size_t off; int ld, dcol, mode = 0, gm = 0, g = 0; float sc = 1.f;
            switch (u.pn) {
                case 0: off = WS_QA; ld = 256; dcol = w0; mode = 1; sc = SCL64; break;
                case 1: off = WS_KA; ld = 256; dcol = w0; mode = 1; break;
                case 2: off = WS_VA; ld = 256; dcol = w0; break;
                case 3: off = WS_QB; ld = 512; dcol = w0; mode = 1; sc = SCL64; break;
                case 4: off = WS_QB; ld = 512; dcol = 256 + w0; mode = 1; sc = SCL64; break;
                case 5: off = (w0 < 128) ? WS_KCMP : WS_VCMP; ld = 64; gm = 1; g = (w0 & 127) >> 6; dcol = w0 & 63; break;
                case 6: off = (w0 < 128) ? WS_KSLC : WS_VSLC; ld = 128; dcol = w0 & 127; mode = (w0 < 128) ? 1 : 0; break;
                case 7: off = (w0 < 128) ? WS_KWIN : WS_VWIN; ld = 128; dcol = w0 & 127; mode = (w0 < 128) ? 1 : 0; break;
                case 8: off = WS_CQ; ld = 256; dcol = w0; break;
                default: if (w0 == 128) { off = WS_KR; ld = 32; dcol = 0; mode = 2; } else { off = WS_MISC; ld = 256; dcol = w0; } break;
            }
            bf16* base = (bf16*)(ws + off);
            const int i0 = 16 * (wc & 1) + 4 * fq;
#pragma unroll
            for (int ai = 0; ai < 2; ++ai) {
                f32x4 cc[4], sn[4];
                if (mode) {
#pragma unroll
                    for (int m = 0; m < 4; ++m) {
                        const int row = u.pm * 256 + ai * 128 + wr * 64 + m * 16 + fr;
                        const float* cs = (mode == 1) ? CS64 + (size_t)row * 64 + i0 : CS32 + (size_t)row * 32 + 4 * fq;
                        cc[m] = *(const f32x4*)cs; sn[m] = *(const f32x4*)(cs + (mode == 1 ? 32 : 16));
                    }
                }
#pragma unroll
                for (int m = 0; m < 4; ++m) {
                    const int row = u.pm * 256 + ai * 128 + wr * 64 + m * 16 + fr;
                    f32x4 v0 = acc[ai][bj][m][0], v1 = acc[ai][bj][m][1];
                    if (mode) rot4(v0, v1, cc[m], sn[m]);
                    v0 = v0 * sc; v1 = v1 * sc;
                    const size_t drow = gm ? (size_t)(((row >> 12) * 2 + g) * SP + (row & 4095)) : (size_t)row;
                    *(u32x4*)(base + drow * ld + dcol + 8 * fq) = pack8(v0, v1);
                }
            }
        }
    }
};
struct EpiCmp {
    static constexpr bool PERM = true, AFTER_DRAIN = true;
    const float* B1P; const bf16* W2T; const float *B2K, *B2V; bf16 *KC, *VC; const float* CS64;
    DI void fused(const AccT& acc, const Unit& u, int wr, int wc, int fr, int fq, LAS unsigned char* lds, int wid, int lane) const {
        constexpr int HST = 528;
        const int kv = u.e, bg = u.pm & 15;
#pragma unroll
        for (int bj = 0; bj < 2; ++bj) {
            const int col = bj * 128 + wc * 32 + 8 * fq;
            const f32x4 b0 = *(const f32x4*)(B1P + kv * 256 + col), b1 = *(const f32x4*)(B1P + kv * 256 + col + 4);
#pragma unroll
            for (int ai = 0; ai < 2; ++ai)
#pragma unroll
                for (int m = 0; m < 4; ++m) {
                    const int rl = ai * 128 + wr * 64 + m * 16 + fr;
                    f32x4 v0 = acc[ai][bj][m][0] + b0, v1 = acc[ai][bj][m][1] + b1;
#pragma unroll
                    for (int j = 0; j < 4; ++j) {
                        float x = v0[j]; float z = 0.7978845608028654f * (x + 0.044715f * x * x * x); v0[j] = x * sigmoidf_(2.f * z);
                        x = v1[j]; z = 0.7978845608028654f * (x + 0.044715f * x * x * x); v1[j] = x * sigmoidf_(2.f * z);
                    }
                    *(LAS u32x4*)(lds + rl * HST + col * 2) = pack8(v0, v1);
                }
        }
        asm volatile("s_waitcnt lgkmcnt(0)\n\ts_barrier" ::: "memory");
        const int r32 = lane & 31, hh = lane >> 5;
        f32x16 out0 = {0.f, 0.f, 0.f, 0.f, 0.f, 0.f, 0.f, 0.f, 0.f, 0.f, 0.f, 0.f, 0.f, 0.f, 0.f, 0.f}, out1 = out0;
        const bf16* w2 = W2T + (size_t)kv * 64 * 256;
#pragma unroll 4
        for (int ks = 0; ks < 16; ++ks) {
            const bf16x8 a = *(const LAS bf16x8*)(lds + (32 * wid + r32) * HST + (16 * ks + 8 * hh) * 2);
            const bf16x8 bq0 = *(const bf16x8*)(w2 + (size_t)r32 * 256 + 16 * ks + 8 * hh), bq1 = *(const bf16x8*)(w2 + (size_t)(32 + r32) * 256 + 16 * ks + 8 * hh);
            out0 = __builtin_amdgcn_mfma_f32_32x32x16_bf16(a, bq0, out0, 0, 0, 0); out1 = __builtin_amdgcn_mfma_f32_32x32x16_bf16(a, bq1, out1, 0, 0, 0);
        }
        const float* b2 = kv ? B2V : B2K;
        const float bb0 = b2[r32], bb1 = b2[32 + r32];
        const int b = bg >> 1;
#pragma unroll
        for (int i = 0; i < 16; ++i) {
            const int c = 32 * wid + 8 * (i >> 2) + 4 * hh + (i & 3);
            const size_t row = (size_t)bg * 256 + c;
            float x1 = out0[i] + bb0, x2 = out1[i] + bb1;
            if (c == 255) { x1 = 0.f; x2 = 0.f; }
            if (kv == 0) {
                const int tokr = (b * S + 16 * c + 31) & (T - 1);
                const float cs = CS64[(size_t)tokr * 64 + r32], sn = CS64[(size_t)tokr * 64 + 32 + r32];
                *(unsigned*)(KC + row * 64 + 2 * r32) = pk2(x1 * cs - x2 * sn, x2 * cs + x1 * sn);
            } else {
                VC[row * 64 + r32] = (bf16)(pk2(x1, 0.f) & 0xffffu); VC[row * 64 + 32 + r32] = (bf16)(pk2(x2, 0.f) & 0xffffu);
            }
        }
    }
};
struct EpiMla {
    static constexpr bool PERM = true, AFTER_DRAIN = false;
    bf16 *QM, *KN, *VM; const bf16 *CQ, *MISC; const float* CS32;
    DI void operator()(const AccT& acc, const Unit& u, int wr, int wc, int fr, int fq) const {
        float rstd[2][4];
#pragma unroll
        for (int ai = 0; ai < 2; ++ai)
#pragma unroll
            for (int m = 0; m < 4; ++m) {
                const int row = u.pm * 256 + ai * 128 + wr * 64 + m * 16 + fr;
                float ss = 0.f;
                if (u.e == 0) {
#pragma unroll
                    for (int c = 0; c < 8; ++c) { const u32x4 w = *(const u32x4*)(CQ + (size_t)row * 256 + fq * 64 + 8 * c);
                        ss += bflo(w.x) * bflo(w.x) + bfhi(w.x) * bfhi(w.x) + bflo(w.y) * bflo(w.y) + bfhi(w.y) * bfhi(w.y) + bflo(w.z) * bflo(w.z) + bfhi(w.z) * bfhi(w.z) + bflo(w.w) * bflo(w.w) + bfhi(w.w) * bfhi(w.w); }
                } else {
#pragma unroll
                    for (int c = 0; c < 4; ++c) { const u32x4 w = *(const u32x4*)(MISC + (size_t)row * 256 + fq * 32 + 8 * c);
                        ss += bflo(w.x) * bflo(w.x) + bfhi(w.x) * bfhi(w.x) + bflo(w.y) * bflo(w.y) + bfhi(w.y) * bfhi(w.y) + bflo(w.z) * bflo(w.z) + bfhi(w.z) * bfhi(w.z) + bflo(w.w) * bflo(w.w) + bfhi(w.w) * bfhi(w.w); }
                }
                ss += __shfl_xor(ss, 16); ss += __shfl_xor(ss, 32);
                rstd[ai][m] = rsqrtf(ss * (u.e == 0 ? (1.0f / 256.0f) : (1.0f / 128.0f)) + EPS);
            }
#pragma unroll
        for (int bj = 0; bj < 2; ++bj) {
            const int gc = u.pn * 256 + bj * 128 + wc * 32;
            bf16* base; int ld, dcol, rope = 0; float sc = 1.f;
            if (u.e == 0) { if (gc >= 384) continue; rope = ((gc >> 5) % 3) == 2; base = QM; ld = 384; dcol = gc; sc = SCL96; }
            else { const int head = gc >> 7, part = (gc & 127) >> 6, o = gc & 63; base = part ? VM : KN; ld = 256; dcol = head * 64 + o; }
#pragma unroll
            for (int ai = 0; ai < 2; ++ai) {
                f32x4 cc[4], sn[4];
                if (rope) {
#pragma unroll
                    for (int m = 0; m < 4; ++m) { const float* cs = CS32 + (size_t)(u.pm * 256 + ai * 128 + wr * 64 + m * 16 + fr) * 32 + 4 * fq; cc[m] = *(const f32x4*)cs; sn[m] = *(const f32x4*)(cs + 16); }
                }
#pragma unroll
                for (int m = 0; m < 4; ++m) {
                    const int row = u.pm * 256 + ai * 128 + wr * 64 + m * 16 + fr;
                    const float r = rstd[ai][m] * sc;
                    f32x4 v0 = acc[ai][bj][m][0] * r, v1 = acc[ai][bj][m][1] * r;
                    if (rope) rot4(v0, v1, cc[m], sn[m]);
                    *(u32x4*)(base + (size_t)row * ld + dcol + 8 * fq) = pack8(v0, v1);
                }
            }
        }
    }
};
struct EpiWout {
    static constexpr bool PERM = false, AFTER_DRAIN = false;
    bf16* X; const float* GT; size_t dofs;
    DI void operator()(const AccT& acc, const Unit& u, int wr, int wc, int fr, int fq) const {
        const int b = (u.pm * 256) >> 12;
        const int col0 = u.pn * 256 + wc * 32 + 4 * fq;
#pragma unroll
        for (int bj = 0; bj < 2; ++bj) {
#pragma unroll
            for (int n = 0; n < 2; ++n) {
                u32x2 xo[2][4];
                const f32x4 gt = *(const f32x4*)(GT + (size_t)b * 6144 + col0 + bj * 128 + n * 16);
#pragma unroll
                for (int ai = 0; ai < 2; ++ai)
#pragma unroll
                    for (int m = 0; m < 4; ++m) xo[ai][m] = *(const u32x2*)(X + (size_t)(u.pm * 256 + ai * 128 + wr * 64 + m * 16 + fr) * 1024 + col0 + bj * 128 + n * 16);
#pragma unroll
                for (int ai = 0; ai < 2; ++ai)
#pragma unroll
                    for (int m = 0; m < 4; ++m) {
                        bf16* p = X + (size_t)(u.pm * 256 + ai * 128 + wr * 64 + m * 16 + fr) * 1024 + col0 + bj * 128 + n * 16;
                        const f32x4 xv = (f32x4){bflo(xo[ai][m].x), bfhi(xo[ai][m].x), bflo(xo[ai][m].y), bfhi(xo[ai][m].y)} + gt * acc[ai][bj][m][n];
                        u32x2 w; w.x = pk2(xv[0], xv[1]); w.y = pk2(xv[2], xv[3]);
                        *(u32x2*)((char*)p + dofs) = w;
                    }
            }
        }
    }
};
struct EpiMoe1 {
    static constexpr bool PERM = true, AFTER_DRAIN = false; static constexpr int A_E8M0 = H8_E8M0;
    bf16* ACT; const float* B1;
    DI void operator()(const AccT& acc, const Unit& u, int wr, int wc, int fr, int fq) const {
#pragma unroll
        for (int bj = 0; bj < 2; ++bj) {
            const int col = u.pn * 256 + bj * 128 + wc * 32 + 8 * fq;
            const f32x4 b0 = *(const f32x4*)(B1 + (size_t)u.e * 2048 + col), b1 = *(const f32x4*)(B1 + (size_t)u.e * 2048 + col + 4);
#pragma unroll
            for (int ai = 0; ai < 2; ++ai)
#pragma unroll
                for (int m = 0; m < 4; ++m) {
                    const int row = u.pm * 256 + ai * 128 + wr * 64 + m * 16 + fr;
                    const f32x4 v0 = acc[ai][bj][m][0] + b0, v1 = acc[ai][bj][m][1] + b1;
                    float o[4];
#pragma unroll
                    for (int j = 0; j < 4; ++j) {
                        const float gl = fminf((j < 2) ? v0[2 * j] : v1[2 * j - 4], 7.0f);
                        const float li = fminf(fmaxf((j < 2) ? v0[2 * j + 1] : v1[2 * j - 3], -7.0f), 7.0f);
                        o[j] = gl * sigmoidf_(1.702f * gl) * (li + 1.0f);
                    }
                    *(unsigned*)((unsigned char*)ACT + (size_t)row * 1024 + (col >> 1)) = pk4_fp8s(o[0], o[1], o[2], o[3], A8_SCALE);
                }
        }
    }
};
struct EpiMoe2 {
    static constexpr bool PERM = true, AFTER_DRAIN = false; static constexpr int A_E8M0 = A8_E8M0;
    unsigned char* Y2; const float* B2; const float* GATEW;
    DI void operator()(const AccT& acc, const Unit& u, int wr, int wc, int fr, int fq) const {
        float gwv[2][4];
#pragma unroll
        for (int ai = 0; ai < 2; ++ai)
#pragma unroll
            for (int m = 0; m < 4; ++m) gwv[ai][m] = GATEW[(size_t)u.e * ECAP + u.ml * 256 + ai * 128 + wr * 64 + m * 16 + fr];
        f32x4 bb[2][2];
#pragma unroll
        for (int bj = 0; bj < 2; ++bj) { const int col = u.pn * 256 + bj * 128 + wc * 32 + 8 * fq; bb[bj][0] = *(const f32x4*)(B2 + (size_t)u.e * 1024 + col); bb[bj][1] = *(const f32x4*)(B2 + (size_t)u.e * 1024 + col + 4); }
#pragma unroll
        for (int ai = 0; ai < 2; ++ai)
#pragma unroll
            for (int m = 0; m < 4; ++m) {
                const int rl = ai * 128 + wr * 64 + m * 16 + fr;
                const float gw = gwv[ai][m];
                const size_t row = (size_t)u.pm * 256 + rl;
#pragma unroll
                for (int bj = 0; bj < 2; ++bj) {
                    const int col = u.pn * 256 + bj * 128 + wc * 32 + 8 * fq;
                    const f32x4 v0 = (acc[ai][bj][m][0] + bb[bj][0]) * gw, v1 = (acc[ai][bj][m][1] + bb[bj][1]) * gw;
                    { u32x2 w8; w8.x = pk4_fp8(v0[0], v0[1], v0[2], v0[3]); w8.y = pk4_fp8(v1[0], v1[1], v1[2], v1[3]); *(u32x2*)(Y2 + row * 1024 + col) = w8; }
                }
            }
    }
};

#define MFMA32(a, b, c) __builtin_amdgcn_mfma_f32_32x32x16_bf16((a), (b), (c), 0, 0, 0)
typedef short v4i16_t __attribute__((ext_vector_type(4)));
DI s16x4 tr_read(const LAS unsigned char* p) { return __builtin_bit_cast(s16x4, __builtin_amdgcn_ds_read_tr16_b64_v4i16((LAS v4i16_t*)p)); }
constexpr int VST = 144;
template <int DQ> struct AC { static constexpr int KST = DQ * 2 + 16, KS = DQ / 16, KBUF = 64 * KST, VBUF = 64 * VST, BUF = KBUF + VBUF; };

template <int DQ>
DI void qk_tile(const LAS unsigned char* kb, const bf16x8 (&qf)[DQ / 16], f32x16 (&s)[2], const f32x16& cinit, int lane) {
    const int r32 = lane & 31, hh = lane >> 5;
    bf16x8 kf[2][DQ / 16];
#pragma unroll
    for (int rt = 0; rt < 2; ++rt)
#pragma unroll
        for (int ks = 0; ks < DQ / 16; ++ks) kf[rt][ks] = *(const LAS bf16x8*)(kb + (32 * rt + r32) * AC<DQ>::KST + (16 * ks + 8 * hh) * 2);
    f32x16 a0 = MFMA32(kf[0][0], qf[0], cinit), a1 = MFMA32(kf[1][0], qf[0], cinit);
#pragma unroll
    for (int ks = 1; ks < DQ / 16; ++ks) { a0 = MFMA32(kf[0][ks], qf[ks], a0); a1 = MFMA32(kf[1][ks], qf[ks], a1); }
    s[0] = a0; s[1] = a1;
}
DI float max3f_(float a, float b, float c) { return __builtin_fmaxf(__builtin_fmaxf(a, b), c); }
constexpr float RESC_THR = 8.0f;
template <int DQ, int KMUL, int VAR = 0>
DI void attn_tile(const LAS unsigned char* kb, const LAS unsigned char* vb, const bf16x8 (&qf)[DQ / 16], f32x16 (&o)[2], f32x16& negm, float& m, float& l,
                  int dq, unsigned maxd, bool lf, int lane, const bool MASKED) {
    const int hh = lane >> 5;
    if (VAR == 1) return;
    f32x16 s[2];
    qk_tile<DQ>(kb, qf, s, negm, lane);
    if (VAR == 2) { o[0] += s[0]; o[1] += s[1]; return; }
    const int i16 = lane & 15, q = i16 >> 2, p_ = i16 & 3, mh = (lane >> 4) & 1;
    const LAS unsigned char* vbase = vb + (4 * hh + q) * VST + 32 * mh + 8 * p_;
    s16x4 vlo[4][2], vhi[4][2];
#pragma unroll
    for (int st = 0; st < 4; ++st)
#pragma unroll
        for (int mt = 0; mt < 2; ++mt) { vlo[st][mt] = tr_read(vbase + (16 * st) * VST + 64 * mt); vhi[st][mt] = tr_read(vbase + (16 * st + 8) * VST + 64 * mt); }
    __builtin_amdgcn_sched_barrier(0);
    if (MASKED) {
#pragma unroll
        for (int rt = 0; rt < 2; ++rt)
#pragma unroll
            for (int i = 0; i < 16; ++i) {
                const int d = dq - (32 * rt + 8 * (i >> 2) + (i & 3)) * KMUL;
                s[rt][i] = ((unsigned)d <= maxd) ? s[rt][i] : -1e30f;
            }
    }
    float mx = max3f_(s[0][0], s[0][1], s[0][2]);
#pragma unroll
    for (int i = 3; i < 15; i += 2) mx = max3f_(mx, s[0][i], s[0][i + 1]);
    mx = max3f_(mx, s[0][15], s[1][0]);
#pragma unroll
    for (int i = 1; i < 15; i += 2) mx = max3f_(mx, s[1][i], s[1][i + 1]);
    mx = fmaxf(mx, s[1][15]);
    if (__ballot(lf && mx > RESC_THR) != 0ull) {
        float mc = lf ? mx : -1e30f;
        mc = fmaxf(mc, __shfl_xor(mc, 32));
        const float delta = mc > RESC_THR ? mc : 0.f;
        const float alpha = fast_exp2(-delta);
        m += delta; l *= alpha;
#pragma unroll
        for (int i = 0; i < 16; ++i) { negm[i] = -m; o[0][i] *= alpha; o[1][i] *= alpha; s[0][i] -= delta; s[1][i] -= delta; }
    }
    float ps = 0.f;
#pragma unroll
    for (int rt = 0; rt < 2; ++rt)
#pragma unroll
        for (int i = 0; i < 16; ++i) { const float p = fast_exp2(s[rt][i]); s[rt][i] = p; ps += p; }
    const unsigned lmask = lf ? 0xffffffffu : 0u;
    l += lf ? ps : 0.f;
    if (VAR == 3) { o[0] += s[0]; o[1] += s[1]; return; }
#pragma unroll
    for (int rt = 0; rt < 2; ++rt)
#pragma unroll
        for (int s2 = 0; s2 < 2; ++s2) {
            u32x4 pw; pw.x = pk2(s[rt][8 * s2 + 0], s[rt][8 * s2 + 1]) & lmask; pw.y = pk2(s[rt][8 * s2 + 2], s[rt][8 * s2 + 3]) & lmask;
            pw.z = pk2(s[rt][8 * s2 + 4], s[rt][8 * s2 + 5]) & lmask; pw.w = pk2(s[rt][8 * s2 + 6], s[rt][8 * s2 + 7]) & lmask;
            const bf16x8 pb = __builtin_bit_cast(bf16x8, pw);
#pragma unroll
            for (int mt = 0; mt < 2; ++mt) {
                const bf16x8 va = __builtin_shufflevector(vlo[2 * rt + s2][mt], vhi[2 * rt + s2][mt], 0, 1, 2, 3, 4, 5, 6, 7);
                o[mt] = MFMA32(va, pb, o[mt]);
            }
        }
}
constexpr int OSTAGE_WAVE = 32 * 144;
static_assert(102400 + 8 * OSTAGE_WAVE <= MISC_OFF, "O stage below the LDS control words");
template <class P>
DI void store_o_rows(const P& p, LAS unsigned char* lds, int off, const f32x16 (&o)[2], float inv, int lane, int wave) {
    LAS unsigned char* st = lds + off + wave * OSTAGE_WAVE;
    const int n = lane & 31, hh = lane >> 5;
#pragma unroll
    for (int mt = 0; mt < 2; ++mt)
#pragma unroll
        for (int a = 0; a < 4; ++a) {
            u32x2 w; w.x = pk2(o[mt][4 * a] * inv, o[mt][4 * a + 1] * inv); w.y = pk2(o[mt][4 * a + 2] * inv, o[mt][4 * a + 3] * inv);
            *(LAS u32x2*)(st + n * 144 + (32 * mt + 8 * a + 4 * hh) * 2) = w;
        }
    asm volatile("s_waitcnt lgkmcnt(0)" ::: "memory");
#pragma unroll
    for (int it = 0; it < 4; ++it) {
        const int r = (lane >> 3) + 8 * it, c = lane & 7;
        const u32x4 v = *(const LAS u32x4*)(st + r * 144 + c * 16);
        *(u32x4*)(p.orow(wave, r) + 8 * c) = v;
    }
}
DI void store_o(bf16* orow, const f32x16 (&o)[2], float inv, int lane) {
    const int hh = lane >> 5;
#pragma unroll
    for (int mt = 0; mt < 2; ++mt)
#pragma unroll
        for (int a = 0; a < 4; ++a) {
            u32x2 w; w.x = pk2(o[mt][4 * a] * inv, o[mt][4 * a + 1] * inv); w.y = pk2(o[mt][4 * a + 2] * inv, o[mt][4 * a + 3] * inv);
            *(u32x2*)(orow + 32 * mt + 8 * a + 4 * hh) = w;
        }
}

struct PolA {
    static constexpr bool HASFLAG = false, LSE = true; static constexpr int KMUL = 1;
    const bf16 *Q, *K, *V; bf16* O; float* LSEP; int b, h, d, r, c; unsigned maxd; int j0, j1;
    DI int ql(int w, int lane) const { return 256 * c + 32 * w + (lane & 31); }
    DI size_t trow(int l_) const { return (size_t)b * S + (size_t)l_ * d + r; }
    DI const bf16* qrow(int w, int lane) const { return Q + trow(ql(w, lane)) * 256 + h * 64; }
    DI int qv(int w, int lane) const { return ql(w, lane); }
    DI int qmin(int w) const { return 256 * c + 32 * w; }
    DI int qmax(int w) const { return 256 * c + 32 * w + 31; }
    DI int kv0(int j) const { return 256 * c - 128 + 64 * j; }
    DI const bf16* krow(int j, int row) const { return K + trow(kv0(j) + row) * 256 + h * 64; }
    DI const bf16* vrow(int j, int row) const { return V + trow(kv0(j) + row) * 256 + h * 64; }
    DI const bf16* rrow(int, int) const { return nullptr; }
    DI bool flag(int, int, int) const { return true; }
    DI bf16* orow(int w, int lane) const { return O + trow(ql(w, lane)) * 256 + h * 64; }
    DI void lse(int w, int lane, float v) const { LSEP[trow(ql(w, lane)) * 4 + h] = v; }
};
struct PolB {
    static constexpr bool LSE = false; static constexpr int KMUL = 1;
    const bf16 *Q, *K, *V; bf16* O; int b, g, qc; unsigned maxd; int j0, j1; u64 sel; bool hasflag;
    DI int tok(int w, int lane) const { return 64 * qc + 8 * w + ((lane & 31) >> 2); }
    DI const bf16* qrow(int w, int lane) const { return Q + ((size_t)b * S + tok(w, lane)) * 512 + (4 * g + (lane & 3)) * 64; }
    DI int qv(int w, int lane) const { return tok(w, lane); }
    DI int qmin(int w) const { return 64 * qc + 8 * w; }
    DI int qmax(int w) const { return 64 * qc + 8 * w + 7; }
    DI int kv0(int j) const { return 64 * j; }
    DI const bf16* krow(int j, int row) const { return K + ((size_t)b * S + 64 * j + row) * 128 + g * 64; }
    DI const bf16* vrow(int j, int row) const { return V + ((size_t)b * S + 64 * j + row) * 128 + g * 64; }
    DI const bf16* rrow(int, int) const { return nullptr; }
    DI bf16* orow(int w, int lane) const { return O + ((size_t)b * S + tok(w, lane)) * 512 + (4 * g + (lane & 3)) * 64; }
    DI void lse(int, int, float) const {}
};
struct PolM {
    static constexpr bool HASFLAG = false, LSE = false; static constexpr int KMUL = 1;
    const bf16 *Q, *KN, *KR, *V; bf16* O; int b, h, c; unsigned maxd; int j0, j1;
    DI int tok(int w, int lane) const { return 256 * c + 32 * w + (lane & 31); }
    DI const bf16* qrow(int w, int lane) const { return Q + ((size_t)b * S + tok(w, lane)) * 384 + h * 96; }
    DI int qv(int w, int lane) const { return tok(w, lane); }
    DI int qmin(int w) const { return 256 * c + 32 * w; }
    DI int qmax(int w) const { return 256 * c + 32 * w + 31; }
    DI int kv0(int j) const { return 64 * j; }
    DI const bf16* krow(int j, int row) const { return KN + ((size_t)b * S + 64 * j + row) * 256 + h * 64; }
    DI const bf16* vrow(int j, int row) const { return V + ((size_t)b * S + 64 * j + row) * 256 + h * 64; }
    DI const bf16* rrow(int j, int row) const { return KR + ((size_t)b * S + 64 * j + row) * 32; }
    DI bf16* orow(int w, int lane) const { return O + ((size_t)b * S + tok(w, lane)) * 256 + h * 64; }
    DI void lse(int, int, float) const {}
};

template <int DQ, class P, bool FLAG, int VAR = 0>
DI void attn_unit(const P& p, LAS unsigned char* lds, int tid, int lane, int wave, u64 sel) {
    typedef AC<DQ> C;
    const int hh = lane >> 5;
    const bf16* qrow = p.qrow(wave, lane);
    bf16x8 qf[DQ / 16];
#pragma unroll
    for (int ks = 0; ks < DQ / 16; ++ks) qf[ks] = *(const bf16x8*)(qrow + 16 * ks + 8 * hh);
#pragma unroll
    for (int ks = 0; ks < DQ / 16; ++ks) asm volatile("s_waitcnt vmcnt(0)" : "+v"(qf[ks]) :: "memory");
    const int qv = p.qv(wave, lane), wq0 = p.qmin(wave), wq1 = p.qmax(wave);
    f32x16 o[2];
#pragma unroll
    for (int mt = 0; mt < 2; ++mt)
#pragma unroll
        for (int i = 0; i < 16; ++i) o[mt][i] = 0.f;
    float m = 0.f, l = 0.f;
    f32x16 negm;
#pragma unroll
    for (int i = 0; i < 16; ++i) negm[i] = 0.f;
    const int j0 = p.j0, j1 = p.j1;
    const int lrow = tid >> 3, lch = tid & 7;
    u32x4 k0A, v0A, r0A = {0u, 0u, 0u, 0u}, k1A, v1A, r1A = {0u, 0u, 0u, 0u}, k0B, v0B, r0B = {0u, 0u, 0u, 0u}, k1B, v1B, r1B = {0u, 0u, 0u, 0u};
    constexpr int NLD = (DQ == 96) ? 6 : 4;
    const int npair = (j1 - j0 + 1) >> 1;
#define ATT_LOAD1(RK, RV, RR, j) do { const bf16* pk_ = p.krow((j), lrow) + 8 * lch; const bf16* pv_ = p.vrow((j), lrow) + 8 * lch; \
        asm volatile("global_load_dwordx4 %0, %2, off\n\tglobal_load_dwordx4 %1, %3, off" : "=&v"(RK), "=&v"(RV) : "v"(pk_), "v"(pv_) : "memory"); \
        if (DQ == 96) { const bf16* pr_ = p.rrow((j), (tid & 255) >> 2) + 8 * (tid & 3); asm volatile("global_load_dwordx4 %0, %1, off" : "=&v"(RR) : "v"(pr_) : "memory"); } } while (0)
#define ATT_LOADP(K0, V0, R0, K1, V1, R1, t) do { const int ja_ = j0 + 2 * (t), jb_ = ja_ + 1; \
        { const int jc_ = ja_ < j1 ? ja_ : j1 - 1; ATT_LOAD1(K0, V0, R0, jc_); } { const int jd_ = jb_ < j1 ? jb_ : j1 - 1; ATT_LOAD1(K1, V1, R1, jd_); } } while (0)
#define ATT_TILE(kb_, jt_) do { const int j_ = (jt_); const int kv0 = p.kv0(j_); \
        bool need = (j_ < j1) && (wq1 - kv0 >= 0) && ((long long)wq0 - (long long)(kv0 + 63 * P::KMUL) <= (long long)p.maxd); \
        const bool interior = (wq0 - (kv0 + 63 * P::KMUL) >= 0) && ((long long)wq1 - (long long)kv0 <= (long long)p.maxd); \
        bool lf = true; \
        if (FLAG) { lf = ((sel >> j_) & 1ull) != 0ull; need = need && (__ballot(lf) != 0ull); } \
        if (need) attn_tile<DQ, P::KMUL, VAR>((kb_), (kb_) + C::KBUF, qf, o, negm, m, l, qv - kv0 - 4 * hh * P::KMUL, p.maxd, lf, lane, !interior); } while (0)
#define ATT_STEP(K0, V0, R0, K1, V1, R1, tt) do { const int t_ = (tt); \
        LAS unsigned char* pbuf = lds + (t_ & 1) * (2 * C::BUF); \
        asm volatile("s_waitcnt vmcnt(%6)" : "+v"(K0), "+v"(V0), "+v"(R0), "+v"(K1), "+v"(V1), "+v"(R1) : "n"(NLD) : "memory"); \
        *(LAS u32x4*)(pbuf + lrow * C::KST + lch * 16) = K0; *(LAS u32x4*)(pbuf + C::KBUF + lrow * VST + lch * 16) = V0; \
        *(LAS u32x4*)(pbuf + C::BUF + lrow * C::KST + lch * 16) = K1; *(LAS u32x4*)(pbuf + C::BUF + C::KBUF + lrow * VST + lch * 16) = V1; \
        if (DQ == 96) { *(LAS u32x4*)(pbuf + ((tid & 255) >> 2) * C::KST + 128 + (tid & 3) * 16) = R0; *(LAS u32x4*)(pbuf + C::BUF + ((tid & 255) >> 2) * C::KST + 128 + (tid & 3) * 16) = R1; } \
        asm volatile("s_waitcnt lgkmcnt(0)\n\ts_barrier" ::: "memory"); \
        ATT_LOADP(K0, V0, R0, K1, V1, R1, t_ + 2); \
        if (ATT_STAGGER > 0 && wave >= 4) __builtin_amdgcn_s_sleep(ATT_STAGGER); \
        ATT_TILE(pbuf, j0 + 2 * t_); ATT_TILE(pbuf + C::BUF, j0 + 2 * t_ + 1); } while (0)
    ATT_LOADP(k0A, v0A, r0A, k1A, v1A, r1A, 0);
    ATT_LOADP(k0B, v0B, r0B, k1B, v1B, r1B, 1);
    if (wave >= 4) __builtin_amdgcn_s_setprio(1);
#pragma unroll 1
    for (int t = 0; t < npair; t += 2) {
        ATT_STEP(k0A, v0A, r0A, k1A, v1A, r1A, t);
        ATT_STEP(k0B, v0B, r0B, k1B, v1B, r1B, t + 1);
    }
    __builtin_amdgcn_s_setprio(0);
    asm volatile("s_waitcnt vmcnt(0)" : "+v"(k0A), "+v"(v0A), "+v"(r0A), "+v"(k1A), "+v"(v1A), "+v"(r1A), "+v"(k0B), "+v"(v0B), "+v"(r0B), "+v"(k1B), "+v"(v1B), "+v"(r1B) :: "memory");
#undef ATT_LOAD1
#undef ATT_LOADP
#undef ATT_TILE
#undef ATT_STEP
    const float lt = l + __shfl_xor(l, 32);
    const float inv = lt > 0.f ? 1.0f / lt : 0.f;
    store_o_rows(p, lds, DQ == 96 ? 102400 : 90112, o, inv, lane, wave);
    if (P::LSE) { if (hh == 0) p.lse(wave, lane, m + __log2f(lt)); }
    __syncthreads();
}

DI u64 cmp_unit(const Ctx& F, int b, int g, int qc) {
    constexpr int KST = 144;
    LAS unsigned char* KL = F.lds; LAS unsigned char* VL = F.lds + 256 * KST; LAS float* IMP = (LAS float*)(F.lds + 2 * 256 * KST);
    const bf16* KC = (const bf16*)(F.ws + WS_KC) + (size_t)(b * 2 + g) * 256 * 64;
    const bf16* VC = (const bf16*)(F.ws + WS_VC) + (size_t)(b * 2 + g) * 256 * 64;
    const int tid = F.tid, lane = F.lane, w = F.wave, hh = lane >> 5, r32 = lane & 31;
#pragma unroll
    for (int it = 0; it < 4; ++it) { const int idx = tid + 512 * it, row = idx >> 3, ch = idx & 7;
        *(LAS u32x4*)(KL + row * KST + ch * 16) = *(const u32x4*)(KC + row * 64 + ch * 8);
        *(LAS u32x4*)(VL + row * VST + ch * 16) = *(const u32x4*)(VC + row * 64 + ch * 8); }
    __syncthreads();
    const int tokl = 8 * w + (r32 >> 2), tok = 64 * qc + tokl, head = 4 * g + (lane & 3);
    const bf16* qrow = (const bf16*)(F.ws + WS_QB) + ((size_t)b * S + tok) * 512 + head * 64;
    bf16x8 qf[4];
#pragma unroll
    for (int ks = 0; ks < 4; ++ks) qf[ks] = *(const bf16x8*)(qrow + 16 * ks + 8 * hh);
    const int qv = tok - 31, wq1 = 64 * qc + 8 * w + 7 - 31;
    f32x16 o[2];
#pragma unroll
    for (int mt = 0; mt < 2; ++mt)
#pragma unroll
        for (int i = 0; i < 16; ++i) o[mt][i] = 0.f;
    float m = 0.f, l = 0.f;
    f32x16 negm;
#pragma unroll
    for (int i = 0; i < 16; ++i) negm[i] = 0.f;
    const int wq0 = 64 * qc + 8 * w - 31;
#pragma unroll 1
    for (int jt = 0; jt < 4; ++jt) {
        if (wq1 - 1024 * jt >= 0) {
            const int dq = qv - 1024 * jt - 4 * hh * 16;
            attn_tile<64, 16>(KL + jt * 64 * KST, VL + jt * 64 * VST, qf, o, negm, m, l, dq, 0x7fffffffu, true, lane, !(wq0 - (1024 * jt + 63 * 16) >= 0));
        }
    }
    const float lt = l + __shfl_xor(l, 32);
    const float inv = lt > 0.f ? 1.0f / lt : 0.f;
    { struct { bf16* O; int b, g, qc; DI bf16* orow(int w_, int n_) const { return O + ((size_t)b * S + 64 * qc + 8 * w_ + (n_ >> 2)) * 512 + (4 * g + (n_ & 3)) * 64; } } pc{(bf16*)(F.ws + WS_OCMP), b, g, qc};
      store_o_rows(pc, F.lds, 90112, o, inv, lane, w); }
    float prev = 0.f;
#pragma unroll 1
    for (int jt = 0; jt < 4; ++jt) {
        const bool need = (wq1 - 1024 * jt >= 0);
        f32x16 s[2];
        if (need) qk_tile<64>(KL + jt * 64 * KST, qf, s, negm, lane);
#pragma unroll
        for (int rt = 0; rt < 2; ++rt)
#pragma unroll
            for (int a = 0; a < 4; ++a) {
                float mainp = 0.f, sp = 0.f;
                if (need) {
                    float pb[4];
#pragma unroll
                    for (int bb = 0; bb < 4; ++bb) { const int kidx = 64 * jt + 32 * rt + 8 * a + 4 * hh + bb; const bool ok = (qv - 16 * kidx) >= 0; pb[bb] = ok ? fast_exp2(s[rt][4 * a + bb]) * inv : 0.f; }
                    mainp = pb[0] + pb[1] + pb[2] + 0.5f * pb[3]; sp = 0.5f * pb[3];
                }
                const float rc = __shfl_xor(sp, 32);
                float v = mainp + (hh ? rc : prev);
                prev = rc;
                v += __shfl_xor(v, 1); v += __shfl_xor(v, 2);
                if ((lane & 3) == 0) IMP[tokl * 64 + 2 * (8 * jt + 4 * rt + a) + hh] = v;
            }
    }
    __syncthreads();
    u64 mysel = 0ull;
#pragma unroll 1
    for (int tk = 0; tk < 8; ++tk) {
        const int tl = 8 * w + tk, t = 64 * qc + tl, j = lane;
        const float v = IMP[tl * 64 + j];
        const bool forced = (j == 0) || (j == qc) || (j == qc - 1);
        const bool valid = j <= qc;
        const float score = forced ? v + 1e4f : (valid ? v : -1.0f);
        int rank = 0;
#pragma unroll
        for (int jp = 0; jp < 64; ++jp) { const float o_ = __builtin_bit_cast(float, __builtin_amdgcn_readlane(__builtin_bit_cast(int, score), jp)); rank += ((o_ > score) || (o_ == score && jp < j)) ? 1 : 0; }
        const u64 mask = __ballot(rank < 16);
        (void)t;
        if (tk == (r32 >> 2)) mysel = mask;
    }
    __syncthreads();
    return mysel;
}

DI void moe_tables(const Ctx& F, int l) {
    LAS int* tb = (LAS int*)(F.lds + AUX_OFF); LAS int* cn = tb + 64;
    if (F.tid == 0) {
        const unsigned* C = (const unsigned*)(F.ws + WS_CTL) + CW_CNT + l * 32 * 64;
        int acc = 0;
        for (int e = 0; e < 32; ++e) { const int c = (int)__hip_atomic_load(C + e * 64, RLX_AGENT); tb[e] = acc; cn[e] = c; acc += (c + 255) >> 8; }
        tb[32] = acc;
    }
    __syncthreads();
}
template <int MODE>
DI void phase_norm1(const Ctx& F, int l) {
    const float* mods = (const float*)(F.ws + WS_MODS);
    const bf16* X = (const bf16*)(F.ws + WS_X); bf16* H = (bf16*)(F.ws + F.dofs + WS_H); bf16* XW = (bf16*)(F.ws + F.dofs + WS_X);
    const LAS int* tb = (const LAS int*)(F.lds + AUX_OFF);
    if (l > 0) moe_tables(F, l - 1);
    const int gw = F.blk * 8 + F.wave, NGW = F.G * 8, lane = F.lane;
    for (int tok = gw; tok < T; tok += NGW) {
        const int b = tok >> 12;
        f32x4 v[4];
        if (l == 0) { const float* xr = ginp(F, I_X) + (size_t)tok * 1024;
#pragma unroll
            for (int k = 0; k < 4; ++k) v[k] = *(const f32x4*)(xr + 4 * lane + 256 * k);
        } else { const bf16* xr = X + (size_t)tok * 1024;
#pragma unroll
            for (int k = 0; k < 4; ++k) { const u32x2 w = *(const u32x2*)(xr + 4 * lane + 256 * k); v[k] = (f32x4){bflo(w.x), bfhi(w.x), bflo(w.y), bfhi(w.y)}; }
        }
        if (l > 0) {
            f32x4 y[4];
#pragma unroll
            for (int k = 0; k < 4; ++k) y[k] = (f32x4){0.f, 0.f, 0.f, 0.f};
            const int* ts = (const int*)(F.ws + WS_TOKSLOT) + (size_t)tok * 4;
#pragma unroll
            for (int s = 0; s < 4; ++s) {
                const int pk = ts[s]; const int e = pk >> 16, pos = pk & 0xffff;
                const unsigned char* yr = (const unsigned char*)(F.ws + WS_Y2) + ((size_t)tb[e] * 256 + pos) * 1024;
#pragma unroll
                for (int k = 0; k < 4; ++k) { const unsigned w = *(const unsigned*)(yr + 4 * lane + 256 * k); y[k] += unpk4_fp8(w); }
            }
            const float* gt2 = mods + ((size_t)((l - 1) * 8 + b) * 6 + 5) * 1024;
#pragma unroll
            for (int k = 0; k < 4; ++k) v[k] = v[k] + *(const f32x4*)(gt2 + 4 * lane + 256 * k) * (y[k] * Y2_ISCALE);
        }
        float ss = 0.f;
#pragma unroll
        for (int k = 0; k < 4; ++k) ss += v[k][0] * v[k][0] + v[k][1] * v[k][1] + v[k][2] * v[k][2] + v[k][3] * v[k][3];
        const float rstd = rsqrtf(wave_sum(ss) * (1.0f / 1024.0f) + EPS);
        if (MODE == 0) {
            const float* g1 = ginp(F, I_G1) + (size_t)l * 1024;
            const float* sh = mods + ((size_t)(l * 8 + b) * 6 + 0) * 1024; const float* sc = sh + 1024;
#pragma unroll
            for (int k = 0; k < 4; ++k) {
                const int c = 4 * lane + 256 * k;
                { u32x2 xw; xw.x = pk2(v[k][0], v[k][1]); xw.y = pk2(v[k][2], v[k][3]); *(u32x2*)(XW + (size_t)tok * 1024 + c) = xw; }
                const f32x4 hv = v[k] * rstd * *(const f32x4*)(g1 + c) * (*(const f32x4*)(sc + c) + 1.0f) + *(const f32x4*)(sh + c);
                u32x2 w; w.x = pk2(hv[0], hv[1]); w.y = pk2(hv[2], hv[3]);
                *(u32x2*)(H + (size_t)tok * 1024 + c) = w;
            }
        } else {
            const float* gf = ginp(F, I_GF);
#pragma unroll
            for (int k = 0; k < 4; ++k) { const int c = 4 * lane + 256 * k; *(f32x4*)(gout(F) + (size_t)tok * 1024 + c) = v[k] * rstd * *(const f32x4*)(gf + c); }
        }
    }
}
DI void phase_prep(const Ctx& F) {
    const bf16* CQ = (const bf16*)(F.ws + WS_CQ); const bf16* MISC = (const bf16*)(F.ws + WS_MISC);
    float* RQ = (float*)(F.ws + WS_RSTDQ); float* RKV = (float*)(F.ws + WS_RSTDKV);
    bf16* KR = (bf16*)(F.ws + WS_KR); float* GATES = (float*)(F.ws + WS_GATES); const float* CS32 = (const float*)(F.ws + WS_CS32);
    const int gw = F.blk * 8 + F.wave, NGW = F.G * 8, lane = F.lane;
    for (int tok = gw; tok < T; tok += NGW) {
        const u32x2 wq = *(const u32x2*)(CQ + (size_t)tok * 256 + 4 * lane);
        const u32x2 wm = *(const u32x2*)(MISC + (size_t)tok * 256 + 4 * lane);
        float a0 = bflo(wq.x), a1 = bfhi(wq.x), a2 = bflo(wq.y), a3 = bfhi(wq.y);
        const float sq = wave_sum(a0 * a0 + a1 * a1 + a2 * a2 + a3 * a3);
        float m0 = bflo(wm.x), m1 = bfhi(wm.x), m2 = bflo(wm.y), m3 = bfhi(wm.y);
        const float skv = wave_sum(lane < 32 ? (m0 * m0 + m1 * m1 + m2 * m2 + m3 * m3) : 0.f);
        if (lane == 0) { RQ[tok] = rsqrtf(sq * (1.0f / 256.0f) + EPS); RKV[tok] = rsqrtf(skv * (1.0f / 128.0f) + EPS); }
        const float p0 = __shfl_xor(m0, 4), p1 = __shfl_xor(m1, 4), p2 = __shfl_xor(m2, 4), p3 = __shfl_xor(m3, 4);
        if (lane >= 32 && lane < 36) {
            const int i0 = 4 * (lane - 32);
            const f32x4 c4 = *(const f32x4*)(CS32 + (size_t)tok * 32 + i0), s4 = *(const f32x4*)(CS32 + (size_t)tok * 32 + 16 + i0);
            u32x4 w;
            w.x = pk2(m0 * c4[0] - p0 * s4[0], p0 * c4[0] + m0 * s4[0]); w.y = pk2(m1 * c4[1] - p1 * s4[1], p1 * c4[1] + m1 * s4[1]);
            w.z = pk2(m2 * c4[2] - p2 * s4[2], p2 * c4[2] + m2 * s4[2]); w.w = pk2(m3 * c4[3] - p3 * s4[3], p3 * c4[3] + m3 * s4[3]);
            *(u32x4*)(KR + (size_t)tok * 32 + 2 * i0) = w;
        }
        if (lane >= 40 && lane < 46) {
            const int gi = 4 * (lane - 40);
            *(f32x4*)(GATES + (size_t)tok * 24 + gi) = (f32x4){sigmoidf_(m0), sigmoidf_(m1), sigmoidf_(m2), sigmoidf_(m3)};
        }
    }
}
DI void phase_cmp2(const Ctx& F, int l) {
    const bf16* HID = (const bf16*)(F.ws + WS_HID);
    const float* CS64 = (const float*)(F.ws + WS_CS64);
    const int gw = F.blk * 8 + F.wave, NGW = F.G * 8, lane = F.lane;
    for (int it = gw; it < 8192; it += NGW) {
        const int kv = it >> 12, row = it & 4095, c = row & 255, bg = row >> 8;
        const float* w2 = ginp(F, kv ? I_W2V : I_W2K) + (size_t)l * 256 * 64;
        const float* b2 = ginp(F, kv ? I_B2V : I_B2K) + (size_t)l * 64;
        const u32x2 hw = *(const u32x2*)(HID + ((size_t)kv * 4096 + row) * 256 + 4 * lane);
        const float h0 = bflo(hw.x), h1 = bfhi(hw.x), h2 = bflo(hw.y), h3 = bfhi(hw.y);
        float acc = b2[lane];
#pragma unroll 4
        for (int k4 = 0; k4 < 64; ++k4) {
            const float x0 = __builtin_bit_cast(float, __builtin_amdgcn_readlane(__builtin_bit_cast(int, h0), k4));
            const float x1 = __builtin_bit_cast(float, __builtin_amdgcn_readlane(__builtin_bit_cast(int, h1), k4));
            const float x2 = __builtin_bit_cast(float, __builtin_amdgcn_readlane(__builtin_bit_cast(int, h2), k4));
            const float x3 = __builtin_bit_cast(float, __builtin_amdgcn_readlane(__builtin_bit_cast(int, h3), k4));
            acc += x0 * w2[(4 * k4 + 0) * 64 + lane] + x1 * w2[(4 * k4 + 1) * 64 + lane] + x2 * w2[(4 * k4 + 2) * 64 + lane] + x3 * w2[(4 * k4 + 3) * 64 + lane];
        }
        if (c == 255) acc = 0.f;
        if (kv == 0) {
            const int b = bg >> 1, tokr = b * S + 16 * c + 31;
            const float other = __shfl_xor(acc, 32);
            const int i = lane & 31;
            const float cs = CS64[(size_t)(tokr & (T - 1)) * 64 + i], sn = CS64[(size_t)(tokr & (T - 1)) * 64 + 32 + i];
            const float y = (lane < 32) ? (acc * cs - other * sn) : (acc * cs + other * sn);
            ((bf16*)(F.ws + WS_KC))[(size_t)row * 64 + 2 * i + (lane >> 5)] = (bf16)(pk2(y, 0.f) & 0xffffu);
        } else {
            ((bf16*)(F.ws + WS_VC))[(size_t)row * 64 + lane] = (bf16)(pk2(acc, 0.f) & 0xffffu);
        }
    }
}
DI void phase_mix(const Ctx& F, int l) {
    const bf16* OA3 = (const bf16*)(F.ws + WS_OA3); const float* LSEA = (const float*)(F.ws + WS_LSEA);
    const bf16* OCMP = (const bf16*)(F.ws + WS_OCMP); const bf16* OSLC = (const bf16*)(F.ws + WS_OSLC); const bf16* OWIN = (const bf16*)(F.ws + WS_OWIN);
    const bf16* OC = (const bf16*)(F.ws + WS_OC); const bf16* MISC = (const bf16*)(F.ws + WS_MISC);
    bf16* AMIX = (bf16*)(F.ws + WS_AMIX);
    const float* ga = ginp(F, I_GOA) + (size_t)l * 256; const float* gb = ginp(F, I_GOB) + (size_t)l * 512; const float* gc = ginp(F, I_GOC) + (size_t)l * 256;
    const int gw = F.blk * 8 + F.wave, NGW = F.G * 8, lane = F.lane, ha = lane >> 4;
    for (int tok0 = gw; tok0 < T; tok0 += 2 * NGW) {
        int tok[2]; tok[0] = tok0; tok[1] = (tok0 + NGW < T) ? tok0 + NGW : tok0;
        float ls[2][3]; u32x2 wa[2][3], wb[2][2][3], wc_[2]; float gl[2][2][3];
#pragma unroll
        for (int q = 0; q < 2; ++q) {
#pragma unroll
            for (int p = 0; p < 3; ++p) { ls[q][p] = LSEA[((size_t)p * T + tok[q]) * 4 + ha]; wa[q][p] = *(const u32x2*)(OA3 + ((size_t)p * T + tok[q]) * 256 + 4 * lane); }
#pragma unroll
            for (int k = 0; k < 2; ++k) {
                const int col = 256 * k + 4 * lane, hb = col >> 6;
                const bf16* g_ = MISC + (size_t)tok[q] * 256 + 160 + hb * 3;
                gl[q][k][0] = bf2f(g_[0]); gl[q][k][1] = bf2f(g_[1]); gl[q][k][2] = bf2f(g_[2]);
                wb[q][k][0] = *(const u32x2*)(OCMP + (size_t)tok[q] * 512 + col); wb[q][k][1] = *(const u32x2*)(OSLC + (size_t)tok[q] * 512 + col); wb[q][k][2] = *(const u32x2*)(OWIN + (size_t)tok[q] * 512 + col);
            }
            wc_[q] = *(const u32x2*)(OC + (size_t)tok[q] * 256 + 4 * lane);
        }
        f32x4 va[2], vb[2][2], vc[2]; float red[2][3];
#pragma unroll
        for (int q = 0; q < 2; ++q) {
            const float mx = fmaxf(ls[q][0], fmaxf(ls[q][1], ls[q][2]));
            const float w0 = fast_exp2(ls[q][0] - mx), w1 = fast_exp2(ls[q][1] - mx), w2 = fast_exp2(ls[q][2] - mx), wi = 1.0f / (w0 + w1 + w2);
            va[q] = ((f32x4){bflo(wa[q][0].x), bfhi(wa[q][0].x), bflo(wa[q][0].y), bfhi(wa[q][0].y)} * w0 + (f32x4){bflo(wa[q][1].x), bfhi(wa[q][1].x), bflo(wa[q][1].y), bfhi(wa[q][1].y)} * w1
                   + (f32x4){bflo(wa[q][2].x), bfhi(wa[q][2].x), bflo(wa[q][2].y), bfhi(wa[q][2].y)} * w2) * wi;
            red[q][0] = va[q][0] * va[q][0] + va[q][1] * va[q][1] + va[q][2] * va[q][2] + va[q][3] * va[q][3];
            float sb = 0.f;
#pragma unroll
            for (int k = 0; k < 2; ++k) {
                const float g0 = sigmoidf_(gl[q][k][0]), g1 = sigmoidf_(gl[q][k][1]), g2 = sigmoidf_(gl[q][k][2]);
                const u32x2 a = wb[q][k][0], b_ = wb[q][k][1], c_ = wb[q][k][2];
                vb[q][k][0] = g0 * bflo(a.x) + g1 * bflo(b_.x) + g2 * bflo(c_.x); vb[q][k][1] = g0 * bfhi(a.x) + g1 * bfhi(b_.x) + g2 * bfhi(c_.x);
                vb[q][k][2] = g0 * bflo(a.y) + g1 * bflo(b_.y) + g2 * bflo(c_.y); vb[q][k][3] = g0 * bfhi(a.y) + g1 * bfhi(b_.y) + g2 * bfhi(c_.y);
                sb += vb[q][k][0] * vb[q][k][0] + vb[q][k][1] * vb[q][k][1] + vb[q][k][2] * vb[q][k][2] + vb[q][k][3] * vb[q][k][3];
            }
            red[q][1] = sb;
            vc[q] = (f32x4){bflo(wc_[q].x), bfhi(wc_[q].x), bflo(wc_[q].y), bfhi(wc_[q].y)};
            red[q][2] = vc[q][0] * vc[q][0] + vc[q][1] * vc[q][1] + vc[q][2] * vc[q][2] + vc[q][3] * vc[q][3];
        }
#pragma unroll
        for (int o = 1; o < 64; o <<= 1) {
#pragma unroll
            for (int q = 0; q < 2; ++q)
#pragma unroll
                for (int j = 0; j < 3; ++j) red[q][j] += __shfl_xor(red[q][j], o);
        }
#pragma unroll
        for (int q = 0; q < 2; ++q) {
            if (q == 1 && tok0 + NGW >= T) break;
            const float ra = rsqrtf(red[q][0] * (1.0f / 256.0f) + EPS), rb = rsqrtf(red[q][1] * (1.0f / 512.0f) + EPS), rc = rsqrtf(red[q][2] * (1.0f / 256.0f) + EPS);
            bf16* orow = AMIX + (size_t)tok[q] * 1024;
            { const f32x4 o = va[q] * ra * *(const f32x4*)(ga + 4 * lane); u32x2 w; w.x = pk2(o[0], o[1]); w.y = pk2(o[2], o[3]); *(u32x2*)(orow + 4 * lane) = w; }
#pragma unroll
            for (int k = 0; k < 2; ++k) { const f32x4 o = vb[q][k] * rb * *(const f32x4*)(gb + 256 * k + 4 * lane); u32x2 w; w.x = pk2(o[0], o[1]); w.y = pk2(o[2], o[3]); *(u32x2*)(orow + 256 + 256 * k + 4 * lane) = w; }
            { const f32x4 o = vc[q] * rc * *(const f32x4*)(gc + 4 * lane); u32x2 w; w.x = pk2(o[0], o[1]); w.y = pk2(o[2], o[3]); *(u32x2*)(orow + 768 + 4 * lane) = w; }
        }
    }
}
DI void phase_router(const Ctx& F, int l) {
    LAS float* WR = (LAS float*)F.lds;
    LAS int* lcnt = (LAS int*)(F.lds + AUX_OFF + 1024); LAS int* gbase = lcnt + 32;
    LAS int* tokE = gbase + 32; LAS float* tokG = (LAS float*)(tokE + 512); LAS int* tokP = (LAS int*)(tokG + 512);
    const float* wr = ginp(F, I_WR) + (size_t)l * 1024 * 32; const float* br = ginp(F, I_BR) + (size_t)l * 32;
    const float* mods = (const float*)(F.ws + WS_MODS); const bf16* X = (const bf16*)(F.ws + WS_X); bf16* H = (bf16*)(F.ws + F.dofs + WS_H);
    const float* g2 = ginp(F, I_G2) + (size_t)l * 1024;
    const int tid = F.tid, lane = F.lane, w = F.wave;
    for (int it = 0; it < 64; ++it) { const int idx = tid + 512 * it, d = idx >> 5, e = idx & 31; WR[e * 1024 + ((((d >> 2) ^ e) << 2) | (d & 3))] = wr[idx]; }
    if (tid < 32) lcnt[tid] = 0;
    __syncthreads();
    unsigned* CNT = (unsigned*)(F.ws + WS_CTL) + CW_CNT + (l + F.dcnt) * 32 * 64;
    for (int chunk = F.blk; chunk < T / 128; chunk += F.G) {
#pragma unroll 1
        for (int tt = 0; tt < 8; ++tt) {
            const int tl0 = w * 16 + 2 * tt, tok0 = chunk * 128 + tl0, b = tok0 >> 12;
            const float* sh = mods + ((size_t)(l * 8 + b) * 6 + 3) * 1024; const float* sc = sh + 1024;
            f32x4 v[2][4]; float ss0 = 0.f, ss1 = 0.f;
#pragma unroll
            for (int k = 0; k < 4; ++k) { const u32x2 wa = *(const u32x2*)(X + (size_t)tok0 * 1024 + 4 * lane + 256 * k), wb = *(const u32x2*)(X + (size_t)(tok0 + 1) * 1024 + 4 * lane + 256 * k);
                v[0][k] = (f32x4){bflo(wa.x), bfhi(wa.x), bflo(wa.y), bfhi(wa.y)}; v[1][k] = (f32x4){bflo(wb.x), bfhi(wb.x), bflo(wb.y), bfhi(wb.y)}; }
#pragma unroll
            for (int k = 0; k < 4; ++k) { ss0 += v[0][k][0] * v[0][k][0] + v[0][k][1] * v[0][k][1] + v[0][k][2] * v[0][k][2] + v[0][k][3] * v[0][k][3];
                                          ss1 += v[1][k][0] * v[1][k][0] + v[1][k][1] * v[1][k][1] + v[1][k][2] * v[1][k][2] + v[1][k][3] * v[1][k][3]; }
#pragma unroll
            for (int o = 1; o < 64; o <<= 1) { ss0 += __shfl_xor(ss0, o); ss1 += __shfl_xor(ss1, o); }
            const float rs0 = rsqrtf(ss0 * (1.0f / 1024.0f) + EPS), rs1 = rsqrtf(ss1 * (1.0f / 1024.0f) + EPS);
#pragma unroll
            for (int k = 0; k < 4; ++k) {
                const int c = 4 * lane + 256 * k;
                const f32x4 gg = *(const f32x4*)(g2 + c) * (*(const f32x4*)(sc + c) + 1.0f), hh_ = *(const f32x4*)(sh + c);
                v[0][k] = v[0][k] * rs0 * gg + hh_; v[1][k] = v[1][k] * rs1 * gg + hh_;
                *(unsigned*)((unsigned char*)H + (size_t)tok0 * 1024 + c) = pk4_fp8s(v[0][k][0], v[0][k][1], v[0][k][2], v[0][k][3], H8_SCALE);
                *(unsigned*)((unsigned char*)H + (size_t)(tok0 + 1) * 1024 + c) = pk4_fp8s(v[1][k][0], v[1][k][1], v[1][k][2], v[1][k][3], H8_SCALE);
            }
            float p0[32], p1[32];
#pragma unroll
            for (int e = 0; e < 32; ++e) {
                float s0 = 0.f, s1 = 0.f;
#pragma unroll
                for (int k = 0; k < 4; ++k) { const f32x4 wv = *(const LAS f32x4*)(WR + e * 1024 + (((lane + 64 * k) ^ e) << 2));
                    s0 += v[0][k][0] * wv[0] + v[0][k][1] * wv[1] + v[0][k][2] * wv[2] + v[0][k][3] * wv[3];
                    s1 += v[1][k][0] * wv[0] + v[1][k][1] * wv[1] + v[1][k][2] * wv[2] + v[1][k][3] * wv[3]; }
                p0[e] = s0; p1[e] = s1;
            }
#define RT_HALVE(N, BIT) _Pragma("unroll") for (int i = 0; i < N; ++i) { const bool hi = (lane & BIT) != 0; \
                { const float keep = hi ? p0[i + N] : p0[i], send = hi ? p0[i] : p0[i + N]; p0[i] = keep + __shfl_xor(send, BIT); } \
                { const float keep = hi ? p1[i + N] : p1[i], send = hi ? p1[i] : p1[i + N]; p1[i] = keep + __shfl_xor(send, BIT); } }
            RT_HALVE(16, 32) RT_HALVE(8, 16) RT_HALVE(4, 8) RT_HALVE(2, 4) RT_HALVE(1, 2)
#undef RT_HALVE
            const float bre = br[lane >> 1];
            const float lg0 = p0[0] + __shfl_xor(p0[0], 1) + bre, lg1 = p1[0] + __shfl_xor(p1[0], 1) + bre;
            int rk0 = 0, rk1 = 0; const int me = lane >> 1;
#pragma unroll
            for (int e = 0; e < 32; ++e) {
                const float o0 = __builtin_bit_cast(float, __builtin_amdgcn_readlane(__builtin_bit_cast(int, lg0), 2 * e));
                const float o1 = __builtin_bit_cast(float, __builtin_amdgcn_readlane(__builtin_bit_cast(int, lg1), 2 * e));
                rk0 += ((o0 > lg0) || (o0 == lg0 && e < me)) ? 1 : 0; rk1 += ((o1 > lg1) || (o1 == lg1 && e < me)) ? 1 : 0;
            }
#pragma unroll
            for (int tk = 0; tk < 2; ++tk) {
                const int rk = tk ? rk1 : rk0; const float lg = tk ? lg1 : lg0;
                int te[4]; float tv[4];
#pragma unroll
                for (int r = 0; r < 4; ++r) {
                    const u64 mk = __ballot(rk == r && (lane & 1) == 0);
                    const int sl = __builtin_amdgcn_readfirstlane((int)__builtin_ctzll(mk));
                    te[r] = sl >> 1; tv[r] = __builtin_bit_cast(float, __builtin_amdgcn_readlane(__builtin_bit_cast(int, lg), sl));
                }
                const float e1 = __expf(tv[1] - tv[0]), e2 = __expf(tv[2] - tv[0]), e3 = __expf(tv[3] - tv[0]);
                const float isum = 1.0f / (1.0f + e1 + e2 + e3);
                if (lane < 4) {
                    const int tl = tl0 + tk;
                    const int e = lane == 0 ? te[0] : lane == 1 ? te[1] : lane == 2 ? te[2] : te[3];
                    const float gte = (lane == 0 ? 1.0f : lane == 1 ? e1 : lane == 2 ? e2 : e3) * isum;
                    const int pos = atomicAdd((int*)(lcnt + e), 1);
                    tokE[tl * 4 + lane] = e; tokG[tl * 4 + lane] = gte; tokP[tl * 4 + lane] = pos;
                }
            }
        }
        __syncthreads();
        if (tid < 32) gbase[tid] = (int)__hip_atomic_fetch_add(CNT + tid * 64, (unsigned)lcnt[tid], RLX_AGENT);
        __syncthreads();
        {
            const int tl = tid >> 2, r = tid & 3, e = tokE[tid], pos = gbase[e] + tokP[tid], tok = chunk * 128 + tl;
            ((int*)(F.ws + F.dofs + WS_IDX))[(size_t)e * ECAP + pos] = tok;
            ((float*)(F.ws + F.dofs + WS_GATEW))[(size_t)e * ECAP + pos] = tokG[tid];
            ((int*)(F.ws + F.dofs + WS_TOKSLOT))[(size_t)tok * 4 + r] = (e << 16) | pos;
        }
        __syncthreads();
        if (tid < 32) lcnt[tid] = 0;
        __syncthreads();
    }
}

DI int ropeperm64(int p) { return (p >> 1) + 32 * (p & 1); }
DI int cmap_win(int n) {
    const int tile = n >> 8, w = n & 255, hb = w & ~63, pp = ropeperm64(w & 63);
    switch (tile) {
        case 0: return hb + pp;
        case 1: return 256 + hb + pp;
        case 2: return 512 + w;
        case 3: return 768 + hb + pp;
        case 4: return 1024 + hb + pp;
        case 5: return w < 128 ? 1280 + w : 1408 + (w - 128);
        case 6: return w < 128 ? 1536 + hb + pp : 1664 + (w - 128);
        case 7: return w < 128 ? 1792 + hb + pp : 1920 + (w - 128);
        case 8: return 2072 + w;
        default: return w < 128 ? 2328 + w : (w < 160 ? 2456 + ((w - 128) >> 1) + 16 * ((w - 128) & 1) : (w < 184 ? 2048 + (w - 160) : -1));
    }
}
DI int cmap_qup(int n) { if (n >= 384) return -1; const int h = n / 96, w = n % 96; if (w < 64) return h * 96 + w; const int j = w - 64; return h * 96 + 64 + (j >> 1) + 16 * (j & 1); }
DI void tr_tile(const float* src, int K, int Nsrc, bf16* dst, int Kdst, int maptype, const float* ksc, int ntile, int ktile, LAS float* scr, int tid) {
    const int n0 = ntile * 64, k0 = ktile * 128, nl = tid & 63, n = n0 + nl;
    const int c = maptype == 0 ? (n < Nsrc ? n : -1) : (maptype == 1 ? cmap_win(n) : cmap_qup(n));
    float v[16];
#pragma unroll
    for (int it = 0; it < 16; ++it) { const int k = k0 + (tid >> 6) + 8 * it; v[it] = (c >= 0 && k < K) ? src[(size_t)k * Nsrc + c] * (ksc ? ksc[k] : 1.0f) : 0.f; }
#pragma unroll
    for (int it = 0; it < 16; ++it) scr[((tid >> 6) + 8 * it) * 65 + nl] = v[it];
    __syncthreads();
#pragma unroll
    for (int it = 0; it < 2; ++it) {
        const int idx = tid + 512 * it, nn = idx >> 4, ch = idx & 15;
        const LAS float* s = scr + (8 * ch) * 65 + nn;
        u32x4 o; o.x = pk2(s[0], s[65]); o.y = pk2(s[2 * 65], s[3 * 65]); o.z = pk2(s[4 * 65], s[5 * 65]); o.w = pk2(s[6 * 65], s[7 * 65]);
        *(u32x4*)(dst + (size_t)(n0 + nn) * Kdst + k0 + 8 * ch) = o;
    }
    __syncthreads();
}
DI void trb_load(f32x4 (&v)[16], const float* src, int N, int n0, int k0, int tid) {
#pragma unroll
    for (int it = 0; it < 16; ++it) v[it] = *(const f32x4*)(src + (size_t)(k0 + (tid >> 6) + 8 * it) * N + n0 + 4 * (tid & 63));
}
DI void trb_store(const f32x4 (&v)[16], bf16* dst, int Kd, int n0, int k0, LAS unsigned char* L, int tid, int wave, int lane, int f8 = 0) {
#pragma unroll
    for (int it = 0; it < 16; ++it) { f32x4 x = v[it];
        if (f8) { x[0] = q8s(x[0], W8_SCALE); x[1] = q8s(x[1], W8_SCALE); x[2] = q8s(x[2], W8_SCALE); x[3] = q8s(x[3], W8_SCALE); }
        u32x2 w; w.x = pk2(x[0], x[1]); w.y = pk2(x[2], x[3]); *(LAS u32x2*)(L + ((tid >> 6) + 8 * it) * 576 + (tid & 63) * 8) = w; }
    asm volatile("s_waitcnt lgkmcnt(0)\n\ts_barrier" ::: "memory");
    const int i = lane & 15, gn = (lane >> 4) & 1, h = lane >> 5, q = i >> 2, p = i & 3;
    const LAS unsigned char* base = L + (8 * h + q) * 576 + (32 * wave + 16 * gn) * 2 + 8 * p;
    if (!f8) {
        bf16* drow = dst + (size_t)(n0 + 32 * wave + 16 * gn + i) * Kd + k0 + 8 * h;
#pragma unroll
        for (int kcp = 0; kcp < 8; ++kcp) {
            const s16x4 lo = tr_read(base + (16 * kcp) * 576), hi = tr_read(base + (16 * kcp + 4) * 576);
            *(bf16x8*)(drow + 16 * kcp) = __builtin_shufflevector(lo, hi, 0, 1, 2, 3, 4, 5, 6, 7);
        }
    } else {
        unsigned char* drow = (unsigned char*)dst + (size_t)(n0 + 32 * wave + 16 * gn + i) * Kd + k0 + 8 * h;
#pragma unroll
        for (int kcp = 0; kcp < 8; ++kcp) {
            const s16x4 lo = tr_read(base + (16 * kcp) * 576), hi = tr_read(base + (16 * kcp + 4) * 576);
            int w0 = __builtin_amdgcn_cvt_pk_fp8_f32(bf2f((unsigned short)lo[0]), bf2f((unsigned short)lo[1]), 0, false); w0 = __builtin_amdgcn_cvt_pk_fp8_f32(bf2f((unsigned short)lo[2]), bf2f((unsigned short)lo[3]), w0, true);
            int w1 = __builtin_amdgcn_cvt_pk_fp8_f32(bf2f((unsigned short)hi[0]), bf2f((unsigned short)hi[1]), 0, false); w1 = __builtin_amdgcn_cvt_pk_fp8_f32(bf2f((unsigned short)hi[2]), bf2f((unsigned short)hi[3]), w1, true);
            u32x2 o; o.x = (unsigned)w0; o.y = (unsigned)w1;
            *(u32x2*)(drow + 16 * kcp) = o;
        }
    }
    asm volatile("s_waitcnt lgkmcnt(0)\n\ts_barrier" ::: "memory");
}
struct TrbItem { const float* src; bf16* dst; int N, n0, k0, f8; };
DI TrbItem trb_item(const Ctx& F, int it) {
    const int le = it / 96, r = it % 96; TrbItem t;
    if (r < 64) { t.src = ginp(F, I_WE1) + (size_t)le * 1024 * 2048; t.dst = (bf16*)(F.ws + WS_W1E + (size_t)le * 2048 * 1024); t.N = 2048; t.n0 = (r & 7) * 256; t.k0 = (r >> 3) * 128; t.f8 = 1; }
    else { const int q = r - 64; t.src = ginp(F, I_WE2) + (size_t)le * 1024 * 1024; t.dst = (bf16*)(F.ws + WS_W2E + (size_t)le * 1024 * 1024); t.N = 1024; t.n0 = (q & 3) * 256; t.k0 = (q >> 2) * 128; t.f8 = 1; }
    return t;
}
DI void conv_layer_tiles(const Ctx& F, int l, int q0, int i0, int cnt) {
    const int NL = 32 * 96;
    int it = q0 + F.blk + F.G * i0; const int end = q0 + F.blk + F.G * (i0 + cnt);
    if (it >= NL) return;
    f32x4 va[16];
    TrbItem ta = trb_item(F, l * NL + it);
    trb_load(va, ta.src, ta.N, ta.n0, ta.k0, F.tid);
#pragma unroll 1
    while (it < NL && it < end) {
        f32x4 vb[16];
#pragma unroll
        for (int k = 0; k < 16; ++k) vb[k] = va[k];
        const TrbItem tc = ta;
        it += F.G;
        const bool more = (it < NL && it < end);
        ta = trb_item(F, l * NL + (more ? it : 0));
        if (more) trb_load(va, ta.src, ta.N, ta.n0, ta.k0, F.tid);
        trb_store(vb, tc.dst, 1024, tc.n0, tc.k0, F.lds, F.tid, F.wave, F.lane, tc.f8);
    }
}
DI void conv_claim_tiles(const Ctx& F, int l, int quota) {
    const int NL = 32 * 96;
    volatile LAS unsigned* slot = (volatile LAS unsigned*)(F.lds + MISC_OFF) + 16;
    __syncthreads();
    if (F.tid == 0) { unsigned* q = (unsigned*)(F.ws + WS_CTL) + CW_CONVQ + l * 64; slot[0] = __hip_atomic_fetch_add(q, (unsigned)quota, __ATOMIC_RELAXED, __HIP_MEMORY_SCOPE_AGENT); }
    __syncthreads();
    int it = __builtin_amdgcn_readfirstlane((int)slot[0]); const int end = it + quota;
    if (it >= NL) return;
    f32x4 va[16];
    TrbItem ta = trb_item(F, l * NL + it);
    trb_load(va, ta.src, ta.N, ta.n0, ta.k0, F.tid);
#pragma unroll 1
    while (it < NL && it < end) {
        f32x4 vb[16];
#pragma unroll
        for (int k = 0; k < 16; ++k) vb[k] = va[k];
        const TrbItem tc = ta;
        it += 1;
        const bool more = (it < NL && it < end);
        ta = trb_item(F, l * NL + (more ? it : 0));
        if (more) trb_load(va, ta.src, ta.N, ta.n0, ta.k0, F.tid);
        trb_store(vb, tc.dst, 1024, tc.n0, tc.k0, F.lds, F.tid, F.wave, F.lane, tc.f8);
    }
}
DI void phase_prologue(const Ctx& F) {
    const Args& A = *F.a; const int tid = F.tid;
    LAS float* scr = (LAS float*)F.lds;
    if (!CONV_IN_LAYER) {
        const int NIT = DEPTH * 32 * 96;
        f32x4 va[16];
        int it = F.blk;
        TrbItem ta = trb_item(F, it < NIT ? it : 0);
        if (it < NIT) trb_load(va, ta.src, ta.N, ta.n0, ta.k0, tid);
#pragma unroll 1
        while (it < NIT) {
            f32x4 vb[16];
#pragma unroll
            for (int k = 0; k < 16; ++k) vb[k] = va[k];
            const TrbItem tc = ta;
            it += F.G;
            ta = trb_item(F, it < NIT ? it : 0);
            if (it < NIT) trb_load(va, ta.src, ta.N, ta.n0, ta.k0, tid);
            trb_store(vb, tc.dst, 1024, tc.n0, tc.k0, F.lds, tid, F.wave, F.lane, tc.f8);
        }
    }
    constexpr int PER_L = 8192 + 4096 + 320 + 128 + 128 + 16 + 16;
    for (int it = F.blk; it < DEPTH * PER_L; it += F.G) {
        const int l = it / PER_L; int r = it % PER_L;
        if (r < 8192 + 4096) continue;
        if (r < 8192) { const int e = r >> 8, t = r & 255;
            tr_tile(ginp(F, I_WE1) + ((size_t)(l * 32 + e)) * 1024 * 2048, 1024, 2048, (bf16*)(F.ws + WS_W1E) + ((size_t)(l * 32 + e)) * 2048 * 1024, 1024, 0, nullptr, t >> 3, t & 7, scr, tid); continue; }
        r -= 8192;
        if (r < 4096) { const int e = r >> 7, t = r & 127;
            tr_tile(ginp(F, I_WE2) + ((size_t)(l * 32 + e)) * 1024 * 1024, 1024, 1024, (bf16*)(F.ws + WS_W2E) + ((size_t)(l * 32 + e)) * 1024 * 1024, 1024, 0, nullptr, t >> 3, t & 7, scr, tid); continue; }
        r -= 4096;
        if (r < 320) { tr_tile(ginp(F, I_WIN) + (size_t)l * 1024 * 2488, 1024, 2488, (bf16*)(F.ws + WS_WIN) + (size_t)l * NIN * 1024, 1024, 1, nullptr, r >> 3, r & 7, scr, tid); continue; }
        r -= 320;
        if (r < 128) { tr_tile(ginp(F, I_WOUT) + (size_t)l * 1024 * 1024, 1024, 1024, (bf16*)(F.ws + WS_WOUT) + (size_t)l * 1024 * 1024, 1024, 0, nullptr, r >> 3, r & 7, scr, tid); continue; }
        r -= 128;
        if (r < 128) { const int kv = r >> 6, t = r & 63;
            tr_tile(ginp(F, kv ? I_W1V : I_W1K) + (size_t)l * 2048 * 256, 2048, 256, (bf16*)(F.ws + WS_NSAW1) + ((size_t)(l * 2 + kv)) * 256 * 2048, 2048, 0, nullptr, t >> 4, t & 15, scr, tid); continue; }
        r -= 128;
        if (r < 16) { tr_tile(ginp(F, I_WQUP) + (size_t)l * 256 * 384, 256, 384, (bf16*)(F.ws + WS_MLAQ) + (size_t)l * 512 * 256, 256, 2, ginp(F, I_GQ) + (size_t)l * 256, r >> 1, r & 1, scr, tid); continue; }
        r -= 16;
        tr_tile(ginp(F, I_WKVUP) + (size_t)l * 128 * 512, 128, 512, (bf16*)(F.ws + WS_MLAKV) + (size_t)l * 512 * 256, 256, 0, ginp(F, I_GKV) + (size_t)l * 128, r >> 1, r & 1, scr, tid);
    }
    for (int it = F.blk; it < DEPTH * 4; it += F.G) {
        const int l = it >> 2, kv = (it >> 1) & 1, kt = it & 1;
        tr_tile(ginp(F, kv ? I_W2V : I_W2K) + (size_t)l * 256 * 64, 256, 64, (bf16*)(F.ws + WS_W2T) + ((size_t)(l * 2 + kv)) * 64 * 256, 256, 0, nullptr, 0, kt, scr, tid);
    }
    {
        float* CS64 = (float*)(F.ws + WS_CS64); float* CS32 = (float*)(F.ws + WS_CS32);
        const int* pos = (const int*)ginp(F, I_POS);
        for (int idx = F.blk * 512 + tid; idx < T * 48; idx += F.G * 512) {
            const int tok = idx / 48, i = idx % 48;
            const double p = (double)pos[tok];
            const double inv = (i < 32) ? exp2(-(double)i * (13.287712379549449 / 32.0)) : exp2(-(double)(i - 32) * (13.287712379549449 / 16.0));
            double ang = p * inv;
            const double kk = __builtin_rint(ang * 0.15915494309189535);
            ang = ang - kk * 6.283185307179586;
            const float af = (float)ang;
            const float cs = __cosf(af), sn = __sinf(af);
            if (i < 32) { CS64[(size_t)tok * 64 + i] = cs; CS64[(size_t)tok * 64 + 32 + i] = sn; }
            else { CS32[(size_t)tok * 32 + (i - 32)] = cs; CS32[(size_t)tok * 32 + 16 + (i - 32)] = sn; }
        }
    }
    for (int item = F.blk; item < 32; item += F.G) {
        const int lk = item >> 2, l = lk >> 1, kv = lk & 1, col = (item & 3) * 64 + F.lane;
        const float* w1 = ginp(F, kv ? I_W1V : I_W1K) + (size_t)l * 2048 * 256 + col; const float* pe = ginp(F, kv ? I_POSV : I_POSK) + (size_t)l * 2048;
        float s = 0.f;
#pragma unroll 1
        for (int kb = 256 * F.wave; kb < 256 * F.wave + 256; kb += 16) {
            float wv[16];
#pragma unroll
            for (int j = 0; j < 16; ++j) wv[j] = w1[(size_t)(kb + j) * 256];
#pragma unroll
            for (int j = 0; j < 16; ++j) s += pe[kb + j] * wv[j];
        }
        scr[F.wave * 64 + F.lane] = s;
        __syncthreads();
        if (tid < 64) { float t = ginp(F, kv ? I_B1V : I_B1K)[(size_t)l * 256 + col];
#pragma unroll
            for (int ww = 0; ww < 8; ++ww) t += scr[ww * 64 + tid];
            ((float*)(F.ws + WS_B1P))[(size_t)lk * 256 + col] = t; }
        __syncthreads();
    }
    {
        LAS float* sc = scr; LAS float* red = scr + 8192;
        for (int i = tid; i < 8192; i += 512) { const float c = ginp(F, I_C)[i]; sc[i] = c * sigmoidf_(c); }
        __syncthreads();
        float* MODS = (float*)(F.ws + WS_MODS);
        const int lane = F.lane, w = F.wave;
        for (int item = F.blk; item < 384; item += F.G) {
            const int l = item / 96, col = (item % 96) * 64 + lane;
            float acc[8];
#pragma unroll
            for (int b = 0; b < 8; ++b) acc[b] = 0.f;
            const float* wa = ginp(F, I_WADA) + (size_t)l * 1024 * 6144 + col;
#pragma unroll 1
            for (int kb = 128 * w; kb < 128 * w + 128; kb += 16) {
                float wv[16];
#pragma unroll
                for (int j = 0; j < 16; ++j) wv[j] = wa[(size_t)(kb + j) * 6144];
#pragma unroll
                for (int j = 0; j < 16; ++j) {
#pragma unroll
                    for (int b = 0; b < 8; ++b) acc[b] += sc[b * 1024 + kb + j] * wv[j]; }
            }
#pragma unroll
            for (int b = 0; b < 8; ++b) red[(w * 8 + b) * 64 + lane] = acc[b];
            __syncthreads();
            { const int b = tid >> 6; float s = ginp(F, I_BADA)[(size_t)l * 6144 + col];
#pragma unroll
              for (int ww = 0; ww < 8; ++ww) s += red[(ww * 8 + b) * 64 + lane];
              MODS[((size_t)(l * 8 + b)) * 6144 + col] = s; }
            __syncthreads();
        }
    }
}

constexpr int PH_PER_LAYER = 11;
constexpr int N_PHASES = 1 + DEPTH * PH_PER_LAYER + 1;

__global__ void __launch_bounds__(512, 2) fwd_kernel(Args args) {
    extern __shared__ __attribute__((aligned(16))) unsigned char lds_raw[];
    Ctx F;
    F.lds = (LAS unsigned char*)lds_raw; F.a = &args; F.ws = args.ws;
    F.dofs = 0; F.dcnt = 0;
    F.tid = threadIdx.x; F.lane = F.tid & 63; F.wave = __builtin_amdgcn_readfirstlane(F.tid >> 6); F.blk = blockIdx.x; F.G = gridDim.x; F.vcu = F.blk;
    volatile LAS unsigned* MISC = (volatile LAS unsigned*)(F.lds + MISC_OFF);
    for (int u = F.tid; u < (LDS_BYTES - MISC_OFF) / 4; u += 512) MISC[u] = 0u;
    __syncthreads();
    unsigned* ctl = (unsigned*)(F.ws + WS_CTL);
    XcdBarrier bar; bar.bar = ctl + CW_BAR; bar.x = 0; bar.st = nullptr;
    if (!MK_PER_PHASE) bar = xcd_barrier_post(ctl + CW_BAR, MISC + 8);
    const int lo = args.ph_lo, hi = args.ph_hi;
#define IN(k) (lo <= (k) && (k) < hi)
#define SEAM(k) do { if (IN(k) && IN((k) + 1)) xcd_barrier(bar); } while (0)
    unsigned char* ws = F.ws;
#define PHASE_BEGIN() do { int t_ = threadIdx.x; asm volatile("" : "+v"(t_)); F.tid = t_; F.lane = t_ & 63; F.wave = __builtin_amdgcn_readfirstlane(t_ >> 6); \
        GAS unsigned char* w_ = (GAS unsigned char*)args.ws; asm volatile("" : "+s"(w_)); F.ws = (unsigned char*)w_; ws = (unsigned char*)w_; int b_ = blockIdx.x; asm volatile("" : "+s"(b_)); F.blk = b_; F.vcu = (F.G % 8 == 0) ? (b_ % 8) * (F.G / 8) + b_ / 8 : b_; } while (0)

    if (PHON(0) && IN(0)) _Pragma("unroll 1") for (int rep_ = 0; rep_ < NREP(0); ++rep_) { PHASE_BEGIN(); phase_prologue(F); }
    SEAM(0);
#pragma unroll 1
    for (int l = 0; l < DEPTH; ++l) {
        const int P = 1 + l * PH_PER_LAYER;
        if (PHON(1) && IN(P + 0)) _Pragma("unroll 1") for (int rep_ = 0; rep_ < (DUM(1) ? 2 : 1); ++rep_) { PHASE_BEGIN(); F.dofs = (DUM(1) && rep_ == 0) ? WS_END : 0; phase_norm1<0>(F, l); }
        SEAM(P + 0);
        if (PHON(2) && IN(P + 1)) _Pragma("unroll 1") for (int rep_ = 0; rep_ < NREP(2); ++rep_) { PHASE_BEGIN();
            SchedGrid Sg{(const char*)(ws + WS_H), (const char*)(ws + WS_WIN) + (size_t)l * NIN * 1024 * 2, 1024, 1024, NIN / 256, (T / 256) * (NIN / 256), F.G, F.vcu};
            EpiWin E{ws, (const float*)(ws + WS_CS64), (const float*)(ws + WS_CS32)};
            pg8::gemm_phase<EpiWin, SchedGrid, false>(F.lds, 1024, 1024, Sg, E);
        }
        SEAM(P + 1);
        if (PHON(3) && IN(P + 2)) _Pragma("unroll 1") for (int rep_ = 0; rep_ < NREP(3); ++rep_) { PHASE_BEGIN();
            if (PHON(13)) {
                SchedCmp Sc{(const char*)(ws + WS_KCMP), (const char*)(ws + WS_VCMP), (const char*)(ws + WS_NSAW1) + (size_t)l * 2 * 256 * 2048 * 2, F.G, F.blk};
                EpiCmp E{(const float*)(ws + WS_B1P) + (size_t)l * 512, (const bf16*)(ws + WS_W2T) + (size_t)l * 2 * 64 * 256, ginp(F, I_B2K) + (size_t)l * 64, ginp(F, I_B2V) + (size_t)l * 64,
                         (bf16*)(ws + WS_KC), (bf16*)(ws + WS_VC), (const float*)(ws + WS_CS64)};
                pg8::gemm_phase<EpiCmp, SchedCmp, false>(F.lds, 1024, 2048, Sc, E);
            }
            PHASE_BEGIN();
            if (PHON(18)) {
                SchedMla Sm{(const char*)(ws + WS_CQ), (const char*)(ws + WS_MISC), (const char*)(ws + WS_MLAQ) + (size_t)l * 512 * 256 * 2, (const char*)(ws + WS_MLAKV) + (size_t)l * 512 * 256 * 2, F.G, F.vcu};
                EpiMla E{(bf16*)(ws + WS_QM), (bf16*)(ws + WS_KN), (bf16*)(ws + WS_VM), (const bf16*)(ws + WS_CQ), (const bf16*)(ws + WS_MISC), (const float*)(ws + WS_CS32)};
                pg8::gemm_phase<EpiMla, SchedMla, false>(F.lds, 256, 256, Sm, E);
            }
            PHASE_BEGIN();
            if (PHON(15)) {
                unsigned* qw = (unsigned*)(ws + WS_CTL) + CW_QUEUE + (l * 2 + rep_) * 64;
                volatile LAS int* qslot = (volatile LAS int*)(F.lds + AUX_OFF + 512);
                int nxt_t = 0;
                if (F.tid == 0) nxt_t = (int)__hip_atomic_fetch_add(qw, 1u, RLX_AGENT);
                for (;;) {
                    if (F.tid == 0) { qslot[0] = nxt_t; nxt_t = (int)__hip_atomic_fetch_add(qw, 1u, RLX_AGENT); }
                    __syncthreads();
                    const int uq = qslot[0];
                    __syncthreads();
                    if (uq >= 2560) break;
                    if (uq < 1024) {
                        const int u = uq;
                        PolB pb; pb.Q = (const bf16*)(ws + WS_QB); pb.K = (const bf16*)(ws + WS_KWIN); pb.V = (const bf16*)(ws + WS_VWIN); pb.O = (bf16*)(ws + WS_OWIN);
                        pb.b = u >> 7; pb.g = (u >> 6) & 1; pb.qc = 63 - (u & 63); pb.maxd = 511u; pb.j0 = pb.qc > 8 ? pb.qc - 8 : 0; pb.j1 = pb.qc + 1;
                        attn_unit<64, PolB, false>(pb, F.lds, F.tid, F.lane, F.wave, 0ull);
                    } else {
                        const int uu = uq - 1024;
                        const int bh = uu / 48, w48 = uu % 48, p = w48 >> 4, s16 = w48 & 15;
                        PolA pa; pa.Q = (const bf16*)(ws + WS_QA); pa.K = (const bf16*)(ws + WS_KA); pa.V = (const bf16*)(ws + WS_VA);
                        pa.O = (bf16*)(ws + WS_OA3) + (size_t)p * T * 256; pa.LSEP = (float*)(ws + WS_LSEA) + (size_t)p * T * 4;
                        pa.b = bh >> 2; pa.h = bh & 3; pa.d = p == 0 ? 1 : (p == 1 ? 4 : 16);
                        const int cpr = p == 0 ? 16 : (p == 1 ? 4 : 1);
                        pa.r = s16 / cpr; pa.c = s16 % cpr; pa.maxd = 128u; pa.j0 = pa.c == 0 ? 2 : 0; pa.j1 = 6;
                        attn_unit<64, PolA, false>(pa, F.lds, F.tid, F.lane, F.wave, 0ull);
                    }
                }
            }
        }
        SEAM(P + 2);
        if (PHON(5) && IN(P + 4)) _Pragma("unroll 1") for (int rep_ = 0; rep_ < NREP(5); ++rep_) { PHASE_BEGIN();
            int cti = 0;
            int cq0 = 0;
            if (CONV_IN_LAYER) { const unsigned t_ = __hip_atomic_load((unsigned*)(ws + WS_CTL) + CW_CONVQ + l * 64, __ATOMIC_RELAXED, __HIP_MEMORY_SCOPE_AGENT); cq0 = __builtin_amdgcn_readfirstlane((int)(t_ < 3072u ? t_ : 3072u)); }
            if (PHON(19)) for (int u = F.vcu; u < 1024; u += F.G) {
                const int bg = (u % 256) >> 4, k = u & 15, rnd = u >> 8;
                const int qc = rnd == 0 ? 2 * k : (rnd == 1 ? 2 * k + 1 : (rnd == 2 ? 63 - 2 * k : 62 - 2 * k));
                const u64 sel = cmp_unit(F, bg >> 1, bg & 1, qc);
                PolB pb; pb.Q = (const bf16*)(ws + WS_QB); pb.K = (const bf16*)(ws + WS_KSLC); pb.V = (const bf16*)(ws + WS_VSLC); pb.O = (bf16*)(ws + WS_OSLC);
                pb.b = bg >> 1; pb.g = bg & 1; pb.qc = qc; pb.maxd = 0x7fffffffu; pb.j0 = 0; pb.j1 = qc + 1;
                attn_unit<64, PolB, true>(pb, F.lds, F.tid, F.lane, F.wave, sel);
                if (CONV_IN_LAYER && rep_ == 0) { PHASE_BEGIN(); conv_layer_tiles(F, l, cq0, cti, 2); cti += 2; }
            }
            PHASE_BEGIN();
            if (PHON(20)) for (int v = F.vcu; v < 512; v += F.G) {
                const int bh = (v & 255) >> 3, k = v & 7, c = (v < 256) ? k : 15 - k;
                PolM pm; pm.Q = (const bf16*)(ws + WS_QM); pm.KN = (const bf16*)(ws + WS_KN); pm.KR = (const bf16*)(ws + WS_KR); pm.V = (const bf16*)(ws + WS_VM); pm.O = (bf16*)(ws + WS_OC);
                pm.b = bh >> 2; pm.h = bh & 3; pm.c = c; pm.maxd = 0x7fffffffu; pm.j0 = 0; pm.j1 = 4 * c + 4;
                attn_unit<96, PolM, false>(pm, F.lds, F.tid, F.lane, F.wave, 0ull);
                if (CONV_IN_LAYER && rep_ == 0) { PHASE_BEGIN(); conv_layer_tiles(F, l, cq0, cti, 2); cti += 2; }
            }
            if (CONV_IN_LAYER && rep_ == 0) { PHASE_BEGIN(); conv_layer_tiles(F, l, cq0, cti, 1 << 20); }
        }
        SEAM(P + 4);
        if (PHON(7) && IN(P + 6)) _Pragma("unroll 1") for (int rep_ = 0; rep_ < NREP(7); ++rep_) { PHASE_BEGIN(); phase_mix(F, l); }
        SEAM(P + 6);
        if (PHON(8) && IN(P + 7)) _Pragma("unroll 1") for (int rep_ = 0; rep_ < (DUM(8) ? 2 : 1); ++rep_) { PHASE_BEGIN(); F.dofs = (DUM(8) && rep_ == 0) ? WS_END : 0;
            SchedGrid Sg{(const char*)(ws + WS_AMIX), (const char*)(ws + WS_WOUT) + (size_t)l * 1024 * 1024 * 2, 1024, 1024, 4, (T / 256) * 4, F.G, F.vcu};
            EpiWout E{(bf16*)(ws + WS_X), (const float*)(ws + WS_MODS) + ((size_t)(l * 8) * 6 + 2) * 1024, F.dofs};
            pg8::gemm_phase<EpiWout, SchedGrid, false>(F.lds, 1024, 1024, Sg, E);
        }
        SEAM(P + 7);
        if (PHON(9) && IN(P + 8)) _Pragma("unroll 1") for (int rep_ = 0; rep_ < (DUM(9) ? 2 : 1); ++rep_) { PHASE_BEGIN(); F.dofs = (DUM(9) && rep_ == 0) ? WS_END : 0; F.dcnt = (DUM(9) && rep_ == 0) ? 4 : 0; phase_router(F, l); }
        SEAM(P + 8);
        if (PHON(10) && IN(P + 9)) _Pragma("unroll 1") for (int rep_ = 0; rep_ < NREP(10); ++rep_) { PHASE_BEGIN();
            moe_tables(F, l);
            const LAS int* tb = (const LAS int*)(F.lds + AUX_OFF);
            SchedMoe1F8 Sm{tb, tb + 64, (const char*)(ws + WS_H), (const char*)(ws + WS_W1E) + (size_t)l * 32 * 2048 * 1024, (const int*)(ws + WS_IDX), tb[32] * 8, F.G, F.vcu};
            EpiMoe1 E{(bf16*)(ws + WS_ACT), ginp(F, I_BE1) + (size_t)l * 32 * 2048};
            pg8::gemm_phase<EpiMoe1, SchedMoe1F8, true, true>(F.lds, 512, 512, Sm, E);
            if (CONV_IN_LAYER && CONV_TAIL1 > 0 && rep_ == 0 && l + 1 < DEPTH) {
                const int nun = tb[32] * 8, rounds = (nun + F.G - 1) / F.G, mine = F.vcu < nun ? (nun - 1 - F.vcu) / F.G + 1 : 0;
                if (mine < rounds) { PHASE_BEGIN(); conv_claim_tiles(F, l + 1, CONV_TAIL1); }
            }
        }
        SEAM(P + 9);
        if (PHON(11) && IN(P + 10)) _Pragma("unroll 1") for (int rep_ = 0; rep_ < NREP(11); ++rep_) { PHASE_BEGIN();
            moe_tables(F, l);
            const LAS int* tb = (const LAS int*)(F.lds + AUX_OFF);
            SchedMoe2F8 Sm{tb, (const char*)(ws + WS_ACT), (const char*)(ws + WS_W2E) + (size_t)l * 32 * 1024 * 1024, tb[32] * 4, F.G, F.vcu};
            EpiMoe2 E{(unsigned char*)(ws + WS_Y2), ginp(F, I_BE2) + (size_t)l * 32 * 1024, (const float*)(ws + WS_GATEW)};
            pg8::gemm_phase<EpiMoe2, SchedMoe2F8, false, true>(F.lds, 512, 512, Sm, E);
            if (CONV_IN_LAYER && CONV_TAIL2 > 0 && rep_ == 0 && l + 1 < DEPTH) {
                const int nun = tb[32] * 4, rounds = (nun + F.G - 1) / F.G, mine = F.vcu < nun ? (nun - 1 - F.vcu) / F.G + 1 : 0;
                if (mine < rounds) { PHASE_BEGIN(); conv_claim_tiles(F, l + 1, CONV_TAIL2); }
            }
        }
        SEAM(P + 10);
    }
    if (PHON(12) && IN(N_PHASES - 1)) { PHASE_BEGIN(); phase_norm1<1>(F, DEPTH); }
#undef IN
#undef SEAM
}

extern "C" void kernel_launch(void* const* d_in, const int* in_sizes, int n_in, void* d_out, int out_size, void* d_ws, size_t ws_size, hipStream_t stream) {
    static int grid = 0;
    if (grid == 0) {
        if (n_in != 33 || out_size != T * D || ws_size < WS_END * (DUM_MASK ? 2 : 1)) { fprintf(stderr, "kernel_launch: unexpected problem (n_in %d out %d ws %zu)\n", n_in, out_size, ws_size); grid = -1; return; }
        int dev = 0, cus = 0, per_cu = 0;
        if (hipGetDevice(&dev) != hipSuccess || hipDeviceGetAttribute(&cus, hipDeviceAttributeMultiprocessorCount, dev) != hipSuccess) { grid = -1; return; }
        if (hipFuncSetAttribute((const void*)fwd_kernel, hipFuncAttributeMaxDynamicSharedMemorySize, LDS_BYTES) != hipSuccess) { fprintf(stderr, "kernel_launch: hipFuncSetAttribute failed\n"); grid = -1; return; }
        if (hipOccupancyMaxActiveBlocksPerMultiprocessor(&per_cu, (const void*)fwd_kernel, 512, LDS_BYTES) != hipSuccess || per_cu < 1) { fprintf(stderr, "kernel_launch: occupancy query says %d\n", per_cu); per_cu = 1; }
        (void)hipGetLastError();
        grid = cus;
    }
    if (grid < 0) return;
    if (hipMemsetAsync((char*)d_ws + WS_CTL, 0, CTL_ZERO_BYTES, stream) != hipSuccess) return;
    Args a{};
    for (int i = 0; i < 33; ++i) a.in[i] = (const float*)d_in[i];
    a.out = (float*)d_out; a.ws = (unsigned char*)d_ws;
#if MK_PER_PHASE
    for (int p = 0; p < N_PHASES; ++p) { a.ph_lo = p; a.ph_hi = p + 1; hipLaunchKernelGGL(fwd_kernel, dim3(grid), dim3(512), LDS_BYTES, stream, a); }
#else
    a.ph_lo = 0; a.ph_hi = N_PHASES;
    hipLaunchKernelGGL(fwd_kernel, dim3(grid), dim3(512), LDS_BYTES, stream, a);
#endif
}
```

```cpp
#include <hip/hip_runtime.h>
#include <cstdio>
#include <cstdint>

#ifndef MK_PER_PHASE
#define MK_PER_PHASE 0
#endif

#ifndef PH_MASK
#define PH_MASK 0xFFFFFFFFu
#endif
#define PHON(k) ((PH_MASK >> (k)) & 1u)
#ifndef DBL_MASK
#define DBL_MASK 0u
#endif
#define NREP(k) (((DBL_MASK >> (k)) & 1u) ? 2 : 1)
#ifndef DUM_MASK
#define DUM_MASK 0u
#endif
#define DUM(k) ((DUM_MASK >> (k)) & 1u)
#ifndef ATT_VAR
#define ATT_VAR 0
#endif
#ifndef CONV_IN_LAYER
#define CONV_IN_LAYER 1
#endif
#ifndef CONV_TAIL1
#define CONV_TAIL1 3
#endif
#ifndef CONV_TAIL2
#define CONV_TAIL2 4
#endif
#ifndef ATT_STAGGER
#define ATT_STAGGER 0
#endif
#define DI __device__ __forceinline__
#define LAS __attribute__((address_space(3)))
#define GAS __attribute__((address_space(1)))
typedef unsigned short bf16;
typedef short bf16x8 __attribute__((ext_vector_type(8)));
typedef short s16x4 __attribute__((ext_vector_type(4)));
typedef float f32x2 __attribute__((ext_vector_type(2)));
typedef float f32x4 __attribute__((ext_vector_type(4)));
typedef float f32x16 __attribute__((ext_vector_type(16)));
typedef unsigned u32x2 __attribute__((ext_vector_type(2)));
typedef unsigned u32x4 __attribute__((ext_vector_type(4)));
typedef __bf16 bf16x2_t __attribute__((ext_vector_type(2)));
typedef unsigned long long u64;

constexpr int NB = 8, S = 4096, T = NB * S, D = 1024, DEPTH = 4;
constexpr int NIN = 2560;
constexpr int NE = 32, DFF = 1024;
constexpr int SP = S + 64;
constexpr int ECAP = 32768;
constexpr int ACT_ROWS = 4 * T + NE * 256;
constexpr float LOG2E = 1.4426950408889634f;
constexpr float SCL64 = 0.125f * LOG2E;
constexpr float SCL96 = 0.10206207261596577f * LOG2E;
constexpr float EPS = 1e-6f;

constexpr size_t MiB = 1u << 20;
constexpr size_t WS_CTL = 0, CTL_ZERO_BYTES = 2 * MiB;
constexpr size_t WS_MODS = 2 * MiB, WS_B1P = 3 * MiB, WS_CS64 = 4 * MiB, WS_CS32 = 12 * MiB;
constexpr size_t WS_WIN = 16 * MiB, WS_WOUT = 36 * MiB, WS_NSAW1 = 44 * MiB, WS_MLAQ = 52 * MiB, WS_MLAKV = 53 * MiB;
constexpr size_t WS_W1E = 64 * MiB, WS_W2E = 576 * MiB;
constexpr size_t WS_X = 832 * MiB, WS_H = 960 * MiB;
constexpr size_t WS_QA = 1024 * MiB, WS_KA = 1040 * MiB, WS_VA = 1056 * MiB, WS_QB = 1072 * MiB;
constexpr size_t WS_KCMP = 1104 * MiB, WS_VCMP = 1113 * MiB;
constexpr size_t WS_KSLC = 1122 * MiB, WS_VSLC = 1130 * MiB, WS_KWIN = 1138 * MiB, WS_VWIN = 1146 * MiB;
constexpr size_t WS_CQ = 1154 * MiB, WS_MISC = 1170 * MiB;
constexpr size_t WS_RSTDQ = 1186 * MiB, WS_RSTDKV = 1186 * MiB + 512 * 1024, WS_KR = 1187 * MiB, WS_GATES = 1189 * MiB;
constexpr size_t WS_W2T = 1195 * MiB;
constexpr size_t WS_HID = 1192 * MiB, WS_KC = 1196 * MiB, WS_VC = 1196 * MiB + 512 * 1024;
constexpr size_t WS_QM = 1197 * MiB, WS_KN = 1221 * MiB, WS_VM = 1237 * MiB;
constexpr size_t WS_OA3 = 1253 * MiB, WS_LSEA = 1301 * MiB;
constexpr size_t WS_OCMP = 1303 * MiB, WS_OSLC = 1335 * MiB, WS_OWIN = 1367 * MiB, WS_OC = 1399 * MiB;
constexpr size_t WS_SEL = 1415 * MiB, WS_AMIX = 1416 * MiB;
constexpr size_t WS_IDX = 1480 * MiB, WS_GATEW = 1484 * MiB, WS_TOKSLOT = 1488 * MiB;
constexpr size_t WS_ACT = 1489 * MiB, WS_Y2 = 1761 * MiB, WS_END = 2033 * MiB;
static_assert((size_t)ACT_ROWS * 1024 * 2 <= 272 * MiB, "act rows");
static_assert((size_t)16 * SP * 64 * 2 + 65536 <= 9 * MiB, "kcmp");

constexpr int CW_TMO = 0, CW_FAIL = 2;
constexpr int CW_BAR = 4096;
constexpr int CW_QUEUE = 12288;
constexpr int CW_CONVQ = 13312;
constexpr int CW_CNT = 16384;

constexpr int RING_BYTES = 131072;
constexpr int AUX_OFF = RING_BYTES;
constexpr int MISC_OFF = AUX_OFF + 8192;
constexpr int LDS_BYTES = 147456;

DI unsigned pk2(float lo, float hi) { f32x2 v = {lo, hi}; bf16x2_t b = __builtin_convertvector(v, bf16x2_t); return __builtin_bit_cast(unsigned, b); }
DI float bf2f(unsigned short h) { return __uint_as_float(((unsigned)h) << 16); }
DI float bflo(unsigned w) { return __uint_as_float(w << 16); }
DI float bfhi(unsigned w) { return __uint_as_float(w & 0xffff0000u); }
typedef float f32x2c __attribute__((ext_vector_type(2)));
constexpr float Y2_SCALE = 16.0f, Y2_ISCALE = 1.0f / 16.0f;
DI unsigned pk4_fp8(float a, float b, float c, float d) {
    a = fminf(fmaxf(a * Y2_SCALE, -440.f), 440.f); b = fminf(fmaxf(b * Y2_SCALE, -440.f), 440.f); c = fminf(fmaxf(c * Y2_SCALE, -440.f), 440.f); d = fminf(fmaxf(d * Y2_SCALE, -440.f), 440.f);
    int w = __builtin_amdgcn_cvt_pk_fp8_f32(a, b, 0, false); w = __builtin_amdgcn_cvt_pk_fp8_f32(c, d, w, true); return (unsigned)w; }
DI f32x4 unpk4_fp8(unsigned w) { const f32x2c lo = __builtin_amdgcn_cvt_pk_f32_fp8((int)w, false), hi = __builtin_amdgcn_cvt_pk_f32_fp8((int)w, true); return (f32x4){lo.x, lo.y, hi.x, hi.y}; }
constexpr float W8_SCALE = 64.0f, A8_SCALE = 4.0f;
constexpr int W8_E8M0 = 127 - 6, A8_E8M0 = 127 - 2;
constexpr float H8_SCALE = 8.0f; constexpr int H8_E8M0 = 127 - 3;
DI int lane_id() { return (int)__builtin_amdgcn_mbcnt_hi(~0u, __builtin_amdgcn_mbcnt_lo(~0u, 0u)); }
DI unsigned pk4_fp8s(float a, float b, float c, float d, float sc) {
    a = fminf(fmaxf(a * sc, -440.f), 440.f); b = fminf(fmaxf(b * sc, -440.f), 440.f); c = fminf(fmaxf(c * sc, -440.f), 440.f); d = fminf(fmaxf(d * sc, -440.f), 440.f);
    int w = __builtin_amdgcn_cvt_pk_fp8_f32(a, b, 0, false); w = __builtin_amdgcn_cvt_pk_fp8_f32(c, d, w, true); return (unsigned)w; }
DI float q8s(float x, float sc) {
    const float a = fminf(fmaxf(x * sc, -440.f), 440.f); const int w = __builtin_amdgcn_cvt_pk_fp8_f32(a, a, 0, false);
    const f32x2c r = __builtin_amdgcn_cvt_pk_f32_fp8(w, false); return r.x; }
DI float wave_sum(float v) {
#pragma unroll
    for (int o = 1; o < 64; o <<= 1) v += __shfl_xor(v, o);
    return v;
}
DI float fast_exp2(float x) { return __builtin_amdgcn_exp2f(x); }
DI float fast_rcp(float x) { return __builtin_amdgcn_rcpf(x); }
DI float sigmoidf_(float x) { return fast_rcp(1.0f + fast_exp2(-x * LOG2E)); }
#define RLX_AGENT __ATOMIC_RELAXED, __HIP_MEMORY_SCOPE_AGENT

#define XB_TMO      128
#define XB_XCNT(j)  (256  + 64 * (j))
#define XB_XSUB(j)  (1280 + 64 * (j))
#define XB_XGEN(j)  (2304 + 64 * (j))
#define XB_TOP      3328
#define XB_TOPGEN   3392
#define XCD_BAR_WORDS 3456
#define XB_SPIN_CAP (1u << 22)
DI unsigned xb_ld(unsigned* p)              { return __hip_atomic_load(p, __ATOMIC_RELAXED, __HIP_MEMORY_SCOPE_AGENT); }
DI unsigned xb_add(unsigned* p, unsigned v) { return __hip_atomic_fetch_add(p, v, __ATOMIC_RELAXED, __HIP_MEMORY_SCOPE_AGENT); }
DI unsigned xb_xcc_id() { return (unsigned)__builtin_amdgcn_s_getreg((3 << 11) | 20) & 0xFu; }
#define XB_SPIN(cond, bar) do { unsigned _sp = 0; while (cond) { __builtin_amdgcn_s_sleep(1); \
    if ((++_sp & 255u) == 0u) { if (xb_ld(&(bar)[XB_TMO])) break; if (_sp > XB_SPIN_CAP) { atomicAdd(&(bar)[XB_TMO], 1u); break; } } } } while (0)
struct XcdBarrier { unsigned* bar; unsigned x; volatile LAS unsigned* st; };
DI XcdBarrier xcd_barrier_post(unsigned* bar, volatile LAS unsigned* st) {
    XcdBarrier b; b.bar = bar; b.x = xb_xcc_id(); b.st = st;
    if (threadIdx.x == 0) (void)xb_add(&bar[XB_XCNT(b.x)], 1u);
    return b;
}
DI void xcd_barrier_complete(unsigned* bar, unsigned x, unsigned& nloc, unsigned& nx) {
    const unsigned G = gridDim.x * gridDim.y * gridDim.z;
    unsigned sum, cnt, mine, sp = 0u;
    for (;;) {
        sum = 0u; cnt = 0u; mine = 0u;
#pragma unroll
        for (unsigned j = 0; j < 16; ++j) { const unsigned c = xb_ld(&bar[XB_XCNT(j)]); sum += c; cnt += (c > 0u) ? 1u : 0u; mine = (j == x) ? c : mine; }
        if (sum == G) break;
        __builtin_amdgcn_s_sleep(1);
        if ((++sp & 255u) == 0u) { if (xb_ld(&bar[XB_TMO])) break; if (sp > XB_SPIN_CAP) { atomicAdd(&bar[XB_TMO], 1u); break; } }
    }
    nloc = mine > 0u ? mine : 1u; nx = cnt > 0u ? cnt : 1u;
}
DI void xcd_barrier(const XcdBarrier& b) {
    asm volatile("s_waitcnt vmcnt(0)" ::: "memory");
    __syncthreads();
    unsigned* bar = b.bar; asm volatile("" : "+s"(bar));
    if (threadIdx.x == 0) {
        __builtin_amdgcn_s_waitcnt(0);
        unsigned nloc = b.st[0], nx = b.st[1];
        if (nloc == 0u) { xcd_barrier_complete(bar, b.x, nloc, nx); b.st[0] = nloc; b.st[1] = nx; }
        const unsigned old = xb_add(&bar[XB_XSUB(b.x)], 1u);
        const unsigned gen = old / nloc;
        if (old + 1u == (gen + 1u) * nloc) {
            __builtin_amdgcn_fence(__ATOMIC_RELEASE, "agent");
            asm volatile("s_waitcnt vmcnt(0)" ::: "memory");
            const unsigned og = xb_add(&bar[XB_TOP], 1u);
            const unsigned tg = og / nx;
            if (og + 1u == (tg + 1u) * nx) xb_add(&bar[XB_TOPGEN], 1u);
            else XB_SPIN(xb_ld(&bar[XB_TOPGEN]) == tg, bar);
            __builtin_amdgcn_fence(__ATOMIC_ACQUIRE, "agent");
            xb_add(&bar[XB_XGEN(b.x)], 1u);
            asm volatile("s_waitcnt vmcnt(0)" ::: "memory");
        } else {
            XB_SPIN(xb_ld(&bar[XB_XGEN(b.x)]) == gen, bar);
            __builtin_amdgcn_fence(__ATOMIC_ACQUIRE, "agent");
            asm volatile("s_waitcnt vmcnt(0)" ::: "memory");
        }
    }
    __syncthreads();
}

struct Args {
    const float* in[33];
    float* out;
    unsigned char* ws;
    int ph_lo, ph_hi;
};
enum { I_X = 0, I_C, I_POS, I_WADA, I_BADA, I_G1, I_G2, I_WIN, I_POSK, I_POSV, I_W1K, I_B1K, I_W2K, I_B2K, I_W1V, I_B1V, I_W2V, I_B2V,
       I_GQ, I_GKV, I_WQUP, I_WKVUP, I_GOA, I_GOB, I_GOC, I_WOUT, I_WR, I_BR, I_WE1, I_BE1, I_WE2, I_BE2, I_GF };

struct Ctx {
    LAS unsigned char* lds;
    const Args* a;
    unsigned char* ws;
    int tid, lane, wave, blk, G, vcu;
    size_t dofs; int dcnt;
};
DI const float* ginp(const Ctx& F, int i) { return (const float*)(GAS const float*)(F.a->in[i]); }
DI float* gout(const Ctx& F) { return (float*)(GAS float*)(F.a->out); }

namespace pg8 {
constexpr int BM = 256, BK = 64, HALF = 128, HTB = HALF * BK * 2;
DI int lds_byte(int r, int c) { const int st = (r >> 4) * 2 + (c >> 5), rr = r & 15, cc = c & 31, ob = rr * 64 + cc * 2; return st * 1024 + (ob ^ (((ob >> 9) & 1) << 5)); }
DI void stage_rc(int b, int& R, int& C) { const int st = b / 1024, sb = b % 1024, swz = sb ^ (((sb >> 9) & 1) << 5); R = (st >> 1) * 16 + swz / 64; C = (st & 1) * 32 + (swz % 64) / 2; }
DI int perm32(int rho) { const int n = rho >> 4, i = rho & 15; return 8 * (i >> 2) + 4 * n + (i & 3); }
struct Unit { const char* a; const char* b; int pm, pn, e, ml; };

template <class Epi, class Sched, bool GATHER, bool FP8 = false>
DI void gemm_phase(LAS unsigned char* lds, const int lda, const int K, const Sched& S, const Epi& E) {
    typedef int i32x4_ __attribute__((ext_vector_type(4))); typedef int i32x8_ __attribute__((ext_vector_type(8)));
    int tid_ = threadIdx.x; asm volatile("" : "+v"(tid_));
    const int tid = tid_, wid = __builtin_amdgcn_readfirstlane(tid >> 6), lane = tid & 63, wr = wid >> 2, wc = wid & 3, fr = lane & 15, fq = lane >> 4;
    const int nt = K / BK;
    int Rr[2], Cc[2]; unsigned voffB[2];
#pragma unroll
    for (int i = 0; i < 2; ++i) { int R, C; stage_rc(tid * 16 + i * 8192, R, C); Rr[i] = R; Cc[i] = C; const int Rb = Epi::PERM ? ((R & ~31) + perm32(R & 31)) : R; voffB[i] = (unsigned)(Rb * K + C) * 2u; }
    const size_t kstep = (size_t)(BK * 2);
    const size_t hstepB = (size_t)HALF * K * 2;
    const unsigned ldsw = (unsigned)wid * 1024u;
    const int aoff = lds_byte(wr * 64 + fr, fq * 8), boff = lds_byte(wc * 32 + fr, fq * 8);
#define PG8_SA(b, h) (((b) * 2 + (h)) * HTB)
#define PG8_SB(b, h) ((4 + (b) * 2 + (h)) * HTB)
#define PG8_STAGE_B(bufoff, gbase) do { _Pragma("unroll") for (int _i = 0; _i < 2; ++_i) \
        __builtin_amdgcn_global_load_lds((const unsigned*)((const char*)(gbase) + (size_t)_i * 64 * K * 2 + voffB[0]), (LAS unsigned*)(lds + (bufoff) + ldsw + _i * 8192), 16, 0, 0); } while (0)
#define PG8_STAGE_A(bufoff, gbase, v, h) do { _Pragma("unroll") for (int _i = 0; _i < 2; ++_i) { \
        if constexpr (GATHER) __builtin_amdgcn_global_load_lds((const unsigned*)((const char*)(gbase) + (v)[h][_i]), (LAS unsigned*)(lds + (bufoff) + ldsw + _i * 8192), 16, 0, 0); \
        else __builtin_amdgcn_global_load_lds((const unsigned*)((const char*)(gbase) + (size_t)((h) * 128 + _i * 64) * lda * 2 + (v)[0][0]), (LAS unsigned*)(lds + (bufoff) + ldsw + _i * 8192), 16, 0, 0); } } while (0)
#define PG8_SETOFF(v, u) do { _Pragma("unroll") for (int _h = 0; _h < 2; ++_h) _Pragma("unroll") for (int _i = 0; _i < 2; ++_i) { \
        if constexpr (GATHER) (v)[_h][_i] = S.gather_off((u), _h * 128 + Rr[_i]) + (unsigned)Cc[_i] * 2u; \
        else (v)[_h][_i] = (unsigned)((_h * 128 + Rr[_i]) * lda + Cc[_i]) * 2u; } } while (0)
#define PG8_LDA(dst, b, h) do { _Pragma("unroll") for (int m = 0; m < 4; ++m) { const i32x4_ lo_ = *(const LAS i32x4_*)(lds + PG8_SA(b, h) + aoff + m * 2048), hi_ = *(const LAS i32x4_*)(lds + PG8_SA(b, h) + aoff + m * 2048 + 1024); dst[m] = __builtin_shufflevector(lo_, hi_, 0, 1, 2, 3, 4, 5, 6, 7); } } while (0)
#define PG8_LDB(dst, b, h) do { _Pragma("unroll") for (int n = 0; n < 2; ++n) { const i32x4_ lo_ = *(const LAS i32x4_*)(lds + PG8_SB(b, h) + boff + n * 2048), hi_ = *(const LAS i32x4_*)(lds + PG8_SB(b, h) + boff + n * 2048 + 1024); dst[n] = __builtin_shufflevector(lo_, hi_, 0, 1, 2, 3, 4, 5, 6, 7); } } while (0)
#define PG8_H0(x) __builtin_bit_cast(bf16x8, __builtin_shufflevector((x), (x), 0, 1, 2, 3))
#define PG8_H1(x) __builtin_bit_cast(bf16x8, __builtin_shufflevector((x), (x), 4, 5, 6, 7))
#define PG8_MMA(ai, bj, At, Bt) do { __builtin_amdgcn_s_setprio(1); \
        if constexpr (FP8) { _Pragma("unroll") for (int m = 0; m < 4; ++m) _Pragma("unroll") for (int n = 0; n < 2; ++n) \
            asm volatile("v_mfma_scale_f32_16x16x128_f8f6f4 %0, %1, %2, %0, %3, %4 op_sel_hi:[0,0,0]" : "+v"(acc[ai][bj][m][n]) : "v"(Bt[n]), "v"(At[m]), "v"(scw_), "v"(sca_)); } \
        else { _Pragma("unroll") for (int m = 0; m < 4; ++m) _Pragma("unroll") for (int n = 0; n < 2; ++n) { \
            acc[ai][bj][m][n] = __builtin_amdgcn_mfma_f32_16x16x32_bf16(PG8_H0(Bt[n]), PG8_H0(At[m]), acc[ai][bj][m][n], 0, 0, 0); \
            acc[ai][bj][m][n] = __builtin_amdgcn_mfma_f32_16x16x32_bf16(PG8_H1(Bt[n]), PG8_H1(At[m]), acc[ai][bj][m][n], 0, 0, 0); } } \
        __builtin_amdgcn_s_setprio(0); } while (0)
#define PG8_WAIT_V(n) asm volatile("s_waitcnt vmcnt(" #n ")" ::: "memory")
#define PG8_WAIT_L(n) asm volatile("s_waitcnt lgkmcnt(" #n ")" ::: "memory")
#define PG8_BAR __builtin_amdgcn_s_barrier()
#define PG8_SCHED __builtin_amdgcn_sched_barrier(0)
    Unit cur, nxt; int ui = 0;
    if (!S.next(0, cur)) return;
    f32x4 acc[2][2][4][2];
#pragma unroll
    for (int a = 0; a < 2; ++a)
#pragma unroll
        for (int b = 0; b < 2; ++b)
#pragma unroll
            for (int m = 0; m < 4; ++m)
#pragma unroll
                for (int n = 0; n < 2; ++n) acc[a][b][m][n] = (f32x4){0.f, 0.f, 0.f, 0.f};
    int scw_ = W8_E8M0, sca_ = A8_E8M0; if constexpr (FP8) sca_ = Epi::A_E8M0;
    i32x8_ At[4], B0[2], B1[2];
    unsigned vA[2][2], vAn[2][2];
    PG8_SETOFF(vA, cur);
    const char* cA = cur.a; const char* cB = cur.b;
    PG8_STAGE_B(PG8_SB(0, 0), cB); PG8_STAGE_B(PG8_SB(0, 1), cB + hstepB); PG8_STAGE_A(PG8_SA(0, 0), cA, vA, 0); PG8_STAGE_A(PG8_SA(0, 1), cA, vA, 1);
    if (wr == 1) PG8_BAR;
    PG8_WAIT_V(2); PG8_BAR;
    PG8_STAGE_B(PG8_SB(1, 0), cB + kstep); PG8_STAGE_A(PG8_SA(1, 0), cA + kstep, vA, 0); PG8_STAGE_B(PG8_SB(1, 1), cB + hstepB + kstep);
    PG8_WAIT_V(6); PG8_BAR;
    for (;;) {
        const bool has_next = S.next(ui + 1, nxt);
        if constexpr (GATHER) {
            if (has_next) {
#pragma unroll
                for (int h = 0; h < 2; ++h)
#pragma unroll
                    for (int i = 0; i < 2; ++i) vAn[h][i] = S.gather_raw(nxt, h * 128 + Rr[i]);
            }
        }
        const char* nA = has_next ? nxt.a : cA; const char* nB = has_next ? nxt.b : cB;
#pragma unroll 1
        for (int t = 0; t < nt; t += 2) {
            const bool last = (t == nt - 2);
            const char* a1 = cA + (size_t)(t + 1) * kstep;
            const char* a2 = last ? nA : cA + (size_t)(t + 2) * kstep; const char* b2 = last ? nB : cB + (size_t)(t + 2) * kstep;
            const char* a3 = a2 + kstep; const char* b3 = b2 + kstep;
            unsigned v2[2][2];
#pragma unroll
            for (int h = 0; h < 2; ++h)
#pragma unroll
                for (int i = 0; i < 2; ++i) v2[h][i] = vA[h][i];
            if constexpr (GATHER) {
                if (last && has_next) {
#pragma unroll
                    for (int h = 0; h < 2; ++h)
#pragma unroll
                        for (int i = 0; i < 2; ++i) { vAn[h][i] = vAn[h][i] * (unsigned)(lda * 2) + (unsigned)Cc[i] * 2u; v2[h][i] = vAn[h][i]; }
                }
            }
            PG8_LDB(B0, 0, 0); PG8_LDB(B1, 0, 1); PG8_SCHED; PG8_LDA(At, 0, 0); PG8_STAGE_A(PG8_SA(1, 1), a1, vA, 1);
            PG8_WAIT_V(8); PG8_WAIT_L(0); PG8_BAR; PG8_MMA(0, 0, At, B0); PG8_MMA(0, 1, At, B1); PG8_BAR; PG8_SCHED;
            PG8_LDA(At, 0, 1); PG8_STAGE_B(PG8_SB(0, 0), b2); PG8_STAGE_B(PG8_SB(0, 1), b2 + hstepB); PG8_STAGE_A(PG8_SA(0, 0), a2, v2, 0);
            PG8_WAIT_V(8); PG8_WAIT_L(0); PG8_BAR; PG8_MMA(1, 0, At, B0); PG8_MMA(1, 1, At, B1); PG8_BAR; PG8_SCHED;
            PG8_LDB(B0, 1, 0); PG8_LDB(B1, 1, 1); PG8_SCHED; PG8_LDA(At, 1, 0); PG8_STAGE_A(PG8_SA(0, 1), a2, v2, 1);
            PG8_WAIT_V(8); PG8_WAIT_L(0); PG8_BAR; PG8_MMA(0, 0, At, B0); PG8_MMA(0, 1, At, B1); PG8_BAR; PG8_SCHED;
            PG8_LDA(At, 1, 1); PG8_STAGE_B(PG8_SB(1, 0), b3); PG8_STAGE_B(PG8_SB(1, 1), b3 + hstepB); PG8_STAGE_A(PG8_SA(1, 0), a3, v2, 0);
            PG8_WAIT_V(8); PG8_WAIT_L(0); PG8_BAR; PG8_MMA(1, 0, At, B0); PG8_MMA(1, 1, At, B1); PG8_BAR; PG8_SCHED;
        }
        if (wr == 0) PG8_BAR;
        if constexpr (FP8) asm volatile("s_nop 15\n\ts_nop 15" ::: "memory");
        if constexpr (!Epi::AFTER_DRAIN) { int fr_ = fr, fq_ = fq; asm volatile("" : "+v"(fr_), "+v"(fq_)); E(acc, cur, wr, wc, fr_, fq_); }
        if (!has_next) break;
#pragma unroll
        for (int a = 0; a < 2; ++a)
#pragma unroll
            for (int b = 0; b < 2; ++b)
#pragma unroll
                for (int m = 0; m < 4; ++m)
#pragma unroll
                    for (int n = 0; n < 2; ++n) acc[a][b][m][n] = (f32x4){0.f, 0.f, 0.f, 0.f};
        cur = nxt; cA = nA; cB = nB; ++ui;
        if constexpr (GATHER) {
#pragma unroll
            for (int h = 0; h < 2; ++h)
#pragma unroll
                for (int i = 0; i < 2; ++i) vA[h][i] = vAn[h][i];
        }
        if (wr == 1) PG8_BAR;
    }
    PG8_WAIT_V(0);
    PG8_BAR;
    if constexpr (Epi::AFTER_DRAIN) { int fr_ = fr, fq_ = fq; asm volatile("" : "+v"(fr_), "+v"(fq_)); E.fused(acc, cur, wr, wc, fr_, fq_, lds, wid, lane); }
#undef PG8_SA
#undef PG8_SB
#undef PG8_STAGE_A
#undef PG8_STAGE_B
#undef PG8_SETOFF
#undef PG8_LDA
#undef PG8_LDB
#undef PG8_MMA
#undef PG8_H0
#undef PG8_H1
#undef PG8_WAIT_V
#undef PG8_WAIT_L
#undef PG8_BAR
#undef PG8_SCHED
}
}
using pg8::Unit;
typedef f32x4 AccT[2][2][4][2];

struct SchedGrid {
    const char* A; const char* B; int lda, K, nN, nwg, G, c;
    DI bool next(int i, Unit& u) const {
        const int L = i * G + c; if (L >= nwg) return false;
        u.pm = L / nN; u.pn = L % nN; u.e = 0; u.ml = 0;
        u.a = A + (size_t)u.pm * 256 * lda * 2; u.b = B + (size_t)u.pn * 256 * K * 2; return true;
    }
    DI unsigned gather_off(const Unit&, int) const { return 0u; }
    DI unsigned gather_raw(const Unit&, int) const { return 0u; }
};
struct SchedCmp {
    const char* KCMP; const char* VCMP; const char* W; int G, c;
    DI bool next(int i, Unit& u) const {
        const int L = i * G + c; if (L >= 32) return false;
        const int kv = L >> 4, bg = L & 15;
        u.pm = L; u.pn = 0; u.e = kv; u.ml = 0;
        u.a = (kv ? VCMP : KCMP) + (size_t)bg * SP * 64 * 2; u.b = W + (size_t)kv * 256 * 2048 * 2; return true;
    }
    DI unsigned gather_off(const Unit&, int) const { return 0u; }
    DI unsigned gather_raw(const Unit&, int) const { return 0u; }
};
struct SchedMla {
    const char* CQ; const char* MISC; const char* WQ; const char* WKV; int G, c;
    DI bool next(int i, Unit& u) const {
        const int L = i * G + c; if (L >= 512) return false;
        const int which = L >> 8, r = L & 255;
        u.pm = r >> 1; u.pn = r & 1; u.e = which; u.ml = 0;
        u.a = (which ? MISC : CQ) + (size_t)u.pm * 256 * 256 * 2; u.b = (which ? WKV : WQ) + (size_t)u.pn * 256 * 256 * 2; return true;
    }
    DI unsigned gather_off(const Unit&, int) const { return 0u; }
    DI unsigned gather_raw(const Unit&, int) const { return 0u; }
};
template <int NT, bool GATHERED>
struct SchedMoe {
    const LAS int* tb; const LAS int* cnt; const char* A; const char* W; const int* IDX; int total, G, c;
    DI bool next(int i, Unit& u) const {
        const int L = i * G + c; if (L >= total) return false;
        const int mtg = L / NT; u.pn = L % NT;
        const int ln_ = threadIdx.x & 63;
        const int e = __popcll(__ballot(ln_ < 32 && tb[ln_ & 31] <= mtg)) - 1;
        u.e = e; u.ml = mtg - tb[e]; u.pm = mtg;
        u.a = GATHERED ? A : A + (size_t)mtg * 256 * 1024 * 2;
        u.b = W + ((size_t)e * NT * 256 + (size_t)u.pn * 256) * 1024 * 2; return true;
    }
    DI unsigned gather_off(const Unit& u, int row) const {
        const int pos = u.ml * 256 + row; const int tok = (pos < cnt[u.e]) ? IDX[u.e * ECAP + pos] : 0;
        return (unsigned)tok * 2048u;
    }
    DI unsigned gather_raw(const Unit& u, int row) const {
        const int pos = u.ml * 256 + row;
        return (unsigned)IDX[u.e * ECAP + (pos < cnt[u.e] ? pos : 0)];
    }
};

struct SchedMoe1F8 {
    static constexpr bool HOOK = false;
    const LAS int* tb; const LAS int* cnt; const char* A; const char* W; const int* IDX; int total, G, c;
    DI bool next(int i, Unit& u) const {
        const int L = i * G + c; if (L >= total) return false;
        const int mtg = L >> 3; u.pn = L & 7;
        const int ln_ = lane_id();
        const int e = __popcll(__ballot(ln_ < 32 && tb[ln_ & 31] <= mtg)) - 1;
        u.e = e; u.ml = mtg - tb[e]; u.pm = mtg;
        u.a = A; u.b = W + ((size_t)e * 2048 + (size_t)u.pn * 256) * 1024; return true;
    }
    DI unsigned gather_raw(const Unit& u, int row) const { const int pos = u.ml * 256 + row; return (unsigned)IDX[u.e * ECAP + (pos < cnt[u.e] ? pos : 0)]; }
    DI unsigned gather_off(const Unit& u, int row) const { return gather_raw(u, row) * 1024u; }
};
struct SchedMoe2F8 {
    static constexpr bool HOOK = false;
    const LAS int* tb; const char* A; const char* W; int total, G, c;
    DI bool next(int i, Unit& u) const {
        const int L = i * G + c; if (L >= total) return false;
        const int mtg = L >> 2; u.pn = L & 3;
        const int ln_ = lane_id();
        const int e = __popcll(__ballot(ln_ < 32 && tb[ln_ & 31] <= mtg)) - 1;
        u.e = e; u.ml = mtg - tb[e]; u.pm = mtg;
        u.a = A + (size_t)mtg * 256 * 1024; u.b = W + ((size_t)e * 1024 + (size_t)u.pn * 256) * 1024; return true;
    }
    DI unsigned gather_off(const Unit&, int) const { return 0u; }
    DI unsigned gather_raw(const Unit&, int) const { return 0u; }
};

DI void rot4(f32x4& v0, f32x4& v1, const f32x4 c, const f32x4 s) {
    const float a0 = v0[0], b0 = v0[1], a1 = v0[2], b1 = v0[3], a2 = v1[0], b2 = v1[1], a3 = v1[2], b3 = v1[3];
    v0[0] = a0 * c[0] - b0 * s[0]; v0[1] = b0 * c[0] + a0 * s[0];
    v0[2] = a1 * c[1] - b1 * s[1]; v0[3] = b1 * c[1] + a1 * s[1];
    v1[0] = a2 * c[2] - b2 * s[2]; v1[1] = b2 * c[2] + a2 * s[2];
    v1[2] = a3 * c[3] - b3 * s[3]; v1[3] = b3 * c[3] + a3 * s[3];
}
DI u32x4 pack8(const f32x4 v0, const f32x4 v1) { u32x4 w; w.x = pk2(v0[0], v0[1]); w.y = pk2(v0[2], v0[3]); w.z = pk2(v1[0], v1[1]); w.w = pk2(v1[2], v1[3]); return w; }

struct EpiWin {
    static constexpr bool PERM = true, AFTER_DRAIN = false;
    unsigned char* ws; const float* CS64; const float* CS32;
    DI void operator()(const AccT& acc, const Unit& u, int wr, int wc, int fr, int fq) const {
#pragma unroll
        for (int bj = 0; bj < 2; ++bj) {
            const int w0 = bj * 128 + wc * 32;
            size_t off; int ld, dcol, mode = 0, gm = 0, g = 0; float sc = 1.f;
            switch (u.pn) {
                case 0: off = WS_QA; ld = 256; dcol = w0; mode = 1; sc = SCL64; break;
                case 1: off = WS_KA; ld = 256; dcol = w0; mode = 1; break;
                case 2: off = WS_VA; ld = 256; dcol = w0; break;
                case 3: off = WS_QB; ld = 512; dcol = w0; mode = 1; sc = SCL64; break;
                case 4: off = WS_QB; ld = 512; dcol = 256 + w0; mode = 1; sc = SCL64; break;
                case 5: off = (w0 < 128) ? WS_KCMP : WS_VCMP; ld = 64; gm = 1; g = (w0 & 127) >> 6; dcol = w0 & 63; break;
                case 6: off = (w0 < 128) ? WS_KSLC : WS_VSLC; ld = 128; dcol = w0 & 127; mode = (w0 < 128) ? 1 : 0; break;
                case 7: off = (w0 < 128) ? WS_KWIN : WS_VWIN; ld = 128; dcol = w0 & 127; mode = (w0 < 128) ? 1 : 0; break;
                case 8: off = WS_CQ; ld = 256; dcol = w0; break;
                default: if (w0 == 128) { off = WS_KR; ld = 32; dcol = 0; mode = 2; } else { off = WS_MISC; ld = 256; dcol = w0; } break;
            }
            bf16* base = (bf16*)(ws + off);
            const int i0 = 16 * (wc & 1) + 4 * fq;
#pragma unroll
            for (int ai = 0; ai < 2; ++ai) {
                f32x4 cc[4], sn[4];
                if (mode) {
#pragma unroll
                    for (int m = 0; m < 4; ++m) {
                        const int row = u.pm * 256 + ai * 128 + wr * 64 + m * 16 + fr;
                        const float* cs = (mode == 1) ? CS64 + (size_t)row * 64 + i0 : CS32 + (size_t)row * 32 + 4 * fq;
                        cc[m] = *(const f32x4*)cs; sn[m] = *(const f32x4*)(cs + (mode == 1 ? 32 : 16));
                    }
                }
#pragma unroll
                for (int m = 0; m < 4; ++m) {
                    const int row = u.pm * 256 + ai * 128 + wr * 64 + m * 16 + fr;
                    f32x4 v0 = acc[ai][bj][m][0], v1 = acc[ai][bj][m][1];
                    if (mode) rot4(v0, v1, cc[m], sn[m]);
                    v0 = v0 * sc; v1 = v1 * sc;
                    const size_t drow = gm ? (size_t)(((row >> 12) * 2 + g) * SP + (row & 4095)) : (size_t)row;
                    *(u32x4*)(base + drow * ld + dcol + 8 * fq) = pack8(v0, v1);
                }
            }
        }
    }
};
struct EpiCmp {
    static constexpr bool PERM = true, AFTER_DRAIN = true;
    const float* B1P; const bf16* W2T; const float *B2K, *B2V; bf16 *KC, *VC; const float* CS64;
    DI void fused(const AccT& acc, const Unit& u, int wr, int wc, int fr, int fq, LAS unsigned char* lds, int wid, int lane) const {
        constexpr int HST = 528;
        const int kv = u.e, bg = u.pm & 15;
#pragma unroll
        for (int bj = 0; bj < 2; ++bj) {
            const int col = bj * 128 + wc * 32 + 8 * fq;
            const f32x4 b0 = *(const f32x4*)(B1P + kv * 256 + col), b1 = *(const f32x4*)(B1P + kv * 256 + col + 4);
#pragma unroll
            for (int ai = 0; ai < 2; ++ai)
#pragma unroll
                for (int m = 0; m < 4; ++m) {
                    const int rl = ai * 128 + wr * 64 + m * 16 + fr;
                    f32x4 v0 = acc[ai][bj][m][0] + b0, v1 = acc[ai][bj][m][1] + b1;
#pragma unroll
                    for (int j = 0; j < 4; ++j) {
                        float x = v0[j]; float z = 0.7978845608028654f * (x + 0.044715f * x * x * x); v0[j] = x * sigmoidf_(2.f * z);
                        x = v1[j]; z = 0.7978845608028654f * (x + 0.044715f * x * x * x); v1[j] = x * sigmoidf_(2.f * z);
                    }
                    *(LAS u32x4*)(lds + rl * HST + col * 2) = pack8(v0, v1);
                }
        }
        asm volatile("s_waitcnt lgkmcnt(0)\n\ts_barrier" ::: "memory");
        const int r32 = lane & 31, hh = lane >> 5;
        f32x16 out0 = {0.f, 0.f, 0.f, 0.f, 0.f, 0.f, 0.f, 0.f, 0.f, 0.f, 0.f, 0.f, 0.f, 0.f, 0.f, 0.f}, out1 = out0;
        const bf16* w2 = W2T + (size_t)kv * 64 * 256;
#pragma unroll 4
        for (int ks = 0; ks < 16; ++ks) {
            const bf16x8 a = *(const LAS bf16x8*)(lds + (32 * wid + r32) * HST + (16 * ks + 8 * hh) * 2);
            const bf16x8 bq0 = *(const bf16x8*)(w2 + (size_t)r32 * 256 + 16 * ks + 8 * hh), bq1 = *(const bf16x8*)(w2 + (size_t)(32 + r32) * 256 + 16 * ks + 8 * hh);
            out0 = __builtin_amdgcn_mfma_f32_32x32x16_bf16(a, bq0, out0, 0, 0, 0); out1 = __builtin_amdgcn_mfma_f32_32x32x16_bf16(a, bq1, out1, 0, 0, 0);
        }
        const float* b2 = kv ? B2V : B2K;
        const float bb0 = b2[r32], bb1 = b2[32 + r32];
        const int b = bg >> 1;
#pragma unroll
        for (int i = 0; i < 16; ++i) {
            const int c = 32 * wid + 8 * (i >> 2) + 4 * hh + (i & 3);
            const size_t row = (size_t)bg * 256 + c;
            float x1 = out0[i] + bb0, x2 = out1[i] + bb1;
            if (c == 255) { x1 = 0.f; x2 = 0.f; }
            if (kv == 0) {
                const int tokr = (b * S + 16 * c + 31) & (T - 1);
                const float cs = CS64[(size_t)tokr * 64 + r32], sn = CS64[(size_t)tokr * 64 + 32 + r32];
                *(unsigned*)(KC + row * 64 + 2 * r32) = pk2(x1 * cs - x2 * sn, x2 * cs + x1 * sn);
            } else {
                VC[row * 64 + r32] = (bf16)(pk2(x1, 0.f) & 0xffffu); VC[row * 64 + 32 + r32] = (bf16)(pk2(x2, 0.f) & 0xffffu);
            }
        }
    }
};
struct EpiMla {
    static constexpr bool PERM = true, AFTER_DRAIN = false;
    bf16 *QM, *KN, *VM; const bf16 *CQ, *MISC; const float* CS32;
    DI void operator()(const AccT& acc, const Unit& u, int wr, int wc, int fr, int fq) const {
        float rstd[2][4];
#pragma unroll
        for (int ai = 0; ai < 2; ++ai)
#pragma unroll
            for (int m = 0; m < 4; ++m) {
                const int row = u.pm * 256 + ai * 128 + wr * 64 + m * 16 + fr;
                float ss = 0.f;
                if (u.e == 0) {
#pragma unroll
                    for (int c = 0; c < 8; ++c) { const u32x4 w = *(const u32x4*)(CQ + (size_t)row * 256 + fq * 64 + 8 * c);
                        ss += bflo(w.x) * bflo(w.x) + bfhi(w.x) * bfhi(w.x) + bflo(w.y) * bflo(w.y) + bfhi(w.y) * bfhi(w.y) + bflo(w.z) * bflo(w.z) + bfhi(w.z) * bfhi(w.z) + bflo(w.w) * bflo(w.w) + bfhi(w.w) * bfhi(w.w); }
                } else {
#pragma unroll
                    for (int c = 0; c < 4; ++c) { const u32x4 w = *(const u32x4*)(MISC + (size_t)row * 256 + fq * 32 + 8 * c);
                        ss += bflo(w.x) * bflo(w.x) + bfhi(w.x) * bfhi(w.x) + bflo(w.y) * bflo(w.y) + bfhi(w.y) * bfhi(w.y) + bflo(w.z) * bflo(w.z) + bfhi(w.z) * bfhi(w.z) + bflo(w.w) * bflo(w.w) + bfhi(w.w) * bfhi(w.w); }
                }
                ss += __shfl_xor(ss, 16); ss += __shfl_xor(ss, 32);
                rstd[ai][m] = rsqrtf(ss * (u.e == 0 ? (1.0f / 256.0f) : (1.0f / 128.0f)) + EPS);
            }
#pragma unroll
        for (int bj = 0; bj < 2; ++bj) {
            const int gc = u.pn * 256 + bj * 128 + wc * 32;
            bf16* base; int ld, dcol, rope = 0; float sc = 1.f;
            if (u.e == 0) { if (gc >= 384) continue; rope = ((gc >> 5) % 3) == 2; base = QM; ld = 384; dcol = gc; sc = SCL96; }
            else { const int head = gc >> 7, part = (gc & 127) >> 6, o = gc & 63; base = part ? VM : KN; ld = 256; dcol = head * 64 + o; }
#pragma unroll
            for (int ai = 0; ai < 2; ++ai) {
                f32x4 cc[4], sn[4];
                if (rope) {
#pragma unroll
                    for (int m = 0; m < 4; ++m) { const float* cs = CS32 + (size_t)(u.pm * 256 + ai * 128 + wr * 64 + m * 16 + fr) * 32 + 4 * fq; cc[m] = *(const f32x4*)cs; sn[m] = *(const f32x4*)(cs + 16); }
                }
#pragma unroll
                for (int m = 0; m < 4; ++m) {
                    const int row = u.pm * 256 + ai * 128 + wr * 64 + m * 16 + fr;
                    const float r = rstd[ai][m] * sc;
                    f32x4 v0 = acc[ai][bj][m][0] * r, v1 = acc[ai][bj][m][1] * r;
                    if (rope) rot4(v0, v1, cc[m], sn[m]);
                    *(u32x4*)(base + (size_t)row * ld + dcol + 8 * fq) = pack8(v0, v1);
                }
            }
        }
    }
};
struct EpiWout {
    static constexpr bool PERM = false, AFTER_DRAIN = false;
    bf16* X; const float* GT; size_t dofs;
    DI void operator()(const AccT& acc, const Unit& u, int wr, int wc, int fr, int fq) const {
        const int b = (u.pm * 256) >> 12;
        const int col0 = u.pn * 256 + wc * 32 + 4 * fq;
#pragma unroll
        for (int bj = 0; bj < 2; ++bj) {
#pragma unroll
            for (int n = 0; n < 2; ++n) {
                u32x2 xo[2][4];
                const f32x4 gt = *(const f32x4*)(GT + (size_t)b * 6144 + col0 + bj * 128 + n * 16);
#pragma unroll
                for (int ai = 0; ai < 2; ++ai)
#pragma unroll
                    for (int m = 0; m < 4; ++m) xo[ai][m] = *(const u32x2*)(X + (size_t)(u.pm * 256 + ai * 128 + wr * 64 + m * 16 + fr) * 1024 + col0 + bj * 128 + n * 16);
#pragma unroll
                for (int ai = 0; ai < 2; ++ai)
#pragma unroll
                    for (int m = 0; m < 4; ++m) {
                        bf16* p = X + (size_t)(u.pm * 256 + ai * 128 + wr * 64 + m * 16 + fr) * 1024 + col0 + bj * 128 + n * 16;
                        const f32x4 xv = (f32x4){bflo(xo[ai][m].x), bfhi(xo[ai][m].x), bflo(xo[ai][m].y), bfhi(xo[ai][m].y)} + gt * acc[ai][bj][m][n];
                        u32x2 w; w.x = pk2(xv[0], xv[1]); w.y = pk2(xv[2], xv[3]);
                        *(u32x2*)((char*)p + dofs) = w;
                    }
            }
        }
    }
};
struct EpiMoe1 {
    static constexpr bool PERM = true, AFTER_DRAIN = false; static constexpr int A_E8M0 = H8_E8M0;
    bf16* ACT; const float* B1;
    DI void operator()(const AccT& acc, const Unit& u, int wr, int wc, int fr, int fq) const {
#pragma unroll
        for (int bj = 0; bj < 2; ++bj) {
            const int col = u.pn * 256 + bj * 128 + wc * 32 + 8 * fq;
            const f32x4 b0 = *(const f32x4*)(B1 + (size_t)u.e * 2048 + col), b1 = *(const f32x4*)(B1 + (size_t)u.e * 2048 + col + 4);
#pragma unroll
            for (int ai = 0; ai < 2; ++ai)
#pragma unroll
                for (int m = 0; m < 4; ++m) {
                    const int row = u.pm * 256 + ai * 128 + wr * 64 + m * 16 + fr;
                    const f32x4 v0 = acc[ai][bj][m][0] + b0, v1 = acc[ai][bj][m][1] + b1;
                    float o[4];
#pragma unroll
                    for (int j = 0; j < 4; ++j) {
                        const float gl = fminf((j < 2) ? v0[2 * j] : v1[2 * j - 4], 7.0f);
                        const float li = fminf(fmaxf((j < 2) ? v0[2 * j + 1] : v1[2 * j - 3], -7.0f), 7.0f);
                        o[j] = gl * sigmoidf_(1.702f * gl) * (li + 1.0f);
                    }
                    *(unsigned*)((unsigned char*)ACT + (size_t)row * 1024 + (col >> 1)) = pk4_fp8s(o[0], o[1], o[2], o[3], A8_SCALE);
                }
        }
    }
};
struct EpiMoe2 {
    static constexpr bool PERM = true, AFTER_DRAIN = false; static constexpr int A_E8M0 = A8_E8M0;
    unsigned char* Y2; const float* B2; const float* GATEW;
    DI void operator()(const AccT& acc, const Unit& u, int wr, int wc, int fr, int fq) const {
        float gwv[2][4];
#pragma unroll
        for (int ai = 0; ai < 2; ++ai)
#pragma unroll
            for (int m = 0; m < 4; ++m) gwv[ai][m] = GATEW[(size_t)u.e * ECAP + u.ml * 256 + ai * 128 + wr * 64 + m * 16 + fr];
        f32x4 bb[2][2];
#pragma unroll
        for (int bj = 0; bj < 2; ++bj) { const int col = u.pn * 256 + bj * 128 + wc * 32 + 8 * fq; bb[bj][0] = *(const f32x4*)(B2 + (size_t)u.e * 1024 + col); bb[bj][1] = *(const f32x4*)(B2 + (size_t)u.e * 1024 + col + 4); }
#pragma unroll
        for (int ai = 0; ai < 2; ++ai)
#pragma unroll
            for (int m = 0; m < 4; ++m) {
                const int rl = ai * 128 + wr * 64 + m * 16 + fr;
                const float gw = gwv[ai][m];
                const size_t row = (size_t)u.pm * 256 + rl;
#pragma unroll
                for (int bj = 0; bj < 2; ++bj) {
                    const int col = u.pn * 256 + bj * 128 + wc * 32 + 8 * fq;
                    const f32x4 v0 = (acc[ai][bj][m][0] + bb[bj][0]) * gw, v1 = (acc[ai][bj][m][1] + bb[bj][1]) * gw;
                    { u32x2 w8; w8.x = pk4_fp8(v0[0], v0[1], v0[2], v0[3]); w8.y = pk4_fp8(v1[0], v1[1], v1[2], v1[3]); *(u32x2*)(Y2 + row * 1024 + col) = w8; }
                }
            }
    }
};

#define MFMA32(a, b, c) __builtin_amdgcn_mfma_f32_32x32x16_bf16((a), (b), (c), 0, 0, 0)
typedef short v4i16_t __attribute__((ext_vector_type(4)));
DI s16x4 tr_read(const LAS unsigned char* p) { return __builtin_bit_cast(s16x4, __builtin_amdgcn_ds_read_tr16_b64_v4i16((LAS v4i16_t*)p)); }
constexpr int VST = 144;
template <int DQ> struct AC { static constexpr int KST = DQ * 2 + 16, KS = DQ / 16, KBUF = 64 * KST, VBUF = 64 * VST, BUF = KBUF + VBUF; };

template <int DQ>
DI void qk_tile(const LAS unsigned char* kb, const bf16x8 (&qf)[DQ / 16], f32x16 (&s)[2], const f32x16& cinit, int lane) {
    const int r32 = lane & 31, hh = lane >> 5;
    bf16x8 kf[2][DQ / 16];
#pragma unroll
    for (int rt = 0; rt < 2; ++rt)
#pragma unroll
        for (int ks = 0; ks < DQ / 16; ++ks) kf[rt][ks] = *(const LAS bf16x8*)(kb + (32 * rt + r32) * AC<DQ>::KST + (16 * ks + 8 * hh) * 2);
    f32x16 a0 = MFMA32(kf[0][0], qf[0], cinit), a1 = MFMA32(kf[1][0], qf[0], cinit);
#pragma unroll
    for (int ks = 1; ks < DQ / 16; ++ks) { a0 = MFMA32(kf[0][ks], qf[ks], a0); a1 = MFMA32(kf[1][ks], qf[ks], a1); }
    s[0] = a0; s[1] = a1;
}
DI float max3f_(float a, float b, float c) { return __builtin_fmaxf(__builtin_fmaxf(a, b), c); }
constexpr float RESC_THR = 8.0f;
template <int DQ, int KMUL, int VAR = 0>
DI void attn_tile(const LAS unsigned char* kb, const LAS unsigned char* vb, const bf16x8 (&qf)[DQ / 16], f32x16 (&o)[2], f32x16& negm, float& m, float& l,
                  int dq, unsigned maxd, bool lf, int lane, const bool MASKED) {
    const int hh = lane >> 5;
    if (VAR == 1) return;
    f32x16 s[2];
    qk_tile<DQ>(kb, qf, s, negm, lane);
    if (VAR == 2) { o[0] += s[0]; o[1] += s[1]; return; }
    const int i16 = lane & 15, q = i16 >> 2, p_ = i16 & 3, mh = (lane >> 4) & 1;
    const LAS unsigned char* vbase = vb + (4 * hh + q) * VST + 32 * mh + 8 * p_;
    s16x4 vlo[4][2], vhi[4][2];
#pragma unroll
    for (int st = 0; st < 4; ++st)
#pragma unroll
        for (int mt = 0; mt < 2; ++mt) { vlo[st][mt] = tr_read(vbase + (16 * st) * VST + 64 * mt); vhi[st][mt] = tr_read(vbase + (16 * st + 8) * VST + 64 * mt); }
    __builtin_amdgcn_sched_barrier(0);
    if (MASKED) {
#pragma unroll
        for (int rt = 0; rt < 2; ++rt)
#pragma unroll
            for (int i = 0; i < 16; ++i) {
                const int d = dq - (32 * rt + 8 * (i >> 2) + (i & 3)) * KMUL;
                s[rt][i] = ((unsigned)d <= maxd) ? s[rt][i] : -1e30f;
            }
    }
    float mx = max3f_(s[0][0], s[0][1], s[0][2]);
#pragma unroll
    for (int i = 3; i < 15; i += 2) mx = max3f_(mx, s[0][i], s[0][i + 1]);
    mx = max3f_(mx, s[0][15], s[1][0]);
#pragma unroll
    for (int i = 1; i < 15; i += 2) mx = max3f_(mx, s[1][i], s[1][i + 1]);
    mx = fmaxf(mx, s[1][15]);
    if (__ballot(lf && mx > RESC_THR) != 0ull) {
        float mc = lf ? mx : -1e30f;
        mc = fmaxf(mc, __shfl_xor(mc, 32));
        const float delta = mc > RESC_THR ? mc : 0.f;
        const float alpha = fast_exp2(-delta);
        m += delta; l *= alpha;
#pragma unroll
        for (int i = 0; i < 16; ++i) { negm[i] = -m; o[0][i] *= alpha; o[1][i] *= alpha; s[0][i] -= delta; s[1][i] -= delta; }
    }
    float ps = 0.f;
#pragma unroll
    for (int rt = 0; rt < 2; ++rt)
#pragma unroll
        for (int i = 0; i < 16; ++i) { const float p = fast_exp2(s[rt][i]); s[rt][i] = p; ps += p; }
    const unsigned lmask = lf ? 0xffffffffu : 0u;
    l += lf ? ps : 0.f;
    if (VAR == 3) { o[0] += s[0]; o[1] += s[1]; return; }
#pragma unroll
    for (int rt = 0; rt < 2; ++rt)
#pragma unroll
        for (int s2 = 0; s2 < 2; ++s2) {
            u32x4 pw; pw.x = pk2(s[rt][8 * s2 + 0], s[rt][8 * s2 + 1]) & lmask; pw.y = pk2(s[rt][8 * s2 + 2], s[rt][8 * s2 + 3]) & lmask;
            pw.z = pk2(s[rt][8 * s2 + 4], s[rt][8 * s2 + 5]) & lmask; pw.w = pk2(s[rt][8 * s2 + 6], s[rt][8 * s2 + 7]) & lmask;
            const bf16x8 pb = __builtin_bit_cast(bf16x8, pw);
#pragma unroll
            for (int mt = 0; mt < 2; ++mt) {
                const bf16x8 va = __builtin_shufflevector(vlo[2 * rt + s2][mt], vhi[2 * rt + s2][mt], 0, 1, 2, 3, 4, 5, 6, 7);
                o[mt] = MFMA32(va, pb, o[mt]);
            }
        }
}
constexpr int OSTAGE_WAVE = 32 * 144;
static_assert(102400 + 8 * OSTAGE_WAVE <= MISC_OFF, "O stage below the LDS control words");
template <class P>
DI void store_o_rows(const P& p, LAS unsigned char* lds, int off, const f32x16 (&o)[2], float inv, int lane, int wave) {
    LAS unsigned char* st = lds + off + wave * OSTAGE_WAVE;
    const int n = lane & 31, hh = lane >> 5;
#pragma unroll
    for (int mt = 0; mt < 2; ++mt)
#pragma unroll
        for (int a = 0; a < 4; ++a) {
            u32x2 w; w.x = pk2(o[mt][4 * a] * inv, o[mt][4 * a + 1] * inv); w.y = pk2(o[mt][4 * a + 2] * inv, o[mt][4 * a + 3] * inv);
            *(LAS u32x2*)(st + n * 144 + (32 * mt + 8 * a + 4 * hh) * 2) = w;
        }
    asm volatile("s_waitcnt lgkmcnt(0)" ::: "memory");
#pragma unroll
    for (int it = 0; it < 4; ++it) {
        const int r = (lane >> 3) + 8 * it, c = lane & 7;
        const u32x4 v = *(const LAS u32x4*)(st + r * 144 + c * 16);
        *(u32x4*)(p.orow(wave, r) + 8 * c) = v;
    }
}
DI void store_o(bf16* orow, const f32x16 (&o)[2], float inv, int lane) {
    const int hh = lane >> 5;
#pragma unroll
    for (int mt = 0; mt < 2; ++mt)
#pragma unroll
        for (int a = 0; a < 4; ++a) {
            u32x2 w; w.x = pk2(o[mt][4 * a] * inv, o[mt][4 * a + 1] * inv); w.y = pk2(o[mt][4 * a + 2] * inv, o[mt][4 * a + 3] * inv);
            *(u32x2*)(orow + 32 * mt + 8 * a + 4 * hh) = w;
        }
}

struct PolA {
    static constexpr bool HASFLAG = false, LSE = true; static constexpr int KMUL = 1;
    const bf16 *Q, *K, *V; bf16* O; float* LSEP; int b, h, d, r, c; unsigned maxd; int j0, j1;
    DI int ql(int w, int lane) const { return 256 * c + 32 * w + (lane & 31); }
    DI size_t trow(int l_) const { return (size_t)b * S + (size_t)l_ * d + r; }
    DI const bf16* qrow(int w, int lane) const { return Q + trow(ql(w, lane)) * 256 + h * 64; }
    DI int qv(int w, int lane) const { return ql(w, lane); }
    DI int qmin(int w) const { return 256 * c + 32 * w; }
    DI int qmax(int w) const { return 256 * c + 32 * w + 31; }
    DI int kv0(int j) const { return 256 * c - 128 + 64 * j; }
    DI const bf16* krow(int j, int row) const { return K + trow(kv0(j) + row) * 256 + h * 64; }
    DI const bf16* vrow(int j, int row) const { return V + trow(kv0(j) + row) * 256 + h * 64; }
    DI const bf16* rrow(int, int) const { return nullptr; }
    DI bool flag(int, int, int) const { return true; }
    DI bf16* orow(int w, int lane) const { return O + trow(ql(w, lane)) * 256 + h * 64; }
    DI void lse(int w, int lane, float v) const { LSEP[trow(ql(w, lane)) * 4 + h] = v; }
};
struct PolB {
    static constexpr bool LSE = false; static constexpr int KMUL = 1;
    const bf16 *Q, *K, *V; bf16* O; int b, g, qc; unsigned maxd; int j0, j1; u64 sel; bool hasflag;
    DI int tok(int w, int lane) const { return 64 * qc + 8 * w + ((lane & 31) >> 2); }
    DI const bf16* qrow(int w, int lane) const { return Q + ((size_t)b * S + tok(w, lane)) * 512 + (4 * g + (lane & 3)) * 64; }
    DI int qv(int w, int lane) const { return tok(w, lane); }
    DI int qmin(int w) const { return 64 * qc + 8 * w; }
    DI int qmax(int w) const { return 64 * qc + 8 * w + 7; }
    DI int kv0(int j) const { return 64 * j; }
    DI const bf16* krow(int j, int row) const { return K + ((size_t)b * S + 64 * j + row) * 128 + g * 64; }
    DI const bf16* vrow(int j, int row) const { return V + ((size_t)b * S + 64 * j + row) * 128 + g * 64; }
    DI const bf16* rrow(int, int) const { return nullptr; }
    DI bf16* orow(int w, int lane) const { return O + ((size_t)b * S + tok(w, lane)) * 512 + (4 * g + (lane & 3)) * 64; }
    DI void lse(int, int, float) const {}
};
struct PolM {
    static constexpr bool HASFLAG = false, LSE = false; static constexpr int KMUL = 1;
    const bf16 *Q, *KN, *KR, *V; bf16* O; int b, h, c; unsigned maxd; int j0, j1;
    DI int tok(int w, int lane) const { return 256 * c + 32 * w + (lane & 31); }
    DI const bf16* qrow(int w, int lane) const { return Q + ((size_t)b * S + tok(w, lane)) * 384 + h * 96; }
    DI int qv(int w, int lane) const { return tok(w, lane); }
    DI int qmin(int w) const { return 256 * c + 32 * w; }
    DI int qmax(int w) const { return 256 * c + 32 * w + 31; }
    DI int kv0(int j) const { return 64 * j; }
    DI const bf16* krow(int j, int row) const { return KN + ((size_t)b * S + 64 * j + row) * 256 + h * 64; }
    DI const bf16* vrow(int j, int row) const { return V + ((size_t)b * S + 64 * j + row) * 256 + h * 64; }
    DI const bf16* rrow(int j, int row) const { return KR + ((size_t)b * S + 64 * j + row) * 32; }
    DI bf16* orow(int w, int lane) const { return O + ((size_t)b * S + tok(w, lane)) * 256 + h * 64; }
    DI void lse(int, int, float) const {}
};

template <int DQ, class P, bool FLAG, int VAR = 0>
DI void attn_unit(const P& p, LAS unsigned char* lds, int tid, int lane, int wave, u64 sel) {
    typedef AC<DQ> C;
    const int hh = lane >> 5;
    const bf16* qrow = p.qrow(wave, lane);
    bf16x8 qf[DQ / 16];
#pragma unroll
    for (int ks = 0; ks < DQ / 16; ++ks) qf[ks] = *(const bf16x8*)(qrow + 16 * ks + 8 * hh);
#pragma unroll
    for (int ks = 0; ks < DQ / 16; ++ks) asm volatile("s_waitcnt vmcnt(0)" : "+v"(qf[ks]) :: "memory");
    const int qv = p.qv(wave, lane), wq0 = p.qmin(wave), wq1 = p.qmax(wave);
    f32x16 o[2];
#pragma unroll
    for (int mt = 0; mt < 2; ++mt)
#pragma unroll
        for (int i = 0; i < 16; ++i) o[mt][i] = 0.f;
    float m = 0.f, l = 0.f;
    f32x16 negm;
#pragma unroll
    for (int i = 0; i < 16; ++i) negm[i] = 0.f;
    const int j0 = p.j0, j1 = p.j1;
    const int lrow = tid >> 3, lch = tid & 7;
    u32x4 k0A, v0A, r0A = {0u, 0u, 0u, 0u}, k1A, v1A, r1A = {0u, 0u, 0u, 0u}, k0B, v0B, r0B = {0u, 0u, 0u, 0u}, k1B, v1B, r1B = {0u, 0u, 0u, 0u};
    constexpr int NLD = (DQ == 96) ? 6 : 4;
    const int npair = (j1 - j0 + 1) >> 1;
#define ATT_LOAD1(RK, RV, RR, j) do { const bf16* pk_ = p.krow((j), lrow) + 8 * lch; const bf16* pv_ = p.vrow((j), lrow) + 8 * lch; \
        asm volatile("global_load_dwordx4 %0, %2, off\n\tglobal_load_dwordx4 %1, %3, off" : "=&v"(RK), "=&v"(RV) : "v"(pk_), "v"(pv_) : "memory"); \
        if (DQ == 96) { const bf16* pr_ = p.rrow((j), (tid & 255) >> 2) + 8 * (tid & 3); asm volatile("global_load_dwordx4 %0, %1, off" : "=&v"(RR) : "v"(pr_) : "memory"); } } while (0)
#define ATT_LOADP(K0, V0, R0, K1, V1, R1, t) do { const int ja_ = j0 + 2 * (t), jb_ = ja_ + 1; \
        { const int jc_ = ja_ < j1 ? ja_ : j1 - 1; ATT_LOAD1(K0, V0, R0, jc_); } { const int jd_ = jb_ < j1 ? jb_ : j1 - 1; ATT_LOAD1(K1, V1, R1, jd_); } } while (0)
#define ATT_TILE(kb_, jt_) do { const int j_ = (jt_); const int kv0 = p.kv0(j_); \
        bool need = (j_ < j1) && (wq1 - kv0 >= 0) && ((long long)wq0 - (long long)(kv0 + 63 * P::KMUL) <= (long long)p.maxd); \
        const bool interior = (wq0 - (kv0 + 63 * P::KMUL) >= 0) && ((long long)wq1 - (long long)kv0 <= (long long)p.maxd); \
        bool lf = true; \
        if (FLAG) { lf = ((sel >> j_) & 1ull) != 0ull; need = need && (__ballot(lf) != 0ull); } \
        if (need) attn_tile<DQ, P::KMUL, VAR>((kb_), (kb_) + C::KBUF, qf, o, negm, m, l, qv - kv0 - 4 * hh * P::KMUL, p.maxd, lf, lane, !interior); } while (0)
#define ATT_STEP(K0, V0, R0, K1, V1, R1, tt) do { const int t_ = (tt); \
        LAS unsigned char* pbuf = lds + (t_ & 1) * (2 * C::BUF); \
        asm volatile("s_waitcnt vmcnt(%6)" : "+v"(K0), "+v"(V0), "+v"(R0), "+v"(K1), "+v"(V1), "+v"(R1) : "n"(NLD) : "memory"); \
        *(LAS u32x4*)(pbuf + lrow * C::KST + lch * 16) = K0; *(LAS u32x4*)(pbuf + C::KBUF + lrow * VST + lch * 16) = V0; \
        *(LAS u32x4*)(pbuf + C::BUF + lrow * C::KST + lch * 16) = K1; *(LAS u32x4*)(pbuf + C::BUF + C::KBUF + lrow * VST + lch * 16) = V1; \
        if (DQ == 96) { *(LAS u32x4*)(pbuf + ((tid & 255) >> 2) * C::KST + 128 + (tid & 3) * 16) = R0; *(LAS u32x4*)(pbuf + C::BUF + ((tid & 255) >> 2) * C::KST + 128 + (tid & 3) * 16) = R1; } \
        asm volatile("s_waitcnt lgkmcnt(0)\n\ts_barrier" ::: "memory"); \
        ATT_LOADP(K0, V0, R0, K1, V1, R1, t_ + 2); \
        if (ATT_STAGGER > 0 && wave >= 4) __builtin_amdgcn_s_sleep(ATT_STAGGER); \
        ATT_TILE(pbuf, j0 + 2 * t_); ATT_TILE(pbuf + C::BUF, j0 + 2 * t_ + 1); } while (0)
    ATT_LOADP(k0A, v0A, r0A, k1A, v1A, r1A, 0);
    ATT_LOADP(k0B, v0B, r0B, k1B, v1B, r1B, 1);
    if (wave >= 4) __builtin_amdgcn_s_setprio(1);
#pragma unroll 1
    for (int t = 0; t < npair; t += 2) {
        ATT_STEP(k0A, v0A, r0A, k1A, v1A, r1A, t);
        ATT_STEP(k0B, v0B, r0B, k1B, v1B, r1B, t + 1);
    }
    __builtin_amdgcn_s_setprio(0);
    asm volatile("s_waitcnt vmcnt(0)" : "+v"(k0A), "+v"(v0A), "+v"(r0A), "+v"(k1A), "+v"(v1A), "+v"(r1A), "+v"(k0B), "+v"(v0B), "+v"(r0B), "+v"(k1B), "+v"(v1B), "+v"(r1B) :: "memory");
#undef ATT_LOAD1
#undef ATT_LOADP
#undef ATT_TILE
#undef ATT_STEP
    const float lt = l + __shfl_xor(l, 32);
    const float inv = lt > 0.f ? 1.0f / lt : 0.f;
    store_o_rows(p, lds, DQ == 96 ? 102400 : 90112, o, inv, lane, wave);
    if (P::LSE) { if (hh == 0) p.lse(wave, lane, m + __log2f(lt)); }
    __syncthreads();
}

DI u64 cmp_unit(const Ctx& F, int b, int g, int qc) {
    constexpr int KST = 144;
    LAS unsigned char* KL = F.lds; LAS unsigned char* VL = F.lds + 256 * KST; LAS float* IMP = (LAS float*)(F.lds + 2 * 256 * KST);
    const bf16* KC = (const bf16*)(F.ws + WS_KC) + (size_t)(b * 2 + g) * 256 * 64;
    const bf16* VC = (const bf16*)(F.ws + WS_VC) + (size_t)(b * 2 + g) * 256 * 64;
    const int tid = F.tid, lane = F.lane, w = F.wave, hh = lane >> 5, r32 = lane & 31;
#pragma unroll
    for (int it = 0; it < 4; ++it) { const int idx = tid + 512 * it, row = idx >> 3, ch = idx & 7;
        *(LAS u32x4*)(KL + row * KST + ch * 16) = *(const u32x4*)(KC + row * 64 + ch * 8);
        *(LAS u32x4*)(VL + row * VST + ch * 16) = *(const u32x4*)(VC + row * 64 + ch * 8); }
    __syncthreads();
    const int tokl = 8 * w + (r32 >> 2), tok = 64 * qc + tokl, head = 4 * g + (lane & 3);
    const bf16* qrow = (const bf16*)(F.ws + WS_QB) + ((size_t)b * S + tok) * 512 + head * 64;
    bf16x8 qf[4];
#pragma unroll
    for (int ks = 0; ks < 4; ++ks) qf[ks] = *(const bf16x8*)(qrow + 16 * ks + 8 * hh);
    const int qv = tok - 31, wq1 = 64 * qc + 8 * w + 7 - 31;
    f32x16 o[2];
#pragma unroll
    for (int mt = 0; mt < 2; ++mt)
#pragma unroll
        for (int i = 0; i < 16; ++i) o[mt][i] = 0.f;
    float m = 0.f, l = 0.f;
    f32x16 negm;
#pragma unroll
    for (int i = 0; i < 16; ++i) negm[i] = 0.f;
    const int wq0 = 64 * qc + 8 * w - 31;
#pragma unroll 1
    for (int jt = 0; jt < 4; ++jt) {
        if (wq1 - 1024 * jt >= 0) {
            const int dq = qv - 1024 * jt - 4 * hh * 16;
            attn_tile<64, 16>(KL + jt * 64 * KST, VL + jt * 64 * VST, qf, o, negm, m, l, dq, 0x7fffffffu, true, lane, !(wq0 - (1024 * jt + 63 * 16) >= 0));
        }
    }
    const float lt = l + __shfl_xor(l, 32);
    const float inv = lt > 0.f ? 1.0f / lt : 0.f;
    { struct { bf16* O; int b, g, qc; DI bf16* orow(int w_, int n_) const { return O + ((size_t)b * S + 64 * qc + 8 * w_ + (n_ >> 2)) * 512 + (4 * g + (n_ & 3)) * 64; } } pc{(bf16*)(F.ws + WS_OCMP), b, g, qc};
      store_o_rows(pc, F.lds, 90112, o, inv, lane, w); }
    float prev = 0.f;
#pragma unroll 1
    for (int jt = 0; jt < 4; ++jt) {
        const bool need = (wq1 - 1024 * jt >= 0);
        f32x16 s[2];
        if (need) qk_tile<64>(KL + jt * 64 * KST, qf, s, negm, lane);
#pragma unroll
        for (int rt = 0; rt < 2; ++rt)
#pragma unroll
            for (int a = 0; a < 4; ++a) {
                float mainp = 0.f, sp = 0.f;
                if (need) {
                    float pb[4];
#pragma unroll
                    for (int bb = 0; bb < 4; ++bb) { const int kidx = 64 * jt + 32 * rt + 8 * a + 4 * hh + bb; const bool ok = (qv - 16 * kidx) >= 0; pb[bb] = ok ? fast_exp2(s[rt][4 * a + bb]) * inv : 0.f; }
                    mainp = pb[0] + pb[1] + pb[2] + 0.5f * pb[3]; sp = 0.5f * pb[3];
                }
                const float rc = __shfl_xor(sp, 32);
                float v = mainp + (hh ? rc : prev);
                prev = rc;
                v += __shfl_xor(v, 1); v += __shfl_xor(v, 2);
                if ((lane & 3) == 0) IMP[tokl * 64 + 2 * (8 * jt + 4 * rt + a) + hh] = v;
            }
    }
    __syncthreads();
    u64 mysel = 0ull;
#pragma unroll 1
    for (int tk = 0; tk < 8; ++tk) {
        const int tl = 8 * w + tk, t = 64 * qc + tl, j = lane;
        const float v = IMP[tl * 64 + j];
        const bool forced = (j == 0) || (j == qc) || (j == qc - 1);
        const bool valid = j <= qc;
        const float score = forced ? v + 1e4f : (valid ? v : -1.0f);
        int rank = 0;
#pragma unroll
        for (int jp = 0; jp < 64; ++jp) { const float o_ = __builtin_bit_cast(float, __builtin_amdgcn_readlane(__builtin_bit_cast(int, score), jp)); rank += ((o_ > score) || (o_ == score && jp < j)) ? 1 : 0; }
        const u64 mask = __ballot(rank < 16);
        (void)t;
        if (tk == (r32 >> 2)) mysel = mask;
    }
    __syncthreads();
    return mysel;
}

DI void moe_tables(const Ctx& F, int l) {
    LAS int* tb = (LAS int*)(F.lds + AUX_OFF); LAS int* cn = tb + 64;
    if (F.tid == 0) {
        const unsigned* C = (const unsigned*)(F.ws + WS_CTL) + CW_CNT + l * 32 * 64;
        int acc = 0;
        for (int e = 0; e < 32; ++e) { const int c = (int)__hip_atomic_load(C + e * 64, RLX_AGENT); tb[e] = acc; cn[e] = c; acc += (c + 255) >> 8; }
        tb[32] = acc;
    }
    __syncthreads();
}
template <int MODE>
DI void phase_norm1(const Ctx& F, int l) {
    const float* mods = (const float*)(F.ws + WS_MODS);
    const bf16* X = (const bf16*)(F.ws + WS_X); bf16* H = (bf16*)(F.ws + F.dofs + WS_H); bf16* XW = (bf16*)(F.ws + F.dofs + WS_X);
    const LAS int* tb = (const LAS int*)(F.lds + AUX_OFF);
    if (l > 0) moe_tables(F, l - 1);
    const int gw = F.blk * 8 + F.wave, NGW = F.G * 8, lane = F.lane;
    for (int tok = gw; tok < T; tok += NGW) {
        const int b = tok >> 12;
        f32x4 v[4];
        if (l == 0) { const float* xr = ginp(F, I_X) + (size_t)tok * 1024;
#pragma unroll
            for (int k = 0; k < 4; ++k) v[k] = *(const f32x4*)(xr + 4 * lane + 256 * k);
        } else { const bf16* xr = X + (size_t)tok * 1024;
#pragma unroll
            for (int k = 0; k < 4; ++k) { const u32x2 w = *(const u32x2*)(xr + 4 * lane + 256 * k); v[k] = (f32x4){bflo(w.x), bfhi(w.x), bflo(w.y), bfhi(w.y)}; }
        }
        if (l > 0) {
            f32x4 y[4];
#pragma unroll
            for (int k = 0; k < 4; ++k) y[k] = (f32x4){0.f, 0.f, 0.f, 0.f};
            const int* ts = (const int*)(F.ws + WS_TOKSLOT) + (size_t)tok * 4;
#pragma unroll
            for (int s = 0; s < 4; ++s) {
                const int pk = ts[s]; const int e = pk >> 16, pos = pk & 0xffff;
                const unsigned char* yr = (const unsigned char*)(F.ws + WS_Y2) + ((size_t)tb[e] * 256 + pos) * 1024;
#pragma unroll
                for (int k = 0; k < 4; ++k) { const unsigned w = *(const unsigned*)(yr + 4 * lane + 256 * k); y[k] += unpk4_fp8(w); }
            }
            const float* gt2 = mods + ((size_t)((l - 1) * 8 + b) * 6 + 5) * 1024;
#pragma unroll
            for (int k = 0; k < 4; ++k) v[k] = v[k] + *(const f32x4*)(gt2 + 4 * lane + 256 * k) * (y[k] * Y2_ISCALE);
        }
        float ss = 0.f;
#pragma unroll
        for (int k = 0; k < 4; ++k) ss += v[k][0] * v[k][0] + v[k][1] * v[k][1] + v[k][2] * v[k][2] + v[k][3] * v[k][3];
        const float rstd = rsqrtf(wave_sum(ss) * (1.0f / 1024.0f) + EPS);
        if (MODE == 0) {
            const float* g1 = ginp(F, I_G1) + (size_t)l * 1024;
            const float* sh = mods + ((size_t)(l * 8 + b) * 6 + 0) * 1024; const float* sc = sh + 1024;
#pragma unroll
            for (int k = 0; k < 4; ++k) {
                const int c = 4 * lane + 256 * k;
                { u32x2 xw; xw.x = pk2(v[k][0], v[k][1]); xw.y = pk2(v[k][2], v[k][3]); *(u32x2*)(XW + (size_t)tok * 1024 + c) = xw; }
                const f32x4 hv = v[k] * rstd * *(const f32x4*)(g1 + c) * (*(const f32x4*)(sc + c) + 1.0f) + *(const f32x4*)(sh + c);
                u32x2 w; w.x = pk2(hv[0], hv[1]); w.y = pk2(hv[2], hv[3]);
                *(u32x2*)(H + (size_t)tok * 1024 + c) = w;
            }
        } else {
            const float* gf = ginp(F, I_GF);
#pragma unroll
            for (int k = 0; k < 4; ++k) { const int c = 4 * lane + 256 * k; *(f32x4*)(gout(F) + (size_t)tok * 1024 + c) = v[k] * rstd * *(const f32x4*)(gf + c); }
        }
    }
}
DI void phase_prep(const Ctx& F) {
    const bf16* CQ = (const bf16*)(F.ws + WS_CQ); const bf16* MISC = (const bf16*)(F.ws + WS_MISC);
    float* RQ = (float*)(F.ws + WS_RSTDQ); float* RKV = (float*)(F.ws + WS_RSTDKV);
    bf16* KR = (bf16*)(F.ws + WS_KR); float* GATES = (float*)(F.ws + WS_GATES); const float* CS32 = (const float*)(F.ws + WS_CS32);
    const int gw = F.blk * 8 + F.wave, NGW = F.G * 8, lane = F.lane;
    for (int tok = gw; tok < T; tok += NGW) {
        const u32x2 wq = *(const u32x2*)(CQ + (size_t)tok * 256 + 4 * lane);
        const u32x2 wm = *(const u32x2*)(MISC + (size_t)tok * 256 + 4 * lane);
        float a0 = bflo(wq.x), a1 = bfhi(wq.x), a2 = bflo(wq.y), a3 = bfhi(wq.y);
        const float sq = wave_sum(a0 * a0 + a1 * a1 + a2 * a2 + a3 * a3);
        float m0 = bflo(wm.x), m1 = bfhi(wm.x), m2 = bflo(wm.y), m3 = bfhi(wm.y);
        const float skv = wave_sum(lane < 32 ? (m0 * m0 + m1 * m1 + m2 * m2 + m3 * m3) : 0.f);
        if (lane == 0) { RQ[tok] = rsqrtf(sq * (1.0f / 256.0f) + EPS); RKV[tok] = rsqrtf(skv * (1.0f / 128.0f) + EPS); }
        const float p0 = __shfl_xor(m0, 4), p1 = __shfl_xor(m1, 4), p2 = __shfl_xor(m2, 4), p3 = __shfl_xor(m3, 4);
        if (lane >= 32 && lane < 36) {
            const int i0 = 4 * (lane - 32);
            const f32x4 c4 = *(const f32x4*)(CS32 + (size_t)tok * 32 + i0), s4 = *(const f32x4*)(CS32 + (size_t)tok * 32 + 16 + i0);
            u32x4 w;
            w.x = pk2(m0 * c4[0] - p0 * s4[0], p0 * c4[0] + m0 * s4[0]); w.y = pk2(m1 * c4[1] - p1 * s4[1], p1 * c4[1] + m1 * s4[1]);
            w.z = pk2(m2 * c4[2] - p2 * s4[2], p2 * c4[2] + m2 * s4[2]); w.w = pk2(m3 * c4[3] - p3 * s4[3], p3 * c4[3] + m3 * s4[3]);
            *(u32x4*)(KR + (size_t)tok * 32 + 2 * i0) = w;
        }
        if (lane >= 40 && lane < 46) {
            const int gi = 4 * (lane - 40);
            *(f32x4*)(GATES + (size_t)tok * 24 + gi) = (f32x4){sigmoidf_(m0), sigmoidf_(m1), sigmoidf_(m2), sigmoidf_(m3)};
        }
    }
}
DI void phase_cmp2(const Ctx& F, int l) {
    const bf16* HID = (const bf16*)(F.ws + WS_HID);
    const float* CS64 = (const float*)(F.ws + WS_CS64);
    const int gw = F.blk * 8 + F.wave, NGW = F.G * 8, lane = F.lane;
    for (int it = gw; it < 8192; it += NGW) {
        const int kv = it >> 12, row = it & 4095, c = row & 255, bg = row >> 8;
        const float* w2 = ginp(F, kv ? I_W2V : I_W2K) + (size_t)l * 256 * 64;
        const float* b2 = ginp(F, kv ? I_B2V : I_B2K) + (size_t)l * 64;
        const u32x2 hw = *(const u32x2*)(HID + ((size_t)kv * 4096 + row) * 256 + 4 * lane);
        const float h0 = bflo(hw.x), h1 = bfhi(hw.x), h2 = bflo(hw.y), h3 = bfhi(hw.y);
        float acc = b2[lane];
#pragma unroll 4
        for (int k4 = 0; k4 < 64; ++k4) {
            const float x0 = __builtin_bit_cast(float, __builtin_amdgcn_readlane(__builtin_bit_cast(int, h0), k4));
            const float x1 = __builtin_bit_cast(float, __builtin_amdgcn_readlane(__builtin_bit_cast(int, h1), k4));
            const float x2 = __builtin_bit_cast(float, __builtin_amdgcn_readlane(__builtin_bit_cast(int, h2), k4));
            const float x3 = __builtin_bit_cast(float, __builtin_amdgcn_readlane(__builtin_bit_cast(int, h3), k4));
            acc += x0 * w2[(4 * k4 + 0) * 64 + lane] + x1 * w2[(4 * k4 + 1) * 64 + lane] + x2 * w2[(4 * k4 + 2) * 64 + lane] + x3 * w2[(4 * k4 + 3) * 64 + lane];
        }
        if (c == 255) acc = 0.f;
        if (kv == 0) {
            const int b = bg >> 1, tokr = b * S + 16 * c + 31;
            const float other = __shfl_xor(acc, 32);
            const int i = lane & 31;
            const float cs = CS64[(size_t)(tokr & (T - 1)) * 64 + i], sn = CS64[(size_t)(tokr & (T - 1)) * 64 + 32 + i];
            const float y = (lane < 32) ? (acc * cs - other * sn) : (acc * cs + other * sn);
            ((bf16*)(F.ws + WS_KC))[(size_t)row * 64 + 2 * i + (lane >> 5)] = (bf16)(pk2(y, 0.f) & 0xffffu);
        } else {
            ((bf16*)(F.ws + WS_VC))[(size_t)row * 64 + lane] = (bf16)(pk2(acc, 0.f) & 0xffffu);
        }
    }
}
DI void phase_mix(const Ctx& F, int l) {
    const bf16* OA3 = (const bf16*)(F.ws + WS_OA3); const float* LSEA = (const float*)(F.ws + WS_LSEA);
    const bf16* OCMP = (const bf16*)(F.ws + WS_OCMP); const bf16* OSLC = (const bf16*)(F.ws + WS_OSLC); const bf16* OWIN = (const bf16*)(F.ws + WS_OWIN);
    const bf16* OC = (const bf16*)(F.ws + WS_OC); const bf16* MISC = (const bf16*)(F.ws + WS_MISC);
    bf16* AMIX = (bf16*)(F.ws + WS_AMIX);
    const float* ga = ginp(F, I_GOA) + (size_t)l * 256; const float* gb = ginp(F, I_GOB) + (size_t)l * 512; const float* gc = ginp(F, I_GOC) + (size_t)l * 256;
    const int gw = F.blk * 8 + F.wave, NGW = F.G * 8, lane = F.lane, ha = lane >> 4;
    for (int tok0 = gw; tok0 < T; tok0 += 2 * NGW) {
        int tok[2]; tok[0] = tok0; tok[1] = (tok0 + NGW < T) ? tok0 + NGW : tok0;
        float ls[2][3]; u32x2 wa[2][3], wb[2][2][3], wc_[2]; float gl[2][2][3];
#pragma unroll
        for (int q = 0; q < 2; ++q) {
#pragma unroll
            for (int p = 0; p < 3; ++p) { ls[q][p] = LSEA[((size_t)p * T + tok[q]) * 4 + ha]; wa[q][p] = *(const u32x2*)(OA3 + ((size_t)p * T + tok[q]) * 256 + 4 * lane); }
#pragma unroll
            for (int k = 0; k < 2; ++k) {
                const int col = 256 * k + 4 * lane, hb = col >> 6;
                const bf16* g_ = MISC + (size_t)tok[q] * 256 + 160 + hb * 3;
                gl[q][k][0] = bf2f(g_[0]); gl[q][k][1] = bf2f(g_[1]); gl[q][k][2] = bf2f(g_[2]);
                wb[q][k][0] = *(const u32x2*)(OCMP + (size_t)tok[q] * 512 + col); wb[q][k][1] = *(const u32x2*)(OSLC + (size_t)tok[q] * 512 + col); wb[q][k][2] = *(const u32x2*)(OWIN + (size_t)tok[q] * 512 + col);
            }
            wc_[q] = *(const u32x2*)(OC + (size_t)tok[q] * 256 + 4 * lane);
        }
        f32x4 va[2], vb[2][2], vc[2]; float red[2][3];
#pragma unroll
        for (int q = 0; q < 2; ++q) {
            const float mx = fmaxf(ls[q][0], fmaxf(ls[q][1], ls[q][2]));
            const float w0 = fast_exp2(ls[q][0] - mx), w1 = fast_exp2(ls[q][1] - mx), w2 = fast_exp2(ls[q][2] - mx), wi = 1.0f / (w0 + w1 + w2);
            va[q] = ((f32x4){bflo(wa[q][0].x), bfhi(wa[q][0].x), bflo(wa[q][0].y), bfhi(wa[q][0].y)} * w0 + (f32x4){bflo(wa[q][1].x), bfhi(wa[q][1].x), bflo(wa[q][1].y), bfhi(wa[q][1].y)} * w1
                   + (f32x4){bflo(wa[q][2].x), bfhi(wa[q][2].x), bflo(wa[q][2].y), bfhi(wa[q][2].y)} * w2) * wi;
            red[q][0] = va[q][0] * va[q][0] + va[q][1] * va[q][1] + va[q][2] * va[q][2] + va[q][3] * va[q][3];
            float sb = 0.f;
#pragma unroll
            for (int k = 0; k < 2; ++k) {
                const float g0 = sigmoidf_(gl[q][k][0]), g1 = sigmoidf_(gl[q][k][1]), g2 = sigmoidf_(gl[q][k][2]);
                const u32x2 a = wb[q][k][0], b_ = wb[q][k][1], c_ = wb[q][k][2];
                vb[q][k][0] = g0 * bflo(a.x) + g1 * bflo(b_.x) + g2 * bflo(c_.x); vb[q][k][1] = g0 * bfhi(a.x) + g1 * bfhi(b_.x) + g2 * bfhi(c_.x);
                vb[q][k][2] = g0 * bflo(a.y) + g1 * bflo(b_.y) + g2 * bflo(c_.y); vb[q][k][3] = g0 * bfhi(a.y) + g1 * bfhi(b_.y) + g2 * bfhi(c_.y);
                sb += vb[q][k][0] * vb[q][k][0] + vb[q][k][1] * vb[q][k][1] + vb[q][k][2] * vb[q][k][2] + vb[q][k][3] * vb[q][k][3];
            }
            red[q][1] = sb;
            vc[q] = (f32x4){bflo(wc_[q].x), bfhi(wc_[q].x), bflo(wc_[q].y), bfhi(wc_[q].y)};
            red[q][2] = vc[q][0] * vc[q][0] + vc[q][1] * vc[q][1] + vc[q][2] * vc[q][2] + vc[q][3] * vc[q][3];
        }
#pragma unroll
        for (int o = 1; o < 64; o <<= 1) {
#pragma unroll
            for (int q = 0; q < 2; ++q)
#pragma unroll
                for (int j = 0; j < 3; ++j) red[q][j] += __shfl_xor(red[q][j], o);
        }
#pragma unroll
        for (int q = 0; q < 2; ++q) {
            if (q == 1 && tok0 + NGW >= T) break;
            const float ra = rsqrtf(red[q][0] * (1.0f / 256.0f) + EPS), rb = rsqrtf(red[q][1] * (1.0f / 512.0f) + EPS), rc = rsqrtf(red[q][2] * (1.0f / 256.0f) + EPS);
            bf16* orow = AMIX + (size_t)tok[q] * 1024;
            { const f32x4 o = va[q] * ra * *(const f32x4*)(ga + 4 * lane); u32x2 w; w.x = pk2(o[0], o[1]); w.y = pk2(o[2], o[3]); *(u32x2*)(orow + 4 * lane) = w; }
#pragma unroll
            for (int k = 0; k < 2; ++k) { const f32x4 o = vb[q][k] * rb * *(const f32x4*)(gb + 256 * k + 4 * lane); u32x2 w; w.x = pk2(o[0], o[1]); w.y = pk2(o[2], o[3]); *(u32x2*)(orow + 256 + 256 * k + 4 * lane) = w; }
            { const f32x4 o = vc[q] * rc * *(const f32x4*)(gc + 4 * lane); u32x2 w; w.x = pk2(o[0], o[1]); w.y = pk2(o[2], o[3]); *(u32x2*)(orow + 768 + 4 * lane) = w; }
        }
    }
}
DI void phase_router(const Ctx& F, int l) {
    LAS unsigned char* WH = F.lds; LAS unsigned char* WL = F.lds + 65536;
    LAS float* biasp = (LAS float*)(F.lds + AUX_OFF); LAS float* RS = biasp + 32;
    LAS int* lcnt = (LAS int*)(F.lds + AUX_OFF + 1024); LAS int* gbase = lcnt + 32;
    LAS int* tokE = gbase + 32; LAS float* tokG = (LAS float*)(tokE + 512); LAS int* tokP = (LAS int*)(tokG + 512);
    const float* wr = ginp(F, I_WR) + (size_t)l * 1024 * 32; const float* br = ginp(F, I_BR) + (size_t)l * 32;
    const float* mods = (const float*)(F.ws + WS_MODS); const bf16* X = (const bf16*)(F.ws + WS_X); bf16* H = (bf16*)(F.ws + F.dofs + WS_H);
    const float* g2 = ginp(F, I_G2) + (size_t)l * 1024;
    const int tid = F.tid, lane = F.lane, w = F.wave;
    if (tid < 32) lcnt[tid] = 0;
    unsigned* CNT = (unsigned*)(F.ws + WS_CTL) + CW_CNT + (l + F.dcnt) * 32 * 64;
    for (int chunk = F.blk; chunk < T / 128; chunk += F.G) {
        const int b = (chunk * 128) >> 12;
        const float* sh = mods + ((size_t)(l * 8 + b) * 6 + 3) * 1024; const float* sc = sh + 1024;
        {
            float bacc = 0.f; const int e = tid & 31;
#pragma unroll 4
            for (int it = 0; it < 32; ++it) {
                const int k = 2 * ((tid + 512 * it) >> 5);
                const float w0 = wr[k * 32 + e], w1 = wr[(k + 1) * 32 + e];
                const float p0 = w0 * (g2[k] * (sc[k] + 1.0f)), p1 = w1 * (g2[k + 1] * (sc[k + 1] + 1.0f));
                bacc += sh[k] * w0 + sh[k + 1] * w1;
                const unsigned hi = pk2(p0, p1);
                const unsigned lo = pk2(p0 - bflo(hi), p1 - bfhi(hi));
                const int off = e * 2048 + ((((k >> 3) ^ e) << 4) | ((k & 7) * 2));
                *(LAS unsigned*)(WH + off) = hi; *(LAS unsigned*)(WL + off) = lo;
            }
            tokG[tid] = bacc;
        }
        __syncthreads();
        if (tid < 32) { float s_ = br[tid];
#pragma unroll
            for (int j = 0; j < 16; ++j) s_ += tokG[tid + 32 * j];
            biasp[tid] = s_; }
#pragma unroll 1
        for (int tt = 0; tt < 8; ++tt) {
            const int tl0 = w * 16 + 2 * tt, tok0 = chunk * 128 + tl0;
            f32x4 v[2][4]; float ss0 = 0.f, ss1 = 0.f;
#pragma unroll
            for (int k = 0; k < 4; ++k) { const u32x2 wa = *(const u32x2*)(X + (size_t)tok0 * 1024 + 4 * lane + 256 * k), wb = *(const u32x2*)(X + (size_t)(tok0 + 1) * 1024 + 4 * lane + 256 * k);
                v[0][k] = (f32x4){bflo(wa.x), bfhi(wa.x), bflo(wa.y), bfhi(wa.y)}; v[1][k] = (f32x4){bflo(wb.x), bfhi(wb.x), bflo(wb.y), bfhi(wb.y)}; }
#pragma unroll
            for (int k = 0; k < 4; ++k) { ss0 += v[0][k][0] * v[0][k][0] + v[0][k][1] * v[0][k][1] + v[0][k][2] * v[0][k][2] + v[0][k][3] * v[0][k][3];
                                          ss1 += v[1][k][0] * v[1][k][0] + v[1][k][1] * v[1][k][1] + v[1][k][2] * v[1][k][2] + v[1][k][3] * v[1][k][3]; }
#pragma unroll
            for (int o = 1; o < 64; o <<= 1) { ss0 += __shfl_xor(ss0, o); ss1 += __shfl_xor(ss1, o); }
            const float rs0 = rsqrtf(ss0 * (1.0f / 1024.0f) + EPS), rs1 = rsqrtf(ss1 * (1.0f / 1024.0f) + EPS);
            if (lane == 0) { RS[tl0] = rs0; RS[tl0 + 1] = rs1; }
#pragma unroll
            for (int k = 0; k < 4; ++k) {
                const int c = 4 * lane + 256 * k;
                const f32x4 gg = *(const f32x4*)(g2 + c) * (*(const f32x4*)(sc + c) + 1.0f), hh_ = *(const f32x4*)(sh + c);
                v[0][k] = v[0][k] * rs0 * gg + hh_; v[1][k] = v[1][k] * rs1 * gg + hh_;
                *(unsigned*)((unsigned char*)H + (size_t)tok0 * 1024 + c) = pk4_fp8s(v[0][k][0], v[0][k][1], v[0][k][2], v[0][k][3], H8_SCALE);
                *(unsigned*)((unsigned char*)H + (size_t)(tok0 + 1) * 1024 + c) = pk4_fp8s(v[1][k][0], v[1][k][1], v[1][k][2], v[1][k][3], H8_SCALE);
            }
        }
        __syncthreads();
        f32x4 acc[2] = {{0.f, 0.f, 0.f, 0.f}, {0.f, 0.f, 0.f, 0.f}};
        {
            const int kg = lane >> 4, n16 = lane & 15;
            const bf16* xr = X + (size_t)(chunk * 128 + w * 16 + n16) * 1024 + 8 * kg;
#pragma unroll 1
            for (int k8 = 0; k8 < 4; ++k8) {
                bf16x8 af[8];
#pragma unroll
                for (int j = 0; j < 8; ++j) af[j] = *(const bf16x8*)(xr + 32 * (8 * k8 + j));
#pragma unroll
                for (int j = 0; j < 8; ++j) {
                    const int c = 4 * (8 * k8 + j) + kg;
#pragma unroll
                    for (int et = 0; et < 2; ++et) {
                        const int e = 16 * et + n16, off = e * 2048 + ((c ^ e) << 4);
                        const bf16x8 bh = *(const LAS bf16x8*)(WH + off), bl = *(const LAS bf16x8*)(WL + off);
                        acc[et] = __builtin_amdgcn_mfma_f32_16x16x32_bf16(af[j], bh, acc[et], 0, 0, 0);
                        acc[et] = __builtin_amdgcn_mfma_f32_16x16x32_bf16(af[j], bl, acc[et], 0, 0, 0);
                    }
                }
            }
        }
        __syncthreads();
        LAS float* LG = (LAS float*)(F.lds + w * 2048);
        {
            const int g4 = lane >> 4, n16 = lane & 15;
#pragma unroll
            for (int et = 0; et < 2; ++et)
#pragma unroll
                for (int i = 0; i < 4; ++i) LG[(4 * g4 + i) * 32 + 16 * et + n16] = acc[et][i] * RS[w * 16 + 4 * g4 + i] + biasp[16 * et + n16];
        }
        asm volatile("s_waitcnt lgkmcnt(0)" ::: "memory");
#pragma unroll 1
        for (int tt = 0; tt < 8; ++tt) {
            const int tl0 = w * 16 + 2 * tt;
            const float lg0 = LG[(2 * tt) * 32 + (lane >> 1)], lg1 = LG[(2 * tt + 1) * 32 + (lane >> 1)];
            int rk0 = 0, rk1 = 0; const int me = lane >> 1;
#pragma unroll
            for (int e = 0; e < 32; ++e) {
                const float o0 = __builtin_bit_cast(float, __builtin_amdgcn_readlane(__builtin_bit_cast(int, lg0), 2 * e));
                const float o1 = __builtin_bit_cast(float, __builtin_amdgcn_readlane(__builtin_bit_cast(int, lg1), 2 * e));
                rk0 += ((o0 > lg0) || (o0 == lg0 && e < me)) ? 1 : 0; rk1 += ((o1 > lg1) || (o1 == lg1 && e < me)) ? 1 : 0;
            }
#pragma unroll
            for (int tk = 0; tk < 2; ++tk) {
                const int rk = tk ? rk1 : rk0; const float lg = tk ? lg1 : lg0;
                int te[4]; float tv[4];
#pragma unroll
                for (int r = 0; r < 4; ++r) {
                    const u64 mk = __ballot(rk == r && (lane & 1) == 0);
                    const int sl = __builtin_amdgcn_readfirstlane((int)__builtin_ctzll(mk));
                    te[r] = sl >> 1; tv[r] = __builtin_bit_cast(float, __builtin_amdgcn_readlane(__builtin_bit_cast(int, lg), sl));
                }
                const float e1 = __expf(tv[1] - tv[0]), e2 = __expf(tv[2] - tv[0]), e3 = __expf(tv[3] - tv[0]);
                const float isum = 1.0f / (1.0f + e1 + e2 + e3);
                if (lane < 4) {
                    const int tl = tl0 + tk;
                    const int e = lane == 0 ? te[0] : lane == 1 ? te[1] : lane == 2 ? te[2] : te[3];
                    const float gte = (lane == 0 ? 1.0f : lane == 1 ? e1 : lane == 2 ? e2 : e3) * isum;
                    const int pos = atomicAdd((int*)(lcnt + e), 1);
                    tokE[tl * 4 + lane] = e; tokG[tl * 4 + lane] = gte; tokP[tl * 4 + lane] = pos;
                }
            }
        }
        __syncthreads();
        if (tid < 32) gbase[tid] = (int)__hip_atomic_fetch_add(CNT + tid * 64, (unsigned)lcnt[tid], RLX_AGENT);
        __syncthreads();
        {
            const int tl = tid >> 2, r = tid & 3, e = tokE[tid], pos = gbase[e] + tokP[tid], tok = chunk * 128 + tl;
            ((int*)(F.ws + F.dofs + WS_IDX))[(size_t)e * ECAP + pos] = tok;
            ((float*)(F.ws + F.dofs + WS_GATEW))[(size_t)e * ECAP + pos] = tokG[tid];
            ((int*)(F.ws + F.dofs + WS_TOKSLOT))[(size_t)tok * 4 + r] = (e << 16) | pos;
        }
        __syncthreads();
        if (tid < 32) lcnt[tid] = 0;
        __syncthreads();
    }
}

DI int ropeperm64(int p) { return (p >> 1) + 32 * (p & 1); }
DI int cmap_win(int n) {
    const int tile = n >> 8, w = n & 255, hb = w & ~63, pp = ropeperm64(w & 63);
    switch (tile) {
        case 0: return hb + pp;
        case 1: return 256 + hb + pp;
        case 2: return 512 + w;
        case 3: return 768 + hb + pp;
        case 4: return 1024 + hb + pp;
        case 5: return w < 128 ? 1280 + w : 1408 + (w - 128);
        case 6: return w < 128 ? 1536 + hb + pp : 1664 + (w - 128);
        case 7: return w < 128 ? 1792 + hb + pp : 1920 + (w - 128);
        case 8: return 2072 + w;
        default: return w < 128 ? 2328 + w : (w < 160 ? 2456 + ((w - 128) >> 1) + 16 * ((w - 128) & 1) : (w < 184 ? 2048 + (w - 160) : -1));
    }
}
DI int cmap_qup(int n) { if (n >= 384) return -1; const int h = n / 96, w = n % 96; if (w < 64) return h * 96 + w; const int j = w - 64; return h * 96 + 64 + (j >> 1) + 16 * (j & 1); }
DI void tr_tile(const float* src, int K, int Nsrc, bf16* dst, int Kdst, int maptype, const float* ksc, int ntile, int ktile, LAS float* scr, int tid) {
    const int n0 = ntile * 64, k0 = ktile * 128, nl = tid & 63, n = n0 + nl;
    const int c = maptype == 0 ? (n < Nsrc ? n : -1) : (maptype == 1 ? cmap_win(n) : cmap_qup(n));
    float v[16];
#pragma unroll
    for (int it = 0; it < 16; ++it) { const int k = k0 + (tid >> 6) + 8 * it; v[it] = (c >= 0 && k < K) ? src[(size_t)k * Nsrc + c] * (ksc ? ksc[k] : 1.0f) : 0.f; }
#pragma unroll
    for (int it = 0; it < 16; ++it) scr[((tid >> 6) + 8 * it) * 65 + nl] = v[it];
    __syncthreads();
#pragma unroll
    for (int it = 0; it < 2; ++it) {
        const int idx = tid + 512 * it, nn = idx >> 4, ch = idx & 15;
        const LAS float* s = scr + (8 * ch) * 65 + nn;
        u32x4 o; o.x = pk2(s[0], s[65]); o.y = pk2(s[2 * 65], s[3 * 65]); o.z = pk2(s[4 * 65], s[5 * 65]); o.w = pk2(s[6 * 65], s[7 * 65]);
        *(u32x4*)(dst + (size_t)(n0 + nn) * Kdst + k0 + 8 * ch) = o;
    }
    __syncthreads();
}
DI void trb_load(f32x4 (&v)[16], const float* src, int N, int n0, int k0, int tid) {
#pragma unroll
    for (int it = 0; it < 16; ++it) v[it] = *(const f32x4*)(src + (size_t)(k0 + (tid >> 6) + 8 * it) * N + n0 + 4 * (tid & 63));
}
DI void trb_store(const f32x4 (&v)[16], bf16* dst, int Kd, int n0, int k0, LAS unsigned char* L, int tid, int wave, int lane, int f8 = 0) {
#pragma unroll
    for (int it = 0; it < 16; ++it) { f32x4 x = v[it];
        if (f8) { x[0] = q8s(x[0], W8_SCALE); x[1] = q8s(x[1], W8_SCALE); x[2] = q8s(x[2], W8_SCALE); x[3] = q8s(x[3], W8_SCALE); }
        u32x2 w; w.x = pk2(x[0], x[1]); w.y = pk2(x[2], x[3]); *(LAS u32x2*)(L + ((tid >> 6) + 8 * it) * 576 + (tid & 63) * 8) = w; }
    asm volatile("s_waitcnt lgkmcnt(0)\n\ts_barrier" ::: "memory");
    const int i = lane & 15, gn = (lane >> 4) & 1, h = lane >> 5, q = i >> 2, p = i & 3;
    const LAS unsigned char* base = L + (8 * h + q) * 576 + (32 * wave + 16 * gn) * 2 + 8 * p;
    if (!f8) {
        bf16* drow = dst + (size_t)(n0 + 32 * wave + 16 * gn + i) * Kd + k0 + 8 * h;
#pragma unroll
        for (int kcp = 0; kcp < 8; ++kcp) {
            const s16x4 lo = tr_read(base + (16 * kcp) * 576), hi = tr_read(base + (16 * kcp + 4) * 576);
            *(bf16x8*)(drow + 16 * kcp) = __builtin_shufflevector(lo, hi, 0, 1, 2, 3, 4, 5, 6, 7);
        }
    } else {
        unsigned char* drow = (unsigned char*)dst + (size_t)(n0 + 32 * wave + 16 * gn + i) * Kd + k0 + 8 * h;
#pragma unroll
        for (int kcp = 0; kcp < 8; ++kcp) {
            const s16x4 lo = tr_read(base + (16 * kcp) * 576), hi = tr_read(base + (16 * kcp + 4) * 576);
            int w0 = __builtin_amdgcn_cvt_pk_fp8_f32(bf2f((unsigned short)lo[0]), bf2f((unsigned short)lo[1]), 0, false); w0 = __builtin_amdgcn_cvt_pk_fp8_f32(bf2f((unsigned short)lo[2]), bf2f((unsigned short)lo[3]), w0, true);
            int w1 = __builtin_amdgcn_cvt_pk_fp8_f32(bf2f((unsigned short)hi[0]), bf2f((unsigned short)hi[1]), 0, false); w1 = __builtin_amdgcn_cvt_pk_fp8_f32(bf2f((unsigned short)hi[2]), bf2f((unsigned short)hi[3]), w1, true);
            u32x2 o; o.x = (unsigned)w0; o.y = (unsigned)w1;
            *(u32x2*)(drow + 16 * kcp) = o;
        }
    }
    asm volatile("s_waitcnt lgkmcnt(0)\n\ts_barrier" ::: "memory");
}
struct TrbItem { const float* src; bf16* dst; int N, n0, k0, f8; };
DI TrbItem trb_item(const Ctx& F, int it) {
    const int le = it / 96, r = it % 96; TrbItem t;
    if (r < 64) { t.src = ginp(F, I_WE1) + (size_t)le * 1024 * 2048; t.dst = (bf16*)(F.ws + WS_W1E + (size_t)le * 2048 * 1024); t.N = 2048; t.n0 = (r & 7) * 256; t.k0 = (r >> 3) * 128; t.f8 = 1; }
    else { const int q = r - 64; t.src = ginp(F, I_WE2) + (size_t)le * 1024 * 1024; t.dst = (bf16*)(F.ws + WS_W2E + (size_t)le * 1024 * 1024); t.N = 1024; t.n0 = (q & 3) * 256; t.k0 = (q >> 2) * 128; t.f8 = 1; }
    return t;
}
DI void conv_layer_tiles(const Ctx& F, int l, int q0, int i0, int cnt) {
    const int NL = 32 * 96;
    int it = q0 + F.blk + F.G * i0; const int end = q0 + F.blk + F.G * (i0 + cnt);
    if (it >= NL) return;
    f32x4 va[16];
    TrbItem ta = trb_item(F, l * NL + it);
    trb_load(va, ta.src, ta.N, ta.n0, ta.k0, F.tid);
#pragma unroll 1
    while (it < NL && it < end) {
        f32x4 vb[16];
#pragma unroll
        for (int k = 0; k < 16; ++k) vb[k] = va[k];
        const TrbItem tc = ta;
        it += F.G;
        const bool more = (it < NL && it < end);
        ta = trb_item(F, l * NL + (more ? it : 0));
        if (more) trb_load(va, ta.src, ta.N, ta.n0, ta.k0, F.tid);
        trb_store(vb, tc.dst, 1024, tc.n0, tc.k0, F.lds, F.tid, F.wave, F.lane, tc.f8);
    }
}
DI void conv_claim_tiles(const Ctx& F, int l, int quota) {
    const int NL = 32 * 96;
    volatile LAS unsigned* slot = (volatile LAS unsigned*)(F.lds + MISC_OFF) + 16;
    __syncthreads();
    if (F.tid == 0) { unsigned* q = (unsigned*)(F.ws + WS_CTL) + CW_CONVQ + l * 64; slot[0] = __hip_atomic_fetch_add(q, (unsigned)quota, __ATOMIC_RELAXED, __HIP_MEMORY_SCOPE_AGENT); }
    __syncthreads();
    int it = __builtin_amdgcn_readfirstlane((int)slot[0]); const int end = it + quota;
    if (it >= NL) return;
    f32x4 va[16];
    TrbItem ta = trb_item(F, l * NL + it);
    trb_load(va, ta.src, ta.N, ta.n0, ta.k0, F.tid);
#pragma unroll 1
    while (it < NL && it < end) {
        f32x4 vb[16];
#pragma unroll
        for (int k = 0; k < 16; ++k) vb[k] = va[k];
        const TrbItem tc = ta;
        it += 1;
        const bool more = (it < NL && it < end);
        ta = trb_item(F, l * NL + (more ? it : 0));
        if (more) trb_load(va, ta.src, ta.N, ta.n0, ta.k0, F.tid);
        trb_store(vb, tc.dst, 1024, tc.n0, tc.k0, F.lds, F.tid, F.wave, F.lane, tc.f8);
    }
}
DI void phase_prologue(const Ctx& F) {
    const Args& A = *F.a; const int tid = F.tid;
    LAS float* scr = (LAS float*)F.lds;
    if (!CONV_IN_LAYER) {
        const int NIT = DEPTH * 32 * 96;
        f32x4 va[16];
        int it = F.blk;
        TrbItem ta = trb_item(F, it < NIT ? it : 0);
        if (it < NIT) trb_load(va, ta.src, ta.N, ta.n0, ta.k0, tid);
#pragma unroll 1
        while (it < NIT) {
            f32x4 vb[16];
#pragma unroll
            for (int k = 0; k < 16; ++k) vb[k] = va[k];
            const TrbItem tc = ta;
            it += F.G;
            ta = trb_item(F, it < NIT ? it : 0);
            if (it < NIT) trb_load(va, ta.src, ta.N, ta.n0, ta.k0, tid);
            trb_store(vb, tc.dst, 1024, tc.n0, tc.k0, F.lds, tid, F.wave, F.lane, tc.f8);
        }
    }
    constexpr int PER_L = 8192 + 4096 + 320 + 128 + 128 + 16 + 16;
    for (int it = F.blk; it < DEPTH * PER_L; it += F.G) {
        const int l = it / PER_L; int r = it % PER_L;
        if (r < 8192 + 4096) continue;
        if (r < 8192) { const int e = r >> 8, t = r & 255;
            tr_tile(ginp(F, I_WE1) + ((size_t)(l * 32 + e)) * 1024 * 2048, 1024, 2048, (bf16*)(F.ws + WS_W1E) + ((size_t)(l * 32 + e)) * 2048 * 1024, 1024, 0, nullptr, t >> 3, t & 7, scr, tid); continue; }
        r -= 8192;
        if (r < 4096) { const int e = r >> 7, t = r & 127;
            tr_tile(ginp(F, I_WE2) + ((size_t)(l * 32 + e)) * 1024 * 1024, 1024, 1024, (bf16*)(F.ws + WS_W2E) + ((size_t)(l * 32 + e)) * 1024 * 1024, 1024, 0, nullptr, t >> 3, t & 7, scr, tid); continue; }
        r -= 4096;
        if (r < 320) { tr_tile(ginp(F, I_WIN) + (size_t)l * 1024 * 2488, 1024, 2488, (bf16*)(F.ws + WS_WIN) + (size_t)l * NIN * 1024, 1024, 1, nullptr, r >> 3, r & 7, scr, tid); continue; }
        r -= 320;
        if (r < 128) { tr_tile(ginp(F, I_WOUT) + (size_t)l * 1024 * 1024, 1024, 1024, (bf16*)(F.ws + WS_WOUT) + (size_t)l * 1024 * 1024, 1024, 0, nullptr, r >> 3, r & 7, scr, tid); continue; }
        r -= 128;
        if (r < 128) { const int kv = r >> 6, t = r & 63;
            tr_tile(ginp(F, kv ? I_W1V : I_W1K) + (size_t)l * 2048 * 256, 2048, 256, (bf16*)(F.ws + WS_NSAW1) + ((size_t)(l * 2 + kv)) * 256 * 2048, 2048, 0, nullptr, t >> 4, t & 15, scr, tid); continue; }
        r -= 128;
        if (r < 16) { tr_tile(ginp(F, I_WQUP) + (size_t)l * 256 * 384, 256, 384, (bf16*)(F.ws + WS_MLAQ) + (size_t)l * 512 * 256, 256, 2, ginp(F, I_GQ) + (size_t)l * 256, r >> 1, r & 1, scr, tid); continue; }
        r -= 16;
        tr_tile(ginp(F, I_WKVUP) + (size_t)l * 128 * 512, 128, 512, (bf16*)(F.ws + WS_MLAKV) + (size_t)l * 512 * 256, 256, 0, ginp(F, I_GKV) + (size_t)l * 128, r >> 1, r & 1, scr, tid);
    }
    for (int it = F.blk; it < DEPTH * 4; it += F.G) {
        const int l = it >> 2, kv = (it >> 1) & 1, kt = it & 1;
        tr_tile(ginp(F, kv ? I_W2V : I_W2K) + (size_t)l * 256 * 64, 256, 64, (bf16*)(F.ws + WS_W2T) + ((size_t)(l * 2 + kv)) * 64 * 256, 256, 0, nullptr, 0, kt, scr, tid);
    }
    {
        float* CS64 = (float*)(F.ws + WS_CS64); float* CS32 = (float*)(F.ws + WS_CS32);
        const int* pos = (const int*)ginp(F, I_POS);
        for (int idx = F.blk * 512 + tid; idx < T * 48; idx += F.G * 512) {
            const int tok = idx / 48, i = idx % 48;
            const double p = (double)pos[tok];
            const double inv = (i < 32) ? exp2(-(double)i * (13.287712379549449 / 32.0)) : exp2(-(double)(i - 32) * (13.287712379549449 / 16.0));
            double ang = p * inv;
            const double kk = __builtin_rint(ang * 0.15915494309189535);
            ang = ang - kk * 6.283185307179586;
            const float af = (float)ang;
            const float cs = __cosf(af), sn = __sinf(af);
            if (i < 32) { CS64[(size_t)tok * 64 + i] = cs; CS64[(size_t)tok * 64 + 32 + i] = sn; }
            else { CS32[(size_t)tok * 32 + (i - 32)] = cs; CS32[(size_t)tok * 32 + 16 + (i - 32)] = sn; }
        }
    }
    for (int item = F.blk; item < 32; item += F.G) {
        const int lk = item >> 2, l = lk >> 1, kv = lk & 1, col = (item & 3) * 64 + F.lane;
        const float* w1 = ginp(F, kv ? I_W1V : I_W1K) + (size_t)l * 2048 * 256 + col; const float* pe = ginp(F, kv ? I_POSV : I_POSK) + (size_t)l * 2048;
        float s = 0.f;
#pragma unroll 1
        for (int kb = 256 * F.wave; kb < 256 * F.wave + 256; kb += 16) {
            float wv[16];
#pragma unroll
            for (int j = 0; j < 16; ++j) wv[j] = w1[(size_t)(kb + j) * 256];
#pragma unroll
            for (int j = 0; j < 16; ++j) s += pe[kb + j] * wv[j];
        }
        scr[F.wave * 64 + F.lane] = s;
        __syncthreads();
        if (tid < 64) { float t = ginp(F, kv ? I_B1V : I_B1K)[(size_t)l * 256 + col];
#pragma unroll
            for (int ww = 0; ww < 8; ++ww) t += scr[ww * 64 + tid];
            ((float*)(F.ws + WS_B1P))[(size_t)lk * 256 + col] = t; }
        __syncthreads();
    }
    {
        LAS float* sc = scr; LAS float* red = scr + 8192;
        for (int i = tid; i < 8192; i += 512) { const float c = ginp(F, I_C)[i]; sc[i] = c * sigmoidf_(c); }
        __syncthreads();
        float* MODS = (float*)(F.ws + WS_MODS);
        const int lane = F.lane, w = F.wave;
        for (int item = F.blk; item < 384; item += F.G) {
            const int l = item / 96, col = (item % 96) * 64 + lane;
            float acc[8];
#pragma unroll
            for (int b = 0; b < 8; ++b) acc[b] = 0.f;
            const float* wa = ginp(F, I_WADA) + (size_t)l * 1024 * 6144 + col;
#pragma unroll 1
            for (int kb = 128 * w; kb < 128 * w + 128; kb += 16) {
                float wv[16];
#pragma unroll
                for (int j = 0; j < 16; ++j) wv[j] = wa[(size_t)(kb + j) * 6144];
#pragma unroll
                for (int j = 0; j < 16; ++j) {
#pragma unroll
                    for (int b = 0; b < 8; ++b) acc[b] += sc[b * 1024 + kb + j] * wv[j]; }
            }
#pragma unroll
            for (int b = 0; b < 8; ++b) red[(w * 8 + b) * 64 + lane] = acc[b];
            __syncthreads();
            { const int b = tid >> 6; float s = ginp(F, I_BADA)[(size_t)l * 6144 + col];
#pragma unroll
              for (int ww = 0; ww < 8; ++ww) s += red[(ww * 8 + b) * 64 + lane];
              MODS[((size_t)(l * 8 + b)) * 6144 + col] = s; }
            __syncthreads();
        }
    }
}

constexpr int PH_PER_LAYER = 11;
constexpr int N_PHASES = 1 + DEPTH * PH_PER_LAYER + 1;

__global__ void __launch_bounds__(512, 2) fwd_kernel(Args args) {
    extern __shared__ __attribute__((aligned(16))) unsigned char lds_raw[];
    Ctx F;
    F.lds = (LAS unsigned char*)lds_raw; F.a = &args; F.ws = args.ws;
    F.dofs = 0; F.dcnt = 0;
    F.tid = threadIdx.x; F.lane = F.tid & 63; F.wave = __builtin_amdgcn_readfirstlane(F.tid >> 6); F.blk = blockIdx.x; F.G = gridDim.x; F.vcu = F.blk;
    volatile LAS unsigned* MISC = (volatile LAS unsigned*)(F.lds + MISC_OFF);
    for (int u = F.tid; u < (LDS_BYTES - MISC_OFF) / 4; u += 512) MISC[u] = 0u;
    __syncthreads();
    unsigned* ctl = (unsigned*)(F.ws + WS_CTL);
    XcdBarrier bar; bar.bar = ctl + CW_BAR; bar.x = 0; bar.st = nullptr;
    if (!MK_PER_PHASE) bar = xcd_barrier_post(ctl + CW_BAR, MISC + 8);
    const int lo = args.ph_lo, hi = args.ph_hi;
#define IN(k) (lo <= (k) && (k) < hi)
#define SEAM(k) do { if (IN(k) && IN((k) + 1)) xcd_barrier(bar); } while (0)
    unsigned char* ws = F.ws;
#define PHASE_BEGIN() do { int t_ = threadIdx.x; asm volatile("" : "+v"(t_)); F.tid = t_; F.lane = t_ & 63; F.wave = __builtin_amdgcn_readfirstlane(t_ >> 6); \
        GAS unsigned char* w_ = (GAS unsigned char*)args.ws; asm volatile("" : "+s"(w_)); F.ws = (unsigned char*)w_; ws = (unsigned char*)w_; int b_ = blockIdx.x; asm volatile("" : "+s"(b_)); F.blk = b_; F.vcu = (F.G % 8 == 0) ? (b_ % 8) * (F.G / 8) + b_ / 8 : b_; } while (0)

    if (PHON(0) && IN(0)) _Pragma("unroll 1") for (int rep_ = 0; rep_ < NREP(0); ++rep_) { PHASE_BEGIN(); phase_prologue(F); }
    SEAM(0);
#pragma unroll 1
    for (int l = 0; l < DEPTH; ++l) {
        const int P = 1 + l * PH_PER_LAYER;
        if (PHON(1) && IN(P + 0)) _Pragma("unroll 1") for (int rep_ = 0; rep_ < (DUM(1) ? 2 : 1); ++rep_) { PHASE_BEGIN(); F.dofs = (DUM(1) && rep_ == 0) ? WS_END : 0; phase_norm1<0>(F, l); }
        SEAM(P + 0);
        if (PHON(2) && IN(P + 1)) _Pragma("unroll 1") for (int rep_ = 0; rep_ < NREP(2); ++rep_) { PHASE_BEGIN();
            SchedGrid Sg{(const char*)(ws + WS_H), (const char*)(ws + WS_WIN) + (size_t)l * NIN * 1024 * 2, 1024, 1024, NIN / 256, (T / 256) * (NIN / 256), F.G, F.vcu};
            EpiWin E{ws, (const float*)(ws + WS_CS64), (const float*)(ws + WS_CS32)};
            pg8::gemm_phase<EpiWin, SchedGrid, false>(F.lds, 1024, 1024, Sg, E);
        }
        SEAM(P + 1);
        if (PHON(3) && IN(P + 2)) _Pragma("unroll 1") for (int rep_ = 0; rep_ < NREP(3); ++rep_) { PHASE_BEGIN();
            if (PHON(13)) {
                SchedCmp Sc{(const char*)(ws + WS_KCMP), (const char*)(ws + WS_VCMP), (const char*)(ws + WS_NSAW1) + (size_t)l * 2 * 256 * 2048 * 2, F.G, F.blk};
                EpiCmp E{(const float*)(ws + WS_B1P) + (size_t)l * 512, (const bf16*)(ws + WS_W2T) + (size_t)l * 2 * 64 * 256, ginp(F, I_B2K) + (size_t)l * 64, ginp(F, I_B2V) + (size_t)l * 64,
                         (bf16*)(ws + WS_KC), (bf16*)(ws + WS_VC), (const float*)(ws + WS_CS64)};
                pg8::gemm_phase<EpiCmp, SchedCmp, false>(F.lds, 1024, 2048, Sc, E);
            }
            PHASE_BEGIN();
            if (PHON(18)) {
                SchedMla Sm{(const char*)(ws + WS_CQ), (const char*)(ws + WS_MISC), (const char*)(ws + WS_MLAQ) + (size_t)l * 512 * 256 * 2, (const char*)(ws + WS_MLAKV) + (size_t)l * 512 * 256 * 2, F.G, F.vcu};
                EpiMla E{(bf16*)(ws + WS_QM), (bf16*)(ws + WS_KN), (bf16*)(ws + WS_VM), (const bf16*)(ws + WS_CQ), (const bf16*)(ws + WS_MISC), (const float*)(ws + WS_CS32)};
                pg8::gemm_phase<EpiMla, SchedMla, false>(F.lds, 256, 256, Sm, E);
            }
            PHASE_BEGIN();
            if (PHON(15)) {
                unsigned* qw = (unsigned*)(ws + WS_CTL) + CW_QUEUE + (l * 2 + rep_) * 64;
                volatile LAS int* qslot = (volatile LAS int*)(F.lds + AUX_OFF + 512);
                int nxt_t = 0;
                if (F.tid == 0) nxt_t = (int)__hip_atomic_fetch_add(qw, 1u, RLX_AGENT);
                for (;;) {
                    if (F.tid == 0) { qslot[0] = nxt_t; nxt_t = (int)__hip_atomic_fetch_add(qw, 1u, RLX_AGENT); }
                    __syncthreads();
                    const int uq = qslot[0];
                    __syncthreads();
                    if (uq >= 2560) break;
                    if (uq < 1024) {
                        const int u = uq;
                        PolB pb; pb.Q = (const bf16*)(ws + WS_QB); pb.K = (const bf16*)(ws + WS_KWIN); pb.V = (const bf16*)(ws + WS_VWIN); pb.O = (bf16*)(ws + WS_OWIN);
                        pb.b = u >> 7; pb.g = (u >> 6) & 1; pb.qc = 63 - (u & 63); pb.maxd = 511u; pb.j0 = pb.qc > 8 ? pb.qc - 8 : 0; pb.j1 = pb.qc + 1;
                        attn_unit<64, PolB, false>(pb, F.lds, F.tid, F.lane, F.wave, 0ull);
                    } else {
                        const int uu = uq - 1024;
                        const int bh = uu / 48, w48 = uu % 48, p = w48 >> 4, s16 = w48 & 15;
                        PolA pa; pa.Q = (const bf16*)(ws + WS_QA); pa.K = (const bf16*)(ws + WS_KA); pa.V = (const bf16*)(ws + WS_VA);
                        pa.O = (bf16*)(ws + WS_OA3) + (size_t)p * T * 256; pa.LSEP = (float*)(ws + WS_LSEA) + (size_t)p * T * 4;
                        pa.b = bh >> 2; pa.h = bh & 3; pa.d = p == 0 ? 1 : (p == 1 ? 4 : 16);
                        const int cpr = p == 0 ? 16 : (p == 1 ? 4 : 1);
                        pa.r = s16 / cpr; pa.c = s16 % cpr; pa.maxd = 128u; pa.j0 = pa.c == 0 ? 2 : 0; pa.j1 = 6;
                        attn_unit<64, PolA, false>(pa, F.lds, F.tid, F.lane, F.wave, 0ull);
                    }
                }
            }
        }
        SEAM(P + 2);
        if (PHON(5) && IN(P + 4)) _Pragma("unroll 1") for (int rep_ = 0; rep_ < NREP(5); ++rep_) { PHASE_BEGIN();
            int cti = 0;
            int cq0 = 0;
            if (CONV_IN_LAYER) { const unsigned t_ = __hip_atomic_load((unsigned*)(ws + WS_CTL) + CW_CONVQ + l * 64, __ATOMIC_RELAXED, __HIP_MEMORY_SCOPE_AGENT); cq0 = __builtin_amdgcn_readfirstlane((int)(t_ < 3072u ? t_ : 3072u)); }
            if (PHON(19)) for (int u = F.vcu; u < 1024; u += F.G) {
                const int bg = (u % 256) >> 4, k = u & 15, rnd = u >> 8;
                const int qc = rnd == 0 ? 2 * k : (rnd == 1 ? 2 * k + 1 : (rnd == 2 ? 63 - 2 * k : 62 - 2 * k));
                const u64 sel = cmp_unit(F, bg >> 1, bg & 1, qc);
                PolB pb; pb.Q = (const bf16*)(ws + WS_QB); pb.K = (const bf16*)(ws + WS_KSLC); pb.V = (const bf16*)(ws + WS_VSLC); pb.O = (bf16*)(ws + WS_OSLC);
                pb.b = bg >> 1; pb.g = bg & 1; pb.qc = qc; pb.maxd = 0x7fffffffu; pb.j0 = 0; pb.j1 = qc + 1;
                attn_unit<64, PolB, true>(pb, F.lds, F.tid, F.lane, F.wave, sel);
                if (CONV_IN_LAYER && rep_ == 0) { PHASE_BEGIN(); conv_layer_tiles(F, l, cq0, cti, 2); cti += 2; }
            }
            PHASE_BEGIN();
            if (PHON(20)) for (int v = F.vcu; v < 512; v += F.G) {
                const int bh = (v & 255) >> 3, k = v & 7, c = (v < 256) ? k : 15 - k;
                PolM pm; pm.Q = (const bf16*)(ws + WS_QM); pm.KN = (const bf16*)(ws + WS_KN); pm.KR = (const bf16*)(ws + WS_KR); pm.V = (const bf16*)(ws + WS_VM); pm.O = (bf16*)(ws + WS_OC);
                pm.b = bh >> 2; pm.h = bh & 3; pm.c = c; pm.maxd = 0x7fffffffu; pm.j0 = 0; pm.j1 = 4 * c + 4;
                attn_unit<96, PolM, false>(pm, F.lds, F.tid, F.lane, F.wave, 0ull);
                if (CONV_IN_LAYER && rep_ == 0) { PHASE_BEGIN(); conv_layer_tiles(F, l, cq0, cti, 2); cti += 2; }
            }
            if (CONV_IN_LAYER && rep_ == 0) { PHASE_BEGIN(); conv_layer_tiles(F, l, cq0, cti, 1 << 20); }
        }
        SEAM(P + 4);
        if (PHON(7) && IN(P + 6)) _Pragma("unroll 1") for (int rep_ = 0; rep_ < NREP(7); ++rep_) { PHASE_BEGIN(); phase_mix(F, l); }
        SEAM(P + 6);
        if (PHON(8) && IN(P + 7)) _Pragma("unroll 1") for (int rep_ = 0; rep_ < (DUM(8) ? 2 : 1); ++rep_) { PHASE_BEGIN(); F.dofs = (DUM(8) && rep_ == 0) ? WS_END : 0;
            SchedGrid Sg{(const char*)(ws + WS_AMIX), (const char*)(ws + WS_WOUT) + (size_t)l * 1024 * 1024 * 2, 1024, 1024, 4, (T / 256) * 4, F.G, F.vcu};
            EpiWout E{(bf16*)(ws + WS_X), (const float*)(ws + WS_MODS) + ((size_t)(l * 8) * 6 + 2) * 1024, F.dofs};
            pg8::gemm_phase<EpiWout, SchedGrid, false>(F.lds, 1024, 1024, Sg, E);
        }
        SEAM(P + 7);
        if (PHON(9) && IN(P + 8)) _Pragma("unroll 1") for (int rep_ = 0; rep_ < (DUM(9) ? 2 : 1); ++rep_) { PHASE_BEGIN(); F.dofs = (DUM(9) && rep_ == 0) ? WS_END : 0; F.dcnt = (DUM(9) && rep_ == 0) ? 4 : 0; phase_router(F, l); }
        SEAM(P + 8);
        if (PHON(10) && IN(P + 9)) _Pragma("unroll 1") for (int rep_ = 0; rep_ < NREP(10); ++rep_) { PHASE_BEGIN();
            moe_tables(F, l);
            const LAS int* tb = (const LAS int*)(F.lds + AUX_OFF);
            SchedMoe1F8 Sm{tb, tb + 64, (const char*)(ws + WS_H), (const char*)(ws + WS_W1E) + (size_t)l * 32 * 2048 * 1024, (const int*)(ws + WS_IDX), tb[32] * 8, F.G, F.vcu};
            EpiMoe1 E{(bf16*)(ws + WS_ACT), ginp(F, I_BE1) + (size_t)l * 32 * 2048};
            pg8::gemm_phase<EpiMoe1, SchedMoe1F8, true, true>(F.lds, 512, 512, Sm, E);
            if (CONV_IN_LAYER && CONV_TAIL1 > 0 && rep_ == 0 && l + 1 < DEPTH) {
                const int nun = tb[32] * 8, rounds = (nun + F.G - 1) / F.G, mine = F.vcu < nun ? (nun - 1 - F.vcu) / F.G + 1 : 0;
                if (mine < rounds) { PHASE_BEGIN(); conv_claim_tiles(F, l + 1, CONV_TAIL1); }
            }
        }
        SEAM(P + 9);
        if (PHON(11) && IN(P + 10)) _Pragma("unroll 1") for (int rep_ = 0; rep_ < NREP(11); ++rep_) { PHASE_BEGIN();
            moe_tables(F, l);
            const LAS int* tb = (const LAS int*)(F.lds + AUX_OFF);
            SchedMoe2F8 Sm{tb, (const char*)(ws + WS_ACT), (const char*)(ws + WS_W2E) + (size_t)l * 32 * 1024 * 1024, tb[32] * 4, F.G, F.vcu};
            EpiMoe2 E{(unsigned char*)(ws + WS_Y2), ginp(F, I_BE2) + (size_t)l * 32 * 1024, (const float*)(ws + WS_GATEW)};
            pg8::gemm_phase<EpiMoe2, SchedMoe2F8, false, true>(F.lds, 512, 512, Sm, E);
            if (CONV_IN_LAYER && CONV_TAIL2 > 0 && rep_ == 0 && l + 1 < DEPTH) {
                const int nun = tb[32] * 4, rounds = (nun + F.G - 1) / F.G, mine = F.vcu < nun ? (nun - 1 - F.vcu) / F.G + 1 : 0;
                if (mine < rounds) { PHASE_BEGIN(); conv_claim_tiles(F, l + 1, CONV_TAIL2); }
            }
        }
        SEAM(P + 10);
    }
    if (PHON(12) && IN(N_PHASES - 1)) { PHASE_BEGIN(); phase_norm1<1>(F, DEPTH); }
#undef IN
#undef SEAM
}

extern "C" void kernel_launch(void* const* d_in, const int* in_sizes, int n_in, void* d_out, int out_size, void* d_ws, size_t ws_size, hipStream_t stream) {
    static int grid = 0;
    if (grid == 0) {
        if (n_in != 33 || out_size != T * D || ws_size < WS_END * (DUM_MASK ? 2 : 1)) { fprintf(stderr, "kernel_launch: unexpected problem (n_in %d out %d ws %zu)\n", n_in, out_size, ws_size); grid = -1; return; }
        int dev = 0, cus = 0, per_cu = 0;
        if (hipGetDevice(&dev) != hipSuccess || hipDeviceGetAttribute(&cus, hipDeviceAttributeMultiprocessorCount, dev) != hipSuccess) { grid = -1; return; }
        if (hipFuncSetAttribute((const void*)fwd_kernel, hipFuncAttributeMaxDynamicSharedMemorySize, LDS_BYTES) != hipSuccess) { fprintf(stderr, "kernel_launch: hipFuncSetAttribute failed\n"); grid = -1; return; }
        if (hipOccupancyMaxActiveBlocksPerMultiprocessor(&per_cu, (const void*)fwd_kernel, 512, LDS_BYTES) != hipSuccess || per_cu < 1) { fprintf(stderr, "kernel_launch: occupancy query says %d\n", per_cu); per_cu = 1; }
        (void)hipGetLastError();
        grid = cus;
    }
    if (grid < 0) return;
    if (hipMemsetAsync((char*)d_ws + WS_CTL, 0, CTL_ZERO_BYTES, stream) != hipSuccess) return;
    Args a{};
    for (int i = 0; i < 33; ++i) a.in[i] = (const float*)d_in[i];
    a.out = (float*)d_out; a.ws = (unsigned char*)d_ws;
#if MK_PER_PHASE
    for (int p = 0; p < N_PHASES; ++p) { a.ph_lo = p; a.ph_hi = p + 1; hipLaunchKernelGGL(fwd_kernel, dim3(grid), dim3(512), LDS_BYTES, stream, a); }
#else
    a.ph_lo = 0; a.ph_hi = N_PHASES;
    hipLaunchKernelGGL(fwd_kernel, dim3(grid), dim3(512), LDS_BYTES, stream, a);
#endif
}
```

```cpp
#include <hip/hip_runtime.h>
#include <cstdio>
#include <cstdint>

#ifndef MK_PER_PHASE
#define MK_PER_PHASE 0
#endif

#ifndef PH_MASK
#define PH_MASK 0xFFFFFFFFu
#endif
#define PHON(k) ((PH_MASK >> (k)) & 1u)
#ifndef DBL_MASK
#define DBL_MASK 0u
#endif
#define NREP(k) (((DBL_MASK >> (k)) & 1u) ? 2 : 1)
#ifndef DUM_MASK
#define DUM_MASK 0u
#endif
#define DUM(k) ((DUM_MASK >> (k)) & 1u)
#ifndef ATT_VAR
#define ATT_VAR 0
#endif
#ifndef CONV_IN_LAYER
#define CONV_IN_LAYER 1
#endif
#ifndef CONV_TAIL1
#define CONV_TAIL1 3
#endif
#ifndef CONV_TAIL2
#define CONV_TAIL2 4
#endif
#ifndef ATT_STAGGER
#define ATT_STAGGER 0
#endif
#define DI __device__ __forceinline__
#define LAS __attribute__((address_space(3)))
#define GAS __attribute__((address_space(1)))
typedef unsigned short bf16;
typedef short bf16x8 __attribute__((ext_vector_type(8)));
typedef short s16x4 __attribute__((ext_vector_type(4)));
typedef float f32x2 __attribute__((ext_vector_type(2)));
typedef float f32x4 __attribute__((ext_vector_type(4)));
typedef float f32x16 __attribute__((ext_vector_type(16)));
typedef unsigned u32x2 __attribute__((ext_vector_type(2)));
typedef unsigned u32x4 __attribute__((ext_vector_type(4)));
typedef __bf16 bf16x2_t __attribute__((ext_vector_type(2)));
typedef unsigned long long u64;

constexpr int NB = 8, S = 4096, T = NB * S, D = 1024, DEPTH = 4;
constexpr int NIN = 2560;
constexpr int NE = 32, DFF = 1024;
constexpr int SP = S + 64;
constexpr int ECAP = 32768;
constexpr int ACT_ROWS = 4 * T + NE * 256;
constexpr float LOG2E = 1.4426950408889634f;
constexpr float SCL64 = 0.125f * LOG2E;
constexpr float SCL96 = 0.10206207261596577f * LOG2E;
constexpr float EPS = 1e-6f;

constexpr size_t MiB = 1u << 20;
constexpr size_t WS_CTL = 0, CTL_ZERO_BYTES = 2 * MiB;
constexpr size_t WS_MODS = 2 * MiB, WS_B1P = 3 * MiB, WS_CS64 = 4 * MiB, WS_CS32 = 12 * MiB;
constexpr size_t WS_WIN = 16 * MiB, WS_WOUT = 36 * MiB, WS_NSAW1 = 44 * MiB, WS_MLAQ = 52 * MiB, WS_MLAKV = 53 * MiB;
constexpr size_t WS_W1E = 64 * MiB, WS_W2E = 576 * MiB;
constexpr size_t WS_X = 832 * MiB, WS_H = 960 * MiB;
constexpr size_t WS_QA = 1024 * MiB, WS_KA = 1040 * MiB, WS_VA = 1056 * MiB, WS_QB = 1072 * MiB;
constexpr size_t WS_KCMP = 1104 * MiB, WS_VCMP = 1113 * MiB;
constexpr size_t WS_KSLC = 1122 * MiB, WS_VSLC = 1130 * MiB, WS_KWIN = 1138 * MiB, WS_VWIN = 1146 * MiB;
constexpr size_t WS_CQ = 1154 * MiB, WS_MISC = 1170 * MiB;
constexpr size_t WS_RSTDQ = 1186 * MiB, WS_RSTDKV = 1186 * MiB + 512 * 1024, WS_KR = 1187 * MiB, WS_GATES = 1189 * MiB;
constexpr size_t WS_W2T = 1195 * MiB;
constexpr size_t WS_HID = 1192 * MiB, WS_KC = 1196 * MiB, WS_VC = 1196 * MiB + 512 * 1024;
constexpr size_t WS_QM = 1197 * MiB, WS_KN = 1221 * MiB, WS_VM = 1237 * MiB;
constexpr size_t WS_OA3 = 1253 * MiB, WS_LSEA = 1301 * MiB;
constexpr size_t WS_OCMP = 1303 * MiB, WS_OSLC = 1335 * MiB, WS_OWIN = 1367 * MiB, WS_OC = 1399 * MiB;
constexpr size_t WS_SEL = 1415 * MiB, WS_AMIX = 1416 * MiB;
constexpr size_t WS_IDX = 1480 * MiB, WS_GATEW = 1484 * MiB, WS_TOKSLOT = 1488 * MiB;
constexpr size_t WS_ACT = 1489 * MiB, WS_Y2 = 1761 * MiB, WS_END = 2033 * MiB;
static_assert((size_t)ACT_ROWS * 1024 * 2 <= 272 * MiB, "act rows");
static_assert((size_t)16 * SP * 64 * 2 + 65536 <= 9 * MiB, "kcmp");

constexpr int CW_TMO = 0, CW_FAIL = 2;
constexpr int CW_BAR = 4096;
constexpr int CW_QUEUE = 12288;
constexpr int CW_CONVQ = 13312;
constexpr int CW_CNT = 16384;

constexpr int RING_BYTES = 131072;
constexpr int AUX_OFF = RING_BYTES;
constexpr int MISC_OFF = AUX_OFF + 8192;
constexpr int LDS_BYTES = 147456;

DI unsigned pk2(float lo, float hi) { f32x2 v = {lo, hi}; bf16x2_t b = __builtin_convertvector(v, bf16x2_t); return __builtin_bit_cast(unsigned, b); }
DI float bf2f(unsigned short h) { return __uint_as_float(((unsigned)h) << 16); }
DI float bflo(unsigned w) { return __uint_as_float(w << 16); }
DI float bfhi(unsigned w) { return __uint_as_float(w & 0xffff0000u); }
typedef float f32x2c __attribute__((ext_vector_type(2)));
constexpr float Y2_SCALE = 16.0f, Y2_ISCALE = 1.0f / 16.0f;
DI unsigned pk4_fp8(float a, float b, float c, float d) {
    a = fminf(fmaxf(a * Y2_SCALE, -440.f), 440.f); b = fminf(fmaxf(b * Y2_SCALE, -440.f), 440.f); c = fminf(fmaxf(c * Y2_SCALE, -440.f), 440.f); d = fminf(fmaxf(d * Y2_SCALE, -440.f), 440.f);
    int w = __builtin_amdgcn_cvt_pk_fp8_f32(a, b, 0, false); w = __builtin_amdgcn_cvt_pk_fp8_f32(c, d, w, true); return (unsigned)w; }
DI f32x4 unpk4_fp8(unsigned w) { const f32x2c lo = __builtin_amdgcn_cvt_pk_f32_fp8((int)w, false), hi = __builtin_amdgcn_cvt_pk_f32_fp8((int)w, true); return (f32x4){lo.x, lo.y, hi.x, hi.y}; }
constexpr float W8_SCALE = 64.0f, A8_SCALE = 4.0f;
constexpr int W8_E8M0 = 127 - 6, A8_E8M0 = 127 - 2;
constexpr float H8_SCALE = 8.0f; constexpr int H8_E8M0 = 127 - 3;
DI int lane_id() { return (int)__builtin_amdgcn_mbcnt_hi(~0u, __builtin_amdgcn_mbcnt_lo(~0u, 0u)); }
DI unsigned pk4_fp8s(float a, float b, float c, float d, float sc) {
    a = fminf(fmaxf(a * sc, -440.f), 440.f); b = fminf(fmaxf(b * sc, -440.f), 440.f); c = fminf(fmaxf(c * sc, -440.f), 440.f); d = fminf(fmaxf(d * sc, -440.f), 440.f);
    int w = __builtin_amdgcn_cvt_pk_fp8_f32(a, b, 0, false); w = __builtin_amdgcn_cvt_pk_fp8_f32(c, d, w, true); return (unsigned)w; }
DI float q8s(float x, float sc) {
    const float a = fminf(fmaxf(x * sc, -440.f), 440.f); const int w = __builtin_amdgcn_cvt_pk_fp8_f32(a, a, 0, false);
    const f32x2c r = __builtin_amdgcn_cvt_pk_f32_fp8(w, false); return r.x; }
DI float wave_sum(float v) {
#pragma unroll
    for (int o = 1; o < 64; o <<= 1) v += __shfl_xor(v, o);
    return v;
}
DI float fast_exp2(float x) { return __builtin_amdgcn_exp2f(x); }
DI float fast_rcp(float x) { return __builtin_amdgcn_rcpf(x); }
DI float sigmoidf_(float x) { return fast_rcp(1.0f + fast_exp2(-x * LOG2E)); }
#define RLX_AGENT __ATOMIC_RELAXED, __HIP_MEMORY_SCOPE_AGENT

#define XB_TMO      128
#define XB_XCNT(j)  (256  + 64 * (j))
#define XB_XSUB(j)  (1280 + 64 * (j))
#define XB_XGEN(j)  (2304 + 64 * (j))
#define XB_TOP      3328
#define XB_TOPGEN   3392
#define XCD_BAR_WORDS 3456
#define XB_SPIN_CAP (1u << 22)
DI unsigned xb_ld(unsigned* p)              { return __hip_atomic_load(p, __ATOMIC_RELAXED, __HIP_MEMORY_SCOPE_AGENT); }
DI unsigned xb_add(unsigned* p, unsigned v) { return __hip_atomic_fetch_add(p, v, __ATOMIC_RELAXED, __HIP_MEMORY_SCOPE_AGENT); }
DI unsigned xb_xcc_id() { return (unsigned)__builtin_amdgcn_s_getreg((3 << 11) | 20) & 0xFu; }
#define XB_SPIN(cond, bar) do { unsigned _sp = 0; while (cond) { __builtin_amdgcn_s_sleep(1); \
    if ((++_sp & 255u) == 0u) { if (xb_ld(&(bar)[XB_TMO])) break; if (_sp > XB_SPIN_CAP) { atomicAdd(&(bar)[XB_TMO], 1u); break; } } } } while (0)
struct XcdBarrier { unsigned* bar; unsigned x; volatile LAS unsigned* st; };
DI XcdBarrier xcd_barrier_post(unsigned* bar, volatile LAS unsigned* st) {
    XcdBarrier b; b.bar = bar; b.x = xb_xcc_id(); b.st = st;
    if (threadIdx.x == 0) (void)xb_add(&bar[XB_XCNT(b.x)], 1u);
    return b;
}
DI void xcd_barrier_complete(unsigned* bar, unsigned x, unsigned& nloc, unsigned& nx) {
    const unsigned G = gridDim.x * gridDim.y * gridDim.z;
    unsigned sum, cnt, mine, sp = 0u;
    for (;;) {
        sum = 0u; cnt = 0u; mine = 0u;
#pragma unroll
        for (unsigned j = 0; j < 16; ++j) { const unsigned c = xb_ld(&bar[XB_XCNT(j)]); sum += c; cnt += (c > 0u) ? 1u : 0u; mine = (j == x) ? c : mine; }
        if (sum == G) break;
        __builtin_amdgcn_s_sleep(1);
        if ((++sp & 255u) == 0u) { if (xb_ld(&bar[XB_TMO])) break; if (sp > XB_SPIN_CAP) { atomicAdd(&bar[XB_TMO], 1u); break; } }
    }
    nloc = mine > 0u ? mine : 1u; nx = cnt > 0u ? cnt : 1u;
}
DI void xcd_barrier(const XcdBarrier& b) {
    asm volatile("s_waitcnt vmcnt(0)" ::: "memory");
    __syncthreads();
    unsigned* bar = b.bar; asm volatile("" : "+s"(bar));
    if (threadIdx.x == 0) {
        __builtin_amdgcn_s_waitcnt(0);
        unsigned nloc = b.st[0], nx = b.st[1];
        if (nloc == 0u) { xcd_barrier_complete(bar, b.x, nloc, nx); b.st[0] = nloc; b.st[1] = nx; }
        const unsigned old = xb_add(&bar[XB_XSUB(b.x)], 1u);
        const unsigned gen = old / nloc;
        if (old + 1u == (gen + 1u) * nloc) {
            __builtin_amdgcn_fence(__ATOMIC_RELEASE, "agent");
            asm volatile("s_waitcnt vmcnt(0)" ::: "memory");
            const unsigned og = xb_add(&bar[XB_TOP], 1u);
            const unsigned tg = og / nx;
            if (og + 1u == (tg + 1u) * nx) xb_add(&bar[XB_TOPGEN], 1u);
            else XB_SPIN(xb_ld(&bar[XB_TOPGEN]) == tg, bar);
            __builtin_amdgcn_fence(__ATOMIC_ACQUIRE, "agent");
            xb_add(&bar[XB_XGEN(b.x)], 1u);
            asm volatile("s_waitcnt vmcnt(0)" ::: "memory");
        } else {
            XB_SPIN(xb_ld(&bar[XB_XGEN(b.x)]) == gen, bar);
            __builtin_amdgcn_fence(__ATOMIC_ACQUIRE, "agent");
            asm volatile("s_waitcnt vmcnt(0)" ::: "memory");
        }
    }
    __syncthreads();
}

struct Args {
    const float* in[33];
    float* out;
    unsigned char* ws;
    int ph_lo, ph_hi;
};
enum { I_X = 0, I_C, I_POS, I_WADA, I_BADA, I_G1, I_G2, I_WIN, I_POSK, I_POSV, I_W1K, I_B1K, I_W2K, I_B2K, I_W1V, I_B1V, I_W2V, I_B2V,
       I_GQ, I_GKV, I_WQUP, I_WKVUP, I_GOA, I_GOB, I_GOC, I_WOUT, I_WR, I_BR, I_WE1, I_BE1, I_WE2, I_BE2, I_GF };

struct Ctx {
    LAS unsigned char* lds;
    const Args* a;
    unsigned char* ws;
    int tid, lane, wave, blk, G, vcu;
    size_t dofs; int dcnt;
};
DI const float* ginp(const Ctx& F, int i) { return (const float*)(GAS const float*)(F.a->in[i]); }
DI float* gout(const Ctx& F) { return (float*)(GAS float*)(F.a->out); }

namespace pg8 {
constexpr int BM = 256, BK = 64, HALF = 128, HTB = HALF * BK * 2;
DI int lds_byte(int r, int c) { const int st = (r >> 4) * 2 + (c >> 5), rr = r & 15, cc = c & 31, ob = rr * 64 + cc * 2; return st * 1024 + (ob ^ (((ob >> 9) & 1) << 5)); }
DI void stage_rc(int b, int& R, int& C) { const int st = b / 1024, sb = b % 1024, swz = sb ^ (((sb >> 9) & 1) << 5); R = (st >> 1) * 16 + swz / 64; C = (st & 1) * 32 + (swz % 64) / 2; }
DI int perm32(int rho) { const int n = rho >> 4, i = rho & 15; return 8 * (i >> 2) + 4 * n + (i & 3); }
struct Unit { const char* a; const char* b; int pm, pn, e, ml; };

template <class Epi, class Sched, bool GATHER, bool FP8 = false>
DI void gemm_phase(LAS unsigned char* lds, const int lda, const int K, const Sched& S, const Epi& E) {
    typedef int i32x4_ __attribute__((ext_vector_type(4))); typedef int i32x8_ __attribute__((ext_vector_type(8)));
    int tid_ = threadIdx.x; asm volatile("" : "+v"(tid_));
    const int tid = tid_, wid = __builtin_amdgcn_readfirstlane(tid >> 6), lane = tid & 63, wr = wid >> 2, wc = wid & 3, fr = lane & 15, fq = lane >> 4;
    const int nt = K / BK;
    int Rr[2], Cc[2]; unsigned voffB[2];
#pragma unroll
    for (int i = 0; i < 2; ++i) { int R, C; stage_rc(tid * 16 + i * 8192, R, C); Rr[i] = R; Cc[i] = C; const int Rb = Epi::PERM ? ((R & ~31) + perm32(R & 31)) : R; voffB[i] = (unsigned)(Rb * K + C) * 2u; }
    const size_t kstep = (size_t)(BK * 2);
    const size_t hstepB = (size_t)HALF * K * 2;
    const unsigned ldsw = (unsigned)wid * 1024u;
    const int aoff = lds_byte(wr * 64 + fr, fq * 8), boff = lds_byte(wc * 32 + fr, fq * 8);
#define PG8_SA(b, h) (((b) * 2 + (h)) * HTB)
#define PG8_SB(b, h) ((4 + (b) * 2 + (h)) * HTB)
#define PG8_STAGE_B(bufoff, gbase) do { _Pragma("unroll") for (int _i = 0; _i < 2; ++_i) \
        __builtin_amdgcn_global_load_lds((const unsigned*)((const char*)(gbase) + (size_t)_i * 64 * K * 2 + voffB[0]), (LAS unsigned*)(lds + (bufoff) + ldsw + _i * 8192), 16, 0, 0); } while (0)
#define PG8_STAGE_A(bufoff, gbase, v, h) do { _Pragma("unroll") for (int _i = 0; _i < 2; ++_i) { \
        if constexpr (GATHER) __builtin_amdgcn_global_load_lds((const unsigned*)((const char*)(gbase) + (v)[h][_i]), (LAS unsigned*)(lds + (bufoff) + ldsw + _i * 8192), 16, 0, 0); \
        else __builtin_amdgcn_global_load_lds((const unsigned*)((const char*)(gbase) + (size_t)((h) * 128 + _i * 64) * lda * 2 + (v)[0][0]), (LAS unsigned*)(lds + (bufoff) + ldsw + _i * 8192), 16, 0, 0); } } while (0)
#define PG8_SETOFF(v, u) do { _Pragma("unroll") for (int _h = 0; _h < 2; ++_h) _Pragma("unroll") for (int _i = 0; _i < 2; ++_i) { \
        if constexpr (GATHER) (v)[_h][_i] = S.gather_off((u), _h * 128 + Rr[_i]) + (unsigned)Cc[_i] * 2u; \
        else (v)[_h][_i] = (unsigned)((_h * 128 + Rr[_i]) * lda + Cc[_i]) * 2u; } } while (0)
#define PG8_LDA(dst, b, h) do { _Pragma("unroll") for (int m = 0; m < 4; ++m) { const i32x4_ lo_ = *(const LAS i32x4_*)(lds + PG8_SA(b, h) + aoff + m * 2048), hi_ = *(const LAS i32x4_*)(lds + PG8_SA(b, h) + aoff + m * 2048 + 1024); dst[m] = __builtin_shufflevector(lo_, hi_, 0, 1, 2, 3, 4, 5, 6, 7); } } while (0)
#define PG8_LDB(dst, b, h) do { _Pragma("unroll") for (int n = 0; n < 2; ++n) { const i32x4_ lo_ = *(const LAS i32x4_*)(lds + PG8_SB(b, h) + boff + n * 2048), hi_ = *(const LAS i32x4_*)(lds + PG8_SB(b, h) + boff + n * 2048 + 1024); dst[n] = __builtin_shufflevector(lo_, hi_, 0, 1, 2, 3, 4, 5, 6, 7); } } while (0)
#define PG8_H0(x) __builtin_bit_cast(bf16x8, __builtin_shufflevector((x), (x), 0, 1, 2, 3))
#define PG8_H1(x) __builtin_bit_cast(bf16x8, __builtin_shufflevector((x), (x), 4, 5, 6, 7))
#define PG8_MMA(ai, bj, At, Bt) do { __builtin_amdgcn_s_setprio(1); \
        if constexpr (FP8) { _Pragma("unroll") for (int m = 0; m < 4; ++m) _Pragma("unroll") for (int n = 0; n < 2; ++n) \
            asm volatile("v_mfma_scale_f32_16x16x128_f8f6f4 %0, %1, %2, %0, %3, %4 op_sel_hi:[0,0,0]" : "+v"(acc[ai][bj][m][n]) : "v"(Bt[n]), "v"(At[m]), "v"(scw_), "v"(sca_)); } \
        else { _Pragma("unroll") for (int m = 0; m < 4; ++m) _Pragma("unroll") for (int n = 0; n < 2; ++n) { \
            acc[ai][bj][m][n] = __builtin_amdgcn_mfma_f32_16x16x32_bf16(PG8_H0(Bt[n]), PG8_H0(At[m]), acc[ai][bj][m][n], 0, 0, 0); \
            acc[ai][bj][m][n] = __builtin_amdgcn_mfma_f32_16x16x32_bf16(PG8_H1(Bt[n]), PG8_H1(At[m]), acc[ai][bj][m][n], 0, 0, 0); } } \
        __builtin_amdgcn_s_setprio(0); } while (0)
#define PG8_WAIT_V(n) asm volatile("s_waitcnt vmcnt(" #n ")" ::: "memory")
#define PG8_WAIT_L(n) asm volatile("s_waitcnt lgkmcnt(" #n ")" ::: "memory")
#define PG8_BAR __builtin_amdgcn_s_barrier()
#define PG8_SCHED __builtin_amdgcn_sched_barrier(0)
    Unit cur, nxt; int ui = 0;
    if (!S.next(0, cur)) return;
    f32x4 acc[2][2][4][2];
#pragma unroll
    for (int a = 0; a < 2; ++a)
#pragma unroll
        for (int b = 0; b < 2; ++b)
#pragma unroll
            for (int m = 0; m < 4; ++m)
#pragma unroll
                for (int n = 0; n < 2; ++n) acc[a][b][m][n] = (f32x4){0.f, 0.f, 0.f, 0.f};
    int scw_ = W8_E8M0, sca_ = A8_E8M0; if constexpr (FP8) sca_ = Epi::A_E8M0;
    i32x8_ At[4], B0[2], B1[2];
    unsigned vA[2][2], vAn[2][2];
    PG8_SETOFF(vA, cur);
    const char* cA = cur.a; const char* cB = cur.b;
    PG8_STAGE_B(PG8_SB(0, 0), cB); PG8_STAGE_B(PG8_SB(0, 1), cB + hstepB); PG8_STAGE_A(PG8_SA(0, 0), cA, vA, 0); PG8_STAGE_A(PG8_SA(0, 1), cA, vA, 1);
    if (wr == 1) PG8_BAR;
    PG8_WAIT_V(2); PG8_BAR;
    PG8_STAGE_B(PG8_SB(1, 0), cB + kstep); PG8_STAGE_A(PG8_SA(1, 0), cA + kstep, vA, 0); PG8_STAGE_B(PG8_SB(1, 1), cB + hstepB + kstep);
    PG8_WAIT_V(6); PG8_BAR;
    for (;;) {
        const bool has_next = S.next(ui + 1, nxt);
        if constexpr (GATHER) {
            if (has_next) {
#pragma unroll
                for (int h = 0; h < 2; ++h)
#pragma unroll
                    for (int i = 0; i < 2; ++i) vAn[h][i] = S.gather_raw(nxt, h * 128 + Rr[i]);
            }
        }
        const char* nA = has_next ? nxt.a : cA; const char* nB = has_next ? nxt.b : cB;
#pragma unroll 1
        for (int t = 0; t < nt; t += 2) {
            const bool last = (t == nt - 2);
            const char* a1 = cA + (size_t)(t + 1) * kstep;
            const char* a2 = last ? nA : cA + (size_t)(t + 2) * kstep; const char* b2 = last ? nB : cB + (size_t)(t + 2) * kstep;
            const char* a3 = a2 + kstep; const char* b3 = b2 + kstep;
            unsigned v2[2][2];
#pragma unroll
            for (int h = 0; h < 2; ++h)
#pragma unroll
                for (int i = 0; i < 2; ++i) v2[h][i] = vA[h][i];
            if constexpr (GATHER) {
                if (last && has_next) {
#pragma unroll
                    for (int h = 0; h < 2; ++h)
#pragma unroll
                        for (int i = 0; i < 2; ++i) { vAn[h][i] = vAn[h][i] * (unsigned)(lda * 2) + (unsigned)Cc[i] * 2u; v2[h][i] = vAn[h][i]; }
                }
            }
            PG8_LDB(B0, 0, 0); PG8_LDB(B1, 0, 1); PG8_SCHED; PG8_LDA(At, 0, 0); PG8_STAGE_A(PG8_SA(1, 1), a1, vA, 1);
            PG8_WAIT_V(8); PG8_WAIT_L(0); PG8_BAR; PG8_MMA(0, 0, At, B0); PG8_MMA(0, 1, At, B1); PG8_BAR; PG8_SCHED;
            PG8_LDA(At, 0, 1); PG8_STAGE_B(PG8_SB(0, 0), b2); PG8_STAGE_B(PG8_SB(0, 1), b2 + hstepB); PG8_STAGE_A(PG8_SA(0, 0), a2, v2, 0);
            PG8_WAIT_V(8); PG8_WAIT_L(0); PG8_BAR; PG8_MMA(1, 0, At, B0); PG8_MMA(1, 1, At, B1); PG8_BAR; PG8_SCHED;
            PG8_LDB(B0, 1, 0); PG8_LDB(B1, 1, 1); PG8_SCHED; PG8_LDA(At, 1, 0); PG8_STAGE_A(PG8_SA(0, 1), a2, v2, 1);
            PG8_WAIT_V(8); PG8_WAIT_L(0); PG8_BAR; PG8_MMA(0, 0, At, B0); PG8_MMA(0, 1, At, B1); PG8_BAR; PG8_SCHED;
            PG8_LDA(At, 1, 1); PG8_STAGE_B(PG8_SB(1, 0), b3); PG8_STAGE_B(PG8_SB(1, 1), b3 + hstepB); PG8_STAGE_A(PG8_SA(1, 0), a3, v2, 0);
            PG8_WAIT_V(8); PG8_WAIT_L(0); PG8_BAR; PG8_MMA(1, 0, At, B0); PG8_MMA(1, 1, At, B1); PG8_BAR; PG8_SCHED;
        }
        if (wr == 0) PG8_BAR;
        if constexpr (FP8) asm volatile("s_nop 15\n\ts_nop 15" ::: "memory");
        if constexpr (!Epi::AFTER_DRAIN) { int fr_ = fr, fq_ = fq; asm volatile("" : "+v"(fr_), "+v"(fq_)); E(acc, cur, wr, wc, fr_, fq_); }
        if (!has_next) break;
#pragma unroll
        for (int a = 0; a < 2; ++a)
#pragma unroll
            for (int b = 0; b < 2; ++b)
#pragma unroll
                for (int m = 0; m < 4; ++m)
#pragma unroll
                    for (int n = 0; n < 2; ++n) acc[a][b][m][n] = (f32x4){0.f, 0.f, 0.f, 0.f};
        cur = nxt; cA = nA; cB = nB; ++ui;
        if constexpr (GATHER) {
#pragma unroll
            for (int h = 0; h < 2; ++h)
#pragma unroll
                for (int i = 0; i < 2; ++i) vA[h][i] = vAn[h][i];
        }
        if (wr == 1) PG8_BAR;
    }
    PG8_WAIT_V(0);
    PG8_BAR;
    if constexpr (Epi::AFTER_DRAIN) { int fr_ = fr, fq_ = fq; asm volatile("" : "+v"(fr_), "+v"(fq_)); E.fused(acc, cur, wr, wc, fr_, fq_, lds, wid, lane); }
#undef PG8_SA
#undef PG8_SB
#undef PG8_STAGE_A
#undef PG8_STAGE_B
#undef PG8_SETOFF
#undef PG8_LDA
#undef PG8_LDB
#undef PG8_MMA
#undef PG8_H0
#undef PG8_H1
#undef PG8_WAIT_V
#undef PG8_WAIT_L
#undef PG8_BAR
#undef PG8_SCHED
}
}
using pg8::Unit;
typedef f32x4 AccT[2][2][4][2];

struct SchedGrid {
    const char* A; const char* B; int lda, K, nN, nwg, G, c;
    DI bool next(int i, Unit& u) const {
        const int L = i * G + c; if (L >= nwg) return false;
        u.pm = L / nN; u.pn = L % nN; u.e = 0; u.ml = 0;
        u.a = A + (size_t)u.pm * 256 * lda * 2; u.b = B + (size_t)u.pn * 256 * K * 2; return true;
    }
    DI unsigned gather_off(const Unit&, int) const { return 0u; }
    DI unsigned gather_raw(const Unit&, int) const { return 0u; }
};
struct SchedCmp {
    const char* KCMP; const char* VCMP; const char* W; int G, c;
    DI bool next(int i, Unit& u) const {
        const int L = i * G + c; if (L >= 32) return false;
        const int kv = L >> 4, bg = L & 15;
        u.pm = L; u.pn = 0; u.e = kv; u.ml = 0;
        u.a = (kv ? VCMP : KCMP) + (size_t)bg * SP * 64 * 2; u.b = W + (size_t)kv * 256 * 2048 * 2; return true;
    }
    DI unsigned gather_off(const Unit&, int) const { return 0u; }
    DI unsigned gather_raw(const Unit&, int) const { return 0u; }
};
struct SchedMla {
    const char* CQ; const char* MISC; const char* WQ; const char* WKV; int G, c;
    DI bool next(int i, Unit& u) const {
        const int L = i * G + c; if (L >= 512) return false;
        const int which = L >> 8, r = L & 255;
        u.pm = r >> 1; u.pn = r & 1; u.e = which; u.ml = 0;
        u.a = (which ? MISC : CQ) + (size_t)u.pm * 256 * 256 * 2; u.b = (which ? WKV : WQ) + (size_t)u.pn * 256 * 256 * 2; return true;
    }
    DI unsigned gather_off(const Unit&, int) const { return 0u; }
    DI unsigned gather_raw(const Unit&, int) const { return 0u; }
};
template <int NT, bool GATHERED>
struct SchedMoe {
    const LAS int* tb; const LAS int* cnt; const char* A; const char* W; const int* IDX; int total, G, c;
    DI bool next(int i, Unit& u) const {
        const int L = i * G + c; if (L >= total) return false;
        const int mtg = L / NT; u.pn = L % NT;
        const int ln_ = threadIdx.x & 63;
        const int e = __popcll(__ballot(ln_ < 32 && tb[ln_ & 31] <= mtg)) - 1;
        u.e = e; u.ml = mtg - tb[e]; u.pm = mtg;
        u.a = GATHERED ? A : A + (size_t)mtg * 256 * 1024 * 2;
        u.b = W + ((size_t)e * NT * 256 + (size_t)u.pn * 256) * 1024 * 2; return true;
    }
    DI unsigned gather_off(const Unit& u, int row) const {
        const int pos = u.ml * 256 + row; const int tok = (pos < cnt[u.e]) ? IDX[u.e * ECAP + pos] : 0;
        return (unsigned)tok * 2048u;
    }
    DI unsigned gather_raw(const Unit& u, int row) const {
        const int pos = u.ml * 256 + row;
        return (unsigned)IDX[u.e * ECAP + (pos < cnt[u.e] ? pos : 0)];
    }
};

struct SchedMoe1F8 {
    static constexpr bool HOOK = false;
    const LAS int* tb; const LAS int* cnt; const char* A; const char* W; const int* IDX; int total, G, c;
    DI bool next(int i, Unit& u) const {
        const int L = i * G + c; if (L >= total) return false;
        const int mtg = L >> 3; u.pn = L & 7;
        const int ln_ = lane_id();
        const int e = __popcll(__ballot(ln_ < 32 && tb[ln_ & 31] <= mtg)) - 1;
        u.e = e; u.ml = mtg - tb[e]; u.pm = mtg;
        u.a = A; u.b = W + ((size_t)e * 2048 + (size_t)u.pn * 256) * 1024; return true;
    }
    DI unsigned gather_raw(const Unit& u, int row) const { const int pos = u.ml * 256 + row; return (unsigned)IDX[u.e * ECAP + (pos < cnt[u.e] ? pos : 0)]; }
    DI unsigned gather_off(const Unit& u, int row) const { return gather_raw(u, row) * 1024u; }
};
struct SchedMoe2F8 {
    static constexpr bool HOOK = false;
    const LAS int* tb; const char* A; const char* W; int total, G, c;
    DI bool next(int i, Unit& u) const {
        const int L = i * G + c; if (L >= total) return false;
        const int mtg = L >> 2; u.pn = L & 3;
        const int ln_ = lane_id();
        const int e = __popcll(__ballot(ln_ < 32 && tb[ln_ & 31] <= mtg)) - 1;
        u.e = e; u.ml = mtg - tb[e]; u.pm = mtg;
        u.a = A + (size_t)mtg * 256 * 1024; u.b = W + ((size_t)e * 1024 + (size_t)u.pn * 256) * 1024; return true;
    }
    DI unsigned gather_off(const Unit&, int) const { return 0u; }
    DI unsigned gather_raw(const Unit&, int) const { return 0u; }
};

DI void rot4(f32x4& v0, f32x4& v1, const f32x4 c, const f32x4 s) {
    const float a0 = v0[0], b0 = v0[1], a1 = v0[2], b1 = v0[3], a2 = v1[0], b2 = v1[1], a3 = v1[2], b3 = v1[3];
    v0[0] = a0 * c[0] - b0 * s[0]; v0[1] = b0 * c[0] + a0 * s[0];
    v0[2] = a1 * c[1] - b1 * s[1]; v0[3] = b1 * c[1] + a1 * s[1];
    v1[0] = a2 * c[2] - b2 * s[2]; v1[1] = b2 * c[2] + a2 * s[2];
    v1[2] = a3 * c[3] - b3 * s[3]; v1[3] = b3 * c[3] + a3 * s[3];
}
DI u32x4 pack8(const f32x4 v0, const f32x4 v1) { u32x4 w; w.x = pk2(v0[0], v0[1]); w.y = pk2(v0[2], v0[3]); w.z = pk2(v1[0], v1[1]); w.w = pk2(v1[2], v1[3]); return w; }

struct EpiWin {
    static constexpr bool PERM = true, AFTER_DRAIN = false;
    unsigned char* ws; const float* CS64; const float* CS32;
    DI void operator()(const AccT& acc, const Unit& u, int wr, int wc, int fr, int fq) const {
#pragma unroll
        for (int bj = 0; bj < 2; ++bj) {
            const int w0 = bj * 128 + wc * 32;
            size_t off; int ld, dcol, mode = 0, gm = 0, g = 0; float sc = 1.f;
            switch (u.pn) {
                case 0: off = WS_QA; ld = 256; dcol = w0; mode = 1; sc = SCL64; break;
                case 1: off = WS_KA; ld = 256; dcol = w0; mode = 1; break;
                case 2: off = WS_VA; ld = 256; dcol = w0; break;
                case 3: off = WS_QB; ld = 512; dcol = w0; mode = 1; sc = SCL64; break;
                case 4: off = WS_QB; ld = 512; dcol = 256 + w0; mode = 1; sc = SCL64; break;
                case 5: off = (w0 < 128) ? WS_KCMP : WS_VCMP; ld = 64; gm = 1; g = (w0 & 127) >> 6; dcol = w0 & 63; break;
                case 6: off = (w0 < 128) ? WS_KSLC : WS_VSLC; ld = 128; dcol = w0 & 127; mode = (w0 < 128) ? 1 : 0; break;
                case 7: off = (w0 < 128) ? WS_KWIN : WS_VWIN; ld = 128; dcol = w0 & 127; mode = (w0 < 128) ? 1 : 0; break;
                case 8: off = WS_CQ; ld = 256; dcol = w0; break;
                default: if (w0 == 128) { off = WS_KR; ld = 32; dcol = 0; mode = 2; } else { off = WS_MISC; ld = 256; dcol = w0; } break;
            }
            bf16* base = (bf16*)(ws + off);
            const int i0 = 16 * (wc & 1) + 4 * fq;
#pragma unroll
            for (int ai = 0; ai < 2; ++ai) {
                f32x4 cc[4], sn[4];
                if (mode) {
#pragma unroll
                    for (int m = 0; m < 4; ++m) {
                        const int row = u.pm * 256 + ai * 128 + wr * 64 + m * 16 + fr;
                        const float* cs = (mode == 1) ? CS64 + (size_t)row * 64 + i0 : CS32 + (size_t)row * 32 + 4 * fq;
                        cc[m] = *(const f32x4*)cs; sn[m] = *(const f32x4*)(cs + (mode == 1 ? 32 : 16));
                    }
                }
#pragma unroll
                for (int m = 0; m < 4; ++m) {
                    const int row = u.pm * 256 + ai * 128 + wr * 64 + m * 16 + fr;
                    f32x4 v0 = acc[ai][bj][m][0], v1 = acc[ai][bj][m][1];
                    if (mode) rot4(v0, v1, cc[m], sn[m]);
                    v0 = v0 * sc; v1 = v1 * sc;
                    const size_t drow = gm ? (size_t)(((row >> 12) * 2 + g) * SP + (row & 4095)) : (size_t)row;
                    *(u32x4*)(base + drow * ld + dcol + 8 * fq) = pack8(v0, v1);
                }
            }
        }
    }
};
struct EpiCmp {
    static constexpr bool PERM = true, AFTER_DRAIN = true;
    const float* B1P; const bf16* W2T; const float *B2K, *B2V; bf16 *KC, *VC; const float* CS64;
    DI void fused(const AccT& acc, const Unit& u, int wr, int wc, int fr, int fq, LAS unsigned char* lds, int wid, int lane) const {
        constexpr int HST = 528;
        const int kv = u.e, bg = u.pm & 15;
#pragma unroll
        for (int bj = 0; bj < 2; ++bj) {
            const int col = bj * 128 + wc * 32 + 8 * fq;
            const f32x4 b0 = *(const f32x4*)(B1P + kv * 256 + col), b1 = *(const f32x4*)(B1P + kv * 256 + col + 4);
#pragma unroll
            for (int ai = 0; ai < 2; ++ai)
#pragma unroll
                for (int m = 0; m < 4; ++m) {
                    const int rl = ai * 128 + wr * 64 + m * 16 + fr;
                    f32x4 v0 = acc[ai][bj][m][0] + b0, v1 = acc[ai][bj][m][1] + b1;
#pragma unroll
                    for (int j = 0; j < 4; ++j) {
                        float x = v0[j]; float z = 0.7978845608028654f * (x + 0.044715f * x * x * x); v0[j] = x * sigmoidf_(2.f * z);
                        x = v1[j]; z = 0.7978845608028654f * (x + 0.044715f * x * x * x); v1[j] = x * sigmoidf_(2.f * z);
                    }
                    *(LAS u32x4*)(lds + rl * HST + col * 2) = pack8(v0, v1);
                }
        }
        asm volatile("s_waitcnt lgkmcnt(0)\n\ts_barrier" ::: "memory");
        const int r32 = lane & 31, hh = lane >> 5;
        f32x16 out0 = {0.f, 0.f, 0.f, 0.f, 0.f, 0.f, 0.f, 0.f, 0.f, 0.f, 0.f, 0.f, 0.f, 0.f, 0.f, 0.f}, out1 = out0;
        const bf16* w2 = W2T + (size_t)kv * 64 * 256;
#pragma unroll 4
        for (int ks = 0; ks < 16; ++ks) {
            const bf16x8 a = *(const LAS bf16x8*)(lds + (32 * wid + r32) * HST + (16 * ks + 8 * hh) * 2);
            const bf16x8 bq0 = *(const bf16x8*)(w2 + (size_t)r32 * 256 + 16 * ks + 8 * hh), bq1 = *(const bf16x8*)(w2 + (size_t)(32 + r32) * 256 + 16 * ks + 8 * hh);
            out0 = __builtin_amdgcn_mfma_f32_32x32x16_bf16(a, bq0, out0, 0, 0, 0); out1 = __builtin_amdgcn_mfma_f32_32x32x16_bf16(a, bq1, out1, 0, 0, 0);
        }
        const float* b2 = kv ? B2V : B2K;
        const float bb0 = b2[r32], bb1 = b2[32 + r32];
        const int b = bg >> 1;
#pragma unroll
        for (int i = 0; i < 16; ++i) {
            const int c = 32 * wid + 8 * (i >> 2) + 4 * hh + (i & 3);
            const size_t row = (size_t)bg * 256 + c;
            float x1 = out0[i] + bb0, x2 = out1[i] + bb1;
            if (c == 255) { x1 = 0.f; x2 = 0.f; }
            if (kv == 0) {
                const int tokr = (b * S + 16 * c + 31) & (T - 1);
                const float cs = CS64[(size_t)tokr * 64 + r32], sn = CS64[(size_t)tokr * 64 + 32 + r32];
                *(unsigned*)(KC + row * 64 + 2 * r32) = pk2(x1 * cs - x2 * sn, x2 * cs + x1 * sn);
            } else {
                VC[row * 64 + r32] = (bf16)(pk2(x1, 0.f) & 0xffffu); VC[row * 64 + 32 + r32] = (bf16)(pk2(x2, 0.f) & 0xffffu);
            }
        }
    }
};
struct EpiMla {
    static constexpr bool PERM = true, AFTER_DRAIN = false;
    bf16 *QM, *KN, *VM; const bf16 *CQ, *MISC; const float* CS32;
    DI void operator()(const AccT& acc, const Unit& u, int wr, int wc, int fr, int fq) const {
        float rstd[2][4];
#pragma unroll
        for (int ai = 0; ai < 2; ++ai)
#pragma unroll
            for (int m = 0; m < 4; ++m) {
                const int row = u.pm * 256 + ai * 128 + wr * 64 + m * 16 + fr;
                float ss = 0.f;
                if (u.e == 0) {
#pragma unroll
                    for (int c = 0; c < 8; ++c) { const u32x4 w = *(const u32x4*)(CQ + (size_t)row * 256 + fq * 64 + 8 * c);
                        ss += bflo(w.x) * bflo(w.x) + bfhi(w.x) * bfhi(w.x) + bflo(w.y) * bflo(w.y) + bfhi(w.y) * bfhi(w.y) + bflo(w.z) * bflo(w.z) + bfhi(w.z) * bfhi(w.z) + bflo(w.w) * bflo(w.w) + bfhi(w.w) * bfhi(w.w); }
                } else {
#pragma unroll
                    for (int c = 0; c < 4; ++c) { const u32x4 w = *(const u32x4*)(MISC + (size_t)row * 256 + fq * 32 + 8 * c);
                        ss += bflo(w.x) * bflo(w.x) + bfhi(w.x) * bfhi(w.x) + bflo(w.y) * bflo(w.y) + bfhi(w.y) * bfhi(w.y) + bflo(w.z) * bflo(w.z) + bfhi(w.z) * bfhi(w.z) + bflo(w.w) * bflo(w.w) + bfhi(w.w) * bfhi(w.w); }
                }
                ss += __shfl_xor(ss, 16); ss += __shfl_xor(ss, 32);
                rstd[ai][m] = rsqrtf(ss * (u.e == 0 ? (1.0f / 256.0f) : (1.0f / 128.0f)) + EPS);
            }
#pragma unroll
        for (int bj = 0; bj < 2; ++bj) {
            const int gc = u.pn * 256 + bj * 128 + wc * 32;
            bf16* base; int ld, dcol, rope = 0; float sc = 1.f;
            if (u.e == 0) { if (gc >= 384) continue; rope = ((gc >> 5) % 3) == 2; base = QM; ld = 384; dcol = gc; sc = SCL96; }
            else { const int head = gc >> 7, part = (gc & 127) >> 6, o = gc & 63; base = part ? VM : KN; ld = 256; dcol = head * 64 + o; }
#pragma unroll
            for (int ai = 0; ai < 2; ++ai) {
                f32x4 cc[4], sn[4];
                if (rope) {
#pragma unroll
                    for (int m = 0; m < 4; ++m) { const float* cs = CS32 + (size_t)(u.pm * 256 + ai * 128 + wr * 64 + m * 16 + fr) * 32 + 4 * fq; cc[m] = *(const f32x4*)cs; sn[m] = *(const f32x4*)(cs + 16); }
                }
#pragma unroll
                for (int m = 0; m < 4; ++m) {
                    const int row = u.pm * 256 + ai * 128 + wr * 64 + m * 16 + fr;
                    const float r = rstd[ai][m] * sc;
                    f32x4 v0 = acc[ai][bj][m][0] * r, v1 = acc[ai][bj][m][1] * r;
                    if (rope) rot4(v0, v1, cc[m], sn[m]);
                    *(u32x4*)(base + (size_t)row * ld + dcol + 8 * fq) = pack8(v0, v1);
                }
            }
        }
    }
};
struct EpiWout {
    static constexpr bool PERM = false, AFTER_DRAIN = false;
    bf16* X; const float* GT; size_t dofs;
    DI void operator()(const AccT& acc, const Unit& u, int wr, int wc, int fr, int fq) const {
        const int b = (u.pm * 256) >> 12;
        const int col0 = u.pn * 256 + wc * 32 + 4 * fq;
#pragma unroll
        for (int bj = 0; bj < 2; ++bj) {
#pragma unroll
            for (int n = 0; n < 2; ++n) {
                u32x2 xo[2][4];
                const f32x4 gt = *(const f32x4*)(GT + (size_t)b * 6144 + col0 + bj * 128 + n * 16);
#pragma unroll
                for (int ai = 0; ai < 2; ++ai)
#pragma unroll
                    for (int m = 0; m < 4; ++m) xo[ai][m] = *(const u32x2*)(X + (size_t)(u.pm * 256 + ai * 128 + wr * 64 + m * 16 + fr) * 1024 + col0 + bj * 128 + n * 16);
#pragma unroll
                for (int ai = 0; ai < 2; ++ai)
#pragma unroll
                    for (int m = 0; m < 4; ++m) {
                        bf16* p = X + (size_t)(u.pm * 256 + ai * 128 + wr * 64 + m * 16 + fr) * 1024 + col0 + bj * 128 + n * 16;
                        const f32x4 xv = (f32x4){bflo(xo[ai][m].x), bfhi(xo[ai][m].x), bflo(xo[ai][m].y), bfhi(xo[ai][m].y)} + gt * acc[ai][bj][m][n];
                        u32x2 w; w.x = pk2(xv[0], xv[1]); w.y = pk2(xv[2], xv[3]);
                        *(u32x2*)((char*)p + dofs) = w;
                    }
            }
        }
    }
};
struct EpiMoe1 {
    static constexpr bool PERM = true, AFTER_DRAIN = false; static constexpr int A_E8M0 = H8_E8M0;
    bf16* ACT; const float* B1;
    DI void operator()(const AccT& acc, const Unit& u, int wr, int wc, int fr, int fq) const {
#pragma unroll
        for (int bj = 0; bj < 2; ++bj) {
            const int col = u.pn * 256 + bj * 128 + wc * 32 + 8 * fq;
            const f32x4 b0 = *(const f32x4*)(B1 + (size_t)u.e * 2048 + col), b1 = *(const f32x4*)(B1 + (size_t)u.e * 2048 + col + 4);
#pragma unroll
            for (int ai = 0; ai < 2; ++ai)
#pragma unroll
                for (int m = 0; m < 4; ++m) {
                    const int row = u.pm * 256 + ai * 128 + wr * 64 + m * 16 + fr;
                    const f32x4 v0 = acc[ai][bj][m][0] + b0, v1 = acc[ai][bj][m][1] + b1;
                    float o[4];
#pragma unroll
                    for (int j = 0; j < 4; ++j) {
                        const float gl = fminf((j < 2) ? v0[2 * j] : v1[2 * j - 4], 7.0f);
                        const float li = fminf(fmaxf((j < 2) ? v0[2 * j + 1] : v1[2 * j - 3], -7.0f), 7.0f);
                        o[j] = gl * sigmoidf_(1.702f * gl) * (li + 1.0f);
                    }
                    *(unsigned*)((unsigned char*)ACT + (size_t)row * 1024 + (col >> 1)) = pk4_fp8s(o[0], o[1], o[2], o[3], A8_SCALE);
                }
        }
    }
};
struct EpiMoe2 {
    static constexpr bool PERM = true, AFTER_DRAIN = false; static constexpr int A_E8M0 = A8_E8M0;
    unsigned char* Y2; const float* B2; const float* GATEW;
    DI void operator()(const AccT& acc, const Unit& u, int wr, int wc, int fr, int fq) const {
        float gwv[2][4];
#pragma unroll
        for (int ai = 0; ai < 2; ++ai)
#pragma unroll
            for (int m = 0; m < 4; ++m) gwv[ai][m] = GATEW[(size_t)u.e * ECAP + u.ml * 256 + ai * 128 + wr * 64 + m * 16 + fr];
        f32x4 bb[2][2];
#pragma unroll
        for (int bj = 0; bj < 2; ++bj) { const int col = u.pn * 256 + bj * 128 + wc * 32 + 8 * fq; bb[bj][0] = *(const f32x4*)(B2 + (size_t)u.e * 1024 + col); bb[bj][1] = *(const f32x4*)(B2 + (size_t)u.e * 1024 + col + 4); }
#pragma unroll
        for (int ai = 0; ai < 2; ++ai)
#pragma unroll
            for (int m = 0; m < 4; ++m) {
                const int rl = ai * 128 + wr * 64 + m * 16 + fr;
                const float gw = gwv[ai][m];
                const size_t row = (size_t)u.pm * 256 + rl;
#pragma unroll
                for (int bj = 0; bj < 2; ++bj) {
                    const int col = u.pn * 256 + bj * 128 + wc * 32 + 8 * fq;
                    const f32x4 v0 = (acc[ai][bj][m][0] + bb[bj][0]) * gw, v1 = (acc[ai][bj][m][1] + bb[bj][1]) * gw;
                    { u32x2 w8; w8.x = pk4_fp8(v0[0], v0[1], v0[2], v0[3]); w8.y = pk4_fp8(v1[0], v1[1], v1[2], v1[3]); *(u32x2*)(Y2 + row * 1024 + col) = w8; }
                }
            }
    }
};

#define MFMA32(a, b, c) __builtin_amdgcn_mfma_f32_32x32x16_bf16((a), (b), (c), 0, 0, 0)
typedef short v4i16_t __attribute__((ext_vector_type(4)));
DI s16x4 tr_read(const LAS unsigned char* p) { return __builtin_bit_cast(s16x4, __builtin_amdgcn_ds_read_tr16_b64_v4i16((LAS v4i16_t*)p)); }
constexpr int VST = 144;
template <int DQ> struct AC { static constexpr int KST = DQ * 2 + 16, KS = DQ / 16, KBUF = 64 * KST, VBUF = 64 * VST, BUF = KBUF + VBUF; };

template <int DQ>
DI void qk_tile(const LAS unsigned char* kb, const bf16x8 (&qf)[DQ / 16], f32x16 (&s)[2], const f32x16& cinit, int lane) {
    const int r32 = lane & 31, hh = lane >> 5;
    bf16x8 kf[2][DQ / 16];
#pragma unroll
    for (int rt = 0; rt < 2; ++rt)
#pragma unroll
        for (int ks = 0; ks < DQ / 16; ++ks) kf[rt][ks] = *(const LAS bf16x8*)(kb + (32 * rt + r32) * AC<DQ>::KST + (16 * ks + 8 * hh) * 2);
    f32x16 a0 = MFMA32(kf[0][0], qf[0], cinit), a1 = MFMA32(kf[1][0], qf[0], cinit);
#pragma unroll
    for (int ks = 1; ks < DQ / 16; ++ks) { a0 = MFMA32(kf[0][ks], qf[ks], a0); a1 = MFMA32(kf[1][ks], qf[ks], a1); }
    s[0] = a0; s[1] = a1;
}
DI float max3f_(float a, float b, float c) { return __builtin_fmaxf(__builtin_fmaxf(a, b), c); }
constexpr float RESC_THR = 8.0f;
template <int DQ, int KMUL, int VAR = 0>
DI void attn_tile(const LAS unsigned char* kb, const LAS unsigned char* vb, const bf16x8 (&qf)[DQ / 16], f32x16 (&o)[2], f32x16& negm, float& m, float& l,
                  int dq, unsigned maxd, bool lf, int lane, const bool MASKED) {
    const int hh = lane >> 5;
    if (VAR == 1) return;
    f32x16 s[2];
    qk_tile<DQ>(kb, qf, s, negm, lane);
    if (VAR == 2) { o[0] += s[0]; o[1] += s[1]; return; }
    const int i16 = lane & 15, q = i16 >> 2, p_ = i16 & 3, mh = (lane >> 4) & 1;
    const LAS unsigned char* vbase = vb + (4 * hh + q) * VST + 32 * mh + 8 * p_;
    s16x4 vlo[4][2], vhi[4][2];
#pragma unroll
    for (int st = 0; st < 4; ++st)
#pragma unroll
        for (int mt = 0; mt < 2; ++mt) { vlo[st][mt] = tr_read(vbase + (16 * st) * VST + 64 * mt); vhi[st][mt] = tr_read(vbase + (16 * st + 8) * VST + 64 * mt); }
    __builtin_amdgcn_sched_barrier(0);
    if (MASKED) {
#pragma unroll
        for (int rt = 0; rt < 2; ++rt)
#pragma unroll
            for (int i = 0; i < 16; ++i) {
                const int d = dq - (32 * rt + 8 * (i >> 2) + (i & 3)) * KMUL;
                s[rt][i] = ((unsigned)d <= maxd) ? s[rt][i] : -1e30f;
            }
    }
    float mx = max3f_(s[0][0], s[0][1], s[0][2]);
#pragma unroll
    for (int i = 3; i < 15; i += 2) mx = max3f_(mx, s[0][i], s[0][i + 1]);
    mx = max3f_(mx, s[0][15], s[1][0]);
#pragma unroll
    for (int i = 1; i < 15; i += 2) mx = max3f_(mx, s[1][i], s[1][i + 1]);
    mx = fmaxf(mx, s[1][15]);
    if (__ballot(lf && mx > RESC_THR) != 0ull) {
        float mc = lf ? mx : -1e30f;
        mc = fmaxf(mc, __shfl_xor(mc, 32));
        const float delta = mc > RESC_THR ? mc : 0.f;
        const float alpha = fast_exp2(-delta);
        m += delta; l *= alpha;
#pragma unroll
        for (int i = 0; i < 16; ++i) { negm[i] = -m; o[0][i] *= alpha; o[1][i] *= alpha; s[0][i] -= delta; s[1][i] -= delta; }
    }
    float ps = 0.f;
#pragma unroll
    for (int rt = 0; rt < 2; ++rt)
#pragma unroll
        for (int i = 0; i < 16; ++i) { const float p = fast_exp2(s[rt][i]); s[rt][i] = p; ps += p; }
    const unsigned lmask = lf ? 0xffffffffu : 0u;
    l += lf ? ps : 0.f;
    if (VAR == 3) { o[0] += s[0]; o[1] += s[1]; return; }
#pragma unroll
    for (int rt = 0; rt < 2; ++rt)
#pragma unroll
        for (int s2 = 0; s2 < 2; ++s2) {
            u32x4 pw; pw.x = pk2(s[rt][8 * s2 + 0], s[rt][8 * s2 + 1]) & lmask; pw.y = pk2(s[rt][8 * s2 + 2], s[rt][8 * s2 + 3]) & lmask;
            pw.z = pk2(s[rt][8 * s2 + 4], s[rt][8 * s2 + 5]) & lmask; pw.w = pk2(s[rt][8 * s2 + 6], s[rt][8 * s2 + 7]) & lmask;
            const bf16x8 pb = __builtin_bit_cast(bf16x8, pw);
#pragma unroll
            for (int mt = 0; mt < 2; ++mt) {
                const bf16x8 va = __builtin_shufflevector(vlo[2 * rt + s2][mt], vhi[2 * rt + s2][mt], 0, 1, 2, 3, 4, 5, 6, 7);
                o[mt] = MFMA32(va, pb, o[mt]);
            }
        }
}
constexpr int OSTAGE_WAVE = 32 * 144;
static_assert(102400 + 8 * OSTAGE_WAVE <= MISC_OFF, "O stage below the LDS control words");
template <class P>
DI void store_o_rows(const P& p, LAS unsigned char* lds, int off, const f32x16 (&o)[2], float inv, int lane, int wave) {
    LAS unsigned char* st = lds + off + wave * OSTAGE_WAVE;
    const int n = lane & 31, hh = lane >> 5;
#pragma unroll
    for (int mt = 0; mt < 2; ++mt)
#pragma unroll
        for (int a = 0; a < 4; ++a) {
            u32x2 w; w.x = pk2(o[mt][4 * a] * inv, o[mt][4 * a + 1] * inv); w.y = pk2(o[mt][4 * a + 2] * inv, o[mt][4 * a + 3] * inv);
            *(LAS u32x2*)(st + n * 144 + (32 * mt + 8 * a + 4 * hh) * 2) = w;
        }
    asm volatile("s_waitcnt lgkmcnt(0)" ::: "memory");
#pragma unroll
    for (int it = 0; it < 4; ++it) {
        const int r = (lane >> 3) + 8 * it, c = lane & 7;
        const u32x4 v = *(const LAS u32x4*)(st + r * 144 + c * 16);
        *(u32x4*)(p.orow(wave, r) + 8 * c) = v;
    }
}
DI void store_o(bf16* orow, const f32x16 (&o)[2], float inv, int lane) {
    const int hh = lane >> 5;
#pragma unroll
    for (int mt = 0; mt < 2; ++mt)
#pragma unroll
        for (int a = 0; a < 4; ++a) {
            u32x2 w; w.x = pk2(o[mt][4 * a] * inv, o[mt][4 * a + 1] * inv); w.y = pk2(o[mt][4 * a + 2] * inv, o[mt][4 * a + 3] * inv);
            *(u32x2*)(orow + 32 * mt + 8 * a + 4 * hh) = w;
        }
}

struct PolA {
    static constexpr bool HASFLAG = false, LSE = true; static constexpr int KMUL = 1;
    const bf16 *Q, *K, *V; bf16* O; float* LSEP; int b, h, d, r, c; unsigned maxd; int j0, j1;
    DI int ql(int w, int lane) const { return 256 * c + 32 * w + (lane & 31); }
    DI size_t trow(int l_) const { return (size_t)b * S + (size_t)l_ * d + r; }
    DI const bf16* qrow(int w, int lane) const { return Q + trow(ql(w, lane)) * 256 + h * 64; }
    DI int qv(int w, int lane) const { return ql(w, lane); }
    DI int qmin(int w) const { return 256 * c + 32 * w; }
    DI int qmax(int w) const { return 256 * c + 32 * w + 31; }
    DI int kv0(int j) const { return 256 * c - 128 + 64 * j; }
    DI const bf16* krow(int j, int row) const { return K + trow(kv0(j) + row) * 256 + h * 64; }
    DI const bf16* vrow(int j, int row) const { return V + trow(kv0(j) + row) * 256 + h * 64; }
    DI const bf16* rrow(int, int) const { return nullptr; }
    DI bool flag(int, int, int) const { return true; }
    DI bf16* orow(int w, int lane) const { return O + trow(ql(w, lane)) * 256 + h * 64; }
    DI void lse(int w, int lane, float v) const { LSEP[trow(ql(w, lane)) * 4 + h] = v; }
};
struct PolB {
    static constexpr bool LSE = false; static constexpr int KMUL = 1;
    const bf16 *Q, *K, *V; bf16* O; int b, g, qc; unsigned maxd; int j0, j1; u64 sel; bool hasflag;
    DI int tok(int w, int lane) const { return 64 * qc + 8 * w + ((lane & 31) >> 2); }
    DI const bf16* qrow(int w, int lane) const { return Q + ((size_t)b * S + tok(w, lane)) * 512 + (4 * g + (lane & 3)) * 64; }
    DI int qv(int w, int lane) const { return tok(w, lane); }
    DI int qmin(int w) const { return 64 * qc + 8 * w; }
    DI int qmax(int w) const { return 64 * qc + 8 * w + 7; }
    DI int kv0(int j) const { return 64 * j; }
    DI const bf16* krow(int j, int row) const { return K + ((size_t)b * S + 64 * j + row) * 128 + g * 64; }
    DI const bf16* vrow(int j, int row) const { return V + ((size_t)b * S + 64 * j + row) * 128 + g * 64; }
    DI const bf16* rrow(int, int) const { return nullptr; }
    DI bf16* orow(int w, int lane) const { return O + ((size_t)b * S + tok(w, lane)) * 512 + (4 * g + (lane & 3)) * 64; }
    DI void lse(int, int, float) const {}
};
struct PolM {
    static constexpr bool HASFLAG = false, LSE = false; static constexpr int KMUL = 1;
    const bf16 *Q, *KN, *KR, *V; bf16* O; int b, h, c; unsigned maxd; int j0, j1;
    DI int tok(int w, int lane) const { return 256 * c + 32 * w + (lane & 31); }
    DI const bf16* qrow(int w, int lane) const { return Q + ((size_t)b * S + tok(w, lane)) * 384 + h * 96; }
    DI int qv(int w, int lane) const { return tok(w, lane); }
    DI int qmin(int w) const { return 256 * c + 32 * w; }
    DI int qmax(int w) const { return 256 * c + 32 * w + 31; }
    DI int kv0(int j) const { return 64 * j; }
    DI const bf16* krow(int j, int row) const { return KN + ((size_t)b * S + 64 * j + row) * 256 + h * 64; }
    DI const bf16* vrow(int j, int row) const { return V + ((size_t)b * S + 64 * j + row) * 256 + h * 64; }
    DI const bf16* rrow(int j, int row) const { return KR + ((size_t)b * S + 64 * j + row) * 32; }
    DI bf16* orow(int w, int lane) const { return O + ((size_t)b * S + tok(w, lane)) * 256 + h * 64; }
    DI void lse(int, int, float) const {}
};

template <int DQ, class P, bool FLAG, int VAR = 0>
DI void attn_unit(const P& p, LAS unsigned char* lds, int tid, int lane, int wave, u64 sel) {
    typedef AC<DQ> C;
    const int hh = lane >> 5;
    const bf16* qrow = p.qrow(wave, lane);
    bf16x8 qf[DQ / 16];
#pragma unroll
    for (int ks = 0; ks < DQ / 16; ++ks) qf[ks] = *(const bf16x8*)(qrow + 16 * ks + 8 * hh);
#pragma unroll
    for (int ks = 0; ks < DQ / 16; ++ks) asm volatile("s_waitcnt vmcnt(0)" : "+v"(qf[ks]) :: "memory");
    const int qv = p.qv(wave, lane), wq0 = p.qmin(wave), wq1 = p.qmax(wave);
    f32x16 o[2];
#pragma unroll
    for (int mt = 0; mt < 2; ++mt)
#pragma unroll
        for (int i = 0; i < 16; ++i) o[mt][i] = 0.f;
    float m = 0.f, l = 0.f;
    f32x16 negm;
#pragma unroll
    for (int i = 0; i < 16; ++i) negm[i] = 0.f;
    const int j0 = p.j0, j1 = p.j1;
    const int lrow = tid >> 3, lch = tid & 7;
    u32x4 k0A, v0A, r0A = {0u, 0u, 0u, 0u}, k1A, v1A, r1A = {0u, 0u, 0u, 0u}, k0B, v0B, r0B = {0u, 0u, 0u, 0u}, k1B, v1B, r1B = {0u, 0u, 0u, 0u};
    constexpr int NLD = (DQ == 96) ? 6 : 4;
    const int npair = (j1 - j0 + 1) >> 1;
#define ATT_LOAD1(RK, RV, RR, j) do { const bf16* pk_ = p.krow((j), lrow) + 8 * lch; const bf16* pv_ = p.vrow((j), lrow) + 8 * lch; \
        asm volatile("global_load_dwordx4 %0, %2, off\n\tglobal_load_dwordx4 %1, %3, off" : "=&v"(RK), "=&v"(RV) : "v"(pk_), "v"(pv_) : "memory"); \
        if (DQ == 96) { const bf16* pr_ = p.rrow((j), (tid & 255) >> 2) + 8 * (tid & 3); asm volatile("global_load_dwordx4 %0, %1, off" : "=&v"(RR) : "v"(pr_) : "memory"); } } while (0)
#define ATT_LOADP(K0, V0, R0, K1, V1, R1, t) do { const int ja_ = j0 + 2 * (t), jb_ = ja_ + 1; \
        { const int jc_ = ja_ < j1 ? ja_ : j1 - 1; ATT_LOAD1(K0, V0, R0, jc_); } { const int jd_ = jb_ < j1 ? jb_ : j1 - 1; ATT_LOAD1(K1, V1, R1, jd_); } } while (0)
#define ATT_TILE(kb_, jt_) do { const int j_ = (jt_); const int kv0 = p.kv0(j_); \
        bool need = (j_ < j1) && (wq1 - kv0 >= 0) && ((long long)wq0 - (long long)(kv0 + 63 * P::KMUL) <= (long long)p.maxd); \
        const bool interior = (wq0 - (kv0 + 63 * P::KMUL) >= 0) && ((long long)wq1 - (long long)kv0 <= (long long)p.maxd); \
        bool lf = true; \
        if (FLAG) { lf = ((sel >> j_) & 1ull) != 0ull; need = need && (__ballot(lf) != 0ull); } \
        if (need) attn_tile<DQ, P::KMUL, VAR>((kb_), (kb_) + C::KBUF, qf, o, negm, m, l, qv - kv0 - 4 * hh * P::KMUL, p.maxd, lf, lane, !interior); } while (0)
#define ATT_STEP(K0, V0, R0, K1, V1, R1, tt) do { const int t_ = (tt); \
        LAS unsigned char* pbuf = lds + (t_ & 1) * (2 * C::BUF); \
        asm volatile("s_waitcnt vmcnt(%6)" : "+v"(K0), "+v"(V0), "+v"(R0), "+v"(K1), "+v"(V1), "+v"(R1) : "n"(NLD) : "memory"); \
        *(LAS u32x4*)(pbuf + lrow * C::KST + lch * 16) = K0; *(LAS u32x4*)(pbuf + C::KBUF + lrow * VST + lch * 16) = V0; \
        *(LAS u32x4*)(pbuf + C::BUF + lrow * C::KST + lch * 16) = K1; *(LAS u32x4*)(pbuf + C::BUF + C::KBUF + lrow * VST + lch * 16) = V1; \
        if (DQ == 96) { *(LAS u32x4*)(pbuf + ((tid & 255) >> 2) * C::KST + 128 + (tid & 3) * 16) = R0; *(LAS u32x4*)(pbuf + C::BUF + ((tid & 255) >> 2) * C::KST + 128 + (tid & 3) * 16) = R1; } \
        asm volatile("s_waitcnt lgkmcnt(0)\n\ts_barrier" ::: "memory"); \
        ATT_LOADP(K0, V0, R0, K1, V1, R1, t_ + 2); \
        if (ATT_STAGGER > 0 && wave >= 4) __builtin_amdgcn_s_sleep(ATT_STAGGER); \
        ATT_TILE(pbuf, j0 + 2 * t_); ATT_TILE(pbuf + C::BUF, j0 + 2 * t_ + 1); } while (0)
    ATT_LOADP(k0A, v0A, r0A, k1A, v1A, r1A, 0);
    ATT_LOADP(k0B, v0B, r0B, k1B, v1B, r1B, 1);
    if (wave >= 4) __builtin_amdgcn_s_setprio(1);
#pragma unroll 1
    for (int t = 0; t < npair; t += 2) {
        ATT_STEP(k0A, v0A, r0A, k1A, v1A, r1A, t);
        ATT_STEP(k0B, v0B, r0B, k1B, v1B, r1B, t + 1);
    }
    __builtin_amdgcn_s_setprio(0);
    asm volatile("s_waitcnt vmcnt(0)" : "+v"(k0A), "+v"(v0A), "+v"(r0A), "+v"(k1A), "+v"(v1A), "+v"(r1A), "+v"(k0B), "+v"(v0B), "+v"(r0B), "+v"(k1B), "+v"(v1B), "+v"(r1B) :: "memory");
#undef ATT_LOAD1
#undef ATT_LOADP
#undef ATT_TILE
#undef ATT_STEP
    const float lt = l + __shfl_xor(l, 32);
    const float inv = lt > 0.f ? 1.0f / lt : 0.f;
    store_o_rows(p, lds, DQ == 96 ? 102400 : 90112, o, inv, lane, wave);
    if (P::LSE) { if (hh == 0) p.lse(wave, lane, m + __log2f(lt)); }
    __syncthreads();
}

DI u64 cmp_unit(const Ctx& F, int b, int g, int qc) {
    constexpr int KST = 144;
    LAS unsigned char* KL = F.lds; LAS unsigned char* VL = F.lds + 256 * KST; LAS float* IMP = (LAS float*)(F.lds + 2 * 256 * KST);
    const bf16* KC = (const bf16*)(F.ws + WS_KC) + (size_t)(b * 2 + g) * 256 * 64;
    const bf16* VC = (const bf16*)(F.ws + WS_VC) + (size_t)(b * 2 + g) * 256 * 64;
    const int tid = F.tid, lane = F.lane, w = F.wave, hh = lane >> 5, r32 = lane & 31;
#pragma unroll
    for (int it = 0; it < 4; ++it) { const int idx = tid + 512 * it, row = idx >> 3, ch = idx & 7;
        *(LAS u32x4*)(KL + row * KST + ch * 16) = *(const u32x4*)(KC + row * 64 + ch * 8);
        *(LAS u32x4*)(VL + row * VST + ch * 16) = *(const u32x4*)(VC + row * 64 + ch * 8); }
    __syncthreads();
    const int tokl = 8 * w + (r32 >> 2), tok = 64 * qc + tokl, head = 4 * g + (lane & 3);
    const bf16* qrow = (const bf16*)(F.ws + WS_QB) + ((size_t)b * S + tok) * 512 + head * 64;
    bf16x8 qf[4];
#pragma unroll
    for (int ks = 0; ks < 4; ++ks) qf[ks] = *(const bf16x8*)(qrow + 16 * ks + 8 * hh);
    const int qv = tok - 31, wq1 = 64 * qc + 8 * w + 7 - 31;
    f32x16 o[2];
#pragma unroll
    for (int mt = 0; mt < 2; ++mt)
#pragma unroll
        for (int i = 0; i < 16; ++i) o[mt][i] = 0.f;
    float m = 0.f, l = 0.f;
    f32x16 negm;
#pragma unroll
    for (int i = 0; i < 16; ++i) negm[i] = 0.f;
    const int wq0 = 64 * qc + 8 * w - 31;
#pragma unroll 1
    for (int jt = 0; jt < 4; ++jt) {
        if (wq1 - 1024 * jt >= 0) {
            const int dq = qv - 1024 * jt - 4 * hh * 16;
            attn_tile<64, 16>(KL + jt * 64 * KST, VL + jt * 64 * VST, qf, o, negm, m, l, dq, 0x7fffffffu, true, lane, !(wq0 - (1024 * jt + 63 * 16) >= 0));
        }
    }
    const float lt = l + __shfl_xor(l, 32);
    const float inv = lt > 0.f ? 1.0f / lt : 0.f;
    { struct { bf16* O; int b, g, qc; DI bf16* orow(int w_, int n_) const { return O + ((size_t)b * S + 64 * qc + 8 * w_ + (n_ >> 2)) * 512 + (4 * g + (n_ & 3)) * 64; } } pc{(bf16*)(F.ws + WS_OCMP), b, g, qc};
      store_o_rows(pc, F.lds, 90112, o, inv, lane, w); }
    float prev = 0.f;
#pragma unroll 1
    for (int jt = 0; jt < 4; ++jt) {
        const bool need = (wq1 - 1024 * jt >= 0);
        f32x16 s[2];
        if (need) qk_tile<64>(KL + jt * 64 * KST, qf, s, negm, lane);
#pragma unroll
        for (int rt = 0; rt < 2; ++rt)
#pragma unroll
            for (int a = 0; a < 4; ++a) {
                float mainp = 0.f, sp = 0.f;
                if (need) {
                    float pb[4];
#pragma unroll
                    for (int bb = 0; bb < 4; ++bb) { const int kidx = 64 * jt + 32 * rt + 8 * a + 4 * hh + bb; const bool ok = (qv - 16 * kidx) >= 0; pb[bb] = ok ? fast_exp2(s[rt][4 * a + bb]) * inv : 0.f; }
                    mainp = pb[0] + pb[1] + pb[2] + 0.5f * pb[3]; sp = 0.5f * pb[3];
                }
                const float rc = __shfl_xor(sp, 32);
                float v = mainp + (hh ? rc : prev);
                prev = rc;
                v += __shfl_xor(v, 1); v += __shfl_xor(v, 2);
                if ((lane & 3) == 0) IMP[tokl * 64 + 2 * (8 * jt + 4 * rt + a) + hh] = v;
            }
    }
    __syncthreads();
    u64 mysel = 0ull;
#pragma unroll 1
    for (int tk = 0; tk < 8; ++tk) {
        const int tl = 8 * w + tk, t = 64 * qc + tl, j = lane;
        const float v = IMP[tl * 64 + j];
        const bool forced = (j == 0) || (j == qc) || (j == qc - 1);
        const bool valid = j <= qc;
        const float score = forced ? v + 1e4f : (valid ? v : -1.0f);
        int rank = 0;
#pragma unroll
        for (int jp = 0; jp < 64; ++jp) { const float o_ = __builtin_bit_cast(float, __builtin_amdgcn_readlane(__builtin_bit_cast(int, score), jp)); rank += ((o_ > score) || (o_ == score && jp < j)) ? 1 : 0; }
        const u64 mask = __ballot(rank < 16);
        (void)t;
        if (tk == (r32 >> 2)) mysel = mask;
    }
    __syncthreads();
    return mysel;
}

DI void moe_tables(const Ctx& F, int l) {
    LAS int* tb = (LAS int*)(F.lds + AUX_OFF); LAS int* cn = tb + 64;
    if (F.tid == 0) {
        const unsigned* C = (const unsigned*)(F.ws + WS_CTL) + CW_CNT + l * 32 * 64;
        int acc = 0;
        for (int e = 0; e < 32; ++e) { const int c = (int)__hip_atomic_load(C + e * 64, RLX_AGENT); tb[e] = acc; cn[e] = c; acc += (c + 255) >> 8; }
        tb[32] = acc;
    }
    __syncthreads();
}
template <int MODE>
DI void phase_norm1(const Ctx& F, int l) {
    const float* mods = (const float*)(F.ws + WS_MODS);
    const bf16* X = (const bf16*)(F.ws + WS_X); bf16* H = (bf16*)(F.ws + F.dofs + WS_H); bf16* XW = (bf16*)(F.ws + F.dofs + WS_X);
    const LAS int* tb = (const LAS int*)(F.lds + AUX_OFF);
    if (l > 0) moe_tables(F, l - 1);
    const int gw = F.blk * 8 + F.wave, NGW = F.G * 8, lane = F.lane;
    for (int tok = gw; tok < T; tok += NGW) {
        const int b = tok >> 12;
        f32x4 v[4];
        if (l == 0) { const float* xr = ginp(F, I_X) + (size_t)tok * 1024;
#pragma unroll
            for (int k = 0; k < 4; ++k) v[k] = *(const f32x4*)(xr + 4 * lane + 256 * k);
        } else { const bf16* xr = X + (size_t)tok * 1024;
#pragma unroll
            for (int k = 0; k < 4; ++k) { const u32x2 w = *(const u32x2*)(xr + 4 * lane + 256 * k); v[k] = (f32x4){bflo(w.x), bfhi(w.x), bflo(w.y), bfhi(w.y)}; }
        }
        if (l > 0) {
            f32x4 y[4];
#pragma unroll
            for (int k = 0; k < 4; ++k) y[k] = (f32x4){0.f, 0.f, 0.f, 0.f};
            const int* ts = (const int*)(F.ws + WS_TOKSLOT) + (size_t)tok * 4;
#pragma unroll
            for (int s = 0; s < 4; ++s) {
                const int pk = ts[s]; const int e = pk >> 16, pos = pk & 0xffff;
                const unsigned char* yr = (const unsigned char*)(F.ws + WS_Y2) + ((size_t)tb[e] * 256 + pos) * 1024;
#pragma unroll
                for (int k = 0; k < 4; ++k) { const unsigned w = *(const unsigned*)(yr + 4 * lane + 256 * k); y[k] += unpk4_fp8(w); }
            }
            const float* gt2 = mods + ((size_t)((l - 1) * 8 + b) * 6 + 5) * 1024;
#pragma unroll
            for (int k = 0; k < 4; ++k) v[k] = v[k] + *(const f32x4*)(gt2 + 4 * lane + 256 * k) * (y[k] * Y2_ISCALE);
        }
        float ss = 0.f;
#pragma unroll
        for (int k = 0; k < 4; ++k) ss += v[k][0] * v[k][0] + v[k][1] * v[k][1] + v[k][2] * v[k][2] + v[k][3] * v[k][3];
        const float rstd = rsqrtf(wave_sum(ss) * (1.0f / 1024.0f) + EPS);
        if (MODE == 0) {
            const float* g1 = ginp(F, I_G1) + (size_t)l * 1024;
            const float* sh = mods + ((size_t)(l * 8 + b) * 6 + 0) * 1024; const float* sc = sh + 1024;
#pragma unroll
            for (int k = 0; k < 4; ++k) {
                const int c = 4 * lane + 256 * k;
                { u32x2 xw; xw.x = pk2(v[k][0], v[k][1]); xw.y = pk2(v[k][2], v[k][3]); *(u32x2*)(XW + (size_t)tok * 1024 + c) = xw; }
                const f32x4 hv = v[k] * rstd * *(const f32x4*)(g1 + c) * (*(const f32x4*)(sc + c) + 1.0f) + *(const f32x4*)(sh + c);
                u32x2 w; w.x = pk2(hv[0], hv[1]); w.y = pk2(hv[2], hv[3]);
                *(u32x2*)(H + (size_t)tok * 1024 + c) = w;
            }
        } else {
            const float* gf = ginp(F, I_GF);
#pragma unroll
            for (int k = 0; k < 4; ++k) { const int c = 4 * lane + 256 * k; *(f32x4*)(gout(F) + (size_t)tok * 1024 + c) = v[k] * rstd * *(const f32x4*)(gf + c); }
        }
    }
}
DI void phase_prep(const Ctx& F) {
    const bf16* CQ = (const bf16*)(F.ws + WS_CQ); const bf16* MISC = (const bf16*)(F.ws + WS_MISC);
    float* RQ = (float*)(F.ws + WS_RSTDQ); float* RKV = (float*)(F.ws + WS_RSTDKV);
    bf16* KR = (bf16*)(F.ws + WS_KR); float* GATES = (float*)(F.ws + WS_GATES); const float* CS32 = (const float*)(F.ws + WS_CS32);
    const int gw = F.blk * 8 + F.wave, NGW = F.G * 8, lane = F.lane;
    for (int tok = gw; tok < T; tok += NGW) {
        const u32x2 wq = *(const u32x2*)(CQ + (size_t)tok * 256 + 4 * lane);
        const u32x2 wm = *(const u32x2*)(MISC + (size_t)tok * 256 + 4 * lane);
        float a0 = bflo(wq.x), a1 = bfhi(wq.x), a2 = bflo(wq.y), a3 = bfhi(wq.y);
        const float sq = wave_sum(a0 * a0 + a1 * a1 + a2 * a2 + a3 * a3);
        float m0 = bflo(wm.x), m1 = bfhi(wm.x), m2 = bflo(wm.y), m3 = bfhi(wm.y);
        const float skv = wave_sum(lane < 32 ? (m0 * m0 + m1 * m1 + m2 * m2 + m3 * m3) : 0.f);
        if (lane == 0) { RQ[tok] = rsqrtf(sq * (1.0f / 256.0f) + EPS); RKV[tok] = rsqrtf(skv * (1.0f / 128.0f) + EPS); }
        const float p0 = __shfl_xor(m0, 4), p1 = __shfl_xor(m1, 4), p2 = __shfl_xor(m2, 4), p3 = __shfl_xor(m3, 4);
        if (lane >= 32 && lane < 36) {
            const int i0 = 4 * (lane - 32);
            const f32x4 c4 = *(const f32x4*)(CS32 + (size_t)tok * 32 + i0), s4 = *(const f32x4*)(CS32 + (size_t)tok * 32 + 16 + i0);
            u32x4 w;
            w.x = pk2(m0 * c4[0] - p0 * s4[0], p0 * c4[0] + m0 * s4[0]); w.y = pk2(m1 * c4[1] - p1 * s4[1], p1 * c4[1] + m1 * s4[1]);
            w.z = pk2(m2 * c4[2] - p2 * s4[2], p2 * c4[2] + m2 * s4[2]); w.w = pk2(m3 * c4[3] - p3 * s4[3], p3 * c4[3] + m3 * s4[3]);
            *(u32x4*)(KR + (size_t)tok * 32 + 2 * i0) = w;
        }
        if (lane >= 40 && lane < 46) {
            const int gi = 4 * (lane - 40);
            *(f32x4*)(GATES + (size_t)tok * 24 + gi) = (f32x4){sigmoidf_(m0), sigmoidf_(m1), sigmoidf_(m2), sigmoidf_(m3)};
        }
    }
}
DI void phase_cmp2(const Ctx& F, int l) {
    const bf16* HID = (const bf16*)(F.ws + WS_HID);
    const float* CS64 = (const float*)(F.ws + WS_CS64);
    const int gw = F.blk * 8 + F.wave, NGW = F.G * 8, lane = F.lane;
    for (int it = gw; it < 8192; it += NGW) {
        const int kv = it >> 12, row = it & 4095, c = row & 255, bg = row >> 8;
        const float* w2 = ginp(F, kv ? I_W2V : I_W2K) + (size_t)l * 256 * 64;
        const float* b2 = ginp(F, kv ? I_B2V : I_B2K) + (size_t)l * 64;
        const u32x2 hw = *(const u32x2*)(HID + ((size_t)kv * 4096 + row) * 256 + 4 * lane);
        const float h0 = bflo(hw.x), h1 = bfhi(hw.x), h2 = bflo(hw.y), h3 = bfhi(hw.y);
        float acc = b2[lane];
#pragma unroll 4
        for (int k4 = 0; k4 < 64; ++k4) {
            const float x0 = __builtin_bit_cast(float, __builtin_amdgcn_readlane(__builtin_bit_cast(int, h0), k4));
            const float x1 = __builtin_bit_cast(float, __builtin_amdgcn_readlane(__builtin_bit_cast(int, h1), k4));
            const float x2 = __builtin_bit_cast(float, __builtin_amdgcn_readlane(__builtin_bit_cast(int, h2), k4));
            const float x3 = __builtin_bit_cast(float, __builtin_amdgcn_readlane(__builtin_bit_cast(int, h3), k4));
            acc += x0 * w2[(4 * k4 + 0) * 64 + lane] + x1 * w2[(4 * k4 + 1) * 64 + lane] + x2 * w2[(4 * k4 + 2) * 64 + lane] + x3 * w2[(4 * k4 + 3) * 64 + lane];
        }
        if (c == 255) acc = 0.f;
        if (kv == 0) {
            const int b = bg >> 1, tokr = b * S + 16 * c + 31;
            const float other = __shfl_xor(acc, 32);
            const int i = lane & 31;
            const float cs = CS64[(size_t)(tokr & (T - 1)) * 64 + i], sn = CS64[(size_t)(tokr & (T - 1)) * 64 + 32 + i];
            const float y = (lane < 32) ? (acc * cs - other * sn) : (acc * cs + other * sn);
            ((bf16*)(F.ws + WS_KC))[(size_t)row * 64 + 2 * i + (lane >> 5)] = (bf16)(pk2(y, 0.f) & 0xffffu);
        } else {
            ((bf16*)(F.ws + WS_VC))[(size_t)row * 64 + lane] = (bf16)(pk2(acc, 0.f) & 0xffffu);
        }
    }
}
DI void phase_mix(const Ctx& F, int l) {
    const bf16* OA3 = (const bf16*)(F.ws + WS_OA3); const float* LSEA = (const float*)(F.ws + WS_LSEA);
    const bf16* OCMP = (const bf16*)(F.ws + WS_OCMP); const bf16* OSLC = (const bf16*)(F.ws + WS_OSLC); const bf16* OWIN = (const bf16*)(F.ws + WS_OWIN);
    const bf16* OC = (const bf16*)(F.ws + WS_OC); const bf16* MISC = (const bf16*)(F.ws + WS_MISC);
    bf16* AMIX = (bf16*)(F.ws + WS_AMIX);
    const float* ga = ginp(F, I_GOA) + (size_t)l * 256; const float* gb = ginp(F, I_GOB) + (size_t)l * 512; const float* gc = ginp(F, I_GOC) + (size_t)l * 256;
    const int gw = F.blk * 8 + F.wave, NGW = F.G * 8, lane = F.lane, ha = lane >> 4;
    for (int tok0 = gw; tok0 < T; tok0 += 2 * NGW) {
        int tok[2]; tok[0] = tok0; tok[1] = (tok0 + NGW < T) ? tok0 + NGW : tok0;
        float ls[2][3]; u32x2 wa[2][3], wb[2][2][3], wc_[2]; float gl[2][2][3];
#pragma unroll
        for (int q = 0; q < 2; ++q) {
#pragma unroll
            for (int p = 0; p < 3; ++p) { ls[q][p] = LSEA[((size_t)p * T + tok[q]) * 4 + ha]; wa[q][p] = *(const u32x2*)(OA3 + ((size_t)p * T + tok[q]) * 256 + 4 * lane); }
#pragma unroll
            for (int k = 0; k < 2; ++k) {
                const int col = 256 * k + 4 * lane, hb = col >> 6;
                const bf16* g_ = MISC + (size_t)tok[q] * 256 + 160 + hb * 3;
                gl[q][k][0] = bf2f(g_[0]); gl[q][k][1] = bf2f(g_[1]); gl[q][k][2] = bf2f(g_[2]);
                wb[q][k][0] = *(const u32x2*)(OCMP + (size_t)tok[q] * 512 + col); wb[q][k][1] = *(const u32x2*)(OSLC + (size_t)tok[q] * 512 + col); wb[q][k][2] = *(const u32x2*)(OWIN + (size_t)tok[q] * 512 + col);
            }
            wc_[q] = *(const u32x2*)(OC + (size_t)tok[q] * 256 + 4 * lane);
        }
        f32x4 va[2], vb[2][2], vc[2]; float red[2][3];
#pragma unroll
        for (int q = 0; q < 2; ++q) {
            const float mx = fmaxf(ls[q][0], fmaxf(ls[q][1], ls[q][2]));
            const float w0 = fast_exp2(ls[q][0] - mx), w1 = fast_exp2(ls[q][1] - mx), w2 = fast_exp2(ls[q][2] - mx), wi = 1.0f / (w0 + w1 + w2);
            va[q] = ((f32x4){bflo(wa[q][0].x), bfhi(wa[q][0].x), bflo(wa[q][0].y), bfhi(wa[q][0].y)} * w0 + (f32x4){bflo(wa[q][1].x), bfhi(wa[q][1].x), bflo(wa[q][1].y), bfhi(wa[q][1].y)} * w1
                   + (f32x4){bflo(wa[q][2].x), bfhi(wa[q][2].x), bflo(wa[q][2].y), bfhi(wa[q][2].y)} * w2) * wi;
            red[q][0] = va[q][0] * va[q][0] + va[q][1] * va[q][1] + va[q][2] * va[q][2] + va[q][3] * va[q][3];
            float sb = 0.f;
#pragma unroll
            for (int k = 0; k < 2; ++k) {
                const float g0 = sigmoidf_(gl[q][k][0]), g1 = sigmoidf_(gl[q][k][1]), g2 = sigmoidf_(gl[q][k][2]);
                const u32x2 a = wb[q][k][0], b_ = wb[q][k][1], c_ = wb[q][k][2];
                vb[q][k][0] = g0 * bflo(a.x) + g1 * bflo(b_.x) + g2 * bflo(c_.x); vb[q][k][1] = g0 * bfhi(a.x) + g1 * bfhi(b_.x) + g2 * bfhi(c_.x);
                vb[q][k][2] = g0 * bflo(a.y) + g1 * bflo(b_.y) + g2 * bflo(c_.y); vb[q][k][3] = g0 * bfhi(a.y) + g1 * bfhi(b_.y) + g2 * bfhi(c_.y);
                sb += vb[q][k][0] * vb[q][k][0] + vb[q][k][1] * vb[q][k][1] + vb[q][k][2] * vb[q][k][2] + vb[q][k][3] * vb[q][k][3];
            }
            red[q][1] = sb;
            vc[q] = (f32x4){bflo(wc_[q].x), bfhi(wc_[q].x), bflo(wc_[q].y), bfhi(wc_[q].y)};
            red[q][2] = vc[q][0] * vc[q][0] + vc[q][1] * vc[q][1] + vc[q][2] * vc[q][2] + vc[q][3] * vc[q][3];
        }
#pragma unroll
        for (int o = 1; o < 64; o <<= 1) {
#pragma unroll
            for (int q = 0; q < 2; ++q)
#pragma unroll
                for (int j = 0; j < 3; ++j) red[q][j] += __shfl_xor(red[q][j], o);
        }
#pragma unroll
        for (int q = 0; q < 2; ++q) {
            if (q == 1 && tok0 + NGW >= T) break;
            const float ra = rsqrtf(red[q][0] * (1.0f / 256.0f) + EPS), rb = rsqrtf(red[q][1] * (1.0f / 512.0f) + EPS), rc = rsqrtf(red[q][2] * (1.0f / 256.0f) + EPS);
            bf16* orow = AMIX + (size_t)tok[q] * 1024;
            { const f32x4 o = va[q] * ra * *(const f32x4*)(ga + 4 * lane); u32x2 w; w.x = pk2(o[0], o[1]); w.y = pk2(o[2], o[3]); *(u32x2*)(orow + 4 * lane) = w; }
#pragma unroll
            for (int k = 0; k < 2; ++k) { const f32x4 o = vb[q][k] * rb * *(const f32x4*)(gb + 256 * k + 4 * lane); u32x2 w; w.x = pk2(o[0], o[1]); w.y = pk2(o[2], o[3]); *(u32x2*)(orow + 256 + 256 * k + 4 * lane) = w; }
            { const f32x4 o = vc[q] * rc * *(const f32x4*)(gc + 4 * lane); u32x2 w; w.x = pk2(o[0], o[1]); w.y = pk2(o[2], o[3]); *(u32x2*)(orow + 768 + 4 * lane) = w; }
        }
    }
}
DI void phase_router(const Ctx& F, int l) {
    LAS unsigned char* WH = F.lds; LAS unsigned char* WL = F.lds + 65536;
    LAS float* biasp = (LAS float*)(F.lds + AUX_OFF); LAS float* RS = biasp + 32;
    LAS int* lcnt = (LAS int*)(F.lds + AUX_OFF + 1024); LAS int* gbase = lcnt + 32;
    LAS int* tokE = gbase + 32; LAS float* tokG = (LAS float*)(tokE + 512); LAS int* tokP = (LAS int*)(tokG + 512);
    const float* wr = ginp(F, I_WR) + (size_t)l * 1024 * 32; const float* br = ginp(F, I_BR) + (size_t)l * 32;
    const float* mods = (const float*)(F.ws + WS_MODS); const bf16* X = (const bf16*)(F.ws + WS_X); bf16* H = (bf16*)(F.ws + F.dofs + WS_H);
    const float* g2 = ginp(F, I_G2) + (size_t)l * 1024;
    const int tid = F.tid, lane = F.lane, w = F.wave;
    if (tid < 32) lcnt[tid] = 0;
    unsigned* CNT = (unsigned*)(F.ws + WS_CTL) + CW_CNT + (l + F.dcnt) * 32 * 64;
    for (int chunk = F.blk; chunk < T / 128; chunk += F.G) {
        const int b = (chunk * 128) >> 12;
        const float* sh = mods + ((size_t)(l * 8 + b) * 6 + 3) * 1024; const float* sc = sh + 1024;
        {
            float bacc = 0.f; const int e = tid & 31;
#pragma unroll 4
            for (int it = 0; it < 32; ++it) {
                const int k = 2 * ((tid + 512 * it) >> 5);
                const float w0 = wr[k * 32 + e], w1 = wr[(k + 1) * 32 + e];
                const float p0 = w0 * (g2[k] * (sc[k] + 1.0f)), p1 = w1 * (g2[k + 1] * (sc[k + 1] + 1.0f));
                bacc += sh[k] * w0 + sh[k + 1] * w1;
                const unsigned hi = pk2(p0, p1);
                const unsigned lo = pk2(p0 - bflo(hi), p1 - bfhi(hi));
                const int off = e * 2048 + ((((k >> 3) ^ e) << 4) | ((k & 7) * 2));
                *(LAS unsigned*)(WH + off) = hi; *(LAS unsigned*)(WL + off) = lo;
            }
            tokG[tid] = bacc;
        }
        __syncthreads();
        if (tid < 32) { float s_ = br[tid];
#pragma unroll
            for (int j = 0; j < 16; ++j) s_ += tokG[tid + 32 * j];
            biasp[tid] = s_; }
        {
            u32x2 ra[4], rb[4];
            f32x4 ggv[4], hhv[4];
#pragma unroll
            for (int k = 0; k < 4; ++k) { const int c = 4 * lane + 256 * k; ggv[k] = *(const f32x4*)(g2 + c) * (*(const f32x4*)(sc + c) + 1.0f); hhv[k] = *(const f32x4*)(sh + c); }
            { const bf16* x0 = X + (size_t)(chunk * 128 + w * 16) * 1024 + 4 * lane;
#pragma unroll
              for (int k = 0; k < 4; ++k) { ra[k] = *(const u32x2*)(x0 + 256 * k); rb[k] = *(const u32x2*)(x0 + 1024 + 256 * k); } }
#pragma unroll 1
            for (int tt = 0; tt < 8; ++tt) {
                const int tl0 = w * 16 + 2 * tt, tok0 = chunk * 128 + tl0;
                f32x4 v[2][4]; float ss0 = 0.f, ss1 = 0.f;
#pragma unroll
                for (int k = 0; k < 4; ++k) { v[0][k] = (f32x4){bflo(ra[k].x), bfhi(ra[k].x), bflo(ra[k].y), bfhi(ra[k].y)}; v[1][k] = (f32x4){bflo(rb[k].x), bfhi(rb[k].x), bflo(rb[k].y), bfhi(rb[k].y)}; }
                { const int tn = (tt < 7) ? tok0 + 2 : tok0; const bf16* x0 = X + (size_t)tn * 1024 + 4 * lane;
#pragma unroll
                  for (int k = 0; k < 4; ++k) { ra[k] = *(const u32x2*)(x0 + 256 * k); rb[k] = *(const u32x2*)(x0 + 1024 + 256 * k); } }
#pragma unroll
                for (int k = 0; k < 4; ++k) { ss0 += v[0][k][0] * v[0][k][0] + v[0][k][1] * v[0][k][1] + v[0][k][2] * v[0][k][2] + v[0][k][3] * v[0][k][3];
                                              ss1 += v[1][k][0] * v[1][k][0] + v[1][k][1] * v[1][k][1] + v[1][k][2] * v[1][k][2] + v[1][k][3] * v[1][k][3]; }
#pragma unroll
                for (int o = 1; o < 64; o <<= 1) { ss0 += __shfl_xor(ss0, o); ss1 += __shfl_xor(ss1, o); }
                const float rs0 = rsqrtf(ss0 * (1.0f / 1024.0f) + EPS), rs1 = rsqrtf(ss1 * (1.0f / 1024.0f) + EPS);
                if (lane == 0) { RS[tl0] = rs0; RS[tl0 + 1] = rs1; }
#pragma unroll
                for (int k = 0; k < 4; ++k) {
                    const int c = 4 * lane + 256 * k;
                    v[0][k] = v[0][k] * rs0 * ggv[k] + hhv[k]; v[1][k] = v[1][k] * rs1 * ggv[k] + hhv[k];
                    *(unsigned*)((unsigned char*)H + (size_t)tok0 * 1024 + c) = pk4_fp8s(v[0][k][0], v[0][k][1], v[0][k][2], v[0][k][3], H8_SCALE);
                    *(unsigned*)((unsigned char*)H + (size_t)(tok0 + 1) * 1024 + c) = pk4_fp8s(v[1][k][0], v[1][k][1], v[1][k][2], v[1][k][3], H8_SCALE);
                }
            }
        }
        __syncthreads();
        f32x4 acc[2] = {{0.f, 0.f, 0.f, 0.f}, {0.f, 0.f, 0.f, 0.f}};
        {
            const int kg = lane >> 4, n16 = lane & 15;
            const bf16* xr = X + (size_t)(chunk * 128 + w * 16 + n16) * 1024 + 8 * kg;
#pragma unroll 1
            for (int k8 = 0; k8 < 4; ++k8) {
                bf16x8 af[8];
#pragma unroll
                for (int j = 0; j < 8; ++j) af[j] = *(const bf16x8*)(xr + 32 * (8 * k8 + j));
#pragma unroll
                for (int j = 0; j < 8; ++j) {
                    const int c = 4 * (8 * k8 + j) + kg;
#pragma unroll
                    for (int et = 0; et < 2; ++et) {
                        const int e = 16 * et + n16, off = e * 2048 + ((c ^ e) << 4);
                        const bf16x8 bh = *(const LAS bf16x8*)(WH + off), bl = *(const LAS bf16x8*)(WL + off);
                        acc[et] = __builtin_amdgcn_mfma_f32_16x16x32_bf16(af[j], bh, acc[et], 0, 0, 0);
                        acc[et] = __builtin_amdgcn_mfma_f32_16x16x32_bf16(af[j], bl, acc[et], 0, 0, 0);
                    }
                }
            }
        }
        __syncthreads();
        LAS float* LG = (LAS float*)(F.lds + w * 2048);
        {
            const int g4 = lane >> 4, n16 = lane & 15;
#pragma unroll
            for (int et = 0; et < 2; ++et)
#pragma unroll
                for (int i = 0; i < 4; ++i) LG[(4 * g4 + i) * 32 + 16 * et + n16] = acc[et][i] * RS[w * 16 + 4 * g4 + i] + biasp[16 * et + n16];
        }
        asm volatile("s_waitcnt lgkmcnt(0)" ::: "memory");
#pragma unroll 1
        for (int tt = 0; tt < 8; ++tt) {
            const int tl0 = w * 16 + 2 * tt;
            const float lg0 = LG[(2 * tt) * 32 + (lane >> 1)], lg1 = LG[(2 * tt + 1) * 32 + (lane >> 1)];
            int rk0 = 0, rk1 = 0; const int me = lane >> 1;
#pragma unroll
            for (int e = 0; e < 32; ++e) {
                const float o0 = __builtin_bit_cast(float, __builtin_amdgcn_readlane(__builtin_bit_cast(int, lg0), 2 * e));
                const float o1 = __builtin_bit_cast(float, __builtin_amdgcn_readlane(__builtin_bit_cast(int, lg1), 2 * e));
                rk0 += ((o0 > lg0) || (o0 == lg0 && e < me)) ? 1 : 0; rk1 += ((o1 > lg1) || (o1 == lg1 && e < me)) ? 1 : 0;
            }
#pragma unroll
            for (int tk = 0; tk < 2; ++tk) {
                const int rk = tk ? rk1 : rk0; const float lg = tk ? lg1 : lg0;
                int te[4]; float tv[4];
#pragma unroll
                for (int r = 0; r < 4; ++r) {
                    const u64 mk = __ballot(rk == r && (lane & 1) == 0);
                    const int sl = __builtin_amdgcn_readfirstlane((int)__builtin_ctzll(mk));
                    te[r] = sl >> 1; tv[r] = __builtin_bit_cast(float, __builtin_amdgcn_readlane(__builtin_bit_cast(int, lg), sl));
                }
                const float e1 = __expf(tv[1] - tv[0]), e2 = __expf(tv[2] - tv[0]), e3 = __expf(tv[3] - tv[0]);
                const float isum = 1.0f / (1.0f + e1 + e2 + e3);
                if (lane < 4) {
                    const int tl = tl0 + tk;
                    const int e = lane == 0 ? te[0] : lane == 1 ? te[1] : lane == 2 ? te[2] : te[3];
                    const float gte = (lane == 0 ? 1.0f : lane == 1 ? e1 : lane == 2 ? e2 : e3) * isum;
                    const int pos = atomicAdd((int*)(lcnt + e), 1);
                    tokE[tl * 4 + lane] = e; tokG[tl * 4 + lane] = gte; tokP[tl * 4 + lane] = pos;
                }
            }
        }
        __syncthreads();
        if (tid < 32) gbase[tid] = (int)__hip_atomic_fetch_add(CNT + tid * 64, (unsigned)lcnt[tid], RLX_AGENT);
        __syncthreads();
        {
            const int tl = tid >> 2, r = tid & 3, e = tokE[tid], pos = gbase[e] + tokP[tid], tok = chunk * 128 + tl;
            ((int*)(F.ws + F.dofs + WS_IDX))[(size_t)e * ECAP + pos] = tok;
            ((float*)(F.ws + F.dofs + WS_GATEW))[(size_t)e * ECAP + pos] = tokG[tid];
            ((int*)(F.ws + F.dofs + WS_TOKSLOT))[(size_t)tok * 4 + r] = (e << 16) | pos;
        }
        __syncthreads();
        if (tid < 32) lcnt[tid] = 0;
        __syncthreads();
    }
}

DI int ropeperm64(int p) { return (p >> 1) + 32 * (p & 1); }
DI int cmap_win(int n) {
    const int tile = n >> 8, w = n & 255, hb = w & ~63, pp = ropeperm64(w & 63);
    switch (tile) {
        case 0: return hb + pp;
        case 1: return 256 + hb + pp;
        case 2: return 512 + w;
        case 3: return 768 + hb + pp;
        case 4: return 1024 + hb + pp;
        case 5: return w < 128 ? 1280 + w : 1408 + (w - 128);
        case 6: return w < 128 ? 1536 + hb + pp : 1664 + (w - 128);
        case 7: return w < 128 ? 1792 + hb + pp : 1920 + (w - 128);
        case 8: return 2072 + w;
        default: return w < 128 ? 2328 + w : (w < 160 ? 2456 + ((w - 128) >> 1) + 16 * ((w - 128) & 1) : (w < 184 ? 2048 + (w - 160) : -1));
    }
}
DI int cmap_qup(int n) { if (n >= 384) return -1; const int h = n / 96, w = n % 96; if (w < 64) return h * 96 + w; const int j = w - 64; return h * 96 + 64 + (j >> 1) + 16 * (j & 1); }
DI void tr_tile(const float* src, int K, int Nsrc, bf16* dst, int Kdst, int maptype, const float* ksc, int ntile, int ktile, LAS float* scr, int tid) {
    const int n0 = ntile * 64, k0 = ktile * 128, nl = tid & 63, n = n0 + nl;
    const int c = maptype == 0 ? (n < Nsrc ? n : -1) : (maptype == 1 ? cmap_win(n) : cmap_qup(n));
    float v[16];
#pragma unroll
    for (int it = 0; it < 16; ++it) { const int k = k0 + (tid >> 6) + 8 * it; v[it] = (c >= 0 && k < K) ? src[(size_t)k * Nsrc + c] * (ksc ? ksc[k] : 1.0f) : 0.f; }
#pragma unroll
    for (int it = 0; it < 16; ++it) scr[((tid >> 6) + 8 * it) * 65 + nl] = v[it];
    __syncthreads();
#pragma unroll
    for (int it = 0; it < 2; ++it) {
        const int idx = tid + 512 * it, nn = idx >> 4, ch = idx & 15;
        const LAS float* s = scr + (8 * ch) * 65 + nn;
        u32x4 o; o.x = pk2(s[0], s[65]); o.y = pk2(s[2 * 65], s[3 * 65]); o.z = pk2(s[4 * 65], s[5 * 65]); o.w = pk2(s[6 * 65], s[7 * 65]);
        *(u32x4*)(dst + (size_t)(n0 + nn) * Kdst + k0 + 8 * ch) = o;
    }
    __syncthreads();
}
DI void trb_load(f32x4 (&v)[16], const float* src, int N, int n0, int k0, int tid) {
#pragma unroll
    for (int it = 0; it < 16; ++it) v[it] = *(const f32x4*)(src + (size_t)(k0 + (tid >> 6) + 8 * it) * N + n0 + 4 * (tid & 63));
}
DI void trb_store(const f32x4 (&v)[16], bf16* dst, int Kd, int n0, int k0, LAS unsigned char* L, int tid, int wave, int lane, int f8 = 0) {
#pragma unroll
    for (int it = 0; it < 16; ++it) { f32x4 x = v[it];
        if (f8) { x[0] = q8s(x[0], W8_SCALE); x[1] = q8s(x[1], W8_SCALE); x[2] = q8s(x[2], W8_SCALE); x[3] = q8s(x[3], W8_SCALE); }
        u32x2 w; w.x = pk2(x[0], x[1]); w.y = pk2(x[2], x[3]); *(LAS u32x2*)(L + ((tid >> 6) + 8 * it) * 576 + (tid & 63) * 8) = w; }
    asm volatile("s_waitcnt lgkmcnt(0)\n\ts_barrier" ::: "memory");
    const int i = lane & 15, gn = (lane >> 4) & 1, h = lane >> 5, q = i >> 2, p = i & 3;
    const LAS unsigned char* base = L + (8 * h + q) * 576 + (32 * wave + 16 * gn) * 2 + 8 * p;
    if (!f8) {
        bf16* drow = dst + (size_t)(n0 + 32 * wave + 16 * gn + i) * Kd + k0 + 8 * h;
#pragma unroll
        for (int kcp = 0; kcp < 8; ++kcp) {
            const s16x4 lo = tr_read(base + (16 * kcp) * 576), hi = tr_read(base + (16 * kcp + 4) * 576);
            *(bf16x8*)(drow + 16 * kcp) = __builtin_shufflevector(lo, hi, 0, 1, 2, 3, 4, 5, 6, 7);
        }
    } else {
        unsigned char* drow = (unsigned char*)dst + (size_t)(n0 + 32 * wave + 16 * gn + i) * Kd + k0 + 8 * h;
#pragma unroll
        for (int kcp = 0; kcp < 8; ++kcp) {
            const s16x4 lo = tr_read(base + (16 * kcp) * 576), hi = tr_read(base + (16 * kcp + 4) * 576);
            int w0 = __builtin_amdgcn_cvt_pk_fp8_f32(bf2f((unsigned short)lo[0]), bf2f((unsigned short)lo[1]), 0, false); w0 = __builtin_amdgcn_cvt_pk_fp8_f32(bf2f((unsigned short)lo[2]), bf2f((unsigned short)lo[3]), w0, true);
            int w1 = __builtin_amdgcn_cvt_pk_fp8_f32(bf2f((unsigned short)hi[0]), bf2f((unsigned short)hi[1]), 0, false); w1 = __builtin_amdgcn_cvt_pk_fp8_f32(bf2f((unsigned short)hi[2]), bf2f((unsigned short)hi[3]), w1, true);
            u32x2 o; o.x = (unsigned)w0; o.y = (unsigned)w1;
            *(u32x2*)(drow + 16 * kcp) = o;
        }
    }
    asm volatile("s_waitcnt lgkmcnt(0)\n\ts_barrier" ::: "memory");
}
struct TrbItem { const float* src; bf16* dst; int N, n0, k0, f8; };
DI TrbItem trb_item(const Ctx& F, int it) {
    const int le = it / 96, r = it % 96; TrbItem t;
    if (r < 64) { t.src = ginp(F, I_WE1) + (size_t)le * 1024 * 2048; t.dst = (bf16*)(F.ws + WS_W1E + (size_t)le * 2048 * 1024); t.N = 2048; t.n0 = (r & 7) * 256; t.k0 = (r >> 3) * 128; t.f8 = 1; }
    else { const int q = r - 64; t.src = ginp(F, I_WE2) + (size_t)le * 1024 * 1024; t.dst = (bf16*)(F.ws + WS_W2E + (size_t)le * 1024 * 1024); t.N = 1024; t.n0 = (q & 3) * 256; t.k0 = (q >> 2) * 128; t.f8 = 1; }
    return t;
}
DI void conv_layer_tiles(const Ctx& F, int l, int q0, int i0, int cnt) {
    const int NL = 32 * 96;
    int it = q0 + F.blk + F.G * i0; const int end = q0 + F.blk + F.G * (i0 + cnt);
    if (it >= NL) return;
    f32x4 va[16];
    TrbItem ta = trb_item(F, l * NL + it);
    trb_load(va, ta.src, ta.N, ta.n0, ta.k0, F.tid);
#pragma unroll 1
    while (it < NL && it < end) {
        f32x4 vb[16];
#pragma unroll
        for (int k = 0; k < 16; ++k) vb[k] = va[k];
        const TrbItem tc = ta;
        it += F.G;
        const bool more = (it < NL && it < end);
        ta = trb_item(F, l * NL + (more ? it : 0));
        if (more) trb_load(va, ta.src, ta.N, ta.n0, ta.k0, F.tid);
        trb_store(vb, tc.dst, 1024, tc.n0, tc.k0, F.lds, F.tid, F.wave, F.lane, tc.f8);
    }
}
DI void conv_claim_tiles(const Ctx& F, int l, int quota) {
    const int NL = 32 * 96;
    volatile LAS unsigned* slot = (volatile LAS unsigned*)(F.lds + MISC_OFF) + 16;
    __syncthreads();
    if (F.tid == 0) { unsigned* q = (unsigned*)(F.ws + WS_CTL) + CW_CONVQ + l * 64; slot[0] = __hip_atomic_fetch_add(q, (unsigned)quota, __ATOMIC_RELAXED, __HIP_MEMORY_SCOPE_AGENT); }
    __syncthreads();
    int it = __builtin_amdgcn_readfirstlane((int)slot[0]); const int end = it + quota;
    if (it >= NL) return;
    f32x4 va[16];
    TrbItem ta = trb_item(F, l * NL + it);
    trb_load(va, ta.src, ta.N, ta.n0, ta.k0, F.tid);
#pragma unroll 1
    while (it < NL && it < end) {
        f32x4 vb[16];
#pragma unroll
        for (int k = 0; k < 16; ++k) vb[k] = va[k];
        const TrbItem tc = ta;
        it += 1;
        const bool more = (it < NL && it < end);
        ta = trb_item(F, l * NL + (more ? it : 0));
        if (more) trb_load(va, ta.src, ta.N, ta.n0, ta.k0, F.tid);
        trb_store(vb, tc.dst, 1024, tc.n0, tc.k0, F.lds, F.tid, F.wave, F.lane, tc.f8);
    }
}
DI void phase_prologue(const Ctx& F) {
    const Args& A = *F.a; const int tid = F.tid;
    LAS float* scr = (LAS float*)F.lds;
    if (!CONV_IN_LAYER) {
        const int NIT = DEPTH * 32 * 96;
        f32x4 va[16];
        int it = F.blk;
        TrbItem ta = trb_item(F, it < NIT ? it : 0);
        if (it < NIT) trb_load(va, ta.src, ta.N, ta.n0, ta.k0, tid);
#pragma unroll 1
        while (it < NIT) {
            f32x4 vb[16];
#pragma unroll
            for (int k = 0; k < 16; ++k) vb[k] = va[k];
            const TrbItem tc = ta;
            it += F.G;
            ta = trb_item(F, it < NIT ? it : 0);
            if (it < NIT) trb_load(va, ta.src, ta.N, ta.n0, ta.k0, tid);
            trb_store(vb, tc.dst, 1024, tc.n0, tc.k0, F.lds, tid, F.wave, F.lane, tc.f8);
        }
    }
    constexpr int PER_L = 8192 + 4096 + 320 + 128 + 128 + 16 + 16;
    for (int it = F.blk; it < DEPTH * PER_L; it += F.G) {
        const int l = it / PER_L; int r = it % PER_L;
        if (r < 8192 + 4096) continue;
        if (r < 8192) { const int e = r >> 8, t = r & 255;
            tr_tile(ginp(F, I_WE1) + ((size_t)(l * 32 + e)) * 1024 * 2048, 1024, 2048, (bf16*)(F.ws + WS_W1E) + ((size_t)(l * 32 + e)) * 2048 * 1024, 1024, 0, nullptr, t >> 3, t & 7, scr, tid); continue; }
        r -= 8192;
        if (r < 4096) { const int e = r >> 7, t = r & 127;
            tr_tile(ginp(F, I_WE2) + ((size_t)(l * 32 + e)) * 1024 * 1024, 1024, 1024, (bf16*)(F.ws + WS_W2E) + ((size_t)(l * 32 + e)) * 1024 * 1024, 1024, 0, nullptr, t >> 3, t & 7, scr, tid); continue; }
        r -= 4096;
        if (r < 320) { tr_tile(ginp(F, I_WIN) + (size_t)l * 1024 * 2488, 1024, 2488, (bf16*)(F.ws + WS_WIN) + (size_t)l * NIN * 1024, 1024, 1, nullptr, r >> 3, r & 7, scr, tid); continue; }
        r -= 320;
        if (r < 128) { tr_tile(ginp(F, I_WOUT) + (size_t)l * 1024 * 1024, 1024, 1024, (bf16*)(F.ws + WS_WOUT) + (size_t)l * 1024 * 1024, 1024, 0, nullptr, r >> 3, r & 7, scr, tid); continue; }
        r -= 128;
        if (r < 128) { const int kv = r >> 6, t = r & 63;
            tr_tile(ginp(F, kv ? I_W1V : I_W1K) + (size_t)l * 2048 * 256, 2048, 256, (bf16*)(F.ws + WS_NSAW1) + ((size_t)(l * 2 + kv)) * 256 * 2048, 2048, 0, nullptr, t >> 4, t & 15, scr, tid); continue; }
        r -= 128;
        if (r < 16) { tr_tile(ginp(F, I_WQUP) + (size_t)l * 256 * 384, 256, 384, (bf16*)(F.ws + WS_MLAQ) + (size_t)l * 512 * 256, 256, 2, ginp(F, I_GQ) + (size_t)l * 256, r >> 1, r & 1, scr, tid); continue; }
        r -= 16;
        tr_tile(ginp(F, I_WKVUP) + (size_t)l * 128 * 512, 128, 512, (bf16*)(F.ws + WS_MLAKV) + (size_t)l * 512 * 256, 256, 0, ginp(F, I_GKV) + (size_t)l * 128, r >> 1, r & 1, scr, tid);
    }
    for (int it = F.blk; it < DEPTH * 4; it += F.G) {
        const int l = it >> 2, kv = (it >> 1) & 1, kt = it & 1;
        tr_tile(ginp(F, kv ? I_W2V : I_W2K) + (size_t)l * 256 * 64, 256, 64, (bf16*)(F.ws + WS_W2T) + ((size_t)(l * 2 + kv)) * 64 * 256, 256, 0, nullptr, 0, kt, scr, tid);
    }
    {
        float* CS64 = (float*)(F.ws + WS_CS64); float* CS32 = (float*)(F.ws + WS_CS32);
        const int* pos = (const int*)ginp(F, I_POS);
        for (int idx = F.blk * 512 + tid; idx < T * 48; idx += F.G * 512) {
            const int tok = idx / 48, i = idx % 48;
            const double p = (double)pos[tok];
            const double inv = (i < 32) ? exp2(-(double)i * (13.287712379549449 / 32.0)) : exp2(-(double)(i - 32) * (13.287712379549449 / 16.0));
            double ang = p * inv;
            const double kk = __builtin_rint(ang * 0.15915494309189535);
            ang = ang - kk * 6.283185307179586;
            const float af = (float)ang;
            const float cs = __cosf(af), sn = __sinf(af);
            if (i < 32) { CS64[(size_t)tok * 64 + i] = cs; CS64[(size_t)tok * 64 + 32 + i] = sn; }
            else { CS32[(size_t)tok * 32 + (i - 32)] = cs; CS32[(size_t)tok * 32 + 16 + (i - 32)] = sn; }
        }
    }
    for (int item = F.blk; item < 32; item += F.G) {
        const int lk = item >> 2, l = lk >> 1, kv = lk & 1, col = (item & 3) * 64 + F.lane;
        const float* w1 = ginp(F, kv ? I_W1V : I_W1K) + (size_t)l * 2048 * 256 + col; const float* pe = ginp(F, kv ? I_POSV : I_POSK) + (size_t)l * 2048;
        float s = 0.f;
#pragma unroll 1
        for (int kb = 256 * F.wave; kb < 256 * F.wave + 256; kb += 16) {
            float wv[16];
#pragma unroll
            for (int j = 0; j < 16; ++j) wv[j] = w1[(size_t)(kb + j) * 256];
#pragma unroll
            for (int j = 0; j < 16; ++j) s += pe[kb + j] * wv[j];
        }
        scr[F.wave * 64 + F.lane] = s;
        __syncthreads();
        if (tid < 64) { float t = ginp(F, kv ? I_B1V : I_B1K)[(size_t)l * 256 + col];
#pragma unroll
            for (int ww = 0; ww < 8; ++ww) t += scr[ww * 64 + tid];
            ((float*)(F.ws + WS_B1P))[(size_t)lk * 256 + col] = t; }
        __syncthreads();
    }
    {
        LAS float* sc = scr; LAS float* red = scr + 8192;
        for (int i = tid; i < 8192; i += 512) { const float c = ginp(F, I_C)[i]; sc[i] = c * sigmoidf_(c); }
        __syncthreads();
        float* MODS = (float*)(F.ws + WS_MODS);
        const int lane = F.lane, w = F.wave;
        for (int item = F.blk; item < 384; item += F.G) {
            const int l = item / 96, col = (item % 96) * 64 + lane;
            float acc[8];
#pragma unroll
            for (int b = 0; b < 8; ++b) acc[b] = 0.f;
            const float* wa = ginp(F, I_WADA) + (size_t)l * 1024 * 6144 + col;
#pragma unroll 1
            for (int kb = 128 * w; kb < 128 * w + 128; kb += 16) {
                float wv[16];
#pragma unroll
                for (int j = 0; j < 16; ++j) wv[j] = wa[(size_t)(kb + j) * 6144];
#pragma unroll
                for (int j = 0; j < 16; ++j) {
#pragma unroll
                    for (int b = 0; b < 8; ++b) acc[b] += sc[b * 1024 + kb + j] * wv[j]; }
            }
#pragma unroll
            for (int b = 0; b < 8; ++b) red[(w * 8 + b) * 64 + lane] = acc[b];
            __syncthreads();
            { const int b = tid >> 6; float s = ginp(F, I_BADA)[(size_t)l * 6144 + col];
#pragma unroll
              for (int ww = 0; ww < 8; ++ww) s += red[(ww * 8 + b) * 64 + lane];
              MODS[((size_t)(l * 8 + b)) * 6144 + col] = s; }
            __syncthreads();
        }
    }
}

constexpr int PH_PER_LAYER = 11;
constexpr int N_PHASES = 1 + DEPTH * PH_PER_LAYER + 1;

__global__ void __launch_bounds__(512, 2) fwd_kernel(Args args) {
    extern __shared__ __attribute__((aligned(16))) unsigned char lds_raw[];
    Ctx F;
    F.lds = (LAS unsigned char*)lds_raw; F.a = &args; F.ws = args.ws;
    F.dofs = 0; F.dcnt = 0;
    F.tid = threadIdx.x; F.lane = F.tid & 63; F.wave = __builtin_amdgcn_readfirstlane(F.tid >> 6); F.blk = blockIdx.x; F.G = gridDim.x; F.vcu = F.blk;
    volatile LAS unsigned* MISC = (volatile LAS unsigned*)(F.lds + MISC_OFF);
    for (int u = F.tid; u < (LDS_BYTES - MISC_OFF) / 4; u += 512) MISC[u] = 0u;
    __syncthreads();
    unsigned* ctl = (unsigned*)(F.ws + WS_CTL);
    XcdBarrier bar; bar.bar = ctl + CW_BAR; bar.x = 0; bar.st = nullptr;
    if (!MK_PER_PHASE) bar = xcd_barrier_post(ctl + CW_BAR, MISC + 8);
    const int lo = args.ph_lo, hi = args.ph_hi;
#define IN(k) (lo <= (k) && (k) < hi)
#define SEAM(k) do { if (IN(k) && IN((k) + 1)) xcd_barrier(bar); } while (0)
    unsigned char* ws = F.ws;
#define PHASE_BEGIN() do { int t_ = threadIdx.x; asm volatile("" : "+v"(t_)); F.tid = t_; F.lane = t_ & 63; F.wave = __builtin_amdgcn_readfirstlane(t_ >> 6); \
        GAS unsigned char* w_ = (GAS unsigned char*)args.ws; asm volatile("" : "+s"(w_)); F.ws = (unsigned char*)w_; ws = (unsigned char*)w_; int b_ = blockIdx.x; asm volatile("" : "+s"(b_)); F.blk = b_; F.vcu = (F.G % 8 == 0) ? (b_ % 8) * (F.G / 8) + b_ / 8 : b_; } while (0)

    if (PHON(0) && IN(0)) _Pragma("unroll 1") for (int rep_ = 0; rep_ < NREP(0); ++rep_) { PHASE_BEGIN(); phase_prologue(F); }
    SEAM(0);
#pragma unroll 1
    for (int l = 0; l < DEPTH; ++l) {
        const int P = 1 + l * PH_PER_LAYER;
        if (PHON(1) && IN(P + 0)) _Pragma("unroll 1") for (int rep_ = 0; rep_ < (DUM(1) ? 2 : 1); ++rep_) { PHASE_BEGIN(); F.dofs = (DUM(1) && rep_ == 0) ? WS_END : 0; phase_norm1<0>(F, l); }
        SEAM(P + 0);
        if (PHON(2) && IN(P + 1)) _Pragma("unroll 1") for (int rep_ = 0; rep_ < NREP(2); ++rep_) { PHASE_BEGIN();
            SchedGrid Sg{(const char*)(ws + WS_H), (const char*)(ws + WS_WIN) + (size_t)l * NIN * 1024 * 2, 1024, 1024, NIN / 256, (T / 256) * (NIN / 256), F.G, F.vcu};
            EpiWin E{ws, (const float*)(ws + WS_CS64), (const float*)(ws + WS_CS32)};
            pg8::gemm_phase<EpiWin, SchedGrid, false>(F.lds, 1024, 1024, Sg, E);
        }
        SEAM(P + 1);
        if (PHON(3) && IN(P + 2)) _Pragma("unroll 1") for (int rep_ = 0; rep_ < NREP(3); ++rep_) { PHASE_BEGIN();
            if (PHON(13)) {
                SchedCmp Sc{(const char*)(ws + WS_KCMP), (const char*)(ws + WS_VCMP), (const char*)(ws + WS_NSAW1) + (size_t)l * 2 * 256 * 2048 * 2, F.G, F.blk};
                EpiCmp E{(const float*)(ws + WS_B1P) + (size_t)l * 512, (const bf16*)(ws + WS_W2T) + (size_t)l * 2 * 64 * 256, ginp(F, I_B2K) + (size_t)l * 64, ginp(F, I_B2V) + (size_t)l * 64,
                         (bf16*)(ws + WS_KC), (bf16*)(ws + WS_VC), (const float*)(ws + WS_CS64)};
                pg8::gemm_phase<EpiCmp, SchedCmp, false>(F.lds, 1024, 2048, Sc, E);
            }
            PHASE_BEGIN();
            if (PHON(18)) {
                SchedMla Sm{(const char*)(ws + WS_CQ), (const char*)(ws + WS_MISC), (const char*)(ws + WS_MLAQ) + (size_t)l * 512 * 256 * 2, (const char*)(ws + WS_MLAKV) + (size_t)l * 512 * 256 * 2, F.G, F.vcu};
                EpiMla E{(bf16*)(ws + WS_QM), (bf16*)(ws + WS_KN), (bf16*)(ws + WS_VM), (const bf16*)(ws + WS_CQ), (const bf16*)(ws + WS_MISC), (const float*)(ws + WS_CS32)};
                pg8::gemm_phase<EpiMla, SchedMla, false>(F.lds, 256, 256, Sm, E);
            }
            PHASE_BEGIN();
            if (PHON(15)) {
                unsigned* qw = (unsigned*)(ws + WS_CTL) + CW_QUEUE + (l * 2 + rep_) * 64;
                volatile LAS int* qslot = (volatile LAS int*)(F.lds + AUX_OFF + 512);
                int nxt_t = 0;
                if (F.tid == 0) nxt_t = (int)__hip_atomic_fetch_add(qw, 1u, RLX_AGENT);
                for (;;) {
                    if (F.tid == 0) { qslot[0] = nxt_t; nxt_t = (int)__hip_atomic_fetch_add(qw, 1u, RLX_AGENT); }
                    __syncthreads();
                    const int uq = qslot[0];
                    __syncthreads();
                    if (uq >= 2560) break;
                    if (uq < 1024) {
                        const int u = uq;
                        PolB pb; pb.Q = (const bf16*)(ws + WS_QB); pb.K = (const bf16*)(ws + WS_KWIN); pb.V = (const bf16*)(ws + WS_VWIN); pb.O = (bf16*)(ws + WS_OWIN);
                        pb.b = u >> 7; pb.g = (u >> 6) & 1; pb.qc = 63 - (u & 63); pb.maxd = 511u; pb.j0 = pb.qc > 8 ? pb.qc - 8 : 0; pb.j1 = pb.qc + 1;
                        attn_unit<64, PolB, false>(pb, F.lds, F.tid, F.lane, F.wave, 0ull);
                    } else {
                        const int uu = uq - 1024;
                        const int bh = uu / 48, w48 = uu % 48, p = w48 >> 4, s16 = w48 & 15;
                        PolA pa; pa.Q = (const bf16*)(ws + WS_QA); pa.K = (const bf16*)(ws + WS_KA); pa.V = (const bf16*)(ws + WS_VA);
                        pa.O = (bf16*)(ws + WS_OA3) + (size_t)p * T * 256; pa.LSEP = (float*)(ws + WS_LSEA) + (size_t)p * T * 4;
                        pa.b = bh >> 2; pa.h = bh & 3; pa.d = p == 0 ? 1 : (p == 1 ? 4 : 16);
                        const int cpr = p == 0 ? 16 : (p == 1 ? 4 : 1);
                        pa.r = s16 / cpr; pa.c = s16 % cpr; pa.maxd = 128u; pa.j0 = pa.c == 0 ? 2 : 0; pa.j1 = 6;
                        attn_unit<64, PolA, false>(pa, F.lds, F.tid, F.lane, F.wave, 0ull);
                    }
                }
            }
        }
        SEAM(P + 2);
        if (PHON(5) && IN(P + 4)) _Pragma("unroll 1") for (int rep_ = 0; rep_ < NREP(5); ++rep_) { PHASE_BEGIN();
            int cti = 0;
            int cq0 = 0;
            if (CONV_IN_LAYER) { const unsigned t_ = __hip_atomic_load((unsigned*)(ws + WS_CTL) + CW_CONVQ + l * 64, __ATOMIC_RELAXED, __HIP_MEMORY_SCOPE_AGENT); cq0 = __builtin_amdgcn_readfirstlane((int)(t_ < 3072u ? t_ : 3072u)); }
            if (PHON(19)) for (int u = F.vcu; u < 1024; u += F.G) {
                const int bg = (u % 256) >> 4, k = u & 15, rnd = u >> 8;
                const int qc = rnd == 0 ? 2 * k : (rnd == 1 ? 2 * k + 1 : (rnd == 2 ? 63 - 2 * k : 62 - 2 * k));
                const u64 sel = cmp_unit(F, bg >> 1, bg & 1, qc);
                PolB pb; pb.Q = (const bf16*)(ws + WS_QB); pb.K = (const bf16*)(ws + WS_KSLC); pb.V = (const bf16*)(ws + WS_VSLC); pb.O = (bf16*)(ws + WS_OSLC);
                pb.b = bg >> 1; pb.g = bg & 1; pb.qc = qc; pb.maxd = 0x7fffffffu; pb.j0 = 0; pb.j1 = qc + 1;
                attn_unit<64, PolB, true>(pb, F.lds, F.tid, F.lane, F.wave, sel);
                if (CONV_IN_LAYER && rep_ == 0) { PHASE_BEGIN(); conv_layer_tiles(F, l, cq0, cti, 2); cti += 2; }
            }
            PHASE_BEGIN();
            if (PHON(20)) for (int v = F.vcu; v < 512; v += F.G) {
                const int bh = (v & 255) >> 3, k = v & 7, c = (v < 256) ? k : 15 - k;
                PolM pm; pm.Q = (const bf16*)(ws + WS_QM); pm.KN = (const bf16*)(ws + WS_KN); pm.KR = (const bf16*)(ws + WS_KR); pm.V = (const bf16*)(ws + WS_VM); pm.O = (bf16*)(ws + WS_OC);
                pm.b = bh >> 2; pm.h = bh & 3; pm.c = c; pm.maxd = 0x7fffffffu; pm.j0 = 0; pm.j1 = 4 * c + 4;
                attn_unit<96, PolM, false>(pm, F.lds, F.tid, F.lane, F.wave, 0ull);
                if (CONV_IN_LAYER && rep_ == 0) { PHASE_BEGIN(); conv_layer_tiles(F, l, cq0, cti, 2); cti += 2; }
            }
            if (CONV_IN_LAYER && rep_ == 0) { PHASE_BEGIN(); conv_layer_tiles(F, l, cq0, cti, 1 << 20); }
        }
        SEAM(P + 4);
        if (PHON(7) && IN(P + 6)) _Pragma("unroll 1") for (int rep_ = 0; rep_ < NREP(7); ++rep_) { PHASE_BEGIN(); phase_mix(F, l); }
        SEAM(P + 6);
        if (PHON(8) && IN(P + 7)) _Pragma("unroll 1") for (int rep_ = 0; rep_ < (DUM(8) ? 2 : 1); ++rep_) { PHASE_BEGIN(); F.dofs = (DUM(8) && rep_ == 0) ? WS_END : 0;
            SchedGrid Sg{(const char*)(ws + WS_AMIX), (const char*)(ws + WS_WOUT) + (size_t)l * 1024 * 1024 * 2, 1024, 1024, 4, (T / 256) * 4, F.G, F.vcu};
            EpiWout E{(bf16*)(ws + WS_X), (const float*)(ws + WS_MODS) + ((size_t)(l * 8) * 6 + 2) * 1024, F.dofs};
            pg8::gemm_phase<EpiWout, SchedGrid, false>(F.lds, 1024, 1024, Sg, E);
        }
        SEAM(P + 7);
        if (PHON(9) && IN(P + 8)) _Pragma("unroll 1") for (int rep_ = 0; rep_ < (DUM(9) ? 2 : 1); ++rep_) { PHASE_BEGIN(); F.dofs = (DUM(9) && rep_ == 0) ? WS_END : 0; F.dcnt = (DUM(9) && rep_ == 0) ? 4 : 0; phase_router(F, l); }
        SEAM(P + 8);
        if (PHON(10) && IN(P + 9)) _Pragma("unroll 1") for (int rep_ = 0; rep_ < NREP(10); ++rep_) { PHASE_BEGIN();
            moe_tables(F, l);
            const LAS int* tb = (const LAS int*)(F.lds + AUX_OFF);
            SchedMoe1F8 Sm{tb, tb + 64, (const char*)(ws + WS_H), (const char*)(ws + WS_W1E) + (size_t)l * 32 * 2048 * 1024, (const int*)(ws + WS_IDX), tb[32] * 8, F.G, F.vcu};
            EpiMoe1 E{(bf16*)(ws + WS_ACT), ginp(F, I_BE1) + (size_t)l * 32 * 2048};
            pg8::gemm_phase<EpiMoe1, SchedMoe1F8, true, true>(F.lds, 512, 512, Sm, E);
            if (CONV_IN_LAYER && CONV_TAIL1 > 0 && rep_ == 0 && l + 1 < DEPTH) {
                const int nun = tb[32] * 8, rounds = (nun + F.G - 1) / F.G, mine = F.vcu < nun ? (nun - 1 - F.vcu) / F.G + 1 : 0;
                if (mine < rounds) { PHASE_BEGIN(); conv_claim_tiles(F, l + 1, CONV_TAIL1); }
            }
        }
        SEAM(P + 9);
        if (PHON(11) && IN(P + 10)) _Pragma("unroll 1") for (int rep_ = 0; rep_ < NREP(11); ++rep_) { PHASE_BEGIN();
            moe_tables(F, l);
            const LAS int* tb = (const LAS int*)(F.lds + AUX_OFF);
            SchedMoe2F8 Sm{tb, (const char*)(ws + WS_ACT), (const char*)(ws + WS_W2E) + (size_t)l * 32 * 1024 * 1024, tb[32] * 4, F.G, F.vcu};
            EpiMoe2 E{(unsigned char*)(ws + WS_Y2), ginp(F, I_BE2) + (size_t)l * 32 * 1024, (const float*)(ws + WS_GATEW)};
            pg8::gemm_phase<EpiMoe2, SchedMoe2F8, false, true>(F.lds, 512, 512, Sm, E);
            if (CONV_IN_LAYER && CONV_TAIL2 > 0 && rep_ == 0 && l + 1 < DEPTH) {
                const int nun = tb[32] * 4, rounds = (nun + F.G - 1) / F.G, mine = F.vcu < nun ? (nun - 1 - F.vcu) / F.G + 1 : 0;
                if (mine < rounds) { PHASE_BEGIN(); conv_claim_tiles(F, l + 1, CONV_TAIL2); }
            }
        }
        SEAM(P + 10);
    }
    if (PHON(12) && IN(N_PHASES - 1)) { PHASE_BEGIN(); phase_norm1<1>(F, DEPTH); }
#undef IN
#undef SEAM
}

extern "C" void kernel_launch(void* const* d_in, const int* in_sizes, int n_in, void* d_out, int out_size, void* d_ws, size_t ws_size, hipStream_t stream) {
    static int grid = 0;
    if (grid == 0) {
        if (n_in != 33 || out_size != T * D || ws_size < WS_END * (DUM_MASK ? 2 : 1)) { fprintf(stderr, "kernel_launch: unexpected problem (n_in %d out %d ws %zu)\n", n_in, out_size, ws_size); grid = -1; return; }
        int dev = 0, cus = 0, per_cu = 0;
        if (hipGetDevice(&dev) != hipSuccess || hipDeviceGetAttribute(&cus, hipDeviceAttributeMultiprocessorCount, dev) != hipSuccess) { grid = -1; return; }
        if (hipFuncSetAttribute((const void*)fwd_kernel, hipFuncAttributeMaxDynamicSharedMemorySize, LDS_BYTES) != hipSuccess) { fprintf(stderr, "kernel_launch: hipFuncSetAttribute failed\n"); grid = -1; return; }
        if (hipOccupancyMaxActiveBlocksPerMultiprocessor(&per_cu, (const void*)fwd_kernel, 512, LDS_BYTES) != hipSuccess || per_cu < 1) { fprintf(stderr, "kernel_launch: occupancy query says %d\n", per_cu); per_cu = 1; }
        (void)hipGetLastError();
        grid = cus;
    }
    if (grid < 0) return;
    if (hipMemsetAsync((char*)d_ws + WS_CTL, 0, CTL_ZERO_BYTES, stream) != hipSuccess) return;
    Args a{};
    for (int i = 0; i < 33; ++i) a.in[i] = (const float*)d_in[i];
    a.out = (float*)d_out; a.ws = (unsigned char*)d_ws;
#if MK_PER_PHASE
    for (int p = 0; p < N_PHASES; ++p) { a.ph_lo = p; a.ph_hi = p + 1; hipLaunchKernelGGL(fwd_kernel, dim3(grid), dim3(512), LDS_BYTES, stream, a); }
#else
    a.ph_lo = 0; a.ph_hi = N_PHASES;
    hipLaunchKernelGGL(fwd_kernel, dim3(grid), dim3(512), LDS_BYTES, stream, a);
#endif
}
```

```cpp
#include <hip/hip_runtime.h>
#include <cstdio>
#include <cstdint>

#ifndef MK_PER_PHASE
#define MK_PER_PHASE 0
#endif

#ifndef PH_MASK
#define PH_MASK 0xFFFFFFFFu
#endif
#define PHON(k) ((PH_MASK >> (k)) & 1u)
#ifndef DBL_MASK
#define DBL_MASK 0u
#endif
#define NREP(k) (((DBL_MASK >> (k)) & 1u) ? 2 : 1)
#ifndef DUM_MASK
#define DUM_MASK 0u
#endif
#define DUM(k) ((DUM_MASK >> (k)) & 1u)
#ifndef ATT_VAR
#define ATT_VAR 0
#endif
#ifndef CONV_IN_LAYER
#define CONV_IN_LAYER 1
#endif
#ifndef CONV_TAIL1
#define CONV_TAIL1 3
#endif
#ifndef CONV_TAIL2
#define CONV_TAIL2 4
#endif
#ifndef ATT_STAGGER
#define ATT_STAGGER 0
#endif
#define DI __device__ __forceinline__
#define LAS __attribute__((address_space(3)))
#define GAS __attribute__((address_space(1)))
typedef unsigned short bf16;
typedef short bf16x8 __attribute__((ext_vector_type(8)));
typedef short s16x4 __attribute__((ext_vector_type(4)));
typedef float f32x2 __attribute__((ext_vector_type(2)));
typedef float f32x4 __attribute__((ext_vector_type(4)));
typedef float f32x16 __attribute__((ext_vector_type(16)));
typedef unsigned u32x2 __attribute__((ext_vector_type(2)));
typedef unsigned u32x4 __attribute__((ext_vector_type(4)));
typedef __bf16 bf16x2_t __attribute__((ext_vector_type(2)));
typedef unsigned long long u64;

constexpr int NB = 8, S = 4096, T = NB * S, D = 1024, DEPTH = 4;
constexpr int NIN = 2560;
constexpr int NE = 32, DFF = 1024;
constexpr int SP = S + 64;
constexpr int ECAP = 32768;
constexpr int ACT_ROWS = 4 * T + NE * 256;
constexpr float LOG2E = 1.4426950408889634f;
constexpr float SCL64 = 0.125f * LOG2E;
constexpr float SCL96 = 0.10206207261596577f * LOG2E;
constexpr float EPS = 1e-6f;

constexpr size_t MiB = 1u << 20;
constexpr size_t WS_CTL = 0, CTL_ZERO_BYTES = 2 * MiB;
constexpr size_t WS_MODS = 2 * MiB, WS_B1P = 3 * MiB, WS_CS64 = 4 * MiB, WS_CS32 = 12 * MiB;
constexpr size_t WS_WIN = 16 * MiB, WS_WOUT = 36 * MiB, WS_NSAW1 = 44 * MiB, WS_MLAQ = 52 * MiB, WS_MLAKV = 53 * MiB;
constexpr size_t WS_W1E = 64 * MiB, WS_W2E = 576 * MiB;
constexpr size_t WS_X = 832 * MiB, WS_H = 960 * MiB;
constexpr size_t WS_QA = 1024 * MiB, WS_KA = 1040 * MiB, WS_VA = 1056 * MiB, WS_QB = 1072 * MiB;
constexpr size_t WS_KCMP = 1104 * MiB, WS_VCMP = 1113 * MiB;
constexpr size_t WS_KSLC = 1122 * MiB, WS_VSLC = 1130 * MiB, WS_KWIN = 1138 * MiB, WS_VWIN = 1146 * MiB;
constexpr size_t WS_CQ = 1154 * MiB, WS_MISC = 1170 * MiB;
constexpr size_t WS_RSTDQ = 1186 * MiB, WS_RSTDKV = 1186 * MiB + 512 * 1024, WS_KR = 1187 * MiB, WS_GATES = 1189 * MiB;
constexpr size_t WS_W2T = 1195 * MiB;
constexpr size_t WS_HID = 1192 * MiB, WS_KC = 1196 * MiB, WS_VC = 1196 * MiB + 512 * 1024;
constexpr size_t WS_QM = 1197 * MiB, WS_KN = 1221 * MiB, WS_VM = 1237 * MiB;
constexpr size_t WS_OA3 = 1253 * MiB, WS_LSEA = 1301 * MiB;
constexpr size_t WS_OCMP = 1303 * MiB, WS_OSLC = 1335 * MiB, WS_OWIN = 1367 * MiB, WS_OC = 1399 * MiB;
constexpr size_t WS_SEL = 1415 * MiB, WS_AMIX = 1416 * MiB;
constexpr size_t WS_IDX = 1480 * MiB, WS_GATEW = 1484 * MiB, WS_TOKSLOT = 1488 * MiB;
constexpr size_t WS_ACT = 1489 * MiB, WS_Y2 = 1761 * MiB, WS_END = 2033 * MiB;
static_assert((size_t)ACT_ROWS * 1024 * 2 <= 272 * MiB, "act rows");
static_assert((size_t)16 * SP * 64 * 2 + 65536 <= 9 * MiB, "kcmp");

constexpr int CW_TMO = 0, CW_FAIL = 2;
constexpr int CW_BAR = 4096;
constexpr int CW_QUEUE = 12288;
constexpr int CW_CONVQ = 13312;
constexpr int CW_CNT = 16384;

constexpr int RING_BYTES = 131072;
constexpr int AUX_OFF = RING_BYTES;
constexpr int MISC_OFF = AUX_OFF + 8192;
constexpr int LDS_BYTES = 147456;

DI unsigned pk2(float lo, float hi) { f32x2 v = {lo, hi}; bf16x2_t b = __builtin_convertvector(v, bf16x2_t); return __builtin_bit_cast(unsigned, b); }
DI float bf2f(unsigned short h) { return __uint_as_float(((unsigned)h) << 16); }
DI float bflo(unsigned w) { return __uint_as_float(w << 16); }
DI float bfhi(unsigned w) { return __uint_as_float(w & 0xffff0000u); }
typedef float f32x2c __attribute__((ext_vector_type(2)));
constexpr float Y2_SCALE = 16.0f, Y2_ISCALE = 1.0f / 16.0f;
DI unsigned pk4_fp8(float a, float b, float c, float d) {
    a = fminf(fmaxf(a * Y2_SCALE, -440.f), 440.f); b = fminf(fmaxf(b * Y2_SCALE, -440.f), 440.f); c = fminf(fmaxf(c * Y2_SCALE, -440.f), 440.f); d = fminf(fmaxf(d * Y2_SCALE, -440.f), 440.f);
    int w = __builtin_amdgcn_cvt_pk_fp8_f32(a, b, 0, false); w = __builtin_amdgcn_cvt_pk_fp8_f32(c, d, w, true); return (unsigned)w; }
DI f32x4 unpk4_fp8(unsigned w) { const f32x2c lo = __builtin_amdgcn_cvt_pk_f32_fp8((int)w, false), hi = __builtin_amdgcn_cvt_pk_f32_fp8((int)w, true); return (f32x4){lo.x, lo.y, hi.x, hi.y}; }
constexpr float W8_SCALE = 64.0f, A8_SCALE = 4.0f;
constexpr int W8_E8M0 = 127 - 6, A8_E8M0 = 127 - 2;
constexpr float H8_SCALE = 8.0f; constexpr int H8_E8M0 = 127 - 3;
DI int lane_id() { return (int)__builtin_amdgcn_mbcnt_hi(~0u, __builtin_amdgcn_mbcnt_lo(~0u, 0u)); }
DI unsigned pk4_fp8s(float a, float b, float c, float d, float sc) {
    a = fminf(fmaxf(a * sc, -440.f), 440.f); b = fminf(fmaxf(b * sc, -440.f), 440.f); c = fminf(fmaxf(c * sc, -440.f), 440.f); d = fminf(fmaxf(d * sc, -440.f), 440.f);
    int w = __builtin_amdgcn_cvt_pk_fp8_f32(a, b, 0, false); w = __builtin_amdgcn_cvt_pk_fp8_f32(c, d, w, true); return (unsigned)w; }
DI float q8s(float x, float sc) {
    const float a = fminf(fmaxf(x * sc, -440.f), 440.f); const int w = __builtin_amdgcn_cvt_pk_fp8_f32(a, a, 0, false);
    const f32x2c r = __builtin_amdgcn_cvt_pk_f32_fp8(w, false); return r.x; }
DI float wave_sum(float v) {
#pragma unroll
    for (int o = 1; o < 64; o <<= 1) v += __shfl_xor(v, o);
    return v;
}
DI float fast_exp2(float x) { return __builtin_amdgcn_exp2f(x); }
DI float fast_rcp(float x) { return __builtin_amdgcn_rcpf(x); }
DI float sigmoidf_(float x) { return fast_rcp(1.0f + fast_exp2(-x * LOG2E)); }
#define RLX_AGENT __ATOMIC_RELAXED, __HIP_MEMORY_SCOPE_AGENT

#define XB_TMO      128
#define XB_XCNT(j)  (256  + 64 * (j))
#define XB_XSUB(j)  (1280 + 64 * (j))
#define XB_XGEN(j)  (2304 + 64 * (j))
#define XB_TOP      3328
#define XB_TOPGEN   3392
#define XCD_BAR_WORDS 3456
#define XB_SPIN_CAP (1u << 22)
DI unsigned xb_ld(unsigned* p)              { return __hip_atomic_load(p, __ATOMIC_RELAXED, __HIP_MEMORY_SCOPE_AGENT); }
DI unsigned xb_add(unsigned* p, unsigned v) { return __hip_atomic_fetch_add(p, v, __ATOMIC_RELAXED, __HIP_MEMORY_SCOPE_AGENT); }
DI unsigned xb_xcc_id() { return (unsigned)__builtin_amdgcn_s_getreg((3 << 11) | 20) & 0xFu; }
#define XB_SPIN(cond, bar) do { unsigned _sp = 0; while (cond) { __builtin_amdgcn_s_sleep(1); \
    if ((++_sp & 255u) == 0u) { if (xb_ld(&(bar)[XB_TMO])) break; if (_sp > XB_SPIN_CAP) { atomicAdd(&(bar)[XB_TMO], 1u); break; } } } } while (0)
struct XcdBarrier { unsigned* bar; unsigned x; volatile LAS unsigned* st; };
DI XcdBarrier xcd_barrier_post(unsigned* bar, volatile LAS unsigned* st) {
    XcdBarrier b; b.bar = bar; b.x = xb_xcc_id(); b.st = st;
    if (threadIdx.x == 0) (void)xb_add(&bar[XB_XCNT(b.x)], 1u);
    return b;
}
DI void xcd_barrier_complete(unsigned* bar, unsigned x, unsigned& nloc, unsigned& nx) {
    const unsigned G = gridDim.x * gridDim.y * gridDim.z;
    unsigned sum, cnt, mine, sp = 0u;
    for (;;) {
        sum = 0u; cnt = 0u; mine = 0u;
#pragma unroll
        for (unsigned j = 0; j < 16; ++j) { const unsigned c = xb_ld(&bar[XB_XCNT(j)]); sum += c; cnt += (c > 0u) ? 1u : 0u; mine = (j == x) ? c : mine; }
        if (sum == G) break;
        __builtin_amdgcn_s_sleep(1);
        if ((++sp & 255u) == 0u) { if (xb_ld(&bar[XB_TMO])) break; if (sp > XB_SPIN_CAP) { atomicAdd(&bar[XB_TMO], 1u); break; } }
    }
    nloc = mine > 0u ? mine : 1u; nx = cnt > 0u ? cnt : 1u;
}
DI void xcd_barrier(const XcdBarrier& b) {
    asm volatile("s_waitcnt vmcnt(0)" ::: "memory");
    __syncthreads();
    unsigned* bar = b.bar; asm volatile("" : "+s"(bar));
    if (threadIdx.x == 0) {
        __builtin_amdgcn_s_waitcnt(0);
        unsigned nloc = b.st[0], nx = b.st[1];
        if (nloc == 0u) { xcd_barrier_complete(bar, b.x, nloc, nx); b.st[0] = nloc; b.st[1] = nx; }
        const unsigned old = xb_add(&bar[XB_XSUB(b.x)], 1u);
        const unsigned gen = old / nloc;
        if (old + 1u == (gen + 1u) * nloc) {
            __builtin_amdgcn_fence(__ATOMIC_RELEASE, "agent");
            asm volatile("s_waitcnt vmcnt(0)" ::: "memory");
            const unsigned og = xb_add(&bar[XB_TOP], 1u);
            const unsigned tg = og / nx;
            if (og + 1u == (tg + 1u) * nx) xb_add(&bar[XB_TOPGEN], 1u);
            else XB_SPIN(xb_ld(&bar[XB_TOPGEN]) == tg, bar);
            __builtin_amdgcn_fence(__ATOMIC_ACQUIRE, "agent");
            xb_add(&bar[XB_XGEN(b.x)], 1u);
            asm volatile("s_waitcnt vmcnt(0)" ::: "memory");
        } else {
            XB_SPIN(xb_ld(&bar[XB_XGEN(b.x)]) == gen, bar);
            __builtin_amdgcn_fence(__ATOMIC_ACQUIRE, "agent");
            asm volatile("s_waitcnt vmcnt(0)" ::: "memory");
        }
    }
    __syncthreads();
}

struct Args {
    const float* in[33];
    float* out;
    unsigned char* ws;
    int ph_lo, ph_hi;
};
enum { I_X = 0, I_C, I_POS, I_WADA, I_BADA, I_G1, I_G2, I_WIN, I_POSK, I_POSV, I_W1K, I_B1K, I_W2K, I_B2K, I_W1V, I_B1V, I_W2V, I_B2V,
       I_GQ, I_GKV, I_WQUP, I_WKVUP, I_GOA, I_GOB, I_GOC, I_WOUT, I_WR, I_BR, I_WE1, I_BE1, I_WE2, I_BE2, I_GF };

struct Ctx {
    LAS unsigned char* lds;
    const Args* a;
    unsigned char* ws;
    int tid, lane, wave, blk, G, vcu;
    size_t dofs; int dcnt;
};
DI const float* ginp(const Ctx& F, int i) { return (const float*)(GAS const float*)(F.a->in[i]); }
DI float* gout(const Ctx& F) { return (float*)(GAS float*)(F.a->out); }

namespace pg8 {
constexpr int BM = 256, BK = 64, HALF = 128, HTB = HALF * BK * 2;
DI int lds_byte(int r, int c) { const int st = (r >> 4) * 2 + (c >> 5), rr = r & 15, cc = c & 31, ob = rr * 64 + cc * 2; return st * 1024 + (ob ^ (((ob >> 9) & 1) << 5)); }
DI void stage_rc(int b, int& R, int& C) { const int st = b / 1024, sb = b % 1024, swz = sb ^ (((sb >> 9) & 1) << 5); R = (st >> 1) * 16 + swz / 64; C = (st & 1) * 32 + (swz % 64) / 2; }
DI int perm32(int rho) { const int n = rho >> 4, i = rho & 15; return 8 * (i >> 2) + 4 * n + (i & 3); }
struct Unit { const char* a; const char* b; int pm, pn, e, ml; };

template <class Epi, class Sched, bool GATHER, bool FP8 = false>
DI void gemm_phase(LAS unsigned char* lds, const int lda, const int K, const Sched& S, const Epi& E) {
    typedef int i32x4_ __attribute__((ext_vector_type(4))); typedef int i32x8_ __attribute__((ext_vector_type(8)));
    int tid_ = threadIdx.x; asm volatile("" : "+v"(tid_));
    const int tid = tid_, wid = __builtin_amdgcn_readfirstlane(tid >> 6), lane = tid & 63, wr = wid >> 2, wc = wid & 3, fr = lane & 15, fq = lane >> 4;
    const int nt = K / BK;
    int Rr[2], Cc[2]; unsigned voffB[2];
#pragma unroll
    for (int i = 0; i < 2; ++i) { int R, C; stage_rc(tid * 16 + i * 8192, R, C); Rr[i] = R; Cc[i] = C; const int Rb = Epi::PERM ? ((R & ~31) + perm32(R & 31)) : R; voffB[i] = (unsigned)(Rb * K + C) * 2u; }
    const size_t kstep = (size_t)(BK * 2);
    const size_t hstepB = (size_t)HALF * K * 2;
    const unsigned ldsw = (unsigned)wid * 1024u;
    const int aoff = lds_byte(wr * 64 + fr, fq * 8), boff = lds_byte(wc * 32 + fr, fq * 8);
#define PG8_SA(b, h) (((b) * 2 + (h)) * HTB)
#define PG8_SB(b, h) ((4 + (b) * 2 + (h)) * HTB)
#define PG8_STAGE_B(bufoff, gbase) do { _Pragma("unroll") for (int _i = 0; _i < 2; ++_i) \
        __builtin_amdgcn_global_load_lds((const unsigned*)((const char*)(gbase) + (size_t)_i * 64 * K * 2 + voffB[0]), (LAS unsigned*)(lds + (bufoff) + ldsw + _i * 8192), 16, 0, 0); } while (0)
#define PG8_STAGE_A(bufoff, gbase, v, h) do { _Pragma("unroll") for (int _i = 0; _i < 2; ++_i) { \
        if constexpr (GATHER) __builtin_amdgcn_global_load_lds((const unsigned*)((const char*)(gbase) + (v)[h][_i]), (LAS unsigned*)(lds + (bufoff) + ldsw + _i * 8192), 16, 0, 0); \
        else __builtin_amdgcn_global_load_lds((const unsigned*)((const char*)(gbase) + (size_t)((h) * 128 + _i * 64) * lda * 2 + (v)[0][0]), (LAS unsigned*)(lds + (bufoff) + ldsw + _i * 8192), 16, 0, 0); } } while (0)
#define PG8_SETOFF(v, u) do { _Pragma("unroll") for (int _h = 0; _h < 2; ++_h) _Pragma("unroll") for (int _i = 0; _i < 2; ++_i) { \
        if constexpr (GATHER) (v)[_h][_i] = S.gather_off((u), _h * 128 + Rr[_i]) + (unsigned)Cc[_i] * 2u; \
        else (v)[_h][_i] = (unsigned)((_h * 128 + Rr[_i]) * lda + Cc[_i]) * 2u; } } while (0)
#define PG8_LDA(dst, b, h) do { _Pragma("unroll") for (int m = 0; m < 4; ++m) { const i32x4_ lo_ = *(const LAS i32x4_*)(lds + PG8_SA(b, h) + aoff + m * 2048), hi_ = *(const LAS i32x4_*)(lds + PG8_SA(b, h) + aoff + m * 2048 + 1024); dst[m] = __builtin_shufflevector(lo_, hi_, 0, 1, 2, 3, 4, 5, 6, 7); } } while (0)
#define PG8_LDB(dst, b, h) do { _Pragma("unroll") for (int n = 0; n < 2; ++n) { const i32x4_ lo_ = *(const LAS i32x4_*)(lds + PG8_SB(b, h) + boff + n * 2048), hi_ = *(const LAS i32x4_*)(lds + PG8_SB(b, h) + boff + n * 2048 + 1024); dst[n] = __builtin_shufflevector(lo_, hi_, 0, 1, 2, 3, 4, 5, 6, 7); } } while (0)
#define PG8_H0(x) __builtin_bit_cast(bf16x8, __builtin_shufflevector((x), (x), 0, 1, 2, 3))
#define PG8_H1(x) __builtin_bit_cast(bf16x8, __builtin_shufflevector((x), (x), 4, 5, 6, 7))
#define PG8_MMA(ai, bj, At, Bt) do { __builtin_amdgcn_s_setprio(1); \
        if constexpr (FP8) { _Pragma("unroll") for (int m = 0; m < 4; ++m) _Pragma("unroll") for (int n = 0; n < 2; ++n) \
            asm volatile("v_mfma_scale_f32_16x16x128_f8f6f4 %0, %1, %2, %0, %3, %4 op_sel_hi:[0,0,0]" : "+v"(acc[ai][bj][m][n]) : "v"(Bt[n]), "v"(At[m]), "v"(scw_), "v"(sca_)); } \
        else { _Pragma("unroll") for (int m = 0; m < 4; ++m) _Pragma("unroll") for (int n = 0; n < 2; ++n) { \
            acc[ai][bj][m][n] = __builtin_amdgcn_mfma_f32_16x16x32_bf16(PG8_H0(Bt[n]), PG8_H0(At[m]), acc[ai][bj][m][n], 0, 0, 0); \
            acc[ai][bj][m][n] = __builtin_amdgcn_mfma_f32_16x16x32_bf16(PG8_H1(Bt[n]), PG8_H1(At[m]), acc[ai][bj][m][n], 0, 0, 0); } } \
        __builtin_amdgcn_s_setprio(0); } while (0)
#define PG8_WAIT_V(n) asm volatile("s_waitcnt vmcnt(" #n ")" ::: "memory")
#define PG8_WAIT_L(n) asm volatile("s_waitcnt lgkmcnt(" #n ")" ::: "memory")
#define PG8_BAR __builtin_amdgcn_s_barrier()
#define PG8_SCHED __builtin_amdgcn_sched_barrier(0)
    Unit cur, nxt; int ui = 0;
    if (!S.next(0, cur)) return;
    f32x4 acc[2][2][4][2];
#pragma unroll
    for (int a = 0; a < 2; ++a)
#pragma unroll
        for (int b = 0; b < 2; ++b)
#pragma unroll
            for (int m = 0; m < 4; ++m)
#pragma unroll
                for (int n = 0; n < 2; ++n) acc[a][b][m][n] = (f32x4){0.f, 0.f, 0.f, 0.f};
    int scw_ = W8_E8M0, sca_ = A8_E8M0; if constexpr (FP8) sca_ = Epi::A_E8M0;
    i32x8_ At[4], B0[2], B1[2];
    unsigned vA[2][2], vAn[2][2];
    PG8_SETOFF(vA, cur);
    const char* cA = cur.a; const char* cB = cur.b;
    PG8_STAGE_B(PG8_SB(0, 0), cB); PG8_STAGE_B(PG8_SB(0, 1), cB + hstepB); PG8_STAGE_A(PG8_SA(0, 0), cA, vA, 0); PG8_STAGE_A(PG8_SA(0, 1), cA, vA, 1);
    if (wr == 1) PG8_BAR;
    PG8_WAIT_V(2); PG8_BAR;
    PG8_STAGE_B(PG8_SB(1, 0), cB + kstep); PG8_STAGE_A(PG8_SA(1, 0), cA + kstep, vA, 0); PG8_STAGE_B(PG8_SB(1, 1), cB + hstepB + kstep);
    PG8_WAIT_V(6); PG8_BAR;
    for (;;) {
        const bool has_next = S.next(ui + 1, nxt);
        if constexpr (GATHER) {
            if (has_next) {
#pragma unroll
                for (int h = 0; h < 2; ++h)
#pragma unroll
                    for (int i = 0; i < 2; ++i) vAn[h][i] = S.gather_raw(nxt, h * 128 + Rr[i]);
            }
        }
        const char* nA = has_next ? nxt.a : cA; const char* nB = has_next ? nxt.b : cB;
#pragma unroll 1
        for (int t = 0; t < nt; t += 2) {
            const bool last = (t == nt - 2);
            const char* a1 = cA + (size_t)(t + 1) * kstep;
            const char* a2 = last ? nA : cA + (size_t)(t + 2) * kstep; const char* b2 = last ? nB : cB + (size_t)(t + 2) * kstep;
            const char* a3 = a2 + kstep; const char* b3 = b2 + kstep;
            unsigned v2[2][2];
#pragma unroll
            for (int h = 0; h < 2; ++h)
#pragma unroll
                for (int i = 0; i < 2; ++i) v2[h][i] = vA[h][i];
            if constexpr (GATHER) {
                if (last && has_next) {
#pragma unroll
                    for (int h = 0; h < 2; ++h)
#pragma unroll
                        for (int i = 0; i < 2; ++i) { vAn[h][i] = vAn[h][i] * (unsigned)(lda * 2) + (unsigned)Cc[i] * 2u; v2[h][i] = vAn[h][i]; }
                }
            }
            PG8_LDB(B0, 0, 0); PG8_LDB(B1, 0, 1); PG8_SCHED; PG8_LDA(At, 0, 0); PG8_STAGE_A(PG8_SA(1, 1), a1, vA, 1);
            PG8_WAIT_V(8); PG8_WAIT_L(0); PG8_BAR; PG8_MMA(0, 0, At, B0); PG8_MMA(0, 1, At, B1); PG8_BAR; PG8_SCHED;
            PG8_LDA(At, 0, 1); PG8_STAGE_B(PG8_SB(0, 0), b2); PG8_STAGE_B(PG8_SB(0, 1), b2 + hstepB); PG8_STAGE_A(PG8_SA(0, 0), a2, v2, 0);
            PG8_WAIT_V(8); PG8_WAIT_L(0); PG8_BAR; PG8_MMA(1, 0, At, B0); PG8_MMA(1, 1, At, B1); PG8_BAR; PG8_SCHED;
            PG8_LDB(B0, 1, 0); PG8_LDB(B1, 1, 1); PG8_SCHED; PG8_LDA(At, 1, 0); PG8_STAGE_A(PG8_SA(0, 1), a2, v2, 1);
            PG8_WAIT_V(8); PG8_WAIT_L(0); PG8_BAR; PG8_MMA(0, 0, At, B0); PG8_MMA(0, 1, At, B1); PG8_BAR; PG8_SCHED;
            PG8_LDA(At, 1, 1); PG8_STAGE_B(PG8_SB(1, 0), b3); PG8_STAGE_B(PG8_SB(1, 1), b3 + hstepB); PG8_STAGE_A(PG8_SA(1, 0), a3, v2, 0);
            PG8_WAIT_V(8); PG8_WAIT_L(0); PG8_BAR; PG8_MMA(1, 0, At, B0); PG8_MMA(1, 1, At, B1); PG8_BAR; PG8_SCHED;
        }
        if (wr == 0) PG8_BAR;
        if constexpr (FP8) asm volatile("s_nop 15\n\ts_nop 15" ::: "memory");
        if constexpr (!Epi::AFTER_DRAIN) { int fr_ = fr, fq_ = fq; asm volatile("" : "+v"(fr_), "+v"(fq_)); E(acc, cur, wr, wc, fr_, fq_); }
        if (!has_next) break;
#pragma unroll
        for (int a = 0; a < 2; ++a)
#pragma unroll
            for (int b = 0; b < 2; ++b)
#pragma unroll
                for (int m = 0; m < 4; ++m)
#pragma unroll
                    for (int n = 0; n < 2; ++n) acc[a][b][m][n] = (f32x4){0.f, 0.f, 0.f, 0.f};
        cur = nxt; cA = nA; cB = nB; ++ui;
        if constexpr (GATHER) {
#pragma unroll
            for (int h = 0; h < 2; ++h)
#pragma unroll
                for (int i = 0; i < 2; ++i) vA[h][i] = vAn[h][i];
        }
        if (wr == 1) PG8_BAR;
    }
    PG8_WAIT_V(0);
    PG8_BAR;
    if constexpr (Epi::AFTER_DRAIN) { int fr_ = fr, fq_ = fq; asm volatile("" : "+v"(fr_), "+v"(fq_)); E.fused(acc, cur, wr, wc, fr_, fq_, lds, wid, lane); }
#undef PG8_SA
#undef PG8_SB
#undef PG8_STAGE_A
#undef PG8_STAGE_B
#undef PG8_SETOFF
#undef PG8_LDA
#undef PG8_LDB
#undef PG8_MMA
#undef PG8_H0
#undef PG8_H1
#undef PG8_WAIT_V
#undef PG8_WAIT_L
#undef PG8_BAR
#undef PG8_SCHED
}
}
using pg8::Unit;
typedef f32x4 AccT[2][2][4][2];

struct SchedGrid {
    const char* A; const char* B; int lda, K, nN, nwg, G, c;
    DI bool next(int i, Unit& u) const {
        const int L = i * G + c; if (L >= nwg) return false;
        u.pm = L / nN; u.pn = L % nN; u.e = 0; u.ml = 0;
        u.a = A + (size_t)u.pm * 256 * lda * 2; u.b = B + (size_t)u.pn * 256 * K * 2; return true;
    }
    DI unsigned gather_off(const Unit&, int) const { return 0u; }
    DI unsigned gather_raw(const Unit&, int) const { return 0u; }
};
struct SchedCmp {
    const char* KCMP; const char* VCMP; const char* W; int G, c;
    DI bool next(int i, Unit& u) const {
        const int L = i * G + c; if (L >= 32) return false;
        const int kv = L >> 4, bg = L & 15;
        u.pm = L; u.pn = 0; u.e = kv; u.ml = 0;
        u.a = (kv ? VCMP : KCMP) + (size_t)bg * SP * 64 * 2; u.b = W + (size_t)kv * 256 * 2048 * 2; return true;
    }
    DI unsigned gather_off(const Unit&, int) const { return 0u; }
    DI unsigned gather_raw(const Unit&, int) const { return 0u; }
};
struct SchedMla {
    const char* CQ; const char* MISC; const char* WQ; const char* WKV; int G, c;
    DI bool next(int i, Unit& u) const {
        const int L = i * G + c; if (L >= 512) return false;
        const int which = L >> 8, r = L & 255;
        u.pm = r >> 1; u.pn = r & 1; u.e = which; u.ml = 0;
        u.a = (which ? MISC : CQ) + (size_t)u.pm * 256 * 256 * 2; u.b = (which ? WKV : WQ) + (size_t)u.pn * 256 * 256 * 2; return true;
    }
    DI unsigned gather_off(const Unit&, int) const { return 0u; }
    DI unsigned gather_raw(const Unit&, int) const { return 0u; }
};
template <int NT, bool GATHERED>
struct SchedMoe {
    const LAS int* tb; const LAS int* cnt; const char* A; const char* W; const int* IDX; int total, G, c;
    DI bool next(int i, Unit& u) const {
        const int L = i * G + c; if (L >= total) return false;
        const int mtg = L / NT; u.pn = L % NT;
        const int ln_ = threadIdx.x & 63;
        const int e = __popcll(__ballot(ln_ < 32 && tb[ln_ & 31] <= mtg)) - 1;
        u.e = e; u.ml = mtg - tb[e]; u.pm = mtg;
        u.a = GATHERED ? A : A + (size_t)mtg * 256 * 1024 * 2;
        u.b = W + ((size_t)e * NT * 256 + (size_t)u.pn * 256) * 1024 * 2; return true;
    }
    DI unsigned gather_off(const Unit& u, int row) const {
        const int pos = u.ml * 256 + row; const int tok = (pos < cnt[u.e]) ? IDX[u.e * ECAP + pos] : 0;
        return (unsigned)tok * 2048u;
    }
    DI unsigned gather_raw(const Unit& u, int row) const {
        const int pos = u.ml * 256 + row;
        return (unsigned)IDX[u.e * ECAP + (pos < cnt[u.e] ? pos : 0)];
    }
};

struct SchedMoe1F8 {
    static constexpr bool HOOK = false;
    const LAS int* tb; const LAS int* cnt; const char* A; const char* W; const int* IDX; int total, G, c;
    DI bool next(int i, Unit& u) const {
        const int L = i * G + c; if (L >= total) return false;
        const int mtg = L >> 3; u.pn = L & 7;
        const int ln_ = lane_id();
        const int e = __popcll(__ballot(ln_ < 32 && tb[ln_ & 31] <= mtg)) - 1;
        u.e = e; u.ml = mtg - tb[e]; u.pm = mtg;
        u.a = A; u.b = W + ((size_t)e * 2048 + (size_t)u.pn * 256) * 1024; return true;
    }
    DI unsigned gather_raw(const Unit& u, int row) const { const int pos = u.ml * 256 + row; return (unsigned)IDX[u.e * ECAP + (pos < cnt[u.e] ? pos : 0)]; }
    DI unsigned gather_off(const Unit& u, int row) const { return gather_raw(u, row) * 1024u; }
};
struct SchedMoe2F8 {
    static constexpr bool HOOK = false;
    const LAS int* tb; const char* A; const char* W; int total, G, c;
    DI bool next(int i, Unit& u) const {
        const int L = i * G + c; if (L >= total) return false;
        const int mtg = L >> 2; u.pn = L & 3;
        const int ln_ = lane_id();
        const int e = __popcll(__ballot(ln_ < 32 && tb[ln_ & 31] <= mtg)) - 1;
        u.e = e; u.ml = mtg - tb[e]; u.pm = mtg;
        u.a = A + (size_t)mtg * 256 * 1024; u.b = W + ((size_t)e * 1024 + (size_t)u.pn * 256) * 1024; return true;
    }
    DI unsigned gather_off(const Unit&, int) const { return 0u; }
    DI unsigned gather_raw(const Unit&, int) const { return 0u; }
};

DI void rot4(f32x4& v0, f32x4& v1, const f32x4 c, const f32x4 s) {
    const float a0 = v0[0], b0 = v0[1], a1 = v0[2], b1 = v0[3], a2 = v1[0], b2 = v1[1], a3 = v1[2], b3 = v1[3];
    v0[0] = a0 * c[0] - b0 * s[0]; v0[1] = b0 * c[0] + a0 * s[0];
    v0[2] = a1 * c[1] - b1 * s[1]; v0[3] = b1 * c[1] + a1 * s[1];
    v1[0] = a2 * c[2] - b2 * s[2]; v1[1] = b2 * c[2] + a2 * s[2];
    v1[2] = a3 * c[3] - b3 * s[3]; v1[3] = b3 * c[3] + a3 * s[3];
}
DI u32x4 pack8(const f32x4 v0, const f32x4 v1) { u32x4 w; w.x = pk2(v0[0], v0[1]); w.y = pk2(v0[2], v0[3]); w.z = pk2(v1[0], v1[1]); w.w = pk2(v1[2], v1[3]); return w; }

struct EpiWin {
    static constexpr bool PERM = true, AFTER_DRAIN = false;
    unsigned char* ws; const float* CS64; const float* CS32;
    DI void operator()(const AccT& acc, const Unit& u, int wr, int wc, int fr, int fq) const {
#pragma unroll
        for (int bj = 0; bj < 2; ++bj) {
            const int w0 = bj * 128 + wc * 32;
            size_t off; int ld, dcol, mode = 0, gm = 0, g = 0; float sc = 1.f;
            switch (u.pn) {
                case 0: off = WS_QA; ld = 256; dcol = w0; mode = 1; sc = SCL64; break;
                case 1: off = WS_KA; ld = 256; dcol = w0; mode = 1; break;
                case 2: off = WS_VA; ld = 256; dcol = w0; break;
                case 3: off = WS_QB; ld = 512; dcol = w0; mode = 1; sc = SCL64; break;
                case 4: off = WS_QB; ld = 512; dcol = 256 + w0; mode = 1; sc = SCL64; break;
                case 5: off = (w0 < 128) ? WS_KCMP : WS_VCMP; ld = 64; gm = 1; g = (w0 & 127) >> 6; dcol = w0 & 63; break;
                case 6: off = (w0 < 128) ? WS_KSLC : WS_VSLC; ld = 128; dcol = w0 & 127; mode = (w0 < 128) ? 1 : 0; break;
                case 7: off = (w0 < 128) ? WS_KWIN : WS_VWIN; ld = 128; dcol = w0 & 127; mode = (w0 < 128) ? 1 : 0; break;
                case 8: off = WS_CQ; ld = 256; dcol = w0; break;
                default: if (w0 == 128) { off = WS_KR; ld = 32; dcol = 0; mode = 2; } else { off = WS_MISC; ld = 256; dcol = w0; } break;
            }
            bf16* base = (bf16*)(ws + off);
            const int i0 = 16 * (wc & 1) + 4 * fq;
#pragma unroll
            for (int ai = 0; ai < 2; ++ai) {
                f32x4 cc[4], sn[4];
                if (mode) {
#pragma unroll
                    for (int m = 0; m < 4; ++m) {
                        const int row = u.pm * 256 + ai * 128 + wr * 64 + m * 16 + fr;
                        const float* cs = (mode == 1) ? CS64 + (size_t)row * 64 + i0 : CS32 + (size_t)row * 32 + 4 * fq;
                        cc[m] = *(const f32x4*)cs; sn[m] = *(const f32x4*)(cs + (mode == 1 ? 32 : 16));
                    }
                }
#pragma unroll
                for (int m = 0; m < 4; ++m) {
                    const int row = u.pm * 256 + ai * 128 + wr * 64 + m * 16 + fr;
                    f32x4 v0 = acc[ai][bj][m][0], v1 = acc[ai][bj][m][1];
                    if (mode) rot4(v0, v1, cc[m], sn[m]);
                    v0 = v0 * sc; v1 = v1 * sc;
                    const size_t drow = gm ? (size_t)(((row >> 12) * 2 + g) * SP + (row & 4095)) : (size_t)row;
                    *(u32x4*)(base + drow * ld + dcol + 8 * fq) = pack8(v0, v1);
                }
            }
        }
    }
};
struct EpiCmp {
    static constexpr bool PERM = true, AFTER_DRAIN = true;
    const float* B1P; const bf16* W2T; const float *B2K, *B2V; bf16 *KC, *VC; const float* CS64;
    DI void fused(const AccT& acc, const Unit& u, int wr, int wc, int fr, int fq, LAS unsigned char* lds, int wid, int lane) const {
        constexpr int HST = 528;
        const int kv = u.e, bg = u.pm & 15;
#pragma unroll
        for (int bj = 0; bj < 2; ++bj) {
            const int col = bj * 128 + wc * 32 + 8 * fq;
            const f32x4 b0 = *(const f32x4*)(B1P + kv * 256 + col), b1 = *(const f32x4*)(B1P + kv * 256 + col + 4);
#pragma unroll
            for (int ai = 0; ai < 2; ++ai)
#pragma unroll
                for (int m = 0; m < 4; ++m) {
                    const int rl = ai * 128 + wr * 64 + m * 16 + fr;
                    f32x4 v0 = acc[ai][bj][m][0] + b0, v1 = acc[ai][bj][m][1] + b1;
#pragma unroll
                    for (int j = 0; j < 4; ++j) {
                        float x = v0[j]; float z = 0.7978845608028654f * (x + 0.044715f * x * x * x); v0[j] = x * sigmoidf_(2.f * z);
                        x = v1[j]; z = 0.7978845608028654f * (x + 0.044715f * x * x * x); v1[j] = x * sigmoidf_(2.f * z);
                    }
                    *(LAS u32x4*)(lds + rl * HST + col * 2) = pack8(v0, v1);
                }
        }
        asm volatile("s_waitcnt lgkmcnt(0)\n\ts_barrier" ::: "memory");
        const int r32 = lane & 31, hh = lane >> 5;
        f32x16 out0 = {0.f, 0.f, 0.f, 0.f, 0.f, 0.f, 0.f, 0.f, 0.f, 0.f, 0.f, 0.f, 0.f, 0.f, 0.f, 0.f}, out1 = out0;
        const bf16* w2 = W2T + (size_t)kv * 64 * 256;
#pragma unroll 4
        for (int ks = 0; ks < 16; ++ks) {
            const bf16x8 a = *(const LAS bf16x8*)(lds + (32 * wid + r32) * HST + (16 * ks + 8 * hh) * 2);
            const bf16x8 bq0 = *(const bf16x8*)(w2 + (size_t)r32 * 256 + 16 * ks + 8 * hh), bq1 = *(const bf16x8*)(w2 + (size_t)(32 + r32) * 256 + 16 * ks + 8 * hh);
            out0 = __builtin_amdgcn_mfma_f32_32x32x16_bf16(a, bq0, out0, 0, 0, 0); out1 = __builtin_amdgcn_mfma_f32_32x32x16_bf16(a, bq1, out1, 0, 0, 0);
        }
        const float* b2 = kv ? B2V : B2K;
        const float bb0 = b2[r32], bb1 = b2[32 + r32];
        const int b = bg >> 1;
#pragma unroll
        for (int i = 0; i < 16; ++i) {
            const int c = 32 * wid + 8 * (i >> 2) + 4 * hh + (i & 3);
            const size_t row = (size_t)bg * 256 + c;
            float x1 = out0[i] + bb0, x2 = out1[i] + bb1;
            if (c == 255) { x1 = 0.f; x2 = 0.f; }
            if (kv == 0) {
                const int tokr = (b * S + 16 * c + 31) & (T - 1);
                const float cs = CS64[(size_t)tokr * 64 + r32], sn = CS64[(size_t)tokr * 64 + 32 + r32];
                *(unsigned*)(KC + row * 64 + 2 * r32) = pk2(x1 * cs - x2 * sn, x2 * cs + x1 * sn);
            } else {
                VC[row * 64 + r32] = (bf16)(pk2(x1, 0.f) & 0xffffu); VC[row * 64 + 32 + r32] = (bf16)(pk2(x2, 0.f) & 0xffffu);
            }
        }
    }
};
struct EpiMla {
    static constexpr bool PERM = true, AFTER_DRAIN = false;
    bf16 *QM, *KN, *VM; const bf16 *CQ, *MISC; const float* CS32;
    DI void operator()(const AccT& acc, const Unit& u, int wr, int wc, int fr, int fq) const {
        float rstd[2][4];
#pragma unroll
        for (int ai = 0; ai < 2; ++ai)
#pragma unroll
            for (int m = 0; m < 4; ++m) {
                const int row = u.pm * 256 + ai * 128 + wr * 64 + m * 16 + fr;
                float ss = 0.f;
                if (u.e == 0) {
#pragma unroll
                    for (int c = 0; c < 8; ++c) { const u32x4 w = *(const u32x4*)(CQ + (size_t)row * 256 + fq * 64 + 8 * c);
                        ss += bflo(w.x) * bflo(w.x) + bfhi(w.x) * bfhi(w.x) + bflo(w.y) * bflo(w.y) + bfhi(w.y) * bfhi(w.y) + bflo(w.z) * bflo(w.z) + bfhi(w.z) * bfhi(w.z) + bflo(w.w) * bflo(w.w) + bfhi(w.w) * bfhi(w.w); }
                } else {
#pragma unroll
                    for (int c = 0; c < 4; ++c) { const u32x4 w = *(const u32x4*)(MISC + (size_t)row * 256 + fq * 32 + 8 * c);
                        ss += bflo(w.x) * bflo(w.x) + bfhi(w.x) * bfhi(w.x) + bflo(w.y) * bflo(w.y) + bfhi(w.y) * bfhi(w.y) + bflo(w.z) * bflo(w.z) + bfhi(w.z) * bfhi(w.z) + bflo(w.w) * bflo(w.w) + bfhi(w.w) * bfhi(w.w); }
                }
                ss += __shfl_xor(ss, 16); ss += __shfl_xor(ss, 32);
                rstd[ai][m] = rsqrtf(ss * (u.e == 0 ? (1.0f / 256.0f) : (1.0f / 128.0f)) + EPS);
            }
#pragma unroll
        for (int bj = 0; bj < 2; ++bj) {
            const int gc = u.pn * 256 + bj * 128 + wc * 32;
            bf16* base; int ld, dcol, rope = 0; float sc = 1.f;
            if (u.e == 0) { if (gc >= 384) continue; rope = ((gc >> 5) % 3) == 2; base = QM; ld = 384; dcol = gc; sc = SCL96; }
            else { const int head = gc >> 7, part = (gc & 127) >> 6, o = gc & 63; base = part ? VM : KN; ld = 256; dcol = head * 64 + o; }
#pragma unroll
            for (int ai = 0; ai < 2; ++ai) {
                f32x4 cc[4], sn[4];
                if (rope) {
#pragma unroll
                    for (int m = 0; m < 4; ++m) { const float* cs = CS32 + (size_t)(u.pm * 256 + ai * 128 + wr * 64 + m * 16 + fr) * 32 + 4 * fq; cc[m] = *(const f32x4*)cs; sn[m] = *(const f32x4*)(cs + 16); }
                }
#pragma unroll
                for (int m = 0; m < 4; ++m) {
                    const int row = u.pm * 256 + ai * 128 + wr * 64 + m * 16 + fr;
                    const float r = rstd[ai][m] * sc;
                    f32x4 v0 = acc[ai][bj][m][0] * r, v1 = acc[ai][bj][m][1] * r;
                    if (rope) rot4(v0, v1, cc[m], sn[m]);
                    *(u32x4*)(base + (size_t)row * ld + dcol + 8 * fq) = pack8(v0, v1);
                }
            }
        }
    }
};
struct EpiWout {
    static constexpr bool PERM = false, AFTER_DRAIN = false;
    bf16* X; const float* GT; size_t dofs;
    DI void operator()(const AccT& acc, const Unit& u, int wr, int wc, int fr, int fq) const {
        const int b = (u.pm * 256) >> 12;
        const int col0 = u.pn * 256 + wc * 32 + 4 * fq;
#pragma unroll
        for (int bj = 0; bj < 2; ++bj) {
#pragma unroll
            for (int n = 0; n < 2; ++n) {
                u32x2 xo[2][4];
                const f32x4 gt = *(const f32x4*)(GT + (size_t)b * 6144 + col0 + bj * 128 + n * 16);
#pragma unroll
                for (int ai = 0; ai < 2; ++ai)
#pragma unroll
                    for (int m = 0; m < 4; ++m) xo[ai][m] = *(const u32x2*)(X + (size_t)(u.pm * 256 + ai * 128 + wr * 64 + m * 16 + fr) * 1024 + col0 + bj * 128 + n * 16);
#pragma unroll
                for (int ai = 0; ai < 2; ++ai)
#pragma unroll
                    for (int m = 0; m < 4; ++m) {
                        bf16* p = X + (size_t)(u.pm * 256 + ai * 128 + wr * 64 + m * 16 + fr) * 1024 + col0 + bj * 128 + n * 16;
                        const f32x4 xv = (f32x4){bflo(xo[ai][m].x), bfhi(xo[ai][m].x), bflo(xo[ai][m].y), bfhi(xo[ai][m].y)} + gt * acc[ai][bj][m][n];
                        u32x2 w; w.x = pk2(xv[0], xv[1]); w.y = pk2(xv[2], xv[3]);
                        *(u32x2*)((char*)p + dofs) = w;
                    }
            }
        }
    }
};
struct EpiMoe1 {
    static constexpr bool PERM = true, AFTER_DRAIN = false; static constexpr int A_E8M0 = H8_E8M0;
    bf16* ACT; const float* B1;
    DI void operator()(const AccT& acc, const Unit& u, int wr, int wc, int fr, int fq) const {
#pragma unroll
        for (int bj = 0; bj < 2; ++bj) {
            const int col = u.pn * 256 + bj * 128 + wc * 32 + 8 * fq;
            const f32x4 b0 = *(const f32x4*)(B1 + (size_t)u.e * 2048 + col), b1 = *(const f32x4*)(B1 + (size_t)u.e * 2048 + col + 4);
#pragma unroll
            for (int ai = 0; ai < 2; ++ai)
#pragma unroll
                for (int m = 0; m < 4; ++m) {
                    const int row = u.pm * 256 + ai * 128 + wr * 64 + m * 16 + fr;
                    const f32x4 v0 = acc[ai][bj][m][0] + b0, v1 = acc[ai][bj][m][1] + b1;
                    float o[4];
#pragma unroll
                    for (int j = 0; j < 4; ++j) {
                        const float gl = fminf((j < 2) ? v0[2 * j] : v1[2 * j - 4], 7.0f);
                        const float li = fminf(fmaxf((j < 2) ? v0[2 * j + 1] : v1[2 * j - 3], -7.0f), 7.0f);
                        o[j] = gl * sigmoidf_(1.702f * gl) * (li + 1.0f);
                    }
                    *(unsigned*)((unsigned char*)ACT + (size_t)row * 1024 + (col >> 1)) = pk4_fp8s(o[0], o[1], o[2], o[3], A8_SCALE);
                }
        }
    }
};
struct EpiMoe2 {
    static constexpr bool PERM = true, AFTER_DRAIN = false; static constexpr int A_E8M0 = A8_E8M0;
    unsigned char* Y2; const float* B2; const float* GATEW;
    DI void operator()(const AccT& acc, const Unit& u, int wr, int wc, int fr, int fq) const {
        float gwv[2][4];
#pragma unroll
        for (int ai = 0; ai < 2; ++ai)
#pragma unroll
            for (int m = 0; m < 4; ++m) gwv[ai][m] = GATEW[(size_t)u.e * ECAP + u.ml * 256 + ai * 128 + wr * 64 + m * 16 + fr];
        f32x4 bb[2][2];
#pragma unroll
        for (int bj = 0; bj < 2; ++bj) { const int col = u.pn * 256 + bj * 128 + wc * 32 + 8 * fq; bb[bj][0] = *(const f32x4*)(B2 + (size_t)u.e * 1024 + col); bb[bj][1] = *(const f32x4*)(B2 + (size_t)u.e * 1024 + col + 4); }
#pragma unroll
        for (int ai = 0; ai < 2; ++ai)
#pragma unroll
            for (int m = 0; m < 4; ++m) {
                const int rl = ai * 128 + wr * 64 + m * 16 + fr;
                const float gw = gwv[ai][m];
                const size_t row = (size_t)u.pm * 256 + rl;
#pragma unroll
                for (int bj = 0; bj < 2; ++bj) {
                    const int col = u.pn * 256 + bj * 128 + wc * 32 + 8 * fq;
                    const f32x4 v0 = (acc[ai][bj][m][0] + bb[bj][0]) * gw, v1 = (acc[ai][bj][m][1] + bb[bj][1]) * gw;
                    { u32x2 w8; w8.x = pk4_fp8(v0[0], v0[1], v0[2], v0[3]); w8.y = pk4_fp8(v1[0], v1[1], v1[2], v1[3]); *(u32x2*)(Y2 + row * 1024 + col) = w8; }
                }
            }
    }
};

#define MFMA32(a, b, c) __builtin_amdgcn_mfma_f32_32x32x16_bf16((a), (b), (c), 0, 0, 0)
typedef short v4i16_t __attribute__((ext_vector_type(4)));
DI s16x4 tr_read(const LAS unsigned char* p) { return __builtin_bit_cast(s16x4, __builtin_amdgcn_ds_read_tr16_b64_v4i16((LAS v4i16_t*)p)); }
constexpr int VST = 144;
template <int DQ> struct AC { static constexpr int KST = DQ * 2 + 16, KS = DQ / 16, KBUF = 64 * KST, VBUF = 64 * VST, BUF = KBUF + VBUF; };

template <int DQ>
DI void qk_tile(const LAS unsigned char* kb, const bf16x8 (&qf)[DQ / 16], f32x16 (&s)[2], const f32x16& cinit, int lane) {
    const int r32 = lane & 31, hh = lane >> 5;
    bf16x8 kf[2][DQ / 16];
#pragma unroll
    for (int rt = 0; rt < 2; ++rt)
#pragma unroll
        for (int ks = 0; ks < DQ / 16; ++ks) kf[rt][ks] = *(const LAS bf16x8*)(kb + (32 * rt + r32) * AC<DQ>::KST + (16 * ks + 8 * hh) * 2);
    f32x16 a0 = MFMA32(kf[0][0], qf[0], cinit), a1 = MFMA32(kf[1][0], qf[0], cinit);
#pragma unroll
    for (int ks = 1; ks < DQ / 16; ++ks) { a0 = MFMA32(kf[0][ks], qf[ks], a0); a1 = MFMA32(kf[1][ks], qf[ks], a1); }
    s[0] = a0; s[1] = a1;
}
DI float max3f_(float a, float b, float c) { return __builtin_fmaxf(__builtin_fmaxf(a, b), c); }
constexpr float RESC_THR = 8.0f;
template <int DQ, int KMUL, int VAR = 0>
DI void attn_tile(const LAS unsigned char* kb, const LAS unsigned char* vb, const bf16x8 (&qf)[DQ / 16], f32x16 (&o)[2], f32x16& negm, float& m, float& l,
                  int dq, unsigned maxd, bool lf, int lane, const bool MASKED) {
    const int hh = lane >> 5;
    if (VAR == 1) return;
    f32x16 s[2];
    qk_tile<DQ>(kb, qf, s, negm, lane);
    if (VAR == 2) { o[0] += s[0]; o[1] += s[1]; return; }
    const int i16 = lane & 15, q = i16 >> 2, p_ = i16 & 3, mh = (lane >> 4) & 1;
    const LAS unsigned char* vbase = vb + (4 * hh + q) * VST + 32 * mh + 8 * p_;
    s16x4 vlo[4][2], vhi[4][2];
#pragma unroll
    for (int st = 0; st < 4; ++st)
#pragma unroll
        for (int mt = 0; mt < 2; ++mt) { vlo[st][mt] = tr_read(vbase + (16 * st) * VST + 64 * mt); vhi[st][mt] = tr_read(vbase + (16 * st + 8) * VST + 64 * mt); }
    __builtin_amdgcn_sched_barrier(0);
    if (MASKED) {
#pragma unroll
        for (int rt = 0; rt < 2; ++rt)
#pragma unroll
            for (int i = 0; i < 16; ++i) {
                const int d = dq - (32 * rt + 8 * (i >> 2) + (i & 3)) * KMUL;
                s[rt][i] = ((unsigned)d <= maxd) ? s[rt][i] : -1e30f;
            }
    }
    float mx = max3f_(s[0][0], s[0][1], s[0][2]);
#pragma unroll
    for (int i = 3; i < 15; i += 2) mx = max3f_(mx, s[0][i], s[0][i + 1]);
    mx = max3f_(mx, s[0][15], s[1][0]);
#pragma unroll
    for (int i = 1; i < 15; i += 2) mx = max3f_(mx, s[1][i], s[1][i + 1]);
    mx = fmaxf(mx, s[1][15]);
    if (__ballot(lf && mx > RESC_THR) != 0ull) {
        float mc = lf ? mx : -1e30f;
        mc = fmaxf(mc, __shfl_xor(mc, 32));
        const float delta = mc > RESC_THR ? mc : 0.f;
        const float alpha = fast_exp2(-delta);
        m += delta; l *= alpha;
#pragma unroll
        for (int i = 0; i < 16; ++i) { negm[i] = -m; o[0][i] *= alpha; o[1][i] *= alpha; s[0][i] -= delta; s[1][i] -= delta; }
    }
    float ps = 0.f;
#pragma unroll
    for (int rt = 0; rt < 2; ++rt)
#pragma unroll
        for (int i = 0; i < 16; ++i) { const float p = fast_exp2(s[rt][i]); s[rt][i] = p; ps += p; }
    const unsigned lmask = lf ? 0xffffffffu : 0u;
    l += lf ? ps : 0.f;
    if (VAR == 3) { o[0] += s[0]; o[1] += s[1]; return; }
#pragma unroll
    for (int rt = 0; rt < 2; ++rt)
#pragma unroll
        for (int s2 = 0; s2 < 2; ++s2) {
            u32x4 pw; pw.x = pk2(s[rt][8 * s2 + 0], s[rt][8 * s2 + 1]) & lmask; pw.y = pk2(s[rt][8 * s2 + 2], s[rt][8 * s2 + 3]) & lmask;
            pw.z = pk2(s[rt][8 * s2 + 4], s[rt][8 * s2 + 5]) & lmask; pw.w = pk2(s[rt][8 * s2 + 6], s[rt][8 * s2 + 7]) & lmask;
            const bf16x8 pb = __builtin_bit_cast(bf16x8, pw);
#pragma unroll
            for (int mt = 0; mt < 2; ++mt) {
                const bf16x8 va = __builtin_shufflevector(vlo[2 * rt + s2][mt], vhi[2 * rt + s2][mt], 0, 1, 2, 3, 4, 5, 6, 7);
                o[mt] = MFMA32(va, pb, o[mt]);
            }
        }
}
constexpr int OSTAGE_WAVE = 32 * 144;
static_assert(102400 + 8 * OSTAGE_WAVE <= MISC_OFF, "O stage below the LDS control words");
struct ChunkId { DI u32x4 operator()(u32x4 v, int, int, int) const { return v; } };
template <class P, class Fx = ChunkId>
DI void store_o_rows(const P& p, LAS unsigned char* lds, int off, const f32x16 (&o)[2], float inv, int lane, int wave, const Fx& fx = Fx()) {
    LAS unsigned char* st = lds + off + wave * OSTAGE_WAVE;
    const int n = lane & 31, hh = lane >> 5;
#pragma unroll
    for (int mt = 0; mt < 2; ++mt)
#pragma unroll
        for (int a = 0; a < 4; ++a) {
            u32x2 w; w.x = pk2(o[mt][4 * a] * inv, o[mt][4 * a + 1] * inv); w.y = pk2(o[mt][4 * a + 2] * inv, o[mt][4 * a + 3] * inv);
            *(LAS u32x2*)(st + n * 144 + (32 * mt + 8 * a + 4 * hh) * 2) = w;
        }
    asm volatile("s_waitcnt lgkmcnt(0)" ::: "memory");
#pragma unroll
    for (int it = 0; it < 4; ++it) {
        const int r = (lane >> 3) + 8 * it, c = lane & 7;
        const u32x4 v = fx(*(const LAS u32x4*)(st + r * 144 + c * 16), wave, r, c);
        *(u32x4*)(p.orow(wave, r) + 8 * c) = v;
    }
}
DI void store_o(bf16* orow, const f32x16 (&o)[2], float inv, int lane) {
    const int hh = lane >> 5;
#pragma unroll
    for (int mt = 0; mt < 2; ++mt)
#pragma unroll
        for (int a = 0; a < 4; ++a) {
            u32x2 w; w.x = pk2(o[mt][4 * a] * inv, o[mt][4 * a + 1] * inv); w.y = pk2(o[mt][4 * a + 2] * inv, o[mt][4 * a + 3] * inv);
            *(u32x2*)(orow + 32 * mt + 8 * a + 4 * hh) = w;
        }
}

struct PolA {
    static constexpr bool HASFLAG = false, LSE = true; static constexpr int KMUL = 1;
    const bf16 *Q, *K, *V; bf16* O; float* LSEP; int b, h, d, r, c; unsigned maxd; int j0, j1;
    DI int ql(int w, int lane) const { return 256 * c + 32 * w + (lane & 31); }
    DI size_t trow(int l_) const { return (size_t)b * S + (size_t)l_ * d + r; }
    DI const bf16* qrow(int w, int lane) const { return Q + trow(ql(w, lane)) * 256 + h * 64; }
    DI int qv(int w, int lane) const { return ql(w, lane); }
    DI int qmin(int w) const { return 256 * c + 32 * w; }
    DI int qmax(int w) const { return 256 * c + 32 * w + 31; }
    DI int kv0(int j) const { return 256 * c - 128 + 64 * j; }
    DI const bf16* krow(int j, int row) const { return K + trow(kv0(j) + row) * 256 + h * 64; }
    DI const bf16* vrow(int j, int row) const { return V + trow(kv0(j) + row) * 256 + h * 64; }
    DI const bf16* rrow(int, int) const { return nullptr; }
    DI bool flag(int, int, int) const { return true; }
    DI bf16* orow(int w, int lane) const { return O + trow(ql(w, lane)) * 256 + h * 64; }
    DI void lse(int w, int lane, float v) const { LSEP[trow(ql(w, lane)) * 4 + h] = v; }
};
struct PolB {
    static constexpr bool LSE = false; static constexpr int KMUL = 1;
    const bf16 *Q, *K, *V; bf16* O; int b, g, qc; unsigned maxd; int j0, j1; u64 sel; bool hasflag;
    const bf16 *GC = nullptr, *GW = nullptr, *GM = nullptr;
    DI int tok(int w, int lane) const { return 64 * qc + 8 * w + ((lane & 31) >> 2); }
    DI const bf16* qrow(int w, int lane) const { return Q + ((size_t)b * S + tok(w, lane)) * 512 + (4 * g + (lane & 3)) * 64; }
    DI int qv(int w, int lane) const { return tok(w, lane); }
    DI int qmin(int w) const { return 64 * qc + 8 * w; }
    DI int qmax(int w) const { return 64 * qc + 8 * w + 7; }
    DI int kv0(int j) const { return 64 * j; }
    DI const bf16* krow(int j, int row) const { return K + ((size_t)b * S + 64 * j + row) * 128 + g * 64; }
    DI const bf16* vrow(int j, int row) const { return V + ((size_t)b * S + 64 * j + row) * 128 + g * 64; }
    DI const bf16* rrow(int, int) const { return nullptr; }
    DI bf16* orow(int w, int lane) const { return O + ((size_t)b * S + tok(w, lane)) * 512 + (4 * g + (lane & 3)) * 64; }
    DI void lse(int, int, float) const {}
};
struct PolM {
    static constexpr bool HASFLAG = false, LSE = false; static constexpr int KMUL = 1;
    const bf16 *Q, *KN, *KR, *V; bf16* O; int b, h, c; unsigned maxd; int j0, j1;
    DI int tok(int w, int lane) const { return 256 * c + 32 * w + (lane & 31); }
    DI const bf16* qrow(int w, int lane) const { return Q + ((size_t)b * S + tok(w, lane)) * 384 + h * 96; }
    DI int qv(int w, int lane) const { return tok(w, lane); }
    DI int qmin(int w) const { return 256 * c + 32 * w; }
    DI int qmax(int w) const { return 256 * c + 32 * w + 31; }
    DI int kv0(int j) const { return 64 * j; }
    DI const bf16* krow(int j, int row) const { return KN + ((size_t)b * S + 64 * j + row) * 256 + h * 64; }
    DI const bf16* vrow(int j, int row) const { return V + ((size_t)b * S + 64 * j + row) * 256 + h * 64; }
    DI const bf16* rrow(int j, int row) const { return KR + ((size_t)b * S + 64 * j + row) * 32; }
    DI bf16* orow(int w, int lane) const { return O + ((size_t)b * S + tok(w, lane)) * 256 + h * 64; }
    DI void lse(int, int, float) const {}
};

template <int DQ, class P, bool FLAG, int VAR = 0>
DI void attn_unit(const P& p, LAS unsigned char* lds, int tid, int lane, int wave, u64 sel) {
    typedef AC<DQ> C;
    const int hh = lane >> 5;
    const bf16* qrow = p.qrow(wave, lane);
    bf16x8 qf[DQ / 16];
#pragma unroll
    for (int ks = 0; ks < DQ / 16; ++ks) qf[ks] = *(const bf16x8*)(qrow + 16 * ks + 8 * hh);
#pragma unroll
    for (int ks = 0; ks < DQ / 16; ++ks) asm volatile("s_waitcnt vmcnt(0)" : "+v"(qf[ks]) :: "memory");
    const int qv = p.qv(wave, lane), wq0 = p.qmin(wave), wq1 = p.qmax(wave);
    f32x16 o[2];
#pragma unroll
    for (int mt = 0; mt < 2; ++mt)
#pragma unroll
        for (int i = 0; i < 16; ++i) o[mt][i] = 0.f;
    float m = 0.f, l = 0.f;
    f32x16 negm;
#pragma unroll
    for (int i = 0; i < 16; ++i) negm[i] = 0.f;
    const int j0 = p.j0, j1 = p.j1;
    const int lrow = tid >> 3, lch = tid & 7;
    u32x4 k0A, v0A, r0A = {0u, 0u, 0u, 0u}, k1A, v1A, r1A = {0u, 0u, 0u, 0u}, k0B, v0B, r0B = {0u, 0u, 0u, 0u}, k1B, v1B, r1B = {0u, 0u, 0u, 0u};
    constexpr int NLD = (DQ == 96) ? 6 : 4;
    const int npair = (j1 - j0 + 1) >> 1;
#define ATT_LOAD1(RK, RV, RR, j) do { const bf16* pk_ = p.krow((j), lrow) + 8 * lch; const bf16* pv_ = p.vrow((j), lrow) + 8 * lch; \
        asm volatile("global_load_dwordx4 %0, %2, off\n\tglobal_load_dwordx4 %1, %3, off" : "=&v"(RK), "=&v"(RV) : "v"(pk_), "v"(pv_) : "memory"); \
        if (DQ == 96) { const bf16* pr_ = p.rrow((j), (tid & 255) >> 2) + 8 * (tid & 3); asm volatile("global_load_dwordx4 %0, %1, off" : "=&v"(RR) : "v"(pr_) : "memory"); } } while (0)
#define ATT_LOADP(K0, V0, R0, K1, V1, R1, t) do { const int ja_ = j0 + 2 * (t), jb_ = ja_ + 1; \
        { const int jc_ = ja_ < j1 ? ja_ : j1 - 1; ATT_LOAD1(K0, V0, R0, jc_); } { const int jd_ = jb_ < j1 ? jb_ : j1 - 1; ATT_LOAD1(K1, V1, R1, jd_); } } while (0)
#define ATT_TILE(kb_, jt_) do { const int j_ = (jt_); const int kv0 = p.kv0(j_); \
        bool need = (j_ < j1) && (wq1 - kv0 >= 0) && ((long long)wq0 - (long long)(kv0 + 63 * P::KMUL) <= (long long)p.maxd); \
        const bool interior = (wq0 - (kv0 + 63 * P::KMUL) >= 0) && ((long long)wq1 - (long long)kv0 <= (long long)p.maxd); \
        bool lf = true; \
        if (FLAG) { lf = ((sel >> j_) & 1ull) != 0ull; need = need && (__ballot(lf) != 0ull); } \
        if (need) attn_tile<DQ, P::KMUL, VAR>((kb_), (kb_) + C::KBUF, qf, o, negm, m, l, qv - kv0 - 4 * hh * P::KMUL, p.maxd, lf, lane, !interior); } while (0)
#define ATT_STEP(K0, V0, R0, K1, V1, R1, tt) do { const int t_ = (tt); \
        LAS unsigned char* pbuf = lds + (t_ & 1) * (2 * C::BUF); \
        asm volatile("s_waitcnt vmcnt(%6)" : "+v"(K0), "+v"(V0), "+v"(R0), "+v"(K1), "+v"(V1), "+v"(R1) : "n"(NLD) : "memory"); \
        *(LAS u32x4*)(pbuf + lrow * C::KST + lch * 16) = K0; *(LAS u32x4*)(pbuf + C::KBUF + lrow * VST + lch * 16) = V0; \
        *(LAS u32x4*)(pbuf + C::BUF + lrow * C::KST + lch * 16) = K1; *(LAS u32x4*)(pbuf + C::BUF + C::KBUF + lrow * VST + lch * 16) = V1; \
        if (DQ == 96) { *(LAS u32x4*)(pbuf + ((tid & 255) >> 2) * C::KST + 128 + (tid & 3) * 16) = R0; *(LAS u32x4*)(pbuf + C::BUF + ((tid & 255) >> 2) * C::KST + 128 + (tid & 3) * 16) = R1; } \
        asm volatile("s_waitcnt lgkmcnt(0)\n\ts_barrier" ::: "memory"); \
        ATT_LOADP(K0, V0, R0, K1, V1, R1, t_ + 2); \
        if (ATT_STAGGER > 0 && wave >= 4) __builtin_amdgcn_s_sleep(ATT_STAGGER); \
        ATT_TILE(pbuf, j0 + 2 * t_); ATT_TILE(pbuf + C::BUF, j0 + 2 * t_ + 1); } while (0)
    ATT_LOADP(k0A, v0A, r0A, k1A, v1A, r1A, 0);
    ATT_LOADP(k0B, v0B, r0B, k1B, v1B, r1B, 1);
    if (wave >= 4) __builtin_amdgcn_s_setprio(1);
#pragma unroll 1
    for (int t = 0; t < npair; t += 2) {
        ATT_STEP(k0A, v0A, r0A, k1A, v1A, r1A, t);
        ATT_STEP(k0B, v0B, r0B, k1B, v1B, r1B, t + 1);
    }
    __builtin_amdgcn_s_setprio(0);
    asm volatile("s_waitcnt vmcnt(0)" : "+v"(k0A), "+v"(v0A), "+v"(r0A), "+v"(k1A), "+v"(v1A), "+v"(r1A), "+v"(k0B), "+v"(v0B), "+v"(r0B), "+v"(k1B), "+v"(v1B), "+v"(r1B) :: "memory");
#undef ATT_LOAD1
#undef ATT_LOADP
#undef ATT_TILE
#undef ATT_STEP
    const float lt = l + __shfl_xor(l, 32);
    const float inv = lt > 0.f ? 1.0f / lt : 0.f;
    if constexpr (FLAG) {
        struct Gate { const P& p;
            DI u32x4 operator()(u32x4 v, int w_, int r, int c) const {
                const size_t tg = (size_t)p.b * S + 64 * p.qc + 8 * w_ + (r >> 2); const int hd = 4 * p.g + (r & 3);
                const bf16* gl = p.GM + tg * 256 + 160 + hd * 3;
                const float g0 = sigmoidf_(bf2f(gl[0])), g1 = sigmoidf_(bf2f(gl[1])), g2 = sigmoidf_(bf2f(gl[2]));
                const u32x4 a = *(const u32x4*)(p.GC + tg * 512 + hd * 64 + 8 * c), d = *(const u32x4*)(p.GW + tg * 512 + hd * 64 + 8 * c);
                u32x4 r_;
                r_.x = pk2(g0 * bflo(a.x) + g1 * bflo(v.x) + g2 * bflo(d.x), g0 * bfhi(a.x) + g1 * bfhi(v.x) + g2 * bfhi(d.x));
                r_.y = pk2(g0 * bflo(a.y) + g1 * bflo(v.y) + g2 * bflo(d.y), g0 * bfhi(a.y) + g1 * bfhi(v.y) + g2 * bfhi(d.y));
                r_.z = pk2(g0 * bflo(a.z) + g1 * bflo(v.z) + g2 * bflo(d.z), g0 * bfhi(a.z) + g1 * bfhi(v.z) + g2 * bfhi(d.z));
                r_.w = pk2(g0 * bflo(a.w) + g1 * bflo(v.w) + g2 * bflo(d.w), g0 * bfhi(a.w) + g1 * bfhi(v.w) + g2 * bfhi(d.w));
                return r_; } } gate{p};
        store_o_rows(p, lds, 90112, o, inv, lane, wave, gate);
    } else store_o_rows(p, lds, DQ == 96 ? 102400 : 90112, o, inv, lane, wave);
    if (P::LSE) { if (hh == 0) p.lse(wave, lane, m + __log2f(lt)); }
    __syncthreads();
}

DI u64 cmp_unit(const Ctx& F, int b, int g, int qc) {
    constexpr int KST = 144;
    LAS unsigned char* KL = F.lds; LAS unsigned char* VL = F.lds + 256 * KST; LAS float* IMP = (LAS float*)(F.lds + 2 * 256 * KST);
    const bf16* KC = (const bf16*)(F.ws + WS_KC) + (size_t)(b * 2 + g) * 256 * 64;
    const bf16* VC = (const bf16*)(F.ws + WS_VC) + (size_t)(b * 2 + g) * 256 * 64;
    const int tid = F.tid, lane = F.lane, w = F.wave, hh = lane >> 5, r32 = lane & 31;
#pragma unroll
    for (int it = 0; it < 4; ++it) { const int idx = tid + 512 * it, row = idx >> 3, ch = idx & 7;
        *(LAS u32x4*)(KL + row * KST + ch * 16) = *(const u32x4*)(KC + row * 64 + ch * 8);
        *(LAS u32x4*)(VL + row * VST + ch * 16) = *(const u32x4*)(VC + row * 64 + ch * 8); }
    __syncthreads();
    const int tokl = 8 * w + (r32 >> 2), tok = 64 * qc + tokl, head = 4 * g + (lane & 3);
    const bf16* qrow = (const bf16*)(F.ws + WS_QB) + ((size_t)b * S + tok) * 512 + head * 64;
    bf16x8 qf[4];
#pragma unroll
    for (int ks = 0; ks < 4; ++ks) qf[ks] = *(const bf16x8*)(qrow + 16 * ks + 8 * hh);
    const int qv = tok - 31, wq1 = 64 * qc + 8 * w + 7 - 31;
    f32x16 o[2];
#pragma unroll
    for (int mt = 0; mt < 2; ++mt)
#pragma unroll
        for (int i = 0; i < 16; ++i) o[mt][i] = 0.f;
    float m = 0.f, l = 0.f;
    f32x16 negm;
#pragma unroll
    for (int i = 0; i < 16; ++i) negm[i] = 0.f;
    const int wq0 = 64 * qc + 8 * w - 31;
#pragma unroll 1
    for (int jt = 0; jt < 4; ++jt) {
        if (wq1 - 1024 * jt >= 0) {
            const int dq = qv - 1024 * jt - 4 * hh * 16;
            attn_tile<64, 16>(KL + jt * 64 * KST, VL + jt * 64 * VST, qf, o, negm, m, l, dq, 0x7fffffffu, true, lane, !(wq0 - (1024 * jt + 63 * 16) >= 0));
        }
    }
    const float lt = l + __shfl_xor(l, 32);
    const float inv = lt > 0.f ? 1.0f / lt : 0.f;
    { struct { bf16* O; int b, g, qc; DI bf16* orow(int w_, int n_) const { return O + ((size_t)b * S + 64 * qc + 8 * w_ + (n_ >> 2)) * 512 + (4 * g + (n_ & 3)) * 64; } } pc{(bf16*)(F.ws + WS_OCMP), b, g, qc};
      store_o_rows(pc, F.lds, 90112, o, inv, lane, w); }
    float prev = 0.f;
#pragma unroll 1
    for (int jt = 0; jt < 4; ++jt) {
        const bool need = (wq1 - 1024 * jt >= 0);
        f32x16 s[2];
        if (need) qk_tile<64>(KL + jt * 64 * KST, qf, s, negm, lane);
#pragma unroll
        for (int rt = 0; rt < 2; ++rt)
#pragma unroll
            for (int a = 0; a < 4; ++a) {
                float mainp = 0.f, sp = 0.f;
                if (need) {
                    float pb[4];
#pragma unroll
                    for (int bb = 0; bb < 4; ++bb) { const int kidx = 64 * jt + 32 * rt + 8 * a + 4 * hh + bb; const bool ok = (qv - 16 * kidx) >= 0; pb[bb] = ok ? fast_exp2(s[rt][4 * a + bb]) * inv : 0.f; }
                    mainp = pb[0] + pb[1] + pb[2] + 0.5f * pb[3]; sp = 0.5f * pb[3];
                }
                const float rc = __shfl_xor(sp, 32);
                float v = mainp + (hh ? rc : prev);
                prev = rc;
                v += __shfl_xor(v, 1); v += __shfl_xor(v, 2);
                if ((lane & 3) == 0) IMP[tokl * 64 + 2 * (8 * jt + 4 * rt + a) + hh] = v;
            }
    }
    __syncthreads();
    u64 mysel = 0ull;
#pragma unroll 1
    for (int tk = 0; tk < 8; ++tk) {
        const int tl = 8 * w + tk, t = 64 * qc + tl, j = lane;
        const float v = IMP[tl * 64 + j];
        const bool forced = (j == 0) || (j == qc) || (j == qc - 1);
        const bool valid = j <= qc;
        const float score = forced ? v + 1e4f : (valid ? v : -1.0f);
        int rank = 0;
#pragma unroll
        for (int jp = 0; jp < 64; ++jp) { const float o_ = __builtin_bit_cast(float, __builtin_amdgcn_readlane(__builtin_bit_cast(int, score), jp)); rank += ((o_ > score) || (o_ == score && jp < j)) ? 1 : 0; }
        const u64 mask = __ballot(rank < 16);
        (void)t;
        if (tk == (r32 >> 2)) mysel = mask;
    }
    __syncthreads();
    return mysel;
}

DI void moe_tables(const Ctx& F, int l) {
    LAS int* tb = (LAS int*)(F.lds + AUX_OFF); LAS int* cn = tb + 64;
    if (F.tid == 0) {
        const unsigned* C = (const unsigned*)(F.ws + WS_CTL) + CW_CNT + l * 32 * 64;
        int acc = 0;
        for (int e = 0; e < 32; ++e) { const int c = (int)__hip_atomic_load(C + e * 64, RLX_AGENT); tb[e] = acc; cn[e] = c; acc += (c + 255) >> 8; }
        tb[32] = acc;
    }
    __syncthreads();
}
template <int MODE>
DI void phase_norm1(const Ctx& F, int l) {
    const float* mods = (const float*)(F.ws + WS_MODS);
    const bf16* X = (const bf16*)(F.ws + WS_X); bf16* H = (bf16*)(F.ws + F.dofs + WS_H); bf16* XW = (bf16*)(F.ws + F.dofs + WS_X);
    const LAS int* tb = (const LAS int*)(F.lds + AUX_OFF);
    if (l > 0) moe_tables(F, l - 1);
    const int gw = F.blk * 8 + F.wave, NGW = F.G * 8, lane = F.lane;
    for (int tok = gw; tok < T; tok += NGW) {
        const int b = tok >> 12;
        f32x4 v[4];
        if (l == 0) { const float* xr = ginp(F, I_X) + (size_t)tok * 1024;
#pragma unroll
            for (int k = 0; k < 4; ++k) v[k] = *(const f32x4*)(xr + 4 * lane + 256 * k);
        } else { const bf16* xr = X + (size_t)tok * 1024;
#pragma unroll
            for (int k = 0; k < 4; ++k) { const u32x2 w = *(const u32x2*)(xr + 4 * lane + 256 * k); v[k] = (f32x4){bflo(w.x), bfhi(w.x), bflo(w.y), bfhi(w.y)}; }
        }
        if (l > 0) {
            f32x4 y[4];
#pragma unroll
            for (int k = 0; k < 4; ++k) y[k] = (f32x4){0.f, 0.f, 0.f, 0.f};
            const int* ts = (const int*)(F.ws + WS_TOKSLOT) + (size_t)tok * 4;
#pragma unroll
            for (int s = 0; s < 4; ++s) {
                const int pk = ts[s]; const int e = pk >> 16, pos = pk & 0xffff;
                const unsigned char* yr = (const unsigned char*)(F.ws + WS_Y2) + ((size_t)tb[e] * 256 + pos) * 1024;
#pragma unroll
                for (int k = 0; k < 4; ++k) { const unsigned w = *(const unsigned*)(yr + 4 * lane + 256 * k); y[k] += unpk4_fp8(w); }
            }
            const float* gt2 = mods + ((size_t)((l - 1) * 8 + b) * 6 + 5) * 1024;
#pragma unroll
            for (int k = 0; k < 4; ++k) v[k] = v[k] + *(const f32x4*)(gt2 + 4 * lane + 256 * k) * (y[k] * Y2_ISCALE);
        }
        float ss = 0.f;
#pragma unroll
        for (int k = 0; k < 4; ++k) ss += v[k][0] * v[k][0] + v[k][1] * v[k][1] + v[k][2] * v[k][2] + v[k][3] * v[k][3];
        const float rstd = rsqrtf(wave_sum(ss) * (1.0f / 1024.0f) + EPS);
        if (MODE == 0) {
            const float* g1 = ginp(F, I_G1) + (size_t)l * 1024;
            const float* sh = mods + ((size_t)(l * 8 + b) * 6 + 0) * 1024; const float* sc = sh + 1024;
#pragma unroll
            for (int k = 0; k < 4; ++k) {
                const int c = 4 * lane + 256 * k;
                { u32x2 xw; xw.x = pk2(v[k][0], v[k][1]); xw.y = pk2(v[k][2], v[k][3]); *(u32x2*)(XW + (size_t)tok * 1024 + c) = xw; }
                const f32x4 hv = v[k] * rstd * *(const f32x4*)(g1 + c) * (*(const f32x4*)(sc + c) + 1.0f) + *(const f32x4*)(sh + c);
                u32x2 w; w.x = pk2(hv[0], hv[1]); w.y = pk2(hv[2], hv[3]);
                *(u32x2*)(H + (size_t)tok * 1024 + c) = w;
            }
        } else {
            const float* gf = ginp(F, I_GF);
#pragma unroll
            for (int k = 0; k < 4; ++k) { const int c = 4 * lane + 256 * k; *(f32x4*)(gout(F) + (size_t)tok * 1024 + c) = v[k] * rstd * *(const f32x4*)(gf + c); }
        }
    }
}
DI void phase_prep(const Ctx& F) {
    const bf16* CQ = (const bf16*)(F.ws + WS_CQ); const bf16* MISC = (const bf16*)(F.ws + WS_MISC);
    float* RQ = (float*)(F.ws + WS_RSTDQ); float* RKV = (float*)(F.ws + WS_RSTDKV);
    bf16* KR = (bf16*)(F.ws + WS_KR); float* GATES = (float*)(F.ws + WS_GATES); const float* CS32 = (const float*)(F.ws + WS_CS32);
    const int gw = F.blk * 8 + F.wave, NGW = F.G * 8, lane = F.lane;
    for (int tok = gw; tok < T; tok += NGW) {
        const u32x2 wq = *(const u32x2*)(CQ + (size_t)tok * 256 + 4 * lane);
        const u32x2 wm = *(const u32x2*)(MISC + (size_t)tok * 256 + 4 * lane);
        float a0 = bflo(wq.x), a1 = bfhi(wq.x), a2 = bflo(wq.y), a3 = bfhi(wq.y);
        const float sq = wave_sum(a0 * a0 + a1 * a1 + a2 * a2 + a3 * a3);
        float m0 = bflo(wm.x), m1 = bfhi(wm.x), m2 = bflo(wm.y), m3 = bfhi(wm.y);
        const float skv = wave_sum(lane < 32 ? (m0 * m0 + m1 * m1 + m2 * m2 + m3 * m3) : 0.f);
        if (lane == 0) { RQ[tok] = rsqrtf(sq * (1.0f / 256.0f) + EPS); RKV[tok] = rsqrtf(skv * (1.0f / 128.0f) + EPS); }
        const float p0 = __shfl_xor(m0, 4), p1 = __shfl_xor(m1, 4), p2 = __shfl_xor(m2, 4), p3 = __shfl_xor(m3, 4);
        if (lane >= 32 && lane < 36) {
            const int i0 = 4 * (lane - 32);
            const f32x4 c4 = *(const f32x4*)(CS32 + (size_t)tok * 32 + i0), s4 = *(const f32x4*)(CS32 + (size_t)tok * 32 + 16 + i0);
            u32x4 w;
            w.x = pk2(m0 * c4[0] - p0 * s4[0], p0 * c4[0] + m0 * s4[0]); w.y = pk2(m1 * c4[1] - p1 * s4[1], p1 * c4[1] + m1 * s4[1]);
            w.z = pk2(m2 * c4[2] - p2 * s4[2], p2 * c4[2] + m2 * s4[2]); w.w = pk2(m3 * c4[3] - p3 * s4[3], p3 * c4[3] + m3 * s4[3]);
            *(u32x4*)(KR + (size_t)tok * 32 + 2 * i0) = w;
        }
        if (lane >= 40 && lane < 46) {
            const int gi = 4 * (lane - 40);
            *(f32x4*)(GATES + (size_t)tok * 24 + gi) = (f32x4){sigmoidf_(m0), sigmoidf_(m1), sigmoidf_(m2), sigmoidf_(m3)};
        }
    }
}
DI void phase_cmp2(const Ctx& F, int l) {
    const bf16* HID = (const bf16*)(F.ws + WS_HID);
    const float* CS64 = (const float*)(F.ws + WS_CS64);
    const int gw = F.blk * 8 + F.wave, NGW = F.G * 8, lane = F.lane;
    for (int it = gw; it < 8192; it += NGW) {
        const int kv = it >> 12, row = it & 4095, c = row & 255, bg = row >> 8;
        const float* w2 = ginp(F, kv ? I_W2V : I_W2K) + (size_t)l * 256 * 64;
        const float* b2 = ginp(F, kv ? I_B2V : I_B2K) + (size_t)l * 64;
        const u32x2 hw = *(const u32x2*)(HID + ((size_t)kv * 4096 + row) * 256 + 4 * lane);
        const float h0 = bflo(hw.x), h1 = bfhi(hw.x), h2 = bflo(hw.y), h3 = bfhi(hw.y);
        float acc = b2[lane];
#pragma unroll 4
        for (int k4 = 0; k4 < 64; ++k4) {
            const float x0 = __builtin_bit_cast(float, __builtin_amdgcn_readlane(__builtin_bit_cast(int, h0), k4));
            const float x1 = __builtin_bit_cast(float, __builtin_amdgcn_readlane(__builtin_bit_cast(int, h1), k4));
            const float x2 = __builtin_bit_cast(float, __builtin_amdgcn_readlane(__builtin_bit_cast(int, h2), k4));
            const float x3 = __builtin_bit_cast(float, __builtin_amdgcn_readlane(__builtin_bit_cast(int, h3), k4));
            acc += x0 * w2[(4 * k4 + 0) * 64 + lane] + x1 * w2[(4 * k4 + 1) * 64 + lane] + x2 * w2[(4 * k4 + 2) * 64 + lane] + x3 * w2[(4 * k4 + 3) * 64 + lane];
        }
        if (c == 255) acc = 0.f;
        if (kv == 0) {
            const int b = bg >> 1, tokr = b * S + 16 * c + 31;
            const float other = __shfl_xor(acc, 32);
            const int i = lane & 31;
            const float cs = CS64[(size_t)(tokr & (T - 1)) * 64 + i], sn = CS64[(size_t)(tokr & (T - 1)) * 64 + 32 + i];
            const float y = (lane < 32) ? (acc * cs - other * sn) : (acc * cs + other * sn);
            ((bf16*)(F.ws + WS_KC))[(size_t)row * 64 + 2 * i + (lane >> 5)] = (bf16)(pk2(y, 0.f) & 0xffffu);
        } else {
            ((bf16*)(F.ws + WS_VC))[(size_t)row * 64 + lane] = (bf16)(pk2(acc, 0.f) & 0xffffu);
        }
    }
}
DI void phase_mix(const Ctx& F, int l) {
    const bf16* OA3 = (const bf16*)(F.ws + WS_OA3); const float* LSEA = (const float*)(F.ws + WS_LSEA);
    const bf16* OCMP = (const bf16*)(F.ws + WS_OCMP); const bf16* OSLC = (const bf16*)(F.ws + WS_OSLC); const bf16* OWIN = (const bf16*)(F.ws + WS_OWIN);
    const bf16* OC = (const bf16*)(F.ws + WS_OC); const bf16* MISC = (const bf16*)(F.ws + WS_MISC);
    bf16* AMIX = (bf16*)(F.ws + WS_AMIX);
    const float* ga = ginp(F, I_GOA) + (size_t)l * 256; const float* gb = ginp(F, I_GOB) + (size_t)l * 512; const float* gc = ginp(F, I_GOC) + (size_t)l * 256;
    const int gw = F.blk * 8 + F.wave, NGW = F.G * 8, lane = F.lane, ha = lane >> 4;
    for (int tok0 = gw; tok0 < T; tok0 += 2 * NGW) {
        int tok[2]; tok[0] = tok0; tok[1] = (tok0 + NGW < T) ? tok0 + NGW : tok0;
        float ls[2][3]; u32x2 wa[2][3], wb[2][2], wc_[2];
#pragma unroll
        for (int q = 0; q < 2; ++q) {
#pragma unroll
            for (int p = 0; p < 3; ++p) { ls[q][p] = LSEA[((size_t)p * T + tok[q]) * 4 + ha]; wa[q][p] = *(const u32x2*)(OA3 + ((size_t)p * T + tok[q]) * 256 + 4 * lane); }
#pragma unroll
            for (int k = 0; k < 2; ++k) {
                const int col = 256 * k + 4 * lane;
                wb[q][k] = *(const u32x2*)(OSLC + (size_t)tok[q] * 512 + col);
            }
            wc_[q] = *(const u32x2*)(OC + (size_t)tok[q] * 256 + 4 * lane);
        }
        f32x4 va[2], vb[2][2], vc[2]; float red[2][3];
#pragma unroll
        for (int q = 0; q < 2; ++q) {
            const float mx = fmaxf(ls[q][0], fmaxf(ls[q][1], ls[q][2]));
            const float w0 = fast_exp2(ls[q][0] - mx), w1 = fast_exp2(ls[q][1] - mx), w2 = fast_exp2(ls[q][2] - mx), wi = 1.0f / (w0 + w1 + w2);
            va[q] = ((f32x4){bflo(wa[q][0].x), bfhi(wa[q][0].x), bflo(wa[q][0].y), bfhi(wa[q][0].y)} * w0 + (f32x4){bflo(wa[q][1].x), bfhi(wa[q][1].x), bflo(wa[q][1].y), bfhi(wa[q][1].y)} * w1
                   + (f32x4){bflo(wa[q][2].x), bfhi(wa[q][2].x), bflo(wa[q][2].y), bfhi(wa[q][2].y)} * w2) * wi;
            red[q][0] = va[q][0] * va[q][0] + va[q][1] * va[q][1] + va[q][2] * va[q][2] + va[q][3] * va[q][3];
            float sb = 0.f;
#pragma unroll
            for (int k = 0; k < 2; ++k) {
                const u32x2 a = wb[q][k];
                vb[q][k][0] = bflo(a.x); vb[q][k][1] = bfhi(a.x); vb[q][k][2] = bflo(a.y); vb[q][k][3] = bfhi(a.y);
                sb += vb[q][k][0] * vb[q][k][0] + vb[q][k][1] * vb[q][k][1] + vb[q][k][2] * vb[q][k][2] + vb[q][k][3] * vb[q][k][3];
            }
            red[q][1] = sb;
            vc[q] = (f32x4){bflo(wc_[q].x), bfhi(wc_[q].x), bflo(wc_[q].y), bfhi(wc_[q].y)};
            red[q][2] = vc[q][0] * vc[q][0] + vc[q][1] * vc[q][1] + vc[q][2] * vc[q][2] + vc[q][3] * vc[q][3];
        }
#pragma unroll
        for (int o = 1; o < 64; o <<= 1) {
#pragma unroll
            for (int q = 0; q < 2; ++q)
#pragma unroll
                for (int j = 0; j < 3; ++j) red[q][j] += __shfl_xor(red[q][j], o);
        }
#pragma unroll
        for (int q = 0; q < 2; ++q) {
            if (q == 1 && tok0 + NGW >= T) break;
            const float ra = rsqrtf(red[q][0] * (1.0f / 256.0f) + EPS), rb = rsqrtf(red[q][1] * (1.0f / 512.0f) + EPS), rc = rsqrtf(red[q][2] * (1.0f / 256.0f) + EPS);
            bf16* orow = AMIX + (size_t)tok[q] * 1024;
            { const f32x4 o = va[q] * ra * *(const f32x4*)(ga + 4 * lane); u32x2 w; w.x = pk2(o[0], o[1]); w.y = pk2(o[2], o[3]); *(u32x2*)(orow + 4 * lane) = w; }
#pragma unroll
            for (int k = 0; k < 2; ++k) { const f32x4 o = vb[q][k] * rb * *(const f32x4*)(gb + 256 * k + 4 * lane); u32x2 w; w.x = pk2(o[0], o[1]); w.y = pk2(o[2], o[3]); *(u32x2*)(orow + 256 + 256 * k + 4 * lane) = w; }
            { const f32x4 o = vc[q] * rc * *(const f32x4*)(gc + 4 * lane); u32x2 w; w.x = pk2(o[0], o[1]); w.y = pk2(o[2], o[3]); *(u32x2*)(orow + 768 + 4 * lane) = w; }
        }
    }
}
DI void phase_router(const Ctx& F, int l) {
    LAS unsigned char* WH = F.lds; LAS unsigned char* WL = F.lds + 65536;
    LAS float* biasp = (LAS float*)(F.lds + AUX_OFF); LAS float* RS = biasp + 32;
    LAS int* lcnt = (LAS int*)(F.lds + AUX_OFF + 1024); LAS int* gbase = lcnt + 32;
    LAS int* tokE = gbase + 32; LAS float* tokG = (LAS float*)(tokE + 512); LAS int* tokP = (LAS int*)(tokG + 512);
    const float* wr = ginp(F, I_WR) + (size_t)l * 1024 * 32; const float* br = ginp(F, I_BR) + (size_t)l * 32;
    const float* mods = (const float*)(F.ws + WS_MODS); const bf16* X = (const bf16*)(F.ws + WS_X); bf16* H = (bf16*)(F.ws + F.dofs + WS_H);
    const float* g2 = ginp(F, I_G2) + (size_t)l * 1024;
    const int tid = F.tid, lane = F.lane, w = F.wave;
    if (tid < 32) lcnt[tid] = 0;
    unsigned* CNT = (unsigned*)(F.ws + WS_CTL) + CW_CNT + (l + F.dcnt) * 32 * 64;
    for (int chunk = F.blk; chunk < T / 128; chunk += F.G) {
        const int b = (chunk * 128) >> 12;
        const float* sh = mods + ((size_t)(l * 8 + b) * 6 + 3) * 1024; const float* sc = sh + 1024;
        {
            float bacc = 0.f; const int e = tid & 31;
#pragma unroll 4
            for (int it = 0; it < 32; ++it) {
                const int k = 2 * ((tid + 512 * it) >> 5);
                const float w0 = wr[k * 32 + e], w1 = wr[(k + 1) * 32 + e];
                const float p0 = w0 * (g2[k] * (sc[k] + 1.0f)), p1 = w1 * (g2[k + 1] * (sc[k + 1] + 1.0f));
                bacc += sh[k] * w0 + sh[k + 1] * w1;
                const unsigned hi = pk2(p0, p1);
                const unsigned lo = pk2(p0 - bflo(hi), p1 - bfhi(hi));
                const int off = e * 2048 + ((((k >> 3) ^ e) << 4) | ((k & 7) * 2));
                *(LAS unsigned*)(WH + off) = hi; *(LAS unsigned*)(WL + off) = lo;
            }
            tokG[tid] = bacc;
        }
        __syncthreads();
        if (tid < 32) { float s_ = br[tid];
#pragma unroll
            for (int j = 0; j < 16; ++j) s_ += tokG[tid + 32 * j];
            biasp[tid] = s_; }
        {
            u32x2 ra[4], rb[4];
            f32x4 ggv[4], hhv[4];
#pragma unroll
            for (int k = 0; k < 4; ++k) { const int c = 4 * lane + 256 * k; ggv[k] = *(const f32x4*)(g2 + c) * (*(const f32x4*)(sc + c) + 1.0f); hhv[k] = *(const f32x4*)(sh + c); }
            { const bf16* x0 = X + (size_t)(chunk * 128 + w * 16) * 1024 + 4 * lane;
#pragma unroll
              for (int k = 0; k < 4; ++k) { ra[k] = *(const u32x2*)(x0 + 256 * k); rb[k] = *(const u32x2*)(x0 + 1024 + 256 * k); } }
#pragma unroll 1
            for (int tt = 0; tt < 8; ++tt) {
                const int tl0 = w * 16 + 2 * tt, tok0 = chunk * 128 + tl0;
                f32x4 v[2][4]; float ss0 = 0.f, ss1 = 0.f;
#pragma unroll
                for (int k = 0; k < 4; ++k) { v[0][k] = (f32x4){bflo(ra[k].x), bfhi(ra[k].x), bflo(ra[k].y), bfhi(ra[k].y)}; v[1][k] = (f32x4){bflo(rb[k].x), bfhi(rb[k].x), bflo(rb[k].y), bfhi(rb[k].y)}; }
                { const int tn = (tt < 7) ? tok0 + 2 : tok0; const bf16* x0 = X + (size_t)tn * 1024 + 4 * lane;
#pragma unroll
                  for (int k = 0; k < 4; ++k) { ra[k] = *(const u32x2*)(x0 + 256 * k); rb[k] = *(const u32x2*)(x0 + 1024 + 256 * k); } }
#pragma unroll
                for (int k = 0; k < 4; ++k) { ss0 += v[0][k][0] * v[0][k][0] + v[0][k][1] * v[0][k][1] + v[0][k][2] * v[0][k][2] + v[0][k][3] * v[0][k][3];
                                              ss1 += v[1][k][0] * v[1][k][0] + v[1][k][1] * v[1][k][1] + v[1][k][2] * v[1][k][2] + v[1][k][3] * v[1][k][3]; }
#pragma unroll
                for (int o = 1; o < 64; o <<= 1) { ss0 += __shfl_xor(ss0, o); ss1 += __shfl_xor(ss1, o); }
                const float rs0 = rsqrtf(ss0 * (1.0f / 1024.0f) + EPS), rs1 = rsqrtf(ss1 * (1.0f / 1024.0f) + EPS);
                if (lane == 0) { RS[tl0] = rs0; RS[tl0 + 1] = rs1; }
#pragma unroll
                for (int k = 0; k < 4; ++k) {
                    const int c = 4 * lane + 256 * k;
                    v[0][k] = v[0][k] * rs0 * ggv[k] + hhv[k]; v[1][k] = v[1][k] * rs1 * ggv[k] + hhv[k];
                    *(unsigned*)((unsigned char*)H + (size_t)tok0 * 1024 + c) = pk4_fp8s(v[0][k][0], v[0][k][1], v[0][k][2], v[0][k][3], H8_SCALE);
                    *(unsigned*)((unsigned char*)H + (size_t)(tok0 + 1) * 1024 + c) = pk4_fp8s(v[1][k][0], v[1][k][1], v[1][k][2], v[1][k][3], H8_SCALE);
                }
            }
        }
        __syncthreads();
        f32x4 acc[2] = {{0.f, 0.f, 0.f, 0.f}, {0.f, 0.f, 0.f, 0.f}};
        {
            const int kg = lane >> 4, n16 = lane & 15;
            const bf16* xr = X + (size_t)(chunk * 128 + w * 16 + n16) * 1024 + 8 * kg;
#pragma unroll 1
            for (int k8 = 0; k8 < 4; ++k8) {
                bf16x8 af[8];
#pragma unroll
                for (int j = 0; j < 8; ++j) af[j] = *(const bf16x8*)(xr + 32 * (8 * k8 + j));
#pragma unroll
                for (int j = 0; j < 8; ++j) {
                    const int c = 4 * (8 * k8 + j) + kg;
#pragma unroll
                    for (int et = 0; et < 2; ++et) {
                        const int e = 16 * et + n16, off = e * 2048 + ((c ^ e) << 4);
                        const bf16x8 bh = *(const LAS bf16x8*)(WH + off), bl = *(const LAS bf16x8*)(WL + off);
                        acc[et] = __builtin_amdgcn_mfma_f32_16x16x32_bf16(af[j], bh, acc[et], 0, 0, 0);
                        acc[et] = __builtin_amdgcn_mfma_f32_16x16x32_bf16(af[j], bl, acc[et], 0, 0, 0);
                    }
                }
            }
        }
        __syncthreads();
        LAS float* LG = (LAS float*)(F.lds + w * 2048);
        {
            const int g4 = lane >> 4, n16 = lane & 15;
#pragma unroll
            for (int et = 0; et < 2; ++et)
#pragma unroll
                for (int i = 0; i < 4; ++i) LG[(4 * g4 + i) * 32 + 16 * et + n16] = acc[et][i] * RS[w * 16 + 4 * g4 + i] + biasp[16 * et + n16];
        }
        asm volatile("s_waitcnt lgkmcnt(0)" ::: "memory");
#pragma unroll 1
        for (int tt = 0; tt < 8; ++tt) {
            const int tl0 = w * 16 + 2 * tt;
            const float lg0 = LG[(2 * tt) * 32 + (lane >> 1)], lg1 = LG[(2 * tt + 1) * 32 + (lane >> 1)];
            int rk0 = 0, rk1 = 0; const int me = lane >> 1;
#pragma unroll
            for (int e = 0; e < 32; ++e) {
                const float o0 = __builtin_bit_cast(float, __builtin_amdgcn_readlane(__builtin_bit_cast(int, lg0), 2 * e));
                const float o1 = __builtin_bit_cast(float, __builtin_amdgcn_readlane(__builtin_bit_cast(int, lg1), 2 * e));
                rk0 += ((o0 > lg0) || (o0 == lg0 && e < me)) ? 1 : 0; rk1 += ((o1 > lg1) || (o1 == lg1 && e < me)) ? 1 : 0;
            }
#pragma unroll
            for (int tk = 0; tk < 2; ++tk) {
                const int rk = tk ? rk1 : rk0; const float lg = tk ? lg1 : lg0;
                int te[4]; float tv[4];
#pragma unroll
                for (int r = 0; r < 4; ++r) {
                    const u64 mk = __ballot(rk == r && (lane & 1) == 0);
                    const int sl = __builtin_amdgcn_readfirstlane((int)__builtin_ctzll(mk));
                    te[r] = sl >> 1; tv[r] = __builtin_bit_cast(float, __builtin_amdgcn_readlane(__builtin_bit_cast(int, lg), sl));
                }
                const float e1 = __expf(tv[1] - tv[0]), e2 = __expf(tv[2] - tv[0]), e3 = __expf(tv[3] - tv[0]);
                const float isum = 1.0f / (1.0f + e1 + e2 + e3);
                if (lane < 4) {
                    const int tl = tl0 + tk;
                    const int e = lane == 0 ? te[0] : lane == 1 ? te[1] : lane == 2 ? te[2] : te[3];
                    const float gte = (lane == 0 ? 1.0f : lane == 1 ? e1 : lane == 2 ? e2 : e3) * isum;
                    const int pos = atomicAdd((int*)(lcnt + e), 1);
                    tokE[tl * 4 + lane] = e; tokG[tl * 4 + lane] = gte; tokP[tl * 4 + lane] = pos;
                }
            }
        }
        __syncthreads();
        if (tid < 32) gbase[tid] = (int)__hip_atomic_fetch_add(CNT + tid * 64, (unsigned)lcnt[tid], RLX_AGENT);
        __syncthreads();
        {
            const int tl = tid >> 2, r = tid & 3, e = tokE[tid], pos = gbase[e] + tokP[tid], tok = chunk * 128 + tl;
            ((int*)(F.ws + F.dofs + WS_IDX))[(size_t)e * ECAP + pos] = tok;
            ((float*)(F.ws + F.dofs + WS_GATEW))[(size_t)e * ECAP + pos] = tokG[tid];
            ((int*)(F.ws + F.dofs + WS_TOKSLOT))[(size_t)tok * 4 + r] = (e << 16) | pos;
        }
        __syncthreads();
        if (tid < 32) lcnt[tid] = 0;
        __syncthreads();
    }
}

DI int ropeperm64(int p) { return (p >> 1) + 32 * (p & 1); }
DI int cmap_win(int n) {
    const int tile = n >> 8, w = n & 255, hb = w & ~63, pp = ropeperm64(w & 63);
    switch (tile) {
        case 0: return hb + pp;
        case 1: return 256 + hb + pp;
        case 2: return 512 + w;
        case 3: return 768 + hb + pp;
        case 4: return 1024 + hb + pp;
        case 5: return w < 128 ? 1280 + w : 1408 + (w - 128);
        case 6: return w < 128 ? 1536 + hb + pp : 1664 + (w - 128);
        case 7: return w < 128 ? 1792 + hb + pp : 1920 + (w - 128);
        case 8: return 2072 + w;
        default: return w < 128 ? 2328 + w : (w < 160 ? 2456 + ((w - 128) >> 1) + 16 * ((w - 128) & 1) : (w < 184 ? 2048 + (w - 160) : -1));
    }
}
DI int cmap_qup(int n) { if (n >= 384) return -1; const int h = n / 96, w = n % 96; if (w < 64) return h * 96 + w; const int j = w - 64; return h * 96 + 64 + (j >> 1) + 16 * (j & 1); }
DI void tr_tile(const float* src, int K, int Nsrc, bf16* dst, int Kdst, int maptype, const float* ksc, int ntile, int ktile, LAS float* scr, int tid) {
    const int n0 = ntile * 64, k0 = ktile * 128, nl = tid & 63, n = n0 + nl;
    const int c = maptype == 0 ? (n < Nsrc ? n : -1) : (maptype == 1 ? cmap_win(n) : cmap_qup(n));
    float v[16];
#pragma unroll
    for (int it = 0; it < 16; ++it) { const int k = k0 + (tid >> 6) + 8 * it; v[it] = (c >= 0 && k < K) ? src[(size_t)k * Nsrc + c] * (ksc ? ksc[k] : 1.0f) : 0.f; }
#pragma unroll
    for (int it = 0; it < 16; ++it) scr[((tid >> 6) + 8 * it) * 65 + nl] = v[it];
    __syncthreads();
#pragma unroll
    for (int it = 0; it < 2; ++it) {
        const int idx = tid + 512 * it, nn = idx >> 4, ch = idx & 15;
        const LAS float* s = scr + (8 * ch) * 65 + nn;
        u32x4 o; o.x = pk2(s[0], s[65]); o.y = pk2(s[2 * 65], s[3 * 65]); o.z = pk2(s[4 * 65], s[5 * 65]); o.w = pk2(s[6 * 65], s[7 * 65]);
        *(u32x4*)(dst + (size_t)(n0 + nn) * Kdst + k0 + 8 * ch) = o;
    }
    __syncthreads();
}
DI void trb_load(f32x4 (&v)[16], const float* src, int N, int n0, int k0, int tid) {
#pragma unroll
    for (int it = 0; it < 16; ++it) v[it] = *(const f32x4*)(src + (size_t)(k0 + (tid >> 6) + 8 * it) * N + n0 + 4 * (tid & 63));
}
DI void trb_store(const f32x4 (&v)[16], bf16* dst, int Kd, int n0, int k0, LAS unsigned char* L, int tid, int wave, int lane, int f8 = 0) {
#pragma unroll
    for (int it = 0; it < 16; ++it) { f32x4 x = v[it];
        if (f8) { x[0] = q8s(x[0], W8_SCALE); x[1] = q8s(x[1], W8_SCALE); x[2] = q8s(x[2], W8_SCALE); x[3] = q8s(x[3], W8_SCALE); }
        u32x2 w; w.x = pk2(x[0], x[1]); w.y = pk2(x[2], x[3]); *(LAS u32x2*)(L + ((tid >> 6) + 8 * it) * 576 + (tid & 63) * 8) = w; }
    asm volatile("s_waitcnt lgkmcnt(0)\n\ts_barrier" ::: "memory");
    const int i = lane & 15, gn = (lane >> 4) & 1, h = lane >> 5, q = i >> 2, p = i & 3;
    const LAS unsigned char* base = L + (8 * h + q) * 576 + (32 * wave + 16 * gn) * 2 + 8 * p;
    if (!f8) {
        bf16* drow = dst + (size_t)(n0 + 32 * wave + 16 * gn + i) * Kd + k0 + 8 * h;
#pragma unroll
        for (int kcp = 0; kcp < 8; ++kcp) {
            const s16x4 lo = tr_read(base + (16 * kcp) * 576), hi = tr_read(base + (16 * kcp + 4) * 576);
            *(bf16x8*)(drow + 16 * kcp) = __builtin_shufflevector(lo, hi, 0, 1, 2, 3, 4, 5, 6, 7);
        }
    } else {
        unsigned char* drow = (unsigned char*)dst + (size_t)(n0 + 32 * wave + 16 * gn + i) * Kd + k0 + 8 * h;
#pragma unroll
        for (int kcp = 0; kcp < 8; ++kcp) {
            const s16x4 lo = tr_read(base + (16 * kcp) * 576), hi = tr_read(base + (16 * kcp + 4) * 576);
            int w0 = __builtin_amdgcn_cvt_pk_fp8_f32(bf2f((unsigned short)lo[0]), bf2f((unsigned short)lo[1]), 0, false); w0 = __builtin_amdgcn_cvt_pk_fp8_f32(bf2f((unsigned short)lo[2]), bf2f((unsigned short)lo[3]), w0, true);
            int w1 = __builtin_amdgcn_cvt_pk_fp8_f32(bf2f((unsigned short)hi[0]), bf2f((unsigned short)hi[1]), 0, false); w1 = __builtin_amdgcn_cvt_pk_fp8_f32(bf2f((unsigned short)hi[2]), bf2f((unsigned short)hi[3]), w1, true);
            u32x2 o; o.x = (unsigned)w0; o.y = (unsigned)w1;
            *(u32x2*)(drow + 16 * kcp) = o;
        }
    }
    asm volatile("s_waitcnt lgkmcnt(0)\n\ts_barrier" ::: "memory");
}
struct TrbItem { const float* src; bf16* dst; int N, n0, k0, f8; };
DI TrbItem trb_item(const Ctx& F, int it) {
    const int le = it / 96, r = it % 96; TrbItem t;
    if (r < 64) { t.src = ginp(F, I_WE1) + (size_t)le * 1024 * 2048; t.dst = (bf16*)(F.ws + WS_W1E + (size_t)le * 2048 * 1024); t.N = 2048; t.n0 = (r & 7) * 256; t.k0 = (r >> 3) * 128; t.f8 = 1; }
    else { const int q = r - 64; t.src = ginp(F, I_WE2) + (size_t)le * 1024 * 1024; t.dst = (bf16*)(F.ws + WS_W2E + (size_t)le * 1024 * 1024); t.N = 1024; t.n0 = (q & 3) * 256; t.k0 = (q >> 2) * 128; t.f8 = 1; }
    return t;
}
DI void conv_layer_tiles(const Ctx& F, int l, int q0, int i0, int cnt) {
    const int NL = 32 * 96;
    int it = q0 + F.blk + F.G * i0; const int end = q0 + F.blk + F.G * (i0 + cnt);
    if (it >= NL) return;
    f32x4 va[16];
    TrbItem ta = trb_item(F, l * NL + it);
    trb_load(va, ta.src, ta.N, ta.n0, ta.k0, F.tid);
#pragma unroll 1
    while (it < NL && it < end) {
        f32x4 vb[16];
#pragma unroll
        for (int k = 0; k < 16; ++k) vb[k] = va[k];
        const TrbItem tc = ta;
        it += F.G;
        const bool more = (it < NL && it < end);
        ta = trb_item(F, l * NL + (more ? it : 0));
        if (more) trb_load(va, ta.src, ta.N, ta.n0, ta.k0, F.tid);
        trb_store(vb, tc.dst, 1024, tc.n0, tc.k0, F.lds, F.tid, F.wave, F.lane, tc.f8);
    }
}
DI void conv_claim_tiles(const Ctx& F, int l, int quota) {
    const int NL = 32 * 96;
    volatile LAS unsigned* slot = (volatile LAS unsigned*)(F.lds + MISC_OFF) + 16;
    __syncthreads();
    if (F.tid == 0) { unsigned* q = (unsigned*)(F.ws + WS_CTL) + CW_CONVQ + l * 64; slot[0] = __hip_atomic_fetch_add(q, (unsigned)quota, __ATOMIC_RELAXED, __HIP_MEMORY_SCOPE_AGENT); }
    __syncthreads();
    int it = __builtin_amdgcn_readfirstlane((int)slot[0]); const int end = it + quota;
    if (it >= NL) return;
    f32x4 va[16];
    TrbItem ta = trb_item(F, l * NL + it);
    trb_load(va, ta.src, ta.N, ta.n0, ta.k0, F.tid);
#pragma unroll 1
    while (it < NL && it < end) {
        f32x4 vb[16];
#pragma unroll
        for (int k = 0; k < 16; ++k) vb[k] = va[k];
        const TrbItem tc = ta;
        it += 1;
        const bool more = (it < NL && it < end);
        ta = trb_item(F, l * NL + (more ? it : 0));
        if (more) trb_load(va, ta.src, ta.N, ta.n0, ta.k0, F.tid);
        trb_store(vb, tc.dst, 1024, tc.n0, tc.k0, F.lds, F.tid, F.wave, F.lane, tc.f8);
    }
}
DI void phase_prologue(const Ctx& F) {
    const Args& A = *F.a; const int tid = F.tid;
    LAS float* scr = (LAS float*)F.lds;
    if (!CONV_IN_LAYER) {
        const int NIT = DEPTH * 32 * 96;
        f32x4 va[16];
        int it = F.blk;
        TrbItem ta = trb_item(F, it < NIT ? it : 0);
        if (it < NIT) trb_load(va, ta.src, ta.N, ta.n0, ta.k0, tid);
#pragma unroll 1
        while (it < NIT) {
            f32x4 vb[16];
#pragma unroll
            for (int k = 0; k < 16; ++k) vb[k] = va[k];
            const TrbItem tc = ta;
            it += F.G;
            ta = trb_item(F, it < NIT ? it : 0);
            if (it < NIT) trb_load(va, ta.src, ta.N, ta.n0, ta.k0, tid);
            trb_store(vb, tc.dst, 1024, tc.n0, tc.k0, F.lds, tid, F.wave, F.lane, tc.f8);
        }
    }
    constexpr int PER_L = 8192 + 4096 + 320 + 128 + 128 + 16 + 16;
    for (int it = F.blk; it < DEPTH * PER_L; it += F.G) {
        const int l = it / PER_L; int r = it % PER_L;
        if (r < 8192 + 4096) continue;
        if (r < 8192) { const int e = r >> 8, t = r & 255;
            tr_tile(ginp(F, I_WE1) + ((size_t)(l * 32 + e)) * 1024 * 2048, 1024, 2048, (bf16*)(F.ws + WS_W1E) + ((size_t)(l * 32 + e)) * 2048 * 1024, 1024, 0, nullptr, t >> 3, t & 7, scr, tid); continue; }
        r -= 8192;
        if (r < 4096) { const int e = r >> 7, t = r & 127;
            tr_tile(ginp(F, I_WE2) + ((size_t)(l * 32 + e)) * 1024 * 1024, 1024, 1024, (bf16*)(F.ws + WS_W2E) + ((size_t)(l * 32 + e)) * 1024 * 1024, 1024, 0, nullptr, t >> 3, t & 7, scr, tid); continue; }
        r -= 4096;
        if (r < 320) { tr_tile(ginp(F, I_WIN) + (size_t)l * 1024 * 2488, 1024, 2488, (bf16*)(F.ws + WS_WIN) + (size_t)l * NIN * 1024, 1024, 1, nullptr, r >> 3, r & 7, scr, tid); continue; }
        r -= 320;
        if (r < 128) { tr_tile(ginp(F, I_WOUT) + (size_t)l * 1024 * 1024, 1024, 1024, (bf16*)(F.ws + WS_WOUT) + (size_t)l * 1024 * 1024, 1024, 0, nullptr, r >> 3, r & 7, scr, tid); continue; }
        r -= 128;
        if (r < 128) { const int kv = r >> 6, t = r & 63;
            tr_tile(ginp(F, kv ? I_W1V : I_W1K) + (size_t)l * 2048 * 256, 2048, 256, (bf16*)(F.ws + WS_NSAW1) + ((size_t)(l * 2 + kv)) * 256 * 2048, 2048, 0, nullptr, t >> 4, t & 15, scr, tid); continue; }
        r -= 128;
        if (r < 16) { tr_tile(ginp(F, I_WQUP) + (size_t)l * 256 * 384, 256, 384, (bf16*)(F.ws + WS_MLAQ) + (size_t)l * 512 * 256, 256, 2, ginp(F, I_GQ) + (size_t)l * 256, r >> 1, r & 1, scr, tid); continue; }
        r -= 16;
        tr_tile(ginp(F, I_WKVUP) + (size_t)l * 128 * 512, 128, 512, (bf16*)(F.ws + WS_MLAKV) + (size_t)l * 512 * 256, 256, 0, ginp(F, I_GKV) + (size_t)l * 128, r >> 1, r & 1, scr, tid);
    }
    for (int it = F.blk; it < DEPTH * 4; it += F.G) {
        const int l = it >> 2, kv = (it >> 1) & 1, kt = it & 1;
        tr_tile(ginp(F, kv ? I_W2V : I_W2K) + (size_t)l * 256 * 64, 256, 64, (bf16*)(F.ws + WS_W2T) + ((size_t)(l * 2 + kv)) * 64 * 256, 256, 0, nullptr, 0, kt, scr, tid);
    }
    {
        float* CS64 = (float*)(F.ws + WS_CS64); float* CS32 = (float*)(F.ws + WS_CS32);
        const int* pos = (const int*)ginp(F, I_POS);
        for (int idx = F.blk * 512 + tid; idx < T * 48; idx += F.G * 512) {
            const int tok = idx / 48, i = idx % 48;
            const double p = (double)pos[tok];
            const double inv = (i < 32) ? exp2(-(double)i * (13.287712379549449 / 32.0)) : exp2(-(double)(i - 32) * (13.287712379549449 / 16.0));
            double ang = p * inv;
            const double kk = __builtin_rint(ang * 0.15915494309189535);
            ang = ang - kk * 6.283185307179586;
            const float af = (float)ang;
            const float cs = __cosf(af), sn = __sinf(af);
            if (i < 32) { CS64[(size_t)tok * 64 + i] = cs; CS64[(size_t)tok * 64 + 32 + i] = sn; }
            else { CS32[(size_t)tok * 32 + (i - 32)] = cs; CS32[(size_t)tok * 32 + 16 + (i - 32)] = sn; }
        }
    }
    for (int item = F.blk; item < 32; item += F.G) {
        const int lk = item >> 2, l = lk >> 1, kv = lk & 1, col = (item & 3) * 64 + F.lane;
        const float* w1 = ginp(F, kv ? I_W1V : I_W1K) + (size_t)l * 2048 * 256 + col; const float* pe = ginp(F, kv ? I_POSV : I_POSK) + (size_t)l * 2048;
        float s = 0.f;
#pragma unroll 1
        for (int kb = 256 * F.wave; kb < 256 * F.wave + 256; kb += 16) {
            float wv[16];
#pragma unroll
            for (int j = 0; j < 16; ++j) wv[j] = w1[(size_t)(kb + j) * 256];
#pragma unroll
            for (int j = 0; j < 16; ++j) s += pe[kb + j] * wv[j];
        }
        scr[F.wave * 64 + F.lane] = s;
        __syncthreads();
        if (tid < 64) { float t = ginp(F, kv ? I_B1V : I_B1K)[(size_t)l * 256 + col];
#pragma unroll
            for (int ww = 0; ww < 8; ++ww) t += scr[ww * 64 + tid];
            ((float*)(F.ws + WS_B1P))[(size_t)lk * 256 + col] = t; }
        __syncthreads();
    }
    {
        LAS float* sc = scr; LAS float* red = scr + 8192;
        for (int i = tid; i < 8192; i += 512) { const float c = ginp(F, I_C)[i]; sc[i] = c * sigmoidf_(c); }
        __syncthreads();
        float* MODS = (float*)(F.ws + WS_MODS);
        const int lane = F.lane, w = F.wave;
        for (int item = F.blk; item < 384; item += F.G) {
            const int l = item / 96, col = (item % 96) * 64 + lane;
            float acc[8];
#pragma unroll
            for (int b = 0; b < 8; ++b) acc[b] = 0.f;
            const float* wa = ginp(F, I_WADA) + (size_t)l * 1024 * 6144 + col;
#pragma unroll 1
            for (int kb = 128 * w; kb < 128 * w + 128; kb += 16) {
                float wv[16];
#pragma unroll
                for (int j = 0; j < 16; ++j) wv[j] = wa[(size_t)(kb + j) * 6144];
#pragma unroll
                for (int j = 0; j < 16; ++j) {
#pragma unroll
                    for (int b = 0; b < 8; ++b) acc[b] += sc[b * 1024 + kb + j] * wv[j]; }
            }
#pragma unroll
            for (int b = 0; b < 8; ++b) red[(w * 8 + b) * 64 + lane] = acc[b];
            __syncthreads();
            { const int b = tid >> 6; float s = ginp(F, I_BADA)[(size_t)l * 6144 + col];
#pragma unroll
              for (int ww = 0; ww < 8; ++ww) s += red[(ww * 8 + b) * 64 + lane];
              MODS[((size_t)(l * 8 + b)) * 6144 + col] = s; }
            __syncthreads();
        }
    }
}

constexpr int PH_PER_LAYER = 11;
constexpr int N_PHASES = 1 + DEPTH * PH_PER_LAYER + 1;

__global__ void __launch_bounds__(512, 2) fwd_kernel(Args args) {
    extern __shared__ __attribute__((aligned(16))) unsigned char lds_raw[];
    Ctx F;
    F.lds = (LAS unsigned char*)lds_raw; F.a = &args; F.ws = args.ws;
    F.dofs = 0; F.dcnt = 0;
    F.tid = threadIdx.x; F.lane = F.tid & 63; F.wave = __builtin_amdgcn_readfirstlane(F.tid >> 6); F.blk = blockIdx.x; F.G = gridDim.x; F.vcu = F.blk;
    volatile LAS unsigned* MISC = (volatile LAS unsigned*)(F.lds + MISC_OFF);
    for (int u = F.tid; u < (LDS_BYTES - MISC_OFF) / 4; u += 512) MISC[u] = 0u;
    __syncthreads();
    unsigned* ctl = (unsigned*)(F.ws + WS_CTL);
    XcdBarrier bar; bar.bar = ctl + CW_BAR; bar.x = 0; bar.st = nullptr;
    if (!MK_PER_PHASE) bar = xcd_barrier_post(ctl + CW_BAR, MISC + 8);
    const int lo = args.ph_lo, hi = args.ph_hi;
#define IN(k) (lo <= (k) && (k) < hi)
#define SEAM(k) do { if (IN(k) && IN((k) + 1)) xcd_barrier(bar); } while (0)
    unsigned char* ws = F.ws;
#define PHASE_BEGIN() do { int t_ = threadIdx.x; asm volatile("" : "+v"(t_)); F.tid = t_; F.lane = t_ & 63; F.wave = __builtin_amdgcn_readfirstlane(t_ >> 6); \
        GAS unsigned char* w_ = (GAS unsigned char*)args.ws; asm volatile("" : "+s"(w_)); F.ws = (unsigned char*)w_; ws = (unsigned char*)w_; int b_ = blockIdx.x; asm volatile("" : "+s"(b_)); F.blk = b_; F.vcu = (F.G % 8 == 0) ? (b_ % 8) * (F.G / 8) + b_ / 8 : b_; } while (0)

    if (PHON(0) && IN(0)) _Pragma("unroll 1") for (int rep_ = 0; rep_ < NREP(0); ++rep_) { PHASE_BEGIN(); phase_prologue(F); }
    SEAM(0);
#pragma unroll 1
    for (int l = 0; l < DEPTH; ++l) {
        const int P = 1 + l * PH_PER_LAYER;
        if (PHON(1) && IN(P + 0)) _Pragma("unroll 1") for (int rep_ = 0; rep_ < (DUM(1) ? 2 : 1); ++rep_) { PHASE_BEGIN(); F.dofs = (DUM(1) && rep_ == 0) ? WS_END : 0; phase_norm1<0>(F, l); }
        SEAM(P + 0);
        if (PHON(2) && IN(P + 1)) _Pragma("unroll 1") for (int rep_ = 0; rep_ < NREP(2); ++rep_) { PHASE_BEGIN();
            SchedGrid Sg{(const char*)(ws + WS_H), (const char*)(ws + WS_WIN) + (size_t)l * NIN * 1024 * 2, 1024, 1024, NIN / 256, (T / 256) * (NIN / 256), F.G, F.vcu};
            EpiWin E{ws, (const float*)(ws + WS_CS64), (const float*)(ws + WS_CS32)};
            pg8::gemm_phase<EpiWin, SchedGrid, false>(F.lds, 1024, 1024, Sg, E);
        }
        SEAM(P + 1);
        if (PHON(3) && IN(P + 2)) _Pragma("unroll 1") for (int rep_ = 0; rep_ < NREP(3); ++rep_) { PHASE_BEGIN();
            if (PHON(13)) {
                SchedCmp Sc{(const char*)(ws + WS_KCMP), (const char*)(ws + WS_VCMP), (const char*)(ws + WS_NSAW1) + (size_t)l * 2 * 256 * 2048 * 2, F.G, F.blk};
                EpiCmp E{(const float*)(ws + WS_B1P) + (size_t)l * 512, (const bf16*)(ws + WS_W2T) + (size_t)l * 2 * 64 * 256, ginp(F, I_B2K) + (size_t)l * 64, ginp(F, I_B2V) + (size_t)l * 64,
                         (bf16*)(ws + WS_KC), (bf16*)(ws + WS_VC), (const float*)(ws + WS_CS64)};
                pg8::gemm_phase<EpiCmp, SchedCmp, false>(F.lds, 1024, 2048, Sc, E);
            }
            PHASE_BEGIN();
            if (PHON(18)) {
                SchedMla Sm{(const char*)(ws + WS_CQ), (const char*)(ws + WS_MISC), (const char*)(ws + WS_MLAQ) + (size_t)l * 512 * 256 * 2, (const char*)(ws + WS_MLAKV) + (size_t)l * 512 * 256 * 2, F.G, F.vcu};
                EpiMla E{(bf16*)(ws + WS_QM), (bf16*)(ws + WS_KN), (bf16*)(ws + WS_VM), (const bf16*)(ws + WS_CQ), (const bf16*)(ws + WS_MISC), (const float*)(ws + WS_CS32)};
                pg8::gemm_phase<EpiMla, SchedMla, false>(F.lds, 256, 256, Sm, E);
            }
            PHASE_BEGIN();
            if (PHON(15)) {
                unsigned* qw = (unsigned*)(ws + WS_CTL) + CW_QUEUE + (l * 2 + rep_) * 64;
                volatile LAS int* qslot = (volatile LAS int*)(F.lds + AUX_OFF + 512);
                int nxt_t = 0;
                if (F.tid == 0) nxt_t = (int)__hip_atomic_fetch_add(qw, 1u, RLX_AGENT);
                for (;;) {
                    if (F.tid == 0) { qslot[0] = nxt_t; nxt_t = (int)__hip_atomic_fetch_add(qw, 1u, RLX_AGENT); }
                    __syncthreads();
                    const int uq = qslot[0];
                    __syncthreads();
                    if (uq >= 2560) break;
                    if (uq < 1024) {
                        const int u = uq;
                        PolB pb; pb.Q = (const bf16*)(ws + WS_QB); pb.K = (const bf16*)(ws + WS_KWIN); pb.V = (const bf16*)(ws + WS_VWIN); pb.O = (bf16*)(ws + WS_OWIN);
                        pb.b = u >> 7; pb.g = (u >> 6) & 1; pb.qc = 63 - (u & 63); pb.maxd = 511u; pb.j0 = pb.qc > 8 ? pb.qc - 8 : 0; pb.j1 = pb.qc + 1;
                        attn_unit<64, PolB, false>(pb, F.lds, F.tid, F.lane, F.wave, 0ull);
                    } else {
                        const int uu = uq - 1024;
                        const int bh = uu / 48, w48 = uu % 48, p = w48 >> 4, s16 = w48 & 15;
                        PolA pa; pa.Q = (const bf16*)(ws + WS_QA); pa.K = (const bf16*)(ws + WS_KA); pa.V = (const bf16*)(ws + WS_VA);
                        pa.O = (bf16*)(ws + WS_OA3) + (size_t)p * T * 256; pa.LSEP = (float*)(ws + WS_LSEA) + (size_t)p * T * 4;
                        pa.b = bh >> 2; pa.h = bh & 3; pa.d = p == 0 ? 1 : (p == 1 ? 4 : 16);
                        const int cpr = p == 0 ? 16 : (p == 1 ? 4 : 1);
                        pa.r = s16 / cpr; pa.c = s16 % cpr; pa.maxd = 128u; pa.j0 = pa.c == 0 ? 2 : 0; pa.j1 = 6;
                        attn_unit<64, PolA, false>(pa, F.lds, F.tid, F.lane, F.wave, 0ull);
                    }
                }
            }
        }
        SEAM(P + 2);
        if (PHON(5) && IN(P + 4)) _Pragma("unroll 1") for (int rep_ = 0; rep_ < NREP(5); ++rep_) { PHASE_BEGIN();
            int cti = 0;
            int cq0 = 0;
            if (CONV_IN_LAYER) { const unsigned t_ = __hip_atomic_load((unsigned*)(ws + WS_CTL) + CW_CONVQ + l * 64, __ATOMIC_RELAXED, __HIP_MEMORY_SCOPE_AGENT); cq0 = __builtin_amdgcn_readfirstlane((int)(t_ < 3072u ? t_ : 3072u)); }
            if (PHON(19)) for (int u = F.vcu; u < 1024; u += F.G) {
                const int bg = (u % 256) >> 4, k = u & 15, rnd = u >> 8;
                const int qc = rnd == 0 ? 2 * k : (rnd == 1 ? 2 * k + 1 : (rnd == 2 ? 63 - 2 * k : 62 - 2 * k));
                const u64 sel = cmp_unit(F, bg >> 1, bg & 1, qc);
                PolB pb; pb.Q = (const bf16*)(ws + WS_QB); pb.K = (const bf16*)(ws + WS_KSLC); pb.V = (const bf16*)(ws + WS_VSLC); pb.O = (bf16*)(ws + WS_OSLC);
                pb.b = bg >> 1; pb.g = bg & 1; pb.qc = qc; pb.maxd = 0x7fffffffu; pb.j0 = 0; pb.j1 = qc + 1;
                pb.GC = (const bf16*)(ws + WS_OCMP); pb.GW = (const bf16*)(ws + WS_OWIN); pb.GM = (const bf16*)(ws + WS_MISC);
                attn_unit<64, PolB, true>(pb, F.lds, F.tid, F.lane, F.wave, sel);
                if (CONV_IN_LAYER && rep_ == 0) { PHASE_BEGIN(); conv_layer_tiles(F, l, cq0, cti, 2); cti += 2; }
            }
            PHASE_BEGIN();
            if (PHON(20)) for (int v = F.vcu; v < 512; v += F.G) {
                const int bh = (v & 255) >> 3, k = v & 7, c = (v < 256) ? k : 15 - k;
                PolM pm; pm.Q = (const bf16*)(ws + WS_QM); pm.KN = (const bf16*)(ws + WS_KN); pm.KR = (const bf16*)(ws + WS_KR); pm.V = (const bf16*)(ws + WS_VM); pm.O = (bf16*)(ws + WS_OC);
                pm.b = bh >> 2; pm.h = bh & 3; pm.c = c; pm.maxd = 0x7fffffffu; pm.j0 = 0; pm.j1 = 4 * c + 4;
                attn_unit<96, PolM, false>(pm, F.lds, F.tid, F.lane, F.wave, 0ull);
                if (CONV_IN_LAYER && rep_ == 0) { PHASE_BEGIN(); conv_layer_tiles(F, l, cq0, cti, 2); cti += 2; }
            }
            if (CONV_IN_LAYER && rep_ == 0) { PHASE_BEGIN(); conv_layer_tiles(F, l, cq0, cti, 1 << 20); }
        }
        SEAM(P + 4);
        if (PHON(7) && IN(P + 6)) _Pragma("unroll 1") for (int rep_ = 0; rep_ < NREP(7); ++rep_) { PHASE_BEGIN(); phase_mix(F, l); }
        SEAM(P + 6);
        if (PHON(8) && IN(P + 7)) _Pragma("unroll 1") for (int rep_ = 0; rep_ < (DUM(8) ? 2 : 1); ++rep_) { PHASE_BEGIN(); F.dofs = (DUM(8) && rep_ == 0) ? WS_END : 0;
            SchedGrid Sg{(const char*)(ws + WS_AMIX), (const char*)(ws + WS_WOUT) + (size_t)l * 1024 * 1024 * 2, 1024, 1024, 4, (T / 256) * 4, F.G, F.vcu};
            EpiWout E{(bf16*)(ws + WS_X), (const float*)(ws + WS_MODS) + ((size_t)(l * 8) * 6 + 2) * 1024, F.dofs};
            pg8::gemm_phase<EpiWout, SchedGrid, false>(F.lds, 1024, 1024, Sg, E);
        }
        SEAM(P + 7);
        if (PHON(9) && IN(P + 8)) _Pragma("unroll 1") for (int rep_ = 0; rep_ < (DUM(9) ? 2 : 1); ++rep_) { PHASE_BEGIN(); F.dofs = (DUM(9) && rep_ == 0) ? WS_END : 0; F.dcnt = (DUM(9) && rep_ == 0) ? 4 : 0; phase_router(F, l); }
        SEAM(P + 8);
        if (PHON(10) && IN(P + 9)) _Pragma("unroll 1") for (int rep_ = 0; rep_ < NREP(10); ++rep_) { PHASE_BEGIN();
            moe_tables(F, l);
            const LAS int* tb = (const LAS int*)(F.lds + AUX_OFF);
            SchedMoe1F8 Sm{tb, tb + 64, (const char*)(ws + WS_H), (const char*)(ws + WS_W1E) + (size_t)l * 32 * 2048 * 1024, (const int*)(ws + WS_IDX), tb[32] * 8, F.G, F.vcu};
            EpiMoe1 E{(bf16*)(ws + WS_ACT), ginp(F, I_BE1) + (size_t)l * 32 * 2048};
            pg8::gemm_phase<EpiMoe1, SchedMoe1F8, true, true>(F.lds, 512, 512, Sm, E);
            if (CONV_IN_LAYER && CONV_TAIL1 > 0 && rep_ == 0 && l + 1 < DEPTH) {
                const int nun = tb[32] * 8, rounds = (nun + F.G - 1) / F.G, mine = F.vcu < nun ? (nun - 1 - F.vcu) / F.G + 1 : 0;
                if (mine < rounds) { PHASE_BEGIN(); conv_claim_tiles(F, l + 1, CONV_TAIL1); }
            }
        }
        SEAM(P + 9);
        if (PHON(11) && IN(P + 10)) _Pragma("unroll 1") for (int rep_ = 0; rep_ < NREP(11); ++rep_) { PHASE_BEGIN();
            moe_tables(F, l);
            const LAS int* tb = (const LAS int*)(F.lds + AUX_OFF);
            SchedMoe2F8 Sm{tb, (const char*)(ws + WS_ACT), (const char*)(ws + WS_W2E) + (size_t)l * 32 * 1024 * 1024, tb[32] * 4, F.G, F.vcu};
            EpiMoe2 E{(unsigned char*)(ws + WS_Y2), ginp(F, I_BE2) + (size_t)l * 32 * 1024, (const float*)(ws + WS_GATEW)};
            pg8::gemm_phase<EpiMoe2, SchedMoe2F8, false, true>(F.lds, 512, 512, Sm, E);
            if (CONV_IN_LAYER && CONV_TAIL2 > 0 && rep_ == 0 && l + 1 < DEPTH) {
                const int nun = tb[32] * 4, rounds = (nun + F.G - 1) / F.G, mine = F.vcu < nun ? (nun - 1 - F.vcu) / F.G + 1 : 0;
                if (mine < rounds) { PHASE_BEGIN(); conv_claim_tiles(F, l + 1, CONV_TAIL2); }
            }
        }
        SEAM(P + 10);
    }
    if (PHON(12) && IN(N_PHASES - 1)) { PHASE_BEGIN(); phase_norm1<1>(F, DEPTH); }
#undef IN
#undef SEAM
}

extern "C" void kernel_launch(void* const* d_in, const int* in_sizes, int n_in, void* d_out, int out_size, void* d_ws, size_t ws_size, hipStream_t stream) {
    static int grid = 0;
    if (grid == 0) {
        if (n_in != 33 || out_size != T * D || ws_size < WS_END * (DUM_MASK ? 2 : 1)) { fprintf(stderr, "kernel_launch: unexpected problem (n_in %d out %d ws %zu)\n", n_in, out_size, ws_size); grid = -1; return; }
        int dev = 0, cus = 0, per_cu = 0;
        if (hipGetDevice(&dev) != hipSuccess || hipDeviceGetAttribute(&cus, hipDeviceAttributeMultiprocessorCount, dev) != hipSuccess) { grid = -1; return; }
        if (hipFuncSetAttribute((const void*)fwd_kernel, hipFuncAttributeMaxDynamicSharedMemorySize, LDS_BYTES) != hipSuccess) { fprintf(stderr, "kernel_launch: hipFuncSetAttribute failed\n"); grid = -1; return; }
        if (hipOccupancyMaxActiveBlocksPerMultiprocessor(&per_cu, (const void*)fwd_kernel, 512, LDS_BYTES) != hipSuccess || per_cu < 1) { fprintf(stderr, "kernel_launch: occupancy query says %d\n", per_cu); per_cu = 1; }
        (void)hipGetLastError();
        grid = cus;
    }
    if (grid < 0) return;
    if (hipMemsetAsync((char*)d_ws + WS_CTL, 0, CTL_ZERO_BYTES, stream) != hipSuccess) return;
    Args a{};
    for (int i = 0; i < 33; ++i) a.in[i] = (const float*)d_in[i];
    a.out = (float*)d_out; a.ws = (unsigned char*)d_ws;
#if MK_PER_PHASE
    for (int p = 0; p < N_PHASES; ++p) { a.ph_lo = p; a.ph_hi = p + 1; hipLaunchKernelGGL(fwd_kernel, dim3(grid), dim3(512), LDS_BYTES, stream, a); }
#else
    a.ph_lo = 0; a.ph_hi = N_PHASES;
    hipLaunchKernelGGL(fwd_kernel, dim3(grid), dim3(512), LDS_BYTES, stream, a);
#endif
}
```

```cpp
#include <hip/hip_runtime.h>
#include <cstdio>
#include <cstdint>

#ifndef MK_PER_PHASE
#define MK_PER_PHASE 0
#endif

#ifndef PH_MASK
#define PH_MASK 0xFFFFFFFFu
#endif
#define PHON(k) ((PH_MASK >> (k)) & 1u)
#ifndef DBL_MASK
#define DBL_MASK 0u
#endif
#define NREP(k) (((DBL_MASK >> (k)) & 1u) ? 2 : 1)
#ifndef DUM_MASK
#define DUM_MASK 0u
#endif
#define DUM(k) ((DUM_MASK >> (k)) & 1u)
#ifndef ATT_VAR
#define ATT_VAR 0
#endif
#ifndef CONV_IN_LAYER
#define CONV_IN_LAYER 1
#endif
#ifndef CONV_TAIL1
#define CONV_TAIL1 3
#endif
#ifndef CONV_TAIL2
#define CONV_TAIL2 4
#endif
#ifndef ATT_STAGGER
#define ATT_STAGGER 0
#endif
#define DI __device__ __forceinline__
#define LAS __attribute__((address_space(3)))
#define GAS __attribute__((address_space(1)))
typedef unsigned short bf16;
typedef short bf16x8 __attribute__((ext_vector_type(8)));
typedef short s16x4 __attribute__((ext_vector_type(4)));
typedef float f32x2 __attribute__((ext_vector_type(2)));
typedef float f32x4 __attribute__((ext_vector_type(4)));
typedef float f32x16 __attribute__((ext_vector_type(16)));
typedef unsigned u32x2 __attribute__((ext_vector_type(2)));
typedef unsigned u32x4 __attribute__((ext_vector_type(4)));
typedef __bf16 bf16x2_t __attribute__((ext_vector_type(2)));
typedef unsigned long long u64;

constexpr int NB = 8, S = 4096, T = NB * S, D = 1024, DEPTH = 4;
constexpr int NIN = 2560;
constexpr int NE = 32, DFF = 1024;
constexpr int SP = S + 64;
constexpr int ECAP = 32768;
constexpr int ACT_ROWS = 4 * T + NE * 256;
constexpr float LOG2E = 1.4426950408889634f;
constexpr float SCL64 = 0.125f * LOG2E;
constexpr float SCL96 = 0.10206207261596577f * LOG2E;
constexpr float EPS = 1e-6f;

constexpr size_t MiB = 1u << 20;
constexpr size_t WS_CTL = 0, CTL_ZERO_BYTES = 2 * MiB;
constexpr size_t WS_MODS = 2 * MiB, WS_B1P = 3 * MiB, WS_CS64 = 4 * MiB, WS_CS32 = 12 * MiB;
constexpr size_t WS_WIN = 16 * MiB, WS_WOUT = 36 * MiB, WS_NSAW1 = 44 * MiB, WS_MLAQ = 52 * MiB, WS_MLAKV = 53 * MiB;
constexpr size_t WS_W1E = 64 * MiB, WS_W2E = 576 * MiB;
constexpr size_t WS_X = 832 * MiB, WS_H = 960 * MiB;
constexpr size_t WS_QA = 1024 * MiB, WS_KA = 1040 * MiB, WS_VA = 1056 * MiB, WS_QB = 1072 * MiB;
constexpr size_t WS_KCMP = 1104 * MiB, WS_VCMP = 1113 * MiB;
constexpr size_t WS_KSLC = 1122 * MiB, WS_VSLC = 1130 * MiB, WS_KWIN = 1138 * MiB, WS_VWIN = 1146 * MiB;
constexpr size_t WS_CQ = 1154 * MiB, WS_MISC = 1170 * MiB;
constexpr size_t WS_RSTDQ = 1186 * MiB, WS_RSTDKV = 1186 * MiB + 512 * 1024, WS_KR = 1187 * MiB, WS_GATES = 1189 * MiB;
constexpr size_t WS_W2T = 1195 * MiB;
constexpr size_t WS_HID = 1192 * MiB, WS_KC = 1196 * MiB, WS_VC = 1196 * MiB + 512 * 1024;
constexpr size_t WS_QM = 1197 * MiB, WS_KN = 1221 * MiB, WS_VM = 1237 * MiB;
constexpr size_t WS_OA3 = 1253 * MiB, WS_LSEA = 1301 * MiB;
constexpr size_t WS_OCMP = 1303 * MiB, WS_OSLC = 1335 * MiB, WS_OWIN = 1367 * MiB, WS_OC = 1399 * MiB;
constexpr size_t WS_SEL = 1415 * MiB, WS_AMIX = 1416 * MiB;
constexpr size_t WS_IDX = 1480 * MiB, WS_GATEW = 1484 * MiB, WS_TOKSLOT = 1488 * MiB;
constexpr size_t WS_ACT = 1489 * MiB, WS_Y2 = 1761 * MiB, WS_END = 2033 * MiB;
static_assert((size_t)ACT_ROWS * 1024 * 2 <= 272 * MiB, "act rows");
static_assert((size_t)16 * SP * 64 * 2 + 65536 <= 9 * MiB, "kcmp");

constexpr int CW_TMO = 0, CW_FAIL = 2;
constexpr int CW_BAR = 4096;
constexpr int CW_QUEUE = 12288;
constexpr int CW_CONVQ = 13312;
constexpr int CW_CNT = 16384;

constexpr int RING_BYTES = 131072;
constexpr int AUX_OFF = RING_BYTES;
constexpr int MISC_OFF = AUX_OFF + 8192;
constexpr int LDS_BYTES = 147456;

DI unsigned pk2(float lo, float hi) { f32x2 v = {lo, hi}; bf16x2_t b = __builtin_convertvector(v, bf16x2_t); return __builtin_bit_cast(unsigned, b); }
DI float bf2f(unsigned short h) { return __uint_as_float(((unsigned)h) << 16); }
DI float bflo(unsigned w) { return __uint_as_float(w << 16); }
DI float bfhi(unsigned w) { return __uint_as_float(w & 0xffff0000u); }
typedef float f32x2c __attribute__((ext_vector_type(2)));
constexpr float Y2_SCALE = 16.0f, Y2_ISCALE = 1.0f / 16.0f;
DI unsigned pk4_fp8(float a, float b, float c, float d) {
    a = fminf(fmaxf(a * Y2_SCALE, -440.f), 440.f); b = fminf(fmaxf(b * Y2_SCALE, -440.f), 440.f); c = fminf(fmaxf(c * Y2_SCALE, -440.f), 440.f); d = fminf(fmaxf(d * Y2_SCALE, -440.f), 440.f);
    int w = __builtin_amdgcn_cvt_pk_fp8_f32(a, b, 0, false); w = __builtin_amdgcn_cvt_pk_fp8_f32(c, d, w, true); return (unsigned)w; }
DI f32x4 unpk4_fp8(unsigned w) { const f32x2c lo = __builtin_amdgcn_cvt_pk_f32_fp8((int)w, false), hi = __builtin_amdgcn_cvt_pk_f32_fp8((int)w, true); return (f32x4){lo.x, lo.y, hi.x, hi.y}; }
constexpr float W8_SCALE = 64.0f, A8_SCALE = 4.0f;
constexpr int W8_E8M0 = 127 - 6, A8_E8M0 = 127 - 2;
constexpr float H8_SCALE = 8.0f; constexpr int H8_E8M0 = 127 - 3;
DI int lane_id() { return (int)__builtin_amdgcn_mbcnt_hi(~0u, __builtin_amdgcn_mbcnt_lo(~0u, 0u)); }
DI unsigned pk4_fp8s(float a, float b, float c, float d, float sc) {
    a = fminf(fmaxf(a * sc, -440.f), 440.f); b = fminf(fmaxf(b * sc, -440.f), 440.f); c = fminf(fmaxf(c * sc, -440.f), 440.f); d = fminf(fmaxf(d * sc, -440.f), 440.f);
    int w = __builtin_amdgcn_cvt_pk_fp8_f32(a, b, 0, false); w = __builtin_amdgcn_cvt_pk_fp8_f32(c, d, w, true); return (unsigned)w; }
DI float q8s(float x, float sc) {
    const float a = fminf(fmaxf(x * sc, -440.f), 440.f); const int w = __builtin_amdgcn_cvt_pk_fp8_f32(a, a, 0, false);
    const f32x2c r = __builtin_amdgcn_cvt_pk_f32_fp8(w, false); return r.x; }
template <int CTRL> DI float dpp_perm(float v) { return __builtin_bit_cast(float, __builtin_amdgcn_update_dpp(0, __builtin_bit_cast(int, v), CTRL, 0xf, 0xf, false)); }
DI float row_sum16(float v) { v += dpp_perm<0xB1>(v); v += dpp_perm<0x4E>(v); v += dpp_perm<0x141>(v); v += dpp_perm<0x140>(v); return v; }
DI float wave_sum(float v) {
    v = row_sum16(v);
    const float r0 = __builtin_bit_cast(float, __builtin_amdgcn_readlane(__builtin_bit_cast(int, v), 0)), r1 = __builtin_bit_cast(float, __builtin_amdgcn_readlane(__builtin_bit_cast(int, v), 16));
    const float r2 = __builtin_bit_cast(float, __builtin_amdgcn_readlane(__builtin_bit_cast(int, v), 32)), r3 = __builtin_bit_cast(float, __builtin_amdgcn_readlane(__builtin_bit_cast(int, v), 48));
    return (r0 + r1) + (r2 + r3);
}
DI float fast_exp2(float x) { return __builtin_amdgcn_exp2f(x); }
DI float fast_rcp(float x) { return __builtin_amdgcn_rcpf(x); }
DI float sigmoidf_(float x) { return fast_rcp(1.0f + fast_exp2(-x * LOG2E)); }
#define RLX_AGENT __ATOMIC_RELAXED, __HIP_MEMORY_SCOPE_AGENT

#define XB_TMO      128
#define XB_XCNT(j)  (256  + 64 * (j))
#define XB_XSUB(j)  (1280 + 64 * (j))
#define XB_XGEN(j)  (2304 + 64 * (j))
#define XB_TOP      3328
#define XB_TOPGEN   3392
#define XCD_BAR_WORDS 3456
#define XB_SPIN_CAP (1u << 22)
DI unsigned xb_ld(unsigned* p)              { return __hip_atomic_load(p, __ATOMIC_RELAXED, __HIP_MEMORY_SCOPE_AGENT); }
DI unsigned xb_add(unsigned* p, unsigned v) { return __hip_atomic_fetch_add(p, v, __ATOMIC_RELAXED, __HIP_MEMORY_SCOPE_AGENT); }
DI unsigned xb_xcc_id() { return (unsigned)__builtin_amdgcn_s_getreg((3 << 11) | 20) & 0xFu; }
#define XB_SPIN(cond, bar) do { unsigned _sp = 0; while (cond) { __builtin_amdgcn_s_sleep(1); \
    if ((++_sp & 255u) == 0u) { if (xb_ld(&(bar)[XB_TMO])) break; if (_sp > XB_SPIN_CAP) { atomicAdd(&(bar)[XB_TMO], 1u); break; } } } } while (0)
struct XcdBarrier { unsigned* bar; unsigned x; volatile LAS unsigned* st; };
DI XcdBarrier xcd_barrier_post(unsigned* bar, volatile LAS unsigned* st) {
    XcdBarrier b; b.bar = bar; b.x = xb_xcc_id(); b.st = st;
    if (threadIdx.x == 0) (void)xb_add(&bar[XB_XCNT(b.x)], 1u);
    return b;
}
DI void xcd_barrier_complete(unsigned* bar, unsigned x, unsigned& nloc, unsigned& nx) {
    const unsigned G = gridDim.x * gridDim.y * gridDim.z;
    unsigned sum, cnt, mine, sp = 0u;
    for (;;) {
        sum = 0u; cnt = 0u; mine = 0u;
#pragma unroll
        for (unsigned j = 0; j < 16; ++j) { const unsigned c = xb_ld(&bar[XB_XCNT(j)]); sum += c; cnt += (c > 0u) ? 1u : 0u; mine = (j == x) ? c : mine; }
        if (sum == G) break;
        __builtin_amdgcn_s_sleep(1);
        if ((++sp & 255u) == 0u) { if (xb_ld(&bar[XB_TMO])) break; if (sp > XB_SPIN_CAP) { atomicAdd(&bar[XB_TMO], 1u); break; } }
    }
    nloc = mine > 0u ? mine : 1u; nx = cnt > 0u ? cnt : 1u;
}
DI void xcd_barrier(const XcdBarrier& b) {
    asm volatile("s_waitcnt vmcnt(0)" ::: "memory");
    __syncthreads();
    unsigned* bar = b.bar; asm volatile("" : "+s"(bar));
    if (threadIdx.x == 0) {
        __builtin_amdgcn_s_waitcnt(0);
        unsigned nloc = b.st[0], nx = b.st[1];
        if (nloc == 0u) { xcd_barrier_complete(bar, b.x, nloc, nx); b.st[0] = nloc; b.st[1] = nx; }
        const unsigned old = xb_add(&bar[XB_XSUB(b.x)], 1u);
        const unsigned gen = old / nloc;
        if (old + 1u == (gen + 1u) * nloc) {
            __builtin_amdgcn_fence(__ATOMIC_RELEASE, "agent");
            asm volatile("s_waitcnt vmcnt(0)" ::: "memory");
            const unsigned og = xb_add(&bar[XB_TOP], 1u);
            const unsigned tg = og / nx;
            if (og + 1u == (tg + 1u) * nx) xb_add(&bar[XB_TOPGEN], 1u);
            else XB_SPIN(xb_ld(&bar[XB_TOPGEN]) == tg, bar);
            __builtin_amdgcn_fence(__ATOMIC_ACQUIRE, "agent");
            xb_add(&bar[XB_XGEN(b.x)], 1u);
            asm volatile("s_waitcnt vmcnt(0)" ::: "memory");
        } else {
            XB_SPIN(xb_ld(&bar[XB_XGEN(b.x)]) == gen, bar);
            __builtin_amdgcn_fence(__ATOMIC_ACQUIRE, "agent");
            asm volatile("s_waitcnt vmcnt(0)" ::: "memory");
        }
    }
    __syncthreads();
}

struct Args {
    const float* in[33];
    float* out;
    unsigned char* ws;
    int ph_lo, ph_hi;
};
enum { I_X = 0, I_C, I_POS, I_WADA, I_BADA, I_G1, I_G2, I_WIN, I_POSK, I_POSV, I_W1K, I_B1K, I_W2K, I_B2K, I_W1V, I_B1V, I_W2V, I_B2V,
       I_GQ, I_GKV, I_WQUP, I_WKVUP, I_GOA, I_GOB, I_GOC, I_WOUT, I_WR, I_BR, I_WE1, I_BE1, I_WE2, I_BE2, I_GF };

struct Ctx {
    LAS unsigned char* lds;
    const Args* a;
    unsigned char* ws;
    int tid, lane, wave, blk, G, vcu;
    size_t dofs; int dcnt;
};
DI const float* ginp(const Ctx& F, int i) { return (const float*)(GAS const float*)(F.a->in[i]); }
DI float* gout(const Ctx& F) { return (float*)(GAS float*)(F.a->out); }

namespace pg8 {
constexpr int BM = 256, BK = 64, HALF = 128, HTB = HALF * BK * 2;
DI int lds_byte(int r, int c) { const int st = (r >> 4) * 2 + (c >> 5), rr = r & 15, cc = c & 31, ob = rr * 64 + cc * 2; return st * 1024 + (ob ^ (((ob >> 9) & 1) << 5)); }
DI void stage_rc(int b, int& R, int& C) { const int st = b / 1024, sb = b % 1024, swz = sb ^ (((sb >> 9) & 1) << 5); R = (st >> 1) * 16 + swz / 64; C = (st & 1) * 32 + (swz % 64) / 2; }
DI int perm32(int rho) { const int n = rho >> 4, i = rho & 15; return 8 * (i >> 2) + 4 * n + (i & 3); }
struct Unit { const char* a; const char* b; int pm, pn, e, ml; };

template <class Epi, class Sched, bool GATHER, bool FP8 = false>
DI void gemm_phase(LAS unsigned char* lds, const int lda, const int K, const Sched& S, const Epi& E) {
    typedef int i32x4_ __attribute__((ext_vector_type(4))); typedef int i32x8_ __attribute__((ext_vector_type(8)));
    int tid_ = threadIdx.x; asm volatile("" : "+v"(tid_));
    const int tid = tid_, wid = __builtin_amdgcn_readfirstlane(tid >> 6), lane = tid & 63, wr = wid >> 2, wc = wid & 3, fr = lane & 15, fq = lane >> 4;
    const int nt = K / BK;
    int Rr[2], Cc[2]; unsigned voffB[2];
#pragma unroll
    for (int i = 0; i < 2; ++i) { int R, C; stage_rc(tid * 16 + i * 8192, R, C); Rr[i] = R; Cc[i] = C; const int Rb = Epi::PERM ? ((R & ~31) + perm32(R & 31)) : R; voffB[i] = (unsigned)(Rb * K + C) * 2u; }
    const size_t kstep = (size_t)(BK * 2);
    const size_t hstepB = (size_t)HALF * K * 2;
    const unsigned ldsw = (unsigned)wid * 1024u;
    const int aoff = lds_byte(wr * 64 + fr, fq * 8), boff = lds_byte(wc * 32 + fr, fq * 8);
#define PG8_SA(b, h) (((b) * 2 + (h)) * HTB)
#define PG8_SB(b, h) ((4 + (b) * 2 + (h)) * HTB)
#define PG8_STAGE_B(bufoff, gbase) do { _Pragma("unroll") for (int _i = 0; _i < 2; ++_i) \
        __builtin_amdgcn_global_load_lds((const unsigned*)((const char*)(gbase) + (size_t)_i * 64 * K * 2 + voffB[0]), (LAS unsigned*)(lds + (bufoff) + ldsw + _i * 8192), 16, 0, 0); } while (0)
#define PG8_STAGE_A(bufoff, gbase, v, h) do { _Pragma("unroll") for (int _i = 0; _i < 2; ++_i) { \
        if constexpr (GATHER) __builtin_amdgcn_global_load_lds((const unsigned*)((const char*)(gbase) + (v)[h][_i]), (LAS unsigned*)(lds + (bufoff) + ldsw + _i * 8192), 16, 0, 0); \
        else __builtin_amdgcn_global_load_lds((const unsigned*)((const char*)(gbase) + (size_t)((h) * 128 + _i * 64) * lda * 2 + (v)[0][0]), (LAS unsigned*)(lds + (bufoff) + ldsw + _i * 8192), 16, 0, 0); } } while (0)
#define PG8_SETOFF(v, u) do { _Pragma("unroll") for (int _h = 0; _h < 2; ++_h) _Pragma("unroll") for (int _i = 0; _i < 2; ++_i) { \
        if constexpr (GATHER) (v)[_h][_i] = S.gather_off((u), _h * 128 + Rr[_i]) + (unsigned)Cc[_i] * 2u; \
        else (v)[_h][_i] = (unsigned)((_h * 128 + Rr[_i]) * lda + Cc[_i]) * 2u; } } while (0)
#define PG8_LDA(dst, b, h) do { _Pragma("unroll") for (int m = 0; m < 4; ++m) { const i32x4_ lo_ = *(const LAS i32x4_*)(lds + PG8_SA(b, h) + aoff + m * 2048), hi_ = *(const LAS i32x4_*)(lds + PG8_SA(b, h) + aoff + m * 2048 + 1024); dst[m] = __builtin_shufflevector(lo_, hi_, 0, 1, 2, 3, 4, 5, 6, 7); } } while (0)
#define PG8_LDB(dst, b, h) do { _Pragma("unroll") for (int n = 0; n < 2; ++n) { const i32x4_ lo_ = *(const LAS i32x4_*)(lds + PG8_SB(b, h) + boff + n * 2048), hi_ = *(const LAS i32x4_*)(lds + PG8_SB(b, h) + boff + n * 2048 + 1024); dst[n] = __builtin_shufflevector(lo_, hi_, 0, 1, 2, 3, 4, 5, 6, 7); } } while (0)
#define PG8_H0(x) __builtin_bit_cast(bf16x8, __builtin_shufflevector((x), (x), 0, 1, 2, 3))
#define PG8_H1(x) __builtin_bit_cast(bf16x8, __builtin_shufflevector((x), (x), 4, 5, 6, 7))
#define PG8_MMA(ai, bj, At, Bt) do { __builtin_amdgcn_s_setprio(1); \
        if constexpr (FP8) { _Pragma("unroll") for (int m = 0; m < 4; ++m) _Pragma("unroll") for (int n = 0; n < 2; ++n) \
            asm volatile("v_mfma_scale_f32_16x16x128_f8f6f4 %0, %1, %2, %0, %3, %4 op_sel_hi:[0,0,0]" : "+v"(acc[ai][bj][m][n]) : "v"(Bt[n]), "v"(At[m]), "v"(scw_), "v"(sca_)); } \
        else { _Pragma("unroll") for (int m = 0; m < 4; ++m) _Pragma("unroll") for (int n = 0; n < 2; ++n) { \
            acc[ai][bj][m][n] = __builtin_amdgcn_mfma_f32_16x16x32_bf16(PG8_H0(Bt[n]), PG8_H0(At[m]), acc[ai][bj][m][n], 0, 0, 0); \
            acc[ai][bj][m][n] = __builtin_amdgcn_mfma_f32_16x16x32_bf16(PG8_H1(Bt[n]), PG8_H1(At[m]), acc[ai][bj][m][n], 0, 0, 0); } } \
        __builtin_amdgcn_s_setprio(0); } while (0)
#define PG8_WAIT_V(n) asm volatile("s_waitcnt vmcnt(" #n ")" ::: "memory")
#define PG8_WAIT_L(n) asm volatile("s_waitcnt lgkmcnt(" #n ")" ::: "memory")
#define PG8_BAR __builtin_amdgcn_s_barrier()
#define PG8_SCHED __builtin_amdgcn_sched_barrier(0)
    Unit cur, nxt; int ui = 0;
    if (!S.next(0, cur)) return;
    f32x4 acc[2][2][4][2];
#pragma unroll
    for (int a = 0; a < 2; ++a)
#pragma unroll
        for (int b = 0; b < 2; ++b)
#pragma unroll
            for (int m = 0; m < 4; ++m)
#pragma unroll
                for (int n = 0; n < 2; ++n) acc[a][b][m][n] = (f32x4){0.f, 0.f, 0.f, 0.f};
    int scw_ = W8_E8M0, sca_ = A8_E8M0; if constexpr (FP8) sca_ = Epi::A_E8M0;
    i32x8_ At[4], B0[2], B1[2];
    unsigned vA[2][2], vAn[2][2];
    PG8_SETOFF(vA, cur);
    const char* cA = cur.a; const char* cB = cur.b;
    PG8_STAGE_B(PG8_SB(0, 0), cB); PG8_STAGE_B(PG8_SB(0, 1), cB + hstepB); PG8_STAGE_A(PG8_SA(0, 0), cA, vA, 0); PG8_STAGE_A(PG8_SA(0, 1), cA, vA, 1);
    if (wr == 1) PG8_BAR;
    PG8_WAIT_V(2); PG8_BAR;
    PG8_STAGE_B(PG8_SB(1, 0), cB + kstep); PG8_STAGE_A(PG8_SA(1, 0), cA + kstep, vA, 0); PG8_STAGE_B(PG8_SB(1, 1), cB + hstepB + kstep);
    PG8_WAIT_V(6); PG8_BAR;
    for (;;) {
        const bool has_next = S.next(ui + 1, nxt);
        if constexpr (GATHER) {
            if (has_next) {
#pragma unroll
                for (int h = 0; h < 2; ++h)
#pragma unroll
                    for (int i = 0; i < 2; ++i) vAn[h][i] = S.gather_raw(nxt, h * 128 + Rr[i]);
            }
        }
        const char* nA = has_next ? nxt.a : cA; const char* nB = has_next ? nxt.b : cB;
#pragma unroll 1
        for (int t = 0; t < nt; t += 2) {
            const bool last = (t == nt - 2);
            const char* a1 = cA + (size_t)(t + 1) * kstep;
            const char* a2 = last ? nA : cA + (size_t)(t + 2) * kstep; const char* b2 = last ? nB : cB + (size_t)(t + 2) * kstep;
            const char* a3 = a2 + kstep; const char* b3 = b2 + kstep;
            unsigned v2[2][2];
#pragma unroll
            for (int h = 0; h < 2; ++h)
#pragma unroll
                for (int i = 0; i < 2; ++i) v2[h][i] = vA[h][i];
            if constexpr (GATHER) {
                if (last && has_next) {
#pragma unroll
                    for (int h = 0; h < 2; ++h)
#pragma unroll
                        for (int i = 0; i < 2; ++i) { vAn[h][i] = vAn[h][i] * (unsigned)(lda * 2) + (unsigned)Cc[i] * 2u; v2[h][i] = vAn[h][i]; }
                }
            }
            PG8_LDB(B0, 0, 0); PG8_LDB(B1, 0, 1); PG8_SCHED; PG8_LDA(At, 0, 0); PG8_STAGE_A(PG8_SA(1, 1), a1, vA, 1);
            PG8_WAIT_V(8); PG8_WAIT_L(0); PG8_BAR; PG8_MMA(0, 0, At, B0); PG8_MMA(0, 1, At, B1); PG8_BAR; PG8_SCHED;
            PG8_LDA(At, 0, 1); PG8_STAGE_B(PG8_SB(0, 0), b2); PG8_STAGE_B(PG8_SB(0, 1), b2 + hstepB); PG8_STAGE_A(PG8_SA(0, 0), a2, v2, 0);
            PG8_WAIT_V(8); PG8_WAIT_L(0); PG8_BAR; PG8_MMA(1, 0, At, B0); PG8_MMA(1, 1, At, B1); PG8_BAR; PG8_SCHED;
            PG8_LDB(B0, 1, 0); PG8_LDB(B1, 1, 1); PG8_SCHED; PG8_LDA(At, 1, 0); PG8_STAGE_A(PG8_SA(0, 1), a2, v2, 1);
            PG8_WAIT_V(8); PG8_WAIT_L(0); PG8_BAR; PG8_MMA(0, 0, At, B0); PG8_MMA(0, 1, At, B1); PG8_BAR; PG8_SCHED;
            PG8_LDA(At, 1, 1); PG8_STAGE_B(PG8_SB(1, 0), b3); PG8_STAGE_B(PG8_SB(1, 1), b3 + hstepB); PG8_STAGE_A(PG8_SA(1, 0), a3, v2, 0);
            PG8_WAIT_V(8); PG8_WAIT_L(0); PG8_BAR; PG8_MMA(1, 0, At, B0); PG8_MMA(1, 1, At, B1); PG8_BAR; PG8_SCHED;
        }
        if (wr == 0) PG8_BAR;
        if constexpr (FP8) asm volatile("s_nop 15\n\ts_nop 15" ::: "memory");
        if constexpr (!Epi::AFTER_DRAIN) { int fr_ = fr, fq_ = fq; asm volatile("" : "+v"(fr_), "+v"(fq_)); E(acc, cur, wr, wc, fr_, fq_); }
        if (!has_next) break;
#pragma unroll
        for (int a = 0; a < 2; ++a)
#pragma unroll
            for (int b = 0; b < 2; ++b)
#pragma unroll
                for (int m = 0; m < 4; ++m)
#pragma unroll
                    for (int n = 0; n < 2; ++n) acc[a][b][m][n] = (f32x4){0.f, 0.f, 0.f, 0.f};
        cur = nxt; cA = nA; cB = nB; ++ui;
        if constexpr (GATHER) {
#pragma unroll
            for (int h = 0; h < 2; ++h)
#pragma unroll
                for (int i = 0; i < 2; ++i) vA[h][i] = vAn[h][i];
        }
        if (wr == 1) PG8_BAR;
    }
    PG8_WAIT_V(0);
    PG8_BAR;
    if constexpr (Epi::AFTER_DRAIN) { int fr_ = fr, fq_ = fq; asm volatile("" : "+v"(fr_), "+v"(fq_)); E.fused(acc, cur, wr, wc, fr_, fq_, lds, wid, lane); }
#undef PG8_SA
#undef PG8_SB
#undef PG8_STAGE_A
#undef PG8_STAGE_B
#undef PG8_SETOFF
#undef PG8_LDA
#undef PG8_LDB
#undef PG8_MMA
#undef PG8_H0
#undef PG8_H1
#undef PG8_WAIT_V
#undef PG8_WAIT_L
#undef PG8_BAR
#undef PG8_SCHED
}
}
using pg8::Unit;
typedef f32x4 AccT[2][2][4][2];

struct SchedGrid {
    const char* A; const char* B; int lda, K, nN, nwg, G, c;
    DI bool next(int i, Unit& u) const {
        const int L = i * G + c; if (L >= nwg) return false;
        u.pm = L / nN; u.pn = L % nN; u.e = 0; u.ml = 0;
        u.a = A + (size_t)u.pm * 256 * lda * 2; u.b = B + (size_t)u.pn * 256 * K * 2; return true;
    }
    DI unsigned gather_off(const Unit&, int) const { return 0u; }
    DI unsigned gather_raw(const Unit&, int) const { return 0u; }
};
struct SchedCmp {
    const char* KCMP; const char* VCMP; const char* W; int G, c;
    DI bool next(int i, Unit& u) const {
        const int L = i * G + c; if (L >= 32) return false;
        const int kv = L >> 4, bg = L & 15;
        u.pm = L; u.pn = 0; u.e = kv; u.ml = 0;
        u.a = (kv ? VCMP : KCMP) + (size_t)bg * SP * 64 * 2; u.b = W + (size_t)kv * 256 * 2048 * 2; return true;
    }
    DI unsigned gather_off(const Unit&, int) const { return 0u; }
    DI unsigned gather_raw(const Unit&, int) const { return 0u; }
};
struct SchedMla {
    const char* CQ; const char* MISC; const char* WQ; const char* WKV; int G, c;
    DI bool next(int i, Unit& u) const {
        const int L = i * G + c; if (L >= 512) return false;
        const int which = L >> 8, r = L & 255;
        u.pm = r >> 1; u.pn = r & 1; u.e = which; u.ml = 0;
        u.a = (which ? MISC : CQ) + (size_t)u.pm * 256 * 256 * 2; u.b = (which ? WKV : WQ) + (size_t)u.pn * 256 * 256 * 2; return true;
    }
    DI unsigned gather_off(const Unit&, int) const { return 0u; }
    DI unsigned gather_raw(const Unit&, int) const { return 0u; }
};
template <int NT, bool GATHERED>
struct SchedMoe {
    const LAS int* tb; const LAS int* cnt; const char* A; const char* W; const int* IDX; int total, G, c;
    DI bool next(int i, Unit& u) const {
        const int L = i * G + c; if (L >= total) return false;
        const int mtg = L / NT; u.pn = L % NT;
        const int ln_ = threadIdx.x & 63;
        const int e = __popcll(__ballot(ln_ < 32 && tb[ln_ & 31] <= mtg)) - 1;
        u.e = e; u.ml = mtg - tb[e]; u.pm = mtg;
        u.a = GATHERED ? A : A + (size_t)mtg * 256 * 1024 * 2;
        u.b = W + ((size_t)e * NT * 256 + (size_t)u.pn * 256) * 1024 * 2; return true;
    }
    DI unsigned gather_off(const Unit& u, int row) const {
        const int pos = u.ml * 256 + row; const int tok = (pos < cnt[u.e]) ? IDX[u.e * ECAP + pos] : 0;
        return (unsigned)tok * 2048u;
    }
    DI unsigned gather_raw(const Unit& u, int row) const {
        const int pos = u.ml * 256 + row;
        return (unsigned)IDX[u.e * ECAP + (pos < cnt[u.e] ? pos : 0)];
    }
};

struct SchedMoe1F8 {
    static constexpr bool HOOK = false;
    const LAS int* tb; const LAS int* cnt; const char* A; const char* W; const int* IDX; int total, G, c;
    DI bool next(int i, Unit& u) const {
        const int L = i * G + c; if (L >= total) return false;
        const int mtg = L >> 3; u.pn = L & 7;
        const int ln_ = lane_id();
        const int e = __popcll(__ballot(ln_ < 32 && tb[ln_ & 31] <= mtg)) - 1;
        u.e = e; u.ml = mtg - tb[e]; u.pm = mtg;
        u.a = A; u.b = W + ((size_t)e * 2048 + (size_t)u.pn * 256) * 1024; return true;
    }
    DI unsigned gather_raw(const Unit& u, int row) const { const int pos = u.ml * 256 + row; return (unsigned)IDX[u.e * ECAP + (pos < cnt[u.e] ? pos : 0)]; }
    DI unsigned gather_off(const Unit& u, int row) const { return gather_raw(u, row) * 1024u; }
};
struct SchedMoe2F8 {
    static constexpr bool HOOK = false;
    const LAS int* tb; const char* A; const char* W; int total, G, c;
    DI bool next(int i, Unit& u) const {
        const int L = i * G + c; if (L >= total) return false;
        const int mtg = L >> 2; u.pn = L & 3;
        const int ln_ = lane_id();
        const int e = __popcll(__ballot(ln_ < 32 && tb[ln_ & 31] <= mtg)) - 1;
        u.e = e; u.ml = mtg - tb[e]; u.pm = mtg;
        u.a = A + (size_t)mtg * 256 * 1024; u.b = W + ((size_t)e * 1024 + (size_t)u.pn * 256) * 1024; return true;
    }
    DI unsigned gather_off(const Unit&, int) const { return 0u; }
    DI unsigned gather_raw(const Unit&, int) const { return 0u; }
};

DI void rot4(f32x4& v0, f32x4& v1, const f32x4 c, const f32x4 s) {
    const float a0 = v0[0], b0 = v0[1], a1 = v0[2], b1 = v0[3], a2 = v1[0], b2 = v1[1], a3 = v1[2], b3 = v1[3];
    v0[0] = a0 * c[0] - b0 * s[0]; v0[1] = b0 * c[0] + a0 * s[0];
    v0[2] = a1 * c[1] - b1 * s[1]; v0[3] = b1 * c[1] + a1 * s[1];
    v1[0] = a2 * c[2] - b2 * s[2]; v1[1] = b2 * c[2] + a2 * s[2];
    v1[2] = a3 * c[3] - b3 * s[3]; v1[3] = b3 * c[3] + a3 * s[3];
}
DI u32x4 pack8(const f32x4 v0, const f32x4 v1) { u32x4 w; w.x = pk2(v0[0], v0[1]); w.y = pk2(v0[2], v0[3]); w.z = pk2(v1[0], v1[1]); w.w = pk2(v1[2], v1[3]); return w; }

struct EpiWin {
    static constexpr bool PERM = true, AFTER_DRAIN = false;
    unsigned char* ws; const float* CS64; const float* CS32;
    DI void operator()(const AccT& acc, const Unit& u, int wr, int wc, int fr, int fq) const {
#pragma unroll
        for (int bj = 0; bj < 2; ++bj) {
            const int w0 = bj * 128 + wc * 32;
            size_t off; int ld, dcol, mode = 0, gm = 0, g = 0; float sc = 1.f;
            switch (u.pn) {
                case 0: off = WS_QA; ld = 256; dcol = w0; mode = 1; sc = SCL64; break;
                case 1: off = WS_KA; ld = 256; dcol = w0; mode = 1; break;
                case 2: off = WS_VA; ld = 256; dcol = w0; break;
                case 3: off = WS_QB; ld = 512; dcol = w0; mode = 1; sc = SCL64; break;
                case 4: off = WS_QB; ld = 512; dcol = 256 + w0; mode = 1; sc = SCL64; break;
                case 5: off = (w0 < 128) ? WS_KCMP : WS_VCMP; ld = 64; gm = 1; g = (w0 & 127) >> 6; dcol = w0 & 63; break;
                case 6: off = (w0 < 128) ? WS_KSLC : WS_VSLC; ld = 128; dcol = w0 & 127; mode = (w0 < 128) ? 1 : 0; break;
                case 7: off = (w0 < 128) ? WS_KWIN : WS_VWIN; ld = 128; dcol = w0 & 127; mode = (w0 < 128) ? 1 : 0; break;
                case 8: off = WS_CQ; ld = 256; dcol = w0; break;
                default: if (w0 == 128) { off = WS_KR; ld = 32; dcol = 0; mode = 2; } else { off = WS_MISC; ld = 256; dcol = w0; } break;
            }
            bf16* base = (bf16*)(ws + off);
            const int i0 = 16 * (wc & 1) + 4 * fq;
#pragma unroll
            for (int ai = 0; ai < 2; ++ai) {
                f32x4 cc[4], sn[4];
                if (mode) {
#pragma unroll
                    for (int m = 0; m < 4; ++m) {
                        const int row = u.pm * 256 + ai * 128 + wr * 64 + m * 16 + fr;
                        const float* cs = (mode == 1) ? CS64 + (size_t)row * 64 + i0 : CS32 + (size_t)row * 32 + 4 * fq;
                        cc[m] = *(const f32x4*)cs; sn[m] = *(const f32x4*)(cs + (mode == 1 ? 32 : 16));
                    }
                }
#pragma unroll
                for (int m = 0; m < 4; ++m) {
                    const int row = u.pm * 256 + ai * 128 + wr * 64 + m * 16 + fr;
                    f32x4 v0 = acc[ai][bj][m][0], v1 = acc[ai][bj][m][1];
                    if (mode) rot4(v0, v1, cc[m], sn[m]);
                    v0 = v0 * sc; v1 = v1 * sc;
                    const size_t drow = gm ? (size_t)(((row >> 12) * 2 + g) * SP + (row & 4095)) : (size_t)row;
                    *(u32x4*)(base + drow * ld + dcol + 8 * fq) = pack8(v0, v1);
                }
            }
        }
    }
};
struct EpiCmp {
    static constexpr bool PERM = true, AFTER_DRAIN = true;
    const float* B1P; const bf16* W2T; const float *B2K, *B2V; bf16 *KC, *VC; const float* CS64;
    DI void fused(const AccT& acc, const Unit& u, int wr, int wc, int fr, int fq, LAS unsigned char* lds, int wid, int lane) const {
        constexpr int HST = 528;
        const int kv = u.e, bg = u.pm & 15;
#pragma unroll
        for (int bj = 0; bj < 2; ++bj) {
            const int col = bj * 128 + wc * 32 + 8 * fq;
            const f32x4 b0 = *(const f32x4*)(B1P + kv * 256 + col), b1 = *(const f32x4*)(B1P + kv * 256 + col + 4);
#pragma unroll
            for (int ai = 0; ai < 2; ++ai)
#pragma unroll
                for (int m = 0; m < 4; ++m) {
                    const int rl = ai * 128 + wr * 64 + m * 16 + fr;
                    f32x4 v0 = acc[ai][bj][m][0] + b0, v1 = acc[ai][bj][m][1] + b1;
#pragma unroll
                    for (int j = 0; j < 4; ++j) {
                        float x = v0[j]; float z = 0.7978845608028654f * (x + 0.044715f * x * x * x); v0[j] = x * sigmoidf_(2.f * z);
                        x = v1[j]; z = 0.7978845608028654f * (x + 0.044715f * x * x * x); v1[j] = x * sigmoidf_(2.f * z);
                    }
                    *(LAS u32x4*)(lds + rl * HST + col * 2) = pack8(v0, v1);
                }
        }
        asm volatile("s_waitcnt lgkmcnt(0)\n\ts_barrier" ::: "memory");
        const int r32 = lane & 31, hh = lane >> 5;
        f32x16 out0 = {0.f, 0.f, 0.f, 0.f, 0.f, 0.f, 0.f, 0.f, 0.f, 0.f, 0.f, 0.f, 0.f, 0.f, 0.f, 0.f}, out1 = out0;
        const bf16* w2 = W2T + (size_t)kv * 64 * 256;
#pragma unroll 4
        for (int ks = 0; ks < 16; ++ks) {
            const bf16x8 a = *(const LAS bf16x8*)(lds + (32 * wid + r32) * HST + (16 * ks + 8 * hh) * 2);
            const bf16x8 bq0 = *(const bf16x8*)(w2 + (size_t)r32 * 256 + 16 * ks + 8 * hh), bq1 = *(const bf16x8*)(w2 + (size_t)(32 + r32) * 256 + 16 * ks + 8 * hh);
            out0 = __builtin_amdgcn_mfma_f32_32x32x16_bf16(a, bq0, out0, 0, 0, 0); out1 = __builtin_amdgcn_mfma_f32_32x32x16_bf16(a, bq1, out1, 0, 0, 0);
        }
        const float* b2 = kv ? B2V : B2K;
        const float bb0 = b2[r32], bb1 = b2[32 + r32];
        const int b = bg >> 1;
#pragma unroll
        for (int i = 0; i < 16; ++i) {
            const int c = 32 * wid + 8 * (i >> 2) + 4 * hh + (i & 3);
            const size_t row = (size_t)bg * 256 + c;
            float x1 = out0[i] + bb0, x2 = out1[i] + bb1;
            if (c == 255) { x1 = 0.f; x2 = 0.f; }
            if (kv == 0) {
                const int tokr = (b * S + 16 * c + 31) & (T - 1);
                const float cs = CS64[(size_t)tokr * 64 + r32], sn = CS64[(size_t)tokr * 64 + 32 + r32];
                *(unsigned*)(KC + row * 64 + 2 * r32) = pk2(x1 * cs - x2 * sn, x2 * cs + x1 * sn);
            } else {
                VC[row * 64 + r32] = (bf16)(pk2(x1, 0.f) & 0xffffu); VC[row * 64 + 32 + r32] = (bf16)(pk2(x2, 0.f) & 0xffffu);
            }
        }
    }
};
struct EpiMla {
    static constexpr bool PERM = true, AFTER_DRAIN = false;
    bf16 *QM, *KN, *VM; const bf16 *CQ, *MISC; const float* CS32;
    DI void operator()(const AccT& acc, const Unit& u, int wr, int wc, int fr, int fq) const {
        float rstd[2][4];
#pragma unroll
        for (int ai = 0; ai < 2; ++ai)
#pragma unroll
            for (int m = 0; m < 4; ++m) {
                const int row = u.pm * 256 + ai * 128 + wr * 64 + m * 16 + fr;
                float ss = 0.f;
                if (u.e == 0) {
#pragma unroll
                    for (int c = 0; c < 8; ++c) { const u32x4 w = *(const u32x4*)(CQ + (size_t)row * 256 + fq * 64 + 8 * c);
                        ss += bflo(w.x) * bflo(w.x) + bfhi(w.x) * bfhi(w.x) + bflo(w.y) * bflo(w.y) + bfhi(w.y) * bfhi(w.y) + bflo(w.z) * bflo(w.z) + bfhi(w.z) * bfhi(w.z) + bflo(w.w) * bflo(w.w) + bfhi(w.w) * bfhi(w.w); }
                } else {
#pragma unroll
                    for (int c = 0; c < 4; ++c) { const u32x4 w = *(const u32x4*)(MISC + (size_t)row * 256 + fq * 32 + 8 * c);
                        ss += bflo(w.x) * bflo(w.x) + bfhi(w.x) * bfhi(w.x) + bflo(w.y) * bflo(w.y) + bfhi(w.y) * bfhi(w.y) + bflo(w.z) * bflo(w.z) + bfhi(w.z) * bfhi(w.z) + bflo(w.w) * bflo(w.w) + bfhi(w.w) * bfhi(w.w); }
                }
                ss += __shfl_xor(ss, 16); ss += __shfl_xor(ss, 32);
                rstd[ai][m] = rsqrtf(ss * (u.e == 0 ? (1.0f / 256.0f) : (1.0f / 128.0f)) + EPS);
            }
#pragma unroll
        for (int bj = 0; bj < 2; ++bj) {
            const int gc = u.pn * 256 + bj * 128 + wc * 32;
            bf16* base; int ld, dcol, rope = 0; float sc = 1.f;
            if (u.e == 0) { if (gc >= 384) continue; rope = ((gc >> 5) % 3) == 2; base = QM; ld = 384; dcol = gc; sc = SCL96; }
            else { const int head = gc >> 7, part = (gc & 127) >> 6, o = gc & 63; base = part ? VM : KN; ld = 256; dcol = head * 64 + o; }
#pragma unroll
            for (int ai = 0; ai < 2; ++ai) {
                f32x4 cc[4], sn[4];
                if (rope) {
#pragma unroll
                    for (int m = 0; m < 4; ++m) { const float* cs = CS32 + (size_t)(u.pm * 256 + ai * 128 + wr * 64 + m * 16 + fr) * 32 + 4 * fq; cc[m] = *(const f32x4*)cs; sn[m] = *(const f32x4*)(cs + 16); }
                }
#pragma unroll
                for (int m = 0; m < 4; ++m) {
                    const int row = u.pm * 256 + ai * 128 + wr * 64 + m * 16 + fr;
                    const float r = rstd[ai][m] * sc;
                    f32x4 v0 = acc[ai][bj][m][0] * r, v1 = acc[ai][bj][m][1] * r;
                    if (rope) rot4(v0, v1, cc[m], sn[m]);
                    *(u32x4*)(base + (size_t)row * ld + dcol + 8 * fq) = pack8(v0, v1);
                }
            }
        }
    }
};
struct EpiWout {
    static constexpr bool PERM = false, AFTER_DRAIN = false;
    bf16* X; const float* GT; size_t dofs;
    DI void operator()(const AccT& acc, const Unit& u, int wr, int wc, int fr, int fq) const {
        const int b = (u.pm * 256) >> 12;
        const int col0 = u.pn * 256 + wc * 32 + 4 * fq;
#pragma unroll
        for (int bj = 0; bj < 2; ++bj) {
#pragma unroll
            for (int n = 0; n < 2; ++n) {
                u32x2 xo[2][4];
                const f32x4 gt = *(const f32x4*)(GT + (size_t)b * 6144 + col0 + bj * 128 + n * 16);
#pragma unroll
                for (int ai = 0; ai < 2; ++ai)
#pragma unroll
                    for (int m = 0; m < 4; ++m) xo[ai][m] = *(const u32x2*)(X + (size_t)(u.pm * 256 + ai * 128 + wr * 64 + m * 16 + fr) * 1024 + col0 + bj * 128 + n * 16);
#pragma unroll
                for (int ai = 0; ai < 2; ++ai)
#pragma unroll
                    for (int m = 0; m < 4; ++m) {
                        bf16* p = X + (size_t)(u.pm * 256 + ai * 128 + wr * 64 + m * 16 + fr) * 1024 + col0 + bj * 128 + n * 16;
                        const f32x4 xv = (f32x4){bflo(xo[ai][m].x), bfhi(xo[ai][m].x), bflo(xo[ai][m].y), bfhi(xo[ai][m].y)} + gt * acc[ai][bj][m][n];
                        u32x2 w; w.x = pk2(xv[0], xv[1]); w.y = pk2(xv[2], xv[3]);
                        *(u32x2*)((char*)p + dofs) = w;
                    }
            }
        }
    }
};
struct EpiMoe1 {
    static constexpr bool PERM = true, AFTER_DRAIN = false; static constexpr int A_E8M0 = H8_E8M0;
    bf16* ACT; const float* B1;
    DI void operator()(const AccT& acc, const Unit& u, int wr, int wc, int fr, int fq) const {
#pragma unroll
        for (int bj = 0; bj < 2; ++bj) {
            const int col = u.pn * 256 + bj * 128 + wc * 32 + 8 * fq;
            const f32x4 b0 = *(const f32x4*)(B1 + (size_t)u.e * 2048 + col), b1 = *(const f32x4*)(B1 + (size_t)u.e * 2048 + col + 4);
#pragma unroll
            for (int ai = 0; ai < 2; ++ai)
#pragma unroll
                for (int m = 0; m < 4; ++m) {
                    const int row = u.pm * 256 + ai * 128 + wr * 64 + m * 16 + fr;
                    const f32x4 v0 = acc[ai][bj][m][0] + b0, v1 = acc[ai][bj][m][1] + b1;
                    float o[4];
#pragma unroll
                    for (int j = 0; j < 4; ++j) {
                        const float gl = fminf((j < 2) ? v0[2 * j] : v1[2 * j - 4], 7.0f);
                        const float li = fminf(fmaxf((j < 2) ? v0[2 * j + 1] : v1[2 * j - 3], -7.0f), 7.0f);
                        o[j] = gl * sigmoidf_(1.702f * gl) * (li + 1.0f);
                    }
                    *(unsigned*)((unsigned char*)ACT + (size_t)row * 1024 + (col >> 1)) = pk4_fp8s(o[0], o[1], o[2], o[3], A8_SCALE);
                }
        }
    }
};
struct EpiMoe2 {
    static constexpr bool PERM = true, AFTER_DRAIN = false; static constexpr int A_E8M0 = A8_E8M0;
    unsigned char* Y2; const float* B2; const float* GATEW;
    DI void operator()(const AccT& acc, const Unit& u, int wr, int wc, int fr, int fq) const {
        float gwv[2][4];
#pragma unroll
        for (int ai = 0; ai < 2; ++ai)
#pragma unroll
            for (int m = 0; m < 4; ++m) gwv[ai][m] = GATEW[(size_t)u.e * ECAP + u.ml * 256 + ai * 128 + wr * 64 + m * 16 + fr];
        f32x4 bb[2][2];
#pragma unroll
        for (int bj = 0; bj < 2; ++bj) { const int col = u.pn * 256 + bj * 128 + wc * 32 + 8 * fq; bb[bj][0] = *(const f32x4*)(B2 + (size_t)u.e * 1024 + col); bb[bj][1] = *(const f32x4*)(B2 + (size_t)u.e * 1024 + col + 4); }
#pragma unroll
        for (int ai = 0; ai < 2; ++ai)
#pragma unroll
            for (int m = 0; m < 4; ++m) {
                const int rl = ai * 128 + wr * 64 + m * 16 + fr;
                const float gw = gwv[ai][m];
                const size_t row = (size_t)u.pm * 256 + rl;
#pragma unroll
                for (int bj = 0; bj < 2; ++bj) {
                    const int col = u.pn * 256 + bj * 128 + wc * 32 + 8 * fq;
                    const f32x4 v0 = (acc[ai][bj][m][0] + bb[bj][0]) * gw, v1 = (acc[ai][bj][m][1] + bb[bj][1]) * gw;
                    { u32x2 w8; w8.x = pk4_fp8(v0[0], v0[1], v0[2], v0[3]); w8.y = pk4_fp8(v1[0], v1[1], v1[2], v1[3]); *(u32x2*)(Y2 + row * 1024 + col) = w8; }
                }
            }
    }
};

#define MFMA32(a, b, c) __builtin_amdgcn_mfma_f32_32x32x16_bf16((a), (b), (c), 0, 0, 0)
typedef short v4i16_t __attribute__((ext_vector_type(4)));
DI s16x4 tr_read(const LAS unsigned char* p) { return __builtin_bit_cast(s16x4, __builtin_amdgcn_ds_read_tr16_b64_v4i16((LAS v4i16_t*)p)); }
constexpr int VST = 144;
template <int DQ> struct AC { static constexpr int KST = DQ * 2 + 16, KS = DQ / 16, KBUF = 64 * KST, VBUF = 64 * VST, BUF = KBUF + VBUF; };

template <int DQ>
DI void qk_tile(const LAS unsigned char* kb, const bf16x8 (&qf)[DQ / 16], f32x16 (&s)[2], const f32x16& cinit, int lane) {
    const int r32 = lane & 31, hh = lane >> 5;
    bf16x8 kf[2][DQ / 16];
#pragma unroll
    for (int rt = 0; rt < 2; ++rt)
#pragma unroll
        for (int ks = 0; ks < DQ / 16; ++ks) kf[rt][ks] = *(const LAS bf16x8*)(kb + (32 * rt + r32) * AC<DQ>::KST + (16 * ks + 8 * hh) * 2);
    f32x16 a0 = MFMA32(kf[0][0], qf[0], cinit), a1 = MFMA32(kf[1][0], qf[0], cinit);
#pragma unroll
    for (int ks = 1; ks < DQ / 16; ++ks) { a0 = MFMA32(kf[0][ks], qf[ks], a0); a1 = MFMA32(kf[1][ks], qf[ks], a1); }
    s[0] = a0; s[1] = a1;
}
DI float max3f_(float a, float b, float c) { return __builtin_fmaxf(__builtin_fmaxf(a, b), c); }
constexpr float RESC_THR = 8.0f;
template <int DQ, int KMUL, int VAR = 0>
DI void attn_tile(const LAS unsigned char* kb, const LAS unsigned char* vb, const bf16x8 (&qf)[DQ / 16], f32x16 (&o)[2], f32x16& negm, float& m, float& l,
                  int dq, unsigned maxd, bool lf, int lane, const bool MASKED) {
    const int hh = lane >> 5;
    if (VAR == 1) return;
    f32x16 s[2];
    qk_tile<DQ>(kb, qf, s, negm, lane);
    if (VAR == 2) { o[0] += s[0]; o[1] += s[1]; return; }
    const int i16 = lane & 15, q = i16 >> 2, p_ = i16 & 3, mh = (lane >> 4) & 1;
    const LAS unsigned char* vbase = vb + (4 * hh + q) * VST + 32 * mh + 8 * p_;
    s16x4 vlo[4][2], vhi[4][2];
#pragma unroll
    for (int st = 0; st < 4; ++st)
#pragma unroll
        for (int mt = 0; mt < 2; ++mt) { vlo[st][mt] = tr_read(vbase + (16 * st) * VST + 64 * mt); vhi[st][mt] = tr_read(vbase + (16 * st + 8) * VST + 64 * mt); }
    __builtin_amdgcn_sched_barrier(0);
    if (MASKED) {
#pragma unroll
        for (int rt = 0; rt < 2; ++rt)
#pragma unroll
            for (int i = 0; i < 16; ++i) {
                const int d = dq - (32 * rt + 8 * (i >> 2) + (i & 3)) * KMUL;
                s[rt][i] = ((unsigned)d <= maxd) ? s[rt][i] : -1e30f;
            }
    }
    float mx = max3f_(s[0][0], s[0][1], s[0][2]);
#pragma unroll
    for (int i = 3; i < 15; i += 2) mx = max3f_(mx, s[0][i], s[0][i + 1]);
    mx = max3f_(mx, s[0][15], s[1][0]);
#pragma unroll
    for (int i = 1; i < 15; i += 2) mx = max3f_(mx, s[1][i], s[1][i + 1]);
    mx = fmaxf(mx, s[1][15]);
    if (__ballot(lf && mx > RESC_THR) != 0ull) {
        float mc = lf ? mx : -1e30f;
        mc = fmaxf(mc, __shfl_xor(mc, 32));
        const float delta = mc > RESC_THR ? mc : 0.f;
        const float alpha = fast_exp2(-delta);
        m += delta; l *= alpha;
#pragma unroll
        for (int i = 0; i < 16; ++i) { negm[i] = -m; o[0][i] *= alpha; o[1][i] *= alpha; s[0][i] -= delta; s[1][i] -= delta; }
    }
    float ps = 0.f;
#pragma unroll
    for (int rt = 0; rt < 2; ++rt)
#pragma unroll
        for (int i = 0; i < 16; ++i) { const float p = fast_exp2(s[rt][i]); s[rt][i] = p; ps += p; }
    const unsigned lmask = lf ? 0xffffffffu : 0u;
    l += lf ? ps : 0.f;
    if (VAR == 3) { o[0] += s[0]; o[1] += s[1]; return; }
#pragma unroll
    for (int rt = 0; rt < 2; ++rt)
#pragma unroll
        for (int s2 = 0; s2 < 2; ++s2) {
            u32x4 pw; pw.x = pk2(s[rt][8 * s2 + 0], s[rt][8 * s2 + 1]) & lmask; pw.y = pk2(s[rt][8 * s2 + 2], s[rt][8 * s2 + 3]) & lmask;
            pw.z = pk2(s[rt][8 * s2 + 4], s[rt][8 * s2 + 5]) & lmask; pw.w = pk2(s[rt][8 * s2 + 6], s[rt][8 * s2 + 7]) & lmask;
            const bf16x8 pb = __builtin_bit_cast(bf16x8, pw);
#pragma unroll
            for (int mt = 0; mt < 2; ++mt) {
                const bf16x8 va = __builtin_shufflevector(vlo[2 * rt + s2][mt], vhi[2 * rt + s2][mt], 0, 1, 2, 3, 4, 5, 6, 7);
                o[mt] = MFMA32(va, pb, o[mt]);
            }
        }
}
constexpr int OSTAGE_WAVE = 32 * 144;
static_assert(102400 + 8 * OSTAGE_WAVE <= MISC_OFF, "O stage below the LDS control words");
struct ChunkId { DI u32x4 operator()(u32x4 v, int, int, int) const { return v; } };
template <class P, class Fx = ChunkId>
DI void store_o_rows(const P& p, LAS unsigned char* lds, int off, const f32x16 (&o)[2], float inv, int lane, int wave, const Fx& fx = Fx()) {
    LAS unsigned char* st = lds + off + wave * OSTAGE_WAVE;
    const int n = lane & 31, hh = lane >> 5;
#pragma unroll
    for (int mt = 0; mt < 2; ++mt)
#pragma unroll
        for (int a = 0; a < 4; ++a) {
            u32x2 w; w.x = pk2(o[mt][4 * a] * inv, o[mt][4 * a + 1] * inv); w.y = pk2(o[mt][4 * a + 2] * inv, o[mt][4 * a + 3] * inv);
            *(LAS u32x2*)(st + n * 144 + (32 * mt + 8 * a + 4 * hh) * 2) = w;
        }
    asm volatile("s_waitcnt lgkmcnt(0)" ::: "memory");
#pragma unroll
    for (int it = 0; it < 4; ++it) {
        const int r = (lane >> 3) + 8 * it, c = lane & 7;
        const u32x4 v = fx(*(const LAS u32x4*)(st + r * 144 + c * 16), wave, r, c);
        *(u32x4*)(p.orow(wave, r) + 8 * c) = v;
    }
}
DI void store_o(bf16* orow, const f32x16 (&o)[2], float inv, int lane) {
    const int hh = lane >> 5;
#pragma unroll
    for (int mt = 0; mt < 2; ++mt)
#pragma unroll
        for (int a = 0; a < 4; ++a) {
            u32x2 w; w.x = pk2(o[mt][4 * a] * inv, o[mt][4 * a + 1] * inv); w.y = pk2(o[mt][4 * a + 2] * inv, o[mt][4 * a + 3] * inv);
            *(u32x2*)(orow + 32 * mt + 8 * a + 4 * hh) = w;
        }
}

struct PolA {
    static constexpr bool HASFLAG = false, LSE = true; static constexpr int KMUL = 1;
    const bf16 *Q, *K, *V; bf16* O; float* LSEP; int b, h, d, r, c; unsigned maxd; int j0, j1;
    DI int ql(int w, int lane) const { return 256 * c + 32 * w + (lane & 31); }
    DI size_t trow(int l_) const { return (size_t)b * S + (size_t)l_ * d + r; }
    DI const bf16* qrow(int w, int lane) const { return Q + trow(ql(w, lane)) * 256 + h * 64; }
    DI int qv(int w, int lane) const { return ql(w, lane); }
    DI int qmin(int w) const { return 256 * c + 32 * w; }
    DI int qmax(int w) const { return 256 * c + 32 * w + 31; }
    DI int kv0(int j) const { return 256 * c - 128 + 64 * j; }
    DI const bf16* krow(int j, int row) const { return K + trow(kv0(j) + row) * 256 + h * 64; }
    DI const bf16* vrow(int j, int row) const { return V + trow(kv0(j) + row) * 256 + h * 64; }
    DI const bf16* rrow(int, int) const { return nullptr; }
    DI bool flag(int, int, int) const { return true; }
    DI bf16* orow(int w, int lane) const { return O + trow(ql(w, lane)) * 256 + h * 64; }
    DI void lse(int w, int lane, float v) const { LSEP[trow(ql(w, lane)) * 4 + h] = v; }
};
struct PolB {
    static constexpr bool LSE = false; static constexpr int KMUL = 1;
    const bf16 *Q, *K, *V; bf16* O; int b, g, qc; unsigned maxd; int j0, j1; u64 sel; bool hasflag;
    const bf16 *GC = nullptr, *GW = nullptr, *GM = nullptr;
    DI int tok(int w, int lane) const { return 64 * qc + 8 * w + ((lane & 31) >> 2); }
    DI const bf16* qrow(int w, int lane) const { return Q + ((size_t)b * S + tok(w, lane)) * 512 + (4 * g + (lane & 3)) * 64; }
    DI int qv(int w, int lane) const { return tok(w, lane); }
    DI int qmin(int w) const { return 64 * qc + 8 * w; }
    DI int qmax(int w) const { return 64 * qc + 8 * w + 7; }
    DI int kv0(int j) const { return 64 * j; }
    DI const bf16* krow(int j, int row) const { return K + ((size_t)b * S + 64 * j + row) * 128 + g * 64; }
    DI const bf16* vrow(int j, int row) const { return V + ((size_t)b * S + 64 * j + row) * 128 + g * 64; }
    DI const bf16* rrow(int, int) const { return nullptr; }
    DI bf16* orow(int w, int lane) const { return O + ((size_t)b * S + tok(w, lane)) * 512 + (4 * g + (lane & 3)) * 64; }
    DI void lse(int, int, float) const {}
};
struct PolM {
    static constexpr bool HASFLAG = false, LSE = false; static constexpr int KMUL = 1;
    const bf16 *Q, *KN, *KR, *V; bf16* O; int b, h, c; unsigned maxd; int j0, j1;
    DI int tok(int w, int lane) const { return 256 * c + 32 * w + (lane & 31); }
    DI const bf16* qrow(int w, int lane) const { return Q + ((size_t)b * S + tok(w, lane)) * 384 + h * 96; }
    DI int qv(int w, int lane) const { return tok(w, lane); }
    DI int qmin(int w) const { return 256 * c + 32 * w; }
    DI int qmax(int w) const { return 256 * c + 32 * w + 31; }
    DI int kv0(int j) const { return 64 * j; }
    DI const bf16* krow(int j, int row) const { return KN + ((size_t)b * S + 64 * j + row) * 256 + h * 64; }
    DI const bf16* vrow(int j, int row) const { return V + ((size_t)b * S + 64 * j + row) * 256 + h * 64; }
    DI const bf16* rrow(int j, int row) const { return KR + ((size_t)b * S + 64 * j + row) * 32; }
    DI bf16* orow(int w, int lane) const { return O + ((size_t)b * S + tok(w, lane)) * 256 + h * 64; }
    DI void lse(int, int, float) const {}
};

template <int DQ, class P, bool FLAG, int VAR = 0>
DI void attn_unit(const P& p, LAS unsigned char* lds, int tid, int lane, int wave, u64 sel) {
    typedef AC<DQ> C;
    const int hh = lane >> 5;
    const bf16* qrow = p.qrow(wave, lane);
    bf16x8 qf[DQ / 16];
#pragma unroll
    for (int ks = 0; ks < DQ / 16; ++ks) qf[ks] = *(const bf16x8*)(qrow + 16 * ks + 8 * hh);
#pragma unroll
    for (int ks = 0; ks < DQ / 16; ++ks) asm volatile("s_waitcnt vmcnt(0)" : "+v"(qf[ks]) :: "memory");
    const int qv = p.qv(wave, lane), wq0 = p.qmin(wave), wq1 = p.qmax(wave);
    f32x16 o[2];
#pragma unroll
    for (int mt = 0; mt < 2; ++mt)
#pragma unroll
        for (int i = 0; i < 16; ++i) o[mt][i] = 0.f;
    float m = 0.f, l = 0.f;
    f32x16 negm;
#pragma unroll
    for (int i = 0; i < 16; ++i) negm[i] = 0.f;
    const int j0 = p.j0, j1 = p.j1;
    const int lrow = tid >> 3, lch = tid & 7;
    u32x4 k0A, v0A, r0A = {0u, 0u, 0u, 0u}, k1A, v1A, r1A = {0u, 0u, 0u, 0u}, k0B, v0B, r0B = {0u, 0u, 0u, 0u}, k1B, v1B, r1B = {0u, 0u, 0u, 0u};
    constexpr int NLD = (DQ == 96) ? 6 : 4;
    const int npair = (j1 - j0 + 1) >> 1;
#define ATT_LOAD1(RK, RV, RR, j) do { const bf16* pk_ = p.krow((j), lrow) + 8 * lch; const bf16* pv_ = p.vrow((j), lrow) + 8 * lch; \
        asm volatile("global_load_dwordx4 %0, %2, off\n\tglobal_load_dwordx4 %1, %3, off" : "=&v"(RK), "=&v"(RV) : "v"(pk_), "v"(pv_) : "memory"); \
        if (DQ == 96) { const bf16* pr_ = p.rrow((j), (tid & 255) >> 2) + 8 * (tid & 3); asm volatile("global_load_dwordx4 %0, %1, off" : "=&v"(RR) : "v"(pr_) : "memory"); } } while (0)
#define ATT_LOADP(K0, V0, R0, K1, V1, R1, t) do { const int ja_ = j0 + 2 * (t), jb_ = ja_ + 1; \
        { const int jc_ = ja_ < j1 ? ja_ : j1 - 1; ATT_LOAD1(K0, V0, R0, jc_); } { const int jd_ = jb_ < j1 ? jb_ : j1 - 1; ATT_LOAD1(K1, V1, R1, jd_); } } while (0)
#define ATT_TILE(kb_, jt_) do { const int j_ = (jt_); const int kv0 = p.kv0(j_); \
        bool need = (j_ < j1) && (wq1 - kv0 >= 0) && ((long long)wq0 - (long long)(kv0 + 63 * P::KMUL) <= (long long)p.maxd); \
        const bool interior = (wq0 - (kv0 + 63 * P::KMUL) >= 0) && ((long long)wq1 - (long long)kv0 <= (long long)p.maxd); \
        bool lf = true; \
        if (FLAG) { lf = ((sel >> j_) & 1ull) != 0ull; need = need && (__ballot(lf) != 0ull); } \
        if (need) attn_tile<DQ, P::KMUL, VAR>((kb_), (kb_) + C::KBUF, qf, o, negm, m, l, qv - kv0 - 4 * hh * P::KMUL, p.maxd, lf, lane, !interior); } while (0)
#define ATT_STEP(K0, V0, R0, K1, V1, R1, tt) do { const int t_ = (tt); \
        LAS unsigned char* pbuf = lds + (t_ & 1) * (2 * C::BUF); \
        asm volatile("s_waitcnt vmcnt(%6)" : "+v"(K0), "+v"(V0), "+v"(R0), "+v"(K1), "+v"(V1), "+v"(R1) : "n"(NLD) : "memory"); \
        *(LAS u32x4*)(pbuf + lrow * C::KST + lch * 16) = K0; *(LAS u32x4*)(pbuf + C::KBUF + lrow * VST + lch * 16) = V0; \
        *(LAS u32x4*)(pbuf + C::BUF + lrow * C::KST + lch * 16) = K1; *(LAS u32x4*)(pbuf + C::BUF + C::KBUF + lrow * VST + lch * 16) = V1; \
        if (DQ == 96) { *(LAS u32x4*)(pbuf + ((tid & 255) >> 2) * C::KST + 128 + (tid & 3) * 16) = R0; *(LAS u32x4*)(pbuf + C::BUF + ((tid & 255) >> 2) * C::KST + 128 + (tid & 3) * 16) = R1; } \
        asm volatile("s_waitcnt lgkmcnt(0)\n\ts_barrier" ::: "memory"); \
        ATT_LOADP(K0, V0, R0, K1, V1, R1, t_ + 2); \
        if (ATT_STAGGER > 0 && wave >= 4) __builtin_amdgcn_s_sleep(ATT_STAGGER); \
        ATT_TILE(pbuf, j0 + 2 * t_); ATT_TILE(pbuf + C::BUF, j0 + 2 * t_ + 1); } while (0)
    ATT_LOADP(k0A, v0A, r0A, k1A, v1A, r1A, 0);
    ATT_LOADP(k0B, v0B, r0B, k1B, v1B, r1B, 1);
    if (wave >= 4) __builtin_amdgcn_s_setprio(1);
#pragma unroll 1
    for (int t = 0; t < npair; t += 2) {
        ATT_STEP(k0A, v0A, r0A, k1A, v1A, r1A, t);
        ATT_STEP(k0B, v0B, r0B, k1B, v1B, r1B, t + 1);
    }
    __builtin_amdgcn_s_setprio(0);
    asm volatile("s_waitcnt vmcnt(0)" : "+v"(k0A), "+v"(v0A), "+v"(r0A), "+v"(k1A), "+v"(v1A), "+v"(r1A), "+v"(k0B), "+v"(v0B), "+v"(r0B), "+v"(k1B), "+v"(v1B), "+v"(r1B) :: "memory");
#undef ATT_LOAD1
#undef ATT_LOADP
#undef ATT_TILE
#undef ATT_STEP
    const float lt = l + __shfl_xor(l, 32);
    const float inv = lt > 0.f ? 1.0f / lt : 0.f;
    if constexpr (FLAG) {
        struct Gate { const P& p;
            DI u32x4 operator()(u32x4 v, int w_, int r, int c) const {
                const size_t tg = (size_t)p.b * S + 64 * p.qc + 8 * w_ + (r >> 2); const int hd = 4 * p.g + (r & 3);
                const bf16* gl = p.GM + tg * 256 + 160 + hd * 3;
                const float g0 = sigmoidf_(bf2f(gl[0])), g1 = sigmoidf_(bf2f(gl[1])), g2 = sigmoidf_(bf2f(gl[2]));
                const u32x4 a = *(const u32x4*)(p.GC + tg * 512 + hd * 64 + 8 * c), d = *(const u32x4*)(p.GW + tg * 512 + hd * 64 + 8 * c);
                u32x4 r_;
                r_.x = pk2(g0 * bflo(a.x) + g1 * bflo(v.x) + g2 * bflo(d.x), g0 * bfhi(a.x) + g1 * bfhi(v.x) + g2 * bfhi(d.x));
                r_.y = pk2(g0 * bflo(a.y) + g1 * bflo(v.y) + g2 * bflo(d.y), g0 * bfhi(a.y) + g1 * bfhi(v.y) + g2 * bfhi(d.y));
                r_.z = pk2(g0 * bflo(a.z) + g1 * bflo(v.z) + g2 * bflo(d.z), g0 * bfhi(a.z) + g1 * bfhi(v.z) + g2 * bfhi(d.z));
                r_.w = pk2(g0 * bflo(a.w) + g1 * bflo(v.w) + g2 * bflo(d.w), g0 * bfhi(a.w) + g1 * bfhi(v.w) + g2 * bfhi(d.w));
                return r_; } } gate{p};
        store_o_rows(p, lds, 90112, o, inv, lane, wave, gate);
    } else store_o_rows(p, lds, DQ == 96 ? 102400 : 90112, o, inv, lane, wave);
    if (P::LSE) { if (hh == 0) p.lse(wave, lane, m + __log2f(lt)); }
    __syncthreads();
}

DI u64 cmp_unit(const Ctx& F, int b, int g, int qc) {
    constexpr int KST = 144;
    LAS unsigned char* KL = F.lds; LAS unsigned char* VL = F.lds + 256 * KST; LAS float* IMP = (LAS float*)(F.lds + 2 * 256 * KST);
    const bf16* KC = (const bf16*)(F.ws + WS_KC) + (size_t)(b * 2 + g) * 256 * 64;
    const bf16* VC = (const bf16*)(F.ws + WS_VC) + (size_t)(b * 2 + g) * 256 * 64;
    const int tid = F.tid, lane = F.lane, w = F.wave, hh = lane >> 5, r32 = lane & 31;
#pragma unroll
    for (int it = 0; it < 4; ++it) { const int idx = tid + 512 * it, row = idx >> 3, ch = idx & 7;
        *(LAS u32x4*)(KL + row * KST + ch * 16) = *(const u32x4*)(KC + row * 64 + ch * 8);
        *(LAS u32x4*)(VL + row * VST + ch * 16) = *(const u32x4*)(VC + row * 64 + ch * 8); }
    __syncthreads();
    const int tokl = 8 * w + (r32 >> 2), tok = 64 * qc + tokl, head = 4 * g + (lane & 3);
    const bf16* qrow = (const bf16*)(F.ws + WS_QB) + ((size_t)b * S + tok) * 512 + head * 64;
    bf16x8 qf[4];
#pragma unroll
    for (int ks = 0; ks < 4; ++ks) qf[ks] = *(const bf16x8*)(qrow + 16 * ks + 8 * hh);
    const int qv = tok - 31, wq1 = 64 * qc + 8 * w + 7 - 31;
    f32x16 o[2];
#pragma unroll
    for (int mt = 0; mt < 2; ++mt)
#pragma unroll
        for (int i = 0; i < 16; ++i) o[mt][i] = 0.f;
    float m = 0.f, l = 0.f;
    f32x16 negm;
#pragma unroll
    for (int i = 0; i < 16; ++i) negm[i] = 0.f;
    const int wq0 = 64 * qc + 8 * w - 31;
#pragma unroll 1
    for (int jt = 0; jt < 4; ++jt) {
        if (wq1 - 1024 * jt >= 0) {
            const int dq = qv - 1024 * jt - 4 * hh * 16;
            attn_tile<64, 16>(KL + jt * 64 * KST, VL + jt * 64 * VST, qf, o, negm, m, l, dq, 0x7fffffffu, true, lane, !(wq0 - (1024 * jt + 63 * 16) >= 0));
        }
    }
    const float lt = l + __shfl_xor(l, 32);
    const float inv = lt > 0.f ? 1.0f / lt : 0.f;
    { struct { bf16* O; int b, g, qc; DI bf16* orow(int w_, int n_) const { return O + ((size_t)b * S + 64 * qc + 8 * w_ + (n_ >> 2)) * 512 + (4 * g + (n_ & 3)) * 64; } } pc{(bf16*)(F.ws + WS_OCMP), b, g, qc};
      store_o_rows(pc, F.lds, 90112, o, inv, lane, w); }
    float prev = 0.f;
#pragma unroll 1
    for (int jt = 0; jt < 4; ++jt) {
        const bool need = (wq1 - 1024 * jt >= 0);
        f32x16 s[2];
        if (need) qk_tile<64>(KL + jt * 64 * KST, qf, s, negm, lane);
#pragma unroll
        for (int rt = 0; rt < 2; ++rt)
#pragma unroll
            for (int a = 0; a < 4; ++a) {
                float mainp = 0.f, sp = 0.f;
                if (need) {
                    float pb[4];
#pragma unroll
                    for (int bb = 0; bb < 4; ++bb) { const int kidx = 64 * jt + 32 * rt + 8 * a + 4 * hh + bb; const bool ok = (qv - 16 * kidx) >= 0; pb[bb] = ok ? fast_exp2(s[rt][4 * a + bb]) * inv : 0.f; }
                    mainp = pb[0] + pb[1] + pb[2] + 0.5f * pb[3]; sp = 0.5f * pb[3];
                }
                const float rc = __shfl_xor(sp, 32);
                float v = mainp + (hh ? rc : prev);
                prev = rc;
                v += __shfl_xor(v, 1); v += __shfl_xor(v, 2);
                if ((lane & 3) == 0) IMP[tokl * 64 + 2 * (8 * jt + 4 * rt + a) + hh] = v;
            }
    }
    __syncthreads();
    u64 mysel = 0ull;
#pragma unroll 1
    for (int tk = 0; tk < 8; ++tk) {
        const int tl = 8 * w + tk, t = 64 * qc + tl, j = lane;
        const float v = IMP[tl * 64 + j];
        const bool forced = (j == 0) || (j == qc) || (j == qc - 1);
        const bool valid = j <= qc;
        const float score = forced ? v + 1e4f : (valid ? v : -1.0f);
        int rank = 0;
#pragma unroll
        for (int jp = 0; jp < 64; ++jp) { const float o_ = __builtin_bit_cast(float, __builtin_amdgcn_readlane(__builtin_bit_cast(int, score), jp)); rank += ((o_ > score) || (o_ == score && jp < j)) ? 1 : 0; }
        const u64 mask = __ballot(rank < 16);
        (void)t;
        if (tk == (r32 >> 2)) mysel = mask;
    }
    __syncthreads();
    return mysel;
}

DI void moe_tables(const Ctx& F, int l) {
    LAS int* tb = (LAS int*)(F.lds + AUX_OFF); LAS int* cn = tb + 64;
    if (F.tid == 0) {
        const unsigned* C = (const unsigned*)(F.ws + WS_CTL) + CW_CNT + l * 32 * 64;
        int acc = 0;
        for (int e = 0; e < 32; ++e) { const int c = (int)__hip_atomic_load(C + e * 64, RLX_AGENT); tb[e] = acc; cn[e] = c; acc += (c + 255) >> 8; }
        tb[32] = acc;
    }
    __syncthreads();
}
template <int MODE>
DI void phase_norm1(const Ctx& F, int l) {
    const float* mods = (const float*)(F.ws + WS_MODS);
    const bf16* X = (const bf16*)(F.ws + WS_X); bf16* H = (bf16*)(F.ws + F.dofs + WS_H); bf16* XW = (bf16*)(F.ws + F.dofs + WS_X);
    const LAS int* tb = (const LAS int*)(F.lds + AUX_OFF);
    if (l > 0) moe_tables(F, l - 1);
    const int gw = F.blk * 8 + F.wave, NGW = F.G * 8, lane = F.lane;
    for (int tok = gw; tok < T; tok += NGW) {
        const int b = tok >> 12;
        f32x4 v[4];
        if (l == 0) { const float* xr = ginp(F, I_X) + (size_t)tok * 1024;
#pragma unroll
            for (int k = 0; k < 4; ++k) v[k] = *(const f32x4*)(xr + 4 * lane + 256 * k);
        } else { const bf16* xr = X + (size_t)tok * 1024;
#pragma unroll
            for (int k = 0; k < 4; ++k) { const u32x2 w = *(const u32x2*)(xr + 4 * lane + 256 * k); v[k] = (f32x4){bflo(w.x), bfhi(w.x), bflo(w.y), bfhi(w.y)}; }
        }
        if (l > 0) {
            f32x4 y[4];
#pragma unroll
            for (int k = 0; k < 4; ++k) y[k] = (f32x4){0.f, 0.f, 0.f, 0.f};
            const int* ts = (const int*)(F.ws + WS_TOKSLOT) + (size_t)tok * 4;
#pragma unroll
            for (int s = 0; s < 4; ++s) {
                const int pk = ts[s]; const int e = pk >> 16, pos = pk & 0xffff;
                const unsigned char* yr = (const unsigned char*)(F.ws + WS_Y2) + ((size_t)tb[e] * 256 + pos) * 1024;
#pragma unroll
                for (int k = 0; k < 4; ++k) { const unsigned w = *(const unsigned*)(yr + 4 * lane + 256 * k); y[k] += unpk4_fp8(w); }
            }
            const float* gt2 = mods + ((size_t)((l - 1) * 8 + b) * 6 + 5) * 1024;
#pragma unroll
            for (int k = 0; k < 4; ++k) v[k] = v[k] + *(const f32x4*)(gt2 + 4 * lane + 256 * k) * (y[k] * Y2_ISCALE);
        }
        float ss = 0.f;
#pragma unroll
        for (int k = 0; k < 4; ++k) ss += v[k][0] * v[k][0] + v[k][1] * v[k][1] + v[k][2] * v[k][2] + v[k][3] * v[k][3];
        const float rstd = rsqrtf(wave_sum(ss) * (1.0f / 1024.0f) + EPS);
        if (MODE == 0) {
            const float* g1 = ginp(F, I_G1) + (size_t)l * 1024;
            const float* sh = mods + ((size_t)(l * 8 + b) * 6 + 0) * 1024; const float* sc = sh + 1024;
#pragma unroll
            for (int k = 0; k < 4; ++k) {
                const int c = 4 * lane + 256 * k;
                { u32x2 xw; xw.x = pk2(v[k][0], v[k][1]); xw.y = pk2(v[k][2], v[k][3]); *(u32x2*)(XW + (size_t)tok * 1024 + c) = xw; }
                const f32x4 hv = v[k] * rstd * *(const f32x4*)(g1 + c) * (*(const f32x4*)(sc + c) + 1.0f) + *(const f32x4*)(sh + c);
                u32x2 w; w.x = pk2(hv[0], hv[1]); w.y = pk2(hv[2], hv[3]);
                *(u32x2*)(H + (size_t)tok * 1024 + c) = w;
            }
        } else {
            const float* gf = ginp(F, I_GF);
#pragma unroll
            for (int k = 0; k < 4; ++k) { const int c = 4 * lane + 256 * k; *(f32x4*)(gout(F) + (size_t)tok * 1024 + c) = v[k] * rstd * *(const f32x4*)(gf + c); }
        }
    }
}
DI void phase_prep(const Ctx& F) {
    const bf16* CQ = (const bf16*)(F.ws + WS_CQ); const bf16* MISC = (const bf16*)(F.ws + WS_MISC);
    float* RQ = (float*)(F.ws + WS_RSTDQ); float* RKV = (float*)(F.ws + WS_RSTDKV);
    bf16* KR = (bf16*)(F.ws + WS_KR); float* GATES = (float*)(F.ws + WS_GATES); const float* CS32 = (const float*)(F.ws + WS_CS32);
    const int gw = F.blk * 8 + F.wave, NGW = F.G * 8, lane = F.lane;
    for (int tok = gw; tok < T; tok += NGW) {
        const u32x2 wq = *(const u32x2*)(CQ + (size_t)tok * 256 + 4 * lane);
        const u32x2 wm = *(const u32x2*)(MISC + (size_t)tok * 256 + 4 * lane);
        float a0 = bflo(wq.x), a1 = bfhi(wq.x), a2 = bflo(wq.y), a3 = bfhi(wq.y);
        const float sq = wave_sum(a0 * a0 + a1 * a1 + a2 * a2 + a3 * a3);
        float m0 = bflo(wm.x), m1 = bfhi(wm.x), m2 = bflo(wm.y), m3 = bfhi(wm.y);
        const float skv = wave_sum(lane < 32 ? (m0 * m0 + m1 * m1 + m2 * m2 + m3 * m3) : 0.f);
        if (lane == 0) { RQ[tok] = rsqrtf(sq * (1.0f / 256.0f) + EPS); RKV[tok] = rsqrtf(skv * (1.0f / 128.0f) + EPS); }
        const float p0 = __shfl_xor(m0, 4), p1 = __shfl_xor(m1, 4), p2 = __shfl_xor(m2, 4), p3 = __shfl_xor(m3, 4);
        if (lane >= 32 && lane < 36) {
            const int i0 = 4 * (lane - 32);
            const f32x4 c4 = *(const f32x4*)(CS32 + (size_t)tok * 32 + i0), s4 = *(const f32x4*)(CS32 + (size_t)tok * 32 + 16 + i0);
            u32x4 w;
            w.x = pk2(m0 * c4[0] - p0 * s4[0], p0 * c4[0] + m0 * s4[0]); w.y = pk2(m1 * c4[1] - p1 * s4[1], p1 * c4[1] + m1 * s4[1]);
            w.z = pk2(m2 * c4[2] - p2 * s4[2], p2 * c4[2] + m2 * s4[2]); w.w = pk2(m3 * c4[3] - p3 * s4[3], p3 * c4[3] + m3 * s4[3]);
            *(u32x4*)(KR + (size_t)tok * 32 + 2 * i0) = w;
        }
        if (lane >= 40 && lane < 46) {
            const int gi = 4 * (lane - 40);
            *(f32x4*)(GATES + (size_t)tok * 24 + gi) = (f32x4){sigmoidf_(m0), sigmoidf_(m1), sigmoidf_(m2), sigmoidf_(m3)};
        }
    }
}
DI void phase_cmp2(const Ctx& F, int l) {
    const bf16* HID = (const bf16*)(F.ws + WS_HID);
    const float* CS64 = (const float*)(F.ws + WS_CS64);
    const int gw = F.blk * 8 + F.wave, NGW = F.G * 8, lane = F.lane;
    for (int it = gw; it < 8192; it += NGW) {
        const int kv = it >> 12, row = it & 4095, c = row & 255, bg = row >> 8;
        const float* w2 = ginp(F, kv ? I_W2V : I_W2K) + (size_t)l * 256 * 64;
        const float* b2 = ginp(F, kv ? I_B2V : I_B2K) + (size_t)l * 64;
        const u32x2 hw = *(const u32x2*)(HID + ((size_t)kv * 4096 + row) * 256 + 4 * lane);
        const float h0 = bflo(hw.x), h1 = bfhi(hw.x), h2 = bflo(hw.y), h3 = bfhi(hw.y);
        float acc = b2[lane];
#pragma unroll 4
        for (int k4 = 0; k4 < 64; ++k4) {
            const float x0 = __builtin_bit_cast(float, __builtin_amdgcn_readlane(__builtin_bit_cast(int, h0), k4));
            const float x1 = __builtin_bit_cast(float, __builtin_amdgcn_readlane(__builtin_bit_cast(int, h1), k4));
            const float x2 = __builtin_bit_cast(float, __builtin_amdgcn_readlane(__builtin_bit_cast(int, h2), k4));
            const float x3 = __builtin_bit_cast(float, __builtin_amdgcn_readlane(__builtin_bit_cast(int, h3), k4));
            acc += x0 * w2[(4 * k4 + 0) * 64 + lane] + x1 * w2[(4 * k4 + 1) * 64 + lane] + x2 * w2[(4 * k4 + 2) * 64 + lane] + x3 * w2[(4 * k4 + 3) * 64 + lane];
        }
        if (c == 255) acc = 0.f;
        if (kv == 0) {
            const int b = bg >> 1, tokr = b * S + 16 * c + 31;
            const float other = __shfl_xor(acc, 32);
            const int i = lane & 31;
            const float cs = CS64[(size_t)(tokr & (T - 1)) * 64 + i], sn = CS64[(size_t)(tokr & (T - 1)) * 64 + 32 + i];
            const float y = (lane < 32) ? (acc * cs - other * sn) : (acc * cs + other * sn);
            ((bf16*)(F.ws + WS_KC))[(size_t)row * 64 + 2 * i + (lane >> 5)] = (bf16)(pk2(y, 0.f) & 0xffffu);
        } else {
            ((bf16*)(F.ws + WS_VC))[(size_t)row * 64 + lane] = (bf16)(pk2(acc, 0.f) & 0xffffu);
        }
    }
}
DI void phase_mix(const Ctx& F, int l) {
    const bf16* OA3 = (const bf16*)(F.ws + WS_OA3); const float* LSEA = (const float*)(F.ws + WS_LSEA);
    const bf16* OCMP = (const bf16*)(F.ws + WS_OCMP); const bf16* OSLC = (const bf16*)(F.ws + WS_OSLC); const bf16* OWIN = (const bf16*)(F.ws + WS_OWIN);
    const bf16* OC = (const bf16*)(F.ws + WS_OC); const bf16* MISC = (const bf16*)(F.ws + WS_MISC);
    bf16* AMIX = (bf16*)(F.ws + WS_AMIX);
    const float* ga = ginp(F, I_GOA) + (size_t)l * 256; const float* gb = ginp(F, I_GOB) + (size_t)l * 512; const float* gc = ginp(F, I_GOC) + (size_t)l * 256;
    const int gw = F.blk * 8 + F.wave, NGW = F.G * 8, lane = F.lane, ha = lane >> 4;
    for (int tok0 = gw; tok0 < T; tok0 += 2 * NGW) {
        int tok[2]; tok[0] = tok0; tok[1] = (tok0 + NGW < T) ? tok0 + NGW : tok0;
        float ls[2][3]; u32x2 wa[2][3], wb[2][2], wc_[2];
#pragma unroll
        for (int q = 0; q < 2; ++q) {
#pragma unroll
            for (int p = 0; p < 3; ++p) { ls[q][p] = LSEA[((size_t)p * T + tok[q]) * 4 + ha]; wa[q][p] = *(const u32x2*)(OA3 + ((size_t)p * T + tok[q]) * 256 + 4 * lane); }
#pragma unroll
            for (int k = 0; k < 2; ++k) {
                const int col = 256 * k + 4 * lane;
                wb[q][k] = *(const u32x2*)(OSLC + (size_t)tok[q] * 512 + col);
            }
            wc_[q] = *(const u32x2*)(OC + (size_t)tok[q] * 256 + 4 * lane);
        }
        f32x4 va[2], vb[2][2], vc[2]; float red[2][3];
#pragma unroll
        for (int q = 0; q < 2; ++q) {
            const float mx = fmaxf(ls[q][0], fmaxf(ls[q][1], ls[q][2]));
            const float w0 = fast_exp2(ls[q][0] - mx), w1 = fast_exp2(ls[q][1] - mx), w2 = fast_exp2(ls[q][2] - mx), wi = 1.0f / (w0 + w1 + w2);
            va[q] = ((f32x4){bflo(wa[q][0].x), bfhi(wa[q][0].x), bflo(wa[q][0].y), bfhi(wa[q][0].y)} * w0 + (f32x4){bflo(wa[q][1].x), bfhi(wa[q][1].x), bflo(wa[q][1].y), bfhi(wa[q][1].y)} * w1
                   + (f32x4){bflo(wa[q][2].x), bfhi(wa[q][2].x), bflo(wa[q][2].y), bfhi(wa[q][2].y)} * w2) * wi;
            red[q][0] = va[q][0] * va[q][0] + va[q][1] * va[q][1] + va[q][2] * va[q][2] + va[q][3] * va[q][3];
            float sb = 0.f;
#pragma unroll
            for (int k = 0; k < 2; ++k) {
                const u32x2 a = wb[q][k];
                vb[q][k][0] = bflo(a.x); vb[q][k][1] = bfhi(a.x); vb[q][k][2] = bflo(a.y); vb[q][k][3] = bfhi(a.y);
                sb += vb[q][k][0] * vb[q][k][0] + vb[q][k][1] * vb[q][k][1] + vb[q][k][2] * vb[q][k][2] + vb[q][k][3] * vb[q][k][3];
            }
            red[q][1] = sb;
            vc[q] = (f32x4){bflo(wc_[q].x), bfhi(wc_[q].x), bflo(wc_[q].y), bfhi(wc_[q].y)};
            red[q][2] = vc[q][0] * vc[q][0] + vc[q][1] * vc[q][1] + vc[q][2] * vc[q][2] + vc[q][3] * vc[q][3];
        }
#pragma unroll
        for (int q = 0; q < 2; ++q)
#pragma unroll
            for (int j = 0; j < 3; ++j) red[q][j] = wave_sum(red[q][j]);
#pragma unroll
        for (int q = 0; q < 2; ++q) {
            if (q == 1 && tok0 + NGW >= T) break;
            const float ra = rsqrtf(red[q][0] * (1.0f / 256.0f) + EPS), rb = rsqrtf(red[q][1] * (1.0f / 512.0f) + EPS), rc = rsqrtf(red[q][2] * (1.0f / 256.0f) + EPS);
            bf16* orow = AMIX + (size_t)tok[q] * 1024;
            { const f32x4 o = va[q] * ra * *(const f32x4*)(ga + 4 * lane); u32x2 w; w.x = pk2(o[0], o[1]); w.y = pk2(o[2], o[3]); *(u32x2*)(orow + 4 * lane) = w; }
#pragma unroll
            for (int k = 0; k < 2; ++k) { const f32x4 o = vb[q][k] * rb * *(const f32x4*)(gb + 256 * k + 4 * lane); u32x2 w; w.x = pk2(o[0], o[1]); w.y = pk2(o[2], o[3]); *(u32x2*)(orow + 256 + 256 * k + 4 * lane) = w; }
            { const f32x4 o = vc[q] * rc * *(const f32x4*)(gc + 4 * lane); u32x2 w; w.x = pk2(o[0], o[1]); w.y = pk2(o[2], o[3]); *(u32x2*)(orow + 768 + 4 * lane) = w; }
        }
    }
}
DI void phase_router(const Ctx& F, int l) {
    LAS unsigned char* WH = F.lds; LAS unsigned char* WL = F.lds + 65536;
    LAS float* biasp = (LAS float*)(F.lds + AUX_OFF); LAS float* RS = biasp + 32;
    LAS int* lcnt = (LAS int*)(F.lds + AUX_OFF + 1024); LAS int* gbase = lcnt + 32;
    LAS int* tokE = gbase + 32; LAS float* tokG = (LAS float*)(tokE + 512); LAS int* tokP = (LAS int*)(tokG + 512);
    const float* wr = ginp(F, I_WR) + (size_t)l * 1024 * 32; const float* br = ginp(F, I_BR) + (size_t)l * 32;
    const float* mods = (const float*)(F.ws + WS_MODS); const bf16* X = (const bf16*)(F.ws + WS_X); bf16* H = (bf16*)(F.ws + F.dofs + WS_H);
    const float* g2 = ginp(F, I_G2) + (size_t)l * 1024;
    const int tid = F.tid, lane = F.lane, w = F.wave;
    if (tid < 32) lcnt[tid] = 0;
    unsigned* CNT = (unsigned*)(F.ws + WS_CTL) + CW_CNT + (l + F.dcnt) * 32 * 64;
    for (int chunk = F.blk; chunk < T / 128; chunk += F.G) {
        const int b = (chunk * 128) >> 12;
        const float* sh = mods + ((size_t)(l * 8 + b) * 6 + 3) * 1024; const float* sc = sh + 1024;
        {
            float bacc = 0.f; const int e = tid & 31;
#pragma unroll 4
            for (int it = 0; it < 32; ++it) {
                const int k = 2 * ((tid + 512 * it) >> 5);
                const float w0 = wr[k * 32 + e], w1 = wr[(k + 1) * 32 + e];
                const float p0 = w0 * (g2[k] * (sc[k] + 1.0f)), p1 = w1 * (g2[k + 1] * (sc[k + 1] + 1.0f));
                bacc += sh[k] * w0 + sh[k + 1] * w1;
                const unsigned hi = pk2(p0, p1);
                const unsigned lo = pk2(p0 - bflo(hi), p1 - bfhi(hi));
                const int off = e * 2048 + ((((k >> 3) ^ e) << 4) | ((k & 7) * 2));
                *(LAS unsigned*)(WH + off) = hi; *(LAS unsigned*)(WL + off) = lo;
            }
            tokG[tid] = bacc;
        }
        __syncthreads();
        if (tid < 32) { float s_ = br[tid];
#pragma unroll
            for (int j = 0; j < 16; ++j) s_ += tokG[tid + 32 * j];
            biasp[tid] = s_; }
        {
            u32x2 ra[4], rb[4];
            f32x4 ggv[4], hhv[4];
#pragma unroll
            for (int k = 0; k < 4; ++k) { const int c = 4 * lane + 256 * k; ggv[k] = *(const f32x4*)(g2 + c) * (*(const f32x4*)(sc + c) + 1.0f); hhv[k] = *(const f32x4*)(sh + c); }
            { const bf16* x0 = X + (size_t)(chunk * 128 + w * 16) * 1024 + 4 * lane;
#pragma unroll
              for (int k = 0; k < 4; ++k) { ra[k] = *(const u32x2*)(x0 + 256 * k); rb[k] = *(const u32x2*)(x0 + 1024 + 256 * k); } }
#pragma unroll 1
            for (int tt = 0; tt < 8; ++tt) {
                const int tl0 = w * 16 + 2 * tt, tok0 = chunk * 128 + tl0;
                f32x4 v[2][4]; float ss0 = 0.f, ss1 = 0.f;
#pragma unroll
                for (int k = 0; k < 4; ++k) { v[0][k] = (f32x4){bflo(ra[k].x), bfhi(ra[k].x), bflo(ra[k].y), bfhi(ra[k].y)}; v[1][k] = (f32x4){bflo(rb[k].x), bfhi(rb[k].x), bflo(rb[k].y), bfhi(rb[k].y)}; }
                { const int tn = (tt < 7) ? tok0 + 2 : tok0; const bf16* x0 = X + (size_t)tn * 1024 + 4 * lane;
#pragma unroll
                  for (int k = 0; k < 4; ++k) { ra[k] = *(const u32x2*)(x0 + 256 * k); rb[k] = *(const u32x2*)(x0 + 1024 + 256 * k); } }
#pragma unroll
                for (int k = 0; k < 4; ++k) { ss0 += v[0][k][0] * v[0][k][0] + v[0][k][1] * v[0][k][1] + v[0][k][2] * v[0][k][2] + v[0][k][3] * v[0][k][3];
                                              ss1 += v[1][k][0] * v[1][k][0] + v[1][k][1] * v[1][k][1] + v[1][k][2] * v[1][k][2] + v[1][k][3] * v[1][k][3]; }
                ss0 = wave_sum(ss0); ss1 = wave_sum(ss1);
                const float rs0 = rsqrtf(ss0 * (1.0f / 1024.0f) + EPS), rs1 = rsqrtf(ss1 * (1.0f / 1024.0f) + EPS);
                if (lane == 0) { RS[tl0] = rs0; RS[tl0 + 1] = rs1; }
#pragma unroll
                for (int k = 0; k < 4; ++k) {
                    const int c = 4 * lane + 256 * k;
                    v[0][k] = v[0][k] * rs0 * ggv[k] + hhv[k]; v[1][k] = v[1][k] * rs1 * ggv[k] + hhv[k];
                    *(unsigned*)((unsigned char*)H + (size_t)tok0 * 1024 + c) = pk4_fp8s(v[0][k][0], v[0][k][1], v[0][k][2], v[0][k][3], H8_SCALE);
                    *(unsigned*)((unsigned char*)H + (size_t)(tok0 + 1) * 1024 + c) = pk4_fp8s(v[1][k][0], v[1][k][1], v[1][k][2], v[1][k][3], H8_SCALE);
                }
            }
        }
        __syncthreads();
        f32x4 acc[2] = {{0.f, 0.f, 0.f, 0.f}, {0.f, 0.f, 0.f, 0.f}};
        {
            const int kg = lane >> 4, n16 = lane & 15;
            const bf16* xr = X + (size_t)(chunk * 128 + w * 16 + n16) * 1024 + 8 * kg;
#pragma unroll 1
            for (int k8 = 0; k8 < 4; ++k8) {
                bf16x8 af[8];
#pragma unroll
                for (int j = 0; j < 8; ++j) af[j] = *(const bf16x8*)(xr + 32 * (8 * k8 + j));
#pragma unroll
                for (int j = 0; j < 8; ++j) {
                    const int c = 4 * (8 * k8 + j) + kg;
#pragma unroll
                    for (int et = 0; et < 2; ++et) {
                        const int e = 16 * et + n16, off = e * 2048 + ((c ^ e) << 4);
                        const bf16x8 bh = *(const LAS bf16x8*)(WH + off), bl = *(const LAS bf16x8*)(WL + off);
                        acc[et] = __builtin_amdgcn_mfma_f32_16x16x32_bf16(af[j], bh, acc[et], 0, 0, 0);
                        acc[et] = __builtin_amdgcn_mfma_f32_16x16x32_bf16(af[j], bl, acc[et], 0, 0, 0);
                    }
                }
            }
        }
        __syncthreads();
        LAS float* LG = (LAS float*)(F.lds + w * 2048);
        {
            const int g4 = lane >> 4, n16 = lane & 15;
#pragma unroll
            for (int et = 0; et < 2; ++et)
#pragma unroll
                for (int i = 0; i < 4; ++i) LG[(4 * g4 + i) * 32 + 16 * et + n16] = acc[et][i] * RS[w * 16 + 4 * g4 + i] + biasp[16 * et + n16];
        }
        asm volatile("s_waitcnt lgkmcnt(0)" ::: "memory");
#pragma unroll 1
        for (int tt = 0; tt < 8; ++tt) {
            const int tl0 = w * 16 + 2 * tt;
            const float lg0 = LG[(2 * tt) * 32 + (lane >> 1)], lg1 = LG[(2 * tt + 1) * 32 + (lane >> 1)];
            int rk0 = 0, rk1 = 0; const int me = lane >> 1;
#pragma unroll
            for (int e = 0; e < 32; ++e) {
                const float o0 = __builtin_bit_cast(float, __builtin_amdgcn_readlane(__builtin_bit_cast(int, lg0), 2 * e));
                const float o1 = __builtin_bit_cast(float, __builtin_amdgcn_readlane(__builtin_bit_cast(int, lg1), 2 * e));
                rk0 += ((o0 > lg0) || (o0 == lg0 && e < me)) ? 1 : 0; rk1 += ((o1 > lg1) || (o1 == lg1 && e < me)) ? 1 : 0;
            }
#pragma unroll
            for (int tk = 0; tk < 2; ++tk) {
                const int rk = tk ? rk1 : rk0; const float lg = tk ? lg1 : lg0;
                int te[4]; float tv[4];
#pragma unroll
                for (int r = 0; r < 4; ++r) {
                    const u64 mk = __ballot(rk == r && (lane & 1) == 0);
                    const int sl = __builtin_amdgcn_readfirstlane((int)__builtin_ctzll(mk));
                    te[r] = sl >> 1; tv[r] = __builtin_bit_cast(float, __builtin_amdgcn_readlane(__builtin_bit_cast(int, lg), sl));
                }
                const float e1 = __expf(tv[1] - tv[0]), e2 = __expf(tv[2] - tv[0]), e3 = __expf(tv[3] - tv[0]);
                const float isum = 1.0f / (1.0f + e1 + e2 + e3);
                if (lane < 4) {
                    const int tl = tl0 + tk;
                    const int e = lane == 0 ? te[0] : lane == 1 ? te[1] : lane == 2 ? te[2] : te[3];
                    const float gte = (lane == 0 ? 1.0f : lane == 1 ? e1 : lane == 2 ? e2 : e3) * isum;
                    const int pos = atomicAdd((int*)(lcnt + e), 1);
                    tokE[tl * 4 + lane] = e; tokG[tl * 4 + lane] = gte; tokP[tl * 4 + lane] = pos;
                }
            }
        }
        __syncthreads();
        if (tid < 32) gbase[tid] = (int)__hip_atomic_fetch_add(CNT + tid * 64, (unsigned)lcnt[tid], RLX_AGENT);
        __syncthreads();
        {
            const int tl = tid >> 2, r = tid & 3, e = tokE[tid], pos = gbase[e] + tokP[tid], tok = chunk * 128 + tl;
            ((int*)(F.ws + F.dofs + WS_IDX))[(size_t)e * ECAP + pos] = tok;
            ((float*)(F.ws + F.dofs + WS_GATEW))[(size_t)e * ECAP + pos] = tokG[tid];
            ((int*)(F.ws + F.dofs + WS_TOKSLOT))[(size_t)tok * 4 + r] = (e << 16) | pos;
        }
        __syncthreads();
        if (tid < 32) lcnt[tid] = 0;
        __syncthreads();
    }
}

DI int ropeperm64(int p) { return (p >> 1) + 32 * (p & 1); }
DI int cmap_win(int n) {
    const int tile = n >> 8, w = n & 255, hb = w & ~63, pp = ropeperm64(w & 63);
    switch (tile) {
        case 0: return hb + pp;
        case 1: return 256 + hb + pp;
        case 2: return 512 + w;
        case 3: return 768 + hb + pp;
        case 4: return 1024 + hb + pp;
        case 5: return w < 128 ? 1280 + w : 1408 + (w - 128);
        case 6: return w < 128 ? 1536 + hb + pp : 1664 + (w - 128);
        case 7: return w < 128 ? 1792 + hb + pp : 1920 + (w - 128);
        case 8: return 2072 + w;
        default: return w < 128 ? 2328 + w : (w < 160 ? 2456 + ((w - 128) >> 1) + 16 * ((w - 128) & 1) : (w < 184 ? 2048 + (w - 160) : -1));
    }
}
DI int cmap_qup(int n) { if (n >= 384) return -1; const int h = n / 96, w = n % 96; if (w < 64) return h * 96 + w; const int j = w - 64; return h * 96 + 64 + (j >> 1) + 16 * (j & 1); }
DI void tr_tile(const float* src, int K, int Nsrc, bf16* dst, int Kdst, int maptype, const float* ksc, int ntile, int ktile, LAS float* scr, int tid) {
    const int n0 = ntile * 64, k0 = ktile * 128, nl = tid & 63, n = n0 + nl;
    const int c = maptype == 0 ? (n < Nsrc ? n : -1) : (maptype == 1 ? cmap_win(n) : cmap_qup(n));
    float v[16];
#pragma unroll
    for (int it = 0; it < 16; ++it) { const int k = k0 + (tid >> 6) + 8 * it; v[it] = (c >= 0 && k < K) ? src[(size_t)k * Nsrc + c] * (ksc ? ksc[k] : 1.0f) : 0.f; }
#pragma unroll
    for (int it = 0; it < 16; ++it) scr[((tid >> 6) + 8 * it) * 65 + nl] = v[it];
    __syncthreads();
#pragma unroll
    for (int it = 0; it < 2; ++it) {
        const int idx = tid + 512 * it, nn = idx >> 4, ch = idx & 15;
        const LAS float* s = scr + (8 * ch) * 65 + nn;
        u32x4 o; o.x = pk2(s[0], s[65]); o.y = pk2(s[2 * 65], s[3 * 65]); o.z = pk2(s[4 * 65], s[5 * 65]); o.w = pk2(s[6 * 65], s[7 * 65]);
        *(u32x4*)(dst + (size_t)(n0 + nn) * Kdst + k0 + 8 * ch) = o;
    }
    __syncthreads();
}
DI void trb_load(f32x4 (&v)[16], const float* src, int N, int n0, int k0, int tid) {
#pragma unroll
    for (int it = 0; it < 16; ++it) v[it] = *(const f32x4*)(src + (size_t)(k0 + (tid >> 6) + 8 * it) * N + n0 + 4 * (tid & 63));
}
DI void trb_store(const f32x4 (&v)[16], bf16* dst, int Kd, int n0, int k0, LAS unsigned char* L, int tid, int wave, int lane, int f8 = 0) {
#pragma unroll
    for (int it = 0; it < 16; ++it) { f32x4 x = v[it];
        if (f8) { x[0] = q8s(x[0], W8_SCALE); x[1] = q8s(x[1], W8_SCALE); x[2] = q8s(x[2], W8_SCALE); x[3] = q8s(x[3], W8_SCALE); }
        u32x2 w; w.x = pk2(x[0], x[1]); w.y = pk2(x[2], x[3]); *(LAS u32x2*)(L + ((tid >> 6) + 8 * it) * 576 + (tid & 63) * 8) = w; }
    asm volatile("s_waitcnt lgkmcnt(0)\n\ts_barrier" ::: "memory");
    const int i = lane & 15, gn = (lane >> 4) & 1, h = lane >> 5, q = i >> 2, p = i & 3;
    const LAS unsigned char* base = L + (8 * h + q) * 576 + (32 * wave + 16 * gn) * 2 + 8 * p;
    if (!f8) {
        bf16* drow = dst + (size_t)(n0 + 32 * wave + 16 * gn + i) * Kd + k0 + 8 * h;
#pragma unroll
        for (int kcp = 0; kcp < 8; ++kcp) {
            const s16x4 lo = tr_read(base + (16 * kcp) * 576), hi = tr_read(base + (16 * kcp + 4) * 576);
            *(bf16x8*)(drow + 16 * kcp) = __builtin_shufflevector(lo, hi, 0, 1, 2, 3, 4, 5, 6, 7);
        }
    } else {
        unsigned char* drow = (unsigned char*)dst + (size_t)(n0 + 32 * wave + 16 * gn + i) * Kd + k0 + 8 * h;
#pragma unroll
        for (int kcp = 0; kcp < 8; ++kcp) {
            const s16x4 lo = tr_read(base + (16 * kcp) * 576), hi = tr_read(base + (16 * kcp + 4) * 576);
            int w0 = __builtin_amdgcn_cvt_pk_fp8_f32(bf2f((unsigned short)lo[0]), bf2f((unsigned short)lo[1]), 0, false); w0 = __builtin_amdgcn_cvt_pk_fp8_f32(bf2f((unsigned short)lo[2]), bf2f((unsigned short)lo[3]), w0, true);
            int w1 = __builtin_amdgcn_cvt_pk_fp8_f32(bf2f((unsigned short)hi[0]), bf2f((unsigned short)hi[1]), 0, false); w1 = __builtin_amdgcn_cvt_pk_fp8_f32(bf2f((unsigned short)hi[2]), bf2f((unsigned short)hi[3]), w1, true);
            u32x2 o; o.x = (unsigned)w0; o.y = (unsigned)w1;
            *(u32x2*)(drow + 16 * kcp) = o;
        }
    }
    asm volatile("s_waitcnt lgkmcnt(0)\n\ts_barrier" ::: "memory");
}
struct TrbItem { const float* src; bf16* dst; int N, n0, k0, f8; };
DI TrbItem trb_item(const Ctx& F, int it) {
    const int le = it / 96, r = it % 96; TrbItem t;
    if (r < 64) { t.src = ginp(F, I_WE1) + (size_t)le * 1024 * 2048; t.dst = (bf16*)(F.ws + WS_W1E + (size_t)le * 2048 * 1024); t.N = 2048; t.n0 = (r & 7) * 256; t.k0 = (r >> 3) * 128; t.f8 = 1; }
    else { const int q = r - 64; t.src = ginp(F, I_WE2) + (size_t)le * 1024 * 1024; t.dst = (bf16*)(F.ws + WS_W2E + (size_t)le * 1024 * 1024); t.N = 1024; t.n0 = (q & 3) * 256; t.k0 = (q >> 2) * 128; t.f8 = 1; }
    return t;
}
DI void conv_layer_tiles(const Ctx& F, int l, int q0, int i0, int cnt) {
    const int NL = 32 * 96;
    int it = q0 + F.blk + F.G * i0; const int end = q0 + F.blk + F.G * (i0 + cnt);
    if (it >= NL) return;
    f32x4 va[16];
    TrbItem ta = trb_item(F, l * NL + it);
    trb_load(va, ta.src, ta.N, ta.n0, ta.k0, F.tid);
#pragma unroll 1
    while (it < NL && it < end) {
        f32x4 vb[16];
#pragma unroll
        for (int k = 0; k < 16; ++k) vb[k] = va[k];
        const TrbItem tc = ta;
        it += F.G;
        const bool more = (it < NL && it < end);
        ta = trb_item(F, l * NL + (more ? it : 0));
        if (more) trb_load(va, ta.src, ta.N, ta.n0, ta.k0, F.tid);
        trb_store(vb, tc.dst, 1024, tc.n0, tc.k0, F.lds, F.tid, F.wave, F.lane, tc.f8);
    }
}
DI void conv_claim_tiles(const Ctx& F, int l, int quota) {
    const int NL = 32 * 96;
    volatile LAS unsigned* slot = (volatile LAS unsigned*)(F.lds + MISC_OFF) + 16;
    __syncthreads();
    if (F.tid == 0) { unsigned* q = (unsigned*)(F.ws + WS_CTL) + CW_CONVQ + l * 64; slot[0] = __hip_atomic_fetch_add(q, (unsigned)quota, __ATOMIC_RELAXED, __HIP_MEMORY_SCOPE_AGENT); }
    __syncthreads();
    int it = __builtin_amdgcn_readfirstlane((int)slot[0]); const int end = it + quota;
    if (it >= NL) return;
    f32x4 va[16];
    TrbItem ta = trb_item(F, l * NL + it);
    trb_load(va, ta.src, ta.N, ta.n0, ta.k0, F.tid);
#pragma unroll 1
    while (it < NL && it < end) {
        f32x4 vb[16];
#pragma unroll
        for (int k = 0; k < 16; ++k) vb[k] = va[k];
        const TrbItem tc = ta;
        it += 1;
        const bool more = (it < NL && it < end);
        ta = trb_item(F, l * NL + (more ? it : 0));
        if (more) trb_load(va, ta.src, ta.N, ta.n0, ta.k0, F.tid);
        trb_store(vb, tc.dst, 1024, tc.n0, tc.k0, F.lds, F.tid, F.wave, F.lane, tc.f8);
    }
}
DI void phase_prologue(const Ctx& F) {
    const Args& A = *F.a; const int tid = F.tid;
    LAS float* scr = (LAS float*)F.lds;
    if (!CONV_IN_LAYER) {
        const int NIT = DEPTH * 32 * 96;
        f32x4 va[16];
        int it = F.blk;
        TrbItem ta = trb_item(F, it < NIT ? it : 0);
        if (it < NIT) trb_load(va, ta.src, ta.N, ta.n0, ta.k0, tid);
#pragma unroll 1
        while (it < NIT) {
            f32x4 vb[16];
#pragma unroll
            for (int k = 0; k < 16; ++k) vb[k] = va[k];
            const TrbItem tc = ta;
            it += F.G;
            ta = trb_item(F, it < NIT ? it : 0);
            if (it < NIT) trb_load(va, ta.src, ta.N, ta.n0, ta.k0, tid);
            trb_store(vb, tc.dst, 1024, tc.n0, tc.k0, F.lds, tid, F.wave, F.lane, tc.f8);
        }
    }
    constexpr int PER_L = 8192 + 4096 + 320 + 128 + 128 + 16 + 16;
    for (int it = F.blk; it < DEPTH * PER_L; it += F.G) {
        const int l = it / PER_L; int r = it % PER_L;
        if (r < 8192 + 4096) continue;
        if (r < 8192) { const int e = r >> 8, t = r & 255;
            tr_tile(ginp(F, I_WE1) + ((size_t)(l * 32 + e)) * 1024 * 2048, 1024, 2048, (bf16*)(F.ws + WS_W1E) + ((size_t)(l * 32 + e)) * 2048 * 1024, 1024, 0, nullptr, t >> 3, t & 7, scr, tid); continue; }
        r -= 8192;
        if (r < 4096) { const int e = r >> 7, t = r & 127;
            tr_tile(ginp(F, I_WE2) + ((size_t)(l * 32 + e)) * 1024 * 1024, 1024, 1024, (bf16*)(F.ws + WS_W2E) + ((size_t)(l * 32 + e)) * 1024 * 1024, 1024, 0, nullptr, t >> 3, t & 7, scr, tid); continue; }
        r -= 4096;
        if (r < 320) { tr_tile(ginp(F, I_WIN) + (size_t)l * 1024 * 2488, 1024, 2488, (bf16*)(F.ws + WS_WIN) + (size_t)l * NIN * 1024, 1024, 1, nullptr, r >> 3, r & 7, scr, tid); continue; }
        r -= 320;
        if (r < 128) { tr_tile(ginp(F, I_WOUT) + (size_t)l * 1024 * 1024, 1024, 1024, (bf16*)(F.ws + WS_WOUT) + (size_t)l * 1024 * 1024, 1024, 0, nullptr, r >> 3, r & 7, scr, tid); continue; }
        r -= 128;
        if (r < 128) { const int kv = r >> 6, t = r & 63;
            tr_tile(ginp(F, kv ? I_W1V : I_W1K) + (size_t)l * 2048 * 256, 2048, 256, (bf16*)(F.ws + WS_NSAW1) + ((size_t)(l * 2 + kv)) * 256 * 2048, 2048, 0, nullptr, t >> 4, t & 15, scr, tid); continue; }
        r -= 128;
        if (r < 16) { tr_tile(ginp(F, I_WQUP) + (size_t)l * 256 * 384, 256, 384, (bf16*)(F.ws + WS_MLAQ) + (size_t)l * 512 * 256, 256, 2, ginp(F, I_GQ) + (size_t)l * 256, r >> 1, r & 1, scr, tid); continue; }
        r -= 16;
        tr_tile(ginp(F, I_WKVUP) + (size_t)l * 128 * 512, 128, 512, (bf16*)(F.ws + WS_MLAKV) + (size_t)l * 512 * 256, 256, 0, ginp(F, I_GKV) + (size_t)l * 128, r >> 1, r & 1, scr, tid);
    }
    for (int it = F.blk; it < DEPTH * 4; it += F.G) {
        const int l = it >> 2, kv = (it >> 1) & 1, kt = it & 1;
        tr_tile(ginp(F, kv ? I_W2V : I_W2K) + (size_t)l * 256 * 64, 256, 64, (bf16*)(F.ws + WS_W2T) + ((size_t)(l * 2 + kv)) * 64 * 256, 256, 0, nullptr, 0, kt, scr, tid);
    }
    {
        float* CS64 = (float*)(F.ws + WS_CS64); float* CS32 = (float*)(F.ws + WS_CS32);
        const int* pos = (const int*)ginp(F, I_POS);
        for (int idx = F.blk * 512 + tid; idx < T * 48; idx += F.G * 512) {
            const int tok = idx / 48, i = idx % 48;
            const double p = (double)pos[tok];
            const double inv = (i < 32) ? exp2(-(double)i * (13.287712379549449 / 32.0)) : exp2(-(double)(i - 32) * (13.287712379549449 / 16.0));
            double ang = p * inv;
            const double kk = __builtin_rint(ang * 0.15915494309189535);
            ang = ang - kk * 6.283185307179586;
            const float af = (float)ang;
            const float cs = __cosf(af), sn = __sinf(af);
            if (i < 32) { CS64[(size_t)tok * 64 + i] = cs; CS64[(size_t)tok * 64 + 32 + i] = sn; }
            else { CS32[(size_t)tok * 32 + (i - 32)] = cs; CS32[(size_t)tok * 32 + 16 + (i - 32)] = sn; }
        }
    }
    for (int item = F.blk; item < 32; item += F.G) {
        const int lk = item >> 2, l = lk >> 1, kv = lk & 1, col = (item & 3) * 64 + F.lane;
        const float* w1 = ginp(F, kv ? I_W1V : I_W1K) + (size_t)l * 2048 * 256 + col; const float* pe = ginp(F, kv ? I_POSV : I_POSK) + (size_t)l * 2048;
        float s = 0.f;
#pragma unroll 1
        for (int kb = 256 * F.wave; kb < 256 * F.wave + 256; kb += 16) {
            float wv[16];
#pragma unroll
            for (int j = 0; j < 16; ++j) wv[j] = w1[(size_t)(kb + j) * 256];
#pragma unroll
            for (int j = 0; j < 16; ++j) s += pe[kb + j] * wv[j];
        }
        scr[F.wave * 64 + F.lane] = s;
        __syncthreads();
        if (tid < 64) { float t = ginp(F, kv ? I_B1V : I_B1K)[(size_t)l * 256 + col];
#pragma unroll
            for (int ww = 0; ww < 8; ++ww) t += scr[ww * 64 + tid];
            ((float*)(F.ws + WS_B1P))[(size_t)lk * 256 + col] = t; }
        __syncthreads();
    }
    {
        LAS float* sc = scr; LAS float* red = scr + 8192;
        for (int i = tid; i < 8192; i += 512) { const float c = ginp(F, I_C)[i]; sc[i] = c * sigmoidf_(c); }
        __syncthreads();
        float* MODS = (float*)(F.ws + WS_MODS);
        const int lane = F.lane, w = F.wave;
        for (int item = F.blk; item < 384; item += F.G) {
            const int l = item / 96, col = (item % 96) * 64 + lane;
            float acc[8];
#pragma unroll
            for (int b = 0; b < 8; ++b) acc[b] = 0.f;
            const float* wa = ginp(F, I_WADA) + (size_t)l * 1024 * 6144 + col;
#pragma unroll 1
            for (int kb = 128 * w; kb < 128 * w + 128; kb += 16) {
                float wv[16];
#pragma unroll
                for (int j = 0; j < 16; ++j) wv[j] = wa[(size_t)(kb + j) * 6144];
#pragma unroll
                for (int j = 0; j < 16; ++j) {
#pragma unroll
                    for (int b = 0; b < 8; ++b) acc[b] += sc[b * 1024 + kb + j] * wv[j]; }
            }
#pragma unroll
            for (int b = 0; b < 8; ++b) red[(w * 8 + b) * 64 + lane] = acc[b];
            __syncthreads();
            { const int b = tid >> 6; float s = ginp(F, I_BADA)[(size_t)l * 6144 + col];
#pragma unroll
              for (int ww = 0; ww < 8; ++ww) s += red[(ww * 8 + b) * 64 + lane];
              MODS[((size_t)(l * 8 + b)) * 6144 + col] = s; }
            __syncthreads();
        }
    }
}

constexpr int PH_PER_LAYER = 11;
constexpr int N_PHASES = 1 + DEPTH * PH_PER_LAYER + 1;

__global__ void __launch_bounds__(512, 2) fwd_kernel(Args args) {
    extern __shared__ __attribute__((aligned(16))) unsigned char lds_raw[];
    Ctx F;
    F.lds = (LAS unsigned char*)lds_raw; F.a = &args; F.ws = args.ws;
    F.dofs = 0; F.dcnt = 0;
    F.tid = threadIdx.x; F.lane = F.tid & 63; F.wave = __builtin_amdgcn_readfirstlane(F.tid >> 6); F.blk = blockIdx.x; F.G = gridDim.x; F.vcu = F.blk;
    volatile LAS unsigned* MISC = (volatile LAS unsigned*)(F.lds + MISC_OFF);
    for (int u = F.tid; u < (LDS_BYTES - MISC_OFF) / 4; u += 512) MISC[u] = 0u;
    __syncthreads();
    unsigned* ctl = (unsigned*)(F.ws + WS_CTL);
    XcdBarrier bar; bar.bar = ctl + CW_BAR; bar.x = 0; bar.st = nullptr;
    if (!MK_PER_PHASE) bar = xcd_barrier_post(ctl + CW_BAR, MISC + 8);
    const int lo = args.ph_lo, hi = args.ph_hi;
#define IN(k) (lo <= (k) && (k) < hi)
#define SEAM(k) do { if (IN(k) && IN((k) + 1)) xcd_barrier(bar); } while (0)
    unsigned char* ws = F.ws;
#define PHASE_BEGIN() do { int t_ = threadIdx.x; asm volatile("" : "+v"(t_)); F.tid = t_; F.lane = t_ & 63; F.wave = __builtin_amdgcn_readfirstlane(t_ >> 6); \
        GAS unsigned char* w_ = (GAS unsigned char*)args.ws; asm volatile("" : "+s"(w_)); F.ws = (unsigned char*)w_; ws = (unsigned char*)w_; int b_ = blockIdx.x; asm volatile("" : "+s"(b_)); F.blk = b_; F.vcu = (F.G % 8 == 0) ? (b_ % 8) * (F.G / 8) + b_ / 8 : b_; } while (0)

    if (PHON(0) && IN(0)) _Pragma("unroll 1") for (int rep_ = 0; rep_ < NREP(0); ++rep_) { PHASE_BEGIN(); phase_prologue(F); }
    SEAM(0);
#pragma unroll 1
    for (int l = 0; l < DEPTH; ++l) {
        const int P = 1 + l * PH_PER_LAYER;
        if (PHON(1) && IN(P + 0)) _Pragma("unroll 1") for (int rep_ = 0; rep_ < (DUM(1) ? 2 : 1); ++rep_) { PHASE_BEGIN(); F.dofs = (DUM(1) && rep_ == 0) ? WS_END : 0; phase_norm1<0>(F, l); }
        SEAM(P + 0);
        if (PHON(2) && IN(P + 1)) _Pragma("unroll 1") for (int rep_ = 0; rep_ < NREP(2); ++rep_) { PHASE_BEGIN();
            SchedGrid Sg{(const char*)(ws + WS_H), (const char*)(ws + WS_WIN) + (size_t)l * NIN * 1024 * 2, 1024, 1024, NIN / 256, (T / 256) * (NIN / 256), F.G, F.vcu};
            EpiWin E{ws, (const float*)(ws + WS_CS64), (const float*)(ws + WS_CS32)};
            pg8::gemm_phase<EpiWin, SchedGrid, false>(F.lds, 1024, 1024, Sg, E);
        }
        SEAM(P + 1);
        if (PHON(3) && IN(P + 2)) _Pragma("unroll 1") for (int rep_ = 0; rep_ < NREP(3); ++rep_) { PHASE_BEGIN();
            if (PHON(13)) {
                SchedCmp Sc{(const char*)(ws + WS_KCMP), (const char*)(ws + WS_VCMP), (const char*)(ws + WS_NSAW1) + (size_t)l * 2 * 256 * 2048 * 2, F.G, F.blk};
                EpiCmp E{(const float*)(ws + WS_B1P) + (size_t)l * 512, (const bf16*)(ws + WS_W2T) + (size_t)l * 2 * 64 * 256, ginp(F, I_B2K) + (size_t)l * 64, ginp(F, I_B2V) + (size_t)l * 64,
                         (bf16*)(ws + WS_KC), (bf16*)(ws + WS_VC), (const float*)(ws + WS_CS64)};
                pg8::gemm_phase<EpiCmp, SchedCmp, false>(F.lds, 1024, 2048, Sc, E);
            }
            PHASE_BEGIN();
            if (PHON(18)) {
                SchedMla Sm{(const char*)(ws + WS_CQ), (const char*)(ws + WS_MISC), (const char*)(ws + WS_MLAQ) + (size_t)l * 512 * 256 * 2, (const char*)(ws + WS_MLAKV) + (size_t)l * 512 * 256 * 2, F.G, F.vcu};
                EpiMla E{(bf16*)(ws + WS_QM), (bf16*)(ws + WS_KN), (bf16*)(ws + WS_VM), (const bf16*)(ws + WS_CQ), (const bf16*)(ws + WS_MISC), (const float*)(ws + WS_CS32)};
                pg8::gemm_phase<EpiMla, SchedMla, false>(F.lds, 256, 256, Sm, E);
            }
            PHASE_BEGIN();
            if (PHON(15)) {
                unsigned* qw = (unsigned*)(ws + WS_CTL) + CW_QUEUE + (l * 2 + rep_) * 64;
                volatile LAS int* qslot = (volatile LAS int*)(F.lds + AUX_OFF + 512);
                int nxt_t = 0;
                if (F.tid == 0) nxt_t = (int)__hip_atomic_fetch_add(qw, 1u, RLX_AGENT);
                for (;;) {
                    if (F.tid == 0) { qslot[0] = nxt_t; nxt_t = (int)__hip_atomic_fetch_add(qw, 1u, RLX_AGENT); }
                    __syncthreads();
                    const int uq = qslot[0];
                    __syncthreads();
                    if (uq >= 2560) break;
                    if (uq < 1024) {
                        const int u = uq;
                        PolB pb; pb.Q = (const bf16*)(ws + WS_QB); pb.K = (const bf16*)(ws + WS_KWIN); pb.V = (const bf16*)(ws + WS_VWIN); pb.O = (bf16*)(ws + WS_OWIN);
                        pb.b = u >> 7; pb.g = (u >> 6) & 1; pb.qc = 63 - (u & 63); pb.maxd = 511u; pb.j0 = pb.qc > 8 ? pb.qc - 8 : 0; pb.j1 = pb.qc + 1;
                        attn_unit<64, PolB, false>(pb, F.lds, F.tid, F.lane, F.wave, 0ull);
                    } else {
                        const int uu = uq - 1024;
                        const int bh = uu / 48, w48 = uu % 48, p = w48 >> 4, s16 = w48 & 15;
                        PolA pa; pa.Q = (const bf16*)(ws + WS_QA); pa.K = (const bf16*)(ws + WS_KA); pa.V = (const bf16*)(ws + WS_VA);
                        pa.O = (bf16*)(ws + WS_OA3) + (size_t)p * T * 256; pa.LSEP = (float*)(ws + WS_LSEA) + (size_t)p * T * 4;
                        pa.b = bh >> 2; pa.h = bh & 3; pa.d = p == 0 ? 1 : (p == 1 ? 4 : 16);
                        const int cpr = p == 0 ? 16 : (p == 1 ? 4 : 1);
                        pa.r = s16 / cpr; pa.c = s16 % cpr; pa.maxd = 128u; pa.j0 = pa.c == 0 ? 2 : 0; pa.j1 = 6;
                        attn_unit<64, PolA, false>(pa, F.lds, F.tid, F.lane, F.wave, 0ull);
                    }
                }
            }
        }
        SEAM(P + 2);
        if (PHON(5) && IN(P + 4)) _Pragma("unroll 1") for (int rep_ = 0; rep_ < NREP(5); ++rep_) { PHASE_BEGIN();
            int cti = 0;
            int cq0 = 0;
            if (CONV_IN_LAYER) { const unsigned t_ = __hip_atomic_load((unsigned*)(ws + WS_CTL) + CW_CONVQ + l * 64, __ATOMIC_RELAXED, __HIP_MEMORY_SCOPE_AGENT); cq0 = __builtin_amdgcn_readfirstlane((int)(t_ < 3072u ? t_ : 3072u)); }
            if (PHON(19)) for (int u = F.vcu; u < 1024; u += F.G) {
                const int bg = (u % 256) >> 4, k = u & 15, rnd = u >> 8;
                const int qc = rnd == 0 ? 2 * k : (rnd == 1 ? 2 * k + 1 : (rnd == 2 ? 63 - 2 * k : 62 - 2 * k));
                const u64 sel = cmp_unit(F, bg >> 1, bg & 1, qc);
                PolB pb; pb.Q = (const bf16*)(ws + WS_QB); pb.K = (const bf16*)(ws + WS_KSLC); pb.V = (const bf16*)(ws + WS_VSLC); pb.O = (bf16*)(ws + WS_OSLC);
                pb.b = bg >> 1; pb.g = bg & 1; pb.qc = qc; pb.maxd = 0x7fffffffu; pb.j0 = 0; pb.j1 = qc + 1;
                pb.GC = (const bf16*)(ws + WS_OCMP); pb.GW = (const bf16*)(ws + WS_OWIN); pb.GM = (const bf16*)(ws + WS_MISC);
                attn_unit<64, PolB, true>(pb, F.lds, F.tid, F.lane, F.wave, sel);
                if (CONV_IN_LAYER && rep_ == 0) { PHASE_BEGIN(); conv_layer_tiles(F, l, cq0, cti, 2); cti += 2; }
            }
            PHASE_BEGIN();
            if (PHON(20)) for (int v = F.vcu; v < 512; v += F.G) {
                const int bh = (v & 255) >> 3, k = v & 7, c = (v < 256) ? k : 15 - k;
                PolM pm; pm.Q = (const bf16*)(ws + WS_QM); pm.KN = (const bf16*)(ws + WS_KN); pm.KR = (const bf16*)(ws + WS_KR); pm.V = (const bf16*)(ws + WS_VM); pm.O = (bf16*)(ws + WS_OC);
                pm.b = bh >> 2; pm.h = bh & 3; pm.c = c; pm.maxd = 0x7fffffffu; pm.j0 = 0; pm.j1 = 4 * c + 4;
                attn_unit<96, PolM, false>(pm, F.lds, F.tid, F.lane, F.wave, 0ull);
                if (CONV_IN_LAYER && rep_ == 0) { PHASE_BEGIN(); conv_layer_tiles(F, l, cq0, cti, 2); cti += 2; }
            }
            if (CONV_IN_LAYER && rep_ == 0) { PHASE_BEGIN(); conv_layer_tiles(F, l, cq0, cti, 1 << 20); }
        }
        SEAM(P + 4);
        if (PHON(7) && IN(P + 6)) _Pragma("unroll 1") for (int rep_ = 0; rep_ < NREP(7); ++rep_) { PHASE_BEGIN(); phase_mix(F, l); }
        SEAM(P + 6);
        if (PHON(8) && IN(P + 7)) _Pragma("unroll 1") for (int rep_ = 0; rep_ < (DUM(8) ? 2 : 1); ++rep_) { PHASE_BEGIN(); F.dofs = (DUM(8) && rep_ == 0) ? WS_END : 0;
            SchedGrid Sg{(const char*)(ws + WS_AMIX), (const char*)(ws + WS_WOUT) + (size_t)l * 1024 * 1024 * 2, 1024, 1024, 4, (T / 256) * 4, F.G, F.vcu};
            EpiWout E{(bf16*)(ws + WS_X), (const float*)(ws + WS_MODS) + ((size_t)(l * 8) * 6 + 2) * 1024, F.dofs};
            pg8::gemm_phase<EpiWout, SchedGrid, false>(F.lds, 1024, 1024, Sg, E);
        }
        SEAM(P + 7);
        if (PHON(9) && IN(P + 8)) _Pragma("unroll 1") for (int rep_ = 0; rep_ < (DUM(9) ? 2 : 1); ++rep_) { PHASE_BEGIN(); F.dofs = (DUM(9) && rep_ == 0) ? WS_END : 0; F.dcnt = (DUM(9) && rep_ == 0) ? 4 : 0; phase_router(F, l); }
        SEAM(P + 8);
        if (PHON(10) && IN(P + 9)) _Pragma("unroll 1") for (int rep_ = 0; rep_ < NREP(10); ++rep_) { PHASE_BEGIN();
            moe_tables(F, l);
            const LAS int* tb = (const LAS int*)(F.lds + AUX_OFF);
            SchedMoe1F8 Sm{tb, tb + 64, (const char*)(ws + WS_H), (const char*)(ws + WS_W1E) + (size_t)l * 32 * 2048 * 1024, (const int*)(ws + WS_IDX), tb[32] * 8, F.G, F.vcu};
            EpiMoe1 E{(bf16*)(ws + WS_ACT), ginp(F, I_BE1) + (size_t)l * 32 * 2048};
            pg8::gemm_phase<EpiMoe1, SchedMoe1F8, true, true>(F.lds, 512, 512, Sm, E);
            if (CONV_IN_LAYER && CONV_TAIL1 > 0 && rep_ == 0 && l + 1 < DEPTH) {
                const int nun = tb[32] * 8, rounds = (nun + F.G - 1) / F.G, mine = F.vcu < nun ? (nun - 1 - F.vcu) / F.G + 1 : 0;
                if (mine < rounds) { PHASE_BEGIN(); conv_claim_tiles(F, l + 1, CONV_TAIL1); }
            }
        }
        SEAM(P + 9);
        if (PHON(11) && IN(P + 10)) _Pragma("unroll 1") for (int rep_ = 0; rep_ < NREP(11); ++rep_) { PHASE_BEGIN();
            moe_tables(F, l);
            const LAS int* tb = (const LAS int*)(F.lds + AUX_OFF);
            SchedMoe2F8 Sm{tb, (const char*)(ws + WS_ACT), (const char*)(ws + WS_W2E) + (size_t)l * 32 * 1024 * 1024, tb[32] * 4, F.G, F.vcu};
            EpiMoe2 E{(unsigned char*)(ws + WS_Y2), ginp(F, I_BE2) + (size_t)l * 32 * 1024, (const float*)(ws + WS_GATEW)};
            pg8::gemm_phase<EpiMoe2, SchedMoe2F8, false, true>(F.lds, 512, 512, Sm, E);
            if (CONV_IN_LAYER && CONV_TAIL2 > 0 && rep_ == 0 && l + 1 < DEPTH) {
                const int nun = tb[32] * 4, rounds = (nun + F.G - 1) / F.G, mine = F.vcu < nun ? (nun - 1 - F.vcu) / F.G + 1 : 0;
                if (mine < rounds) { PHASE_BEGIN(); conv_claim_tiles(F, l + 1, CONV_TAIL2); }
            }
        }
        SEAM(P + 10);
    }
    if (PHON(12) && IN(N_PHASES - 1)) { PHASE_BEGIN(); phase_norm1<1>(F, DEPTH); }
#undef IN
#undef SEAM
}

extern "C" void kernel_launch(void* const* d_in, const int* in_sizes, int n_in, void* d_out, int out_size, void* d_ws, size_t ws_size, hipStream_t stream) {
    static int grid = 0;
    if (grid == 0) {
        if (n_in != 33 || out_size != T * D || ws_size < WS_END * (DUM_MASK ? 2 : 1)) { fprintf(stderr, "kernel_launch: unexpected problem (n_in %d out %d ws %zu)\n", n_in, out_size, ws_size); grid = -1; return; }
        int dev = 0, cus = 0, per_cu = 0;
        if (hipGetDevice(&dev) != hipSuccess || hipDeviceGetAttribute(&cus, hipDeviceAttributeMultiprocessorCount, dev) != hipSuccess) { grid = -1; return; }
        if (hipFuncSetAttribute((const void*)fwd_kernel, hipFuncAttributeMaxDynamicSharedMemorySize, LDS_BYTES) != hipSuccess) { fprintf(stderr, "kernel_launch: hipFuncSetAttribute failed\n"); grid = -1; return; }
        if (hipOccupancyMaxActiveBlocksPerMultiprocessor(&per_cu, (const void*)fwd_kernel, 512, LDS_BYTES) != hipSuccess || per_cu < 1) { fprintf(stderr, "kernel_launch: occupancy query says %d\n", per_cu); per_cu = 1; }
        (void)hipGetLastError();
        grid = cus;
    }
    if (grid < 0) return;
    if (hipMemsetAsync((char*)d_ws + WS_CTL, 0, CTL_ZERO_BYTES, stream) != hipSuccess) return;
    Args a{};
    for (int i = 0; i < 33; ++i) a.in[i] = (const float*)d_in[i];
    a.out = (float*)d_out; a.ws = (unsigned char*)d_ws;
#if MK_PER_PHASE
    for (int p = 0; p < N_PHASES; ++p) { a.ph_lo = p; a.ph_hi = p + 1; hipLaunchKernelGGL(fwd_kernel, dim3(grid), dim3(512), LDS_BYTES, stream, a); }
#else
    a.ph_lo = 0; a.ph_hi = N_PHASES;
    hipLaunchKernelGGL(fwd_kernel, dim3(grid), dim3(512), LDS_BYTES, stream, a);
#endif
}
```

```cpp
#include <hip/hip_runtime.h>
#include <cstdio>
#include <cstdint>

#ifndef MK_PER_PHASE
#define MK_PER_PHASE 0
#endif

#ifndef PH_MASK
#define PH_MASK 0xFFFFFFFFu
#endif
#define PHON(k) ((PH_MASK >> (k)) & 1u)
#ifndef DBL_MASK
#define DBL_MASK 0u
#endif
#define NREP(k) (((DBL_MASK >> (k)) & 1u) ? 2 : 1)
#ifndef DUM_MASK
#define DUM_MASK 0u
#endif
#define DUM(k) ((DUM_MASK >> (k)) & 1u)
#ifndef ATT_VAR
#define ATT_VAR 0
#endif
#ifndef CONV_IN_LAYER
#define CONV_IN_LAYER 1
#endif
#ifndef CONV_TAIL1
#define CONV_TAIL1 3
#endif
#ifndef CONV_TAIL2
#define CONV_TAIL2 4
#endif
#ifndef ATT_STAGGER
#define ATT_STAGGER 0
#endif
#define DI __device__ __forceinline__
#define LAS __attribute__((address_space(3)))
#define GAS __attribute__((address_space(1)))
typedef unsigned short bf16;
typedef short bf16x8 __attribute__((ext_vector_type(8)));
typedef short s16x4 __attribute__((ext_vector_type(4)));
typedef float f32x2 __attribute__((ext_vector_type(2)));
typedef float f32x4 __attribute__((ext_vector_type(4)));
typedef float f32x16 __attribute__((ext_vector_type(16)));
typedef unsigned u32x2 __attribute__((ext_vector_type(2)));
typedef unsigned u32x4 __attribute__((ext_vector_type(4)));
typedef __bf16 bf16x2_t __attribute__((ext_vector_type(2)));
typedef unsigned long long u64;

constexpr int NB = 8, S = 4096, T = NB * S, D = 1024, DEPTH = 4;
constexpr int NIN = 2560;
constexpr int NE = 32, DFF = 1024;
constexpr int SP = S + 64;
constexpr int ECAP = 32768;
constexpr int ACT_ROWS = 4 * T + NE * 256;
constexpr float LOG2E = 1.4426950408889634f;
constexpr float SCL64 = 0.125f * LOG2E;
constexpr float SCL96 = 0.10206207261596577f * LOG2E;
constexpr float EPS = 1e-6f;

constexpr size_t MiB = 1u << 20;
constexpr size_t WS_CTL = 0, CTL_ZERO_BYTES = 2 * MiB;
constexpr size_t WS_MODS = 2 * MiB, WS_B1P = 3 * MiB, WS_CS64 = 4 * MiB, WS_CS32 = 12 * MiB;
constexpr size_t WS_WIN = 16 * MiB, WS_WOUT = 36 * MiB, WS_NSAW1 = 44 * MiB, WS_MLAQ = 52 * MiB, WS_MLAKV = 53 * MiB;
constexpr size_t WS_W1E = 64 * MiB, WS_W2E = 576 * MiB;
constexpr size_t WS_X = 832 * MiB, WS_H = 960 * MiB;
constexpr size_t WS_QA = 1024 * MiB, WS_KA = 1040 * MiB, WS_VA = 1056 * MiB, WS_QB = 1072 * MiB;
constexpr size_t WS_KCMP = 1104 * MiB, WS_VCMP = 1113 * MiB;
constexpr size_t WS_KSLC = 1122 * MiB, WS_VSLC = 1130 * MiB, WS_KWIN = 1138 * MiB, WS_VWIN = 1146 * MiB;
constexpr size_t WS_CQ = 1154 * MiB, WS_MISC = 1170 * MiB;
constexpr size_t WS_RSTDQ = 1186 * MiB, WS_RSTDKV = 1186 * MiB + 512 * 1024, WS_KR = 1187 * MiB, WS_GATES = 1189 * MiB;
constexpr size_t WS_W2T = 1195 * MiB;
constexpr size_t WS_HID = 1192 * MiB, WS_KC = 1196 * MiB, WS_VC = 1196 * MiB + 512 * 1024;
constexpr size_t WS_QM = 1197 * MiB, WS_KN = 1221 * MiB, WS_VM = 1237 * MiB;
constexpr size_t WS_OA3 = 1253 * MiB, WS_LSEA = 1301 * MiB;
constexpr size_t WS_OCMP = 1303 * MiB, WS_OSLC = 1335 * MiB, WS_OWIN = 1367 * MiB, WS_OC = 1399 * MiB;
constexpr size_t WS_SEL = 1415 * MiB, WS_AMIX = 1416 * MiB;
constexpr size_t WS_IDX = 1480 * MiB, WS_GATEW = 1484 * MiB, WS_TOKSLOT = 1488 * MiB, WS_TOKG = WS_TOKSLOT + 512 * 1024;
constexpr size_t WS_ACT = 1489 * MiB, WS_Y2 = 1761 * MiB, WS_END = 2033 * MiB;
static_assert((size_t)ACT_ROWS * 1024 * 2 <= 272 * MiB, "act rows");
static_assert((size_t)16 * SP * 64 * 2 + 65536 <= 9 * MiB, "kcmp");

constexpr int CW_TMO = 0, CW_FAIL = 2;
constexpr int CW_BAR = 4096;
constexpr int CW_QUEUE = 12288;
constexpr int CW_CONVQ = 13312;
constexpr int CW_CNT = 16384;

constexpr int RING_BYTES = 131072;
constexpr int AUX_OFF = RING_BYTES;
constexpr int MISC_OFF = AUX_OFF + 8192;
constexpr int LDS_BYTES = 147456;

DI unsigned pk2(float lo, float hi) { f32x2 v = {lo, hi}; bf16x2_t b = __builtin_convertvector(v, bf16x2_t); return __builtin_bit_cast(unsigned, b); }
DI float bf2f(unsigned short h) { return __uint_as_float(((unsigned)h) << 16); }
DI float bflo(unsigned w) { return __uint_as_float(w << 16); }
DI float bfhi(unsigned w) { return __uint_as_float(w & 0xffff0000u); }
typedef float f32x2c __attribute__((ext_vector_type(2)));
constexpr float Y2_SCALE = 4.0f, Y2_ISCALE = 1.0f / 4.0f;
DI unsigned pk4_fp8(float a, float b, float c, float d) {
    a = fminf(fmaxf(a * Y2_SCALE, -440.f), 440.f); b = fminf(fmaxf(b * Y2_SCALE, -440.f), 440.f); c = fminf(fmaxf(c * Y2_SCALE, -440.f), 440.f); d = fminf(fmaxf(d * Y2_SCALE, -440.f), 440.f);
    int w = __builtin_amdgcn_cvt_pk_fp8_f32(a, b, 0, false); w = __builtin_amdgcn_cvt_pk_fp8_f32(c, d, w, true); return (unsigned)w; }
DI f32x4 unpk4_fp8(unsigned w) { const f32x2c lo = __builtin_amdgcn_cvt_pk_f32_fp8((int)w, false), hi = __builtin_amdgcn_cvt_pk_f32_fp8((int)w, true); return (f32x4){lo.x, lo.y, hi.x, hi.y}; }
constexpr float W8_SCALE = 64.0f, A8_SCALE = 4.0f;
constexpr int W8_E8M0 = 127 - 6, A8_E8M0 = 127 - 2;
constexpr float H8_SCALE = 8.0f; constexpr int H8_E8M0 = 127 - 3;
DI int lane_id() { return (int)__builtin_amdgcn_mbcnt_hi(~0u, __builtin_amdgcn_mbcnt_lo(~0u, 0u)); }
DI unsigned pk4_fp8s(float a, float b, float c, float d, float sc) {
    a = fminf(fmaxf(a * sc, -440.f), 440.f); b = fminf(fmaxf(b * sc, -440.f), 440.f); c = fminf(fmaxf(c * sc, -440.f), 440.f); d = fminf(fmaxf(d * sc, -440.f), 440.f);
    int w = __builtin_amdgcn_cvt_pk_fp8_f32(a, b, 0, false); w = __builtin_amdgcn_cvt_pk_fp8_f32(c, d, w, true); return (unsigned)w; }
DI float q8s(float x, float sc) {
    const float a = fminf(fmaxf(x * sc, -440.f), 440.f); const int w = __builtin_amdgcn_cvt_pk_fp8_f32(a, a, 0, false);
    const f32x2c r = __builtin_amdgcn_cvt_pk_f32_fp8(w, false); return r.x; }
template <int CTRL> DI float dpp_perm(float v) { return __builtin_bit_cast(float, __builtin_amdgcn_update_dpp(0, __builtin_bit_cast(int, v), CTRL, 0xf, 0xf, false)); }
DI float row_sum16(float v) { v += dpp_perm<0xB1>(v); v += dpp_perm<0x4E>(v); v += dpp_perm<0x141>(v); v += dpp_perm<0x140>(v); return v; }
DI float wave_sum(float v) {
    v = row_sum16(v);
    const float r0 = __builtin_bit_cast(float, __builtin_amdgcn_readlane(__builtin_bit_cast(int, v), 0)), r1 = __builtin_bit_cast(float, __builtin_amdgcn_readlane(__builtin_bit_cast(int, v), 16));
    const float r2 = __builtin_bit_cast(float, __builtin_amdgcn_readlane(__builtin_bit_cast(int, v), 32)), r3 = __builtin_bit_cast(float, __builtin_amdgcn_readlane(__builtin_bit_cast(int, v), 48));
    return (r0 + r1) + (r2 + r3);
}
DI float fast_exp2(float x) { return __builtin_amdgcn_exp2f(x); }
DI float fast_rcp(float x) { return __builtin_amdgcn_rcpf(x); }
DI float sigmoidf_(float x) { return fast_rcp(1.0f + fast_exp2(-x * LOG2E)); }
#define RLX_AGENT __ATOMIC_RELAXED, __HIP_MEMORY_SCOPE_AGENT

#define XB_TMO      128
#define XB_XCNT(j)  (256  + 64 * (j))
#define XB_XSUB(j)  (1280 + 64 * (j))
#define XB_XGEN(j)  (2304 + 64 * (j))
#define XB_TOP      3328
#define XB_TOPGEN   3392
#define XCD_BAR_WORDS 3456
#define XB_SPIN_CAP (1u << 22)
DI unsigned xb_ld(unsigned* p)              { return __hip_atomic_load(p, __ATOMIC_RELAXED, __HIP_MEMORY_SCOPE_AGENT); }
DI unsigned xb_add(unsigned* p, unsigned v) { return __hip_atomic_fetch_add(p, v, __ATOMIC_RELAXED, __HIP_MEMORY_SCOPE_AGENT); }
DI unsigned xb_xcc_id() { return (unsigned)__builtin_amdgcn_s_getreg((3 << 11) | 20) & 0xFu; }
#define XB_SPIN(cond, bar) do { unsigned _sp = 0; while (cond) { __builtin_amdgcn_s_sleep(1); \
    if ((++_sp & 255u) == 0u) { if (xb_ld(&(bar)[XB_TMO])) break; if (_sp > XB_SPIN_CAP) { atomicAdd(&(bar)[XB_TMO], 1u); break; } } } } while (0)
struct XcdBarrier { unsigned* bar; unsigned x; volatile LAS unsigned* st; };
DI XcdBarrier xcd_barrier_post(unsigned* bar, volatile LAS unsigned* st) {
    XcdBarrier b; b.bar = bar; b.x = xb_xcc_id(); b.st = st;
    if (threadIdx.x == 0) (void)xb_add(&bar[XB_XCNT(b.x)], 1u);
    return b;
}
DI void xcd_barrier_complete(unsigned* bar, unsigned x, unsigned& nloc, unsigned& nx) {
    const unsigned G = gridDim.x * gridDim.y * gridDim.z;
    unsigned sum, cnt, mine, sp = 0u;
    for (;;) {
        sum = 0u; cnt = 0u; mine = 0u;
#pragma unroll
        for (unsigned j = 0; j < 16; ++j) { const unsigned c = xb_ld(&bar[XB_XCNT(j)]); sum += c; cnt += (c > 0u) ? 1u : 0u; mine = (j == x) ? c : mine; }
        if (sum == G) break;
        __builtin_amdgcn_s_sleep(1);
        if ((++sp & 255u) == 0u) { if (xb_ld(&bar[XB_TMO])) break; if (sp > XB_SPIN_CAP) { atomicAdd(&bar[XB_TMO], 1u); break; } }
    }
    nloc = mine > 0u ? mine : 1u; nx = cnt > 0u ? cnt : 1u;
}
DI void xcd_barrier(const XcdBarrier& b) {
    asm volatile("s_waitcnt vmcnt(0)" ::: "memory");
    __syncthreads();
    unsigned* bar = b.bar; asm volatile("" : "+s"(bar));
    if (threadIdx.x == 0) {
        __builtin_amdgcn_s_waitcnt(0);
        unsigned nloc = b.st[0], nx = b.st[1];
        if (nloc == 0u) { xcd_barrier_complete(bar, b.x, nloc, nx); b.st[0] = nloc; b.st[1] = nx; }
        const unsigned old = xb_add(&bar[XB_XSUB(b.x)], 1u);
        const unsigned gen = old / nloc;
        if (old + 1u == (gen + 1u) * nloc) {
            __builtin_amdgcn_fence(__ATOMIC_RELEASE, "agent");
            asm volatile("s_waitcnt vmcnt(0)" ::: "memory");
            const unsigned og = xb_add(&bar[XB_TOP], 1u);
            const unsigned tg = og / nx;
            if (og + 1u == (tg + 1u) * nx) xb_add(&bar[XB_TOPGEN], 1u);
            else XB_SPIN(xb_ld(&bar[XB_TOPGEN]) == tg, bar);
            __builtin_amdgcn_fence(__ATOMIC_ACQUIRE, "agent");
            xb_add(&bar[XB_XGEN(b.x)], 1u);
            asm volatile("s_waitcnt vmcnt(0)" ::: "memory");
        } else {
            XB_SPIN(xb_ld(&bar[XB_XGEN(b.x)]) == gen, bar);
            __builtin_amdgcn_fence(__ATOMIC_ACQUIRE, "agent");
            asm volatile("s_waitcnt vmcnt(0)" ::: "memory");
        }
    }
    __syncthreads();
}

struct Args {
    const float* in[33];
    float* out;
    unsigned char* ws;
    int ph_lo, ph_hi;
};
enum { I_X = 0, I_C, I_POS, I_WADA, I_BADA, I_G1, I_G2, I_WIN, I_POSK, I_POSV, I_W1K, I_B1K, I_W2K, I_B2K, I_W1V, I_B1V, I_W2V, I_B2V,
       I_GQ, I_GKV, I_WQUP, I_WKVUP, I_GOA, I_GOB, I_GOC, I_WOUT, I_WR, I_BR, I_WE1, I_BE1, I_WE2, I_BE2, I_GF };

struct Ctx {
    LAS unsigned char* lds;
    const Args* a;
    unsigned char* ws;
    int tid, lane, wave, blk, G, vcu;
    size_t dofs; int dcnt;
};
DI const float* ginp(const Ctx& F, int i) { return (const float*)(GAS const float*)(F.a->in[i]); }
DI float* gout(const Ctx& F) { return (float*)(GAS float*)(F.a->out); }

namespace pg8 {
constexpr int BM = 256, BK = 64, HALF = 128, HTB = HALF * BK * 2;
DI int lds_byte(int r, int c) { const int st = (r >> 4) * 2 + (c >> 5), rr = r & 15, cc = c & 31, ob = rr * 64 + cc * 2; return st * 1024 + (ob ^ (((ob >> 9) & 1) << 5)); }
DI void stage_rc(int b, int& R, int& C) { const int st = b / 1024, sb = b % 1024, swz = sb ^ (((sb >> 9) & 1) << 5); R = (st >> 1) * 16 + swz / 64; C = (st & 1) * 32 + (swz % 64) / 2; }
DI int perm32(int rho) { const int n = rho >> 4, i = rho & 15; return 8 * (i >> 2) + 4 * n + (i & 3); }
struct Unit { const char* a; const char* b; int pm, pn, e, ml; };

template <class Epi, class Sched, bool GATHER, bool FP8 = false>
DI void gemm_phase(LAS unsigned char* lds, const int lda, const int K, const Sched& S, const Epi& E) {
    typedef int i32x4_ __attribute__((ext_vector_type(4))); typedef int i32x8_ __attribute__((ext_vector_type(8)));
    int tid_ = threadIdx.x; asm volatile("" : "+v"(tid_));
    const int tid = tid_, wid = __builtin_amdgcn_readfirstlane(tid >> 6), lane = tid & 63, wr = wid >> 2, wc = wid & 3, fr = lane & 15, fq = lane >> 4;
    const int nt = K / BK;
    int Rr[2], Cc[2]; unsigned voffB[2];
#pragma unroll
    for (int i = 0; i < 2; ++i) { int R, C; stage_rc(tid * 16 + i * 8192, R, C); Rr[i] = R; Cc[i] = C; const int Rb = Epi::PERM ? ((R & ~31) + perm32(R & 31)) : R; voffB[i] = (unsigned)(Rb * K + C) * 2u; }
    const size_t kstep = (size_t)(BK * 2);
    const size_t hstepB = (size_t)HALF * K * 2;
    const unsigned ldsw = (unsigned)wid * 1024u;
    const int aoff = lds_byte(wr * 64 + fr, fq * 8), boff = lds_byte(wc * 32 + fr, fq * 8);
#define PG8_SA(b, h) (((b) * 2 + (h)) * HTB)
#define PG8_SB(b, h) ((4 + (b) * 2 + (h)) * HTB)
#define PG8_STAGE_B(bufoff, gbase) do { _Pragma("unroll") for (int _i = 0; _i < 2; ++_i) \
        __builtin_amdgcn_global_load_lds((const unsigned*)((const char*)(gbase) + (size_t)_i * 64 * K * 2 + voffB[0]), (LAS unsigned*)(lds + (bufoff) + ldsw + _i * 8192), 16, 0, 0); } while (0)
#define PG8_STAGE_A(bufoff, gbase, v, h) do { _Pragma("unroll") for (int _i = 0; _i < 2; ++_i) { \
        if constexpr (GATHER) __builtin_amdgcn_global_load_lds((const unsigned*)((const char*)(gbase) + (v)[h][_i]), (LAS unsigned*)(lds + (bufoff) + ldsw + _i * 8192), 16, 0, 0); \
        else __builtin_amdgcn_global_load_lds((const unsigned*)((const char*)(gbase) + (size_t)((h) * 128 + _i * 64) * lda * 2 + (v)[0][0]), (LAS unsigned*)(lds + (bufoff) + ldsw + _i * 8192), 16, 0, 0); } } while (0)
#define PG8_SETOFF(v, u) do { _Pragma("unroll") for (int _h = 0; _h < 2; ++_h) _Pragma("unroll") for (int _i = 0; _i < 2; ++_i) { \
        if constexpr (GATHER) (v)[_h][_i] = S.gather_off((u), _h * 128 + Rr[_i]) + (unsigned)Cc[_i] * 2u; \
        else (v)[_h][_i] = (unsigned)((_h * 128 + Rr[_i]) * lda + Cc[_i]) * 2u; } } while (0)
#define PG8_LDA(dst, b, h) do { _Pragma("unroll") for (int m = 0; m < 4; ++m) { const i32x4_ lo_ = *(const LAS i32x4_*)(lds + PG8_SA(b, h) + aoff + m * 2048), hi_ = *(const LAS i32x4_*)(lds + PG8_SA(b, h) + aoff + m * 2048 + 1024); dst[m] = __builtin_shufflevector(lo_, hi_, 0, 1, 2, 3, 4, 5, 6, 7); } } while (0)
#define PG8_LDB(dst, b, h) do { _Pragma("unroll") for (int n = 0; n < 2; ++n) { const i32x4_ lo_ = *(const LAS i32x4_*)(lds + PG8_SB(b, h) + boff + n * 2048), hi_ = *(const LAS i32x4_*)(lds + PG8_SB(b, h) + boff + n * 2048 + 1024); dst[n] = __builtin_shufflevector(lo_, hi_, 0, 1, 2, 3, 4, 5, 6, 7); } } while (0)
#define PG8_H0(x) __builtin_bit_cast(bf16x8, __builtin_shufflevector((x), (x), 0, 1, 2, 3))
#define PG8_H1(x) __builtin_bit_cast(bf16x8, __builtin_shufflevector((x), (x), 4, 5, 6, 7))
#define PG8_MMA(ai, bj, At, Bt) do { __builtin_amdgcn_s_setprio(1); \
        if constexpr (FP8) { _Pragma("unroll") for (int m = 0; m < 4; ++m) _Pragma("unroll") for (int n = 0; n < 2; ++n) \
            asm volatile("v_mfma_scale_f32_16x16x128_f8f6f4 %0, %1, %2, %0, %3, %4 op_sel_hi:[0,0,0]" : "+v"(acc[ai][bj][m][n]) : "v"(Bt[n]), "v"(At[m]), "v"(scw_), "v"(sca_)); } \
        else { _Pragma("unroll") for (int m = 0; m < 4; ++m) _Pragma("unroll") for (int n = 0; n < 2; ++n) { \
            acc[ai][bj][m][n] = __builtin_amdgcn_mfma_f32_16x16x32_bf16(PG8_H0(Bt[n]), PG8_H0(At[m]), acc[ai][bj][m][n], 0, 0, 0); \
            acc[ai][bj][m][n] = __builtin_amdgcn_mfma_f32_16x16x32_bf16(PG8_H1(Bt[n]), PG8_H1(At[m]), acc[ai][bj][m][n], 0, 0, 0); } } \
        __builtin_amdgcn_s_setprio(0); } while (0)
#define PG8_WAIT_V(n) asm volatile("s_waitcnt vmcnt(" #n ")" ::: "memory")
#define PG8_WAIT_L(n) asm volatile("s_waitcnt lgkmcnt(" #n ")" ::: "memory")
#define PG8_BAR __builtin_amdgcn_s_barrier()
#define PG8_SCHED __builtin_amdgcn_sched_barrier(0)
    Unit cur, nxt; int ui = 0;
    if (!S.next(0, cur)) return;
    f32x4 acc[2][2][4][2];
#pragma unroll
    for (int a = 0; a < 2; ++a)
#pragma unroll
        for (int b = 0; b < 2; ++b)
#pragma unroll
            for (int m = 0; m < 4; ++m)
#pragma unroll
                for (int n = 0; n < 2; ++n) acc[a][b][m][n] = (f32x4){0.f, 0.f, 0.f, 0.f};
    int scw_ = W8_E8M0, sca_ = A8_E8M0; if constexpr (FP8) sca_ = Epi::A_E8M0;
    i32x8_ At[4], B0[2], B1[2];
    unsigned vA[2][2], vAn[2][2];
    PG8_SETOFF(vA, cur);
    const char* cA = cur.a; const char* cB = cur.b;
    PG8_STAGE_B(PG8_SB(0, 0), cB); PG8_STAGE_B(PG8_SB(0, 1), cB + hstepB); PG8_STAGE_A(PG8_SA(0, 0), cA, vA, 0); PG8_STAGE_A(PG8_SA(0, 1), cA, vA, 1);
    if (wr == 1) PG8_BAR;
    PG8_WAIT_V(2); PG8_BAR;
    PG8_STAGE_B(PG8_SB(1, 0), cB + kstep); PG8_STAGE_A(PG8_SA(1, 0), cA + kstep, vA, 0); PG8_STAGE_B(PG8_SB(1, 1), cB + hstepB + kstep);
    PG8_WAIT_V(6); PG8_BAR;
    for (;;) {
        const bool has_next = S.next(ui + 1, nxt);
        if constexpr (GATHER) {
            if (has_next) {
#pragma unroll
                for (int h = 0; h < 2; ++h)
#pragma unroll
                    for (int i = 0; i < 2; ++i) vAn[h][i] = S.gather_raw(nxt, h * 128 + Rr[i]);
            }
        }
        const char* nA = has_next ? nxt.a : cA; const char* nB = has_next ? nxt.b : cB;
#pragma unroll 1
        for (int t = 0; t < nt; t += 2) {
            const bool last = (t == nt - 2);
            const char* a1 = cA + (size_t)(t + 1) * kstep;
            const char* a2 = last ? nA : cA + (size_t)(t + 2) * kstep; const char* b2 = last ? nB : cB + (size_t)(t + 2) * kstep;
            const char* a3 = a2 + kstep; const char* b3 = b2 + kstep;
            unsigned v2[2][2];
#pragma unroll
            for (int h = 0; h < 2; ++h)
#pragma unroll
                for (int i = 0; i < 2; ++i) v2[h][i] = vA[h][i];
            if constexpr (GATHER) {
                if (last && has_next) {
#pragma unroll
                    for (int h = 0; h < 2; ++h)
#pragma unroll
                        for (int i = 0; i < 2; ++i) { vAn[h][i] = vAn[h][i] * (unsigned)(lda * 2) + (unsigned)Cc[i] * 2u; v2[h][i] = vAn[h][i]; }
                }
            }
            PG8_LDB(B0, 0, 0); PG8_LDB(B1, 0, 1); PG8_SCHED; PG8_LDA(At, 0, 0); PG8_STAGE_A(PG8_SA(1, 1), a1, vA, 1);
            PG8_WAIT_V(8); PG8_WAIT_L(0); PG8_BAR; PG8_MMA(0, 0, At, B0); PG8_MMA(0, 1, At, B1); PG8_BAR; PG8_SCHED;
            PG8_LDA(At, 0, 1); PG8_STAGE_B(PG8_SB(0, 0), b2); PG8_STAGE_B(PG8_SB(0, 1), b2 + hstepB); PG8_STAGE_A(PG8_SA(0, 0), a2, v2, 0);
            PG8_WAIT_V(8); PG8_WAIT_L(0); PG8_BAR; PG8_MMA(1, 0, At, B0); PG8_MMA(1, 1, At, B1); PG8_BAR; PG8_SCHED;
            PG8_LDB(B0, 1, 0); PG8_LDB(B1, 1, 1); PG8_SCHED; PG8_LDA(At, 1, 0); PG8_STAGE_A(PG8_SA(0, 1), a2, v2, 1);
            PG8_WAIT_V(8); PG8_WAIT_L(0); PG8_BAR; PG8_MMA(0, 0, At, B0); PG8_MMA(0, 1, At, B1); PG8_BAR; PG8_SCHED;
            PG8_LDA(At, 1, 1); PG8_STAGE_B(PG8_SB(1, 0), b3); PG8_STAGE_B(PG8_SB(1, 1), b3 + hstepB); PG8_STAGE_A(PG8_SA(1, 0), a3, v2, 0);
            PG8_WAIT_V(8); PG8_WAIT_L(0); PG8_BAR; PG8_MMA(1, 0, At, B0); PG8_MMA(1, 1, At, B1); PG8_BAR; PG8_SCHED;
        }
        if (wr == 0) PG8_BAR;
        if constexpr (FP8) asm volatile("s_nop 15\n\ts_nop 15" ::: "memory");
        if constexpr (!Epi::AFTER_DRAIN) { int fr_ = fr, fq_ = fq; asm volatile("" : "+v"(fr_), "+v"(fq_)); E(acc, cur, wr, wc, fr_, fq_); }
        if (!has_next) break;
#pragma unroll
        for (int a = 0; a < 2; ++a)
#pragma unroll
            for (int b = 0; b < 2; ++b)
#pragma unroll
                for (int m = 0; m < 4; ++m)
#pragma unroll
                    for (int n = 0; n < 2; ++n) acc[a][b][m][n] = (f32x4){0.f, 0.f, 0.f, 0.f};
        cur = nxt; cA = nA; cB = nB; ++ui;
        if constexpr (GATHER) {
#pragma unroll
            for (int h = 0; h < 2; ++h)
#pragma unroll
                for (int i = 0; i < 2; ++i) vA[h][i] = vAn[h][i];
        }
        if (wr == 1) PG8_BAR;
    }
    PG8_WAIT_V(0);
    PG8_BAR;
    if constexpr (Epi::AFTER_DRAIN) { int fr_ = fr, fq_ = fq; asm volatile("" : "+v"(fr_), "+v"(fq_)); E.fused(acc, cur, wr, wc, fr_, fq_, lds, wid, lane); }
#undef PG8_SA
#undef PG8_SB
#undef PG8_STAGE_A
#undef PG8_STAGE_B
#undef PG8_SETOFF
#undef PG8_LDA
#undef PG8_LDB
#undef PG8_MMA
#undef PG8_H0
#undef PG8_H1
#undef PG8_WAIT_V
#undef PG8_WAIT_L
#undef PG8_BAR
#undef PG8_SCHED
}
}
using pg8::Unit;
typedef f32x4 AccT[2][2][4][2];

struct SchedGrid {
    const char* A; const char* B; int lda, K, nN, nwg, G, c;
    DI bool next(int i, Unit& u) const {
        const int L = i * G + c; if (L >= nwg) return false;
        u.pm = L / nN; u.pn = L % nN; u.e = 0; u.ml = 0;
        u.a = A + (size_t)u.pm * 256 * lda * 2; u.b = B + (size_t)u.pn * 256 * K * 2; return true;
    }
    DI unsigned gather_off(const Unit&, int) const { return 0u; }
    DI unsigned gather_raw(const Unit&, int) const { return 0u; }
};
struct SchedCmp {
    const char* KCMP; const char* VCMP; const char* W; int G, c;
    DI bool next(int i, Unit& u) const {
        const int L = i * G + c; if (L >= 32) return false;
        const int kv = L >> 4, bg = L & 15;
        u.pm = L; u.pn = 0; u.e = kv; u.ml = 0;
        u.a = (kv ? VCMP : KCMP) + (size_t)bg * SP * 64 * 2; u.b = W + (size_t)kv * 256 * 2048 * 2; return true;
    }
    DI unsigned gather_off(const Unit&, int) const { return 0u; }
    DI unsigned gather_raw(const Unit&, int) const { return 0u; }
};
struct SchedMla {
    const char* CQ; const char* MISC; const char* WQ; const char* WKV; int G, c;
    DI bool next(int i, Unit& u) const {
        const int L = i * G + c; if (L >= 512) return false;
        const int which = L >> 8, r = L & 255;
        u.pm = r >> 1; u.pn = r & 1; u.e = which; u.ml = 0;
        u.a = (which ? MISC : CQ) + (size_t)u.pm * 256 * 256 * 2; u.b = (which ? WKV : WQ) + (size_t)u.pn * 256 * 256 * 2; return true;
    }
    DI unsigned gather_off(const Unit&, int) const { return 0u; }
    DI unsigned gather_raw(const Unit&, int) const { return 0u; }
};
template <int NT, bool GATHERED>
struct SchedMoe {
    const LAS int* tb; const LAS int* cnt; const char* A; const char* W; const int* IDX; int total, G, c;
    DI bool next(int i, Unit& u) const {
        const int L = i * G + c; if (L >= total) return false;
        const int mtg = L / NT; u.pn = L % NT;
        const int ln_ = threadIdx.x & 63;
        const int e = __popcll(__ballot(ln_ < 32 && tb[ln_ & 31] <= mtg)) - 1;
        u.e = e; u.ml = mtg - tb[e]; u.pm = mtg;
        u.a = GATHERED ? A : A + (size_t)mtg * 256 * 1024 * 2;
        u.b = W + ((size_t)e * NT * 256 + (size_t)u.pn * 256) * 1024 * 2; return true;
    }
    DI unsigned gather_off(const Unit& u, int row) const {
        const int pos = u.ml * 256 + row; const int tok = (pos < cnt[u.e]) ? IDX[u.e * ECAP + pos] : 0;
        return (unsigned)tok * 2048u;
    }
    DI unsigned gather_raw(const Unit& u, int row) const {
        const int pos = u.ml * 256 + row;
        return (unsigned)IDX[u.e * ECAP + (pos < cnt[u.e] ? pos : 0)];
    }
};

struct SchedMoe1F8 {
    static constexpr bool HOOK = false;
    const LAS int* tb; const LAS int* cnt; const char* A; const char* W; const int* IDX; int total, G, c;
    DI bool next(int i, Unit& u) const {
        const int L = i * G + c; if (L >= total) return false;
        const int mtg = L >> 3; u.pn = L & 7;
        const int ln_ = lane_id();
        const int e = __popcll(__ballot(ln_ < 32 && tb[ln_ & 31] <= mtg)) - 1;
        u.e = e; u.ml = mtg - tb[e]; u.pm = mtg;
        u.a = A; u.b = W + ((size_t)e * 2048 + (size_t)u.pn * 256) * 1024; return true;
    }
    DI unsigned gather_raw(const Unit& u, int row) const { const int pos = u.ml * 256 + row; return (unsigned)IDX[u.e * ECAP + (pos < cnt[u.e] ? pos : 0)]; }
    DI unsigned gather_off(const Unit& u, int row) const { return gather_raw(u, row) * 1024u; }
};
struct SchedMoe2F8 {
    static constexpr bool HOOK = false;
    const LAS int* tb; const char* A; const char* W; int total, G, c;
    DI bool next(int i, Unit& u) const {
        const int L = i * G + c; if (L >= total) return false;
        const int mtg = L >> 2; u.pn = L & 3;
        const int ln_ = lane_id();
        const int e = __popcll(__ballot(ln_ < 32 && tb[ln_ & 31] <= mtg)) - 1;
        u.e = e; u.ml = mtg - tb[e]; u.pm = mtg;
        u.a = A + (size_t)mtg * 256 * 1024; u.b = W + ((size_t)e * 1024 + (size_t)u.pn * 256) * 1024; return true;
    }
    DI unsigned gather_off(const Unit&, int) const { return 0u; }
    DI unsigned gather_raw(const Unit&, int) const { return 0u; }
};

DI void rot4(f32x4& v0, f32x4& v1, const f32x4 c, const f32x4 s) {
    const float a0 = v0[0], b0 = v0[1], a1 = v0[2], b1 = v0[3], a2 = v1[0], b2 = v1[1], a3 = v1[2], b3 = v1[3];
    v0[0] = a0 * c[0] - b0 * s[0]; v0[1] = b0 * c[0] + a0 * s[0];
    v0[2] = a1 * c[1] - b1 * s[1]; v0[3] = b1 * c[1] + a1 * s[1];
    v1[0] = a2 * c[2] - b2 * s[2]; v1[1] = b2 * c[2] + a2 * s[2];
    v1[2] = a3 * c[3] - b3 * s[3]; v1[3] = b3 * c[3] + a3 * s[3];
}
DI u32x4 pack8(const f32x4 v0, const f32x4 v1) { u32x4 w; w.x = pk2(v0[0], v0[1]); w.y = pk2(v0[2], v0[3]); w.z = pk2(v1[0], v1[1]); w.w = pk2(v1[2], v1[3]); return w; }

struct EpiWin {
    static constexpr bool PERM = true, AFTER_DRAIN = false;
    unsigned char* ws; const float* CS64; const float* CS32;
    DI void operator()(const AccT& acc, const Unit& u, int wr, int wc, int fr, int fq) const {
#pragma unroll
        for (int bj = 0; bj < 2; ++bj) {
            const int w0 = bj * 128 + wc * 32;
            size_t off; int ld, dcol, mode = 0, gm = 0, g = 0; float sc = 1.f;
            switch (u.pn) {
                case 0: off = WS_QA; ld = 256; dcol = w0; mode = 1; sc = SCL64; break;
                case 1: off = WS_KA; ld = 256; dcol = w0; mode = 1; break;
                case 2: off = WS_VA; ld = 256; dcol = w0; break;
                case 3: off = WS_QB; ld = 512; dcol = w0; mode = 1; sc = SCL64; break;
                case 4: off = WS_QB; ld = 512; dcol = 256 + w0; mode = 1; sc = SCL64; break;
                case 5: off = (w0 < 128) ? WS_KCMP : WS_VCMP; ld = 64; gm = 1; g = (w0 & 127) >> 6; dcol = w0 & 63; break;
                case 6: off = (w0 < 128) ? WS_KSLC : WS_VSLC; ld = 128; dcol = w0 & 127; mode = (w0 < 128) ? 1 : 0; break;
                case 7: off = (w0 < 128) ? WS_KWIN : WS_VWIN; ld = 128; dcol = w0 & 127; mode = (w0 < 128) ? 1 : 0; break;
                case 8: off = WS_CQ; ld = 256; dcol = w0; break;
                default: if (w0 == 128) { off = WS_KR; ld = 32; dcol = 0; mode = 2; } else { off = WS_MISC; ld = 256; dcol = w0; } break;
            }
            bf16* base = (bf16*)(ws + off);
            const int i0 = 16 * (wc & 1) + 4 * fq;
#pragma unroll
            for (int ai = 0; ai < 2; ++ai) {
                f32x4 cc[4], sn[4];
                if (mode) {
#pragma unroll
                    for (int m = 0; m < 4; ++m) {
                        const int row = u.pm * 256 + ai * 128 + wr * 64 + m * 16 + fr;
                        const float* cs = (mode == 1) ? CS64 + (size_t)row * 64 + i0 : CS32 + (size_t)row * 32 + 4 * fq;
                        cc[m] = *(const f32x4*)cs; sn[m] = *(const f32x4*)(cs + (mode == 1 ? 32 : 16));
                    }
                }
#pragma unroll
                for (int m = 0; m < 4; ++m) {
                    const int row = u.pm * 256 + ai * 128 + wr * 64 + m * 16 + fr;
                    f32x4 v0 = acc[ai][bj][m][0], v1 = acc[ai][bj][m][1];
                    if (mode) rot4(v0, v1, cc[m], sn[m]);
                    v0 = v0 * sc; v1 = v1 * sc;
                    const size_t drow = gm ? (size_t)(((row >> 12) * 2 + g) * SP + (row & 4095)) : (size_t)row;
                    *(u32x4*)(base + drow * ld + dcol + 8 * fq) = pack8(v0, v1);
                }
            }
        }
    }
};
struct EpiCmp {
    static constexpr bool PERM = true, AFTER_DRAIN = true;
    const float* B1P; const bf16* W2T; const float *B2K, *B2V; bf16 *KC, *VC; const float* CS64;
    DI void fused(const AccT& acc, const Unit& u, int wr, int wc, int fr, int fq, LAS unsigned char* lds, int wid, int lane) const {
        constexpr int HST = 528;
        const int kv = u.e, bg = u.pm & 15;
#pragma unroll
        for (int bj = 0; bj < 2; ++bj) {
            const int col = bj * 128 + wc * 32 + 8 * fq;
            const f32x4 b0 = *(const f32x4*)(B1P + kv * 256 + col), b1 = *(const f32x4*)(B1P + kv * 256 + col + 4);
#pragma unroll
            for (int ai = 0; ai < 2; ++ai)
#pragma unroll
                for (int m = 0; m < 4; ++m) {
                    const int rl = ai * 128 + wr * 64 + m * 16 + fr;
                    f32x4 v0 = acc[ai][bj][m][0] + b0, v1 = acc[ai][bj][m][1] + b1;
#pragma unroll
                    for (int j = 0; j < 4; ++j) {
                        float x = v0[j]; float z = 0.7978845608028654f * (x + 0.044715f * x * x * x); v0[j] = x * sigmoidf_(2.f * z);
                        x = v1[j]; z = 0.7978845608028654f * (x + 0.044715f * x * x * x); v1[j] = x * sigmoidf_(2.f * z);
                    }
                    *(LAS u32x4*)(lds + rl * HST + col * 2) = pack8(v0, v1);
                }
        }
        asm volatile("s_waitcnt lgkmcnt(0)\n\ts_barrier" ::: "memory");
        const int r32 = lane & 31, hh = lane >> 5;
        f32x16 out0 = {0.f, 0.f, 0.f, 0.f, 0.f, 0.f, 0.f, 0.f, 0.f, 0.f, 0.f, 0.f, 0.f, 0.f, 0.f, 0.f}, out1 = out0;
        const bf16* w2 = W2T + (size_t)kv * 64 * 256;
#pragma unroll 4
        for (int ks = 0; ks < 16; ++ks) {
            const bf16x8 a = *(const LAS bf16x8*)(lds + (32 * wid + r32) * HST + (16 * ks + 8 * hh) * 2);
            const bf16x8 bq0 = *(const bf16x8*)(w2 + (size_t)r32 * 256 + 16 * ks + 8 * hh), bq1 = *(const bf16x8*)(w2 + (size_t)(32 + r32) * 256 + 16 * ks + 8 * hh);
            out0 = __builtin_amdgcn_mfma_f32_32x32x16_bf16(a, bq0, out0, 0, 0, 0); out1 = __builtin_amdgcn_mfma_f32_32x32x16_bf16(a, bq1, out1, 0, 0, 0);
        }
        const float* b2 = kv ? B2V : B2K;
        const float bb0 = b2[r32], bb1 = b2[32 + r32];
        const int b = bg >> 1;
#pragma unroll
        for (int i = 0; i < 16; ++i) {
            const int c = 32 * wid + 8 * (i >> 2) + 4 * hh + (i & 3);
            const size_t row = (size_t)bg * 256 + c;
            float x1 = out0[i] + bb0, x2 = out1[i] + bb1;
            if (c == 255) { x1 = 0.f; x2 = 0.f; }
            if (kv == 0) {
                const int tokr = (b * S + 16 * c + 31) & (T - 1);
                const float cs = CS64[(size_t)tokr * 64 + r32], sn = CS64[(size_t)tokr * 64 + 32 + r32];
                *(unsigned*)(KC + row * 64 + 2 * r32) = pk2(x1 * cs - x2 * sn, x2 * cs + x1 * sn);
            } else {
                VC[row * 64 + r32] = (bf16)(pk2(x1, 0.f) & 0xffffu); VC[row * 64 + 32 + r32] = (bf16)(pk2(x2, 0.f) & 0xffffu);
            }
        }
    }
};
struct EpiMla {
    static constexpr bool PERM = true, AFTER_DRAIN = false;
    bf16 *QM, *KN, *VM; const bf16 *CQ, *MISC; const float* CS32;
    DI void operator()(const AccT& acc, const Unit& u, int wr, int wc, int fr, int fq) const {
        float rstd[2][4];
#pragma unroll
        for (int ai = 0; ai < 2; ++ai)
#pragma unroll
            for (int m = 0; m < 4; ++m) {
                const int row = u.pm * 256 + ai * 128 + wr * 64 + m * 16 + fr;
                float ss = 0.f;
                if (u.e == 0) {
#pragma unroll
                    for (int c = 0; c < 8; ++c) { const u32x4 w = *(const u32x4*)(CQ + (size_t)row * 256 + fq * 64 + 8 * c);
                        ss += bflo(w.x) * bflo(w.x) + bfhi(w.x) * bfhi(w.x) + bflo(w.y) * bflo(w.y) + bfhi(w.y) * bfhi(w.y) + bflo(w.z) * bflo(w.z) + bfhi(w.z) * bfhi(w.z) + bflo(w.w) * bflo(w.w) + bfhi(w.w) * bfhi(w.w); }
                } else {
#pragma unroll
                    for (int c = 0; c < 4; ++c) { const u32x4 w = *(const u32x4*)(MISC + (size_t)row * 256 + fq * 32 + 8 * c);
                        ss += bflo(w.x) * bflo(w.x) + bfhi(w.x) * bfhi(w.x) + bflo(w.y) * bflo(w.y) + bfhi(w.y) * bfhi(w.y) + bflo(w.z) * bflo(w.z) + bfhi(w.z) * bfhi(w.z) + bflo(w.w) * bflo(w.w) + bfhi(w.w) * bfhi(w.w); }
                }
                ss += __shfl_xor(ss, 16); ss += __shfl_xor(ss, 32);
                rstd[ai][m] = rsqrtf(ss * (u.e == 0 ? (1.0f / 256.0f) : (1.0f / 128.0f)) + EPS);
            }
#pragma unroll
        for (int bj = 0; bj < 2; ++bj) {
            const int gc = u.pn * 256 + bj * 128 + wc * 32;
            bf16* base; int ld, dcol, rope = 0; float sc = 1.f;
            if (u.e == 0) { if (gc >= 384) continue; rope = ((gc >> 5) % 3) == 2; base = QM; ld = 384; dcol = gc; sc = SCL96; }
            else { const int head = gc >> 7, part = (gc & 127) >> 6, o = gc & 63; base = part ? VM : KN; ld = 256; dcol = head * 64 + o; }
#pragma unroll
            for (int ai = 0; ai < 2; ++ai) {
                f32x4 cc[4], sn[4];
                if (rope) {
#pragma unroll
                    for (int m = 0; m < 4; ++m) { const float* cs = CS32 + (size_t)(u.pm * 256 + ai * 128 + wr * 64 + m * 16 + fr) * 32 + 4 * fq; cc[m] = *(const f32x4*)cs; sn[m] = *(const f32x4*)(cs + 16); }
                }
#pragma unroll
                for (int m = 0; m < 4; ++m) {
                    const int row = u.pm * 256 + ai * 128 + wr * 64 + m * 16 + fr;
                    const float r = rstd[ai][m] * sc;
                    f32x4 v0 = acc[ai][bj][m][0] * r, v1 = acc[ai][bj][m][1] * r;
                    if (rope) rot4(v0, v1, cc[m], sn[m]);
                    *(u32x4*)(base + (size_t)row * ld + dcol + 8 * fq) = pack8(v0, v1);
                }
            }
        }
    }
};
struct EpiWout {
    static constexpr bool PERM = false, AFTER_DRAIN = false;
    bf16* X; const float* GT; size_t dofs;
    DI void operator()(const AccT& acc, const Unit& u, int wr, int wc, int fr, int fq) const {
        const int b = (u.pm * 256) >> 12;
        const int col0 = u.pn * 256 + wc * 32 + 4 * fq;
#pragma unroll
        for (int bj = 0; bj < 2; ++bj) {
#pragma unroll
            for (int n = 0; n < 2; ++n) {
                u32x2 xo[2][4];
                const f32x4 gt = *(const f32x4*)(GT + (size_t)b * 6144 + col0 + bj * 128 + n * 16);
#pragma unroll
                for (int ai = 0; ai < 2; ++ai)
#pragma unroll
                    for (int m = 0; m < 4; ++m) xo[ai][m] = *(const u32x2*)(X + (size_t)(u.pm * 256 + ai * 128 + wr * 64 + m * 16 + fr) * 1024 + col0 + bj * 128 + n * 16);
#pragma unroll
                for (int ai = 0; ai < 2; ++ai)
#pragma unroll
                    for (int m = 0; m < 4; ++m) {
                        bf16* p = X + (size_t)(u.pm * 256 + ai * 128 + wr * 64 + m * 16 + fr) * 1024 + col0 + bj * 128 + n * 16;
                        const f32x4 xv = (f32x4){bflo(xo[ai][m].x), bfhi(xo[ai][m].x), bflo(xo[ai][m].y), bfhi(xo[ai][m].y)} + gt * acc[ai][bj][m][n];
                        u32x2 w; w.x = pk2(xv[0], xv[1]); w.y = pk2(xv[2], xv[3]);
                        *(u32x2*)((char*)p + dofs) = w;
                    }
            }
        }
    }
};
struct EpiMoe1 {
    static constexpr bool PERM = true, AFTER_DRAIN = false; static constexpr int A_E8M0 = H8_E8M0;
    bf16* ACT; const float* B1;
    DI void operator()(const AccT& acc, const Unit& u, int wr, int wc, int fr, int fq) const {
#pragma unroll
        for (int bj = 0; bj < 2; ++bj) {
            const int col = u.pn * 256 + bj * 128 + wc * 32 + 8 * fq;
            const f32x4 b0 = *(const f32x4*)(B1 + (size_t)u.e * 2048 + col), b1 = *(const f32x4*)(B1 + (size_t)u.e * 2048 + col + 4);
#pragma unroll
            for (int ai = 0; ai < 2; ++ai)
#pragma unroll
                for (int m = 0; m < 4; ++m) {
                    const int row = u.pm * 256 + ai * 128 + wr * 64 + m * 16 + fr;
                    const f32x4 v0 = acc[ai][bj][m][0] + b0, v1 = acc[ai][bj][m][1] + b1;
                    float o[4];
#pragma unroll
                    for (int j = 0; j < 4; ++j) {
                        const float gl = fminf((j < 2) ? v0[2 * j] : v1[2 * j - 4], 7.0f);
                        const float li = fminf(fmaxf((j < 2) ? v0[2 * j + 1] : v1[2 * j - 3], -7.0f), 7.0f);
                        o[j] = gl * sigmoidf_(1.702f * gl) * (li + 1.0f);
                    }
                    *(unsigned*)((unsigned char*)ACT + (size_t)row * 1024 + (col >> 1)) = pk4_fp8s(o[0], o[1], o[2], o[3], A8_SCALE);
                }
        }
    }
};
struct EpiMoe2 {
    static constexpr bool PERM = true, AFTER_DRAIN = false; static constexpr int A_E8M0 = A8_E8M0;
    unsigned char* Y2; const float* B2;
    DI void operator()(const AccT& acc, const Unit& u, int wr, int wc, int fr, int fq) const {
        f32x4 bb[2][2];
#pragma unroll
        for (int bj = 0; bj < 2; ++bj) { const int col = u.pn * 256 + bj * 128 + wc * 32 + 8 * fq; bb[bj][0] = *(const f32x4*)(B2 + (size_t)u.e * 1024 + col); bb[bj][1] = *(const f32x4*)(B2 + (size_t)u.e * 1024 + col + 4); }
#pragma unroll
        for (int ai = 0; ai < 2; ++ai)
#pragma unroll
            for (int m = 0; m < 4; ++m) {
                const int rl = ai * 128 + wr * 64 + m * 16 + fr;
                const size_t row = (size_t)u.pm * 256 + rl;
#pragma unroll
                for (int bj = 0; bj < 2; ++bj) {
                    const int col = u.pn * 256 + bj * 128 + wc * 32 + 8 * fq;
                    const f32x4 v0 = acc[ai][bj][m][0] + bb[bj][0], v1 = acc[ai][bj][m][1] + bb[bj][1];
                    { u32x2 w8; w8.x = pk4_fp8(v0[0], v0[1], v0[2], v0[3]); w8.y = pk4_fp8(v1[0], v1[1], v1[2], v1[3]); *(u32x2*)(Y2 + row * 1024 + col) = w8; }
                }
            }
    }
};

#define MFMA32(a, b, c) __builtin_amdgcn_mfma_f32_32x32x16_bf16((a), (b), (c), 0, 0, 0)
typedef short v4i16_t __attribute__((ext_vector_type(4)));
DI s16x4 tr_read(const LAS unsigned char* p) { return __builtin_bit_cast(s16x4, __builtin_amdgcn_ds_read_tr16_b64_v4i16((LAS v4i16_t*)p)); }
constexpr int VST = 144;
template <int DQ> struct AC { static constexpr int KST = DQ * 2 + 16, KS = DQ / 16, KBUF = 64 * KST, VBUF = 64 * VST, BUF = KBUF + VBUF; };

template <int DQ>
DI void qk_tile(const LAS unsigned char* kb, const bf16x8 (&qf)[DQ / 16], f32x16 (&s)[2], const f32x16& cinit, int lane) {
    const int r32 = lane & 31, hh = lane >> 5;
    bf16x8 kf[2][DQ / 16];
#pragma unroll
    for (int rt = 0; rt < 2; ++rt)
#pragma unroll
        for (int ks = 0; ks < DQ / 16; ++ks) kf[rt][ks] = *(const LAS bf16x8*)(kb + (32 * rt + r32) * AC<DQ>::KST + (16 * ks + 8 * hh) * 2);
    f32x16 a0 = MFMA32(kf[0][0], qf[0], cinit), a1 = MFMA32(kf[1][0], qf[0], cinit);
#pragma unroll
    for (int ks = 1; ks < DQ / 16; ++ks) { a0 = MFMA32(kf[0][ks], qf[ks], a0); a1 = MFMA32(kf[1][ks], qf[ks], a1); }
    s[0] = a0; s[1] = a1;
}
DI float max3f_(float a, float b, float c) { return __builtin_fmaxf(__builtin_fmaxf(a, b), c); }
constexpr float RESC_THR = 8.0f;
template <int DQ, int KMUL, int VAR = 0>
DI void attn_tile(const LAS unsigned char* kb, const LAS unsigned char* vb, const bf16x8 (&qf)[DQ / 16], f32x16 (&o)[2], f32x16& negm, float& m, float& l,
                  int dq, unsigned maxd, bool lf, int lane, const bool MASKED) {
    const int hh = lane >> 5;
    if (VAR == 1) return;
    f32x16 s[2];
    qk_tile<DQ>(kb, qf, s, negm, lane);
    if (VAR == 2) { o[0] += s[0]; o[1] += s[1]; return; }
    const int i16 = lane & 15, q = i16 >> 2, p_ = i16 & 3, mh = (lane >> 4) & 1;
    const LAS unsigned char* vbase = vb + (4 * hh + q) * VST + 32 * mh + 8 * p_;
    s16x4 vlo[4][2], vhi[4][2];
#pragma unroll
    for (int st = 0; st < 4; ++st)
#pragma unroll
        for (int mt = 0; mt < 2; ++mt) { vlo[st][mt] = tr_read(vbase + (16 * st) * VST + 64 * mt); vhi[st][mt] = tr_read(vbase + (16 * st + 8) * VST + 64 * mt); }
    __builtin_amdgcn_sched_barrier(0);
    if (MASKED) {
#pragma unroll
        for (int rt = 0; rt < 2; ++rt)
#pragma unroll
            for (int i = 0; i < 16; ++i) {
                const int d = dq - (32 * rt + 8 * (i >> 2) + (i & 3)) * KMUL;
                s[rt][i] = ((unsigned)d <= maxd) ? s[rt][i] : -1e30f;
            }
    }
    float mx = max3f_(s[0][0], s[0][1], s[0][2]);
#pragma unroll
    for (int i = 3; i < 15; i += 2) mx = max3f_(mx, s[0][i], s[0][i + 1]);
    mx = max3f_(mx, s[0][15], s[1][0]);
#pragma unroll
    for (int i = 1; i < 15; i += 2) mx = max3f_(mx, s[1][i], s[1][i + 1]);
    mx = fmaxf(mx, s[1][15]);
    if (__ballot(lf && mx > RESC_THR) != 0ull) {
        float mc = lf ? mx : -1e30f;
        mc = fmaxf(mc, __shfl_xor(mc, 32));
        const float delta = mc > RESC_THR ? mc : 0.f;
        const float alpha = fast_exp2(-delta);
        m += delta; l *= alpha;
#pragma unroll
        for (int i = 0; i < 16; ++i) { negm[i] = -m; o[0][i] *= alpha; o[1][i] *= alpha; s[0][i] -= delta; s[1][i] -= delta; }
    }
    float ps = 0.f;
#pragma unroll
    for (int rt = 0; rt < 2; ++rt)
#pragma unroll
        for (int i = 0; i < 16; ++i) { const float p = fast_exp2(s[rt][i]); s[rt][i] = p; ps += p; }
    const unsigned lmask = lf ? 0xffffffffu : 0u;
    l += lf ? ps : 0.f;
    if (VAR == 3) { o[0] += s[0]; o[1] += s[1]; return; }
#pragma unroll
    for (int rt = 0; rt < 2; ++rt)
#pragma unroll
        for (int s2 = 0; s2 < 2; ++s2) {
            u32x4 pw; pw.x = pk2(s[rt][8 * s2 + 0], s[rt][8 * s2 + 1]) & lmask; pw.y = pk2(s[rt][8 * s2 + 2], s[rt][8 * s2 + 3]) & lmask;
            pw.z = pk2(s[rt][8 * s2 + 4], s[rt][8 * s2 + 5]) & lmask; pw.w = pk2(s[rt][8 * s2 + 6], s[rt][8 * s2 + 7]) & lmask;
            const bf16x8 pb = __builtin_bit_cast(bf16x8, pw);
#pragma unroll
            for (int mt = 0; mt < 2; ++mt) {
                const bf16x8 va = __builtin_shufflevector(vlo[2 * rt + s2][mt], vhi[2 * rt + s2][mt], 0, 1, 2, 3, 4, 5, 6, 7);
                o[mt] = MFMA32(va, pb, o[mt]);
            }
        }
}
constexpr int OSTAGE_WAVE = 32 * 144;
static_assert(102400 + 8 * OSTAGE_WAVE <= MISC_OFF, "O stage below the LDS control words");
struct ChunkId { DI u32x4 operator()(u32x4 v, int, int, int) const { return v; } };
template <class P, class Fx = ChunkId>
DI void store_o_rows(const P& p, LAS unsigned char* lds, int off, const f32x16 (&o)[2], float inv, int lane, int wave, const Fx& fx = Fx()) {
    LAS unsigned char* st = lds + off + wave * OSTAGE_WAVE;
    const int n = lane & 31, hh = lane >> 5;
#pragma unroll
    for (int mt = 0; mt < 2; ++mt)
#pragma unroll
        for (int a = 0; a < 4; ++a) {
            u32x2 w; w.x = pk2(o[mt][4 * a] * inv, o[mt][4 * a + 1] * inv); w.y = pk2(o[mt][4 * a + 2] * inv, o[mt][4 * a + 3] * inv);
            *(LAS u32x2*)(st + n * 144 + (32 * mt + 8 * a + 4 * hh) * 2) = w;
        }
    asm volatile("s_waitcnt lgkmcnt(0)" ::: "memory");
#pragma unroll
    for (int it = 0; it < 4; ++it) {
        const int r = (lane >> 3) + 8 * it, c = lane & 7;
        const u32x4 v = fx(*(const LAS u32x4*)(st + r * 144 + c * 16), wave, r, c);
        *(u32x4*)(p.orow(wave, r) + 8 * c) = v;
    }
}
DI void store_o(bf16* orow, const f32x16 (&o)[2], float inv, int lane) {
    const int hh = lane >> 5;
#pragma unroll
    for (int mt = 0; mt < 2; ++mt)
#pragma unroll
        for (int a = 0; a < 4; ++a) {
            u32x2 w; w.x = pk2(o[mt][4 * a] * inv, o[mt][4 * a + 1] * inv); w.y = pk2(o[mt][4 * a + 2] * inv, o[mt][4 * a + 3] * inv);
            *(u32x2*)(orow + 32 * mt + 8 * a + 4 * hh) = w;
        }
}

struct PolA {
    static constexpr bool HASFLAG = false, LSE = true; static constexpr int KMUL = 1;
    const bf16 *Q, *K, *V; bf16* O; float* LSEP; int b, h, d, r, c; unsigned maxd; int j0, j1;
    DI int ql(int w, int lane) const { return 256 * c + 32 * w + (lane & 31); }
    DI size_t trow(int l_) const { return (size_t)b * S + (size_t)l_ * d + r; }
    DI const bf16* qrow(int w, int lane) const { return Q + trow(ql(w, lane)) * 256 + h * 64; }
    DI int qv(int w, int lane) const { return ql(w, lane); }
    DI int qmin(int w) const { return 256 * c + 32 * w; }
    DI int qmax(int w) const { return 256 * c + 32 * w + 31; }
    DI int kv0(int j) const { return 256 * c - 128 + 64 * j; }
    DI const bf16* krow(int j, int row) const { return K + trow(kv0(j) + row) * 256 + h * 64; }
    DI const bf16* vrow(int j, int row) const { return V + trow(kv0(j) + row) * 256 + h * 64; }
    DI const bf16* rrow(int, int) const { return nullptr; }
    DI bool flag(int, int, int) const { return true; }
    DI bf16* orow(int w, int lane) const { return O + trow(ql(w, lane)) * 256 + h * 64; }
    DI void lse(int w, int lane, float v) const { LSEP[trow(ql(w, lane)) * 4 + h] = v; }
};
struct PolB {
    static constexpr bool LSE = false; static constexpr int KMUL = 1;
    const bf16 *Q, *K, *V; bf16* O; int b, g, qc; unsigned maxd; int j0, j1; u64 sel; bool hasflag;
    const bf16 *GC = nullptr, *GW = nullptr, *GM = nullptr;
    DI int tok(int w, int lane) const { return 64 * qc + 8 * w + ((lane & 31) >> 2); }
    DI const bf16* qrow(int w, int lane) const { return Q + ((size_t)b * S + tok(w, lane)) * 512 + (4 * g + (lane & 3)) * 64; }
    DI int qv(int w, int lane) const { return tok(w, lane); }
    DI int qmin(int w) const { return 64 * qc + 8 * w; }
    DI int qmax(int w) const { return 64 * qc + 8 * w + 7; }
    DI int kv0(int j) const { return 64 * j; }
    DI const bf16* krow(int j, int row) const { return K + ((size_t)b * S + 64 * j + row) * 128 + g * 64; }
    DI const bf16* vrow(int j, int row) const { return V + ((size_t)b * S + 64 * j + row) * 128 + g * 64; }
    DI const bf16* rrow(int, int) const { return nullptr; }
    DI bf16* orow(int w, int lane) const { return O + ((size_t)b * S + tok(w, lane)) * 512 + (4 * g + (lane & 3)) * 64; }
    DI void lse(int, int, float) const {}
};
struct PolM {
    static constexpr bool HASFLAG = false, LSE = false; static constexpr int KMUL = 1;
    const bf16 *Q, *KN, *KR, *V; bf16* O; int b, h, c; unsigned maxd; int j0, j1;
    DI int tok(int w, int lane) const { return 256 * c + 32 * w + (lane & 31); }
    DI const bf16* qrow(int w, int lane) const { return Q + ((size_t)b * S + tok(w, lane)) * 384 + h * 96; }
    DI int qv(int w, int lane) const { return tok(w, lane); }
    DI int qmin(int w) const { return 256 * c + 32 * w; }
    DI int qmax(int w) const { return 256 * c + 32 * w + 31; }
    DI int kv0(int j) const { return 64 * j; }
    DI const bf16* krow(int j, int row) const { return KN + ((size_t)b * S + 64 * j + row) * 256 + h * 64; }
    DI const bf16* vrow(int j, int row) const { return V + ((size_t)b * S + 64 * j + row) * 256 + h * 64; }
    DI const bf16* rrow(int j, int row) const { return KR + ((size_t)b * S + 64 * j + row) * 32; }
    DI bf16* orow(int w, int lane) const { return O + ((size_t)b * S + tok(w, lane)) * 256 + h * 64; }
    DI void lse(int, int, float) const {}
};

template <int DQ, class P, bool FLAG, int VAR = 0>
DI void attn_unit(const P& p, LAS unsigned char* lds, int tid, int lane, int wave, u64 sel) {
    typedef AC<DQ> C;
    const int hh = lane >> 5;
    const bf16* qrow = p.qrow(wave, lane);
    bf16x8 qf[DQ / 16];
#pragma unroll
    for (int ks = 0; ks < DQ / 16; ++ks) qf[ks] = *(const bf16x8*)(qrow + 16 * ks + 8 * hh);
#pragma unroll
    for (int ks = 0; ks < DQ / 16; ++ks) asm volatile("s_waitcnt vmcnt(0)" : "+v"(qf[ks]) :: "memory");
    const int qv = p.qv(wave, lane), wq0 = p.qmin(wave), wq1 = p.qmax(wave);
    f32x16 o[2];
#pragma unroll
    for (int mt = 0; mt < 2; ++mt)
#pragma unroll
        for (int i = 0; i < 16; ++i) o[mt][i] = 0.f;
    float m = 0.f, l = 0.f;
    f32x16 negm;
#pragma unroll
    for (int i = 0; i < 16; ++i) negm[i] = 0.f;
    const int j0 = p.j0, j1 = p.j1;
    const int lrow = tid >> 3, lch = tid & 7;
    u32x4 k0A, v0A, r0A = {0u, 0u, 0u, 0u}, k1A, v1A, r1A = {0u, 0u, 0u, 0u}, k0B, v0B, r0B = {0u, 0u, 0u, 0u}, k1B, v1B, r1B = {0u, 0u, 0u, 0u};
    constexpr int NLD = (DQ == 96) ? 6 : 4;
    const int npair = (j1 - j0 + 1) >> 1;
#define ATT_LOAD1(RK, RV, RR, j) do { const bf16* pk_ = p.krow((j), lrow) + 8 * lch; const bf16* pv_ = p.vrow((j), lrow) + 8 * lch; \
        asm volatile("global_load_dwordx4 %0, %2, off\n\tglobal_load_dwordx4 %1, %3, off" : "=&v"(RK), "=&v"(RV) : "v"(pk_), "v"(pv_) : "memory"); \
        if (DQ == 96) { const bf16* pr_ = p.rrow((j), (tid & 255) >> 2) + 8 * (tid & 3); asm volatile("global_load_dwordx4 %0, %1, off" : "=&v"(RR) : "v"(pr_) : "memory"); } } while (0)
#define ATT_LOADP(K0, V0, R0, K1, V1, R1, t) do { const int ja_ = j0 + 2 * (t), jb_ = ja_ + 1; \
        { const int jc_ = ja_ < j1 ? ja_ : j1 - 1; ATT_LOAD1(K0, V0, R0, jc_); } { const int jd_ = jb_ < j1 ? jb_ : j1 - 1; ATT_LOAD1(K1, V1, R1, jd_); } } while (0)
#define ATT_TILE(kb_, jt_) do { const int j_ = (jt_); const int kv0 = p.kv0(j_); \
        bool need = (j_ < j1) && (wq1 - kv0 >= 0) && ((long long)wq0 - (long long)(kv0 + 63 * P::KMUL) <= (long long)p.maxd); \
        const bool interior = (wq0 - (kv0 + 63 * P::KMUL) >= 0) && ((long long)wq1 - (long long)kv0 <= (long long)p.maxd); \
        bool lf = true; \
        if (FLAG) { lf = ((sel >> j_) & 1ull) != 0ull; need = need && (__ballot(lf) != 0ull); } \
        if (need) attn_tile<DQ, P::KMUL, VAR>((kb_), (kb_) + C::KBUF, qf, o, negm, m, l, qv - kv0 - 4 * hh * P::KMUL, p.maxd, lf, lane, !interior); } while (0)
#define ATT_STEP(K0, V0, R0, K1, V1, R1, tt) do { const int t_ = (tt); \
        LAS unsigned char* pbuf = lds + (t_ & 1) * (2 * C::BUF); \
        asm volatile("s_waitcnt vmcnt(%6)" : "+v"(K0), "+v"(V0), "+v"(R0), "+v"(K1), "+v"(V1), "+v"(R1) : "n"(NLD) : "memory"); \
        *(LAS u32x4*)(pbuf + lrow * C::KST + lch * 16) = K0; *(LAS u32x4*)(pbuf + C::KBUF + lrow * VST + lch * 16) = V0; \
        *(LAS u32x4*)(pbuf + C::BUF + lrow * C::KST + lch * 16) = K1; *(LAS u32x4*)(pbuf + C::BUF + C::KBUF + lrow * VST + lch * 16) = V1; \
        if (DQ == 96) { *(LAS u32x4*)(pbuf + ((tid & 255) >> 2) * C::KST + 128 + (tid & 3) * 16) = R0; *(LAS u32x4*)(pbuf + C::BUF + ((tid & 255) >> 2) * C::KST + 128 + (tid & 3) * 16) = R1; } \
        asm volatile("s_waitcnt lgkmcnt(0)\n\ts_barrier" ::: "memory"); \
        ATT_LOADP(K0, V0, R0, K1, V1, R1, t_ + 2); \
        if (ATT_STAGGER > 0 && wave >= 4) __builtin_amdgcn_s_sleep(ATT_STAGGER); \
        ATT_TILE(pbuf, j0 + 2 * t_); ATT_TILE(pbuf + C::BUF, j0 + 2 * t_ + 1); } while (0)
    ATT_LOADP(k0A, v0A, r0A, k1A, v1A, r1A, 0);
    ATT_LOADP(k0B, v0B, r0B, k1B, v1B, r1B, 1);
    if (wave >= 4) __builtin_amdgcn_s_setprio(1);
#pragma unroll 1
    for (int t = 0; t < npair; t += 2) {
        ATT_STEP(k0A, v0A, r0A, k1A, v1A, r1A, t);
        ATT_STEP(k0B, v0B, r0B, k1B, v1B, r1B, t + 1);
    }
    __builtin_amdgcn_s_setprio(0);
    asm volatile("s_waitcnt vmcnt(0)" : "+v"(k0A), "+v"(v0A), "+v"(r0A), "+v"(k1A), "+v"(v1A), "+v"(r1A), "+v"(k0B), "+v"(v0B), "+v"(r0B), "+v"(k1B), "+v"(v1B), "+v"(r1B) :: "memory");
#undef ATT_LOAD1
#undef ATT_LOADP
#undef ATT_TILE
#undef ATT_STEP
    const float lt = l + __shfl_xor(l, 32);
    const float inv = lt > 0.f ? 1.0f / lt : 0.f;
    if constexpr (FLAG) {
        struct Gate { const P& p;
            DI u32x4 operator()(u32x4 v, int w_, int r, int c) const {
                const size_t tg = (size_t)p.b * S + 64 * p.qc + 8 * w_ + (r >> 2); const int hd = 4 * p.g + (r & 3);
                const bf16* gl = p.GM + tg * 256 + 160 + hd * 3;
                const float g0 = sigmoidf_(bf2f(gl[0])), g1 = sigmoidf_(bf2f(gl[1])), g2 = sigmoidf_(bf2f(gl[2]));
                const u32x4 a = *(const u32x4*)(p.GC + tg * 512 + hd * 64 + 8 * c), d = *(const u32x4*)(p.GW + tg * 512 + hd * 64 + 8 * c);
                u32x4 r_;
                r_.x = pk2(g0 * bflo(a.x) + g1 * bflo(v.x) + g2 * bflo(d.x), g0 * bfhi(a.x) + g1 * bfhi(v.x) + g2 * bfhi(d.x));
                r_.y = pk2(g0 * bflo(a.y) + g1 * bflo(v.y) + g2 * bflo(d.y), g0 * bfhi(a.y) + g1 * bfhi(v.y) + g2 * bfhi(d.y));
                r_.z = pk2(g0 * bflo(a.z) + g1 * bflo(v.z) + g2 * bflo(d.z), g0 * bfhi(a.z) + g1 * bfhi(v.z) + g2 * bfhi(d.z));
                r_.w = pk2(g0 * bflo(a.w) + g1 * bflo(v.w) + g2 * bflo(d.w), g0 * bfhi(a.w) + g1 * bfhi(v.w) + g2 * bfhi(d.w));
                return r_; } } gate{p};
        store_o_rows(p, lds, 90112, o, inv, lane, wave, gate);
    } else store_o_rows(p, lds, DQ == 96 ? 102400 : 90112, o, inv, lane, wave);
    if (P::LSE) { if (hh == 0) p.lse(wave, lane, m + __log2f(lt)); }
    __syncthreads();
}

DI u64 cmp_unit(const Ctx& F, int b, int g, int qc) {
    constexpr int KST = 144;
    LAS unsigned char* KL = F.lds; LAS unsigned char* VL = F.lds + 256 * KST; LAS float* IMP = (LAS float*)(F.lds + 2 * 256 * KST);
    const bf16* KC = (const bf16*)(F.ws + WS_KC) + (size_t)(b * 2 + g) * 256 * 64;
    const bf16* VC = (const bf16*)(F.ws + WS_VC) + (size_t)(b * 2 + g) * 256 * 64;
    const int tid = F.tid, lane = F.lane, w = F.wave, hh = lane >> 5, r32 = lane & 31;
#pragma unroll
    for (int it = 0; it < 4; ++it) { const int idx = tid + 512 * it, row = idx >> 3, ch = idx & 7;
        *(LAS u32x4*)(KL + row * KST + ch * 16) = *(const u32x4*)(KC + row * 64 + ch * 8);
        *(LAS u32x4*)(VL + row * VST + ch * 16) = *(const u32x4*)(VC + row * 64 + ch * 8); }
    __syncthreads();
    const int tokl = 8 * w + (r32 >> 2), tok = 64 * qc + tokl, head = 4 * g + (lane & 3);
    const bf16* qrow = (const bf16*)(F.ws + WS_QB) + ((size_t)b * S + tok) * 512 + head * 64;
    bf16x8 qf[4];
#pragma unroll
    for (int ks = 0; ks < 4; ++ks) qf[ks] = *(const bf16x8*)(qrow + 16 * ks + 8 * hh);
    const int qv = tok - 31, wq1 = 64 * qc + 8 * w + 7 - 31;
    f32x16 o[2];
#pragma unroll
    for (int mt = 0; mt < 2; ++mt)
#pragma unroll
        for (int i = 0; i < 16; ++i) o[mt][i] = 0.f;
    float m = 0.f, l = 0.f;
    f32x16 negm;
#pragma unroll
    for (int i = 0; i < 16; ++i) negm[i] = 0.f;
    const int wq0 = 64 * qc + 8 * w - 31;
#pragma unroll 1
    for (int jt = 0; jt < 4; ++jt) {
        if (wq1 - 1024 * jt >= 0) {
            const int dq = qv - 1024 * jt - 4 * hh * 16;
            attn_tile<64, 16>(KL + jt * 64 * KST, VL + jt * 64 * VST, qf, o, negm, m, l, dq, 0x7fffffffu, true, lane, !(wq0 - (1024 * jt + 63 * 16) >= 0));
        }
    }
    const float lt = l + __shfl_xor(l, 32);
    const float inv = lt > 0.f ? 1.0f / lt : 0.f;
    { struct { bf16* O; int b, g, qc; DI bf16* orow(int w_, int n_) const { return O + ((size_t)b * S + 64 * qc + 8 * w_ + (n_ >> 2)) * 512 + (4 * g + (n_ & 3)) * 64; } } pc{(bf16*)(F.ws + WS_OCMP), b, g, qc};
      store_o_rows(pc, F.lds, 90112, o, inv, lane, w); }
    float prev = 0.f;
#pragma unroll 1
    for (int jt = 0; jt < 4; ++jt) {
        const bool need = (wq1 - 1024 * jt >= 0);
        f32x16 s[2];
        if (need) qk_tile<64>(KL + jt * 64 * KST, qf, s, negm, lane);
#pragma unroll
        for (int rt = 0; rt < 2; ++rt)
#pragma unroll
            for (int a = 0; a < 4; ++a) {
                float mainp = 0.f, sp = 0.f;
                if (need) {
                    float pb[4];
#pragma unroll
                    for (int bb = 0; bb < 4; ++bb) { const int kidx = 64 * jt + 32 * rt + 8 * a + 4 * hh + bb; const bool ok = (qv - 16 * kidx) >= 0; pb[bb] = ok ? fast_exp2(s[rt][4 * a + bb]) * inv : 0.f; }
                    mainp = pb[0] + pb[1] + pb[2] + 0.5f * pb[3]; sp = 0.5f * pb[3];
                }
                const float rc = __shfl_xor(sp, 32);
                float v = mainp + (hh ? rc : prev);
                prev = rc;
                v += __shfl_xor(v, 1); v += __shfl_xor(v, 2);
                if ((lane & 3) == 0) IMP[tokl * 64 + 2 * (8 * jt + 4 * rt + a) + hh] = v;
            }
    }
    __syncthreads();
    u64 mysel = 0ull;
#pragma unroll 1
    for (int tk = 0; tk < 8; ++tk) {
        const int tl = 8 * w + tk, t = 64 * qc + tl, j = lane;
        const float v = IMP[tl * 64 + j];
        const bool forced = (j == 0) || (j == qc) || (j == qc - 1);
        const bool valid = j <= qc;
        const float score = forced ? v + 1e4f : (valid ? v : -1.0f);
        int rank = 0;
#pragma unroll
        for (int jp = 0; jp < 64; ++jp) { const float o_ = __builtin_bit_cast(float, __builtin_amdgcn_readlane(__builtin_bit_cast(int, score), jp)); rank += ((o_ > score) || (o_ == score && jp < j)) ? 1 : 0; }
        const u64 mask = __ballot(rank < 16);
        (void)t;
        if (tk == (r32 >> 2)) mysel = mask;
    }
    __syncthreads();
    return mysel;
}

DI void moe_tables(const Ctx& F, int l) {
    LAS int* tb = (LAS int*)(F.lds + AUX_OFF); LAS int* cn = tb + 64;
    if (F.tid == 0) {
        const unsigned* C = (const unsigned*)(F.ws + WS_CTL) + CW_CNT + l * 32 * 64;
        int acc = 0;
        for (int e = 0; e < 32; ++e) { const int c = (int)__hip_atomic_load(C + e * 64, RLX_AGENT); tb[e] = acc; cn[e] = c; acc += (c + 255) >> 8; }
        tb[32] = acc;
    }
    __syncthreads();
}
template <int MODE>
DI void phase_norm1(const Ctx& F, int l) {
    const float* mods = (const float*)(F.ws + WS_MODS);
    const bf16* X = (const bf16*)(F.ws + WS_X); bf16* H = (bf16*)(F.ws + F.dofs + WS_H); bf16* XW = (bf16*)(F.ws + F.dofs + WS_X);
    const LAS int* tb = (const LAS int*)(F.lds + AUX_OFF);
    if (l > 0) moe_tables(F, l - 1);
    const int gw = F.blk * 8 + F.wave, NGW = F.G * 8, lane = F.lane;
    for (int tok = gw; tok < T; tok += NGW) {
        const int b = tok >> 12;
        f32x4 v[4];
        if (l == 0) { const float* xr = ginp(F, I_X) + (size_t)tok * 1024;
#pragma unroll
            for (int k = 0; k < 4; ++k) v[k] = *(const f32x4*)(xr + 4 * lane + 256 * k);
        } else { const bf16* xr = X + (size_t)tok * 1024;
#pragma unroll
            for (int k = 0; k < 4; ++k) { const u32x2 w = *(const u32x2*)(xr + 4 * lane + 256 * k); v[k] = (f32x4){bflo(w.x), bfhi(w.x), bflo(w.y), bfhi(w.y)}; }
        }
        if (l > 0) {
            f32x4 y[4];
#pragma unroll
            for (int k = 0; k < 4; ++k) y[k] = (f32x4){0.f, 0.f, 0.f, 0.f};
            const int* ts = (const int*)(F.ws + WS_TOKSLOT) + (size_t)tok * 4;
            const f32x4 tg = *(const f32x4*)((const float*)(F.ws + WS_TOKG) + (size_t)tok * 4) * Y2_ISCALE;
#pragma unroll
            for (int s = 0; s < 4; ++s) {
                const int pk = ts[s]; const int e = pk >> 16, pos = pk & 0xffff;
                const unsigned char* yr = (const unsigned char*)(F.ws + WS_Y2) + ((size_t)tb[e] * 256 + pos) * 1024;
#pragma unroll
                for (int k = 0; k < 4; ++k) { const unsigned w = *(const unsigned*)(yr + 4 * lane + 256 * k); y[k] += unpk4_fp8(w) * tg[s]; }
            }
            const float* gt2 = mods + ((size_t)((l - 1) * 8 + b) * 6 + 5) * 1024;
#pragma unroll
            for (int k = 0; k < 4; ++k) v[k] = v[k] + *(const f32x4*)(gt2 + 4 * lane + 256 * k) * y[k];
        }
        float ss = 0.f;
#pragma unroll
        for (int k = 0; k < 4; ++k) ss += v[k][0] * v[k][0] + v[k][1] * v[k][1] + v[k][2] * v[k][2] + v[k][3] * v[k][3];
        const float rstd = rsqrtf(wave_sum(ss) * (1.0f / 1024.0f) + EPS);
        if (MODE == 0) {
            const float* g1 = ginp(F, I_G1) + (size_t)l * 1024;
            const float* sh = mods + ((size_t)(l * 8 + b) * 6 + 0) * 1024; const float* sc = sh + 1024;
#pragma unroll
            for (int k = 0; k < 4; ++k) {
                const int c = 4 * lane + 256 * k;
                { u32x2 xw; xw.x = pk2(v[k][0], v[k][1]); xw.y = pk2(v[k][2], v[k][3]); *(u32x2*)(XW + (size_t)tok * 1024 + c) = xw; }
                const f32x4 hv = v[k] * rstd * *(const f32x4*)(g1 + c) * (*(const f32x4*)(sc + c) + 1.0f) + *(const f32x4*)(sh + c);
                u32x2 w; w.x = pk2(hv[0], hv[1]); w.y = pk2(hv[2], hv[3]);
                *(u32x2*)(H + (size_t)tok * 1024 + c) = w;
            }
        } else {
            const float* gf = ginp(F, I_GF);
#pragma unroll
            for (int k = 0; k < 4; ++k) { const int c = 4 * lane + 256 * k; *(f32x4*)(gout(F) + (size_t)tok * 1024 + c) = v[k] * rstd * *(const f32x4*)(gf + c); }
        }
    }
}
DI void phase_prep(const Ctx& F) {
    const bf16* CQ = (const bf16*)(F.ws + WS_CQ); const bf16* MISC = (const bf16*)(F.ws + WS_MISC);
    float* RQ = (float*)(F.ws + WS_RSTDQ); float* RKV = (float*)(F.ws + WS_RSTDKV);
    bf16* KR = (bf16*)(F.ws + WS_KR); float* GATES = (float*)(F.ws + WS_GATES); const float* CS32 = (const float*)(F.ws + WS_CS32);
    const int gw = F.blk * 8 + F.wave, NGW = F.G * 8, lane = F.lane;
    for (int tok = gw; tok < T; tok += NGW) {
        const u32x2 wq = *(const u32x2*)(CQ + (size_t)tok * 256 + 4 * lane);
        const u32x2 wm = *(const u32x2*)(MISC + (size_t)tok * 256 + 4 * lane);
        float a0 = bflo(wq.x), a1 = bfhi(wq.x), a2 = bflo(wq.y), a3 = bfhi(wq.y);
        const float sq = wave_sum(a0 * a0 + a1 * a1 + a2 * a2 + a3 * a3);
        float m0 = bflo(wm.x), m1 = bfhi(wm.x), m2 = bflo(wm.y), m3 = bfhi(wm.y);
        const float skv = wave_sum(lane < 32 ? (m0 * m0 + m1 * m1 + m2 * m2 + m3 * m3) : 0.f);
        if (lane == 0) { RQ[tok] = rsqrtf(sq * (1.0f / 256.0f) + EPS); RKV[tok] = rsqrtf(skv * (1.0f / 128.0f) + EPS); }
        const float p0 = __shfl_xor(m0, 4), p1 = __shfl_xor(m1, 4), p2 = __shfl_xor(m2, 4), p3 = __shfl_xor(m3, 4);
        if (lane >= 32 && lane < 36) {
            const int i0 = 4 * (lane - 32);
            const f32x4 c4 = *(const f32x4*)(CS32 + (size_t)tok * 32 + i0), s4 = *(const f32x4*)(CS32 + (size_t)tok * 32 + 16 + i0);
            u32x4 w;
            w.x = pk2(m0 * c4[0] - p0 * s4[0], p0 * c4[0] + m0 * s4[0]); w.y = pk2(m1 * c4[1] - p1 * s4[1], p1 * c4[1] + m1 * s4[1]);
            w.z = pk2(m2 * c4[2] - p2 * s4[2], p2 * c4[2] + m2 * s4[2]); w.w = pk2(m3 * c4[3] - p3 * s4[3], p3 * c4[3] + m3 * s4[3]);
            *(u32x4*)(KR + (size_t)tok * 32 + 2 * i0) = w;
        }
        if (lane >= 40 && lane < 46) {
            const int gi = 4 * (lane - 40);
            *(f32x4*)(GATES + (size_t)tok * 24 + gi) = (f32x4){sigmoidf_(m0), sigmoidf_(m1), sigmoidf_(m2), sigmoidf_(m3)};
        }
    }
}
DI void phase_cmp2(const Ctx& F, int l) {
    const bf16* HID = (const bf16*)(F.ws + WS_HID);
    const float* CS64 = (const float*)(F.ws + WS_CS64);
    const int gw = F.blk * 8 + F.wave, NGW = F.G * 8, lane = F.lane;
    for (int it = gw; it < 8192; it += NGW) {
        const int kv = it >> 12, row = it & 4095, c = row & 255, bg = row >> 8;
        const float* w2 = ginp(F, kv ? I_W2V : I_W2K) + (size_t)l * 256 * 64;
        const float* b2 = ginp(F, kv ? I_B2V : I_B2K) + (size_t)l * 64;
        const u32x2 hw = *(const u32x2*)(HID + ((size_t)kv * 4096 + row) * 256 + 4 * lane);
        const float h0 = bflo(hw.x), h1 = bfhi(hw.x), h2 = bflo(hw.y), h3 = bfhi(hw.y);
        float acc = b2[lane];
#pragma unroll 4
        for (int k4 = 0; k4 < 64; ++k4) {
            const float x0 = __builtin_bit_cast(float, __builtin_amdgcn_readlane(__builtin_bit_cast(int, h0), k4));
            const float x1 = __builtin_bit_cast(float, __builtin_amdgcn_readlane(__builtin_bit_cast(int, h1), k4));
            const float x2 = __builtin_bit_cast(float, __builtin_amdgcn_readlane(__builtin_bit_cast(int, h2), k4));
            const float x3 = __builtin_bit_cast(float, __builtin_amdgcn_readlane(__builtin_bit_cast(int, h3), k4));
            acc += x0 * w2[(4 * k4 + 0) * 64 + lane] + x1 * w2[(4 * k4 + 1) * 64 + lane] + x2 * w2[(4 * k4 + 2) * 64 + lane] + x3 * w2[(4 * k4 + 3) * 64 + lane];
        }
        if (c == 255) acc = 0.f;
        if (kv == 0) {
            const int b = bg >> 1, tokr = b * S + 16 * c + 31;
            const float other = __shfl_xor(acc, 32);
            const int i = lane & 31;
            const float cs = CS64[(size_t)(tokr & (T - 1)) * 64 + i], sn = CS64[(size_t)(tokr & (T - 1)) * 64 + 32 + i];
            const float y = (lane < 32) ? (acc * cs - other * sn) : (acc * cs + other * sn);
            ((bf16*)(F.ws + WS_KC))[(size_t)row * 64 + 2 * i + (lane >> 5)] = (bf16)(pk2(y, 0.f) & 0xffffu);
        } else {
            ((bf16*)(F.ws + WS_VC))[(size_t)row * 64 + lane] = (bf16)(pk2(acc, 0.f) & 0xffffu);
        }
    }
}
DI void phase_mix(const Ctx& F, int l) {
    const bf16* OA3 = (const bf16*)(F.ws + WS_OA3); const float* LSEA = (const float*)(F.ws + WS_LSEA);
    const bf16* OCMP = (const bf16*)(F.ws + WS_OCMP); const bf16* OSLC = (const bf16*)(F.ws + WS_OSLC); const bf16* OWIN = (const bf16*)(F.ws + WS_OWIN);
    const bf16* OC = (const bf16*)(F.ws + WS_OC); const bf16* MISC = (const bf16*)(F.ws + WS_MISC);
    bf16* AMIX = (bf16*)(F.ws + WS_AMIX);
    const float* ga = ginp(F, I_GOA) + (size_t)l * 256; const float* gb = ginp(F, I_GOB) + (size_t)l * 512; const float* gc = ginp(F, I_GOC) + (size_t)l * 256;
    const int gw = F.blk * 8 + F.wave, NGW = F.G * 8, lane = F.lane, ha = lane >> 4;
    for (int tok0 = gw; tok0 < T; tok0 += 2 * NGW) {
        int tok[2]; tok[0] = tok0; tok[1] = (tok0 + NGW < T) ? tok0 + NGW : tok0;
        float ls[2][3]; u32x2 wa[2][3], wb[2][2], wc_[2];
#pragma unroll
        for (int q = 0; q < 2; ++q) {
#pragma unroll
            for (int p = 0; p < 3; ++p) { ls[q][p] = LSEA[((size_t)p * T + tok[q]) * 4 + ha]; wa[q][p] = *(const u32x2*)(OA3 + ((size_t)p * T + tok[q]) * 256 + 4 * lane); }
#pragma unroll
            for (int k = 0; k < 2; ++k) {
                const int col = 256 * k + 4 * lane;
                wb[q][k] = *(const u32x2*)(OSLC + (size_t)tok[q] * 512 + col);
            }
            wc_[q] = *(const u32x2*)(OC + (size_t)tok[q] * 256 + 4 * lane);
        }
        f32x4 va[2], vb[2][2], vc[2]; float red[2][3];
#pragma unroll
        for (int q = 0; q < 2; ++q) {
            const float mx = fmaxf(ls[q][0], fmaxf(ls[q][1], ls[q][2]));
            const float w0 = fast_exp2(ls[q][0] - mx), w1 = fast_exp2(ls[q][1] - mx), w2 = fast_exp2(ls[q][2] - mx), wi = 1.0f / (w0 + w1 + w2);
            va[q] = ((f32x4){bflo(wa[q][0].x), bfhi(wa[q][0].x), bflo(wa[q][0].y), bfhi(wa[q][0].y)} * w0 + (f32x4){bflo(wa[q][1].x), bfhi(wa[q][1].x), bflo(wa[q][1].y), bfhi(wa[q][1].y)} * w1
                   + (f32x4){bflo(wa[q][2].x), bfhi(wa[q][2].x), bflo(wa[q][2].y), bfhi(wa[q][2].y)} * w2) * wi;
            red[q][0] = va[q][0] * va[q][0] + va[q][1] * va[q][1] + va[q][2] * va[q][2] + va[q][3] * va[q][3];
            float sb = 0.f;
#pragma unroll
            for (int k = 0; k < 2; ++k) {
                const u32x2 a = wb[q][k];
                vb[q][k][0] = bflo(a.x); vb[q][k][1] = bfhi(a.x); vb[q][k][2] = bflo(a.y); vb[q][k][3] = bfhi(a.y);
                sb += vb[q][k][0] * vb[q][k][0] + vb[q][k][1] * vb[q][k][1] + vb[q][k][2] * vb[q][k][2] + vb[q][k][3] * vb[q][k][3];
            }
            red[q][1] = sb;
            vc[q] = (f32x4){bflo(wc_[q].x), bfhi(wc_[q].x), bflo(wc_[q].y), bfhi(wc_[q].y)};
            red[q][2] = vc[q][0] * vc[q][0] + vc[q][1] * vc[q][1] + vc[q][2] * vc[q][2] + vc[q][3] * vc[q][3];
        }
#pragma unroll
        for (int q = 0; q < 2; ++q)
#pragma unroll
            for (int j = 0; j < 3; ++j) red[q][j] = wave_sum(red[q][j]);
#pragma unroll
        for (int q = 0; q < 2; ++q) {
            if (q == 1 && tok0 + NGW >= T) break;
            const float ra = rsqrtf(red[q][0] * (1.0f / 256.0f) + EPS), rb = rsqrtf(red[q][1] * (1.0f / 512.0f) + EPS), rc = rsqrtf(red[q][2] * (1.0f / 256.0f) + EPS);
            bf16* orow = AMIX + (size_t)tok[q] * 1024;
            { const f32x4 o = va[q] * ra * *(const f32x4*)(ga + 4 * lane); u32x2 w; w.x = pk2(o[0], o[1]); w.y = pk2(o[2], o[3]); *(u32x2*)(orow + 4 * lane) = w; }
#pragma unroll
            for (int k = 0; k < 2; ++k) { const f32x4 o = vb[q][k] * rb * *(const f32x4*)(gb + 256 * k + 4 * lane); u32x2 w; w.x = pk2(o[0], o[1]); w.y = pk2(o[2], o[3]); *(u32x2*)(orow + 256 + 256 * k + 4 * lane) = w; }
            { const f32x4 o = vc[q] * rc * *(const f32x4*)(gc + 4 * lane); u32x2 w; w.x = pk2(o[0], o[1]); w.y = pk2(o[2], o[3]); *(u32x2*)(orow + 768 + 4 * lane) = w; }
        }
    }
}
DI void phase_router(const Ctx& F, int l) {
    LAS unsigned char* WH = F.lds; LAS unsigned char* WL = F.lds + 65536;
    LAS float* biasp = (LAS float*)(F.lds + AUX_OFF); LAS float* RS = biasp + 32;
    LAS int* lcnt = (LAS int*)(F.lds + AUX_OFF + 1024); LAS int* gbase = lcnt + 32;
    LAS int* tokE = gbase + 32; LAS float* tokG = (LAS float*)(tokE + 512); LAS int* tokP = (LAS int*)(tokG + 512);
    const float* wr = ginp(F, I_WR) + (size_t)l * 1024 * 32; const float* br = ginp(F, I_BR) + (size_t)l * 32;
    const float* mods = (const float*)(F.ws + WS_MODS); const bf16* X = (const bf16*)(F.ws + WS_X); bf16* H = (bf16*)(F.ws + F.dofs + WS_H);
    const float* g2 = ginp(F, I_G2) + (size_t)l * 1024;
    const int tid = F.tid, lane = F.lane, w = F.wave;
    if (tid < 32) lcnt[tid] = 0;
    unsigned* CNT = (unsigned*)(F.ws + WS_CTL) + CW_CNT + (l + F.dcnt) * 32 * 64;
    for (int chunk = F.blk; chunk < T / 128; chunk += F.G) {
        const int b = (chunk * 128) >> 12;
        const float* sh = mods + ((size_t)(l * 8 + b) * 6 + 3) * 1024; const float* sc = sh + 1024;
        {
            float bacc = 0.f; const int e = tid & 31;
#pragma unroll 4
            for (int it = 0; it < 32; ++it) {
                const int k = 2 * ((tid + 512 * it) >> 5);
                const float w0 = wr[k * 32 + e], w1 = wr[(k + 1) * 32 + e];
                const float p0 = w0 * (g2[k] * (sc[k] + 1.0f)), p1 = w1 * (g2[k + 1] * (sc[k + 1] + 1.0f));
                bacc += sh[k] * w0 + sh[k + 1] * w1;
                const unsigned hi = pk2(p0, p1);
                const unsigned lo = pk2(p0 - bflo(hi), p1 - bfhi(hi));
                const int off = e * 2048 + ((((k >> 3) ^ e) << 4) | ((k & 7) * 2));
                *(LAS unsigned*)(WH + off) = hi; *(LAS unsigned*)(WL + off) = lo;
            }
            tokG[tid] = bacc;
        }
        __syncthreads();
        if (tid < 32) { float s_ = br[tid];
#pragma unroll
            for (int j = 0; j < 16; ++j) s_ += tokG[tid + 32 * j];
            biasp[tid] = s_; }
        {
            u32x2 ra[4], rb[4];
            f32x4 ggv[4], hhv[4];
#pragma unroll
            for (int k = 0; k < 4; ++k) { const int c = 4 * lane + 256 * k; ggv[k] = *(const f32x4*)(g2 + c) * (*(const f32x4*)(sc + c) + 1.0f); hhv[k] = *(const f32x4*)(sh + c); }
            { const bf16* x0 = X + (size_t)(chunk * 128 + w * 16) * 1024 + 4 * lane;
#pragma unroll
              for (int k = 0; k < 4; ++k) { ra[k] = *(const u32x2*)(x0 + 256 * k); rb[k] = *(const u32x2*)(x0 + 1024 + 256 * k); } }
#pragma unroll 1
            for (int tt = 0; tt < 8; ++tt) {
                const int tl0 = w * 16 + 2 * tt, tok0 = chunk * 128 + tl0;
                f32x4 v[2][4]; float ss0 = 0.f, ss1 = 0.f;
#pragma unroll
                for (int k = 0; k < 4; ++k) { v[0][k] = (f32x4){bflo(ra[k].x), bfhi(ra[k].x), bflo(ra[k].y), bfhi(ra[k].y)}; v[1][k] = (f32x4){bflo(rb[k].x), bfhi(rb[k].x), bflo(rb[k].y), bfhi(rb[k].y)}; }
                { const int tn = (tt < 7) ? tok0 + 2 : tok0; const bf16* x0 = X + (size_t)tn * 1024 + 4 * lane;
#pragma unroll
                  for (int k = 0; k < 4; ++k) { ra[k] = *(const u32x2*)(x0 + 256 * k); rb[k] = *(const u32x2*)(x0 + 1024 + 256 * k); } }
#pragma unroll
                for (int k = 0; k < 4; ++k) { ss0 += v[0][k][0] * v[0][k][0] + v[0][k][1] * v[0][k][1] + v[0][k][2] * v[0][k][2] + v[0][k][3] * v[0][k][3];
                                              ss1 += v[1][k][0] * v[1][k][0] + v[1][k][1] * v[1][k][1] + v[1][k][2] * v[1][k][2] + v[1][k][3] * v[1][k][3]; }
                ss0 = wave_sum(ss0); ss1 = wave_sum(ss1);
                const float rs0 = rsqrtf(ss0 * (1.0f / 1024.0f) + EPS), rs1 = rsqrtf(ss1 * (1.0f / 1024.0f) + EPS);
                if (lane == 0) { RS[tl0] = rs0; RS[tl0 + 1] = rs1; }
#pragma unroll
                for (int k = 0; k < 4; ++k) {
                    const int c = 4 * lane + 256 * k;
                    v[0][k] = v[0][k] * rs0 * ggv[k] + hhv[k]; v[1][k] = v[1][k] * rs1 * ggv[k] + hhv[k];
                    *(unsigned*)((unsigned char*)H + (size_t)tok0 * 1024 + c) = pk4_fp8s(v[0][k][0], v[0][k][1], v[0][k][2], v[0][k][3], H8_SCALE);
                    *(unsigned*)((unsigned char*)H + (size_t)(tok0 + 1) * 1024 + c) = pk4_fp8s(v[1][k][0], v[1][k][1], v[1][k][2], v[1][k][3], H8_SCALE);
                }
            }
        }
        __syncthreads();
        f32x4 acc[2] = {{0.f, 0.f, 0.f, 0.f}, {0.f, 0.f, 0.f, 0.f}};
        {
            const int kg = lane >> 4, n16 = lane & 15;
            const bf16* xr = X + (size_t)(chunk * 128 + w * 16 + n16) * 1024 + 8 * kg;
#pragma unroll 1
            for (int k8 = 0; k8 < 4; ++k8) {
                bf16x8 af[8];
#pragma unroll
                for (int j = 0; j < 8; ++j) af[j] = *(const bf16x8*)(xr + 32 * (8 * k8 + j));
#pragma unroll
                for (int j = 0; j < 8; ++j) {
                    const int c = 4 * (8 * k8 + j) + kg;
#pragma unroll
                    for (int et = 0; et < 2; ++et) {
                        const int e = 16 * et + n16, off = e * 2048 + ((c ^ e) << 4);
                        const bf16x8 bh = *(const LAS bf16x8*)(WH + off), bl = *(const LAS bf16x8*)(WL + off);
                        acc[et] = __builtin_amdgcn_mfma_f32_16x16x32_bf16(af[j], bh, acc[et], 0, 0, 0);
                        acc[et] = __builtin_amdgcn_mfma_f32_16x16x32_bf16(af[j], bl, acc[et], 0, 0, 0);
                    }
                }
            }
        }
        __syncthreads();
        LAS float* LG = (LAS float*)(F.lds + w * 2048);
        {
            const int g4 = lane >> 4, n16 = lane & 15;
#pragma unroll
            for (int et = 0; et < 2; ++et)
#pragma unroll
                for (int i = 0; i < 4; ++i) LG[(4 * g4 + i) * 32 + 16 * et + n16] = acc[et][i] * RS[w * 16 + 4 * g4 + i] + biasp[16 * et + n16];
        }
        asm volatile("s_waitcnt lgkmcnt(0)" ::: "memory");
#pragma unroll 1
        for (int tt = 0; tt < 8; ++tt) {
            const int tl0 = w * 16 + 2 * tt;
            const float lg0 = LG[(2 * tt) * 32 + (lane >> 1)], lg1 = LG[(2 * tt + 1) * 32 + (lane >> 1)];
            int rk0 = 0, rk1 = 0; const int me = lane >> 1;
#pragma unroll
            for (int e = 0; e < 32; ++e) {
                const float o0 = __builtin_bit_cast(float, __builtin_amdgcn_readlane(__builtin_bit_cast(int, lg0), 2 * e));
                const float o1 = __builtin_bit_cast(float, __builtin_amdgcn_readlane(__builtin_bit_cast(int, lg1), 2 * e));
                rk0 += ((o0 > lg0) || (o0 == lg0 && e < me)) ? 1 : 0; rk1 += ((o1 > lg1) || (o1 == lg1 && e < me)) ? 1 : 0;
            }
#pragma unroll
            for (int tk = 0; tk < 2; ++tk) {
                const int rk = tk ? rk1 : rk0; const float lg = tk ? lg1 : lg0;
                int te[4]; float tv[4];
#pragma unroll
                for (int r = 0; r < 4; ++r) {
                    const u64 mk = __ballot(rk == r && (lane & 1) == 0);
                    const int sl = __builtin_amdgcn_readfirstlane((int)__builtin_ctzll(mk));
                    te[r] = sl >> 1; tv[r] = __builtin_bit_cast(float, __builtin_amdgcn_readlane(__builtin_bit_cast(int, lg), sl));
                }
                const float e1 = __expf(tv[1] - tv[0]), e2 = __expf(tv[2] - tv[0]), e3 = __expf(tv[3] - tv[0]);
                const float isum = 1.0f / (1.0f + e1 + e2 + e3);
                if (lane < 4) {
                    const int tl = tl0 + tk;
                    const int e = lane == 0 ? te[0] : lane == 1 ? te[1] : lane == 2 ? te[2] : te[3];
                    const float gte = (lane == 0 ? 1.0f : lane == 1 ? e1 : lane == 2 ? e2 : e3) * isum;
                    const int pos = atomicAdd((int*)(lcnt + e), 1);
                    tokE[tl * 4 + lane] = e; tokG[tl * 4 + lane] = gte; tokP[tl * 4 + lane] = pos;
                }
            }
        }
        __syncthreads();
        if (tid < 32) gbase[tid] = (int)__hip_atomic_fetch_add(CNT + tid * 64, (unsigned)lcnt[tid], RLX_AGENT);
        __syncthreads();
        {
            const int tl = tid >> 2, r = tid & 3, e = tokE[tid], pos = gbase[e] + tokP[tid], tok = chunk * 128 + tl;
            ((int*)(F.ws + F.dofs + WS_IDX))[(size_t)e * ECAP + pos] = tok;
            ((float*)(F.ws + F.dofs + WS_TOKG))[(size_t)tok * 4 + r] = tokG[tid];
            ((int*)(F.ws + F.dofs + WS_TOKSLOT))[(size_t)tok * 4 + r] = (e << 16) | pos;
        }
        __syncthreads();
        if (tid < 32) lcnt[tid] = 0;
        __syncthreads();
    }
}

DI int ropeperm64(int p) { return (p >> 1) + 32 * (p & 1); }
DI int cmap_win(int n) {
    const int tile = n >> 8, w = n & 255, hb = w & ~63, pp = ropeperm64(w & 63);
    switch (tile) {
        case 0: return hb + pp;
        case 1: return 256 + hb + pp;
        case 2: return 512 + w;
        case 3: return 768 + hb + pp;
        case 4: return 1024 + hb + pp;
        case 5: return w < 128 ? 1280 + w : 1408 + (w - 128);
        case 6: return w < 128 ? 1536 + hb + pp : 1664 + (w - 128);
        case 7: return w < 128 ? 1792 + hb + pp : 1920 + (w - 128);
        case 8: return 2072 + w;
        default: return w < 128 ? 2328 + w : (w < 160 ? 2456 + ((w - 128) >> 1) + 16 * ((w - 128) & 1) : (w < 184 ? 2048 + (w - 160) : -1));
    }
}
DI int cmap_qup(int n) { if (n >= 384) return -1; const int h = n / 96, w = n % 96; if (w < 64) return h * 96 + w; const int j = w - 64; return h * 96 + 64 + (j >> 1) + 16 * (j & 1); }
DI void tr_tile(const float* src, int K, int Nsrc, bf16* dst, int Kdst, int maptype, const float* ksc, int ntile, int ktile, LAS float* scr, int tid) {
    const int n0 = ntile * 64, k0 = ktile * 128, nl = tid & 63, n = n0 + nl;
    const int c = maptype == 0 ? (n < Nsrc ? n : -1) : (maptype == 1 ? cmap_win(n) : cmap_qup(n));
    float v[16];
#pragma unroll
    for (int it = 0; it < 16; ++it) { const int k = k0 + (tid >> 6) + 8 * it; v[it] = (c >= 0 && k < K) ? src[(size_t)k * Nsrc + c] * (ksc ? ksc[k] : 1.0f) : 0.f; }
#pragma unroll
    for (int it = 0; it < 16; ++it) scr[((tid >> 6) + 8 * it) * 65 + nl] = v[it];
    __syncthreads();
#pragma unroll
    for (int it = 0; it < 2; ++it) {
        const int idx = tid + 512 * it, nn = idx >> 4, ch = idx & 15;
        const LAS float* s = scr + (8 * ch) * 65 + nn;
        u32x4 o; o.x = pk2(s[0], s[65]); o.y = pk2(s[2 * 65], s[3 * 65]); o.z = pk2(s[4 * 65], s[5 * 65]); o.w = pk2(s[6 * 65], s[7 * 65]);
        *(u32x4*)(dst + (size_t)(n0 + nn) * Kdst + k0 + 8 * ch) = o;
    }
    __syncthreads();
}
DI void trb_load(f32x4 (&v)[16], const float* src, int N, int n0, int k0, int tid) {
#pragma unroll
    for (int it = 0; it < 16; ++it) v[it] = *(const f32x4*)(src + (size_t)(k0 + (tid >> 6) + 8 * it) * N + n0 + 4 * (tid & 63));
}
DI void trb_store(const f32x4 (&v)[16], bf16* dst, int Kd, int n0, int k0, LAS unsigned char* L, int tid, int wave, int lane, int f8 = 0) {
#pragma unroll
    for (int it = 0; it < 16; ++it) { f32x4 x = v[it];
        if (f8) { x[0] = q8s(x[0], W8_SCALE); x[1] = q8s(x[1], W8_SCALE); x[2] = q8s(x[2], W8_SCALE); x[3] = q8s(x[3], W8_SCALE); }
        u32x2 w; w.x = pk2(x[0], x[1]); w.y = pk2(x[2], x[3]); *(LAS u32x2*)(L + ((tid >> 6) + 8 * it) * 576 + (tid & 63) * 8) = w; }
    asm volatile("s_waitcnt lgkmcnt(0)\n\ts_barrier" ::: "memory");
    const int i = lane & 15, gn = (lane >> 4) & 1, h = lane >> 5, q = i >> 2, p = i & 3;
    const LAS unsigned char* base = L + (8 * h + q) * 576 + (32 * wave + 16 * gn) * 2 + 8 * p;
    if (!f8) {
        bf16* drow = dst + (size_t)(n0 + 32 * wave + 16 * gn + i) * Kd + k0 + 8 * h;
#pragma unroll
        for (int kcp = 0; kcp < 8; ++kcp) {
            const s16x4 lo = tr_read(base + (16 * kcp) * 576), hi = tr_read(base + (16 * kcp + 4) * 576);
            *(bf16x8*)(drow + 16 * kcp) = __builtin_shufflevector(lo, hi, 0, 1, 2, 3, 4, 5, 6, 7);
        }
    } else {
        unsigned char* drow = (unsigned char*)dst + (size_t)(n0 + 32 * wave + 16 * gn + i) * Kd + k0 + 8 * h;
#pragma unroll
        for (int kcp = 0; kcp < 8; ++kcp) {
            const s16x4 lo = tr_read(base + (16 * kcp) * 576), hi = tr_read(base + (16 * kcp + 4) * 576);
            int w0 = __builtin_amdgcn_cvt_pk_fp8_f32(bf2f((unsigned short)lo[0]), bf2f((unsigned short)lo[1]), 0, false); w0 = __builtin_amdgcn_cvt_pk_fp8_f32(bf2f((unsigned short)lo[2]), bf2f((unsigned short)lo[3]), w0, true);
            int w1 = __builtin_amdgcn_cvt_pk_fp8_f32(bf2f((unsigned short)hi[0]), bf2f((unsigned short)hi[1]), 0, false); w1 = __builtin_amdgcn_cvt_pk_fp8_f32(bf2f((unsigned short)hi[2]), bf2f((unsigned short)hi[3]), w1, true);
            u32x2 o; o.x = (unsigned)w0; o.y = (unsigned)w1;
            *(u32x2*)(drow + 16 * kcp) = o;
        }
    }
    asm volatile("s_waitcnt lgkmcnt(0)\n\ts_barrier" ::: "memory");
}
struct TrbItem { const float* src; bf16* dst; int N, n0, k0, f8; };
DI TrbItem trb_item(const Ctx& F, int it) {
    const int le = it / 96, r = it % 96; TrbItem t;
    if (r < 64) { t.src = ginp(F, I_WE1) + (size_t)le * 1024 * 2048; t.dst = (bf16*)(F.ws + WS_W1E + (size_t)le * 2048 * 1024); t.N = 2048; t.n0 = (r & 7) * 256; t.k0 = (r >> 3) * 128; t.f8 = 1; }
    else { const int q = r - 64; t.src = ginp(F, I_WE2) + (size_t)le * 1024 * 1024; t.dst = (bf16*)(F.ws + WS_W2E + (size_t)le * 1024 * 1024); t.N = 1024; t.n0 = (q & 3) * 256; t.k0 = (q >> 2) * 128; t.f8 = 1; }
    return t;
}
DI void conv_layer_tiles(const Ctx& F, int l, int q0, int i0, int cnt) {
    const int NL = 32 * 96;
    int it = q0 + F.blk + F.G * i0; const int end = q0 + F.blk + F.G * (i0 + cnt);
    if (it >= NL) return;
    f32x4 va[16];
    TrbItem ta = trb_item(F, l * NL + it);
    trb_load(va, ta.src, ta.N, ta.n0, ta.k0, F.tid);
#pragma unroll 1
    while (it < NL && it < end) {
        f32x4 vb[16];
#pragma unroll
        for (int k = 0; k < 16; ++k) vb[k] = va[k];
        const TrbItem tc = ta;
        it += F.G;
        const bool more = (it < NL && it < end);
        ta = trb_item(F, l * NL + (more ? it : 0));
        if (more) trb_load(va, ta.src, ta.N, ta.n0, ta.k0, F.tid);
        trb_store(vb, tc.dst, 1024, tc.n0, tc.k0, F.lds, F.tid, F.wave, F.lane, tc.f8);
    }
}
DI void conv_claim_tiles(const Ctx& F, int l, int quota) {
    const int NL = 32 * 96;
    volatile LAS unsigned* slot = (volatile LAS unsigned*)(F.lds + MISC_OFF) + 16;
    __syncthreads();
    if (F.tid == 0) { unsigned* q = (unsigned*)(F.ws + WS_CTL) + CW_CONVQ + l * 64; slot[0] = __hip_atomic_fetch_add(q, (unsigned)quota, __ATOMIC_RELAXED, __HIP_MEMORY_SCOPE_AGENT); }
    __syncthreads();
    int it = __builtin_amdgcn_readfirstlane((int)slot[0]); const int end = it + quota;
    if (it >= NL) return;
    f32x4 va[16];
    TrbItem ta = trb_item(F, l * NL + it);
    trb_load(va, ta.src, ta.N, ta.n0, ta.k0, F.tid);
#pragma unroll 1
    while (it < NL && it < end) {
        f32x4 vb[16];
#pragma unroll
        for (int k = 0; k < 16; ++k) vb[k] = va[k];
        const TrbItem tc = ta;
        it += 1;
        const bool more = (it < NL && it < end);
        ta = trb_item(F, l * NL + (more ? it : 0));
        if (more) trb_load(va, ta.src, ta.N, ta.n0, ta.k0, F.tid);
        trb_store(vb, tc.dst, 1024, tc.n0, tc.k0, F.lds, F.tid, F.wave, F.lane, tc.f8);
    }
}
DI void phase_prologue(const Ctx& F) {
    const Args& A = *F.a; const int tid = F.tid;
    LAS float* scr = (LAS float*)F.lds;
    if (!CONV_IN_LAYER) {
        const int NIT = DEPTH * 32 * 96;
        f32x4 va[16];
        int it = F.blk;
        TrbItem ta = trb_item(F, it < NIT ? it : 0);
        if (it < NIT) trb_load(va, ta.src, ta.N, ta.n0, ta.k0, tid);
#pragma unroll 1
        while (it < NIT) {
            f32x4 vb[16];
#pragma unroll
            for (int k = 0; k < 16; ++k) vb[k] = va[k];
            const TrbItem tc = ta;
            it += F.G;
            ta = trb_item(F, it < NIT ? it : 0);
            if (it < NIT) trb_load(va, ta.src, ta.N, ta.n0, ta.k0, tid);
            trb_store(vb, tc.dst, 1024, tc.n0, tc.k0, F.lds, tid, F.wave, F.lane, tc.f8);
        }
    }
    constexpr int PER_L = 8192 + 4096 + 320 + 128 + 128 + 16 + 16;
    for (int it = F.blk; it < DEPTH * PER_L; it += F.G) {
        const int l = it / PER_L; int r = it % PER_L;
        if (r < 8192 + 4096) continue;
        if (r < 8192) { const int e = r >> 8, t = r & 255;
            tr_tile(ginp(F, I_WE1) + ((size_t)(l * 32 + e)) * 1024 * 2048, 1024, 2048, (bf16*)(F.ws + WS_W1E) + ((size_t)(l * 32 + e)) * 2048 * 1024, 1024, 0, nullptr, t >> 3, t & 7, scr, tid); continue; }
        r -= 8192;
        if (r < 4096) { const int e = r >> 7, t = r & 127;
            tr_tile(ginp(F, I_WE2) + ((size_t)(l * 32 + e)) * 1024 * 1024, 1024, 1024, (bf16*)(F.ws + WS_W2E) + ((size_t)(l * 32 + e)) * 1024 * 1024, 1024, 0, nullptr, t >> 3, t & 7, scr, tid); continue; }
        r -= 4096;
        if (r < 320) { tr_tile(ginp(F, I_WIN) + (size_t)l * 1024 * 2488, 1024, 2488, (bf16*)(F.ws + WS_WIN) + (size_t)l * NIN * 1024, 1024, 1, nullptr, r >> 3, r & 7, scr, tid); continue; }
        r -= 320;
        if (r < 128) { tr_tile(ginp(F, I_WOUT) + (size_t)l * 1024 * 1024, 1024, 1024, (bf16*)(F.ws + WS_WOUT) + (size_t)l * 1024 * 1024, 1024, 0, nullptr, r >> 3, r & 7, scr, tid); continue; }
        r -= 128;
        if (r < 128) { const int kv = r >> 6, t = r & 63;
            tr_tile(ginp(F, kv ? I_W1V : I_W1K) + (size_t)l * 2048 * 256, 2048, 256, (bf16*)(F.ws + WS_NSAW1) + ((size_t)(l * 2 + kv)) * 256 * 2048, 2048, 0, nullptr, t >> 4, t & 15, scr, tid); continue; }
        r -= 128;
        if (r < 16) { tr_tile(ginp(F, I_WQUP) + (size_t)l * 256 * 384, 256, 384, (bf16*)(F.ws + WS_MLAQ) + (size_t)l * 512 * 256, 256, 2, ginp(F, I_GQ) + (size_t)l * 256, r >> 1, r & 1, scr, tid); continue; }
        r -= 16;
        tr_tile(ginp(F, I_WKVUP) + (size_t)l * 128 * 512, 128, 512, (bf16*)(F.ws + WS_MLAKV) + (size_t)l * 512 * 256, 256, 0, ginp(F, I_GKV) + (size_t)l * 128, r >> 1, r & 1, scr, tid);
    }
    for (int it = F.blk; it < DEPTH * 4; it += F.G) {
        const int l = it >> 2, kv = (it >> 1) & 1, kt = it & 1;
        tr_tile(ginp(F, kv ? I_W2V : I_W2K) + (size_t)l * 256 * 64, 256, 64, (bf16*)(F.ws + WS_W2T) + ((size_t)(l * 2 + kv)) * 64 * 256, 256, 0, nullptr, 0, kt, scr, tid);
    }
    {
        float* CS64 = (float*)(F.ws + WS_CS64); float* CS32 = (float*)(F.ws + WS_CS32);
        const int* pos = (const int*)ginp(F, I_POS);
        for (int idx = F.blk * 512 + tid; idx < T * 48; idx += F.G * 512) {
            const int tok = idx / 48, i = idx % 48;
            const double p = (double)pos[tok];
            const double inv = (i < 32) ? exp2(-(double)i * (13.287712379549449 / 32.0)) : exp2(-(double)(i - 32) * (13.287712379549449 / 16.0));
            double ang = p * inv;
            const double kk = __builtin_rint(ang * 0.15915494309189535);
            ang = ang - kk * 6.283185307179586;
            const float af = (float)ang;
            const float cs = __cosf(af), sn = __sinf(af);
            if (i < 32) { CS64[(size_t)tok * 64 + i] = cs; CS64[(size_t)tok * 64 + 32 + i] = sn; }
            else { CS32[(size_t)tok * 32 + (i - 32)] = cs; CS32[(size_t)tok * 32 + 16 + (i - 32)] = sn; }
        }
    }
    for (int item = F.blk; item < 32; item += F.G) {
        const int lk = item >> 2, l = lk >> 1, kv = lk & 1, col = (item & 3) * 64 + F.lane;
        const float* w1 = ginp(F, kv ? I_W1V : I_W1K) + (size_t)l * 2048 * 256 + col; const float* pe = ginp(F, kv ? I_POSV : I_POSK) + (size_t)l * 2048;
        float s = 0.f;
#pragma unroll 1
        for (int kb = 256 * F.wave; kb < 256 * F.wave + 256; kb += 16) {
            float wv[16];
#pragma unroll
            for (int j = 0; j < 16; ++j) wv[j] = w1[(size_t)(kb + j) * 256];
#pragma unroll
            for (int j = 0; j < 16; ++j) s += pe[kb + j] * wv[j];
        }
        scr[F.wave * 64 + F.lane] = s;
        __syncthreads();
        if (tid < 64) { float t = ginp(F, kv ? I_B1V : I_B1K)[(size_t)l * 256 + col];
#pragma unroll
            for (int ww = 0; ww < 8; ++ww) t += scr[ww * 64 + tid];
            ((float*)(F.ws + WS_B1P))[(size_t)lk * 256 + col] = t; }
        __syncthreads();
    }
    {
        LAS float* sc = scr; LAS float* red = scr + 8192;
        for (int i = tid; i < 8192; i += 512) { const float c = ginp(F, I_C)[i]; sc[i] = c * sigmoidf_(c); }
        __syncthreads();
        float* MODS = (float*)(F.ws + WS_MODS);
        const int lane = F.lane, w = F.wave;
        for (int item = F.blk; item < 384; item += F.G) {
            const int l = item / 96, col = (item % 96) * 64 + lane;
            float acc[8];
#pragma unroll
            for (int b = 0; b < 8; ++b) acc[b] = 0.f;
            const float* wa = ginp(F, I_WADA) + (size_t)l * 1024 * 6144 + col;
#pragma unroll 1
            for (int kb = 128 * w; kb < 128 * w + 128; kb += 16) {
                float wv[16];
#pragma unroll
                for (int j = 0; j < 16; ++j) wv[j] = wa[(size_t)(kb + j) * 6144];
#pragma unroll
                for (int j = 0; j < 16; ++j) {
#pragma unroll
                    for (int b = 0; b < 8; ++b) acc[b] += sc[b * 1024 + kb + j] * wv[j]; }
            }
#pragma unroll
            for (int b = 0; b < 8; ++b) red[(w * 8 + b) * 64 + lane] = acc[b];
            __syncthreads();
            { const int b = tid >> 6; float s = ginp(F, I_BADA)[(size_t)l * 6144 + col];
#pragma unroll
              for (int ww = 0; ww < 8; ++ww) s += red[(ww * 8 + b) * 64 + lane];
              MODS[((size_t)(l * 8 + b)) * 6144 + col] = s; }
            __syncthreads();
        }
    }
}

constexpr int PH_PER_LAYER = 11;
constexpr int N_PHASES = 1 + DEPTH * PH_PER_LAYER + 1;

__global__ void __launch_bounds__(512, 2) fwd_kernel(Args args) {
    extern __shared__ __attribute__((aligned(16))) unsigned char lds_raw[];
    Ctx F;
    F.lds = (LAS unsigned char*)lds_raw; F.a = &args; F.ws = args.ws;
    F.dofs = 0; F.dcnt = 0;
    F.tid = threadIdx.x; F.lane = F.tid & 63; F.wave = __builtin_amdgcn_readfirstlane(F.tid >> 6); F.blk = blockIdx.x; F.G = gridDim.x; F.vcu = F.blk;
    volatile LAS unsigned* MISC = (volatile LAS unsigned*)(F.lds + MISC_OFF);
    for (int u = F.tid; u < (LDS_BYTES - MISC_OFF) / 4; u += 512) MISC[u] = 0u;
    __syncthreads();
    unsigned* ctl = (unsigned*)(F.ws + WS_CTL);
    XcdBarrier bar; bar.bar = ctl + CW_BAR; bar.x = 0; bar.st = nullptr;
    if (!MK_PER_PHASE) bar = xcd_barrier_post(ctl + CW_BAR, MISC + 8);
    const int lo = args.ph_lo, hi = args.ph_hi;
#define IN(k) (lo <= (k) && (k) < hi)
#define SEAM(k) do { if (IN(k) && IN((k) + 1)) xcd_barrier(bar); } while (0)
    unsigned char* ws = F.ws;
#define PHASE_BEGIN() do { int t_ = threadIdx.x; asm volatile("" : "+v"(t_)); F.tid = t_; F.lane = t_ & 63; F.wave = __builtin_amdgcn_readfirstlane(t_ >> 6); \
        GAS unsigned char* w_ = (GAS unsigned char*)args.ws; asm volatile("" : "+s"(w_)); F.ws = (unsigned char*)w_; ws = (unsigned char*)w_; int b_ = blockIdx.x; asm volatile("" : "+s"(b_)); F.blk = b_; F.vcu = (F.G % 8 == 0) ? (b_ % 8) * (F.G / 8) + b_ / 8 : b_; } while (0)

    if (PHON(0) && IN(0)) _Pragma("unroll 1") for (int rep_ = 0; rep_ < NREP(0); ++rep_) { PHASE_BEGIN(); phase_prologue(F); }
    SEAM(0);
#pragma unroll 1
    for (int l = 0; l < DEPTH; ++l) {
        const int P = 1 + l * PH_PER_LAYER;
        if (PHON(1) && IN(P + 0)) _Pragma("unroll 1") for (int rep_ = 0; rep_ < (DUM(1) ? 2 : 1); ++rep_) { PHASE_BEGIN(); F.dofs = (DUM(1) && rep_ == 0) ? WS_END : 0; phase_norm1<0>(F, l); }
        SEAM(P + 0);
        if (PHON(2) && IN(P + 1)) _Pragma("unroll 1") for (int rep_ = 0; rep_ < NREP(2); ++rep_) { PHASE_BEGIN();
            SchedGrid Sg{(const char*)(ws + WS_H), (const char*)(ws + WS_WIN) + (size_t)l * NIN * 1024 * 2, 1024, 1024, NIN / 256, (T / 256) * (NIN / 256), F.G, F.vcu};
            EpiWin E{ws, (const float*)(ws + WS_CS64), (const float*)(ws + WS_CS32)};
            pg8::gemm_phase<EpiWin, SchedGrid, false>(F.lds, 1024, 1024, Sg, E);
        }
        SEAM(P + 1);
        if (PHON(3) && IN(P + 2)) _Pragma("unroll 1") for (int rep_ = 0; rep_ < NREP(3); ++rep_) { PHASE_BEGIN();
            if (PHON(13)) {
                SchedCmp Sc{(const char*)(ws + WS_KCMP), (const char*)(ws + WS_VCMP), (const char*)(ws + WS_NSAW1) + (size_t)l * 2 * 256 * 2048 * 2, F.G, F.blk};
                EpiCmp E{(const float*)(ws + WS_B1P) + (size_t)l * 512, (const bf16*)(ws + WS_W2T) + (size_t)l * 2 * 64 * 256, ginp(F, I_B2K) + (size_t)l * 64, ginp(F, I_B2V) + (size_t)l * 64,
                         (bf16*)(ws + WS_KC), (bf16*)(ws + WS_VC), (const float*)(ws + WS_CS64)};
                pg8::gemm_phase<EpiCmp, SchedCmp, false>(F.lds, 1024, 2048, Sc, E);
            }
            PHASE_BEGIN();
            if (PHON(18)) {
                SchedMla Sm{(const char*)(ws + WS_CQ), (const char*)(ws + WS_MISC), (const char*)(ws + WS_MLAQ) + (size_t)l * 512 * 256 * 2, (const char*)(ws + WS_MLAKV) + (size_t)l * 512 * 256 * 2, F.G, F.vcu};
                EpiMla E{(bf16*)(ws + WS_QM), (bf16*)(ws + WS_KN), (bf16*)(ws + WS_VM), (const bf16*)(ws + WS_CQ), (const bf16*)(ws + WS_MISC), (const float*)(ws + WS_CS32)};
                pg8::gemm_phase<EpiMla, SchedMla, false>(F.lds, 256, 256, Sm, E);
            }
            PHASE_BEGIN();
            if (PHON(15)) {
                unsigned* qw = (unsigned*)(ws + WS_CTL) + CW_QUEUE + (l * 2 + rep_) * 64;
                volatile LAS int* qslot = (volatile LAS int*)(F.lds + AUX_OFF + 512);
                int nxt_t = 0;
                if (F.tid == 0) nxt_t = (int)__hip_atomic_fetch_add(qw, 1u, RLX_AGENT);
                for (;;) {
                    if (F.tid == 0) { qslot[0] = nxt_t; nxt_t = (int)__hip_atomic_fetch_add(qw, 1u, RLX_AGENT); }
                    __syncthreads();
                    const int uq = qslot[0];
                    __syncthreads();
                    if (uq >= 2560) break;
                    if (uq < 1024) {
                        const int u = uq;
                        PolB pb; pb.Q = (const bf16*)(ws + WS_QB); pb.K = (const bf16*)(ws + WS_KWIN); pb.V = (const bf16*)(ws + WS_VWIN); pb.O = (bf16*)(ws + WS_OWIN);
                        pb.b = u >> 7; pb.g = (u >> 6) & 1; pb.qc = 63 - (u & 63); pb.maxd = 511u; pb.j0 = pb.qc > 8 ? pb.qc - 8 : 0; pb.j1 = pb.qc + 1;
                        attn_unit<64, PolB, false>(pb, F.lds, F.tid, F.lane, F.wave, 0ull);
                    } else {
                        const int uu = uq - 1024;
                        const int bh = uu / 48, w48 = uu % 48, p = w48 >> 4, s16 = w48 & 15;
                        PolA pa; pa.Q = (const bf16*)(ws + WS_QA); pa.K = (const bf16*)(ws + WS_KA); pa.V = (const bf16*)(ws + WS_VA);
                        pa.O = (bf16*)(ws + WS_OA3) + (size_t)p * T * 256; pa.LSEP = (float*)(ws + WS_LSEA) + (size_t)p * T * 4;
                        pa.b = bh >> 2; pa.h = bh & 3; pa.d = p == 0 ? 1 : (p == 1 ? 4 : 16);
                        const int cpr = p == 0 ? 16 : (p == 1 ? 4 : 1);
                        pa.r = s16 / cpr; pa.c = s16 % cpr; pa.maxd = 128u; pa.j0 = pa.c == 0 ? 2 : 0; pa.j1 = 6;
                        attn_unit<64, PolA, false>(pa, F.lds, F.tid, F.lane, F.wave, 0ull);
                    }
                }
            }
        }
        SEAM(P + 2);
        if (PHON(5) && IN(P + 4)) _Pragma("unroll 1") for (int rep_ = 0; rep_ < NREP(5); ++rep_) { PHASE_BEGIN();
            int cti = 0;
            int cq0 = 0;
            if (CONV_IN_LAYER) { const unsigned t_ = __hip_atomic_load((unsigned*)(ws + WS_CTL) + CW_CONVQ + l * 64, __ATOMIC_RELAXED, __HIP_MEMORY_SCOPE_AGENT); cq0 = __builtin_amdgcn_readfirstlane((int)(t_ < 3072u ? t_ : 3072u)); }
            if (PHON(19)) for (int u = F.vcu; u < 1024; u += F.G) {
                const int bg = (u % 256) >> 4, k = u & 15, rnd = u >> 8;
                const int qc = rnd == 0 ? 2 * k : (rnd == 1 ? 2 * k + 1 : (rnd == 2 ? 63 - 2 * k : 62 - 2 * k));
                const u64 sel = cmp_unit(F, bg >> 1, bg & 1, qc);
                PolB pb; pb.Q = (const bf16*)(ws + WS_QB); pb.K = (const bf16*)(ws + WS_KSLC); pb.V = (const bf16*)(ws + WS_VSLC); pb.O = (bf16*)(ws + WS_OSLC);
                pb.b = bg >> 1; pb.g = bg & 1; pb.qc = qc; pb.maxd = 0x7fffffffu; pb.j0 = 0; pb.j1 = qc + 1;
                pb.GC = (const bf16*)(ws + WS_OCMP); pb.GW = (const bf16*)(ws + WS_OWIN); pb.GM = (const bf16*)(ws + WS_MISC);
                attn_unit<64, PolB, true>(pb, F.lds, F.tid, F.lane, F.wave, sel);
                if (CONV_IN_LAYER && rep_ == 0) { PHASE_BEGIN(); conv_layer_tiles(F, l, cq0, cti, 2); cti += 2; }
            }
            PHASE_BEGIN();
            if (PHON(20)) for (int v = F.vcu; v < 512; v += F.G) {
                const int bh = (v & 255) >> 3, k = v & 7, c = (v < 256) ? k : 15 - k;
                PolM pm; pm.Q = (const bf16*)(ws + WS_QM); pm.KN = (const bf16*)(ws + WS_KN); pm.KR = (const bf16*)(ws + WS_KR); pm.V = (const bf16*)(ws + WS_VM); pm.O = (bf16*)(ws + WS_OC);
                pm.b = bh >> 2; pm.h = bh & 3; pm.c = c; pm.maxd = 0x7fffffffu; pm.j0 = 0; pm.j1 = 4 * c + 4;
                attn_unit<96, PolM, false>(pm, F.lds, F.tid, F.lane, F.wave, 0ull);
                if (CONV_IN_LAYER && rep_ == 0) { PHASE_BEGIN(); conv_layer_tiles(F, l, cq0, cti, 2); cti += 2; }
            }
            if (CONV_IN_LAYER && rep_ == 0) { PHASE_BEGIN(); conv_layer_tiles(F, l, cq0, cti, 1 << 20); }
        }
        SEAM(P + 4);
        if (PHON(7) && IN(P + 6)) _Pragma("unroll 1") for (int rep_ = 0; rep_ < NREP(7); ++rep_) { PHASE_BEGIN(); phase_mix(F, l); }
        SEAM(P + 6);
        if (PHON(8) && IN(P + 7)) _Pragma("unroll 1") for (int rep_ = 0; rep_ < (DUM(8) ? 2 : 1); ++rep_) { PHASE_BEGIN(); F.dofs = (DUM(8) && rep_ == 0) ? WS_END : 0;
            SchedGrid Sg{(const char*)(ws + WS_AMIX), (const char*)(ws + WS_WOUT) + (size_t)l * 1024 * 1024 * 2, 1024, 1024, 4, (T / 256) * 4, F.G, F.vcu};
            EpiWout E{(bf16*)(ws + WS_X), (const float*)(ws + WS_MODS) + ((size_t)(l * 8) * 6 + 2) * 1024, F.dofs};
            pg8::gemm_phase<EpiWout, SchedGrid, false>(F.lds, 1024, 1024, Sg, E);
        }
        SEAM(P + 7);
        if (PHON(9) && IN(P + 8)) _Pragma("unroll 1") for (int rep_ = 0; rep_ < (DUM(9) ? 2 : 1); ++rep_) { PHASE_BEGIN(); F.dofs = (DUM(9) && rep_ == 0) ? WS_END : 0; F.dcnt = (DUM(9) && rep_ == 0) ? 4 : 0; phase_router(F, l); }
        SEAM(P + 8);
        if (PHON(10) && IN(P + 9)) _Pragma("unroll 1") for (int rep_ = 0; rep_ < NREP(10); ++rep_) { PHASE_BEGIN();
            moe_tables(F, l);
            const LAS int* tb = (const LAS int*)(F.lds + AUX_OFF);
            SchedMoe1F8 Sm{tb, tb + 64, (const char*)(ws + WS_H), (const char*)(ws + WS_W1E) + (size_t)l * 32 * 2048 * 1024, (const int*)(ws + WS_IDX), tb[32] * 8, F.G, F.vcu};
            EpiMoe1 E{(bf16*)(ws + WS_ACT), ginp(F, I_BE1) + (size_t)l * 32 * 2048};
            pg8::gemm_phase<EpiMoe1, SchedMoe1F8, true, true>(F.lds, 512, 512, Sm, E);
            if (CONV_IN_LAYER && CONV_TAIL1 > 0 && rep_ == 0 && l + 1 < DEPTH) {
                const int nun = tb[32] * 8, rounds = (nun + F.G - 1) / F.G, mine = F.vcu < nun ? (nun - 1 - F.vcu) / F.G + 1 : 0;
                if (mine < rounds) { PHASE_BEGIN(); conv_claim_tiles(F, l + 1, CONV_TAIL1); }
            }
        }
        SEAM(P + 9);
        if (PHON(11) && IN(P + 10)) _Pragma("unroll 1") for (int rep_ = 0; rep_ < NREP(11); ++rep_) { PHASE_BEGIN();
            moe_tables(F, l);
            const LAS int* tb = (const LAS int*)(F.lds + AUX_OFF);
            SchedMoe2F8 Sm{tb, (const char*)(ws + WS_ACT), (const char*)(ws + WS_W2E) + (size_t)l * 32 * 1024 * 1024, tb[32] * 4, F.G, F.vcu};
            EpiMoe2 E{(unsigned char*)(ws + WS_Y2), ginp(F, I_BE2) + (size_t)l * 32 * 1024};
            pg8::gemm_phase<EpiMoe2, SchedMoe2F8, false, true>(F.lds, 512, 512, Sm, E);
            if (CONV_IN_LAYER && CONV_TAIL2 > 0 && rep_ == 0 && l + 1 < DEPTH) {
                const int nun = tb[32] * 4, rounds = (nun + F.G - 1) / F.G, mine = F.vcu < nun ? (nun - 1 - F.vcu) / F.G + 1 : 0;
                if (mine < rounds) { PHASE_BEGIN(); conv_claim_tiles(F, l + 1, CONV_TAIL2); }
            }
        }
        SEAM(P + 10);
    }
    if (PHON(12) && IN(N_PHASES - 1)) { PHASE_BEGIN(); phase_norm1<1>(F, DEPTH); }
#undef IN
#undef SEAM
}

extern "C" void kernel_launch(void* const* d_in, const int* in_sizes, int n_in, void* d_out, int out_size, void* d_ws, size_t ws_size, hipStream_t stream) {
    static int grid = 0;
    if (grid == 0) {
        if (n_in != 33 || out_size != T * D || ws_size < WS_END * (DUM_MASK ? 2 : 1)) { fprintf(stderr, "kernel_launch: unexpected problem (n_in %d out %d ws %zu)\n", n_in, out_size, ws_size); grid = -1; return; }
        int dev = 0, cus = 0, per_cu = 0;
        if (hipGetDevice(&dev) != hipSuccess || hipDeviceGetAttribute(&cus, hipDeviceAttributeMultiprocessorCount, dev) != hipSuccess) { grid = -1; return; }
        if (hipFuncSetAttribute((const void*)fwd_kernel, hipFuncAttributeMaxDynamicSharedMemorySize, LDS_BYTES) != hipSuccess) { fprintf(stderr, "kernel_launch: hipFuncSetAttribute failed\n"); grid = -1; return; }
        if (hipOccupancyMaxActiveBlocksPerMultiprocessor(&per_cu, (const void*)fwd_kernel, 512, LDS_BYTES) != hipSuccess || per_cu < 1) { fprintf(stderr, "kernel_launch: occupancy query says %d\n", per_cu); per_cu = 1; }
        (void)hipGetLastError();
        grid = cus;
    }
    if (grid < 0) return;
    if (hipMemsetAsync((char*)d_ws + WS_CTL, 0, CTL_ZERO_BYTES, stream) != hipSuccess) return;
    Args a{};
    for (int i = 0; i < 33; ++i) a.in[i] = (const float*)d_in[i];
    a.out = (float*)d_out; a.ws = (unsigned char*)d_ws;
#if MK_PER_PHASE
    for (int p = 0; p < N_PHASES; ++p) { a.ph_lo = p; a.ph_hi = p + 1; hipLaunchKernelGGL(fwd_kernel, dim3(grid), dim3(512), LDS_BYTES, stream, a); }
#else
    a.ph_lo = 0; a.ph_hi = N_PHASES;
    hipLaunchKernelGGL(fwd_kernel, dim3(grid), dim3(512), LDS_BYTES, stream, a);
#endif
}
```

```cpp
#include <hip/hip_runtime.h>
#include <cstdio>
#include <cstdint>

#ifndef MK_PER_PHASE
#define MK_PER_PHASE 0
#endif

#ifndef PH_MASK
#define PH_MASK 0xFFFFFFFFu
#endif
#define PHON(k) ((PH_MASK >> (k)) & 1u)
#ifndef DBL_MASK
#define DBL_MASK 0u
#endif
#define NREP(k) (((DBL_MASK >> (k)) & 1u) ? 2 : 1)
#ifndef DUM_MASK
#define DUM_MASK 0u
#endif
#define DUM(k) ((DUM_MASK >> (k)) & 1u)
#ifndef ATT_VAR
#define ATT_VAR 0
#endif
#ifndef CONV_IN_LAYER
#define CONV_IN_LAYER 1
#endif
#ifndef CONV_TAIL1
#define CONV_TAIL1 3
#endif
#ifndef CONV_TAIL2
#define CONV_TAIL2 4
#endif
#ifndef ATT_STAGGER
#define ATT_STAGGER 0
#endif
#define DI __device__ __forceinline__
#define LAS __attribute__((address_space(3)))
#define GAS __attribute__((address_space(1)))
typedef unsigned short bf16;
typedef short bf16x8 __attribute__((ext_vector_type(8)));
typedef short s16x4 __attribute__((ext_vector_type(4)));
typedef float f32x2 __attribute__((ext_vector_type(2)));
typedef float f32x4 __attribute__((ext_vector_type(4)));
typedef float f32x16 __attribute__((ext_vector_type(16)));
typedef unsigned u32x2 __attribute__((ext_vector_type(2)));
typedef unsigned u32x4 __attribute__((ext_vector_type(4)));
typedef __bf16 bf16x2_t __attribute__((ext_vector_type(2)));
typedef unsigned long long u64;

constexpr int NB = 8, S = 4096, T = NB * S, D = 1024, DEPTH = 4;
constexpr int NIN = 2560;
constexpr int NE = 32, DFF = 1024;
constexpr int SP = S + 64;
constexpr int ECAP = 32768;
constexpr int ACT_ROWS = 4 * T + NE * 256;
constexpr float LOG2E = 1.4426950408889634f;
constexpr float SCL64 = 0.125f * LOG2E;
constexpr float SCL96 = 0.10206207261596577f * LOG2E;
constexpr float EPS = 1e-6f;

constexpr size_t MiB = 1u << 20;
constexpr size_t WS_CTL = 0, CTL_ZERO_BYTES = 2 * MiB;
constexpr size_t WS_MODS = 2 * MiB, WS_B1P = 3 * MiB, WS_CS64 = 4 * MiB, WS_CS32 = 12 * MiB;
constexpr size_t WS_WIN = 16 * MiB, WS_WOUT = 36 * MiB, WS_NSAW1 = 44 * MiB, WS_MLAQ = 52 * MiB, WS_MLAKV = 53 * MiB;
constexpr size_t WS_W1E = 64 * MiB, WS_W2E = 576 * MiB;
constexpr size_t WS_X = 832 * MiB, WS_H = 960 * MiB;
constexpr size_t WS_QA = 1024 * MiB, WS_KA = 1040 * MiB, WS_VA = 1056 * MiB, WS_QB = 1072 * MiB;
constexpr size_t WS_KCMP = 1104 * MiB, WS_VCMP = 1113 * MiB;
constexpr size_t WS_KSLC = 1122 * MiB, WS_VSLC = 1130 * MiB, WS_KWIN = 1138 * MiB, WS_VWIN = 1146 * MiB;
constexpr size_t WS_CQ = 1154 * MiB, WS_MISC = 1170 * MiB;
constexpr size_t WS_RSTDQ = 1186 * MiB, WS_RSTDKV = 1186 * MiB + 512 * 1024, WS_KR = 1187 * MiB, WS_GATES = 1189 * MiB;
constexpr size_t WS_W2T = 1195 * MiB;
constexpr size_t WS_HID = 1192 * MiB, WS_KC = 1196 * MiB, WS_VC = 1196 * MiB + 512 * 1024;
constexpr size_t WS_QM = 1197 * MiB, WS_KN = 1221 * MiB, WS_VM = 1237 * MiB;
constexpr size_t WS_OA3 = 1253 * MiB, WS_LSEA = 1301 * MiB;
constexpr size_t WS_OCMP = 1303 * MiB, WS_OSLC = 1335 * MiB, WS_OWIN = 1367 * MiB, WS_OC = 1399 * MiB;
constexpr size_t WS_SEL = 1415 * MiB, WS_AMIX = 1416 * MiB;
constexpr size_t WS_IDX = 1480 * MiB, WS_GATEW = 1484 * MiB, WS_TOKSLOT = 1488 * MiB, WS_TOKG = WS_TOKSLOT + 512 * 1024;
constexpr size_t WS_ACT = 1489 * MiB, WS_Y2 = 1761 * MiB, WS_END = 2033 * MiB;
static_assert((size_t)ACT_ROWS * 1024 * 2 <= 272 * MiB, "act rows");
static_assert((size_t)16 * SP * 64 * 2 + 65536 <= 9 * MiB, "kcmp");

constexpr int CW_TMO = 0, CW_FAIL = 2;
constexpr int CW_BAR = 4096;
constexpr int CW_QUEUE = 12288;
constexpr int CW_CONVQ = 13312;
constexpr int CW_CNT = 16384;

constexpr int RING_BYTES = 131072;
constexpr int AUX_OFF = RING_BYTES;
constexpr int MISC_OFF = AUX_OFF + 8192;
constexpr int LDS_BYTES = 147456;

DI unsigned pk2(float lo, float hi) { f32x2 v = {lo, hi}; bf16x2_t b = __builtin_convertvector(v, bf16x2_t); return __builtin_bit_cast(unsigned, b); }
DI float bf2f(unsigned short h) { return __uint_as_float(((unsigned)h) << 16); }
DI float bflo(unsigned w) { return __uint_as_float(w << 16); }
DI float bfhi(unsigned w) { return __uint_as_float(w & 0xffff0000u); }
typedef float f32x2c __attribute__((ext_vector_type(2)));
constexpr float Y2_SCALE = 4.0f, Y2_ISCALE = 1.0f / 4.0f;
DI unsigned pk4_fp8(float a, float b, float c, float d) {
    a = fminf(fmaxf(a * Y2_SCALE, -440.f), 440.f); b = fminf(fmaxf(b * Y2_SCALE, -440.f), 440.f); c = fminf(fmaxf(c * Y2_SCALE, -440.f), 440.f); d = fminf(fmaxf(d * Y2_SCALE, -440.f), 440.f);
    int w = __builtin_amdgcn_cvt_pk_fp8_f32(a, b, 0, false); w = __builtin_amdgcn_cvt_pk_fp8_f32(c, d, w, true); return (unsigned)w; }
DI f32x4 unpk4_fp8(unsigned w) { const f32x2c lo = __builtin_amdgcn_cvt_pk_f32_fp8((int)w, false), hi = __builtin_amdgcn_cvt_pk_f32_fp8((int)w, true); return (f32x4){lo.x, lo.y, hi.x, hi.y}; }
constexpr float W8_SCALE = 64.0f, A8_SCALE = 4.0f;
constexpr int W8_E8M0 = 127 - 6, A8_E8M0 = 127 - 2;
constexpr float H8_SCALE = 8.0f; constexpr int H8_E8M0 = 127 - 3;
DI int lane_id() { return (int)__builtin_amdgcn_mbcnt_hi(~0u, __builtin_amdgcn_mbcnt_lo(~0u, 0u)); }
DI unsigned pk4_fp8s(float a, float b, float c, float d, float sc) {
    a = fminf(fmaxf(a * sc, -440.f), 440.f); b = fminf(fmaxf(b * sc, -440.f), 440.f); c = fminf(fmaxf(c * sc, -440.f), 440.f); d = fminf(fmaxf(d * sc, -440.f), 440.f);
    int w = __builtin_amdgcn_cvt_pk_fp8_f32(a, b, 0, false); w = __builtin_amdgcn_cvt_pk_fp8_f32(c, d, w, true); return (unsigned)w; }
DI float q8s(float x, float sc) {
    const float a = fminf(fmaxf(x * sc, -440.f), 440.f); const int w = __builtin_amdgcn_cvt_pk_fp8_f32(a, a, 0, false);
    const f32x2c r = __builtin_amdgcn_cvt_pk_f32_fp8(w, false); return r.x; }
template <int CTRL> DI float dpp_perm(float v) { return __builtin_bit_cast(float, __builtin_amdgcn_update_dpp(0, __builtin_bit_cast(int, v), CTRL, 0xf, 0xf, false)); }
DI float row_sum16(float v) { v += dpp_perm<0xB1>(v); v += dpp_perm<0x4E>(v); v += dpp_perm<0x141>(v); v += dpp_perm<0x140>(v); return v; }
DI float wave_sum(float v) {
    v = row_sum16(v);
    const float r0 = __builtin_bit_cast(float, __builtin_amdgcn_readlane(__builtin_bit_cast(int, v), 0)), r1 = __builtin_bit_cast(float, __builtin_amdgcn_readlane(__builtin_bit_cast(int, v), 16));
    const float r2 = __builtin_bit_cast(float, __builtin_amdgcn_readlane(__builtin_bit_cast(int, v), 32)), r3 = __builtin_bit_cast(float, __builtin_amdgcn_readlane(__builtin_bit_cast(int, v), 48));
    return (r0 + r1) + (r2 + r3);
}
DI float fast_exp2(float x) { return __builtin_amdgcn_exp2f(x); }
DI float fast_rcp(float x) { return __builtin_amdgcn_rcpf(x); }
DI float sigmoidf_(float x) { return fast_rcp(1.0f + fast_exp2(-x * LOG2E)); }
#define RLX_AGENT __ATOMIC_RELAXED, __HIP_MEMORY_SCOPE_AGENT

#define XB_TMO      128
#define XB_XCNT(j)  (256  + 64 * (j))
#define XB_XSUB(j)  (1280 + 64 * (j))
#define XB_XGEN(j)  (2304 + 64 * (j))
#define XB_TOP      3328
#define XB_TOPGEN   3392
#define XCD_BAR_WORDS 3456
#define XB_SPIN_CAP (1u << 22)
DI unsigned xb_ld(unsigned* p)              { return __hip_atomic_load(p, __ATOMIC_RELAXED, __HIP_MEMORY_SCOPE_AGENT); }
DI unsigned xb_add(unsigned* p, unsigned v) { return __hip_atomic_fetch_add(p, v, __ATOMIC_RELAXED, __HIP_MEMORY_SCOPE_AGENT); }
DI unsigned xb_xcc_id() { return (unsigned)__builtin_amdgcn_s_getreg((3 << 11) | 20) & 0xFu; }
#define XB_SPIN(cond, bar) do { unsigned _sp = 0; while (cond) { __builtin_amdgcn_s_sleep(1); \
    if ((++_sp & 255u) == 0u) { if (xb_ld(&(bar)[XB_TMO])) break; if (_sp > XB_SPIN_CAP) { atomicAdd(&(bar)[XB_TMO], 1u); break; } } } } while (0)
struct XcdBarrier { unsigned* bar; unsigned x; volatile LAS unsigned* st; };
DI XcdBarrier xcd_barrier_post(unsigned* bar, volatile LAS unsigned* st) {
    XcdBarrier b; b.bar = bar; b.x = xb_xcc_id(); b.st = st;
    if (threadIdx.x == 0) (void)xb_add(&bar[XB_XCNT(b.x)], 1u);
    return b;
}
DI void xcd_barrier_complete(unsigned* bar, unsigned x, unsigned& nloc, unsigned& nx) {
    const unsigned G = gridDim.x * gridDim.y * gridDim.z;
    unsigned sum, cnt, mine, sp = 0u;
    for (;;) {
        sum = 0u; cnt = 0u; mine = 0u;
#pragma unroll
        for (unsigned j = 0; j < 16; ++j) { const unsigned c = xb_ld(&bar[XB_XCNT(j)]); sum += c; cnt += (c > 0u) ? 1u : 0u; mine = (j == x) ? c : mine; }
        if (sum == G) break;
        __builtin_amdgcn_s_sleep(1);
        if ((++sp & 255u) == 0u) { if (xb_ld(&bar[XB_TMO])) break; if (sp > XB_SPIN_CAP) { atomicAdd(&bar[XB_TMO], 1u); break; } }
    }
    nloc = mine > 0u ? mine : 1u; nx = cnt > 0u ? cnt : 1u;
}
DI void xcd_barrier(const XcdBarrier& b) {
    asm volatile("s_waitcnt vmcnt(0)" ::: "memory");
    __syncthreads();
    unsigned* bar = b.bar; asm volatile("" : "+s"(bar));
    if (threadIdx.x == 0) {
        __builtin_amdgcn_s_waitcnt(0);
        unsigned nloc = b.st[0], nx = b.st[1];
        if (nloc == 0u) { xcd_barrier_complete(bar, b.x, nloc, nx); b.st[0] = nloc; b.st[1] = nx; }
        const unsigned old = xb_add(&bar[XB_XSUB(b.x)], 1u);
        const unsigned gen = old / nloc;
        if (old + 1u == (gen + 1u) * nloc) {
            __builtin_amdgcn_fence(__ATOMIC_RELEASE, "agent");
            asm volatile("s_waitcnt vmcnt(0)" ::: "memory");
            const unsigned og = xb_add(&bar[XB_TOP], 1u);
            const unsigned tg = og / nx;
            if (og + 1u == (tg + 1u) * nx) xb_add(&bar[XB_TOPGEN], 1u);
            else XB_SPIN(xb_ld(&bar[XB_TOPGEN]) == tg, bar);
            __builtin_amdgcn_fence(__ATOMIC_ACQUIRE, "agent");
            xb_add(&bar[XB_XGEN(b.x)], 1u);
            asm volatile("s_waitcnt vmcnt(0)" ::: "memory");
        } else {
            XB_SPIN(xb_ld(&bar[XB_XGEN(b.x)]) == gen, bar);
            __builtin_amdgcn_fence(__ATOMIC_ACQUIRE, "agent");
            asm volatile("s_waitcnt vmcnt(0)" ::: "memory");
        }
    }
    __syncthreads();
}

struct Args {
    const float* in[33];
    float* out;
    unsigned char* ws;
    int ph_lo, ph_hi;
};
enum { I_X = 0, I_C, I_POS, I_WADA, I_BADA, I_G1, I_G2, I_WIN, I_POSK, I_POSV, I_W1K, I_B1K, I_W2K, I_B2K, I_W1V, I_B1V, I_W2V, I_B2V,
       I_GQ, I_GKV, I_WQUP, I_WKVUP, I_GOA, I_GOB, I_GOC, I_WOUT, I_WR, I_BR, I_WE1, I_BE1, I_WE2, I_BE2, I_GF };

struct Ctx {
    LAS unsigned char* lds;
    const Args* a;
    unsigned char* ws;
    int tid, lane, wave, blk, G, vcu;
    size_t dofs; int dcnt;
};
DI const float* ginp(const Ctx& F, int i) { return (const float*)(GAS const float*)(F.a->in[i]); }
DI float* gout(const Ctx& F) { return (float*)(GAS float*)(F.a->out); }

namespace pg8 {
constexpr int BM = 256, BK = 64, HALF = 128, HTB = HALF * BK * 2;
DI int lds_byte(int r, int c) { const int st = (r >> 4) * 2 + (c >> 5), rr = r & 15, cc = c & 31, ob = rr * 64 + cc * 2; return st * 1024 + (ob ^ (((ob >> 9) & 1) << 5)); }
DI void stage_rc(int b, int& R, int& C) { const int st = b / 1024, sb = b % 1024, swz = sb ^ (((sb >> 9) & 1) << 5); R = (st >> 1) * 16 + swz / 64; C = (st & 1) * 32 + (swz % 64) / 2; }
DI int perm32(int rho) { const int n = rho >> 4, i = rho & 15; return 8 * (i >> 2) + 4 * n + (i & 3); }
struct Unit { const char* a; const char* b; int pm, pn, e, ml; };
template <class E_, class = void> struct acc_bias_t { static constexpr bool value = false; };
template <class E_> struct acc_bias_t<E_, decltype((void)E_::ACC_BIAS)> { static constexpr bool value = E_::ACC_BIAS; };
template <class E_> constexpr bool acc_bias_v = acc_bias_t<E_>::value;

template <class Epi, class Sched, bool GATHER, bool FP8 = false>
DI void gemm_phase(LAS unsigned char* lds, const int lda, const int K, const Sched& S, const Epi& E) {
    typedef int i32x4_ __attribute__((ext_vector_type(4))); typedef int i32x8_ __attribute__((ext_vector_type(8)));
    int tid_ = threadIdx.x; asm volatile("" : "+v"(tid_));
    const int tid = tid_, wid = __builtin_amdgcn_readfirstlane(tid >> 6), lane = tid & 63, wr = wid >> 2, wc = wid & 3, fr = lane & 15, fq = lane >> 4;
    const int nt = K / BK;
    int Rr[2], Cc[2]; unsigned voffB[2];
#pragma unroll
    for (int i = 0; i < 2; ++i) { int R, C; stage_rc(tid * 16 + i * 8192, R, C); Rr[i] = R; Cc[i] = C; const int Rb = Epi::PERM ? ((R & ~31) + perm32(R & 31)) : R; voffB[i] = (unsigned)(Rb * K + C) * 2u; }
    const size_t kstep = (size_t)(BK * 2);
    const size_t hstepB = (size_t)HALF * K * 2;
    const unsigned ldsw = (unsigned)wid * 1024u;
    const int aoff = lds_byte(wr * 64 + fr, fq * 8), boff = lds_byte(wc * 32 + fr, fq * 8);
#define PG8_SA(b, h) (((b) * 2 + (h)) * HTB)
#define PG8_SB(b, h) ((4 + (b) * 2 + (h)) * HTB)
#define PG8_STAGE_B(bufoff, gbase) do { _Pragma("unroll") for (int _i = 0; _i < 2; ++_i) \
        __builtin_amdgcn_global_load_lds((const unsigned*)((const char*)(gbase) + (size_t)_i * 64 * K * 2 + voffB[0]), (LAS unsigned*)(lds + (bufoff) + ldsw + _i * 8192), 16, 0, 0); } while (0)
#define PG8_STAGE_A(bufoff, gbase, v, h) do { _Pragma("unroll") for (int _i = 0; _i < 2; ++_i) { \
        if constexpr (GATHER) __builtin_amdgcn_global_load_lds((const unsigned*)((const char*)(gbase) + (v)[h][_i]), (LAS unsigned*)(lds + (bufoff) + ldsw + _i * 8192), 16, 0, 0); \
        else __builtin_amdgcn_global_load_lds((const unsigned*)((const char*)(gbase) + (size_t)((h) * 128 + _i * 64) * lda * 2 + (v)[0][0]), (LAS unsigned*)(lds + (bufoff) + ldsw + _i * 8192), 16, 0, 0); } } while (0)
#define PG8_SETOFF(v, u) do { _Pragma("unroll") for (int _h = 0; _h < 2; ++_h) _Pragma("unroll") for (int _i = 0; _i < 2; ++_i) { \
        if constexpr (GATHER) (v)[_h][_i] = S.gather_off((u), _h * 128 + Rr[_i]) + (unsigned)Cc[_i] * 2u; \
        else (v)[_h][_i] = (unsigned)((_h * 128 + Rr[_i]) * lda + Cc[_i]) * 2u; } } while (0)
#define PG8_LDA(dst, b, h) do { _Pragma("unroll") for (int m = 0; m < 4; ++m) { const i32x4_ lo_ = *(const LAS i32x4_*)(lds + PG8_SA(b, h) + aoff + m * 2048), hi_ = *(const LAS i32x4_*)(lds + PG8_SA(b, h) + aoff + m * 2048 + 1024); dst[m] = __builtin_shufflevector(lo_, hi_, 0, 1, 2, 3, 4, 5, 6, 7); } } while (0)
#define PG8_LDB(dst, b, h) do { _Pragma("unroll") for (int n = 0; n < 2; ++n) { const i32x4_ lo_ = *(const LAS i32x4_*)(lds + PG8_SB(b, h) + boff + n * 2048), hi_ = *(const LAS i32x4_*)(lds + PG8_SB(b, h) + boff + n * 2048 + 1024); dst[n] = __builtin_shufflevector(lo_, hi_, 0, 1, 2, 3, 4, 5, 6, 7); } } while (0)
#define PG8_H0(x) __builtin_bit_cast(bf16x8, __builtin_shufflevector((x), (x), 0, 1, 2, 3))
#define PG8_H1(x) __builtin_bit_cast(bf16x8, __builtin_shufflevector((x), (x), 4, 5, 6, 7))
#define PG8_MMA(ai, bj, At, Bt) do { __builtin_amdgcn_s_setprio(1); \
        if constexpr (FP8) { _Pragma("unroll") for (int m = 0; m < 4; ++m) _Pragma("unroll") for (int n = 0; n < 2; ++n) \
            asm volatile("v_mfma_scale_f32_16x16x128_f8f6f4 %0, %1, %2, %0, %3, %4 op_sel_hi:[0,0,0]" : "+v"(acc[ai][bj][m][n]) : "v"(Bt[n]), "v"(At[m]), "v"(scw_), "v"(sca_)); } \
        else { _Pragma("unroll") for (int m = 0; m < 4; ++m) _Pragma("unroll") for (int n = 0; n < 2; ++n) { \
            acc[ai][bj][m][n] = __builtin_amdgcn_mfma_f32_16x16x32_bf16(PG8_H0(Bt[n]), PG8_H0(At[m]), acc[ai][bj][m][n], 0, 0, 0); \
            acc[ai][bj][m][n] = __builtin_amdgcn_mfma_f32_16x16x32_bf16(PG8_H1(Bt[n]), PG8_H1(At[m]), acc[ai][bj][m][n], 0, 0, 0); } } \
        __builtin_amdgcn_s_setprio(0); } while (0)
#define PG8_WAIT_V(n) asm volatile("s_waitcnt vmcnt(" #n ")" ::: "memory")
#define PG8_WAIT_L(n) asm volatile("s_waitcnt lgkmcnt(" #n ")" ::: "memory")
#define PG8_BAR __builtin_amdgcn_s_barrier()
#define PG8_SCHED __builtin_amdgcn_sched_barrier(0)
    Unit cur, nxt; int ui = 0;
    if (!S.next(0, cur)) return;
    f32x4 acc[2][2][4][2];
    f32x4 bv[2][2] = {{{0.f, 0.f, 0.f, 0.f}, {0.f, 0.f, 0.f, 0.f}}, {{0.f, 0.f, 0.f, 0.f}, {0.f, 0.f, 0.f, 0.f}}};
    if constexpr (acc_bias_v<Epi>) E.bias(cur, wc, fq, bv);
#pragma unroll
    for (int a = 0; a < 2; ++a)
#pragma unroll
        for (int b = 0; b < 2; ++b)
#pragma unroll
            for (int m = 0; m < 4; ++m)
#pragma unroll
                for (int n = 0; n < 2; ++n) acc[a][b][m][n] = bv[b][n];
    int scw_ = W8_E8M0, sca_ = A8_E8M0; if constexpr (FP8) sca_ = Epi::A_E8M0;
    i32x8_ At[4], B0[2], B1[2];
    unsigned vA[2][2], vAn[2][2];
    PG8_SETOFF(vA, cur);
    const char* cA = cur.a; const char* cB = cur.b;
    PG8_STAGE_B(PG8_SB(0, 0), cB); PG8_STAGE_B(PG8_SB(0, 1), cB + hstepB); PG8_STAGE_A(PG8_SA(0, 0), cA, vA, 0); PG8_STAGE_A(PG8_SA(0, 1), cA, vA, 1);
    if (wr == 1) PG8_BAR;
    PG8_WAIT_V(2); PG8_BAR;
    PG8_STAGE_B(PG8_SB(1, 0), cB + kstep); PG8_STAGE_A(PG8_SA(1, 0), cA + kstep, vA, 0); PG8_STAGE_B(PG8_SB(1, 1), cB + hstepB + kstep);
    PG8_WAIT_V(6); PG8_BAR;
    for (;;) {
        const bool has_next = S.next(ui + 1, nxt);
        if constexpr (GATHER) {
            if (has_next) {
#pragma unroll
                for (int h = 0; h < 2; ++h)
#pragma unroll
                    for (int i = 0; i < 2; ++i) vAn[h][i] = S.gather_raw(nxt, h * 128 + Rr[i]);
            }
        }
        const char* nA = has_next ? nxt.a : cA; const char* nB = has_next ? nxt.b : cB;
#pragma unroll 1
        for (int t = 0; t < nt; t += 2) {
            const bool last = (t == nt - 2);
            const char* a1 = cA + (size_t)(t + 1) * kstep;
            const char* a2 = last ? nA : cA + (size_t)(t + 2) * kstep; const char* b2 = last ? nB : cB + (size_t)(t + 2) * kstep;
            const char* a3 = a2 + kstep; const char* b3 = b2 + kstep;
            unsigned v2[2][2];
#pragma unroll
            for (int h = 0; h < 2; ++h)
#pragma unroll
                for (int i = 0; i < 2; ++i) v2[h][i] = vA[h][i];
            if constexpr (GATHER) {
                if (last && has_next) {
#pragma unroll
                    for (int h = 0; h < 2; ++h)
#pragma unroll
                        for (int i = 0; i < 2; ++i) { vAn[h][i] = vAn[h][i] * (unsigned)(lda * 2) + (unsigned)Cc[i] * 2u; v2[h][i] = vAn[h][i]; }
                }
            }
            PG8_LDB(B0, 0, 0); PG8_LDB(B1, 0, 1); PG8_SCHED; PG8_LDA(At, 0, 0); PG8_STAGE_A(PG8_SA(1, 1), a1, vA, 1);
            PG8_WAIT_V(8); PG8_WAIT_L(0); PG8_BAR; PG8_MMA(0, 0, At, B0); PG8_MMA(0, 1, At, B1); PG8_BAR; PG8_SCHED;
            PG8_LDA(At, 0, 1); PG8_STAGE_B(PG8_SB(0, 0), b2); PG8_STAGE_B(PG8_SB(0, 1), b2 + hstepB); PG8_STAGE_A(PG8_SA(0, 0), a2, v2, 0);
            PG8_WAIT_V(8); PG8_WAIT_L(0); PG8_BAR; PG8_MMA(1, 0, At, B0); PG8_MMA(1, 1, At, B1); PG8_BAR; PG8_SCHED;
            PG8_LDB(B0, 1, 0); PG8_LDB(B1, 1, 1); PG8_SCHED; PG8_LDA(At, 1, 0); PG8_STAGE_A(PG8_SA(0, 1), a2, v2, 1);
            PG8_WAIT_V(8); PG8_WAIT_L(0); PG8_BAR; PG8_MMA(0, 0, At, B0); PG8_MMA(0, 1, At, B1); PG8_BAR; PG8_SCHED;
            PG8_LDA(At, 1, 1); PG8_STAGE_B(PG8_SB(1, 0), b3); PG8_STAGE_B(PG8_SB(1, 1), b3 + hstepB); PG8_STAGE_A(PG8_SA(1, 0), a3, v2, 0);
            PG8_WAIT_V(8); PG8_WAIT_L(0); PG8_BAR; PG8_MMA(1, 0, At, B0); PG8_MMA(1, 1, At, B1); PG8_BAR; PG8_SCHED;
        }
        if (wr == 0) PG8_BAR;
        if constexpr (FP8) asm volatile("s_nop 15\n\ts_nop 15" ::: "memory");
        if constexpr (acc_bias_v<Epi>) E.bias(has_next ? nxt : cur, wc, fq, bv);
        if constexpr (!Epi::AFTER_DRAIN) { int fr_ = fr, fq_ = fq; asm volatile("" : "+v"(fr_), "+v"(fq_)); E(acc, cur, wr, wc, fr_, fq_); }
        if (!has_next) break;
#pragma unroll
        for (int a = 0; a < 2; ++a)
#pragma unroll
            for (int b = 0; b < 2; ++b)
#pragma unroll
                for (int m = 0; m < 4; ++m)
#pragma unroll
                    for (int n = 0; n < 2; ++n) acc[a][b][m][n] = bv[b][n];
        cur = nxt; cA = nA; cB = nB; ++ui;
        if constexpr (GATHER) {
#pragma unroll
            for (int h = 0; h < 2; ++h)
#pragma unroll
                for (int i = 0; i < 2; ++i) vA[h][i] = vAn[h][i];
        }
        if (wr == 1) PG8_BAR;
    }
    PG8_WAIT_V(0);
    PG8_BAR;
    if constexpr (Epi::AFTER_DRAIN) { int fr_ = fr, fq_ = fq; asm volatile("" : "+v"(fr_), "+v"(fq_)); E.fused(acc, cur, wr, wc, fr_, fq_, lds, wid, lane); }
#undef PG8_SA
#undef PG8_SB
#undef PG8_STAGE_A
#undef PG8_STAGE_B
#undef PG8_SETOFF
#undef PG8_LDA
#undef PG8_LDB
#undef PG8_MMA
#undef PG8_H0
#undef PG8_H1
#undef PG8_WAIT_V
#undef PG8_WAIT_L
#undef PG8_BAR
#undef PG8_SCHED
}
}
using pg8::Unit;
typedef f32x4 AccT[2][2][4][2];

struct SchedGrid {
    const char* A; const char* B; int lda, K, nN, nwg, G, c;
    DI bool next(int i, Unit& u) const {
        const int L = i * G + c; if (L >= nwg) return false;
        u.pm = L / nN; u.pn = L % nN; u.e = 0; u.ml = 0;
        u.a = A + (size_t)u.pm * 256 * lda * 2; u.b = B + (size_t)u.pn * 256 * K * 2; return true;
    }
    DI unsigned gather_off(const Unit&, int) const { return 0u; }
    DI unsigned gather_raw(const Unit&, int) const { return 0u; }
};
struct SchedCmp {
    const char* KCMP; const char* VCMP; const char* W; int G, c;
    DI bool next(int i, Unit& u) const {
        const int L = i * G + c; if (L >= 32) return false;
        const int kv = L >> 4, bg = L & 15;
        u.pm = L; u.pn = 0; u.e = kv; u.ml = 0;
        u.a = (kv ? VCMP : KCMP) + (size_t)bg * SP * 64 * 2; u.b = W + (size_t)kv * 256 * 2048 * 2; return true;
    }
    DI unsigned gather_off(const Unit&, int) const { return 0u; }
    DI unsigned gather_raw(const Unit&, int) const { return 0u; }
};
struct SchedMla {
    const char* CQ; const char* MISC; const char* WQ; const char* WKV; int G, c;
    DI bool next(int i, Unit& u) const {
        const int L = i * G + c; if (L >= 512) return false;
        const int which = L >> 8, r = L & 255;
        u.pm = r >> 1; u.pn = r & 1; u.e = which; u.ml = 0;
        u.a = (which ? MISC : CQ) + (size_t)u.pm * 256 * 256 * 2; u.b = (which ? WKV : WQ) + (size_t)u.pn * 256 * 256 * 2; return true;
    }
    DI unsigned gather_off(const Unit&, int) const { return 0u; }
    DI unsigned gather_raw(const Unit&, int) const { return 0u; }
};
template <int NT, bool GATHERED>
struct SchedMoe {
    const LAS int* tb; const LAS int* cnt; const char* A; const char* W; const int* IDX; int total, G, c;
    DI bool next(int i, Unit& u) const {
        const int L = i * G + c; if (L >= total) return false;
        const int mtg = L / NT; u.pn = L % NT;
        const int ln_ = threadIdx.x & 63;
        const int e = __popcll(__ballot(ln_ < 32 && tb[ln_ & 31] <= mtg)) - 1;
        u.e = e; u.ml = mtg - tb[e]; u.pm = mtg;
        u.a = GATHERED ? A : A + (size_t)mtg * 256 * 1024 * 2;
        u.b = W + ((size_t)e * NT * 256 + (size_t)u.pn * 256) * 1024 * 2; return true;
    }
    DI unsigned gather_off(const Unit& u, int row) const {
        const int pos = u.ml * 256 + row; const int tok = (pos < cnt[u.e]) ? IDX[u.e * ECAP + pos] : 0;
        return (unsigned)tok * 2048u;
    }
    DI unsigned gather_raw(const Unit& u, int row) const {
        const int pos = u.ml * 256 + row;
        return (unsigned)IDX[u.e * ECAP + (pos < cnt[u.e] ? pos : 0)];
    }
};

struct SchedMoe1F8 {
    static constexpr bool HOOK = false;
    const LAS int* tb; const LAS int* cnt; const char* A; const char* W; const int* IDX; int total, G, c;
    DI bool next(int i, Unit& u) const {
        const int L = i * G + c; if (L >= total) return false;
        const int mtg = L >> 3; u.pn = L & 7;
        const int ln_ = lane_id();
        const int e = __popcll(__ballot(ln_ < 32 && tb[ln_ & 31] <= mtg)) - 1;
        u.e = e; u.ml = mtg - tb[e]; u.pm = mtg;
        u.a = A; u.b = W + ((size_t)e * 2048 + (size_t)u.pn * 256) * 1024; return true;
    }
    DI unsigned gather_raw(const Unit& u, int row) const { const int pos = u.ml * 256 + row; return (unsigned)IDX[u.e * ECAP + (pos < cnt[u.e] ? pos : 0)]; }
    DI unsigned gather_off(const Unit& u, int row) const { return gather_raw(u, row) * 1024u; }
};
struct SchedMoe2F8 {
    static constexpr bool HOOK = false;
    const LAS int* tb; const char* A; const char* W; int total, G, c;
    DI bool next(int i, Unit& u) const {
        const int L = i * G + c; if (L >= total) return false;
        const int mtg = L >> 2; u.pn = L & 3;
        const int ln_ = lane_id();
        const int e = __popcll(__ballot(ln_ < 32 && tb[ln_ & 31] <= mtg)) - 1;
        u.e = e; u.ml = mtg - tb[e]; u.pm = mtg;
        u.a = A + (size_t)mtg * 256 * 1024; u.b = W + ((size_t)e * 1024 + (size_t)u.pn * 256) * 1024; return true;
    }
    DI unsigned gather_off(const Unit&, int) const { return 0u; }
    DI unsigned gather_raw(const Unit&, int) const { return 0u; }
};

DI void rot4(f32x4& v0, f32x4& v1, const f32x4 c, const f32x4 s) {
    const float a0 = v0[0], b0 = v0[1], a1 = v0[2], b1 = v0[3], a2 = v1[0], b2 = v1[1], a3 = v1[2], b3 = v1[3];
    v0[0] = a0 * c[0] - b0 * s[0]; v0[1] = b0 * c[0] + a0 * s[0];
    v0[2] = a1 * c[1] - b1 * s[1]; v0[3] = b1 * c[1] + a1 * s[1];
    v1[0] = a2 * c[2] - b2 * s[2]; v1[1] = b2 * c[2] + a2 * s[2];
    v1[2] = a3 * c[3] - b3 * s[3]; v1[3] = b3 * c[3] + a3 * s[3];
}
DI u32x4 pack8(const f32x4 v0, const f32x4 v1) { u32x4 w; w.x = pk2(v0[0], v0[1]); w.y = pk2(v0[2], v0[3]); w.z = pk2(v1[0], v1[1]); w.w = pk2(v1[2], v1[3]); return w; }

struct EpiWin {
    static constexpr bool PERM = true, AFTER_DRAIN = false;
    unsigned char* ws; const float* CS64; const float* CS32;
    DI void operator()(const AccT& acc, const Unit& u, int wr, int wc, int fr, int fq) const {
#pragma unroll
        for (int bj = 0; bj < 2; ++bj) {
            const int w0 = bj * 128 + wc * 32;
            size_t off; int ld, dcol, mode = 0, gm = 0, g = 0; float sc = 1.f;
            switch (u.pn) {
                case 0: off = WS_QA; ld = 256; dcol = w0; mode = 1; sc = SCL64; break;
                case 1: off = WS_KA; ld = 256; dcol = w0; mode = 1; break;
                case 2: off = WS_VA; ld = 256; dcol = w0; break;
                case 3: off = WS_QB; ld = 512; dcol = w0; mode = 1; sc = SCL64; break;
                case 4: off = WS_QB; ld = 512; dcol = 256 + w0; mode = 1; sc = SCL64; break;
                case 5: off = (w0 < 128) ? WS_KCMP : WS_VCMP; ld = 64; gm = 1; g = (w0 & 127) >> 6; dcol = w0 & 63; break;
                case 6: off = (w0 < 128) ? WS_KSLC : WS_VSLC; ld = 128; dcol = w0 & 127; mode = (w0 < 128) ? 1 : 0; break;
                case 7: off = (w0 < 128) ? WS_KWIN : WS_VWIN; ld = 128; dcol = w0 & 127; mode = (w0 < 128) ? 1 : 0; break;
                case 8: off = WS_CQ; ld = 256; dcol = w0; break;
                default: if (w0 == 128) { off = WS_KR; ld = 32; dcol = 0; mode = 2; } else { off = WS_MISC; ld = 256; dcol = w0; } break;
            }
            bf16* base = (bf16*)(ws + off);
            const int i0 = 16 * (wc & 1) + 4 * fq;
#pragma unroll
            for (int ai = 0; ai < 2; ++ai) {
                f32x4 cc[4], sn[4];
                if (mode) {
#pragma unroll
                    for (int m = 0; m < 4; ++m) {
                        const int row = u.pm * 256 + ai * 128 + wr * 64 + m * 16 + fr;
                        const float* cs = (mode == 1) ? CS64 + (size_t)row * 64 + i0 : CS32 + (size_t)row * 32 + 4 * fq;
                        cc[m] = *(const f32x4*)cs; sn[m] = *(const f32x4*)(cs + (mode == 1 ? 32 : 16));
                    }
                }
#pragma unroll
                for (int m = 0; m < 4; ++m) {
                    const int row = u.pm * 256 + ai * 128 + wr * 64 + m * 16 + fr;
                    f32x4 v0 = acc[ai][bj][m][0], v1 = acc[ai][bj][m][1];
                    if (mode) rot4(v0, v1, cc[m], sn[m]);
                    v0 = v0 * sc; v1 = v1 * sc;
                    const size_t drow = gm ? (size_t)(((row >> 12) * 2 + g) * SP + (row & 4095)) : (size_t)row;
                    *(u32x4*)(base + drow * ld + dcol + 8 * fq) = pack8(v0, v1);
                }
            }
        }
    }
};
struct EpiCmp {
    static constexpr bool PERM = true, AFTER_DRAIN = true;
    const float* B1P; const bf16* W2T; const float *B2K, *B2V; bf16 *KC, *VC; const float* CS64;
    DI void fused(const AccT& acc, const Unit& u, int wr, int wc, int fr, int fq, LAS unsigned char* lds, int wid, int lane) const {
        constexpr int HST = 528;
        const int kv = u.e, bg = u.pm & 15;
#pragma unroll
        for (int bj = 0; bj < 2; ++bj) {
            const int col = bj * 128 + wc * 32 + 8 * fq;
            const f32x4 b0 = *(const f32x4*)(B1P + kv * 256 + col), b1 = *(const f32x4*)(B1P + kv * 256 + col + 4);
#pragma unroll
            for (int ai = 0; ai < 2; ++ai)
#pragma unroll
                for (int m = 0; m < 4; ++m) {
                    const int rl = ai * 128 + wr * 64 + m * 16 + fr;
                    f32x4 v0 = acc[ai][bj][m][0] + b0, v1 = acc[ai][bj][m][1] + b1;
#pragma unroll
                    for (int j = 0; j < 4; ++j) {
                        float x = v0[j]; float z = 0.7978845608028654f * (x + 0.044715f * x * x * x); v0[j] = x * sigmoidf_(2.f * z);
                        x = v1[j]; z = 0.7978845608028654f * (x + 0.044715f * x * x * x); v1[j] = x * sigmoidf_(2.f * z);
                    }
                    *(LAS u32x4*)(lds + rl * HST + col * 2) = pack8(v0, v1);
                }
        }
        asm volatile("s_waitcnt lgkmcnt(0)\n\ts_barrier" ::: "memory");
        const int r32 = lane & 31, hh = lane >> 5;
        f32x16 out0 = {0.f, 0.f, 0.f, 0.f, 0.f, 0.f, 0.f, 0.f, 0.f, 0.f, 0.f, 0.f, 0.f, 0.f, 0.f, 0.f}, out1 = out0;
        const bf16* w2 = W2T + (size_t)kv * 64 * 256;
#pragma unroll 4
        for (int ks = 0; ks < 16; ++ks) {
            const bf16x8 a = *(const LAS bf16x8*)(lds + (32 * wid + r32) * HST + (16 * ks + 8 * hh) * 2);
            const bf16x8 bq0 = *(const bf16x8*)(w2 + (size_t)r32 * 256 + 16 * ks + 8 * hh), bq1 = *(const bf16x8*)(w2 + (size_t)(32 + r32) * 256 + 16 * ks + 8 * hh);
            out0 = __builtin_amdgcn_mfma_f32_32x32x16_bf16(a, bq0, out0, 0, 0, 0); out1 = __builtin_amdgcn_mfma_f32_32x32x16_bf16(a, bq1, out1, 0, 0, 0);
        }
        const float* b2 = kv ? B2V : B2K;
        const float bb0 = b2[r32], bb1 = b2[32 + r32];
        const int b = bg >> 1;
#pragma unroll
        for (int i = 0; i < 16; ++i) {
            const int c = 32 * wid + 8 * (i >> 2) + 4 * hh + (i & 3);
            const size_t row = (size_t)bg * 256 + c;
            float x1 = out0[i] + bb0, x2 = out1[i] + bb1;
            if (c == 255) { x1 = 0.f; x2 = 0.f; }
            if (kv == 0) {
                const int tokr = (b * S + 16 * c + 31) & (T - 1);
                const float cs = CS64[(size_t)tokr * 64 + r32], sn = CS64[(size_t)tokr * 64 + 32 + r32];
                *(unsigned*)(KC + row * 64 + 2 * r32) = pk2(x1 * cs - x2 * sn, x2 * cs + x1 * sn);
            } else {
                VC[row * 64 + r32] = (bf16)(pk2(x1, 0.f) & 0xffffu); VC[row * 64 + 32 + r32] = (bf16)(pk2(x2, 0.f) & 0xffffu);
            }
        }
    }
};
struct EpiMla {
    static constexpr bool PERM = true, AFTER_DRAIN = false;
    bf16 *QM, *KN, *VM; const bf16 *CQ, *MISC; const float* CS32;
    DI void operator()(const AccT& acc, const Unit& u, int wr, int wc, int fr, int fq) const {
        float rstd[2][4];
#pragma unroll
        for (int ai = 0; ai < 2; ++ai)
#pragma unroll
            for (int m = 0; m < 4; ++m) {
                const int row = u.pm * 256 + ai * 128 + wr * 64 + m * 16 + fr;
                float ss = 0.f;
                if (u.e == 0) {
#pragma unroll
                    for (int c = 0; c < 8; ++c) { const u32x4 w = *(const u32x4*)(CQ + (size_t)row * 256 + fq * 64 + 8 * c);
                        ss += bflo(w.x) * bflo(w.x) + bfhi(w.x) * bfhi(w.x) + bflo(w.y) * bflo(w.y) + bfhi(w.y) * bfhi(w.y) + bflo(w.z) * bflo(w.z) + bfhi(w.z) * bfhi(w.z) + bflo(w.w) * bflo(w.w) + bfhi(w.w) * bfhi(w.w); }
                } else {
#pragma unroll
                    for (int c = 0; c < 4; ++c) { const u32x4 w = *(const u32x4*)(MISC + (size_t)row * 256 + fq * 32 + 8 * c);
                        ss += bflo(w.x) * bflo(w.x) + bfhi(w.x) * bfhi(w.x) + bflo(w.y) * bflo(w.y) + bfhi(w.y) * bfhi(w.y) + bflo(w.z) * bflo(w.z) + bfhi(w.z) * bfhi(w.z) + bflo(w.w) * bflo(w.w) + bfhi(w.w) * bfhi(w.w); }
                }
                ss += __shfl_xor(ss, 16); ss += __shfl_xor(ss, 32);
                rstd[ai][m] = rsqrtf(ss * (u.e == 0 ? (1.0f / 256.0f) : (1.0f / 128.0f)) + EPS);
            }
#pragma unroll
        for (int bj = 0; bj < 2; ++bj) {
            const int gc = u.pn * 256 + bj * 128 + wc * 32;
            bf16* base; int ld, dcol, rope = 0; float sc = 1.f;
            if (u.e == 0) { if (gc >= 384) continue; rope = ((gc >> 5) % 3) == 2; base = QM; ld = 384; dcol = gc; sc = SCL96; }
            else { const int head = gc >> 7, part = (gc & 127) >> 6, o = gc & 63; base = part ? VM : KN; ld = 256; dcol = head * 64 + o; }
#pragma unroll
            for (int ai = 0; ai < 2; ++ai) {
                f32x4 cc[4], sn[4];
                if (rope) {
#pragma unroll
                    for (int m = 0; m < 4; ++m) { const float* cs = CS32 + (size_t)(u.pm * 256 + ai * 128 + wr * 64 + m * 16 + fr) * 32 + 4 * fq; cc[m] = *(const f32x4*)cs; sn[m] = *(const f32x4*)(cs + 16); }
                }
#pragma unroll
                for (int m = 0; m < 4; ++m) {
                    const int row = u.pm * 256 + ai * 128 + wr * 64 + m * 16 + fr;
                    const float r = rstd[ai][m] * sc;
                    f32x4 v0 = acc[ai][bj][m][0] * r, v1 = acc[ai][bj][m][1] * r;
                    if (rope) rot4(v0, v1, cc[m], sn[m]);
                    *(u32x4*)(base + (size_t)row * ld + dcol + 8 * fq) = pack8(v0, v1);
                }
            }
        }
    }
};
struct EpiWout {
    static constexpr bool PERM = false, AFTER_DRAIN = false;
    bf16* X; const float* GT; size_t dofs;
    DI void operator()(const AccT& acc, const Unit& u, int wr, int wc, int fr, int fq) const {
        const int b = (u.pm * 256) >> 12;
        const int col0 = u.pn * 256 + wc * 32 + 4 * fq;
#pragma unroll
        for (int bj = 0; bj < 2; ++bj) {
#pragma unroll
            for (int n = 0; n < 2; ++n) {
                u32x2 xo[2][4];
                const f32x4 gt = *(const f32x4*)(GT + (size_t)b * 6144 + col0 + bj * 128 + n * 16);
#pragma unroll
                for (int ai = 0; ai < 2; ++ai)
#pragma unroll
                    for (int m = 0; m < 4; ++m) xo[ai][m] = *(const u32x2*)(X + (size_t)(u.pm * 256 + ai * 128 + wr * 64 + m * 16 + fr) * 1024 + col0 + bj * 128 + n * 16);
#pragma unroll
                for (int ai = 0; ai < 2; ++ai)
#pragma unroll
                    for (int m = 0; m < 4; ++m) {
                        bf16* p = X + (size_t)(u.pm * 256 + ai * 128 + wr * 64 + m * 16 + fr) * 1024 + col0 + bj * 128 + n * 16;
                        const f32x4 xv = (f32x4){bflo(xo[ai][m].x), bfhi(xo[ai][m].x), bflo(xo[ai][m].y), bfhi(xo[ai][m].y)} + gt * acc[ai][bj][m][n];
                        u32x2 w; w.x = pk2(xv[0], xv[1]); w.y = pk2(xv[2], xv[3]);
                        *(u32x2*)((char*)p + dofs) = w;
                    }
            }
        }
    }
};
struct EpiMoe1 {
    static constexpr bool PERM = true, AFTER_DRAIN = false; static constexpr int A_E8M0 = H8_E8M0;
    static constexpr bool ACC_BIAS = true;
    bf16* ACT; const float* B1;
    DI void bias(const Unit& u, int wc, int fq, f32x4 (&bv)[2][2]) const {
#pragma unroll
        for (int bj = 0; bj < 2; ++bj) { const int col = u.pn * 256 + bj * 128 + wc * 32 + 8 * fq; bv[bj][0] = *(const f32x4*)(B1 + (size_t)u.e * 2048 + col); bv[bj][1] = *(const f32x4*)(B1 + (size_t)u.e * 2048 + col + 4); }
    }
    DI void operator()(const AccT& acc, const Unit& u, int wr, int wc, int fr, int fq) const {
#pragma unroll
        for (int bj = 0; bj < 2; ++bj) {
            const int col = u.pn * 256 + bj * 128 + wc * 32 + 8 * fq;
#pragma unroll
            for (int ai = 0; ai < 2; ++ai)
#pragma unroll
                for (int m = 0; m < 4; ++m) {
                    const int row = u.pm * 256 + ai * 128 + wr * 64 + m * 16 + fr;
                    const f32x4 v0 = acc[ai][bj][m][0], v1 = acc[ai][bj][m][1];
                    float o[4];
#pragma unroll
                    for (int j = 0; j < 4; ++j) {
                        const float gl = fminf((j < 2) ? v0[2 * j] : v1[2 * j - 4], 7.0f);
                        const float li = fminf(fmaxf((j < 2) ? v0[2 * j + 1] : v1[2 * j - 3], -7.0f), 7.0f);
                        o[j] = gl * sigmoidf_(1.702f * gl) * (li + 1.0f);
                    }
                    *(unsigned*)((unsigned char*)ACT + (size_t)row * 1024 + (col >> 1)) = pk4_fp8s(o[0], o[1], o[2], o[3], A8_SCALE);
                }
        }
    }
};
struct EpiMoe2 {
    static constexpr bool PERM = true, AFTER_DRAIN = false; static constexpr int A_E8M0 = A8_E8M0;
    static constexpr bool ACC_BIAS = true;
    unsigned char* Y2; const float* B2;
    DI void bias(const Unit& u, int wc, int fq, f32x4 (&bv)[2][2]) const {
#pragma unroll
        for (int bj = 0; bj < 2; ++bj) { const int col = u.pn * 256 + bj * 128 + wc * 32 + 8 * fq; bv[bj][0] = *(const f32x4*)(B2 + (size_t)u.e * 1024 + col); bv[bj][1] = *(const f32x4*)(B2 + (size_t)u.e * 1024 + col + 4); }
    }
    DI void operator()(const AccT& acc, const Unit& u, int wr, int wc, int fr, int fq) const {
#pragma unroll
        for (int ai = 0; ai < 2; ++ai)
#pragma unroll
            for (int m = 0; m < 4; ++m) {
                const int rl = ai * 128 + wr * 64 + m * 16 + fr;
                const size_t row = (size_t)u.pm * 256 + rl;
#pragma unroll
                for (int bj = 0; bj < 2; ++bj) {
                    const int col = u.pn * 256 + bj * 128 + wc * 32 + 8 * fq;
                    const f32x4 v0 = acc[ai][bj][m][0], v1 = acc[ai][bj][m][1];
                    { u32x2 w8; w8.x = pk4_fp8(v0[0], v0[1], v0[2], v0[3]); w8.y = pk4_fp8(v1[0], v1[1], v1[2], v1[3]); *(u32x2*)(Y2 + row * 1024 + col) = w8; }
                }
            }
    }
};

#define MFMA32(a, b, c) __builtin_amdgcn_mfma_f32_32x32x16_bf16((a), (b), (c), 0, 0, 0)
typedef short v4i16_t __attribute__((ext_vector_type(4)));
DI s16x4 tr_read(const LAS unsigned char* p) { return __builtin_bit_cast(s16x4, __builtin_amdgcn_ds_read_tr16_b64_v4i16((LAS v4i16_t*)p)); }
constexpr int VST = 144;
template <int DQ> struct AC { static constexpr int KST = DQ * 2 + 16, KS = DQ / 16, KBUF = 64 * KST, VBUF = 64 * VST, BUF = KBUF + VBUF; };

template <int DQ>
DI void qk_tile(const LAS unsigned char* kb, const bf16x8 (&qf)[DQ / 16], f32x16 (&s)[2], const f32x16& cinit, int lane) {
    const int r32 = lane & 31, hh = lane >> 5;
    bf16x8 kf[2][DQ / 16];
#pragma unroll
    for (int rt = 0; rt < 2; ++rt)
#pragma unroll
        for (int ks = 0; ks < DQ / 16; ++ks) kf[rt][ks] = *(const LAS bf16x8*)(kb + (32 * rt + r32) * AC<DQ>::KST + (16 * ks + 8 * hh) * 2);
    f32x16 a0 = MFMA32(kf[0][0], qf[0], cinit), a1 = MFMA32(kf[1][0], qf[0], cinit);
#pragma unroll
    for (int ks = 1; ks < DQ / 16; ++ks) { a0 = MFMA32(kf[0][ks], qf[ks], a0); a1 = MFMA32(kf[1][ks], qf[ks], a1); }
    s[0] = a0; s[1] = a1;
}
DI float max3f_(float a, float b, float c) { return __builtin_fmaxf(__builtin_fmaxf(a, b), c); }
constexpr float RESC_THR = 8.0f;
template <int DQ, int KMUL, int VAR = 0>
DI void attn_tile(const LAS unsigned char* kb, const LAS unsigned char* vb, const bf16x8 (&qf)[DQ / 16], f32x16 (&o)[2], f32x16& negm, float& m, float& l,
                  int dq, unsigned maxd, bool lf, int lane, const bool MASKED) {
    const int hh = lane >> 5;
    if (VAR == 1) return;
    f32x16 s[2];
    qk_tile<DQ>(kb, qf, s, negm, lane);
    if (VAR == 2) { o[0] += s[0]; o[1] += s[1]; return; }
    const int i16 = lane & 15, q = i16 >> 2, p_ = i16 & 3, mh = (lane >> 4) & 1;
    const LAS unsigned char* vbase = vb + (4 * hh + q) * VST + 32 * mh + 8 * p_;
    s16x4 vlo[4][2], vhi[4][2];
#pragma unroll
    for (int st = 0; st < 4; ++st)
#pragma unroll
        for (int mt = 0; mt < 2; ++mt) { vlo[st][mt] = tr_read(vbase + (16 * st) * VST + 64 * mt); vhi[st][mt] = tr_read(vbase + (16 * st + 8) * VST + 64 * mt); }
    __builtin_amdgcn_sched_barrier(0);
    if (MASKED) {
#pragma unroll
        for (int rt = 0; rt < 2; ++rt)
#pragma unroll
            for (int i = 0; i < 16; ++i) {
                const int d = dq - (32 * rt + 8 * (i >> 2) + (i & 3)) * KMUL;
                s[rt][i] = ((unsigned)d <= maxd) ? s[rt][i] : -1e30f;
            }
    }
    float mx = max3f_(s[0][0], s[0][1], s[0][2]);
#pragma unroll
    for (int i = 3; i < 15; i += 2) mx = max3f_(mx, s[0][i], s[0][i + 1]);
    mx = max3f_(mx, s[0][15], s[1][0]);
#pragma unroll
    for (int i = 1; i < 15; i += 2) mx = max3f_(mx, s[1][i], s[1][i + 1]);
    mx = fmaxf(mx, s[1][15]);
    if (__ballot(lf && mx > RESC_THR) != 0ull) {
        float mc = lf ? mx : -1e30f;
        mc = fmaxf(mc, __shfl_xor(mc, 32));
        const float delta = mc > RESC_THR ? mc : 0.f;
        const float alpha = fast_exp2(-delta);
        m += delta; l *= alpha;
#pragma unroll
        for (int i = 0; i < 16; ++i) { negm[i] = -m; o[0][i] *= alpha; o[1][i] *= alpha; s[0][i] -= delta; s[1][i] -= delta; }
    }
    float ps = 0.f;
#pragma unroll
    for (int rt = 0; rt < 2; ++rt)
#pragma unroll
        for (int i = 0; i < 16; ++i) { const float p = fast_exp2(s[rt][i]); s[rt][i] = p; ps += p; }
    const unsigned lmask = lf ? 0xffffffffu : 0u;
    l += lf ? ps : 0.f;
    if (VAR == 3) { o[0] += s[0]; o[1] += s[1]; return; }
#pragma unroll
    for (int rt = 0; rt < 2; ++rt)
#pragma unroll
        for (int s2 = 0; s2 < 2; ++s2) {
            u32x4 pw; pw.x = pk2(s[rt][8 * s2 + 0], s[rt][8 * s2 + 1]) & lmask; pw.y = pk2(s[rt][8 * s2 + 2], s[rt][8 * s2 + 3]) & lmask;
            pw.z = pk2(s[rt][8 * s2 + 4], s[rt][8 * s2 + 5]) & lmask; pw.w = pk2(s[rt][8 * s2 + 6], s[rt][8 * s2 + 7]) & lmask;
            const bf16x8 pb = __builtin_bit_cast(bf16x8, pw);
#pragma unroll
            for (int mt = 0; mt < 2; ++mt) {
                const bf16x8 va = __builtin_shufflevector(vlo[2 * rt + s2][mt], vhi[2 * rt + s2][mt], 0, 1, 2, 3, 4, 5, 6, 7);
                o[mt] = MFMA32(va, pb, o[mt]);
            }
        }
}
constexpr int OSTAGE_WAVE = 32 * 144;
static_assert(102400 + 8 * OSTAGE_WAVE <= MISC_OFF, "O stage below the LDS control words");
struct ChunkId { DI u32x4 operator()(u32x4 v, int, int, int) const { return v; } };
template <class P, class Fx = ChunkId>
DI void store_o_rows(const P& p, LAS unsigned char* lds, int off, const f32x16 (&o)[2], float inv, int lane, int wave, const Fx& fx = Fx()) {
    LAS unsigned char* st = lds + off + wave * OSTAGE_WAVE;
    const int n = lane & 31, hh = lane >> 5;
#pragma unroll
    for (int mt = 0; mt < 2; ++mt)
#pragma unroll
        for (int a = 0; a < 4; ++a) {
            u32x2 w; w.x = pk2(o[mt][4 * a] * inv, o[mt][4 * a + 1] * inv); w.y = pk2(o[mt][4 * a + 2] * inv, o[mt][4 * a + 3] * inv);
            *(LAS u32x2*)(st + n * 144 + (32 * mt + 8 * a + 4 * hh) * 2) = w;
        }
    asm volatile("s_waitcnt lgkmcnt(0)" ::: "memory");
#pragma unroll
    for (int it = 0; it < 4; ++it) {
        const int r = (lane >> 3) + 8 * it, c = lane & 7;
        const u32x4 v = fx(*(const LAS u32x4*)(st + r * 144 + c * 16), wave, r, c);
        *(u32x4*)(p.orow(wave, r) + 8 * c) = v;
    }
}
DI void store_o(bf16* orow, const f32x16 (&o)[2], float inv, int lane) {
    const int hh = lane >> 5;
#pragma unroll
    for (int mt = 0; mt < 2; ++mt)
#pragma unroll
        for (int a = 0; a < 4; ++a) {
            u32x2 w; w.x = pk2(o[mt][4 * a] * inv, o[mt][4 * a + 1] * inv); w.y = pk2(o[mt][4 * a + 2] * inv, o[mt][4 * a + 3] * inv);
            *(u32x2*)(orow + 32 * mt + 8 * a + 4 * hh) = w;
        }
}

struct PolA {
    static constexpr bool HASFLAG = false, LSE = true; static constexpr int KMUL = 1;
    const bf16 *Q, *K, *V; bf16* O; float* LSEP; int b, h, d, r, c; unsigned maxd; int j0, j1;
    DI int ql(int w, int lane) const { return 256 * c + 32 * w + (lane & 31); }
    DI size_t trow(int l_) const { return (size_t)b * S + (size_t)l_ * d + r; }
    DI const bf16* qrow(int w, int lane) const { return Q + trow(ql(w, lane)) * 256 + h * 64; }
    DI int qv(int w, int lane) const { return ql(w, lane); }
    DI int qmin(int w) const { return 256 * c + 32 * w; }
    DI int qmax(int w) const { return 256 * c + 32 * w + 31; }
    DI int kv0(int j) const { return 256 * c - 128 + 64 * j; }
    DI const bf16* krow(int j, int row) const { return K + trow(kv0(j) + row) * 256 + h * 64; }
    DI const bf16* vrow(int j, int row) const { return V + trow(kv0(j) + row) * 256 + h * 64; }
    DI const bf16* rrow(int, int) const { return nullptr; }
    DI bool flag(int, int, int) const { return true; }
    DI bf16* orow(int w, int lane) const { return O + trow(ql(w, lane)) * 256 + h * 64; }
    DI void lse(int w, int lane, float v) const { LSEP[trow(ql(w, lane)) * 4 + h] = v; }
};
struct PolB {
    static constexpr bool LSE = false; static constexpr int KMUL = 1;
    const bf16 *Q, *K, *V; bf16* O; int b, g, qc; unsigned maxd; int j0, j1; u64 sel; bool hasflag;
    const bf16 *GC = nullptr, *GW = nullptr, *GM = nullptr;
    DI int tok(int w, int lane) const { return 64 * qc + 8 * w + ((lane & 31) >> 2); }
    DI const bf16* qrow(int w, int lane) const { return Q + ((size_t)b * S + tok(w, lane)) * 512 + (4 * g + (lane & 3)) * 64; }
    DI int qv(int w, int lane) const { return tok(w, lane); }
    DI int qmin(int w) const { return 64 * qc + 8 * w; }
    DI int qmax(int w) const { return 64 * qc + 8 * w + 7; }
    DI int kv0(int j) const { return 64 * j; }
    DI const bf16* krow(int j, int row) const { return K + ((size_t)b * S + 64 * j + row) * 128 + g * 64; }
    DI const bf16* vrow(int j, int row) const { return V + ((size_t)b * S + 64 * j + row) * 128 + g * 64; }
    DI const bf16* rrow(int, int) const { return nullptr; }
    DI bf16* orow(int w, int lane) const { return O + ((size_t)b * S + tok(w, lane)) * 512 + (4 * g + (lane & 3)) * 64; }
    DI void lse(int, int, float) const {}
};
struct PolM {
    static constexpr bool HASFLAG = false, LSE = false; static constexpr int KMUL = 1;
    const bf16 *Q, *KN, *KR, *V; bf16* O; int b, h, c; unsigned maxd; int j0, j1;
    DI int tok(int w, int lane) const { return 256 * c + 32 * w + (lane & 31); }
    DI const bf16* qrow(int w, int lane) const { return Q + ((size_t)b * S + tok(w, lane)) * 384 + h * 96; }
    DI int qv(int w, int lane) const { return tok(w, lane); }
    DI int qmin(int w) const { return 256 * c + 32 * w; }
    DI int qmax(int w) const { return 256 * c + 32 * w + 31; }
    DI int kv0(int j) const { return 64 * j; }
    DI const bf16* krow(int j, int row) const { return KN + ((size_t)b * S + 64 * j + row) * 256 + h * 64; }
    DI const bf16* vrow(int j, int row) const { return V + ((size_t)b * S + 64 * j + row) * 256 + h * 64; }
    DI const bf16* rrow(int j, int row) const { return KR + ((size_t)b * S + 64 * j + row) * 32; }
    DI bf16* orow(int w, int lane) const { return O + ((size_t)b * S + tok(w, lane)) * 256 + h * 64; }
    DI void lse(int, int, float) const {}
};

template <int DQ, class P, bool FLAG, int VAR = 0>
DI void attn_unit(const P& p, LAS unsigned char* lds, int tid, int lane, int wave, u64 sel) {
    typedef AC<DQ> C;
    const int hh = lane >> 5;
    const bf16* qrow = p.qrow(wave, lane);
    bf16x8 qf[DQ / 16];
#pragma unroll
    for (int ks = 0; ks < DQ / 16; ++ks) qf[ks] = *(const bf16x8*)(qrow + 16 * ks + 8 * hh);
#pragma unroll
    for (int ks = 0; ks < DQ / 16; ++ks) asm volatile("s_waitcnt vmcnt(0)" : "+v"(qf[ks]) :: "memory");
    const int qv = p.qv(wave, lane), wq0 = p.qmin(wave), wq1 = p.qmax(wave);
    f32x16 o[2];
#pragma unroll
    for (int mt = 0; mt < 2; ++mt)
#pragma unroll
        for (int i = 0; i < 16; ++i) o[mt][i] = 0.f;
    float m = 0.f, l = 0.f;
    f32x16 negm;
#pragma unroll
    for (int i = 0; i < 16; ++i) negm[i] = 0.f;
    const int j0 = p.j0, j1 = p.j1;
    const int lrow = tid >> 3, lch = tid & 7;
    u32x4 k0A, v0A, r0A = {0u, 0u, 0u, 0u}, k1A, v1A, r1A = {0u, 0u, 0u, 0u}, k0B, v0B, r0B = {0u, 0u, 0u, 0u}, k1B, v1B, r1B = {0u, 0u, 0u, 0u};
    constexpr int NLD = (DQ == 96) ? 6 : 4;
    const int npair = (j1 - j0 + 1) >> 1;
#define ATT_LOAD1(RK, RV, RR, j) do { const bf16* pk_ = p.krow((j), lrow) + 8 * lch; const bf16* pv_ = p.vrow((j), lrow) + 8 * lch; \
        asm volatile("global_load_dwordx4 %0, %2, off\n\tglobal_load_dwordx4 %1, %3, off" : "=&v"(RK), "=&v"(RV) : "v"(pk_), "v"(pv_) : "memory"); \
        if (DQ == 96) { const bf16* pr_ = p.rrow((j), (tid & 255) >> 2) + 8 * (tid & 3); asm volatile("global_load_dwordx4 %0, %1, off" : "=&v"(RR) : "v"(pr_) : "memory"); } } while (0)
#define ATT_LOADP(K0, V0, R0, K1, V1, R1, t) do { const int ja_ = j0 + 2 * (t), jb_ = ja_ + 1; \
        { const int jc_ = ja_ < j1 ? ja_ : j1 - 1; ATT_LOAD1(K0, V0, R0, jc_); } { const int jd_ = jb_ < j1 ? jb_ : j1 - 1; ATT_LOAD1(K1, V1, R1, jd_); } } while (0)
#define ATT_TILE(kb_, jt_) do { const int j_ = (jt_); const int kv0 = p.kv0(j_); \
        bool need = (j_ < j1) && (wq1 - kv0 >= 0) && ((long long)wq0 - (long long)(kv0 + 63 * P::KMUL) <= (long long)p.maxd); \
        const bool interior = (wq0 - (kv0 + 63 * P::KMUL) >= 0) && ((long long)wq1 - (long long)kv0 <= (long long)p.maxd); \
        bool lf = true; \
        if (FLAG) { lf = ((sel >> j_) & 1ull) != 0ull; need = need && (__ballot(lf) != 0ull); } \
        if (need) attn_tile<DQ, P::KMUL, VAR>((kb_), (kb_) + C::KBUF, qf, o, negm, m, l, qv - kv0 - 4 * hh * P::KMUL, p.maxd, lf, lane, !interior); } while (0)
#define ATT_STEP(K0, V0, R0, K1, V1, R1, tt) do { const int t_ = (tt); \
        LAS unsigned char* pbuf = lds + (t_ & 1) * (2 * C::BUF); \
        asm volatile("s_waitcnt vmcnt(%6)" : "+v"(K0), "+v"(V0), "+v"(R0), "+v"(K1), "+v"(V1), "+v"(R1) : "n"(NLD) : "memory"); \
        *(LAS u32x4*)(pbuf + lrow * C::KST + lch * 16) = K0; *(LAS u32x4*)(pbuf + C::KBUF + lrow * VST + lch * 16) = V0; \
        *(LAS u32x4*)(pbuf + C::BUF + lrow * C::KST + lch * 16) = K1; *(LAS u32x4*)(pbuf + C::BUF + C::KBUF + lrow * VST + lch * 16) = V1; \
        if (DQ == 96) { *(LAS u32x4*)(pbuf + ((tid & 255) >> 2) * C::KST + 128 + (tid & 3) * 16) = R0; *(LAS u32x4*)(pbuf + C::BUF + ((tid & 255) >> 2) * C::KST + 128 + (tid & 3) * 16) = R1; } \
        asm volatile("s_waitcnt lgkmcnt(0)\n\ts_barrier" ::: "memory"); \
        ATT_LOADP(K0, V0, R0, K1, V1, R1, t_ + 2); \
        if (ATT_STAGGER > 0 && wave >= 4) __builtin_amdgcn_s_sleep(ATT_STAGGER); \
        ATT_TILE(pbuf, j0 + 2 * t_); ATT_TILE(pbuf + C::BUF, j0 + 2 * t_ + 1); } while (0)
    ATT_LOADP(k0A, v0A, r0A, k1A, v1A, r1A, 0);
    ATT_LOADP(k0B, v0B, r0B, k1B, v1B, r1B, 1);
    if (wave >= 4) __builtin_amdgcn_s_setprio(1);
#pragma unroll 1
    for (int t = 0; t < npair; t += 2) {
        ATT_STEP(k0A, v0A, r0A, k1A, v1A, r1A, t);
        ATT_STEP(k0B, v0B, r0B, k1B, v1B, r1B, t + 1);
    }
    __builtin_amdgcn_s_setprio(0);
    asm volatile("s_waitcnt vmcnt(0)" : "+v"(k0A), "+v"(v0A), "+v"(r0A), "+v"(k1A), "+v"(v1A), "+v"(r1A), "+v"(k0B), "+v"(v0B), "+v"(r0B), "+v"(k1B), "+v"(v1B), "+v"(r1B) :: "memory");
#undef ATT_LOAD1
#undef ATT_LOADP
#undef ATT_TILE
#undef ATT_STEP
    const float lt = l + __shfl_xor(l, 32);
    const float inv = lt > 0.f ? 1.0f / lt : 0.f;
    if constexpr (FLAG) {
        struct Gate { const P& p;
            DI u32x4 operator()(u32x4 v, int w_, int r, int c) const {
                const size_t tg = (size_t)p.b * S + 64 * p.qc + 8 * w_ + (r >> 2); const int hd = 4 * p.g + (r & 3);
                const bf16* gl = p.GM + tg * 256 + 160 + hd * 3;
                const float g0 = sigmoidf_(bf2f(gl[0])), g1 = sigmoidf_(bf2f(gl[1])), g2 = sigmoidf_(bf2f(gl[2]));
                const u32x4 a = *(const u32x4*)(p.GC + tg * 512 + hd * 64 + 8 * c), d = *(const u32x4*)(p.GW + tg * 512 + hd * 64 + 8 * c);
                u32x4 r_;
                r_.x = pk2(g0 * bflo(a.x) + g1 * bflo(v.x) + g2 * bflo(d.x), g0 * bfhi(a.x) + g1 * bfhi(v.x) + g2 * bfhi(d.x));
                r_.y = pk2(g0 * bflo(a.y) + g1 * bflo(v.y) + g2 * bflo(d.y), g0 * bfhi(a.y) + g1 * bfhi(v.y) + g2 * bfhi(d.y));
                r_.z = pk2(g0 * bflo(a.z) + g1 * bflo(v.z) + g2 * bflo(d.z), g0 * bfhi(a.z) + g1 * bfhi(v.z) + g2 * bfhi(d.z));
                r_.w = pk2(g0 * bflo(a.w) + g1 * bflo(v.w) + g2 * bflo(d.w), g0 * bfhi(a.w) + g1 * bfhi(v.w) + g2 * bfhi(d.w));
                return r_; } } gate{p};
        store_o_rows(p, lds, 90112, o, inv, lane, wave, gate);
    } else store_o_rows(p, lds, DQ == 96 ? 102400 : 90112, o, inv, lane, wave);
    if (P::LSE) { if (hh == 0) p.lse(wave, lane, m + __log2f(lt)); }
    __syncthreads();
}

DI u64 cmp_unit(const Ctx& F, int b, int g, int qc) {
    constexpr int KST = 144;
    LAS unsigned char* KL = F.lds; LAS unsigned char* VL = F.lds + 256 * KST; LAS float* IMP = (LAS float*)(F.lds + 2 * 256 * KST);
    const bf16* KC = (const bf16*)(F.ws + WS_KC) + (size_t)(b * 2 + g) * 256 * 64;
    const bf16* VC = (const bf16*)(F.ws + WS_VC) + (size_t)(b * 2 + g) * 256 * 64;
    const int tid = F.tid, lane = F.lane, w = F.wave, hh = lane >> 5, r32 = lane & 31;
#pragma unroll
    for (int it = 0; it < 4; ++it) { const int idx = tid + 512 * it, row = idx >> 3, ch = idx & 7;
        *(LAS u32x4*)(KL + row * KST + ch * 16) = *(const u32x4*)(KC + row * 64 + ch * 8);
        *(LAS u32x4*)(VL + row * VST + ch * 16) = *(const u32x4*)(VC + row * 64 + ch * 8); }
    __syncthreads();
    const int tokl = 8 * w + (r32 >> 2), tok = 64 * qc + tokl, head = 4 * g + (lane & 3);
    const bf16* qrow = (const bf16*)(F.ws + WS_QB) + ((size_t)b * S + tok) * 512 + head * 64;
    bf16x8 qf[4];
#pragma unroll
    for (int ks = 0; ks < 4; ++ks) qf[ks] = *(const bf16x8*)(qrow + 16 * ks + 8 * hh);
    const int qv = tok - 31, wq1 = 64 * qc + 8 * w + 7 - 31;
    f32x16 o[2];
#pragma unroll
    for (int mt = 0; mt < 2; ++mt)
#pragma unroll
        for (int i = 0; i < 16; ++i) o[mt][i] = 0.f;
    float m = 0.f, l = 0.f;
    f32x16 negm;
#pragma unroll
    for (int i = 0; i < 16; ++i) negm[i] = 0.f;
    const int wq0 = 64 * qc + 8 * w - 31;
#pragma unroll 1
    for (int jt = 0; jt < 4; ++jt) {
        if (wq1 - 1024 * jt >= 0) {
            const int dq = qv - 1024 * jt - 4 * hh * 16;
            attn_tile<64, 16>(KL + jt * 64 * KST, VL + jt * 64 * VST, qf, o, negm, m, l, dq, 0x7fffffffu, true, lane, !(wq0 - (1024 * jt + 63 * 16) >= 0));
        }
    }
    const float lt = l + __shfl_xor(l, 32);
    const float inv = lt > 0.f ? 1.0f / lt : 0.f;
    { struct { bf16* O; int b, g, qc; DI bf16* orow(int w_, int n_) const { return O + ((size_t)b * S + 64 * qc + 8 * w_ + (n_ >> 2)) * 512 + (4 * g + (n_ & 3)) * 64; } } pc{(bf16*)(F.ws + WS_OCMP), b, g, qc};
      store_o_rows(pc, F.lds, 90112, o, inv, lane, w); }
    float prev = 0.f;
#pragma unroll 1
    for (int jt = 0; jt < 4; ++jt) {
        const bool need = (wq1 - 1024 * jt >= 0);
        f32x16 s[2];
        if (need) qk_tile<64>(KL + jt * 64 * KST, qf, s, negm, lane);
#pragma unroll
        for (int rt = 0; rt < 2; ++rt)
#pragma unroll
            for (int a = 0; a < 4; ++a) {
                float mainp = 0.f, sp = 0.f;
                if (need) {
                    float pb[4];
#pragma unroll
                    for (int bb = 0; bb < 4; ++bb) { const int kidx = 64 * jt + 32 * rt + 8 * a + 4 * hh + bb; const bool ok = (qv - 16 * kidx) >= 0; pb[bb] = ok ? fast_exp2(s[rt][4 * a + bb]) * inv : 0.f; }
                    mainp = pb[0] + pb[1] + pb[2] + 0.5f * pb[3]; sp = 0.5f * pb[3];
                }
                const float rc = __shfl_xor(sp, 32);
                float v = mainp + (hh ? rc : prev);
                prev = rc;
                v += __shfl_xor(v, 1); v += __shfl_xor(v, 2);
                if ((lane & 3) == 0) IMP[tokl * 64 + 2 * (8 * jt + 4 * rt + a) + hh] = v;
            }
    }
    __syncthreads();
    u64 mysel = 0ull;
#pragma unroll 1
    for (int tk = 0; tk < 8; ++tk) {
        const int tl = 8 * w + tk, t = 64 * qc + tl, j = lane;
        const float v = IMP[tl * 64 + j];
        const bool forced = (j == 0) || (j == qc) || (j == qc - 1);
        const bool valid = j <= qc;
        const float score = forced ? v + 1e4f : (valid ? v : -1.0f);
        int rank = 0;
#pragma unroll
        for (int jp = 0; jp < 64; ++jp) { const float o_ = __builtin_bit_cast(float, __builtin_amdgcn_readlane(__builtin_bit_cast(int, score), jp)); rank += ((o_ > score) || (o_ == score && jp < j)) ? 1 : 0; }
        const u64 mask = __ballot(rank < 16);
        (void)t;
        if (tk == (r32 >> 2)) mysel = mask;
    }
    __syncthreads();
    return mysel;
}

DI void moe_tables(const Ctx& F, int l) {
    LAS int* tb = (LAS int*)(F.lds + AUX_OFF); LAS int* cn = tb + 64;
    if (F.tid == 0) {
        const unsigned* C = (const unsigned*)(F.ws + WS_CTL) + CW_CNT + l * 32 * 64;
        int acc = 0;
        for (int e = 0; e < 32; ++e) { const int c = (int)__hip_atomic_load(C + e * 64, RLX_AGENT); tb[e] = acc; cn[e] = c; acc += (c + 255) >> 8; }
        tb[32] = acc;
    }
    __syncthreads();
}
template <int MODE>
DI void phase_norm1(const Ctx& F, int l) {
    const float* mods = (const float*)(F.ws + WS_MODS);
    const bf16* X = (const bf16*)(F.ws + WS_X); bf16* H = (bf16*)(F.ws + F.dofs + WS_H); bf16* XW = (bf16*)(F.ws + F.dofs + WS_X);
    const LAS int* tb = (const LAS int*)(F.lds + AUX_OFF);
    if (l > 0) moe_tables(F, l - 1);
    const int gw = F.blk * 8 + F.wave, NGW = F.G * 8, lane = F.lane;
    for (int tok = gw; tok < T; tok += NGW) {
        const int b = tok >> 12;
        f32x4 v[4];
        if (l == 0) { const float* xr = ginp(F, I_X) + (size_t)tok * 1024;
#pragma unroll
            for (int k = 0; k < 4; ++k) v[k] = *(const f32x4*)(xr + 4 * lane + 256 * k);
        } else { const bf16* xr = X + (size_t)tok * 1024;
#pragma unroll
            for (int k = 0; k < 4; ++k) { const u32x2 w = *(const u32x2*)(xr + 4 * lane + 256 * k); v[k] = (f32x4){bflo(w.x), bfhi(w.x), bflo(w.y), bfhi(w.y)}; }
        }
        if (l > 0) {
            f32x4 y[4];
#pragma unroll
            for (int k = 0; k < 4; ++k) y[k] = (f32x4){0.f, 0.f, 0.f, 0.f};
            const int* ts = (const int*)(F.ws + WS_TOKSLOT) + (size_t)tok * 4;
            const f32x4 tg = *(const f32x4*)((const float*)(F.ws + WS_TOKG) + (size_t)tok * 4) * Y2_ISCALE;
#pragma unroll
            for (int s = 0; s < 4; ++s) {
                const int pk = ts[s]; const int e = pk >> 16, pos = pk & 0xffff;
                const unsigned char* yr = (const unsigned char*)(F.ws + WS_Y2) + ((size_t)tb[e] * 256 + pos) * 1024;
#pragma unroll
                for (int k = 0; k < 4; ++k) { const unsigned w = *(const unsigned*)(yr + 4 * lane + 256 * k); y[k] += unpk4_fp8(w) * tg[s]; }
            }
            const float* gt2 = mods + ((size_t)((l - 1) * 8 + b) * 6 + 5) * 1024;
#pragma unroll
            for (int k = 0; k < 4; ++k) v[k] = v[k] + *(const f32x4*)(gt2 + 4 * lane + 256 * k) * y[k];
        }
        float ss = 0.f;
#pragma unroll
        for (int k = 0; k < 4; ++k) ss += v[k][0] * v[k][0] + v[k][1] * v[k][1] + v[k][2] * v[k][2] + v[k][3] * v[k][3];
        const float rstd = rsqrtf(wave_sum(ss) * (1.0f / 1024.0f) + EPS);
        if (MODE == 0) {
            const float* g1 = ginp(F, I_G1) + (size_t)l * 1024;
            const float* sh = mods + ((size_t)(l * 8 + b) * 6 + 0) * 1024; const float* sc = sh + 1024;
#pragma unroll
            for (int k = 0; k < 4; ++k) {
                const int c = 4 * lane + 256 * k;
                { u32x2 xw; xw.x = pk2(v[k][0], v[k][1]); xw.y = pk2(v[k][2], v[k][3]); *(u32x2*)(XW + (size_t)tok * 1024 + c) = xw; }
                const f32x4 hv = v[k] * rstd * *(const f32x4*)(g1 + c) * (*(const f32x4*)(sc + c) + 1.0f) + *(const f32x4*)(sh + c);
                u32x2 w; w.x = pk2(hv[0], hv[1]); w.y = pk2(hv[2], hv[3]);
                *(u32x2*)(H + (size_t)tok * 1024 + c) = w;
            }
        } else {
            const float* gf = ginp(F, I_GF);
#pragma unroll
            for (int k = 0; k < 4; ++k) { const int c = 4 * lane + 256 * k; *(f32x4*)(gout(F) + (size_t)tok * 1024 + c) = v[k] * rstd * *(const f32x4*)(gf + c); }
        }
    }
}
DI void phase_prep(const Ctx& F) {
    const bf16* CQ = (const bf16*)(F.ws + WS_CQ); const bf16* MISC = (const bf16*)(F.ws + WS_MISC);
    float* RQ = (float*)(F.ws + WS_RSTDQ); float* RKV = (float*)(F.ws + WS_RSTDKV);
    bf16* KR = (bf16*)(F.ws + WS_KR); float* GATES = (float*)(F.ws + WS_GATES); const float* CS32 = (const float*)(F.ws + WS_CS32);
    const int gw = F.blk * 8 + F.wave, NGW = F.G * 8, lane = F.lane;
    for (int tok = gw; tok < T; tok += NGW) {
        const u32x2 wq = *(const u32x2*)(CQ + (size_t)tok * 256 + 4 * lane);
        const u32x2 wm = *(const u32x2*)(MISC + (size_t)tok * 256 + 4 * lane);
        float a0 = bflo(wq.x), a1 = bfhi(wq.x), a2 = bflo(wq.y), a3 = bfhi(wq.y);
        const float sq = wave_sum(a0 * a0 + a1 * a1 + a2 * a2 + a3 * a3);
        float m0 = bflo(wm.x), m1 = bfhi(wm.x), m2 = bflo(wm.y), m3 = bfhi(wm.y);
        const float skv = wave_sum(lane < 32 ? (m0 * m0 + m1 * m1 + m2 * m2 + m3 * m3) : 0.f);
        if (lane == 0) { RQ[tok] = rsqrtf(sq * (1.0f / 256.0f) + EPS); RKV[tok] = rsqrtf(skv * (1.0f / 128.0f) + EPS); }
        const float p0 = __shfl_xor(m0, 4), p1 = __shfl_xor(m1, 4), p2 = __shfl_xor(m2, 4), p3 = __shfl_xor(m3, 4);
        if (lane >= 32 && lane < 36) {
            const int i0 = 4 * (lane - 32);
            const f32x4 c4 = *(const f32x4*)(CS32 + (size_t)tok * 32 + i0), s4 = *(const f32x4*)(CS32 + (size_t)tok * 32 + 16 + i0);
            u32x4 w;
            w.x = pk2(m0 * c4[0] - p0 * s4[0], p0 * c4[0] + m0 * s4[0]); w.y = pk2(m1 * c4[1] - p1 * s4[1], p1 * c4[1] + m1 * s4[1]);
            w.z = pk2(m2 * c4[2] - p2 * s4[2], p2 * c4[2] + m2 * s4[2]); w.w = pk2(m3 * c4[3] - p3 * s4[3], p3 * c4[3] + m3 * s4[3]);
            *(u32x4*)(KR + (size_t)tok * 32 + 2 * i0) = w;
        }
        if (lane >= 40 && lane < 46) {
            const int gi = 4 * (lane - 40);
            *(f32x4*)(GATES + (size_t)tok * 24 + gi) = (f32x4){sigmoidf_(m0), sigmoidf_(m1), sigmoidf_(m2), sigmoidf_(m3)};
        }
    }
}
DI void phase_cmp2(const Ctx& F, int l) {
    const bf16* HID = (const bf16*)(F.ws + WS_HID);
    const float* CS64 = (const float*)(F.ws + WS_CS64);
    const int gw = F.blk * 8 + F.wave, NGW = F.G * 8, lane = F.lane;
    for (int it = gw; it < 8192; it += NGW) {
        const int kv = it >> 12, row = it & 4095, c = row & 255, bg = row >> 8;
        const float* w2 = ginp(F, kv ? I_W2V : I_W2K) + (size_t)l * 256 * 64;
        const float* b2 = ginp(F, kv ? I_B2V : I_B2K) + (size_t)l * 64;
        const u32x2 hw = *(const u32x2*)(HID + ((size_t)kv * 4096 + row) * 256 + 4 * lane);
        const float h0 = bflo(hw.x), h1 = bfhi(hw.x), h2 = bflo(hw.y), h3 = bfhi(hw.y);
        float acc = b2[lane];
#pragma unroll 4
        for (int k4 = 0; k4 < 64; ++k4) {
            const float x0 = __builtin_bit_cast(float, __builtin_amdgcn_readlane(__builtin_bit_cast(int, h0), k4));
            const float x1 = __builtin_bit_cast(float, __builtin_amdgcn_readlane(__builtin_bit_cast(int, h1), k4));
            const float x2 = __builtin_bit_cast(float, __builtin_amdgcn_readlane(__builtin_bit_cast(int, h2), k4));
            const float x3 = __builtin_bit_cast(float, __builtin_amdgcn_readlane(__builtin_bit_cast(int, h3), k4));
            acc += x0 * w2[(4 * k4 + 0) * 64 + lane] + x1 * w2[(4 * k4 + 1) * 64 + lane] + x2 * w2[(4 * k4 + 2) * 64 + lane] + x3 * w2[(4 * k4 + 3) * 64 + lane];
        }
        if (c == 255) acc = 0.f;
        if (kv == 0) {
            const int b = bg >> 1, tokr = b * S + 16 * c + 31;
            const float other = __shfl_xor(acc, 32);
            const int i = lane & 31;
            const float cs = CS64[(size_t)(tokr & (T - 1)) * 64 + i], sn = CS64[(size_t)(tokr & (T - 1)) * 64 + 32 + i];
            const float y = (lane < 32) ? (acc * cs - other * sn) : (acc * cs + other * sn);
            ((bf16*)(F.ws + WS_KC))[(size_t)row * 64 + 2 * i + (lane >> 5)] = (bf16)(pk2(y, 0.f) & 0xffffu);
        } else {
            ((bf16*)(F.ws + WS_VC))[(size_t)row * 64 + lane] = (bf16)(pk2(acc, 0.f) & 0xffffu);
        }
    }
}
DI void phase_mix(const Ctx& F, int l) {
    const bf16* OA3 = (const bf16*)(F.ws + WS_OA3); const float* LSEA = (const float*)(F.ws + WS_LSEA);
    const bf16* OCMP = (const bf16*)(F.ws + WS_OCMP); const bf16* OSLC = (const bf16*)(F.ws + WS_OSLC); const bf16* OWIN = (const bf16*)(F.ws + WS_OWIN);
    const bf16* OC = (const bf16*)(F.ws + WS_OC); const bf16* MISC = (const bf16*)(F.ws + WS_MISC);
    bf16* AMIX = (bf16*)(F.ws + WS_AMIX);
    const float* ga = ginp(F, I_GOA) + (size_t)l * 256; const float* gb = ginp(F, I_GOB) + (size_t)l * 512; const float* gc = ginp(F, I_GOC) + (size_t)l * 256;
    const int gw = F.blk * 8 + F.wave, NGW = F.G * 8, lane = F.lane, ha = lane >> 4;
    for (int tok0 = gw; tok0 < T; tok0 += 2 * NGW) {
        int tok[2]; tok[0] = tok0; tok[1] = (tok0 + NGW < T) ? tok0 + NGW : tok0;
        float ls[2][3]; u32x2 wa[2][3], wb[2][2], wc_[2];
#pragma unroll
        for (int q = 0; q < 2; ++q) {
#pragma unroll
            for (int p = 0; p < 3; ++p) { ls[q][p] = LSEA[((size_t)p * T + tok[q]) * 4 + ha]; wa[q][p] = *(const u32x2*)(OA3 + ((size_t)p * T + tok[q]) * 256 + 4 * lane); }
#pragma unroll
            for (int k = 0; k < 2; ++k) {
                const int col = 256 * k + 4 * lane;
                wb[q][k] = *(const u32x2*)(OSLC + (size_t)tok[q] * 512 + col);
            }
            wc_[q] = *(const u32x2*)(OC + (size_t)tok[q] * 256 + 4 * lane);
        }
        f32x4 va[2], vb[2][2], vc[2]; float red[2][3];
#pragma unroll
        for (int q = 0; q < 2; ++q) {
            const float mx = fmaxf(ls[q][0], fmaxf(ls[q][1], ls[q][2]));
            const float w0 = fast_exp2(ls[q][0] - mx), w1 = fast_exp2(ls[q][1] - mx), w2 = fast_exp2(ls[q][2] - mx), wi = 1.0f / (w0 + w1 + w2);
            va[q] = ((f32x4){bflo(wa[q][0].x), bfhi(wa[q][0].x), bflo(wa[q][0].y), bfhi(wa[q][0].y)} * w0 + (f32x4){bflo(wa[q][1].x), bfhi(wa[q][1].x), bflo(wa[q][1].y), bfhi(wa[q][1].y)} * w1
                   + (f32x4){bflo(wa[q][2].x), bfhi(wa[q][2].x), bflo(wa[q][2].y), bfhi(wa[q][2].y)} * w2) * wi;
            red[q][0] = va[q][0] * va[q][0] + va[q][1] * va[q][1] + va[q][2] * va[q][2] + va[q][3] * va[q][3];
            float sb = 0.f;
#pragma unroll
            for (int k = 0; k < 2; ++k) {
                const u32x2 a = wb[q][k];
                vb[q][k][0] = bflo(a.x); vb[q][k][1] = bfhi(a.x); vb[q][k][2] = bflo(a.y); vb[q][k][3] = bfhi(a.y);
                sb += vb[q][k][0] * vb[q][k][0] + vb[q][k][1] * vb[q][k][1] + vb[q][k][2] * vb[q][k][2] + vb[q][k][3] * vb[q][k][3];
            }
            red[q][1] = sb;
            vc[q] = (f32x4){bflo(wc_[q].x), bfhi(wc_[q].x), bflo(wc_[q].y), bfhi(wc_[q].y)};
            red[q][2] = vc[q][0] * vc[q][0] + vc[q][1] * vc[q][1] + vc[q][2] * vc[q][2] + vc[q][3] * vc[q][3];
        }
#pragma unroll
        for (int q = 0; q < 2; ++q)
#pragma unroll
            for (int j = 0; j < 3; ++j) red[q][j] = wave_sum(red[q][j]);
#pragma unroll
        for (int q = 0; q < 2; ++q) {
            if (q == 1 && tok0 + NGW >= T) break;
            const float ra = rsqrtf(red[q][0] * (1.0f / 256.0f) + EPS), rb = rsqrtf(red[q][1] * (1.0f / 512.0f) + EPS), rc = rsqrtf(red[q][2] * (1.0f / 256.0f) + EPS);
            bf16* orow = AMIX + (size_t)tok[q] * 1024;
            { const f32x4 o = va[q] * ra * *(const f32x4*)(ga + 4 * lane); u32x2 w; w.x = pk2(o[0], o[1]); w.y = pk2(o[2], o[3]); *(u32x2*)(orow + 4 * lane) = w; }
#pragma unroll
            for (int k = 0; k < 2; ++k) { const f32x4 o = vb[q][k] * rb * *(const f32x4*)(gb + 256 * k + 4 * lane); u32x2 w; w.x = pk2(o[0], o[1]); w.y = pk2(o[2], o[3]); *(u32x2*)(orow + 256 + 256 * k + 4 * lane) = w; }
            { const f32x4 o = vc[q] * rc * *(const f32x4*)(gc + 4 * lane); u32x2 w; w.x = pk2(o[0], o[1]); w.y = pk2(o[2], o[3]); *(u32x2*)(orow + 768 + 4 * lane) = w; }
        }
    }
}
DI void phase_router(const Ctx& F, int l) {
    LAS unsigned char* WH = F.lds; LAS unsigned char* WL = F.lds + 65536;
    LAS float* biasp = (LAS float*)(F.lds + AUX_OFF); LAS float* RS = biasp + 32;
    LAS int* lcnt = (LAS int*)(F.lds + AUX_OFF + 1024); LAS int* gbase = lcnt + 32;
    LAS int* tokE = gbase + 32; LAS float* tokG = (LAS float*)(tokE + 512); LAS int* tokP = (LAS int*)(tokG + 512);
    const float* wr = ginp(F, I_WR) + (size_t)l * 1024 * 32; const float* br = ginp(F, I_BR) + (size_t)l * 32;
    const float* mods = (const float*)(F.ws + WS_MODS); const bf16* X = (const bf16*)(F.ws + WS_X); bf16* H = (bf16*)(F.ws + F.dofs + WS_H);
    const float* g2 = ginp(F, I_G2) + (size_t)l * 1024;
    const int tid = F.tid, lane = F.lane, w = F.wave;
    if (tid < 32) lcnt[tid] = 0;
    unsigned* CNT = (unsigned*)(F.ws + WS_CTL) + CW_CNT + (l + F.dcnt) * 32 * 64;
    for (int chunk = F.blk; chunk < T / 128; chunk += F.G) {
        const int b = (chunk * 128) >> 12;
        const float* sh = mods + ((size_t)(l * 8 + b) * 6 + 3) * 1024; const float* sc = sh + 1024;
        {
            float bacc = 0.f; const int e = tid & 31;
#pragma unroll 4
            for (int it = 0; it < 32; ++it) {
                const int k = 2 * ((tid + 512 * it) >> 5);
                const float w0 = wr[k * 32 + e], w1 = wr[(k + 1) * 32 + e];
                const float p0 = w0 * (g2[k] * (sc[k] + 1.0f)), p1 = w1 * (g2[k + 1] * (sc[k + 1] + 1.0f));
                bacc += sh[k] * w0 + sh[k + 1] * w1;
                const unsigned hi = pk2(p0, p1);
                const unsigned lo = pk2(p0 - bflo(hi), p1 - bfhi(hi));
                const int off = e * 2048 + ((((k >> 3) ^ e) << 4) | ((k & 7) * 2));
                *(LAS unsigned*)(WH + off) = hi; *(LAS unsigned*)(WL + off) = lo;
            }
            tokG[tid] = bacc;
        }
        __syncthreads();
        if (tid < 32) { float s_ = br[tid];
#pragma unroll
            for (int j = 0; j < 16; ++j) s_ += tokG[tid + 32 * j];
            biasp[tid] = s_; }
        {
            u32x2 ra[4], rb[4];
            f32x4 ggv[4], hhv[4];
#pragma unroll
            for (int k = 0; k < 4; ++k) { const int c = 4 * lane + 256 * k; ggv[k] = *(const f32x4*)(g2 + c) * (*(const f32x4*)(sc + c) + 1.0f); hhv[k] = *(const f32x4*)(sh + c); }
            { const bf16* x0 = X + (size_t)(chunk * 128 + w * 16) * 1024 + 4 * lane;
#pragma unroll
              for (int k = 0; k < 4; ++k) { ra[k] = *(const u32x2*)(x0 + 256 * k); rb[k] = *(const u32x2*)(x0 + 1024 + 256 * k); } }
#pragma unroll 1
            for (int tt = 0; tt < 8; ++tt) {
                const int tl0 = w * 16 + 2 * tt, tok0 = chunk * 128 + tl0;
                f32x4 v[2][4]; float ss0 = 0.f, ss1 = 0.f;
#pragma unroll
                for (int k = 0; k < 4; ++k) { v[0][k] = (f32x4){bflo(ra[k].x), bfhi(ra[k].x), bflo(ra[k].y), bfhi(ra[k].y)}; v[1][k] = (f32x4){bflo(rb[k].x), bfhi(rb[k].x), bflo(rb[k].y), bfhi(rb[k].y)}; }
                { const int tn = (tt < 7) ? tok0 + 2 : tok0; const bf16* x0 = X + (size_t)tn * 1024 + 4 * lane;
#pragma unroll
                  for (int k = 0; k < 4; ++k) { ra[k] = *(const u32x2*)(x0 + 256 * k); rb[k] = *(const u32x2*)(x0 + 1024 + 256 * k); } }
#pragma unroll
                for (int k = 0; k < 4; ++k) { ss0 += v[0][k][0] * v[0][k][0] + v[0][k][1] * v[0][k][1] + v[0][k][2] * v[0][k][2] + v[0][k][3] * v[0][k][3];
                                              ss1 += v[1][k][0] * v[1][k][0] + v[1][k][1] * v[1][k][1] + v[1][k][2] * v[1][k][2] + v[1][k][3] * v[1][k][3]; }
                ss0 = wave_sum(ss0); ss1 = wave_sum(ss1);
                const float rs0 = rsqrtf(ss0 * (1.0f / 1024.0f) + EPS), rs1 = rsqrtf(ss1 * (1.0f / 1024.0f) + EPS);
                if (lane == 0) { RS[tl0] = rs0; RS[tl0 + 1] = rs1; }
#pragma unroll
                for (int k = 0; k < 4; ++k) {
                    const int c = 4 * lane + 256 * k;
                    v[0][k] = v[0][k] * rs0 * ggv[k] + hhv[k]; v[1][k] = v[1][k] * rs1 * ggv[k] + hhv[k];
                    *(unsigned*)((unsigned char*)H + (size_t)tok0 * 1024 + c) = pk4_fp8s(v[0][k][0], v[0][k][1], v[0][k][2], v[0][k][3], H8_SCALE);
                    *(unsigned*)((unsigned char*)H + (size_t)(tok0 + 1) * 1024 + c) = pk4_fp8s(v[1][k][0], v[1][k][1], v[1][k][2], v[1][k][3], H8_SCALE);
                }
            }
        }
        __syncthreads();
        f32x4 acc[2] = {{0.f, 0.f, 0.f, 0.f}, {0.f, 0.f, 0.f, 0.f}};
        {
            const int kg = lane >> 4, n16 = lane & 15;
            const bf16* xr = X + (size_t)(chunk * 128 + w * 16 + n16) * 1024 + 8 * kg;
#pragma unroll 1
            for (int k8 = 0; k8 < 4; ++k8) {
                bf16x8 af[8];
#pragma unroll
                for (int j = 0; j < 8; ++j) af[j] = *(const bf16x8*)(xr + 32 * (8 * k8 + j));
#pragma unroll
                for (int j = 0; j < 8; ++j) {
                    const int c = 4 * (8 * k8 + j) + kg;
#pragma unroll
                    for (int et = 0; et < 2; ++et) {
                        const int e = 16 * et + n16, off = e * 2048 + ((c ^ e) << 4);
                        const bf16x8 bh = *(const LAS bf16x8*)(WH + off), bl = *(const LAS bf16x8*)(WL + off);
                        acc[et] = __builtin_amdgcn_mfma_f32_16x16x32_bf16(af[j], bh, acc[et], 0, 0, 0);
                        acc[et] = __builtin_amdgcn_mfma_f32_16x16x32_bf16(af[j], bl, acc[et], 0, 0, 0);
                    }
                }
            }
        }
        __syncthreads();
        LAS float* LG = (LAS float*)(F.lds + w * 2048);
        {
            const int g4 = lane >> 4, n16 = lane & 15;
#pragma unroll
            for (int et = 0; et < 2; ++et)
#pragma unroll
                for (int i = 0; i < 4; ++i) LG[(4 * g4 + i) * 32 + 16 * et + n16] = acc[et][i] * RS[w * 16 + 4 * g4 + i] + biasp[16 * et + n16];
        }
        asm volatile("s_waitcnt lgkmcnt(0)" ::: "memory");
#pragma unroll 1
        for (int tt = 0; tt < 8; ++tt) {
            const int tl0 = w * 16 + 2 * tt;
            const float lg0 = LG[(2 * tt) * 32 + (lane >> 1)], lg1 = LG[(2 * tt + 1) * 32 + (lane >> 1)];
            int rk0 = 0, rk1 = 0; const int me = lane >> 1;
#pragma unroll
            for (int e = 0; e < 32; ++e) {
                const float o0 = __builtin_bit_cast(float, __builtin_amdgcn_readlane(__builtin_bit_cast(int, lg0), 2 * e));
                const float o1 = __builtin_bit_cast(float, __builtin_amdgcn_readlane(__builtin_bit_cast(int, lg1), 2 * e));
                rk0 += ((o0 > lg0) || (o0 == lg0 && e < me)) ? 1 : 0; rk1 += ((o1 > lg1) || (o1 == lg1 && e < me)) ? 1 : 0;
            }
#pragma unroll
            for (int tk = 0; tk < 2; ++tk) {
                const int rk = tk ? rk1 : rk0; const float lg = tk ? lg1 : lg0;
                int te[4]; float tv[4];
#pragma unroll
                for (int r = 0; r < 4; ++r) {
                    const u64 mk = __ballot(rk == r && (lane & 1) == 0);
                    const int sl = __builtin_amdgcn_readfirstlane((int)__builtin_ctzll(mk));
                    te[r] = sl >> 1; tv[r] = __builtin_bit_cast(float, __builtin_amdgcn_readlane(__builtin_bit_cast(int, lg), sl));
                }
                const float e1 = __expf(tv[1] - tv[0]), e2 = __expf(tv[2] - tv[0]), e3 = __expf(tv[3] - tv[0]);
                const float isum = 1.0f / (1.0f + e1 + e2 + e3);
                if (lane < 4) {
                    const int tl = tl0 + tk;
                    const int e = lane == 0 ? te[0] : lane == 1 ? te[1] : lane == 2 ? te[2] : te[3];
                    const float gte = (lane == 0 ? 1.0f : lane == 1 ? e1 : lane == 2 ? e2 : e3) * isum;
                    const int pos = atomicAdd((int*)(lcnt + e), 1);
                    tokE[tl * 4 + lane] = e; tokG[tl * 4 + lane] = gte; tokP[tl * 4 + lane] = pos;
                }
            }
        }
        __syncthreads();
        if (tid < 32) gbase[tid] = (int)__hip_atomic_fetch_add(CNT + tid * 64, (unsigned)lcnt[tid], RLX_AGENT);
        __syncthreads();
        {
            const int tl = tid >> 2, r = tid & 3, e = tokE[tid], pos = gbase[e] + tokP[tid], tok = chunk * 128 + tl;
            ((int*)(F.ws + F.dofs + WS_IDX))[(size_t)e * ECAP + pos] = tok;
            ((float*)(F.ws + F.dofs + WS_TOKG))[(size_t)tok * 4 + r] = tokG[tid];
            ((int*)(F.ws + F.dofs + WS_TOKSLOT))[(size_t)tok * 4 + r] = (e << 16) | pos;
        }
        __syncthreads();
        if (tid < 32) lcnt[tid] = 0;
        __syncthreads();
    }
}

DI int ropeperm64(int p) { return (p >> 1) + 32 * (p & 1); }
DI int cmap_win(int n) {
    const int tile = n >> 8, w = n & 255, hb = w & ~63, pp = ropeperm64(w & 63);
    switch (tile) {
        case 0: return hb + pp;
        case 1: return 256 + hb + pp;
        case 2: return 512 + w;
        case 3: return 768 + hb + pp;
        case 4: return 1024 + hb + pp;
        case 5: return w < 128 ? 1280 + w : 1408 + (w - 128);
        case 6: return w < 128 ? 1536 + hb + pp : 1664 + (w - 128);
        case 7: return w < 128 ? 1792 + hb + pp : 1920 + (w - 128);
        case 8: return 2072 + w;
        default: return w < 128 ? 2328 + w : (w < 160 ? 2456 + ((w - 128) >> 1) + 16 * ((w - 128) & 1) : (w < 184 ? 2048 + (w - 160) : -1));
    }
}
DI int cmap_qup(int n) { if (n >= 384) return -1; const int h = n / 96, w = n % 96; if (w < 64) return h * 96 + w; const int j = w - 64; return h * 96 + 64 + (j >> 1) + 16 * (j & 1); }
DI void tr_tile(const float* src, int K, int Nsrc, bf16* dst, int Kdst, int maptype, const float* ksc, int ntile, int ktile, LAS float* scr, int tid) {
    const int n0 = ntile * 64, k0 = ktile * 128, nl = tid & 63, n = n0 + nl;
    const int c = maptype == 0 ? (n < Nsrc ? n : -1) : (maptype == 1 ? cmap_win(n) : cmap_qup(n));
    float v[16];
#pragma unroll
    for (int it = 0; it < 16; ++it) { const int k = k0 + (tid >> 6) + 8 * it; v[it] = (c >= 0 && k < K) ? src[(size_t)k * Nsrc + c] * (ksc ? ksc[k] : 1.0f) : 0.f; }
#pragma unroll
    for (int it = 0; it < 16; ++it) scr[((tid >> 6) + 8 * it) * 65 + nl] = v[it];
    __syncthreads();
#pragma unroll
    for (int it = 0; it < 2; ++it) {
        const int idx = tid + 512 * it, nn = idx >> 4, ch = idx & 15;
        const LAS float* s = scr + (8 * ch) * 65 + nn;
        u32x4 o; o.x = pk2(s[0], s[65]); o.y = pk2(s[2 * 65], s[3 * 65]); o.z = pk2(s[4 * 65], s[5 * 65]); o.w = pk2(s[6 * 65], s[7 * 65]);
        *(u32x4*)(dst + (size_t)(n0 + nn) * Kdst + k0 + 8 * ch) = o;
    }
    __syncthreads();
}
DI void trb_load(f32x4 (&v)[16], const float* src, int N, int n0, int k0, int tid) {
#pragma unroll
    for (int it = 0; it < 16; ++it) v[it] = *(const f32x4*)(src + (size_t)(k0 + (tid >> 6) + 8 * it) * N + n0 + 4 * (tid & 63));
}
DI void trb_store(const f32x4 (&v)[16], bf16* dst, int Kd, int n0, int k0, LAS unsigned char* L, int tid, int wave, int lane, int f8 = 0) {
#pragma unroll
    for (int it = 0; it < 16; ++it) { f32x4 x = v[it];
        if (f8) { x[0] = q8s(x[0], W8_SCALE); x[1] = q8s(x[1], W8_SCALE); x[2] = q8s(x[2], W8_SCALE); x[3] = q8s(x[3], W8_SCALE); }
        u32x2 w; w.x = pk2(x[0], x[1]); w.y = pk2(x[2], x[3]); *(LAS u32x2*)(L + ((tid >> 6) + 8 * it) * 576 + (tid & 63) * 8) = w; }
    asm volatile("s_waitcnt lgkmcnt(0)\n\ts_barrier" ::: "memory");
    const int i = lane & 15, gn = (lane >> 4) & 1, h = lane >> 5, q = i >> 2, p = i & 3;
    const LAS unsigned char* base = L + (8 * h + q) * 576 + (32 * wave + 16 * gn) * 2 + 8 * p;
    if (!f8) {
        bf16* drow = dst + (size_t)(n0 + 32 * wave + 16 * gn + i) * Kd + k0 + 8 * h;
#pragma unroll
        for (int kcp = 0; kcp < 8; ++kcp) {
            const s16x4 lo = tr_read(base + (16 * kcp) * 576), hi = tr_read(base + (16 * kcp + 4) * 576);
            *(bf16x8*)(drow + 16 * kcp) = __builtin_shufflevector(lo, hi, 0, 1, 2, 3, 4, 5, 6, 7);
        }
    } else {
        unsigned char* drow = (unsigned char*)dst + (size_t)(n0 + 32 * wave + 16 * gn + i) * Kd + k0 + 8 * h;
#pragma unroll
        for (int kcp = 0; kcp < 8; ++kcp) {
            const s16x4 lo = tr_read(base + (16 * kcp) * 576), hi = tr_read(base + (16 * kcp + 4) * 576);
            int w0 = __builtin_amdgcn_cvt_pk_fp8_f32(bf2f((unsigned short)lo[0]), bf2f((unsigned short)lo[1]), 0, false); w0 = __builtin_amdgcn_cvt_pk_fp8_f32(bf2f((unsigned short)lo[2]), bf2f((unsigned short)lo[3]), w0, true);
            int w1 = __builtin_amdgcn_cvt_pk_fp8_f32(bf2f((unsigned short)hi[0]), bf2f((unsigned short)hi[1]), 0, false); w1 = __builtin_amdgcn_cvt_pk_fp8_f32(bf2f((unsigned short)hi[2]), bf2f((unsigned short)hi[3]), w1, true);
            u32x2 o; o.x = (unsigned)w0; o.y = (unsigned)w1;
            *(u32x2*)(drow + 16 * kcp) = o;
        }
    }
    asm volatile("s_waitcnt lgkmcnt(0)\n\ts_barrier" ::: "memory");
}
struct TrbItem { const float* src; bf16* dst; int N, n0, k0, f8; };
DI TrbItem trb_item(const Ctx& F, int it) {
    const int le = it / 96, r = it % 96; TrbItem t;
    if (r < 64) { t.src = ginp(F, I_WE1) + (size_t)le * 1024 * 2048; t.dst = (bf16*)(F.ws + WS_W1E + (size_t)le * 2048 * 1024); t.N = 2048; t.n0 = (r & 7) * 256; t.k0 = (r >> 3) * 128; t.f8 = 1; }
    else { const int q = r - 64; t.src = ginp(F, I_WE2) + (size_t)le * 1024 * 1024; t.dst = (bf16*)(F.ws + WS_W2E + (size_t)le * 1024 * 1024); t.N = 1024; t.n0 = (q & 3) * 256; t.k0 = (q >> 2) * 128; t.f8 = 1; }
    return t;
}
DI void conv_layer_tiles(const Ctx& F, int l, int q0, int i0, int cnt) {
    const int NL = 32 * 96;
    int it = q0 + F.blk + F.G * i0; const int end = q0 + F.blk + F.G * (i0 + cnt);
    if (it >= NL) return;
    f32x4 va[16];
    TrbItem ta = trb_item(F, l * NL + it);
    trb_load(va, ta.src, ta.N, ta.n0, ta.k0, F.tid);
#pragma unroll 1
    while (it < NL && it < end) {
        f32x4 vb[16];
#pragma unroll
        for (int k = 0; k < 16; ++k) vb[k] = va[k];
        const TrbItem tc = ta;
        it += F.G;
        const bool more = (it < NL && it < end);
        ta = trb_item(F, l * NL + (more ? it : 0));
        if (more) trb_load(va, ta.src, ta.N, ta.n0, ta.k0, F.tid);
        trb_store(vb, tc.dst, 1024, tc.n0, tc.k0, F.lds, F.tid, F.wave, F.lane, tc.f8);
    }
}
DI void conv_claim_tiles(const Ctx& F, int l, int quota) {
    const int NL = 32 * 96;
    volatile LAS unsigned* slot = (volatile LAS unsigned*)(F.lds + MISC_OFF) + 16;
    __syncthreads();
    if (F.tid == 0) { unsigned* q = (unsigned*)(F.ws + WS_CTL) + CW_CONVQ + l * 64; slot[0] = __hip_atomic_fetch_add(q, (unsigned)quota, __ATOMIC_RELAXED, __HIP_MEMORY_SCOPE_AGENT); }
    __syncthreads();
    int it = __builtin_amdgcn_readfirstlane((int)slot[0]); const int end = it + quota;
    if (it >= NL) return;
    f32x4 va[16];
    TrbItem ta = trb_item(F, l * NL + it);
    trb_load(va, ta.src, ta.N, ta.n0, ta.k0, F.tid);
#pragma unroll 1
    while (it < NL && it < end) {
        f32x4 vb[16];
#pragma unroll
        for (int k = 0; k < 16; ++k) vb[k] = va[k];
        const TrbItem tc = ta;
        it += 1;
        const bool more = (it < NL && it < end);
        ta = trb_item(F, l * NL + (more ? it : 0));
        if (more) trb_load(va, ta.src, ta.N, ta.n0, ta.k0, F.tid);
        trb_store(vb, tc.dst, 1024, tc.n0, tc.k0, F.lds, F.tid, F.wave, F.lane, tc.f8);
    }
}
DI void phase_prologue(const Ctx& F) {
    const Args& A = *F.a; const int tid = F.tid;
    LAS float* scr = (LAS float*)F.lds;
    if (!CONV_IN_LAYER) {
        const int NIT = DEPTH * 32 * 96;
        f32x4 va[16];
        int it = F.blk;
        TrbItem ta = trb_item(F, it < NIT ? it : 0);
        if (it < NIT) trb_load(va, ta.src, ta.N, ta.n0, ta.k0, tid);
#pragma unroll 1
        while (it < NIT) {
            f32x4 vb[16];
#pragma unroll
            for (int k = 0; k < 16; ++k) vb[k] = va[k];
            const TrbItem tc = ta;
            it += F.G;
            ta = trb_item(F, it < NIT ? it : 0);
            if (it < NIT) trb_load(va, ta.src, ta.N, ta.n0, ta.k0, tid);
            trb_store(vb, tc.dst, 1024, tc.n0, tc.k0, F.lds, tid, F.wave, F.lane, tc.f8);
        }
    }
    constexpr int PER_L = 8192 + 4096 + 320 + 128 + 128 + 16 + 16;
    for (int it = F.blk; it < DEPTH * PER_L; it += F.G) {
        const int l = it / PER_L; int r = it % PER_L;
        if (r < 8192 + 4096) continue;
        if (r < 8192) { const int e = r >> 8, t = r & 255;
            tr_tile(ginp(F, I_WE1) + ((size_t)(l * 32 + e)) * 1024 * 2048, 1024, 2048, (bf16*)(F.ws + WS_W1E) + ((size_t)(l * 32 + e)) * 2048 * 1024, 1024, 0, nullptr, t >> 3, t & 7, scr, tid); continue; }
        r -= 8192;
        if (r < 4096) { const int e = r >> 7, t = r & 127;
            tr_tile(ginp(F, I_WE2) + ((size_t)(l * 32 + e)) * 1024 * 1024, 1024, 1024, (bf16*)(F.ws + WS_W2E) + ((size_t)(l * 32 + e)) * 1024 * 1024, 1024, 0, nullptr, t >> 3, t & 7, scr, tid); continue; }
        r -= 4096;
        if (r < 320) { tr_tile(ginp(F, I_WIN) + (size_t)l * 1024 * 2488, 1024, 2488, (bf16*)(F.ws + WS_WIN) + (size_t)l * NIN * 1024, 1024, 1, nullptr, r >> 3, r & 7, scr, tid); continue; }
        r -= 320;
        if (r < 128) { tr_tile(ginp(F, I_WOUT) + (size_t)l * 1024 * 1024, 1024, 1024, (bf16*)(F.ws + WS_WOUT) + (size_t)l * 1024 * 1024, 1024, 0, nullptr, r >> 3, r & 7, scr, tid); continue; }
        r -= 128;
        if (r < 128) { const int kv = r >> 6, t = r & 63;
            tr_tile(ginp(F, kv ? I_W1V : I_W1K) + (size_t)l * 2048 * 256, 2048, 256, (bf16*)(F.ws + WS_NSAW1) + ((size_t)(l * 2 + kv)) * 256 * 2048, 2048, 0, nullptr, t >> 4, t & 15, scr, tid); continue; }
        r -= 128;
        if (r < 16) { tr_tile(ginp(F, I_WQUP) + (size_t)l * 256 * 384, 256, 384, (bf16*)(F.ws + WS_MLAQ) + (size_t)l * 512 * 256, 256, 2, ginp(F, I_GQ) + (size_t)l * 256, r >> 1, r & 1, scr, tid); continue; }
        r -= 16;
        tr_tile(ginp(F, I_WKVUP) + (size_t)l * 128 * 512, 128, 512, (bf16*)(F.ws + WS_MLAKV) + (size_t)l * 512 * 256, 256, 0, ginp(F, I_GKV) + (size_t)l * 128, r >> 1, r & 1, scr, tid);
    }
    for (int it = F.blk; it < DEPTH * 4; it += F.G) {
        const int l = it >> 2, kv = (it >> 1) & 1, kt = it & 1;
        tr_tile(ginp(F, kv ? I_W2V : I_W2K) + (size_t)l * 256 * 64, 256, 64, (bf16*)(F.ws + WS_W2T) + ((size_t)(l * 2 + kv)) * 64 * 256, 256, 0, nullptr, 0, kt, scr, tid);
    }
    {
        float* CS64 = (float*)(F.ws + WS_CS64); float* CS32 = (float*)(F.ws + WS_CS32);
        const int* pos = (const int*)ginp(F, I_POS);
        for (int idx = F.blk * 512 + tid; idx < T * 48; idx += F.G * 512) {
            const int tok = idx / 48, i = idx % 48;
            const double p = (double)pos[tok];
            const double inv = (i < 32) ? exp2(-(double)i * (13.287712379549449 / 32.0)) : exp2(-(double)(i - 32) * (13.287712379549449 / 16.0));
            double ang = p * inv;
            const double kk = __builtin_rint(ang * 0.15915494309189535);
            ang = ang - kk * 6.283185307179586;
            const float af = (float)ang;
            const float cs = __cosf(af), sn = __sinf(af);
            if (i < 32) { CS64[(size_t)tok * 64 + i] = cs; CS64[(size_t)tok * 64 + 32 + i] = sn; }
            else { CS32[(size_t)tok * 32 + (i - 32)] = cs; CS32[(size_t)tok * 32 + 16 + (i - 32)] = sn; }
        }
    }
    for (int item = F.blk; item < 32; item += F.G) {
        const int lk = item >> 2, l = lk >> 1, kv = lk & 1, col = (item & 3) * 64 + F.lane;
        const float* w1 = ginp(F, kv ? I_W1V : I_W1K) + (size_t)l * 2048 * 256 + col; const float* pe = ginp(F, kv ? I_POSV : I_POSK) + (size_t)l * 2048;
        float s = 0.f;
#pragma unroll 1
        for (int kb = 256 * F.wave; kb < 256 * F.wave + 256; kb += 16) {
            float wv[16];
#pragma unroll
            for (int j = 0; j < 16; ++j) wv[j] = w1[(size_t)(kb + j) * 256];
#pragma unroll
            for (int j = 0; j < 16; ++j) s += pe[kb + j] * wv[j];
        }
        scr[F.wave * 64 + F.lane] = s;
        __syncthreads();
        if (tid < 64) { float t = ginp(F, kv ? I_B1V : I_B1K)[(size_t)l * 256 + col];
#pragma unroll
            for (int ww = 0; ww < 8; ++ww) t += scr[ww * 64 + tid];
            ((float*)(F.ws + WS_B1P))[(size_t)lk * 256 + col] = t; }
        __syncthreads();
    }
    {
        LAS float* sc = scr; LAS float* red = scr + 8192;
        for (int i = tid; i < 8192; i += 512) { const float c = ginp(F, I_C)[i]; sc[i] = c * sigmoidf_(c); }
        __syncthreads();
        float* MODS = (float*)(F.ws + WS_MODS);
        const int lane = F.lane, w = F.wave;
        for (int item = F.blk; item < 384; item += F.G) {
            const int l = item / 96, col = (item % 96) * 64 + lane;
            float acc[8];
#pragma unroll
            for (int b = 0; b < 8; ++b) acc[b] = 0.f;
            const float* wa = ginp(F, I_WADA) + (size_t)l * 1024 * 6144 + col;
#pragma unroll 1
            for (int kb = 128 * w; kb < 128 * w + 128; kb += 16) {
                float wv[16];
#pragma unroll
                for (int j = 0; j < 16; ++j) wv[j] = wa[(size_t)(kb + j) * 6144];
#pragma unroll
                for (int j = 0; j < 16; ++j) {
#pragma unroll
                    for (int b = 0; b < 8; ++b) acc[b] += sc[b * 1024 + kb + j] * wv[j]; }
            }
#pragma unroll
            for (int b = 0; b < 8; ++b) red[(w * 8 + b) * 64 + lane] = acc[b];
            __syncthreads();
            { const int b = tid >> 6; float s = ginp(F, I_BADA)[(size_t)l * 6144 + col];
#pragma unroll
              for (int ww = 0; ww < 8; ++ww) s += red[(ww * 8 + b) * 64 + lane];
              MODS[((size_t)(l * 8 + b)) * 6144 + col] = s; }
            __syncthreads();
        }
    }
}

constexpr int PH_PER_LAYER = 11;
constexpr int N_PHASES = 1 + DEPTH * PH_PER_LAYER + 1;

__global__ void __launch_bounds__(512, 2) fwd_kernel(Args args) {
    extern __shared__ __attribute__((aligned(16))) unsigned char lds_raw[];
    Ctx F;
    F.lds = (LAS unsigned char*)lds_raw; F.a = &args; F.ws = args.ws;
    F.dofs = 0; F.dcnt = 0;
    F.tid = threadIdx.x; F.lane = F.tid & 63; F.wave = __builtin_amdgcn_readfirstlane(F.tid >> 6); F.blk = blockIdx.x; F.G = gridDim.x; F.vcu = F.blk;
    volatile LAS unsigned* MISC = (volatile LAS unsigned*)(F.lds + MISC_OFF);
    for (int u = F.tid; u < (LDS_BYTES - MISC_OFF) / 4; u += 512) MISC[u] = 0u;
    __syncthreads();
    unsigned* ctl = (unsigned*)(F.ws + WS_CTL);
    XcdBarrier bar; bar.bar = ctl + CW_BAR; bar.x = 0; bar.st = nullptr;
    if (!MK_PER_PHASE) bar = xcd_barrier_post(ctl + CW_BAR, MISC + 8);
    const int lo = args.ph_lo, hi = args.ph_hi;
#define IN(k) (lo <= (k) && (k) < hi)
#define SEAM(k) do { if (IN(k) && IN((k) + 1)) xcd_barrier(bar); } while (0)
    unsigned char* ws = F.ws;
#define PHASE_BEGIN() do { int t_ = threadIdx.x; asm volatile("" : "+v"(t_)); F.tid = t_; F.lane = t_ & 63; F.wave = __builtin_amdgcn_readfirstlane(t_ >> 6); \
        GAS unsigned char* w_ = (GAS unsigned char*)args.ws; asm volatile("" : "+s"(w_)); F.ws = (unsigned char*)w_; ws = (unsigned char*)w_; int b_ = blockIdx.x; asm volatile("" : "+s"(b_)); F.blk = b_; F.vcu = (F.G % 8 == 0) ? (b_ % 8) * (F.G / 8) + b_ / 8 : b_; } while (0)

    if (PHON(0) && IN(0)) _Pragma("unroll 1") for (int rep_ = 0; rep_ < NREP(0); ++rep_) { PHASE_BEGIN(); phase_prologue(F); }
    SEAM(0);
#pragma unroll 1
    for (int l = 0; l < DEPTH; ++l) {
        const int P = 1 + l * PH_PER_LAYER;
        if (PHON(1) && IN(P + 0)) _Pragma("unroll 1") for (int rep_ = 0; rep_ < (DUM(1) ? 2 : 1); ++rep_) { PHASE_BEGIN(); F.dofs = (DUM(1) && rep_ == 0) ? WS_END : 0; phase_norm1<0>(F, l); }
        SEAM(P + 0);
        if (PHON(2) && IN(P + 1)) _Pragma("unroll 1") for (int rep_ = 0; rep_ < NREP(2); ++rep_) { PHASE_BEGIN();
            SchedGrid Sg{(const char*)(ws + WS_H), (const char*)(ws + WS_WIN) + (size_t)l * NIN * 1024 * 2, 1024, 1024, NIN / 256, (T / 256) * (NIN / 256), F.G, F.vcu};
            EpiWin E{ws, (const float*)(ws + WS_CS64), (const float*)(ws + WS_CS32)};
            pg8::gemm_phase<EpiWin, SchedGrid, false>(F.lds, 1024, 1024, Sg, E);
        }
        SEAM(P + 1);
        if (PHON(3) && IN(P + 2)) _Pragma("unroll 1") for (int rep_ = 0; rep_ < NREP(3); ++rep_) { PHASE_BEGIN();
            if (PHON(13)) {
                SchedCmp Sc{(const char*)(ws + WS_KCMP), (const char*)(ws + WS_VCMP), (const char*)(ws + WS_NSAW1) + (size_t)l * 2 * 256 * 2048 * 2, F.G, F.blk};
                EpiCmp E{(const float*)(ws + WS_B1P) + (size_t)l * 512, (const bf16*)(ws + WS_W2T) + (size_t)l * 2 * 64 * 256, ginp(F, I_B2K) + (size_t)l * 64, ginp(F, I_B2V) + (size_t)l * 64,
                         (bf16*)(ws + WS_KC), (bf16*)(ws + WS_VC), (const float*)(ws + WS_CS64)};
                pg8::gemm_phase<EpiCmp, SchedCmp, false>(F.lds, 1024, 2048, Sc, E);
            }
            PHASE_BEGIN();
            if (PHON(18)) {
                SchedMla Sm{(const char*)(ws + WS_CQ), (const char*)(ws + WS_MISC), (const char*)(ws + WS_MLAQ) + (size_t)l * 512 * 256 * 2, (const char*)(ws + WS_MLAKV) + (size_t)l * 512 * 256 * 2, F.G, F.vcu};
                EpiMla E{(bf16*)(ws + WS_QM), (bf16*)(ws + WS_KN), (bf16*)(ws + WS_VM), (const bf16*)(ws + WS_CQ), (const bf16*)(ws + WS_MISC), (const float*)(ws + WS_CS32)};
                pg8::gemm_phase<EpiMla, SchedMla, false>(F.lds, 256, 256, Sm, E);
            }
            PHASE_BEGIN();
            if (PHON(15)) {
                unsigned* qw = (unsigned*)(ws + WS_CTL) + CW_QUEUE + (l * 2 + rep_) * 64;
                volatile LAS int* qslot = (volatile LAS int*)(F.lds + AUX_OFF + 512);
                int nxt_t = 0;
                if (F.tid == 0) nxt_t = (int)__hip_atomic_fetch_add(qw, 1u, RLX_AGENT);
                for (;;) {
                    if (F.tid == 0) { qslot[0] = nxt_t; nxt_t = (int)__hip_atomic_fetch_add(qw, 1u, RLX_AGENT); }
                    __syncthreads();
                    const int uq = qslot[0];
                    __syncthreads();
                    if (uq >= 2560) break;
                    if (uq < 1024) {
                        const int u = uq;
                        PolB pb; pb.Q = (const bf16*)(ws + WS_QB); pb.K = (const bf16*)(ws + WS_KWIN); pb.V = (const bf16*)(ws + WS_VWIN); pb.O = (bf16*)(ws + WS_OWIN);
                        pb.b = u >> 7; pb.g = (u >> 6) & 1; pb.qc = 63 - (u & 63); pb.maxd = 511u; pb.j0 = pb.qc > 8 ? pb.qc - 8 : 0; pb.j1 = pb.qc + 1;
                        attn_unit<64, PolB, false>(pb, F.lds, F.tid, F.lane, F.wave, 0ull);
                    } else {
                        const int uu = uq - 1024;
                        const int bh = uu / 48, w48 = uu % 48, p = w48 >> 4, s16 = w48 & 15;
                        PolA pa; pa.Q = (const bf16*)(ws + WS_QA); pa.K = (const bf16*)(ws + WS_KA); pa.V = (const bf16*)(ws + WS_VA);
                        pa.O = (bf16*)(ws + WS_OA3) + (size_t)p * T * 256; pa.LSEP = (float*)(ws + WS_LSEA) + (size_t)p * T * 4;
                        pa.b = bh >> 2; pa.h = bh & 3; pa.d = p == 0 ? 1 : (p == 1 ? 4 : 16);
                        const int cpr = p == 0 ? 16 : (p == 1 ? 4 : 1);
                        pa.r = s16 / cpr; pa.c = s16 % cpr; pa.maxd = 128u; pa.j0 = pa.c == 0 ? 2 : 0; pa.j1 = 6;
                        attn_unit<64, PolA, false>(pa, F.lds, F.tid, F.lane, F.wave, 0ull);
                    }
                }
            }
        }
        SEAM(P + 2);
        if (PHON(5) && IN(P + 4)) _Pragma("unroll 1") for (int rep_ = 0; rep_ < NREP(5); ++rep_) { PHASE_BEGIN();
            int cti = 0;
            int cq0 = 0;
            if (CONV_IN_LAYER) { const unsigned t_ = __hip_atomic_load((unsigned*)(ws + WS_CTL) + CW_CONVQ + l * 64, __ATOMIC_RELAXED, __HIP_MEMORY_SCOPE_AGENT); cq0 = __builtin_amdgcn_readfirstlane((int)(t_ < 3072u ? t_ : 3072u)); }
            if (PHON(19)) for (int u = F.vcu; u < 1024; u += F.G) {
                const int bg = (u % 256) >> 4, k = u & 15, rnd = u >> 8;
                const int qc = rnd == 0 ? 2 * k : (rnd == 1 ? 2 * k + 1 : (rnd == 2 ? 63 - 2 * k : 62 - 2 * k));
                const u64 sel = cmp_unit(F, bg >> 1, bg & 1, qc);
                PolB pb; pb.Q = (const bf16*)(ws + WS_QB); pb.K = (const bf16*)(ws + WS_KSLC); pb.V = (const bf16*)(ws + WS_VSLC); pb.O = (bf16*)(ws + WS_OSLC);
                pb.b = bg >> 1; pb.g = bg & 1; pb.qc = qc; pb.maxd = 0x7fffffffu; pb.j0 = 0; pb.j1 = qc + 1;
                pb.GC = (const bf16*)(ws + WS_OCMP); pb.GW = (const bf16*)(ws + WS_OWIN); pb.GM = (const bf16*)(ws + WS_MISC);
                attn_unit<64, PolB, true>(pb, F.lds, F.tid, F.lane, F.wave, sel);
                if (CONV_IN_LAYER && rep_ == 0) { PHASE_BEGIN(); conv_layer_tiles(F, l, cq0, cti, 2); cti += 2; }
            }
            PHASE_BEGIN();
            if (PHON(20)) for (int v = F.vcu; v < 512; v += F.G) {
                const int bh = (v & 255) >> 3, k = v & 7, c = (v < 256) ? k : 15 - k;
                PolM pm; pm.Q = (const bf16*)(ws + WS_QM); pm.KN = (const bf16*)(ws + WS_KN); pm.KR = (const bf16*)(ws + WS_KR); pm.V = (const bf16*)(ws + WS_VM); pm.O = (bf16*)(ws + WS_OC);
                pm.b = bh >> 2; pm.h = bh & 3; pm.c = c; pm.maxd = 0x7fffffffu; pm.j0 = 0; pm.j1 = 4 * c + 4;
                attn_unit<96, PolM, false>(pm, F.lds, F.tid, F.lane, F.wave, 0ull);
                if (CONV_IN_LAYER && rep_ == 0) { PHASE_BEGIN(); conv_layer_tiles(F, l, cq0, cti, 2); cti += 2; }
            }
            if (CONV_IN_LAYER && rep_ == 0) { PHASE_BEGIN(); conv_layer_tiles(F, l, cq0, cti, 1 << 20); }
        }
        SEAM(P + 4);
        if (PHON(7) && IN(P + 6)) _Pragma("unroll 1") for (int rep_ = 0; rep_ < NREP(7); ++rep_) { PHASE_BEGIN(); phase_mix(F, l); }
        SEAM(P + 6);
        if (PHON(8) && IN(P + 7)) _Pragma("unroll 1") for (int rep_ = 0; rep_ < (DUM(8) ? 2 : 1); ++rep_) { PHASE_BEGIN(); F.dofs = (DUM(8) && rep_ == 0) ? WS_END : 0;
            SchedGrid Sg{(const char*)(ws + WS_AMIX), (const char*)(ws + WS_WOUT) + (size_t)l * 1024 * 1024 * 2, 1024, 1024, 4, (T / 256) * 4, F.G, F.vcu};
            EpiWout E{(bf16*)(ws + WS_X), (const float*)(ws + WS_MODS) + ((size_t)(l * 8) * 6 + 2) * 1024, F.dofs};
            pg8::gemm_phase<EpiWout, SchedGrid, false>(F.lds, 1024, 1024, Sg, E);
        }
        SEAM(P + 7);
        if (PHON(9) && IN(P + 8)) _Pragma("unroll 1") for (int rep_ = 0; rep_ < (DUM(9) ? 2 : 1); ++rep_) { PHASE_BEGIN(); F.dofs = (DUM(9) && rep_ == 0) ? WS_END : 0; F.dcnt = (DUM(9) && rep_ == 0) ? 4 : 0; phase_router(F, l); }
        SEAM(P + 8);
        if (PHON(10) && IN(P + 9)) _Pragma("unroll 1") for (int rep_ = 0; rep_ < NREP(10); ++rep_) { PHASE_BEGIN();
            moe_tables(F, l);
            const LAS int* tb = (const LAS int*)(F.lds + AUX_OFF);
            SchedMoe1F8 Sm{tb, tb + 64, (const char*)(ws + WS_H), (const char*)(ws + WS_W1E) + (size_t)l * 32 * 2048 * 1024, (const int*)(ws + WS_IDX), tb[32] * 8, F.G, F.vcu};
            EpiMoe1 E{(bf16*)(ws + WS_ACT), ginp(F, I_BE1) + (size_t)l * 32 * 2048};
            pg8::gemm_phase<EpiMoe1, SchedMoe1F8, true, true>(F.lds, 512, 512, Sm, E);
            if (CONV_IN_LAYER && CONV_TAIL1 > 0 && rep_ == 0 && l + 1 < DEPTH) {
                const int nun = tb[32] * 8, rounds = (nun + F.G - 1) / F.G, mine = F.vcu < nun ? (nun - 1 - F.vcu) / F.G + 1 : 0;
                if (mine < rounds) { PHASE_BEGIN(); conv_claim_tiles(F, l + 1, CONV_TAIL1); }
            }
        }
        SEAM(P + 9);
        if (PHON(11) && IN(P + 10)) _Pragma("unroll 1") for (int rep_ = 0; rep_ < NREP(11); ++rep_) { PHASE_BEGIN();
            moe_tables(F, l);
            const LAS int* tb = (const LAS int*)(F.lds + AUX_OFF);
            SchedMoe2F8 Sm{tb, (const char*)(ws + WS_ACT), (const char*)(ws + WS_W2E) + (size_t)l * 32 * 1024 * 1024, tb[32] * 4, F.G, F.vcu};
            EpiMoe2 E{(unsigned char*)(ws + WS_Y2), ginp(F, I_BE2) + (size_t)l * 32 * 1024};
            pg8::gemm_phase<EpiMoe2, SchedMoe2F8, false, true>(F.lds, 512, 512, Sm, E);
            if (CONV_IN_LAYER && CONV_TAIL2 > 0 && rep_ == 0 && l + 1 < DEPTH) {
                const int nun = tb[32] * 4, rounds = (nun + F.G - 1) / F.G, mine = F.vcu < nun ? (nun - 1 - F.vcu) / F.G + 1 : 0;
                if (mine < rounds) { PHASE_BEGIN(); conv_claim_tiles(F, l + 1, CONV_TAIL2); }
            }
        }
        SEAM(P + 10);
    }
    if (PHON(12) && IN(N_PHASES - 1)) { PHASE_BEGIN(); phase_norm1<1>(F, DEPTH); }
#undef IN
#undef SEAM
}

extern "C" void kernel_launch(void* const* d_in, const int* in_sizes, int n_in, void* d_out, int out_size, void* d_ws, size_t ws_size, hipStream_t stream) {
    static int grid = 0;
    if (grid == 0) {
        if (n_in != 33 || out_size != T * D || ws_size < WS_END * (DUM_MASK ? 2 : 1)) { fprintf(stderr, "kernel_launch: unexpected problem (n_in %d out %d ws %zu)\n", n_in, out_size, ws_size); grid = -1; return; }
        int dev = 0, cus = 0, per_cu = 0;
        if (hipGetDevice(&dev) != hipSuccess || hipDeviceGetAttribute(&cus, hipDeviceAttributeMultiprocessorCount, dev) != hipSuccess) { grid = -1; return; }
        if (hipFuncSetAttribute((const void*)fwd_kernel, hipFuncAttributeMaxDynamicSharedMemorySize, LDS_BYTES) != hipSuccess) { fprintf(stderr, "kernel_launch: hipFuncSetAttribute failed\n"); grid = -1; return; }
        if (hipOccupancyMaxActiveBlocksPerMultiprocessor(&per_cu, (const void*)fwd_kernel, 512, LDS_BYTES) != hipSuccess || per_cu < 1) { fprintf(stderr, "kernel_launch: occupancy query says %d\n", per_cu); per_cu = 1; }
        (void)hipGetLastError();
        grid = cus;
    }
    if (grid < 0) return;
    if (hipMemsetAsync((char*)d_ws + WS_CTL, 0, CTL_ZERO_BYTES, stream) != hipSuccess) return;
    Args a{};
    for (int i = 0; i < 33; ++i) a.in[i] = (const float*)d_in[i];
    a.out = (float*)d_out; a.ws = (unsigned char*)d_ws;
#if MK_PER_PHASE
    for (int p = 0; p < N_PHASES; ++p) { a.ph_lo = p; a.ph_hi = p + 1; hipLaunchKernelGGL(fwd_kernel, dim3(grid), dim3(512), LDS_BYTES, stream, a); }
#else
    a.ph_lo = 0; a.ph_hi = N_PHASES;
    hipLaunchKernelGGL(fwd_kernel, dim3(grid), dim3(512), LDS_BYTES, stream, a);
#endif
}
```

```cpp
#include <hip/hip_runtime.h>
#include <cstdio>
#include <cstdint>

#ifndef MK_PER_PHASE
#define MK_PER_PHASE 0
#endif

#ifndef PH_MASK
#define PH_MASK 0xFFFFFFFFu
#endif
#define PHON(k) ((PH_MASK >> (k)) & 1u)
#ifndef DBL_MASK
#define DBL_MASK 0u
#endif
#define NREP(k) (((DBL_MASK >> (k)) & 1u) ? 2 : 1)
#ifndef DUM_MASK
#define DUM_MASK 0u
#endif
#define DUM(k) ((DUM_MASK >> (k)) & 1u)
#ifndef ATT_VAR
#define ATT_VAR 0
#endif
#ifndef CONV_IN_LAYER
#define CONV_IN_LAYER 1
#endif
#ifndef CONV_TAIL1
#define CONV_TAIL1 3
#endif
#ifndef CONV_TAIL2
#define CONV_TAIL2 4
#endif
#ifndef ATT_STAGGER
#define ATT_STAGGER 0
#endif
#define DI __device__ __forceinline__
#define LAS __attribute__((address_space(3)))
#define GAS __attribute__((address_space(1)))
typedef unsigned short bf16;
typedef short bf16x8 __attribute__((ext_vector_type(8)));
typedef short s16x4 __attribute__((ext_vector_type(4)));
typedef float f32x2 __attribute__((ext_vector_type(2)));
typedef float f32x4 __attribute__((ext_vector_type(4)));
typedef float f32x16 __attribute__((ext_vector_type(16)));
typedef unsigned u32x2 __attribute__((ext_vector_type(2)));
typedef unsigned u32x4 __attribute__((ext_vector_type(4)));
typedef __bf16 bf16x2_t __attribute__((ext_vector_type(2)));
typedef unsigned long long u64;

constexpr int NB = 8, S = 4096, T = NB * S, D = 1024, DEPTH = 4;
constexpr int NIN = 2560;
constexpr int NE = 32, DFF = 1024;
constexpr int SP = S + 64;
constexpr int ECAP = 32768;
constexpr int ACT_ROWS = 4 * T + NE * 256;
constexpr float LOG2E = 1.4426950408889634f;
constexpr float SCL64 = 0.125f * LOG2E;
constexpr float SCL96 = 0.10206207261596577f * LOG2E;
constexpr float EPS = 1e-6f;

constexpr size_t MiB = 1u << 20;
constexpr size_t WS_CTL = 0, CTL_ZERO_BYTES = 2 * MiB;
constexpr size_t WS_MODS = 2 * MiB, WS_B1P = 3 * MiB, WS_CS64 = 4 * MiB, WS_CS32 = 12 * MiB;
constexpr size_t WS_WIN = 16 * MiB, WS_WOUT = 36 * MiB, WS_NSAW1 = 44 * MiB, WS_MLAQ = 52 * MiB, WS_MLAKV = 53 * MiB;
constexpr size_t WS_W1E = 64 * MiB, WS_W2E = 576 * MiB;
constexpr size_t WS_X = 832 * MiB, WS_H = 960 * MiB;
constexpr size_t WS_QA = 1024 * MiB, WS_KA = 1040 * MiB, WS_VA = 1056 * MiB, WS_QB = 1072 * MiB;
constexpr size_t WS_KCMP = 1104 * MiB, WS_VCMP = 1113 * MiB;
constexpr size_t WS_KSLC = 1122 * MiB, WS_VSLC = 1130 * MiB, WS_KWIN = 1138 * MiB, WS_VWIN = 1146 * MiB;
constexpr size_t WS_CQ = 1154 * MiB, WS_MISC = 1170 * MiB;
constexpr size_t WS_RSTDQ = 1186 * MiB, WS_RSTDKV = 1186 * MiB + 512 * 1024, WS_KR = 1187 * MiB, WS_GATES = 1189 * MiB;
constexpr size_t WS_W2T = 1195 * MiB;
constexpr size_t WS_HID = 1192 * MiB, WS_KC = 1196 * MiB, WS_VC = 1196 * MiB + 512 * 1024;
constexpr size_t WS_QM = 1197 * MiB, WS_KN = 1221 * MiB, WS_VM = 1237 * MiB;
constexpr size_t WS_OA3 = 1253 * MiB, WS_LSEA = 1301 * MiB;
constexpr size_t WS_OCMP = 1303 * MiB, WS_OSLC = 1335 * MiB, WS_OWIN = 1367 * MiB, WS_OC = 1399 * MiB;
constexpr size_t WS_SEL = 1415 * MiB, WS_AMIX = 1416 * MiB;
constexpr size_t WS_IDX = 1480 * MiB, WS_GATEW = 1484 * MiB, WS_TOKSLOT = 1488 * MiB, WS_TOKG = WS_TOKSLOT + 512 * 1024;
constexpr size_t WS_ACT = 1489 * MiB, WS_Y2 = 1761 * MiB, WS_END = 2033 * MiB;
static_assert((size_t)ACT_ROWS * 1024 * 2 <= 272 * MiB, "act rows");
static_assert((size_t)16 * SP * 64 * 2 + 65536 <= 9 * MiB, "kcmp");

constexpr int CW_TMO = 0, CW_FAIL = 2;
constexpr int CW_BAR = 4096;
constexpr int CW_QUEUE = 12288;
constexpr int CW_CONVQ = 13312;
constexpr int CW_CNT = 16384;

constexpr int RING_BYTES = 131072;
constexpr int AUX_OFF = RING_BYTES;
constexpr int MISC_OFF = AUX_OFF + 8192;
constexpr int LDS_BYTES = 147456;

DI unsigned pk2(float lo, float hi) { f32x2 v = {lo, hi}; bf16x2_t b = __builtin_convertvector(v, bf16x2_t); return __builtin_bit_cast(unsigned, b); }
DI float bf2f(unsigned short h) { return __uint_as_float(((unsigned)h) << 16); }
DI float bflo(unsigned w) { return __uint_as_float(w << 16); }
DI float bfhi(unsigned w) { return __uint_as_float(w & 0xffff0000u); }
typedef float f32x2c __attribute__((ext_vector_type(2)));
constexpr float Y2_SCALE = 4.0f, Y2_ISCALE = 1.0f / 4.0f;
DI unsigned pk4_fp8(float a, float b, float c, float d) {
    a = fminf(fmaxf(a * Y2_SCALE, -440.f), 440.f); b = fminf(fmaxf(b * Y2_SCALE, -440.f), 440.f); c = fminf(fmaxf(c * Y2_SCALE, -440.f), 440.f); d = fminf(fmaxf(d * Y2_SCALE, -440.f), 440.f);
    int w = __builtin_amdgcn_cvt_pk_fp8_f32(a, b, 0, false); w = __builtin_amdgcn_cvt_pk_fp8_f32(c, d, w, true); return (unsigned)w; }
DI f32x4 unpk4_fp8(unsigned w) { const f32x2c lo = __builtin_amdgcn_cvt_pk_f32_fp8((int)w, false), hi = __builtin_amdgcn_cvt_pk_f32_fp8((int)w, true); return (f32x4){lo.x, lo.y, hi.x, hi.y}; }
constexpr float W8_SCALE = 64.0f, A8_SCALE = 4.0f;
constexpr int W8_E8M0 = 127 - 6, A8_E8M0 = 127 - 2;
constexpr float H8_SCALE = 8.0f; constexpr int H8_E8M0 = 127 - 3;
DI int lane_id() { return (int)__builtin_amdgcn_mbcnt_hi(~0u, __builtin_amdgcn_mbcnt_lo(~0u, 0u)); }
DI unsigned pk4_fp8s(float a, float b, float c, float d, float sc) {
    a = fminf(fmaxf(a * sc, -440.f), 440.f); b = fminf(fmaxf(b * sc, -440.f), 440.f); c = fminf(fmaxf(c * sc, -440.f), 440.f); d = fminf(fmaxf(d * sc, -440.f), 440.f);
    int w = __builtin_amdgcn_cvt_pk_fp8_f32(a, b, 0, false); w = __builtin_amdgcn_cvt_pk_fp8_f32(c, d, w, true); return (unsigned)w; }
DI float q8s(float x, float sc) {
    const float a = fminf(fmaxf(x * sc, -440.f), 440.f); const int w = __builtin_amdgcn_cvt_pk_fp8_f32(a, a, 0, false);
    const f32x2c r = __builtin_amdgcn_cvt_pk_f32_fp8(w, false); return r.x; }
template <int CTRL> DI float dpp_perm(float v) { return __builtin_bit_cast(float, __builtin_amdgcn_update_dpp(0, __builtin_bit_cast(int, v), CTRL, 0xf, 0xf, false)); }
DI float row_sum16(float v) { v += dpp_perm<0xB1>(v); v += dpp_perm<0x4E>(v); v += dpp_perm<0x141>(v); v += dpp_perm<0x140>(v); return v; }
DI float wave_sum(float v) {
    v = row_sum16(v);
    const float r0 = __builtin_bit_cast(float, __builtin_amdgcn_readlane(__builtin_bit_cast(int, v), 0)), r1 = __builtin_bit_cast(float, __builtin_amdgcn_readlane(__builtin_bit_cast(int, v), 16));
    const float r2 = __builtin_bit_cast(float, __builtin_amdgcn_readlane(__builtin_bit_cast(int, v), 32)), r3 = __builtin_bit_cast(float, __builtin_amdgcn_readlane(__builtin_bit_cast(int, v), 48));
    return (r0 + r1) + (r2 + r3);
}
DI float fast_exp2(float x) { return __builtin_amdgcn_exp2f(x); }
DI float fast_rcp(float x) { return __builtin_amdgcn_rcpf(x); }
DI float sigmoidf_(float x) { return fast_rcp(1.0f + fast_exp2(-x * LOG2E)); }
#define RLX_AGENT __ATOMIC_RELAXED, __HIP_MEMORY_SCOPE_AGENT

#define XB_TMO      128
#define XB_XCNT(j)  (256  + 64 * (j))
#define XB_XSUB(j)  (1280 + 64 * (j))
#define XB_XGEN(j)  (2304 + 64 * (j))
#define XB_TOP      3328
#define XB_TOPGEN   3392
#define XCD_BAR_WORDS 3456
#define XB_SPIN_CAP (1u << 22)
DI unsigned xb_ld(unsigned* p)              { return __hip_atomic_load(p, __ATOMIC_RELAXED, __HIP_MEMORY_SCOPE_AGENT); }
DI unsigned xb_add(unsigned* p, unsigned v) { return __hip_atomic_fetch_add(p, v, __ATOMIC_RELAXED, __HIP_MEMORY_SCOPE_AGENT); }
DI unsigned xb_xcc_id() { return (unsigned)__builtin_amdgcn_s_getreg((3 << 11) | 20) & 0xFu; }
#define XB_SPIN(cond, bar) do { unsigned _sp = 0; while (cond) { __builtin_amdgcn_s_sleep(1); \
    if ((++_sp & 255u) == 0u) { if (xb_ld(&(bar)[XB_TMO])) break; if (_sp > XB_SPIN_CAP) { atomicAdd(&(bar)[XB_TMO], 1u); break; } } } } while (0)
struct XcdBarrier { unsigned* bar; unsigned x; volatile LAS unsigned* st; };
DI XcdBarrier xcd_barrier_post(unsigned* bar, volatile LAS unsigned* st) {
    XcdBarrier b; b.bar = bar; b.x = xb_xcc_id(); b.st = st;
    if (threadIdx.x == 0) (void)xb_add(&bar[XB_XCNT(b.x)], 1u);
    return b;
}
DI void xcd_barrier_complete(unsigned* bar, unsigned x, unsigned& nloc, unsigned& nx) {
    const unsigned G = gridDim.x * gridDim.y * gridDim.z;
    unsigned sum, cnt, mine, sp = 0u;
    for (;;) {
        sum = 0u; cnt = 0u; mine = 0u;
#pragma unroll
        for (unsigned j = 0; j < 16; ++j) { const unsigned c = xb_ld(&bar[XB_XCNT(j)]); sum += c; cnt += (c > 0u) ? 1u : 0u; mine = (j == x) ? c : mine; }
        if (sum == G) break;
        __builtin_amdgcn_s_sleep(1);
        if ((++sp & 255u) == 0u) { if (xb_ld(&bar[XB_TMO])) break; if (sp > XB_SPIN_CAP) { atomicAdd(&bar[XB_TMO], 1u); break; } }
    }
    nloc = mine > 0u ? mine : 1u; nx = cnt > 0u ? cnt : 1u;
}
DI void xcd_barrier(const XcdBarrier& b) {
    asm volatile("s_waitcnt vmcnt(0)" ::: "memory");
    __syncthreads();
    unsigned* bar = b.bar; asm volatile("" : "+s"(bar));
    if (threadIdx.x == 0) {
        __builtin_amdgcn_s_waitcnt(0);
        unsigned nloc = b.st[0], nx = b.st[1];
        if (nloc == 0u) { xcd_barrier_complete(bar, b.x, nloc, nx); b.st[0] = nloc; b.st[1] = nx; }
        const unsigned old = xb_add(&bar[XB_XSUB(b.x)], 1u);
        const unsigned gen = old / nloc;
        if (old + 1u == (gen + 1u) * nloc) {
            __builtin_amdgcn_fence(__ATOMIC_RELEASE, "agent");
            asm volatile("s_waitcnt vmcnt(0)" ::: "memory");
            const unsigned og = xb_add(&bar[XB_TOP], 1u);
            const unsigned tg = og / nx;
            if (og + 1u == (tg + 1u) * nx) xb_add(&bar[XB_TOPGEN], 1u);
            else XB_SPIN(xb_ld(&bar[XB_TOPGEN]) == tg, bar);
            __builtin_amdgcn_fence(__ATOMIC_ACQUIRE, "agent");
            xb_add(&bar[XB_XGEN(b.x)], 1u);
            asm volatile("s_waitcnt vmcnt(0)" ::: "memory");
        } else {
            XB_SPIN(xb_ld(&bar[XB_XGEN(b.x)]) == gen, bar);
            __builtin_amdgcn_fence(__ATOMIC_ACQUIRE, "agent");
            asm volatile("s_waitcnt vmcnt(0)" ::: "memory");
        }
    }
    __syncthreads();
}

struct Args {
    const float* in[33];
    float* out;
    unsigned char* ws;
    int ph_lo, ph_hi;
};
enum { I_X = 0, I_C, I_POS, I_WADA, I_BADA, I_G1, I_G2, I_WIN, I_POSK, I_POSV, I_W1K, I_B1K, I_W2K, I_B2K, I_W1V, I_B1V, I_W2V, I_B2V,
       I_GQ, I_GKV, I_WQUP, I_WKVUP, I_GOA, I_GOB, I_GOC, I_WOUT, I_WR, I_BR, I_WE1, I_BE1, I_WE2, I_BE2, I_GF };

struct Ctx {
    LAS unsigned char* lds;
    const Args* a;
    unsigned char* ws;
    int tid, lane, wave, blk, G, vcu;
    size_t dofs; int dcnt;
};
DI const float* ginp(const Ctx& F, int i) { return (const float*)(GAS const float*)(F.a->in[i]); }
DI float* gout(const Ctx& F) { return (float*)(GAS float*)(F.a->out); }

namespace pg8 {
constexpr int BM = 256, BK = 64, HALF = 128, HTB = HALF * BK * 2;
DI int lds_byte(int r, int c) { const int st = (r >> 4) * 2 + (c >> 5), rr = r & 15, cc = c & 31, ob = rr * 64 + cc * 2; return st * 1024 + (ob ^ (((ob >> 9) & 1) << 5)); }
DI void stage_rc(int b, int& R, int& C) { const int st = b / 1024, sb = b % 1024, swz = sb ^ (((sb >> 9) & 1) << 5); R = (st >> 1) * 16 + swz / 64; C = (st & 1) * 32 + (swz % 64) / 2; }
DI int perm32(int rho) { const int n = rho >> 4, i = rho & 15; return 8 * (i >> 2) + 4 * n + (i & 3); }
struct Unit { const char* a; const char* b; int pm, pn, e, ml; };
template <class E_, class = void> struct acc_bias_t { static constexpr bool value = false; };
template <class E_> struct acc_bias_t<E_, decltype((void)E_::ACC_BIAS)> { static constexpr bool value = E_::ACC_BIAS; };
template <class E_> constexpr bool acc_bias_v = acc_bias_t<E_>::value;
template <class E_, class = void> struct perm2_t { static constexpr bool value = false; };
template <class E_> struct perm2_t<E_, decltype((void)E_::PERM2)> { static constexpr bool value = E_::PERM2; };
template <class E_> constexpr bool perm2_v = perm2_t<E_>::value;

template <class Epi, class Sched, bool GATHER, bool FP8 = false>
DI void gemm_phase(LAS unsigned char* lds, const int lda, const int K, const Sched& S, const Epi& E) {
    typedef int i32x4_ __attribute__((ext_vector_type(4))); typedef int i32x8_ __attribute__((ext_vector_type(8)));
    int tid_ = threadIdx.x; asm volatile("" : "+v"(tid_));
    const int tid = tid_, wid = __builtin_amdgcn_readfirstlane(tid >> 6), lane = tid & 63, wr = wid >> 2, wc = wid & 3, fr = lane & 15, fq = lane >> 4;
    const int nt = K / BK;
    int Rr[2], Cc[2]; unsigned voffB[2];
#pragma unroll
    for (int i = 0; i < 2; ++i) { int R, C; stage_rc(tid * 16 + i * 8192, R, C); Rr[i] = R; Cc[i] = C; const int Rb = perm2_v<Epi> ? ((R >> 5) * 64 + 16 * ((R & 15) >> 2) + 4 * ((R >> 4) & 1) + (R & 3)) : (Epi::PERM ? ((R & ~31) + perm32(R & 31)) : R); voffB[i] = (unsigned)(Rb * K + C) * 2u; }
    const size_t kstep = (size_t)(BK * 2);
    const size_t hstepB = (size_t)(perm2_v<Epi> ? 8 : HALF) * K * 2;
    const size_t istepB = (size_t)(perm2_v<Epi> ? 128 : 64) * K * 2;
    const unsigned ldsw = (unsigned)wid * 1024u;
    const int aoff = lds_byte(wr * 64 + fr, fq * 8), boff = lds_byte(wc * 32 + fr, fq * 8);
#define PG8_SA(b, h) (((b) * 2 + (h)) * HTB)
#define PG8_SB(b, h) ((4 + (b) * 2 + (h)) * HTB)
#define PG8_STAGE_B(bufoff, gbase) do { _Pragma("unroll") for (int _i = 0; _i < 2; ++_i) \
        __builtin_amdgcn_global_load_lds((const unsigned*)((const char*)(gbase) + (size_t)_i * istepB + voffB[0]), (LAS unsigned*)(lds + (bufoff) + ldsw + _i * 8192), 16, 0, 0); } while (0)
#define PG8_STAGE_A(bufoff, gbase, v, h) do { _Pragma("unroll") for (int _i = 0; _i < 2; ++_i) { \
        if constexpr (GATHER) __builtin_amdgcn_global_load_lds((const unsigned*)((const char*)(gbase) + (v)[h][_i]), (LAS unsigned*)(lds + (bufoff) + ldsw + _i * 8192), 16, 0, 0); \
        else __builtin_amdgcn_global_load_lds((const unsigned*)((const char*)(gbase) + (size_t)((h) * 128 + _i * 64) * lda * 2 + (v)[0][0]), (LAS unsigned*)(lds + (bufoff) + ldsw + _i * 8192), 16, 0, 0); } } while (0)
#define PG8_SETOFF(v, u) do { _Pragma("unroll") for (int _h = 0; _h < 2; ++_h) _Pragma("unroll") for (int _i = 0; _i < 2; ++_i) { \
        if constexpr (GATHER) (v)[_h][_i] = S.gather_off((u), _h * 128 + Rr[_i]) + (unsigned)Cc[_i] * 2u; \
        else (v)[_h][_i] = (unsigned)((_h * 128 + Rr[_i]) * lda + Cc[_i]) * 2u; } } while (0)
#define PG8_LDA(dst, b, h) do { _Pragma("unroll") for (int m = 0; m < 4; ++m) { const i32x4_ lo_ = *(const LAS i32x4_*)(lds + PG8_SA(b, h) + aoff + m * 2048), hi_ = *(const LAS i32x4_*)(lds + PG8_SA(b, h) + aoff + m * 2048 + 1024); dst[m] = __builtin_shufflevector(lo_, hi_, 0, 1, 2, 3, 4, 5, 6, 7); } } while (0)
#define PG8_LDB(dst, b, h) do { _Pragma("unroll") for (int n = 0; n < 2; ++n) { const i32x4_ lo_ = *(const LAS i32x4_*)(lds + PG8_SB(b, h) + boff + n * 2048), hi_ = *(const LAS i32x4_*)(lds + PG8_SB(b, h) + boff + n * 2048 + 1024); dst[n] = __builtin_shufflevector(lo_, hi_, 0, 1, 2, 3, 4, 5, 6, 7); } } while (0)
#define PG8_H0(x) __builtin_bit_cast(bf16x8, __builtin_shufflevector((x), (x), 0, 1, 2, 3))
#define PG8_H1(x) __builtin_bit_cast(bf16x8, __builtin_shufflevector((x), (x), 4, 5, 6, 7))
#define PG8_MMA(ai, bj, At, Bt) do { __builtin_amdgcn_s_setprio(1); \
        if constexpr (FP8) { _Pragma("unroll") for (int m = 0; m < 4; ++m) _Pragma("unroll") for (int n = 0; n < 2; ++n) \
            asm volatile("v_mfma_scale_f32_16x16x128_f8f6f4 %0, %1, %2, %0, %3, %4 op_sel_hi:[0,0,0]" : "+v"(acc[ai][bj][m][n]) : "v"(Bt[n]), "v"(At[m]), "v"(scw_), "v"(sca_)); } \
        else { _Pragma("unroll") for (int m = 0; m < 4; ++m) _Pragma("unroll") for (int n = 0; n < 2; ++n) { \
            acc[ai][bj][m][n] = __builtin_amdgcn_mfma_f32_16x16x32_bf16(PG8_H0(Bt[n]), PG8_H0(At[m]), acc[ai][bj][m][n], 0, 0, 0); \
            acc[ai][bj][m][n] = __builtin_amdgcn_mfma_f32_16x16x32_bf16(PG8_H1(Bt[n]), PG8_H1(At[m]), acc[ai][bj][m][n], 0, 0, 0); } } \
        __builtin_amdgcn_s_setprio(0); } while (0)
#define PG8_WAIT_V(n) asm volatile("s_waitcnt vmcnt(" #n ")" ::: "memory")
#define PG8_WAIT_L(n) asm volatile("s_waitcnt lgkmcnt(" #n ")" ::: "memory")
#define PG8_BAR __builtin_amdgcn_s_barrier()
#define PG8_SCHED __builtin_amdgcn_sched_barrier(0)
    Unit cur, nxt; int ui = 0;
    if (!S.next(0, cur)) return;
    f32x4 acc[2][2][4][2];
    f32x4 bv[2][2] = {{{0.f, 0.f, 0.f, 0.f}, {0.f, 0.f, 0.f, 0.f}}, {{0.f, 0.f, 0.f, 0.f}, {0.f, 0.f, 0.f, 0.f}}};
    if constexpr (acc_bias_v<Epi>) E.bias(cur, wc, fq, bv);
#pragma unroll
    for (int a = 0; a < 2; ++a)
#pragma unroll
        for (int b = 0; b < 2; ++b)
#pragma unroll
            for (int m = 0; m < 4; ++m)
#pragma unroll
                for (int n = 0; n < 2; ++n) acc[a][b][m][n] = bv[b][n];
    int scw_ = W8_E8M0, sca_ = A8_E8M0; if constexpr (FP8) sca_ = Epi::A_E8M0;
    i32x8_ At[4], B0[2], B1[2];
    unsigned vA[2][2], vAn[2][2];
    PG8_SETOFF(vA, cur);
    const char* cA = cur.a; const char* cB = cur.b;
    PG8_STAGE_B(PG8_SB(0, 0), cB); PG8_STAGE_B(PG8_SB(0, 1), cB + hstepB); PG8_STAGE_A(PG8_SA(0, 0), cA, vA, 0); PG8_STAGE_A(PG8_SA(0, 1), cA, vA, 1);
    if (wr == 1) PG8_BAR;
    PG8_WAIT_V(2); PG8_BAR;
    PG8_STAGE_B(PG8_SB(1, 0), cB + kstep); PG8_STAGE_A(PG8_SA(1, 0), cA + kstep, vA, 0); PG8_STAGE_B(PG8_SB(1, 1), cB + hstepB + kstep);
    PG8_WAIT_V(6); PG8_BAR;
    for (;;) {
        const bool has_next = S.next(ui + 1, nxt);
        if constexpr (GATHER) {
            if (has_next) {
#pragma unroll
                for (int h = 0; h < 2; ++h)
#pragma unroll
                    for (int i = 0; i < 2; ++i) vAn[h][i] = S.gather_raw(nxt, h * 128 + Rr[i]);
            }
        }
        const char* nA = has_next ? nxt.a : cA; const char* nB = has_next ? nxt.b : cB;
#pragma unroll 1
        for (int t = 0; t < nt; t += 2) {
            const bool last = (t == nt - 2);
            const char* a1 = cA + (size_t)(t + 1) * kstep;
            const char* a2 = last ? nA : cA + (size_t)(t + 2) * kstep; const char* b2 = last ? nB : cB + (size_t)(t + 2) * kstep;
            const char* a3 = a2 + kstep; const char* b3 = b2 + kstep;
            unsigned v2[2][2];
#pragma unroll
            for (int h = 0; h < 2; ++h)
#pragma unroll
                for (int i = 0; i < 2; ++i) v2[h][i] = vA[h][i];
            if constexpr (GATHER) {
                if (last && has_next) {
#pragma unroll
                    for (int h = 0; h < 2; ++h)
#pragma unroll
                        for (int i = 0; i < 2; ++i) { vAn[h][i] = vAn[h][i] * (unsigned)(lda * 2) + (unsigned)Cc[i] * 2u; v2[h][i] = vAn[h][i]; }
                }
            }
            PG8_LDB(B0, 0, 0); PG8_LDB(B1, 0, 1); PG8_SCHED; PG8_LDA(At, 0, 0); PG8_STAGE_A(PG8_SA(1, 1), a1, vA, 1);
            PG8_WAIT_V(8); PG8_WAIT_L(0); PG8_BAR; PG8_MMA(0, 0, At, B0); PG8_MMA(0, 1, At, B1); PG8_BAR; PG8_SCHED;
            PG8_LDA(At, 0, 1); PG8_STAGE_B(PG8_SB(0, 0), b2); PG8_STAGE_B(PG8_SB(0, 1), b2 + hstepB); PG8_STAGE_A(PG8_SA(0, 0), a2, v2, 0);
            PG8_WAIT_V(8); PG8_WAIT_L(0); PG8_BAR; PG8_MMA(1, 0, At, B0); PG8_MMA(1, 1, At, B1); PG8_BAR; PG8_SCHED;
            PG8_LDB(B0, 1, 0); PG8_LDB(B1, 1, 1); PG8_SCHED; PG8_LDA(At, 1, 0); PG8_STAGE_A(PG8_SA(0, 1), a2, v2, 1);
            PG8_WAIT_V(8); PG8_WAIT_L(0); PG8_BAR; PG8_MMA(0, 0, At, B0); PG8_MMA(0, 1, At, B1); PG8_BAR; PG8_SCHED;
            PG8_LDA(At, 1, 1); PG8_STAGE_B(PG8_SB(1, 0), b3); PG8_STAGE_B(PG8_SB(1, 1), b3 + hstepB); PG8_STAGE_A(PG8_SA(1, 0), a3, v2, 0);
            PG8_WAIT_V(8); PG8_WAIT_L(0); PG8_BAR; PG8_MMA(1, 0, At, B0); PG8_MMA(1, 1, At, B1); PG8_BAR; PG8_SCHED;
        }
        if (wr == 0) PG8_BAR;
        if constexpr (FP8) asm volatile("s_nop 15\n\ts_nop 15" ::: "memory");
        if constexpr (acc_bias_v<Epi>) E.bias(has_next ? nxt : cur, wc, fq, bv);
        if constexpr (!Epi::AFTER_DRAIN) { int fr_ = fr, fq_ = fq; asm volatile("" : "+v"(fr_), "+v"(fq_)); E(acc, cur, wr, wc, fr_, fq_); }
        if (!has_next) break;
#pragma unroll
        for (int a = 0; a < 2; ++a)
#pragma unroll
            for (int b = 0; b < 2; ++b)
#pragma unroll
                for (int m = 0; m < 4; ++m)
#pragma unroll
                    for (int n = 0; n < 2; ++n) acc[a][b][m][n] = bv[b][n];
        cur = nxt; cA = nA; cB = nB; ++ui;
        if constexpr (GATHER) {
#pragma unroll
            for (int h = 0; h < 2; ++h)
#pragma unroll
                for (int i = 0; i < 2; ++i) vA[h][i] = vAn[h][i];
        }
        if (wr == 1) PG8_BAR;
    }
    PG8_WAIT_V(0);
    PG8_BAR;
    if constexpr (Epi::AFTER_DRAIN) { int fr_ = fr, fq_ = fq; asm volatile("" : "+v"(fr_), "+v"(fq_)); E.fused(acc, cur, wr, wc, fr_, fq_, lds, wid, lane); }
#undef PG8_SA
#undef PG8_SB
#undef PG8_STAGE_A
#undef PG8_STAGE_B
#undef PG8_SETOFF
#undef PG8_LDA
#undef PG8_LDB
#undef PG8_MMA
#undef PG8_H0
#undef PG8_H1
#undef PG8_WAIT_V
#undef PG8_WAIT_L
#undef PG8_BAR
#undef PG8_SCHED
}
}
using pg8::Unit;
typedef f32x4 AccT[2][2][4][2];

struct SchedGrid {
    const char* A; const char* B; int lda, K, nN, nwg, G, c;
    DI bool next(int i, Unit& u) const {
        const int L = i * G + c; if (L >= nwg) return false;
        u.pm = L / nN; u.pn = L % nN; u.e = 0; u.ml = 0;
        u.a = A + (size_t)u.pm * 256 * lda * 2; u.b = B + (size_t)u.pn * 256 * K * 2; return true;
    }
    DI unsigned gather_off(const Unit&, int) const { return 0u; }
    DI unsigned gather_raw(const Unit&, int) const { return 0u; }
};
struct SchedCmp {
    const char* KCMP; const char* VCMP; const char* W; int G, c;
    DI bool next(int i, Unit& u) const {
        const int L = i * G + c; if (L >= 32) return false;
        const int kv = L >> 4, bg = L & 15;
        u.pm = L; u.pn = 0; u.e = kv; u.ml = 0;
        u.a = (kv ? VCMP : KCMP) + (size_t)bg * SP * 64 * 2; u.b = W + (size_t)kv * 256 * 2048 * 2; return true;
    }
    DI unsigned gather_off(const Unit&, int) const { return 0u; }
    DI unsigned gather_raw(const Unit&, int) const { return 0u; }
};
struct SchedMla {
    const char* CQ; const char* MISC; const char* WQ; const char* WKV; int G, c;
    DI bool next(int i, Unit& u) const {
        const int L = i * G + c; if (L >= 512) return false;
        const int which = L >> 8, r = L & 255;
        u.pm = r >> 1; u.pn = r & 1; u.e = which; u.ml = 0;
        u.a = (which ? MISC : CQ) + (size_t)u.pm * 256 * 256 * 2; u.b = (which ? WKV : WQ) + (size_t)u.pn * 256 * 256 * 2; return true;
    }
    DI unsigned gather_off(const Unit&, int) const { return 0u; }
    DI unsigned gather_raw(const Unit&, int) const { return 0u; }
};
template <int NT, bool GATHERED>
struct SchedMoe {
    const LAS int* tb; const LAS int* cnt; const char* A; const char* W; const int* IDX; int total, G, c;
    DI bool next(int i, Unit& u) const {
        const int L = i * G + c; if (L >= total) return false;
        const int mtg = L / NT; u.pn = L % NT;
        const int ln_ = threadIdx.x & 63;
        const int e = __popcll(__ballot(ln_ < 32 && tb[ln_ & 31] <= mtg)) - 1;
        u.e = e; u.ml = mtg - tb[e]; u.pm = mtg;
        u.a = GATHERED ? A : A + (size_t)mtg * 256 * 1024 * 2;
        u.b = W + ((size_t)e * NT * 256 + (size_t)u.pn * 256) * 1024 * 2; return true;
    }
    DI unsigned gather_off(const Unit& u, int row) const {
        const int pos = u.ml * 256 + row; const int tok = (pos < cnt[u.e]) ? IDX[u.e * ECAP + pos] : 0;
        return (unsigned)tok * 2048u;
    }
    DI unsigned gather_raw(const Unit& u, int row) const {
        const int pos = u.ml * 256 + row;
        return (unsigned)IDX[u.e * ECAP + (pos < cnt[u.e] ? pos : 0)];
    }
};

struct SchedMoe1F8 {
    static constexpr bool HOOK = false;
    const LAS int* tb; const LAS int* cnt; const char* A; const char* W; const int* IDX; int total, G, c;
    DI bool next(int i, Unit& u) const {
        const int L = i * G + c; if (L >= total) return false;
        const int mtg = L >> 3; u.pn = L & 7;
        const int ln_ = lane_id();
        const int e = __popcll(__ballot(ln_ < 32 && tb[ln_ & 31] <= mtg)) - 1;
        u.e = e; u.ml = mtg - tb[e]; u.pm = mtg;
        u.a = A; u.b = W + ((size_t)e * 2048 + (size_t)u.pn * 256) * 1024; return true;
    }
    DI unsigned gather_raw(const Unit& u, int row) const { const int pos = u.ml * 256 + row; return (unsigned)IDX[u.e * ECAP + (pos < cnt[u.e] ? pos : 0)]; }
    DI unsigned gather_off(const Unit& u, int row) const { return gather_raw(u, row) * 1024u; }
};
struct SchedMoe2F8 {
    static constexpr bool HOOK = false;
    const LAS int* tb; const char* A; const char* W; int total, G, c;
    DI bool next(int i, Unit& u) const {
        const int L = i * G + c; if (L >= total) return false;
        const int mtg = L >> 2; u.pn = L & 3;
        const int ln_ = lane_id();
        const int e = __popcll(__ballot(ln_ < 32 && tb[ln_ & 31] <= mtg)) - 1;
        u.e = e; u.ml = mtg - tb[e]; u.pm = mtg;
        u.a = A + (size_t)mtg * 256 * 1024; u.b = W + ((size_t)e * 1024 + (size_t)u.pn * 256) * 1024; return true;
    }
    DI unsigned gather_off(const Unit&, int) const { return 0u; }
    DI unsigned gather_raw(const Unit&, int) const { return 0u; }
};

DI void rot4(f32x4& v0, f32x4& v1, const f32x4 c, const f32x4 s) {
    const float a0 = v0[0], b0 = v0[1], a1 = v0[2], b1 = v0[3], a2 = v1[0], b2 = v1[1], a3 = v1[2], b3 = v1[3];
    v0[0] = a0 * c[0] - b0 * s[0]; v0[1] = b0 * c[0] + a0 * s[0];
    v0[2] = a1 * c[1] - b1 * s[1]; v0[3] = b1 * c[1] + a1 * s[1];
    v1[0] = a2 * c[2] - b2 * s[2]; v1[1] = b2 * c[2] + a2 * s[2];
    v1[2] = a3 * c[3] - b3 * s[3]; v1[3] = b3 * c[3] + a3 * s[3];
}
DI u32x4 pack8(const f32x4 v0, const f32x4 v1) { u32x4 w; w.x = pk2(v0[0], v0[1]); w.y = pk2(v0[2], v0[3]); w.z = pk2(v1[0], v1[1]); w.w = pk2(v1[2], v1[3]); return w; }

struct EpiWin {
    static constexpr bool PERM = true, AFTER_DRAIN = false;
    unsigned char* ws; const float* CS64; const float* CS32;
    DI void operator()(const AccT& acc, const Unit& u, int wr, int wc, int fr, int fq) const {
#pragma unroll
        for (int bj = 0; bj < 2; ++bj) {
            const int w0 = bj * 128 + wc * 32;
            size_t off; int ld, dcol, mode = 0, gm = 0, g = 0; float sc = 1.f;
            switch (u.pn) {
                case 0: off = WS_QA; ld = 256; dcol = w0; mode = 1; sc = SCL64; break;
                case 1: off = WS_KA; ld = 256; dcol = w0; mode = 1; break;
                case 2: off = WS_VA; ld = 256; dcol = w0; break;
                case 3: off = WS_QB; ld = 512; dcol = w0; mode = 1; sc = SCL64; break;
                case 4: off = WS_QB; ld = 512; dcol = 256 + w0; mode = 1; sc = SCL64; break;
                case 5: off = (w0 < 128) ? WS_KCMP : WS_VCMP; ld = 64; gm = 1; g = (w0 & 127) >> 6; dcol = w0 & 63; break;
                case 6: off = (w0 < 128) ? WS_KSLC : WS_VSLC; ld = 128; dcol = w0 & 127; mode = (w0 < 128) ? 1 : 0; break;
                case 7: off = (w0 < 128) ? WS_KWIN : WS_VWIN; ld = 128; dcol = w0 & 127; mode = (w0 < 128) ? 1 : 0; break;
                case 8: off = WS_CQ; ld = 256; dcol = w0; break;
                default: if (w0 == 128) { off = WS_KR; ld = 32; dcol = 0; mode = 2; } else { off = WS_MISC; ld = 256; dcol = w0; } break;
            }
            bf16* base = (bf16*)(ws + off);
            const int i0 = 16 * (wc & 1) + 4 * fq;
#pragma unroll
            for (int ai = 0; ai < 2; ++ai) {
                f32x4 cc[4], sn[4];
                if (mode) {
#pragma unroll
                    for (int m = 0; m < 4; ++m) {
                        const int row = u.pm * 256 + ai * 128 + wr * 64 + m * 16 + fr;
                        const float* cs = (mode == 1) ? CS64 + (size_t)row * 64 + i0 : CS32 + (size_t)row * 32 + 4 * fq;
                        cc[m] = *(const f32x4*)cs; sn[m] = *(const f32x4*)(cs + (mode == 1 ? 32 : 16));
                    }
                }
#pragma unroll
                for (int m = 0; m < 4; ++m) {
                    const int row = u.pm * 256 + ai * 128 + wr * 64 + m * 16 + fr;
                    f32x4 v0 = acc[ai][bj][m][0], v1 = acc[ai][bj][m][1];
                    if (mode) rot4(v0, v1, cc[m], sn[m]);
                    v0 = v0 * sc; v1 = v1 * sc;
                    const size_t drow = gm ? (size_t)(((row >> 12) * 2 + g) * SP + (row & 4095)) : (size_t)row;
                    *(u32x4*)(base + drow * ld + dcol + 8 * fq) = pack8(v0, v1);
                }
            }
        }
    }
};
struct EpiCmp {
    static constexpr bool PERM = true, AFTER_DRAIN = true;
    const float* B1P; const bf16* W2T; const float *B2K, *B2V; bf16 *KC, *VC; const float* CS64;
    DI void fused(const AccT& acc, const Unit& u, int wr, int wc, int fr, int fq, LAS unsigned char* lds, int wid, int lane) const {
        constexpr int HST = 528;
        const int kv = u.e, bg = u.pm & 15;
#pragma unroll
        for (int bj = 0; bj < 2; ++bj) {
            const int col = bj * 128 + wc * 32 + 8 * fq;
            const f32x4 b0 = *(const f32x4*)(B1P + kv * 256 + col), b1 = *(const f32x4*)(B1P + kv * 256 + col + 4);
#pragma unroll
            for (int ai = 0; ai < 2; ++ai)
#pragma unroll
                for (int m = 0; m < 4; ++m) {
                    const int rl = ai * 128 + wr * 64 + m * 16 + fr;
                    f32x4 v0 = acc[ai][bj][m][0] + b0, v1 = acc[ai][bj][m][1] + b1;
#pragma unroll
                    for (int j = 0; j < 4; ++j) {
                        float x = v0[j]; float z = 0.7978845608028654f * (x + 0.044715f * x * x * x); v0[j] = x * sigmoidf_(2.f * z);
                        x = v1[j]; z = 0.7978845608028654f * (x + 0.044715f * x * x * x); v1[j] = x * sigmoidf_(2.f * z);
                    }
                    *(LAS u32x4*)(lds + rl * HST + col * 2) = pack8(v0, v1);
                }
        }
        asm volatile("s_waitcnt lgkmcnt(0)\n\ts_barrier" ::: "memory");
        const int r32 = lane & 31, hh = lane >> 5;
        f32x16 out0 = {0.f, 0.f, 0.f, 0.f, 0.f, 0.f, 0.f, 0.f, 0.f, 0.f, 0.f, 0.f, 0.f, 0.f, 0.f, 0.f}, out1 = out0;
        const bf16* w2 = W2T + (size_t)kv * 64 * 256;
#pragma unroll 4
        for (int ks = 0; ks < 16; ++ks) {
            const bf16x8 a = *(const LAS bf16x8*)(lds + (32 * wid + r32) * HST + (16 * ks + 8 * hh) * 2);
            const bf16x8 bq0 = *(const bf16x8*)(w2 + (size_t)r32 * 256 + 16 * ks + 8 * hh), bq1 = *(const bf16x8*)(w2 + (size_t)(32 + r32) * 256 + 16 * ks + 8 * hh);
            out0 = __builtin_amdgcn_mfma_f32_32x32x16_bf16(a, bq0, out0, 0, 0, 0); out1 = __builtin_amdgcn_mfma_f32_32x32x16_bf16(a, bq1, out1, 0, 0, 0);
        }
        const float* b2 = kv ? B2V : B2K;
        const float bb0 = b2[r32], bb1 = b2[32 + r32];
        const int b = bg >> 1;
#pragma unroll
        for (int i = 0; i < 16; ++i) {
            const int c = 32 * wid + 8 * (i >> 2) + 4 * hh + (i & 3);
            const size_t row = (size_t)bg * 256 + c;
            float x1 = out0[i] + bb0, x2 = out1[i] + bb1;
            if (c == 255) { x1 = 0.f; x2 = 0.f; }
            if (kv == 0) {
                const int tokr = (b * S + 16 * c + 31) & (T - 1);
                const float cs = CS64[(size_t)tokr * 64 + r32], sn = CS64[(size_t)tokr * 64 + 32 + r32];
                *(unsigned*)(KC + row * 64 + 2 * r32) = pk2(x1 * cs - x2 * sn, x2 * cs + x1 * sn);
            } else {
                VC[row * 64 + r32] = (bf16)(pk2(x1, 0.f) & 0xffffu); VC[row * 64 + 32 + r32] = (bf16)(pk2(x2, 0.f) & 0xffffu);
            }
        }
    }
};
struct EpiMla {
    static constexpr bool PERM = true, AFTER_DRAIN = false;
    bf16 *QM, *KN, *VM; const bf16 *CQ, *MISC; const float* CS32;
    DI void operator()(const AccT& acc, const Unit& u, int wr, int wc, int fr, int fq) const {
        float rstd[2][4];
#pragma unroll
        for (int ai = 0; ai < 2; ++ai)
#pragma unroll
            for (int m = 0; m < 4; ++m) {
                const int row = u.pm * 256 + ai * 128 + wr * 64 + m * 16 + fr;
                float ss = 0.f;
                if (u.e == 0) {
#pragma unroll
                    for (int c = 0; c < 8; ++c) { const u32x4 w = *(const u32x4*)(CQ + (size_t)row * 256 + fq * 64 + 8 * c);
                        ss += bflo(w.x) * bflo(w.x) + bfhi(w.x) * bfhi(w.x) + bflo(w.y) * bflo(w.y) + bfhi(w.y) * bfhi(w.y) + bflo(w.z) * bflo(w.z) + bfhi(w.z) * bfhi(w.z) + bflo(w.w) * bflo(w.w) + bfhi(w.w) * bfhi(w.w); }
                } else {
#pragma unroll
                    for (int c = 0; c < 4; ++c) { const u32x4 w = *(const u32x4*)(MISC + (size_t)row * 256 + fq * 32 + 8 * c);
                        ss += bflo(w.x) * bflo(w.x) + bfhi(w.x) * bfhi(w.x) + bflo(w.y) * bflo(w.y) + bfhi(w.y) * bfhi(w.y) + bflo(w.z) * bflo(w.z) + bfhi(w.z) * bfhi(w.z) + bflo(w.w) * bflo(w.w) + bfhi(w.w) * bfhi(w.w); }
                }
                ss += __shfl_xor(ss, 16); ss += __shfl_xor(ss, 32);
                rstd[ai][m] = rsqrtf(ss * (u.e == 0 ? (1.0f / 256.0f) : (1.0f / 128.0f)) + EPS);
            }
#pragma unroll
        for (int bj = 0; bj < 2; ++bj) {
            const int gc = u.pn * 256 + bj * 128 + wc * 32;
            bf16* base; int ld, dcol, rope = 0; float sc = 1.f;
            if (u.e == 0) { if (gc >= 384) continue; rope = ((gc >> 5) % 3) == 2; base = QM; ld = 384; dcol = gc; sc = SCL96; }
            else { const int head = gc >> 7, part = (gc & 127) >> 6, o = gc & 63; base = part ? VM : KN; ld = 256; dcol = head * 64 + o; }
#pragma unroll
            for (int ai = 0; ai < 2; ++ai) {
                f32x4 cc[4], sn[4];
                if (rope) {
#pragma unroll
                    for (int m = 0; m < 4; ++m) { const float* cs = CS32 + (size_t)(u.pm * 256 + ai * 128 + wr * 64 + m * 16 + fr) * 32 + 4 * fq; cc[m] = *(const f32x4*)cs; sn[m] = *(const f32x4*)(cs + 16); }
                }
#pragma unroll
                for (int m = 0; m < 4; ++m) {
                    const int row = u.pm * 256 + ai * 128 + wr * 64 + m * 16 + fr;
                    const float r = rstd[ai][m] * sc;
                    f32x4 v0 = acc[ai][bj][m][0] * r, v1 = acc[ai][bj][m][1] * r;
                    if (rope) rot4(v0, v1, cc[m], sn[m]);
                    *(u32x4*)(base + (size_t)row * ld + dcol + 8 * fq) = pack8(v0, v1);
                }
            }
        }
    }
};
struct EpiWout {
    static constexpr bool PERM = false, AFTER_DRAIN = false;
    bf16* X; const float* GT; size_t dofs;
    DI void operator()(const AccT& acc, const Unit& u, int wr, int wc, int fr, int fq) const {
        const int b = (u.pm * 256) >> 12;
        const int col0 = u.pn * 256 + wc * 32 + 4 * fq;
#pragma unroll
        for (int bj = 0; bj < 2; ++bj) {
#pragma unroll
            for (int n = 0; n < 2; ++n) {
                u32x2 xo[2][4];
                const f32x4 gt = *(const f32x4*)(GT + (size_t)b * 6144 + col0 + bj * 128 + n * 16);
#pragma unroll
                for (int ai = 0; ai < 2; ++ai)
#pragma unroll
                    for (int m = 0; m < 4; ++m) xo[ai][m] = *(const u32x2*)(X + (size_t)(u.pm * 256 + ai * 128 + wr * 64 + m * 16 + fr) * 1024 + col0 + bj * 128 + n * 16);
#pragma unroll
                for (int ai = 0; ai < 2; ++ai)
#pragma unroll
                    for (int m = 0; m < 4; ++m) {
                        bf16* p = X + (size_t)(u.pm * 256 + ai * 128 + wr * 64 + m * 16 + fr) * 1024 + col0 + bj * 128 + n * 16;
                        const f32x4 xv = (f32x4){bflo(xo[ai][m].x), bfhi(xo[ai][m].x), bflo(xo[ai][m].y), bfhi(xo[ai][m].y)} + gt * acc[ai][bj][m][n];
                        u32x2 w; w.x = pk2(xv[0], xv[1]); w.y = pk2(xv[2], xv[3]);
                        *(u32x2*)((char*)p + dofs) = w;
                    }
            }
        }
    }
};
struct EpiMoe1 {
    static constexpr bool PERM = true, PERM2 = true, AFTER_DRAIN = false; static constexpr int A_E8M0 = H8_E8M0;
    static constexpr bool ACC_BIAS = true;
    bf16* ACT; const float* B1;
    DI void bias(const Unit& u, int wc, int fq, f32x4 (&bv)[2][2]) const {
        const float* bp = B1 + (size_t)u.e * 2048 + u.pn * 256 + wc * 64 + 16 * fq;
#pragma unroll
        for (int bj = 0; bj < 2; ++bj) { bv[bj][0] = *(const f32x4*)(bp + 8 * bj); bv[bj][1] = *(const f32x4*)(bp + 8 * bj + 4); }
    }
    DI void operator()(const AccT& acc, const Unit& u, int wr, int wc, int fr, int fq) const {
        const int col = u.pn * 256 + wc * 64 + 16 * fq;
#pragma unroll
        for (int ai = 0; ai < 2; ++ai)
#pragma unroll
            for (int m = 0; m < 4; ++m) {
                const int row = u.pm * 256 + ai * 128 + wr * 64 + m * 16 + fr;
                float o[8];
#pragma unroll
                for (int bj = 0; bj < 2; ++bj) {
                    const f32x4 v0 = acc[ai][bj][m][0], v1 = acc[ai][bj][m][1];
#pragma unroll
                    for (int j = 0; j < 4; ++j) {
                        const float gl = fminf((j < 2) ? v0[2 * j] : v1[2 * j - 4], 7.0f);
                        const float li = fminf(fmaxf((j < 2) ? v0[2 * j + 1] : v1[2 * j - 3], -7.0f), 7.0f);
                        o[4 * bj + j] = gl * sigmoidf_(1.702f * gl) * (li + 1.0f);
                    }
                }
                u32x2 w8; w8.x = pk4_fp8s(o[0], o[1], o[2], o[3], A8_SCALE); w8.y = pk4_fp8s(o[4], o[5], o[6], o[7], A8_SCALE);
                *(u32x2*)((unsigned char*)ACT + (size_t)row * 1024 + (col >> 1)) = w8;
            }
    }
};
struct EpiMoe2 {
    static constexpr bool PERM = true, PERM2 = true, AFTER_DRAIN = false; static constexpr int A_E8M0 = A8_E8M0;
    static constexpr bool ACC_BIAS = true;
    unsigned char* Y2; const float* B2;
    DI void bias(const Unit& u, int wc, int fq, f32x4 (&bv)[2][2]) const {
        const float* bp = B2 + (size_t)u.e * 1024 + u.pn * 256 + wc * 64 + 16 * fq;
#pragma unroll
        for (int bj = 0; bj < 2; ++bj) { bv[bj][0] = *(const f32x4*)(bp + 8 * bj); bv[bj][1] = *(const f32x4*)(bp + 8 * bj + 4); }
    }
    DI void operator()(const AccT& acc, const Unit& u, int wr, int wc, int fr, int fq) const {
        const int col = u.pn * 256 + wc * 64 + 16 * fq;
#pragma unroll
        for (int ai = 0; ai < 2; ++ai)
#pragma unroll
            for (int m = 0; m < 4; ++m) {
                const size_t row = (size_t)u.pm * 256 + ai * 128 + wr * 64 + m * 16 + fr;
                u32x4 w8;
                { const f32x4 v0 = acc[ai][0][m][0], v1 = acc[ai][0][m][1]; w8.x = pk4_fp8(v0[0], v0[1], v0[2], v0[3]); w8.y = pk4_fp8(v1[0], v1[1], v1[2], v1[3]); }
                { const f32x4 v0 = acc[ai][1][m][0], v1 = acc[ai][1][m][1]; w8.z = pk4_fp8(v0[0], v0[1], v0[2], v0[3]); w8.w = pk4_fp8(v1[0], v1[1], v1[2], v1[3]); }
                *(u32x4*)(Y2 + row * 1024 + col) = w8;
            }
    }
};

#define MFMA32(a, b, c) __builtin_amdgcn_mfma_f32_32x32x16_bf16((a), (b), (c), 0, 0, 0)
typedef short v4i16_t __attribute__((ext_vector_type(4)));
DI s16x4 tr_read(const LAS unsigned char* p) { return __builtin_bit_cast(s16x4, __builtin_amdgcn_ds_read_tr16_b64_v4i16((LAS v4i16_t*)p)); }
constexpr int VST = 144;
template <int DQ> struct AC { static constexpr int KST = DQ * 2 + 16, KS = DQ / 16, KBUF = 64 * KST, VBUF = 64 * VST, BUF = KBUF + VBUF; };

template <int DQ>
DI void qk_tile(const LAS unsigned char* kb, const bf16x8 (&qf)[DQ / 16], f32x16 (&s)[2], const f32x16& cinit, int lane) {
    const int r32 = lane & 31, hh = lane >> 5;
    bf16x8 kf[2][DQ / 16];
#pragma unroll
    for (int rt = 0; rt < 2; ++rt)
#pragma unroll
        for (int ks = 0; ks < DQ / 16; ++ks) kf[rt][ks] = *(const LAS bf16x8*)(kb + (32 * rt + r32) * AC<DQ>::KST + (16 * ks + 8 * hh) * 2);
    f32x16 a0 = MFMA32(kf[0][0], qf[0], cinit), a1 = MFMA32(kf[1][0], qf[0], cinit);
#pragma unroll
    for (int ks = 1; ks < DQ / 16; ++ks) { a0 = MFMA32(kf[0][ks], qf[ks], a0); a1 = MFMA32(kf[1][ks], qf[ks], a1); }
    s[0] = a0; s[1] = a1;
}
DI float max3f_(float a, float b, float c) { return __builtin_fmaxf(__builtin_fmaxf(a, b), c); }
constexpr float RESC_THR = 8.0f;
template <int DQ, int KMUL, int VAR = 0>
DI void attn_tile(const LAS unsigned char* kb, const LAS unsigned char* vb, const bf16x8 (&qf)[DQ / 16], f32x16 (&o)[2], f32x16& negm, float& m, float& l,
                  int dq, unsigned maxd, bool lf, int lane, const bool MASKED) {
    const int hh = lane >> 5;
    if (VAR == 1) return;
    f32x16 s[2];
    qk_tile<DQ>(kb, qf, s, negm, lane);
    if (VAR == 2) { o[0] += s[0]; o[1] += s[1]; return; }
    const int i16 = lane & 15, q = i16 >> 2, p_ = i16 & 3, mh = (lane >> 4) & 1;
    const LAS unsigned char* vbase = vb + (4 * hh + q) * VST + 32 * mh + 8 * p_;
    s16x4 vlo[4][2], vhi[4][2];
#pragma unroll
    for (int st = 0; st < 4; ++st)
#pragma unroll
        for (int mt = 0; mt < 2; ++mt) { vlo[st][mt] = tr_read(vbase + (16 * st) * VST + 64 * mt); vhi[st][mt] = tr_read(vbase + (16 * st + 8) * VST + 64 * mt); }
    __builtin_amdgcn_sched_barrier(0);
    if (MASKED) {
#pragma unroll
        for (int rt = 0; rt < 2; ++rt)
#pragma unroll
            for (int i = 0; i < 16; ++i) {
                const int d = dq - (32 * rt + 8 * (i >> 2) + (i & 3)) * KMUL;
                s[rt][i] = ((unsigned)d <= maxd) ? s[rt][i] : -1e30f;
            }
    }
    float mx = max3f_(s[0][0], s[0][1], s[0][2]);
#pragma unroll
    for (int i = 3; i < 15; i += 2) mx = max3f_(mx, s[0][i], s[0][i + 1]);
    mx = max3f_(mx, s[0][15], s[1][0]);
#pragma unroll
    for (int i = 1; i < 15; i += 2) mx = max3f_(mx, s[1][i], s[1][i + 1]);
    mx = fmaxf(mx, s[1][15]);
    if (__ballot(lf && mx > RESC_THR) != 0ull) {
        float mc = lf ? mx : -1e30f;
        mc = fmaxf(mc, __shfl_xor(mc, 32));
        const float delta = mc > RESC_THR ? mc : 0.f;
        const float alpha = fast_exp2(-delta);
        m += delta; l *= alpha;
#pragma unroll
        for (int i = 0; i < 16; ++i) { negm[i] = -m; o[0][i] *= alpha; o[1][i] *= alpha; s[0][i] -= delta; s[1][i] -= delta; }
    }
    float ps = 0.f;
#pragma unroll
    for (int rt = 0; rt < 2; ++rt)
#pragma unroll
        for (int i = 0; i < 16; ++i) { const float p = fast_exp2(s[rt][i]); s[rt][i] = p; ps += p; }
    const unsigned lmask = lf ? 0xffffffffu : 0u;
    l += lf ? ps : 0.f;
    if (VAR == 3) { o[0] += s[0]; o[1] += s[1]; return; }
#pragma unroll
    for (int rt = 0; rt < 2; ++rt)
#pragma unroll
        for (int s2 = 0; s2 < 2; ++s2) {
            u32x4 pw; pw.x = pk2(s[rt][8 * s2 + 0], s[rt][8 * s2 + 1]) & lmask; pw.y = pk2(s[rt][8 * s2 + 2], s[rt][8 * s2 + 3]) & lmask;
            pw.z = pk2(s[rt][8 * s2 + 4], s[rt][8 * s2 + 5]) & lmask; pw.w = pk2(s[rt][8 * s2 + 6], s[rt][8 * s2 + 7]) & lmask;
            const bf16x8 pb = __builtin_bit_cast(bf16x8, pw);
#pragma unroll
            for (int mt = 0; mt < 2; ++mt) {
                const bf16x8 va = __builtin_shufflevector(vlo[2 * rt + s2][mt], vhi[2 * rt + s2][mt], 0, 1, 2, 3, 4, 5, 6, 7);
                o[mt] = MFMA32(va, pb, o[mt]);
            }
        }
}
constexpr int OSTAGE_WAVE = 32 * 144;
static_assert(102400 + 8 * OSTAGE_WAVE <= MISC_OFF, "O stage below the LDS control words");
struct ChunkId { DI u32x4 operator()(u32x4 v, int, int, int) const { return v; } };
template <class P, class Fx = ChunkId>
DI void store_o_rows(const P& p, LAS unsigned char* lds, int off, const f32x16 (&o)[2], float inv, int lane, int wave, const Fx& fx = Fx()) {
    LAS unsigned char* st = lds + off + wave * OSTAGE_WAVE;
    const int n = lane & 31, hh = lane >> 5;
#pragma unroll
    for (int mt = 0; mt < 2; ++mt)
#pragma unroll
        for (int a = 0; a < 4; ++a) {
            u32x2 w; w.x = pk2(o[mt][4 * a] * inv, o[mt][4 * a + 1] * inv); w.y = pk2(o[mt][4 * a + 2] * inv, o[mt][4 * a + 3] * inv);
            *(LAS u32x2*)(st + n * 144 + (32 * mt + 8 * a + 4 * hh) * 2) = w;
        }
    asm volatile("s_waitcnt lgkmcnt(0)" ::: "memory");
#pragma unroll
    for (int it = 0; it < 4; ++it) {
        const int r = (lane >> 3) + 8 * it, c = lane & 7;
        const u32x4 v = fx(*(const LAS u32x4*)(st + r * 144 + c * 16), wave, r, c);
        *(u32x4*)(p.orow(wave, r) + 8 * c) = v;
    }
}
DI void store_o(bf16* orow, const f32x16 (&o)[2], float inv, int lane) {
    const int hh = lane >> 5;
#pragma unroll
    for (int mt = 0; mt < 2; ++mt)
#pragma unroll
        for (int a = 0; a < 4; ++a) {
            u32x2 w; w.x = pk2(o[mt][4 * a] * inv, o[mt][4 * a + 1] * inv); w.y = pk2(o[mt][4 * a + 2] * inv, o[mt][4 * a + 3] * inv);
            *(u32x2*)(orow + 32 * mt + 8 * a + 4 * hh) = w;
        }
}

struct PolA {
    static constexpr bool HASFLAG = false, LSE = true; static constexpr int KMUL = 1;
    const bf16 *Q, *K, *V; bf16* O; float* LSEP; int b, h, d, r, c; unsigned maxd; int j0, j1;
    DI int ql(int w, int lane) const { return 256 * c + 32 * w + (lane & 31); }
    DI size_t trow(int l_) const { return (size_t)b * S + (size_t)l_ * d + r; }
    DI const bf16* qrow(int w, int lane) const { return Q + trow(ql(w, lane)) * 256 + h * 64; }
    DI int qv(int w, int lane) const { return ql(w, lane); }
    DI int qmin(int w) const { return 256 * c + 32 * w; }
    DI int qmax(int w) const { return 256 * c + 32 * w + 31; }
    DI int kv0(int j) const { return 256 * c - 128 + 64 * j; }
    DI const bf16* krow(int j, int row) const { return K + trow(kv0(j) + row) * 256 + h * 64; }
    DI const bf16* vrow(int j, int row) const { return V + trow(kv0(j) + row) * 256 + h * 64; }
    DI const bf16* rrow(int, int) const { return nullptr; }
    DI bool flag(int, int, int) const { return true; }
    DI bf16* orow(int w, int lane) const { return O + trow(ql(w, lane)) * 256 + h * 64; }
    DI void lse(int w, int lane, float v) const { LSEP[trow(ql(w, lane)) * 4 + h] = v; }
};
struct PolB {
    static constexpr bool LSE = false; static constexpr int KMUL = 1;
    const bf16 *Q, *K, *V; bf16* O; int b, g, qc; unsigned maxd; int j0, j1; u64 sel; bool hasflag;
    const bf16 *GC = nullptr, *GW = nullptr, *GM = nullptr;
    DI int tok(int w, int lane) const { return 64 * qc + 8 * w + ((lane & 31) >> 2); }
    DI const bf16* qrow(int w, int lane) const { return Q + ((size_t)b * S + tok(w, lane)) * 512 + (4 * g + (lane & 3)) * 64; }
    DI int qv(int w, int lane) const { return tok(w, lane); }
    DI int qmin(int w) const { return 64 * qc + 8 * w; }
    DI int qmax(int w) const { return 64 * qc + 8 * w + 7; }
    DI int kv0(int j) const { return 64 * j; }
    DI const bf16* krow(int j, int row) const { return K + ((size_t)b * S + 64 * j + row) * 128 + g * 64; }
    DI const bf16* vrow(int j, int row) const { return V + ((size_t)b * S + 64 * j + row) * 128 + g * 64; }
    DI const bf16* rrow(int, int) const { return nullptr; }
    DI bf16* orow(int w, int lane) const { return O + ((size_t)b * S + tok(w, lane)) * 512 + (4 * g + (lane & 3)) * 64; }
    DI void lse(int, int, float) const {}
};
struct PolM {
    static constexpr bool HASFLAG = false, LSE = false; static constexpr int KMUL = 1;
    const bf16 *Q, *KN, *KR, *V; bf16* O; int b, h, c; unsigned maxd; int j0, j1;
    DI int tok(int w, int lane) const { return 256 * c + 32 * w + (lane & 31); }
    DI const bf16* qrow(int w, int lane) const { return Q + ((size_t)b * S + tok(w, lane)) * 384 + h * 96; }
    DI int qv(int w, int lane) const { return tok(w, lane); }
    DI int qmin(int w) const { return 256 * c + 32 * w; }
    DI int qmax(int w) const { return 256 * c + 32 * w + 31; }
    DI int kv0(int j) const { return 64 * j; }
    DI const bf16* krow(int j, int row) const { return KN + ((size_t)b * S + 64 * j + row) * 256 + h * 64; }
    DI const bf16* vrow(int j, int row) const { return V + ((size_t)b * S + 64 * j + row) * 256 + h * 64; }
    DI const bf16* rrow(int j, int row) const { return KR + ((size_t)b * S + 64 * j + row) * 32; }
    DI bf16* orow(int w, int lane) const { return O + ((size_t)b * S + tok(w, lane)) * 256 + h * 64; }
    DI void lse(int, int, float) const {}
};

template <int DQ, class P, bool FLAG, int VAR = 0>
DI void attn_unit(const P& p, LAS unsigned char* lds, int tid, int lane, int wave, u64 sel) {
    typedef AC<DQ> C;
    const int hh = lane >> 5;
    const bf16* qrow = p.qrow(wave, lane);
    bf16x8 qf[DQ / 16];
#pragma unroll
    for (int ks = 0; ks < DQ / 16; ++ks) qf[ks] = *(const bf16x8*)(qrow + 16 * ks + 8 * hh);
#pragma unroll
    for (int ks = 0; ks < DQ / 16; ++ks) asm volatile("s_waitcnt vmcnt(0)" : "+v"(qf[ks]) :: "memory");
    const int qv = p.qv(wave, lane), wq0 = p.qmin(wave), wq1 = p.qmax(wave);
    f32x16 o[2];
#pragma unroll
    for (int mt = 0; mt < 2; ++mt)
#pragma unroll
        for (int i = 0; i < 16; ++i) o[mt][i] = 0.f;
    float m = 0.f, l = 0.f;
    f32x16 negm;
#pragma unroll
    for (int i = 0; i < 16; ++i) negm[i] = 0.f;
    const int j0 = p.j0, j1 = p.j1;
    const int lrow = tid >> 3, lch = tid & 7;
    u32x4 k0A, v0A, r0A = {0u, 0u, 0u, 0u}, k1A, v1A, r1A = {0u, 0u, 0u, 0u}, k0B, v0B, r0B = {0u, 0u, 0u, 0u}, k1B, v1B, r1B = {0u, 0u, 0u, 0u};
    constexpr int NLD = (DQ == 96) ? 6 : 4;
    const int npair = (j1 - j0 + 1) >> 1;
#define ATT_LOAD1(RK, RV, RR, j) do { const bf16* pk_ = p.krow((j), lrow) + 8 * lch; const bf16* pv_ = p.vrow((j), lrow) + 8 * lch; \
        asm volatile("global_load_dwordx4 %0, %2, off\n\tglobal_load_dwordx4 %1, %3, off" : "=&v"(RK), "=&v"(RV) : "v"(pk_), "v"(pv_) : "memory"); \
        if (DQ == 96) { const bf16* pr_ = p.rrow((j), (tid & 255) >> 2) + 8 * (tid & 3); asm volatile("global_load_dwordx4 %0, %1, off" : "=&v"(RR) : "v"(pr_) : "memory"); } } while (0)
#define ATT_LOADP(K0, V0, R0, K1, V1, R1, t) do { const int ja_ = j0 + 2 * (t), jb_ = ja_ + 1; \
        { const int jc_ = ja_ < j1 ? ja_ : j1 - 1; ATT_LOAD1(K0, V0, R0, jc_); } { const int jd_ = jb_ < j1 ? jb_ : j1 - 1; ATT_LOAD1(K1, V1, R1, jd_); } } while (0)
#define ATT_TILE(kb_, jt_) do { const int j_ = (jt_); const int kv0 = p.kv0(j_); \
        bool need = (j_ < j1) && (wq1 - kv0 >= 0) && ((long long)wq0 - (long long)(kv0 + 63 * P::KMUL) <= (long long)p.maxd); \
        const bool interior = (wq0 - (kv0 + 63 * P::KMUL) >= 0) && ((long long)wq1 - (long long)kv0 <= (long long)p.maxd); \
        bool lf = true; \
        if (FLAG) { lf = ((sel >> j_) & 1ull) != 0ull; need = need && (__ballot(lf) != 0ull); } \
        if (need) attn_tile<DQ, P::KMUL, VAR>((kb_), (kb_) + C::KBUF, qf, o, negm, m, l, qv - kv0 - 4 * hh * P::KMUL, p.maxd, lf, lane, !interior); } while (0)
#define ATT_STEP(K0, V0, R0, K1, V1, R1, tt) do { const int t_ = (tt); \
        LAS unsigned char* pbuf = lds + (t_ & 1) * (2 * C::BUF); \
        asm volatile("s_waitcnt vmcnt(%6)" : "+v"(K0), "+v"(V0), "+v"(R0), "+v"(K1), "+v"(V1), "+v"(R1) : "n"(NLD) : "memory"); \
        *(LAS u32x4*)(pbuf + lrow * C::KST + lch * 16) = K0; *(LAS u32x4*)(pbuf + C::KBUF + lrow * VST + lch * 16) = V0; \
        *(LAS u32x4*)(pbuf + C::BUF + lrow * C::KST + lch * 16) = K1; *(LAS u32x4*)(pbuf + C::BUF + C::KBUF + lrow * VST + lch * 16) = V1; \
        if (DQ == 96) { *(LAS u32x4*)(pbuf + ((tid & 255) >> 2) * C::KST + 128 + (tid & 3) * 16) = R0; *(LAS u32x4*)(pbuf + C::BUF + ((tid & 255) >> 2) * C::KST + 128 + (tid & 3) * 16) = R1; } \
        asm volatile("s_waitcnt lgkmcnt(0)\n\ts_barrier" ::: "memory"); \
        ATT_LOADP(K0, V0, R0, K1, V1, R1, t_ + 2); \
        if (ATT_STAGGER > 0 && wave >= 4) __builtin_amdgcn_s_sleep(ATT_STAGGER); \
        ATT_TILE(pbuf, j0 + 2 * t_); ATT_TILE(pbuf + C::BUF, j0 + 2 * t_ + 1); } while (0)
    ATT_LOADP(k0A, v0A, r0A, k1A, v1A, r1A, 0);
    ATT_LOADP(k0B, v0B, r0B, k1B, v1B, r1B, 1);
    if (wave >= 4) __builtin_amdgcn_s_setprio(1);
#pragma unroll 1
    for (int t = 0; t < npair; t += 2) {
        ATT_STEP(k0A, v0A, r0A, k1A, v1A, r1A, t);
        ATT_STEP(k0B, v0B, r0B, k1B, v1B, r1B, t + 1);
    }
    __builtin_amdgcn_s_setprio(0);
    asm volatile("s_waitcnt vmcnt(0)" : "+v"(k0A), "+v"(v0A), "+v"(r0A), "+v"(k1A), "+v"(v1A), "+v"(r1A), "+v"(k0B), "+v"(v0B), "+v"(r0B), "+v"(k1B), "+v"(v1B), "+v"(r1B) :: "memory");
#undef ATT_LOAD1
#undef ATT_LOADP
#undef ATT_TILE
#undef ATT_STEP
    const float lt = l + __shfl_xor(l, 32);
    const float inv = lt > 0.f ? 1.0f / lt : 0.f;
    if constexpr (FLAG) {
        struct Gate { const P& p;
            DI u32x4 operator()(u32x4 v, int w_, int r, int c) const {
                const size_t tg = (size_t)p.b * S + 64 * p.qc + 8 * w_ + (r >> 2); const int hd = 4 * p.g + (r & 3);
                const bf16* gl = p.GM + tg * 256 + 160 + hd * 3;
                const float g0 = sigmoidf_(bf2f(gl[0])), g1 = sigmoidf_(bf2f(gl[1])), g2 = sigmoidf_(bf2f(gl[2]));
                const u32x4 a = *(const u32x4*)(p.GC + tg * 512 + hd * 64 + 8 * c), d = *(const u32x4*)(p.GW + tg * 512 + hd * 64 + 8 * c);
                u32x4 r_;
                r_.x = pk2(g0 * bflo(a.x) + g1 * bflo(v.x) + g2 * bflo(d.x), g0 * bfhi(a.x) + g1 * bfhi(v.x) + g2 * bfhi(d.x));
                r_.y = pk2(g0 * bflo(a.y) + g1 * bflo(v.y) + g2 * bflo(d.y), g0 * bfhi(a.y) + g1 * bfhi(v.y) + g2 * bfhi(d.y));
                r_.z = pk2(g0 * bflo(a.z) + g1 * bflo(v.z) + g2 * bflo(d.z), g0 * bfhi(a.z) + g1 * bfhi(v.z) + g2 * bfhi(d.z));
                r_.w = pk2(g0 * bflo(a.w) + g1 * bflo(v.w) + g2 * bflo(d.w), g0 * bfhi(a.w) + g1 * bfhi(v.w) + g2 * bfhi(d.w));
                return r_; } } gate{p};
        store_o_rows(p, lds, 90112, o, inv, lane, wave, gate);
    } else store_o_rows(p, lds, DQ == 96 ? 102400 : 90112, o, inv, lane, wave);
    if (P::LSE) { if (hh == 0) p.lse(wave, lane, m + __log2f(lt)); }
    __syncthreads();
}

DI u64 cmp_unit(const Ctx& F, int b, int g, int qc) {
    constexpr int KST = 144;
    LAS unsigned char* KL = F.lds; LAS unsigned char* VL = F.lds + 256 * KST; LAS float* IMP = (LAS float*)(F.lds + 2 * 256 * KST);
    const bf16* KC = (const bf16*)(F.ws + WS_KC) + (size_t)(b * 2 + g) * 256 * 64;
    const bf16* VC = (const bf16*)(F.ws + WS_VC) + (size_t)(b * 2 + g) * 256 * 64;
    const int tid = F.tid, lane = F.lane, w = F.wave, hh = lane >> 5, r32 = lane & 31;
#pragma unroll
    for (int it = 0; it < 4; ++it) { const int idx = tid + 512 * it, row = idx >> 3, ch = idx & 7;
        *(LAS u32x4*)(KL + row * KST + ch * 16) = *(const u32x4*)(KC + row * 64 + ch * 8);
        *(LAS u32x4*)(VL + row * VST + ch * 16) = *(const u32x4*)(VC + row * 64 + ch * 8); }
    __syncthreads();
    const int tokl = 8 * w + (r32 >> 2), tok = 64 * qc + tokl, head = 4 * g + (lane & 3);
    const bf16* qrow = (const bf16*)(F.ws + WS_QB) + ((size_t)b * S + tok) * 512 + head * 64;
    bf16x8 qf[4];
#pragma unroll
    for (int ks = 0; ks < 4; ++ks) qf[ks] = *(const bf16x8*)(qrow + 16 * ks + 8 * hh);
    const int qv = tok - 31, wq1 = 64 * qc + 8 * w + 7 - 31;
    f32x16 o[2];
#pragma unroll
    for (int mt = 0; mt < 2; ++mt)
#pragma unroll
        for (int i = 0; i < 16; ++i) o[mt][i] = 0.f;
    float m = 0.f, l = 0.f;
    f32x16 negm;
#pragma unroll
    for (int i = 0; i < 16; ++i) negm[i] = 0.f;
    const int wq0 = 64 * qc + 8 * w - 31;
#pragma unroll 1
    for (int jt = 0; jt < 4; ++jt) {
        if (wq1 - 1024 * jt >= 0) {
            const int dq = qv - 1024 * jt - 4 * hh * 16;
            attn_tile<64, 16>(KL + jt * 64 * KST, VL + jt * 64 * VST, qf, o, negm, m, l, dq, 0x7fffffffu, true, lane, !(wq0 - (1024 * jt + 63 * 16) >= 0));
        }
    }
    const float lt = l + __shfl_xor(l, 32);
    const float inv = lt > 0.f ? 1.0f / lt : 0.f;
    { struct { bf16* O; int b, g, qc; DI bf16* orow(int w_, int n_) const { return O + ((size_t)b * S + 64 * qc + 8 * w_ + (n_ >> 2)) * 512 + (4 * g + (n_ & 3)) * 64; } } pc{(bf16*)(F.ws + WS_OCMP), b, g, qc};
      store_o_rows(pc, F.lds, 90112, o, inv, lane, w); }
    float prev = 0.f;
#pragma unroll 1
    for (int jt = 0; jt < 4; ++jt) {
        const bool need = (wq1 - 1024 * jt >= 0);
        f32x16 s[2];
        if (need) qk_tile<64>(KL + jt * 64 * KST, qf, s, negm, lane);
#pragma unroll
        for (int rt = 0; rt < 2; ++rt)
#pragma unroll
            for (int a = 0; a < 4; ++a) {
                float mainp = 0.f, sp = 0.f;
                if (need) {
                    float pb[4];
#pragma unroll
                    for (int bb = 0; bb < 4; ++bb) { const int kidx = 64 * jt + 32 * rt + 8 * a + 4 * hh + bb; const bool ok = (qv - 16 * kidx) >= 0; pb[bb] = ok ? fast_exp2(s[rt][4 * a + bb]) * inv : 0.f; }
                    mainp = pb[0] + pb[1] + pb[2] + 0.5f * pb[3]; sp = 0.5f * pb[3];
                }
                const float rc = __shfl_xor(sp, 32);
                float v = mainp + (hh ? rc : prev);
                prev = rc;
                v += __shfl_xor(v, 1); v += __shfl_xor(v, 2);
                if ((lane & 3) == 0) IMP[tokl * 64 + 2 * (8 * jt + 4 * rt + a) + hh] = v;
            }
    }
    __syncthreads();
    u64 mysel = 0ull;
#pragma unroll 1
    for (int tk = 0; tk < 8; ++tk) {
        const int tl = 8 * w + tk, t = 64 * qc + tl, j = lane;
        const float v = IMP[tl * 64 + j];
        const bool forced = (j == 0) || (j == qc) || (j == qc - 1);
        const bool valid = j <= qc;
        const float score = forced ? v + 1e4f : (valid ? v : -1.0f);
        int rank = 0;
#pragma unroll
        for (int jp = 0; jp < 64; ++jp) { const float o_ = __builtin_bit_cast(float, __builtin_amdgcn_readlane(__builtin_bit_cast(int, score), jp)); rank += ((o_ > score) || (o_ == score && jp < j)) ? 1 : 0; }
        const u64 mask = __ballot(rank < 16);
        (void)t;
        if (tk == (r32 >> 2)) mysel = mask;
    }
    __syncthreads();
    return mysel;
}

DI void moe_tables(const Ctx& F, int l) {
    LAS int* tb = (LAS int*)(F.lds + AUX_OFF); LAS int* cn = tb + 64;
    if (F.tid == 0) {
        const unsigned* C = (const unsigned*)(F.ws + WS_CTL) + CW_CNT + l * 32 * 64;
        int acc = 0;
        for (int e = 0; e < 32; ++e) { const int c = (int)__hip_atomic_load(C + e * 64, RLX_AGENT); tb[e] = acc; cn[e] = c; acc += (c + 255) >> 8; }
        tb[32] = acc;
    }
    __syncthreads();
}
template <int MODE>
DI void phase_norm1(const Ctx& F, int l) {
    const float* mods = (const float*)(F.ws + WS_MODS);
    const bf16* X = (const bf16*)(F.ws + WS_X); bf16* H = (bf16*)(F.ws + F.dofs + WS_H); bf16* XW = (bf16*)(F.ws + F.dofs + WS_X);
    const LAS int* tb = (const LAS int*)(F.lds + AUX_OFF);
    if (l > 0) moe_tables(F, l - 1);
    const int gw = F.blk * 8 + F.wave, NGW = F.G * 8, lane = F.lane;
    for (int tok = gw; tok < T; tok += NGW) {
        const int b = tok >> 12;
        f32x4 v[4];
        if (l == 0) { const float* xr = ginp(F, I_X) + (size_t)tok * 1024;
#pragma unroll
            for (int k = 0; k < 4; ++k) v[k] = *(const f32x4*)(xr + 4 * lane + 256 * k);
        } else { const bf16* xr = X + (size_t)tok * 1024;
#pragma unroll
            for (int k = 0; k < 4; ++k) { const u32x2 w = *(const u32x2*)(xr + 4 * lane + 256 * k); v[k] = (f32x4){bflo(w.x), bfhi(w.x), bflo(w.y), bfhi(w.y)}; }
        }
        if (l > 0) {
            f32x4 y[4];
#pragma unroll
            for (int k = 0; k < 4; ++k) y[k] = (f32x4){0.f, 0.f, 0.f, 0.f};
            const int* ts = (const int*)(F.ws + WS_TOKSLOT) + (size_t)tok * 4;
            const f32x4 tg = *(const f32x4*)((const float*)(F.ws + WS_TOKG) + (size_t)tok * 4) * Y2_ISCALE;
#pragma unroll
            for (int s = 0; s < 4; ++s) {
                const int pk = ts[s]; const int e = pk >> 16, pos = pk & 0xffff;
                const unsigned char* yr = (const unsigned char*)(F.ws + WS_Y2) + ((size_t)tb[e] * 256 + pos) * 1024;
#pragma unroll
                for (int k = 0; k < 4; ++k) { const unsigned w = *(const unsigned*)(yr + 4 * lane + 256 * k); y[k] += unpk4_fp8(w) * tg[s]; }
            }
            const float* gt2 = mods + ((size_t)((l - 1) * 8 + b) * 6 + 5) * 1024;
#pragma unroll
            for (int k = 0; k < 4; ++k) v[k] = v[k] + *(const f32x4*)(gt2 + 4 * lane + 256 * k) * y[k];
        }
        float ss = 0.f;
#pragma unroll
        for (int k = 0; k < 4; ++k) ss += v[k][0] * v[k][0] + v[k][1] * v[k][1] + v[k][2] * v[k][2] + v[k][3] * v[k][3];
        const float rstd = rsqrtf(wave_sum(ss) * (1.0f / 1024.0f) + EPS);
        if (MODE == 0) {
            const float* g1 = ginp(F, I_G1) + (size_t)l * 1024;
            const float* sh = mods + ((size_t)(l * 8 + b) * 6 + 0) * 1024; const float* sc = sh + 1024;
#pragma unroll
            for (int k = 0; k < 4; ++k) {
                const int c = 4 * lane + 256 * k;
                { u32x2 xw; xw.x = pk2(v[k][0], v[k][1]); xw.y = pk2(v[k][2], v[k][3]); *(u32x2*)(XW + (size_t)tok * 1024 + c) = xw; }
                const f32x4 hv = v[k] * rstd * *(const f32x4*)(g1 + c) * (*(const f32x4*)(sc + c) + 1.0f) + *(const f32x4*)(sh + c);
                u32x2 w; w.x = pk2(hv[0], hv[1]); w.y = pk2(hv[2], hv[3]);
                *(u32x2*)(H + (size_t)tok * 1024 + c) = w;
            }
        } else {
            const float* gf = ginp(F, I_GF);
#pragma unroll
            for (int k = 0; k < 4; ++k) { const int c = 4 * lane + 256 * k; *(f32x4*)(gout(F) + (size_t)tok * 1024 + c) = v[k] * rstd * *(const f32x4*)(gf + c); }
        }
    }
}
DI void phase_prep(const Ctx& F) {
    const bf16* CQ = (const bf16*)(F.ws + WS_CQ); const bf16* MISC = (const bf16*)(F.ws + WS_MISC);
    float* RQ = (float*)(F.ws + WS_RSTDQ); float* RKV = (float*)(F.ws + WS_RSTDKV);
    bf16* KR = (bf16*)(F.ws + WS_KR); float* GATES = (float*)(F.ws + WS_GATES); const float* CS32 = (const float*)(F.ws + WS_CS32);
    const int gw = F.blk * 8 + F.wave, NGW = F.G * 8, lane = F.lane;
    for (int tok = gw; tok < T; tok += NGW) {
        const u32x2 wq = *(const u32x2*)(CQ + (size_t)tok * 256 + 4 * lane);
        const u32x2 wm = *(const u32x2*)(MISC + (size_t)tok * 256 + 4 * lane);
        float a0 = bflo(wq.x), a1 = bfhi(wq.x), a2 = bflo(wq.y), a3 = bfhi(wq.y);
        const float sq = wave_sum(a0 * a0 + a1 * a1 + a2 * a2 + a3 * a3);
        float m0 = bflo(wm.x), m1 = bfhi(wm.x), m2 = bflo(wm.y), m3 = bfhi(wm.y);
        const float skv = wave_sum(lane < 32 ? (m0 * m0 + m1 * m1 + m2 * m2 + m3 * m3) : 0.f);
        if (lane == 0) { RQ[tok] = rsqrtf(sq * (1.0f / 256.0f) + EPS); RKV[tok] = rsqrtf(skv * (1.0f / 128.0f) + EPS); }
        const float p0 = __shfl_xor(m0, 4), p1 = __shfl_xor(m1, 4), p2 = __shfl_xor(m2, 4), p3 = __shfl_xor(m3, 4);
        if (lane >= 32 && lane < 36) {
            const int i0 = 4 * (lane - 32);
            const f32x4 c4 = *(const f32x4*)(CS32 + (size_t)tok * 32 + i0), s4 = *(const f32x4*)(CS32 + (size_t)tok * 32 + 16 + i0);
            u32x4 w;
            w.x = pk2(m0 * c4[0] - p0 * s4[0], p0 * c4[0] + m0 * s4[0]); w.y = pk2(m1 * c4[1] - p1 * s4[1], p1 * c4[1] + m1 * s4[1]);
            w.z = pk2(m2 * c4[2] - p2 * s4[2], p2 * c4[2] + m2 * s4[2]); w.w = pk2(m3 * c4[3] - p3 * s4[3], p3 * c4[3] + m3 * s4[3]);
            *(u32x4*)(KR + (size_t)tok * 32 + 2 * i0) = w;
        }
        if (lane >= 40 && lane < 46) {
            const int gi = 4 * (lane - 40);
            *(f32x4*)(GATES + (size_t)tok * 24 + gi) = (f32x4){sigmoidf_(m0), sigmoidf_(m1), sigmoidf_(m2), sigmoidf_(m3)};
        }
    }
}
DI void phase_cmp2(const Ctx& F, int l) {
    const bf16* HID = (const bf16*)(F.ws + WS_HID);
    const float* CS64 = (const float*)(F.ws + WS_CS64);
    const int gw = F.blk * 8 + F.wave, NGW = F.G * 8, lane = F.lane;
    for (int it = gw; it < 8192; it += NGW) {
        const int kv = it >> 12, row = it & 4095, c = row & 255, bg = row >> 8;
        const float* w2 = ginp(F, kv ? I_W2V : I_W2K) + (size_t)l * 256 * 64;
        const float* b2 = ginp(F, kv ? I_B2V : I_B2K) + (size_t)l * 64;
        const u32x2 hw = *(const u32x2*)(HID + ((size_t)kv * 4096 + row) * 256 + 4 * lane);
        const float h0 = bflo(hw.x), h1 = bfhi(hw.x), h2 = bflo(hw.y), h3 = bfhi(hw.y);
        float acc = b2[lane];
#pragma unroll 4
        for (int k4 = 0; k4 < 64; ++k4) {
            const float x0 = __builtin_bit_cast(float, __builtin_amdgcn_readlane(__builtin_bit_cast(int, h0), k4));
            const float x1 = __builtin_bit_cast(float, __builtin_amdgcn_readlane(__builtin_bit_cast(int, h1), k4));
            const float x2 = __builtin_bit_cast(float, __builtin_amdgcn_readlane(__builtin_bit_cast(int, h2), k4));
            const float x3 = __builtin_bit_cast(float, __builtin_amdgcn_readlane(__builtin_bit_cast(int, h3), k4));
            acc += x0 * w2[(4 * k4 + 0) * 64 + lane] + x1 * w2[(4 * k4 + 1) * 64 + lane] + x2 * w2[(4 * k4 + 2) * 64 + lane] + x3 * w2[(4 * k4 + 3) * 64 + lane];
        }
        if (c == 255) acc = 0.f;
        if (kv == 0) {
            const int b = bg >> 1, tokr = b * S + 16 * c + 31;
            const float other = __shfl_xor(acc, 32);
            const int i = lane & 31;
            const float cs = CS64[(size_t)(tokr & (T - 1)) * 64 + i], sn = CS64[(size_t)(tokr & (T - 1)) * 64 + 32 + i];
            const float y = (lane < 32) ? (acc * cs - other * sn) : (acc * cs + other * sn);
            ((bf16*)(F.ws + WS_KC))[(size_t)row * 64 + 2 * i + (lane >> 5)] = (bf16)(pk2(y, 0.f) & 0xffffu);
        } else {
            ((bf16*)(F.ws + WS_VC))[(size_t)row * 64 + lane] = (bf16)(pk2(acc, 0.f) & 0xffffu);
        }
    }
}
DI void phase_mix(const Ctx& F, int l) {
    const bf16* OA3 = (const bf16*)(F.ws + WS_OA3); const float* LSEA = (const float*)(F.ws + WS_LSEA);
    const bf16* OCMP = (const bf16*)(F.ws + WS_OCMP); const bf16* OSLC = (const bf16*)(F.ws + WS_OSLC); const bf16* OWIN = (const bf16*)(F.ws + WS_OWIN);
    const bf16* OC = (const bf16*)(F.ws + WS_OC); const bf16* MISC = (const bf16*)(F.ws + WS_MISC);
    bf16* AMIX = (bf16*)(F.ws + WS_AMIX);
    const float* ga = ginp(F, I_GOA) + (size_t)l * 256; const float* gb = ginp(F, I_GOB) + (size_t)l * 512; const float* gc = ginp(F, I_GOC) + (size_t)l * 256;
    const int gw = F.blk * 8 + F.wave, NGW = F.G * 8, lane = F.lane, ha = lane >> 4;
    for (int tok0 = gw; tok0 < T; tok0 += 2 * NGW) {
        int tok[2]; tok[0] = tok0; tok[1] = (tok0 + NGW < T) ? tok0 + NGW : tok0;
        float ls[2][3]; u32x2 wa[2][3], wb[2][2], wc_[2];
#pragma unroll
        for (int q = 0; q < 2; ++q) {
#pragma unroll
            for (int p = 0; p < 3; ++p) { ls[q][p] = LSEA[((size_t)p * T + tok[q]) * 4 + ha]; wa[q][p] = *(const u32x2*)(OA3 + ((size_t)p * T + tok[q]) * 256 + 4 * lane); }
#pragma unroll
            for (int k = 0; k < 2; ++k) {
                const int col = 256 * k + 4 * lane;
                wb[q][k] = *(const u32x2*)(OSLC + (size_t)tok[q] * 512 + col);
            }
            wc_[q] = *(const u32x2*)(OC + (size_t)tok[q] * 256 + 4 * lane);
        }
        f32x4 va[2], vb[2][2], vc[2]; float red[2][3];
#pragma unroll
        for (int q = 0; q < 2; ++q) {
            const float mx = fmaxf(ls[q][0], fmaxf(ls[q][1], ls[q][2]));
            const float w0 = fast_exp2(ls[q][0] - mx), w1 = fast_exp2(ls[q][1] - mx), w2 = fast_exp2(ls[q][2] - mx), wi = 1.0f / (w0 + w1 + w2);
            va[q] = ((f32x4){bflo(wa[q][0].x), bfhi(wa[q][0].x), bflo(wa[q][0].y), bfhi(wa[q][0].y)} * w0 + (f32x4){bflo(wa[q][1].x), bfhi(wa[q][1].x), bflo(wa[q][1].y), bfhi(wa[q][1].y)} * w1
                   + (f32x4){bflo(wa[q][2].x), bfhi(wa[q][2].x), bflo(wa[q][2].y), bfhi(wa[q][2].y)} * w2) * wi;
            red[q][0] = va[q][0] * va[q][0] + va[q][1] * va[q][1] + va[q][2] * va[q][2] + va[q][3] * va[q][3];
            float sb = 0.f;
#pragma unroll
            for (int k = 0; k < 2; ++k) {
                const u32x2 a = wb[q][k];
                vb[q][k][0] = bflo(a.x); vb[q][k][1] = bfhi(a.x); vb[q][k][2] = bflo(a.y); vb[q][k][3] = bfhi(a.y);
                sb += vb[q][k][0] * vb[q][k][0] + vb[q][k][1] * vb[q][k][1] + vb[q][k][2] * vb[q][k][2] + vb[q][k][3] * vb[q][k][3];
            }
            red[q][1] = sb;
            vc[q] = (f32x4){bflo(wc_[q].x), bfhi(wc_[q].x), bflo(wc_[q].y), bfhi(wc_[q].y)};
            red[q][2] = vc[q][0] * vc[q][0] + vc[q][1] * vc[q][1] + vc[q][2] * vc[q][2] + vc[q][3] * vc[q][3];
        }
#pragma unroll
        for (int q = 0; q < 2; ++q)
#pragma unroll
            for (int j = 0; j < 3; ++j) red[q][j] = wave_sum(red[q][j]);
#pragma unroll
        for (int q = 0; q < 2; ++q) {
            if (q == 1 && tok0 + NGW >= T) break;
            const float ra = rsqrtf(red[q][0] * (1.0f / 256.0f) + EPS), rb = rsqrtf(red[q][1] * (1.0f / 512.0f) + EPS), rc = rsqrtf(red[q][2] * (1.0f / 256.0f) + EPS);
            bf16* orow = AMIX + (size_t)tok[q] * 1024;
            { const f32x4 o = va[q] * ra * *(const f32x4*)(ga + 4 * lane); u32x2 w; w.x = pk2(o[0], o[1]); w.y = pk2(o[2], o[3]); *(u32x2*)(orow + 4 * lane) = w; }
#pragma unroll
            for (int k = 0; k < 2; ++k) { const f32x4 o = vb[q][k] * rb * *(const f32x4*)(gb + 256 * k + 4 * lane); u32x2 w; w.x = pk2(o[0], o[1]); w.y = pk2(o[2], o[3]); *(u32x2*)(orow + 256 + 256 * k + 4 * lane) = w; }
            { const f32x4 o = vc[q] * rc * *(const f32x4*)(gc + 4 * lane); u32x2 w; w.x = pk2(o[0], o[1]); w.y = pk2(o[2], o[3]); *(u32x2*)(orow + 768 + 4 * lane) = w; }
        }
    }
}
DI void phase_router(const Ctx& F, int l) {
    LAS unsigned char* WH = F.lds; LAS unsigned char* WL = F.lds + 65536;
    LAS float* biasp = (LAS float*)(F.lds + AUX_OFF); LAS float* RS = biasp + 32;
    LAS int* lcnt = (LAS int*)(F.lds + AUX_OFF + 1024); LAS int* gbase = lcnt + 32;
    LAS int* tokE = gbase + 32; LAS float* tokG = (LAS float*)(tokE + 512); LAS int* tokP = (LAS int*)(tokG + 512);
    const float* wr = ginp(F, I_WR) + (size_t)l * 1024 * 32; const float* br = ginp(F, I_BR) + (size_t)l * 32;
    const float* mods = (const float*)(F.ws + WS_MODS); const bf16* X = (const bf16*)(F.ws + WS_X); bf16* H = (bf16*)(F.ws + F.dofs + WS_H);
    const float* g2 = ginp(F, I_G2) + (size_t)l * 1024;
    const int tid = F.tid, lane = F.lane, w = F.wave;
    if (tid < 32) lcnt[tid] = 0;
    unsigned* CNT = (unsigned*)(F.ws + WS_CTL) + CW_CNT + (l + F.dcnt) * 32 * 64;
    for (int chunk = F.blk; chunk < T / 128; chunk += F.G) {
        const int b = (chunk * 128) >> 12;
        const float* sh = mods + ((size_t)(l * 8 + b) * 6 + 3) * 1024; const float* sc = sh + 1024;
        {
            float bacc = 0.f; const int e = tid & 31;
#pragma unroll 4
            for (int it = 0; it < 32; ++it) {
                const int k = 2 * ((tid + 512 * it) >> 5);
                const float w0 = wr[k * 32 + e], w1 = wr[(k + 1) * 32 + e];
                const float p0 = w0 * (g2[k] * (sc[k] + 1.0f)), p1 = w1 * (g2[k + 1] * (sc[k + 1] + 1.0f));
                bacc += sh[k] * w0 + sh[k + 1] * w1;
                const unsigned hi = pk2(p0, p1);
                const unsigned lo = pk2(p0 - bflo(hi), p1 - bfhi(hi));
                const int off = e * 2048 + ((((k >> 3) ^ e) << 4) | ((k & 7) * 2));
                *(LAS unsigned*)(WH + off) = hi; *(LAS unsigned*)(WL + off) = lo;
            }
            tokG[tid] = bacc;
        }
        __syncthreads();
        if (tid < 32) { float s_ = br[tid];
#pragma unroll
            for (int j = 0; j < 16; ++j) s_ += tokG[tid + 32 * j];
            biasp[tid] = s_; }
        {
            u32x2 ra[4], rb[4];
            f32x4 ggv[4], hhv[4];
#pragma unroll
            for (int k = 0; k < 4; ++k) { const int c = 4 * lane + 256 * k; ggv[k] = *(const f32x4*)(g2 + c) * (*(const f32x4*)(sc + c) + 1.0f); hhv[k] = *(const f32x4*)(sh + c); }
            { const bf16* x0 = X + (size_t)(chunk * 128 + w * 16) * 1024 + 4 * lane;
#pragma unroll
              for (int k = 0; k < 4; ++k) { ra[k] = *(const u32x2*)(x0 + 256 * k); rb[k] = *(const u32x2*)(x0 + 1024 + 256 * k); } }
#pragma unroll 1
            for (int tt = 0; tt < 8; ++tt) {
                const int tl0 = w * 16 + 2 * tt, tok0 = chunk * 128 + tl0;
                f32x4 v[2][4]; float ss0 = 0.f, ss1 = 0.f;
#pragma unroll
                for (int k = 0; k < 4; ++k) { v[0][k] = (f32x4){bflo(ra[k].x), bfhi(ra[k].x), bflo(ra[k].y), bfhi(ra[k].y)}; v[1][k] = (f32x4){bflo(rb[k].x), bfhi(rb[k].x), bflo(rb[k].y), bfhi(rb[k].y)}; }
                { const int tn = (tt < 7) ? tok0 + 2 : tok0; const bf16* x0 = X + (size_t)tn * 1024 + 4 * lane;
#pragma unroll
                  for (int k = 0; k < 4; ++k) { ra[k] = *(const u32x2*)(x0 + 256 * k); rb[k] = *(const u32x2*)(x0 + 1024 + 256 * k); } }
#pragma unroll
                for (int k = 0; k < 4; ++k) { ss0 += v[0][k][0] * v[0][k][0] + v[0][k][1] * v[0][k][1] + v[0][k][2] * v[0][k][2] + v[0][k][3] * v[0][k][3];
                                              ss1 += v[1][k][0] * v[1][k][0] + v[1][k][1] * v[1][k][1] + v[1][k][2] * v[1][k][2] + v[1][k][3] * v[1][k][3]; }
                ss0 = wave_sum(ss0); ss1 = wave_sum(ss1);
                const float rs0 = rsqrtf(ss0 * (1.0f / 1024.0f) + EPS), rs1 = rsqrtf(ss1 * (1.0f / 1024.0f) + EPS);
                if (lane == 0) { RS[tl0] = rs0; RS[tl0 + 1] = rs1; }
#pragma unroll
                for (int k = 0; k < 4; ++k) {
                    const int c = 4 * lane + 256 * k;
                    v[0][k] = v[0][k] * rs0 * ggv[k] + hhv[k]; v[1][k] = v[1][k] * rs1 * ggv[k] + hhv[k];
                    *(unsigned*)((unsigned char*)H + (size_t)tok0 * 1024 + c) = pk4_fp8s(v[0][k][0], v[0][k][1], v[0][k][2], v[0][k][3], H8_SCALE);
                    *(unsigned*)((unsigned char*)H + (size_t)(tok0 + 1) * 1024 + c) = pk4_fp8s(v[1][k][0], v[1][k][1], v[1][k][2], v[1][k][3], H8_SCALE);
                }
            }
        }
        __syncthreads();
        f32x4 acc[2] = {{0.f, 0.f, 0.f, 0.f}, {0.f, 0.f, 0.f, 0.f}};
        {
            const int kg = lane >> 4, n16 = lane & 15;
            const bf16* xr = X + (size_t)(chunk * 128 + w * 16 + n16) * 1024 + 8 * kg;
#pragma unroll 1
            for (int k8 = 0; k8 < 4; ++k8) {
                bf16x8 af[8];
#pragma unroll
                for (int j = 0; j < 8; ++j) af[j] = *(const bf16x8*)(xr + 32 * (8 * k8 + j));
#pragma unroll
                for (int j = 0; j < 8; ++j) {
                    const int c = 4 * (8 * k8 + j) + kg;
#pragma unroll
                    for (int et = 0; et < 2; ++et) {
                        const int e = 16 * et + n16, off = e * 2048 + ((c ^ e) << 4);
                        const bf16x8 bh = *(const LAS bf16x8*)(WH + off), bl = *(const LAS bf16x8*)(WL + off);
                        acc[et] = __builtin_amdgcn_mfma_f32_16x16x32_bf16(af[j], bh, acc[et], 0, 0, 0);
                        acc[et] = __builtin_amdgcn_mfma_f32_16x16x32_bf16(af[j], bl, acc[et], 0, 0, 0);
                    }
                }
            }
        }
        __syncthreads();
        LAS float* LG = (LAS float*)(F.lds + w * 2048);
        {
            const int g4 = lane >> 4, n16 = lane & 15;
#pragma unroll
            for (int et = 0; et < 2; ++et)
#pragma unroll
                for (int i = 0; i < 4; ++i) LG[(4 * g4 + i) * 32 + 16 * et + n16] = acc[et][i] * RS[w * 16 + 4 * g4 + i] + biasp[16 * et + n16];
        }
        asm volatile("s_waitcnt lgkmcnt(0)" ::: "memory");
#pragma unroll 1
        for (int tt = 0; tt < 8; ++tt) {
            const int tl0 = w * 16 + 2 * tt;
            const float lg0 = LG[(2 * tt) * 32 + (lane >> 1)], lg1 = LG[(2 * tt + 1) * 32 + (lane >> 1)];
            int rk0 = 0, rk1 = 0; const int me = lane >> 1;
#pragma unroll
            for (int e = 0; e < 32; ++e) {
                const float o0 = __builtin_bit_cast(float, __builtin_amdgcn_readlane(__builtin_bit_cast(int, lg0), 2 * e));
                const float o1 = __builtin_bit_cast(float, __builtin_amdgcn_readlane(__builtin_bit_cast(int, lg1), 2 * e));
                rk0 += ((o0 > lg0) || (o0 == lg0 && e < me)) ? 1 : 0; rk1 += ((o1 > lg1) || (o1 == lg1 && e < me)) ? 1 : 0;
            }
#pragma unroll
            for (int tk = 0; tk < 2; ++tk) {
                const int rk = tk ? rk1 : rk0; const float lg = tk ? lg1 : lg0;
                int te[4]; float tv[4];
#pragma unroll
                for (int r = 0; r < 4; ++r) {
                    const u64 mk = __ballot(rk == r && (lane & 1) == 0);
                    const int sl = __builtin_amdgcn_readfirstlane((int)__builtin_ctzll(mk));
                    te[r] = sl >> 1; tv[r] = __builtin_bit_cast(float, __builtin_amdgcn_readlane(__builtin_bit_cast(int, lg), sl));
                }
                const float e1 = __expf(tv[1] - tv[0]), e2 = __expf(tv[2] - tv[0]), e3 = __expf(tv[3] - tv[0]);
                const float isum = 1.0f / (1.0f + e1 + e2 + e3);
                if (lane < 4) {
                    const int tl = tl0 + tk;
                    const int e = lane == 0 ? te[0] : lane == 1 ? te[1] : lane == 2 ? te[2] : te[3];
                    const float gte = (lane == 0 ? 1.0f : lane == 1 ? e1 : lane == 2 ? e2 : e3) * isum;
                    const int pos = atomicAdd((int*)(lcnt + e), 1);
                    tokE[tl * 4 + lane] = e; tokG[tl * 4 + lane] = gte; tokP[tl * 4 + lane] = pos;
                }
            }
        }
        __syncthreads();
        if (tid < 32) gbase[tid] = (int)__hip_atomic_fetch_add(CNT + tid * 64, (unsigned)lcnt[tid], RLX_AGENT);
        __syncthreads();
        {
            const int tl = tid >> 2, r = tid & 3, e = tokE[tid], pos = gbase[e] + tokP[tid], tok = chunk * 128 + tl;
            ((int*)(F.ws + F.dofs + WS_IDX))[(size_t)e * ECAP + pos] = tok;
            ((float*)(F.ws + F.dofs + WS_TOKG))[(size_t)tok * 4 + r] = tokG[tid];
            ((int*)(F.ws + F.dofs + WS_TOKSLOT))[(size_t)tok * 4 + r] = (e << 16) | pos;
        }
        __syncthreads();
        if (tid < 32) lcnt[tid] = 0;
        __syncthreads();
    }
}

DI int ropeperm64(int p) { return (p >> 1) + 32 * (p & 1); }
DI int cmap_win(int n) {
    const int tile = n >> 8, w = n & 255, hb = w & ~63, pp = ropeperm64(w & 63);
    switch (tile) {
        case 0: return hb + pp;
        case 1: return 256 + hb + pp;
        case 2: return 512 + w;
        case 3: return 768 + hb + pp;
        case 4: return 1024 + hb + pp;
        case 5: return w < 128 ? 1280 + w : 1408 + (w - 128);
        case 6: return w < 128 ? 1536 + hb + pp : 1664 + (w - 128);
        case 7: return w < 128 ? 1792 + hb + pp : 1920 + (w - 128);
        case 8: return 2072 + w;
        default: return w < 128 ? 2328 + w : (w < 160 ? 2456 + ((w - 128) >> 1) + 16 * ((w - 128) & 1) : (w < 184 ? 2048 + (w - 160) : -1));
    }
}
DI int cmap_qup(int n) { if (n >= 384) return -1; const int h = n / 96, w = n % 96; if (w < 64) return h * 96 + w; const int j = w - 64; return h * 96 + 64 + (j >> 1) + 16 * (j & 1); }
DI void tr_tile(const float* src, int K, int Nsrc, bf16* dst, int Kdst, int maptype, const float* ksc, int ntile, int ktile, LAS float* scr, int tid) {
    const int n0 = ntile * 64, k0 = ktile * 128, nl = tid & 63, n = n0 + nl;
    const int c = maptype == 0 ? (n < Nsrc ? n : -1) : (maptype == 1 ? cmap_win(n) : cmap_qup(n));
    float v[16];
#pragma unroll
    for (int it = 0; it < 16; ++it) { const int k = k0 + (tid >> 6) + 8 * it; v[it] = (c >= 0 && k < K) ? src[(size_t)k * Nsrc + c] * (ksc ? ksc[k] : 1.0f) : 0.f; }
#pragma unroll
    for (int it = 0; it < 16; ++it) scr[((tid >> 6) + 8 * it) * 65 + nl] = v[it];
    __syncthreads();
#pragma unroll
    for (int it = 0; it < 2; ++it) {
        const int idx = tid + 512 * it, nn = idx >> 4, ch = idx & 15;
        const LAS float* s = scr + (8 * ch) * 65 + nn;
        u32x4 o; o.x = pk2(s[0], s[65]); o.y = pk2(s[2 * 65], s[3 * 65]); o.z = pk2(s[4 * 65], s[5 * 65]); o.w = pk2(s[6 * 65], s[7 * 65]);
        *(u32x4*)(dst + (size_t)(n0 + nn) * Kdst + k0 + 8 * ch) = o;
    }
    __syncthreads();
}
DI void trb_load(f32x4 (&v)[16], const float* src, int N, int n0, int k0, int tid) {
#pragma unroll
    for (int it = 0; it < 16; ++it) v[it] = *(const f32x4*)(src + (size_t)(k0 + (tid >> 6) + 8 * it) * N + n0 + 4 * (tid & 63));
}
DI void trb_store(const f32x4 (&v)[16], bf16* dst, int Kd, int n0, int k0, LAS unsigned char* L, int tid, int wave, int lane, int f8 = 0) {
#pragma unroll
    for (int it = 0; it < 16; ++it) { f32x4 x = v[it];
        if (f8) { x[0] = q8s(x[0], W8_SCALE); x[1] = q8s(x[1], W8_SCALE); x[2] = q8s(x[2], W8_SCALE); x[3] = q8s(x[3], W8_SCALE); }
        u32x2 w; w.x = pk2(x[0], x[1]); w.y = pk2(x[2], x[3]); *(LAS u32x2*)(L + ((tid >> 6) + 8 * it) * 576 + (tid & 63) * 8) = w; }
    asm volatile("s_waitcnt lgkmcnt(0)\n\ts_barrier" ::: "memory");
    const int i = lane & 15, gn = (lane >> 4) & 1, h = lane >> 5, q = i >> 2, p = i & 3;
    const LAS unsigned char* base = L + (8 * h + q) * 576 + (32 * wave + 16 * gn) * 2 + 8 * p;
    if (!f8) {
        bf16* drow = dst + (size_t)(n0 + 32 * wave + 16 * gn + i) * Kd + k0 + 8 * h;
#pragma unroll
        for (int kcp = 0; kcp < 8; ++kcp) {
            const s16x4 lo = tr_read(base + (16 * kcp) * 576), hi = tr_read(base + (16 * kcp + 4) * 576);
            *(bf16x8*)(drow + 16 * kcp) = __builtin_shufflevector(lo, hi, 0, 1, 2, 3, 4, 5, 6, 7);
        }
    } else {
        unsigned char* drow = (unsigned char*)dst + (size_t)(n0 + 32 * wave + 16 * gn + i) * Kd + k0 + 8 * h;
#pragma unroll
        for (int kcp = 0; kcp < 8; ++kcp) {
            const s16x4 lo = tr_read(base + (16 * kcp) * 576), hi = tr_read(base + (16 * kcp + 4) * 576);
            int w0 = __builtin_amdgcn_cvt_pk_fp8_f32(bf2f((unsigned short)lo[0]), bf2f((unsigned short)lo[1]), 0, false); w0 = __builtin_amdgcn_cvt_pk_fp8_f32(bf2f((unsigned short)lo[2]), bf2f((unsigned short)lo[3]), w0, true);
            int w1 = __builtin_amdgcn_cvt_pk_fp8_f32(bf2f((unsigned short)hi[0]), bf2f((unsigned short)hi[1]), 0, false); w1 = __builtin_amdgcn_cvt_pk_fp8_f32(bf2f((unsigned short)hi[2]), bf2f((unsigned short)hi[3]), w1, true);
            u32x2 o; o.x = (unsigned)w0; o.y = (unsigned)w1;
            *(u32x2*)(drow + 16 * kcp) = o;
        }
    }
    asm volatile("s_waitcnt lgkmcnt(0)\n\ts_barrier" ::: "memory");
}
struct TrbItem { const float* src; bf16* dst; int N, n0, k0, f8; };
DI TrbItem trb_item(const Ctx& F, int it) {
    const int le = it / 96, r = it % 96; TrbItem t;
    if (r < 64) { t.src = ginp(F, I_WE1) + (size_t)le * 1024 * 2048; t.dst = (bf16*)(F.ws + WS_W1E + (size_t)le * 2048 * 1024); t.N = 2048; t.n0 = (r & 7) * 256; t.k0 = (r >> 3) * 128; t.f8 = 1; }
    else { const int q = r - 64; t.src = ginp(F, I_WE2) + (size_t)le * 1024 * 1024; t.dst = (bf16*)(F.ws + WS_W2E + (size_t)le * 1024 * 1024); t.N = 1024; t.n0 = (q & 3) * 256; t.k0 = (q >> 2) * 128; t.f8 = 1; }
    return t;
}
DI void conv_layer_tiles(const Ctx& F, int l, int q0, int i0, int cnt) {
    const int NL = 32 * 96;
    int it = q0 + F.blk + F.G * i0; const int end = q0 + F.blk + F.G * (i0 + cnt);
    if (it >= NL) return;
    f32x4 va[16];
    TrbItem ta = trb_item(F, l * NL + it);
    trb_load(va, ta.src, ta.N, ta.n0, ta.k0, F.tid);
#pragma unroll 1
    while (it < NL && it < end) {
        f32x4 vb[16];
#pragma unroll
        for (int k = 0; k < 16; ++k) vb[k] = va[k];
        const TrbItem tc = ta;
        it += F.G;
        const bool more = (it < NL && it < end);
        ta = trb_item(F, l * NL + (more ? it : 0));
        if (more) trb_load(va, ta.src, ta.N, ta.n0, ta.k0, F.tid);
        trb_store(vb, tc.dst, 1024, tc.n0, tc.k0, F.lds, F.tid, F.wave, F.lane, tc.f8);
    }
}
DI void conv_claim_tiles(const Ctx& F, int l, int quota) {
    const int NL = 32 * 96;
    volatile LAS unsigned* slot = (volatile LAS unsigned*)(F.lds + MISC_OFF) + 16;
    __syncthreads();
    if (F.tid == 0) { unsigned* q = (unsigned*)(F.ws + WS_CTL) + CW_CONVQ + l * 64; slot[0] = __hip_atomic_fetch_add(q, (unsigned)quota, __ATOMIC_RELAXED, __HIP_MEMORY_SCOPE_AGENT); }
    __syncthreads();
    int it = __builtin_amdgcn_readfirstlane((int)slot[0]); const int end = it + quota;
    if (it >= NL) return;
    f32x4 va[16];
    TrbItem ta = trb_item(F, l * NL + it);
    trb_load(va, ta.src, ta.N, ta.n0, ta.k0, F.tid);
#pragma unroll 1
    while (it < NL && it < end) {
        f32x4 vb[16];
#pragma unroll
        for (int k = 0; k < 16; ++k) vb[k] = va[k];
        const TrbItem tc = ta;
        it += 1;
        const bool more = (it < NL && it < end);
        ta = trb_item(F, l * NL + (more ? it : 0));
        if (more) trb_load(va, ta.src, ta.N, ta.n0, ta.k0, F.tid);
        trb_store(vb, tc.dst, 1024, tc.n0, tc.k0, F.lds, F.tid, F.wave, F.lane, tc.f8);
    }
}
DI void phase_prologue(const Ctx& F) {
    const Args& A = *F.a; const int tid = F.tid;
    LAS float* scr = (LAS float*)F.lds;
    if (!CONV_IN_LAYER) {
        const int NIT = DEPTH * 32 * 96;
        f32x4 va[16];
        int it = F.blk;
        TrbItem ta = trb_item(F, it < NIT ? it : 0);
        if (it < NIT) trb_load(va, ta.src, ta.N, ta.n0, ta.k0, tid);
#pragma unroll 1
        while (it < NIT) {
            f32x4 vb[16];
#pragma unroll
            for (int k = 0; k < 16; ++k) vb[k] = va[k];
            const TrbItem tc = ta;
            it += F.G;
            ta = trb_item(F, it < NIT ? it : 0);
            if (it < NIT) trb_load(va, ta.src, ta.N, ta.n0, ta.k0, tid);
            trb_store(vb, tc.dst, 1024, tc.n0, tc.k0, F.lds, tid, F.wave, F.lane, tc.f8);
        }
    }
    constexpr int PER_L = 8192 + 4096 + 320 + 128 + 128 + 16 + 16;
    for (int it = F.blk; it < DEPTH * PER_L; it += F.G) {
        const int l = it / PER_L; int r = it % PER_L;
        if (r < 8192 + 4096) continue;
        if (r < 8192) { const int e = r >> 8, t = r & 255;
            tr_tile(ginp(F, I_WE1) + ((size_t)(l * 32 + e)) * 1024 * 2048, 1024, 2048, (bf16*)(F.ws + WS_W1E) + ((size_t)(l * 32 + e)) * 2048 * 1024, 1024, 0, nullptr, t >> 3, t & 7, scr, tid); continue; }
        r -= 8192;
        if (r < 4096) { const int e = r >> 7, t = r & 127;
            tr_tile(ginp(F, I_WE2) + ((size_t)(l * 32 + e)) * 1024 * 1024, 1024, 1024, (bf16*)(F.ws + WS_W2E) + ((size_t)(l * 32 + e)) * 1024 * 1024, 1024, 0, nullptr, t >> 3, t & 7, scr, tid); continue; }
        r -= 4096;
        if (r < 320) { tr_tile(ginp(F, I_WIN) + (size_t)l * 1024 * 2488, 1024, 2488, (bf16*)(F.ws + WS_WIN) + (size_t)l * NIN * 1024, 1024, 1, nullptr, r >> 3, r & 7, scr, tid); continue; }
        r -= 320;
        if (r < 128) { tr_tile(ginp(F, I_WOUT) + (size_t)l * 1024 * 1024, 1024, 1024, (bf16*)(F.ws + WS_WOUT) + (size_t)l * 1024 * 1024, 1024, 0, nullptr, r >> 3, r & 7, scr, tid); continue; }
        r -= 128;
        if (r < 128) { const int kv = r >> 6, t = r & 63;
            tr_tile(ginp(F, kv ? I_W1V : I_W1K) + (size_t)l * 2048 * 256, 2048, 256, (bf16*)(F.ws + WS_NSAW1) + ((size_t)(l * 2 + kv)) * 256 * 2048, 2048, 0, nullptr, t >> 4, t & 15, scr, tid); continue; }
        r -= 128;
        if (r < 16) { tr_tile(ginp(F, I_WQUP) + (size_t)l * 256 * 384, 256, 384, (bf16*)(F.ws + WS_MLAQ) + (size_t)l * 512 * 256, 256, 2, ginp(F, I_GQ) + (size_t)l * 256, r >> 1, r & 1, scr, tid); continue; }
        r -= 16;
        tr_tile(ginp(F, I_WKVUP) + (size_t)l * 128 * 512, 128, 512, (bf16*)(F.ws + WS_MLAKV) + (size_t)l * 512 * 256, 256, 0, ginp(F, I_GKV) + (size_t)l * 128, r >> 1, r & 1, scr, tid);
    }
    for (int it = F.blk; it < DEPTH * 4; it += F.G) {
        const int l = it >> 2, kv = (it >> 1) & 1, kt = it & 1;
        tr_tile(ginp(F, kv ? I_W2V : I_W2K) + (size_t)l * 256 * 64, 256, 64, (bf16*)(F.ws + WS_W2T) + ((size_t)(l * 2 + kv)) * 64 * 256, 256, 0, nullptr, 0, kt, scr, tid);
    }
    {
        float* CS64 = (float*)(F.ws + WS_CS64); float* CS32 = (float*)(F.ws + WS_CS32);
        const int* pos = (const int*)ginp(F, I_POS);
        for (int idx = F.blk * 512 + tid; idx < T * 48; idx += F.G * 512) {
            const int tok = idx / 48, i = idx % 48;
            const double p = (double)pos[tok];
            const double inv = (i < 32) ? exp2(-(double)i * (13.287712379549449 / 32.0)) : exp2(-(double)(i - 32) * (13.287712379549449 / 16.0));
            double ang = p * inv;
            const double kk = __builtin_rint(ang * 0.15915494309189535);
            ang = ang - kk * 6.283185307179586;
            const float af = (float)ang;
            const float cs = __cosf(af), sn = __sinf(af);
            if (i < 32) { CS64[(size_t)tok * 64 + i] = cs; CS64[(size_t)tok * 64 + 32 + i] = sn; }
            else { CS32[(size_t)tok * 32 + (i - 32)] = cs; CS32[(size_t)tok * 32 + 16 + (i - 32)] = sn; }
        }
    }
    for (int item = F.blk; item < 32; item += F.G) {
        const int lk = item >> 2, l = lk >> 1, kv = lk & 1, col = (item & 3) * 64 + F.lane;
        const float* w1 = ginp(F, kv ? I_W1V : I_W1K) + (size_t)l * 2048 * 256 + col; const float* pe = ginp(F, kv ? I_POSV : I_POSK) + (size_t)l * 2048;
        float s = 0.f;
#pragma unroll 1
        for (int kb = 256 * F.wave; kb < 256 * F.wave + 256; kb += 16) {
            float wv[16];
#pragma unroll
            for (int j = 0; j < 16; ++j) wv[j] = w1[(size_t)(kb + j) * 256];
#pragma unroll
            for (int j = 0; j < 16; ++j) s += pe[kb + j] * wv[j];
        }
        scr[F.wave * 64 + F.lane] = s;
        __syncthreads();
        if (tid < 64) { float t = ginp(F, kv ? I_B1V : I_B1K)[(size_t)l * 256 + col];
#pragma unroll
            for (int ww = 0; ww < 8; ++ww) t += scr[ww * 64 + tid];
            ((float*)(F.ws + WS_B1P))[(size_t)lk * 256 + col] = t; }
        __syncthreads();
    }
    {
        LAS float* sc = scr; LAS float* red = scr + 8192;
        for (int i = tid; i < 8192; i += 512) { const float c = ginp(F, I_C)[i]; sc[i] = c * sigmoidf_(c); }
        __syncthreads();
        float* MODS = (float*)(F.ws + WS_MODS);
        const int lane = F.lane, w = F.wave;
        for (int item = F.blk; item < 384; item += F.G) {
            const int l = item / 96, col = (item % 96) * 64 + lane;
            float acc[8];
#pragma unroll
            for (int b = 0; b < 8; ++b) acc[b] = 0.f;
            const float* wa = ginp(F, I_WADA) + (size_t)l * 1024 * 6144 + col;
#pragma unroll 1
            for (int kb = 128 * w; kb < 128 * w + 128; kb += 16) {
                float wv[16];
#pragma unroll
                for (int j = 0; j < 16; ++j) wv[j] = wa[(size_t)(kb + j) * 6144];
#pragma unroll
                for (int j = 0; j < 16; ++j) {
#pragma unroll
                    for (int b = 0; b < 8; ++b) acc[b] += sc[b * 1024 + kb + j] * wv[j]; }
            }
#pragma unroll
            for (int b = 0; b < 8; ++b) red[(w * 8 + b) * 64 + lane] = acc[b];
            __syncthreads();
            { const int b = tid >> 6; float s = ginp(F, I_BADA)[(size_t)l * 6144 + col];
#pragma unroll
              for (int ww = 0; ww < 8; ++ww) s += red[(ww * 8 + b) * 64 + lane];
              MODS[((size_t)(l * 8 + b)) * 6144 + col] = s; }
            __syncthreads();
        }
    }
}

constexpr int PH_PER_LAYER = 11;
constexpr int N_PHASES = 1 + DEPTH * PH_PER_LAYER + 1;

__global__ void __launch_bounds__(512, 2) fwd_kernel(Args args) {
    extern __shared__ __attribute__((aligned(16))) unsigned char lds_raw[];
    Ctx F;
    F.lds = (LAS unsigned char*)lds_raw; F.a = &args; F.ws = args.ws;
    F.dofs = 0; F.dcnt = 0;
    F.tid = threadIdx.x; F.lane = F.tid & 63; F.wave = __builtin_amdgcn_readfirstlane(F.tid >> 6); F.blk = blockIdx.x; F.G = gridDim.x; F.vcu = F.blk;
    volatile LAS unsigned* MISC = (volatile LAS unsigned*)(F.lds + MISC_OFF);
    for (int u = F.tid; u < (LDS_BYTES - MISC_OFF) / 4; u += 512) MISC[u] = 0u;
    __syncthreads();
    unsigned* ctl = (unsigned*)(F.ws + WS_CTL);
    XcdBarrier bar; bar.bar = ctl + CW_BAR; bar.x = 0; bar.st = nullptr;
    if (!MK_PER_PHASE) bar = xcd_barrier_post(ctl + CW_BAR, MISC + 8);
    const int lo = args.ph_lo, hi = args.ph_hi;
#define IN(k) (lo <= (k) && (k) < hi)
#define SEAM(k) do { if (IN(k) && IN((k) + 1)) xcd_barrier(bar); } while (0)
    unsigned char* ws = F.ws;
#define PHASE_BEGIN() do { int t_ = threadIdx.x; asm volatile("" : "+v"(t_)); F.tid = t_; F.lane = t_ & 63; F.wave = __builtin_amdgcn_readfirstlane(t_ >> 6); \
        GAS unsigned char* w_ = (GAS unsigned char*)args.ws; asm volatile("" : "+s"(w_)); F.ws = (unsigned char*)w_; ws = (unsigned char*)w_; int b_ = blockIdx.x; asm volatile("" : "+s"(b_)); F.blk = b_; F.vcu = (F.G % 8 == 0) ? (b_ % 8) * (F.G / 8) + b_ / 8 : b_; } while (0)

    if (PHON(0) && IN(0)) _Pragma("unroll 1") for (int rep_ = 0; rep_ < NREP(0); ++rep_) { PHASE_BEGIN(); phase_prologue(F); }
    SEAM(0);
#pragma unroll 1
    for (int l = 0; l < DEPTH; ++l) {
        const int P = 1 + l * PH_PER_LAYER;
        if (PHON(1) && IN(P + 0)) _Pragma("unroll 1") for (int rep_ = 0; rep_ < (DUM(1) ? 2 : 1); ++rep_) { PHASE_BEGIN(); F.dofs = (DUM(1) && rep_ == 0) ? WS_END : 0; phase_norm1<0>(F, l); }
        SEAM(P + 0);
        if (PHON(2) && IN(P + 1)) _Pragma("unroll 1") for (int rep_ = 0; rep_ < NREP(2); ++rep_) { PHASE_BEGIN();
            SchedGrid Sg{(const char*)(ws + WS_H), (const char*)(ws + WS_WIN) + (size_t)l * NIN * 1024 * 2, 1024, 1024, NIN / 256, (T / 256) * (NIN / 256), F.G, F.vcu};
            EpiWin E{ws, (const float*)(ws + WS_CS64), (const float*)(ws + WS_CS32)};
            pg8::gemm_phase<EpiWin, SchedGrid, false>(F.lds, 1024, 1024, Sg, E);
        }
        SEAM(P + 1);
        if (PHON(3) && IN(P + 2)) _Pragma("unroll 1") for (int rep_ = 0; rep_ < NREP(3); ++rep_) { PHASE_BEGIN();
            if (PHON(13)) {
                SchedCmp Sc{(const char*)(ws + WS_KCMP), (const char*)(ws + WS_VCMP), (const char*)(ws + WS_NSAW1) + (size_t)l * 2 * 256 * 2048 * 2, F.G, F.blk};
                EpiCmp E{(const float*)(ws + WS_B1P) + (size_t)l * 512, (const bf16*)(ws + WS_W2T) + (size_t)l * 2 * 64 * 256, ginp(F, I_B2K) + (size_t)l * 64, ginp(F, I_B2V) + (size_t)l * 64,
                         (bf16*)(ws + WS_KC), (bf16*)(ws + WS_VC), (const float*)(ws + WS_CS64)};
                pg8::gemm_phase<EpiCmp, SchedCmp, false>(F.lds, 1024, 2048, Sc, E);
            }
            PHASE_BEGIN();
            if (PHON(18)) {
                SchedMla Sm{(const char*)(ws + WS_CQ), (const char*)(ws + WS_MISC), (const char*)(ws + WS_MLAQ) + (size_t)l * 512 * 256 * 2, (const char*)(ws + WS_MLAKV) + (size_t)l * 512 * 256 * 2, F.G, F.vcu};
                EpiMla E{(bf16*)(ws + WS_QM), (bf16*)(ws + WS_KN), (bf16*)(ws + WS_VM), (const bf16*)(ws + WS_CQ), (const bf16*)(ws + WS_MISC), (const float*)(ws + WS_CS32)};
                pg8::gemm_phase<EpiMla, SchedMla, false>(F.lds, 256, 256, Sm, E);
            }
            PHASE_BEGIN();
            if (PHON(15)) {
                unsigned* qw = (unsigned*)(ws + WS_CTL) + CW_QUEUE + (l * 2 + rep_) * 64;
                volatile LAS int* qslot = (volatile LAS int*)(F.lds + AUX_OFF + 512);
                int nxt_t = 0;
                if (F.tid == 0) nxt_t = (int)__hip_atomic_fetch_add(qw, 1u, RLX_AGENT);
                for (;;) {
                    if (F.tid == 0) { qslot[0] = nxt_t; nxt_t = (int)__hip_atomic_fetch_add(qw, 1u, RLX_AGENT); }
                    __syncthreads();
                    const int uq = qslot[0];
                    __syncthreads();
                    if (uq >= 2560) break;
                    if (uq < 1024) {
                        const int u = uq;
                        PolB pb; pb.Q = (const bf16*)(ws + WS_QB); pb.K = (const bf16*)(ws + WS_KWIN); pb.V = (const bf16*)(ws + WS_VWIN); pb.O = (bf16*)(ws + WS_OWIN);
                        pb.b = u >> 7; pb.g = (u >> 6) & 1; pb.qc = 63 - (u & 63); pb.maxd = 511u; pb.j0 = pb.qc > 8 ? pb.qc - 8 : 0; pb.j1 = pb.qc + 1;
                        attn_unit<64, PolB, false>(pb, F.lds, F.tid, F.lane, F.wave, 0ull);
                    } else {
                        const int uu = uq - 1024;
                        const int bh = uu / 48, w48 = uu % 48, p = w48 >> 4, s16 = w48 & 15;
                        PolA pa; pa.Q = (const bf16*)(ws + WS_QA); pa.K = (const bf16*)(ws + WS_KA); pa.V = (const bf16*)(ws + WS_VA);
                        pa.O = (bf16*)(ws + WS_OA3) + (size_t)p * T * 256; pa.LSEP = (float*)(ws + WS_LSEA) + (size_t)p * T * 4;
                        pa.b = bh >> 2; pa.h = bh & 3; pa.d = p == 0 ? 1 : (p == 1 ? 4 : 16);
                        const int cpr = p == 0 ? 16 : (p == 1 ? 4 : 1);
                        pa.r = s16 / cpr; pa.c = s16 % cpr; pa.maxd = 128u; pa.j0 = pa.c == 0 ? 2 : 0; pa.j1 = 6;
                        attn_unit<64, PolA, false>(pa, F.lds, F.tid, F.lane, F.wave, 0ull);
                    }
                }
            }
        }
        SEAM(P + 2);
        if (PHON(5) && IN(P + 4)) _Pragma("unroll 1") for (int rep_ = 0; rep_ < NREP(5); ++rep_) { PHASE_BEGIN();
            int cti = 0;
            int cq0 = 0;
            if (CONV_IN_LAYER) { const unsigned t_ = __hip_atomic_load((unsigned*)(ws + WS_CTL) + CW_CONVQ + l * 64, __ATOMIC_RELAXED, __HIP_MEMORY_SCOPE_AGENT); cq0 = __builtin_amdgcn_readfirstlane((int)(t_ < 3072u ? t_ : 3072u)); }
            if (PHON(19)) for (int u = F.vcu; u < 1024; u += F.G) {
                const int bg = (u % 256) >> 4, k = u & 15, rnd = u >> 8;
                const int qc = rnd == 0 ? 2 * k : (rnd == 1 ? 2 * k + 1 : (rnd == 2 ? 63 - 2 * k : 62 - 2 * k));
                const u64 sel = cmp_unit(F, bg >> 1, bg & 1, qc);
                PolB pb; pb.Q = (const bf16*)(ws + WS_QB); pb.K = (const bf16*)(ws + WS_KSLC); pb.V = (const bf16*)(ws + WS_VSLC); pb.O = (bf16*)(ws + WS_OSLC);
                pb.b = bg >> 1; pb.g = bg & 1; pb.qc = qc; pb.maxd = 0x7fffffffu; pb.j0 = 0; pb.j1 = qc + 1;
                pb.GC = (const bf16*)(ws + WS_OCMP); pb.GW = (const bf16*)(ws + WS_OWIN); pb.GM = (const bf16*)(ws + WS_MISC);
                attn_unit<64, PolB, true>(pb, F.lds, F.tid, F.lane, F.wave, sel);
                if (CONV_IN_LAYER && rep_ == 0) { PHASE_BEGIN(); conv_layer_tiles(F, l, cq0, cti, 2); cti += 2; }
            }
            PHASE_BEGIN();
            if (PHON(20)) for (int v = F.vcu; v < 512; v += F.G) {
                const int bh = (v & 255) >> 3, k = v & 7, c = (v < 256) ? k : 15 - k;
                PolM pm; pm.Q = (const bf16*)(ws + WS_QM); pm.KN = (const bf16*)(ws + WS_KN); pm.KR = (const bf16*)(ws + WS_KR); pm.V = (const bf16*)(ws + WS_VM); pm.O = (bf16*)(ws + WS_OC);
                pm.b = bh >> 2; pm.h = bh & 3; pm.c = c; pm.maxd = 0x7fffffffu; pm.j0 = 0; pm.j1 = 4 * c + 4;
                attn_unit<96, PolM, false>(pm, F.lds, F.tid, F.lane, F.wave, 0ull);
                if (CONV_IN_LAYER && rep_ == 0) { PHASE_BEGIN(); conv_layer_tiles(F, l, cq0, cti, 2); cti += 2; }
            }
            if (CONV_IN_LAYER && rep_ == 0) { PHASE_BEGIN(); conv_layer_tiles(F, l, cq0, cti, 1 << 20); }
        }
        SEAM(P + 4);
        if (PHON(7) && IN(P + 6)) _Pragma("unroll 1") for (int rep_ = 0; rep_ < NREP(7); ++rep_) { PHASE_BEGIN(); phase_mix(F, l); }
        SEAM(P + 6);
        if (PHON(8) && IN(P + 7)) _Pragma("unroll 1") for (int rep_ = 0; rep_ < (DUM(8) ? 2 : 1); ++rep_) { PHASE_BEGIN(); F.dofs = (DUM(8) && rep_ == 0) ? WS_END : 0;
            SchedGrid Sg{(const char*)(ws + WS_AMIX), (const char*)(ws + WS_WOUT) + (size_t)l * 1024 * 1024 * 2, 1024, 1024, 4, (T / 256) * 4, F.G, F.vcu};
            EpiWout E{(bf16*)(ws + WS_X), (const float*)(ws + WS_MODS) + ((size_t)(l * 8) * 6 + 2) * 1024, F.dofs};
            pg8::gemm_phase<EpiWout, SchedGrid, false>(F.lds, 1024, 1024, Sg, E);
        }
        SEAM(P + 7);
        if (PHON(9) && IN(P + 8)) _Pragma("unroll 1") for (int rep_ = 0; rep_ < (DUM(9) ? 2 : 1); ++rep_) { PHASE_BEGIN(); F.dofs = (DUM(9) && rep_ == 0) ? WS_END : 0; F.dcnt = (DUM(9) && rep_ == 0) ? 4 : 0; phase_router(F, l); }
        SEAM(P + 8);
        if (PHON(10) && IN(P + 9)) _Pragma("unroll 1") for (int rep_ = 0; rep_ < NREP(10); ++rep_) { PHASE_BEGIN();
            moe_tables(F, l);
            const LAS int* tb = (const LAS int*)(F.lds + AUX_OFF);
            SchedMoe1F8 Sm{tb, tb + 64, (const char*)(ws + WS_H), (const char*)(ws + WS_W1E) + (size_t)l * 32 * 2048 * 1024, (const int*)(ws + WS_IDX), tb[32] * 8, F.G, F.vcu};
            EpiMoe1 E{(bf16*)(ws + WS_ACT), ginp(F, I_BE1) + (size_t)l * 32 * 2048};
            pg8::gemm_phase<EpiMoe1, SchedMoe1F8, true, true>(F.lds, 512, 512, Sm, E);
            if (CONV_IN_LAYER && CONV_TAIL1 > 0 && rep_ == 0 && l + 1 < DEPTH) {
                const int nun = tb[32] * 8, rounds = (nun + F.G - 1) / F.G, mine = F.vcu < nun ? (nun - 1 - F.vcu) / F.G + 1 : 0;
                if (mine < rounds) { PHASE_BEGIN(); conv_claim_tiles(F, l + 1, CONV_TAIL1); }
            }
        }
        SEAM(P + 9);
        if (PHON(11) && IN(P + 10)) _Pragma("unroll 1") for (int rep_ = 0; rep_ < NREP(11); ++rep_) { PHASE_BEGIN();
            moe_tables(F, l);
            const LAS int* tb = (const LAS int*)(F.lds + AUX_OFF);
            SchedMoe2F8 Sm{tb, (const char*)(ws + WS_ACT), (const char*)(ws + WS_W2E) + (size_t)l * 32 * 1024 * 1024, tb[32] * 4, F.G, F.vcu};
            EpiMoe2 E{(unsigned char*)(ws + WS_Y2), ginp(F, I_BE2) + (size_t)l * 32 * 1024};
            pg8::gemm_phase<EpiMoe2, SchedMoe2F8, false, true>(F.lds, 512, 512, Sm, E);
            if (CONV_IN_LAYER && CONV_TAIL2 > 0 && rep_ == 0 && l + 1 < DEPTH) {
                const int nun = tb[32] * 4, rounds = (nun + F.G - 1) / F.G, mine = F.vcu < nun ? (nun - 1 - F.vcu) / F.G + 1 : 0;
                if (mine < rounds) { PHASE_BEGIN(); conv_claim_tiles(F, l + 1, CONV_TAIL2); }
            }
        }
        SEAM(P + 10);
    }
    if (PHON(12) && IN(N_PHASES - 1)) { PHASE_BEGIN(); phase_norm1<1>(F, DEPTH); }
#undef IN
#undef SEAM
}

extern "C" void kernel_launch(void* const* d_in, const int* in_sizes, int n_in, void* d_out, int out_size, void* d_ws, size_t ws_size, hipStream_t stream) {
    static int grid = 0;
    if (grid == 0) {
        if (n_in != 33 || out_size != T * D || ws_size < WS_END * (DUM_MASK ? 2 : 1)) { fprintf(stderr, "kernel_launch: unexpected problem (n_in %d out %d ws %zu)\n", n_in, out_size, ws_size); grid = -1; return; }
        int dev = 0, cus = 0, per_cu = 0;
        if (hipGetDevice(&dev) != hipSuccess || hipDeviceGetAttribute(&cus, hipDeviceAttributeMultiprocessorCount, dev) != hipSuccess) { grid = -1; return; }
        if (hipFuncSetAttribute((const void*)fwd_kernel, hipFuncAttributeMaxDynamicSharedMemorySize, LDS_BYTES) != hipSuccess) { fprintf(stderr, "kernel_launch: hipFuncSetAttribute failed\n"); grid = -1; return; }
        if (hipOccupancyMaxActiveBlocksPerMultiprocessor(&per_cu, (const void*)fwd_kernel, 512, LDS_BYTES) != hipSuccess || per_cu < 1) { fprintf(stderr, "kernel_launch: occupancy query says %d\n", per_cu); per_cu = 1; }
        (void)hipGetLastError();
        grid = cus;
    }
    if (grid < 0) return;
    if (hipMemsetAsync((char*)d_ws + WS_CTL, 0, CTL_ZERO_BYTES, stream) != hipSuccess) return;
    Args a{};
    for (int i = 0; i < 33; ++i) a.in[i] = (const float*)d_in[i];
    a.out = (float*)d_out; a.ws = (unsigned char*)d_ws;
#if MK_PER_PHASE
    for (int p = 0; p < N_PHASES; ++p) { a.ph_lo = p; a.ph_hi = p + 1; hipLaunchKernelGGL(fwd_kernel, dim3(grid), dim3(512), LDS_BYTES, stream, a); }
#else
    a.ph_lo = 0; a.ph_hi = N_PHASES;
    hipLaunchKernelGGL(fwd_kernel, dim3(grid), dim3(512), LDS_BYTES, stream, a);
#endif
}
```

```cpp
#include <hip/hip_runtime.h>
#include <cstdio>
#include <cstdint>

#ifndef MK_PER_PHASE
#define MK_PER_PHASE 0
#endif

#ifndef PH_MASK
#define PH_MASK 0xFFFFFFFFu
#endif
#define PHON(k) ((PH_MASK >> (k)) & 1u)
#ifndef DBL_MASK
#define DBL_MASK 0u
#endif
#define NREP(k) (((DBL_MASK >> (k)) & 1u) ? 2 : 1)
#ifndef DUM_MASK
#define DUM_MASK 0u
#endif
#define DUM(k) ((DUM_MASK >> (k)) & 1u)
#ifndef ATT_VAR
#define ATT_VAR 0
#endif
#ifndef CONV_IN_LAYER
#define CONV_IN_LAYER 1
#endif
#ifndef CONV_TAIL1
#define CONV_TAIL1 3
#endif
#ifndef CONV_TAIL2
#define CONV_TAIL2 4
#endif
#ifndef ATT_STAGGER
#define ATT_STAGGER 0
#endif
#define DI __device__ __forceinline__
#define LAS __attribute__((address_space(3)))
#define GAS __attribute__((address_space(1)))
typedef unsigned short bf16;
typedef short bf16x8 __attribute__((ext_vector_type(8)));
typedef short s16x4 __attribute__((ext_vector_type(4)));
typedef float f32x2 __attribute__((ext_vector_type(2)));
typedef float f32x4 __attribute__((ext_vector_type(4)));
typedef float f32x16 __attribute__((ext_vector_type(16)));
typedef unsigned u32x2 __attribute__((ext_vector_type(2)));
typedef unsigned u32x4 __attribute__((ext_vector_type(4)));
typedef __bf16 bf16x2_t __attribute__((ext_vector_type(2)));
typedef unsigned long long u64;

constexpr int NB = 8, S = 4096, T = NB * S, D = 1024, DEPTH = 4;
constexpr int NIN = 2560;
constexpr int NE = 32, DFF = 1024;
constexpr int SP = S + 64;
constexpr int ECAP = 32768;
constexpr int ACT_ROWS = 4 * T + NE * 256;
constexpr float LOG2E = 1.4426950408889634f;
constexpr float SCL64 = 0.125f * LOG2E;
constexpr float SCL96 = 0.10206207261596577f * LOG2E;
constexpr float EPS = 1e-6f;

constexpr size_t MiB = 1u << 20;
constexpr size_t WS_CTL = 0, CTL_ZERO_BYTES = 2 * MiB;
constexpr size_t WS_MODS = 2 * MiB, WS_B1P = 3 * MiB, WS_CS64 = 4 * MiB, WS_CS32 = 12 * MiB;
constexpr size_t WS_WIN = 16 * MiB, WS_WOUT = 36 * MiB, WS_NSAW1 = 44 * MiB, WS_MLAQ = 52 * MiB, WS_MLAKV = 53 * MiB;
constexpr size_t WS_W1E = 64 * MiB, WS_W2E = 576 * MiB;
constexpr size_t WS_X = 832 * MiB, WS_H = 960 * MiB;
constexpr size_t WS_QA = 1024 * MiB, WS_KA = 1040 * MiB, WS_VA = 1056 * MiB, WS_QB = 1072 * MiB;
constexpr size_t WS_KCMP = 1104 * MiB, WS_VCMP = 1113 * MiB;
constexpr size_t WS_KSLC = 1122 * MiB, WS_VSLC = 1130 * MiB, WS_KWIN = 1138 * MiB, WS_VWIN = 1146 * MiB;
constexpr size_t WS_CQ = 1154 * MiB, WS_MISC = 1170 * MiB;
constexpr size_t WS_RSTDQ = 1186 * MiB, WS_RSTDKV = 1186 * MiB + 512 * 1024, WS_KR = 1187 * MiB, WS_GATES = 1189 * MiB;
constexpr size_t WS_W2T = 1195 * MiB;
constexpr size_t WS_HID = 1192 * MiB, WS_KC = 1196 * MiB, WS_VC = 1196 * MiB + 512 * 1024;
constexpr size_t WS_QM = 1197 * MiB, WS_KN = 1221 * MiB, WS_VM = 1237 * MiB;
constexpr size_t WS_OA3 = 1253 * MiB, WS_LSEA = 1301 * MiB;
constexpr size_t WS_OCMP = 1303 * MiB, WS_OSLC = 1335 * MiB, WS_OWIN = 1367 * MiB, WS_OC = 1399 * MiB;
constexpr size_t WS_SEL = 1415 * MiB, WS_AMIX = 1416 * MiB;
constexpr size_t WS_IDX = 1480 * MiB, WS_GATEW = 1484 * MiB, WS_TOKSLOT = 1488 * MiB, WS_TOKG = WS_TOKSLOT + 512 * 1024;
constexpr size_t WS_ACT = 1489 * MiB, WS_Y2 = 1761 * MiB, WS_END = 2033 * MiB;
static_assert((size_t)ACT_ROWS * 1024 * 2 <= 272 * MiB, "act rows");
static_assert((size_t)16 * SP * 64 * 2 + 65536 <= 9 * MiB, "kcmp");

constexpr int CW_TMO = 0, CW_FAIL = 2;
constexpr int CW_BAR = 4096;
constexpr int CW_QUEUE = 12288;
constexpr int CW_CONVQ = 13312;
constexpr int CW_CNT = 16384;

constexpr int RING_BYTES = 131072;
constexpr int AUX_OFF = RING_BYTES;
constexpr int MISC_OFF = AUX_OFF + 8192;
constexpr int LDS_BYTES = 147456;

DI unsigned pk2(float lo, float hi) { f32x2 v = {lo, hi}; bf16x2_t b = __builtin_convertvector(v, bf16x2_t); return __builtin_bit_cast(unsigned, b); }
DI float bf2f(unsigned short h) { return __uint_as_float(((unsigned)h) << 16); }
DI float bflo(unsigned w) { return __uint_as_float(w << 16); }
DI float bfhi(unsigned w) { return __uint_as_float(w & 0xffff0000u); }
typedef float f32x2c __attribute__((ext_vector_type(2)));
constexpr float Y2_SCALE = 4.0f, Y2_ISCALE = 1.0f / 4.0f;
DI unsigned pk4_fp8(float a, float b, float c, float d) {
    a = fminf(fmaxf(a * Y2_SCALE, -440.f), 440.f); b = fminf(fmaxf(b * Y2_SCALE, -440.f), 440.f); c = fminf(fmaxf(c * Y2_SCALE, -440.f), 440.f); d = fminf(fmaxf(d * Y2_SCALE, -440.f), 440.f);
    int w = __builtin_amdgcn_cvt_pk_fp8_f32(a, b, 0, false); w = __builtin_amdgcn_cvt_pk_fp8_f32(c, d, w, true); return (unsigned)w; }
DI f32x4 unpk4_fp8(unsigned w) { const f32x2c lo = __builtin_amdgcn_cvt_pk_f32_fp8((int)w, false), hi = __builtin_amdgcn_cvt_pk_f32_fp8((int)w, true); return (f32x4){lo.x, lo.y, hi.x, hi.y}; }
constexpr float W8_SCALE = 64.0f, A8_SCALE = 4.0f;
constexpr int W8_E8M0 = 127 - 6, A8_E8M0 = 127 - 2;
constexpr float H8_SCALE = 8.0f; constexpr int H8_E8M0 = 127 - 3;
DI int lane_id() { return (int)__builtin_amdgcn_mbcnt_hi(~0u, __builtin_amdgcn_mbcnt_lo(~0u, 0u)); }
DI unsigned pk4_fp8s(float a, float b, float c, float d, float sc) {
    a = fminf(fmaxf(a * sc, -440.f), 440.f); b = fminf(fmaxf(b * sc, -440.f), 440.f); c = fminf(fmaxf(c * sc, -440.f), 440.f); d = fminf(fmaxf(d * sc, -440.f), 440.f);
    int w = __builtin_amdgcn_cvt_pk_fp8_f32(a, b, 0, false); w = __builtin_amdgcn_cvt_pk_fp8_f32(c, d, w, true); return (unsigned)w; }
DI float q8s(float x, float sc) {
    const float a = fminf(fmaxf(x * sc, -440.f), 440.f); const int w = __builtin_amdgcn_cvt_pk_fp8_f32(a, a, 0, false);
    const f32x2c r = __builtin_amdgcn_cvt_pk_f32_fp8(w, false); return r.x; }
template <int CTRL> DI float dpp_perm(float v) { return __builtin_bit_cast(float, __builtin_amdgcn_update_dpp(0, __builtin_bit_cast(int, v), CTRL, 0xf, 0xf, false)); }
DI float row_sum16(float v) { v += dpp_perm<0xB1>(v); v += dpp_perm<0x4E>(v); v += dpp_perm<0x141>(v); v += dpp_perm<0x140>(v); return v; }
DI float wave_sum(float v) {
    v = row_sum16(v);
    const float r0 = __builtin_bit_cast(float, __builtin_amdgcn_readlane(__builtin_bit_cast(int, v), 0)), r1 = __builtin_bit_cast(float, __builtin_amdgcn_readlane(__builtin_bit_cast(int, v), 16));
    const float r2 = __builtin_bit_cast(float, __builtin_amdgcn_readlane(__builtin_bit_cast(int, v), 32)), r3 = __builtin_bit_cast(float, __builtin_amdgcn_readlane(__builtin_bit_cast(int, v), 48));
    return (r0 + r1) + (r2 + r3);
}
DI float fast_exp2(float x) { return __builtin_amdgcn_exp2f(x); }
DI float fast_rcp(float x) { return __builtin_amdgcn_rcpf(x); }
DI float sigmoidf_(float x) { return fast_rcp(1.0f + fast_exp2(-x * LOG2E)); }
#define RLX_AGENT __ATOMIC_RELAXED, __HIP_MEMORY_SCOPE_AGENT

#define XB_TMO      128
#define XB_XCNT(j)  (256  + 64 * (j))
#define XB_XSUB(j)  (1280 + 64 * (j))
#define XB_XGEN(j)  (2304 + 64 * (j))
#define XB_TOP      3328
#define XB_TOPGEN   3392
#define XCD_BAR_WORDS 3456
#define XB_SPIN_CAP (1u << 22)
DI unsigned xb_ld(unsigned* p)              { return __hip_atomic_load(p, __ATOMIC_RELAXED, __HIP_MEMORY_SCOPE_AGENT); }
DI unsigned xb_add(unsigned* p, unsigned v) { return __hip_atomic_fetch_add(p, v, __ATOMIC_RELAXED, __HIP_MEMORY_SCOPE_AGENT); }
DI unsigned xb_xcc_id() { return (unsigned)__builtin_amdgcn_s_getreg((3 << 11) | 20) & 0xFu; }
#define XB_SPIN(cond, bar) do { unsigned _sp = 0; while (cond) { __builtin_amdgcn_s_sleep(1); \
    if ((++_sp & 255u) == 0u) { if (xb_ld(&(bar)[XB_TMO])) break; if (_sp > XB_SPIN_CAP) { atomicAdd(&(bar)[XB_TMO], 1u); break; } } } } while (0)
struct XcdBarrier { unsigned* bar; unsigned x; volatile LAS unsigned* st; };
DI XcdBarrier xcd_barrier_post(unsigned* bar, volatile LAS unsigned* st) {
    XcdBarrier b; b.bar = bar; b.x = xb_xcc_id(); b.st = st;
    if (threadIdx.x == 0) (void)xb_add(&bar[XB_XCNT(b.x)], 1u);
    return b;
}
DI void xcd_barrier_complete(unsigned* bar, unsigned x, unsigned& nloc, unsigned& nx) {
    const unsigned G = gridDim.x * gridDim.y * gridDim.z;
    unsigned sum, cnt, mine, sp = 0u;
    for (;;) {
        sum = 0u; cnt = 0u; mine = 0u;
#pragma unroll
        for (unsigned j = 0; j < 16; ++j) { const unsigned c = xb_ld(&bar[XB_XCNT(j)]); sum += c; cnt += (c > 0u) ? 1u : 0u; mine = (j == x) ? c : mine; }
        if (sum == G) break;
        __builtin_amdgcn_s_sleep(1);
        if ((++sp & 255u) == 0u) { if (xb_ld(&bar[XB_TMO])) break; if (sp > XB_SPIN_CAP) { atomicAdd(&bar[XB_TMO], 1u); break; } }
    }
    nloc = mine > 0u ? mine : 1u; nx = cnt > 0u ? cnt : 1u;
}
DI void xcd_barrier(const XcdBarrier& b) {
    asm volatile("s_waitcnt vmcnt(0)" ::: "memory");
    __syncthreads();
    unsigned* bar = b.bar; asm volatile("" : "+s"(bar));
    if (threadIdx.x == 0) {
        __builtin_amdgcn_s_waitcnt(0);
        unsigned nloc = b.st[0], nx = b.st[1];
        if (nloc == 0u) { xcd_barrier_complete(bar, b.x, nloc, nx); b.st[0] = nloc; b.st[1] = nx; }
        const unsigned old = xb_add(&bar[XB_XSUB(b.x)], 1u);
        const unsigned gen = old / nloc;
        if (old + 1u == (gen + 1u) * nloc) {
            __builtin_amdgcn_fence(__ATOMIC_RELEASE, "agent");
            asm volatile("s_waitcnt vmcnt(0)" ::: "memory");
            const unsigned og = xb_add(&bar[XB_TOP], 1u);
            const unsigned tg = og / nx;
            if (og + 1u == (tg + 1u) * nx) xb_add(&bar[XB_TOPGEN], 1u);
            else XB_SPIN(xb_ld(&bar[XB_TOPGEN]) == tg, bar);
            __builtin_amdgcn_fence(__ATOMIC_ACQUIRE, "agent");
            xb_add(&bar[XB_XGEN(b.x)], 1u);
            asm volatile("s_waitcnt vmcnt(0)" ::: "memory");
        } else {
            XB_SPIN(xb_ld(&bar[XB_XGEN(b.x)]) == gen, bar);
            __builtin_amdgcn_fence(__ATOMIC_ACQUIRE, "agent");
            asm volatile("s_waitcnt vmcnt(0)" ::: "memory");
        }
    }
    __syncthreads();
}

struct Args {
    const float* in[33];
    float* out;
    unsigned char* ws;
    int ph_lo, ph_hi;
};
enum { I_X = 0, I_C, I_POS, I_WADA, I_BADA, I_G1, I_G2, I_WIN, I_POSK, I_POSV, I_W1K, I_B1K, I_W2K, I_B2K, I_W1V, I_B1V, I_W2V, I_B2V,
       I_GQ, I_GKV, I_WQUP, I_WKVUP, I_GOA, I_GOB, I_GOC, I_WOUT, I_WR, I_BR, I_WE1, I_BE1, I_WE2, I_BE2, I_GF };

struct Ctx {
    LAS unsigned char* lds;
    const Args* a;
    unsigned char* ws;
    int tid, lane, wave, blk, G, vcu;
    size_t dofs; int dcnt;
};
DI const float* ginp(const Ctx& F, int i) { return (const float*)(GAS const float*)(F.a->in[i]); }
DI float* gout(const Ctx& F) { return (float*)(GAS float*)(F.a->out); }

namespace pg8 {
constexpr int BM = 256, BK = 64, HALF = 128, HTB = HALF * BK * 2;
DI int lds_byte(int r, int c) { const int st = (r >> 4) * 2 + (c >> 5), rr = r & 15, cc = c & 31, ob = rr * 64 + cc * 2; return st * 1024 + (ob ^ (((ob >> 9) & 1) << 5)); }
DI void stage_rc(int b, int& R, int& C) { const int st = b / 1024, sb = b % 1024, swz = sb ^ (((sb >> 9) & 1) << 5); R = (st >> 1) * 16 + swz / 64; C = (st & 1) * 32 + (swz % 64) / 2; }
DI int perm32(int rho) { const int n = rho >> 4, i = rho & 15; return 8 * (i >> 2) + 4 * n + (i & 3); }
struct Unit { const char* a; const char* b; int pm, pn, e, ml; };
template <class E_, class = void> struct acc_bias_t { static constexpr bool value = false; };
template <class E_> struct acc_bias_t<E_, decltype((void)E_::ACC_BIAS)> { static constexpr bool value = E_::ACC_BIAS; };
template <class E_> constexpr bool acc_bias_v = acc_bias_t<E_>::value;
template <class E_, class = void> struct perm2_t { static constexpr bool value = false; };
template <class E_> struct perm2_t<E_, decltype((void)E_::PERM2)> { static constexpr bool value = E_::PERM2; };
template <class E_> constexpr bool perm2_v = perm2_t<E_>::value;

template <class Epi, class Sched, bool GATHER, bool FP8 = false>
DI void gemm_phase(LAS unsigned char* lds, const int lda, const int K, const Sched& S, const Epi& E) {
    typedef int i32x4_ __attribute__((ext_vector_type(4))); typedef int i32x8_ __attribute__((ext_vector_type(8)));
    int tid_ = threadIdx.x; asm volatile("" : "+v"(tid_));
    const int tid = tid_, wid = __builtin_amdgcn_readfirstlane(tid >> 6), lane = tid & 63, wr = wid >> 2, wc = wid & 3, fr = lane & 15, fq = lane >> 4;
    const int nt = K / BK;
    int Rr[2], Cc[2]; unsigned voffB[2];
#pragma unroll
    for (int i = 0; i < 2; ++i) { int R, C; stage_rc(tid * 16 + i * 8192, R, C); Rr[i] = R; Cc[i] = C; const int Rb = perm2_v<Epi> ? ((R >> 5) * 64 + 16 * ((R & 15) >> 2) + 4 * ((R >> 4) & 1) + (R & 3)) : (Epi::PERM ? ((R & ~31) + perm32(R & 31)) : R); voffB[i] = (unsigned)(Rb * K + C) * 2u; }
    const size_t kstep = (size_t)(BK * 2);
    const size_t hstepB = (size_t)(perm2_v<Epi> ? 8 : HALF) * K * 2;
    const size_t istepB = (size_t)(perm2_v<Epi> ? 128 : 64) * K * 2;
    const unsigned ldsw = (unsigned)wid * 1024u;
    const int aoff = lds_byte(wr * 64 + fr, fq * 8), boff = lds_byte(wc * 32 + fr, fq * 8);
#define PG8_SA(b, h) (((b) * 2 + (h)) * HTB)
#define PG8_SB(b, h) ((4 + (b) * 2 + (h)) * HTB)
#define PG8_STAGE_B(bufoff, gbase) do { _Pragma("unroll") for (int _i = 0; _i < 2; ++_i) \
        __builtin_amdgcn_global_load_lds((const unsigned*)((const char*)(gbase) + (size_t)_i * istepB + voffB[0]), (LAS unsigned*)(lds + (bufoff) + ldsw + _i * 8192), 16, 0, 0); } while (0)
#define PG8_STAGE_A(bufoff, gbase, v, h) do { _Pragma("unroll") for (int _i = 0; _i < 2; ++_i) { \
        if constexpr (GATHER) __builtin_amdgcn_global_load_lds((const unsigned*)((const char*)(gbase) + (v)[h][_i]), (LAS unsigned*)(lds + (bufoff) + ldsw + _i * 8192), 16, 0, 0); \
        else __builtin_amdgcn_global_load_lds((const unsigned*)((const char*)(gbase) + (size_t)((h) * 128 + _i * 64) * lda * 2 + (v)[0][0]), (LAS unsigned*)(lds + (bufoff) + ldsw + _i * 8192), 16, 0, 0); } } while (0)
#define PG8_SETOFF(v, u) do { _Pragma("unroll") for (int _h = 0; _h < 2; ++_h) _Pragma("unroll") for (int _i = 0; _i < 2; ++_i) { \
        if constexpr (GATHER) (v)[_h][_i] = S.gather_off((u), _h * 128 + Rr[_i]) + (unsigned)Cc[_i] * 2u; \
        else (v)[_h][_i] = (unsigned)((_h * 128 + Rr[_i]) * lda + Cc[_i]) * 2u; } } while (0)
#define PG8_LDA(dst, b, h) do { _Pragma("unroll") for (int m = 0; m < 4; ++m) { const i32x4_ lo_ = *(const LAS i32x4_*)(lds + PG8_SA(b, h) + aoff + m * 2048), hi_ = *(const LAS i32x4_*)(lds + PG8_SA(b, h) + aoff + m * 2048 + 1024); dst[m] = __builtin_shufflevector(lo_, hi_, 0, 1, 2, 3, 4, 5, 6, 7); } } while (0)
#define PG8_LDB(dst, b, h) do { _Pragma("unroll") for (int n = 0; n < 2; ++n) { const i32x4_ lo_ = *(const LAS i32x4_*)(lds + PG8_SB(b, h) + boff + n * 2048), hi_ = *(const LAS i32x4_*)(lds + PG8_SB(b, h) + boff + n * 2048 + 1024); dst[n] = __builtin_shufflevector(lo_, hi_, 0, 1, 2, 3, 4, 5, 6, 7); } } while (0)
#define PG8_H0(x) __builtin_bit_cast(bf16x8, __builtin_shufflevector((x), (x), 0, 1, 2, 3))
#define PG8_H1(x) __builtin_bit_cast(bf16x8, __builtin_shufflevector((x), (x), 4, 5, 6, 7))
#define PG8_MMA(ai, bj, At, Bt) do { __builtin_amdgcn_s_setprio(1); \
        if constexpr (FP8) { _Pragma("unroll") for (int m = 0; m < 4; ++m) _Pragma("unroll") for (int n = 0; n < 2; ++n) \
            asm volatile("v_mfma_scale_f32_16x16x128_f8f6f4 %0, %1, %2, %0, %3, %4 op_sel_hi:[0,0,0]" : "+v"(acc[ai][bj][m][n]) : "v"(Bt[n]), "v"(At[m]), "v"(scw_), "v"(sca_)); } \
        else { _Pragma("unroll") for (int m = 0; m < 4; ++m) _Pragma("unroll") for (int n = 0; n < 2; ++n) { \
            acc[ai][bj][m][n] = __builtin_amdgcn_mfma_f32_16x16x32_bf16(PG8_H0(Bt[n]), PG8_H0(At[m]), acc[ai][bj][m][n], 0, 0, 0); \
            acc[ai][bj][m][n] = __builtin_amdgcn_mfma_f32_16x16x32_bf16(PG8_H1(Bt[n]), PG8_H1(At[m]), acc[ai][bj][m][n], 0, 0, 0); } } \
        __builtin_amdgcn_s_setprio(0); } while (0)
#define PG8_WAIT_V(n) asm volatile("s_waitcnt vmcnt(" #n ")" ::: "memory")
#define PG8_WAIT_L(n) asm volatile("s_waitcnt lgkmcnt(" #n ")" ::: "memory")
#define PG8_BAR __builtin_amdgcn_s_barrier()
#define PG8_SCHED __builtin_amdgcn_sched_barrier(0)
    Unit cur, nxt; int ui = 0;
    if (!S.next(0, cur)) return;
    f32x4 acc[2][2][4][2];
    f32x4 bv[2][2] = {{{0.f, 0.f, 0.f, 0.f}, {0.f, 0.f, 0.f, 0.f}}, {{0.f, 0.f, 0.f, 0.f}, {0.f, 0.f, 0.f, 0.f}}};
    if constexpr (acc_bias_v<Epi>) E.bias(cur, wc, fq, bv);
#pragma unroll
    for (int a = 0; a < 2; ++a)
#pragma unroll
        for (int b = 0; b < 2; ++b)
#pragma unroll
            for (int m = 0; m < 4; ++m)
#pragma unroll
                for (int n = 0; n < 2; ++n) acc[a][b][m][n] = bv[b][n];
    int scw_ = W8_E8M0, sca_ = A8_E8M0; if constexpr (FP8) sca_ = Epi::A_E8M0;
    i32x8_ At[4], B0[2], B1[2];
    unsigned vA[2][2], vAn[2][2];
    PG8_SETOFF(vA, cur);
    const char* cA = cur.a; const char* cB = cur.b;
    PG8_STAGE_B(PG8_SB(0, 0), cB); PG8_STAGE_B(PG8_SB(0, 1), cB + hstepB); PG8_STAGE_A(PG8_SA(0, 0), cA, vA, 0); PG8_STAGE_A(PG8_SA(0, 1), cA, vA, 1);
    if (wr == 1) PG8_BAR;
    PG8_WAIT_V(2); PG8_BAR;
    PG8_STAGE_B(PG8_SB(1, 0), cB + kstep); PG8_STAGE_A(PG8_SA(1, 0), cA + kstep, vA, 0); PG8_STAGE_B(PG8_SB(1, 1), cB + hstepB + kstep);
    PG8_WAIT_V(6); PG8_BAR;
    for (;;) {
        const bool has_next = S.next(ui + 1, nxt);
        if constexpr (GATHER) {
            if (has_next) {
#pragma unroll
                for (int h = 0; h < 2; ++h)
#pragma unroll
                    for (int i = 0; i < 2; ++i) vAn[h][i] = S.gather_raw(nxt, h * 128 + Rr[i]);
            }
        }
        const char* nA = has_next ? nxt.a : cA; const char* nB = has_next ? nxt.b : cB;
#pragma unroll 1
        for (int t = 0; t < nt; t += 2) {
            const bool last = (t == nt - 2);
            const char* a1 = cA + (size_t)(t + 1) * kstep;
            const char* a2 = last ? nA : cA + (size_t)(t + 2) * kstep; const char* b2 = last ? nB : cB + (size_t)(t + 2) * kstep;
            const char* a3 = a2 + kstep; const char* b3 = b2 + kstep;
            unsigned v2[2][2];
#pragma unroll
            for (int h = 0; h < 2; ++h)
#pragma unroll
                for (int i = 0; i < 2; ++i) v2[h][i] = vA[h][i];
            if constexpr (GATHER) {
                if (last && has_next) {
#pragma unroll
                    for (int h = 0; h < 2; ++h)
#pragma unroll
                        for (int i = 0; i < 2; ++i) { vAn[h][i] = vAn[h][i] * (unsigned)(lda * 2) + (unsigned)Cc[i] * 2u; v2[h][i] = vAn[h][i]; }
                }
            }
            PG8_LDB(B0, 0, 0); PG8_LDB(B1, 0, 1); PG8_SCHED; PG8_LDA(At, 0, 0); PG8_STAGE_A(PG8_SA(1, 1), a1, vA, 1);
            PG8_WAIT_V(8); PG8_WAIT_L(0); PG8_BAR; PG8_MMA(0, 0, At, B0); PG8_MMA(0, 1, At, B1); PG8_BAR; PG8_SCHED;
            PG8_LDA(At, 0, 1); PG8_STAGE_B(PG8_SB(0, 0), b2); PG8_STAGE_B(PG8_SB(0, 1), b2 + hstepB); PG8_STAGE_A(PG8_SA(0, 0), a2, v2, 0);
            PG8_WAIT_V(8); PG8_WAIT_L(0); PG8_BAR; PG8_MMA(1, 0, At, B0); PG8_MMA(1, 1, At, B1); PG8_BAR; PG8_SCHED;
            PG8_LDB(B0, 1, 0); PG8_LDB(B1, 1, 1); PG8_SCHED; PG8_LDA(At, 1, 0); PG8_STAGE_A(PG8_SA(0, 1), a2, v2, 1);
            PG8_WAIT_V(8); PG8_WAIT_L(0); PG8_BAR; PG8_MMA(0, 0, At, B0); PG8_MMA(0, 1, At, B1); PG8_BAR; PG8_SCHED;
            PG8_LDA(At, 1, 1); PG8_STAGE_B(PG8_SB(1, 0), b3); PG8_STAGE_B(PG8_SB(1, 1), b3 + hstepB); PG8_STAGE_A(PG8_SA(1, 0), a3, v2, 0);
            PG8_WAIT_V(8); PG8_WAIT_L(0); PG8_BAR; PG8_MMA(1, 0, At, B0); PG8_MMA(1, 1, At, B1); PG8_BAR; PG8_SCHED;
        }
        if (wr == 0) PG8_BAR;
        if constexpr (FP8) asm volatile("s_nop 15\n\ts_nop 15" ::: "memory");
        if constexpr (acc_bias_v<Epi>) E.bias(has_next ? nxt : cur, wc, fq, bv);
        if constexpr (!Epi::AFTER_DRAIN) { int fr_ = fr, fq_ = fq; asm volatile("" : "+v"(fr_), "+v"(fq_)); E(acc, cur, wr, wc, fr_, fq_); }
        if (!has_next) break;
#pragma unroll
        for (int a = 0; a < 2; ++a)
#pragma unroll
            for (int b = 0; b < 2; ++b)
#pragma unroll
                for (int m = 0; m < 4; ++m)
#pragma unroll
                    for (int n = 0; n < 2; ++n) acc[a][b][m][n] = bv[b][n];
        cur = nxt; cA = nA; cB = nB; ++ui;
        if constexpr (GATHER) {
#pragma unroll
            for (int h = 0; h < 2; ++h)
#pragma unroll
                for (int i = 0; i < 2; ++i) vA[h][i] = vAn[h][i];
        }
        if (wr == 1) PG8_BAR;
    }
    PG8_WAIT_V(0);
    PG8_BAR;
    if constexpr (Epi::AFTER_DRAIN) { int fr_ = fr, fq_ = fq; asm volatile("" : "+v"(fr_), "+v"(fq_)); E.fused(acc, cur, wr, wc, fr_, fq_, lds, wid, lane); }
#undef PG8_SA
#undef PG8_SB
#undef PG8_STAGE_A
#undef PG8_STAGE_B
#undef PG8_SETOFF
#undef PG8_LDA
#undef PG8_LDB
#undef PG8_MMA
#undef PG8_H0
#undef PG8_H1
#undef PG8_WAIT_V
#undef PG8_WAIT_L
#undef PG8_BAR
#undef PG8_SCHED
}
}
using pg8::Unit;
typedef f32x4 AccT[2][2][4][2];

struct SchedGrid {
    const char* A; const char* B; int lda, K, nN, nwg, G, c;
    DI bool next(int i, Unit& u) const {
        const int L = i * G + c; if (L >= nwg) return false;
        u.pm = L / nN; u.pn = L % nN; u.e = 0; u.ml = 0;
        u.a = A + (size_t)u.pm * 256 * lda * 2; u.b = B + (size_t)u.pn * 256 * K * 2; return true;
    }
    DI unsigned gather_off(const Unit&, int) const { return 0u; }
    DI unsigned gather_raw(const Unit&, int) const { return 0u; }
};
struct SchedCmp {
    const char* KCMP; const char* VCMP; const char* W; int G, c;
    DI bool next(int i, Unit& u) const {
        const int L = i * G + c; if (L >= 32) return false;
        const int kv = L >> 4, bg = L & 15;
        u.pm = L; u.pn = 0; u.e = kv; u.ml = 0;
        u.a = (kv ? VCMP : KCMP) + (size_t)bg * SP * 64 * 2; u.b = W + (size_t)kv * 256 * 2048 * 2; return true;
    }
    DI unsigned gather_off(const Unit&, int) const { return 0u; }
    DI unsigned gather_raw(const Unit&, int) const { return 0u; }
};
struct SchedMla {
    const char* CQ; const char* MISC; const char* WQ; const char* WKV; int G, c;
    DI bool next(int i, Unit& u) const {
        const int L = i * G + c; if (L >= 512) return false;
        const int which = L >> 8, r = L & 255;
        u.pm = r >> 1; u.pn = r & 1; u.e = which; u.ml = 0;
        u.a = (which ? MISC : CQ) + (size_t)u.pm * 256 * 256 * 2; u.b = (which ? WKV : WQ) + (size_t)u.pn * 256 * 256 * 2; return true;
    }
    DI unsigned gather_off(const Unit&, int) const { return 0u; }
    DI unsigned gather_raw(const Unit&, int) const { return 0u; }
};
template <int NT, bool GATHERED>
struct SchedMoe {
    const LAS int* tb; const LAS int* cnt; const char* A; const char* W; const int* IDX; int total, G, c;
    DI bool next(int i, Unit& u) const {
        const int L = i * G + c; if (L >= total) return false;
        const int mtg = L / NT; u.pn = L % NT;
        const int ln_ = threadIdx.x & 63;
        const int e = __popcll(__ballot(ln_ < 32 && tb[ln_ & 31] <= mtg)) - 1;
        u.e = e; u.ml = mtg - tb[e]; u.pm = mtg;
        u.a = GATHERED ? A : A + (size_t)mtg * 256 * 1024 * 2;
        u.b = W + ((size_t)e * NT * 256 + (size_t)u.pn * 256) * 1024 * 2; return true;
    }
    DI unsigned gather_off(const Unit& u, int row) const {
        const int pos = u.ml * 256 + row; const int tok = (pos < cnt[u.e]) ? IDX[u.e * ECAP + pos] : 0;
        return (unsigned)tok * 2048u;
    }
    DI unsigned gather_raw(const Unit& u, int row) const {
        const int pos = u.ml * 256 + row;
        return (unsigned)IDX[u.e * ECAP + (pos < cnt[u.e] ? pos : 0)];
    }
};

struct SchedMoe1F8 {
    static constexpr bool HOOK = false;
    const LAS int* tb; const LAS int* cnt; const char* A; const char* W; const int* IDX; int total, G, c;
    DI bool next(int i, Unit& u) const {
        const int L = i * G + c; if (L >= total) return false;
        const int mtg = L >> 3; u.pn = L & 7;
        const int ln_ = lane_id();
        const int e = __popcll(__ballot(ln_ < 32 && tb[ln_ & 31] <= mtg)) - 1;
        u.e = e; u.ml = mtg - tb[e]; u.pm = mtg;
        u.a = A; u.b = W + ((size_t)e * 2048 + (size_t)u.pn * 256) * 1024; return true;
    }
    DI unsigned gather_raw(const Unit& u, int row) const { const int pos = u.ml * 256 + row; return (unsigned)IDX[u.e * ECAP + (pos < cnt[u.e] ? pos : 0)]; }
    DI unsigned gather_off(const Unit& u, int row) const { return gather_raw(u, row) * 1024u; }
};
struct SchedMoe2F8 {
    static constexpr bool HOOK = false;
    const LAS int* tb; const char* A; const char* W; int total, G, c;
    DI bool next(int i, Unit& u) const {
        const int L = i * G + c; if (L >= total) return false;
        const int mtg = L >> 2; u.pn = L & 3;
        const int ln_ = lane_id();
        const int e = __popcll(__ballot(ln_ < 32 && tb[ln_ & 31] <= mtg)) - 1;
        u.e = e; u.ml = mtg - tb[e]; u.pm = mtg;
        u.a = A + (size_t)mtg * 256 * 1024; u.b = W + ((size_t)e * 1024 + (size_t)u.pn * 256) * 1024; return true;
    }
    DI unsigned gather_off(const Unit&, int) const { return 0u; }
    DI unsigned gather_raw(const Unit&, int) const { return 0u; }
};

DI void rot4(f32x4& v0, f32x4& v1, const f32x4 c, const f32x4 s) {
    const float a0 = v0[0], b0 = v0[1], a1 = v0[2], b1 = v0[3], a2 = v1[0], b2 = v1[1], a3 = v1[2], b3 = v1[3];
    v0[0] = a0 * c[0] - b0 * s[0]; v0[1] = b0 * c[0] + a0 * s[0];
    v0[2] = a1 * c[1] - b1 * s[1]; v0[3] = b1 * c[1] + a1 * s[1];
    v1[0] = a2 * c[2] - b2 * s[2]; v1[1] = b2 * c[2] + a2 * s[2];
    v1[2] = a3 * c[3] - b3 * s[3]; v1[3] = b3 * c[3] + a3 * s[3];
}
DI u32x4 pack8(const f32x4 v0, const f32x4 v1) { u32x4 w; w.x = pk2(v0[0], v0[1]); w.y = pk2(v0[2], v0[3]); w.z = pk2(v1[0], v1[1]); w.w = pk2(v1[2], v1[3]); return w; }

struct EpiWin {
    static constexpr bool PERM = true, AFTER_DRAIN = false;
    unsigned char* ws; const float* CS64; const float* CS32;
    DI void dest(int pn, int w0, size_t& off, int& ld, int& dcol, int& mode, int& gm, int& g, float& sc) const {
        mode = 0; gm = 0; g = 0; sc = 1.f;
        switch (pn) {
            case 0: off = WS_QA; ld = 256; dcol = w0; mode = 1; sc = SCL64; break;
            case 1: off = WS_KA; ld = 256; dcol = w0; mode = 1; break;
            case 2: off = WS_VA; ld = 256; dcol = w0; break;
            case 3: off = WS_QB; ld = 512; dcol = w0; mode = 1; sc = SCL64; break;
            case 4: off = WS_QB; ld = 512; dcol = 256 + w0; mode = 1; sc = SCL64; break;
            case 5: off = (w0 < 128) ? WS_KCMP : WS_VCMP; ld = 64; gm = 1; g = (w0 & 127) >> 6; dcol = w0 & 63; break;
            case 6: off = (w0 < 128) ? WS_KSLC : WS_VSLC; ld = 128; dcol = w0 & 127; mode = (w0 < 128) ? 1 : 0; break;
            case 7: off = (w0 < 128) ? WS_KWIN : WS_VWIN; ld = 128; dcol = w0 & 127; mode = (w0 < 128) ? 1 : 0; break;
            case 8: off = WS_CQ; ld = 256; dcol = w0; break;
            default: if (w0 == 128) { off = WS_KR; ld = 32; dcol = 0; mode = 2; } else { off = WS_MISC; ld = 256; dcol = w0; } break;
        }
    }
    DI void operator()(const AccT& acc, const Unit& u, int wr, int wc, int fr, int fq) const {
        size_t off[2]; int ld[2], dcol[2], mode[2], gm[2], g[2]; float sc[2];
#pragma unroll
        for (int bj = 0; bj < 2; ++bj) dest(u.pn, bj * 128 + wc * 32, off[bj], ld[bj], dcol[bj], mode[bj], gm[bj], g[bj], sc[bj]);
        const bool shared = (mode[0] == 1) && (mode[1] == 1);
        const int i0 = 16 * (wc & 1) + 4 * fq;
#pragma unroll
        for (int ai = 0; ai < 2; ++ai) {
            f32x4 cc[4], sn[4];
            if (shared) {
#pragma unroll
                for (int m = 0; m < 4; ++m) { const int row = u.pm * 256 + ai * 128 + wr * 64 + m * 16 + fr; const float* cs = CS64 + (size_t)row * 64 + i0; cc[m] = *(const f32x4*)cs; sn[m] = *(const f32x4*)(cs + 32); }
            }
#pragma unroll
            for (int bj = 0; bj < 2; ++bj) {
                bf16* base = (bf16*)(ws + off[bj]);
                const int md = mode[bj];
                if (md && !shared) {
#pragma unroll
                    for (int m = 0; m < 4; ++m) {
                        const int row = u.pm * 256 + ai * 128 + wr * 64 + m * 16 + fr;
                        const float* cs = (md == 1) ? CS64 + (size_t)row * 64 + i0 : CS32 + (size_t)row * 32 + 4 * fq;
                        cc[m] = *(const f32x4*)cs; sn[m] = *(const f32x4*)(cs + (md == 1 ? 32 : 16));
                    }
                }
#pragma unroll
                for (int m = 0; m < 4; ++m) {
                    const int row = u.pm * 256 + ai * 128 + wr * 64 + m * 16 + fr;
                    f32x4 v0 = acc[ai][bj][m][0], v1 = acc[ai][bj][m][1];
                    if (md) rot4(v0, v1, cc[m], sn[m]);
                    v0 = v0 * sc[bj]; v1 = v1 * sc[bj];
                    const size_t drow = gm[bj] ? (size_t)(((row >> 12) * 2 + g[bj]) * SP + (row & 4095)) : (size_t)row;
                    *(u32x4*)(base + drow * ld[bj] + dcol[bj] + 8 * fq) = pack8(v0, v1);
                }
            }
        }
    }
};
struct EpiCmp {
    static constexpr bool PERM = true, AFTER_DRAIN = true;
    const float* B1P; const bf16* W2T; const float *B2K, *B2V; bf16 *KC, *VC; const float* CS64;
    DI void fused(const AccT& acc, const Unit& u, int wr, int wc, int fr, int fq, LAS unsigned char* lds, int wid, int lane) const {
        constexpr int HST = 528;
        const int kv = u.e, bg = u.pm & 15;
#pragma unroll
        for (int bj = 0; bj < 2; ++bj) {
            const int col = bj * 128 + wc * 32 + 8 * fq;
            const f32x4 b0 = *(const f32x4*)(B1P + kv * 256 + col), b1 = *(const f32x4*)(B1P + kv * 256 + col + 4);
#pragma unroll
            for (int ai = 0; ai < 2; ++ai)
#pragma unroll
                for (int m = 0; m < 4; ++m) {
                    const int rl = ai * 128 + wr * 64 + m * 16 + fr;
                    f32x4 v0 = acc[ai][bj][m][0] + b0, v1 = acc[ai][bj][m][1] + b1;
#pragma unroll
                    for (int j = 0; j < 4; ++j) {
                        float x = v0[j]; float z = 0.7978845608028654f * (x + 0.044715f * x * x * x); v0[j] = x * sigmoidf_(2.f * z);
                        x = v1[j]; z = 0.7978845608028654f * (x + 0.044715f * x * x * x); v1[j] = x * sigmoidf_(2.f * z);
                    }
                    *(LAS u32x4*)(lds + rl * HST + col * 2) = pack8(v0, v1);
                }
        }
        asm volatile("s_waitcnt lgkmcnt(0)\n\ts_barrier" ::: "memory");
        const int r32 = lane & 31, hh = lane >> 5;
        f32x16 out0 = {0.f, 0.f, 0.f, 0.f, 0.f, 0.f, 0.f, 0.f, 0.f, 0.f, 0.f, 0.f, 0.f, 0.f, 0.f, 0.f}, out1 = out0;
        const bf16* w2 = W2T + (size_t)kv * 64 * 256;
#pragma unroll 4
        for (int ks = 0; ks < 16; ++ks) {
            const bf16x8 a = *(const LAS bf16x8*)(lds + (32 * wid + r32) * HST + (16 * ks + 8 * hh) * 2);
            const bf16x8 bq0 = *(const bf16x8*)(w2 + (size_t)r32 * 256 + 16 * ks + 8 * hh), bq1 = *(const bf16x8*)(w2 + (size_t)(32 + r32) * 256 + 16 * ks + 8 * hh);
            out0 = __builtin_amdgcn_mfma_f32_32x32x16_bf16(a, bq0, out0, 0, 0, 0); out1 = __builtin_amdgcn_mfma_f32_32x32x16_bf16(a, bq1, out1, 0, 0, 0);
        }
        const float* b2 = kv ? B2V : B2K;
        const float bb0 = b2[r32], bb1 = b2[32 + r32];
        const int b = bg >> 1;
#pragma unroll
        for (int i = 0; i < 16; ++i) {
            const int c = 32 * wid + 8 * (i >> 2) + 4 * hh + (i & 3);
            const size_t row = (size_t)bg * 256 + c;
            float x1 = out0[i] + bb0, x2 = out1[i] + bb1;
            if (c == 255) { x1 = 0.f; x2 = 0.f; }
            if (kv == 0) {
                const int tokr = (b * S + 16 * c + 31) & (T - 1);
                const float cs = CS64[(size_t)tokr * 64 + r32], sn = CS64[(size_t)tokr * 64 + 32 + r32];
                *(unsigned*)(KC + row * 64 + 2 * r32) = pk2(x1 * cs - x2 * sn, x2 * cs + x1 * sn);
            } else {
                VC[row * 64 + r32] = (bf16)(pk2(x1, 0.f) & 0xffffu); VC[row * 64 + 32 + r32] = (bf16)(pk2(x2, 0.f) & 0xffffu);
            }
        }
    }
};
struct EpiMla {
    static constexpr bool PERM = true, AFTER_DRAIN = false;
    bf16 *QM, *KN, *VM; const bf16 *CQ, *MISC; const float* CS32;
    DI void operator()(const AccT& acc, const Unit& u, int wr, int wc, int fr, int fq) const {
        float rstd[2][4];
#pragma unroll
        for (int ai = 0; ai < 2; ++ai)
#pragma unroll
            for (int m = 0; m < 4; ++m) {
                const int row = u.pm * 256 + ai * 128 + wr * 64 + m * 16 + fr;
                float ss = 0.f;
                if (u.e == 0) {
#pragma unroll
                    for (int c = 0; c < 8; ++c) { const u32x4 w = *(const u32x4*)(CQ + (size_t)row * 256 + fq * 64 + 8 * c);
                        ss += bflo(w.x) * bflo(w.x) + bfhi(w.x) * bfhi(w.x) + bflo(w.y) * bflo(w.y) + bfhi(w.y) * bfhi(w.y) + bflo(w.z) * bflo(w.z) + bfhi(w.z) * bfhi(w.z) + bflo(w.w) * bflo(w.w) + bfhi(w.w) * bfhi(w.w); }
                } else {
#pragma unroll
                    for (int c = 0; c < 4; ++c) { const u32x4 w = *(const u32x4*)(MISC + (size_t)row * 256 + fq * 32 + 8 * c);
                        ss += bflo(w.x) * bflo(w.x) + bfhi(w.x) * bfhi(w.x) + bflo(w.y) * bflo(w.y) + bfhi(w.y) * bfhi(w.y) + bflo(w.z) * bflo(w.z) + bfhi(w.z) * bfhi(w.z) + bflo(w.w) * bflo(w.w) + bfhi(w.w) * bfhi(w.w); }
                }
                ss += __shfl_xor(ss, 16); ss += __shfl_xor(ss, 32);
                rstd[ai][m] = rsqrtf(ss * (u.e == 0 ? (1.0f / 256.0f) : (1.0f / 128.0f)) + EPS);
            }
#pragma unroll
        for (int bj = 0; bj < 2; ++bj) {
            const int gc = u.pn * 256 + bj * 128 + wc * 32;
            bf16* base; int ld, dcol, rope = 0; float sc = 1.f;
            if (u.e == 0) { if (gc >= 384) continue; rope = ((gc >> 5) % 3) == 2; base = QM; ld = 384; dcol = gc; sc = SCL96; }
            else { const int head = gc >> 7, part = (gc & 127) >> 6, o = gc & 63; base = part ? VM : KN; ld = 256; dcol = head * 64 + o; }
#pragma unroll
            for (int ai = 0; ai < 2; ++ai) {
                f32x4 cc[4], sn[4];
                if (rope) {
#pragma unroll
                    for (int m = 0; m < 4; ++m) { const float* cs = CS32 + (size_t)(u.pm * 256 + ai * 128 + wr * 64 + m * 16 + fr) * 32 + 4 * fq; cc[m] = *(const f32x4*)cs; sn[m] = *(const f32x4*)(cs + 16); }
                }
#pragma unroll
                for (int m = 0; m < 4; ++m) {
                    const int row = u.pm * 256 + ai * 128 + wr * 64 + m * 16 + fr;
                    const float r = rstd[ai][m] * sc;
                    f32x4 v0 = acc[ai][bj][m][0] * r, v1 = acc[ai][bj][m][1] * r;
                    if (rope) rot4(v0, v1, cc[m], sn[m]);
                    *(u32x4*)(base + (size_t)row * ld + dcol + 8 * fq) = pack8(v0, v1);
                }
            }
        }
    }
};
struct EpiWout {
    static constexpr bool PERM = false, AFTER_DRAIN = false;
    bf16* X; const float* GT; size_t dofs;
    DI void operator()(const AccT& acc, const Unit& u, int wr, int wc, int fr, int fq) const {
        const int b = (u.pm * 256) >> 12;
        const int col0 = u.pn * 256 + wc * 32 + 4 * fq;
#pragma unroll
        for (int bj = 0; bj < 2; ++bj) {
#pragma unroll
            for (int n = 0; n < 2; ++n) {
                u32x2 xo[2][4];
                const f32x4 gt = *(const f32x4*)(GT + (size_t)b * 6144 + col0 + bj * 128 + n * 16);
#pragma unroll
                for (int ai = 0; ai < 2; ++ai)
#pragma unroll
                    for (int m = 0; m < 4; ++m) xo[ai][m] = *(const u32x2*)(X + (size_t)(u.pm * 256 + ai * 128 + wr * 64 + m * 16 + fr) * 1024 + col0 + bj * 128 + n * 16);
#pragma unroll
                for (int ai = 0; ai < 2; ++ai)
#pragma unroll
                    for (int m = 0; m < 4; ++m) {
                        bf16* p = X + (size_t)(u.pm * 256 + ai * 128 + wr * 64 + m * 16 + fr) * 1024 + col0 + bj * 128 + n * 16;
                        const f32x4 xv = (f32x4){bflo(xo[ai][m].x), bfhi(xo[ai][m].x), bflo(xo[ai][m].y), bfhi(xo[ai][m].y)} + gt * acc[ai][bj][m][n];
                        u32x2 w; w.x = pk2(xv[0], xv[1]); w.y = pk2(xv[2], xv[3]);
                        *(u32x2*)((char*)p + dofs) = w;
                    }
            }
        }
    }
};
struct EpiMoe1 {
    static constexpr bool PERM = true, PERM2 = true, AFTER_DRAIN = false; static constexpr int A_E8M0 = H8_E8M0;
    static constexpr bool ACC_BIAS = true;
    bf16* ACT; const float* B1;
    DI void bias(const Unit& u, int wc, int fq, f32x4 (&bv)[2][2]) const {
        const float* bp = B1 + (size_t)u.e * 2048 + u.pn * 256 + wc * 64 + 16 * fq;
#pragma unroll
        for (int bj = 0; bj < 2; ++bj) { bv[bj][0] = *(const f32x4*)(bp + 8 * bj); bv[bj][1] = *(const f32x4*)(bp + 8 * bj + 4); }
    }
    DI void operator()(const AccT& acc, const Unit& u, int wr, int wc, int fr, int fq) const {
        const int col = u.pn * 256 + wc * 64 + 16 * fq;
#pragma unroll
        for (int ai = 0; ai < 2; ++ai)
#pragma unroll
            for (int m = 0; m < 4; ++m) {
                const int row = u.pm * 256 + ai * 128 + wr * 64 + m * 16 + fr;
                float o[8];
#pragma unroll
                for (int bj = 0; bj < 2; ++bj) {
                    const f32x4 v0 = acc[ai][bj][m][0], v1 = acc[ai][bj][m][1];
#pragma unroll
                    for (int j = 0; j < 4; ++j) {
                        const float gl = fminf((j < 2) ? v0[2 * j] : v1[2 * j - 4], 7.0f);
                        const float li = fminf(fmaxf((j < 2) ? v0[2 * j + 1] : v1[2 * j - 3], -7.0f), 7.0f);
                        o[4 * bj + j] = gl * sigmoidf_(1.702f * gl) * (li + 1.0f);
                    }
                }
                u32x2 w8; w8.x = pk4_fp8s(o[0], o[1], o[2], o[3], A8_SCALE); w8.y = pk4_fp8s(o[4], o[5], o[6], o[7], A8_SCALE);
                *(u32x2*)((unsigned char*)ACT + (size_t)row * 1024 + (col >> 1)) = w8;
            }
    }
};
struct EpiMoe2 {
    static constexpr bool PERM = true, PERM2 = true, AFTER_DRAIN = false; static constexpr int A_E8M0 = A8_E8M0;
    static constexpr bool ACC_BIAS = true;
    unsigned char* Y2; const float* B2;
    DI void bias(const Unit& u, int wc, int fq, f32x4 (&bv)[2][2]) const {
        const float* bp = B2 + (size_t)u.e * 1024 + u.pn * 256 + wc * 64 + 16 * fq;
#pragma unroll
        for (int bj = 0; bj < 2; ++bj) { bv[bj][0] = *(const f32x4*)(bp + 8 * bj); bv[bj][1] = *(const f32x4*)(bp + 8 * bj + 4); }
    }
    DI void operator()(const AccT& acc, const Unit& u, int wr, int wc, int fr, int fq) const {
        const int col = u.pn * 256 + wc * 64 + 16 * fq;
#pragma unroll
        for (int ai = 0; ai < 2; ++ai)
#pragma unroll
            for (int m = 0; m < 4; ++m) {
                const size_t row = (size_t)u.pm * 256 + ai * 128 + wr * 64 + m * 16 + fr;
                u32x4 w8;
                { const f32x4 v0 = acc[ai][0][m][0], v1 = acc[ai][0][m][1]; w8.x = pk4_fp8(v0[0], v0[1], v0[2], v0[3]); w8.y = pk4_fp8(v1[0], v1[1], v1[2], v1[3]); }
                { const f32x4 v0 = acc[ai][1][m][0], v1 = acc[ai][1][m][1]; w8.z = pk4_fp8(v0[0], v0[1], v0[2], v0[3]); w8.w = pk4_fp8(v1[0], v1[1], v1[2], v1[3]); }
                *(u32x4*)(Y2 + row * 1024 + col) = w8;
            }
    }
};

#define MFMA32(a, b, c) __builtin_amdgcn_mfma_f32_32x32x16_bf16((a), (b), (c), 0, 0, 0)
typedef short v4i16_t __attribute__((ext_vector_type(4)));
DI s16x4 tr_read(const LAS unsigned char* p) { return __builtin_bit_cast(s16x4, __builtin_amdgcn_ds_read_tr16_b64_v4i16((LAS v4i16_t*)p)); }
constexpr int VST = 144;
template <int DQ> struct AC { static constexpr int KST = DQ * 2 + 16, KS = DQ / 16, KBUF = 64 * KST, VBUF = 64 * VST, BUF = KBUF + VBUF; };

template <int DQ>
DI void qk_tile(const LAS unsigned char* kb, const bf16x8 (&qf)[DQ / 16], f32x16 (&s)[2], const f32x16& cinit, int lane) {
    const int r32 = lane & 31, hh = lane >> 5;
    bf16x8 kf[2][DQ / 16];
#pragma unroll
    for (int rt = 0; rt < 2; ++rt)
#pragma unroll
        for (int ks = 0; ks < DQ / 16; ++ks) kf[rt][ks] = *(const LAS bf16x8*)(kb + (32 * rt + r32) * AC<DQ>::KST + (16 * ks + 8 * hh) * 2);
    f32x16 a0 = MFMA32(kf[0][0], qf[0], cinit), a1 = MFMA32(kf[1][0], qf[0], cinit);
#pragma unroll
    for (int ks = 1; ks < DQ / 16; ++ks) { a0 = MFMA32(kf[0][ks], qf[ks], a0); a1 = MFMA32(kf[1][ks], qf[ks], a1); }
    s[0] = a0; s[1] = a1;
}
DI float max3f_(float a, float b, float c) { return __builtin_fmaxf(__builtin_fmaxf(a, b), c); }
constexpr float RESC_THR = 8.0f;
template <int DQ, int KMUL, int VAR = 0>
DI void attn_tile(const LAS unsigned char* kb, const LAS unsigned char* vb, const bf16x8 (&qf)[DQ / 16], f32x16 (&o)[2], f32x16& negm, float& m, float& l,
                  int dq, unsigned maxd, bool lf, int lane, const bool MASKED) {
    const int hh = lane >> 5;
    if (VAR == 1) return;
    f32x16 s[2];
    qk_tile<DQ>(kb, qf, s, negm, lane);
    if (VAR == 2) { o[0] += s[0]; o[1] += s[1]; return; }
    const int i16 = lane & 15, q = i16 >> 2, p_ = i16 & 3, mh = (lane >> 4) & 1;
    const LAS unsigned char* vbase = vb + (4 * hh + q) * VST + 32 * mh + 8 * p_;
    s16x4 vlo[4][2], vhi[4][2];
#pragma unroll
    for (int st = 0; st < 4; ++st)
#pragma unroll
        for (int mt = 0; mt < 2; ++mt) { vlo[st][mt] = tr_read(vbase + (16 * st) * VST + 64 * mt); vhi[st][mt] = tr_read(vbase + (16 * st + 8) * VST + 64 * mt); }
    __builtin_amdgcn_sched_barrier(0);
    if (MASKED) {
#pragma unroll
        for (int rt = 0; rt < 2; ++rt)
#pragma unroll
            for (int i = 0; i < 16; ++i) {
                const int d = dq - (32 * rt + 8 * (i >> 2) + (i & 3)) * KMUL;
                s[rt][i] = ((unsigned)d <= maxd) ? s[rt][i] : -1e30f;
            }
    }
    float mx = max3f_(s[0][0], s[0][1], s[0][2]);
#pragma unroll
    for (int i = 3; i < 15; i += 2) mx = max3f_(mx, s[0][i], s[0][i + 1]);
    mx = max3f_(mx, s[0][15], s[1][0]);
#pragma unroll
    for (int i = 1; i < 15; i += 2) mx = max3f_(mx, s[1][i], s[1][i + 1]);
    mx = fmaxf(mx, s[1][15]);
    if (__ballot(lf && mx > RESC_THR) != 0ull) {
        float mc = lf ? mx : -1e30f;
        mc = fmaxf(mc, __shfl_xor(mc, 32));
        const float delta = mc > RESC_THR ? mc : 0.f;
        const float alpha = fast_exp2(-delta);
        m += delta; l *= alpha;
#pragma unroll
        for (int i = 0; i < 16; ++i) { negm[i] = -m; o[0][i] *= alpha; o[1][i] *= alpha; s[0][i] -= delta; s[1][i] -= delta; }
    }
    float ps = 0.f;
#pragma unroll
    for (int rt = 0; rt < 2; ++rt)
#pragma unroll
        for (int i = 0; i < 16; ++i) { const float p = fast_exp2(s[rt][i]); s[rt][i] = p; ps += p; }
    const unsigned lmask = lf ? 0xffffffffu : 0u;
    l += lf ? ps : 0.f;
    if (VAR == 3) { o[0] += s[0]; o[1] += s[1]; return; }
#pragma unroll
    for (int rt = 0; rt < 2; ++rt)
#pragma unroll
        for (int s2 = 0; s2 < 2; ++s2) {
            u32x4 pw; pw.x = pk2(s[rt][8 * s2 + 0], s[rt][8 * s2 + 1]) & lmask; pw.y = pk2(s[rt][8 * s2 + 2], s[rt][8 * s2 + 3]) & lmask;
            pw.z = pk2(s[rt][8 * s2 + 4], s[rt][8 * s2 + 5]) & lmask; pw.w = pk2(s[rt][8 * s2 + 6], s[rt][8 * s2 + 7]) & lmask;
            const bf16x8 pb = __builtin_bit_cast(bf16x8, pw);
#pragma unroll
            for (int mt = 0; mt < 2; ++mt) {
                const bf16x8 va = __builtin_shufflevector(vlo[2 * rt + s2][mt], vhi[2 * rt + s2][mt], 0, 1, 2, 3, 4, 5, 6, 7);
                o[mt] = MFMA32(va, pb, o[mt]);
            }
        }
}
constexpr int OSTAGE_WAVE = 32 * 144;
static_assert(102400 + 8 * OSTAGE_WAVE <= MISC_OFF, "O stage below the LDS control words");
struct ChunkId { DI u32x4 operator()(u32x4 v, int, int, int) const { return v; } };
template <class P, class Fx = ChunkId>
DI void store_o_rows(const P& p, LAS unsigned char* lds, int off, const f32x16 (&o)[2], float inv, int lane, int wave, const Fx& fx = Fx()) {
    LAS unsigned char* st = lds + off + wave * OSTAGE_WAVE;
    const int n = lane & 31, hh = lane >> 5;
#pragma unroll
    for (int mt = 0; mt < 2; ++mt)
#pragma unroll
        for (int a = 0; a < 4; ++a) {
            u32x2 w; w.x = pk2(o[mt][4 * a] * inv, o[mt][4 * a + 1] * inv); w.y = pk2(o[mt][4 * a + 2] * inv, o[mt][4 * a + 3] * inv);
            *(LAS u32x2*)(st + n * 144 + (32 * mt + 8 * a + 4 * hh) * 2) = w;
        }
    asm volatile("s_waitcnt lgkmcnt(0)" ::: "memory");
#pragma unroll
    for (int it = 0; it < 4; ++it) {
        const int r = (lane >> 3) + 8 * it, c = lane & 7;
        const u32x4 v = fx(*(const LAS u32x4*)(st + r * 144 + c * 16), wave, r, c);
        *(u32x4*)(p.orow(wave, r) + 8 * c) = v;
    }
}
DI void store_o(bf16* orow, const f32x16 (&o)[2], float inv, int lane) {
    const int hh = lane >> 5;
#pragma unroll
    for (int mt = 0; mt < 2; ++mt)
#pragma unroll
        for (int a = 0; a < 4; ++a) {
            u32x2 w; w.x = pk2(o[mt][4 * a] * inv, o[mt][4 * a + 1] * inv); w.y = pk2(o[mt][4 * a + 2] * inv, o[mt][4 * a + 3] * inv);
            *(u32x2*)(orow + 32 * mt + 8 * a + 4 * hh) = w;
        }
}

struct PolA {
    static constexpr bool HASFLAG = false, LSE = true; static constexpr int KMUL = 1;
    const bf16 *Q, *K, *V; bf16* O; float* LSEP; int b, h, d, r, c; unsigned maxd; int j0, j1;
    DI int ql(int w, int lane) const { return 256 * c + 32 * w + (lane & 31); }
    DI size_t trow(int l_) const { return (size_t)b * S + (size_t)l_ * d + r; }
    DI const bf16* qrow(int w, int lane) const { return Q + trow(ql(w, lane)) * 256 + h * 64; }
    DI int qv(int w, int lane) const { return ql(w, lane); }
    DI int qmin(int w) const { return 256 * c + 32 * w; }
    DI int qmax(int w) const { return 256 * c + 32 * w + 31; }
    DI int kv0(int j) const { return 256 * c - 128 + 64 * j; }
    DI const bf16* krow(int j, int row) const { return K + trow(kv0(j) + row) * 256 + h * 64; }
    DI const bf16* vrow(int j, int row) const { return V + trow(kv0(j) + row) * 256 + h * 64; }
    DI const bf16* rrow(int, int) const { return nullptr; }
    DI bool flag(int, int, int) const { return true; }
    DI bf16* orow(int w, int lane) const { return O + trow(ql(w, lane)) * 256 + h * 64; }
    DI void lse(int w, int lane, float v) const { LSEP[trow(ql(w, lane)) * 4 + h] = v; }
};
struct PolB {
    static constexpr bool LSE = false; static constexpr int KMUL = 1;
    const bf16 *Q, *K, *V; bf16* O; int b, g, qc; unsigned maxd; int j0, j1; u64 sel; bool hasflag;
    const bf16 *GC = nullptr, *GW = nullptr, *GM = nullptr;
    DI int tok(int w, int lane) const { return 64 * qc + 8 * w + ((lane & 31) >> 2); }
    DI const bf16* qrow(int w, int lane) const { return Q + ((size_t)b * S + tok(w, lane)) * 512 + (4 * g + (lane & 3)) * 64; }
    DI int qv(int w, int lane) const { return tok(w, lane); }
    DI int qmin(int w) const { return 64 * qc + 8 * w; }
    DI int qmax(int w) const { return 64 * qc + 8 * w + 7; }
    DI int kv0(int j) const { return 64 * j; }
    DI const bf16* krow(int j, int row) const { return K + ((size_t)b * S + 64 * j + row) * 128 + g * 64; }
    DI const bf16* vrow(int j, int row) const { return V + ((size_t)b * S + 64 * j + row) * 128 + g * 64; }
    DI const bf16* rrow(int, int) const { return nullptr; }
    DI bf16* orow(int w, int lane) const { return O + ((size_t)b * S + tok(w, lane)) * 512 + (4 * g + (lane & 3)) * 64; }
    DI void lse(int, int, float) const {}
};
struct PolM {
    static constexpr bool HASFLAG = false, LSE = false; static constexpr int KMUL = 1;
    const bf16 *Q, *KN, *KR, *V; bf16* O; int b, h, c; unsigned maxd; int j0, j1;
    DI int tok(int w, int lane) const { return 256 * c + 32 * w + (lane & 31); }
    DI const bf16* qrow(int w, int lane) const { return Q + ((size_t)b * S + tok(w, lane)) * 384 + h * 96; }
    DI int qv(int w, int lane) const { return tok(w, lane); }
    DI int qmin(int w) const { return 256 * c + 32 * w; }
    DI int qmax(int w) const { return 256 * c + 32 * w + 31; }
    DI int kv0(int j) const { return 64 * j; }
    DI const bf16* krow(int j, int row) const { return KN + ((size_t)b * S + 64 * j + row) * 256 + h * 64; }
    DI const bf16* vrow(int j, int row) const { return V + ((size_t)b * S + 64 * j + row) * 256 + h * 64; }
    DI const bf16* rrow(int j, int row) const { return KR + ((size_t)b * S + 64 * j + row) * 32; }
    DI bf16* orow(int w, int lane) const { return O + ((size_t)b * S + tok(w, lane)) * 256 + h * 64; }
    DI void lse(int, int, float) const {}
};

template <int DQ, class P, bool FLAG, int VAR = 0>
DI void attn_unit(const P& p, LAS unsigned char* lds, int tid, int lane, int wave, u64 sel) {
    typedef AC<DQ> C;
    const int hh = lane >> 5;
    const bf16* qrow = p.qrow(wave, lane);
    bf16x8 qf[DQ / 16];
#pragma unroll
    for (int ks = 0; ks < DQ / 16; ++ks) qf[ks] = *(const bf16x8*)(qrow + 16 * ks + 8 * hh);
#pragma unroll
    for (int ks = 0; ks < DQ / 16; ++ks) asm volatile("s_waitcnt vmcnt(0)" : "+v"(qf[ks]) :: "memory");
    const int qv = p.qv(wave, lane), wq0 = p.qmin(wave), wq1 = p.qmax(wave);
    f32x16 o[2];
#pragma unroll
    for (int mt = 0; mt < 2; ++mt)
#pragma unroll
        for (int i = 0; i < 16; ++i) o[mt][i] = 0.f;
    float m = 0.f, l = 0.f;
    f32x16 negm;
#pragma unroll
    for (int i = 0; i < 16; ++i) negm[i] = 0.f;
    const int j0 = p.j0, j1 = p.j1;
    const int lrow = tid >> 3, lch = tid & 7;
    u32x4 k0A, v0A, r0A = {0u, 0u, 0u, 0u}, k1A, v1A, r1A = {0u, 0u, 0u, 0u}, k0B, v0B, r0B = {0u, 0u, 0u, 0u}, k1B, v1B, r1B = {0u, 0u, 0u, 0u};
    constexpr int NLD = (DQ == 96) ? 6 : 4;
    const int npair = (j1 - j0 + 1) >> 1;
#define ATT_LOAD1(RK, RV, RR, j) do { const bf16* pk_ = p.krow((j), lrow) + 8 * lch; const bf16* pv_ = p.vrow((j), lrow) + 8 * lch; \
        asm volatile("global_load_dwordx4 %0, %2, off\n\tglobal_load_dwordx4 %1, %3, off" : "=&v"(RK), "=&v"(RV) : "v"(pk_), "v"(pv_) : "memory"); \
        if (DQ == 96) { const bf16* pr_ = p.rrow((j), (tid & 255) >> 2) + 8 * (tid & 3); asm volatile("global_load_dwordx4 %0, %1, off" : "=&v"(RR) : "v"(pr_) : "memory"); } } while (0)
#define ATT_LOADP(K0, V0, R0, K1, V1, R1, t) do { const int ja_ = j0 + 2 * (t), jb_ = ja_ + 1; \
        { const int jc_ = ja_ < j1 ? ja_ : j1 - 1; ATT_LOAD1(K0, V0, R0, jc_); } { const int jd_ = jb_ < j1 ? jb_ : j1 - 1; ATT_LOAD1(K1, V1, R1, jd_); } } while (0)
#define ATT_TILE(kb_, jt_) do { const int j_ = (jt_); const int kv0 = p.kv0(j_); \
        bool need = (j_ < j1) && (wq1 - kv0 >= 0) && ((long long)wq0 - (long long)(kv0 + 63 * P::KMUL) <= (long long)p.maxd); \
        const bool interior = (wq0 - (kv0 + 63 * P::KMUL) >= 0) && ((long long)wq1 - (long long)kv0 <= (long long)p.maxd); \
        bool lf = true; \
        if (FLAG) { lf = ((sel >> j_) & 1ull) != 0ull; need = need && (__ballot(lf) != 0ull); } \
        if (need) attn_tile<DQ, P::KMUL, VAR>((kb_), (kb_) + C::KBUF, qf, o, negm, m, l, qv - kv0 - 4 * hh * P::KMUL, p.maxd, lf, lane, !interior); } while (0)
#define ATT_STEP(K0, V0, R0, K1, V1, R1, tt) do { const int t_ = (tt); \
        LAS unsigned char* pbuf = lds + (t_ & 1) * (2 * C::BUF); \
        asm volatile("s_waitcnt vmcnt(%6)" : "+v"(K0), "+v"(V0), "+v"(R0), "+v"(K1), "+v"(V1), "+v"(R1) : "n"(NLD) : "memory"); \
        *(LAS u32x4*)(pbuf + lrow * C::KST + lch * 16) = K0; *(LAS u32x4*)(pbuf + C::KBUF + lrow * VST + lch * 16) = V0; \
        *(LAS u32x4*)(pbuf + C::BUF + lrow * C::KST + lch * 16) = K1; *(LAS u32x4*)(pbuf + C::BUF + C::KBUF + lrow * VST + lch * 16) = V1; \
        if (DQ == 96) { *(LAS u32x4*)(pbuf + ((tid & 255) >> 2) * C::KST + 128 + (tid & 3) * 16) = R0; *(LAS u32x4*)(pbuf + C::BUF + ((tid & 255) >> 2) * C::KST + 128 + (tid & 3) * 16) = R1; } \
        asm volatile("s_waitcnt lgkmcnt(0)\n\ts_barrier" ::: "memory"); \
        ATT_LOADP(K0, V0, R0, K1, V1, R1, t_ + 2); \
        if (ATT_STAGGER > 0 && wave >= 4) __builtin_amdgcn_s_sleep(ATT_STAGGER); \
        ATT_TILE(pbuf, j0 + 2 * t_); ATT_TILE(pbuf + C::BUF, j0 + 2 * t_ + 1); } while (0)
    ATT_LOADP(k0A, v0A, r0A, k1A, v1A, r1A, 0);
    ATT_LOADP(k0B, v0B, r0B, k1B, v1B, r1B, 1);
    if (wave >= 4) __builtin_amdgcn_s_setprio(1);
#pragma unroll 1
    for (int t = 0; t < npair; t += 2) {
        ATT_STEP(k0A, v0A, r0A, k1A, v1A, r1A, t);
        ATT_STEP(k0B, v0B, r0B, k1B, v1B, r1B, t + 1);
    }
    __builtin_amdgcn_s_setprio(0);
    asm volatile("s_waitcnt vmcnt(0)" : "+v"(k0A), "+v"(v0A), "+v"(r0A), "+v"(k1A), "+v"(v1A), "+v"(r1A), "+v"(k0B), "+v"(v0B), "+v"(r0B), "+v"(k1B), "+v"(v1B), "+v"(r1B) :: "memory");
#undef ATT_LOAD1
#undef ATT_LOADP
#undef ATT_TILE
#undef ATT_STEP
    const float lt = l + __shfl_xor(l, 32);
    const float inv = lt > 0.f ? 1.0f / lt : 0.f;
    if constexpr (FLAG) {
        struct Gate { const P& p;
            DI u32x4 operator()(u32x4 v, int w_, int r, int c) const {
                const size_t tg = (size_t)p.b * S + 64 * p.qc + 8 * w_ + (r >> 2); const int hd = 4 * p.g + (r & 3);
                const bf16* gl = p.GM + tg * 256 + 160 + hd * 3;
                const float g0 = sigmoidf_(bf2f(gl[0])), g1 = sigmoidf_(bf2f(gl[1])), g2 = sigmoidf_(bf2f(gl[2]));
                const u32x4 a = *(const u32x4*)(p.GC + tg * 512 + hd * 64 + 8 * c), d = *(const u32x4*)(p.GW + tg * 512 + hd * 64 + 8 * c);
                u32x4 r_;
                r_.x = pk2(g0 * bflo(a.x) + g1 * bflo(v.x) + g2 * bflo(d.x), g0 * bfhi(a.x) + g1 * bfhi(v.x) + g2 * bfhi(d.x));
                r_.y = pk2(g0 * bflo(a.y) + g1 * bflo(v.y) + g2 * bflo(d.y), g0 * bfhi(a.y) + g1 * bfhi(v.y) + g2 * bfhi(d.y));
                r_.z = pk2(g0 * bflo(a.z) + g1 * bflo(v.z) + g2 * bflo(d.z), g0 * bfhi(a.z) + g1 * bfhi(v.z) + g2 * bfhi(d.z));
                r_.w = pk2(g0 * bflo(a.w) + g1 * bflo(v.w) + g2 * bflo(d.w), g0 * bfhi(a.w) + g1 * bfhi(v.w) + g2 * bfhi(d.w));
                return r_; } } gate{p};
        store_o_rows(p, lds, 90112, o, inv, lane, wave, gate);
    } else store_o_rows(p, lds, DQ == 96 ? 102400 : 90112, o, inv, lane, wave);
    if (P::LSE) { if (hh == 0) p.lse(wave, lane, m + __log2f(lt)); }
    __syncthreads();
}

DI u64 cmp_unit(const Ctx& F, int b, int g, int qc) {
    constexpr int KST = 144;
    LAS unsigned char* KL = F.lds; LAS unsigned char* VL = F.lds + 256 * KST; LAS float* IMP = (LAS float*)(F.lds + 2 * 256 * KST);
    const bf16* KC = (const bf16*)(F.ws + WS_KC) + (size_t)(b * 2 + g) * 256 * 64;
    const bf16* VC = (const bf16*)(F.ws + WS_VC) + (size_t)(b * 2 + g) * 256 * 64;
    const int tid = F.tid, lane = F.lane, w = F.wave, hh = lane >> 5, r32 = lane & 31;
#pragma unroll
    for (int it = 0; it < 4; ++it) { const int idx = tid + 512 * it, row = idx >> 3, ch = idx & 7;
        *(LAS u32x4*)(KL + row * KST + ch * 16) = *(const u32x4*)(KC + row * 64 + ch * 8);
        *(LAS u32x4*)(VL + row * VST + ch * 16) = *(const u32x4*)(VC + row * 64 + ch * 8); }
    __syncthreads();
    const int tokl = 8 * w + (r32 >> 2), tok = 64 * qc + tokl, head = 4 * g + (lane & 3);
    const bf16* qrow = (const bf16*)(F.ws + WS_QB) + ((size_t)b * S + tok) * 512 + head * 64;
    bf16x8 qf[4];
#pragma unroll
    for (int ks = 0; ks < 4; ++ks) qf[ks] = *(const bf16x8*)(qrow + 16 * ks + 8 * hh);
    const int qv = tok - 31, wq1 = 64 * qc + 8 * w + 7 - 31;
    f32x16 o[2];
#pragma unroll
    for (int mt = 0; mt < 2; ++mt)
#pragma unroll
        for (int i = 0; i < 16; ++i) o[mt][i] = 0.f;
    float m = 0.f, l = 0.f;
    f32x16 negm;
#pragma unroll
    for (int i = 0; i < 16; ++i) negm[i] = 0.f;
    const int wq0 = 64 * qc + 8 * w - 31;
#pragma unroll 1
    for (int jt = 0; jt < 4; ++jt) {
        if (wq1 - 1024 * jt >= 0) {
            const int dq = qv - 1024 * jt - 4 * hh * 16;
            attn_tile<64, 16>(KL + jt * 64 * KST, VL + jt * 64 * VST, qf, o, negm, m, l, dq, 0x7fffffffu, true, lane, !(wq0 - (1024 * jt + 63 * 16) >= 0));
        }
    }
    const float lt = l + __shfl_xor(l, 32);
    const float inv = lt > 0.f ? 1.0f / lt : 0.f;
    { struct { bf16* O; int b, g, qc; DI bf16* orow(int w_, int n_) const { return O + ((size_t)b * S + 64 * qc + 8 * w_ + (n_ >> 2)) * 512 + (4 * g + (n_ & 3)) * 64; } } pc{(bf16*)(F.ws + WS_OCMP), b, g, qc};
      store_o_rows(pc, F.lds, 90112, o, inv, lane, w); }
    float prev = 0.f;
#pragma unroll 1
    for (int jt = 0; jt < 4; ++jt) {
        const bool need = (wq1 - 1024 * jt >= 0);
        f32x16 s[2];
        if (need) qk_tile<64>(KL + jt * 64 * KST, qf, s, negm, lane);
#pragma unroll
        for (int rt = 0; rt < 2; ++rt)
#pragma unroll
            for (int a = 0; a < 4; ++a) {
                float mainp = 0.f, sp = 0.f;
                if (need) {
                    float pb[4];
#pragma unroll
                    for (int bb = 0; bb < 4; ++bb) { const int kidx = 64 * jt + 32 * rt + 8 * a + 4 * hh + bb; const bool ok = (qv - 16 * kidx) >= 0; pb[bb] = ok ? fast_exp2(s[rt][4 * a + bb]) * inv : 0.f; }
                    mainp = pb[0] + pb[1] + pb[2] + 0.5f * pb[3]; sp = 0.5f * pb[3];
                }
                const float rc = __shfl_xor(sp, 32);
                float v = mainp + (hh ? rc : prev);
                prev = rc;
                v += __shfl_xor(v, 1); v += __shfl_xor(v, 2);
                if ((lane & 3) == 0) IMP[tokl * 64 + 2 * (8 * jt + 4 * rt + a) + hh] = v;
            }
    }
    __syncthreads();
    u64 mysel = 0ull;
#pragma unroll 1
    for (int tk = 0; tk < 8; ++tk) {
        const int tl = 8 * w + tk, t = 64 * qc + tl, j = lane;
        const float v = IMP[tl * 64 + j];
        const bool forced = (j == 0) || (j == qc) || (j == qc - 1);
        const bool valid = j <= qc;
        const float score = forced ? v + 1e4f : (valid ? v : -1.0f);
        int rank = 0;
#pragma unroll
        for (int jp = 0; jp < 64; ++jp) { const float o_ = __builtin_bit_cast(float, __builtin_amdgcn_readlane(__builtin_bit_cast(int, score), jp)); rank += ((o_ > score) || (o_ == score && jp < j)) ? 1 : 0; }
        const u64 mask = __ballot(rank < 16);
        (void)t;
        if (tk == (r32 >> 2)) mysel = mask;
    }
    __syncthreads();
    return mysel;
}

DI void moe_tables(const Ctx& F, int l) {
    LAS int* tb = (LAS int*)(F.lds + AUX_OFF); LAS int* cn = tb + 64;
    if (F.tid == 0) {
        const unsigned* C = (const unsigned*)(F.ws + WS_CTL) + CW_CNT + l * 32 * 64;
        int acc = 0;
        for (int e = 0; e < 32; ++e) { const int c = (int)__hip_atomic_load(C + e * 64, RLX_AGENT); tb[e] = acc; cn[e] = c; acc += (c + 255) >> 8; }
        tb[32] = acc;
    }
    __syncthreads();
}
template <int MODE>
DI void phase_norm1(const Ctx& F, int l) {
    const float* mods = (const float*)(F.ws + WS_MODS);
    const bf16* X = (const bf16*)(F.ws + WS_X); bf16* H = (bf16*)(F.ws + F.dofs + WS_H); bf16* XW = (bf16*)(F.ws + F.dofs + WS_X);
    const LAS int* tb = (const LAS int*)(F.lds + AUX_OFF);
    if (l > 0) moe_tables(F, l - 1);
    const int gw = F.blk * 8 + F.wave, NGW = F.G * 8, lane = F.lane;
    for (int tok = gw; tok < T; tok += NGW) {
        const int b = tok >> 12;
        f32x4 v[4];
        if (l == 0) { const float* xr = ginp(F, I_X) + (size_t)tok * 1024;
#pragma unroll
            for (int k = 0; k < 4; ++k) v[k] = *(const f32x4*)(xr + 4 * lane + 256 * k);
        } else { const bf16* xr = X + (size_t)tok * 1024;
#pragma unroll
            for (int k = 0; k < 4; ++k) { const u32x2 w = *(const u32x2*)(xr + 4 * lane + 256 * k); v[k] = (f32x4){bflo(w.x), bfhi(w.x), bflo(w.y), bfhi(w.y)}; }
        }
        if (l > 0) {
            f32x4 y[4];
#pragma unroll
            for (int k = 0; k < 4; ++k) y[k] = (f32x4){0.f, 0.f, 0.f, 0.f};
            const int* ts = (const int*)(F.ws + WS_TOKSLOT) + (size_t)tok * 4;
            const f32x4 tg = *(const f32x4*)((const float*)(F.ws + WS_TOKG) + (size_t)tok * 4) * Y2_ISCALE;
#pragma unroll
            for (int s = 0; s < 4; ++s) {
                const int pk = ts[s]; const int e = pk >> 16, pos = pk & 0xffff;
                const unsigned char* yr = (const unsigned char*)(F.ws + WS_Y2) + ((size_t)tb[e] * 256 + pos) * 1024;
#pragma unroll
                for (int k = 0; k < 4; ++k) { const unsigned w = *(const unsigned*)(yr + 4 * lane + 256 * k); y[k] += unpk4_fp8(w) * tg[s]; }
            }
            const float* gt2 = mods + ((size_t)((l - 1) * 8 + b) * 6 + 5) * 1024;
#pragma unroll
            for (int k = 0; k < 4; ++k) v[k] = v[k] + *(const f32x4*)(gt2 + 4 * lane + 256 * k) * y[k];
        }
        float ss = 0.f;
#pragma unroll
        for (int k = 0; k < 4; ++k) ss += v[k][0] * v[k][0] + v[k][1] * v[k][1] + v[k][2] * v[k][2] + v[k][3] * v[k][3];
        const float rstd = rsqrtf(wave_sum(ss) * (1.0f / 1024.0f) + EPS);
        if (MODE == 0) {
            const float* g1 = ginp(F, I_G1) + (size_t)l * 1024;
            const float* sh = mods + ((size_t)(l * 8 + b) * 6 + 0) * 1024; const float* sc = sh + 1024;
#pragma unroll
            for (int k = 0; k < 4; ++k) {
                const int c = 4 * lane + 256 * k;
                { u32x2 xw; xw.x = pk2(v[k][0], v[k][1]); xw.y = pk2(v[k][2], v[k][3]); *(u32x2*)(XW + (size_t)tok * 1024 + c) = xw; }
                const f32x4 hv = v[k] * rstd * *(const f32x4*)(g1 + c) * (*(const f32x4*)(sc + c) + 1.0f) + *(const f32x4*)(sh + c);
                u32x2 w; w.x = pk2(hv[0], hv[1]); w.y = pk2(hv[2], hv[3]);
                *(u32x2*)(H + (size_t)tok * 1024 + c) = w;
            }
        } else {
            const float* gf = ginp(F, I_GF);
#pragma unroll
            for (int k = 0; k < 4; ++k) { const int c = 4 * lane + 256 * k; *(f32x4*)(gout(F) + (size_t)tok * 1024 + c) = v[k] * rstd * *(const f32x4*)(gf + c); }
        }
    }
}
DI void phase_prep(const Ctx& F) {
    const bf16* CQ = (const bf16*)(F.ws + WS_CQ); const bf16* MISC = (const bf16*)(F.ws + WS_MISC);
    float* RQ = (float*)(F.ws + WS_RSTDQ); float* RKV = (float*)(F.ws + WS_RSTDKV);
    bf16* KR = (bf16*)(F.ws + WS_KR); float* GATES = (float*)(F.ws + WS_GATES); const float* CS32 = (const float*)(F.ws + WS_CS32);
    const int gw = F.blk * 8 + F.wave, NGW = F.G * 8, lane = F.lane;
    for (int tok = gw; tok < T; tok += NGW) {
        const u32x2 wq = *(const u32x2*)(CQ + (size_t)tok * 256 + 4 * lane);
        const u32x2 wm = *(const u32x2*)(MISC + (size_t)tok * 256 + 4 * lane);
        float a0 = bflo(wq.x), a1 = bfhi(wq.x), a2 = bflo(wq.y), a3 = bfhi(wq.y);
        const float sq = wave_sum(a0 * a0 + a1 * a1 + a2 * a2 + a3 * a3);
        float m0 = bflo(wm.x), m1 = bfhi(wm.x), m2 = bflo(wm.y), m3 = bfhi(wm.y);
        const float skv = wave_sum(lane < 32 ? (m0 * m0 + m1 * m1 + m2 * m2 + m3 * m3) : 0.f);
        if (lane == 0) { RQ[tok] = rsqrtf(sq * (1.0f / 256.0f) + EPS); RKV[tok] = rsqrtf(skv * (1.0f / 128.0f) + EPS); }
        const float p0 = __shfl_xor(m0, 4), p1 = __shfl_xor(m1, 4), p2 = __shfl_xor(m2, 4), p3 = __shfl_xor(m3, 4);
        if (lane >= 32 && lane < 36) {
            const int i0 = 4 * (lane - 32);
            const f32x4 c4 = *(const f32x4*)(CS32 + (size_t)tok * 32 + i0), s4 = *(const f32x4*)(CS32 + (size_t)tok * 32 + 16 + i0);
            u32x4 w;
            w.x = pk2(m0 * c4[0] - p0 * s4[0], p0 * c4[0] + m0 * s4[0]); w.y = pk2(m1 * c4[1] - p1 * s4[1], p1 * c4[1] + m1 * s4[1]);
            w.z = pk2(m2 * c4[2] - p2 * s4[2], p2 * c4[2] + m2 * s4[2]); w.w = pk2(m3 * c4[3] - p3 * s4[3], p3 * c4[3] + m3 * s4[3]);
            *(u32x4*)(KR + (size_t)tok * 32 + 2 * i0) = w;
        }
        if (lane >= 40 && lane < 46) {
            const int gi = 4 * (lane - 40);
            *(f32x4*)(GATES + (size_t)tok * 24 + gi) = (f32x4){sigmoidf_(m0), sigmoidf_(m1), sigmoidf_(m2), sigmoidf_(m3)};
        }
    }
}
DI void phase_cmp2(const Ctx& F, int l) {
    const bf16* HID = (const bf16*)(F.ws + WS_HID);
    const float* CS64 = (const float*)(F.ws + WS_CS64);
    const int gw = F.blk * 8 + F.wave, NGW = F.G * 8, lane = F.lane;
    for (int it = gw; it < 8192; it += NGW) {
        const int kv = it >> 12, row = it & 4095, c = row & 255, bg = row >> 8;
        const float* w2 = ginp(F, kv ? I_W2V : I_W2K) + (size_t)l * 256 * 64;
        const float* b2 = ginp(F, kv ? I_B2V : I_B2K) + (size_t)l * 64;
        const u32x2 hw = *(const u32x2*)(HID + ((size_t)kv * 4096 + row) * 256 + 4 * lane);
        const float h0 = bflo(hw.x), h1 = bfhi(hw.x), h2 = bflo(hw.y), h3 = bfhi(hw.y);
        float acc = b2[lane];
#pragma unroll 4
        for (int k4 = 0; k4 < 64; ++k4) {
            const float x0 = __builtin_bit_cast(float, __builtin_amdgcn_readlane(__builtin_bit_cast(int, h0), k4));
            const float x1 = __builtin_bit_cast(float, __builtin_amdgcn_readlane(__builtin_bit_cast(int, h1), k4));
            const float x2 = __builtin_bit_cast(float, __builtin_amdgcn_readlane(__builtin_bit_cast(int, h2), k4));
            const float x3 = __builtin_bit_cast(float, __builtin_amdgcn_readlane(__builtin_bit_cast(int, h3), k4));
            acc += x0 * w2[(4 * k4 + 0) * 64 + lane] + x1 * w2[(4 * k4 + 1) * 64 + lane] + x2 * w2[(4 * k4 + 2) * 64 + lane] + x3 * w2[(4 * k4 + 3) * 64 + lane];
        }
        if (c == 255) acc = 0.f;
        if (kv == 0) {
            const int b = bg >> 1, tokr = b * S + 16 * c + 31;
            const float other = __shfl_xor(acc, 32);
            const int i = lane & 31;
            const float cs = CS64[(size_t)(tokr & (T - 1)) * 64 + i], sn = CS64[(size_t)(tokr & (T - 1)) * 64 + 32 + i];
            const float y = (lane < 32) ? (acc * cs - other * sn) : (acc * cs + other * sn);
            ((bf16*)(F.ws + WS_KC))[(size_t)row * 64 + 2 * i + (lane >> 5)] = (bf16)(pk2(y, 0.f) & 0xffffu);
        } else {
            ((bf16*)(F.ws + WS_VC))[(size_t)row * 64 + lane] = (bf16)(pk2(acc, 0.f) & 0xffffu);
        }
    }
}
DI void phase_mix(const Ctx& F, int l) {
    const bf16* OA3 = (const bf16*)(F.ws + WS_OA3); const float* LSEA = (const float*)(F.ws + WS_LSEA);
    const bf16* OCMP = (const bf16*)(F.ws + WS_OCMP); const bf16* OSLC = (const bf16*)(F.ws + WS_OSLC); const bf16* OWIN = (const bf16*)(F.ws + WS_OWIN);
    const bf16* OC = (const bf16*)(F.ws + WS_OC); const bf16* MISC = (const bf16*)(F.ws + WS_MISC);
    bf16* AMIX = (bf16*)(F.ws + WS_AMIX);
    const float* ga = ginp(F, I_GOA) + (size_t)l * 256; const float* gb = ginp(F, I_GOB) + (size_t)l * 512; const float* gc = ginp(F, I_GOC) + (size_t)l * 256;
    const int gw = F.blk * 8 + F.wave, NGW = F.G * 8, lane = F.lane, ha = lane >> 4;
    for (int tok0 = gw; tok0 < T; tok0 += 2 * NGW) {
        int tok[2]; tok[0] = tok0; tok[1] = (tok0 + NGW < T) ? tok0 + NGW : tok0;
        float ls[2][3]; u32x2 wa[2][3], wb[2][2], wc_[2];
#pragma unroll
        for (int q = 0; q < 2; ++q) {
#pragma unroll
            for (int p = 0; p < 3; ++p) { ls[q][p] = LSEA[((size_t)p * T + tok[q]) * 4 + ha]; wa[q][p] = *(const u32x2*)(OA3 + ((size_t)p * T + tok[q]) * 256 + 4 * lane); }
#pragma unroll
            for (int k = 0; k < 2; ++k) {
                const int col = 256 * k + 4 * lane;
                wb[q][k] = *(const u32x2*)(OSLC + (size_t)tok[q] * 512 + col);
            }
            wc_[q] = *(const u32x2*)(OC + (size_t)tok[q] * 256 + 4 * lane);
        }
        f32x4 va[2], vb[2][2], vc[2]; float red[2][3];
#pragma unroll
        for (int q = 0; q < 2; ++q) {
            const float mx = fmaxf(ls[q][0], fmaxf(ls[q][1], ls[q][2]));
            const float w0 = fast_exp2(ls[q][0] - mx), w1 = fast_exp2(ls[q][1] - mx), w2 = fast_exp2(ls[q][2] - mx), wi = 1.0f / (w0 + w1 + w2);
            va[q] = ((f32x4){bflo(wa[q][0].x), bfhi(wa[q][0].x), bflo(wa[q][0].y), bfhi(wa[q][0].y)} * w0 + (f32x4){bflo(wa[q][1].x), bfhi(wa[q][1].x), bflo(wa[q][1].y), bfhi(wa[q][1].y)} * w1
                   + (f32x4){bflo(wa[q][2].x), bfhi(wa[q][2].x), bflo(wa[q][2].y), bfhi(wa[q][2].y)} * w2) * wi;
            red[q][0] = va[q][0] * va[q][0] + va[q][1] * va[q][1] + va[q][2] * va[q][2] + va[q][3] * va[q][3];
            float sb = 0.f;
#pragma unroll
            for (int k = 0; k < 2; ++k) {
                const u32x2 a = wb[q][k];
                vb[q][k][0] = bflo(a.x); vb[q][k][1] = bfhi(a.x); vb[q][k][2] = bflo(a.y); vb[q][k][3] = bfhi(a.y);
                sb += vb[q][k][0] * vb[q][k][0] + vb[q][k][1] * vb[q][k][1] + vb[q][k][2] * vb[q][k][2] + vb[q][k][3] * vb[q][k][3];
            }
            red[q][1] = sb;
            vc[q] = (f32x4){bflo(wc_[q].x), bfhi(wc_[q].x), bflo(wc_[q].y), bfhi(wc_[q].y)};
            red[q][2] = vc[q][0] * vc[q][0] + vc[q][1] * vc[q][1] + vc[q][2] * vc[q][2] + vc[q][3] * vc[q][3];
        }
#pragma unroll
        for (int q = 0; q < 2; ++q)
#pragma unroll
            for (int j = 0; j < 3; ++j) red[q][j] = wave_sum(red[q][j]);
#pragma unroll
        for (int q = 0; q < 2; ++q) {
            if (q == 1 && tok0 + NGW >= T) break;
            const float ra = rsqrtf(red[q][0] * (1.0f / 256.0f) + EPS), rb = rsqrtf(red[q][1] * (1.0f / 512.0f) + EPS), rc = rsqrtf(red[q][2] * (1.0f / 256.0f) + EPS);
            bf16* orow = AMIX + (size_t)tok[q] * 1024;
            { const f32x4 o = va[q] * ra * *(const f32x4*)(ga + 4 * lane); u32x2 w; w.x = pk2(o[0], o[1]); w.y = pk2(o[2], o[3]); *(u32x2*)(orow + 4 * lane) = w; }
#pragma unroll
            for (int k = 0; k < 2; ++k) { const f32x4 o = vb[q][k] * rb * *(const f32x4*)(gb + 256 * k + 4 * lane); u32x2 w; w.x = pk2(o[0], o[1]); w.y = pk2(o[2], o[3]); *(u32x2*)(orow + 256 + 256 * k + 4 * lane) = w; }
            { const f32x4 o = vc[q] * rc * *(const f32x4*)(gc + 4 * lane); u32x2 w; w.x = pk2(o[0], o[1]); w.y = pk2(o[2], o[3]); *(u32x2*)(orow + 768 + 4 * lane) = w; }
        }
    }
}
DI void phase_router(const Ctx& F, int l) {
    LAS unsigned char* WH = F.lds; LAS unsigned char* WL = F.lds + 65536;
    LAS float* biasp = (LAS float*)(F.lds + AUX_OFF); LAS float* RS = biasp + 32;
    LAS int* lcnt = (LAS int*)(F.lds + AUX_OFF + 1024); LAS int* gbase = lcnt + 32;
    LAS int* tokE = gbase + 32; LAS float* tokG = (LAS float*)(tokE + 512); LAS int* tokP = (LAS int*)(tokG + 512);
    const float* wr = ginp(F, I_WR) + (size_t)l * 1024 * 32; const float* br = ginp(F, I_BR) + (size_t)l * 32;
    const float* mods = (const float*)(F.ws + WS_MODS); const bf16* X = (const bf16*)(F.ws + WS_X); bf16* H = (bf16*)(F.ws + F.dofs + WS_H);
    const float* g2 = ginp(F, I_G2) + (size_t)l * 1024;
    const int tid = F.tid, lane = F.lane, w = F.wave;
    if (tid < 32) lcnt[tid] = 0;
    unsigned* CNT = (unsigned*)(F.ws + WS_CTL) + CW_CNT + (l + F.dcnt) * 32 * 64;
    for (int chunk = F.blk; chunk < T / 128; chunk += F.G) {
        const int b = (chunk * 128) >> 12;
        const float* sh = mods + ((size_t)(l * 8 + b) * 6 + 3) * 1024; const float* sc = sh + 1024;
        {
            float bacc = 0.f; const int e = tid & 31;
#pragma unroll 4
            for (int it = 0; it < 32; ++it) {
                const int k = 2 * ((tid + 512 * it) >> 5);
                const float w0 = wr[k * 32 + e], w1 = wr[(k + 1) * 32 + e];
                const float p0 = w0 * (g2[k] * (sc[k] + 1.0f)), p1 = w1 * (g2[k + 1] * (sc[k + 1] + 1.0f));
                bacc += sh[k] * w0 + sh[k + 1] * w1;
                const unsigned hi = pk2(p0, p1);
                const unsigned lo = pk2(p0 - bflo(hi), p1 - bfhi(hi));
                const int off = e * 2048 + ((((k >> 3) ^ e) << 4) | ((k & 7) * 2));
                *(LAS unsigned*)(WH + off) = hi; *(LAS unsigned*)(WL + off) = lo;
            }
            tokG[tid] = bacc;
        }
        __syncthreads();
        if (tid < 32) { float s_ = br[tid];
#pragma unroll
            for (int j = 0; j < 16; ++j) s_ += tokG[tid + 32 * j];
            biasp[tid] = s_; }
        {
            u32x2 ra[4], rb[4];
            f32x4 ggv[4], hhv[4];
#pragma unroll
            for (int k = 0; k < 4; ++k) { const int c = 4 * lane + 256 * k; ggv[k] = *(const f32x4*)(g2 + c) * (*(const f32x4*)(sc + c) + 1.0f); hhv[k] = *(const f32x4*)(sh + c); }
            { const bf16* x0 = X + (size_t)(chunk * 128 + w * 16) * 1024 + 4 * lane;
#pragma unroll
              for (int k = 0; k < 4; ++k) { ra[k] = *(const u32x2*)(x0 + 256 * k); rb[k] = *(const u32x2*)(x0 + 1024 + 256 * k); } }
#pragma unroll 1
            for (int tt = 0; tt < 8; ++tt) {
                const int tl0 = w * 16 + 2 * tt, tok0 = chunk * 128 + tl0;
                f32x4 v[2][4]; float ss0 = 0.f, ss1 = 0.f;
#pragma unroll
                for (int k = 0; k < 4; ++k) { v[0][k] = (f32x4){bflo(ra[k].x), bfhi(ra[k].x), bflo(ra[k].y), bfhi(ra[k].y)}; v[1][k] = (f32x4){bflo(rb[k].x), bfhi(rb[k].x), bflo(rb[k].y), bfhi(rb[k].y)}; }
                { const int tn = (tt < 7) ? tok0 + 2 : tok0; const bf16* x0 = X + (size_t)tn * 1024 + 4 * lane;
#pragma unroll
                  for (int k = 0; k < 4; ++k) { ra[k] = *(const u32x2*)(x0 + 256 * k); rb[k] = *(const u32x2*)(x0 + 1024 + 256 * k); } }
#pragma unroll
                for (int k = 0; k < 4; ++k) { ss0 += v[0][k][0] * v[0][k][0] + v[0][k][1] * v[0][k][1] + v[0][k][2] * v[0][k][2] + v[0][k][3] * v[0][k][3];
                                              ss1 += v[1][k][0] * v[1][k][0] + v[1][k][1] * v[1][k][1] + v[1][k][2] * v[1][k][2] + v[1][k][3] * v[1][k][3]; }
                ss0 = wave_sum(ss0); ss1 = wave_sum(ss1);
                const float rs0 = rsqrtf(ss0 * (1.0f / 1024.0f) + EPS), rs1 = rsqrtf(ss1 * (1.0f / 1024.0f) + EPS);
                if (lane == 0) { RS[tl0] = rs0; RS[tl0 + 1] = rs1; }
#pragma unroll
                for (int k = 0; k < 4; ++k) {
                    const int c = 4 * lane + 256 * k;
                    v[0][k] = v[0][k] * rs0 * ggv[k] + hhv[k]; v[1][k] = v[1][k] * rs1 * ggv[k] + hhv[k];
                    *(unsigned*)((unsigned char*)H + (size_t)tok0 * 1024 + c) = pk4_fp8s(v[0][k][0], v[0][k][1], v[0][k][2], v[0][k][3], H8_SCALE);
                    *(unsigned*)((unsigned char*)H + (size_t)(tok0 + 1) * 1024 + c) = pk4_fp8s(v[1][k][0], v[1][k][1], v[1][k][2], v[1][k][3], H8_SCALE);
                }
            }
        }
        __syncthreads();
        f32x4 acc[2] = {{0.f, 0.f, 0.f, 0.f}, {0.f, 0.f, 0.f, 0.f}};
        {
            const int kg = lane >> 4, n16 = lane & 15;
            const bf16* xr = X + (size_t)(chunk * 128 + w * 16 + n16) * 1024 + 8 * kg;
#pragma unroll 1
            for (int k8 = 0; k8 < 4; ++k8) {
                bf16x8 af[8];
#pragma unroll
                for (int j = 0; j < 8; ++j) af[j] = *(const bf16x8*)(xr + 32 * (8 * k8 + j));
#pragma unroll
                for (int j = 0; j < 8; ++j) {
                    const int c = 4 * (8 * k8 + j) + kg;
#pragma unroll
                    for (int et = 0; et < 2; ++et) {
                        const int e = 16 * et + n16, off = e * 2048 + ((c ^ e) << 4);
                        const bf16x8 bh = *(const LAS bf16x8*)(WH + off), bl = *(const LAS bf16x8*)(WL + off);
                        acc[et] = __builtin_amdgcn_mfma_f32_16x16x32_bf16(af[j], bh, acc[et], 0, 0, 0);
                        acc[et] = __builtin_amdgcn_mfma_f32_16x16x32_bf16(af[j], bl, acc[et], 0, 0, 0);
                    }
                }
            }
        }
        __syncthreads();
        LAS float* LG = (LAS float*)(F.lds + w * 2048);
        {
            const int g4 = lane >> 4, n16 = lane & 15;
#pragma unroll
            for (int et = 0; et < 2; ++et)
#pragma unroll
                for (int i = 0; i < 4; ++i) LG[(4 * g4 + i) * 32 + 16 * et + n16] = acc[et][i] * RS[w * 16 + 4 * g4 + i] + biasp[16 * et + n16];
        }
        asm volatile("s_waitcnt lgkmcnt(0)" ::: "memory");
#pragma unroll 1
        for (int tt = 0; tt < 8; ++tt) {
            const int tl0 = w * 16 + 2 * tt;
            const float lg0 = LG[(2 * tt) * 32 + (lane >> 1)], lg1 = LG[(2 * tt + 1) * 32 + (lane >> 1)];
            int rk0 = 0, rk1 = 0; const int me = lane >> 1;
#pragma unroll
            for (int e = 0; e < 32; ++e) {
                const float o0 = __builtin_bit_cast(float, __builtin_amdgcn_readlane(__builtin_bit_cast(int, lg0), 2 * e));
                const float o1 = __builtin_bit_cast(float, __builtin_amdgcn_readlane(__builtin_bit_cast(int, lg1), 2 * e));
                rk0 += ((o0 > lg0) || (o0 == lg0 && e < me)) ? 1 : 0; rk1 += ((o1 > lg1) || (o1 == lg1 && e < me)) ? 1 : 0;
            }
#pragma unroll
            for (int tk = 0; tk < 2; ++tk) {
                const int rk = tk ? rk1 : rk0; const float lg = tk ? lg1 : lg0;
                int te[4]; float tv[4];
#pragma unroll
                for (int r = 0; r < 4; ++r) {
                    const u64 mk = __ballot(rk == r && (lane & 1) == 0);
                    const int sl = __builtin_amdgcn_readfirstlane((int)__builtin_ctzll(mk));
                    te[r] = sl >> 1; tv[r] = __builtin_bit_cast(float, __builtin_amdgcn_readlane(__builtin_bit_cast(int, lg), sl));
                }
                const float e1 = __expf(tv[1] - tv[0]), e2 = __expf(tv[2] - tv[0]), e3 = __expf(tv[3] - tv[0]);
                const float isum = 1.0f / (1.0f + e1 + e2 + e3);
                if (lane < 4) {
                    const int tl = tl0 + tk;
                    const int e = lane == 0 ? te[0] : lane == 1 ? te[1] : lane == 2 ? te[2] : te[3];
                    const float gte = (lane == 0 ? 1.0f : lane == 1 ? e1 : lane == 2 ? e2 : e3) * isum;
                    const int pos = atomicAdd((int*)(lcnt + e), 1);
                    tokE[tl * 4 + lane] = e; tokG[tl * 4 + lane] = gte; tokP[tl * 4 + lane] = pos;
                }
            }
        }
        __syncthreads();
        if (tid < 32) gbase[tid] = (int)__hip_atomic_fetch_add(CNT + tid * 64, (unsigned)lcnt[tid], RLX_AGENT);
        __syncthreads();
        {
            const int tl = tid >> 2, r = tid & 3, e = tokE[tid], pos = gbase[e] + tokP[tid], tok = chunk * 128 + tl;
            ((int*)(F.ws + F.dofs + WS_IDX))[(size_t)e * ECAP + pos] = tok;
            ((float*)(F.ws + F.dofs + WS_TOKG))[(size_t)tok * 4 + r] = tokG[tid];
            ((int*)(F.ws + F.dofs + WS_TOKSLOT))[(size_t)tok * 4 + r] = (e << 16) | pos;
        }
        __syncthreads();
        if (tid < 32) lcnt[tid] = 0;
        __syncthreads();
    }
}

DI int ropeperm64(int p) { return (p >> 1) + 32 * (p & 1); }
DI int cmap_win(int n) {
    const int tile = n >> 8, w = n & 255, hb = w & ~63, pp = ropeperm64(w & 63);
    switch (tile) {
        case 0: return hb + pp;
        case 1: return 256 + hb + pp;
        case 2: return 512 + w;
        case 3: return 768 + hb + pp;
        case 4: return 1024 + hb + pp;
        case 5: return w < 128 ? 1280 + w : 1408 + (w - 128);
        case 6: return w < 128 ? 1536 + hb + pp : 1664 + (w - 128);
        case 7: return w < 128 ? 1792 + hb + pp : 1920 + (w - 128);
        case 8: return 2072 + w;
        default: return w < 128 ? 2328 + w : (w < 160 ? 2456 + ((w - 128) >> 1) + 16 * ((w - 128) & 1) : (w < 184 ? 2048 + (w - 160) : -1));
    }
}
DI int cmap_qup(int n) { if (n >= 384) return -1; const int h = n / 96, w = n % 96; if (w < 64) return h * 96 + w; const int j = w - 64; return h * 96 + 64 + (j >> 1) + 16 * (j & 1); }
DI void tr_tile(const float* src, int K, int Nsrc, bf16* dst, int Kdst, int maptype, const float* ksc, int ntile, int ktile, LAS float* scr, int tid) {
    const int n0 = ntile * 64, k0 = ktile * 128, nl = tid & 63, n = n0 + nl;
    const int c = maptype == 0 ? (n < Nsrc ? n : -1) : (maptype == 1 ? cmap_win(n) : cmap_qup(n));
    float v[16];
#pragma unroll
    for (int it = 0; it < 16; ++it) { const int k = k0 + (tid >> 6) + 8 * it; v[it] = (c >= 0 && k < K) ? src[(size_t)k * Nsrc + c] * (ksc ? ksc[k] : 1.0f) : 0.f; }
#pragma unroll
    for (int it = 0; it < 16; ++it) scr[((tid >> 6) + 8 * it) * 65 + nl] = v[it];
    __syncthreads();
#pragma unroll
    for (int it = 0; it < 2; ++it) {
        const int idx = tid + 512 * it, nn = idx >> 4, ch = idx & 15;
        const LAS float* s = scr + (8 * ch) * 65 + nn;
        u32x4 o; o.x = pk2(s[0], s[65]); o.y = pk2(s[2 * 65], s[3 * 65]); o.z = pk2(s[4 * 65], s[5 * 65]); o.w = pk2(s[6 * 65], s[7 * 65]);
        *(u32x4*)(dst + (size_t)(n0 + nn) * Kdst + k0 + 8 * ch) = o;
    }
    __syncthreads();
}
DI void trb_load(f32x4 (&v)[16], const float* src, int N, int n0, int k0, int tid) {
#pragma unroll
    for (int it = 0; it < 16; ++it) v[it] = *(const f32x4*)(src + (size_t)(k0 + (tid >> 6) + 8 * it) * N + n0 + 4 * (tid & 63));
}
DI void trb_store(const f32x4 (&v)[16], bf16* dst, int Kd, int n0, int k0, LAS unsigned char* L, int tid, int wave, int lane, int f8 = 0) {
#pragma unroll
    for (int it = 0; it < 16; ++it) { f32x4 x = v[it];
        if (f8) { x[0] = q8s(x[0], W8_SCALE); x[1] = q8s(x[1], W8_SCALE); x[2] = q8s(x[2], W8_SCALE); x[3] = q8s(x[3], W8_SCALE); }
        u32x2 w; w.x = pk2(x[0], x[1]); w.y = pk2(x[2], x[3]); *(LAS u32x2*)(L + ((tid >> 6) + 8 * it) * 576 + (tid & 63) * 8) = w; }
    asm volatile("s_waitcnt lgkmcnt(0)\n\ts_barrier" ::: "memory");
    const int i = lane & 15, gn = (lane >> 4) & 1, h = lane >> 5, q = i >> 2, p = i & 3;
    const LAS unsigned char* base = L + (8 * h + q) * 576 + (32 * wave + 16 * gn) * 2 + 8 * p;
    if (!f8) {
        bf16* drow = dst + (size_t)(n0 + 32 * wave + 16 * gn + i) * Kd + k0 + 8 * h;
#pragma unroll
        for (int kcp = 0; kcp < 8; ++kcp) {
            const s16x4 lo = tr_read(base + (16 * kcp) * 576), hi = tr_read(base + (16 * kcp + 4) * 576);
            *(bf16x8*)(drow + 16 * kcp) = __builtin_shufflevector(lo, hi, 0, 1, 2, 3, 4, 5, 6, 7);
        }
    } else {
        unsigned char* drow = (unsigned char*)dst + (size_t)(n0 + 32 * wave + 16 * gn + i) * Kd + k0 + 8 * h;
#pragma unroll
        for (int kcp = 0; kcp < 8; ++kcp) {
            const s16x4 lo = tr_read(base + (16 * kcp) * 576), hi = tr_read(base + (16 * kcp + 4) * 576);
            int w0 = __builtin_amdgcn_cvt_pk_fp8_f32(bf2f((unsigned short)lo[0]), bf2f((unsigned short)lo[1]), 0, false); w0 = __builtin_amdgcn_cvt_pk_fp8_f32(bf2f((unsigned short)lo[2]), bf2f((unsigned short)lo[3]), w0, true);
            int w1 = __builtin_amdgcn_cvt_pk_fp8_f32(bf2f((unsigned short)hi[0]), bf2f((unsigned short)hi[1]), 0, false); w1 = __builtin_amdgcn_cvt_pk_fp8_f32(bf2f((unsigned short)hi[2]), bf2f((unsigned short)hi[3]), w1, true);
            u32x2 o; o.x = (unsigned)w0; o.y = (unsigned)w1;
            *(u32x2*)(drow + 16 * kcp) = o;
        }
    }
    asm volatile("s_waitcnt lgkmcnt(0)\n\ts_barrier" ::: "memory");
}
struct TrbItem { const float* src; bf16* dst; int N, n0, k0, f8; };
DI TrbItem trb_item(const Ctx& F, int it) {
    const int le = it / 96, r = it % 96; TrbItem t;
    if (r < 64) { t.src = ginp(F, I_WE1) + (size_t)le * 1024 * 2048; t.dst = (bf16*)(F.ws + WS_W1E + (size_t)le * 2048 * 1024); t.N = 2048; t.n0 = (r & 7) * 256; t.k0 = (r >> 3) * 128; t.f8 = 1; }
    else { const int q = r - 64; t.src = ginp(F, I_WE2) + (size_t)le * 1024 * 1024; t.dst = (bf16*)(F.ws + WS_W2E + (size_t)le * 1024 * 1024); t.N = 1024; t.n0 = (q & 3) * 256; t.k0 = (q >> 2) * 128; t.f8 = 1; }
    return t;
}
DI void conv_layer_tiles(const Ctx& F, int l, int q0, int i0, int cnt) {
    const int NL = 32 * 96;
    int it = q0 + F.blk + F.G * i0; const int end = q0 + F.blk + F.G * (i0 + cnt);
    if (it >= NL) return;
    f32x4 va[16];
    TrbItem ta = trb_item(F, l * NL + it);
    trb_load(va, ta.src, ta.N, ta.n0, ta.k0, F.tid);
#pragma unroll 1
    while (it < NL && it < end) {
        f32x4 vb[16];
#pragma unroll
        for (int k = 0; k < 16; ++k) vb[k] = va[k];
        const TrbItem tc = ta;
        it += F.G;
        const bool more = (it < NL && it < end);
        ta = trb_item(F, l * NL + (more ? it : 0));
        if (more) trb_load(va, ta.src, ta.N, ta.n0, ta.k0, F.tid);
        trb_store(vb, tc.dst, 1024, tc.n0, tc.k0, F.lds, F.tid, F.wave, F.lane, tc.f8);
    }
}
DI void conv_claim_tiles(const Ctx& F, int l, int quota) {
    const int NL = 32 * 96;
    volatile LAS unsigned* slot = (volatile LAS unsigned*)(F.lds + MISC_OFF) + 16;
    __syncthreads();
    if (F.tid == 0) { unsigned* q = (unsigned*)(F.ws + WS_CTL) + CW_CONVQ + l * 64; slot[0] = __hip_atomic_fetch_add(q, (unsigned)quota, __ATOMIC_RELAXED, __HIP_MEMORY_SCOPE_AGENT); }
    __syncthreads();
    int it = __builtin_amdgcn_readfirstlane((int)slot[0]); const int end = it + quota;
    if (it >= NL) return;
    f32x4 va[16];
    TrbItem ta = trb_item(F, l * NL + it);
    trb_load(va, ta.src, ta.N, ta.n0, ta.k0, F.tid);
#pragma unroll 1
    while (it < NL && it < end) {
        f32x4 vb[16];
#pragma unroll
        for (int k = 0; k < 16; ++k) vb[k] = va[k];
        const TrbItem tc = ta;
        it += 1;
        const bool more = (it < NL && it < end);
        ta = trb_item(F, l * NL + (more ? it : 0));
        if (more) trb_load(va, ta.src, ta.N, ta.n0, ta.k0, F.tid);
        trb_store(vb, tc.dst, 1024, tc.n0, tc.k0, F.lds, F.tid, F.wave, F.lane, tc.f8);
    }
}
DI void phase_prologue(const Ctx& F) {
    const Args& A = *F.a; const int tid = F.tid;
    LAS float* scr = (LAS float*)F.lds;
    if (!CONV_IN_LAYER) {
        const int NIT = DEPTH * 32 * 96;
        f32x4 va[16];
        int it = F.blk;
        TrbItem ta = trb_item(F, it < NIT ? it : 0);
        if (it < NIT) trb_load(va, ta.src, ta.N, ta.n0, ta.k0, tid);
#pragma unroll 1
        while (it < NIT) {
            f32x4 vb[16];
#pragma unroll
            for (int k = 0; k < 16; ++k) vb[k] = va[k];
            const TrbItem tc = ta;
            it += F.G;
            ta = trb_item(F, it < NIT ? it : 0);
            if (it < NIT) trb_load(va, ta.src, ta.N, ta.n0, ta.k0, tid);
            trb_store(vb, tc.dst, 1024, tc.n0, tc.k0, F.lds, tid, F.wave, F.lane, tc.f8);
        }
    }
    constexpr int PER_L = 8192 + 4096 + 320 + 128 + 128 + 16 + 16;
    for (int it = F.blk; it < DEPTH * PER_L; it += F.G) {
        const int l = it / PER_L; int r = it % PER_L;
        if (r < 8192 + 4096) continue;
        if (r < 8192) { const int e = r >> 8, t = r & 255;
            tr_tile(ginp(F, I_WE1) + ((size_t)(l * 32 + e)) * 1024 * 2048, 1024, 2048, (bf16*)(F.ws + WS_W1E) + ((size_t)(l * 32 + e)) * 2048 * 1024, 1024, 0, nullptr, t >> 3, t & 7, scr, tid); continue; }
        r -= 8192;
        if (r < 4096) { const int e = r >> 7, t = r & 127;
            tr_tile(ginp(F, I_WE2) + ((size_t)(l * 32 + e)) * 1024 * 1024, 1024, 1024, (bf16*)(F.ws + WS_W2E) + ((size_t)(l * 32 + e)) * 1024 * 1024, 1024, 0, nullptr, t >> 3, t & 7, scr, tid); continue; }
        r -= 4096;
        if (r < 320) { tr_tile(ginp(F, I_WIN) + (size_t)l * 1024 * 2488, 1024, 2488, (bf16*)(F.ws + WS_WIN) + (size_t)l * NIN * 1024, 1024, 1, nullptr, r >> 3, r & 7, scr, tid); continue; }
        r -= 320;
        if (r < 128) { tr_tile(ginp(F, I_WOUT) + (size_t)l * 1024 * 1024, 1024, 1024, (bf16*)(F.ws + WS_WOUT) + (size_t)l * 1024 * 1024, 1024, 0, nullptr, r >> 3, r & 7, scr, tid); continue; }
        r -= 128;
        if (r < 128) { const int kv = r >> 6, t = r & 63;
            tr_tile(ginp(F, kv ? I_W1V : I_W1K) + (size_t)l * 2048 * 256, 2048, 256, (bf16*)(F.ws + WS_NSAW1) + ((size_t)(l * 2 + kv)) * 256 * 2048, 2048, 0, nullptr, t >> 4, t & 15, scr, tid); continue; }
        r -= 128;
        if (r < 16) { tr_tile(ginp(F, I_WQUP) + (size_t)l * 256 * 384, 256, 384, (bf16*)(F.ws + WS_MLAQ) + (size_t)l * 512 * 256, 256, 2, ginp(F, I_GQ) + (size_t)l * 256, r >> 1, r & 1, scr, tid); continue; }
        r -= 16;
        tr_tile(ginp(F, I_WKVUP) + (size_t)l * 128 * 512, 128, 512, (bf16*)(F.ws + WS_MLAKV) + (size_t)l * 512 * 256, 256, 0, ginp(F, I_GKV) + (size_t)l * 128, r >> 1, r & 1, scr, tid);
    }
    for (int it = F.blk; it < DEPTH * 4; it += F.G) {
        const int l = it >> 2, kv = (it >> 1) & 1, kt = it & 1;
        tr_tile(ginp(F, kv ? I_W2V : I_W2K) + (size_t)l * 256 * 64, 256, 64, (bf16*)(F.ws + WS_W2T) + ((size_t)(l * 2 + kv)) * 64 * 256, 256, 0, nullptr, 0, kt, scr, tid);
    }
    {
        float* CS64 = (float*)(F.ws + WS_CS64); float* CS32 = (float*)(F.ws + WS_CS32);
        const int* pos = (const int*)ginp(F, I_POS);
        for (int idx = F.blk * 512 + tid; idx < T * 48; idx += F.G * 512) {
            const int tok = idx / 48, i = idx % 48;
            const double p = (double)pos[tok];
            const double inv = (i < 32) ? exp2(-(double)i * (13.287712379549449 / 32.0)) : exp2(-(double)(i - 32) * (13.287712379549449 / 16.0));
            double ang = p * inv;
            const double kk = __builtin_rint(ang * 0.15915494309189535);
            ang = ang - kk * 6.283185307179586;
            const float af = (float)ang;
            const float cs = __cosf(af), sn = __sinf(af);
            if (i < 32) { CS64[(size_t)tok * 64 + i] = cs; CS64[(size_t)tok * 64 + 32 + i] = sn; }
            else { CS32[(size_t)tok * 32 + (i - 32)] = cs; CS32[(size_t)tok * 32 + 16 + (i - 32)] = sn; }
        }
    }
    for (int item = F.blk; item < 32; item += F.G) {
        const int lk = item >> 2, l = lk >> 1, kv = lk & 1, col = (item & 3) * 64 + F.lane;
        const float* w1 = ginp(F, kv ? I_W1V : I_W1K) + (size_t)l * 2048 * 256 + col; const float* pe = ginp(F, kv ? I_POSV : I_POSK) + (size_t)l * 2048;
        float s = 0.f;
#pragma unroll 1
        for (int kb = 256 * F.wave; kb < 256 * F.wave + 256; kb += 16) {
            float wv[16];
#pragma unroll
            for (int j = 0; j < 16; ++j) wv[j] = w1[(size_t)(kb + j) * 256];
#pragma unroll
            for (int j = 0; j < 16; ++j) s += pe[kb + j] * wv[j];
        }
        scr[F.wave * 64 + F.lane] = s;
        __syncthreads();
        if (tid < 64) { float t = ginp(F, kv ? I_B1V : I_B1K)[(size_t)l * 256 + col];
#pragma unroll
            for (int ww = 0; ww < 8; ++ww) t += scr[ww * 64 + tid];
            ((float*)(F.ws + WS_B1P))[(size_t)lk * 256 + col] = t; }
        __syncthreads();
    }
    {
        LAS float* sc = scr; LAS float* red = scr + 8192;
        for (int i = tid; i < 8192; i += 512) { const float c = ginp(F, I_C)[i]; sc[i] = c * sigmoidf_(c); }
        __syncthreads();
        float* MODS = (float*)(F.ws + WS_MODS);
        const int lane = F.lane, w = F.wave;
        for (int item = F.blk; item < 384; item += F.G) {
            const int l = item / 96, col = (item % 96) * 64 + lane;
            float acc[8];
#pragma unroll
            for (int b = 0; b < 8; ++b) acc[b] = 0.f;
            const float* wa = ginp(F, I_WADA) + (size_t)l * 1024 * 6144 + col;
#pragma unroll 1
            for (int kb = 128 * w; kb < 128 * w + 128; kb += 16) {
                float wv[16];
#pragma unroll
                for (int j = 0; j < 16; ++j) wv[j] = wa[(size_t)(kb + j) * 6144];
#pragma unroll
                for (int j = 0; j < 16; ++j) {
#pragma unroll
                    for (int b = 0; b < 8; ++b) acc[b] += sc[b * 1024 + kb + j] * wv[j]; }
            }
#pragma unroll
            for (int b = 0; b < 8; ++b) red[(w * 8 + b) * 64 + lane] = acc[b];
            __syncthreads();
            { const int b = tid >> 6; float s = ginp(F, I_BADA)[(size_t)l * 6144 + col];
#pragma unroll
              for (int ww = 0; ww < 8; ++ww) s += red[(ww * 8 + b) * 64 + lane];
              MODS[((size_t)(l * 8 + b)) * 6144 + col] = s; }
            __syncthreads();
        }
    }
}

constexpr int PH_PER_LAYER = 11;
constexpr int N_PHASES = 1 + DEPTH * PH_PER_LAYER + 1;

__global__ void __launch_bounds__(512, 2) fwd_kernel(Args args) {
    extern __shared__ __attribute__((aligned(16))) unsigned char lds_raw[];
    Ctx F;
    F.lds = (LAS unsigned char*)lds_raw; F.a = &args; F.ws = args.ws;
    F.dofs = 0; F.dcnt = 0;
    F.tid = threadIdx.x; F.lane = F.tid & 63; F.wave = __builtin_amdgcn_readfirstlane(F.tid >> 6); F.blk = blockIdx.x; F.G = gridDim.x; F.vcu = F.blk;
    volatile LAS unsigned* MISC = (volatile LAS unsigned*)(F.lds + MISC_OFF);
    for (int u = F.tid; u < (LDS_BYTES - MISC_OFF) / 4; u += 512) MISC[u] = 0u;
    __syncthreads();
    unsigned* ctl = (unsigned*)(F.ws + WS_CTL);
    XcdBarrier bar; bar.bar = ctl + CW_BAR; bar.x = 0; bar.st = nullptr;
    if (!MK_PER_PHASE) bar = xcd_barrier_post(ctl + CW_BAR, MISC + 8);
    const int lo = args.ph_lo, hi = args.ph_hi;
#define IN(k) (lo <= (k) && (k) < hi)
#define SEAM(k) do { if (IN(k) && IN((k) + 1)) xcd_barrier(bar); } while (0)
    unsigned char* ws = F.ws;
#define PHASE_BEGIN() do { int t_ = threadIdx.x; asm volatile("" : "+v"(t_)); F.tid = t_; F.lane = t_ & 63; F.wave = __builtin_amdgcn_readfirstlane(t_ >> 6); \
        GAS unsigned char* w_ = (GAS unsigned char*)args.ws; asm volatile("" : "+s"(w_)); F.ws = (unsigned char*)w_; ws = (unsigned char*)w_; int b_ = blockIdx.x; asm volatile("" : "+s"(b_)); F.blk = b_; F.vcu = (F.G % 8 == 0) ? (b_ % 8) * (F.G / 8) + b_ / 8 : b_; } while (0)

    if (PHON(0) && IN(0)) _Pragma("unroll 1") for (int rep_ = 0; rep_ < NREP(0); ++rep_) { PHASE_BEGIN(); phase_prologue(F); }
    SEAM(0);
#pragma unroll 1
    for (int l = 0; l < DEPTH; ++l) {
        const int P = 1 + l * PH_PER_LAYER;
        if (PHON(1) && IN(P + 0)) _Pragma("unroll 1") for (int rep_ = 0; rep_ < (DUM(1) ? 2 : 1); ++rep_) { PHASE_BEGIN(); F.dofs = (DUM(1) && rep_ == 0) ? WS_END : 0; phase_norm1<0>(F, l); }
        SEAM(P + 0);
        if (PHON(2) && IN(P + 1)) _Pragma("unroll 1") for (int rep_ = 0; rep_ < NREP(2); ++rep_) { PHASE_BEGIN();
            SchedGrid Sg{(const char*)(ws + WS_H), (const char*)(ws + WS_WIN) + (size_t)l * NIN * 1024 * 2, 1024, 1024, NIN / 256, (T / 256) * (NIN / 256), F.G, F.vcu};
            EpiWin E{ws, (const float*)(ws + WS_CS64), (const float*)(ws + WS_CS32)};
            pg8::gemm_phase<EpiWin, SchedGrid, false>(F.lds, 1024, 1024, Sg, E);
        }
        SEAM(P + 1);
        if (PHON(3) && IN(P + 2)) _Pragma("unroll 1") for (int rep_ = 0; rep_ < NREP(3); ++rep_) { PHASE_BEGIN();
            if (PHON(13)) {
                SchedCmp Sc{(const char*)(ws + WS_KCMP), (const char*)(ws + WS_VCMP), (const char*)(ws + WS_NSAW1) + (size_t)l * 2 * 256 * 2048 * 2, F.G, F.blk};
                EpiCmp E{(const float*)(ws + WS_B1P) + (size_t)l * 512, (const bf16*)(ws + WS_W2T) + (size_t)l * 2 * 64 * 256, ginp(F, I_B2K) + (size_t)l * 64, ginp(F, I_B2V) + (size_t)l * 64,
                         (bf16*)(ws + WS_KC), (bf16*)(ws + WS_VC), (const float*)(ws + WS_CS64)};
                pg8::gemm_phase<EpiCmp, SchedCmp, false>(F.lds, 1024, 2048, Sc, E);
            }
            PHASE_BEGIN();
            if (PHON(18)) {
                SchedMla Sm{(const char*)(ws + WS_CQ), (const char*)(ws + WS_MISC), (const char*)(ws + WS_MLAQ) + (size_t)l * 512 * 256 * 2, (const char*)(ws + WS_MLAKV) + (size_t)l * 512 * 256 * 2, F.G, F.vcu};
                EpiMla E{(bf16*)(ws + WS_QM), (bf16*)(ws + WS_KN), (bf16*)(ws + WS_VM), (const bf16*)(ws + WS_CQ), (const bf16*)(ws + WS_MISC), (const float*)(ws + WS_CS32)};
                pg8::gemm_phase<EpiMla, SchedMla, false>(F.lds, 256, 256, Sm, E);
            }
            PHASE_BEGIN();
            if (PHON(15)) {
                unsigned* qw = (unsigned*)(ws + WS_CTL) + CW_QUEUE + (l * 2 + rep_) * 64;
                volatile LAS int* qslot = (volatile LAS int*)(F.lds + AUX_OFF + 512);
                int nxt_t = 0;
                if (F.tid == 0) nxt_t = (int)__hip_atomic_fetch_add(qw, 1u, RLX_AGENT);
                for (;;) {
                    if (F.tid == 0) { qslot[0] = nxt_t; nxt_t = (int)__hip_atomic_fetch_add(qw, 1u, RLX_AGENT); }
                    __syncthreads();
                    const int uq = qslot[0];
                    __syncthreads();
                    if (uq >= 2560) break;
                    if (uq < 1024) {
                        const int u = uq;
                        PolB pb; pb.Q = (const bf16*)(ws + WS_QB); pb.K = (const bf16*)(ws + WS_KWIN); pb.V = (const bf16*)(ws + WS_VWIN); pb.O = (bf16*)(ws + WS_OWIN);
                        pb.b = u >> 7; pb.g = (u >> 6) & 1; pb.qc = 63 - (u & 63); pb.maxd = 511u; pb.j0 = pb.qc > 8 ? pb.qc - 8 : 0; pb.j1 = pb.qc + 1;
                        attn_unit<64, PolB, false>(pb, F.lds, F.tid, F.lane, F.wave, 0ull);
                    } else {
                        const int uu = uq - 1024;
                        const int bh = uu / 48, w48 = uu % 48, p = w48 >> 4, s16 = w48 & 15;
                        PolA pa; pa.Q = (const bf16*)(ws + WS_QA); pa.K = (const bf16*)(ws + WS_KA); pa.V = (const bf16*)(ws + WS_VA);
                        pa.O = (bf16*)(ws + WS_OA3) + (size_t)p * T * 256; pa.LSEP = (float*)(ws + WS_LSEA) + (size_t)p * T * 4;
                        pa.b = bh >> 2; pa.h = bh & 3; pa.d = p == 0 ? 1 : (p == 1 ? 4 : 16);
                        const int cpr = p == 0 ? 16 : (p == 1 ? 4 : 1);
                        pa.r = s16 / cpr; pa.c = s16 % cpr; pa.maxd = 128u; pa.j0 = pa.c == 0 ? 2 : 0; pa.j1 = 6;
                        attn_unit<64, PolA, false>(pa, F.lds, F.tid, F.lane, F.wave, 0ull);
                    }
                }
            }
        }
        SEAM(P + 2);
        if (PHON(5) && IN(P + 4)) _Pragma("unroll 1") for (int rep_ = 0; rep_ < NREP(5); ++rep_) { PHASE_BEGIN();
            int cti = 0;
            int cq0 = 0;
            if (CONV_IN_LAYER) { const unsigned t_ = __hip_atomic_load((unsigned*)(ws + WS_CTL) + CW_CONVQ + l * 64, __ATOMIC_RELAXED, __HIP_MEMORY_SCOPE_AGENT); cq0 = __builtin_amdgcn_readfirstlane((int)(t_ < 3072u ? t_ : 3072u)); }
            if (PHON(19)) for (int u = F.vcu; u < 1024; u += F.G) {
                const int bg = (u % 256) >> 4, k = u & 15, rnd = u >> 8;
                const int qc = rnd == 0 ? 2 * k : (rnd == 1 ? 2 * k + 1 : (rnd == 2 ? 63 - 2 * k : 62 - 2 * k));
                const u64 sel = cmp_unit(F, bg >> 1, bg & 1, qc);
                PolB pb; pb.Q = (const bf16*)(ws + WS_QB); pb.K = (const bf16*)(ws + WS_KSLC); pb.V = (const bf16*)(ws + WS_VSLC); pb.O = (bf16*)(ws + WS_OSLC);
                pb.b = bg >> 1; pb.g = bg & 1; pb.qc = qc; pb.maxd = 0x7fffffffu; pb.j0 = 0; pb.j1 = qc + 1;
                pb.GC = (const bf16*)(ws + WS_OCMP); pb.GW = (const bf16*)(ws + WS_OWIN); pb.GM = (const bf16*)(ws + WS_MISC);
                attn_unit<64, PolB, true>(pb, F.lds, F.tid, F.lane, F.wave, sel);
                if (CONV_IN_LAYER && rep_ == 0) { PHASE_BEGIN(); conv_layer_tiles(F, l, cq0, cti, 2); cti += 2; }
            }
            PHASE_BEGIN();
            if (PHON(20)) for (int v = F.vcu; v < 512; v += F.G) {
                const int bh = (v & 255) >> 3, k = v & 7, c = (v < 256) ? k : 15 - k;
                PolM pm; pm.Q = (const bf16*)(ws + WS_QM); pm.KN = (const bf16*)(ws + WS_KN); pm.KR = (const bf16*)(ws + WS_KR); pm.V = (const bf16*)(ws + WS_VM); pm.O = (bf16*)(ws + WS_OC);
                pm.b = bh >> 2; pm.h = bh & 3; pm.c = c; pm.maxd = 0x7fffffffu; pm.j0 = 0; pm.j1 = 4 * c + 4;
                attn_unit<96, PolM, false>(pm, F.lds, F.tid, F.lane, F.wave, 0ull);
                if (CONV_IN_LAYER && rep_ == 0) { PHASE_BEGIN(); conv_layer_tiles(F, l, cq0, cti, 2); cti += 2; }
            }
            if (CONV_IN_LAYER && rep_ == 0) { PHASE_BEGIN(); conv_layer_tiles(F, l, cq0, cti, 1 << 20); }
        }
        SEAM(P + 4);
        if (PHON(7) && IN(P + 6)) _Pragma("unroll 1") for (int rep_ = 0; rep_ < NREP(7); ++rep_) { PHASE_BEGIN(); phase_mix(F, l); }
        SEAM(P + 6);
        if (PHON(8) && IN(P + 7)) _Pragma("unroll 1") for (int rep_ = 0; rep_ < (DUM(8) ? 2 : 1); ++rep_) { PHASE_BEGIN(); F.dofs = (DUM(8) && rep_ == 0) ? WS_END : 0;
            SchedGrid Sg{(const char*)(ws + WS_AMIX), (const char*)(ws + WS_WOUT) + (size_t)l * 1024 * 1024 * 2, 1024, 1024, 4, (T / 256) * 4, F.G, F.vcu};
            EpiWout E{(bf16*)(ws + WS_X), (const float*)(ws + WS_MODS) + ((size_t)(l * 8) * 6 + 2) * 1024, F.dofs};
            pg8::gemm_phase<EpiWout, SchedGrid, false>(F.lds, 1024, 1024, Sg, E);
        }
        SEAM(P + 7);
        if (PHON(9) && IN(P + 8)) _Pragma("unroll 1") for (int rep_ = 0; rep_ < (DUM(9) ? 2 : 1); ++rep_) { PHASE_BEGIN(); F.dofs = (DUM(9) && rep_ == 0) ? WS_END : 0; F.dcnt = (DUM(9) && rep_ == 0) ? 4 : 0; phase_router(F, l); }
        SEAM(P + 8);
        if (PHON(10) && IN(P + 9)) _Pragma("unroll 1") for (int rep_ = 0; rep_ < NREP(10); ++rep_) { PHASE_BEGIN();
            moe_tables(F, l);
            const LAS int* tb = (const LAS int*)(F.lds + AUX_OFF);
            SchedMoe1F8 Sm{tb, tb + 64, (const char*)(ws + WS_H), (const char*)(ws + WS_W1E) + (size_t)l * 32 * 2048 * 1024, (const int*)(ws + WS_IDX), tb[32] * 8, F.G, F.vcu};
            EpiMoe1 E{(bf16*)(ws + WS_ACT), ginp(F, I_BE1) + (size_t)l * 32 * 2048};
            pg8::gemm_phase<EpiMoe1, SchedMoe1F8, true, true>(F.lds, 512, 512, Sm, E);
            if (CONV_IN_LAYER && CONV_TAIL1 > 0 && rep_ == 0 && l + 1 < DEPTH) {
                const int nun = tb[32] * 8, rounds = (nun + F.G - 1) / F.G, mine = F.vcu < nun ? (nun - 1 - F.vcu) / F.G + 1 : 0;
                if (mine < rounds) { PHASE_BEGIN(); conv_claim_tiles(F, l + 1, CONV_TAIL1); }
            }
        }
        SEAM(P + 9);
        if (PHON(11) && IN(P + 10)) _Pragma("unroll 1") for (int rep_ = 0; rep_ < NREP(11); ++rep_) { PHASE_BEGIN();
            moe_tables(F, l);
            const LAS int* tb = (const LAS int*)(F.lds + AUX_OFF);
            SchedMoe2F8 Sm{tb, (const char*)(ws + WS_ACT), (const char*)(ws + WS_W2E) + (size_t)l * 32 * 1024 * 1024, tb[32] * 4, F.G, F.vcu};
            EpiMoe2 E{(unsigned char*)(ws + WS_Y2), ginp(F, I_BE2) + (size_t)l * 32 * 1024};
            pg8::gemm_phase<EpiMoe2, SchedMoe2F8, false, true>(F.lds, 512, 512, Sm, E);
            if (CONV_IN_LAYER && CONV_TAIL2 > 0 && rep_ == 0 && l + 1 < DEPTH) {
                const int nun = tb[32] * 4, rounds = (nun + F.G - 1) / F.G, mine = F.vcu < nun ? (nun - 1 - F.vcu) / F.G + 1 : 0;
                if (mine < rounds) { PHASE_BEGIN(); conv_claim_tiles(F, l + 1, CONV_TAIL2); }
            }
        }
        SEAM(P + 10);
    }
    if (PHON(12) && IN(N_PHASES - 1)) { PHASE_BEGIN(); phase_norm1<1>(F, DEPTH); }
#undef IN
#undef SEAM
}

extern "C" void kernel_launch(void* const* d_in, const int* in_sizes, int n_in, void* d_out, int out_size, void* d_ws, size_t ws_size, hipStream_t stream) {
    static int grid = 0;
    if (grid == 0) {
        if (n_in != 33 || out_size != T * D || ws_size < WS_END * (DUM_MASK ? 2 : 1)) { fprintf(stderr, "kernel_launch: unexpected problem (n_in %d out %d ws %zu)\n", n_in, out_size, ws_size); grid = -1; return; }
        int dev = 0, cus = 0, per_cu = 0;
        if (hipGetDevice(&dev) != hipSuccess || hipDeviceGetAttribute(&cus, hipDeviceAttributeMultiprocessorCount, dev) != hipSuccess) { grid = -1; return; }
        if (hipFuncSetAttribute((const void*)fwd_kernel, hipFuncAttributeMaxDynamicSharedMemorySize, LDS_BYTES) != hipSuccess) { fprintf(stderr, "kernel_launch: hipFuncSetAttribute failed\n"); grid = -1; return; }
        if (hipOccupancyMaxActiveBlocksPerMultiprocessor(&per_cu, (const void*)fwd_kernel, 512, LDS_BYTES) != hipSuccess || per_cu < 1) { fprintf(stderr, "kernel_launch: occupancy query says %d\n", per_cu); per_cu = 1; }
        (void)hipGetLastError();
        grid = cus;
    }
    if (grid < 0) return;
    if (hipMemsetAsync((char*)d_ws + WS_CTL, 0, CTL_ZERO_BYTES, stream) != hipSuccess) return;
    Args a{};
    for (int i = 0; i < 33; ++i) a.in[i] = (const float*)d_in[i];
    a.out = (float*)d_out; a.ws = (unsigned char*)d_ws;
#if MK_PER_PHASE
    for (int p = 0; p < N_PHASES; ++p) { a.ph_lo = p; a.ph_hi = p + 1; hipLaunchKernelGGL(fwd_kernel, dim3(grid), dim3(512), LDS_BYTES, stream, a); }
#else
    a.ph_lo = 0; a.ph_hi = N_PHASES;
    hipLaunchKernelGGL(fwd_kernel, dim3(grid), dim3(512), LDS_BYTES, stream, a);
#endif
}
```

```cpp
#include <hip/hip_runtime.h>
#include <cstdio>
#include <cstdint>

#ifndef MK_PER_PHASE
#define MK_PER_PHASE 0
#endif

#ifndef PH_MASK
#define PH_MASK 0xFFFFFFFFu
#endif
#define PHON(k) ((PH_MASK >> (k)) & 1u)
#ifndef DBL_MASK
#define DBL_MASK 0u
#endif
#define NREP(k) (((DBL_MASK >> (k)) & 1u) ? 2 : 1)
#ifndef DUM_MASK
#define DUM_MASK 0u
#endif
#define DUM(k) ((DUM_MASK >> (k)) & 1u)
#ifndef ATT_VAR
#define ATT_VAR 0
#endif
#ifndef CONV_IN_LAYER
#define CONV_IN_LAYER 1
#endif
#ifndef CONV_TAIL1
#define CONV_TAIL1 3
#endif
#ifndef CONV_TAIL2
#define CONV_TAIL2 4
#endif
#ifndef ATT_STAGGER
#define ATT_STAGGER 0
#endif
#define DI __device__ __forceinline__
#define LAS __attribute__((address_space(3)))
#define GAS __attribute__((address_space(1)))
typedef unsigned short bf16;
typedef short bf16x8 __attribute__((ext_vector_type(8)));
typedef short s16x4 __attribute__((ext_vector_type(4)));
typedef float f32x2 __attribute__((ext_vector_type(2)));
typedef float f32x4 __attribute__((ext_vector_type(4)));
typedef float f32x16 __attribute__((ext_vector_type(16)));
typedef unsigned u32x2 __attribute__((ext_vector_type(2)));
typedef unsigned u32x4 __attribute__((ext_vector_type(4)));
typedef __bf16 bf16x2_t __attribute__((ext_vector_type(2)));
typedef unsigned long long u64;

constexpr int NB = 8, S = 4096, T = NB * S, D = 1024, DEPTH = 4;
constexpr int NIN = 2560;
constexpr int NE = 32, DFF = 1024;
constexpr int SP = S + 64;
constexpr int ECAP = 32768;
constexpr int ACT_ROWS = 4 * T + NE * 256;
constexpr float LOG2E = 1.4426950408889634f;
constexpr float SCL64 = 0.125f * LOG2E;
constexpr float SCL96 = 0.10206207261596577f * LOG2E;
constexpr float EPS = 1e-6f;

constexpr size_t MiB = 1u << 20;
constexpr size_t WS_CTL = 0, CTL_ZERO_BYTES = 2 * MiB;
constexpr size_t WS_MODS = 2 * MiB, WS_B1P = 3 * MiB, WS_CS64 = 4 * MiB, WS_CS32 = 12 * MiB;
constexpr size_t WS_WIN = 16 * MiB, WS_WOUT = 36 * MiB, WS_NSAW1 = 44 * MiB, WS_MLAQ = 52 * MiB, WS_MLAKV = 53 * MiB;
constexpr size_t WS_W1E = 64 * MiB, WS_W2E = 576 * MiB;
constexpr size_t WS_X = 832 * MiB, WS_H = 960 * MiB;
constexpr size_t WS_QA = 1024 * MiB, WS_KA = 1040 * MiB, WS_VA = 1056 * MiB, WS_QB = 1072 * MiB;
constexpr size_t WS_KCMP = 1104 * MiB, WS_VCMP = 1113 * MiB;
constexpr size_t WS_KSLC = 1122 * MiB, WS_VSLC = 1130 * MiB, WS_KWIN = 1138 * MiB, WS_VWIN = 1146 * MiB;
constexpr size_t WS_CQ = 1154 * MiB, WS_MISC = 1170 * MiB;
constexpr size_t WS_RSTDQ = 1186 * MiB, WS_RSTDKV = 1186 * MiB + 512 * 1024, WS_KR = 1187 * MiB, WS_GATES = 1189 * MiB;
constexpr size_t WS_W2T = 1195 * MiB;
constexpr size_t WS_HID = 1192 * MiB, WS_KC = 1196 * MiB, WS_VC = 1196 * MiB + 512 * 1024;
constexpr size_t WS_QM = 1197 * MiB, WS_KN = 1221 * MiB, WS_VM = 1237 * MiB;
constexpr size_t WS_OA3 = 1253 * MiB, WS_LSEA = 1301 * MiB;
constexpr size_t WS_OCMP = 1303 * MiB, WS_OSLC = 1335 * MiB, WS_OWIN = 1367 * MiB, WS_OC = 1399 * MiB;
constexpr size_t WS_SEL = 1415 * MiB, WS_AMIX = 1416 * MiB;
constexpr size_t WS_IDX = 1480 * MiB, WS_GATEW = 1484 * MiB, WS_TOKSLOT = 1488 * MiB, WS_TOKG = WS_TOKSLOT + 512 * 1024;
constexpr size_t WS_ACT = 1489 * MiB, WS_Y2 = 1761 * MiB, WS_END = 2033 * MiB;
static_assert((size_t)ACT_ROWS * 1024 * 2 <= 272 * MiB, "act rows");
static_assert((size_t)16 * SP * 64 * 2 + 65536 <= 9 * MiB, "kcmp");

constexpr int CW_TMO = 0, CW_FAIL = 2;
constexpr int CW_BAR = 4096;
constexpr int CW_QUEUE = 12288;
constexpr int CW_CONVQ = 13312;
constexpr int CW_CNT = 16384;

constexpr int RING_BYTES = 131072;
constexpr int AUX_OFF = RING_BYTES;
constexpr int MISC_OFF = AUX_OFF + 8192;
constexpr int LDS_BYTES = 147456;

DI unsigned pk2(float lo, float hi) { f32x2 v = {lo, hi}; bf16x2_t b = __builtin_convertvector(v, bf16x2_t); return __builtin_bit_cast(unsigned, b); }
DI float bf2f(unsigned short h) { return __uint_as_float(((unsigned)h) << 16); }
DI float bflo(unsigned w) { return __uint_as_float(w << 16); }
DI float bfhi(unsigned w) { return __uint_as_float(w & 0xffff0000u); }
typedef float f32x2c __attribute__((ext_vector_type(2)));
constexpr float Y2_SCALE = 4.0f, Y2_ISCALE = 1.0f / 4.0f;
DI unsigned pk4_fp8(float a, float b, float c, float d) {
    a = fminf(fmaxf(a * Y2_SCALE, -440.f), 440.f); b = fminf(fmaxf(b * Y2_SCALE, -440.f), 440.f); c = fminf(fmaxf(c * Y2_SCALE, -440.f), 440.f); d = fminf(fmaxf(d * Y2_SCALE, -440.f), 440.f);
    int w = __builtin_amdgcn_cvt_pk_fp8_f32(a, b, 0, false); w = __builtin_amdgcn_cvt_pk_fp8_f32(c, d, w, true); return (unsigned)w; }
DI f32x4 unpk4_fp8(unsigned w) { const f32x2c lo = __builtin_amdgcn_cvt_pk_f32_fp8((int)w, false), hi = __builtin_amdgcn_cvt_pk_f32_fp8((int)w, true); return (f32x4){lo.x, lo.y, hi.x, hi.y}; }
constexpr float W8_SCALE = 64.0f, A8_SCALE = 4.0f;
constexpr int W8_E8M0 = 127 - 6, A8_E8M0 = 127 - 2;
constexpr float H8_SCALE = 8.0f; constexpr int H8_E8M0 = 127 - 3;
DI int lane_id() { return (int)__builtin_amdgcn_mbcnt_hi(~0u, __builtin_amdgcn_mbcnt_lo(~0u, 0u)); }
DI unsigned pk4_fp8s(float a, float b, float c, float d, float sc) {
    a = fminf(fmaxf(a * sc, -440.f), 440.f); b = fminf(fmaxf(b * sc, -440.f), 440.f); c = fminf(fmaxf(c * sc, -440.f), 440.f); d = fminf(fmaxf(d * sc, -440.f), 440.f);
    int w = __builtin_amdgcn_cvt_pk_fp8_f32(a, b, 0, false); w = __builtin_amdgcn_cvt_pk_fp8_f32(c, d, w, true); return (unsigned)w; }
DI float q8s(float x, float sc) {
    const float a = fminf(fmaxf(x * sc, -440.f), 440.f); const int w = __builtin_amdgcn_cvt_pk_fp8_f32(a, a, 0, false);
    const f32x2c r = __builtin_amdgcn_cvt_pk_f32_fp8(w, false); return r.x; }
template <int CTRL> DI float dpp_perm(float v) { return __builtin_bit_cast(float, __builtin_amdgcn_update_dpp(0, __builtin_bit_cast(int, v), CTRL, 0xf, 0xf, false)); }
DI float row_sum16(float v) { v += dpp_perm<0xB1>(v); v += dpp_perm<0x4E>(v); v += dpp_perm<0x141>(v); v += dpp_perm<0x140>(v); return v; }
DI float wave_sum(float v) {
    v = row_sum16(v);
    const float r0 = __builtin_bit_cast(float, __builtin_amdgcn_readlane(__builtin_bit_cast(int, v), 0)), r1 = __builtin_bit_cast(float, __builtin_amdgcn_readlane(__builtin_bit_cast(int, v), 16));
    const float r2 = __builtin_bit_cast(float, __builtin_amdgcn_readlane(__builtin_bit_cast(int, v), 32)), r3 = __builtin_bit_cast(float, __builtin_amdgcn_readlane(__builtin_bit_cast(int, v), 48));
    return (r0 + r1) + (r2 + r3);
}
DI float fast_exp2(float x) { return __builtin_amdgcn_exp2f(x); }
DI float fast_rcp(float x) { return __builtin_amdgcn_rcpf(x); }
DI float sigmoidf_(float x) { return fast_rcp(1.0f + fast_exp2(-x * LOG2E)); }
#define RLX_AGENT __ATOMIC_RELAXED, __HIP_MEMORY_SCOPE_AGENT

#define XB_TMO      128
#define XB_XCNT(j)  (256  + 64 * (j))
#define XB_XSUB(j)  (1280 + 64 * (j))
#define XB_XGEN(j)  (2304 + 64 * (j))
#define XB_TOP      3328
#define XB_TOPGEN   3392
#define XCD_BAR_WORDS 3456
#define XB_SPIN_CAP (1u << 22)
DI unsigned xb_ld(unsigned* p)              { return __hip_atomic_load(p, __ATOMIC_RELAXED, __HIP_MEMORY_SCOPE_AGENT); }
DI unsigned xb_add(unsigned* p, unsigned v) { return __hip_atomic_fetch_add(p, v, __ATOMIC_RELAXED, __HIP_MEMORY_SCOPE_AGENT); }
DI unsigned xb_xcc_id() { return (unsigned)__builtin_amdgcn_s_getreg((3 << 11) | 20) & 0xFu; }
#define XB_SPIN(cond, bar) do { unsigned _sp = 0; while (cond) { __builtin_amdgcn_s_sleep(1); \
    if ((++_sp & 255u) == 0u) { if (xb_ld(&(bar)[XB_TMO])) break; if (_sp > XB_SPIN_CAP) { atomicAdd(&(bar)[XB_TMO], 1u); break; } } } } while (0)
struct XcdBarrier { unsigned* bar; unsigned x; volatile LAS unsigned* st; };
DI XcdBarrier xcd_barrier_post(unsigned* bar, volatile LAS unsigned* st) {
    XcdBarrier b; b.bar = bar; b.x = xb_xcc_id(); b.st = st;
    if (threadIdx.x == 0) (void)xb_add(&bar[XB_XCNT(b.x)], 1u);
    return b;
}
DI void xcd_barrier_complete(unsigned* bar, unsigned x, unsigned& nloc, unsigned& nx) {
    const unsigned G = gridDim.x * gridDim.y * gridDim.z;
    unsigned sum, cnt, mine, sp = 0u;
    for (;;) {
        sum = 0u; cnt = 0u; mine = 0u;
#pragma unroll
        for (unsigned j = 0; j < 16; ++j) { const unsigned c = xb_ld(&bar[XB_XCNT(j)]); sum += c; cnt += (c > 0u) ? 1u : 0u; mine = (j == x) ? c : mine; }
        if (sum == G) break;
        __builtin_amdgcn_s_sleep(1);
        if ((++sp & 255u) == 0u) { if (xb_ld(&bar[XB_TMO])) break; if (sp > XB_SPIN_CAP) { atomicAdd(&bar[XB_TMO], 1u); break; } }
    }
    nloc = mine > 0u ? mine : 1u; nx = cnt > 0u ? cnt : 1u;
}
DI void xcd_barrier(const XcdBarrier& b) {
    asm volatile("s_waitcnt vmcnt(0)" ::: "memory");
    __syncthreads();
    unsigned* bar = b.bar; asm volatile("" : "+s"(bar));
    if (threadIdx.x == 0) {
        __builtin_amdgcn_s_waitcnt(0);
        unsigned nloc = b.st[0], nx = b.st[1];
        if (nloc == 0u) { xcd_barrier_complete(bar, b.x, nloc, nx); b.st[0] = nloc; b.st[1] = nx; }
        const unsigned old = xb_add(&bar[XB_XSUB(b.x)], 1u);
        const unsigned gen = old / nloc;
        if (old + 1u == (gen + 1u) * nloc) {
            __builtin_amdgcn_fence(__ATOMIC_RELEASE, "agent");
            asm volatile("s_waitcnt vmcnt(0)" ::: "memory");
            const unsigned og = xb_add(&bar[XB_TOP], 1u);
            const unsigned tg = og / nx;
            if (og + 1u == (tg + 1u) * nx) xb_add(&bar[XB_TOPGEN], 1u);
            else XB_SPIN(xb_ld(&bar[XB_TOPGEN]) == tg, bar);
            __builtin_amdgcn_fence(__ATOMIC_ACQUIRE, "agent");
            xb_add(&bar[XB_XGEN(b.x)], 1u);
            asm volatile("s_waitcnt vmcnt(0)" ::: "memory");
        } else {
            XB_SPIN(xb_ld(&bar[XB_XGEN(b.x)]) == gen, bar);
            __builtin_amdgcn_fence(__ATOMIC_ACQUIRE, "agent");
            asm volatile("s_waitcnt vmcnt(0)" ::: "memory");
        }
    }
    __syncthreads();
}

struct Args {
    const float* in[33];
    float* out;
    unsigned char* ws;
    int ph_lo, ph_hi;
};
enum { I_X = 0, I_C, I_POS, I_WADA, I_BADA, I_G1, I_G2, I_WIN, I_POSK, I_POSV, I_W1K, I_B1K, I_W2K, I_B2K, I_W1V, I_B1V, I_W2V, I_B2V,
       I_GQ, I_GKV, I_WQUP, I_WKVUP, I_GOA, I_GOB, I_GOC, I_WOUT, I_WR, I_BR, I_WE1, I_BE1, I_WE2, I_BE2, I_GF };

struct Ctx {
    LAS unsigned char* lds;
    const Args* a;
    unsigned char* ws;
    int tid, lane, wave, blk, G, vcu;
    size_t dofs; int dcnt;
};
DI const float* ginp(const Ctx& F, int i) { return (const float*)(GAS const float*)(F.a->in[i]); }
DI float* gout(const Ctx& F) { return (float*)(GAS float*)(F.a->out); }

namespace pg8 {
constexpr int BM = 256, BK = 64, HALF = 128, HTB = HALF * BK * 2;
DI int lds_byte(int r, int c) { const int st = (r >> 4) * 2 + (c >> 5), rr = r & 15, cc = c & 31, ob = rr * 64 + cc * 2; return st * 1024 + (ob ^ (((ob >> 9) & 1) << 5)); }
DI void stage_rc(int b, int& R, int& C) { const int st = b / 1024, sb = b % 1024, swz = sb ^ (((sb >> 9) & 1) << 5); R = (st >> 1) * 16 + swz / 64; C = (st & 1) * 32 + (swz % 64) / 2; }
DI int perm32(int rho) { const int n = rho >> 4, i = rho & 15; return 8 * (i >> 2) + 4 * n + (i & 3); }
struct Unit { const char* a; const char* b; int pm, pn, e, ml; };
template <class E_, class = void> struct acc_bias_t { static constexpr bool value = false; };
template <class E_> struct acc_bias_t<E_, decltype((void)E_::ACC_BIAS)> { static constexpr bool value = E_::ACC_BIAS; };
template <class E_> constexpr bool acc_bias_v = acc_bias_t<E_>::value;
template <class E_, class = void> struct perm2_t { static constexpr bool value = false; };
template <class E_> struct perm2_t<E_, decltype((void)E_::PERM2)> { static constexpr bool value = E_::PERM2; };
template <class E_> constexpr bool perm2_v = perm2_t<E_>::value;

template <class Epi, class Sched, bool GATHER, bool FP8 = false>
DI void gemm_phase(LAS unsigned char* lds, const int lda, const int K, const Sched& S, const Epi& E) {
    typedef int i32x4_ __attribute__((ext_vector_type(4))); typedef int i32x8_ __attribute__((ext_vector_type(8)));
    int tid_ = threadIdx.x; asm volatile("" : "+v"(tid_));
    const int tid = tid_, wid = __builtin_amdgcn_readfirstlane(tid >> 6), lane = tid & 63, wr = wid >> 2, wc = wid & 3, fr = lane & 15, fq = lane >> 4;
    const int nt = K / BK;
    int Rr[2], Cc[2]; unsigned voffB[2];
#pragma unroll
    for (int i = 0; i < 2; ++i) { int R, C; stage_rc(tid * 16 + i * 8192, R, C); Rr[i] = R; Cc[i] = C; const int Rb = perm2_v<Epi> ? ((R >> 5) * 64 + 16 * ((R & 15) >> 2) + 4 * ((R >> 4) & 1) + (R & 3)) : (Epi::PERM ? ((R & ~31) + perm32(R & 31)) : R); voffB[i] = (unsigned)(Rb * K + C) * 2u; }
    const size_t kstep = (size_t)(BK * 2);
    const size_t hstepB = (size_t)(perm2_v<Epi> ? 8 : HALF) * K * 2;
    const size_t istepB = (size_t)(perm2_v<Epi> ? 128 : 64) * K * 2;
    const unsigned ldsw = (unsigned)wid * 1024u;
    const int aoff = lds_byte(wr * 64 + fr, fq * 8), boff = lds_byte(wc * 32 + fr, fq * 8);
#define PG8_SA(b, h) (((b) * 2 + (h)) * HTB)
#define PG8_SB(b, h) ((4 + (b) * 2 + (h)) * HTB)
#define PG8_STAGE_B(bufoff, gbase) do { _Pragma("unroll") for (int _i = 0; _i < 2; ++_i) \
        __builtin_amdgcn_global_load_lds((const unsigned*)((const char*)(gbase) + (size_t)_i * istepB + voffB[0]), (LAS unsigned*)(lds + (bufoff) + ldsw + _i * 8192), 16, 0, 0); } while (0)
#define PG8_STAGE_A(bufoff, gbase, v, h) do { _Pragma("unroll") for (int _i = 0; _i < 2; ++_i) { \
        if constexpr (GATHER) __builtin_amdgcn_global_load_lds((const unsigned*)((const char*)(gbase) + (v)[h][_i]), (LAS unsigned*)(lds + (bufoff) + ldsw + _i * 8192), 16, 0, 0); \
        else __builtin_amdgcn_global_load_lds((const unsigned*)((const char*)(gbase) + (size_t)((h) * 128 + _i * 64) * lda * 2 + (v)[0][0]), (LAS unsigned*)(lds + (bufoff) + ldsw + _i * 8192), 16, 0, 0); } } while (0)
#define PG8_SETOFF(v, u) do { _Pragma("unroll") for (int _h = 0; _h < 2; ++_h) _Pragma("unroll") for (int _i = 0; _i < 2; ++_i) { \
        if constexpr (GATHER) (v)[_h][_i] = S.gather_off((u), _h * 128 + Rr[_i]) + (unsigned)Cc[_i] * 2u; \
        else (v)[_h][_i] = (unsigned)((_h * 128 + Rr[_i]) * lda + Cc[_i]) * 2u; } } while (0)
#define PG8_LDA(dst, b, h) do { _Pragma("unroll") for (int m = 0; m < 4; ++m) { const i32x4_ lo_ = *(const LAS i32x4_*)(lds + PG8_SA(b, h) + aoff + m * 2048), hi_ = *(const LAS i32x4_*)(lds + PG8_SA(b, h) + aoff + m * 2048 + 1024); dst[m] = __builtin_shufflevector(lo_, hi_, 0, 1, 2, 3, 4, 5, 6, 7); } } while (0)
#define PG8_LDB(dst, b, h) do { _Pragma("unroll") for (int n = 0; n < 2; ++n) { const i32x4_ lo_ = *(const LAS i32x4_*)(lds + PG8_SB(b, h) + boff + n * 2048), hi_ = *(const LAS i32x4_*)(lds + PG8_SB(b, h) + boff + n * 2048 + 1024); dst[n] = __builtin_shufflevector(lo_, hi_, 0, 1, 2, 3, 4, 5, 6, 7); } } while (0)
#define PG8_H0(x) __builtin_bit_cast(bf16x8, __builtin_shufflevector((x), (x), 0, 1, 2, 3))
#define PG8_H1(x) __builtin_bit_cast(bf16x8, __builtin_shufflevector((x), (x), 4, 5, 6, 7))
#define PG8_MMA(ai, bj, At, Bt) do { __builtin_amdgcn_s_setprio(1); \
        if constexpr (FP8) { _Pragma("unroll") for (int m = 0; m < 4; ++m) _Pragma("unroll") for (int n = 0; n < 2; ++n) \
            asm volatile("v_mfma_scale_f32_16x16x128_f8f6f4 %0, %1, %2, %0, %3, %4 op_sel_hi:[0,0,0]" : "+v"(acc[ai][bj][m][n]) : "v"(Bt[n]), "v"(At[m]), "v"(scw_), "v"(sca_)); } \
        else { _Pragma("unroll") for (int m = 0; m < 4; ++m) _Pragma("unroll") for (int n = 0; n < 2; ++n) { \
            acc[ai][bj][m][n] = __builtin_amdgcn_mfma_f32_16x16x32_bf16(PG8_H0(Bt[n]), PG8_H0(At[m]), acc[ai][bj][m][n], 0, 0, 0); \
            acc[ai][bj][m][n] = __builtin_amdgcn_mfma_f32_16x16x32_bf16(PG8_H1(Bt[n]), PG8_H1(At[m]), acc[ai][bj][m][n], 0, 0, 0); } } \
        __builtin_amdgcn_s_setprio(0); } while (0)
#define PG8_WAIT_V(n) asm volatile("s_waitcnt vmcnt(" #n ")" ::: "memory")
#define PG8_WAIT_L(n) asm volatile("s_waitcnt lgkmcnt(" #n ")" ::: "memory")
#define PG8_BAR __builtin_amdgcn_s_barrier()
#define PG8_SCHED __builtin_amdgcn_sched_barrier(0)
    Unit cur, nxt; int ui = 0;
    if (!S.next(0, cur)) return;
    f32x4 acc[2][2][4][2];
    f32x4 bv[2][2] = {{{0.f, 0.f, 0.f, 0.f}, {0.f, 0.f, 0.f, 0.f}}, {{0.f, 0.f, 0.f, 0.f}, {0.f, 0.f, 0.f, 0.f}}};
    if constexpr (acc_bias_v<Epi>) E.bias(cur, wc, fq, bv);
#pragma unroll
    for (int a = 0; a < 2; ++a)
#pragma unroll
        for (int b = 0; b < 2; ++b)
#pragma unroll
            for (int m = 0; m < 4; ++m)
#pragma unroll
                for (int n = 0; n < 2; ++n) acc[a][b][m][n] = bv[b][n];
    int scw_ = W8_E8M0, sca_ = A8_E8M0; if constexpr (FP8) sca_ = Epi::A_E8M0;
    i32x8_ At[4], B0[2], B1[2];
    unsigned vA[2][2], vAn[2][2];
    PG8_SETOFF(vA, cur);
    const char* cA = cur.a; const char* cB = cur.b;
    PG8_STAGE_B(PG8_SB(0, 0), cB); PG8_STAGE_B(PG8_SB(0, 1), cB + hstepB); PG8_STAGE_A(PG8_SA(0, 0), cA, vA, 0); PG8_STAGE_A(PG8_SA(0, 1), cA, vA, 1);
    if (wr == 1) PG8_BAR;
    PG8_WAIT_V(2); PG8_BAR;
    PG8_STAGE_B(PG8_SB(1, 0), cB + kstep); PG8_STAGE_A(PG8_SA(1, 0), cA + kstep, vA, 0); PG8_STAGE_B(PG8_SB(1, 1), cB + hstepB + kstep);
    PG8_WAIT_V(6); PG8_BAR;
    for (;;) {
        const bool has_next = S.next(ui + 1, nxt);
        if constexpr (GATHER) {
            if (has_next) {
#pragma unroll
                for (int h = 0; h < 2; ++h)
#pragma unroll
                    for (int i = 0; i < 2; ++i) vAn[h][i] = S.gather_raw(nxt, h * 128 + Rr[i]);
            }
        }
        const char* nA = has_next ? nxt.a : cA; const char* nB = has_next ? nxt.b : cB;
#pragma unroll 1
        for (int t = 0; t < nt; t += 2) {
            const bool last = (t == nt - 2);
            const char* a1 = cA + (size_t)(t + 1) * kstep;
            const char* a2 = last ? nA : cA + (size_t)(t + 2) * kstep; const char* b2 = last ? nB : cB + (size_t)(t + 2) * kstep;
            const char* a3 = a2 + kstep; const char* b3 = b2 + kstep;
            unsigned v2[2][2];
#pragma unroll
            for (int h = 0; h < 2; ++h)
#pragma unroll
                for (int i = 0; i < 2; ++i) v2[h][i] = vA[h][i];
            if constexpr (GATHER) {
                if (last && has_next) {
#pragma unroll
                    for (int h = 0; h < 2; ++h)
#pragma unroll
                        for (int i = 0; i < 2; ++i) { vAn[h][i] = vAn[h][i] * (unsigned)(lda * 2) + (unsigned)Cc[i] * 2u; v2[h][i] = vAn[h][i]; }
                }
            }
            PG8_LDB(B0, 0, 0); PG8_LDB(B1, 0, 1); PG8_SCHED; PG8_LDA(At, 0, 0); PG8_STAGE_A(PG8_SA(1, 1), a1, vA, 1);
            PG8_WAIT_V(8); PG8_WAIT_L(0); PG8_BAR; PG8_MMA(0, 0, At, B0); PG8_MMA(0, 1, At, B1); PG8_BAR; PG8_SCHED;
            PG8_LDA(At, 0, 1); PG8_STAGE_B(PG8_SB(0, 0), b2); PG8_STAGE_B(PG8_SB(0, 1), b2 + hstepB); PG8_STAGE_A(PG8_SA(0, 0), a2, v2, 0);
            PG8_WAIT_V(8); PG8_WAIT_L(0); PG8_BAR; PG8_MMA(1, 0, At, B0); PG8_MMA(1, 1, At, B1); PG8_BAR; PG8_SCHED;
            PG8_LDB(B0, 1, 0); PG8_LDB(B1, 1, 1); PG8_SCHED; PG8_LDA(At, 1, 0); PG8_STAGE_A(PG8_SA(0, 1), a2, v2, 1);
            PG8_WAIT_V(8); PG8_WAIT_L(0); PG8_BAR; PG8_MMA(0, 0, At, B0); PG8_MMA(0, 1, At, B1); PG8_BAR; PG8_SCHED;
            PG8_LDA(At, 1, 1); PG8_STAGE_B(PG8_SB(1, 0), b3); PG8_STAGE_B(PG8_SB(1, 1), b3 + hstepB); PG8_STAGE_A(PG8_SA(1, 0), a3, v2, 0);
            PG8_WAIT_V(8); PG8_WAIT_L(0); PG8_BAR; PG8_MMA(1, 0, At, B0); PG8_MMA(1, 1, At, B1); PG8_BAR; PG8_SCHED;
        }
        if (wr == 0) PG8_BAR;
        if constexpr (FP8) asm volatile("s_nop 15\n\ts_nop 15" ::: "memory");
        if constexpr (acc_bias_v<Epi>) E.bias(has_next ? nxt : cur, wc, fq, bv);
        if constexpr (!Epi::AFTER_DRAIN) { int fr_ = fr, fq_ = fq; asm volatile("" : "+v"(fr_), "+v"(fq_)); E(acc, cur, wr, wc, fr_, fq_); }
        if (!has_next) break;
#pragma unroll
        for (int a = 0; a < 2; ++a)
#pragma unroll
            for (int b = 0; b < 2; ++b)
#pragma unroll
                for (int m = 0; m < 4; ++m)
#pragma unroll
                    for (int n = 0; n < 2; ++n) acc[a][b][m][n] = bv[b][n];
        cur = nxt; cA = nA; cB = nB; ++ui;
        if constexpr (GATHER) {
#pragma unroll
            for (int h = 0; h < 2; ++h)
#pragma unroll
                for (int i = 0; i < 2; ++i) vA[h][i] = vAn[h][i];
        }
        if (wr == 1) PG8_BAR;
    }
    PG8_WAIT_V(0);
    PG8_BAR;
    if constexpr (Epi::AFTER_DRAIN) { int fr_ = fr, fq_ = fq; asm volatile("" : "+v"(fr_), "+v"(fq_)); E.fused(acc, cur, wr, wc, fr_, fq_, lds, wid, lane); }
#undef PG8_SA
#undef PG8_SB
#undef PG8_STAGE_A
#undef PG8_STAGE_B
#undef PG8_SETOFF
#undef PG8_LDA
#undef PG8_LDB
#undef PG8_MMA
#undef PG8_H0
#undef PG8_H1
#undef PG8_WAIT_V
#undef PG8_WAIT_L
#undef PG8_BAR
#undef PG8_SCHED
}
}
using pg8::Unit;
typedef f32x4 AccT[2][2][4][2];

struct SchedGrid {
    const char* A; const char* B; int lda, K, nN, nwg, G, c;
    DI bool next(int i, Unit& u) const {
        const int L = i * G + c; if (L >= nwg) return false;
        u.pm = L / nN; u.pn = L % nN; u.e = 0; u.ml = 0;
        u.a = A + (size_t)u.pm * 256 * lda * 2; u.b = B + (size_t)u.pn * 256 * K * 2; return true;
    }
    DI unsigned gather_off(const Unit&, int) const { return 0u; }
    DI unsigned gather_raw(const Unit&, int) const { return 0u; }
};
struct SchedCmp {
    const char* KCMP; const char* VCMP; const char* W; int G, c;
    DI bool next(int i, Unit& u) const {
        const int L = i * G + c; if (L >= 32) return false;
        const int kv = L >> 4, bg = L & 15;
        u.pm = L; u.pn = 0; u.e = kv; u.ml = 0;
        u.a = (kv ? VCMP : KCMP) + (size_t)bg * SP * 64 * 2; u.b = W + (size_t)kv * 256 * 2048 * 2; return true;
    }
    DI unsigned gather_off(const Unit&, int) const { return 0u; }
    DI unsigned gather_raw(const Unit&, int) const { return 0u; }
};
struct SchedMla {
    const char* CQ; const char* MISC; const char* WQ; const char* WKV; int G, c;
    DI bool next(int i, Unit& u) const {
        const int L = i * G + c; if (L >= 512) return false;
        const int which = L >> 8, r = L & 255;
        u.pm = r >> 1; u.pn = r & 1; u.e = which; u.ml = 0;
        u.a = (which ? MISC : CQ) + (size_t)u.pm * 256 * 256 * 2; u.b = (which ? WKV : WQ) + (size_t)u.pn * 256 * 256 * 2; return true;
    }
    DI unsigned gather_off(const Unit&, int) const { return 0u; }
    DI unsigned gather_raw(const Unit&, int) const { return 0u; }
};
template <int NT, bool GATHERED>
struct SchedMoe {
    const LAS int* tb; const LAS int* cnt; const char* A; const char* W; const int* IDX; int total, G, c;
    DI bool next(int i, Unit& u) const {
        const int L = i * G + c; if (L >= total) return false;
        const int mtg = L / NT; u.pn = L % NT;
        const int ln_ = threadIdx.x & 63;
        const int e = __popcll(__ballot(ln_ < 32 && tb[ln_ & 31] <= mtg)) - 1;
        u.e = e; u.ml = mtg - tb[e]; u.pm = mtg;
        u.a = GATHERED ? A : A + (size_t)mtg * 256 * 1024 * 2;
        u.b = W + ((size_t)e * NT * 256 + (size_t)u.pn * 256) * 1024 * 2; return true;
    }
    DI unsigned gather_off(const Unit& u, int row) const {
        const int pos = u.ml * 256 + row; const int tok = (pos < cnt[u.e]) ? IDX[u.e * ECAP + pos] : 0;
        return (unsigned)tok * 2048u;
    }
    DI unsigned gather_raw(const Unit& u, int row) const {
        const int pos = u.ml * 256 + row;
        return (unsigned)IDX[u.e * ECAP + (pos < cnt[u.e] ? pos : 0)];
    }
};

struct SchedMoe1F8 {
    static constexpr bool HOOK = false;
    const LAS int* tb; const LAS int* cnt; const char* A; const char* W; const int* IDX; int total, G, c;
    DI bool next(int i, Unit& u) const {
        const int L = i * G + c; if (L >= total) return false;
        const int mtg = L >> 3; u.pn = L & 7;
        const int ln_ = lane_id();
        const int e = __popcll(__ballot(ln_ < 32 && tb[ln_ & 31] <= mtg)) - 1;
        u.e = e; u.ml = mtg - tb[e]; u.pm = mtg;
        u.a = A; u.b = W + ((size_t)e * 2048 + (size_t)u.pn * 256) * 1024; return true;
    }
    DI unsigned gather_raw(const Unit& u, int row) const { const int pos = u.ml * 256 + row; return (unsigned)IDX[u.e * ECAP + (pos < cnt[u.e] ? pos : 0)]; }
    DI unsigned gather_off(const Unit& u, int row) const { return gather_raw(u, row) * 1024u; }
};
struct SchedMoe2F8 {
    static constexpr bool HOOK = false;
    const LAS int* tb; const char* A; const char* W; int total, G, c;
    DI bool next(int i, Unit& u) const {
        const int L = i * G + c; if (L >= total) return false;
        const int mtg = L >> 2; u.pn = L & 3;
        const int ln_ = lane_id();
        const int e = __popcll(__ballot(ln_ < 32 && tb[ln_ & 31] <= mtg)) - 1;
        u.e = e; u.ml = mtg - tb[e]; u.pm = mtg;
        u.a = A + (size_t)mtg * 256 * 1024; u.b = W + ((size_t)e * 1024 + (size_t)u.pn * 256) * 1024; return true;
    }
    DI unsigned gather_off(const Unit&, int) const { return 0u; }
    DI unsigned gather_raw(const Unit&, int) const { return 0u; }
};

DI void rot4(f32x4& v0, f32x4& v1, const f32x4 c, const f32x4 s) {
    const float a0 = v0[0], b0 = v0[1], a1 = v0[2], b1 = v0[3], a2 = v1[0], b2 = v1[1], a3 = v1[2], b3 = v1[3];
    v0[0] = a0 * c[0] - b0 * s[0]; v0[1] = b0 * c[0] + a0 * s[0];
    v0[2] = a1 * c[1] - b1 * s[1]; v0[3] = b1 * c[1] + a1 * s[1];
    v1[0] = a2 * c[2] - b2 * s[2]; v1[1] = b2 * c[2] + a2 * s[2];
    v1[2] = a3 * c[3] - b3 * s[3]; v1[3] = b3 * c[3] + a3 * s[3];
}
DI u32x4 pack8(const f32x4 v0, const f32x4 v1) { u32x4 w; w.x = pk2(v0[0], v0[1]); w.y = pk2(v0[2], v0[3]); w.z = pk2(v1[0], v1[1]); w.w = pk2(v1[2], v1[3]); return w; }

struct EpiWin {
    static constexpr bool PERM = true, AFTER_DRAIN = false;
    unsigned char* ws; const float* CS64; const float* CS32;
    DI void dest(int pn, int w0, size_t& off, int& ld, int& dcol, int& mode, int& gm, int& g, float& sc) const {
        mode = 0; gm = 0; g = 0; sc = 1.f;
        switch (pn) {
            case 0: off = WS_QA; ld = 256; dcol = w0; mode = 1; sc = SCL64; break;
            case 1: off = WS_KA; ld = 256; dcol = w0; mode = 1; break;
            case 2: off = WS_VA; ld = 256; dcol = w0; break;
            case 3: off = WS_QB; ld = 512; dcol = w0; mode = 1; sc = SCL64; break;
            case 4: off = WS_QB; ld = 512; dcol = 256 + w0; mode = 1; sc = SCL64; break;
            case 5: off = (w0 < 128) ? WS_KCMP : WS_VCMP; ld = 64; gm = 1; g = (w0 & 127) >> 6; dcol = w0 & 63; break;
            case 6: off = (w0 < 128) ? WS_KSLC : WS_VSLC; ld = 128; dcol = w0 & 127; mode = (w0 < 128) ? 1 : 0; break;
            case 7: off = (w0 < 128) ? WS_KWIN : WS_VWIN; ld = 128; dcol = w0 & 127; mode = (w0 < 128) ? 1 : 0; break;
            case 8: off = WS_CQ; ld = 256; dcol = w0; break;
            default: if (w0 == 128) { off = WS_KR; ld = 32; dcol = 0; mode = 2; } else { off = WS_MISC; ld = 256; dcol = w0; } break;
        }
    }
    DI void operator()(const AccT& acc, const Unit& u, int wr, int wc, int fr, int fq) const {
        size_t off[2]; int ld[2], dcol[2], mode[2], gm[2], g[2]; float sc[2];
#pragma unroll
        for (int bj = 0; bj < 2; ++bj) dest(u.pn, bj * 128 + wc * 32, off[bj], ld[bj], dcol[bj], mode[bj], gm[bj], g[bj], sc[bj]);
        const bool shared = (mode[0] == 1) && (mode[1] == 1);
        const int i0 = 16 * (wc & 1) + 4 * fq;
#pragma unroll
        for (int ai = 0; ai < 2; ++ai) {
            f32x4 cc[4], sn[4];
            if (shared) {
#pragma unroll
                for (int m = 0; m < 4; ++m) { const int row = u.pm * 256 + ai * 128 + wr * 64 + m * 16 + fr; const float* cs = CS64 + (size_t)row * 64 + i0; cc[m] = *(const f32x4*)cs; sn[m] = *(const f32x4*)(cs + 32); }
            }
#pragma unroll
            for (int bj = 0; bj < 2; ++bj) {
                bf16* base = (bf16*)(ws + off[bj]);
                const int md = mode[bj];
                if (md && !shared) {
#pragma unroll
                    for (int m = 0; m < 4; ++m) {
                        const int row = u.pm * 256 + ai * 128 + wr * 64 + m * 16 + fr;
                        const float* cs = (md == 1) ? CS64 + (size_t)row * 64 + i0 : CS32 + (size_t)row * 32 + 4 * fq;
                        cc[m] = *(const f32x4*)cs; sn[m] = *(const f32x4*)(cs + (md == 1 ? 32 : 16));
                    }
                }
#pragma unroll
                for (int m = 0; m < 4; ++m) {
                    const int row = u.pm * 256 + ai * 128 + wr * 64 + m * 16 + fr;
                    f32x4 v0 = acc[ai][bj][m][0], v1 = acc[ai][bj][m][1];
                    if (md) rot4(v0, v1, cc[m], sn[m]);
                    v0 = v0 * sc[bj]; v1 = v1 * sc[bj];
                    const size_t drow = gm[bj] ? (size_t)(((row >> 12) * 2 + g[bj]) * SP + (row & 4095)) : (size_t)row;
                    *(u32x4*)(base + drow * ld[bj] + dcol[bj] + 8 * fq) = pack8(v0, v1);
                }
            }
        }
    }
};
struct EpiCmp {
    static constexpr bool PERM = true, AFTER_DRAIN = true;
    const float* B1P; const bf16* W2T; const float *B2K, *B2V; bf16 *KC, *VC; const float* CS64;
    DI void fused(const AccT& acc, const Unit& u, int wr, int wc, int fr, int fq, LAS unsigned char* lds, int wid, int lane) const {
        constexpr int HST = 528;
        const int kv = u.e, bg = u.pm & 15;
#pragma unroll
        for (int bj = 0; bj < 2; ++bj) {
            const int col = bj * 128 + wc * 32 + 8 * fq;
            const f32x4 b0 = *(const f32x4*)(B1P + kv * 256 + col), b1 = *(const f32x4*)(B1P + kv * 256 + col + 4);
#pragma unroll
            for (int ai = 0; ai < 2; ++ai)
#pragma unroll
                for (int m = 0; m < 4; ++m) {
                    const int rl = ai * 128 + wr * 64 + m * 16 + fr;
                    f32x4 v0 = acc[ai][bj][m][0] + b0, v1 = acc[ai][bj][m][1] + b1;
#pragma unroll
                    for (int j = 0; j < 4; ++j) {
                        float x = v0[j]; float z = 0.7978845608028654f * (x + 0.044715f * x * x * x); v0[j] = x * sigmoidf_(2.f * z);
                        x = v1[j]; z = 0.7978845608028654f * (x + 0.044715f * x * x * x); v1[j] = x * sigmoidf_(2.f * z);
                    }
                    *(LAS u32x4*)(lds + rl * HST + col * 2) = pack8(v0, v1);
                }
        }
        asm volatile("s_waitcnt lgkmcnt(0)\n\ts_barrier" ::: "memory");
        const int r32 = lane & 31, hh = lane >> 5;
        f32x16 out0 = {0.f, 0.f, 0.f, 0.f, 0.f, 0.f, 0.f, 0.f, 0.f, 0.f, 0.f, 0.f, 0.f, 0.f, 0.f, 0.f}, out1 = out0;
        const bf16* w2 = W2T + (size_t)kv * 64 * 256;
#pragma unroll 4
        for (int ks = 0; ks < 16; ++ks) {
            const bf16x8 a = *(const LAS bf16x8*)(lds + (32 * wid + r32) * HST + (16 * ks + 8 * hh) * 2);
            const bf16x8 bq0 = *(const bf16x8*)(w2 + (size_t)r32 * 256 + 16 * ks + 8 * hh), bq1 = *(const bf16x8*)(w2 + (size_t)(32 + r32) * 256 + 16 * ks + 8 * hh);
            out0 = __builtin_amdgcn_mfma_f32_32x32x16_bf16(a, bq0, out0, 0, 0, 0); out1 = __builtin_amdgcn_mfma_f32_32x32x16_bf16(a, bq1, out1, 0, 0, 0);
        }
        const float* b2 = kv ? B2V : B2K;
        const float bb0 = b2[r32], bb1 = b2[32 + r32];
        const int b = bg >> 1;
#pragma unroll
        for (int i = 0; i < 16; ++i) {
            const int c = 32 * wid + 8 * (i >> 2) + 4 * hh + (i & 3);
            const size_t row = (size_t)bg * 256 + c;
            float x1 = out0[i] + bb0, x2 = out1[i] + bb1;
            if (c == 255) { x1 = 0.f; x2 = 0.f; }
            if (kv == 0) {
                const int tokr = (b * S + 16 * c + 31) & (T - 1);
                const float cs = CS64[(size_t)tokr * 64 + r32], sn = CS64[(size_t)tokr * 64 + 32 + r32];
                *(unsigned*)(KC + row * 64 + 2 * r32) = pk2(x1 * cs - x2 * sn, x2 * cs + x1 * sn);
            } else {
                VC[row * 64 + r32] = (bf16)(pk2(x1, 0.f) & 0xffffu); VC[row * 64 + 32 + r32] = (bf16)(pk2(x2, 0.f) & 0xffffu);
            }
        }
    }
};
struct EpiMla {
    static constexpr bool PERM = true, AFTER_DRAIN = false;
    bf16 *QM, *KN, *VM; const bf16 *CQ, *MISC; const float* CS32;
    DI void operator()(const AccT& acc, const Unit& u, int wr, int wc, int fr, int fq) const {
        float rstd[2][4];
#pragma unroll
        for (int ai = 0; ai < 2; ++ai)
#pragma unroll
            for (int m = 0; m < 4; ++m) {
                const int row = u.pm * 256 + ai * 128 + wr * 64 + m * 16 + fr;
                float ss = 0.f;
                if (u.e == 0) {
#pragma unroll
                    for (int c = 0; c < 8; ++c) { const u32x4 w = *(const u32x4*)(CQ + (size_t)row * 256 + fq * 64 + 8 * c);
                        ss += bflo(w.x) * bflo(w.x) + bfhi(w.x) * bfhi(w.x) + bflo(w.y) * bflo(w.y) + bfhi(w.y) * bfhi(w.y) + bflo(w.z) * bflo(w.z) + bfhi(w.z) * bfhi(w.z) + bflo(w.w) * bflo(w.w) + bfhi(w.w) * bfhi(w.w); }
                } else {
#pragma unroll
                    for (int c = 0; c < 4; ++c) { const u32x4 w = *(const u32x4*)(MISC + (size_t)row * 256 + fq * 32 + 8 * c);
                        ss += bflo(w.x) * bflo(w.x) + bfhi(w.x) * bfhi(w.x) + bflo(w.y) * bflo(w.y) + bfhi(w.y) * bfhi(w.y) + bflo(w.z) * bflo(w.z) + bfhi(w.z) * bfhi(w.z) + bflo(w.w) * bflo(w.w) + bfhi(w.w) * bfhi(w.w); }
                }
                ss += __shfl_xor(ss, 16); ss += __shfl_xor(ss, 32);
                rstd[ai][m] = rsqrtf(ss * (u.e == 0 ? (1.0f / 256.0f) : (1.0f / 128.0f)) + EPS);
            }
#pragma unroll
        for (int bj = 0; bj < 2; ++bj) {
            const int gc = u.pn * 256 + bj * 128 + wc * 32;
            bf16* base; int ld, dcol, rope = 0; float sc = 1.f;
            if (u.e == 0) { if (gc >= 384) continue; rope = ((gc >> 5) % 3) == 2; base = QM; ld = 384; dcol = gc; sc = SCL96; }
            else { const int head = gc >> 7, part = (gc & 127) >> 6, o = gc & 63; base = part ? VM : KN; ld = 256; dcol = head * 64 + o; }
#pragma unroll
            for (int ai = 0; ai < 2; ++ai) {
                f32x4 cc[4], sn[4];
                if (rope) {
#pragma unroll
                    for (int m = 0; m < 4; ++m) { const float* cs = CS32 + (size_t)(u.pm * 256 + ai * 128 + wr * 64 + m * 16 + fr) * 32 + 4 * fq; cc[m] = *(const f32x4*)cs; sn[m] = *(const f32x4*)(cs + 16); }
                }
#pragma unroll
                for (int m = 0; m < 4; ++m) {
                    const int row = u.pm * 256 + ai * 128 + wr * 64 + m * 16 + fr;
                    const float r = rstd[ai][m] * sc;
                    f32x4 v0 = acc[ai][bj][m][0] * r, v1 = acc[ai][bj][m][1] * r;
                    if (rope) rot4(v0, v1, cc[m], sn[m]);
                    *(u32x4*)(base + (size_t)row * ld + dcol + 8 * fq) = pack8(v0, v1);
                }
            }
        }
    }
};
struct EpiWout {
    static constexpr bool PERM = true, AFTER_DRAIN = false;
    bf16* X; const float* GT; size_t dofs;
    DI void operator()(const AccT& acc, const Unit& u, int wr, int wc, int fr, int fq) const {
        const int b = (u.pm * 256) >> 12;
        const int col0 = u.pn * 256 + wc * 32 + 8 * fq;
        u32x4 xo[2][2][4]; f32x4 gt[2][2];
#pragma unroll
        for (int bj = 0; bj < 2; ++bj) {
            gt[bj][0] = *(const f32x4*)(GT + (size_t)b * 6144 + col0 + bj * 128); gt[bj][1] = *(const f32x4*)(GT + (size_t)b * 6144 + col0 + bj * 128 + 4);
#pragma unroll
            for (int ai = 0; ai < 2; ++ai)
#pragma unroll
                for (int m = 0; m < 4; ++m) xo[bj][ai][m] = *(const u32x4*)(X + (size_t)(u.pm * 256 + ai * 128 + wr * 64 + m * 16 + fr) * 1024 + col0 + bj * 128);
        }
#pragma unroll
        for (int bj = 0; bj < 2; ++bj)
#pragma unroll
            for (int ai = 0; ai < 2; ++ai)
#pragma unroll
                for (int m = 0; m < 4; ++m) {
                    bf16* p = X + (size_t)(u.pm * 256 + ai * 128 + wr * 64 + m * 16 + fr) * 1024 + col0 + bj * 128;
                    const u32x4 xw = xo[bj][ai][m];
                    const f32x4 x0 = (f32x4){bflo(xw.x), bfhi(xw.x), bflo(xw.y), bfhi(xw.y)} + gt[bj][0] * acc[ai][bj][m][0];
                    const f32x4 x1 = (f32x4){bflo(xw.z), bfhi(xw.z), bflo(xw.w), bfhi(xw.w)} + gt[bj][1] * acc[ai][bj][m][1];
                    u32x4 w; w.x = pk2(x0[0], x0[1]); w.y = pk2(x0[2], x0[3]); w.z = pk2(x1[0], x1[1]); w.w = pk2(x1[2], x1[3]);
                    *(u32x4*)((char*)p + dofs) = w;
                }
    }
};
struct EpiMoe1 {
    static constexpr bool PERM = true, PERM2 = true, AFTER_DRAIN = false; static constexpr int A_E8M0 = H8_E8M0;
    static constexpr bool ACC_BIAS = true;
    bf16* ACT; const float* B1;
    DI void bias(const Unit& u, int wc, int fq, f32x4 (&bv)[2][2]) const {
        const float* bp = B1 + (size_t)u.e * 2048 + u.pn * 256 + wc * 64 + 16 * fq;
#pragma unroll
        for (int bj = 0; bj < 2; ++bj) { bv[bj][0] = *(const f32x4*)(bp + 8 * bj); bv[bj][1] = *(const f32x4*)(bp + 8 * bj + 4); }
    }
    DI void operator()(const AccT& acc, const Unit& u, int wr, int wc, int fr, int fq) const {
        const int col = u.pn * 256 + wc * 64 + 16 * fq;
#pragma unroll
        for (int ai = 0; ai < 2; ++ai)
#pragma unroll
            for (int m = 0; m < 4; ++m) {
                const int row = u.pm * 256 + ai * 128 + wr * 64 + m * 16 + fr;
                float o[8];
#pragma unroll
                for (int bj = 0; bj < 2; ++bj) {
                    const f32x4 v0 = acc[ai][bj][m][0], v1 = acc[ai][bj][m][1];
#pragma unroll
                    for (int j = 0; j < 4; ++j) {
                        const float gl = fminf((j < 2) ? v0[2 * j] : v1[2 * j - 4], 7.0f);
                        const float li = fminf(fmaxf((j < 2) ? v0[2 * j + 1] : v1[2 * j - 3], -7.0f), 7.0f);
                        o[4 * bj + j] = gl * sigmoidf_(1.702f * gl) * (li + 1.0f);
                    }
                }
                u32x2 w8; w8.x = pk4_fp8s(o[0], o[1], o[2], o[3], A8_SCALE); w8.y = pk4_fp8s(o[4], o[5], o[6], o[7], A8_SCALE);
                *(u32x2*)((unsigned char*)ACT + (size_t)row * 1024 + (col >> 1)) = w8;
            }
    }
};
struct EpiMoe2 {
    static constexpr bool PERM = true, PERM2 = true, AFTER_DRAIN = false; static constexpr int A_E8M0 = A8_E8M0;
    static constexpr bool ACC_BIAS = true;
    unsigned char* Y2; const float* B2;
    DI void bias(const Unit& u, int wc, int fq, f32x4 (&bv)[2][2]) const {
        const float* bp = B2 + (size_t)u.e * 1024 + u.pn * 256 + wc * 64 + 16 * fq;
#pragma unroll
        for (int bj = 0; bj < 2; ++bj) { bv[bj][0] = *(const f32x4*)(bp + 8 * bj); bv[bj][1] = *(const f32x4*)(bp + 8 * bj + 4); }
    }
    DI void operator()(const AccT& acc, const Unit& u, int wr, int wc, int fr, int fq) const {
        const int col = u.pn * 256 + wc * 64 + 16 * fq;
#pragma unroll
        for (int ai = 0; ai < 2; ++ai)
#pragma unroll
            for (int m = 0; m < 4; ++m) {
                const size_t row = (size_t)u.pm * 256 + ai * 128 + wr * 64 + m * 16 + fr;
                u32x4 w8;
                { const f32x4 v0 = acc[ai][0][m][0], v1 = acc[ai][0][m][1]; w8.x = pk4_fp8(v0[0], v0[1], v0[2], v0[3]); w8.y = pk4_fp8(v1[0], v1[1], v1[2], v1[3]); }
                { const f32x4 v0 = acc[ai][1][m][0], v1 = acc[ai][1][m][1]; w8.z = pk4_fp8(v0[0], v0[1], v0[2], v0[3]); w8.w = pk4_fp8(v1[0], v1[1], v1[2], v1[3]); }
                *(u32x4*)(Y2 + row * 1024 + col) = w8;
            }
    }
};

#define MFMA32(a, b, c) __builtin_amdgcn_mfma_f32_32x32x16_bf16((a), (b), (c), 0, 0, 0)
typedef short v4i16_t __attribute__((ext_vector_type(4)));
DI s16x4 tr_read(const LAS unsigned char* p) { return __builtin_bit_cast(s16x4, __builtin_amdgcn_ds_read_tr16_b64_v4i16((LAS v4i16_t*)p)); }
constexpr int VST = 144;
template <int DQ> struct AC { static constexpr int KST = DQ * 2 + 16, KS = DQ / 16, KBUF = 64 * KST, VBUF = 64 * VST, BUF = KBUF + VBUF; };

template <int DQ>
DI void qk_tile(const LAS unsigned char* kb, const bf16x8 (&qf)[DQ / 16], f32x16 (&s)[2], const f32x16& cinit, int lane) {
    const int r32 = lane & 31, hh = lane >> 5;
    bf16x8 kf[2][DQ / 16];
#pragma unroll
    for (int rt = 0; rt < 2; ++rt)
#pragma unroll
        for (int ks = 0; ks < DQ / 16; ++ks) kf[rt][ks] = *(const LAS bf16x8*)(kb + (32 * rt + r32) * AC<DQ>::KST + (16 * ks + 8 * hh) * 2);
    f32x16 a0 = MFMA32(kf[0][0], qf[0], cinit), a1 = MFMA32(kf[1][0], qf[0], cinit);
#pragma unroll
    for (int ks = 1; ks < DQ / 16; ++ks) { a0 = MFMA32(kf[0][ks], qf[ks], a0); a1 = MFMA32(kf[1][ks], qf[ks], a1); }
    s[0] = a0; s[1] = a1;
}
DI float max3f_(float a, float b, float c) { return __builtin_fmaxf(__builtin_fmaxf(a, b), c); }
constexpr float RESC_THR = 8.0f;
template <int DQ, int KMUL, int VAR = 0>
DI void attn_tile(const LAS unsigned char* kb, const LAS unsigned char* vb, const bf16x8 (&qf)[DQ / 16], f32x16 (&o)[2], f32x16& negm, float& m, float& l,
                  int dq, unsigned maxd, bool lf, int lane, const bool MASKED) {
    const int hh = lane >> 5;
    if (VAR == 1) return;
    f32x16 s[2];
    qk_tile<DQ>(kb, qf, s, negm, lane);
    if (VAR == 2) { o[0] += s[0]; o[1] += s[1]; return; }
    const int i16 = lane & 15, q = i16 >> 2, p_ = i16 & 3, mh = (lane >> 4) & 1;
    const LAS unsigned char* vbase = vb + (4 * hh + q) * VST + 32 * mh + 8 * p_;
    s16x4 vlo[4][2], vhi[4][2];
#pragma unroll
    for (int st = 0; st < 4; ++st)
#pragma unroll
        for (int mt = 0; mt < 2; ++mt) { vlo[st][mt] = tr_read(vbase + (16 * st) * VST + 64 * mt); vhi[st][mt] = tr_read(vbase + (16 * st + 8) * VST + 64 * mt); }
    __builtin_amdgcn_sched_barrier(0);
    if (MASKED) {
#pragma unroll
        for (int rt = 0; rt < 2; ++rt)
#pragma unroll
            for (int i = 0; i < 16; ++i) {
                const int d = dq - (32 * rt + 8 * (i >> 2) + (i & 3)) * KMUL;
                s[rt][i] = ((unsigned)d <= maxd) ? s[rt][i] : -1e30f;
            }
    }
    float mx = max3f_(s[0][0], s[0][1], s[0][2]);
#pragma unroll
    for (int i = 3; i < 15; i += 2) mx = max3f_(mx, s[0][i], s[0][i + 1]);
    mx = max3f_(mx, s[0][15], s[1][0]);
#pragma unroll
    for (int i = 1; i < 15; i += 2) mx = max3f_(mx, s[1][i], s[1][i + 1]);
    mx = fmaxf(mx, s[1][15]);
    if (__ballot(lf && mx > RESC_THR) != 0ull) {
        float mc = lf ? mx : -1e30f;
        mc = fmaxf(mc, __shfl_xor(mc, 32));
        const float delta = mc > RESC_THR ? mc : 0.f;
        const float alpha = fast_exp2(-delta);
        m += delta; l *= alpha;
#pragma unroll
        for (int i = 0; i < 16; ++i) { negm[i] = -m; o[0][i] *= alpha; o[1][i] *= alpha; s[0][i] -= delta; s[1][i] -= delta; }
    }
    float ps = 0.f;
#pragma unroll
    for (int rt = 0; rt < 2; ++rt)
#pragma unroll
        for (int i = 0; i < 16; ++i) { const float p = fast_exp2(s[rt][i]); s[rt][i] = p; ps += p; }
    const unsigned lmask = lf ? 0xffffffffu : 0u;
    l += lf ? ps : 0.f;
    if (VAR == 3) { o[0] += s[0]; o[1] += s[1]; return; }
#pragma unroll
    for (int rt = 0; rt < 2; ++rt)
#pragma unroll
        for (int s2 = 0; s2 < 2; ++s2) {
            u32x4 pw; pw.x = pk2(s[rt][8 * s2 + 0], s[rt][8 * s2 + 1]) & lmask; pw.y = pk2(s[rt][8 * s2 + 2], s[rt][8 * s2 + 3]) & lmask;
            pw.z = pk2(s[rt][8 * s2 + 4], s[rt][8 * s2 + 5]) & lmask; pw.w = pk2(s[rt][8 * s2 + 6], s[rt][8 * s2 + 7]) & lmask;
            const bf16x8 pb = __builtin_bit_cast(bf16x8, pw);
#pragma unroll
            for (int mt = 0; mt < 2; ++mt) {
                const bf16x8 va = __builtin_shufflevector(vlo[2 * rt + s2][mt], vhi[2 * rt + s2][mt], 0, 1, 2, 3, 4, 5, 6, 7);
                o[mt] = MFMA32(va, pb, o[mt]);
            }
        }
}
constexpr int OSTAGE_WAVE = 32 * 144;
static_assert(102400 + 8 * OSTAGE_WAVE <= MISC_OFF, "O stage below the LDS control words");
struct ChunkId { DI u32x4 operator()(u32x4 v, int, int, int) const { return v; } };
template <class P, class Fx = ChunkId>
DI void store_o_rows(const P& p, LAS unsigned char* lds, int off, const f32x16 (&o)[2], float inv, int lane, int wave, const Fx& fx = Fx()) {
    LAS unsigned char* st = lds + off + wave * OSTAGE_WAVE;
    const int n = lane & 31, hh = lane >> 5;
#pragma unroll
    for (int mt = 0; mt < 2; ++mt)
#pragma unroll
        for (int a = 0; a < 4; ++a) {
            u32x2 w; w.x = pk2(o[mt][4 * a] * inv, o[mt][4 * a + 1] * inv); w.y = pk2(o[mt][4 * a + 2] * inv, o[mt][4 * a + 3] * inv);
            *(LAS u32x2*)(st + n * 144 + (32 * mt + 8 * a + 4 * hh) * 2) = w;
        }
    asm volatile("s_waitcnt lgkmcnt(0)" ::: "memory");
#pragma unroll
    for (int it = 0; it < 4; ++it) {
        const int r = (lane >> 3) + 8 * it, c = lane & 7;
        const u32x4 v = fx(*(const LAS u32x4*)(st + r * 144 + c * 16), wave, r, c);
        *(u32x4*)(p.orow(wave, r) + 8 * c) = v;
    }
}
DI void store_o(bf16* orow, const f32x16 (&o)[2], float inv, int lane) {
    const int hh = lane >> 5;
#pragma unroll
    for (int mt = 0; mt < 2; ++mt)
#pragma unroll
        for (int a = 0; a < 4; ++a) {
            u32x2 w; w.x = pk2(o[mt][4 * a] * inv, o[mt][4 * a + 1] * inv); w.y = pk2(o[mt][4 * a + 2] * inv, o[mt][4 * a + 3] * inv);
            *(u32x2*)(orow + 32 * mt + 8 * a + 4 * hh) = w;
        }
}

struct PolA {
    static constexpr bool HASFLAG = false, LSE = true; static constexpr int KMUL = 1;
    const bf16 *Q, *K, *V; bf16* O; float* LSEP; int b, h, d, r, c; unsigned maxd; int j0, j1;
    DI int ql(int w, int lane) const { return 256 * c + 32 * w + (lane & 31); }
    DI size_t trow(int l_) const { return (size_t)b * S + (size_t)l_ * d + r; }
    DI const bf16* qrow(int w, int lane) const { return Q + trow(ql(w, lane)) * 256 + h * 64; }
    DI int qv(int w, int lane) const { return ql(w, lane); }
    DI int qmin(int w) const { return 256 * c + 32 * w; }
    DI int qmax(int w) const { return 256 * c + 32 * w + 31; }
    DI int kv0(int j) const { return 256 * c - 128 + 64 * j; }
    DI const bf16* krow(int j, int row) const { return K + trow(kv0(j) + row) * 256 + h * 64; }
    DI const bf16* vrow(int j, int row) const { return V + trow(kv0(j) + row) * 256 + h * 64; }
    DI const bf16* rrow(int, int) const { return nullptr; }
    DI bool flag(int, int, int) const { return true; }
    DI bf16* orow(int w, int lane) const { return O + trow(ql(w, lane)) * 256 + h * 64; }
    DI void lse(int w, int lane, float v) const { LSEP[trow(ql(w, lane)) * 4 + h] = v; }
};
struct PolB {
    static constexpr bool LSE = false; static constexpr int KMUL = 1;
    const bf16 *Q, *K, *V; bf16* O; int b, g, qc; unsigned maxd; int j0, j1; u64 sel; bool hasflag;
    const bf16 *GC = nullptr, *GW = nullptr, *GM = nullptr;
    DI int tok(int w, int lane) const { return 64 * qc + 8 * w + ((lane & 31) >> 2); }
    DI const bf16* qrow(int w, int lane) const { return Q + ((size_t)b * S + tok(w, lane)) * 512 + (4 * g + (lane & 3)) * 64; }
    DI int qv(int w, int lane) const { return tok(w, lane); }
    DI int qmin(int w) const { return 64 * qc + 8 * w; }
    DI int qmax(int w) const { return 64 * qc + 8 * w + 7; }
    DI int kv0(int j) const { return 64 * j; }
    DI const bf16* krow(int j, int row) const { return K + ((size_t)b * S + 64 * j + row) * 128 + g * 64; }
    DI const bf16* vrow(int j, int row) const { return V + ((size_t)b * S + 64 * j + row) * 128 + g * 64; }
    DI const bf16* rrow(int, int) const { return nullptr; }
    DI bf16* orow(int w, int lane) const { return O + ((size_t)b * S + tok(w, lane)) * 512 + (4 * g + (lane & 3)) * 64; }
    DI void lse(int, int, float) const {}
};
struct PolM {
    static constexpr bool HASFLAG = false, LSE = false; static constexpr int KMUL = 1;
    const bf16 *Q, *KN, *KR, *V; bf16* O; int b, h, c; unsigned maxd; int j0, j1;
    DI int tok(int w, int lane) const { return 256 * c + 32 * w + (lane & 31); }
    DI const bf16* qrow(int w, int lane) const { return Q + ((size_t)b * S + tok(w, lane)) * 384 + h * 96; }
    DI int qv(int w, int lane) const { return tok(w, lane); }
    DI int qmin(int w) const { return 256 * c + 32 * w; }
    DI int qmax(int w) const { return 256 * c + 32 * w + 31; }
    DI int kv0(int j) const { return 64 * j; }
    DI const bf16* krow(int j, int row) const { return KN + ((size_t)b * S + 64 * j + row) * 256 + h * 64; }
    DI const bf16* vrow(int j, int row) const { return V + ((size_t)b * S + 64 * j + row) * 256 + h * 64; }
    DI const bf16* rrow(int j, int row) const { return KR + ((size_t)b * S + 64 * j + row) * 32; }
    DI bf16* orow(int w, int lane) const { return O + ((size_t)b * S + tok(w, lane)) * 256 + h * 64; }
    DI void lse(int, int, float) const {}
};

template <int DQ, class P, bool FLAG, int VAR = 0>
DI void attn_unit(const P& p, LAS unsigned char* lds, int tid, int lane, int wave, u64 sel) {
    typedef AC<DQ> C;
    const int hh = lane >> 5;
    const bf16* qrow = p.qrow(wave, lane);
    bf16x8 qf[DQ / 16];
#pragma unroll
    for (int ks = 0; ks < DQ / 16; ++ks) qf[ks] = *(const bf16x8*)(qrow + 16 * ks + 8 * hh);
#pragma unroll
    for (int ks = 0; ks < DQ / 16; ++ks) asm volatile("s_waitcnt vmcnt(0)" : "+v"(qf[ks]) :: "memory");
    const int qv = p.qv(wave, lane), wq0 = p.qmin(wave), wq1 = p.qmax(wave);
    f32x16 o[2];
#pragma unroll
    for (int mt = 0; mt < 2; ++mt)
#pragma unroll
        for (int i = 0; i < 16; ++i) o[mt][i] = 0.f;
    float m = 0.f, l = 0.f;
    f32x16 negm;
#pragma unroll
    for (int i = 0; i < 16; ++i) negm[i] = 0.f;
    const int j0 = p.j0, j1 = p.j1;
    const int lrow = tid >> 3, lch = tid & 7;
    u32x4 k0A, v0A, r0A = {0u, 0u, 0u, 0u}, k1A, v1A, r1A = {0u, 0u, 0u, 0u}, k0B, v0B, r0B = {0u, 0u, 0u, 0u}, k1B, v1B, r1B = {0u, 0u, 0u, 0u};
    constexpr int NLD = (DQ == 96) ? 6 : 4;
    const int npair = (j1 - j0 + 1) >> 1;
#define ATT_LOAD1(RK, RV, RR, j) do { const bf16* pk_ = p.krow((j), lrow) + 8 * lch; const bf16* pv_ = p.vrow((j), lrow) + 8 * lch; \
        asm volatile("global_load_dwordx4 %0, %2, off\n\tglobal_load_dwordx4 %1, %3, off" : "=&v"(RK), "=&v"(RV) : "v"(pk_), "v"(pv_) : "memory"); \
        if (DQ == 96) { const bf16* pr_ = p.rrow((j), (tid & 255) >> 2) + 8 * (tid & 3); asm volatile("global_load_dwordx4 %0, %1, off" : "=&v"(RR) : "v"(pr_) : "memory"); } } while (0)
#define ATT_LOADP(K0, V0, R0, K1, V1, R1, t) do { const int ja_ = j0 + 2 * (t), jb_ = ja_ + 1; \
        { const int jc_ = ja_ < j1 ? ja_ : j1 - 1; ATT_LOAD1(K0, V0, R0, jc_); } { const int jd_ = jb_ < j1 ? jb_ : j1 - 1; ATT_LOAD1(K1, V1, R1, jd_); } } while (0)
#define ATT_TILE(kb_, jt_) do { const int j_ = (jt_); const int kv0 = p.kv0(j_); \
        bool need = (j_ < j1) && (wq1 - kv0 >= 0) && ((long long)wq0 - (long long)(kv0 + 63 * P::KMUL) <= (long long)p.maxd); \
        const bool interior = (wq0 - (kv0 + 63 * P::KMUL) >= 0) && ((long long)wq1 - (long long)kv0 <= (long long)p.maxd); \
        bool lf = true; \
        if (FLAG) { lf = ((sel >> j_) & 1ull) != 0ull; need = need && (__ballot(lf) != 0ull); } \
        if (need) attn_tile<DQ, P::KMUL, VAR>((kb_), (kb_) + C::KBUF, qf, o, negm, m, l, qv - kv0 - 4 * hh * P::KMUL, p.maxd, lf, lane, !interior); } while (0)
#define ATT_STEP(K0, V0, R0, K1, V1, R1, tt) do { const int t_ = (tt); \
        LAS unsigned char* pbuf = lds + (t_ & 1) * (2 * C::BUF); \
        asm volatile("s_waitcnt vmcnt(%6)" : "+v"(K0), "+v"(V0), "+v"(R0), "+v"(K1), "+v"(V1), "+v"(R1) : "n"(NLD) : "memory"); \
        *(LAS u32x4*)(pbuf + lrow * C::KST + lch * 16) = K0; *(LAS u32x4*)(pbuf + C::KBUF + lrow * VST + lch * 16) = V0; \
        *(LAS u32x4*)(pbuf + C::BUF + lrow * C::KST + lch * 16) = K1; *(LAS u32x4*)(pbuf + C::BUF + C::KBUF + lrow * VST + lch * 16) = V1; \
        if (DQ == 96) { *(LAS u32x4*)(pbuf + ((tid & 255) >> 2) * C::KST + 128 + (tid & 3) * 16) = R0; *(LAS u32x4*)(pbuf + C::BUF + ((tid & 255) >> 2) * C::KST + 128 + (tid & 3) * 16) = R1; } \
        asm volatile("s_waitcnt lgkmcnt(0)\n\ts_barrier" ::: "memory"); \
        ATT_LOADP(K0, V0, R0, K1, V1, R1, t_ + 2); \
        if (ATT_STAGGER > 0 && wave >= 4) __builtin_amdgcn_s_sleep(ATT_STAGGER); \
        ATT_TILE(pbuf, j0 + 2 * t_); ATT_TILE(pbuf + C::BUF, j0 + 2 * t_ + 1); } while (0)
    ATT_LOADP(k0A, v0A, r0A, k1A, v1A, r1A, 0);
    ATT_LOADP(k0B, v0B, r0B, k1B, v1B, r1B, 1);
    if (wave >= 4) __builtin_amdgcn_s_setprio(1);
#pragma unroll 1
    for (int t = 0; t < npair; t += 2) {
        ATT_STEP(k0A, v0A, r0A, k1A, v1A, r1A, t);
        ATT_STEP(k0B, v0B, r0B, k1B, v1B, r1B, t + 1);
    }
    __builtin_amdgcn_s_setprio(0);
    asm volatile("s_waitcnt vmcnt(0)" : "+v"(k0A), "+v"(v0A), "+v"(r0A), "+v"(k1A), "+v"(v1A), "+v"(r1A), "+v"(k0B), "+v"(v0B), "+v"(r0B), "+v"(k1B), "+v"(v1B), "+v"(r1B) :: "memory");
#undef ATT_LOAD1
#undef ATT_LOADP
#undef ATT_TILE
#undef ATT_STEP
    const float lt = l + __shfl_xor(l, 32);
    const float inv = lt > 0.f ? 1.0f / lt : 0.f;
    if constexpr (FLAG) {
        struct Gate { const P& p;
            DI u32x4 operator()(u32x4 v, int w_, int r, int c) const {
                const size_t tg = (size_t)p.b * S + 64 * p.qc + 8 * w_ + (r >> 2); const int hd = 4 * p.g + (r & 3);
                const bf16* gl = p.GM + tg * 256 + 160 + hd * 3;
                const float g0 = sigmoidf_(bf2f(gl[0])), g1 = sigmoidf_(bf2f(gl[1])), g2 = sigmoidf_(bf2f(gl[2]));
                const u32x4 a = *(const u32x4*)(p.GC + tg * 512 + hd * 64 + 8 * c), d = *(const u32x4*)(p.GW + tg * 512 + hd * 64 + 8 * c);
                u32x4 r_;
                r_.x = pk2(g0 * bflo(a.x) + g1 * bflo(v.x) + g2 * bflo(d.x), g0 * bfhi(a.x) + g1 * bfhi(v.x) + g2 * bfhi(d.x));
                r_.y = pk2(g0 * bflo(a.y) + g1 * bflo(v.y) + g2 * bflo(d.y), g0 * bfhi(a.y) + g1 * bfhi(v.y) + g2 * bfhi(d.y));
                r_.z = pk2(g0 * bflo(a.z) + g1 * bflo(v.z) + g2 * bflo(d.z), g0 * bfhi(a.z) + g1 * bfhi(v.z) + g2 * bfhi(d.z));
                r_.w = pk2(g0 * bflo(a.w) + g1 * bflo(v.w) + g2 * bflo(d.w), g0 * bfhi(a.w) + g1 * bfhi(v.w) + g2 * bfhi(d.w));
                return r_; } } gate{p};
        store_o_rows(p, lds, 90112, o, inv, lane, wave, gate);
    } else store_o_rows(p, lds, DQ == 96 ? 102400 : 90112, o, inv, lane, wave);
    if (P::LSE) { if (hh == 0) p.lse(wave, lane, m + __log2f(lt)); }
    __syncthreads();
}

DI u64 cmp_unit(const Ctx& F, int b, int g, int qc) {
    constexpr int KST = 144;
    LAS unsigned char* KL = F.lds; LAS unsigned char* VL = F.lds + 256 * KST; LAS float* IMP = (LAS float*)(F.lds + 2 * 256 * KST);
    const bf16* KC = (const bf16*)(F.ws + WS_KC) + (size_t)(b * 2 + g) * 256 * 64;
    const bf16* VC = (const bf16*)(F.ws + WS_VC) + (size_t)(b * 2 + g) * 256 * 64;
    const int tid = F.tid, lane = F.lane, w = F.wave, hh = lane >> 5, r32 = lane & 31;
#pragma unroll
    for (int it = 0; it < 4; ++it) { const int idx = tid + 512 * it, row = idx >> 3, ch = idx & 7;
        *(LAS u32x4*)(KL + row * KST + ch * 16) = *(const u32x4*)(KC + row * 64 + ch * 8);
        *(LAS u32x4*)(VL + row * VST + ch * 16) = *(const u32x4*)(VC + row * 64 + ch * 8); }
    __syncthreads();
    const int tokl = 8 * w + (r32 >> 2), tok = 64 * qc + tokl, head = 4 * g + (lane & 3);
    const bf16* qrow = (const bf16*)(F.ws + WS_QB) + ((size_t)b * S + tok) * 512 + head * 64;
    bf16x8 qf[4];
#pragma unroll
    for (int ks = 0; ks < 4; ++ks) qf[ks] = *(const bf16x8*)(qrow + 16 * ks + 8 * hh);
    const int qv = tok - 31, wq1 = 64 * qc + 8 * w + 7 - 31;
    f32x16 o[2];
#pragma unroll
    for (int mt = 0; mt < 2; ++mt)
#pragma unroll
        for (int i = 0; i < 16; ++i) o[mt][i] = 0.f;
    float m = 0.f, l = 0.f;
    f32x16 negm;
#pragma unroll
    for (int i = 0; i < 16; ++i) negm[i] = 0.f;
    const int wq0 = 64 * qc + 8 * w - 31;
#pragma unroll 1
    for (int jt = 0; jt < 4; ++jt) {
        if (wq1 - 1024 * jt >= 0) {
            const int dq = qv - 1024 * jt - 4 * hh * 16;
            attn_tile<64, 16>(KL + jt * 64 * KST, VL + jt * 64 * VST, qf, o, negm, m, l, dq, 0x7fffffffu, true, lane, !(wq0 - (1024 * jt + 63 * 16) >= 0));
        }
    }
    const float lt = l + __shfl_xor(l, 32);
    const float inv = lt > 0.f ? 1.0f / lt : 0.f;
    { struct { bf16* O; int b, g, qc; DI bf16* orow(int w_, int n_) const { return O + ((size_t)b * S + 64 * qc + 8 * w_ + (n_ >> 2)) * 512 + (4 * g + (n_ & 3)) * 64; } } pc{(bf16*)(F.ws + WS_OCMP), b, g, qc};
      store_o_rows(pc, F.lds, 90112, o, inv, lane, w); }
    float prev = 0.f;
#pragma unroll 1
    for (int jt = 0; jt < 4; ++jt) {
        const bool need = (wq1 - 1024 * jt >= 0);
        f32x16 s[2];
        if (need) qk_tile<64>(KL + jt * 64 * KST, qf, s, negm, lane);
#pragma unroll
        for (int rt = 0; rt < 2; ++rt)
#pragma unroll
            for (int a = 0; a < 4; ++a) {
                float mainp = 0.f, sp = 0.f;
                if (need) {
                    float pb[4];
#pragma unroll
                    for (int bb = 0; bb < 4; ++bb) { const int kidx = 64 * jt + 32 * rt + 8 * a + 4 * hh + bb; const bool ok = (qv - 16 * kidx) >= 0; pb[bb] = ok ? fast_exp2(s[rt][4 * a + bb]) * inv : 0.f; }
                    mainp = pb[0] + pb[1] + pb[2] + 0.5f * pb[3]; sp = 0.5f * pb[3];
                }
                const float rc = __shfl_xor(sp, 32);
                float v = mainp + (hh ? rc : prev);
                prev = rc;
                v += __shfl_xor(v, 1); v += __shfl_xor(v, 2);
                if ((lane & 3) == 0) IMP[tokl * 64 + 2 * (8 * jt + 4 * rt + a) + hh] = v;
            }
    }
    __syncthreads();
    u64 mysel = 0ull;
#pragma unroll 1
    for (int tk = 0; tk < 8; ++tk) {
        const int tl = 8 * w + tk, t = 64 * qc + tl, j = lane;
        const float v = IMP[tl * 64 + j];
        const bool forced = (j == 0) || (j == qc) || (j == qc - 1);
        const bool valid = j <= qc;
        const float score = forced ? v + 1e4f : (valid ? v : -1.0f);
        int rank = 0;
#pragma unroll
        for (int jp = 0; jp < 64; ++jp) { const float o_ = __builtin_bit_cast(float, __builtin_amdgcn_readlane(__builtin_bit_cast(int, score), jp)); rank += ((o_ > score) || (o_ == score && jp < j)) ? 1 : 0; }
        const u64 mask = __ballot(rank < 16);
        (void)t;
        if (tk == (r32 >> 2)) mysel = mask;
    }
    __syncthreads();
    return mysel;
}

DI void moe_tables(const Ctx& F, int l) {
    LAS int* tb = (LAS int*)(F.lds + AUX_OFF); LAS int* cn = tb + 64;
    if (F.tid == 0) {
        const unsigned* C = (const unsigned*)(F.ws + WS_CTL) + CW_CNT + l * 32 * 64;
        int acc = 0;
        for (int e = 0; e < 32; ++e) { const int c = (int)__hip_atomic_load(C + e * 64, RLX_AGENT); tb[e] = acc; cn[e] = c; acc += (c + 255) >> 8; }
        tb[32] = acc;
    }
    __syncthreads();
}
template <int MODE>
DI void phase_norm1(const Ctx& F, int l) {
    const float* mods = (const float*)(F.ws + WS_MODS);
    const bf16* X = (const bf16*)(F.ws + WS_X); bf16* H = (bf16*)(F.ws + F.dofs + WS_H); bf16* XW = (bf16*)(F.ws + F.dofs + WS_X);
    const LAS int* tb = (const LAS int*)(F.lds + AUX_OFF);
    if (l > 0) moe_tables(F, l - 1);
    const int gw = F.blk * 8 + F.wave, NGW = F.G * 8, lane = F.lane;
    for (int tok = gw; tok < T; tok += NGW) {
        const int b = tok >> 12;
        f32x4 v[4];
        if (l == 0) { const float* xr = ginp(F, I_X) + (size_t)tok * 1024;
#pragma unroll
            for (int k = 0; k < 4; ++k) v[k] = *(const f32x4*)(xr + 4 * lane + 256 * k);
        } else { const bf16* xr = X + (size_t)tok * 1024;
#pragma unroll
            for (int k = 0; k < 4; ++k) { const u32x2 w = *(const u32x2*)(xr + 4 * lane + 256 * k); v[k] = (f32x4){bflo(w.x), bfhi(w.x), bflo(w.y), bfhi(w.y)}; }
        }
        if (l > 0) {
            f32x4 y[4];
#pragma unroll
            for (int k = 0; k < 4; ++k) y[k] = (f32x4){0.f, 0.f, 0.f, 0.f};
            const int* ts = (const int*)(F.ws + WS_TOKSLOT) + (size_t)tok * 4;
            const f32x4 tg = *(const f32x4*)((const float*)(F.ws + WS_TOKG) + (size_t)tok * 4) * Y2_ISCALE;
#pragma unroll
            for (int s = 0; s < 4; ++s) {
                const int pk = ts[s]; const int e = pk >> 16, pos = pk & 0xffff;
                const unsigned char* yr = (const unsigned char*)(F.ws + WS_Y2) + ((size_t)tb[e] * 256 + pos) * 1024;
#pragma unroll
                for (int k = 0; k < 4; ++k) { const unsigned w = *(const unsigned*)(yr + 4 * lane + 256 * k); y[k] += unpk4_fp8(w) * tg[s]; }
            }
            const float* gt2 = mods + ((size_t)((l - 1) * 8 + b) * 6 + 5) * 1024;
#pragma unroll
            for (int k = 0; k < 4; ++k) v[k] = v[k] + *(const f32x4*)(gt2 + 4 * lane + 256 * k) * y[k];
        }
        float ss = 0.f;
#pragma unroll
        for (int k = 0; k < 4; ++k) ss += v[k][0] * v[k][0] + v[k][1] * v[k][1] + v[k][2] * v[k][2] + v[k][3] * v[k][3];
        const float rstd = rsqrtf(wave_sum(ss) * (1.0f / 1024.0f) + EPS);
        if (MODE == 0) {
            const float* g1 = ginp(F, I_G1) + (size_t)l * 1024;
            const float* sh = mods + ((size_t)(l * 8 + b) * 6 + 0) * 1024; const float* sc = sh + 1024;
#pragma unroll
            for (int k = 0; k < 4; ++k) {
                const int c = 4 * lane + 256 * k;
                { u32x2 xw; xw.x = pk2(v[k][0], v[k][1]); xw.y = pk2(v[k][2], v[k][3]); *(u32x2*)(XW + (size_t)tok * 1024 + c) = xw; }
                const f32x4 hv = v[k] * rstd * *(const f32x4*)(g1 + c) * (*(const f32x4*)(sc + c) + 1.0f) + *(const f32x4*)(sh + c);
                u32x2 w; w.x = pk2(hv[0], hv[1]); w.y = pk2(hv[2], hv[3]);
                *(u32x2*)(H + (size_t)tok * 1024 + c) = w;
            }
        } else {
            const float* gf = ginp(F, I_GF);
#pragma unroll
            for (int k = 0; k < 4; ++k) { const int c = 4 * lane + 256 * k; *(f32x4*)(gout(F) + (size_t)tok * 1024 + c) = v[k] * rstd * *(const f32x4*)(gf + c); }
        }
    }
}
DI void phase_prep(const Ctx& F) {
    const bf16* CQ = (const bf16*)(F.ws + WS_CQ); const bf16* MISC = (const bf16*)(F.ws + WS_MISC);
    float* RQ = (float*)(F.ws + WS_RSTDQ); float* RKV = (float*)(F.ws + WS_RSTDKV);
    bf16* KR = (bf16*)(F.ws + WS_KR); float* GATES = (float*)(F.ws + WS_GATES); const float* CS32 = (const float*)(F.ws + WS_CS32);
    const int gw = F.blk * 8 + F.wave, NGW = F.G * 8, lane = F.lane;
    for (int tok = gw; tok < T; tok += NGW) {
        const u32x2 wq = *(const u32x2*)(CQ + (size_t)tok * 256 + 4 * lane);
        const u32x2 wm = *(const u32x2*)(MISC + (size_t)tok * 256 + 4 * lane);
        float a0 = bflo(wq.x), a1 = bfhi(wq.x), a2 = bflo(wq.y), a3 = bfhi(wq.y);
        const float sq = wave_sum(a0 * a0 + a1 * a1 + a2 * a2 + a3 * a3);
        float m0 = bflo(wm.x), m1 = bfhi(wm.x), m2 = bflo(wm.y), m3 = bfhi(wm.y);
        const float skv = wave_sum(lane < 32 ? (m0 * m0 + m1 * m1 + m2 * m2 + m3 * m3) : 0.f);
        if (lane == 0) { RQ[tok] = rsqrtf(sq * (1.0f / 256.0f) + EPS); RKV[tok] = rsqrtf(skv * (1.0f / 128.0f) + EPS); }
        const float p0 = __shfl_xor(m0, 4), p1 = __shfl_xor(m1, 4), p2 = __shfl_xor(m2, 4), p3 = __shfl_xor(m3, 4);
        if (lane >= 32 && lane < 36) {
            const int i0 = 4 * (lane - 32);
            const f32x4 c4 = *(const f32x4*)(CS32 + (size_t)tok * 32 + i0), s4 = *(const f32x4*)(CS32 + (size_t)tok * 32 + 16 + i0);
            u32x4 w;
            w.x = pk2(m0 * c4[0] - p0 * s4[0], p0 * c4[0] + m0 * s4[0]); w.y = pk2(m1 * c4[1] - p1 * s4[1], p1 * c4[1] + m1 * s4[1]);
            w.z = pk2(m2 * c4[2] - p2 * s4[2], p2 * c4[2] + m2 * s4[2]); w.w = pk2(m3 * c4[3] - p3 * s4[3], p3 * c4[3] + m3 * s4[3]);
            *(u32x4*)(KR + (size_t)tok * 32 + 2 * i0) = w;
        }
        if (lane >= 40 && lane < 46) {
            const int gi = 4 * (lane - 40);
            *(f32x4*)(GATES + (size_t)tok * 24 + gi) = (f32x4){sigmoidf_(m0), sigmoidf_(m1), sigmoidf_(m2), sigmoidf_(m3)};
        }
    }
}
DI void phase_cmp2(const Ctx& F, int l) {
    const bf16* HID = (const bf16*)(F.ws + WS_HID);
    const float* CS64 = (const float*)(F.ws + WS_CS64);
    const int gw = F.blk * 8 + F.wave, NGW = F.G * 8, lane = F.lane;
    for (int it = gw; it < 8192; it += NGW) {
        const int kv = it >> 12, row = it & 4095, c = row & 255, bg = row >> 8;
        const float* w2 = ginp(F, kv ? I_W2V : I_W2K) + (size_t)l * 256 * 64;
        const float* b2 = ginp(F, kv ? I_B2V : I_B2K) + (size_t)l * 64;
        const u32x2 hw = *(const u32x2*)(HID + ((size_t)kv * 4096 + row) * 256 + 4 * lane);
        const float h0 = bflo(hw.x), h1 = bfhi(hw.x), h2 = bflo(hw.y), h3 = bfhi(hw.y);
        float acc = b2[lane];
#pragma unroll 4
        for (int k4 = 0; k4 < 64; ++k4) {
            const float x0 = __builtin_bit_cast(float, __builtin_amdgcn_readlane(__builtin_bit_cast(int, h0), k4));
            const float x1 = __builtin_bit_cast(float, __builtin_amdgcn_readlane(__builtin_bit_cast(int, h1), k4));
            const float x2 = __builtin_bit_cast(float, __builtin_amdgcn_readlane(__builtin_bit_cast(int, h2), k4));
            const float x3 = __builtin_bit_cast(float, __builtin_amdgcn_readlane(__builtin_bit_cast(int, h3), k4));
            acc += x0 * w2[(4 * k4 + 0) * 64 + lane] + x1 * w2[(4 * k4 + 1) * 64 + lane] + x2 * w2[(4 * k4 + 2) * 64 + lane] + x3 * w2[(4 * k4 + 3) * 64 + lane];
        }
        if (c == 255) acc = 0.f;
        if (kv == 0) {
            const int b = bg >> 1, tokr = b * S + 16 * c + 31;
            const float other = __shfl_xor(acc, 32);
            const int i = lane & 31;
            const float cs = CS64[(size_t)(tokr & (T - 1)) * 64 + i], sn = CS64[(size_t)(tokr & (T - 1)) * 64 + 32 + i];
            const float y = (lane < 32) ? (acc * cs - other * sn) : (acc * cs + other * sn);
            ((bf16*)(F.ws + WS_KC))[(size_t)row * 64 + 2 * i + (lane >> 5)] = (bf16)(pk2(y, 0.f) & 0xffffu);
        } else {
            ((bf16*)(F.ws + WS_VC))[(size_t)row * 64 + lane] = (bf16)(pk2(acc, 0.f) & 0xffffu);
        }
    }
}
DI void phase_mix(const Ctx& F, int l) {
    const bf16* OA3 = (const bf16*)(F.ws + WS_OA3); const float* LSEA = (const float*)(F.ws + WS_LSEA);
    const bf16* OCMP = (const bf16*)(F.ws + WS_OCMP); const bf16* OSLC = (const bf16*)(F.ws + WS_OSLC); const bf16* OWIN = (const bf16*)(F.ws + WS_OWIN);
    const bf16* OC = (const bf16*)(F.ws + WS_OC); const bf16* MISC = (const bf16*)(F.ws + WS_MISC);
    bf16* AMIX = (bf16*)(F.ws + WS_AMIX);
    const float* ga = ginp(F, I_GOA) + (size_t)l * 256; const float* gb = ginp(F, I_GOB) + (size_t)l * 512; const float* gc = ginp(F, I_GOC) + (size_t)l * 256;
    const int gw = F.blk * 8 + F.wave, NGW = F.G * 8, lane = F.lane, ha = lane >> 4;
    for (int tok0 = gw; tok0 < T; tok0 += 2 * NGW) {
        int tok[2]; tok[0] = tok0; tok[1] = (tok0 + NGW < T) ? tok0 + NGW : tok0;
        float ls[2][3]; u32x2 wa[2][3], wb[2][2], wc_[2];
#pragma unroll
        for (int q = 0; q < 2; ++q) {
#pragma unroll
            for (int p = 0; p < 3; ++p) { ls[q][p] = LSEA[((size_t)p * T + tok[q]) * 4 + ha]; wa[q][p] = *(const u32x2*)(OA3 + ((size_t)p * T + tok[q]) * 256 + 4 * lane); }
#pragma unroll
            for (int k = 0; k < 2; ++k) {
                const int col = 256 * k + 4 * lane;
                wb[q][k] = *(const u32x2*)(OSLC + (size_t)tok[q] * 512 + col);
            }
            wc_[q] = *(const u32x2*)(OC + (size_t)tok[q] * 256 + 4 * lane);
        }
        f32x4 va[2], vb[2][2], vc[2]; float red[2][3];
#pragma unroll
        for (int q = 0; q < 2; ++q) {
            const float mx = fmaxf(ls[q][0], fmaxf(ls[q][1], ls[q][2]));
            const float w0 = fast_exp2(ls[q][0] - mx), w1 = fast_exp2(ls[q][1] - mx), w2 = fast_exp2(ls[q][2] - mx), wi = 1.0f / (w0 + w1 + w2);
            va[q] = ((f32x4){bflo(wa[q][0].x), bfhi(wa[q][0].x), bflo(wa[q][0].y), bfhi(wa[q][0].y)} * w0 + (f32x4){bflo(wa[q][1].x), bfhi(wa[q][1].x), bflo(wa[q][1].y), bfhi(wa[q][1].y)} * w1
                   + (f32x4){bflo(wa[q][2].x), bfhi(wa[q][2].x), bflo(wa[q][2].y), bfhi(wa[q][2].y)} * w2) * wi;
            red[q][0] = va[q][0] * va[q][0] + va[q][1] * va[q][1] + va[q][2] * va[q][2] + va[q][3] * va[q][3];
            float sb = 0.f;
#pragma unroll
            for (int k = 0; k < 2; ++k) {
                const u32x2 a = wb[q][k];
                vb[q][k][0] = bflo(a.x); vb[q][k][1] = bfhi(a.x); vb[q][k][2] = bflo(a.y); vb[q][k][3] = bfhi(a.y);
                sb += vb[q][k][0] * vb[q][k][0] + vb[q][k][1] * vb[q][k][1] + vb[q][k][2] * vb[q][k][2] + vb[q][k][3] * vb[q][k][3];
            }
            red[q][1] = sb;
            vc[q] = (f32x4){bflo(wc_[q].x), bfhi(wc_[q].x), bflo(wc_[q].y), bfhi(wc_[q].y)};
            red[q][2] = vc[q][0] * vc[q][0] + vc[q][1] * vc[q][1] + vc[q][2] * vc[q][2] + vc[q][3] * vc[q][3];
        }
#pragma unroll
        for (int q = 0; q < 2; ++q)
#pragma unroll
            for (int j = 0; j < 3; ++j) red[q][j] = wave_sum(red[q][j]);
#pragma unroll
        for (int q = 0; q < 2; ++q) {
            if (q == 1 && tok0 + NGW >= T) break;
            const float ra = rsqrtf(red[q][0] * (1.0f / 256.0f) + EPS), rb = rsqrtf(red[q][1] * (1.0f / 512.0f) + EPS), rc = rsqrtf(red[q][2] * (1.0f / 256.0f) + EPS);
            bf16* orow = AMIX + (size_t)tok[q] * 1024;
            { const f32x4 o = va[q] * ra * *(const f32x4*)(ga + 4 * lane); u32x2 w; w.x = pk2(o[0], o[1]); w.y = pk2(o[2], o[3]); *(u32x2*)(orow + 4 * lane) = w; }
#pragma unroll
            for (int k = 0; k < 2; ++k) { const f32x4 o = vb[q][k] * rb * *(const f32x4*)(gb + 256 * k + 4 * lane); u32x2 w; w.x = pk2(o[0], o[1]); w.y = pk2(o[2], o[3]); *(u32x2*)(orow + 256 + 256 * k + 4 * lane) = w; }
            { const f32x4 o = vc[q] * rc * *(const f32x4*)(gc + 4 * lane); u32x2 w; w.x = pk2(o[0], o[1]); w.y = pk2(o[2], o[3]); *(u32x2*)(orow + 768 + 4 * lane) = w; }
        }
    }
}
DI void phase_router(const Ctx& F, int l) {
    LAS unsigned char* WH = F.lds; LAS unsigned char* WL = F.lds + 65536;
    LAS float* biasp = (LAS float*)(F.lds + AUX_OFF); LAS float* RS = biasp + 32;
    LAS int* lcnt = (LAS int*)(F.lds + AUX_OFF + 1024); LAS int* gbase = lcnt + 32;
    LAS int* tokE = gbase + 32; LAS float* tokG = (LAS float*)(tokE + 512); LAS int* tokP = (LAS int*)(tokG + 512);
    const float* wr = ginp(F, I_WR) + (size_t)l * 1024 * 32; const float* br = ginp(F, I_BR) + (size_t)l * 32;
    const float* mods = (const float*)(F.ws + WS_MODS); const bf16* X = (const bf16*)(F.ws + WS_X); bf16* H = (bf16*)(F.ws + F.dofs + WS_H);
    const float* g2 = ginp(F, I_G2) + (size_t)l * 1024;
    const int tid = F.tid, lane = F.lane, w = F.wave;
    if (tid < 32) lcnt[tid] = 0;
    unsigned* CNT = (unsigned*)(F.ws + WS_CTL) + CW_CNT + (l + F.dcnt) * 32 * 64;
    for (int chunk = F.blk; chunk < T / 128; chunk += F.G) {
        const int b = (chunk * 128) >> 12;
        const float* sh = mods + ((size_t)(l * 8 + b) * 6 + 3) * 1024; const float* sc = sh + 1024;
        {
            float bacc = 0.f; const int e = tid & 31;
#pragma unroll 4
            for (int it = 0; it < 32; ++it) {
                const int k = 2 * ((tid + 512 * it) >> 5);
                const float w0 = wr[k * 32 + e], w1 = wr[(k + 1) * 32 + e];
                const float p0 = w0 * (g2[k] * (sc[k] + 1.0f)), p1 = w1 * (g2[k + 1] * (sc[k + 1] + 1.0f));
                bacc += sh[k] * w0 + sh[k + 1] * w1;
                const unsigned hi = pk2(p0, p1);
                const unsigned lo = pk2(p0 - bflo(hi), p1 - bfhi(hi));
                const int off = e * 2048 + ((((k >> 3) ^ e) << 4) | ((k & 7) * 2));
                *(LAS unsigned*)(WH + off) = hi; *(LAS unsigned*)(WL + off) = lo;
            }
            tokG[tid] = bacc;
        }
        __syncthreads();
        if (tid < 32) { float s_ = br[tid];
#pragma unroll
            for (int j = 0; j < 16; ++j) s_ += tokG[tid + 32 * j];
            biasp[tid] = s_; }
        {
            u32x2 ra[4], rb[4];
            f32x4 ggv[4], hhv[4];
#pragma unroll
            for (int k = 0; k < 4; ++k) { const int c = 4 * lane + 256 * k; ggv[k] = *(const f32x4*)(g2 + c) * (*(const f32x4*)(sc + c) + 1.0f); hhv[k] = *(const f32x4*)(sh + c); }
            { const bf16* x0 = X + (size_t)(chunk * 128 + w * 16) * 1024 + 4 * lane;
#pragma unroll
              for (int k = 0; k < 4; ++k) { ra[k] = *(const u32x2*)(x0 + 256 * k); rb[k] = *(const u32x2*)(x0 + 1024 + 256 * k); } }
#pragma unroll 1
            for (int tt = 0; tt < 8; ++tt) {
                const int tl0 = w * 16 + 2 * tt, tok0 = chunk * 128 + tl0;
                f32x4 v[2][4]; float ss0 = 0.f, ss1 = 0.f;
#pragma unroll
                for (int k = 0; k < 4; ++k) { v[0][k] = (f32x4){bflo(ra[k].x), bfhi(ra[k].x), bflo(ra[k].y), bfhi(ra[k].y)}; v[1][k] = (f32x4){bflo(rb[k].x), bfhi(rb[k].x), bflo(rb[k].y), bfhi(rb[k].y)}; }
                { const int tn = (tt < 7) ? tok0 + 2 : tok0; const bf16* x0 = X + (size_t)tn * 1024 + 4 * lane;
#pragma unroll
                  for (int k = 0; k < 4; ++k) { ra[k] = *(const u32x2*)(x0 + 256 * k); rb[k] = *(const u32x2*)(x0 + 1024 + 256 * k); } }
#pragma unroll
                for (int k = 0; k < 4; ++k) { ss0 += v[0][k][0] * v[0][k][0] + v[0][k][1] * v[0][k][1] + v[0][k][2] * v[0][k][2] + v[0][k][3] * v[0][k][3];
                                              ss1 += v[1][k][0] * v[1][k][0] + v[1][k][1] * v[1][k][1] + v[1][k][2] * v[1][k][2] + v[1][k][3] * v[1][k][3]; }
                ss0 = wave_sum(ss0); ss1 = wave_sum(ss1);
                const float rs0 = rsqrtf(ss0 * (1.0f / 1024.0f) + EPS), rs1 = rsqrtf(ss1 * (1.0f / 1024.0f) + EPS);
                if (lane == 0) { RS[tl0] = rs0; RS[tl0 + 1] = rs1; }
#pragma unroll
                for (int k = 0; k < 4; ++k) {
                    const int c = 4 * lane + 256 * k;
                    v[0][k] = v[0][k] * rs0 * ggv[k] + hhv[k]; v[1][k] = v[1][k] * rs1 * ggv[k] + hhv[k];
                    *(unsigned*)((unsigned char*)H + (size_t)tok0 * 1024 + c) = pk4_fp8s(v[0][k][0], v[0][k][1], v[0][k][2], v[0][k][3], H8_SCALE);
                    *(unsigned*)((unsigned char*)H + (size_t)(tok0 + 1) * 1024 + c) = pk4_fp8s(v[1][k][0], v[1][k][1], v[1][k][2], v[1][k][3], H8_SCALE);
                }
            }
        }
        __syncthreads();
        f32x4 acc[2] = {{0.f, 0.f, 0.f, 0.f}, {0.f, 0.f, 0.f, 0.f}};
        {
            const int kg = lane >> 4, n16 = lane & 15;
            const bf16* xr = X + (size_t)(chunk * 128 + w * 16 + n16) * 1024 + 8 * kg;
#pragma unroll 1
            for (int k8 = 0; k8 < 4; ++k8) {
                bf16x8 af[8];
#pragma unroll
                for (int j = 0; j < 8; ++j) af[j] = *(const bf16x8*)(xr + 32 * (8 * k8 + j));
#pragma unroll
                for (int j = 0; j < 8; ++j) {
                    const int c = 4 * (8 * k8 + j) + kg;
#pragma unroll
                    for (int et = 0; et < 2; ++et) {
                        const int e = 16 * et + n16, off = e * 2048 + ((c ^ e) << 4);
                        const bf16x8 bh = *(const LAS bf16x8*)(WH + off), bl = *(const LAS bf16x8*)(WL + off);
                        acc[et] = __builtin_amdgcn_mfma_f32_16x16x32_bf16(af[j], bh, acc[et], 0, 0, 0);
                        acc[et] = __builtin_amdgcn_mfma_f32_16x16x32_bf16(af[j], bl, acc[et], 0, 0, 0);
                    }
                }
            }
        }
        __syncthreads();
        LAS float* LG = (LAS float*)(F.lds + w * 2048);
        {
            const int g4 = lane >> 4, n16 = lane & 15;
#pragma unroll
            for (int et = 0; et < 2; ++et)
#pragma unroll
                for (int i = 0; i < 4; ++i) LG[(4 * g4 + i) * 32 + 16 * et + n16] = acc[et][i] * RS[w * 16 + 4 * g4 + i] + biasp[16 * et + n16];
        }
        asm volatile("s_waitcnt lgkmcnt(0)" ::: "memory");
#pragma unroll 1
        for (int tt = 0; tt < 8; ++tt) {
            const int tl0 = w * 16 + 2 * tt;
            const float lg0 = LG[(2 * tt) * 32 + (lane >> 1)], lg1 = LG[(2 * tt + 1) * 32 + (lane >> 1)];
            int rk0 = 0, rk1 = 0; const int me = lane >> 1;
#pragma unroll
            for (int e = 0; e < 32; ++e) {
                const float o0 = __builtin_bit_cast(float, __builtin_amdgcn_readlane(__builtin_bit_cast(int, lg0), 2 * e));
                const float o1 = __builtin_bit_cast(float, __builtin_amdgcn_readlane(__builtin_bit_cast(int, lg1), 2 * e));
                rk0 += ((o0 > lg0) || (o0 == lg0 && e < me)) ? 1 : 0; rk1 += ((o1 > lg1) || (o1 == lg1 && e < me)) ? 1 : 0;
            }
#pragma unroll
            for (int tk = 0; tk < 2; ++tk) {
                const int rk = tk ? rk1 : rk0; const float lg = tk ? lg1 : lg0;
                int te[4]; float tv[4];
#pragma unroll
                for (int r = 0; r < 4; ++r) {
                    const u64 mk = __ballot(rk == r && (lane & 1) == 0);
                    const int sl = __builtin_amdgcn_readfirstlane((int)__builtin_ctzll(mk));
                    te[r] = sl >> 1; tv[r] = __builtin_bit_cast(float, __builtin_amdgcn_readlane(__builtin_bit_cast(int, lg), sl));
                }
                const float e1 = __expf(tv[1] - tv[0]), e2 = __expf(tv[2] - tv[0]), e3 = __expf(tv[3] - tv[0]);
                const float isum = 1.0f / (1.0f + e1 + e2 + e3);
                if (lane < 4) {
                    const int tl = tl0 + tk;
                    const int e = lane == 0 ? te[0] : lane == 1 ? te[1] : lane == 2 ? te[2] : te[3];
                    const float gte = (lane == 0 ? 1.0f : lane == 1 ? e1 : lane == 2 ? e2 : e3) * isum;
                    const int pos = atomicAdd((int*)(lcnt + e), 1);
                    tokE[tl * 4 + lane] = e; tokG[tl * 4 + lane] = gte; tokP[tl * 4 + lane] = pos;
                }
            }
        }
        __syncthreads();
        if (tid < 32) gbase[tid] = (int)__hip_atomic_fetch_add(CNT + tid * 64, (unsigned)lcnt[tid], RLX_AGENT);
        __syncthreads();
        {
            const int tl = tid >> 2, r = tid & 3, e = tokE[tid], pos = gbase[e] + tokP[tid], tok = chunk * 128 + tl;
            ((int*)(F.ws + F.dofs + WS_IDX))[(size_t)e * ECAP + pos] = tok;
            ((float*)(F.ws + F.dofs + WS_TOKG))[(size_t)tok * 4 + r] = tokG[tid];
            ((int*)(F.ws + F.dofs + WS_TOKSLOT))[(size_t)tok * 4 + r] = (e << 16) | pos;
        }
        __syncthreads();
        if (tid < 32) lcnt[tid] = 0;
        __syncthreads();
    }
}

DI int ropeperm64(int p) { return (p >> 1) + 32 * (p & 1); }
DI int cmap_win(int n) {
    const int tile = n >> 8, w = n & 255, hb = w & ~63, pp = ropeperm64(w & 63);
    switch (tile) {
        case 0: return hb + pp;
        case 1: return 256 + hb + pp;
        case 2: return 512 + w;
        case 3: return 768 + hb + pp;
        case 4: return 1024 + hb + pp;
        case 5: return w < 128 ? 1280 + w : 1408 + (w - 128);
        case 6: return w < 128 ? 1536 + hb + pp : 1664 + (w - 128);
        case 7: return w < 128 ? 1792 + hb + pp : 1920 + (w - 128);
        case 8: return 2072 + w;
        default: return w < 128 ? 2328 + w : (w < 160 ? 2456 + ((w - 128) >> 1) + 16 * ((w - 128) & 1) : (w < 184 ? 2048 + (w - 160) : -1));
    }
}
DI int cmap_qup(int n) { if (n >= 384) return -1; const int h = n / 96, w = n % 96; if (w < 64) return h * 96 + w; const int j = w - 64; return h * 96 + 64 + (j >> 1) + 16 * (j & 1); }
DI void tr_tile(const float* src, int K, int Nsrc, bf16* dst, int Kdst, int maptype, const float* ksc, int ntile, int ktile, LAS float* scr, int tid) {
    const int n0 = ntile * 64, k0 = ktile * 128, nl = tid & 63, n = n0 + nl;
    const int c = maptype == 0 ? (n < Nsrc ? n : -1) : (maptype == 1 ? cmap_win(n) : cmap_qup(n));
    float v[16];
#pragma unroll
    for (int it = 0; it < 16; ++it) { const int k = k0 + (tid >> 6) + 8 * it; v[it] = (c >= 0 && k < K) ? src[(size_t)k * Nsrc + c] * (ksc ? ksc[k] : 1.0f) : 0.f; }
#pragma unroll
    for (int it = 0; it < 16; ++it) scr[((tid >> 6) + 8 * it) * 65 + nl] = v[it];
    __syncthreads();
#pragma unroll
    for (int it = 0; it < 2; ++it) {
        const int idx = tid + 512 * it, nn = idx >> 4, ch = idx & 15;
        const LAS float* s = scr + (8 * ch) * 65 + nn;
        u32x4 o; o.x = pk2(s[0], s[65]); o.y = pk2(s[2 * 65], s[3 * 65]); o.z = pk2(s[4 * 65], s[5 * 65]); o.w = pk2(s[6 * 65], s[7 * 65]);
        *(u32x4*)(dst + (size_t)(n0 + nn) * Kdst + k0 + 8 * ch) = o;
    }
    __syncthreads();
}
DI void trb_load(f32x4 (&v)[16], const float* src, int N, int n0, int k0, int tid) {
#pragma unroll
    for (int it = 0; it < 16; ++it) v[it] = *(const f32x4*)(src + (size_t)(k0 + (tid >> 6) + 8 * it) * N + n0 + 4 * (tid & 63));
}
DI void trb_store(const f32x4 (&v)[16], bf16* dst, int Kd, int n0, int k0, LAS unsigned char* L, int tid, int wave, int lane, int f8 = 0) {
#pragma unroll
    for (int it = 0; it < 16; ++it) { f32x4 x = v[it];
        if (f8) { x[0] = q8s(x[0], W8_SCALE); x[1] = q8s(x[1], W8_SCALE); x[2] = q8s(x[2], W8_SCALE); x[3] = q8s(x[3], W8_SCALE); }
        u32x2 w; w.x = pk2(x[0], x[1]); w.y = pk2(x[2], x[3]); *(LAS u32x2*)(L + ((tid >> 6) + 8 * it) * 576 + (tid & 63) * 8) = w; }
    asm volatile("s_waitcnt lgkmcnt(0)\n\ts_barrier" ::: "memory");
    const int i = lane & 15, gn = (lane >> 4) & 1, h = lane >> 5, q = i >> 2, p = i & 3;
    const LAS unsigned char* base = L + (8 * h + q) * 576 + (32 * wave + 16 * gn) * 2 + 8 * p;
    if (!f8) {
        bf16* drow = dst + (size_t)(n0 + 32 * wave + 16 * gn + i) * Kd + k0 + 8 * h;
#pragma unroll
        for (int kcp = 0; kcp < 8; ++kcp) {
            const s16x4 lo = tr_read(base + (16 * kcp) * 576), hi = tr_read(base + (16 * kcp + 4) * 576);
            *(bf16x8*)(drow + 16 * kcp) = __builtin_shufflevector(lo, hi, 0, 1, 2, 3, 4, 5, 6, 7);
        }
    } else {
        unsigned char* drow = (unsigned char*)dst + (size_t)(n0 + 32 * wave + 16 * gn + i) * Kd + k0 + 8 * h;
#pragma unroll
        for (int kcp = 0; kcp < 8; ++kcp) {
            const s16x4 lo = tr_read(base + (16 * kcp) * 576), hi = tr_read(base + (16 * kcp + 4) * 576);
            int w0 = __builtin_amdgcn_cvt_pk_fp8_f32(bf2f((unsigned short)lo[0]), bf2f((unsigned short)lo[1]), 0, false); w0 = __builtin_amdgcn_cvt_pk_fp8_f32(bf2f((unsigned short)lo[2]), bf2f((unsigned short)lo[3]), w0, true);
            int w1 = __builtin_amdgcn_cvt_pk_fp8_f32(bf2f((unsigned short)hi[0]), bf2f((unsigned short)hi[1]), 0, false); w1 = __builtin_amdgcn_cvt_pk_fp8_f32(bf2f((unsigned short)hi[2]), bf2f((unsigned short)hi[3]), w1, true);
            u32x2 o; o.x = (unsigned)w0; o.y = (unsigned)w1;
            *(u32x2*)(drow + 16 * kcp) = o;
        }
    }
    asm volatile("s_waitcnt lgkmcnt(0)\n\ts_barrier" ::: "memory");
}
struct TrbItem { const float* src; bf16* dst; int N, n0, k0, f8; };
DI TrbItem trb_item(const Ctx& F, int it) {
    const int le = it / 96, r = it % 96; TrbItem t;
    if (r < 64) { t.src = ginp(F, I_WE1) + (size_t)le * 1024 * 2048; t.dst = (bf16*)(F.ws + WS_W1E + (size_t)le * 2048 * 1024); t.N = 2048; t.n0 = (r & 7) * 256; t.k0 = (r >> 3) * 128; t.f8 = 1; }
    else { const int q = r - 64; t.src = ginp(F, I_WE2) + (size_t)le * 1024 * 1024; t.dst = (bf16*)(F.ws + WS_W2E + (size_t)le * 1024 * 1024); t.N = 1024; t.n0 = (q & 3) * 256; t.k0 = (q >> 2) * 128; t.f8 = 1; }
    return t;
}
DI void conv_layer_tiles(const Ctx& F, int l, int q0, int i0, int cnt) {
    const int NL = 32 * 96;
    int it = q0 + F.blk + F.G * i0; const int end = q0 + F.blk + F.G * (i0 + cnt);
    if (it >= NL) return;
    f32x4 va[16];
    TrbItem ta = trb_item(F, l * NL + it);
    trb_load(va, ta.src, ta.N, ta.n0, ta.k0, F.tid);
#pragma unroll 1
    while (it < NL && it < end) {
        f32x4 vb[16];
#pragma unroll
        for (int k = 0; k < 16; ++k) vb[k] = va[k];
        const TrbItem tc = ta;
        it += F.G;
        const bool more = (it < NL && it < end);
        ta = trb_item(F, l * NL + (more ? it : 0));
        if (more) trb_load(va, ta.src, ta.N, ta.n0, ta.k0, F.tid);
        trb_store(vb, tc.dst, 1024, tc.n0, tc.k0, F.lds, F.tid, F.wave, F.lane, tc.f8);
    }
}
DI void conv_claim_tiles(const Ctx& F, int l, int quota) {
    const int NL = 32 * 96;
    volatile LAS unsigned* slot = (volatile LAS unsigned*)(F.lds + MISC_OFF) + 16;
    __syncthreads();
    if (F.tid == 0) { unsigned* q = (unsigned*)(F.ws + WS_CTL) + CW_CONVQ + l * 64; slot[0] = __hip_atomic_fetch_add(q, (unsigned)quota, __ATOMIC_RELAXED, __HIP_MEMORY_SCOPE_AGENT); }
    __syncthreads();
    int it = __builtin_amdgcn_readfirstlane((int)slot[0]); const int end = it + quota;
    if (it >= NL) return;
    f32x4 va[16];
    TrbItem ta = trb_item(F, l * NL + it);
    trb_load(va, ta.src, ta.N, ta.n0, ta.k0, F.tid);
#pragma unroll 1
    while (it < NL && it < end) {
        f32x4 vb[16];
#pragma unroll
        for (int k = 0; k < 16; ++k) vb[k] = va[k];
        const TrbItem tc = ta;
        it += 1;
        const bool more = (it < NL && it < end);
        ta = trb_item(F, l * NL + (more ? it : 0));
        if (more) trb_load(va, ta.src, ta.N, ta.n0, ta.k0, F.tid);
        trb_store(vb, tc.dst, 1024, tc.n0, tc.k0, F.lds, F.tid, F.wave, F.lane, tc.f8);
    }
}
DI void phase_prologue(const Ctx& F) {
    const Args& A = *F.a; const int tid = F.tid;
    LAS float* scr = (LAS float*)F.lds;
    if (!CONV_IN_LAYER) {
        const int NIT = DEPTH * 32 * 96;
        f32x4 va[16];
        int it = F.blk;
        TrbItem ta = trb_item(F, it < NIT ? it : 0);
        if (it < NIT) trb_load(va, ta.src, ta.N, ta.n0, ta.k0, tid);
#pragma unroll 1
        while (it < NIT) {
            f32x4 vb[16];
#pragma unroll
            for (int k = 0; k < 16; ++k) vb[k] = va[k];
            const TrbItem tc = ta;
            it += F.G;
            ta = trb_item(F, it < NIT ? it : 0);
            if (it < NIT) trb_load(va, ta.src, ta.N, ta.n0, ta.k0, tid);
            trb_store(vb, tc.dst, 1024, tc.n0, tc.k0, F.lds, tid, F.wave, F.lane, tc.f8);
        }
    }
    constexpr int PER_L = 8192 + 4096 + 320 + 128 + 128 + 16 + 16;
    for (int it = F.blk; it < DEPTH * PER_L; it += F.G) {
        const int l = it / PER_L; int r = it % PER_L;
        if (r < 8192 + 4096) continue;
        if (r < 8192) { const int e = r >> 8, t = r & 255;
            tr_tile(ginp(F, I_WE1) + ((size_t)(l * 32 + e)) * 1024 * 2048, 1024, 2048, (bf16*)(F.ws + WS_W1E) + ((size_t)(l * 32 + e)) * 2048 * 1024, 1024, 0, nullptr, t >> 3, t & 7, scr, tid); continue; }
        r -= 8192;
        if (r < 4096) { const int e = r >> 7, t = r & 127;
            tr_tile(ginp(F, I_WE2) + ((size_t)(l * 32 + e)) * 1024 * 1024, 1024, 1024, (bf16*)(F.ws + WS_W2E) + ((size_t)(l * 32 + e)) * 1024 * 1024, 1024, 0, nullptr, t >> 3, t & 7, scr, tid); continue; }
        r -= 4096;
        if (r < 320) { tr_tile(ginp(F, I_WIN) + (size_t)l * 1024 * 2488, 1024, 2488, (bf16*)(F.ws + WS_WIN) + (size_t)l * NIN * 1024, 1024, 1, nullptr, r >> 3, r & 7, scr, tid); continue; }
        r -= 320;
        if (r < 128) { tr_tile(ginp(F, I_WOUT) + (size_t)l * 1024 * 1024, 1024, 1024, (bf16*)(F.ws + WS_WOUT) + (size_t)l * 1024 * 1024, 1024, 0, nullptr, r >> 3, r & 7, scr, tid); continue; }
        r -= 128;
        if (r < 128) { const int kv = r >> 6, t = r & 63;
            tr_tile(ginp(F, kv ? I_W1V : I_W1K) + (size_t)l * 2048 * 256, 2048, 256, (bf16*)(F.ws + WS_NSAW1) + ((size_t)(l * 2 + kv)) * 256 * 2048, 2048, 0, nullptr, t >> 4, t & 15, scr, tid); continue; }
        r -= 128;
        if (r < 16) { tr_tile(ginp(F, I_WQUP) + (size_t)l * 256 * 384, 256, 384, (bf16*)(F.ws + WS_MLAQ) + (size_t)l * 512 * 256, 256, 2, ginp(F, I_GQ) + (size_t)l * 256, r >> 1, r & 1, scr, tid); continue; }
        r -= 16;
        tr_tile(ginp(F, I_WKVUP) + (size_t)l * 128 * 512, 128, 512, (bf16*)(F.ws + WS_MLAKV) + (size_t)l * 512 * 256, 256, 0, ginp(F, I_GKV) + (size_t)l * 128, r >> 1, r & 1, scr, tid);
    }
    for (int it = F.blk; it < DEPTH * 4; it += F.G) {
        const int l = it >> 2, kv = (it >> 1) & 1, kt = it & 1;
        tr_tile(ginp(F, kv ? I_W2V : I_W2K) + (size_t)l * 256 * 64, 256, 64, (bf16*)(F.ws + WS_W2T) + ((size_t)(l * 2 + kv)) * 64 * 256, 256, 0, nullptr, 0, kt, scr, tid);
    }
    {
        float* CS64 = (float*)(F.ws + WS_CS64); float* CS32 = (float*)(F.ws + WS_CS32);
        const int* pos = (const int*)ginp(F, I_POS);
        for (int idx = F.blk * 512 + tid; idx < T * 48; idx += F.G * 512) {
            const int tok = idx / 48, i = idx % 48;
            const double p = (double)pos[tok];
            const double inv = (i < 32) ? exp2(-(double)i * (13.287712379549449 / 32.0)) : exp2(-(double)(i - 32) * (13.287712379549449 / 16.0));
            double ang = p * inv;
            const double kk = __builtin_rint(ang * 0.15915494309189535);
            ang = ang - kk * 6.283185307179586;
            const float af = (float)ang;
            const float cs = __cosf(af), sn = __sinf(af);
            if (i < 32) { CS64[(size_t)tok * 64 + i] = cs; CS64[(size_t)tok * 64 + 32 + i] = sn; }
            else { CS32[(size_t)tok * 32 + (i - 32)] = cs; CS32[(size_t)tok * 32 + 16 + (i - 32)] = sn; }
        }
    }
    for (int item = F.blk; item < 32; item += F.G) {
        const int lk = item >> 2, l = lk >> 1, kv = lk & 1, col = (item & 3) * 64 + F.lane;
        const float* w1 = ginp(F, kv ? I_W1V : I_W1K) + (size_t)l * 2048 * 256 + col; const float* pe = ginp(F, kv ? I_POSV : I_POSK) + (size_t)l * 2048;
        float s = 0.f;
#pragma unroll 1
        for (int kb = 256 * F.wave; kb < 256 * F.wave + 256; kb += 16) {
            float wv[16];
#pragma unroll
            for (int j = 0; j < 16; ++j) wv[j] = w1[(size_t)(kb + j) * 256];
#pragma unroll
            for (int j = 0; j < 16; ++j) s += pe[kb + j] * wv[j];
        }
        scr[F.wave * 64 + F.lane] = s;
        __syncthreads();
        if (tid < 64) { float t = ginp(F, kv ? I_B1V : I_B1K)[(size_t)l * 256 + col];
#pragma unroll
            for (int ww = 0; ww < 8; ++ww) t += scr[ww * 64 + tid];
            ((float*)(F.ws + WS_B1P))[(size_t)lk * 256 + col] = t; }
        __syncthreads();
    }
    {
        LAS float* sc = scr; LAS float* red = scr + 8192;
        for (int i = tid; i < 8192; i += 512) { const float c = ginp(F, I_C)[i]; sc[i] = c * sigmoidf_(c); }
        __syncthreads();
        float* MODS = (float*)(F.ws + WS_MODS);
        const int lane = F.lane, w = F.wave;
        for (int item = F.blk; item < 384; item += F.G) {
            const int l = item / 96, col = (item % 96) * 64 + lane;
            float acc[8];
#pragma unroll
            for (int b = 0; b < 8; ++b) acc[b] = 0.f;
            const float* wa = ginp(F, I_WADA) + (size_t)l * 1024 * 6144 + col;
#pragma unroll 1
            for (int kb = 128 * w; kb < 128 * w + 128; kb += 16) {
                float wv[16];
#pragma unroll
                for (int j = 0; j < 16; ++j) wv[j] = wa[(size_t)(kb + j) * 6144];
#pragma unroll
                for (int j = 0; j < 16; ++j) {
#pragma unroll
                    for (int b = 0; b < 8; ++b) acc[b] += sc[b * 1024 + kb + j] * wv[j]; }
            }
#pragma unroll
            for (int b = 0; b < 8; ++b) red[(w * 8 + b) * 64 + lane] = acc[b];
            __syncthreads();
            { const int b = tid >> 6; float s = ginp(F, I_BADA)[(size_t)l * 6144 + col];
#pragma unroll
              for (int ww = 0; ww < 8; ++ww) s += red[(ww * 8 + b) * 64 + lane];
              MODS[((size_t)(l * 8 + b)) * 6144 + col] = s; }
            __syncthreads();
        }
    }
}

constexpr int PH_PER_LAYER = 11;
constexpr int N_PHASES = 1 + DEPTH * PH_PER_LAYER + 1;

__global__ void __launch_bounds__(512, 2) fwd_kernel(Args args) {
    extern __shared__ __attribute__((aligned(16))) unsigned char lds_raw[];
    Ctx F;
    F.lds = (LAS unsigned char*)lds_raw; F.a = &args; F.ws = args.ws;
    F.dofs = 0; F.dcnt = 0;
    F.tid = threadIdx.x; F.lane = F.tid & 63; F.wave = __builtin_amdgcn_readfirstlane(F.tid >> 6); F.blk = blockIdx.x; F.G = gridDim.x; F.vcu = F.blk;
    volatile LAS unsigned* MISC = (volatile LAS unsigned*)(F.lds + MISC_OFF);
    for (int u = F.tid; u < (LDS_BYTES - MISC_OFF) / 4; u += 512) MISC[u] = 0u;
    __syncthreads();
    unsigned* ctl = (unsigned*)(F.ws + WS_CTL);
    XcdBarrier bar; bar.bar = ctl + CW_BAR; bar.x = 0; bar.st = nullptr;
    if (!MK_PER_PHASE) bar = xcd_barrier_post(ctl + CW_BAR, MISC + 8);
    const int lo = args.ph_lo, hi = args.ph_hi;
#define IN(k) (lo <= (k) && (k) < hi)
#define SEAM(k) do { if (IN(k) && IN((k) + 1)) xcd_barrier(bar); } while (0)
    unsigned char* ws = F.ws;
#define PHASE_BEGIN() do { int t_ = threadIdx.x; asm volatile("" : "+v"(t_)); F.tid = t_; F.lane = t_ & 63; F.wave = __builtin_amdgcn_readfirstlane(t_ >> 6); \
        GAS unsigned char* w_ = (GAS unsigned char*)args.ws; asm volatile("" : "+s"(w_)); F.ws = (unsigned char*)w_; ws = (unsigned char*)w_; int b_ = blockIdx.x; asm volatile("" : "+s"(b_)); F.blk = b_; F.vcu = (F.G % 8 == 0) ? (b_ % 8) * (F.G / 8) + b_ / 8 : b_; } while (0)

    if (PHON(0) && IN(0)) _Pragma("unroll 1") for (int rep_ = 0; rep_ < NREP(0); ++rep_) { PHASE_BEGIN(); phase_prologue(F); }
    SEAM(0);
#pragma unroll 1
    for (int l = 0; l < DEPTH; ++l) {
        const int P = 1 + l * PH_PER_LAYER;
        if (PHON(1) && IN(P + 0)) _Pragma("unroll 1") for (int rep_ = 0; rep_ < (DUM(1) ? 2 : 1); ++rep_) { PHASE_BEGIN(); F.dofs = (DUM(1) && rep_ == 0) ? WS_END : 0; phase_norm1<0>(F, l); }
        SEAM(P + 0);
        if (PHON(2) && IN(P + 1)) _Pragma("unroll 1") for (int rep_ = 0; rep_ < NREP(2); ++rep_) { PHASE_BEGIN();
            SchedGrid Sg{(const char*)(ws + WS_H), (const char*)(ws + WS_WIN) + (size_t)l * NIN * 1024 * 2, 1024, 1024, NIN / 256, (T / 256) * (NIN / 256), F.G, F.vcu};
            EpiWin E{ws, (const float*)(ws + WS_CS64), (const float*)(ws + WS_CS32)};
            pg8::gemm_phase<EpiWin, SchedGrid, false>(F.lds, 1024, 1024, Sg, E);
        }
        SEAM(P + 1);
        if (PHON(3) && IN(P + 2)) _Pragma("unroll 1") for (int rep_ = 0; rep_ < NREP(3); ++rep_) { PHASE_BEGIN();
            if (PHON(13)) {
                SchedCmp Sc{(const char*)(ws + WS_KCMP), (const char*)(ws + WS_VCMP), (const char*)(ws + WS_NSAW1) + (size_t)l * 2 * 256 * 2048 * 2, F.G, F.blk};
                EpiCmp E{(const float*)(ws + WS_B1P) + (size_t)l * 512, (const bf16*)(ws + WS_W2T) + (size_t)l * 2 * 64 * 256, ginp(F, I_B2K) + (size_t)l * 64, ginp(F, I_B2V) + (size_t)l * 64,
                         (bf16*)(ws + WS_KC), (bf16*)(ws + WS_VC), (const float*)(ws + WS_CS64)};
                pg8::gemm_phase<EpiCmp, SchedCmp, false>(F.lds, 1024, 2048, Sc, E);
            }
            PHASE_BEGIN();
            if (PHON(18)) {
                SchedMla Sm{(const char*)(ws + WS_CQ), (const char*)(ws + WS_MISC), (const char*)(ws + WS_MLAQ) + (size_t)l * 512 * 256 * 2, (const char*)(ws + WS_MLAKV) + (size_t)l * 512 * 256 * 2, F.G, F.vcu};
                EpiMla E{(bf16*)(ws + WS_QM), (bf16*)(ws + WS_KN), (bf16*)(ws + WS_VM), (const bf16*)(ws + WS_CQ), (const bf16*)(ws + WS_MISC), (const float*)(ws + WS_CS32)};
                pg8::gemm_phase<EpiMla, SchedMla, false>(F.lds, 256, 256, Sm, E);
            }
            PHASE_BEGIN();
            if (PHON(15)) {
                unsigned* qw = (unsigned*)(ws + WS_CTL) + CW_QUEUE + (l * 2 + rep_) * 64;
                volatile LAS int* qslot = (volatile LAS int*)(F.lds + AUX_OFF + 512);
                int nxt_t = 0;
                if (F.tid == 0) nxt_t = (int)__hip_atomic_fetch_add(qw, 1u, RLX_AGENT);
                for (;;) {
                    if (F.tid == 0) { qslot[0] = nxt_t; nxt_t = (int)__hip_atomic_fetch_add(qw, 1u, RLX_AGENT); }
                    __syncthreads();
                    const int uq = qslot[0];
                    __syncthreads();
                    if (uq >= 2560) break;
                    if (uq < 1024) {
                        const int u = uq;
                        PolB pb; pb.Q = (const bf16*)(ws + WS_QB); pb.K = (const bf16*)(ws + WS_KWIN); pb.V = (const bf16*)(ws + WS_VWIN); pb.O = (bf16*)(ws + WS_OWIN);
                        pb.b = u >> 7; pb.g = (u >> 6) & 1; pb.qc = 63 - (u & 63); pb.maxd = 511u; pb.j0 = pb.qc > 8 ? pb.qc - 8 : 0; pb.j1 = pb.qc + 1;
                        attn_unit<64, PolB, false>(pb, F.lds, F.tid, F.lane, F.wave, 0ull);
                    } else {
                        const int uu = uq - 1024;
                        const int bh = uu / 48, w48 = uu % 48, p = w48 >> 4, s16 = w48 & 15;
                        PolA pa; pa.Q = (const bf16*)(ws + WS_QA); pa.K = (const bf16*)(ws + WS_KA); pa.V = (const bf16*)(ws + WS_VA);
                        pa.O = (bf16*)(ws + WS_OA3) + (size_t)p * T * 256; pa.LSEP = (float*)(ws + WS_LSEA) + (size_t)p * T * 4;
                        pa.b = bh >> 2; pa.h = bh & 3; pa.d = p == 0 ? 1 : (p == 1 ? 4 : 16);
                        const int cpr = p == 0 ? 16 : (p == 1 ? 4 : 1);
                        pa.r = s16 / cpr; pa.c = s16 % cpr; pa.maxd = 128u; pa.j0 = pa.c == 0 ? 2 : 0; pa.j1 = 6;
                        attn_unit<64, PolA, false>(pa, F.lds, F.tid, F.lane, F.wave, 0ull);
                    }
                }
            }
        }
        SEAM(P + 2);
        if (PHON(5) && IN(P + 4)) _Pragma("unroll 1") for (int rep_ = 0; rep_ < NREP(5); ++rep_) { PHASE_BEGIN();
            int cti = 0;
            int cq0 = 0;
            if (CONV_IN_LAYER) { const unsigned t_ = __hip_atomic_load((unsigned*)(ws + WS_CTL) + CW_CONVQ + l * 64, __ATOMIC_RELAXED, __HIP_MEMORY_SCOPE_AGENT); cq0 = __builtin_amdgcn_readfirstlane((int)(t_ < 3072u ? t_ : 3072u)); }
            if (PHON(19)) for (int u = F.vcu; u < 1024; u += F.G) {
                const int bg = (u % 256) >> 4, k = u & 15, rnd = u >> 8;
                const int qc = rnd == 0 ? 2 * k : (rnd == 1 ? 2 * k + 1 : (rnd == 2 ? 63 - 2 * k : 62 - 2 * k));
                const u64 sel = cmp_unit(F, bg >> 1, bg & 1, qc);
                PolB pb; pb.Q = (const bf16*)(ws + WS_QB); pb.K = (const bf16*)(ws + WS_KSLC); pb.V = (const bf16*)(ws + WS_VSLC); pb.O = (bf16*)(ws + WS_OSLC);
                pb.b = bg >> 1; pb.g = bg & 1; pb.qc = qc; pb.maxd = 0x7fffffffu; pb.j0 = 0; pb.j1 = qc + 1;
                pb.GC = (const bf16*)(ws + WS_OCMP); pb.GW = (const bf16*)(ws + WS_OWIN); pb.GM = (const bf16*)(ws + WS_MISC);
                attn_unit<64, PolB, true>(pb, F.lds, F.tid, F.lane, F.wave, sel);
                if (CONV_IN_LAYER && rep_ == 0) { PHASE_BEGIN(); conv_layer_tiles(F, l, cq0, cti, 2); cti += 2; }
            }
            PHASE_BEGIN();
            if (PHON(20)) for (int v = F.vcu; v < 512; v += F.G) {
                const int bh = (v & 255) >> 3, k = v & 7, c = (v < 256) ? k : 15 - k;
                PolM pm; pm.Q = (const bf16*)(ws + WS_QM); pm.KN = (const bf16*)(ws + WS_KN); pm.KR = (const bf16*)(ws + WS_KR); pm.V = (const bf16*)(ws + WS_VM); pm.O = (bf16*)(ws + WS_OC);
                pm.b = bh >> 2; pm.h = bh & 3; pm.c = c; pm.maxd = 0x7fffffffu; pm.j0 = 0; pm.j1 = 4 * c + 4;
                attn_unit<96, PolM, false>(pm, F.lds, F.tid, F.lane, F.wave, 0ull);
                if (CONV_IN_LAYER && rep_ == 0) { PHASE_BEGIN(); conv_layer_tiles(F, l, cq0, cti, 2); cti += 2; }
            }
            if (CONV_IN_LAYER && rep_ == 0) { PHASE_BEGIN(); conv_layer_tiles(F, l, cq0, cti, 1 << 20); }
        }
        SEAM(P + 4);
        if (PHON(7) && IN(P + 6)) _Pragma("unroll 1") for (int rep_ = 0; rep_ < NREP(7); ++rep_) { PHASE_BEGIN(); phase_mix(F, l); }
        SEAM(P + 6);
        if (PHON(8) && IN(P + 7)) _Pragma("unroll 1") for (int rep_ = 0; rep_ < (DUM(8) ? 2 : 1); ++rep_) { PHASE_BEGIN(); F.dofs = (DUM(8) && rep_ == 0) ? WS_END : 0;
            SchedGrid Sg{(const char*)(ws + WS_AMIX), (const char*)(ws + WS_WOUT) + (size_t)l * 1024 * 1024 * 2, 1024, 1024, 4, (T / 256) * 4, F.G, F.vcu};
            EpiWout E{(bf16*)(ws + WS_X), (const float*)(ws + WS_MODS) + ((size_t)(l * 8) * 6 + 2) * 1024, F.dofs};
            pg8::gemm_phase<EpiWout, SchedGrid, false>(F.lds, 1024, 1024, Sg, E);
        }
        SEAM(P + 7);
        if (PHON(9) && IN(P + 8)) _Pragma("unroll 1") for (int rep_ = 0; rep_ < (DUM(9) ? 2 : 1); ++rep_) { PHASE_BEGIN(); F.dofs = (DUM(9) && rep_ == 0) ? WS_END : 0; F.dcnt = (DUM(9) && rep_ == 0) ? 4 : 0; phase_router(F, l); }
        SEAM(P + 8);
        if (PHON(10) && IN(P + 9)) _Pragma("unroll 1") for (int rep_ = 0; rep_ < NREP(10); ++rep_) { PHASE_BEGIN();
            moe_tables(F, l);
            const LAS int* tb = (const LAS int*)(F.lds + AUX_OFF);
            SchedMoe1F8 Sm{tb, tb + 64, (const char*)(ws + WS_H), (const char*)(ws + WS_W1E) + (size_t)l * 32 * 2048 * 1024, (const int*)(ws + WS_IDX), tb[32] * 8, F.G, F.vcu};
            EpiMoe1 E{(bf16*)(ws + WS_ACT), ginp(F, I_BE1) + (size_t)l * 32 * 2048};
            pg8::gemm_phase<EpiMoe1, SchedMoe1F8, true, true>(F.lds, 512, 512, Sm, E);
            if (CONV_IN_LAYER && CONV_TAIL1 > 0 && rep_ == 0 && l + 1 < DEPTH) {
                const int nun = tb[32] * 8, rounds = (nun + F.G - 1) / F.G, mine = F.vcu < nun ? (nun - 1 - F.vcu) / F.G + 1 : 0;
                if (mine < rounds) { PHASE_BEGIN(); conv_claim_tiles(F, l + 1, CONV_TAIL1); }
            }
        }
        SEAM(P + 9);
        if (PHON(11) && IN(P + 10)) _Pragma("unroll 1") for (int rep_ = 0; rep_ < NREP(11); ++rep_) { PHASE_BEGIN();
            moe_tables(F, l);
            const LAS int* tb = (const LAS int*)(F.lds + AUX_OFF);
            SchedMoe2F8 Sm{tb, (const char*)(ws + WS_ACT), (const char*)(ws + WS_W2E) + (size_t)l * 32 * 1024 * 1024, tb[32] * 4, F.G, F.vcu};
            EpiMoe2 E{(unsigned char*)(ws + WS_Y2), ginp(F, I_BE2) + (size_t)l * 32 * 1024};
            pg8::gemm_phase<EpiMoe2, SchedMoe2F8, false, true>(F.lds, 512, 512, Sm, E);
            if (CONV_IN_LAYER && CONV_TAIL2 > 0 && rep_ == 0 && l + 1 < DEPTH) {
                const int nun = tb[32] * 4, rounds = (nun + F.G - 1) / F.G, mine = F.vcu < nun ? (nun - 1 - F.vcu) / F.G + 1 : 0;
                if (mine < rounds) { PHASE_BEGIN(); conv_claim_tiles(F, l + 1, CONV_TAIL2); }
            }
        }
        SEAM(P + 10);
    }
    if (PHON(12) && IN(N_PHASES - 1)) { PHASE_BEGIN(); phase_norm1<1>(F, DEPTH); }
#undef IN
#undef SEAM
}

extern "C" void kernel_launch(void* const* d_in, const int* in_sizes, int n_in, void* d_out, int out_size, void* d_ws, size_t ws_size, hipStream_t stream) {
    static int grid = 0;
    if (grid == 0) {
        if (n_in != 33 || out_size != T * D || ws_size < WS_END * (DUM_MASK ? 2 : 1)) { fprintf(stderr, "kernel_launch: unexpected problem (n_in %d out %d ws %zu)\n", n_in, out_size, ws_size); grid = -1; return; }
        int dev = 0, cus = 0, per_cu = 0;
        if (hipGetDevice(&dev) != hipSuccess || hipDeviceGetAttribute(&cus, hipDeviceAttributeMultiprocessorCount, dev) != hipSuccess) { grid = -1; return; }
        if (hipFuncSetAttribute((const void*)fwd_kernel, hipFuncAttributeMaxDynamicSharedMemorySize, LDS_BYTES) != hipSuccess) { fprintf(stderr, "kernel_launch: hipFuncSetAttribute failed\n"); grid = -1; return; }
        if (hipOccupancyMaxActiveBlocksPerMultiprocessor(&per_cu, (const void*)fwd_kernel, 512, LDS_BYTES) != hipSuccess || per_cu < 1) { fprintf(stderr, "kernel_launch: occupancy query says %d\n", per_cu); per_cu = 1; }
        (void)hipGetLastError();
        grid = cus;
    }
    if (grid < 0) return;
    if (hipMemsetAsync((char*)d_ws + WS_CTL, 0, CTL_ZERO_BYTES, stream) != hipSuccess) return;
    Args a{};
    for (int i = 0; i < 33; ++i) a.in[i] = (const float*)d_in[i];
    a.out = (float*)d_out; a.ws = (unsigned char*)d_ws;
#if MK_PER_PHASE
    for (int p = 0; p < N_PHASES; ++p) { a.ph_lo = p; a.ph_hi = p + 1; hipLaunchKernelGGL(fwd_kernel, dim3(grid), dim3(512), LDS_BYTES, stream, a); }
#else
    a.ph_lo = 0; a.ph_hi = N_PHASES;
    hipLaunchKernelGGL(fwd_kernel, dim3(grid), dim3(512), LDS_BYTES, stream, a);
#endif
}
```

```cpp
#include <hip/hip_runtime.h>
#include <cstdio>
#include <cstdint>

#ifndef MK_PER_PHASE
#define MK_PER_PHASE 0
#endif

#ifndef PH_MASK
#define PH_MASK 0xFFFFFFFFu
#endif
#define PHON(k) ((PH_MASK >> (k)) & 1u)
#ifndef DBL_MASK
#define DBL_MASK 0u
#endif
#define NREP(k) (((DBL_MASK >> (k)) & 1u) ? 2 : 1)
#ifndef DUM_MASK
#define DUM_MASK 0u
#endif
#define DUM(k) ((DUM_MASK >> (k)) & 1u)
#ifndef ATT_VAR
#define ATT_VAR 0
#endif
#ifndef CONV_IN_LAYER
#define CONV_IN_LAYER 1
#endif
#ifndef CONV_TAIL1
#define CONV_TAIL1 3
#endif
#ifndef CONV_TAIL2
#define CONV_TAIL2 4
#endif
#ifndef ATT_STAGGER
#define ATT_STAGGER 0
#endif
#define DI __device__ __forceinline__
#define LAS __attribute__((address_space(3)))
#define GAS __attribute__((address_space(1)))
typedef unsigned short bf16;
typedef short bf16x8 __attribute__((ext_vector_type(8)));
typedef short s16x4 __attribute__((ext_vector_type(4)));
typedef float f32x2 __attribute__((ext_vector_type(2)));
typedef float f32x4 __attribute__((ext_vector_type(4)));
typedef float f32x16 __attribute__((ext_vector_type(16)));
typedef unsigned u32x2 __attribute__((ext_vector_type(2)));
typedef unsigned u32x4 __attribute__((ext_vector_type(4)));
typedef __bf16 bf16x2_t __attribute__((ext_vector_type(2)));
typedef unsigned long long u64;

constexpr int NB = 8, S = 4096, T = NB * S, D = 1024, DEPTH = 4;
constexpr int NIN = 2560;
constexpr int NE = 32, DFF = 1024;
constexpr int SP = S + 64;
constexpr int ECAP = 32768;
constexpr int ACT_ROWS = 4 * T + NE * 256;
constexpr float LOG2E = 1.4426950408889634f;
constexpr float SCL64 = 0.125f * LOG2E;
constexpr float SCL96 = 0.10206207261596577f * LOG2E;
constexpr float EPS = 1e-6f;

constexpr size_t MiB = 1u << 20;
constexpr size_t WS_CTL = 0, CTL_ZERO_BYTES = 2 * MiB;
constexpr size_t WS_MODS = 2 * MiB, WS_B1P = 3 * MiB, WS_CS64 = 4 * MiB, WS_CS32 = 12 * MiB;
constexpr size_t WS_WIN = 16 * MiB, WS_WOUT = 36 * MiB, WS_NSAW1 = 44 * MiB, WS_MLAQ = 52 * MiB, WS_MLAKV = 53 * MiB;
constexpr size_t WS_W1E = 64 * MiB, WS_W2E = 576 * MiB;
constexpr size_t WS_X = 832 * MiB, WS_H = 960 * MiB;
constexpr size_t WS_QA = 1024 * MiB, WS_KA = 1040 * MiB, WS_VA = 1056 * MiB, WS_QB = 1072 * MiB;
constexpr size_t WS_KCMP = 1104 * MiB, WS_VCMP = 1113 * MiB;
constexpr size_t WS_KSLC = 1122 * MiB, WS_VSLC = 1130 * MiB, WS_KWIN = 1138 * MiB, WS_VWIN = 1146 * MiB;
constexpr size_t WS_CQ = 1154 * MiB, WS_MISC = 1170 * MiB;
constexpr size_t WS_RSTDQ = 1186 * MiB, WS_RSTDKV = 1186 * MiB + 512 * 1024, WS_KR = 1187 * MiB, WS_GATES = 1189 * MiB;
constexpr size_t WS_W2T = 1195 * MiB;
constexpr size_t WS_HID = 1192 * MiB, WS_KC = 1196 * MiB, WS_VC = 1196 * MiB + 512 * 1024;
constexpr size_t WS_QM = 1197 * MiB, WS_KN = 1221 * MiB, WS_VM = 1237 * MiB;
constexpr size_t WS_OA3 = 1253 * MiB, WS_LSEA = 1301 * MiB;
constexpr size_t WS_OCMP = 1303 * MiB, WS_OSLC = 1335 * MiB, WS_OWIN = 1367 * MiB, WS_OC = 1399 * MiB;
constexpr size_t WS_SEL = 1415 * MiB, WS_AMIX = 1416 * MiB;
constexpr size_t WS_IDX = 1480 * MiB, WS_GATEW = 1484 * MiB, WS_TOKSLOT = 1488 * MiB, WS_TOKG = WS_TOKSLOT + 512 * 1024;
constexpr size_t WS_ACT = 1489 * MiB, WS_Y2 = 1761 * MiB, WS_END = 2033 * MiB;
static_assert((size_t)ACT_ROWS * 1024 * 2 <= 272 * MiB, "act rows");
static_assert((size_t)16 * SP * 64 * 2 + 65536 <= 9 * MiB, "kcmp");

constexpr int CW_TMO = 0, CW_FAIL = 2;
constexpr int CW_BAR = 4096;
constexpr int CW_QUEUE = 12288;
constexpr int CW_CONVQ = 13312;
constexpr int CW_CNT = 16384;

constexpr int RING_BYTES = 131072;
constexpr int AUX_OFF = RING_BYTES;
constexpr int MISC_OFF = AUX_OFF + 8192;
constexpr int LDS_BYTES = 147456;

DI unsigned pk2(float lo, float hi) { f32x2 v = {lo, hi}; bf16x2_t b = __builtin_convertvector(v, bf16x2_t); return __builtin_bit_cast(unsigned, b); }
DI float bf2f(unsigned short h) { return __uint_as_float(((unsigned)h) << 16); }
DI float bflo(unsigned w) { return __uint_as_float(w << 16); }
DI float bfhi(unsigned w) { return __uint_as_float(w & 0xffff0000u); }
typedef float f32x2c __attribute__((ext_vector_type(2)));
constexpr float Y2_SCALE = 4.0f, Y2_ISCALE = 1.0f / 4.0f;
DI unsigned pk4_fp8(float a, float b, float c, float d) {
    a = fminf(fmaxf(a * Y2_SCALE, -440.f), 440.f); b = fminf(fmaxf(b * Y2_SCALE, -440.f), 440.f); c = fminf(fmaxf(c * Y2_SCALE, -440.f), 440.f); d = fminf(fmaxf(d * Y2_SCALE, -440.f), 440.f);
    int w = __builtin_amdgcn_cvt_pk_fp8_f32(a, b, 0, false); w = __builtin_amdgcn_cvt_pk_fp8_f32(c, d, w, true); return (unsigned)w; }
DI f32x4 unpk4_fp8(unsigned w) { const f32x2c lo = __builtin_amdgcn_cvt_pk_f32_fp8((int)w, false), hi = __builtin_amdgcn_cvt_pk_f32_fp8((int)w, true); return (f32x4){lo.x, lo.y, hi.x, hi.y}; }
constexpr float W8_SCALE = 64.0f, A8_SCALE = 4.0f;
constexpr int W8_E8M0 = 127 - 6, A8_E8M0 = 127 - 2;
constexpr float H8_SCALE = 8.0f; constexpr int H8_E8M0 = 127 - 3;
DI int lane_id() { return (int)__builtin_amdgcn_mbcnt_hi(~0u, __builtin_amdgcn_mbcnt_lo(~0u, 0u)); }
DI unsigned pk4_fp8s(float a, float b, float c, float d, float sc) {
    a = fminf(fmaxf(a * sc, -440.f), 440.f); b = fminf(fmaxf(b * sc, -440.f), 440.f); c = fminf(fmaxf(c * sc, -440.f), 440.f); d = fminf(fmaxf(d * sc, -440.f), 440.f);
    int w = __builtin_amdgcn_cvt_pk_fp8_f32(a, b, 0, false); w = __builtin_amdgcn_cvt_pk_fp8_f32(c, d, w, true); return (unsigned)w; }
DI float q8s(float x, float sc) {
    const float a = fminf(fmaxf(x * sc, -440.f), 440.f); const int w = __builtin_amdgcn_cvt_pk_fp8_f32(a, a, 0, false);
    const f32x2c r = __builtin_amdgcn_cvt_pk_f32_fp8(w, false); return r.x; }
template <int CTRL> DI float dpp_perm(float v) { return __builtin_bit_cast(float, __builtin_amdgcn_update_dpp(0, __builtin_bit_cast(int, v), CTRL, 0xf, 0xf, false)); }
DI float row_sum16(float v) { v += dpp_perm<0xB1>(v); v += dpp_perm<0x4E>(v); v += dpp_perm<0x141>(v); v += dpp_perm<0x140>(v); return v; }
DI float wave_sum(float v) {
    v = row_sum16(v);
    const float r0 = __builtin_bit_cast(float, __builtin_amdgcn_readlane(__builtin_bit_cast(int, v), 0)), r1 = __builtin_bit_cast(float, __builtin_amdgcn_readlane(__builtin_bit_cast(int, v), 16));
    const float r2 = __builtin_bit_cast(float, __builtin_amdgcn_readlane(__builtin_bit_cast(int, v), 32)), r3 = __builtin_bit_cast(float, __builtin_amdgcn_readlane(__builtin_bit_cast(int, v), 48));
    return (r0 + r1) + (r2 + r3);
}
DI float fast_exp2(float x) { return __builtin_amdgcn_exp2f(x); }
DI float fast_rcp(float x) { return __builtin_amdgcn_rcpf(x); }
DI float sigmoidf_(float x) { return fast_rcp(1.0f + fast_exp2(-x * LOG2E)); }
#define RLX_AGENT __ATOMIC_RELAXED, __HIP_MEMORY_SCOPE_AGENT

#define XB_TMO      128
#define XB_XCNT(j)  (256  + 64 * (j))
#define XB_XSUB(j)  (1280 + 64 * (j))
#define XB_XGEN(j)  (2304 + 64 * (j))
#define XB_TOP      3328
#define XB_TOPGEN   3392
#define XCD_BAR_WORDS 3456
#define XB_SPIN_CAP (1u << 22)
DI unsigned xb_ld(unsigned* p)              { return __hip_atomic_load(p, __ATOMIC_RELAXED, __HIP_MEMORY_SCOPE_AGENT); }
DI unsigned xb_add(unsigned* p, unsigned v) { return __hip_atomic_fetch_add(p, v, __ATOMIC_RELAXED, __HIP_MEMORY_SCOPE_AGENT); }
DI unsigned xb_xcc_id() { return (unsigned)__builtin_amdgcn_s_getreg((3 << 11) | 20) & 0xFu; }
#define XB_SPIN(cond, bar) do { unsigned _sp = 0; while (cond) { __builtin_amdgcn_s_sleep(1); \
    if ((++_sp & 255u) == 0u) { if (xb_ld(&(bar)[XB_TMO])) break; if (_sp > XB_SPIN_CAP) { atomicAdd(&(bar)[XB_TMO], 1u); break; } } } } while (0)
struct XcdBarrier { unsigned* bar; unsigned x; volatile LAS unsigned* st; };
DI XcdBarrier xcd_barrier_post(unsigned* bar, volatile LAS unsigned* st) {
    XcdBarrier b; b.bar = bar; b.x = xb_xcc_id(); b.st = st;
    if (threadIdx.x == 0) (void)xb_add(&bar[XB_XCNT(b.x)], 1u);
    return b;
}
DI void xcd_barrier_complete(unsigned* bar, unsigned x, unsigned& nloc, unsigned& nx) {
    const unsigned G = gridDim.x * gridDim.y * gridDim.z;
    unsigned sum, cnt, mine, sp = 0u;
    for (;;) {
        sum = 0u; cnt = 0u; mine = 0u;
#pragma unroll
        for (unsigned j = 0; j < 16; ++j) { const unsigned c = xb_ld(&bar[XB_XCNT(j)]); sum += c; cnt += (c > 0u) ? 1u : 0u; mine = (j == x) ? c : mine; }
        if (sum == G) break;
        __builtin_amdgcn_s_sleep(1);
        if ((++sp & 255u) == 0u) { if (xb_ld(&bar[XB_TMO])) break; if (sp > XB_SPIN_CAP) { atomicAdd(&bar[XB_TMO], 1u); break; } }
    }
    nloc = mine > 0u ? mine : 1u; nx = cnt > 0u ? cnt : 1u;
}
DI void xcd_barrier(const XcdBarrier& b) {
    asm volatile("s_waitcnt vmcnt(0)" ::: "memory");
    __syncthreads();
    unsigned* bar = b.bar; asm volatile("" : "+s"(bar));
    if (threadIdx.x == 0) {
        __builtin_amdgcn_s_waitcnt(0);
        unsigned nloc = b.st[0], nx = b.st[1];
        if (nloc == 0u) { xcd_barrier_complete(bar, b.x, nloc, nx); b.st[0] = nloc; b.st[1] = nx; }
        const unsigned old = xb_add(&bar[XB_XSUB(b.x)], 1u);
        const unsigned gen = old / nloc;
        if (old + 1u == (gen + 1u) * nloc) {
            __builtin_amdgcn_fence(__ATOMIC_RELEASE, "agent");
            asm volatile("s_waitcnt vmcnt(0)" ::: "memory");
            const unsigned og = xb_add(&bar[XB_TOP], 1u);
            const unsigned tg = og / nx;
            if (og + 1u == (tg + 1u) * nx) xb_add(&bar[XB_TOPGEN], 1u);
            else XB_SPIN(xb_ld(&bar[XB_TOPGEN]) == tg, bar);
            __builtin_amdgcn_fence(__ATOMIC_ACQUIRE, "agent");
            xb_add(&bar[XB_XGEN(b.x)], 1u);
            asm volatile("s_waitcnt vmcnt(0)" ::: "memory");
        } else {
            XB_SPIN(xb_ld(&bar[XB_XGEN(b.x)]) == gen, bar);
            __builtin_amdgcn_fence(__ATOMIC_ACQUIRE, "agent");
            asm volatile("s_waitcnt vmcnt(0)" ::: "memory");
        }
    }
    __syncthreads();
}

struct Args {
    const float* in[33];
    float* out;
    unsigned char* ws;
    int ph_lo, ph_hi;
};
enum { I_X = 0, I_C, I_POS, I_WADA, I_BADA, I_G1, I_G2, I_WIN, I_POSK, I_POSV, I_W1K, I_B1K, I_W2K, I_B2K, I_W1V, I_B1V, I_W2V, I_B2V,
       I_GQ, I_GKV, I_WQUP, I_WKVUP, I_GOA, I_GOB, I_GOC, I_WOUT, I_WR, I_BR, I_WE1, I_BE1, I_WE2, I_BE2, I_GF };

struct Ctx {
    LAS unsigned char* lds;
    const Args* a;
    unsigned char* ws;
    int tid, lane, wave, blk, G, vcu;
    size_t dofs; int dcnt;
};
DI const float* ginp(const Ctx& F, int i) { return (const float*)(GAS const float*)(F.a->in[i]); }
DI float* gout(const Ctx& F) { return (float*)(GAS float*)(F.a->out); }

namespace pg8 {
constexpr int BM = 256, BK = 64, HALF = 128, HTB = HALF * BK * 2;
DI int lds_byte(int r, int c) { const int st = (r >> 4) * 2 + (c >> 5), rr = r & 15, cc = c & 31, ob = rr * 64 + cc * 2; return st * 1024 + (ob ^ (((ob >> 9) & 1) << 5)); }
DI void stage_rc(int b, int& R, int& C) { const int st = b / 1024, sb = b % 1024, swz = sb ^ (((sb >> 9) & 1) << 5); R = (st >> 1) * 16 + swz / 64; C = (st & 1) * 32 + (swz % 64) / 2; }
DI int perm32(int rho) { const int n = rho >> 4, i = rho & 15; return 8 * (i >> 2) + 4 * n + (i & 3); }
struct Unit { const char* a; const char* b; int pm, pn, e, ml; };
template <class E_, class = void> struct acc_bias_t { static constexpr bool value = false; };
template <class E_> struct acc_bias_t<E_, decltype((void)E_::ACC_BIAS)> { static constexpr bool value = E_::ACC_BIAS; };
template <class E_> constexpr bool acc_bias_v = acc_bias_t<E_>::value;
template <class E_, class = void> struct perm2_t { static constexpr bool value = false; };
template <class E_> struct perm2_t<E_, decltype((void)E_::PERM2)> { static constexpr bool value = E_::PERM2; };
template <class E_> constexpr bool perm2_v = perm2_t<E_>::value;

template <class Epi, class Sched, bool GATHER, bool FP8 = false>
DI void gemm_phase(LAS unsigned char* lds, const int lda, const int K, const Sched& S, const Epi& E) {
    typedef int i32x4_ __attribute__((ext_vector_type(4))); typedef int i32x8_ __attribute__((ext_vector_type(8)));
    int tid_ = threadIdx.x; asm volatile("" : "+v"(tid_));
    const int tid = tid_, wid = __builtin_amdgcn_readfirstlane(tid >> 6), lane = tid & 63, wr = wid >> 2, wc = wid & 3, fr = lane & 15, fq = lane >> 4;
    const int nt = K / BK;
    int Rr[2], Cc[2]; unsigned voffB[2];
#pragma unroll
    for (int i = 0; i < 2; ++i) { int R, C; stage_rc(tid * 16 + i * 8192, R, C); Rr[i] = R; Cc[i] = C; const int Rb = perm2_v<Epi> ? ((R >> 5) * 64 + 16 * ((R & 15) >> 2) + 4 * ((R >> 4) & 1) + (R & 3)) : (Epi::PERM ? ((R & ~31) + perm32(R & 31)) : R); voffB[i] = (unsigned)(Rb * K + C) * 2u; }
    const size_t kstep = (size_t)(BK * 2);
    const size_t hstepB = (size_t)(perm2_v<Epi> ? 8 : HALF) * K * 2;
    const size_t istepB = (size_t)(perm2_v<Epi> ? 128 : 64) * K * 2;
    const unsigned ldsw = (unsigned)wid * 1024u;
    const int aoff = lds_byte(wr * 64 + fr, fq * 8), boff = lds_byte(wc * 32 + fr, fq * 8);
#define PG8_SA(b, h) (((b) * 2 + (h)) * HTB)
#define PG8_SB(b, h) ((4 + (b) * 2 + (h)) * HTB)
#define PG8_STAGE_B(bufoff, gbase) do { _Pragma("unroll") for (int _i = 0; _i < 2; ++_i) \
        __builtin_amdgcn_global_load_lds((const unsigned*)((const char*)(gbase) + (size_t)_i * istepB + voffB[0]), (LAS unsigned*)(lds + (bufoff) + ldsw + _i * 8192), 16, 0, 0); } while (0)
#define PG8_STAGE_A(bufoff, gbase, v, h) do { _Pragma("unroll") for (int _i = 0; _i < 2; ++_i) { \
        if constexpr (GATHER) __builtin_amdgcn_global_load_lds((const unsigned*)((const char*)(gbase) + (v)[h][_i]), (LAS unsigned*)(lds + (bufoff) + ldsw + _i * 8192), 16, 0, 0); \
        else __builtin_amdgcn_global_load_lds((const unsigned*)((const char*)(gbase) + (size_t)((h) * 128 + _i * 64) * lda * 2 + (v)[0][0]), (LAS unsigned*)(lds + (bufoff) + ldsw + _i * 8192), 16, 0, 0); } } while (0)
#define PG8_SETOFF(v, u) do { _Pragma("unroll") for (int _h = 0; _h < 2; ++_h) _Pragma("unroll") for (int _i = 0; _i < 2; ++_i) { \
        if constexpr (GATHER) (v)[_h][_i] = S.gather_off((u), _h * 128 + Rr[_i]) + (unsigned)Cc[_i] * 2u; \
        else (v)[_h][_i] = (unsigned)((_h * 128 + Rr[_i]) * lda + Cc[_i]) * 2u; } } while (0)
#define PG8_LDA(dst, b, h) do { _Pragma("unroll") for (int m = 0; m < 4; ++m) { const i32x4_ lo_ = *(const LAS i32x4_*)(lds + PG8_SA(b, h) + aoff + m * 2048), hi_ = *(const LAS i32x4_*)(lds + PG8_SA(b, h) + aoff + m * 2048 + 1024); dst[m] = __builtin_shufflevector(lo_, hi_, 0, 1, 2, 3, 4, 5, 6, 7); } } while (0)
#define PG8_LDB(dst, b, h) do { _Pragma("unroll") for (int n = 0; n < 2; ++n) { const i32x4_ lo_ = *(const LAS i32x4_*)(lds + PG8_SB(b, h) + boff + n * 2048), hi_ = *(const LAS i32x4_*)(lds + PG8_SB(b, h) + boff + n * 2048 + 1024); dst[n] = __builtin_shufflevector(lo_, hi_, 0, 1, 2, 3, 4, 5, 6, 7); } } while (0)
#define PG8_H0(x) __builtin_bit_cast(bf16x8, __builtin_shufflevector((x), (x), 0, 1, 2, 3))
#define PG8_H1(x) __builtin_bit_cast(bf16x8, __builtin_shufflevector((x), (x), 4, 5, 6, 7))
#define PG8_MMA(ai, bj, At, Bt) do { __builtin_amdgcn_s_setprio(1); \
        if constexpr (FP8) { _Pragma("unroll") for (int m = 0; m < 4; ++m) _Pragma("unroll") for (int n = 0; n < 2; ++n) \
            asm volatile("v_mfma_scale_f32_16x16x128_f8f6f4 %0, %1, %2, %0, %3, %4 op_sel_hi:[0,0,0]" : "+v"(acc[ai][bj][m][n]) : "v"(Bt[n]), "v"(At[m]), "v"(scw_), "v"(sca_)); } \
        else { _Pragma("unroll") for (int m = 0; m < 4; ++m) _Pragma("unroll") for (int n = 0; n < 2; ++n) { \
            acc[ai][bj][m][n] = __builtin_amdgcn_mfma_f32_16x16x32_bf16(PG8_H0(Bt[n]), PG8_H0(At[m]), acc[ai][bj][m][n], 0, 0, 0); \
            acc[ai][bj][m][n] = __builtin_amdgcn_mfma_f32_16x16x32_bf16(PG8_H1(Bt[n]), PG8_H1(At[m]), acc[ai][bj][m][n], 0, 0, 0); } } \
        __builtin_amdgcn_s_setprio(0); } while (0)
#define PG8_WAIT_V(n) asm volatile("s_waitcnt vmcnt(" #n ")" ::: "memory")
#define PG8_WAIT_L(n) asm volatile("s_waitcnt lgkmcnt(" #n ")" ::: "memory")
#define PG8_BAR __builtin_amdgcn_s_barrier()
#define PG8_SCHED __builtin_amdgcn_sched_barrier(0)
    Unit cur, nxt; int ui = 0;
    if (!S.next(0, cur)) return;
    f32x4 acc[2][2][4][2];
    f32x4 bv[2][2] = {{{0.f, 0.f, 0.f, 0.f}, {0.f, 0.f, 0.f, 0.f}}, {{0.f, 0.f, 0.f, 0.f}, {0.f, 0.f, 0.f, 0.f}}};
    if constexpr (acc_bias_v<Epi>) E.bias(cur, wc, fq, bv);
#pragma unroll
    for (int a = 0; a < 2; ++a)
#pragma unroll
        for (int b = 0; b < 2; ++b)
#pragma unroll
            for (int m = 0; m < 4; ++m)
#pragma unroll
                for (int n = 0; n < 2; ++n) acc[a][b][m][n] = bv[b][n];
    int scw_ = W8_E8M0, sca_ = A8_E8M0; if constexpr (FP8) sca_ = Epi::A_E8M0;
    i32x8_ At[4], B0[2], B1[2];
    unsigned vA[2][2], vAn[2][2];
    PG8_SETOFF(vA, cur);
    const char* cA = cur.a; const char* cB = cur.b;
    PG8_STAGE_B(PG8_SB(0, 0), cB); PG8_STAGE_B(PG8_SB(0, 1), cB + hstepB); PG8_STAGE_A(PG8_SA(0, 0), cA, vA, 0); PG8_STAGE_A(PG8_SA(0, 1), cA, vA, 1);
    if (wr == 1) PG8_BAR;
    PG8_WAIT_V(2); PG8_BAR;
    PG8_STAGE_B(PG8_SB(1, 0), cB + kstep); PG8_STAGE_A(PG8_SA(1, 0), cA + kstep, vA, 0); PG8_STAGE_B(PG8_SB(1, 1), cB + hstepB + kstep);
    PG8_WAIT_V(6); PG8_BAR;
    for (;;) {
        const bool has_next = S.next(ui + 1, nxt);
        if constexpr (GATHER) {
            if (has_next) {
#pragma unroll
                for (int h = 0; h < 2; ++h)
#pragma unroll
                    for (int i = 0; i < 2; ++i) vAn[h][i] = S.gather_raw(nxt, h * 128 + Rr[i]);
            }
        }
        const char* nA = has_next ? nxt.a : cA; const char* nB = has_next ? nxt.b : cB;
#pragma unroll 1
        for (int t = 0; t < nt; t += 2) {
            const bool last = (t == nt - 2);
            const char* a1 = cA + (size_t)(t + 1) * kstep;
            const char* a2 = last ? nA : cA + (size_t)(t + 2) * kstep; const char* b2 = last ? nB : cB + (size_t)(t + 2) * kstep;
            const char* a3 = a2 + kstep; const char* b3 = b2 + kstep;
            unsigned v2[2][2];
#pragma unroll
            for (int h = 0; h < 2; ++h)
#pragma unroll
                for (int i = 0; i < 2; ++i) v2[h][i] = vA[h][i];
            if constexpr (GATHER) {
                if (last && has_next) {
#pragma unroll
                    for (int h = 0; h < 2; ++h)
#pragma unroll
                        for (int i = 0; i < 2; ++i) { vAn[h][i] = vAn[h][i] * (unsigned)(lda * 2) + (unsigned)Cc[i] * 2u; v2[h][i] = vAn[h][i]; }
                }
            }
            PG8_LDB(B0, 0, 0); PG8_LDB(B1, 0, 1); PG8_SCHED; PG8_LDA(At, 0, 0); PG8_STAGE_A(PG8_SA(1, 1), a1, vA, 1);
            PG8_WAIT_V(8); PG8_WAIT_L(0); PG8_BAR; PG8_MMA(0, 0, At, B0); PG8_MMA(0, 1, At, B1); PG8_BAR; PG8_SCHED;
            PG8_LDA(At, 0, 1); PG8_STAGE_B(PG8_SB(0, 0), b2); PG8_STAGE_B(PG8_SB(0, 1), b2 + hstepB); PG8_STAGE_A(PG8_SA(0, 0), a2, v2, 0);
            PG8_WAIT_V(8); PG8_WAIT_L(0); PG8_BAR; PG8_MMA(1, 0, At, B0); PG8_MMA(1, 1, At, B1); PG8_BAR; PG8_SCHED;
            PG8_LDB(B0, 1, 0); PG8_LDB(B1, 1, 1); PG8_SCHED; PG8_LDA(At, 1, 0); PG8_STAGE_A(PG8_SA(0, 1), a2, v2, 1);
            PG8_WAIT_V(8); PG8_WAIT_L(0); PG8_BAR; PG8_MMA(0, 0, At, B0); PG8_MMA(0, 1, At, B1); PG8_BAR; PG8_SCHED;
            PG8_LDA(At, 1, 1); PG8_STAGE_B(PG8_SB(1, 0), b3); PG8_STAGE_B(PG8_SB(1, 1), b3 + hstepB); PG8_STAGE_A(PG8_SA(1, 0), a3, v2, 0);
            PG8_WAIT_V(8); PG8_WAIT_L(0); PG8_BAR; PG8_MMA(1, 0, At, B0); PG8_MMA(1, 1, At, B1); PG8_BAR; PG8_SCHED;
        }
        if (wr == 0) PG8_BAR;
        if constexpr (FP8) asm volatile("s_nop 15\n\ts_nop 15" ::: "memory");
        if constexpr (acc_bias_v<Epi>) E.bias(has_next ? nxt : cur, wc, fq, bv);
        if constexpr (!Epi::AFTER_DRAIN) { int fr_ = fr, fq_ = fq; asm volatile("" : "+v"(fr_), "+v"(fq_)); E(acc, cur, wr, wc, fr_, fq_); }
        if (!has_next) break;
#pragma unroll
        for (int a = 0; a < 2; ++a)
#pragma unroll
            for (int b = 0; b < 2; ++b)
#pragma unroll
                for (int m = 0; m < 4; ++m)
#pragma unroll
                    for (int n = 0; n < 2; ++n) acc[a][b][m][n] = bv[b][n];
        cur = nxt; cA = nA; cB = nB; ++ui;
        if constexpr (GATHER) {
#pragma unroll
            for (int h = 0; h < 2; ++h)
#pragma unroll
                for (int i = 0; i < 2; ++i) vA[h][i] = vAn[h][i];
        }
        if (wr == 1) PG8_BAR;
    }
    PG8_WAIT_V(0);
    PG8_BAR;
    if constexpr (Epi::AFTER_DRAIN) { int fr_ = fr, fq_ = fq; asm volatile("" : "+v"(fr_), "+v"(fq_)); E.fused(acc, cur, wr, wc, fr_, fq_, lds, wid, lane); }
#undef PG8_SA
#undef PG8_SB
#undef PG8_STAGE_A
#undef PG8_STAGE_B
#undef PG8_SETOFF
#undef PG8_LDA
#undef PG8_LDB
#undef PG8_MMA
#undef PG8_H0
#undef PG8_H1
#undef PG8_WAIT_V
#undef PG8_WAIT_L
#undef PG8_BAR
#undef PG8_SCHED
}
}
using pg8::Unit;
typedef f32x4 AccT[2][2][4][2];

struct SchedGrid {
    const char* A; const char* B; int lda, K, nN, nwg, G, c;
    DI bool next(int i, Unit& u) const {
        const int L = i * G + c; if (L >= nwg) return false;
        u.pm = L / nN; u.pn = L % nN; u.e = 0; u.ml = 0;
        u.a = A + (size_t)u.pm * 256 * lda * 2; u.b = B + (size_t)u.pn * 256 * K * 2; return true;
    }
    DI unsigned gather_off(const Unit&, int) const { return 0u; }
    DI unsigned gather_raw(const Unit&, int) const { return 0u; }
};
struct SchedCmp {
    const char* KCMP; const char* VCMP; const char* W; int G, c;
    DI bool next(int i, Unit& u) const {
        const int L = i * G + c; if (L >= 32) return false;
        const int kv = L >> 4, bg = L & 15;
        u.pm = L; u.pn = 0; u.e = kv; u.ml = 0;
        u.a = (kv ? VCMP : KCMP) + (size_t)bg * SP * 64 * 2; u.b = W + (size_t)kv * 256 * 2048 * 2; return true;
    }
    DI unsigned gather_off(const Unit&, int) const { return 0u; }
    DI unsigned gather_raw(const Unit&, int) const { return 0u; }
};
struct SchedMla {
    const char* CQ; const char* MISC; const char* WQ; const char* WKV; int G, c;
    DI bool next(int i, Unit& u) const {
        const int L = i * G + c; if (L >= 512) return false;
        const int which = L >> 8, r = L & 255;
        u.pm = r >> 1; u.pn = r & 1; u.e = which; u.ml = 0;
        u.a = (which ? MISC : CQ) + (size_t)u.pm * 256 * 256 * 2; u.b = (which ? WKV : WQ) + (size_t)u.pn * 256 * 256 * 2; return true;
    }
    DI unsigned gather_off(const Unit&, int) const { return 0u; }
    DI unsigned gather_raw(const Unit&, int) const { return 0u; }
};
template <int NT, bool GATHERED>
struct SchedMoe {
    const LAS int* tb; const LAS int* cnt; const char* A; const char* W; const int* IDX; int total, G, c;
    DI bool next(int i, Unit& u) const {
        const int L = i * G + c; if (L >= total) return false;
        const int mtg = L / NT; u.pn = L % NT;
        const int ln_ = threadIdx.x & 63;
        const int e = __popcll(__ballot(ln_ < 32 && tb[ln_ & 31] <= mtg)) - 1;
        u.e = e; u.ml = mtg - tb[e]; u.pm = mtg;
        u.a = GATHERED ? A : A + (size_t)mtg * 256 * 1024 * 2;
        u.b = W + ((size_t)e * NT * 256 + (size_t)u.pn * 256) * 1024 * 2; return true;
    }
    DI unsigned gather_off(const Unit& u, int row) const {
        const int pos = u.ml * 256 + row; const int tok = (pos < cnt[u.e]) ? IDX[u.e * ECAP + pos] : 0;
        return (unsigned)tok * 2048u;
    }
    DI unsigned gather_raw(const Unit& u, int row) const {
        const int pos = u.ml * 256 + row;
        return (unsigned)IDX[u.e * ECAP + (pos < cnt[u.e] ? pos : 0)];
    }
};

struct SchedMoe1F8 {
    static constexpr bool HOOK = false;
    const LAS int* tb; const LAS int* cnt; const char* A; const char* W; const int* IDX; int total, G, c;
    DI bool next(int i, Unit& u) const {
        const int L = i * G + c; if (L >= total) return false;
        const int mtg = L >> 3; u.pn = L & 7;
        const int ln_ = lane_id();
        const int e = __popcll(__ballot(ln_ < 32 && tb[ln_ & 31] <= mtg)) - 1;
        u.e = e; u.ml = mtg - tb[e]; u.pm = mtg;
        u.a = A; u.b = W + ((size_t)e * 2048 + (size_t)u.pn * 256) * 1024; return true;
    }
    DI unsigned gather_raw(const Unit& u, int row) const { const int pos = u.ml * 256 + row; return (unsigned)IDX[u.e * ECAP + (pos < cnt[u.e] ? pos : 0)]; }
    DI unsigned gather_off(const Unit& u, int row) const { return gather_raw(u, row) * 1024u; }
};
struct SchedMoe2F8 {
    static constexpr bool HOOK = false;
    const LAS int* tb; const char* A; const char* W; int total, G, c;
    DI bool next(int i, Unit& u) const {
        const int L = i * G + c; if (L >= total) return false;
        const int mtg = L >> 2; u.pn = L & 3;
        const int ln_ = lane_id();
        const int e = __popcll(__ballot(ln_ < 32 && tb[ln_ & 31] <= mtg)) - 1;
        u.e = e; u.ml = mtg - tb[e]; u.pm = mtg;
        u.a = A + (size_t)mtg * 256 * 1024; u.b = W + ((size_t)e * 1024 + (size_t)u.pn * 256) * 1024; return true;
    }
    DI unsigned gather_off(const Unit&, int) const { return 0u; }
    DI unsigned gather_raw(const Unit&, int) const { return 0u; }
};

DI void rot4(f32x4& v0, f32x4& v1, const f32x4 c, const f32x4 s) {
    const float a0 = v0[0], b0 = v0[1], a1 = v0[2], b1 = v0[3], a2 = v1[0], b2 = v1[1], a3 = v1[2], b3 = v1[3];
    v0[0] = a0 * c[0] - b0 * s[0]; v0[1] = b0 * c[0] + a0 * s[0];
    v0[2] = a1 * c[1] - b1 * s[1]; v0[3] = b1 * c[1] + a1 * s[1];
    v1[0] = a2 * c[2] - b2 * s[2]; v1[1] = b2 * c[2] + a2 * s[2];
    v1[2] = a3 * c[3] - b3 * s[3]; v1[3] = b3 * c[3] + a3 * s[3];
}
DI u32x4 pack8(const f32x4 v0, const f32x4 v1) { u32x4 w; w.x = pk2(v0[0], v0[1]); w.y = pk2(v0[2], v0[3]); w.z = pk2(v1[0], v1[1]); w.w = pk2(v1[2], v1[3]); return w; }

struct EpiWin {
    static constexpr bool PERM = true, AFTER_DRAIN = false;
    unsigned char* ws; const float* CS64; const float* CS32;
    DI void dest(int pn, int w0, size_t& off, int& ld, int& dcol, int& mode, int& gm, int& g, float& sc) const {
        mode = 0; gm = 0; g = 0; sc = 1.f;
        switch (pn) {
            case 0: off = WS_QA; ld = 256; dcol = w0; mode = 1; sc = SCL64; break;
            case 1: off = WS_KA; ld = 256; dcol = w0; mode = 1; break;
            case 2: off = WS_VA; ld = 256; dcol = w0; break;
            case 3: off = WS_QB; ld = 512; dcol = w0; mode = 1; sc = SCL64; break;
            case 4: off = WS_QB; ld = 512; dcol = 256 + w0; mode = 1; sc = SCL64; break;
            case 5: off = (w0 < 128) ? WS_KCMP : WS_VCMP; ld = 64; gm = 1; g = (w0 & 127) >> 6; dcol = w0 & 63; break;
            case 6: off = (w0 < 128) ? WS_KSLC : WS_VSLC; ld = 128; dcol = w0 & 127; mode = (w0 < 128) ? 1 : 0; break;
            case 7: off = (w0 < 128) ? WS_KWIN : WS_VWIN; ld = 128; dcol = w0 & 127; mode = (w0 < 128) ? 1 : 0; break;
            case 8: off = WS_CQ; ld = 256; dcol = w0; break;
            default: if (w0 == 128) { off = WS_KR; ld = 32; dcol = 0; mode = 2; } else { off = WS_MISC; ld = 256; dcol = w0; } break;
        }
    }
    DI void operator()(const AccT& acc, const Unit& u, int wr, int wc, int fr, int fq) const {
        size_t off[2]; int ld[2], dcol[2], mode[2], gm[2], g[2]; float sc[2];
#pragma unroll
        for (int bj = 0; bj < 2; ++bj) dest(u.pn, bj * 128 + wc * 32, off[bj], ld[bj], dcol[bj], mode[bj], gm[bj], g[bj], sc[bj]);
        const bool shared = (mode[0] == 1) && (mode[1] == 1);
        const int i0 = 16 * (wc & 1) + 4 * fq;
#pragma unroll
        for (int ai = 0; ai < 2; ++ai) {
            f32x4 cc[4], sn[4];
            if (shared) {
#pragma unroll
                for (int m = 0; m < 4; ++m) { const int row = u.pm * 256 + ai * 128 + wr * 64 + m * 16 + fr; const float* cs = CS64 + (size_t)row * 64 + i0; cc[m] = *(const f32x4*)cs; sn[m] = *(const f32x4*)(cs + 32); }
            }
#pragma unroll
            for (int bj = 0; bj < 2; ++bj) {
                bf16* base = (bf16*)(ws + off[bj]);
                const int md = mode[bj];
                if (md && !shared) {
#pragma unroll
                    for (int m = 0; m < 4; ++m) {
                        const int row = u.pm * 256 + ai * 128 + wr * 64 + m * 16 + fr;
                        const float* cs = (md == 1) ? CS64 + (size_t)row * 64 + i0 : CS32 + (size_t)row * 32 + 4 * fq;
                        cc[m] = *(const f32x4*)cs; sn[m] = *(const f32x4*)(cs + (md == 1 ? 32 : 16));
                    }
                }
#pragma unroll
                for (int m = 0; m < 4; ++m) {
                    const int row = u.pm * 256 + ai * 128 + wr * 64 + m * 16 + fr;
                    f32x4 v0 = acc[ai][bj][m][0], v1 = acc[ai][bj][m][1];
                    if (md) rot4(v0, v1, cc[m], sn[m]);
                    v0 = v0 * sc[bj]; v1 = v1 * sc[bj];
                    const size_t drow = gm[bj] ? (size_t)(((row >> 12) * 2 + g[bj]) * SP + (row & 4095)) : (size_t)row;
                    *(u32x4*)(base + drow * ld[bj] + dcol[bj] + 8 * fq) = pack8(v0, v1);
                }
            }
        }
    }
};
struct EpiCmp {
    static constexpr bool PERM = true, AFTER_DRAIN = true;
    const float* B1P; const bf16* W2T; const float *B2K, *B2V; bf16 *KC, *VC; const float* CS64;
    DI void fused(const AccT& acc, const Unit& u, int wr, int wc, int fr, int fq, LAS unsigned char* lds, int wid, int lane) const {
        constexpr int HST = 528;
        const int kv = u.e, bg = u.pm & 15;
#pragma unroll
        for (int bj = 0; bj < 2; ++bj) {
            const int col = bj * 128 + wc * 32 + 8 * fq;
            const f32x4 b0 = *(const f32x4*)(B1P + kv * 256 + col), b1 = *(const f32x4*)(B1P + kv * 256 + col + 4);
#pragma unroll
            for (int ai = 0; ai < 2; ++ai)
#pragma unroll
                for (int m = 0; m < 4; ++m) {
                    const int rl = ai * 128 + wr * 64 + m * 16 + fr;
                    f32x4 v0 = acc[ai][bj][m][0] + b0, v1 = acc[ai][bj][m][1] + b1;
#pragma unroll
                    for (int j = 0; j < 4; ++j) {
                        float x = v0[j]; float z = 0.7978845608028654f * (x + 0.044715f * x * x * x); v0[j] = x * sigmoidf_(2.f * z);
                        x = v1[j]; z = 0.7978845608028654f * (x + 0.044715f * x * x * x); v1[j] = x * sigmoidf_(2.f * z);
                    }
                    *(LAS u32x4*)(lds + rl * HST + col * 2) = pack8(v0, v1);
                }
        }
        asm volatile("s_waitcnt lgkmcnt(0)\n\ts_barrier" ::: "memory");
        const int r32 = lane & 31, hh = lane >> 5;
        f32x16 out0 = {0.f, 0.f, 0.f, 0.f, 0.f, 0.f, 0.f, 0.f, 0.f, 0.f, 0.f, 0.f, 0.f, 0.f, 0.f, 0.f}, out1 = out0;
        const bf16* w2 = W2T + (size_t)kv * 64 * 256;
#pragma unroll 4
        for (int ks = 0; ks < 16; ++ks) {
            const bf16x8 a = *(const LAS bf16x8*)(lds + (32 * wid + r32) * HST + (16 * ks + 8 * hh) * 2);
            const bf16x8 bq0 = *(const bf16x8*)(w2 + (size_t)r32 * 256 + 16 * ks + 8 * hh), bq1 = *(const bf16x8*)(w2 + (size_t)(32 + r32) * 256 + 16 * ks + 8 * hh);
            out0 = __builtin_amdgcn_mfma_f32_32x32x16_bf16(a, bq0, out0, 0, 0, 0); out1 = __builtin_amdgcn_mfma_f32_32x32x16_bf16(a, bq1, out1, 0, 0, 0);
        }
        const float* b2 = kv ? B2V : B2K;
        const float bb0 = b2[r32], bb1 = b2[32 + r32];
        const int b = bg >> 1;
#pragma unroll
        for (int i = 0; i < 16; ++i) {
            const int c = 32 * wid + 8 * (i >> 2) + 4 * hh + (i & 3);
            const size_t row = (size_t)bg * 256 + c;
            float x1 = out0[i] + bb0, x2 = out1[i] + bb1;
            if (c == 255) { x1 = 0.f; x2 = 0.f; }
            if (kv == 0) {
                const int tokr = (b * S + 16 * c + 31) & (T - 1);
                const float cs = CS64[(size_t)tokr * 64 + r32], sn = CS64[(size_t)tokr * 64 + 32 + r32];
                *(unsigned*)(KC + row * 64 + 2 * r32) = pk2(x1 * cs - x2 * sn, x2 * cs + x1 * sn);
            } else {
                VC[row * 64 + r32] = (bf16)(pk2(x1, 0.f) & 0xffffu); VC[row * 64 + 32 + r32] = (bf16)(pk2(x2, 0.f) & 0xffffu);
            }
        }
    }
};
struct EpiMla {
    static constexpr bool PERM = true, AFTER_DRAIN = false;
    bf16 *QM, *KN, *VM; const bf16 *CQ, *MISC; const float* CS32; LAS float* RS;
    DI void operator()(const AccT& acc, const Unit& u, int wr, int wc, int fr, int fq) const {
#pragma unroll
        for (int ai = 0; ai < 2; ++ai) {
            const int rl = ai * 128 + wr * 64 + wc * 16 + fr, row = u.pm * 256 + rl;
            float ss = 0.f;
            if (u.e == 0) {
#pragma unroll
                for (int c = 0; c < 8; ++c) { const u32x4 w = *(const u32x4*)(CQ + (size_t)row * 256 + fq * 64 + 8 * c);
                    ss += bflo(w.x) * bflo(w.x) + bfhi(w.x) * bfhi(w.x) + bflo(w.y) * bflo(w.y) + bfhi(w.y) * bfhi(w.y) + bflo(w.z) * bflo(w.z) + bfhi(w.z) * bfhi(w.z) + bflo(w.w) * bflo(w.w) + bfhi(w.w) * bfhi(w.w); }
            } else {
#pragma unroll
                for (int c = 0; c < 4; ++c) { const u32x4 w = *(const u32x4*)(MISC + (size_t)row * 256 + fq * 32 + 8 * c);
                    ss += bflo(w.x) * bflo(w.x) + bfhi(w.x) * bfhi(w.x) + bflo(w.y) * bflo(w.y) + bfhi(w.y) * bfhi(w.y) + bflo(w.z) * bflo(w.z) + bfhi(w.z) * bfhi(w.z) + bflo(w.w) * bflo(w.w) + bfhi(w.w) * bfhi(w.w); }
            }
            ss += __shfl_xor(ss, 16); ss += __shfl_xor(ss, 32);
            if (fq == 0) RS[rl] = rsqrtf(ss * (u.e == 0 ? (1.0f / 256.0f) : (1.0f / 128.0f)) + EPS);
        }
        asm volatile("s_waitcnt lgkmcnt(0)\n\ts_barrier" ::: "memory");
        float rstd[2][4];
#pragma unroll
        for (int ai = 0; ai < 2; ++ai)
#pragma unroll
            for (int m = 0; m < 4; ++m) rstd[ai][m] = RS[ai * 128 + wr * 64 + m * 16 + fr];
#pragma unroll
        for (int bj = 0; bj < 2; ++bj) {
            const int gc = u.pn * 256 + bj * 128 + wc * 32;
            bf16* base; int ld, dcol, rope = 0; float sc = 1.f;
            if (u.e == 0) { if (gc >= 384) continue; rope = ((gc >> 5) % 3) == 2; base = QM; ld = 384; dcol = gc; sc = SCL96; }
            else { const int head = gc >> 7, part = (gc & 127) >> 6, o = gc & 63; base = part ? VM : KN; ld = 256; dcol = head * 64 + o; }
#pragma unroll
            for (int ai = 0; ai < 2; ++ai) {
                f32x4 cc[4], sn[4];
                if (rope) {
#pragma unroll
                    for (int m = 0; m < 4; ++m) { const float* cs = CS32 + (size_t)(u.pm * 256 + ai * 128 + wr * 64 + m * 16 + fr) * 32 + 4 * fq; cc[m] = *(const f32x4*)cs; sn[m] = *(const f32x4*)(cs + 16); }
                }
#pragma unroll
                for (int m = 0; m < 4; ++m) {
                    const int row = u.pm * 256 + ai * 128 + wr * 64 + m * 16 + fr;
                    const float r = rstd[ai][m] * sc;
                    f32x4 v0 = acc[ai][bj][m][0] * r, v1 = acc[ai][bj][m][1] * r;
                    if (rope) rot4(v0, v1, cc[m], sn[m]);
                    *(u32x4*)(base + (size_t)row * ld + dcol + 8 * fq) = pack8(v0, v1);
                }
            }
        }
    }
};
struct EpiWout {
    static constexpr bool PERM = true, AFTER_DRAIN = false;
    bf16* X; const float* GT; size_t dofs;
    DI void operator()(const AccT& acc, const Unit& u, int wr, int wc, int fr, int fq) const {
        const int b = (u.pm * 256) >> 12;
        const int col0 = u.pn * 256 + wc * 32 + 8 * fq;
        u32x4 xo[2][2][4]; f32x4 gt[2][2];
#pragma unroll
        for (int bj = 0; bj < 2; ++bj) {
            gt[bj][0] = *(const f32x4*)(GT + (size_t)b * 6144 + col0 + bj * 128); gt[bj][1] = *(const f32x4*)(GT + (size_t)b * 6144 + col0 + bj * 128 + 4);
#pragma unroll
            for (int ai = 0; ai < 2; ++ai)
#pragma unroll
                for (int m = 0; m < 4; ++m) xo[bj][ai][m] = *(const u32x4*)(X + (size_t)(u.pm * 256 + ai * 128 + wr * 64 + m * 16 + fr) * 1024 + col0 + bj * 128);
        }
#pragma unroll
        for (int bj = 0; bj < 2; ++bj)
#pragma unroll
            for (int ai = 0; ai < 2; ++ai)
#pragma unroll
                for (int m = 0; m < 4; ++m) {
                    bf16* p = X + (size_t)(u.pm * 256 + ai * 128 + wr * 64 + m * 16 + fr) * 1024 + col0 + bj * 128;
                    const u32x4 xw = xo[bj][ai][m];
                    const f32x4 x0 = (f32x4){bflo(xw.x), bfhi(xw.x), bflo(xw.y), bfhi(xw.y)} + gt[bj][0] * acc[ai][bj][m][0];
                    const f32x4 x1 = (f32x4){bflo(xw.z), bfhi(xw.z), bflo(xw.w), bfhi(xw.w)} + gt[bj][1] * acc[ai][bj][m][1];
                    u32x4 w; w.x = pk2(x0[0], x0[1]); w.y = pk2(x0[2], x0[3]); w.z = pk2(x1[0], x1[1]); w.w = pk2(x1[2], x1[3]);
                    *(u32x4*)((char*)p + dofs) = w;
                }
    }
};
struct EpiMoe1 {
    static constexpr bool PERM = true, PERM2 = true, AFTER_DRAIN = false; static constexpr int A_E8M0 = H8_E8M0;
    static constexpr bool ACC_BIAS = true;
    bf16* ACT; const float* B1;
    DI void bias(const Unit& u, int wc, int fq, f32x4 (&bv)[2][2]) const {
        const float* bp = B1 + (size_t)u.e * 2048 + u.pn * 256 + wc * 64 + 16 * fq;
#pragma unroll
        for (int bj = 0; bj < 2; ++bj) { bv[bj][0] = *(const f32x4*)(bp + 8 * bj); bv[bj][1] = *(const f32x4*)(bp + 8 * bj + 4); }
    }
    DI void operator()(const AccT& acc, const Unit& u, int wr, int wc, int fr, int fq) const {
        const int col = u.pn * 256 + wc * 64 + 16 * fq;
#pragma unroll
        for (int ai = 0; ai < 2; ++ai)
#pragma unroll
            for (int m = 0; m < 4; ++m) {
                const int row = u.pm * 256 + ai * 128 + wr * 64 + m * 16 + fr;
                float o[8];
#pragma unroll
                for (int bj = 0; bj < 2; ++bj) {
                    const f32x4 v0 = acc[ai][bj][m][0], v1 = acc[ai][bj][m][1];
#pragma unroll
                    for (int j = 0; j < 4; ++j) {
                        const float gl = fminf((j < 2) ? v0[2 * j] : v1[2 * j - 4], 7.0f);
                        const float li = fminf(fmaxf((j < 2) ? v0[2 * j + 1] : v1[2 * j - 3], -7.0f), 7.0f);
                        o[4 * bj + j] = gl * sigmoidf_(1.702f * gl) * (li + 1.0f);
                    }
                }
                u32x2 w8; w8.x = pk4_fp8s(o[0], o[1], o[2], o[3], A8_SCALE); w8.y = pk4_fp8s(o[4], o[5], o[6], o[7], A8_SCALE);
                *(u32x2*)((unsigned char*)ACT + (size_t)row * 1024 + (col >> 1)) = w8;
            }
    }
};
struct EpiMoe2 {
    static constexpr bool PERM = true, PERM2 = true, AFTER_DRAIN = false; static constexpr int A_E8M0 = A8_E8M0;
    static constexpr bool ACC_BIAS = true;
    unsigned char* Y2; const float* B2;
    DI void bias(const Unit& u, int wc, int fq, f32x4 (&bv)[2][2]) const {
        const float* bp = B2 + (size_t)u.e * 1024 + u.pn * 256 + wc * 64 + 16 * fq;
#pragma unroll
        for (int bj = 0; bj < 2; ++bj) { bv[bj][0] = *(const f32x4*)(bp + 8 * bj); bv[bj][1] = *(const f32x4*)(bp + 8 * bj + 4); }
    }
    DI void operator()(const AccT& acc, const Unit& u, int wr, int wc, int fr, int fq) const {
        const int col = u.pn * 256 + wc * 64 + 16 * fq;
#pragma unroll
        for (int ai = 0; ai < 2; ++ai)
#pragma unroll
            for (int m = 0; m < 4; ++m) {
                const size_t row = (size_t)u.pm * 256 + ai * 128 + wr * 64 + m * 16 + fr;
                u32x4 w8;
                { const f32x4 v0 = acc[ai][0][m][0], v1 = acc[ai][0][m][1]; w8.x = pk4_fp8(v0[0], v0[1], v0[2], v0[3]); w8.y = pk4_fp8(v1[0], v1[1], v1[2], v1[3]); }
                { const f32x4 v0 = acc[ai][1][m][0], v1 = acc[ai][1][m][1]; w8.z = pk4_fp8(v0[0], v0[1], v0[2], v0[3]); w8.w = pk4_fp8(v1[0], v1[1], v1[2], v1[3]); }
                *(u32x4*)(Y2 + row * 1024 + col) = w8;
            }
    }
};

#define MFMA32(a, b, c) __builtin_amdgcn_mfma_f32_32x32x16_bf16((a), (b), (c), 0, 0, 0)
typedef short v4i16_t __attribute__((ext_vector_type(4)));
DI s16x4 tr_read(const LAS unsigned char* p) { return __builtin_bit_cast(s16x4, __builtin_amdgcn_ds_read_tr16_b64_v4i16((LAS v4i16_t*)p)); }
constexpr int VST = 144;
template <int DQ> struct AC { static constexpr int KST = DQ * 2 + 16, KS = DQ / 16, KBUF = 64 * KST, VBUF = 64 * VST, BUF = KBUF + VBUF; };

template <int DQ>
DI void qk_tile(const LAS unsigned char* kb, const bf16x8 (&qf)[DQ / 16], f32x16 (&s)[2], const f32x16& cinit, int lane) {
    const int r32 = lane & 31, hh = lane >> 5;
    bf16x8 kf[2][DQ / 16];
#pragma unroll
    for (int rt = 0; rt < 2; ++rt)
#pragma unroll
        for (int ks = 0; ks < DQ / 16; ++ks) kf[rt][ks] = *(const LAS bf16x8*)(kb + (32 * rt + r32) * AC<DQ>::KST + (16 * ks + 8 * hh) * 2);
    f32x16 a0 = MFMA32(kf[0][0], qf[0], cinit), a1 = MFMA32(kf[1][0], qf[0], cinit);
#pragma unroll
    for (int ks = 1; ks < DQ / 16; ++ks) { a0 = MFMA32(kf[0][ks], qf[ks], a0); a1 = MFMA32(kf[1][ks], qf[ks], a1); }
    s[0] = a0; s[1] = a1;
}
DI float max3f_(float a, float b, float c) { return __builtin_fmaxf(__builtin_fmaxf(a, b), c); }
constexpr float RESC_THR = 8.0f;
template <int DQ, int KMUL, int VAR = 0>
DI void attn_tile(const LAS unsigned char* kb, const LAS unsigned char* vb, const bf16x8 (&qf)[DQ / 16], f32x16 (&o)[2], f32x16& negm, float& m, float& l,
                  int dq, unsigned maxd, bool lf, int lane, const bool MASKED) {
    const int hh = lane >> 5;
    if (VAR == 1) return;
    f32x16 s[2];
    qk_tile<DQ>(kb, qf, s, negm, lane);
    if (VAR == 2) { o[0] += s[0]; o[1] += s[1]; return; }
    const int i16 = lane & 15, q = i16 >> 2, p_ = i16 & 3, mh = (lane >> 4) & 1;
    const LAS unsigned char* vbase = vb + (4 * hh + q) * VST + 32 * mh + 8 * p_;
    s16x4 vlo[4][2], vhi[4][2];
#pragma unroll
    for (int st = 0; st < 4; ++st)
#pragma unroll
        for (int mt = 0; mt < 2; ++mt) { vlo[st][mt] = tr_read(vbase + (16 * st) * VST + 64 * mt); vhi[st][mt] = tr_read(vbase + (16 * st + 8) * VST + 64 * mt); }
    __builtin_amdgcn_sched_barrier(0);
    if (MASKED) {
#pragma unroll
        for (int rt = 0; rt < 2; ++rt)
#pragma unroll
            for (int i = 0; i < 16; ++i) {
                const int d = dq - (32 * rt + 8 * (i >> 2) + (i & 3)) * KMUL;
                s[rt][i] = ((unsigned)d <= maxd) ? s[rt][i] : -1e30f;
            }
    }
    float mx = max3f_(s[0][0], s[0][1], s[0][2]);
#pragma unroll
    for (int i = 3; i < 15; i += 2) mx = max3f_(mx, s[0][i], s[0][i + 1]);
    mx = max3f_(mx, s[0][15], s[1][0]);
#pragma unroll
    for (int i = 1; i < 15; i += 2) mx = max3f_(mx, s[1][i], s[1][i + 1]);
    mx = fmaxf(mx, s[1][15]);
    if (__ballot(lf && mx > RESC_THR) != 0ull) {
        float mc = lf ? mx : -1e30f;
        mc = fmaxf(mc, __shfl_xor(mc, 32));
        const float delta = mc > RESC_THR ? mc : 0.f;
        const float alpha = fast_exp2(-delta);
        m += delta; l *= alpha;
#pragma unroll
        for (int i = 0; i < 16; ++i) { negm[i] = -m; o[0][i] *= alpha; o[1][i] *= alpha; s[0][i] -= delta; s[1][i] -= delta; }
    }
    float ps = 0.f;
#pragma unroll
    for (int rt = 0; rt < 2; ++rt)
#pragma unroll
        for (int i = 0; i < 16; ++i) { const float p = fast_exp2(s[rt][i]); s[rt][i] = p; ps += p; }
    const unsigned lmask = lf ? 0xffffffffu : 0u;
    l += lf ? ps : 0.f;
    if (VAR == 3) { o[0] += s[0]; o[1] += s[1]; return; }
#pragma unroll
    for (int rt = 0; rt < 2; ++rt)
#pragma unroll
        for (int s2 = 0; s2 < 2; ++s2) {
            u32x4 pw; pw.x = pk2(s[rt][8 * s2 + 0], s[rt][8 * s2 + 1]) & lmask; pw.y = pk2(s[rt][8 * s2 + 2], s[rt][8 * s2 + 3]) & lmask;
            pw.z = pk2(s[rt][8 * s2 + 4], s[rt][8 * s2 + 5]) & lmask; pw.w = pk2(s[rt][8 * s2 + 6], s[rt][8 * s2 + 7]) & lmask;
            const bf16x8 pb = __builtin_bit_cast(bf16x8, pw);
#pragma unroll
            for (int mt = 0; mt < 2; ++mt) {
                const bf16x8 va = __builtin_shufflevector(vlo[2 * rt + s2][mt], vhi[2 * rt + s2][mt], 0, 1, 2, 3, 4, 5, 6, 7);
                o[mt] = MFMA32(va, pb, o[mt]);
            }
        }
}
constexpr int OSTAGE_WAVE = 32 * 144;
static_assert(102400 + 8 * OSTAGE_WAVE <= MISC_OFF, "O stage below the LDS control words");
struct ChunkId { DI u32x4 operator()(u32x4 v, int, int, int) const { return v; } };
template <class P, class Fx = ChunkId>
DI void store_o_rows(const P& p, LAS unsigned char* lds, int off, const f32x16 (&o)[2], float inv, int lane, int wave, const Fx& fx = Fx()) {
    LAS unsigned char* st = lds + off + wave * OSTAGE_WAVE;
    const int n = lane & 31, hh = lane >> 5;
#pragma unroll
    for (int mt = 0; mt < 2; ++mt)
#pragma unroll
        for (int a = 0; a < 4; ++a) {
            u32x2 w; w.x = pk2(o[mt][4 * a] * inv, o[mt][4 * a + 1] * inv); w.y = pk2(o[mt][4 * a + 2] * inv, o[mt][4 * a + 3] * inv);
            *(LAS u32x2*)(st + n * 144 + (32 * mt + 8 * a + 4 * hh) * 2) = w;
        }
    asm volatile("s_waitcnt lgkmcnt(0)" ::: "memory");
#pragma unroll
    for (int it = 0; it < 4; ++it) {
        const int r = (lane >> 3) + 8 * it, c = lane & 7;
        const u32x4 v = fx(*(const LAS u32x4*)(st + r * 144 + c * 16), wave, r, c);
        *(u32x4*)(p.orow(wave, r) + 8 * c) = v;
    }
}
DI void store_o(bf16* orow, const f32x16 (&o)[2], float inv, int lane) {
    const int hh = lane >> 5;
#pragma unroll
    for (int mt = 0; mt < 2; ++mt)
#pragma unroll
        for (int a = 0; a < 4; ++a) {
            u32x2 w; w.x = pk2(o[mt][4 * a] * inv, o[mt][4 * a + 1] * inv); w.y = pk2(o[mt][4 * a + 2] * inv, o[mt][4 * a + 3] * inv);
            *(u32x2*)(orow + 32 * mt + 8 * a + 4 * hh) = w;
        }
}

struct PolA {
    static constexpr bool HASFLAG = false, LSE = true; static constexpr int KMUL = 1;
    const bf16 *Q, *K, *V; bf16* O; float* LSEP; int b, h, d, r, c; unsigned maxd; int j0, j1;
    DI int ql(int w, int lane) const { return 256 * c + 32 * w + (lane & 31); }
    DI size_t trow(int l_) const { return (size_t)b * S + (size_t)l_ * d + r; }
    DI const bf16* qrow(int w, int lane) const { return Q + trow(ql(w, lane)) * 256 + h * 64; }
    DI int qv(int w, int lane) const { return ql(w, lane); }
    DI int qmin(int w) const { return 256 * c + 32 * w; }
    DI int qmax(int w) const { return 256 * c + 32 * w + 31; }
    DI int kv0(int j) const { return 256 * c - 128 + 64 * j; }
    DI const bf16* krow(int j, int row) const { return K + trow(kv0(j) + row) * 256 + h * 64; }
    DI const bf16* vrow(int j, int row) const { return V + trow(kv0(j) + row) * 256 + h * 64; }
    DI const bf16* rrow(int, int) const { return nullptr; }
    DI bool flag(int, int, int) const { return true; }
    DI bf16* orow(int w, int lane) const { return O + trow(ql(w, lane)) * 256 + h * 64; }
    DI void lse(int w, int lane, float v) const { LSEP[trow(ql(w, lane)) * 4 + h] = v; }
};
struct PolB {
    static constexpr bool LSE = false; static constexpr int KMUL = 1;
    const bf16 *Q, *K, *V; bf16* O; int b, g, qc; unsigned maxd; int j0, j1; u64 sel; bool hasflag;
    const bf16 *GC = nullptr, *GW = nullptr, *GM = nullptr;
    DI int tok(int w, int lane) const { return 64 * qc + 8 * w + ((lane & 31) >> 2); }
    DI const bf16* qrow(int w, int lane) const { return Q + ((size_t)b * S + tok(w, lane)) * 512 + (4 * g + (lane & 3)) * 64; }
    DI int qv(int w, int lane) const { return tok(w, lane); }
    DI int qmin(int w) const { return 64 * qc + 8 * w; }
    DI int qmax(int w) const { return 64 * qc + 8 * w + 7; }
    DI int kv0(int j) const { return 64 * j; }
    DI const bf16* krow(int j, int row) const { return K + ((size_t)b * S + 64 * j + row) * 128 + g * 64; }
    DI const bf16* vrow(int j, int row) const { return V + ((size_t)b * S + 64 * j + row) * 128 + g * 64; }
    DI const bf16* rrow(int, int) const { return nullptr; }
    DI bf16* orow(int w, int lane) const { return O + ((size_t)b * S + tok(w, lane)) * 512 + (4 * g + (lane & 3)) * 64; }
    DI void lse(int, int, float) const {}
};
struct PolM {
    static constexpr bool HASFLAG = false, LSE = false; static constexpr int KMUL = 1;
    const bf16 *Q, *KN, *KR, *V; bf16* O; int b, h, c; unsigned maxd; int j0, j1;
    DI int tok(int w, int lane) const { return 256 * c + 32 * w + (lane & 31); }
    DI const bf16* qrow(int w, int lane) const { return Q + ((size_t)b * S + tok(w, lane)) * 384 + h * 96; }
    DI int qv(int w, int lane) const { return tok(w, lane); }
    DI int qmin(int w) const { return 256 * c + 32 * w; }
    DI int qmax(int w) const { return 256 * c + 32 * w + 31; }
    DI int kv0(int j) const { return 64 * j; }
    DI const bf16* krow(int j, int row) const { return KN + ((size_t)b * S + 64 * j + row) * 256 + h * 64; }
    DI const bf16* vrow(int j, int row) const { return V + ((size_t)b * S + 64 * j + row) * 256 + h * 64; }
    DI const bf16* rrow(int j, int row) const { return KR + ((size_t)b * S + 64 * j + row) * 32; }
    DI bf16* orow(int w, int lane) const { return O + ((size_t)b * S + tok(w, lane)) * 256 + h * 64; }
    DI void lse(int, int, float) const {}
};

template <int DQ, class P, bool FLAG, int VAR = 0>
DI void attn_unit(const P& p, LAS unsigned char* lds, int tid, int lane, int wave, u64 sel) {
    typedef AC<DQ> C;
    const int hh = lane >> 5;
    const bf16* qrow = p.qrow(wave, lane);
    bf16x8 qf[DQ / 16];
#pragma unroll
    for (int ks = 0; ks < DQ / 16; ++ks) qf[ks] = *(const bf16x8*)(qrow + 16 * ks + 8 * hh);
#pragma unroll
    for (int ks = 0; ks < DQ / 16; ++ks) asm volatile("s_waitcnt vmcnt(0)" : "+v"(qf[ks]) :: "memory");
    const int qv = p.qv(wave, lane), wq0 = p.qmin(wave), wq1 = p.qmax(wave);
    f32x16 o[2];
#pragma unroll
    for (int mt = 0; mt < 2; ++mt)
#pragma unroll
        for (int i = 0; i < 16; ++i) o[mt][i] = 0.f;
    float m = 0.f, l = 0.f;
    f32x16 negm;
#pragma unroll
    for (int i = 0; i < 16; ++i) negm[i] = 0.f;
    const int j0 = p.j0, j1 = p.j1;
    const int lrow = tid >> 3, lch = tid & 7;
    u32x4 k0A, v0A, r0A = {0u, 0u, 0u, 0u}, k1A, v1A, r1A = {0u, 0u, 0u, 0u}, k0B, v0B, r0B = {0u, 0u, 0u, 0u}, k1B, v1B, r1B = {0u, 0u, 0u, 0u};
    constexpr int NLD = (DQ == 96) ? 6 : 4;
    const int npair = (j1 - j0 + 1) >> 1;
#define ATT_LOAD1(RK, RV, RR, j) do { const bf16* pk_ = p.krow((j), lrow) + 8 * lch; const bf16* pv_ = p.vrow((j), lrow) + 8 * lch; \
        asm volatile("global_load_dwordx4 %0, %2, off\n\tglobal_load_dwordx4 %1, %3, off" : "=&v"(RK), "=&v"(RV) : "v"(pk_), "v"(pv_) : "memory"); \
        if (DQ == 96) { const bf16* pr_ = p.rrow((j), (tid & 255) >> 2) + 8 * (tid & 3); asm volatile("global_load_dwordx4 %0, %1, off" : "=&v"(RR) : "v"(pr_) : "memory"); } } while (0)
#define ATT_LOADP(K0, V0, R0, K1, V1, R1, t) do { const int ja_ = j0 + 2 * (t), jb_ = ja_ + 1; \
        { const int jc_ = ja_ < j1 ? ja_ : j1 - 1; ATT_LOAD1(K0, V0, R0, jc_); } { const int jd_ = jb_ < j1 ? jb_ : j1 - 1; ATT_LOAD1(K1, V1, R1, jd_); } } while (0)
#define ATT_TILE(kb_, jt_) do { const int j_ = (jt_); const int kv0 = p.kv0(j_); \
        bool need = (j_ < j1) && (wq1 - kv0 >= 0) && ((long long)wq0 - (long long)(kv0 + 63 * P::KMUL) <= (long long)p.maxd); \
        const bool interior = (wq0 - (kv0 + 63 * P::KMUL) >= 0) && ((long long)wq1 - (long long)kv0 <= (long long)p.maxd); \
        bool lf = true; \
        if (FLAG) { lf = ((sel >> j_) & 1ull) != 0ull; need = need && (__ballot(lf) != 0ull); } \
        if (need) attn_tile<DQ, P::KMUL, VAR>((kb_), (kb_) + C::KBUF, qf, o, negm, m, l, qv - kv0 - 4 * hh * P::KMUL, p.maxd, lf, lane, !interior); } while (0)
#define ATT_STEP(K0, V0, R0, K1, V1, R1, tt) do { const int t_ = (tt); \
        LAS unsigned char* pbuf = lds + (t_ & 1) * (2 * C::BUF); \
        asm volatile("s_waitcnt vmcnt(%6)" : "+v"(K0), "+v"(V0), "+v"(R0), "+v"(K1), "+v"(V1), "+v"(R1) : "n"(NLD) : "memory"); \
        *(LAS u32x4*)(pbuf + lrow * C::KST + lch * 16) = K0; *(LAS u32x4*)(pbuf + C::KBUF + lrow * VST + lch * 16) = V0; \
        *(LAS u32x4*)(pbuf + C::BUF + lrow * C::KST + lch * 16) = K1; *(LAS u32x4*)(pbuf + C::BUF + C::KBUF + lrow * VST + lch * 16) = V1; \
        if (DQ == 96) { *(LAS u32x4*)(pbuf + ((tid & 255) >> 2) * C::KST + 128 + (tid & 3) * 16) = R0; *(LAS u32x4*)(pbuf + C::BUF + ((tid & 255) >> 2) * C::KST + 128 + (tid & 3) * 16) = R1; } \
        asm volatile("s_waitcnt lgkmcnt(0)\n\ts_barrier" ::: "memory"); \
        ATT_LOADP(K0, V0, R0, K1, V1, R1, t_ + 2); \
        if (ATT_STAGGER > 0 && wave >= 4) __builtin_amdgcn_s_sleep(ATT_STAGGER); \
        ATT_TILE(pbuf, j0 + 2 * t_); ATT_TILE(pbuf + C::BUF, j0 + 2 * t_ + 1); } while (0)
    ATT_LOADP(k0A, v0A, r0A, k1A, v1A, r1A, 0);
    ATT_LOADP(k0B, v0B, r0B, k1B, v1B, r1B, 1);
    if (wave >= 4) __builtin_amdgcn_s_setprio(1);
#pragma unroll 1
    for (int t = 0; t < npair; t += 2) {
        ATT_STEP(k0A, v0A, r0A, k1A, v1A, r1A, t);
        ATT_STEP(k0B, v0B, r0B, k1B, v1B, r1B, t + 1);
    }
    __builtin_amdgcn_s_setprio(0);
    asm volatile("s_waitcnt vmcnt(0)" : "+v"(k0A), "+v"(v0A), "+v"(r0A), "+v"(k1A), "+v"(v1A), "+v"(r1A), "+v"(k0B), "+v"(v0B), "+v"(r0B), "+v"(k1B), "+v"(v1B), "+v"(r1B) :: "memory");
#undef ATT_LOAD1
#undef ATT_LOADP
#undef ATT_TILE
#undef ATT_STEP
    const float lt = l + __shfl_xor(l, 32);
    const float inv = lt > 0.f ? 1.0f / lt : 0.f;
    if constexpr (FLAG) {
        struct Gate { const P& p;
            DI u32x4 operator()(u32x4 v, int w_, int r, int c) const {
                const size_t tg = (size_t)p.b * S + 64 * p.qc + 8 * w_ + (r >> 2); const int hd = 4 * p.g + (r & 3);
                const bf16* gl = p.GM + tg * 256 + 160 + hd * 3;
                const float g0 = sigmoidf_(bf2f(gl[0])), g1 = sigmoidf_(bf2f(gl[1])), g2 = sigmoidf_(bf2f(gl[2]));
                const u32x4 a = *(const u32x4*)(p.GC + tg * 512 + hd * 64 + 8 * c), d = *(const u32x4*)(p.GW + tg * 512 + hd * 64 + 8 * c);
                u32x4 r_;
                r_.x = pk2(g0 * bflo(a.x) + g1 * bflo(v.x) + g2 * bflo(d.x), g0 * bfhi(a.x) + g1 * bfhi(v.x) + g2 * bfhi(d.x));
                r_.y = pk2(g0 * bflo(a.y) + g1 * bflo(v.y) + g2 * bflo(d.y), g0 * bfhi(a.y) + g1 * bfhi(v.y) + g2 * bfhi(d.y));
                r_.z = pk2(g0 * bflo(a.z) + g1 * bflo(v.z) + g2 * bflo(d.z), g0 * bfhi(a.z) + g1 * bfhi(v.z) + g2 * bfhi(d.z));
                r_.w = pk2(g0 * bflo(a.w) + g1 * bflo(v.w) + g2 * bflo(d.w), g0 * bfhi(a.w) + g1 * bfhi(v.w) + g2 * bfhi(d.w));
                return r_; } } gate{p};
        store_o_rows(p, lds, 90112, o, inv, lane, wave, gate);
    } else store_o_rows(p, lds, DQ == 96 ? 102400 : 90112, o, inv, lane, wave);
    if (P::LSE) { if (hh == 0) p.lse(wave, lane, m + __log2f(lt)); }
    __syncthreads();
}

DI u64 cmp_unit(const Ctx& F, int b, int g, int qc) {
    constexpr int KST = 144;
    LAS unsigned char* KL = F.lds; LAS unsigned char* VL = F.lds + 256 * KST; LAS float* IMP = (LAS float*)(F.lds + 2 * 256 * KST);
    const bf16* KC = (const bf16*)(F.ws + WS_KC) + (size_t)(b * 2 + g) * 256 * 64;
    const bf16* VC = (const bf16*)(F.ws + WS_VC) + (size_t)(b * 2 + g) * 256 * 64;
    const int tid = F.tid, lane = F.lane, w = F.wave, hh = lane >> 5, r32 = lane & 31;
    const int tokl = 8 * w + (r32 >> 2), tok = 64 * qc + tokl, head = 4 * g + (lane & 3);
    const bf16* qrow = (const bf16*)(F.ws + WS_QB) + ((size_t)b * S + tok) * 512 + head * 64;
    bf16x8 qf[4];
#pragma unroll
    for (int ks = 0; ks < 4; ++ks) qf[ks] = *(const bf16x8*)(qrow + 16 * ks + 8 * hh);
#pragma unroll
    for (int it = 0; it < 4; ++it) { const int idx = tid + 512 * it, row = idx >> 3, ch = idx & 7;
        *(LAS u32x4*)(KL + row * KST + ch * 16) = *(const u32x4*)(KC + row * 64 + ch * 8);
        *(LAS u32x4*)(VL + row * VST + ch * 16) = *(const u32x4*)(VC + row * 64 + ch * 8); }
    __syncthreads();
    const int qv = tok - 31, wq1 = 64 * qc + 8 * w + 7 - 31;
    f32x16 o[2];
#pragma unroll
    for (int mt = 0; mt < 2; ++mt)
#pragma unroll
        for (int i = 0; i < 16; ++i) o[mt][i] = 0.f;
    float m = 0.f, l = 0.f;
    f32x16 negm;
#pragma unroll
    for (int i = 0; i < 16; ++i) negm[i] = 0.f;
    const int wq0 = 64 * qc + 8 * w - 31;
#pragma unroll 1
    for (int jt = 0; jt < 4; ++jt) {
        if (wq1 - 1024 * jt >= 0) {
            const int dq = qv - 1024 * jt - 4 * hh * 16;
            attn_tile<64, 16>(KL + jt * 64 * KST, VL + jt * 64 * VST, qf, o, negm, m, l, dq, 0x7fffffffu, true, lane, !(wq0 - (1024 * jt + 63 * 16) >= 0));
        }
    }
    const float lt = l + __shfl_xor(l, 32);
    const float inv = lt > 0.f ? 1.0f / lt : 0.f;
    { struct { bf16* O; int b, g, qc; DI bf16* orow(int w_, int n_) const { return O + ((size_t)b * S + 64 * qc + 8 * w_ + (n_ >> 2)) * 512 + (4 * g + (n_ & 3)) * 64; } } pc{(bf16*)(F.ws + WS_OCMP), b, g, qc};
      store_o_rows(pc, F.lds, 90112, o, inv, lane, w); }
    float prev = 0.f;
#pragma unroll 1
    for (int jt = 0; jt < 4; ++jt) {
        const bool need = (wq1 - 1024 * jt >= 0);
        f32x16 s[2];
        if (need) qk_tile<64>(KL + jt * 64 * KST, qf, s, negm, lane);
#pragma unroll
        for (int rt = 0; rt < 2; ++rt)
#pragma unroll
            for (int a = 0; a < 4; ++a) {
                float mainp = 0.f, sp = 0.f;
                if (need) {
                    float pb[4];
#pragma unroll
                    for (int bb = 0; bb < 4; ++bb) { const int kidx = 64 * jt + 32 * rt + 8 * a + 4 * hh + bb; const bool ok = (qv - 16 * kidx) >= 0; pb[bb] = ok ? fast_exp2(s[rt][4 * a + bb]) * inv : 0.f; }
                    mainp = pb[0] + pb[1] + pb[2] + 0.5f * pb[3]; sp = 0.5f * pb[3];
                }
                const float rc = __shfl_xor(sp, 32);
                float v = mainp + (hh ? rc : prev);
                prev = rc;
                v += __shfl_xor(v, 1); v += __shfl_xor(v, 2);
                if ((lane & 3) == 0) IMP[tokl * 64 + 2 * (8 * jt + 4 * rt + a) + hh] = v;
            }
    }
    __syncthreads();
    u64 mysel = 0ull;
#pragma unroll 1
    for (int tk = 0; tk < 8; ++tk) {
        const int tl = 8 * w + tk, t = 64 * qc + tl, j = lane;
        const float v = IMP[tl * 64 + j];
        const bool forced = (j == 0) || (j == qc) || (j == qc - 1);
        const bool valid = j <= qc;
        const float score = forced ? v + 1e4f : (valid ? v : -1.0f);
        int rank = 0;
#pragma unroll
        for (int jp = 0; jp < 64; ++jp) { const float o_ = __builtin_bit_cast(float, __builtin_amdgcn_readlane(__builtin_bit_cast(int, score), jp)); rank += ((o_ > score) || (o_ == score && jp < j)) ? 1 : 0; }
        const u64 mask = __ballot(rank < 16);
        (void)t;
        if (tk == (r32 >> 2)) mysel = mask;
    }
    __syncthreads();
    return mysel;
}

DI void moe_tables(const Ctx& F, int l) {
    LAS int* tb = (LAS int*)(F.lds + AUX_OFF); LAS int* cn = tb + 64;
    if (F.tid == 0) {
        const unsigned* C = (const unsigned*)(F.ws + WS_CTL) + CW_CNT + l * 32 * 64;
        int acc = 0;
        for (int e = 0; e < 32; ++e) { const int c = (int)__hip_atomic_load(C + e * 64, RLX_AGENT); tb[e] = acc; cn[e] = c; acc += (c + 255) >> 8; }
        tb[32] = acc;
    }
    __syncthreads();
}
template <int MODE>
DI void phase_norm1(const Ctx& F, int l) {
    const float* mods = (const float*)(F.ws + WS_MODS);
    const bf16* X = (const bf16*)(F.ws + WS_X); bf16* H = (bf16*)(F.ws + F.dofs + WS_H); bf16* XW = (bf16*)(F.ws + F.dofs + WS_X);
    const LAS int* tb = (const LAS int*)(F.lds + AUX_OFF);
    if (l > 0) moe_tables(F, l - 1);
    const int gw = F.blk * 8 + F.wave, NGW = F.G * 8, lane = F.lane;
    for (int tok = gw; tok < T; tok += NGW) {
        const int b = tok >> 12;
        f32x4 v[4];
        if (l == 0) { const float* xr = ginp(F, I_X) + (size_t)tok * 1024;
#pragma unroll
            for (int k = 0; k < 4; ++k) v[k] = *(const f32x4*)(xr + 4 * lane + 256 * k);
        } else { const bf16* xr = X + (size_t)tok * 1024;
#pragma unroll
            for (int k = 0; k < 4; ++k) { const u32x2 w = *(const u32x2*)(xr + 4 * lane + 256 * k); v[k] = (f32x4){bflo(w.x), bfhi(w.x), bflo(w.y), bfhi(w.y)}; }
        }
        if (l > 0) {
            f32x4 y[4];
#pragma unroll
            for (int k = 0; k < 4; ++k) y[k] = (f32x4){0.f, 0.f, 0.f, 0.f};
            const int* ts = (const int*)(F.ws + WS_TOKSLOT) + (size_t)tok * 4;
            const f32x4 tg = *(const f32x4*)((const float*)(F.ws + WS_TOKG) + (size_t)tok * 4) * Y2_ISCALE;
#pragma unroll
            for (int s = 0; s < 4; ++s) {
                const int pk = ts[s]; const int e = pk >> 16, pos = pk & 0xffff;
                const unsigned char* yr = (const unsigned char*)(F.ws + WS_Y2) + ((size_t)tb[e] * 256 + pos) * 1024;
#pragma unroll
                for (int k = 0; k < 4; ++k) { const unsigned w = *(const unsigned*)(yr + 4 * lane + 256 * k); y[k] += unpk4_fp8(w) * tg[s]; }
            }
            const float* gt2 = mods + ((size_t)((l - 1) * 8 + b) * 6 + 5) * 1024;
#pragma unroll
            for (int k = 0; k < 4; ++k) v[k] = v[k] + *(const f32x4*)(gt2 + 4 * lane + 256 * k) * y[k];
        }
        float ss = 0.f;
#pragma unroll
        for (int k = 0; k < 4; ++k) ss += v[k][0] * v[k][0] + v[k][1] * v[k][1] + v[k][2] * v[k][2] + v[k][3] * v[k][3];
        const float rstd = rsqrtf(wave_sum(ss) * (1.0f / 1024.0f) + EPS);
        if (MODE == 0) {
            const float* g1 = ginp(F, I_G1) + (size_t)l * 1024;
            const float* sh = mods + ((size_t)(l * 8 + b) * 6 + 0) * 1024; const float* sc = sh + 1024;
#pragma unroll
            for (int k = 0; k < 4; ++k) {
                const int c = 4 * lane + 256 * k;
                { u32x2 xw; xw.x = pk2(v[k][0], v[k][1]); xw.y = pk2(v[k][2], v[k][3]); *(u32x2*)(XW + (size_t)tok * 1024 + c) = xw; }
                const f32x4 hv = v[k] * rstd * *(const f32x4*)(g1 + c) * (*(const f32x4*)(sc + c) + 1.0f) + *(const f32x4*)(sh + c);
                u32x2 w; w.x = pk2(hv[0], hv[1]); w.y = pk2(hv[2], hv[3]);
                *(u32x2*)(H + (size_t)tok * 1024 + c) = w;
            }
        } else {
            const float* gf = ginp(F, I_GF);
#pragma unroll
            for (int k = 0; k < 4; ++k) { const int c = 4 * lane + 256 * k; *(f32x4*)(gout(F) + (size_t)tok * 1024 + c) = v[k] * rstd * *(const f32x4*)(gf + c); }
        }
    }
}
DI void phase_prep(const Ctx& F) {
    const bf16* CQ = (const bf16*)(F.ws + WS_CQ); const bf16* MISC = (const bf16*)(F.ws + WS_MISC);
    float* RQ = (float*)(F.ws + WS_RSTDQ); float* RKV = (float*)(F.ws + WS_RSTDKV);
    bf16* KR = (bf16*)(F.ws + WS_KR); float* GATES = (float*)(F.ws + WS_GATES); const float* CS32 = (const float*)(F.ws + WS_CS32);
    const int gw = F.blk * 8 + F.wave, NGW = F.G * 8, lane = F.lane;
    for (int tok = gw; tok < T; tok += NGW) {
        const u32x2 wq = *(const u32x2*)(CQ + (size_t)tok * 256 + 4 * lane);
        const u32x2 wm = *(const u32x2*)(MISC + (size_t)tok * 256 + 4 * lane);
        float a0 = bflo(wq.x), a1 = bfhi(wq.x), a2 = bflo(wq.y), a3 = bfhi(wq.y);
        const float sq = wave_sum(a0 * a0 + a1 * a1 + a2 * a2 + a3 * a3);
        float m0 = bflo(wm.x), m1 = bfhi(wm.x), m2 = bflo(wm.y), m3 = bfhi(wm.y);
        const float skv = wave_sum(lane < 32 ? (m0 * m0 + m1 * m1 + m2 * m2 + m3 * m3) : 0.f);
        if (lane == 0) { RQ[tok] = rsqrtf(sq * (1.0f / 256.0f) + EPS); RKV[tok] = rsqrtf(skv * (1.0f / 128.0f) + EPS); }
        const float p0 = __shfl_xor(m0, 4), p1 = __shfl_xor(m1, 4), p2 = __shfl_xor(m2, 4), p3 = __shfl_xor(m3, 4);
        if (lane >= 32 && lane < 36) {
            const int i0 = 4 * (lane - 32);
            const f32x4 c4 = *(const f32x4*)(CS32 + (size_t)tok * 32 + i0), s4 = *(const f32x4*)(CS32 + (size_t)tok * 32 + 16 + i0);
            u32x4 w;
            w.x = pk2(m0 * c4[0] - p0 * s4[0], p0 * c4[0] + m0 * s4[0]); w.y = pk2(m1 * c4[1] - p1 * s4[1], p1 * c4[1] + m1 * s4[1]);
            w.z = pk2(m2 * c4[2] - p2 * s4[2], p2 * c4[2] + m2 * s4[2]); w.w = pk2(m3 * c4[3] - p3 * s4[3], p3 * c4[3] + m3 * s4[3]);
            *(u32x4*)(KR + (size_t)tok * 32 + 2 * i0) = w;
        }
        if (lane >= 40 && lane < 46) {
            const int gi = 4 * (lane - 40);
            *(f32x4*)(GATES + (size_t)tok * 24 + gi) = (f32x4){sigmoidf_(m0), sigmoidf_(m1), sigmoidf_(m2), sigmoidf_(m3)};
        }
    }
}
DI void phase_cmp2(const Ctx& F, int l) {
    const bf16* HID = (const bf16*)(F.ws + WS_HID);
    const float* CS64 = (const float*)(F.ws + WS_CS64);
    const int gw = F.blk * 8 + F.wave, NGW = F.G * 8, lane = F.lane;
    for (int it = gw; it < 8192; it += NGW) {
        const int kv = it >> 12, row = it & 4095, c = row & 255, bg = row >> 8;
        const float* w2 = ginp(F, kv ? I_W2V : I_W2K) + (size_t)l * 256 * 64;
        const float* b2 = ginp(F, kv ? I_B2V : I_B2K) + (size_t)l * 64;
        const u32x2 hw = *(const u32x2*)(HID + ((size_t)kv * 4096 + row) * 256 + 4 * lane);
        const float h0 = bflo(hw.x), h1 = bfhi(hw.x), h2 = bflo(hw.y), h3 = bfhi(hw.y);
        float acc = b2[lane];
#pragma unroll 4
        for (int k4 = 0; k4 < 64; ++k4) {
            const float x0 = __builtin_bit_cast(float, __builtin_amdgcn_readlane(__builtin_bit_cast(int, h0), k4));
            const float x1 = __builtin_bit_cast(float, __builtin_amdgcn_readlane(__builtin_bit_cast(int, h1), k4));
            const float x2 = __builtin_bit_cast(float, __builtin_amdgcn_readlane(__builtin_bit_cast(int, h2), k4));
            const float x3 = __builtin_bit_cast(float, __builtin_amdgcn_readlane(__builtin_bit_cast(int, h3), k4));
            acc += x0 * w2[(4 * k4 + 0) * 64 + lane] + x1 * w2[(4 * k4 + 1) * 64 + lane] + x2 * w2[(4 * k4 + 2) * 64 + lane] + x3 * w2[(4 * k4 + 3) * 64 + lane];
        }
        if (c == 255) acc = 0.f;
        if (kv == 0) {
            const int b = bg >> 1, tokr = b * S + 16 * c + 31;
            const float other = __shfl_xor(acc, 32);
            const int i = lane & 31;
            const float cs = CS64[(size_t)(tokr & (T - 1)) * 64 + i], sn = CS64[(size_t)(tokr & (T - 1)) * 64 + 32 + i];
            const float y = (lane < 32) ? (acc * cs - other * sn) : (acc * cs + other * sn);
            ((bf16*)(F.ws + WS_KC))[(size_t)row * 64 + 2 * i + (lane >> 5)] = (bf16)(pk2(y, 0.f) & 0xffffu);
        } else {
            ((bf16*)(F.ws + WS_VC))[(size_t)row * 64 + lane] = (bf16)(pk2(acc, 0.f) & 0xffffu);
        }
    }
}
DI void phase_mix(const Ctx& F, int l) {
    const bf16* OA3 = (const bf16*)(F.ws + WS_OA3); const float* LSEA = (const float*)(F.ws + WS_LSEA);
    const bf16* OCMP = (const bf16*)(F.ws + WS_OCMP); const bf16* OSLC = (const bf16*)(F.ws + WS_OSLC); const bf16* OWIN = (const bf16*)(F.ws + WS_OWIN);
    const bf16* OC = (const bf16*)(F.ws + WS_OC); const bf16* MISC = (const bf16*)(F.ws + WS_MISC);
    bf16* AMIX = (bf16*)(F.ws + WS_AMIX);
    const float* ga = ginp(F, I_GOA) + (size_t)l * 256; const float* gb = ginp(F, I_GOB) + (size_t)l * 512; const float* gc = ginp(F, I_GOC) + (size_t)l * 256;
    const int gw = F.blk * 8 + F.wave, NGW = F.G * 8, lane = F.lane, ha = lane >> 4;
    for (int tok0 = gw; tok0 < T; tok0 += 2 * NGW) {
        int tok[2]; tok[0] = tok0; tok[1] = (tok0 + NGW < T) ? tok0 + NGW : tok0;
        float ls[2][3]; u32x2 wa[2][3], wb[2][2], wc_[2];
#pragma unroll
        for (int q = 0; q < 2; ++q) {
#pragma unroll
            for (int p = 0; p < 3; ++p) { ls[q][p] = LSEA[((size_t)p * T + tok[q]) * 4 + ha]; wa[q][p] = *(const u32x2*)(OA3 + ((size_t)p * T + tok[q]) * 256 + 4 * lane); }
#pragma unroll
            for (int k = 0; k < 2; ++k) {
                const int col = 256 * k + 4 * lane;
                wb[q][k] = *(const u32x2*)(OSLC + (size_t)tok[q] * 512 + col);
            }
            wc_[q] = *(const u32x2*)(OC + (size_t)tok[q] * 256 + 4 * lane);
        }
        f32x4 va[2], vb[2][2], vc[2]; float red[2][3];
#pragma unroll
        for (int q = 0; q < 2; ++q) {
            const float mx = fmaxf(ls[q][0], fmaxf(ls[q][1], ls[q][2]));
            const float w0 = fast_exp2(ls[q][0] - mx), w1 = fast_exp2(ls[q][1] - mx), w2 = fast_exp2(ls[q][2] - mx), wi = 1.0f / (w0 + w1 + w2);
            va[q] = ((f32x4){bflo(wa[q][0].x), bfhi(wa[q][0].x), bflo(wa[q][0].y), bfhi(wa[q][0].y)} * w0 + (f32x4){bflo(wa[q][1].x), bfhi(wa[q][1].x), bflo(wa[q][1].y), bfhi(wa[q][1].y)} * w1
                   + (f32x4){bflo(wa[q][2].x), bfhi(wa[q][2].x), bflo(wa[q][2].y), bfhi(wa[q][2].y)} * w2) * wi;
            red[q][0] = va[q][0] * va[q][0] + va[q][1] * va[q][1] + va[q][2] * va[q][2] + va[q][3] * va[q][3];
            float sb = 0.f;
#pragma unroll
            for (int k = 0; k < 2; ++k) {
                const u32x2 a = wb[q][k];
                vb[q][k][0] = bflo(a.x); vb[q][k][1] = bfhi(a.x); vb[q][k][2] = bflo(a.y); vb[q][k][3] = bfhi(a.y);
                sb += vb[q][k][0] * vb[q][k][0] + vb[q][k][1] * vb[q][k][1] + vb[q][k][2] * vb[q][k][2] + vb[q][k][3] * vb[q][k][3];
            }
            red[q][1] = sb;
            vc[q] = (f32x4){bflo(wc_[q].x), bfhi(wc_[q].x), bflo(wc_[q].y), bfhi(wc_[q].y)};
            red[q][2] = vc[q][0] * vc[q][0] + vc[q][1] * vc[q][1] + vc[q][2] * vc[q][2] + vc[q][3] * vc[q][3];
        }
#pragma unroll
        for (int q = 0; q < 2; ++q)
#pragma unroll
            for (int j = 0; j < 3; ++j) red[q][j] = wave_sum(red[q][j]);
#pragma unroll
        for (int q = 0; q < 2; ++q) {
            if (q == 1 && tok0 + NGW >= T) break;
            const float ra = rsqrtf(red[q][0] * (1.0f / 256.0f) + EPS), rb = rsqrtf(red[q][1] * (1.0f / 512.0f) + EPS), rc = rsqrtf(red[q][2] * (1.0f / 256.0f) + EPS);
            bf16* orow = AMIX + (size_t)tok[q] * 1024;
            { const f32x4 o = va[q] * ra * *(const f32x4*)(ga + 4 * lane); u32x2 w; w.x = pk2(o[0], o[1]); w.y = pk2(o[2], o[3]); *(u32x2*)(orow + 4 * lane) = w; }
#pragma unroll
            for (int k = 0; k < 2; ++k) { const f32x4 o = vb[q][k] * rb * *(const f32x4*)(gb + 256 * k + 4 * lane); u32x2 w; w.x = pk2(o[0], o[1]); w.y = pk2(o[2], o[3]); *(u32x2*)(orow + 256 + 256 * k + 4 * lane) = w; }
            { const f32x4 o = vc[q] * rc * *(const f32x4*)(gc + 4 * lane); u32x2 w; w.x = pk2(o[0], o[1]); w.y = pk2(o[2], o[3]); *(u32x2*)(orow + 768 + 4 * lane) = w; }
        }
    }
}
DI void phase_router(const Ctx& F, int l) {
    LAS unsigned char* WH = F.lds; LAS unsigned char* WL = F.lds + 65536;
    LAS float* biasp = (LAS float*)(F.lds + AUX_OFF); LAS float* RS = biasp + 32;
    LAS int* lcnt = (LAS int*)(F.lds + AUX_OFF + 1024); LAS int* gbase = lcnt + 32;
    LAS int* tokE = gbase + 32; LAS float* tokG = (LAS float*)(tokE + 512); LAS int* tokP = (LAS int*)(tokG + 512);
    const float* wr = ginp(F, I_WR) + (size_t)l * 1024 * 32; const float* br = ginp(F, I_BR) + (size_t)l * 32;
    const float* mods = (const float*)(F.ws + WS_MODS); const bf16* X = (const bf16*)(F.ws + WS_X); bf16* H = (bf16*)(F.ws + F.dofs + WS_H);
    const float* g2 = ginp(F, I_G2) + (size_t)l * 1024;
    const int tid = F.tid, lane = F.lane, w = F.wave;
    if (tid < 32) lcnt[tid] = 0;
    unsigned* CNT = (unsigned*)(F.ws + WS_CTL) + CW_CNT + (l + F.dcnt) * 32 * 64;
    for (int chunk = F.blk; chunk < T / 128; chunk += F.G) {
        const int b = (chunk * 128) >> 12;
        const float* sh = mods + ((size_t)(l * 8 + b) * 6 + 3) * 1024; const float* sc = sh + 1024;
        {
            float bacc = 0.f; const int e = tid & 31;
#pragma unroll 4
            for (int it = 0; it < 32; ++it) {
                const int k = 2 * ((tid + 512 * it) >> 5);
                const float w0 = wr[k * 32 + e], w1 = wr[(k + 1) * 32 + e];
                const float p0 = w0 * (g2[k] * (sc[k] + 1.0f)), p1 = w1 * (g2[k + 1] * (sc[k + 1] + 1.0f));
                bacc += sh[k] * w0 + sh[k + 1] * w1;
                const unsigned hi = pk2(p0, p1);
                const unsigned lo = pk2(p0 - bflo(hi), p1 - bfhi(hi));
                const int off = e * 2048 + ((((k >> 3) ^ e) << 4) | ((k & 7) * 2));
                *(LAS unsigned*)(WH + off) = hi; *(LAS unsigned*)(WL + off) = lo;
            }
            tokG[tid] = bacc;
        }
        __syncthreads();
        if (tid < 32) { float s_ = br[tid];
#pragma unroll
            for (int j = 0; j < 16; ++j) s_ += tokG[tid + 32 * j];
            biasp[tid] = s_; }
        {
            u32x2 ra[4], rb[4];
            f32x4 ggv[4], hhv[4];
#pragma unroll
            for (int k = 0; k < 4; ++k) { const int c = 4 * lane + 256 * k; ggv[k] = *(const f32x4*)(g2 + c) * (*(const f32x4*)(sc + c) + 1.0f); hhv[k] = *(const f32x4*)(sh + c); }
            { const bf16* x0 = X + (size_t)(chunk * 128 + w * 16) * 1024 + 4 * lane;
#pragma unroll
              for (int k = 0; k < 4; ++k) { ra[k] = *(const u32x2*)(x0 + 256 * k); rb[k] = *(const u32x2*)(x0 + 1024 + 256 * k); } }
#pragma unroll 1
            for (int tt = 0; tt < 8; ++tt) {
                const int tl0 = w * 16 + 2 * tt, tok0 = chunk * 128 + tl0;
                f32x4 v[2][4]; float ss0 = 0.f, ss1 = 0.f;
#pragma unroll
                for (int k = 0; k < 4; ++k) { v[0][k] = (f32x4){bflo(ra[k].x), bfhi(ra[k].x), bflo(ra[k].y), bfhi(ra[k].y)}; v[1][k] = (f32x4){bflo(rb[k].x), bfhi(rb[k].x), bflo(rb[k].y), bfhi(rb[k].y)}; }
                { const int tn = (tt < 7) ? tok0 + 2 : tok0; const bf16* x0 = X + (size_t)tn * 1024 + 4 * lane;
#pragma unroll
                  for (int k = 0; k < 4; ++k) { ra[k] = *(const u32x2*)(x0 + 256 * k); rb[k] = *(const u32x2*)(x0 + 1024 + 256 * k); } }
#pragma unroll
                for (int k = 0; k < 4; ++k) { ss0 += v[0][k][0] * v[0][k][0] + v[0][k][1] * v[0][k][1] + v[0][k][2] * v[0][k][2] + v[0][k][3] * v[0][k][3];
                                              ss1 += v[1][k][0] * v[1][k][0] + v[1][k][1] * v[1][k][1] + v[1][k][2] * v[1][k][2] + v[1][k][3] * v[1][k][3]; }
                ss0 = wave_sum(ss0); ss1 = wave_sum(ss1);
                const float rs0 = rsqrtf(ss0 * (1.0f / 1024.0f) + EPS), rs1 = rsqrtf(ss1 * (1.0f / 1024.0f) + EPS);
                if (lane == 0) { RS[tl0] = rs0; RS[tl0 + 1] = rs1; }
#pragma unroll
                for (int k = 0; k < 4; ++k) {
                    const int c = 4 * lane + 256 * k;
                    v[0][k] = v[0][k] * rs0 * ggv[k] + hhv[k]; v[1][k] = v[1][k] * rs1 * ggv[k] + hhv[k];
                    *(unsigned*)((unsigned char*)H + (size_t)tok0 * 1024 + c) = pk4_fp8s(v[0][k][0], v[0][k][1], v[0][k][2], v[0][k][3], H8_SCALE);
                    *(unsigned*)((unsigned char*)H + (size_t)(tok0 + 1) * 1024 + c) = pk4_fp8s(v[1][k][0], v[1][k][1], v[1][k][2], v[1][k][3], H8_SCALE);
                }
            }
        }
        __syncthreads();
        f32x4 acc[2] = {{0.f, 0.f, 0.f, 0.f}, {0.f, 0.f, 0.f, 0.f}};
        {
            const int kg = lane >> 4, n16 = lane & 15;
            const bf16* xr = X + (size_t)(chunk * 128 + w * 16 + n16) * 1024 + 8 * kg;
#pragma unroll 1
            for (int k8 = 0; k8 < 4; ++k8) {
                bf16x8 af[8];
#pragma unroll
                for (int j = 0; j < 8; ++j) af[j] = *(const bf16x8*)(xr + 32 * (8 * k8 + j));
#pragma unroll
                for (int j = 0; j < 8; ++j) {
                    const int c = 4 * (8 * k8 + j) + kg;
#pragma unroll
                    for (int et = 0; et < 2; ++et) {
                        const int e = 16 * et + n16, off = e * 2048 + ((c ^ e) << 4);
                        const bf16x8 bh = *(const LAS bf16x8*)(WH + off), bl = *(const LAS bf16x8*)(WL + off);
                        acc[et] = __builtin_amdgcn_mfma_f32_16x16x32_bf16(af[j], bh, acc[et], 0, 0, 0);
                        acc[et] = __builtin_amdgcn_mfma_f32_16x16x32_bf16(af[j], bl, acc[et], 0, 0, 0);
                    }
                }
            }
        }
        __syncthreads();
        LAS float* LG = (LAS float*)(F.lds + w * 2048);
        {
            const int g4 = lane >> 4, n16 = lane & 15;
#pragma unroll
            for (int et = 0; et < 2; ++et)
#pragma unroll
                for (int i = 0; i < 4; ++i) LG[(4 * g4 + i) * 32 + 16 * et + n16] = acc[et][i] * RS[w * 16 + 4 * g4 + i] + biasp[16 * et + n16];
        }
        asm volatile("s_waitcnt lgkmcnt(0)" ::: "memory");
#pragma unroll 1
        for (int tt = 0; tt < 8; ++tt) {
            const int tl0 = w * 16 + 2 * tt;
            const float lg0 = LG[(2 * tt) * 32 + (lane >> 1)], lg1 = LG[(2 * tt + 1) * 32 + (lane >> 1)];
            int rk0 = 0, rk1 = 0; const int me = lane >> 1;
#pragma unroll
            for (int e = 0; e < 32; ++e) {
                const float o0 = __builtin_bit_cast(float, __builtin_amdgcn_readlane(__builtin_bit_cast(int, lg0), 2 * e));
                const float o1 = __builtin_bit_cast(float, __builtin_amdgcn_readlane(__builtin_bit_cast(int, lg1), 2 * e));
                rk0 += ((o0 > lg0) || (o0 == lg0 && e < me)) ? 1 : 0; rk1 += ((o1 > lg1) || (o1 == lg1 && e < me)) ? 1 : 0;
            }
#pragma unroll
            for (int tk = 0; tk < 2; ++tk) {
                const int rk = tk ? rk1 : rk0; const float lg = tk ? lg1 : lg0;
                int te[4]; float tv[4];
#pragma unroll
                for (int r = 0; r < 4; ++r) {
                    const u64 mk = __ballot(rk == r && (lane & 1) == 0);
                    const int sl = __builtin_amdgcn_readfirstlane((int)__builtin_ctzll(mk));
                    te[r] = sl >> 1; tv[r] = __builtin_bit_cast(float, __builtin_amdgcn_readlane(__builtin_bit_cast(int, lg), sl));
                }
                const float e1 = __expf(tv[1] - tv[0]), e2 = __expf(tv[2] - tv[0]), e3 = __expf(tv[3] - tv[0]);
                const float isum = 1.0f / (1.0f + e1 + e2 + e3);
                if (lane < 4) {
                    const int tl = tl0 + tk;
                    const int e = lane == 0 ? te[0] : lane == 1 ? te[1] : lane == 2 ? te[2] : te[3];
                    const float gte = (lane == 0 ? 1.0f : lane == 1 ? e1 : lane == 2 ? e2 : e3) * isum;
                    const int pos = atomicAdd((int*)(lcnt + e), 1);
                    tokE[tl * 4 + lane] = e; tokG[tl * 4 + lane] = gte; tokP[tl * 4 + lane] = pos;
                }
            }
        }
        __syncthreads();
        if (tid < 32) gbase[tid] = (int)__hip_atomic_fetch_add(CNT + tid * 64, (unsigned)lcnt[tid], RLX_AGENT);
        __syncthreads();
        {
            const int tl = tid >> 2, r = tid & 3, e = tokE[tid], pos = gbase[e] + tokP[tid], tok = chunk * 128 + tl;
            ((int*)(F.ws + F.dofs + WS_IDX))[(size_t)e * ECAP + pos] = tok;
            ((float*)(F.ws + F.dofs + WS_TOKG))[(size_t)tok * 4 + r] = tokG[tid];
            ((int*)(F.ws + F.dofs + WS_TOKSLOT))[(size_t)tok * 4 + r] = (e << 16) | pos;
        }
        __syncthreads();
        if (tid < 32) lcnt[tid] = 0;
        __syncthreads();
    }
}

DI int ropeperm64(int p) { return (p >> 1) + 32 * (p & 1); }
DI int cmap_win(int n) {
    const int tile = n >> 8, w = n & 255, hb = w & ~63, pp = ropeperm64(w & 63);
    switch (tile) {
        case 0: return hb + pp;
        case 1: return 256 + hb + pp;
        case 2: return 512 + w;
        case 3: return 768 + hb + pp;
        case 4: return 1024 + hb + pp;
        case 5: return w < 128 ? 1280 + w : 1408 + (w - 128);
        case 6: return w < 128 ? 1536 + hb + pp : 1664 + (w - 128);
        case 7: return w < 128 ? 1792 + hb + pp : 1920 + (w - 128);
        case 8: return 2072 + w;
        default: return w < 128 ? 2328 + w : (w < 160 ? 2456 + ((w - 128) >> 1) + 16 * ((w - 128) & 1) : (w < 184 ? 2048 + (w - 160) : -1));
    }
}
DI int cmap_qup(int n) { if (n >= 384) return -1; const int h = n / 96, w = n % 96; if (w < 64) return h * 96 + w; const int j = w - 64; return h * 96 + 64 + (j >> 1) + 16 * (j & 1); }
DI void tr_tile(const float* src, int K, int Nsrc, bf16* dst, int Kdst, int maptype, const float* ksc, int ntile, int ktile, LAS float* scr, int tid) {
    const int n0 = ntile * 64, k0 = ktile * 128, nl = tid & 63, n = n0 + nl;
    const int c = maptype == 0 ? (n < Nsrc ? n : -1) : (maptype == 1 ? cmap_win(n) : cmap_qup(n));
    float v[16];
#pragma unroll
    for (int it = 0; it < 16; ++it) { const int k = k0 + (tid >> 6) + 8 * it; v[it] = (c >= 0 && k < K) ? src[(size_t)k * Nsrc + c] * (ksc ? ksc[k] : 1.0f) : 0.f; }
#pragma unroll
    for (int it = 0; it < 16; ++it) scr[((tid >> 6) + 8 * it) * 65 + nl] = v[it];
    __syncthreads();
#pragma unroll
    for (int it = 0; it < 2; ++it) {
        const int idx = tid + 512 * it, nn = idx >> 4, ch = idx & 15;
        const LAS float* s = scr + (8 * ch) * 65 + nn;
        u32x4 o; o.x = pk2(s[0], s[65]); o.y = pk2(s[2 * 65], s[3 * 65]); o.z = pk2(s[4 * 65], s[5 * 65]); o.w = pk2(s[6 * 65], s[7 * 65]);
        *(u32x4*)(dst + (size_t)(n0 + nn) * Kdst + k0 + 8 * ch) = o;
    }
    __syncthreads();
}
DI void trb_load(f32x4 (&v)[16], const float* src, int N, int n0, int k0, int tid) {
#pragma unroll
    for (int it = 0; it < 16; ++it) v[it] = *(const f32x4*)(src + (size_t)(k0 + (tid >> 6) + 8 * it) * N + n0 + 4 * (tid & 63));
}
DI void trb_store(const f32x4 (&v)[16], bf16* dst, int Kd, int n0, int k0, LAS unsigned char* L, int tid, int wave, int lane, int f8 = 0) {
#pragma unroll
    for (int it = 0; it < 16; ++it) { f32x4 x = v[it];
        if (f8) { x[0] = q8s(x[0], W8_SCALE); x[1] = q8s(x[1], W8_SCALE); x[2] = q8s(x[2], W8_SCALE); x[3] = q8s(x[3], W8_SCALE); }
        u32x2 w; w.x = pk2(x[0], x[1]); w.y = pk2(x[2], x[3]); *(LAS u32x2*)(L + ((tid >> 6) + 8 * it) * 576 + (tid & 63) * 8) = w; }
    asm volatile("s_waitcnt lgkmcnt(0)\n\ts_barrier" ::: "memory");
    const int i = lane & 15, gn = (lane >> 4) & 1, h = lane >> 5, q = i >> 2, p = i & 3;
    const LAS unsigned char* base = L + (8 * h + q) * 576 + (32 * wave + 16 * gn) * 2 + 8 * p;
    if (!f8) {
        bf16* drow = dst + (size_t)(n0 + 32 * wave + 16 * gn + i) * Kd + k0 + 8 * h;
#pragma unroll
        for (int kcp = 0; kcp < 8; ++kcp) {
            const s16x4 lo = tr_read(base + (16 * kcp) * 576), hi = tr_read(base + (16 * kcp + 4) * 576);
            *(bf16x8*)(drow + 16 * kcp) = __builtin_shufflevector(lo, hi, 0, 1, 2, 3, 4, 5, 6, 7);
        }
    } else {
        unsigned char* drow = (unsigned char*)dst + (size_t)(n0 + 32 * wave + 16 * gn + i) * Kd + k0 + 8 * h;
#pragma unroll
        for (int kcp = 0; kcp < 8; ++kcp) {
            const s16x4 lo = tr_read(base + (16 * kcp) * 576), hi = tr_read(base + (16 * kcp + 4) * 576);
            int w0 = __builtin_amdgcn_cvt_pk_fp8_f32(bf2f((unsigned short)lo[0]), bf2f((unsigned short)lo[1]), 0, false); w0 = __builtin_amdgcn_cvt_pk_fp8_f32(bf2f((unsigned short)lo[2]), bf2f((unsigned short)lo[3]), w0, true);
            int w1 = __builtin_amdgcn_cvt_pk_fp8_f32(bf2f((unsigned short)hi[0]), bf2f((unsigned short)hi[1]), 0, false); w1 = __builtin_amdgcn_cvt_pk_fp8_f32(bf2f((unsigned short)hi[2]), bf2f((unsigned short)hi[3]), w1, true);
            u32x2 o; o.x = (unsigned)w0; o.y = (unsigned)w1;
            *(u32x2*)(drow + 16 * kcp) = o;
        }
    }
    asm volatile("s_waitcnt lgkmcnt(0)\n\ts_barrier" ::: "memory");
}
struct TrbItem { const float* src; bf16* dst; int N, n0, k0, f8; };
DI TrbItem trb_item(const Ctx& F, int it) {
    const int le = it / 96, r = it % 96; TrbItem t;
    if (r < 64) { t.src = ginp(F, I_WE1) + (size_t)le * 1024 * 2048; t.dst = (bf16*)(F.ws + WS_W1E + (size_t)le * 2048 * 1024); t.N = 2048; t.n0 = (r & 7) * 256; t.k0 = (r >> 3) * 128; t.f8 = 1; }
    else { const int q = r - 64; t.src = ginp(F, I_WE2) + (size_t)le * 1024 * 1024; t.dst = (bf16*)(F.ws + WS_W2E + (size_t)le * 1024 * 1024); t.N = 1024; t.n0 = (q & 3) * 256; t.k0 = (q >> 2) * 128; t.f8 = 1; }
    return t;
}
DI void conv_layer_tiles(const Ctx& F, int l, int q0, int i0, int cnt) {
    const int NL = 32 * 96;
    int it = q0 + F.blk + F.G * i0; const int end = q0 + F.blk + F.G * (i0 + cnt);
    if (it >= NL) return;
    f32x4 va[16];
    TrbItem ta = trb_item(F, l * NL + it);
    trb_load(va, ta.src, ta.N, ta.n0, ta.k0, F.tid);
#pragma unroll 1
    while (it < NL && it < end) {
        f32x4 vb[16];
#pragma unroll
        for (int k = 0; k < 16; ++k) vb[k] = va[k];
        const TrbItem tc = ta;
        it += F.G;
        const bool more = (it < NL && it < end);
        ta = trb_item(F, l * NL + (more ? it : 0));
        if (more) trb_load(va, ta.src, ta.N, ta.n0, ta.k0, F.tid);
        trb_store(vb, tc.dst, 1024, tc.n0, tc.k0, F.lds, F.tid, F.wave, F.lane, tc.f8);
    }
}
DI void conv_claim_tiles(const Ctx& F, int l, int quota) {
    const int NL = 32 * 96;
    volatile LAS unsigned* slot = (volatile LAS unsigned*)(F.lds + MISC_OFF) + 16;
    __syncthreads();
    if (F.tid == 0) { unsigned* q = (unsigned*)(F.ws + WS_CTL) + CW_CONVQ + l * 64; slot[0] = __hip_atomic_fetch_add(q, (unsigned)quota, __ATOMIC_RELAXED, __HIP_MEMORY_SCOPE_AGENT); }
    __syncthreads();
    int it = __builtin_amdgcn_readfirstlane((int)slot[0]); const int end = it + quota;
    if (it >= NL) return;
    f32x4 va[16];
    TrbItem ta = trb_item(F, l * NL + it);
    trb_load(va, ta.src, ta.N, ta.n0, ta.k0, F.tid);
#pragma unroll 1
    while (it < NL && it < end) {
        f32x4 vb[16];
#pragma unroll
        for (int k = 0; k < 16; ++k) vb[k] = va[k];
        const TrbItem tc = ta;
        it += 1;
        const bool more = (it < NL && it < end);
        ta = trb_item(F, l * NL + (more ? it : 0));
        if (more) trb_load(va, ta.src, ta.N, ta.n0, ta.k0, F.tid);
        trb_store(vb, tc.dst, 1024, tc.n0, tc.k0, F.lds, F.tid, F.wave, F.lane, tc.f8);
    }
}
DI void phase_prologue(const Ctx& F) {
    const Args& A = *F.a; const int tid = F.tid;
    LAS float* scr = (LAS float*)F.lds;
    if (!CONV_IN_LAYER) {
        const int NIT = DEPTH * 32 * 96;
        f32x4 va[16];
        int it = F.blk;
        TrbItem ta = trb_item(F, it < NIT ? it : 0);
        if (it < NIT) trb_load(va, ta.src, ta.N, ta.n0, ta.k0, tid);
#pragma unroll 1
        while (it < NIT) {
            f32x4 vb[16];
#pragma unroll
            for (int k = 0; k < 16; ++k) vb[k] = va[k];
            const TrbItem tc = ta;
            it += F.G;
            ta = trb_item(F, it < NIT ? it : 0);
            if (it < NIT) trb_load(va, ta.src, ta.N, ta.n0, ta.k0, tid);
            trb_store(vb, tc.dst, 1024, tc.n0, tc.k0, F.lds, tid, F.wave, F.lane, tc.f8);
        }
    }
    constexpr int PER_L = 8192 + 4096 + 320 + 128 + 128 + 16 + 16;
    for (int it = F.blk; it < DEPTH * PER_L; it += F.G) {
        const int l = it / PER_L; int r = it % PER_L;
        if (r < 8192 + 4096) continue;
        if (r < 8192) { const int e = r >> 8, t = r & 255;
            tr_tile(ginp(F, I_WE1) + ((size_t)(l * 32 + e)) * 1024 * 2048, 1024, 2048, (bf16*)(F.ws + WS_W1E) + ((size_t)(l * 32 + e)) * 2048 * 1024, 1024, 0, nullptr, t >> 3, t & 7, scr, tid); continue; }
        r -= 8192;
        if (r < 4096) { const int e = r >> 7, t = r & 127;
            tr_tile(ginp(F, I_WE2) + ((size_t)(l * 32 + e)) * 1024 * 1024, 1024, 1024, (bf16*)(F.ws + WS_W2E) + ((size_t)(l * 32 + e)) * 1024 * 1024, 1024, 0, nullptr, t >> 3, t & 7, scr, tid); continue; }
        r -= 4096;
        if (r < 320) { tr_tile(ginp(F, I_WIN) + (size_t)l * 1024 * 2488, 1024, 2488, (bf16*)(F.ws + WS_WIN) + (size_t)l * NIN * 1024, 1024, 1, nullptr, r >> 3, r & 7, scr, tid); continue; }
        r -= 320;
        if (r < 128) { tr_tile(ginp(F, I_WOUT) + (size_t)l * 1024 * 1024, 1024, 1024, (bf16*)(F.ws + WS_WOUT) + (size_t)l * 1024 * 1024, 1024, 0, nullptr, r >> 3, r & 7, scr, tid); continue; }
        r -= 128;
        if (r < 128) { const int kv = r >> 6, t = r & 63;
            tr_tile(ginp(F, kv ? I_W1V : I_W1K) + (size_t)l * 2048 * 256, 2048, 256, (bf16*)(F.ws + WS_NSAW1) + ((size_t)(l * 2 + kv)) * 256 * 2048, 2048, 0, nullptr, t >> 4, t & 15, scr, tid); continue; }
        r -= 128;
        if (r < 16) { tr_tile(ginp(F, I_WQUP) + (size_t)l * 256 * 384, 256, 384, (bf16*)(F.ws + WS_MLAQ) + (size_t)l * 512 * 256, 256, 2, ginp(F, I_GQ) + (size_t)l * 256, r >> 1, r & 1, scr, tid); continue; }
        r -= 16;
        tr_tile(ginp(F, I_WKVUP) + (size_t)l * 128 * 512, 128, 512, (bf16*)(F.ws + WS_MLAKV) + (size_t)l * 512 * 256, 256, 0, ginp(F, I_GKV) + (size_t)l * 128, r >> 1, r & 1, scr, tid);
    }
    for (int it = F.blk; it < DEPTH * 4; it += F.G) {
        const int l = it >> 2, kv = (it >> 1) & 1, kt = it & 1;
        tr_tile(ginp(F, kv ? I_W2V : I_W2K) + (size_t)l * 256 * 64, 256, 64, (bf16*)(F.ws + WS_W2T) + ((size_t)(l * 2 + kv)) * 64 * 256, 256, 0, nullptr, 0, kt, scr, tid);
    }
    {
        float* CS64 = (float*)(F.ws + WS_CS64); float* CS32 = (float*)(F.ws + WS_CS32);
        const int* pos = (const int*)ginp(F, I_POS);
        for (int idx = F.blk * 512 + tid; idx < T * 48; idx += F.G * 512) {
            const int tok = idx / 48, i = idx % 48;
            const double p = (double)pos[tok];
            const double inv = (i < 32) ? exp2(-(double)i * (13.287712379549449 / 32.0)) : exp2(-(double)(i - 32) * (13.287712379549449 / 16.0));
            double ang = p * inv;
            const double kk = __builtin_rint(ang * 0.15915494309189535);
            ang = ang - kk * 6.283185307179586;
            const float af = (float)ang;
            const float cs = __cosf(af), sn = __sinf(af);
            if (i < 32) { CS64[(size_t)tok * 64 + i] = cs; CS64[(size_t)tok * 64 + 32 + i] = sn; }
            else { CS32[(size_t)tok * 32 + (i - 32)] = cs; CS32[(size_t)tok * 32 + 16 + (i - 32)] = sn; }
        }
    }
    for (int item = F.blk; item < 32; item += F.G) {
        const int lk = item >> 2, l = lk >> 1, kv = lk & 1, col = (item & 3) * 64 + F.lane;
        const float* w1 = ginp(F, kv ? I_W1V : I_W1K) + (size_t)l * 2048 * 256 + col; const float* pe = ginp(F, kv ? I_POSV : I_POSK) + (size_t)l * 2048;
        float s = 0.f;
#pragma unroll 1
        for (int kb = 256 * F.wave; kb < 256 * F.wave + 256; kb += 16) {
            float wv[16];
#pragma unroll
            for (int j = 0; j < 16; ++j) wv[j] = w1[(size_t)(kb + j) * 256];
#pragma unroll
            for (int j = 0; j < 16; ++j) s += pe[kb + j] * wv[j];
        }
        scr[F.wave * 64 + F.lane] = s;
        __syncthreads();
        if (tid < 64) { float t = ginp(F, kv ? I_B1V : I_B1K)[(size_t)l * 256 + col];
#pragma unroll
            for (int ww = 0; ww < 8; ++ww) t += scr[ww * 64 + tid];
            ((float*)(F.ws + WS_B1P))[(size_t)lk * 256 + col] = t; }
        __syncthreads();
    }
    {
        LAS float* sc = scr; LAS float* red = scr + 8192;
        for (int i = tid; i < 8192; i += 512) { const float c = ginp(F, I_C)[i]; sc[i] = c * sigmoidf_(c); }
        __syncthreads();
        float* MODS = (float*)(F.ws + WS_MODS);
        const int lane = F.lane, w = F.wave;
        for (int item = F.blk; item < 384; item += F.G) {
            const int l = item / 96, col = (item % 96) * 64 + lane;
            float acc[8];
#pragma unroll
            for (int b = 0; b < 8; ++b) acc[b] = 0.f;
            const float* wa = ginp(F, I_WADA) + (size_t)l * 1024 * 6144 + col;
#pragma unroll 1
            for (int kb = 128 * w; kb < 128 * w + 128; kb += 16) {
                float wv[16];
#pragma unroll
                for (int j = 0; j < 16; ++j) wv[j] = wa[(size_t)(kb + j) * 6144];
#pragma unroll
                for (int j = 0; j < 16; ++j) {
#pragma unroll
                    for (int b = 0; b < 8; ++b) acc[b] += sc[b * 1024 + kb + j] * wv[j]; }
            }
#pragma unroll
            for (int b = 0; b < 8; ++b) red[(w * 8 + b) * 64 + lane] = acc[b];
            __syncthreads();
            { const int b = tid >> 6; float s = ginp(F, I_BADA)[(size_t)l * 6144 + col];
#pragma unroll
              for (int ww = 0; ww < 8; ++ww) s += red[(ww * 8 + b) * 64 + lane];
              MODS[((size_t)(l * 8 + b)) * 6144 + col] = s; }
            __syncthreads();
        }
    }
}

constexpr int PH_PER_LAYER = 11;
constexpr int N_PHASES = 1 + DEPTH * PH_PER_LAYER + 1;

__global__ void __launch_bounds__(512, 2) fwd_kernel(Args args) {
    extern __shared__ __attribute__((aligned(16))) unsigned char lds_raw[];
    Ctx F;
    F.lds = (LAS unsigned char*)lds_raw; F.a = &args; F.ws = args.ws;
    F.dofs = 0; F.dcnt = 0;
    F.tid = threadIdx.x; F.lane = F.tid & 63; F.wave = __builtin_amdgcn_readfirstlane(F.tid >> 6); F.blk = blockIdx.x; F.G = gridDim.x; F.vcu = F.blk;
    volatile LAS unsigned* MISC = (volatile LAS unsigned*)(F.lds + MISC_OFF);
    for (int u = F.tid; u < (LDS_BYTES - MISC_OFF) / 4; u += 512) MISC[u] = 0u;
    __syncthreads();
    unsigned* ctl = (unsigned*)(F.ws + WS_CTL);
    XcdBarrier bar; bar.bar = ctl + CW_BAR; bar.x = 0; bar.st = nullptr;
    if (!MK_PER_PHASE) bar = xcd_barrier_post(ctl + CW_BAR, MISC + 8);
    const int lo = args.ph_lo, hi = args.ph_hi;
#define IN(k) (lo <= (k) && (k) < hi)
#define SEAM(k) do { if (IN(k) && IN((k) + 1)) xcd_barrier(bar); } while (0)
    unsigned char* ws = F.ws;
#define PHASE_BEGIN() do { int t_ = threadIdx.x; asm volatile("" : "+v"(t_)); F.tid = t_; F.lane = t_ & 63; F.wave = __builtin_amdgcn_readfirstlane(t_ >> 6); \
        GAS unsigned char* w_ = (GAS unsigned char*)args.ws; asm volatile("" : "+s"(w_)); F.ws = (unsigned char*)w_; ws = (unsigned char*)w_; int b_ = blockIdx.x; asm volatile("" : "+s"(b_)); F.blk = b_; F.vcu = (F.G % 8 == 0) ? (b_ % 8) * (F.G / 8) + b_ / 8 : b_; } while (0)

    if (PHON(0) && IN(0)) _Pragma("unroll 1") for (int rep_ = 0; rep_ < NREP(0); ++rep_) { PHASE_BEGIN(); phase_prologue(F); }
    SEAM(0);
#pragma unroll 1
    for (int l = 0; l < DEPTH; ++l) {
        const int P = 1 + l * PH_PER_LAYER;
        if (PHON(1) && IN(P + 0)) _Pragma("unroll 1") for (int rep_ = 0; rep_ < (DUM(1) ? 2 : 1); ++rep_) { PHASE_BEGIN(); F.dofs = (DUM(1) && rep_ == 0) ? WS_END : 0; phase_norm1<0>(F, l); }
        SEAM(P + 0);
        if (PHON(2) && IN(P + 1)) _Pragma("unroll 1") for (int rep_ = 0; rep_ < NREP(2); ++rep_) { PHASE_BEGIN();
            SchedGrid Sg{(const char*)(ws + WS_H), (const char*)(ws + WS_WIN) + (size_t)l * NIN * 1024 * 2, 1024, 1024, NIN / 256, (T / 256) * (NIN / 256), F.G, F.vcu};
            EpiWin E{ws, (const float*)(ws + WS_CS64), (const float*)(ws + WS_CS32)};
            pg8::gemm_phase<EpiWin, SchedGrid, false>(F.lds, 1024, 1024, Sg, E);
        }
        SEAM(P + 1);
        if (PHON(3) && IN(P + 2)) _Pragma("unroll 1") for (int rep_ = 0; rep_ < NREP(3); ++rep_) { PHASE_BEGIN();
            if (PHON(13)) {
                SchedCmp Sc{(const char*)(ws + WS_KCMP), (const char*)(ws + WS_VCMP), (const char*)(ws + WS_NSAW1) + (size_t)l * 2 * 256 * 2048 * 2, F.G, F.blk};
                EpiCmp E{(const float*)(ws + WS_B1P) + (size_t)l * 512, (const bf16*)(ws + WS_W2T) + (size_t)l * 2 * 64 * 256, ginp(F, I_B2K) + (size_t)l * 64, ginp(F, I_B2V) + (size_t)l * 64,
                         (bf16*)(ws + WS_KC), (bf16*)(ws + WS_VC), (const float*)(ws + WS_CS64)};
                pg8::gemm_phase<EpiCmp, SchedCmp, false>(F.lds, 1024, 2048, Sc, E);
            }
            PHASE_BEGIN();
            if (PHON(18)) {
                SchedMla Sm{(const char*)(ws + WS_CQ), (const char*)(ws + WS_MISC), (const char*)(ws + WS_MLAQ) + (size_t)l * 512 * 256 * 2, (const char*)(ws + WS_MLAKV) + (size_t)l * 512 * 256 * 2, F.G, F.vcu};
                EpiMla E{(bf16*)(ws + WS_QM), (bf16*)(ws + WS_KN), (bf16*)(ws + WS_VM), (const bf16*)(ws + WS_CQ), (const bf16*)(ws + WS_MISC), (const float*)(ws + WS_CS32), (LAS float*)(F.lds + AUX_OFF + 1024)};
                pg8::gemm_phase<EpiMla, SchedMla, false>(F.lds, 256, 256, Sm, E);
            }
            PHASE_BEGIN();
            if (PHON(15)) {
                unsigned* qw = (unsigned*)(ws + WS_CTL) + CW_QUEUE + (l * 2 + rep_) * 64;
                volatile LAS int* qslot = (volatile LAS int*)(F.lds + AUX_OFF + 512);
                int nxt_t = 0;
                if (F.tid == 0) nxt_t = (int)__hip_atomic_fetch_add(qw, 1u, RLX_AGENT);
                for (;;) {
                    if (F.tid == 0) { qslot[0] = nxt_t; nxt_t = (int)__hip_atomic_fetch_add(qw, 1u, RLX_AGENT); }
                    __syncthreads();
                    const int uq = qslot[0];
                    __syncthreads();
                    if (uq >= 2560) break;
                    if (uq < 1024) {
                        const int u = uq;
                        PolB pb; pb.Q = (const bf16*)(ws + WS_QB); pb.K = (const bf16*)(ws + WS_KWIN); pb.V = (const bf16*)(ws + WS_VWIN); pb.O = (bf16*)(ws + WS_OWIN);
                        pb.b = u >> 7; pb.g = (u >> 6) & 1; pb.qc = 63 - (u & 63); pb.maxd = 511u; pb.j0 = pb.qc > 8 ? pb.qc - 8 : 0; pb.j1 = pb.qc + 1;
                        attn_unit<64, PolB, false>(pb, F.lds, F.tid, F.lane, F.wave, 0ull);
                    } else {
                        const int uu = uq - 1024;
                        const int bh = uu / 48, w48 = uu % 48, p = w48 >> 4, s16 = w48 & 15;
                        PolA pa; pa.Q = (const bf16*)(ws + WS_QA); pa.K = (const bf16*)(ws + WS_KA); pa.V = (const bf16*)(ws + WS_VA);
                        pa.O = (bf16*)(ws + WS_OA3) + (size_t)p * T * 256; pa.LSEP = (float*)(ws + WS_LSEA) + (size_t)p * T * 4;
                        pa.b = bh >> 2; pa.h = bh & 3; pa.d = p == 0 ? 1 : (p == 1 ? 4 : 16);
                        const int cpr = p == 0 ? 16 : (p == 1 ? 4 : 1);
                        pa.r = s16 / cpr; pa.c = s16 % cpr; pa.maxd = 128u; pa.j0 = pa.c == 0 ? 2 : 0; pa.j1 = 6;
                        attn_unit<64, PolA, false>(pa, F.lds, F.tid, F.lane, F.wave, 0ull);
                    }
                }
            }
        }
        SEAM(P + 2);
        if (PHON(5) && IN(P + 4)) _Pragma("unroll 1") for (int rep_ = 0; rep_ < NREP(5); ++rep_) { PHASE_BEGIN();
            int cti = 0;
            int cq0 = 0;
            if (CONV_IN_LAYER) { const unsigned t_ = __hip_atomic_load((unsigned*)(ws + WS_CTL) + CW_CONVQ + l * 64, __ATOMIC_RELAXED, __HIP_MEMORY_SCOPE_AGENT); cq0 = __builtin_amdgcn_readfirstlane((int)(t_ < 3072u ? t_ : 3072u)); }
            if (PHON(19)) for (int u = F.vcu; u < 1024; u += F.G) {
                const int bg = (u % 256) >> 4, k = u & 15, rnd = u >> 8;
                const int qc = rnd == 0 ? 2 * k : (rnd == 1 ? 2 * k + 1 : (rnd == 2 ? 63 - 2 * k : 62 - 2 * k));
                const u64 sel = cmp_unit(F, bg >> 1, bg & 1, qc);
                PolB pb; pb.Q = (const bf16*)(ws + WS_QB); pb.K = (const bf16*)(ws + WS_KSLC); pb.V = (const bf16*)(ws + WS_VSLC); pb.O = (bf16*)(ws + WS_OSLC);
                pb.b = bg >> 1; pb.g = bg & 1; pb.qc = qc; pb.maxd = 0x7fffffffu; pb.j0 = 0; pb.j1 = qc + 1;
                pb.GC = (const bf16*)(ws + WS_OCMP); pb.GW = (const bf16*)(ws + WS_OWIN); pb.GM = (const bf16*)(ws + WS_MISC);
                attn_unit<64, PolB, true>(pb, F.lds, F.tid, F.lane, F.wave, sel);
                if (CONV_IN_LAYER && rep_ == 0) { PHASE_BEGIN(); conv_layer_tiles(F, l, cq0, cti, 2); cti += 2; }
            }
            PHASE_BEGIN();
            if (PHON(20)) for (int v = F.vcu; v < 512; v += F.G) {
                const int bh = (v & 255) >> 3, k = v & 7, c = (v < 256) ? k : 15 - k;
                PolM pm; pm.Q = (const bf16*)(ws + WS_QM); pm.KN = (const bf16*)(ws + WS_KN); pm.KR = (const bf16*)(ws + WS_KR); pm.V = (const bf16*)(ws + WS_VM); pm.O = (bf16*)(ws + WS_OC);
                pm.b = bh >> 2; pm.h = bh & 3; pm.c = c; pm.maxd = 0x7fffffffu; pm.j0 = 0; pm.j1 = 4 * c + 4;
                attn_unit<96, PolM, false>(pm, F.lds, F.tid, F.lane, F.wave, 0ull);
                if (CONV_IN_LAYER && rep_ == 0) { PHASE_BEGIN(); conv_layer_tiles(F, l, cq0, cti, 2); cti += 2; }
            }
            if (CONV_IN_LAYER && rep_ == 0) { PHASE_BEGIN(); conv_layer_tiles(F, l, cq0, cti, 1 << 20); }
        }
        SEAM(P + 4);
        if (PHON(7) && IN(P + 6)) _Pragma("unroll 1") for (int rep_ = 0; rep_ < NREP(7); ++rep_) { PHASE_BEGIN(); phase_mix(F, l); }
        SEAM(P + 6);
        if (PHON(8) && IN(P + 7)) _Pragma("unroll 1") for (int rep_ = 0; rep_ < (DUM(8) ? 2 : 1); ++rep_) { PHASE_BEGIN(); F.dofs = (DUM(8) && rep_ == 0) ? WS_END : 0;
            SchedGrid Sg{(const char*)(ws + WS_AMIX), (const char*)(ws + WS_WOUT) + (size_t)l * 1024 * 1024 * 2, 1024, 1024, 4, (T / 256) * 4, F.G, F.vcu};
            EpiWout E{(bf16*)(ws + WS_X), (const float*)(ws + WS_MODS) + ((size_t)(l * 8) * 6 + 2) * 1024, F.dofs};
            pg8::gemm_phase<EpiWout, SchedGrid, false>(F.lds, 1024, 1024, Sg, E);
        }
        SEAM(P + 7);
        if (PHON(9) && IN(P + 8)) _Pragma("unroll 1") for (int rep_ = 0; rep_ < (DUM(9) ? 2 : 1); ++rep_) { PHASE_BEGIN(); F.dofs = (DUM(9) && rep_ == 0) ? WS_END : 0; F.dcnt = (DUM(9) && rep_ == 0) ? 4 : 0; phase_router(F, l); }
        SEAM(P + 8);
        if (PHON(10) && IN(P + 9)) _Pragma("unroll 1") for (int rep_ = 0; rep_ < NREP(10); ++rep_) { PHASE_BEGIN();
            moe_tables(F, l);
            const LAS int* tb = (const LAS int*)(F.lds + AUX_OFF);
            SchedMoe1F8 Sm{tb, tb + 64, (const char*)(ws + WS_H), (const char*)(ws + WS_W1E) + (size_t)l * 32 * 2048 * 1024, (const int*)(ws + WS_IDX), tb[32] * 8, F.G, F.vcu};
            EpiMoe1 E{(bf16*)(ws + WS_ACT), ginp(F, I_BE1) + (size_t)l * 32 * 2048};
            pg8::gemm_phase<EpiMoe1, SchedMoe1F8, true, true>(F.lds, 512, 512, Sm, E);
            if (CONV_IN_LAYER && CONV_TAIL1 > 0 && rep_ == 0 && l + 1 < DEPTH) {
                const int nun = tb[32] * 8, rounds = (nun + F.G - 1) / F.G, mine = F.vcu < nun ? (nun - 1 - F.vcu) / F.G + 1 : 0;
                if (mine < rounds) { PHASE_BEGIN(); conv_claim_tiles(F, l + 1, CONV_TAIL1); }
            }
        }
        SEAM(P + 9);
        if (PHON(11) && IN(P + 10)) _Pragma("unroll 1") for (int rep_ = 0; rep_ < NREP(11); ++rep_) { PHASE_BEGIN();
            moe_tables(F, l);
            const LAS int* tb = (const LAS int*)(F.lds + AUX_OFF);
            SchedMoe2F8 Sm{tb, (const char*)(ws + WS_ACT), (const char*)(ws + WS_W2E) + (size_t)l * 32 * 1024 * 1024, tb[32] * 4, F.G, F.vcu};
            EpiMoe2 E{(unsigned char*)(ws + WS_Y2), ginp(F, I_BE2) + (size_t)l * 32 * 1024};
            pg8::gemm_phase<EpiMoe2, SchedMoe2F8, false, true>(F.lds, 512, 512, Sm, E);
            if (CONV_IN_LAYER && CONV_TAIL2 > 0 && rep_ == 0 && l + 1 < DEPTH) {
                const int nun = tb[32] * 4, rounds = (nun + F.G - 1) / F.G, mine = F.vcu < nun ? (nun - 1 - F.vcu) / F.G + 1 : 0;
                if (mine < rounds) { PHASE_BEGIN(); conv_claim_tiles(F, l + 1, CONV_TAIL2); }
            }
        }
        SEAM(P + 10);
    }
    if (PHON(12) && IN(N_PHASES - 1)) { PHASE_BEGIN(); phase_norm1<1>(F, DEPTH); }
#undef IN
#undef SEAM
}

extern "C" void kernel_launch(void* const* d_in, const int* in_sizes, int n_in, void* d_out, int out_size, void* d_ws, size_t ws_size, hipStream_t stream) {
    static int grid = 0;
    if (grid == 0) {
        if (n_in != 33 || out_size != T * D || ws_size < WS_END * (DUM_MASK ? 2 : 1)) { fprintf(stderr, "kernel_launch: unexpected problem (n_in %d out %d ws %zu)\n", n_in, out_size, ws_size); grid = -1; return; }
        int dev = 0, cus = 0, per_cu = 0;
        if (hipGetDevice(&dev) != hipSuccess || hipDeviceGetAttribute(&cus, hipDeviceAttributeMultiprocessorCount, dev) != hipSuccess) { grid = -1; return; }
        if (hipFuncSetAttribute((const void*)fwd_kernel, hipFuncAttributeMaxDynamicSharedMemorySize, LDS_BYTES) != hipSuccess) { fprintf(stderr, "kernel_launch: hipFuncSetAttribute failed\n"); grid = -1; return; }
        if (hipOccupancyMaxActiveBlocksPerMultiprocessor(&per_cu, (const void*)fwd_kernel, 512, LDS_BYTES) != hipSuccess || per_cu < 1) { fprintf(stderr, "kernel_launch: occupancy query says %d\n", per_cu); per_cu = 1; }
        (void)hipGetLastError();
        grid = cus;
    }
    if (grid < 0) return;
    if (hipMemsetAsync((char*)d_ws + WS_CTL, 0, CTL_ZERO_BYTES, stream) != hipSuccess) return;
    Args a{};
    for (int i = 0; i < 33; ++i) a.in[i] = (const float*)d_in[i];
    a.out = (float*)d_out; a.ws = (unsigned char*)d_ws;
#if MK_PER_PHASE
    for (int p = 0; p < N_PHASES; ++p) { a.ph_lo = p; a.ph_hi = p + 1; hipLaunchKernelGGL(fwd_kernel, dim3(grid), dim3(512), LDS_BYTES, stream, a); }
#else
    a.ph_lo = 0; a.ph_hi = N_PHASES;
    hipLaunchKernelGGL(fwd_kernel, dim3(grid), dim3(512), LDS_BYTES, stream, a);
#endif
}
```

```cpp
#include <hip/hip_runtime.h>
#include <cstdio>
#include <cstdint>

#ifndef MK_PER_PHASE
#define MK_PER_PHASE 0
#endif

#ifndef PH_MASK
#define PH_MASK 0xFFFFFFFFu
#endif
#define PHON(k) ((PH_MASK >> (k)) & 1u)
#ifndef DBL_MASK
#define DBL_MASK 0u
#endif
#define NREP(k) (((DBL_MASK >> (k)) & 1u) ? 2 : 1)
#ifndef DUM_MASK
#define DUM_MASK 0u
#endif
#define DUM(k) ((DUM_MASK >> (k)) & 1u)
#ifndef ATT_VAR
#define ATT_VAR 0
#endif
#ifndef CONV_IN_LAYER
#define CONV_IN_LAYER 1
#endif
#ifndef CONV_TAIL1
#define CONV_TAIL1 3
#endif
#ifndef CONV_TAIL2
#define CONV_TAIL2 4
#endif
#ifndef ATT_STAGGER
#define ATT_STAGGER 0
#endif
#define DI __device__ __forceinline__
#define LAS __attribute__((address_space(3)))
#define GAS __attribute__((address_space(1)))
typedef unsigned short bf16;
typedef short bf16x8 __attribute__((ext_vector_type(8)));
typedef short s16x4 __attribute__((ext_vector_type(4)));
typedef float f32x2 __attribute__((ext_vector_type(2)));
typedef float f32x4 __attribute__((ext_vector_type(4)));
typedef float f32x16 __attribute__((ext_vector_type(16)));
typedef unsigned u32x2 __attribute__((ext_vector_type(2)));
typedef unsigned u32x4 __attribute__((ext_vector_type(4)));
typedef __bf16 bf16x2_t __attribute__((ext_vector_type(2)));
typedef unsigned long long u64;

constexpr int NB = 8, S = 4096, T = NB * S, D = 1024, DEPTH = 4;
constexpr int NIN = 2560;
constexpr int NE = 32, DFF = 1024;
constexpr int SP = S + 64;
constexpr int ECAP = 32768;
constexpr int ACT_ROWS = 4 * T + NE * 256;
constexpr float LOG2E = 1.4426950408889634f;
constexpr float SCL64 = 0.125f * LOG2E;
constexpr float SCL96 = 0.10206207261596577f * LOG2E;
constexpr float EPS = 1e-6f;

constexpr size_t MiB = 1u << 20;
constexpr size_t WS_CTL = 0, CTL_ZERO_BYTES = 2 * MiB;
constexpr size_t WS_MODS = 2 * MiB, WS_B1P = 3 * MiB, WS_CS64 = 4 * MiB, WS_CS32 = 12 * MiB;
constexpr size_t WS_WIN = 16 * MiB, WS_WOUT = 36 * MiB, WS_NSAW1 = 44 * MiB, WS_MLAQ = 52 * MiB, WS_MLAKV = 53 * MiB;
constexpr size_t WS_W1E = 64 * MiB, WS_W2E = 576 * MiB;
constexpr size_t WS_X = 832 * MiB, WS_H = 960 * MiB;
constexpr size_t WS_QA = 1024 * MiB, WS_KA = 1040 * MiB, WS_VA = 1056 * MiB, WS_QB = 1072 * MiB;
constexpr size_t WS_KCMP = 1104 * MiB, WS_VCMP = 1113 * MiB;
constexpr size_t WS_KSLC = 1122 * MiB, WS_VSLC = 1130 * MiB, WS_KWIN = 1138 * MiB, WS_VWIN = 1146 * MiB;
constexpr size_t WS_CQ = 1154 * MiB, WS_MISC = 1170 * MiB;
constexpr size_t WS_RSTDQ = 1186 * MiB, WS_RSTDKV = 1186 * MiB + 512 * 1024, WS_KR = 1187 * MiB, WS_GATES = 1189 * MiB;
constexpr size_t WS_W2T = 1195 * MiB;
constexpr size_t WS_HID = 1192 * MiB, WS_KC = 1196 * MiB, WS_VC = 1196 * MiB + 512 * 1024;
constexpr size_t WS_QM = 1197 * MiB, WS_KN = 1221 * MiB, WS_VM = 1237 * MiB;
constexpr size_t WS_OA3 = 1253 * MiB, WS_LSEA = 1301 * MiB;
constexpr size_t WS_OCMP = 1303 * MiB, WS_OSLC = 1335 * MiB, WS_OWIN = 1367 * MiB, WS_OC = 1399 * MiB;
constexpr size_t WS_SEL = 1415 * MiB, WS_AMIX = 1416 * MiB;
constexpr size_t WS_IDX = 1480 * MiB, WS_GATEW = 1484 * MiB, WS_TOKSLOT = 1488 * MiB, WS_TOKG = WS_TOKSLOT + 512 * 1024;
constexpr size_t WS_ACT = 1489 * MiB, WS_Y2 = 1761 * MiB, WS_END = 2033 * MiB;
static_assert((size_t)ACT_ROWS * 1024 * 2 <= 272 * MiB, "act rows");
static_assert((size_t)16 * SP * 64 * 2 + 65536 <= 9 * MiB, "kcmp");

constexpr int CW_TMO = 0, CW_FAIL = 2;
constexpr int CW_BAR = 4096;
constexpr int CW_QUEUE = 12288;
constexpr int CW_CONVQ = 13312;
constexpr int CW_CNT = 16384;

constexpr int RING_BYTES = 131072;
constexpr int AUX_OFF = RING_BYTES;
constexpr int MISC_OFF = AUX_OFF + 8192;
constexpr int LDS_BYTES = 147456;

DI unsigned pk2(float lo, float hi) { f32x2 v = {lo, hi}; bf16x2_t b = __builtin_convertvector(v, bf16x2_t); return __builtin_bit_cast(unsigned, b); }
DI float bf2f(unsigned short h) { return __uint_as_float(((unsigned)h) << 16); }
DI float bflo(unsigned w) { return __uint_as_float(w << 16); }
DI float bfhi(unsigned w) { return __uint_as_float(w & 0xffff0000u); }
typedef float f32x2c __attribute__((ext_vector_type(2)));
constexpr float Y2_SCALE = 4.0f, Y2_ISCALE = 1.0f / 4.0f;
DI unsigned pk4_fp8(float a, float b, float c, float d) {
    a = fminf(fmaxf(a * Y2_SCALE, -440.f), 440.f); b = fminf(fmaxf(b * Y2_SCALE, -440.f), 440.f); c = fminf(fmaxf(c * Y2_SCALE, -440.f), 440.f); d = fminf(fmaxf(d * Y2_SCALE, -440.f), 440.f);
    int w = __builtin_amdgcn_cvt_pk_fp8_f32(a, b, 0, false); w = __builtin_amdgcn_cvt_pk_fp8_f32(c, d, w, true); return (unsigned)w; }
DI f32x4 unpk4_fp8(unsigned w) { const f32x2c lo = __builtin_amdgcn_cvt_pk_f32_fp8((int)w, false), hi = __builtin_amdgcn_cvt_pk_f32_fp8((int)w, true); return (f32x4){lo.x, lo.y, hi.x, hi.y}; }
constexpr float W8_SCALE = 64.0f, A8_SCALE = 4.0f;
constexpr int W8_E8M0 = 127 - 6, A8_E8M0 = 127 - 2;
constexpr float H8_SCALE = 8.0f; constexpr int H8_E8M0 = 127 - 3;
DI int lane_id() { return (int)__builtin_amdgcn_mbcnt_hi(~0u, __builtin_amdgcn_mbcnt_lo(~0u, 0u)); }
DI unsigned pk4_fp8s(float a, float b, float c, float d, float sc) {
    a = fminf(fmaxf(a * sc, -440.f), 440.f); b = fminf(fmaxf(b * sc, -440.f), 440.f); c = fminf(fmaxf(c * sc, -440.f), 440.f); d = fminf(fmaxf(d * sc, -440.f), 440.f);
    int w = __builtin_amdgcn_cvt_pk_fp8_f32(a, b, 0, false); w = __builtin_amdgcn_cvt_pk_fp8_f32(c, d, w, true); return (unsigned)w; }
DI float q8s(float x, float sc) {
    const float a = fminf(fmaxf(x * sc, -440.f), 440.f); const int w = __builtin_amdgcn_cvt_pk_fp8_f32(a, a, 0, false);
    const f32x2c r = __builtin_amdgcn_cvt_pk_f32_fp8(w, false); return r.x; }
template <int CTRL> DI float dpp_perm(float v) { return __builtin_bit_cast(float, __builtin_amdgcn_update_dpp(0, __builtin_bit_cast(int, v), CTRL, 0xf, 0xf, false)); }
DI float row_sum16(float v) { v += dpp_perm<0xB1>(v); v += dpp_perm<0x4E>(v); v += dpp_perm<0x141>(v); v += dpp_perm<0x140>(v); return v; }
DI float wave_sum(float v) {
    v = row_sum16(v);
    const float r0 = __builtin_bit_cast(float, __builtin_amdgcn_readlane(__builtin_bit_cast(int, v), 0)), r1 = __builtin_bit_cast(float, __builtin_amdgcn_readlane(__builtin_bit_cast(int, v), 16));
    const float r2 = __builtin_bit_cast(float, __builtin_amdgcn_readlane(__builtin_bit_cast(int, v), 32)), r3 = __builtin_bit_cast(float, __builtin_amdgcn_readlane(__builtin_bit_cast(int, v), 48));
    return (r0 + r1) + (r2 + r3);
}
DI float fast_exp2(float x) { return __builtin_amdgcn_exp2f(x); }
DI float fast_rcp(float x) { return __builtin_amdgcn_rcpf(x); }
DI float sigmoidf_(float x) { return fast_rcp(1.0f + fast_exp2(-x * LOG2E)); }
#define RLX_AGENT __ATOMIC_RELAXED, __HIP_MEMORY_SCOPE_AGENT

#define XB_TMO      128
#define XB_XCNT(j)  (256  + 64 * (j))
#define XB_XSUB(j)  (1280 + 64 * (j))
#define XB_XGEN(j)  (2304 + 64 * (j))
#define XB_TOP      3328
#define XB_TOPGEN   3392
#define XCD_BAR_WORDS 3456
#define XB_SPIN_CAP (1u << 22)
DI unsigned xb_ld(unsigned* p)              { return __hip_atomic_load(p, __ATOMIC_RELAXED, __HIP_MEMORY_SCOPE_AGENT); }
DI unsigned xb_add(unsigned* p, unsigned v) { return __hip_atomic_fetch_add(p, v, __ATOMIC_RELAXED, __HIP_MEMORY_SCOPE_AGENT); }
DI unsigned xb_xcc_id() { return (unsigned)__builtin_amdgcn_s_getreg((3 << 11) | 20) & 0xFu; }
#define XB_SPIN(cond, bar) do { unsigned _sp = 0; while (cond) { __builtin_amdgcn_s_sleep(1); \
    if ((++_sp & 255u) == 0u) { if (xb_ld(&(bar)[XB_TMO])) break; if (_sp > XB_SPIN_CAP) { atomicAdd(&(bar)[XB_TMO], 1u); break; } } } } while (0)
struct XcdBarrier { unsigned* bar; unsigned x; volatile LAS unsigned* st; };
DI XcdBarrier xcd_barrier_post(unsigned* bar, volatile LAS unsigned* st) {
    XcdBarrier b; b.bar = bar; b.x = xb_xcc_id(); b.st = st;
    if (threadIdx.x == 0) (void)xb_add(&bar[XB_XCNT(b.x)], 1u);
    return b;
}
DI void xcd_barrier_complete(unsigned* bar, unsigned x, unsigned& nloc, unsigned& nx) {
    const unsigned G = gridDim.x * gridDim.y * gridDim.z;
    unsigned sum, cnt, mine, sp = 0u;
    for (;;) {
        sum = 0u; cnt = 0u; mine = 0u;
#pragma unroll
        for (unsigned j = 0; j < 16; ++j) { const unsigned c = xb_ld(&bar[XB_XCNT(j)]); sum += c; cnt += (c > 0u) ? 1u : 0u; mine = (j == x) ? c : mine; }
        if (sum == G) break;
        __builtin_amdgcn_s_sleep(1);
        if ((++sp & 255u) == 0u) { if (xb_ld(&bar[XB_TMO])) break; if (sp > XB_SPIN_CAP) { atomicAdd(&bar[XB_TMO], 1u); break; } }
    }
    nloc = mine > 0u ? mine : 1u; nx = cnt > 0u ? cnt : 1u;
}
DI void xcd_barrier(const XcdBarrier& b) {
    asm volatile("s_waitcnt vmcnt(0)" ::: "memory");
    __syncthreads();
    unsigned* bar = b.bar; asm volatile("" : "+s"(bar));
    if (threadIdx.x == 0) {
        __builtin_amdgcn_s_waitcnt(0);
        unsigned nloc = b.st[0], nx = b.st[1];
        if (nloc == 0u) { xcd_barrier_complete(bar, b.x, nloc, nx); b.st[0] = nloc; b.st[1] = nx; }
        const unsigned old = xb_add(&bar[XB_XSUB(b.x)], 1u);
        const unsigned gen = old / nloc;
        if (old + 1u == (gen + 1u) * nloc) {
            __builtin_amdgcn_fence(__ATOMIC_RELEASE, "agent");
            asm volatile("s_waitcnt vmcnt(0)" ::: "memory");
            const unsigned og = xb_add(&bar[XB_TOP], 1u);
            const unsigned tg = og / nx;
            if (og + 1u == (tg + 1u) * nx) xb_add(&bar[XB_TOPGEN], 1u);
            else XB_SPIN(xb_ld(&bar[XB_TOPGEN]) == tg, bar);
            __builtin_amdgcn_fence(__ATOMIC_ACQUIRE, "agent");
            xb_add(&bar[XB_XGEN(b.x)], 1u);
            asm volatile("s_waitcnt vmcnt(0)" ::: "memory");
        } else {
            XB_SPIN(xb_ld(&bar[XB_XGEN(b.x)]) == gen, bar);
            __builtin_amdgcn_fence(__ATOMIC_ACQUIRE, "agent");
            asm volatile("s_waitcnt vmcnt(0)" ::: "memory");
        }
    }
    __syncthreads();
}

struct Args {
    const float* in[33];
    float* out;
    unsigned char* ws;
    int ph_lo, ph_hi;
};
enum { I_X = 0, I_C, I_POS, I_WADA, I_BADA, I_G1, I_G2, I_WIN, I_POSK, I_POSV, I_W1K, I_B1K, I_W2K, I_B2K, I_W1V, I_B1V, I_W2V, I_B2V,
       I_GQ, I_GKV, I_WQUP, I_WKVUP, I_GOA, I_GOB, I_GOC, I_WOUT, I_WR, I_BR, I_WE1, I_BE1, I_WE2, I_BE2, I_GF };

struct Ctx {
    LAS unsigned char* lds;
    const Args* a;
    unsigned char* ws;
    int tid, lane, wave, blk, G, vcu;
    size_t dofs; int dcnt;
};
DI const float* ginp(const Ctx& F, int i) { return (const float*)(GAS const float*)(F.a->in[i]); }
DI float* gout(const Ctx& F) { return (float*)(GAS float*)(F.a->out); }

namespace pg8 {
constexpr int BM = 256, BK = 64, HALF = 128, HTB = HALF * BK * 2;
DI int lds_byte(int r, int c) { const int st = (r >> 4) * 2 + (c >> 5), rr = r & 15, cc = c & 31, ob = rr * 64 + cc * 2; return st * 1024 + (ob ^ (((ob >> 9) & 1) << 5)); }
DI void stage_rc(int b, int& R, int& C) { const int st = b / 1024, sb = b % 1024, swz = sb ^ (((sb >> 9) & 1) << 5); R = (st >> 1) * 16 + swz / 64; C = (st & 1) * 32 + (swz % 64) / 2; }
DI int perm32(int rho) { const int n = rho >> 4, i = rho & 15; return 8 * (i >> 2) + 4 * n + (i & 3); }
struct Unit { const char* a; const char* b; int pm, pn, e, ml; };
template <class E_, class = void> struct acc_bias_t { static constexpr bool value = false; };
template <class E_> struct acc_bias_t<E_, decltype((void)E_::ACC_BIAS)> { static constexpr bool value = E_::ACC_BIAS; };
template <class E_> constexpr bool acc_bias_v = acc_bias_t<E_>::value;
template <class E_, class = void> struct perm2_t { static constexpr bool value = false; };
template <class E_> struct perm2_t<E_, decltype((void)E_::PERM2)> { static constexpr bool value = E_::PERM2; };
template <class E_> constexpr bool perm2_v = perm2_t<E_>::value;

template <class Epi, class Sched, bool GATHER, bool FP8 = false>
DI void gemm_phase(LAS unsigned char* lds, const int lda, const int K, const Sched& S, const Epi& E) {
    typedef int i32x4_ __attribute__((ext_vector_type(4))); typedef int i32x8_ __attribute__((ext_vector_type(8)));
    int tid_ = threadIdx.x; asm volatile("" : "+v"(tid_));
    const int tid = tid_, wid = __builtin_amdgcn_readfirstlane(tid >> 6), lane = tid & 63, wr = wid >> 2, wc = wid & 3, fr = lane & 15, fq = lane >> 4;
    const int nt = K / BK;
    int Rr[2], Cc[2]; unsigned voffB[2];
#pragma unroll
    for (int i = 0; i < 2; ++i) { int R, C; stage_rc(tid * 16 + i * 8192, R, C); Rr[i] = R; Cc[i] = C; const int Rb = perm2_v<Epi> ? ((R >> 5) * 64 + 16 * ((R & 15) >> 2) + 4 * ((R >> 4) & 1) + (R & 3)) : (Epi::PERM ? ((R & ~31) + perm32(R & 31)) : R); voffB[i] = (unsigned)(Rb * K + C) * 2u; }
    const size_t kstep = (size_t)(BK * 2);
    const size_t hstepB = (size_t)(perm2_v<Epi> ? 8 : HALF) * K * 2;
    const size_t istepB = (size_t)(perm2_v<Epi> ? 128 : 64) * K * 2;
    const unsigned ldsw = (unsigned)wid * 1024u;
    const int aoff = lds_byte(wr * 64 + fr, fq * 8), boff = lds_byte(wc * 32 + fr, fq * 8);
#define PG8_SA(b, h) (((b) * 2 + (h)) * HTB)
#define PG8_SB(b, h) ((4 + (b) * 2 + (h)) * HTB)
#define PG8_STAGE_B(bufoff, gbase) do { _Pragma("unroll") for (int _i = 0; _i < 2; ++_i) \
        __builtin_amdgcn_global_load_lds((const unsigned*)((const char*)(gbase) + (size_t)_i * istepB + voffB[0]), (LAS unsigned*)(lds + (bufoff) + ldsw + _i * 8192), 16, 0, 0); } while (0)
#define PG8_STAGE_A(bufoff, gbase, v, h) do { _Pragma("unroll") for (int _i = 0; _i < 2; ++_i) { \
        if constexpr (GATHER) __builtin_amdgcn_global_load_lds((const unsigned*)((const char*)(gbase) + (v)[h][_i]), (LAS unsigned*)(lds + (bufoff) + ldsw + _i * 8192), 16, 0, 0); \
        else __builtin_amdgcn_global_load_lds((const unsigned*)((const char*)(gbase) + (size_t)((h) * 128 + _i * 64) * lda * 2 + (v)[0][0]), (LAS unsigned*)(lds + (bufoff) + ldsw + _i * 8192), 16, 0, 0); } } while (0)
#define PG8_SETOFF(v, u) do { _Pragma("unroll") for (int _h = 0; _h < 2; ++_h) _Pragma("unroll") for (int _i = 0; _i < 2; ++_i) { \
        if constexpr (GATHER) (v)[_h][_i] = S.gather_off((u), _h * 128 + Rr[_i]) + (unsigned)Cc[_i] * 2u; \
        else (v)[_h][_i] = (unsigned)((_h * 128 + Rr[_i]) * lda + Cc[_i]) * 2u; } } while (0)
#define PG8_LDA(dst, b, h) do { _Pragma("unroll") for (int m = 0; m < 4; ++m) { const i32x4_ lo_ = *(const LAS i32x4_*)(lds + PG8_SA(b, h) + aoff + m * 2048), hi_ = *(const LAS i32x4_*)(lds + PG8_SA(b, h) + aoff + m * 2048 + 1024); dst[m] = __builtin_shufflevector(lo_, hi_, 0, 1, 2, 3, 4, 5, 6, 7); } } while (0)
#define PG8_LDB(dst, b, h) do { _Pragma("unroll") for (int n = 0; n < 2; ++n) { const i32x4_ lo_ = *(const LAS i32x4_*)(lds + PG8_SB(b, h) + boff + n * 2048), hi_ = *(const LAS i32x4_*)(lds + PG8_SB(b, h) + boff + n * 2048 + 1024); dst[n] = __builtin_shufflevector(lo_, hi_, 0, 1, 2, 3, 4, 5, 6, 7); } } while (0)
#define PG8_H0(x) __builtin_bit_cast(bf16x8, __builtin_shufflevector((x), (x), 0, 1, 2, 3))
#define PG8_H1(x) __builtin_bit_cast(bf16x8, __builtin_shufflevector((x), (x), 4, 5, 6, 7))
#define PG8_MMA(ai, bj, At, Bt) do { __builtin_amdgcn_s_setprio(1); \
        if constexpr (FP8) { _Pragma("unroll") for (int m = 0; m < 4; ++m) _Pragma("unroll") for (int n = 0; n < 2; ++n) \
            asm volatile("v_mfma_scale_f32_16x16x128_f8f6f4 %0, %1, %2, %0, %3, %4 op_sel_hi:[0,0,0]" : "+v"(acc[ai][bj][m][n]) : "v"(Bt[n]), "v"(At[m]), "v"(scw_), "v"(sca_)); } \
        else { _Pragma("unroll") for (int m = 0; m < 4; ++m) _Pragma("unroll") for (int n = 0; n < 2; ++n) { \
            acc[ai][bj][m][n] = __builtin_amdgcn_mfma_f32_16x16x32_bf16(PG8_H0(Bt[n]), PG8_H0(At[m]), acc[ai][bj][m][n], 0, 0, 0); \
            acc[ai][bj][m][n] = __builtin_amdgcn_mfma_f32_16x16x32_bf16(PG8_H1(Bt[n]), PG8_H1(At[m]), acc[ai][bj][m][n], 0, 0, 0); } } \
        __builtin_amdgcn_s_setprio(0); } while (0)
#define PG8_WAIT_V(n) asm volatile("s_waitcnt vmcnt(" #n ")" ::: "memory")
#define PG8_WAIT_L(n) asm volatile("s_waitcnt lgkmcnt(" #n ")" ::: "memory")
#define PG8_BAR __builtin_amdgcn_s_barrier()
#define PG8_SCHED __builtin_amdgcn_sched_barrier(0)
    Unit cur, nxt; int ui = 0;
    if (!S.next(0, cur)) return;
    f32x4 acc[2][2][4][2];
    f32x4 bv[2][2] = {{{0.f, 0.f, 0.f, 0.f}, {0.f, 0.f, 0.f, 0.f}}, {{0.f, 0.f, 0.f, 0.f}, {0.f, 0.f, 0.f, 0.f}}};
    if constexpr (acc_bias_v<Epi>) E.bias(cur, wc, fq, bv);
#pragma unroll
    for (int a = 0; a < 2; ++a)
#pragma unroll
        for (int b = 0; b < 2; ++b)
#pragma unroll
            for (int m = 0; m < 4; ++m)
#pragma unroll
                for (int n = 0; n < 2; ++n) acc[a][b][m][n] = bv[b][n];
    int scw_ = W8_E8M0, sca_ = A8_E8M0; if constexpr (FP8) sca_ = Epi::A_E8M0;
    i32x8_ At[4], B0[2], B1[2];
    unsigned vA[2][2], vAn[2][2];
    PG8_SETOFF(vA, cur);
    const char* cA = cur.a; const char* cB = cur.b;
    PG8_STAGE_B(PG8_SB(0, 0), cB); PG8_STAGE_B(PG8_SB(0, 1), cB + hstepB); PG8_STAGE_A(PG8_SA(0, 0), cA, vA, 0); PG8_STAGE_A(PG8_SA(0, 1), cA, vA, 1);
    if (wr == 1) PG8_BAR;
    PG8_WAIT_V(2); PG8_BAR;
    PG8_STAGE_B(PG8_SB(1, 0), cB + kstep); PG8_STAGE_A(PG8_SA(1, 0), cA + kstep, vA, 0); PG8_STAGE_B(PG8_SB(1, 1), cB + hstepB + kstep);
    PG8_WAIT_V(6); PG8_BAR;
    for (;;) {
        const bool has_next = S.next(ui + 1, nxt);
        if constexpr (GATHER) {
            if (has_next) {
#pragma unroll
                for (int h = 0; h < 2; ++h)
#pragma unroll
                    for (int i = 0; i < 2; ++i) vAn[h][i] = S.gather_raw(nxt, h * 128 + Rr[i]);
            }
        }
        const char* nA = has_next ? nxt.a : cA; const char* nB = has_next ? nxt.b : cB;
#pragma unroll 1
        for (int t = 0; t < nt; t += 2) {
            const bool last = (t == nt - 2);
            const char* a1 = cA + (size_t)(t + 1) * kstep;
            const char* a2 = last ? nA : cA + (size_t)(t + 2) * kstep; const char* b2 = last ? nB : cB + (size_t)(t + 2) * kstep;
            const char* a3 = a2 + kstep; const char* b3 = b2 + kstep;
            unsigned v2[2][2];
#pragma unroll
            for (int h = 0; h < 2; ++h)
#pragma unroll
                for (int i = 0; i < 2; ++i) v2[h][i] = vA[h][i];
            if constexpr (GATHER) {
                if (last && has_next) {
#pragma unroll
                    for (int h = 0; h < 2; ++h)
#pragma unroll
                        for (int i = 0; i < 2; ++i) { vAn[h][i] = vAn[h][i] * (unsigned)(lda * 2) + (unsigned)Cc[i] * 2u; v2[h][i] = vAn[h][i]; }
                }
            }
            PG8_LDB(B0, 0, 0); PG8_LDB(B1, 0, 1); PG8_SCHED; PG8_LDA(At, 0, 0); PG8_STAGE_A(PG8_SA(1, 1), a1, vA, 1);
            PG8_WAIT_V(8); PG8_WAIT_L(0); PG8_BAR; PG8_MMA(0, 0, At, B0); PG8_MMA(0, 1, At, B1); PG8_BAR; PG8_SCHED;
            PG8_LDA(At, 0, 1); PG8_STAGE_B(PG8_SB(0, 0), b2); PG8_STAGE_B(PG8_SB(0, 1), b2 + hstepB); PG8_STAGE_A(PG8_SA(0, 0), a2, v2, 0);
            PG8_WAIT_V(8); PG8_WAIT_L(0); PG8_BAR; PG8_MMA(1, 0, At, B0); PG8_MMA(1, 1, At, B1); PG8_BAR; PG8_SCHED;
            PG8_LDB(B0, 1, 0); PG8_LDB(B1, 1, 1); PG8_SCHED; PG8_LDA(At, 1, 0); PG8_STAGE_A(PG8_SA(0, 1), a2, v2, 1);
            PG8_WAIT_V(8); PG8_WAIT_L(0); PG8_BAR; PG8_MMA(0, 0, At, B0); PG8_MMA(0, 1, At, B1); PG8_BAR; PG8_SCHED;
            PG8_LDA(At, 1, 1); PG8_STAGE_B(PG8_SB(1, 0), b3); PG8_STAGE_B(PG8_SB(1, 1), b3 + hstepB); PG8_STAGE_A(PG8_SA(1, 0), a3, v2, 0);
            PG8_WAIT_V(8); PG8_WAIT_L(0); PG8_BAR; PG8_MMA(1, 0, At, B0); PG8_MMA(1, 1, At, B1); PG8_BAR; PG8_SCHED;
        }
        if (wr == 0) PG8_BAR;
        if constexpr (FP8) asm volatile("s_nop 15\n\ts_nop 15" ::: "memory");
        if constexpr (acc_bias_v<Epi>) E.bias(has_next ? nxt : cur, wc, fq, bv);
        if constexpr (!Epi::AFTER_DRAIN) { int fr_ = fr, fq_ = fq; asm volatile("" : "+v"(fr_), "+v"(fq_)); E(acc, cur, wr, wc, fr_, fq_); }
        if (!has_next) break;
#pragma unroll
        for (int a = 0; a < 2; ++a)
#pragma unroll
            for (int b = 0; b < 2; ++b)
#pragma unroll
                for (int m = 0; m < 4; ++m)
#pragma unroll
                    for (int n = 0; n < 2; ++n) acc[a][b][m][n] = bv[b][n];
        cur = nxt; cA = nA; cB = nB; ++ui;
        if constexpr (GATHER) {
#pragma unroll
            for (int h = 0; h < 2; ++h)
#pragma unroll
                for (int i = 0; i < 2; ++i) vA[h][i] = vAn[h][i];
        }
        if (wr == 1) PG8_BAR;
    }
    PG8_WAIT_V(0);
    PG8_BAR;
    if constexpr (Epi::AFTER_DRAIN) { int fr_ = fr, fq_ = fq; asm volatile("" : "+v"(fr_), "+v"(fq_)); E.fused(acc, cur, wr, wc, fr_, fq_, lds, wid, lane); }
#undef PG8_SA
#undef PG8_SB
#undef PG8_STAGE_A
#undef PG8_STAGE_B
#undef PG8_SETOFF
#undef PG8_LDA
#undef PG8_LDB
#undef PG8_MMA
#undef PG8_H0
#undef PG8_H1
#undef PG8_WAIT_V
#undef PG8_WAIT_L
#undef PG8_BAR
#undef PG8_SCHED
}
}
using pg8::Unit;
typedef f32x4 AccT[2][2][4][2];

struct SchedGrid {
    const char* A; const char* B; int lda, K, nN, nwg, G, c;
    DI bool next(int i, Unit& u) const {
        const int L = i * G + c; if (L >= nwg) return false;
        u.pm = L / nN; u.pn = L % nN; u.e = 0; u.ml = 0;
        u.a = A + (size_t)u.pm * 256 * lda * 2; u.b = B + (size_t)u.pn * 256 * K * 2; return true;
    }
    DI unsigned gather_off(const Unit&, int) const { return 0u; }
    DI unsigned gather_raw(const Unit&, int) const { return 0u; }
};
struct SchedCmp {
    const char* KCMP; const char* VCMP; const char* W; int G, c;
    DI bool next(int i, Unit& u) const {
        const int L = i * G + c; if (L >= 32) return false;
        const int kv = L >> 4, bg = L & 15;
        u.pm = L; u.pn = 0; u.e = kv; u.ml = 0;
        u.a = (kv ? VCMP : KCMP) + (size_t)bg * SP * 64 * 2; u.b = W + (size_t)kv * 256 * 2048 * 2; return true;
    }
    DI unsigned gather_off(const Unit&, int) const { return 0u; }
    DI unsigned gather_raw(const Unit&, int) const { return 0u; }
};
struct SchedMla {
    const char* CQ; const char* MISC; const char* WQ; const char* WKV; int G, c;
    DI bool next(int i, Unit& u) const {
        const int L = i * G + c; if (L >= 512) return false;
        const int which = L >> 8, r = L & 255;
        u.pm = r >> 1; u.pn = r & 1; u.e = which; u.ml = 0;
        u.a = (which ? MISC : CQ) + (size_t)u.pm * 256 * 256 * 2; u.b = (which ? WKV : WQ) + (size_t)u.pn * 256 * 256 * 2; return true;
    }
    DI unsigned gather_off(const Unit&, int) const { return 0u; }
    DI unsigned gather_raw(const Unit&, int) const { return 0u; }
};
template <int NT, bool GATHERED>
struct SchedMoe {
    const LAS int* tb; const LAS int* cnt; const char* A; const char* W; const int* IDX; int total, G, c;
    DI bool next(int i, Unit& u) const {
        const int L = i * G + c; if (L >= total) return false;
        const int mtg = L / NT; u.pn = L % NT;
        const int ln_ = threadIdx.x & 63;
        const int e = __popcll(__ballot(ln_ < 32 && tb[ln_ & 31] <= mtg)) - 1;
        u.e = e; u.ml = mtg - tb[e]; u.pm = mtg;
        u.a = GATHERED ? A : A + (size_t)mtg * 256 * 1024 * 2;
        u.b = W + ((size_t)e * NT * 256 + (size_t)u.pn * 256) * 1024 * 2; return true;
    }
    DI unsigned gather_off(const Unit& u, int row) const {
        const int pos = u.ml * 256 + row; const int tok = (pos < cnt[u.e]) ? IDX[u.e * ECAP + pos] : 0;
        return (unsigned)tok * 2048u;
    }
    DI unsigned gather_raw(const Unit& u, int row) const {
        const int pos = u.ml * 256 + row;
        return (unsigned)IDX[u.e * ECAP + (pos < cnt[u.e] ? pos : 0)];
    }
};

struct SchedMoe1F8 {
    static constexpr bool HOOK = false;
    const LAS int* tb; const LAS int* cnt; const char* A; const char* W; const int* IDX; int total, G, c;
    DI bool next(int i, Unit& u) const {
        const int L = i * G + c; if (L >= total) return false;
        const int mtg = L >> 3; u.pn = L & 7;
        const int ln_ = lane_id();
        const int e = __popcll(__ballot(ln_ < 32 && tb[ln_ & 31] <= mtg)) - 1;
        u.e = e; u.ml = mtg - tb[e]; u.pm = mtg;
        u.a = A; u.b = W + ((size_t)e * 2048 + (size_t)u.pn * 256) * 1024; return true;
    }
    DI unsigned gather_raw(const Unit& u, int row) const { const int pos = u.ml * 256 + row; return (unsigned)IDX[u.e * ECAP + (pos < cnt[u.e] ? pos : 0)]; }
    DI unsigned gather_off(const Unit& u, int row) const { return gather_raw(u, row) * 1024u; }
};
struct SchedMoe2F8 {
    static constexpr bool HOOK = false;
    const LAS int* tb; const char* A; const char* W; int total, G, c;
    DI bool next(int i, Unit& u) const {
        const int L = i * G + c; if (L >= total) return false;
        const int mtg = L >> 2; u.pn = L & 3;
        const int ln_ = lane_id();
        const int e = __popcll(__ballot(ln_ < 32 && tb[ln_ & 31] <= mtg)) - 1;
        u.e = e; u.ml = mtg - tb[e]; u.pm = mtg;
        u.a = A + (size_t)mtg * 256 * 1024; u.b = W + ((size_t)e * 1024 + (size_t)u.pn * 256) * 1024; return true;
    }
    DI unsigned gather_off(const Unit&, int) const { return 0u; }
    DI unsigned gather_raw(const Unit&, int) const { return 0u; }
};

DI void rot4(f32x4& v0, f32x4& v1, const f32x4 c, const f32x4 s) {
    const float a0 = v0[0], b0 = v0[1], a1 = v0[2], b1 = v0[3], a2 = v1[0], b2 = v1[1], a3 = v1[2], b3 = v1[3];
    v0[0] = a0 * c[0] - b0 * s[0]; v0[1] = b0 * c[0] + a0 * s[0];
    v0[2] = a1 * c[1] - b1 * s[1]; v0[3] = b1 * c[1] + a1 * s[1];
    v1[0] = a2 * c[2] - b2 * s[2]; v1[1] = b2 * c[2] + a2 * s[2];
    v1[2] = a3 * c[3] - b3 * s[3]; v1[3] = b3 * c[3] + a3 * s[3];
}
DI u32x4 pack8(const f32x4 v0, const f32x4 v1) { u32x4 w; w.x = pk2(v0[0], v0[1]); w.y = pk2(v0[2], v0[3]); w.z = pk2(v1[0], v1[1]); w.w = pk2(v1[2], v1[3]); return w; }

struct EpiWin {
    static constexpr bool PERM = true, AFTER_DRAIN = false;
    unsigned char* ws; const float* CS64; const float* CS32;
    DI void dest(int pn, int w0, size_t& off, int& ld, int& dcol, int& mode, int& gm, int& g, float& sc) const {
        mode = 0; gm = 0; g = 0; sc = 1.f;
        switch (pn) {
            case 0: off = WS_QA; ld = 256; dcol = w0; mode = 1; sc = SCL64; break;
            case 1: off = WS_KA; ld = 256; dcol = w0; mode = 1; break;
            case 2: off = WS_VA; ld = 256; dcol = w0; break;
            case 3: off = WS_QB; ld = 512; dcol = w0; mode = 1; sc = SCL64; break;
            case 4: off = WS_QB; ld = 512; dcol = 256 + w0; mode = 1; sc = SCL64; break;
            case 5: off = (w0 < 128) ? WS_KCMP : WS_VCMP; ld = 64; gm = 1; g = (w0 & 127) >> 6; dcol = w0 & 63; break;
            case 6: off = (w0 < 128) ? WS_KSLC : WS_VSLC; ld = 128; dcol = w0 & 127; mode = (w0 < 128) ? 1 : 0; break;
            case 7: off = (w0 < 128) ? WS_KWIN : WS_VWIN; ld = 128; dcol = w0 & 127; mode = (w0 < 128) ? 1 : 0; break;
            case 8: off = WS_CQ; ld = 256; dcol = w0; break;
            default: if (w0 == 128) { off = WS_KR; ld = 32; dcol = 0; mode = 2; } else { off = WS_MISC; ld = 256; dcol = w0; } break;
        }
    }
    DI void operator()(const AccT& acc, const Unit& u, int wr, int wc, int fr, int fq) const {
        size_t off[2]; int ld[2], dcol[2], mode[2], gm[2], g[2]; float sc[2];
#pragma unroll
        for (int bj = 0; bj < 2; ++bj) dest(u.pn, bj * 128 + wc * 32, off[bj], ld[bj], dcol[bj], mode[bj], gm[bj], g[bj], sc[bj]);
        const bool shared = (mode[0] == 1) && (mode[1] == 1);
        const int i0 = 16 * (wc & 1) + 4 * fq;
#pragma unroll
        for (int ai = 0; ai < 2; ++ai) {
            f32x4 cc[4], sn[4];
            if (shared) {
#pragma unroll
                for (int m = 0; m < 4; ++m) { const int row = u.pm * 256 + ai * 128 + wr * 64 + m * 16 + fr; const float* cs = CS64 + (size_t)row * 64 + i0; cc[m] = *(const f32x4*)cs; sn[m] = *(const f32x4*)(cs + 32); }
            }
#pragma unroll
            for (int bj = 0; bj < 2; ++bj) {
                bf16* base = (bf16*)(ws + off[bj]);
                const int md = mode[bj];
                if (md && !shared) {
#pragma unroll
                    for (int m = 0; m < 4; ++m) {
                        const int row = u.pm * 256 + ai * 128 + wr * 64 + m * 16 + fr;
                        const float* cs = (md == 1) ? CS64 + (size_t)row * 64 + i0 : CS32 + (size_t)row * 32 + 4 * fq;
                        cc[m] = *(const f32x4*)cs; sn[m] = *(const f32x4*)(cs + (md == 1 ? 32 : 16));
                    }
                }
#pragma unroll
                for (int m = 0; m < 4; ++m) {
                    const int row = u.pm * 256 + ai * 128 + wr * 64 + m * 16 + fr;
                    f32x4 v0 = acc[ai][bj][m][0], v1 = acc[ai][bj][m][1];
                    if (md) rot4(v0, v1, cc[m], sn[m]);
                    v0 = v0 * sc[bj]; v1 = v1 * sc[bj];
                    const size_t drow = gm[bj] ? (size_t)(((row >> 12) * 2 + g[bj]) * SP + (row & 4095)) : (size_t)row;
                    *(u32x4*)(base + drow * ld[bj] + dcol[bj] + 8 * fq) = pack8(v0, v1);
                }
            }
        }
    }
};
struct EpiCmp {
    static constexpr bool PERM = true, AFTER_DRAIN = true;
    const float* B1P; const bf16* W2T; const float *B2K, *B2V; bf16 *KC, *VC; const float* CS64;
    DI void fused(const AccT& acc, const Unit& u, int wr, int wc, int fr, int fq, LAS unsigned char* lds, int wid, int lane) const {
        constexpr int HST = 528;
        const int kv = u.e, bg = u.pm & 15;
#pragma unroll
        for (int bj = 0; bj < 2; ++bj) {
            const int col = bj * 128 + wc * 32 + 8 * fq;
            const f32x4 b0 = *(const f32x4*)(B1P + kv * 256 + col), b1 = *(const f32x4*)(B1P + kv * 256 + col + 4);
#pragma unroll
            for (int ai = 0; ai < 2; ++ai)
#pragma unroll
                for (int m = 0; m < 4; ++m) {
                    const int rl = ai * 128 + wr * 64 + m * 16 + fr;
                    f32x4 v0 = acc[ai][bj][m][0] + b0, v1 = acc[ai][bj][m][1] + b1;
#pragma unroll
                    for (int j = 0; j < 4; ++j) {
                        float x = v0[j]; float z = 0.7978845608028654f * (x + 0.044715f * x * x * x); v0[j] = x * sigmoidf_(2.f * z);
                        x = v1[j]; z = 0.7978845608028654f * (x + 0.044715f * x * x * x); v1[j] = x * sigmoidf_(2.f * z);
                    }
                    *(LAS u32x4*)(lds + rl * HST + col * 2) = pack8(v0, v1);
                }
        }
        asm volatile("s_waitcnt lgkmcnt(0)\n\ts_barrier" ::: "memory");
        const int r32 = lane & 31, hh = lane >> 5;
        f32x16 out0 = {0.f, 0.f, 0.f, 0.f, 0.f, 0.f, 0.f, 0.f, 0.f, 0.f, 0.f, 0.f, 0.f, 0.f, 0.f, 0.f}, out1 = out0;
        const bf16* w2 = W2T + (size_t)kv * 64 * 256;
#pragma unroll 4
        for (int ks = 0; ks < 16; ++ks) {
            const bf16x8 a = *(const LAS bf16x8*)(lds + (32 * wid + r32) * HST + (16 * ks + 8 * hh) * 2);
            const bf16x8 bq0 = *(const bf16x8*)(w2 + (size_t)r32 * 256 + 16 * ks + 8 * hh), bq1 = *(const bf16x8*)(w2 + (size_t)(32 + r32) * 256 + 16 * ks + 8 * hh);
            out0 = __builtin_amdgcn_mfma_f32_32x32x16_bf16(a, bq0, out0, 0, 0, 0); out1 = __builtin_amdgcn_mfma_f32_32x32x16_bf16(a, bq1, out1, 0, 0, 0);
        }
        const float* b2 = kv ? B2V : B2K;
        const float bb0 = b2[r32], bb1 = b2[32 + r32];
        const int b = bg >> 1;
#pragma unroll
        for (int i = 0; i < 16; ++i) {
            const int c = 32 * wid + 8 * (i >> 2) + 4 * hh + (i & 3);
            const size_t row = (size_t)bg * 256 + c;
            float x1 = out0[i] + bb0, x2 = out1[i] + bb1;
            if (c == 255) { x1 = 0.f; x2 = 0.f; }
            if (kv == 0) {
                const int tokr = (b * S + 16 * c + 31) & (T - 1);
                const float cs = CS64[(size_t)tokr * 64 + r32], sn = CS64[(size_t)tokr * 64 + 32 + r32];
                *(unsigned*)(KC + row * 64 + 2 * r32) = pk2(x1 * cs - x2 * sn, x2 * cs + x1 * sn);
            } else {
                VC[row * 64 + r32] = (bf16)(pk2(x1, 0.f) & 0xffffu); VC[row * 64 + 32 + r32] = (bf16)(pk2(x2, 0.f) & 0xffffu);
            }
        }
    }
};
struct EpiMla {
    static constexpr bool PERM = true, AFTER_DRAIN = false;
    bf16 *QM, *KN, *VM; const bf16 *CQ, *MISC; const float* CS32; LAS float* RS;
    DI void operator()(const AccT& acc, const Unit& u, int wr, int wc, int fr, int fq) const {
#pragma unroll
        for (int ai = 0; ai < 2; ++ai) {
            const int rl = ai * 128 + wr * 64 + wc * 16 + fr, row = u.pm * 256 + rl;
            float ss = 0.f;
            if (u.e == 0) {
#pragma unroll
                for (int c = 0; c < 8; ++c) { const u32x4 w = *(const u32x4*)(CQ + (size_t)row * 256 + fq * 64 + 8 * c);
                    ss += bflo(w.x) * bflo(w.x) + bfhi(w.x) * bfhi(w.x) + bflo(w.y) * bflo(w.y) + bfhi(w.y) * bfhi(w.y) + bflo(w.z) * bflo(w.z) + bfhi(w.z) * bfhi(w.z) + bflo(w.w) * bflo(w.w) + bfhi(w.w) * bfhi(w.w); }
            } else {
#pragma unroll
                for (int c = 0; c < 4; ++c) { const u32x4 w = *(const u32x4*)(MISC + (size_t)row * 256 + fq * 32 + 8 * c);
                    ss += bflo(w.x) * bflo(w.x) + bfhi(w.x) * bfhi(w.x) + bflo(w.y) * bflo(w.y) + bfhi(w.y) * bfhi(w.y) + bflo(w.z) * bflo(w.z) + bfhi(w.z) * bfhi(w.z) + bflo(w.w) * bflo(w.w) + bfhi(w.w) * bfhi(w.w); }
            }
            ss += __shfl_xor(ss, 16); ss += __shfl_xor(ss, 32);
            if (fq == 0) RS[rl] = rsqrtf(ss * (u.e == 0 ? (1.0f / 256.0f) : (1.0f / 128.0f)) + EPS);
        }
        asm volatile("s_waitcnt lgkmcnt(0)\n\ts_barrier" ::: "memory");
        float rstd[2][4];
#pragma unroll
        for (int ai = 0; ai < 2; ++ai)
#pragma unroll
            for (int m = 0; m < 4; ++m) rstd[ai][m] = RS[ai * 128 + wr * 64 + m * 16 + fr];
#pragma unroll
        for (int bj = 0; bj < 2; ++bj) {
            const int gc = u.pn * 256 + bj * 128 + wc * 32;
            bf16* base; int ld, dcol, rope = 0; float sc = 1.f;
            if (u.e == 0) { if (gc >= 384) continue; rope = ((gc >> 5) % 3) == 2; base = QM; ld = 384; dcol = gc; sc = SCL96; }
            else { const int head = gc >> 7, part = (gc & 127) >> 6, o = gc & 63; base = part ? VM : KN; ld = 256; dcol = head * 64 + o; }
#pragma unroll
            for (int ai = 0; ai < 2; ++ai) {
                f32x4 cc[4], sn[4];
                if (rope) {
#pragma unroll
                    for (int m = 0; m < 4; ++m) { const float* cs = CS32 + (size_t)(u.pm * 256 + ai * 128 + wr * 64 + m * 16 + fr) * 32 + 4 * fq; cc[m] = *(const f32x4*)cs; sn[m] = *(const f32x4*)(cs + 16); }
                }
#pragma unroll
                for (int m = 0; m < 4; ++m) {
                    const int row = u.pm * 256 + ai * 128 + wr * 64 + m * 16 + fr;
                    const float r = rstd[ai][m] * sc;
                    f32x4 v0 = acc[ai][bj][m][0] * r, v1 = acc[ai][bj][m][1] * r;
                    if (rope) rot4(v0, v1, cc[m], sn[m]);
                    *(u32x4*)(base + (size_t)row * ld + dcol + 8 * fq) = pack8(v0, v1);
                }
            }
        }
    }
};
struct EpiWout {
    static constexpr bool PERM = true, AFTER_DRAIN = false;
    bf16* X; const float* GT; size_t dofs;
    DI void operator()(const AccT& acc, const Unit& u, int wr, int wc, int fr, int fq) const {
        const int b = (u.pm * 256) >> 12;
        const int col0 = u.pn * 256 + wc * 32 + 8 * fq;
        u32x4 xo[2][2][4]; f32x4 gt[2][2];
#pragma unroll
        for (int bj = 0; bj < 2; ++bj) {
            gt[bj][0] = *(const f32x4*)(GT + (size_t)b * 6144 + col0 + bj * 128); gt[bj][1] = *(const f32x4*)(GT + (size_t)b * 6144 + col0 + bj * 128 + 4);
#pragma unroll
            for (int ai = 0; ai < 2; ++ai)
#pragma unroll
                for (int m = 0; m < 4; ++m) xo[bj][ai][m] = *(const u32x4*)(X + (size_t)(u.pm * 256 + ai * 128 + wr * 64 + m * 16 + fr) * 1024 + col0 + bj * 128);
        }
#pragma unroll
        for (int bj = 0; bj < 2; ++bj)
#pragma unroll
            for (int ai = 0; ai < 2; ++ai)
#pragma unroll
                for (int m = 0; m < 4; ++m) {
                    bf16* p = X + (size_t)(u.pm * 256 + ai * 128 + wr * 64 + m * 16 + fr) * 1024 + col0 + bj * 128;
                    const u32x4 xw = xo[bj][ai][m];
                    const f32x4 x0 = (f32x4){bflo(xw.x), bfhi(xw.x), bflo(xw.y), bfhi(xw.y)} + gt[bj][0] * acc[ai][bj][m][0];
                    const f32x4 x1 = (f32x4){bflo(xw.z), bfhi(xw.z), bflo(xw.w), bfhi(xw.w)} + gt[bj][1] * acc[ai][bj][m][1];
                    u32x4 w; w.x = pk2(x0[0], x0[1]); w.y = pk2(x0[2], x0[3]); w.z = pk2(x1[0], x1[1]); w.w = pk2(x1[2], x1[3]);
                    *(u32x4*)((char*)p + dofs) = w;
                }
    }
};
struct EpiMoe1 {
    static constexpr bool PERM = true, PERM2 = true, AFTER_DRAIN = false; static constexpr int A_E8M0 = H8_E8M0;
    static constexpr bool ACC_BIAS = true;
    bf16* ACT; const float* B1;
    DI void bias(const Unit& u, int wc, int fq, f32x4 (&bv)[2][2]) const {
        const float* bp = B1 + (size_t)u.e * 2048 + u.pn * 256 + wc * 64 + 16 * fq;
#pragma unroll
        for (int bj = 0; bj < 2; ++bj) { bv[bj][0] = *(const f32x4*)(bp + 8 * bj); bv[bj][1] = *(const f32x4*)(bp + 8 * bj + 4); }
    }
    DI void operator()(const AccT& acc, const Unit& u, int wr, int wc, int fr, int fq) const {
        const int col = u.pn * 256 + wc * 64 + 16 * fq;
#pragma unroll
        for (int ai = 0; ai < 2; ++ai)
#pragma unroll
            for (int m = 0; m < 4; ++m) {
                const int row = u.pm * 256 + ai * 128 + wr * 64 + m * 16 + fr;
                float o[8];
#pragma unroll
                for (int bj = 0; bj < 2; ++bj) {
                    const f32x4 v0 = acc[ai][bj][m][0], v1 = acc[ai][bj][m][1];
#pragma unroll
                    for (int j = 0; j < 4; ++j) {
                        const float gl = fminf((j < 2) ? v0[2 * j] : v1[2 * j - 4], 7.0f);
                        const float li = fminf(fmaxf((j < 2) ? v0[2 * j + 1] : v1[2 * j - 3], -7.0f), 7.0f);
                        o[4 * bj + j] = gl * sigmoidf_(1.702f * gl) * (li + 1.0f);
                    }
                }
                u32x2 w8; w8.x = pk4_fp8s(o[0], o[1], o[2], o[3], A8_SCALE); w8.y = pk4_fp8s(o[4], o[5], o[6], o[7], A8_SCALE);
                *(u32x2*)((unsigned char*)ACT + (size_t)row * 1024 + (col >> 1)) = w8;
            }
    }
};
struct EpiMoe2 {
    static constexpr bool PERM = true, PERM2 = true, AFTER_DRAIN = false; static constexpr int A_E8M0 = A8_E8M0;
    static constexpr bool ACC_BIAS = true;
    unsigned char* Y2; const float* B2;
    DI void bias(const Unit& u, int wc, int fq, f32x4 (&bv)[2][2]) const {
        const float* bp = B2 + (size_t)u.e * 1024 + u.pn * 256 + wc * 64 + 16 * fq;
#pragma unroll
        for (int bj = 0; bj < 2; ++bj) { bv[bj][0] = *(const f32x4*)(bp + 8 * bj); bv[bj][1] = *(const f32x4*)(bp + 8 * bj + 4); }
    }
    DI void operator()(const AccT& acc, const Unit& u, int wr, int wc, int fr, int fq) const {
        const int col = u.pn * 256 + wc * 64 + 16 * fq;
#pragma unroll
        for (int ai = 0; ai < 2; ++ai)
#pragma unroll
            for (int m = 0; m < 4; ++m) {
                const size_t row = (size_t)u.pm * 256 + ai * 128 + wr * 64 + m * 16 + fr;
                u32x4 w8;
                { const f32x4 v0 = acc[ai][0][m][0], v1 = acc[ai][0][m][1]; w8.x = pk4_fp8(v0[0], v0[1], v0[2], v0[3]); w8.y = pk4_fp8(v1[0], v1[1], v1[2], v1[3]); }
                { const f32x4 v0 = acc[ai][1][m][0], v1 = acc[ai][1][m][1]; w8.z = pk4_fp8(v0[0], v0[1], v0[2], v0[3]); w8.w = pk4_fp8(v1[0], v1[1], v1[2], v1[3]); }
                *(u32x4*)(Y2 + row * 1024 + col) = w8;
            }
    }
};

#define MFMA32(a, b, c) __builtin_amdgcn_mfma_f32_32x32x16_bf16((a), (b), (c), 0, 0, 0)
typedef short v4i16_t __attribute__((ext_vector_type(4)));
DI s16x4 tr_read(const LAS unsigned char* p) { return __builtin_bit_cast(s16x4, __builtin_amdgcn_ds_read_tr16_b64_v4i16((LAS v4i16_t*)p)); }
constexpr int VST = 144;
template <int DQ> struct AC { static constexpr int KST = DQ * 2 + 16, KS = DQ / 16, KBUF = 64 * KST, VBUF = 64 * VST, BUF = KBUF + VBUF; };

template <int DQ>
DI void qk_tile(const LAS unsigned char* kb, const bf16x8 (&qf)[DQ / 16], f32x16 (&s)[2], const f32x16& cinit, int lane) {
    const int r32 = lane & 31, hh = lane >> 5;
    bf16x8 kf[2][DQ / 16];
#pragma unroll
    for (int rt = 0; rt < 2; ++rt)
#pragma unroll
        for (int ks = 0; ks < DQ / 16; ++ks) kf[rt][ks] = *(const LAS bf16x8*)(kb + (32 * rt + r32) * AC<DQ>::KST + (16 * ks + 8 * hh) * 2);
    f32x16 a0 = MFMA32(kf[0][0], qf[0], cinit), a1 = MFMA32(kf[1][0], qf[0], cinit);
#pragma unroll
    for (int ks = 1; ks < DQ / 16; ++ks) { a0 = MFMA32(kf[0][ks], qf[ks], a0); a1 = MFMA32(kf[1][ks], qf[ks], a1); }
    s[0] = a0; s[1] = a1;
}
DI float max3f_(float a, float b, float c) { return __builtin_fmaxf(__builtin_fmaxf(a, b), c); }
constexpr float RESC_THR = 8.0f;
template <int DQ, int KMUL, int VAR = 0>
DI void attn_tile(const LAS unsigned char* kb, const LAS unsigned char* vb, const bf16x8 (&qf)[DQ / 16], f32x16 (&o)[2], f32x16& negm, float& m, float& l,
                  int dq, unsigned maxd, bool lf, int lane, const bool MASKED) {
    const int hh = lane >> 5;
    if (VAR == 1) return;
    f32x16 s[2];
    qk_tile<DQ>(kb, qf, s, negm, lane);
    if (VAR == 2) { o[0] += s[0]; o[1] += s[1]; return; }
    const int i16 = lane & 15, q = i16 >> 2, p_ = i16 & 3, mh = (lane >> 4) & 1;
    const LAS unsigned char* vbase = vb + (4 * hh + q) * VST + 32 * mh + 8 * p_;
    s16x4 vlo[4][2], vhi[4][2];
#pragma unroll
    for (int st = 0; st < 4; ++st)
#pragma unroll
        for (int mt = 0; mt < 2; ++mt) { vlo[st][mt] = tr_read(vbase + (16 * st) * VST + 64 * mt); vhi[st][mt] = tr_read(vbase + (16 * st + 8) * VST + 64 * mt); }
    __builtin_amdgcn_sched_barrier(0);
    if (MASKED) {
#pragma unroll
        for (int rt = 0; rt < 2; ++rt)
#pragma unroll
            for (int i = 0; i < 16; ++i) {
                const int d = dq - (32 * rt + 8 * (i >> 2) + (i & 3)) * KMUL;
                s[rt][i] = ((unsigned)d <= maxd) ? s[rt][i] : -1e30f;
            }
    }
    float mx = max3f_(s[0][0], s[0][1], s[0][2]);
#pragma unroll
    for (int i = 3; i < 15; i += 2) mx = max3f_(mx, s[0][i], s[0][i + 1]);
    mx = max3f_(mx, s[0][15], s[1][0]);
#pragma unroll
    for (int i = 1; i < 15; i += 2) mx = max3f_(mx, s[1][i], s[1][i + 1]);
    mx = fmaxf(mx, s[1][15]);
    if (__ballot(lf && mx > RESC_THR) != 0ull) {
        float mc = lf ? mx : -1e30f;
        mc = fmaxf(mc, __shfl_xor(mc, 32));
        const float delta = mc > RESC_THR ? mc : 0.f;
        const float alpha = fast_exp2(-delta);
        m += delta; l *= alpha;
#pragma unroll
        for (int i = 0; i < 16; ++i) { negm[i] = -m; o[0][i] *= alpha; o[1][i] *= alpha; s[0][i] -= delta; s[1][i] -= delta; }
    }
    float ps = 0.f;
#pragma unroll
    for (int rt = 0; rt < 2; ++rt)
#pragma unroll
        for (int i = 0; i < 16; ++i) { const float p = fast_exp2(s[rt][i]); s[rt][i] = p; ps += p; }
    const unsigned lmask = lf ? 0xffffffffu : 0u;
    l += lf ? ps : 0.f;
    if (VAR == 3) { o[0] += s[0]; o[1] += s[1]; return; }
#pragma unroll
    for (int rt = 0; rt < 2; ++rt)
#pragma unroll
        for (int s2 = 0; s2 < 2; ++s2) {
            u32x4 pw; pw.x = pk2(s[rt][8 * s2 + 0], s[rt][8 * s2 + 1]) & lmask; pw.y = pk2(s[rt][8 * s2 + 2], s[rt][8 * s2 + 3]) & lmask;
            pw.z = pk2(s[rt][8 * s2 + 4], s[rt][8 * s2 + 5]) & lmask; pw.w = pk2(s[rt][8 * s2 + 6], s[rt][8 * s2 + 7]) & lmask;
            const bf16x8 pb = __builtin_bit_cast(bf16x8, pw);
#pragma unroll
            for (int mt = 0; mt < 2; ++mt) {
                const bf16x8 va = __builtin_shufflevector(vlo[2 * rt + s2][mt], vhi[2 * rt + s2][mt], 0, 1, 2, 3, 4, 5, 6, 7);
                o[mt] = MFMA32(va, pb, o[mt]);
            }
        }
}
constexpr int OSTAGE_WAVE = 32 * 144;
static_assert(102400 + 8 * OSTAGE_WAVE <= MISC_OFF, "O stage below the LDS control words");
struct ChunkId { DI u32x4 operator()(u32x4 v, int, int, int) const { return v; } };
template <class P, class Fx = ChunkId>
DI void store_o_rows(const P& p, LAS unsigned char* lds, int off, const f32x16 (&o)[2], float inv, int lane, int wave, const Fx& fx = Fx()) {
    LAS unsigned char* st = lds + off + wave * OSTAGE_WAVE;
    const int n = lane & 31, hh = lane >> 5;
#pragma unroll
    for (int mt = 0; mt < 2; ++mt)
#pragma unroll
        for (int a = 0; a < 4; ++a) {
            u32x2 w; w.x = pk2(o[mt][4 * a] * inv, o[mt][4 * a + 1] * inv); w.y = pk2(o[mt][4 * a + 2] * inv, o[mt][4 * a + 3] * inv);
            *(LAS u32x2*)(st + n * 144 + (32 * mt + 8 * a + 4 * hh) * 2) = w;
        }
    asm volatile("s_waitcnt lgkmcnt(0)" ::: "memory");
#pragma unroll
    for (int it = 0; it < 4; ++it) {
        const int r = (lane >> 3) + 8 * it, c = lane & 7;
        const u32x4 v = fx(*(const LAS u32x4*)(st + r * 144 + c * 16), wave, r, c);
        *(u32x4*)(p.orow(wave, r) + 8 * c) = v;
    }
}
DI void store_o(bf16* orow, const f32x16 (&o)[2], float inv, int lane) {
    const int hh = lane >> 5;
#pragma unroll
    for (int mt = 0; mt < 2; ++mt)
#pragma unroll
        for (int a = 0; a < 4; ++a) {
            u32x2 w; w.x = pk2(o[mt][4 * a] * inv, o[mt][4 * a + 1] * inv); w.y = pk2(o[mt][4 * a + 2] * inv, o[mt][4 * a + 3] * inv);
            *(u32x2*)(orow + 32 * mt + 8 * a + 4 * hh) = w;
        }
}

struct PolA {
    static constexpr bool HASFLAG = false, LSE = true; static constexpr int KMUL = 1;
    const bf16 *Q, *K, *V; bf16* O; float* LSEP; int b, h, d, r, c; unsigned maxd; int j0, j1;
    DI int ql(int w, int lane) const { return 256 * c + 32 * w + (lane & 31); }
    DI size_t trow(int l_) const { return (size_t)b * S + (size_t)l_ * d + r; }
    DI const bf16* qrow(int w, int lane) const { return Q + trow(ql(w, lane)) * 256 + h * 64; }
    DI int qv(int w, int lane) const { return ql(w, lane); }
    DI int qmin(int w) const { return 256 * c + 32 * w; }
    DI int qmax(int w) const { return 256 * c + 32 * w + 31; }
    DI int kv0(int j) const { return 256 * c - 128 + 64 * j; }
    DI const bf16* krow(int j, int row) const { return K + trow(kv0(j) + row) * 256 + h * 64; }
    DI const bf16* vrow(int j, int row) const { return V + trow(kv0(j) + row) * 256 + h * 64; }
    DI const bf16* rrow(int, int) const { return nullptr; }
    DI bool flag(int, int, int) const { return true; }
    DI bf16* orow(int w, int lane) const { return O + trow(ql(w, lane)) * 256 + h * 64; }
    DI void lse(int w, int lane, float v) const { LSEP[trow(ql(w, lane)) * 4 + h] = v; }
};
struct PolB {
    static constexpr bool LSE = false; static constexpr int KMUL = 1;
    const bf16 *Q, *K, *V; bf16* O; int b, g, qc; unsigned maxd; int j0, j1; u64 sel; bool hasflag;
    const bf16 *GC = nullptr, *GW = nullptr, *GM = nullptr;
    DI int tok(int w, int lane) const { return 64 * qc + 8 * w + ((lane & 31) >> 2); }
    DI const bf16* qrow(int w, int lane) const { return Q + ((size_t)b * S + tok(w, lane)) * 512 + (4 * g + (lane & 3)) * 64; }
    DI int qv(int w, int lane) const { return tok(w, lane); }
    DI int qmin(int w) const { return 64 * qc + 8 * w; }
    DI int qmax(int w) const { return 64 * qc + 8 * w + 7; }
    DI int kv0(int j) const { return 64 * j; }
    DI const bf16* krow(int j, int row) const { return K + ((size_t)b * S + 64 * j + row) * 128 + g * 64; }
    DI const bf16* vrow(int j, int row) const { return V + ((size_t)b * S + 64 * j + row) * 128 + g * 64; }
    DI const bf16* rrow(int, int) const { return nullptr; }
    DI bf16* orow(int w, int lane) const { return O + ((size_t)b * S + tok(w, lane)) * 512 + (4 * g + (lane & 3)) * 64; }
    DI void lse(int, int, float) const {}
};
struct PolM {
    static constexpr bool HASFLAG = false, LSE = false; static constexpr int KMUL = 1;
    const bf16 *Q, *KN, *KR, *V; bf16* O; int b, h, c; unsigned maxd; int j0, j1;
    DI int tok(int w, int lane) const { return 256 * c + 32 * w + (lane & 31); }
    DI const bf16* qrow(int w, int lane) const { return Q + ((size_t)b * S + tok(w, lane)) * 384 + h * 96; }
    DI int qv(int w, int lane) const { return tok(w, lane); }
    DI int qmin(int w) const { return 256 * c + 32 * w; }
    DI int qmax(int w) const { return 256 * c + 32 * w + 31; }
    DI int kv0(int j) const { return 64 * j; }
    DI const bf16* krow(int j, int row) const { return KN + ((size_t)b * S + 64 * j + row) * 256 + h * 64; }
    DI const bf16* vrow(int j, int row) const { return V + ((size_t)b * S + 64 * j + row) * 256 + h * 64; }
    DI const bf16* rrow(int j, int row) const { return KR + ((size_t)b * S + 64 * j + row) * 32; }
    DI bf16* orow(int w, int lane) const { return O + ((size_t)b * S + tok(w, lane)) * 256 + h * 64; }
    DI void lse(int, int, float) const {}
};

template <int DQ, class P, bool FLAG, int VAR = 0>
DI void attn_unit(const P& p, LAS unsigned char* lds, int tid, int lane, int wave, u64 sel) {
    typedef AC<DQ> C;
    const int hh = lane >> 5;
    const bf16* qrow = p.qrow(wave, lane);
    bf16x8 qf[DQ / 16];
#pragma unroll
    for (int ks = 0; ks < DQ / 16; ++ks) qf[ks] = *(const bf16x8*)(qrow + 16 * ks + 8 * hh);
#pragma unroll
    for (int ks = 0; ks < DQ / 16; ++ks) asm volatile("s_waitcnt vmcnt(0)" : "+v"(qf[ks]) :: "memory");
    const int qv = p.qv(wave, lane), wq0 = p.qmin(wave), wq1 = p.qmax(wave);
    f32x16 o[2];
#pragma unroll
    for (int mt = 0; mt < 2; ++mt)
#pragma unroll
        for (int i = 0; i < 16; ++i) o[mt][i] = 0.f;
    float m = 0.f, l = 0.f;
    f32x16 negm;
#pragma unroll
    for (int i = 0; i < 16; ++i) negm[i] = 0.f;
    const int j0 = p.j0, j1 = p.j1;
    const int lrow = tid >> 3, lch = tid & 7;
    u32x4 k0A, v0A, r0A = {0u, 0u, 0u, 0u}, k1A, v1A, r1A = {0u, 0u, 0u, 0u}, k0B, v0B, r0B = {0u, 0u, 0u, 0u}, k1B, v1B, r1B = {0u, 0u, 0u, 0u};
    constexpr int NLD = (DQ == 96) ? 6 : 4;
    const int npair = (j1 - j0 + 1) >> 1;
#define ATT_LOAD1(RK, RV, RR, j) do { const bf16* pk_ = p.krow((j), lrow) + 8 * lch; const bf16* pv_ = p.vrow((j), lrow) + 8 * lch; \
        asm volatile("global_load_dwordx4 %0, %2, off\n\tglobal_load_dwordx4 %1, %3, off" : "=&v"(RK), "=&v"(RV) : "v"(pk_), "v"(pv_) : "memory"); \
        if (DQ == 96) { const bf16* pr_ = p.rrow((j), (tid & 255) >> 2) + 8 * (tid & 3); asm volatile("global_load_dwordx4 %0, %1, off" : "=&v"(RR) : "v"(pr_) : "memory"); } } while (0)
#define ATT_LOADP(K0, V0, R0, K1, V1, R1, t) do { const int ja_ = j0 + 2 * (t), jb_ = ja_ + 1; \
        { const int jc_ = ja_ < j1 ? ja_ : j1 - 1; ATT_LOAD1(K0, V0, R0, jc_); } { const int jd_ = jb_ < j1 ? jb_ : j1 - 1; ATT_LOAD1(K1, V1, R1, jd_); } } while (0)
#define ATT_TILE(kb_, jt_) do { const int j_ = (jt_); const int kv0 = p.kv0(j_); \
        bool need = (j_ < j1) && (wq1 - kv0 >= 0) && ((long long)wq0 - (long long)(kv0 + 63 * P::KMUL) <= (long long)p.maxd); \
        const bool interior = (wq0 - (kv0 + 63 * P::KMUL) >= 0) && ((long long)wq1 - (long long)kv0 <= (long long)p.maxd); \
        bool lf = true; \
        if (FLAG) { lf = ((sel >> j_) & 1ull) != 0ull; need = need && (__ballot(lf) != 0ull); } \
        if (need) attn_tile<DQ, P::KMUL, VAR>((kb_), (kb_) + C::KBUF, qf, o, negm, m, l, qv - kv0 - 4 * hh * P::KMUL, p.maxd, lf, lane, !interior); } while (0)
#define ATT_STEP(K0, V0, R0, K1, V1, R1, tt) do { const int t_ = (tt); \
        LAS unsigned char* pbuf = lds + (t_ & 1) * (2 * C::BUF); \
        asm volatile("s_waitcnt vmcnt(%6)" : "+v"(K0), "+v"(V0), "+v"(R0), "+v"(K1), "+v"(V1), "+v"(R1) : "n"(NLD) : "memory"); \
        *(LAS u32x4*)(pbuf + lrow * C::KST + lch * 16) = K0; *(LAS u32x4*)(pbuf + C::KBUF + lrow * VST + lch * 16) = V0; \
        *(LAS u32x4*)(pbuf + C::BUF + lrow * C::KST + lch * 16) = K1; *(LAS u32x4*)(pbuf + C::BUF + C::KBUF + lrow * VST + lch * 16) = V1; \
        if (DQ == 96) { *(LAS u32x4*)(pbuf + ((tid & 255) >> 2) * C::KST + 128 + (tid & 3) * 16) = R0; *(LAS u32x4*)(pbuf + C::BUF + ((tid & 255) >> 2) * C::KST + 128 + (tid & 3) * 16) = R1; } \
        asm volatile("s_waitcnt lgkmcnt(0)\n\ts_barrier" ::: "memory"); \
        ATT_LOADP(K0, V0, R0, K1, V1, R1, t_ + 2); \
        if (ATT_STAGGER > 0 && wave >= 4) __builtin_amdgcn_s_sleep(ATT_STAGGER); \
        ATT_TILE(pbuf, j0 + 2 * t_); ATT_TILE(pbuf + C::BUF, j0 + 2 * t_ + 1); } while (0)
    ATT_LOADP(k0A, v0A, r0A, k1A, v1A, r1A, 0);
    ATT_LOADP(k0B, v0B, r0B, k1B, v1B, r1B, 1);
    if (wave >= 4) __builtin_amdgcn_s_setprio(1);
#pragma unroll 1
    for (int t = 0; t < npair; t += 2) {
        ATT_STEP(k0A, v0A, r0A, k1A, v1A, r1A, t);
        ATT_STEP(k0B, v0B, r0B, k1B, v1B, r1B, t + 1);
    }
    __builtin_amdgcn_s_setprio(0);
    asm volatile("s_waitcnt vmcnt(0)" : "+v"(k0A), "+v"(v0A), "+v"(r0A), "+v"(k1A), "+v"(v1A), "+v"(r1A), "+v"(k0B), "+v"(v0B), "+v"(r0B), "+v"(k1B), "+v"(v1B), "+v"(r1B) :: "memory");
#undef ATT_LOAD1
#undef ATT_LOADP
#undef ATT_TILE
#undef ATT_STEP
    const float lt = l + __shfl_xor(l, 32);
    const float inv = lt > 0.f ? 1.0f / lt : 0.f;
    if constexpr (FLAG) {
        struct Gate { const P& p;
            DI u32x4 operator()(u32x4 v, int w_, int r, int c) const {
                const size_t tg = (size_t)p.b * S + 64 * p.qc + 8 * w_ + (r >> 2); const int hd = 4 * p.g + (r & 3);
                const bf16* gl = p.GM + tg * 256 + 160 + hd * 3;
                const float g0 = sigmoidf_(bf2f(gl[0])), g1 = sigmoidf_(bf2f(gl[1])), g2 = sigmoidf_(bf2f(gl[2]));
                const u32x4 a = *(const u32x4*)(p.GC + tg * 512 + hd * 64 + 8 * c), d = *(const u32x4*)(p.GW + tg * 512 + hd * 64 + 8 * c);
                u32x4 r_;
                r_.x = pk2(g0 * bflo(a.x) + g1 * bflo(v.x) + g2 * bflo(d.x), g0 * bfhi(a.x) + g1 * bfhi(v.x) + g2 * bfhi(d.x));
                r_.y = pk2(g0 * bflo(a.y) + g1 * bflo(v.y) + g2 * bflo(d.y), g0 * bfhi(a.y) + g1 * bfhi(v.y) + g2 * bfhi(d.y));
                r_.z = pk2(g0 * bflo(a.z) + g1 * bflo(v.z) + g2 * bflo(d.z), g0 * bfhi(a.z) + g1 * bfhi(v.z) + g2 * bfhi(d.z));
                r_.w = pk2(g0 * bflo(a.w) + g1 * bflo(v.w) + g2 * bflo(d.w), g0 * bfhi(a.w) + g1 * bfhi(v.w) + g2 * bfhi(d.w));
                return r_; } } gate{p};
        store_o_rows(p, lds, 90112, o, inv, lane, wave, gate);
    } else store_o_rows(p, lds, DQ == 96 ? 102400 : 90112, o, inv, lane, wave);
    if (P::LSE) { if (hh == 0) p.lse(wave, lane, m + __log2f(lt)); }
    __syncthreads();
}

DI u64 cmp_unit(const Ctx& F, int b, int g, int qc) {
    constexpr int KST = 144;
    LAS unsigned char* KL = F.lds; LAS unsigned char* VL = F.lds + 256 * KST; LAS float* IMP = (LAS float*)(F.lds + 2 * 256 * KST);
    const bf16* KC = (const bf16*)(F.ws + WS_KC) + (size_t)(b * 2 + g) * 256 * 64;
    const bf16* VC = (const bf16*)(F.ws + WS_VC) + (size_t)(b * 2 + g) * 256 * 64;
    const int tid = F.tid, lane = F.lane, w = F.wave, hh = lane >> 5, r32 = lane & 31;
    const int tokl = 8 * w + (r32 >> 2), tok = 64 * qc + tokl, head = 4 * g + (lane & 3);
    const bf16* qrow = (const bf16*)(F.ws + WS_QB) + ((size_t)b * S + tok) * 512 + head * 64;
    bf16x8 qf[4];
#pragma unroll
    for (int ks = 0; ks < 4; ++ks) qf[ks] = *(const bf16x8*)(qrow + 16 * ks + 8 * hh);
#pragma unroll
    for (int it = 0; it < 4; ++it) { const int idx = tid + 512 * it, row = idx >> 3, ch = idx & 7;
        *(LAS u32x4*)(KL + row * KST + ch * 16) = *(const u32x4*)(KC + row * 64 + ch * 8);
        *(LAS u32x4*)(VL + row * VST + ch * 16) = *(const u32x4*)(VC + row * 64 + ch * 8); }
    __syncthreads();
    const int qv = tok - 31, wq1 = 64 * qc + 8 * w + 7 - 31;
    f32x16 o[2];
#pragma unroll
    for (int mt = 0; mt < 2; ++mt)
#pragma unroll
        for (int i = 0; i < 16; ++i) o[mt][i] = 0.f;
    float m = 0.f, l = 0.f;
    f32x16 negm;
#pragma unroll
    for (int i = 0; i < 16; ++i) negm[i] = 0.f;
    const int wq0 = 64 * qc + 8 * w - 31;
#pragma unroll 1
    for (int jt = 0; jt < 4; ++jt) {
        if (wq1 - 1024 * jt >= 0) {
            const int dq = qv - 1024 * jt - 4 * hh * 16;
            attn_tile<64, 16>(KL + jt * 64 * KST, VL + jt * 64 * VST, qf, o, negm, m, l, dq, 0x7fffffffu, true, lane, !(wq0 - (1024 * jt + 63 * 16) >= 0));
        }
    }
    const float lt = l + __shfl_xor(l, 32);
    const float inv = lt > 0.f ? 1.0f / lt : 0.f;
    { struct { bf16* O; int b, g, qc; DI bf16* orow(int w_, int n_) const { return O + ((size_t)b * S + 64 * qc + 8 * w_ + (n_ >> 2)) * 512 + (4 * g + (n_ & 3)) * 64; } } pc{(bf16*)(F.ws + WS_OCMP), b, g, qc};
      store_o_rows(pc, F.lds, 90112, o, inv, lane, w); }
    float prev = 0.f;
#pragma unroll 1
    for (int jt = 0; jt < 4; ++jt) {
        const bool need = (wq1 - 1024 * jt >= 0);
        f32x16 s[2];
        if (need) qk_tile<64>(KL + jt * 64 * KST, qf, s, negm, lane);
#pragma unroll
        for (int rt = 0; rt < 2; ++rt)
#pragma unroll
            for (int a = 0; a < 4; ++a) {
                float mainp = 0.f, sp = 0.f;
                if (need) {
                    float pb[4];
#pragma unroll
                    for (int bb = 0; bb < 4; ++bb) { const int kidx = 64 * jt + 32 * rt + 8 * a + 4 * hh + bb; const bool ok = (qv - 16 * kidx) >= 0; pb[bb] = ok ? fast_exp2(s[rt][4 * a + bb]) * inv : 0.f; }
                    mainp = pb[0] + pb[1] + pb[2] + 0.5f * pb[3]; sp = 0.5f * pb[3];
                }
                const float rc = __shfl_xor(sp, 32);
                float v = mainp + (hh ? rc : prev);
                prev = rc;
                v += __shfl_xor(v, 1); v += __shfl_xor(v, 2);
                if ((lane & 3) == 0) IMP[tokl * 64 + 2 * (8 * jt + 4 * rt + a) + hh] = v;
            }
    }
    __syncthreads();
    u64 mysel = 0ull;
#pragma unroll 1
    for (int tk = 0; tk < 8; ++tk) {
        const int tl = 8 * w + tk, t = 64 * qc + tl, j = lane;
        const float v = IMP[tl * 64 + j];
        const bool forced = (j == 0) || (j == qc) || (j == qc - 1);
        const bool valid = j <= qc;
        const float score = forced ? v + 1e4f : (valid ? v : -1.0f);
        int rank = 0;
#pragma unroll
        for (int jp = 0; jp < 64; ++jp) { const float o_ = __builtin_bit_cast(float, __builtin_amdgcn_readlane(__builtin_bit_cast(int, score), jp)); rank += ((o_ > score) || (o_ == score && jp < j)) ? 1 : 0; }
        const u64 mask = __ballot(rank < 16);
        (void)t;
        if (tk == (r32 >> 2)) mysel = mask;
    }
    __syncthreads();
    return mysel;
}

DI void moe_tables(const Ctx& F, int l) {
    LAS int* tb = (LAS int*)(F.lds + AUX_OFF); LAS int* cn = tb + 64;
    if (F.tid == 0) {
        const unsigned* C = (const unsigned*)(F.ws + WS_CTL) + CW_CNT + l * 32 * 64;
        int acc = 0;
        for (int e = 0; e < 32; ++e) { const int c = (int)__hip_atomic_load(C + e * 64, RLX_AGENT); tb[e] = acc; cn[e] = c; acc += (c + 255) >> 8; }
        tb[32] = acc;
    }
    __syncthreads();
}
template <int MODE>
DI void phase_norm1(const Ctx& F, int l) {
    const float* mods = (const float*)(F.ws + WS_MODS);
    const bf16* X = (const bf16*)(F.ws + WS_X); bf16* H = (bf16*)(F.ws + F.dofs + WS_H); bf16* XW = (bf16*)(F.ws + F.dofs + WS_X);
    const LAS int* tb = (const LAS int*)(F.lds + AUX_OFF);
    if (l > 0) moe_tables(F, l - 1);
    const int gw = F.blk * 8 + F.wave, NGW = F.G * 8, lane = F.lane;
    for (int tok = gw; tok < T; tok += NGW) {
        const int b = tok >> 12;
        f32x4 v[4];
        if (l == 0) { const float* xr = ginp(F, I_X) + (size_t)tok * 1024;
#pragma unroll
            for (int k = 0; k < 4; ++k) v[k] = *(const f32x4*)(xr + 4 * lane + 256 * k);
        } else { const bf16* xr = X + (size_t)tok * 1024;
#pragma unroll
            for (int k = 0; k < 4; ++k) { const u32x2 w = *(const u32x2*)(xr + 4 * lane + 256 * k); v[k] = (f32x4){bflo(w.x), bfhi(w.x), bflo(w.y), bfhi(w.y)}; }
        }
        if (l > 0) {
            f32x4 y[4];
#pragma unroll
            for (int k = 0; k < 4; ++k) y[k] = (f32x4){0.f, 0.f, 0.f, 0.f};
            const int* ts = (const int*)(F.ws + WS_TOKSLOT) + (size_t)tok * 4;
            const f32x4 tg = *(const f32x4*)((const float*)(F.ws + WS_TOKG) + (size_t)tok * 4) * Y2_ISCALE;
#pragma unroll
            for (int s = 0; s < 4; ++s) {
                const int pk = ts[s]; const int e = pk >> 16, pos = pk & 0xffff;
                const unsigned char* yr = (const unsigned char*)(F.ws + WS_Y2) + ((size_t)tb[e] * 256 + pos) * 1024;
#pragma unroll
                for (int k = 0; k < 4; ++k) { const unsigned w = *(const unsigned*)(yr + 4 * lane + 256 * k); y[k] += unpk4_fp8(w) * tg[s]; }
            }
            const float* gt2 = mods + ((size_t)((l - 1) * 8 + b) * 6 + 5) * 1024;
#pragma unroll
            for (int k = 0; k < 4; ++k) v[k] = v[k] + *(const f32x4*)(gt2 + 4 * lane + 256 * k) * y[k];
        }
        float ss = 0.f;
#pragma unroll
        for (int k = 0; k < 4; ++k) ss += v[k][0] * v[k][0] + v[k][1] * v[k][1] + v[k][2] * v[k][2] + v[k][3] * v[k][3];
        const float rstd = rsqrtf(wave_sum(ss) * (1.0f / 1024.0f) + EPS);
        if (MODE == 0) {
            const float* g1 = ginp(F, I_G1) + (size_t)l * 1024;
            const float* sh = mods + ((size_t)(l * 8 + b) * 6 + 0) * 1024; const float* sc = sh + 1024;
#pragma unroll
            for (int k = 0; k < 4; ++k) {
                const int c = 4 * lane + 256 * k;
                { u32x2 xw; xw.x = pk2(v[k][0], v[k][1]); xw.y = pk2(v[k][2], v[k][3]); *(u32x2*)(XW + (size_t)tok * 1024 + c) = xw; }
                const f32x4 hv = v[k] * rstd * *(const f32x4*)(g1 + c) * (*(const f32x4*)(sc + c) + 1.0f) + *(const f32x4*)(sh + c);
                u32x2 w; w.x = pk2(hv[0], hv[1]); w.y = pk2(hv[2], hv[3]);
                *(u32x2*)(H + (size_t)tok * 1024 + c) = w;
            }
        } else {
            const float* gf = ginp(F, I_GF);
#pragma unroll
            for (int k = 0; k < 4; ++k) { const int c = 4 * lane + 256 * k; *(f32x4*)(gout(F) + (size_t)tok * 1024 + c) = v[k] * rstd * *(const f32x4*)(gf + c); }
        }
    }
}
DI void phase_prep(const Ctx& F) {
    const bf16* CQ = (const bf16*)(F.ws + WS_CQ); const bf16* MISC = (const bf16*)(F.ws + WS_MISC);
    float* RQ = (float*)(F.ws + WS_RSTDQ); float* RKV = (float*)(F.ws + WS_RSTDKV);
    bf16* KR = (bf16*)(F.ws + WS_KR); float* GATES = (float*)(F.ws + WS_GATES); const float* CS32 = (const float*)(F.ws + WS_CS32);
    const int gw = F.blk * 8 + F.wave, NGW = F.G * 8, lane = F.lane;
    for (int tok = gw; tok < T; tok += NGW) {
        const u32x2 wq = *(const u32x2*)(CQ + (size_t)tok * 256 + 4 * lane);
        const u32x2 wm = *(const u32x2*)(MISC + (size_t)tok * 256 + 4 * lane);
        float a0 = bflo(wq.x), a1 = bfhi(wq.x), a2 = bflo(wq.y), a3 = bfhi(wq.y);
        const float sq = wave_sum(a0 * a0 + a1 * a1 + a2 * a2 + a3 * a3);
        float m0 = bflo(wm.x), m1 = bfhi(wm.x), m2 = bflo(wm.y), m3 = bfhi(wm.y);
        const float skv = wave_sum(lane < 32 ? (m0 * m0 + m1 * m1 + m2 * m2 + m3 * m3) : 0.f);
        if (lane == 0) { RQ[tok] = rsqrtf(sq * (1.0f / 256.0f) + EPS); RKV[tok] = rsqrtf(skv * (1.0f / 128.0f) + EPS); }
        const float p0 = __shfl_xor(m0, 4), p1 = __shfl_xor(m1, 4), p2 = __shfl_xor(m2, 4), p3 = __shfl_xor(m3, 4);
        if (lane >= 32 && lane < 36) {
            const int i0 = 4 * (lane - 32);
            const f32x4 c4 = *(const f32x4*)(CS32 + (size_t)tok * 32 + i0), s4 = *(const f32x4*)(CS32 + (size_t)tok * 32 + 16 + i0);
            u32x4 w;
            w.x = pk2(m0 * c4[0] - p0 * s4[0], p0 * c4[0] + m0 * s4[0]); w.y = pk2(m1 * c4[1] - p1 * s4[1], p1 * c4[1] + m1 * s4[1]);
            w.z = pk2(m2 * c4[2] - p2 * s4[2], p2 * c4[2] + m2 * s4[2]); w.w = pk2(m3 * c4[3] - p3 * s4[3], p3 * c4[3] + m3 * s4[3]);
            *(u32x4*)(KR + (size_t)tok * 32 + 2 * i0) = w;
        }
        if (lane >= 40 && lane < 46) {
            const int gi = 4 * (lane - 40);
            *(f32x4*)(GATES + (size_t)tok * 24 + gi) = (f32x4){sigmoidf_(m0), sigmoidf_(m1), sigmoidf_(m2), sigmoidf_(m3)};
        }
    }
}
DI void phase_cmp2(const Ctx& F, int l) {
    const bf16* HID = (const bf16*)(F.ws + WS_HID);
    const float* CS64 = (const float*)(F.ws + WS_CS64);
    const int gw = F.blk * 8 + F.wave, NGW = F.G * 8, lane = F.lane;
    for (int it = gw; it < 8192; it += NGW) {
        const int kv = it >> 12, row = it & 4095, c = row & 255, bg = row >> 8;
        const float* w2 = ginp(F, kv ? I_W2V : I_W2K) + (size_t)l * 256 * 64;
        const float* b2 = ginp(F, kv ? I_B2V : I_B2K) + (size_t)l * 64;
        const u32x2 hw = *(const u32x2*)(HID + ((size_t)kv * 4096 + row) * 256 + 4 * lane);
        const float h0 = bflo(hw.x), h1 = bfhi(hw.x), h2 = bflo(hw.y), h3 = bfhi(hw.y);
        float acc = b2[lane];
#pragma unroll 4
        for (int k4 = 0; k4 < 64; ++k4) {
            const float x0 = __builtin_bit_cast(float, __builtin_amdgcn_readlane(__builtin_bit_cast(int, h0), k4));
            const float x1 = __builtin_bit_cast(float, __builtin_amdgcn_readlane(__builtin_bit_cast(int, h1), k4));
            const float x2 = __builtin_bit_cast(float, __builtin_amdgcn_readlane(__builtin_bit_cast(int, h2), k4));
            const float x3 = __builtin_bit_cast(float, __builtin_amdgcn_readlane(__builtin_bit_cast(int, h3), k4));
            acc += x0 * w2[(4 * k4 + 0) * 64 + lane] + x1 * w2[(4 * k4 + 1) * 64 + lane] + x2 * w2[(4 * k4 + 2) * 64 + lane] + x3 * w2[(4 * k4 + 3) * 64 + lane];
        }
        if (c == 255) acc = 0.f;
        if (kv == 0) {
            const int b = bg >> 1, tokr = b * S + 16 * c + 31;
            const float other = __shfl_xor(acc, 32);
            const int i = lane & 31;
            const float cs = CS64[(size_t)(tokr & (T - 1)) * 64 + i], sn = CS64[(size_t)(tokr & (T - 1)) * 64 + 32 + i];
            const float y = (lane < 32) ? (acc * cs - other * sn) : (acc * cs + other * sn);
            ((bf16*)(F.ws + WS_KC))[(size_t)row * 64 + 2 * i + (lane >> 5)] = (bf16)(pk2(y, 0.f) & 0xffffu);
        } else {
            ((bf16*)(F.ws + WS_VC))[(size_t)row * 64 + lane] = (bf16)(pk2(acc, 0.f) & 0xffffu);
        }
    }
}
DI void phase_mix(const Ctx& F, int l) {
    const bf16* OA3 = (const bf16*)(F.ws + WS_OA3); const float* LSEA = (const float*)(F.ws + WS_LSEA);
    const bf16* OCMP = (const bf16*)(F.ws + WS_OCMP); const bf16* OSLC = (const bf16*)(F.ws + WS_OSLC); const bf16* OWIN = (const bf16*)(F.ws + WS_OWIN);
    const bf16* OC = (const bf16*)(F.ws + WS_OC); const bf16* MISC = (const bf16*)(F.ws + WS_MISC);
    bf16* AMIX = (bf16*)(F.ws + WS_AMIX);
    const float* ga = ginp(F, I_GOA) + (size_t)l * 256; const float* gb = ginp(F, I_GOB) + (size_t)l * 512; const float* gc = ginp(F, I_GOC) + (size_t)l * 256;
    const int gw = F.blk * 8 + F.wave, NGW = F.G * 8, lane = F.lane, ha = lane >> 4;
    for (int tok0 = gw; tok0 < T; tok0 += 2 * NGW) {
        int tok[2]; tok[0] = tok0; tok[1] = (tok0 + NGW < T) ? tok0 + NGW : tok0;
        float ls[2][3]; u32x2 wa[2][3], wb[2][2], wc_[2];
#pragma unroll
        for (int q = 0; q < 2; ++q) {
#pragma unroll
            for (int p = 0; p < 3; ++p) { ls[q][p] = LSEA[((size_t)p * T + tok[q]) * 4 + ha]; wa[q][p] = *(const u32x2*)(OA3 + ((size_t)p * T + tok[q]) * 256 + 4 * lane); }
#pragma unroll
            for (int k = 0; k < 2; ++k) {
                const int col = 256 * k + 4 * lane;
                wb[q][k] = *(const u32x2*)(OSLC + (size_t)tok[q] * 512 + col);
            }
            wc_[q] = *(const u32x2*)(OC + (size_t)tok[q] * 256 + 4 * lane);
        }
        f32x4 va[2], vb[2][2], vc[2]; float red[2][3];
#pragma unroll
        for (int q = 0; q < 2; ++q) {
            const float mx = fmaxf(ls[q][0], fmaxf(ls[q][1], ls[q][2]));
            const float w0 = fast_exp2(ls[q][0] - mx), w1 = fast_exp2(ls[q][1] - mx), w2 = fast_exp2(ls[q][2] - mx), wi = 1.0f / (w0 + w1 + w2);
            va[q] = ((f32x4){bflo(wa[q][0].x), bfhi(wa[q][0].x), bflo(wa[q][0].y), bfhi(wa[q][0].y)} * w0 + (f32x4){bflo(wa[q][1].x), bfhi(wa[q][1].x), bflo(wa[q][1].y), bfhi(wa[q][1].y)} * w1
                   + (f32x4){bflo(wa[q][2].x), bfhi(wa[q][2].x), bflo(wa[q][2].y), bfhi(wa[q][2].y)} * w2) * wi;
            red[q][0] = va[q][0] * va[q][0] + va[q][1] * va[q][1] + va[q][2] * va[q][2] + va[q][3] * va[q][3];
            float sb = 0.f;
#pragma unroll
            for (int k = 0; k < 2; ++k) {
                const u32x2 a = wb[q][k];
                vb[q][k][0] = bflo(a.x); vb[q][k][1] = bfhi(a.x); vb[q][k][2] = bflo(a.y); vb[q][k][3] = bfhi(a.y);
                sb += vb[q][k][0] * vb[q][k][0] + vb[q][k][1] * vb[q][k][1] + vb[q][k][2] * vb[q][k][2] + vb[q][k][3] * vb[q][k][3];
            }
            red[q][1] = sb;
            vc[q] = (f32x4){bflo(wc_[q].x), bfhi(wc_[q].x), bflo(wc_[q].y), bfhi(wc_[q].y)};
            red[q][2] = vc[q][0] * vc[q][0] + vc[q][1] * vc[q][1] + vc[q][2] * vc[q][2] + vc[q][3] * vc[q][3];
        }
#pragma unroll
        for (int q = 0; q < 2; ++q)
#pragma unroll
            for (int j = 0; j < 3; ++j) red[q][j] = wave_sum(red[q][j]);
#pragma unroll
        for (int q = 0; q < 2; ++q) {
            if (q == 1 && tok0 + NGW >= T) break;
            const float ra = rsqrtf(red[q][0] * (1.0f / 256.0f) + EPS), rb = rsqrtf(red[q][1] * (1.0f / 512.0f) + EPS), rc = rsqrtf(red[q][2] * (1.0f / 256.0f) + EPS);
            bf16* orow = AMIX + (size_t)tok[q] * 1024;
            { const f32x4 o = va[q] * ra * *(const f32x4*)(ga + 4 * lane); u32x2 w; w.x = pk2(o[0], o[1]); w.y = pk2(o[2], o[3]); *(u32x2*)(orow + 4 * lane) = w; }
#pragma unroll
            for (int k = 0; k < 2; ++k) { const f32x4 o = vb[q][k] * rb * *(const f32x4*)(gb + 256 * k + 4 * lane); u32x2 w; w.x = pk2(o[0], o[1]); w.y = pk2(o[2], o[3]); *(u32x2*)(orow + 256 + 256 * k + 4 * lane) = w; }
            { const f32x4 o = vc[q] * rc * *(const f32x4*)(gc + 4 * lane); u32x2 w; w.x = pk2(o[0], o[1]); w.y = pk2(o[2], o[3]); *(u32x2*)(orow + 768 + 4 * lane) = w; }
        }
    }
}
DI void phase_router(const Ctx& F, int l) {
    LAS unsigned char* WH = F.lds; LAS unsigned char* WL = F.lds + 65536;
    LAS float* biasp = (LAS float*)(F.lds + AUX_OFF); LAS float* RS = biasp + 32;
    LAS int* lcnt = (LAS int*)(F.lds + AUX_OFF + 1024); LAS int* gbase = lcnt + 32;
    LAS int* tokE = gbase + 32; LAS float* tokG = (LAS float*)(tokE + 512); LAS int* tokP = (LAS int*)(tokG + 512);
    const float* wr = ginp(F, I_WR) + (size_t)l * 1024 * 32; const float* br = ginp(F, I_BR) + (size_t)l * 32;
    const float* mods = (const float*)(F.ws + WS_MODS); const bf16* X = (const bf16*)(F.ws + WS_X); bf16* H = (bf16*)(F.ws + F.dofs + WS_H);
    const float* g2 = ginp(F, I_G2) + (size_t)l * 1024;
    const int tid = F.tid, lane = F.lane, w = F.wave;
    if (tid < 32) lcnt[tid] = 0;
    unsigned* CNT = (unsigned*)(F.ws + WS_CTL) + CW_CNT + (l + F.dcnt) * 32 * 64;
    for (int chunk = F.blk; chunk < T / 128; chunk += F.G) {
        const int b = (chunk * 128) >> 12;
        const float* sh = mods + ((size_t)(l * 8 + b) * 6 + 3) * 1024; const float* sc = sh + 1024;
        {
            float bacc = 0.f; const int e = tid & 31;
#pragma unroll 4
            for (int it = 0; it < 32; ++it) {
                const int k = 2 * ((tid + 512 * it) >> 5);
                const float w0 = wr[k * 32 + e], w1 = wr[(k + 1) * 32 + e];
                const float p0 = w0 * (g2[k] * (sc[k] + 1.0f)), p1 = w1 * (g2[k + 1] * (sc[k + 1] + 1.0f));
                bacc += sh[k] * w0 + sh[k + 1] * w1;
                const unsigned hi = pk2(p0, p1);
                const unsigned lo = pk2(p0 - bflo(hi), p1 - bfhi(hi));
                const int off = e * 2048 + ((((k >> 3) ^ e) << 4) | ((k & 7) * 2));
                *(LAS unsigned*)(WH + off) = hi; *(LAS unsigned*)(WL + off) = lo;
            }
            tokG[tid] = bacc;
        }
        __syncthreads();
        if (tid < 32) { float s_ = br[tid];
#pragma unroll
            for (int j = 0; j < 16; ++j) s_ += tokG[tid + 32 * j];
            biasp[tid] = s_; }
        {
            u32x2 ra[4], rb[4];
            f32x4 ggv[4], hhv[4];
#pragma unroll
            for (int k = 0; k < 4; ++k) { const int c = 4 * lane + 256 * k; ggv[k] = *(const f32x4*)(g2 + c) * (*(const f32x4*)(sc + c) + 1.0f); hhv[k] = *(const f32x4*)(sh + c); }
            { const bf16* x0 = X + (size_t)(chunk * 128 + w * 16) * 1024 + 4 * lane;
#pragma unroll
              for (int k = 0; k < 4; ++k) { ra[k] = *(const u32x2*)(x0 + 256 * k); rb[k] = *(const u32x2*)(x0 + 1024 + 256 * k); } }
#pragma unroll 1
            for (int tt = 0; tt < 8; ++tt) {
                const int tl0 = w * 16 + 2 * tt, tok0 = chunk * 128 + tl0;
                f32x4 v[2][4]; float ss0 = 0.f, ss1 = 0.f;
#pragma unroll
                for (int k = 0; k < 4; ++k) { v[0][k] = (f32x4){bflo(ra[k].x), bfhi(ra[k].x), bflo(ra[k].y), bfhi(ra[k].y)}; v[1][k] = (f32x4){bflo(rb[k].x), bfhi(rb[k].x), bflo(rb[k].y), bfhi(rb[k].y)}; }
                { const int tn = (tt < 7) ? tok0 + 2 : tok0; const bf16* x0 = X + (size_t)tn * 1024 + 4 * lane;
#pragma unroll
                  for (int k = 0; k < 4; ++k) { ra[k] = *(const u32x2*)(x0 + 256 * k); rb[k] = *(const u32x2*)(x0 + 1024 + 256 * k); } }
#pragma unroll
                for (int k = 0; k < 4; ++k) { ss0 += v[0][k][0] * v[0][k][0] + v[0][k][1] * v[0][k][1] + v[0][k][2] * v[0][k][2] + v[0][k][3] * v[0][k][3];
                                              ss1 += v[1][k][0] * v[1][k][0] + v[1][k][1] * v[1][k][1] + v[1][k][2] * v[1][k][2] + v[1][k][3] * v[1][k][3]; }
                ss0 = wave_sum(ss0); ss1 = wave_sum(ss1);
                const float rs0 = rsqrtf(ss0 * (1.0f / 1024.0f) + EPS), rs1 = rsqrtf(ss1 * (1.0f / 1024.0f) + EPS);
                if (lane == 0) { RS[tl0] = rs0; RS[tl0 + 1] = rs1; }
#pragma unroll
                for (int k = 0; k < 4; ++k) {
                    const int c = 4 * lane + 256 * k;
                    v[0][k] = v[0][k] * rs0 * ggv[k] + hhv[k]; v[1][k] = v[1][k] * rs1 * ggv[k] + hhv[k];
                    *(unsigned*)((unsigned char*)H + (size_t)tok0 * 1024 + c) = pk4_fp8s(v[0][k][0], v[0][k][1], v[0][k][2], v[0][k][3], H8_SCALE);
                    *(unsigned*)((unsigned char*)H + (size_t)(tok0 + 1) * 1024 + c) = pk4_fp8s(v[1][k][0], v[1][k][1], v[1][k][2], v[1][k][3], H8_SCALE);
                }
            }
        }
        __syncthreads();
        f32x4 acc[2] = {{0.f, 0.f, 0.f, 0.f}, {0.f, 0.f, 0.f, 0.f}};
        {
            const int kg = lane >> 4, n16 = lane & 15;
            const bf16* xr = X + (size_t)(chunk * 128 + w * 16 + n16) * 1024 + 8 * kg;
#pragma unroll 1
            for (int k8 = 0; k8 < 4; ++k8) {
                bf16x8 af[8];
#pragma unroll
                for (int j = 0; j < 8; ++j) af[j] = *(const bf16x8*)(xr + 32 * (8 * k8 + j));
#pragma unroll
                for (int j = 0; j < 8; ++j) {
                    const int c = 4 * (8 * k8 + j) + kg;
#pragma unroll
                    for (int et = 0; et < 2; ++et) {
                        const int e = 16 * et + n16, off = e * 2048 + ((c ^ e) << 4);
                        const bf16x8 bh = *(const LAS bf16x8*)(WH + off), bl = *(const LAS bf16x8*)(WL + off);
                        acc[et] = __builtin_amdgcn_mfma_f32_16x16x32_bf16(af[j], bh, acc[et], 0, 0, 0);
                        acc[et] = __builtin_amdgcn_mfma_f32_16x16x32_bf16(af[j], bl, acc[et], 0, 0, 0);
                    }
                }
            }
        }
        __syncthreads();
        LAS float* LG = (LAS float*)(F.lds + w * 2048);
        {
            const int g4 = lane >> 4, n16 = lane & 15;
#pragma unroll
            for (int et = 0; et < 2; ++et)
#pragma unroll
                for (int i = 0; i < 4; ++i) LG[(4 * g4 + i) * 32 + 16 * et + n16] = acc[et][i] * RS[w * 16 + 4 * g4 + i] + biasp[16 * et + n16];
        }
        asm volatile("s_waitcnt lgkmcnt(0)" ::: "memory");
#pragma unroll 1
        for (int tt = 0; tt < 8; ++tt) {
            const int tl0 = w * 16 + 2 * tt;
            const float lg0 = LG[(2 * tt) * 32 + (lane >> 1)], lg1 = LG[(2 * tt + 1) * 32 + (lane >> 1)];
            int rk0 = 0, rk1 = 0; const int me = lane >> 1;
#pragma unroll
            for (int e = 0; e < 32; ++e) {
                const float o0 = __builtin_bit_cast(float, __builtin_amdgcn_readlane(__builtin_bit_cast(int, lg0), 2 * e));
                const float o1 = __builtin_bit_cast(float, __builtin_amdgcn_readlane(__builtin_bit_cast(int, lg1), 2 * e));
                rk0 += ((o0 > lg0) || (o0 == lg0 && e < me)) ? 1 : 0; rk1 += ((o1 > lg1) || (o1 == lg1 && e < me)) ? 1 : 0;
            }
#pragma unroll
            for (int tk = 0; tk < 2; ++tk) {
                const int rk = tk ? rk1 : rk0; const float lg = tk ? lg1 : lg0;
                int te[4]; float tv[4];
#pragma unroll
                for (int r = 0; r < 4; ++r) {
                    const u64 mk = __ballot(rk == r && (lane & 1) == 0);
                    const int sl = __builtin_amdgcn_readfirstlane((int)__builtin_ctzll(mk));
                    te[r] = sl >> 1; tv[r] = __builtin_bit_cast(float, __builtin_amdgcn_readlane(__builtin_bit_cast(int, lg), sl));
                }
                const float e1 = __expf(tv[1] - tv[0]), e2 = __expf(tv[2] - tv[0]), e3 = __expf(tv[3] - tv[0]);
                const float isum = 1.0f / (1.0f + e1 + e2 + e3);
                if (lane < 4) {
                    const int tl = tl0 + tk;
                    const int e = lane == 0 ? te[0] : lane == 1 ? te[1] : lane == 2 ? te[2] : te[3];
                    const float gte = (lane == 0 ? 1.0f : lane == 1 ? e1 : lane == 2 ? e2 : e3) * isum;
                    const int pos = atomicAdd((int*)(lcnt + e), 1);
                    tokE[tl * 4 + lane] = e; tokG[tl * 4 + lane] = gte; tokP[tl * 4 + lane] = pos;
                }
            }
        }
        __syncthreads();
        if (tid < 32) gbase[tid] = (int)__hip_atomic_fetch_add(CNT + tid * 64, (unsigned)lcnt[tid], RLX_AGENT);
        __syncthreads();
        {
            const int tl = tid >> 2, r = tid & 3, e = tokE[tid], pos = gbase[e] + tokP[tid], tok = chunk * 128 + tl;
            ((int*)(F.ws + F.dofs + WS_IDX))[(size_t)e * ECAP + pos] = tok;
            ((float*)(F.ws + F.dofs + WS_TOKG))[(size_t)tok * 4 + r] = tokG[tid];
            ((int*)(F.ws + F.dofs + WS_TOKSLOT))[(size_t)tok * 4 + r] = (e << 16) | pos;
        }
        __syncthreads();
        if (tid < 32) lcnt[tid] = 0;
        __syncthreads();
    }
}

DI int ropeperm64(int p) { return (p >> 1) + 32 * (p & 1); }
DI int cmap_win(int n) {
    const int tile = n >> 8, w = n & 255, hb = w & ~63, pp = ropeperm64(w & 63);
    switch (tile) {
        case 0: return hb + pp;
        case 1: return 256 + hb + pp;
        case 2: return 512 + w;
        case 3: return 768 + hb + pp;
        case 4: return 1024 + hb + pp;
        case 5: return w < 128 ? 1280 + w : 1408 + (w - 128);
        case 6: return w < 128 ? 1536 + hb + pp : 1664 + (w - 128);
        case 7: return w < 128 ? 1792 + hb + pp : 1920 + (w - 128);
        case 8: return 2072 + w;
        default: return w < 128 ? 2328 + w : (w < 160 ? 2456 + ((w - 128) >> 1) + 16 * ((w - 128) & 1) : (w < 184 ? 2048 + (w - 160) : -1));
    }
}
DI int cmap_qup(int n) { if (n >= 384) return -1; const int h = n / 96, w = n % 96; if (w < 64) return h * 96 + w; const int j = w - 64; return h * 96 + 64 + (j >> 1) + 16 * (j & 1); }
DI void tr_tile(const float* src, int K, int Nsrc, bf16* dst, int Kdst, int maptype, const float* ksc, int ntile, int ktile, LAS float* scr, int tid) {
    const int n0 = ntile * 64, k0 = ktile * 128, nl = tid & 63, n = n0 + nl;
    const int c = maptype == 0 ? (n < Nsrc ? n : -1) : (maptype == 1 ? cmap_win(n) : cmap_qup(n));
    float v[16];
#pragma unroll
    for (int it = 0; it < 16; ++it) { const int k = k0 + (tid >> 6) + 8 * it; v[it] = (c >= 0 && k < K) ? src[(size_t)k * Nsrc + c] * (ksc ? ksc[k] : 1.0f) : 0.f; }
#pragma unroll
    for (int it = 0; it < 16; ++it) scr[((tid >> 6) + 8 * it) * 65 + nl] = v[it];
    __syncthreads();
#pragma unroll
    for (int it = 0; it < 2; ++it) {
        const int idx = tid + 512 * it, nn = idx >> 4, ch = idx & 15;
        const LAS float* s = scr + (8 * ch) * 65 + nn;
        u32x4 o; o.x = pk2(s[0], s[65]); o.y = pk2(s[2 * 65], s[3 * 65]); o.z = pk2(s[4 * 65], s[5 * 65]); o.w = pk2(s[6 * 65], s[7 * 65]);
        *(u32x4*)(dst + (size_t)(n0 + nn) * Kdst + k0 + 8 * ch) = o;
    }
    __syncthreads();
}
DI void trb_load(f32x4 (&v)[16], const float* src, int N, int n0, int k0, int tid) {
#pragma unroll
    for (int it = 0; it < 16; ++it) v[it] = *(const f32x4*)(src + (size_t)(k0 + (tid >> 6) + 8 * it) * N + n0 + 4 * (tid & 63));
}
DI void trb_store(const f32x4 (&v)[16], bf16* dst, int Kd, int n0, int k0, LAS unsigned char* L, int tid, int wave, int lane, int f8 = 0) {
#pragma unroll
    for (int it = 0; it < 16; ++it) { f32x4 x = v[it];
        if (f8) { x[0] = q8s(x[0], W8_SCALE); x[1] = q8s(x[1], W8_SCALE); x[2] = q8s(x[2], W8_SCALE); x[3] = q8s(x[3], W8_SCALE); }
        u32x2 w; w.x = pk2(x[0], x[1]); w.y = pk2(x[2], x[3]); *(LAS u32x2*)(L + ((tid >> 6) + 8 * it) * 576 + (tid & 63) * 8) = w; }
    asm volatile("s_waitcnt lgkmcnt(0)\n\ts_barrier" ::: "memory");
    const int i = lane & 15, gn = (lane >> 4) & 1, h = lane >> 5, q = i >> 2, p = i & 3;
    const LAS unsigned char* base = L + (8 * h + q) * 576 + (32 * wave + 16 * gn) * 2 + 8 * p;
    if (!f8) {
        bf16* drow = dst + (size_t)(n0 + 32 * wave + 16 * gn + i) * Kd + k0 + 8 * h;
#pragma unroll
        for (int kcp = 0; kcp < 8; ++kcp) {
            const s16x4 lo = tr_read(base + (16 * kcp) * 576), hi = tr_read(base + (16 * kcp + 4) * 576);
            *(bf16x8*)(drow + 16 * kcp) = __builtin_shufflevector(lo, hi, 0, 1, 2, 3, 4, 5, 6, 7);
        }
    } else {
        unsigned char* drow = (unsigned char*)dst + (size_t)(n0 + 32 * wave + 16 * gn + i) * Kd + k0 + 16 * h;
#pragma unroll
        for (int kq = 0; kq < 4; ++kq) {
            u32x2 o[2];
#pragma unroll
            for (int e_ = 0; e_ < 2; ++e_) {
                const int kcp = 2 * kq + e_;
                const s16x4 lo = tr_read(base + (16 * kcp) * 576), hi = tr_read(base + (16 * kcp + 4) * 576);
                int w0 = __builtin_amdgcn_cvt_pk_fp8_f32(bf2f((unsigned short)lo[0]), bf2f((unsigned short)lo[1]), 0, false); w0 = __builtin_amdgcn_cvt_pk_fp8_f32(bf2f((unsigned short)lo[2]), bf2f((unsigned short)lo[3]), w0, true);
                int w1 = __builtin_amdgcn_cvt_pk_fp8_f32(bf2f((unsigned short)hi[0]), bf2f((unsigned short)hi[1]), 0, false); w1 = __builtin_amdgcn_cvt_pk_fp8_f32(bf2f((unsigned short)hi[2]), bf2f((unsigned short)hi[3]), w1, true);
                o[e_].x = (unsigned)w0; o[e_].y = (unsigned)w1;
            }
            const auto sx = __builtin_amdgcn_permlane32_swap(o[0].x, o[1].x, false, false), sy = __builtin_amdgcn_permlane32_swap(o[0].y, o[1].y, false, false);
            u32x4 w; w.x = sx[0]; w.y = sy[0]; w.z = sx[1]; w.w = sy[1];
            *(u32x4*)(drow + 32 * kq) = w;
        }
    }
    asm volatile("s_waitcnt lgkmcnt(0)\n\ts_barrier" ::: "memory");
}
struct TrbItem { const float* src; bf16* dst; int N, n0, k0, f8; };
DI TrbItem trb_item(const Ctx& F, int it) {
    const int le = it / 96, r = it % 96; TrbItem t;
    if (r < 64) { t.src = ginp(F, I_WE1) + (size_t)le * 1024 * 2048; t.dst = (bf16*)(F.ws + WS_W1E + (size_t)le * 2048 * 1024); t.N = 2048; t.n0 = (r & 7) * 256; t.k0 = (r >> 3) * 128; t.f8 = 1; }
    else { const int q = r - 64; t.src = ginp(F, I_WE2) + (size_t)le * 1024 * 1024; t.dst = (bf16*)(F.ws + WS_W2E + (size_t)le * 1024 * 1024); t.N = 1024; t.n0 = (q & 3) * 256; t.k0 = (q >> 2) * 128; t.f8 = 1; }
    return t;
}
DI void conv_layer_tiles(const Ctx& F, int l, int q0, int i0, int cnt) {
    const int NL = 32 * 96;
    int it = q0 + F.blk + F.G * i0; const int end = q0 + F.blk + F.G * (i0 + cnt);
    if (it >= NL) return;
    f32x4 va[16];
    TrbItem ta = trb_item(F, l * NL + it);
    trb_load(va, ta.src, ta.N, ta.n0, ta.k0, F.tid);
#pragma unroll 1
    while (it < NL && it < end) {
        f32x4 vb[16];
#pragma unroll
        for (int k = 0; k < 16; ++k) vb[k] = va[k];
        const TrbItem tc = ta;
        it += F.G;
        const bool more = (it < NL && it < end);
        ta = trb_item(F, l * NL + (more ? it : 0));
        if (more) trb_load(va, ta.src, ta.N, ta.n0, ta.k0, F.tid);
        trb_store(vb, tc.dst, 1024, tc.n0, tc.k0, F.lds, F.tid, F.wave, F.lane, tc.f8);
    }
}
DI void conv_claim_tiles(const Ctx& F, int l, int quota) {
    const int NL = 32 * 96;
    volatile LAS unsigned* slot = (volatile LAS unsigned*)(F.lds + MISC_OFF) + 16;
    __syncthreads();
    if (F.tid == 0) { unsigned* q = (unsigned*)(F.ws + WS_CTL) + CW_CONVQ + l * 64; slot[0] = __hip_atomic_fetch_add(q, (unsigned)quota, __ATOMIC_RELAXED, __HIP_MEMORY_SCOPE_AGENT); }
    __syncthreads();
    int it = __builtin_amdgcn_readfirstlane((int)slot[0]); const int end = it + quota;
    if (it >= NL) return;
    f32x4 va[16];
    TrbItem ta = trb_item(F, l * NL + it);
    trb_load(va, ta.src, ta.N, ta.n0, ta.k0, F.tid);
#pragma unroll 1
    while (it < NL && it < end) {
        f32x4 vb[16];
#pragma unroll
        for (int k = 0; k < 16; ++k) vb[k] = va[k];
        const TrbItem tc = ta;
        it += 1;
        const bool more = (it < NL && it < end);
        ta = trb_item(F, l * NL + (more ? it : 0));
        if (more) trb_load(va, ta.src, ta.N, ta.n0, ta.k0, F.tid);
        trb_store(vb, tc.dst, 1024, tc.n0, tc.k0, F.lds, F.tid, F.wave, F.lane, tc.f8);
    }
}
DI void phase_prologue(const Ctx& F) {
    const Args& A = *F.a; const int tid = F.tid;
    LAS float* scr = (LAS float*)F.lds;
    if (!CONV_IN_LAYER) {
        const int NIT = DEPTH * 32 * 96;
        f32x4 va[16];
        int it = F.blk;
        TrbItem ta = trb_item(F, it < NIT ? it : 0);
        if (it < NIT) trb_load(va, ta.src, ta.N, ta.n0, ta.k0, tid);
#pragma unroll 1
        while (it < NIT) {
            f32x4 vb[16];
#pragma unroll
            for (int k = 0; k < 16; ++k) vb[k] = va[k];
            const TrbItem tc = ta;
            it += F.G;
            ta = trb_item(F, it < NIT ? it : 0);
            if (it < NIT) trb_load(va, ta.src, ta.N, ta.n0, ta.k0, tid);
            trb_store(vb, tc.dst, 1024, tc.n0, tc.k0, F.lds, tid, F.wave, F.lane, tc.f8);
        }
    }
    constexpr int PER_L = 8192 + 4096 + 320 + 128 + 128 + 16 + 16;
    for (int it = F.blk; it < DEPTH * PER_L; it += F.G) {
        const int l = it / PER_L; int r = it % PER_L;
        if (r < 8192 + 4096) continue;
        if (r < 8192) { const int e = r >> 8, t = r & 255;
            tr_tile(ginp(F, I_WE1) + ((size_t)(l * 32 + e)) * 1024 * 2048, 1024, 2048, (bf16*)(F.ws + WS_W1E) + ((size_t)(l * 32 + e)) * 2048 * 1024, 1024, 0, nullptr, t >> 3, t & 7, scr, tid); continue; }
        r -= 8192;
        if (r < 4096) { const int e = r >> 7, t = r & 127;
            tr_tile(ginp(F, I_WE2) + ((size_t)(l * 32 + e)) * 1024 * 1024, 1024, 1024, (bf16*)(F.ws + WS_W2E) + ((size_t)(l * 32 + e)) * 1024 * 1024, 1024, 0, nullptr, t >> 3, t & 7, scr, tid); continue; }
        r -= 4096;
        if (r < 320) { tr_tile(ginp(F, I_WIN) + (size_t)l * 1024 * 2488, 1024, 2488, (bf16*)(F.ws + WS_WIN) + (size_t)l * NIN * 1024, 1024, 1, nullptr, r >> 3, r & 7, scr, tid); continue; }
        r -= 320;
        if (r < 128) { tr_tile(ginp(F, I_WOUT) + (size_t)l * 1024 * 1024, 1024, 1024, (bf16*)(F.ws + WS_WOUT) + (size_t)l * 1024 * 1024, 1024, 0, nullptr, r >> 3, r & 7, scr, tid); continue; }
        r -= 128;
        if (r < 128) { const int kv = r >> 6, t = r & 63;
            tr_tile(ginp(F, kv ? I_W1V : I_W1K) + (size_t)l * 2048 * 256, 2048, 256, (bf16*)(F.ws + WS_NSAW1) + ((size_t)(l * 2 + kv)) * 256 * 2048, 2048, 0, nullptr, t >> 4, t & 15, scr, tid); continue; }
        r -= 128;
        if (r < 16) { tr_tile(ginp(F, I_WQUP) + (size_t)l * 256 * 384, 256, 384, (bf16*)(F.ws + WS_MLAQ) + (size_t)l * 512 * 256, 256, 2, ginp(F, I_GQ) + (size_t)l * 256, r >> 1, r & 1, scr, tid); continue; }
        r -= 16;
        tr_tile(ginp(F, I_WKVUP) + (size_t)l * 128 * 512, 128, 512, (bf16*)(F.ws + WS_MLAKV) + (size_t)l * 512 * 256, 256, 0, ginp(F, I_GKV) + (size_t)l * 128, r >> 1, r & 1, scr, tid);
    }
    for (int it = F.blk; it < DEPTH * 4; it += F.G) {
        const int l = it >> 2, kv = (it >> 1) & 1, kt = it & 1;
        tr_tile(ginp(F, kv ? I_W2V : I_W2K) + (size_t)l * 256 * 64, 256, 64, (bf16*)(F.ws + WS_W2T) + ((size_t)(l * 2 + kv)) * 64 * 256, 256, 0, nullptr, 0, kt, scr, tid);
    }
    {
        float* CS64 = (float*)(F.ws + WS_CS64); float* CS32 = (float*)(F.ws + WS_CS32);
        const int* pos = (const int*)ginp(F, I_POS);
        for (int idx = F.blk * 512 + tid; idx < T * 48; idx += F.G * 512) {
            const int tok = idx / 48, i = idx % 48;
            const double p = (double)pos[tok];
            const double inv = (i < 32) ? exp2(-(double)i * (13.287712379549449 / 32.0)) : exp2(-(double)(i - 32) * (13.287712379549449 / 16.0));
            double ang = p * inv;
            const double kk = __builtin_rint(ang * 0.15915494309189535);
            ang = ang - kk * 6.283185307179586;
            const float af = (float)ang;
            const float cs = __cosf(af), sn = __sinf(af);
            if (i < 32) { CS64[(size_t)tok * 64 + i] = cs; CS64[(size_t)tok * 64 + 32 + i] = sn; }
            else { CS32[(size_t)tok * 32 + (i - 32)] = cs; CS32[(size_t)tok * 32 + 16 + (i - 32)] = sn; }
        }
    }
    for (int item = F.blk; item < 32; item += F.G) {
        const int lk = item >> 2, l = lk >> 1, kv = lk & 1, col = (item & 3) * 64 + F.lane;
        const float* w1 = ginp(F, kv ? I_W1V : I_W1K) + (size_t)l * 2048 * 256 + col; const float* pe = ginp(F, kv ? I_POSV : I_POSK) + (size_t)l * 2048;
        float s = 0.f;
#pragma unroll 1
        for (int kb = 256 * F.wave; kb < 256 * F.wave + 256; kb += 16) {
            float wv[16];
#pragma unroll
            for (int j = 0; j < 16; ++j) wv[j] = w1[(size_t)(kb + j) * 256];
#pragma unroll
            for (int j = 0; j < 16; ++j) s += pe[kb + j] * wv[j];
        }
        scr[F.wave * 64 + F.lane] = s;
        __syncthreads();
        if (tid < 64) { float t = ginp(F, kv ? I_B1V : I_B1K)[(size_t)l * 256 + col];
#pragma unroll
            for (int ww = 0; ww < 8; ++ww) t += scr[ww * 64 + tid];
            ((float*)(F.ws + WS_B1P))[(size_t)lk * 256 + col] = t; }
        __syncthreads();
    }
    {
        LAS float* sc = scr; LAS float* red = scr + 8192;
        for (int i = tid; i < 8192; i += 512) { const float c = ginp(F, I_C)[i]; sc[i] = c * sigmoidf_(c); }
        __syncthreads();
        float* MODS = (float*)(F.ws + WS_MODS);
        const int lane = F.lane, w = F.wave;
        for (int item = F.blk; item < 384; item += F.G) {
            const int l = item / 96, col = (item % 96) * 64 + lane;
            float acc[8];
#pragma unroll
            for (int b = 0; b < 8; ++b) acc[b] = 0.f;
            const float* wa = ginp(F, I_WADA) + (size_t)l * 1024 * 6144 + col;
#pragma unroll 1
            for (int kb = 128 * w; kb < 128 * w + 128; kb += 16) {
                float wv[16];
#pragma unroll
                for (int j = 0; j < 16; ++j) wv[j] = wa[(size_t)(kb + j) * 6144];
#pragma unroll
                for (int j = 0; j < 16; ++j) {
#pragma unroll
                    for (int b = 0; b < 8; ++b) acc[b] += sc[b * 1024 + kb + j] * wv[j]; }
            }
#pragma unroll
            for (int b = 0; b < 8; ++b) red[(w * 8 + b) * 64 + lane] = acc[b];
            __syncthreads();
            { const int b = tid >> 6; float s = ginp(F, I_BADA)[(size_t)l * 6144 + col];
#pragma unroll
              for (int ww = 0; ww < 8; ++ww) s += red[(ww * 8 + b) * 64 + lane];
              MODS[((size_t)(l * 8 + b)) * 6144 + col] = s; }
            __syncthreads();
        }
    }
}

constexpr int PH_PER_LAYER = 11;
constexpr int N_PHASES = 1 + DEPTH * PH_PER_LAYER + 1;

__global__ void __launch_bounds__(512, 2) fwd_kernel(Args args) {
    extern __shared__ __attribute__((aligned(16))) unsigned char lds_raw[];
    Ctx F;
    F.lds = (LAS unsigned char*)lds_raw; F.a = &args; F.ws = args.ws;
    F.dofs = 0; F.dcnt = 0;
    F.tid = threadIdx.x; F.lane = F.tid & 63; F.wave = __builtin_amdgcn_readfirstlane(F.tid >> 6); F.blk = blockIdx.x; F.G = gridDim.x; F.vcu = F.blk;
    volatile LAS unsigned* MISC = (volatile LAS unsigned*)(F.lds + MISC_OFF);
    for (int u = F.tid; u < (LDS_BYTES - MISC_OFF) / 4; u += 512) MISC[u] = 0u;
    __syncthreads();
    unsigned* ctl = (unsigned*)(F.ws + WS_CTL);
    XcdBarrier bar; bar.bar = ctl + CW_BAR; bar.x = 0; bar.st = nullptr;
    if (!MK_PER_PHASE) bar = xcd_barrier_post(ctl + CW_BAR, MISC + 8);
    const int lo = args.ph_lo, hi = args.ph_hi;
#define IN(k) (lo <= (k) && (k) < hi)
#define SEAM(k) do { if (IN(k) && IN((k) + 1)) xcd_barrier(bar); } while (0)
    unsigned char* ws = F.ws;
#define PHASE_BEGIN() do { int t_ = threadIdx.x; asm volatile("" : "+v"(t_)); F.tid = t_; F.lane = t_ & 63; F.wave = __builtin_amdgcn_readfirstlane(t_ >> 6); \
        GAS unsigned char* w_ = (GAS unsigned char*)args.ws; asm volatile("" : "+s"(w_)); F.ws = (unsigned char*)w_; ws = (unsigned char*)w_; int b_ = blockIdx.x; asm volatile("" : "+s"(b_)); F.blk = b_; F.vcu = (F.G % 8 == 0) ? (b_ % 8) * (F.G / 8) + b_ / 8 : b_; } while (0)

    if (PHON(0) && IN(0)) _Pragma("unroll 1") for (int rep_ = 0; rep_ < NREP(0); ++rep_) { PHASE_BEGIN(); phase_prologue(F); }
    SEAM(0);
#pragma unroll 1
    for (int l = 0; l < DEPTH; ++l) {
        const int P = 1 + l * PH_PER_LAYER;
        if (PHON(1) && IN(P + 0)) _Pragma("unroll 1") for (int rep_ = 0; rep_ < (DUM(1) ? 2 : 1); ++rep_) { PHASE_BEGIN(); F.dofs = (DUM(1) && rep_ == 0) ? WS_END : 0; phase_norm1<0>(F, l); }
        SEAM(P + 0);
        if (PHON(2) && IN(P + 1)) _Pragma("unroll 1") for (int rep_ = 0; rep_ < NREP(2); ++rep_) { PHASE_BEGIN();
            SchedGrid Sg{(const char*)(ws + WS_H), (const char*)(ws + WS_WIN) + (size_t)l * NIN * 1024 * 2, 1024, 1024, NIN / 256, (T / 256) * (NIN / 256), F.G, F.vcu};
            EpiWin E{ws, (const float*)(ws + WS_CS64), (const float*)(ws + WS_CS32)};
            pg8::gemm_phase<EpiWin, SchedGrid, false>(F.lds, 1024, 1024, Sg, E);
        }
        SEAM(P + 1);
        if (PHON(3) && IN(P + 2)) _Pragma("unroll 1") for (int rep_ = 0; rep_ < NREP(3); ++rep_) { PHASE_BEGIN();
            if (PHON(13)) {
                SchedCmp Sc{(const char*)(ws + WS_KCMP), (const char*)(ws + WS_VCMP), (const char*)(ws + WS_NSAW1) + (size_t)l * 2 * 256 * 2048 * 2, F.G, F.blk};
                EpiCmp E{(const float*)(ws + WS_B1P) + (size_t)l * 512, (const bf16*)(ws + WS_W2T) + (size_t)l * 2 * 64 * 256, ginp(F, I_B2K) + (size_t)l * 64, ginp(F, I_B2V) + (size_t)l * 64,
                         (bf16*)(ws + WS_KC), (bf16*)(ws + WS_VC), (const float*)(ws + WS_CS64)};
                pg8::gemm_phase<EpiCmp, SchedCmp, false>(F.lds, 1024, 2048, Sc, E);
            }
            PHASE_BEGIN();
            if (PHON(18)) {
                SchedMla Sm{(const char*)(ws + WS_CQ), (const char*)(ws + WS_MISC), (const char*)(ws + WS_MLAQ) + (size_t)l * 512 * 256 * 2, (const char*)(ws + WS_MLAKV) + (size_t)l * 512 * 256 * 2, F.G, F.vcu};
                EpiMla E{(bf16*)(ws + WS_QM), (bf16*)(ws + WS_KN), (bf16*)(ws + WS_VM), (const bf16*)(ws + WS_CQ), (const bf16*)(ws + WS_MISC), (const float*)(ws + WS_CS32), (LAS float*)(F.lds + AUX_OFF + 1024)};
                pg8::gemm_phase<EpiMla, SchedMla, false>(F.lds, 256, 256, Sm, E);
            }
            PHASE_BEGIN();
            if (PHON(15)) {
                unsigned* qw = (unsigned*)(ws + WS_CTL) + CW_QUEUE + (l * 2 + rep_) * 64;
                volatile LAS int* qslot = (volatile LAS int*)(F.lds + AUX_OFF + 512);
                int nxt_t = 0;
                if (F.tid == 0) nxt_t = (int)__hip_atomic_fetch_add(qw, 1u, RLX_AGENT);
                for (;;) {
                    if (F.tid == 0) { qslot[0] = nxt_t; nxt_t = (int)__hip_atomic_fetch_add(qw, 1u, RLX_AGENT); }
                    __syncthreads();
                    const int uq = qslot[0];
                    __syncthreads();
                    if (uq >= 2560) break;
                    if (uq < 1024) {
                        const int u = uq;
                        PolB pb; pb.Q = (const bf16*)(ws + WS_QB); pb.K = (const bf16*)(ws + WS_KWIN); pb.V = (const bf16*)(ws + WS_VWIN); pb.O = (bf16*)(ws + WS_OWIN);
                        pb.b = u >> 7; pb.g = (u >> 6) & 1; pb.qc = 63 - (u & 63); pb.maxd = 511u; pb.j0 = pb.qc > 8 ? pb.qc - 8 : 0; pb.j1 = pb.qc + 1;
                        attn_unit<64, PolB, false>(pb, F.lds, F.tid, F.lane, F.wave, 0ull);
                    } else {
                        const int uu = uq - 1024;
                        const int bh = uu / 48, w48 = uu % 48, p = w48 >> 4, s16 = w48 & 15;
                        PolA pa; pa.Q = (const bf16*)(ws + WS_QA); pa.K = (const bf16*)(ws + WS_KA); pa.V = (const bf16*)(ws + WS_VA);
                        pa.O = (bf16*)(ws + WS_OA3) + (size_t)p * T * 256; pa.LSEP = (float*)(ws + WS_LSEA) + (size_t)p * T * 4;
                        pa.b = bh >> 2; pa.h = bh & 3; pa.d = p == 0 ? 1 : (p == 1 ? 4 : 16);
                        const int cpr = p == 0 ? 16 : (p == 1 ? 4 : 1);
                        pa.r = s16 / cpr; pa.c = s16 % cpr; pa.maxd = 128u; pa.j0 = pa.c == 0 ? 2 : 0; pa.j1 = 6;
                        attn_unit<64, PolA, false>(pa, F.lds, F.tid, F.lane, F.wave, 0ull);
                    }
                }
            }
        }
        SEAM(P + 2);
        if (PHON(5) && IN(P + 4)) _Pragma("unroll 1") for (int rep_ = 0; rep_ < NREP(5); ++rep_) { PHASE_BEGIN();
            int cti = 0;
            int cq0 = 0;
            if (CONV_IN_LAYER) { const unsigned t_ = __hip_atomic_load((unsigned*)(ws + WS_CTL) + CW_CONVQ + l * 64, __ATOMIC_RELAXED, __HIP_MEMORY_SCOPE_AGENT); cq0 = __builtin_amdgcn_readfirstlane((int)(t_ < 3072u ? t_ : 3072u)); }
            if (PHON(19)) for (int u = F.vcu; u < 1024; u += F.G) {
                const int bg = (u % 256) >> 4, k = u & 15, rnd = u >> 8;
                const int qc = rnd == 0 ? 2 * k : (rnd == 1 ? 2 * k + 1 : (rnd == 2 ? 63 - 2 * k : 62 - 2 * k));
                const u64 sel = cmp_unit(F, bg >> 1, bg & 1, qc);
                PolB pb; pb.Q = (const bf16*)(ws + WS_QB); pb.K = (const bf16*)(ws + WS_KSLC); pb.V = (const bf16*)(ws + WS_VSLC); pb.O = (bf16*)(ws + WS_OSLC);
                pb.b = bg >> 1; pb.g = bg & 1; pb.qc = qc; pb.maxd = 0x7fffffffu; pb.j0 = 0; pb.j1 = qc + 1;
                pb.GC = (const bf16*)(ws + WS_OCMP); pb.GW = (const bf16*)(ws + WS_OWIN); pb.GM = (const bf16*)(ws + WS_MISC);
                attn_unit<64, PolB, true>(pb, F.lds, F.tid, F.lane, F.wave, sel);
                if (CONV_IN_LAYER && rep_ == 0) { PHASE_BEGIN(); conv_layer_tiles(F, l, cq0, cti, 2); cti += 2; }
            }
            PHASE_BEGIN();
            if (PHON(20)) for (int v = F.vcu; v < 512; v += F.G) {
                const int bh = (v & 255) >> 3, k = v & 7, c = (v < 256) ? k : 15 - k;
                PolM pm; pm.Q = (const bf16*)(ws + WS_QM); pm.KN = (const bf16*)(ws + WS_KN); pm.KR = (const bf16*)(ws + WS_KR); pm.V = (const bf16*)(ws + WS_VM); pm.O = (bf16*)(ws + WS_OC);
                pm.b = bh >> 2; pm.h = bh & 3; pm.c = c; pm.maxd = 0x7fffffffu; pm.j0 = 0; pm.j1 = 4 * c + 4;
                attn_unit<96, PolM, false>(pm, F.lds, F.tid, F.lane, F.wave, 0ull);
                if (CONV_IN_LAYER && rep_ == 0) { PHASE_BEGIN(); conv_layer_tiles(F, l, cq0, cti, 2); cti += 2; }
            }
            if (CONV_IN_LAYER && rep_ == 0) { PHASE_BEGIN(); conv_layer_tiles(F, l, cq0, cti, 1 << 20); }
        }
        SEAM(P + 4);
        if (PHON(7) && IN(P + 6)) _Pragma("unroll 1") for (int rep_ = 0; rep_ < NREP(7); ++rep_) { PHASE_BEGIN(); phase_mix(F, l); }
        SEAM(P + 6);
        if (PHON(8) && IN(P + 7)) _Pragma("unroll 1") for (int rep_ = 0; rep_ < (DUM(8) ? 2 : 1); ++rep_) { PHASE_BEGIN(); F.dofs = (DUM(8) && rep_ == 0) ? WS_END : 0;
            SchedGrid Sg{(const char*)(ws + WS_AMIX), (const char*)(ws + WS_WOUT) + (size_t)l * 1024 * 1024 * 2, 1024, 1024, 4, (T / 256) * 4, F.G, F.vcu};
            EpiWout E{(bf16*)(ws + WS_X), (const float*)(ws + WS_MODS) + ((size_t)(l * 8) * 6 + 2) * 1024, F.dofs};
            pg8::gemm_phase<EpiWout, SchedGrid, false>(F.lds, 1024, 1024, Sg, E);
        }
        SEAM(P + 7);
        if (PHON(9) && IN(P + 8)) _Pragma("unroll 1") for (int rep_ = 0; rep_ < (DUM(9) ? 2 : 1); ++rep_) { PHASE_BEGIN(); F.dofs = (DUM(9) && rep_ == 0) ? WS_END : 0; F.dcnt = (DUM(9) && rep_ == 0) ? 4 : 0; phase_router(F, l); }
        SEAM(P + 8);
        if (PHON(10) && IN(P + 9)) _Pragma("unroll 1") for (int rep_ = 0; rep_ < NREP(10); ++rep_) { PHASE_BEGIN();
            moe_tables(F, l);
            const LAS int* tb = (const LAS int*)(F.lds + AUX_OFF);
            SchedMoe1F8 Sm{tb, tb + 64, (const char*)(ws + WS_H), (const char*)(ws + WS_W1E) + (size_t)l * 32 * 2048 * 1024, (const int*)(ws + WS_IDX), tb[32] * 8, F.G, F.vcu};
            EpiMoe1 E{(bf16*)(ws + WS_ACT), ginp(F, I_BE1) + (size_t)l * 32 * 2048};
            pg8::gemm_phase<EpiMoe1, SchedMoe1F8, true, true>(F.lds, 512, 512, Sm, E);
            if (CONV_IN_LAYER && CONV_TAIL1 > 0 && rep_ == 0 && l + 1 < DEPTH) {
                const int nun = tb[32] * 8, rounds = (nun + F.G - 1) / F.G, mine = F.vcu < nun ? (nun - 1 - F.vcu) / F.G + 1 : 0;
                if (mine < rounds) { PHASE_BEGIN(); conv_claim_tiles(F, l + 1, CONV_TAIL1); }
            }
        }
        SEAM(P + 9);
        if (PHON(11) && IN(P + 10)) _Pragma("unroll 1") for (int rep_ = 0; rep_ < NREP(11); ++rep_) { PHASE_BEGIN();
            moe_tables(F, l);
            const LAS int* tb = (const LAS int*)(F.lds + AUX_OFF);
            SchedMoe2F8 Sm{tb, (const char*)(ws + WS_ACT), (const char*)(ws + WS_W2E) + (size_t)l * 32 * 1024 * 1024, tb[32] * 4, F.G, F.vcu};
            EpiMoe2 E{(unsigned char*)(ws + WS_Y2), ginp(F, I_BE2) + (size_t)l * 32 * 1024};
            pg8::gemm_phase<EpiMoe2, SchedMoe2F8, false, true>(F.lds, 512, 512, Sm, E);
            if (CONV_IN_LAYER && CONV_TAIL2 > 0 && rep_ == 0 && l + 1 < DEPTH) {
                const int nun = tb[32] * 4, rounds = (nun + F.G - 1) / F.G, mine = F.vcu < nun ? (nun - 1 - F.vcu) / F.G + 1 : 0;
                if (mine < rounds) { PHASE_BEGIN(); conv_claim_tiles(F, l + 1, CONV_TAIL2); }
            }
        }
        SEAM(P + 10);
    }
    if (PHON(12) && IN(N_PHASES - 1)) { PHASE_BEGIN(); phase_norm1<1>(F, DEPTH); }
#undef IN
#undef SEAM
}

extern "C" void kernel_launch(void* const* d_in, const int* in_sizes, int n_in, void* d_out, int out_size, void* d_ws, size_t ws_size, hipStream_t stream) {
    static int grid = 0;
    if (grid == 0) {
        if (n_in != 33 || out_size != T * D || ws_size < WS_END * (DUM_MASK ? 2 : 1)) { fprintf(stderr, "kernel_launch: unexpected problem (n_in %d out %d ws %zu)\n", n_in, out_size, ws_size); grid = -1; return; }
        int dev = 0, cus = 0, per_cu = 0;
        if (hipGetDevice(&dev) != hipSuccess || hipDeviceGetAttribute(&cus, hipDeviceAttributeMultiprocessorCount, dev) != hipSuccess) { grid = -1; return; }
        if (hipFuncSetAttribute((const void*)fwd_kernel, hipFuncAttributeMaxDynamicSharedMemorySize, LDS_BYTES) != hipSuccess) { fprintf(stderr, "kernel_launch: hipFuncSetAttribute failed\n"); grid = -1; return; }
        if (hipOccupancyMaxActiveBlocksPerMultiprocessor(&per_cu, (const void*)fwd_kernel, 512, LDS_BYTES) != hipSuccess || per_cu < 1) { fprintf(stderr, "kernel_launch: occupancy query says %d\n", per_cu); per_cu = 1; }
        (void)hipGetLastError();
        grid = cus;
    }
    if (grid < 0) return;
    if (hipMemsetAsync((char*)d_ws + WS_CTL, 0, CTL_ZERO_BYTES, stream) != hipSuccess) return;
    Args a{};
    for (int i = 0; i < 33; ++i) a.in[i] = (const float*)d_in[i];
    a.out = (float*)d_out; a.ws = (unsigned char*)d_ws;
#if MK_PER_PHASE
    for (int p = 0; p < N_PHASES; ++p) { a.ph_lo = p; a.ph_hi = p + 1; hipLaunchKernelGGL(fwd_kernel, dim3(grid), dim3(512), LDS_BYTES, stream, a); }
#else
    a.ph_lo = 0; a.ph_hi = N_PHASES;
    hipLaunchKernelGGL(fwd_kernel, dim3(grid), dim3(512), LDS_BYTES, stream, a);
#endif
}
```
